# Optimizing an MI355X kernel written in HIP

```python
import jax, jax.numpy as jnp
from jax import lax
import numpy as np

D_MODEL = 1024
BATCH = 1
SEQ = 16384
DEPTH = 1

GRID_W = 64
CTX_LEN = 256
HEAD_DIM = 64
N_Q_HEADS = 12
N_KV_HEADS = 4
Q_PER_KV = N_Q_HEADS // N_KV_HEADS
ATTN_WIDTH = N_Q_HEADS * HEAD_DIM
KV_WIDTH = N_KV_HEADS * HEAD_DIM
N_FOURIER_GROUPS = 4
FOURIER_GROUP_DIM = 64
FOURIER_WIDTH = N_FOURIER_GROUPS * FOURIER_GROUP_DIM
MIX_WIDTH = FOURIER_WIDTH + ATTN_WIDTH
IN_WIDTH = FOURIER_WIDTH + ATTN_WIDTH + 2 * KV_WIDTH
Q_BLOCK = 128
ROPE_BASE = 10000.0
N_EXPERTS = 16
EC_CAPACITY_FACTOR = 2
D_EXPERT = 2048
N_MOD = 6
NORM_EPS = 1e-6

kernel_name = "hymba_fnet_gqa_ec_moe_dit"


def rms_norm(x, g):
    xf = x.astype(jnp.float32)
    y = xf * lax.rsqrt(jnp.mean(xf * xf, axis=-1, keepdims=True) + NORM_EPS)
    return (y * g.astype(jnp.float32)).astype(x.dtype)


def modulate(x, g, shift, scale):
    return rms_norm(x, g) * (1 + scale) + shift


def split_projection(p):
    f = p[..., :FOURIER_WIDTH]
    q = p[..., FOURIER_WIDTH:FOURIER_WIDTH + ATTN_WIDTH]
    k = p[..., FOURIER_WIDTH + ATTN_WIDTH:FOURIER_WIDTH + ATTN_WIDTH + KV_WIDTH]
    v = p[..., FOURIER_WIDTH + ATTN_WIDTH + KV_WIDTH:]
    return f, q, k, v


def fourier_mix(f, w_four):
    B, N = f.shape[:2]
    fg = f.reshape(B, N, N_FOURIER_GROUPS, FOURIER_GROUP_DIM).astype(jnp.float32)
    y = jnp.fft.fftn(fg, axes=(1, 3), norm="ortho").real.astype(f.dtype)
    y = jnp.einsum('bngc,gcd->bngd', y, w_four)
    return y.reshape(B, N, FOURIER_WIDTH)


def rope_1d(x, pos):
    half = x.shape[-1] // 2
    freqs = ROPE_BASE ** (-jnp.arange(half, dtype=jnp.float32) / half)
    ang = pos.astype(jnp.float32)[:, None] * freqs[None, :]
    cos = jnp.cos(ang)[None, :, None, :]
    sin = jnp.sin(ang)[None, :, None, :]
    x1 = x[..., :half].astype(jnp.float32)
    x2 = x[..., half:].astype(jnp.float32)
    return jnp.concatenate([x1 * cos - x2 * sin, x1 * sin + x2 * cos], axis=-1).astype(x.dtype)


def axial_rope(x, row, col):
    h = HEAD_DIM // 2
    return jnp.concatenate([rope_1d(x[..., :h], row), rope_1d(x[..., h:], col)], axis=-1)


def heads(t, n_heads, g):
    B, N = t.shape[:2]
    return rms_norm(t.reshape(B, N, n_heads, HEAD_DIM), g)


def gqa_block(qi, k_all, v_all):
    s = jnp.einsum('bqkgd,bskd->bkgqs', qi, k_all).astype(jnp.float32) * (HEAD_DIM ** -0.5)
    p = jax.nn.softmax(s, axis=-1).astype(v_all.dtype)
    return jnp.einsum('bkgqs,bskd->bqkgd', p, v_all)


def latent_attention(q, k_lat, v_lat, k_ctx, v_ctx):
    B, N = q.shape[:2]
    k_all = jnp.concatenate([k_lat, k_ctx], axis=1)
    v_all = jnp.concatenate([v_lat, v_ctx], axis=1)
    nb = N // Q_BLOCK
    qb = q.reshape(B, nb, Q_BLOCK, N_KV_HEADS, Q_PER_KV, HEAD_DIM).swapaxes(0, 1)
    o = lax.map(lambda qi: gqa_block(qi, k_all, v_all), qb)
    return o.swapaxes(0, 1).reshape(B, N, ATTN_WIDTH)


def context_attention(q, k, v):
    B, L = q.shape[:2]
    qg = q.reshape(B, L, N_KV_HEADS, Q_PER_KV, HEAD_DIM)
    return gqa_block(qg, k, v).reshape(B, L, ATTN_WIDTH)


def expert_choice_ffn(h, w_router, w_gate, w_up, w_down):
    B, N, D = h.shape
    cap = EC_CAPACITY_FACTOR * N // N_EXPERTS
    aff = jax.nn.softmax(jnp.einsum('bnd,de->bne', h, w_router).astype(jnp.float32), axis=-1)
    gates, idx = lax.top_k(aff.swapaxes(1, 2), cap)
    bidx = jnp.arange(B)[:, None, None]
    xe = h[bidx, idx]
    hid = jax.nn.silu(jnp.einsum('becd,edf->becf', xe, w_gate)) * jnp.einsum('becd,edf->becf', xe, w_up)
    ye = jnp.einsum('becf,efd->becd', hid, w_down) * gates[..., None].astype(h.dtype)
    return jnp.zeros_like(h).at[bidx, idx].add(ye)


def setup_inputs(seed: int = 0) -> dict:
    key = jax.random.key(seed)
    ks = jax.random.split(key, 20)
    f32 = jnp.float32
    nrm = lambda k, shp, s: jax.random.normal(k, shp, f32) * s
    return {
        "x": nrm(ks[0], (BATCH, SEQ, D_MODEL), 1.0),
        "c": nrm(ks[1], (BATCH, D_MODEL), 1.0),
        "ctx": nrm(ks[2], (BATCH, CTX_LEN, D_MODEL), 1.0),
        "c_ctx": nrm(ks[3], (D_MODEL,), 1.0),
        "w_mod": nrm(ks[4], (DEPTH, D_MODEL, N_MOD * D_MODEL), 0.5 * D_MODEL ** -0.5),
        "b_mod": nrm(ks[5], (DEPTH, N_MOD * D_MODEL), 0.02),
        "norm_mix_g": 1.0 + nrm(ks[6], (DEPTH, D_MODEL), 0.1),
        "norm_ffn_g": 1.0 + nrm(ks[7], (DEPTH, D_MODEL), 0.1),
        "w_in": nrm(ks[8], (DEPTH, D_MODEL, IN_WIDTH), D_MODEL ** -0.5),
        "w_four": nrm(ks[9], (DEPTH, N_FOURIER_GROUPS, FOURIER_GROUP_DIM, FOURIER_GROUP_DIM), FOURIER_GROUP_DIM ** -0.5),
        "q_norm_g": 1.0 + nrm(ks[10], (DEPTH, HEAD_DIM), 0.1),
        "k_norm_g": 1.0 + nrm(ks[11], (DEPTH, HEAD_DIM), 0.1),
        "w_out": nrm(ks[12], (DEPTH, MIX_WIDTH, D_MODEL), MIX_WIDTH ** -0.5),
        "w_router": nrm(ks[13], (DEPTH, D_MODEL, N_EXPERTS), D_MODEL ** -0.5),
        "w_gate": nrm(ks[14], (DEPTH, N_EXPERTS, D_MODEL, D_EXPERT), D_MODEL ** -0.5),
        "w_up": nrm(ks[15], (DEPTH, N_EXPERTS, D_MODEL, D_EXPERT), D_MODEL ** -0.5),
        "w_down": nrm(ks[16], (DEPTH, N_EXPERTS, D_EXPERT, D_MODEL), D_EXPERT ** -0.5),
        "final_norm_g": 1.0 + nrm(ks[17], (D_MODEL,), 0.1),
    }


def reference(x, c, ctx, c_ctx, w_mod, b_mod, norm_mix_g, norm_ffn_g, w_in, w_four,
              q_norm_g, k_norm_g, w_out, w_router, w_gate, w_up, w_down, final_norm_g):
    B, N, _ = x.shape
    rows = N // GRID_W
    row = jnp.repeat(jnp.arange(rows, dtype=jnp.int32), GRID_W)
    col = jnp.tile(jnp.arange(GRID_W, dtype=jnp.int32), rows)

    for l in range(DEPTH):
        last = l == DEPTH - 1
        mod_x = (jax.nn.silu(c) @ w_mod[l] + b_mod[l])[:, None, :]
        mod_c = (jax.nn.silu(c_ctx) @ w_mod[l] + b_mod[l])[None, None, :]
        sh1, sc1, g1, sh2, sc2, g2 = jnp.split(mod_x, N_MOD, axis=-1)
        csh1, csc1, cg1, csh2, csc2, cg2 = jnp.split(mod_c, N_MOD, axis=-1)

        hx = modulate(x, norm_mix_g[l], sh1, sc1)
        hc = modulate(ctx, norm_mix_g[l], csh1, csc1)
        fx, qx, kx, vx = split_projection(hx @ w_in[l])
        fc, qc, kc, vc = split_projection(hc @ w_in[l])

        qx = axial_rope(heads(qx, N_Q_HEADS, q_norm_g[l]), row, col)
        kx = axial_rope(heads(kx, N_KV_HEADS, k_norm_g[l]), row, col)
        vx = vx.reshape(B, N, N_KV_HEADS, HEAD_DIM)
        kc = heads(kc, N_KV_HEADS, k_norm_g[l])
        vc = vc.reshape(B, ctx.shape[1], N_KV_HEADS, HEAD_DIM)

        attn_x = latent_attention(qx, kx, vx, kc, vc)
        four_x = fourier_mix(fx, w_four[l])
        x = x + g1 * (jnp.concatenate([four_x, attn_x], axis=-1) @ w_out[l])

        x = x + g2 * expert_choice_ffn(modulate(x, norm_ffn_g[l], sh2, sc2),
                                       w_router[l], w_gate[l], w_up[l], w_down[l])

        if not last:
            qc = heads(qc, N_Q_HEADS, q_norm_g[l])
            attn_c = context_attention(qc, kc, vc)
            four_c = fourier_mix(fc, w_four[l])
            ctx = ctx + cg1 * (jnp.concatenate([four_c, attn_c], axis=-1) @ w_out[l])
            ctx = ctx + cg2 * expert_choice_ffn(modulate(ctx, norm_ffn_g[l], csh2, csc2),
                                                w_router[l], w_gate[l], w_up[l], w_down[l])

    return rms_norm(x, final_norm_g)
```

```cpp
#include <hip/hip_runtime.h>
#include <hip/hip_bf16.h>
#include <cstdio>
#include <cstdint>
#include <cmath>

#ifndef STEP
#define STEP 4
#endif
#ifndef PROBE
#define PROBE 0
#endif
#ifndef PHMASK
#define PHMASK 0xFFFF
#endif
#define PH(k) ((PHMASK >> (k)) & 1)

constexpr int DM = 1024, NTOK = 16384, NCTX = 256, NROWS = NTOK + NCTX, INW = 1536;
constexpr int NHQ = 12, NHKV = 4, HD = 64, NE = 16, CAP = 2048, DE = 2048, NMOD = 6;
constexpr int NKEYS = NROWS;
constexpr float EPS = 1e-6f;

__device__ __forceinline__ int fresh_lane() { int l; asm volatile("v_mbcnt_lo_u32_b32 %0, -1, 0\n\tv_mbcnt_hi_u32_b32 %0, -1, %0" : "=v"(l)); return l; }

namespace pg8 {
#define PG8_LAS __attribute__((address_space(3)))
typedef unsigned short bf16_t;
typedef short bf16x8 __attribute__((ext_vector_type(8)));
typedef float f32x4 __attribute__((ext_vector_type(4)));
typedef unsigned u32x4 __attribute__((ext_vector_type(4)));
typedef unsigned u32x2 __attribute__((ext_vector_type(2)));
constexpr int BM = 256, BK = 64, HALF = 128, HTB = HALF * BK * 2, STAGE_BYTES = 8 * HTB, NXCD = 8, WGM = 8;

__host__ __device__ __forceinline__ int lds_byte(int r, int c) { const int st = (r >> 4) * 2 + (c >> 5), rr = r & 15, cc = c & 31, ob = rr * 64 + cc * 2; return st * 1024 + (ob ^ (((ob >> 9) & 1) << 5)); }
__host__ __device__ __forceinline__ void stage_rc(int b, int& R, int& C) { const int st = b / 1024, sb = b % 1024, swz = sb ^ (((sb >> 9) & 1) << 5); R = (st >> 1) * 16 + swz / 64; C = (st & 1) * 32 + (swz % 64) / 2; }
__host__ __device__ __forceinline__ int perm32(int rho) { const int n = rho >> 4, i = rho & 15; return 8 * (i >> 2) + 4 * n + (i & 3); }

struct Unit { int pm, pn; };

struct StaticOrder {
    int nM, nN, nwg, G, c;
    __host__ __device__ void init(int nM_, int nN_, int G_, int c_) { nM = nM_; nN = nN_; nwg = nM * nN; G = G_; c = c_; }
    __host__ __device__ bool next(int i, Unit& u) const {
        const long L = (long)i * G + c; if (L >= nwg) return false;
        int wgid = (int)L; { const int q = nwg / NXCD, r = nwg % NXCD, xcd = wgid % NXCD, off = wgid / NXCD; wgid = (xcd < r ? xcd * (q + 1) : r * (q + 1) + (xcd - r) * q) + off; }
        const int nig = WGM * nN, gid = wgid / nig, fm = gid * WGM, gsz = (nM - fm) < WGM ? (nM - fm) : WGM;
        u.pm = fm + ((wgid % nig) % gsz); u.pn = (wgid % nig) / gsz; return true;
    }
};

__device__ __forceinline__ unsigned cvt_pk_bf16(float lo, float hi) { unsigned r; asm volatile("v_cvt_pk_bf16_f32 %0, %1, %2" : "=v"(r) : "v"(lo), "v"(hi)); return r; }

template <class P, bool GATHER, bool ALIGN_EPI, bool SP2>
__device__ __forceinline__ void gemm_phase(PG8_LAS unsigned char* lds, const P& S, const PG8_LAS unsigned* rowtab, int wid) {
    const int lane = fresh_lane(), tid = wid * 64 + lane, wr = wid >> 2, wc = wid & 3, fr = lane & 15, fq = lane >> 4;
    constexpr int K = P::K, nt = K / BK;
    int R0, C0; stage_rc(tid * 16, R0, C0);
    unsigned voffB[2];
#pragma unroll
    for (int i = 0; i < 2; ++i) { const int R = R0 + 64 * i; const int Rb = P::PERM ? ((R & ~31) + perm32(R & 31)) : R; voffB[i] = (unsigned)(Rb * K + C0) * 2u; }
    constexpr size_t kstep = (size_t)(BK * 2);
    constexpr size_t hstep = (size_t)HALF * K * 2;
    const unsigned ldsw = (unsigned)wid * 1024u;
    const int aoff = lds_byte(wr * 64 + fr, fq * 8), boff = lds_byte(wc * 32 + fr, fq * 8);
#define PG8_SA(b, h) (((b) * 2 + (h)) * HTB)
#define PG8_SB(b, h) ((4 + (b) * 2 + (h)) * HTB)
#define PG8_STAGE(bufoff, gbase, voff) do { _Pragma("unroll") for (int _i = 0; _i < 2; ++_i) \
        __builtin_amdgcn_global_load_lds((const unsigned*)((const char*)(gbase) + (voff)[_i]), (PG8_LAS unsigned*)(lds + (bufoff) + ldsw + _i * 8192), 16, 0, 0); } while (0)
#define PG8_LDA(dst, b, h) do { _Pragma("unroll") for (int m = 0; m < 4; ++m) _Pragma("unroll") for (int k = 0; k < 2; ++k) dst[m][k] = *(const PG8_LAS bf16x8*)(lds + PG8_SA(b, h) + aoff + m * 2048 + k * 1024); } while (0)
#define PG8_LDB(dst, b, h) do { _Pragma("unroll") for (int n = 0; n < 2; ++n) _Pragma("unroll") for (int k = 0; k < 2; ++k) dst[n][k] = *(const PG8_LAS bf16x8*)(lds + PG8_SB(b, h) + boff + n * 2048 + k * 1024); } while (0)
#define PG8_MMA(ai, bj, At, Bt) do { __builtin_amdgcn_s_setprio(1); _Pragma("unroll") for (int m = 0; m < 4; ++m) _Pragma("unroll") for (int n = 0; n < 2; ++n) _Pragma("unroll") for (int k = 0; k < 2; ++k) \
        acc[ai][bj][m][n] = __builtin_amdgcn_mfma_f32_16x16x32_bf16(Bt[n][k], At[m][k], acc[ai][bj][m][n], 0, 0, 0); __builtin_amdgcn_s_setprio(0); } while (0)
#define PG8_WAIT_V(n) asm volatile("s_waitcnt vmcnt(" #n ")" ::: "memory")
#define PG8_WAIT_L(n) asm volatile("s_waitcnt lgkmcnt(" #n ")" ::: "memory")
#define PG8_BAR __builtin_amdgcn_s_barrier()
#define PG8_SCHED __builtin_amdgcn_sched_barrier(0)
#define PG8_AOFF(dst, u_, ui_) do { _Pragma("unroll") for (int _h = 0; _h < 2; ++_h) _Pragma("unroll") for (int _i = 0; _i < 2; ++_i) { \
        if constexpr (GATHER) dst[_h][_i] = (unsigned)(rowtab[(ui_) * 256 + _h * HALF + _i * 64 + R0] * (unsigned)K + (unsigned)C0) * 2u; \
        else dst[_h][_i] = (unsigned)((_h * HALF + _i * 64 + R0) * K + C0) * 2u; } } while (0)
    Unit cur, nxt; int ui = 0;
    if (!S.next(0, cur)) return;
    f32x4 acc[2][2][4][2];
#pragma unroll
    for (int a = 0; a < 2; ++a)
#pragma unroll
        for (int b = 0; b < 2; ++b)
#pragma unroll
            for (int m = 0; m < 4; ++m)
#pragma unroll
                for (int n = 0; n < 2; ++n) acc[a][b][m][n] = (f32x4){0.f, 0.f, 0.f, 0.f};
    bf16x8 At[4][2], B0[2][2], B1[2][2];
    unsigned vAc[2][2], vAn[2][2];
    PG8_AOFF(vAc, cur, 0);
    const char* cA = S.aptr(cur); const char* cB = S.bptr(cur);
    if constexpr (SP2) {
        PG8_STAGE(PG8_SB(0, 0), cB, voffB); PG8_STAGE(PG8_SB(0, 1), cB + hstep, voffB); PG8_STAGE(PG8_SA(0, 0), cA, vAc[0]); PG8_STAGE(PG8_SA(0, 1), cA, vAc[1]);
        if (wr == 1) PG8_BAR;
        PG8_WAIT_V(2); PG8_BAR;
        PG8_STAGE(PG8_SB(1, 0), cB + kstep, voffB); PG8_STAGE(PG8_SA(1, 0), cA + kstep, vAc[0]); PG8_STAGE(PG8_SB(1, 1), cB + hstep + kstep, voffB);
        PG8_WAIT_V(6); PG8_BAR;
    } else {
        PG8_STAGE(PG8_SB(0, 0), cB, voffB); PG8_STAGE(PG8_SA(0, 0), cA, vAc[0]); PG8_STAGE(PG8_SB(0, 1), cB + hstep, voffB); PG8_STAGE(PG8_SA(0, 1), cA, vAc[1]);
        if (wr == 1) PG8_BAR;
        PG8_WAIT_V(4); PG8_BAR;
        PG8_STAGE(PG8_SB(1, 0), cB + kstep, voffB); PG8_STAGE(PG8_SA(1, 0), cA + kstep, vAc[0]); PG8_STAGE(PG8_SB(1, 1), cB + hstep + kstep, voffB);
        PG8_WAIT_V(6); PG8_BAR;
    }
    for (;;) {
        const bool has_next = S.next(ui + 1, nxt);
        const char* nA = has_next ? S.aptr(nxt) : cA; const char* nB = has_next ? S.bptr(nxt) : cB;
        if (has_next) { PG8_AOFF(vAn, nxt, ui + 1); }
        else {
#pragma unroll
            for (int h = 0; h < 2; ++h)
#pragma unroll
                for (int i = 0; i < 2; ++i) vAn[h][i] = vAc[h][i];
        }
        for (int t = 0; t < nt; t += 2) {
            const bool last = (t == nt - 2);
            const char* a1 = cA + (size_t)(t + 1) * kstep;
            const char* a2 = last ? nA : cA + (size_t)(t + 2) * kstep; const char* b2 = last ? nB : cB + (size_t)(t + 2) * kstep;
            const char* a3 = a2 + kstep; const char* b3 = b2 + kstep;
            unsigned w2[2][2];
#pragma unroll
            for (int h = 0; h < 2; ++h)
#pragma unroll
                for (int i = 0; i < 2; ++i) w2[h][i] = last ? vAn[h][i] : vAc[h][i];
            if constexpr (SP2) {
            PG8_LDB(B0, 0, 0); PG8_LDB(B1, 0, 1); PG8_SCHED; PG8_LDA(At, 0, 0); PG8_STAGE(PG8_SA(1, 1), a1, vAc[1]);
            PG8_WAIT_V(8); PG8_WAIT_L(0); PG8_BAR; PG8_MMA(0, 0, At, B0); PG8_MMA(0, 1, At, B1); PG8_BAR; PG8_SCHED;
            PG8_LDA(At, 0, 1); PG8_STAGE(PG8_SB(0, 0), b2, voffB); PG8_STAGE(PG8_SB(0, 1), b2 + hstep, voffB); PG8_STAGE(PG8_SA(0, 0), a2, w2[0]);
            PG8_WAIT_V(8); PG8_WAIT_L(0); PG8_BAR; PG8_MMA(1, 0, At, B0); PG8_MMA(1, 1, At, B1); PG8_BAR; PG8_SCHED;
            PG8_LDB(B0, 1, 0); PG8_LDB(B1, 1, 1); PG8_SCHED; PG8_LDA(At, 1, 0); PG8_STAGE(PG8_SA(0, 1), a2, w2[1]);
            PG8_WAIT_V(8); PG8_WAIT_L(0); PG8_BAR; PG8_MMA(0, 0, At, B0); PG8_MMA(0, 1, At, B1); PG8_BAR; PG8_SCHED;
            PG8_LDA(At, 1, 1); PG8_STAGE(PG8_SB(1, 0), b3, voffB); PG8_STAGE(PG8_SB(1, 1), b3 + hstep, voffB); PG8_STAGE(PG8_SA(1, 0), a3, w2[0]);
            PG8_WAIT_V(8); PG8_WAIT_L(0); PG8_BAR; PG8_MMA(1, 0, At, B0); PG8_MMA(1, 1, At, B1); PG8_BAR; PG8_SCHED;
            } else {
            PG8_LDB(B0, 0, 0); PG8_SCHED; PG8_LDA(At, 0, 0); PG8_STAGE(PG8_SA(1, 1), a1, vAc[1]);
            PG8_WAIT_L(8); PG8_BAR; PG8_WAIT_L(0); PG8_MMA(0, 0, At, B0); PG8_BAR; PG8_SCHED;
            PG8_LDB(B1, 0, 1); PG8_STAGE(PG8_SB(0, 0), b2, voffB);
            PG8_BAR; PG8_WAIT_L(0); PG8_MMA(0, 1, At, B1); PG8_BAR;
            PG8_LDA(At, 0, 1); PG8_STAGE(PG8_SA(0, 0), a2, w2[0]);
            PG8_BAR; PG8_WAIT_L(0); PG8_MMA(1, 0, At, B0); PG8_BAR; PG8_SCHED;
            PG8_STAGE(PG8_SB(0, 1), b2 + hstep, voffB);
            PG8_WAIT_V(6); PG8_BAR; PG8_MMA(1, 1, At, B1); PG8_BAR;
            PG8_LDB(B0, 1, 0); PG8_SCHED; PG8_LDA(At, 1, 0); PG8_STAGE(PG8_SA(0, 1), a2, w2[1]);
            PG8_WAIT_L(8); PG8_BAR; PG8_WAIT_L(0); PG8_MMA(0, 0, At, B0); PG8_BAR; PG8_SCHED;
            PG8_LDB(B1, 1, 1); PG8_STAGE(PG8_SB(1, 0), b3, voffB);
            PG8_BAR; PG8_WAIT_L(0); PG8_MMA(0, 1, At, B1); PG8_BAR;
            PG8_LDA(At, 1, 1); PG8_STAGE(PG8_SA(1, 0), a3, w2[0]);
            PG8_BAR; PG8_WAIT_L(0); PG8_MMA(1, 0, At, B0); PG8_BAR; PG8_SCHED;
            PG8_STAGE(PG8_SB(1, 1), b3 + hstep, voffB);
            PG8_WAIT_V(6); PG8_BAR; PG8_MMA(1, 1, At, B1); PG8_BAR;
            }
        }
        if constexpr (ALIGN_EPI) { if (wr == 0) PG8_BAR; }
        S.epi(acc, cur, wr, wc, fr, fq);
        if (!has_next) break;
#pragma unroll
        for (int a = 0; a < 2; ++a)
#pragma unroll
            for (int b = 0; b < 2; ++b)
#pragma unroll
                for (int m = 0; m < 4; ++m)
#pragma unroll
                    for (int n = 0; n < 2; ++n) acc[a][b][m][n] = (f32x4){0.f, 0.f, 0.f, 0.f};
        cur = nxt; cA = nA; cB = nB; ++ui;
#pragma unroll
        for (int h = 0; h < 2; ++h)
#pragma unroll
            for (int i = 0; i < 2; ++i) vAc[h][i] = vAn[h][i];
        if constexpr (ALIGN_EPI) { if (wr == 1) PG8_BAR; }
    }
    PG8_WAIT_V(0);
    if constexpr (!ALIGN_EPI) { if (wr == 0) PG8_BAR; }
    PG8_BAR;
#undef PG8_SA
#undef PG8_SB
#undef PG8_STAGE
#undef PG8_LDA
#undef PG8_LDB
#undef PG8_MMA
#undef PG8_WAIT_V
#undef PG8_WAIT_L
#undef PG8_BAR
#undef PG8_SCHED
#undef PG8_AOFF
}
}

namespace attn_body {
using bf16 = __hip_bfloat16;
using bf16x8 = __attribute__((ext_vector_type(8))) short;
using s16x4 = __attribute__((ext_vector_type(4))) short;
using f32x16 = __attribute__((ext_vector_type(16))) float;
using u32x4 = __attribute__((ext_vector_type(4))) unsigned;
constexpr int D = 64, QPITCH = NHQ * D, KPITCH = NHKV * D, OPITCH = DM, OCOL0 = 256;
constexpr int NW = 8, QBLK = 32, QB = QBLK * NW, KVBLK = 64, NQB = NTOK / QB, NT = NKEYS / KVBLK;
static_assert(NT % 2 == 0 && NT >= 8, "tile count");
__device__ __forceinline__ int crow(int r, int hi) { return (r & 3) + 8 * (r >> 2) + 4 * hi; }
#define SBAR() __builtin_amdgcn_sched_barrier(0)
constexpr int NSLOT = 3, SLOTB = 8192;
constexpr int LDS_K = 0, LDS_V = NSLOT * SLOTB, LDS_WS = 2 * NSLOT * SLOTB, LDS_OST = LDS_WS + NW * 64 * 4, LDS_BYTES = LDS_OST + NW * 4096;
constexpr float C2 = 0.125f * 1.4426950408889634f;
__device__ __forceinline__ void glds16(const void* gsrc, unsigned lds_dst) { unsigned keep;
  asm volatile("s_mov_b32 %0, m0\n\ts_mov_b32 m0, %2\n\ts_nop 0\n\tglobal_load_lds_dwordx4 %1, off\n\ts_mov_b32 m0, %0" : "=&s"(keep) : "v"(gsrc), "s"(lds_dst) : "memory"); }
__device__ __forceinline__ float max3f(float a, float b, float c) { float r; asm("v_max3_f32 %0, %1, %2, %3" : "=v"(r) : "v"(a), "v"(b), "v"(c)); return r; }
__device__ __forceinline__ float max2f(float a, float b) { float r; asm("v_max_f32_e32 %0, %1, %2" : "=v"(r) : "v"(a), "v"(b)); return r; }
__device__ __forceinline__ float fadd_s(float a, float b) { float r; asm("v_add_f32_e32 %0, %1, %2" : "=v"(r) : "v"(a), "v"(b)); return r; }
__device__ __forceinline__ float fsub_s(float a, float b) { float r; asm("v_sub_f32_e32 %0, %1, %2" : "=v"(r) : "v"(a), "v"(b)); return r; }
typedef float f32x2_t __attribute__((ext_vector_type(2))); typedef __bf16 bf16x2_t __attribute__((ext_vector_type(2)));
__device__ __forceinline__ unsigned cvtpk_s(float lo, float hi) { f32x2_t v = {lo, hi}; bf16x2_t b = __builtin_convertvector(v, bf16x2_t); return __builtin_bit_cast(unsigned, b); }
#define WAIT_BAR(N) asm volatile("s_waitcnt vmcnt(" #N ") lgkmcnt(0)\n\ts_barrier" ::: "memory")

__device__ __forceinline__ void qkt(f32x16& p0, f32x16& p1, const char* Kslot, const bf16x8* qr, const f32x16& negm, int r32, int hi) {
  const char* kb = Kslot + hi * 1024 + r32 * 16;
  #pragma unroll
  for (int d0 = 0; d0 < 4; ++d0) {
    const bf16x8 b0 = *reinterpret_cast<const bf16x8*>(kb + d0 * 2048);
    const bf16x8 b1 = *reinterpret_cast<const bf16x8*>(kb + d0 * 2048 + 512);
    if (d0 == 0) { p0 = __builtin_amdgcn_mfma_f32_32x32x16_bf16(b0, qr[0], negm, 0, 0, 0); p1 = __builtin_amdgcn_mfma_f32_32x32x16_bf16(b1, qr[0], negm, 0, 0, 0); }
    else { p0 = __builtin_amdgcn_mfma_f32_32x32x16_bf16(b0, qr[d0], p0, 0, 0, 0); p1 = __builtin_amdgcn_mfma_f32_32x32x16_bf16(b1, qr[d0], p1, 0, 0, 0); } }
}
typedef __attribute__((address_space(3))) const char* lds_cptr;
typedef short v4i16_t __attribute__((ext_vector_type(4)));
__device__ __forceinline__ void kload8(bf16x8* kf, lds_cptr kp) {
  kf[0] = *(const __attribute__((address_space(3))) bf16x8*)(kp);        kf[1] = *(const __attribute__((address_space(3))) bf16x8*)(kp + 512);
  kf[2] = *(const __attribute__((address_space(3))) bf16x8*)(kp + 2048); kf[3] = *(const __attribute__((address_space(3))) bf16x8*)(kp + 2560);
  kf[4] = *(const __attribute__((address_space(3))) bf16x8*)(kp + 4096); kf[5] = *(const __attribute__((address_space(3))) bf16x8*)(kp + 4608);
  kf[6] = *(const __attribute__((address_space(3))) bf16x8*)(kp + 6144); kf[7] = *(const __attribute__((address_space(3))) bf16x8*)(kp + 6656);
}
__device__ __forceinline__ void kload2(bf16x8* kf, lds_cptr kp, int j) { kf[2 * j] = *(const __attribute__((address_space(3))) bf16x8*)(kp + j * 2048); kf[2 * j + 1] = *(const __attribute__((address_space(3))) bf16x8*)(kp + j * 2048 + 512); }
__device__ __forceinline__ s16x4 vtr(lds_cptr p) { return __builtin_bit_cast(s16x4, __builtin_amdgcn_ds_read_tr16_b64_v4i16((__attribute__((address_space(3))) v4i16_t*)p)); }
__device__ __forceinline__ float rowmax(const f32x16& p0, const f32x16& p1) {
  float a = max3f(p0[0], p0[1], p1[0]), b = max3f(p0[2], p0[3], p1[1]); a = max3f(a, p1[2], p1[3]);
  #pragma unroll
  for (int r = 4; r < 16; r += 4) { a = max3f(a, p0[r], p0[r + 1]); b = max3f(b, p0[r + 2], p0[r + 3]); a = max3f(a, p1[r], p1[r + 1]); b = max3f(b, p1[r + 2], p1[r + 3]); }
  const float m = max2f(a, b);
  auto rr = __builtin_amdgcn_permlane32_swap(__float_as_uint(m), __float_as_uint(m), false, false);
  return max2f(__uint_as_float(rr[0]), __uint_as_float(rr[1]));
}
__device__ __forceinline__ void pv(f32x16* o, int vb, bf16x8 pa0, bf16x8 pa1, bf16x8 pa2, bf16x8 pa3) {
  #pragma unroll
  for (int d0 = 0; d0 < 2; ++d0) { s16x4 lo[4], hi[4];
    #pragma unroll
    for (int ks = 0; ks < 4; ++ks) {
      asm volatile("ds_read_b64_tr_b16 %0,%1 offset:%c2" : "=&v"(lo[ks]) : "v"(vb), "i"(d0 * 4096 + ks * 1024) : "memory");
      asm volatile("ds_read_b64_tr_b16 %0,%1 offset:%c2" : "=&v"(hi[ks]) : "v"(vb), "i"(d0 * 4096 + ks * 1024 + 512) : "memory"); }
    asm volatile("s_waitcnt lgkmcnt(0)" ::: "memory"); SBAR();
    #define PK(k) (bf16x8){lo[k][0], lo[k][1], lo[k][2], lo[k][3], hi[k][0], hi[k][1], hi[k][2], hi[k][3]}
    o[d0] = __builtin_amdgcn_mfma_f32_32x32x16_bf16(pa0, PK(0), o[d0], 0, 0, 0);
    o[d0] = __builtin_amdgcn_mfma_f32_32x32x16_bf16(pa1, PK(1), o[d0], 0, 0, 0);
    o[d0] = __builtin_amdgcn_mfma_f32_32x32x16_bf16(pa2, PK(2), o[d0], 0, 0, 0);
    o[d0] = __builtin_amdgcn_mfma_f32_32x32x16_bf16(pa3, PK(3), o[d0], 0, 0, 0);
    #undef PK
  }
}
#define ATTN_STORE16(p, v) (*(u32x4*)(p) = (v))
template <int THRL> __device__ __forceinline__ void attn_unit(int h, int kvh, int qb, const bf16* Q, const bf16* __restrict__ K, const bf16* __restrict__ V, bf16* O, char* shm, int wid) {
  const int lane = fresh_lane(), r32 = lane & 31, hi = lane >> 5;
  const int q0 = qb * QB;
  const bf16* Qw = Q + (long)(q0 + wid * QBLK) * QPITCH + h * D;
  const bf16* Kh = K + kvh * D, *Vh = V + kvh * D;
  const unsigned lds0 = (unsigned)(uintptr_t)shm;
  float* wsf = (float*)(shm + LDS_WS) + wid * 64;
  const bf16* ksrc = Kh + (long)lane * KPITCH + wid * 8;
  const bf16* vsrc = Vh + (long)(16 * (wid & 3) + (lane >> 2)) * KPITCH + (wid >> 2) * 32 + (lane & 3) * 8;
  const unsigned kdst = lds0 + LDS_K + wid * 1024, vdst = lds0 + LDS_V + wid * 1024;
  #define DMA_K(t, slot) glds16(ksrc + (long)(t) * KVBLK * KPITCH, (unsigned)__builtin_amdgcn_readfirstlane(kdst + (slot)))
  #define DMA_V(t, slot) glds16(vsrc + (long)(t) * KVBLK * KPITCH, (unsigned)__builtin_amdgcn_readfirstlane(vdst + (slot)))
  const int vb0 = (int)(lds0 + LDS_V) + ((lane >> 4) & 1) * 32 + (lane & 3) * 8 + (4 * hi + ((lane & 15) >> 2)) * 64;
  const char* Kbase = shm + LDS_K; bf16x8 kf[8];
  const lds_cptr shm3 = (lds_cptr)shm; const lds_cptr kp0 = shm3 + LDS_K + hi * 1024 + r32 * 16; const lds_cptr vp0 = shm3 + LDS_V + ((lane >> 4) & 1) * 32 + (lane & 3) * 8 + (4 * hi + ((lane & 15) >> 2)) * 64;
  DMA_K(0, 0); DMA_V(0, 0); DMA_K(1, SLOTB);
  bf16x8 qr[4];
  #pragma unroll
  for (int d0 = 0; d0 < 4; ++d0) qr[d0] = *reinterpret_cast<const bf16x8*>(&Qw[(long)r32 * QPITCH + d0 * 16 + hi * 8]);
  float mhat = 0.f, l_reg = 0.f; f32x16 o[2]; o[0] = f32x16{}; o[1] = f32x16{}; f32x16 negm = f32x16{}; asm volatile("" : "+v"(negm));
  bool resc = false;
  #define START(P0, P1) do { const float rm = rowmax(P0, P1); resc = false; \
    { const float dl = rm; mhat = fadd_s(mhat, dl); \
      _Pragma("unroll") for (int r = 0; r < 16; ++r) { P0[r] = fsub_s(P0[r], dl); P1[r] = fsub_s(P1[r], dl); } \
      _Pragma("unroll") for (int r = 0; r < 16; ++r) negm[r] = -mhat; asm volatile("" : "+v"(negm)); } \
    _Pragma("unroll") for (int r = 0; r < 16; ++r) P0[r] = __builtin_amdgcn_exp2f(P0[r]); } while (0)
  #define RESC() do { if (resc) { asm volatile("s_waitcnt lgkmcnt(0)" ::: "memory"); \
      _Pragma("unroll") for (int d_ = 0; d_ < 2; ++d_) _Pragma("unroll") for (int r = 0; r < 16; ++r) o[d_][r] *= wsf[crow(r, hi)]; } } while (0)
  f32x16 pA0, pA1, pB0, pB1;
  int sl_prev = 0, sl_cur = 0, sl_next = SLOTB;
  #define ROT() do { sl_prev = sl_cur; sl_cur = sl_next; sl_next = (sl_next == (NSLOT - 1) * SLOTB) ? 0 : sl_next + SLOTB; } while (0)
  DMA_K(2, 2 * SLOTB);
  WAIT_BAR(3);
  qkt(pA0, pA1, Kbase, qr, negm, r32, hi); asm volatile("s_nop 15\n\ts_nop 7" : "+v"(pA0), "+v"(pA1));
  START(pA0, pA1);
  _Pragma("unroll") for (int r = 0; r < 16; ++r) pA1[r] = __builtin_amdgcn_exp2f(pA1[r]);
  WAIT_BAR(0);
  DMA_K(3, 0); DMA_V(1, SLOTB);
  ROT();
  kload8(kf, kp0 + sl_cur);
  WAIT_BAR(2);
  s16x4 vlo[8], vhi[8]; u32x4 pw0, pw1, pw2, pw3;
  #define PKW(P, B) cvtpk_s(P[B], P[B + 1])
  #define PAF(k) __builtin_bit_cast(bf16x8, pw##k)
  #define VFR(i) (bf16x8){vlo[i][0], vlo[i][1], vlo[i][2], vlo[i][3], vhi[i][0], vhi[i][1], vhi[i][2], vhi[i][3]}
  #define PIN(x) asm volatile("" : "+v"(x))
  #define MX3(a, b, c) __builtin_fmaxf(__builtin_fmaxf((a), (b)), (c))
  #define GAPA(MF, A0, A1, A2, A3, W0, W1, PW) do { MF; sacc += A0; sacc += A1; sacc += A2; sacc += A3; PIN(sacc); W0; W1; PIN(PW); SBAR(); } while (0)
  #define EX(v) __builtin_amdgcn_exp2f(v)
  #define GAPB(MF, X, B) do { MF; X[B] = EX(X[B]); X[B + 1] = EX(X[B + 1]); X[B + 2] = EX(X[B + 2]); X[B + 3] = EX(X[B + 3]); PIN(X); SBAR(); } while (0)
  #define VRD(i) do { vlo[i] = vtr(vp_ + (((i) >> 2) * 4096 + ((i) & 3) * 1024)); vhi[i] = vtr(vp_ + (((i) >> 2) * 4096 + ((i) & 3) * 1024 + 512)); } while (0)
  #define KRD(G, j) do { if (G) { kload2(kf, kp0 + sl_next, j); SBAR(); } } while (0)
  #define STEPM(C0, C1, P0, P1, t, GK, GV, GL) do { SBAR(); \
    const lds_cptr vp_ = vp0 + sl_prev; \
    VRD(0); SBAR(); float sacc = (P0[0] + P0[1]); \
    GAPA(C0 = __builtin_amdgcn_mfma_f32_32x32x16_bf16(kf[0], qr[0], negm, 0, 0, 0), P0[2], P0[3], P0[4], P0[5],     pw0[0] = PKW(P0, 0), pw0[1] = PKW(P0, 2), pw0); \
    VRD(4); SBAR(); GAPA(C1 = __builtin_amdgcn_mfma_f32_32x32x16_bf16(kf[1], qr[0], negm, 0, 0, 0), P0[6], P0[7], P0[8], P0[9],     pw0[2] = PKW(P0, 4), pw0[3] = PKW(P0, 6), pw0); \
    VRD(1); SBAR(); GAPA(C0 = __builtin_amdgcn_mfma_f32_32x32x16_bf16(kf[2], qr[1], C0, 0, 0, 0),   P0[10], P0[11], P0[12], P0[13], pw1[0] = PKW(P0, 8), pw1[1] = PKW(P0, 10), pw1); \
    VRD(5); SBAR(); GAPA(C1 = __builtin_amdgcn_mfma_f32_32x32x16_bf16(kf[3], qr[1], C1, 0, 0, 0),   P0[14], P0[15], P1[0], P1[1],   pw1[2] = PKW(P0, 12), pw1[3] = PKW(P0, 14), pw1); \
    VRD(2); SBAR(); GAPA(C0 = __builtin_amdgcn_mfma_f32_32x32x16_bf16(kf[4], qr[2], C0, 0, 0, 0),   P1[2], P1[3], P1[4], P1[5],     pw2[0] = PKW(P1, 0), pw2[1] = PKW(P1, 2), pw2); \
    VRD(6); SBAR(); GAPA(C1 = __builtin_amdgcn_mfma_f32_32x32x16_bf16(kf[5], qr[2], C1, 0, 0, 0),   P1[6], P1[7], P1[8], P1[9],     pw2[2] = PKW(P1, 4), pw2[3] = PKW(P1, 6), pw2); \
    VRD(3); SBAR(); GAPA(C0 = __builtin_amdgcn_mfma_f32_32x32x16_bf16(kf[6], qr[3], C0, 0, 0, 0),   P1[10], P1[11], P1[12], P1[13], pw3[0] = PKW(P1, 8), pw3[1] = PKW(P1, 10), pw3); \
    VRD(7); SBAR(); GAPA(C1 = __builtin_amdgcn_mfma_f32_32x32x16_bf16(kf[7], qr[3], C1, 0, 0, 0),   P1[14], P1[15], 0.f, 0.f,       pw3[2] = PKW(P1, 12), pw3[3] = PKW(P1, 14), pw3); \
    l_reg += sacc; \
    if (GK) { DMA_K((t) + 3, sl_cur); } if (GV) { DMA_V((t) + 1, sl_next); } \
    { float a = MX3(C0[0], C0[1], C1[0]), b = MX3(C0[2], C0[3], C1[1]); a = MX3(a, C1[2], C1[3]); \
      _Pragma("unroll") for (int r = 4; r < 16; r += 4) { a = MX3(a, C0[r], C0[r + 1]); b = MX3(b, C0[r + 2], C0[r + 3]); a = MX3(a, C1[r], C1[r + 1]); b = MX3(b, C1[r + 2], C1[r + 3]); } \
      float rm = __builtin_fmaxf(a, b); { auto rr = __builtin_amdgcn_permlane32_swap(__float_as_uint(rm), __float_as_uint(rm), false, false); rm = __builtin_fmaxf(__uint_as_float(rr[0]), __uint_as_float(rr[1])); } \
      resc = false; \
      if (__builtin_expect(__any(rm > (float)THRL), 0)) { const float dl = __builtin_fmaxf(rm, 0.f); mhat += dl; \
        _Pragma("unroll") for (int r = 0; r < 16; ++r) { C0[r] -= dl; C1[r] -= dl; } \
        _Pragma("unroll") for (int r = 0; r < 16; ++r) negm[r] = -mhat; asm volatile("" : "+v"(negm)); \
        const float f = __builtin_amdgcn_exp2f(-dl); l_reg *= f; if (hi == 0) wsf[r32] = f; resc = true; } } \
    SBAR(); \
    GAPB(o[0] = __builtin_amdgcn_mfma_f32_32x32x16_bf16(PAF(0), VFR(0), o[0], 0, 0, 0), C0, 0); \
    GAPB(o[1] = __builtin_amdgcn_mfma_f32_32x32x16_bf16(PAF(0), VFR(4), o[1], 0, 0, 0), C0, 4); \
    KRD(GL, 0); GAPB(o[0] = __builtin_amdgcn_mfma_f32_32x32x16_bf16(PAF(1), VFR(1), o[0], 0, 0, 0), C0, 8); \
    KRD(GL, 1); GAPB(o[1] = __builtin_amdgcn_mfma_f32_32x32x16_bf16(PAF(1), VFR(5), o[1], 0, 0, 0), C0, 12); \
    KRD(GL, 2); GAPB(o[0] = __builtin_amdgcn_mfma_f32_32x32x16_bf16(PAF(2), VFR(2), o[0], 0, 0, 0), C1, 0); \
    KRD(GL, 3); GAPB(o[1] = __builtin_amdgcn_mfma_f32_32x32x16_bf16(PAF(2), VFR(6), o[1], 0, 0, 0), C1, 4); \
    GAPB(o[0] = __builtin_amdgcn_mfma_f32_32x32x16_bf16(PAF(3), VFR(3), o[0], 0, 0, 0), C1, 8); \
    GAPB(o[1] = __builtin_amdgcn_mfma_f32_32x32x16_bf16(PAF(3), VFR(7), o[1], 0, 0, 0), C1, 12); \
    } while (0)
  int t = 1;
  for (; t + 5 < NT; t += 2) {
    STEPM(pB0, pB1, pA0, pA1, t, true, true, true);     WAIT_BAR(2); RESC(); ROT();
    STEPM(pA0, pA1, pB0, pB1, t + 1, true, true, true); WAIT_BAR(2); RESC(); ROT();
  }
  #define ENDW(tt) do { if ((tt) + 3 < NT) { WAIT_BAR(2); } else if ((tt) + 2 < NT) { WAIT_BAR(1); } else { WAIT_BAR(0); } } while (0)
  for (; t + 1 < NT; t += 2) {
    STEPM(pB0, pB1, pA0, pA1, t, (t + 3 < NT), (t + 1 < NT), (t + 1 < NT));         ENDW(t);     RESC(); ROT();
    STEPM(pA0, pA1, pB0, pB1, t + 1, (t + 4 < NT), (t + 2 < NT), (t + 2 < NT));     ENDW(t + 1); RESC(); ROT();
  }
  STEPM(pB0, pB1, pA0, pA1, NT - 1, false, false, false); RESC();
  { float sacc = pB0[0] + pB0[1]; _Pragma("unroll") for (int r = 2; r < 16; ++r) sacc += pB0[r]; _Pragma("unroll") for (int r = 0; r < 16; ++r) sacc += pB1[r]; l_reg += sacc;
    pw0 = (u32x4){PKW(pB0, 0), PKW(pB0, 2), PKW(pB0, 4), PKW(pB0, 6)}; pw1 = (u32x4){PKW(pB0, 8), PKW(pB0, 10), PKW(pB0, 12), PKW(pB0, 14)}; pw2 = (u32x4){PKW(pB1, 0), PKW(pB1, 2), PKW(pB1, 4), PKW(pB1, 6)}; pw3 = (u32x4){PKW(pB1, 8), PKW(pB1, 10), PKW(pB1, 12), PKW(pB1, 14)};
    SBAR(); pv(o, vb0 + sl_cur, PAF(0), PAF(1), PAF(2), PAF(3)); }
  #undef PKW
  #undef PAF
  #undef VFR
  #undef PIN
  #undef MX3
  #undef GAPA
  #undef GAPB
  #undef EX
  #undef VRD
  #undef KRD
  #undef STEPM
  #undef ENDW
  { auto rr = __builtin_amdgcn_permlane32_swap(__float_as_uint(l_reg), __float_as_uint(l_reg), false, false); l_reg = __uint_as_float(rr[0]) + __uint_as_float(rr[1]); }
  if (hi == 0) wsf[32 + r32] = l_reg; asm volatile("s_waitcnt lgkmcnt(0)" ::: "memory");
  float rli[16];
  #pragma unroll
  for (int r = 0; r < 16; ++r) rli[r] = __builtin_amdgcn_rcpf(wsf[32 + crow(r, hi)]);
  bf16* Ow = O + (long)(q0 + wid * QBLK) * OPITCH + OCOL0 + h * D;
  { bf16* stg = (bf16*)(shm + LDS_OST) + wid * 2048;
    #pragma unroll
    for (int r = 0; r < 16; ++r) { const int orow = crow(r, hi);
      #pragma unroll
      for (int d0 = 0; d0 < 2; ++d0) stg[orow * 64 + d0 * 32 + r32] = __float2bfloat16(o[d0][r] * rli[r]); }
    asm volatile("s_waitcnt lgkmcnt(0)" ::: "memory");
    #pragma unroll
    for (int i = 0; i < 4; ++i) { const int row = i * 8 + (lane >> 3), ch = lane & 7; const u32x4 v = *(const u32x4*)(stg + row * 64 + ch * 8); ATTN_STORE16(Ow + (long)row * OPITCH + ch * 8, v); } }
  asm volatile("s_waitcnt lgkmcnt(0)\n\ts_barrier" ::: "memory");
  #undef DMA_K
  #undef DMA_V
  #undef START
  #undef RESC
  #undef ROT
}
#undef SBAR
#undef WAIT_BAR
}

constexpr int NWAVES = 8, NTHR = NWAVES * 64;
constexpr size_t MiB = 1u << 20;
constexpr size_t WS_CTL = 0, CTL_ZERO_BYTES = 64 * 1024;
constexpr size_t WS_MOD = 1 * MiB;
constexpr size_t WS_MISC = WS_MOD + 64 * 1024;
constexpr size_t WS_IDX = WS_MISC, WS_GATE = WS_IDX + 128 * 1024, WS_TOKSLOT = WS_GATE + 128 * 1024;
constexpr size_t WS_AFF = 3 * MiB;
constexpr size_t WS_WIN = 4 * MiB;
constexpr size_t WS_WOUT = 7 * MiB;
constexpr size_t WS_WGU = 9 * MiB;
constexpr size_t WS_WD = 137 * MiB;
constexpr size_t WS_X1 = 201 * MiB;
constexpr size_t WS_R1 = 265 * MiB;
constexpr size_t WS_XN = WS_R1;
constexpr size_t WS_Q = WS_XN + (size_t)NROWS * DM * 2;
constexpr size_t WS_K = WS_Q + (size_t)NTOK * 768 * 2;
constexpr size_t WS_V = WS_K + (size_t)NROWS * 256 * 2;
constexpr size_t WS_FT = WS_V + (size_t)NROWS * 256 * 2;
constexpr size_t WS_MIX = WS_FT + (size_t)256 * NTOK * 4;
constexpr size_t WS_HID = WS_R1;
constexpr size_t WS_R2 = 393 * MiB;
constexpr size_t WS_H2 = WS_R2;
constexpr size_t WS_YE = WS_R2;
constexpr size_t WS_END = 457 * MiB;
static_assert(WS_MIX + (size_t)NTOK * DM * 2 <= WS_R1 + 128 * MiB, "R1 map");
static_assert(WS_TOKSLOT + (size_t)NTOK * 16 * 4 <= WS_AFF, "misc map");
constexpr int CW_TMO = 0, CW_FLAG = 2, CW_BAR = 1024;

constexpr int LDS_BYTES = 163840;
constexpr int RING_BYTES = 131072, XTRA_OFF = RING_BYTES;
constexpr int MISC_OFF = LDS_BYTES - 512;

#define GAS __attribute__((address_space(1)))
#define LAS __attribute__((address_space(3)))
typedef unsigned short bf16;
typedef unsigned v4u __attribute__((ext_vector_type(4)));
typedef unsigned v2u __attribute__((ext_vector_type(2)));
typedef float f32x4 __attribute__((ext_vector_type(4)));
typedef float f32x2 __attribute__((ext_vector_type(2)));
typedef GAS unsigned gu32;
#define RLX_AGENT __ATOMIC_RELAXED, __HIP_MEMORY_SCOPE_AGENT
#define LDS_WAIT() asm volatile("s_waitcnt lgkmcnt(0)" ::: "memory")
#define VM_WAIT() asm volatile("s_waitcnt vmcnt(0)" ::: "memory")
__device__ __forceinline__ unsigned f2bf(float f) { unsigned u = __builtin_bit_cast(unsigned, f); return (u + 0x7fffu + ((u >> 16) & 1u)) >> 16; }
__device__ __forceinline__ unsigned pk2(float lo, float hi) { return f2bf(lo) | (f2bf(hi) << 16); }
__device__ __forceinline__ float bf2f(unsigned short b) { return __builtin_bit_cast(float, (unsigned)b << 16); }

#define XB_TMO      128
#define XB_XCNT(j)  (256  + 64 * (j))
#define XB_XSUB(j)  (1280 + 64 * (j))
#define XB_XGEN(j)  (2304 + 64 * (j))
#define XB_TOP      3328
#define XB_TOPGEN   3392
#define XCD_BAR_WORDS 3456
#define XB_SPIN_CAP (1u << 20)
static_assert((CW_BAR + XCD_BAR_WORDS) * 4 <= (int)CTL_ZERO_BYTES, "ctl");
__device__ __forceinline__ unsigned xb_ld(unsigned* p)              { return __hip_atomic_load(p, __ATOMIC_RELAXED, __HIP_MEMORY_SCOPE_AGENT); }
__device__ __forceinline__ unsigned xb_add(unsigned* p, unsigned v) { return __hip_atomic_fetch_add(p, v, __ATOMIC_RELAXED, __HIP_MEMORY_SCOPE_AGENT); }
__device__ __forceinline__ unsigned xb_xcc_id() { return (unsigned)__builtin_amdgcn_s_getreg((3 << 11) | 20) & 0xFu; }
#define XB_SPIN(cond, bar) do { unsigned _sp = 0; while (cond) { __builtin_amdgcn_s_sleep(1); \
    if ((++_sp & 255u) == 0u) { if (xb_ld(&(bar)[XB_TMO])) break; if (_sp > XB_SPIN_CAP) { atomicAdd(&(bar)[XB_TMO], 1u); break; } } } } while (0)
struct XcdBarrier { unsigned* bar; unsigned x; volatile LAS unsigned* st; };
__device__ __forceinline__ XcdBarrier xcd_barrier_post(unsigned* bar, volatile LAS unsigned* st, bool leader) {
    XcdBarrier b; b.bar = bar; b.x = xb_xcc_id(); b.st = st;
    if (leader) (void)xb_add(&bar[XB_XCNT(b.x)], 1u);
    return b;
}
__device__ __forceinline__ void xcd_barrier_complete(unsigned* bar, unsigned x, unsigned& nloc, unsigned& nx) {
    const unsigned G = gridDim.x * gridDim.y * gridDim.z;
    unsigned sum, cnt, mine, sp = 0u;
    for (;;) {
        sum = 0u; cnt = 0u; mine = 0u;
#pragma unroll
        for (unsigned j = 0; j < 16; ++j) { const unsigned c = xb_ld(&bar[XB_XCNT(j)]); sum += c; cnt += (c > 0u) ? 1u : 0u; mine = (j == x) ? c : mine; }
        if (sum == G) break;
        __builtin_amdgcn_s_sleep(1);
        if ((++sp & 255u) == 0u) { if (xb_ld(&bar[XB_TMO])) break; if (sp > XB_SPIN_CAP) { atomicAdd(&bar[XB_TMO], 1u); break; } }
    }
    nloc = mine > 0u ? mine : 1u; nx = cnt > 0u ? cnt : 1u;
}
__device__ __forceinline__ void xcd_barrier(const XcdBarrier& b, int wave) {
    asm volatile("s_waitcnt vmcnt(0)" ::: "memory");
    __syncthreads();
    if (wave == 0 && fresh_lane() == 0) {
        unsigned* bar = b.bar;
        __builtin_amdgcn_s_waitcnt(0);
        unsigned nloc = b.st[0], nx = b.st[1];
        if (nloc == 0u) { xcd_barrier_complete(bar, b.x, nloc, nx); b.st[0] = nloc; b.st[1] = nx; }
        const unsigned old = xb_add(&bar[XB_XSUB(b.x)], 1u);
        const unsigned gen = old / nloc;
        if (old + 1u == (gen + 1u) * nloc) {
            __builtin_amdgcn_fence(__ATOMIC_RELEASE, "agent");
            asm volatile("s_waitcnt vmcnt(0)" ::: "memory");
            const unsigned og = xb_add(&bar[XB_TOP], 1u);
            const unsigned tg = og / nx;
            if (og + 1u == (tg + 1u) * nx) xb_add(&bar[XB_TOPGEN], 1u);
            else XB_SPIN(xb_ld(&bar[XB_TOPGEN]) == tg, bar);
            __builtin_amdgcn_fence(__ATOMIC_ACQUIRE, "agent");
            xb_add(&bar[XB_XGEN(b.x)], 1u);
            asm volatile("s_waitcnt vmcnt(0)" ::: "memory");
        } else {
            XB_SPIN(xb_ld(&bar[XB_XGEN(b.x)]) == gen, bar);
            __builtin_amdgcn_fence(__ATOMIC_ACQUIRE, "agent");
            asm volatile("s_waitcnt vmcnt(0)" ::: "memory");
        }
    }
    __syncthreads();
}

struct Args {
    const float *x, *c, *ctx, *c_ctx, *w_mod, *b_mod, *norm_mix_g, *norm_ffn_g, *w_in, *w_four, *q_norm_g, *k_norm_g, *w_out, *w_router, *w_gate, *w_up, *w_down, *final_norm_g;
    float* out; unsigned char* ws;
};

__device__ __forceinline__ float wave_sum(float v) {
#pragma unroll
    for (int o = 1; o < 64; o <<= 1) v += __shfl_xor(v, o);
    return v;
}

template <class RowMap>
__device__ __forceinline__ void tr_item(const float* __restrict__ W, int ldw, int k0, int n0, bf16* WT, int ldt, int kdst0, const RowMap& drow, LAS float* scr, int lane) {
    const int kq = lane >> 4, nq = lane & 15;
    f32x4 v[16];
#pragma unroll
    for (int it = 0; it < 16; ++it) v[it] = *(const f32x4*)(W + (size_t)(k0 + 4 * it + kq) * ldw + n0 + 4 * nq);
#pragma unroll
    for (int it = 0; it < 16; ++it) { LAS float* s = scr + (4 * it + kq) * 65 + 4 * nq; s[0] = v[it][0]; s[1] = v[it][1]; s[2] = v[it][2]; s[3] = v[it][3]; }
    LDS_WAIT(); asm volatile("" ::: "memory");
    const int c = lane >> 3, nn = lane & 7;
#pragma unroll
    for (int j = 0; j < 8; ++j) { const int n = nn + 8 * j; const LAS float* s = scr + (8 * c) * 65 + n;
        v4u o; o.x = pk2(s[0 * 65], s[1 * 65]); o.y = pk2(s[2 * 65], s[3 * 65]); o.z = pk2(s[4 * 65], s[5 * 65]); o.w = pk2(s[6 * 65], s[7 * 65]);
        *(GAS v4u*)(WT + (size_t)drow(n0 + n) * ldt + kdst0 + k0 + 8 * c) = o; }
    LDS_WAIT(); asm volatile("" ::: "memory");
}
struct RowId { int base; __device__ __forceinline__ int operator()(int n) const { return base + n; } };
struct RowQKV { __device__ __forceinline__ int operator()(int n) const { const int t = n >> 8, w = n & 255, hd = w >> 6, d = w & 63; return 256 + 256 * t + 128 * (d >> 5) + 32 * hd + (d & 31); } };
struct RowGU { int base, up; __device__ __forceinline__ int operator()(int f) const { return base + 256 * (f >> 7) + 128 * up + (f & 127); } };

__host__ __device__ __forceinline__ int four_pos(int mp) { return mp == 0 ? 0 : (mp == 32 ? 1 : (mp < 32 ? 2 * mp : 2 * (64 - mp) + 1)); }

__device__ __forceinline__ void p0_prologue(const Args& a, LAS unsigned char* lds, int vcu, int G, int wave) {
    const int lane = fresh_lane(), tid = wave * 64 + lane;
    unsigned char* ws = a.ws;
    bf16* WinT = (bf16*)(ws + WS_WIN); bf16* WoT = (bf16*)(ws + WS_WOUT); bf16* WguT = (bf16*)(ws + WS_WGU); bf16* WdT = (bf16*)(ws + WS_WD);
    float* MOD = (float*)(ws + WS_MOD);
    if (vcu < 24) {
        LAS float* sv = (LAS float*)lds;
        LAS float* red = sv + 2048;
        for (int i = tid; i < 1024; i += NTHR) { const float c0 = a.c[i], c1 = a.c_ctx[i]; sv[i] = c0 / (1.f + __expf(-c0)); sv[1024 + i] = c1 / (1.f + __expf(-c1)); }
        __syncthreads();
        const int col = vcu * 256 + 4 * lane;
        f32x4 a0 = {0.f, 0.f, 0.f, 0.f}, a1 = {0.f, 0.f, 0.f, 0.f};
        if (lane < 64) {
            const int kb = wave * 128;
#pragma unroll 8
            for (int k = 0; k < 128; ++k) { const f32x4 w = *(const f32x4*)(a.w_mod + (size_t)(kb + k) * (NMOD * DM) + col); const float s0 = sv[kb + k], s1 = sv[1024 + kb + k]; a0 += w * s0; a1 += w * s1; }
        }
        *(LAS f32x4*)(red + (wave * 2 + 0) * 256 + 4 * lane) = a0; *(LAS f32x4*)(red + (wave * 2 + 1) * 256 + 4 * lane) = a1;
        __syncthreads();
        { const int v = tid >> 8, cc = tid & 255; float s = 0.f;
#pragma unroll
          for (int w = 0; w < 8; ++w) s += red[(w * 2 + v) * 256 + cc];
          MOD[v * (NMOD * DM) + vcu * 256 + cc] = s + a.b_mod[vcu * 256 + cc]; }
        __syncthreads();
    }
    LAS float* scr = (LAS float*)(lds + wave * 16640);
    const int gw = vcu * NWAVES + wave, NGW = G * NWAVES;
    constexpr int I_IN = 16 * 20, I_OUT = 12 * 16, I_G = 16 * 16 * 32, I_U = I_G, I_D = 16 * 32 * 16, I_F1 = 64, I_F2 = 64;
    constexpr int NITEMS = I_F1 + I_F2 + I_IN + I_OUT + I_G + I_U + I_D;
    for (int it = gw; it < NITEMS; it += NGW) {
        int r = it;
        if (r < I_F1) {
            const int g = r & 3, kb = r >> 2, k = kb * 64 + lane;
            LAS float* ct = scr;
            ct[lane] = cospif((float)lane * (1.f / 32.f)); LDS_WAIT(); asm volatile("" ::: "memory");
            float w[64];
#pragma unroll
            for (int c4 = 0; c4 < 16; ++c4) { const f32x4 t = *(const f32x4*)(a.w_in + (size_t)k * INW + 64 * g + 4 * c4); w[4 * c4] = t[0]; w[4 * c4 + 1] = t[1]; w[4 * c4 + 2] = t[2]; w[4 * c4 + 3] = t[3]; }
            for (int j = 0; j < 64; ++j) { const int m = j <= 32 ? j : j - 32; const int ph = j <= 32 ? 0 : 48;
                float s = 0.f;
#pragma unroll
                for (int c = 0; c < 64; ++c) s += w[c] * ct[(c * m + ph) & 63];
                WinT[(size_t)(64 * g + j) * DM + k] = (bf16)f2bf(s * (1.f / 1024.f)); }
            LDS_WAIT(); asm volatile("" ::: "memory");
            continue; }
        r -= I_F1;
        if (r < I_F2) {
            const int g = r & 3, jb = r >> 2, j = jb * 64 + lane;
            float w[64];
#pragma unroll
            for (int d = 0; d < 64; ++d) w[d] = a.w_out[(size_t)(64 * g + d) * DM + j];
            for (int mp = 0; mp < 64; ++mp) { float s = 0.f; const float* wf = a.w_four + (size_t)(g * 64 + mp) * 64;
#pragma unroll
                for (int d = 0; d < 64; ++d) s += wf[d] * w[d];
                WoT[(size_t)j * DM + 64 * g + four_pos(mp)] = (bf16)f2bf(s); }
            continue; }
        r -= I_F2;
        if (r < I_IN) { const int kb = r / 20, nb = r % 20; tr_item(a.w_in + 256, INW, kb * 64, nb * 64, WinT, DM, 0, RowQKV{}, scr, lane); continue; }
        r -= I_IN;
        if (r < I_OUT) { const int kb = r / 16, nb = r % 16; tr_item(a.w_out + (size_t)256 * DM, DM, kb * 64, nb * 64, WoT, DM, 256, RowId{0}, scr, lane); continue; }
        r -= I_OUT;
        if (r < I_G + I_U) { const int up = r >= I_G; if (up) r -= I_G; const int e = r / 512, q = r % 512, kb = q / 32, nb = q % 32;
            tr_item((up ? a.w_up : a.w_gate) + (size_t)e * DM * DE, DE, kb * 64, nb * 64, WguT + (size_t)e * 4096 * DM, DM, 0, RowGU{0, up}, scr, lane); continue; }
        r -= I_G + I_U;
        { const int e = r / 512, q = r % 512, kb = q / 16, nb = q % 16;
          tr_item(a.w_down + (size_t)e * DE * DM, DM, kb * 64, nb * 64, WdT + (size_t)e * DM * DE, DE, 0, RowId{0}, scr, lane); }
    }
}

__device__ __forceinline__ void p0b_modulate(const Args& a, int vcu, int G, int wave) {
    const int lane = fresh_lane();
    unsigned char* ws = a.ws; const float* MOD = (const float*)(ws + WS_MOD); bf16* XN = (bf16*)(ws + WS_XN);
    const int gw = vcu * NWAVES + wave, NGW = G * NWAVES;
    for (int pass = 0; pass < 2; ++pass) {
        const float* md = MOD + pass * (NMOD * DM);
        const int nrows = pass == 0 ? NTOK : NCTX; const float* src = pass == 0 ? a.x : a.ctx; bf16* dst = XN + (size_t)(pass == 0 ? 0 : NTOK) * DM;
        if (gw >= nrows) continue;
        f32x4 av[4], sh[4];
#pragma unroll
        for (int j = 0; j < 4; ++j) { const int col = 4 * lane + 256 * j; const f32x4 g = *(const f32x4*)(a.norm_mix_g + col); const f32x4 sc = *(const f32x4*)(md + DM + col); av[j] = g * (sc + 1.f); sh[j] = *(const f32x4*)(md + col); }
        for (int m = gw; m < nrows; m += NGW) {
            const GAS f32x4* xr = (const GAS f32x4*)(src + (size_t)m * DM) + lane;
            f32x4 v[4]; float s = 0.f;
#pragma unroll
            for (int j = 0; j < 4; ++j) { v[j] = xr[64 * j]; s += (v[j].x * v[j].x + v[j].y * v[j].y) + (v[j].z * v[j].z + v[j].w * v[j].w); }
            const float rinv = 1.f / sqrtf(wave_sum(s) * (1.f / DM) + EPS);
            GAS unsigned long long* o8 = (GAS unsigned long long*)(dst + (size_t)m * DM) + lane;
#pragma unroll
            for (int j = 0; j < 4; ++j) { const f32x4 y = v[j] * rinv * av[j] + sh[j]; o8[64 * j] = (unsigned long long)pk2(y.x, y.y) | ((unsigned long long)pk2(y.z, y.w) << 32); }
        }
    }
}

struct P1Prob {
    static constexpr int K = DM; static constexpr bool PERM = false;
    const bf16* XN; const bf16* WinT; bf16 *Q, *Kb, *Vb; float* FT; const float *qg, *kg; pg8::StaticOrder so;
    __device__ __forceinline__ bool next(int i, pg8::Unit& u) const { return so.next(i, u); }
    __device__ __forceinline__ const char* aptr(const pg8::Unit& u) const { return u.pn == 0 ? (const char*)WinT : (const char*)(XN + (size_t)u.pm * 256 * DM); }
    __device__ __forceinline__ const char* bptr(const pg8::Unit& u) const { return u.pn == 0 ? (const char*)(XN + (size_t)u.pm * 256 * DM) : (const char*)(WinT + (size_t)u.pn * 256 * DM); }
    __device__ __forceinline__ void epi(const pg8::f32x4 (&acc)[2][2][4][2], const pg8::Unit& u, int wr, int wc, int fr, int fq) const {
        if (u.pn == 0) {
            if (u.pm >= NTOK / 256) return;
#pragma unroll
            for (int ai = 0; ai < 2; ++ai)
#pragma unroll
                for (int m = 0; m < 4; ++m) { float* rowp = FT + (size_t)(ai * 128 + wr * 64 + m * 16 + fr) * NTOK + u.pm * 256 + wc * 32 + 4 * fq;
#pragma unroll
                    for (int bj = 0; bj < 2; ++bj)
#pragma unroll
                        for (int n = 0; n < 2; ++n) *(pg8::f32x4*)(rowp + bj * 128 + n * 16) = acc[ai][bj][m][n]; }
            return;
        }
        const bool isq = u.pn <= 3, isv = u.pn == 5, lat = u.pm < NTOK / 256;
        if (isq && !lat) return;
        if (isv) {
#pragma unroll
            for (int ai = 0; ai < 2; ++ai)
#pragma unroll
                for (int m = 0; m < 4; ++m) { const int t = u.pm * 256 + ai * 128 + wr * 64 + m * 16 + fr; bf16* rowp = Vb + (size_t)t * 256 + wc * 64 + 4 * fq;
#pragma unroll
                    for (int bj = 0; bj < 2; ++bj)
#pragma unroll
                        for (int n = 0; n < 2; ++n) { const pg8::f32x4 v = acc[ai][bj][m][n]; *(v2u*)(rowp + 32 * bj + 16 * n) = (v2u){pk2(v[0], v[1]), pk2(v[2], v[3])}; } }
            return;
        }
        const float* gw = isq ? qg : kg;
        pg8::f32x4 gv[2][2];
#pragma unroll
        for (int bj = 0; bj < 2; ++bj)
#pragma unroll
            for (int n = 0; n < 2; ++n) gv[bj][n] = *(const pg8::f32x4*)(gw + 32 * bj + 16 * n + 4 * fq);
        float frq[4];
#pragma unroll
        for (int e = 0; e < 4; ++e) frq[e] = exp2f(-(float)(4 * fq + e) * (13.287712379549449f / 16.f)) * 0.15915494309189535f;
        const float qs = isq ? attn_body::C2 : 1.f;
        bf16* base = isq ? Q + (size_t)((u.pn - 1) * 4 + wc) * 64 : Kb + (size_t)wc * 64; const int pitch = isq ? 768 : 256;
#pragma unroll
        for (int ai = 0; ai < 2; ++ai) {
            float rowpos = (float)(u.pm * 4 + ai * 2 + wr); asm volatile("" : "+v"(rowpos));
            float cr[4], sr[4];
#pragma unroll
            for (int e = 0; e < 4; ++e) { const float rev = rowpos * frq[e], f_ = rev - floorf(rev); cr[e] = __builtin_amdgcn_cosf(f_); sr[e] = __builtin_amdgcn_sinf(f_); }
#pragma unroll
            for (int m = 0; m < 4; ++m) {
                float colpos = (float)(m * 16 + fr); asm volatile("" : "+v"(colpos));
                const int t = u.pm * 256 + ai * 128 + wr * 64 + m * 16 + fr;
                float ss = 0.f;
#pragma unroll
                for (int bj = 0; bj < 2; ++bj)
#pragma unroll
                    for (int n = 0; n < 2; ++n) { const pg8::f32x4 v = acc[ai][bj][m][n]; ss += (v[0] * v[0] + v[1] * v[1]) + (v[2] * v[2] + v[3] * v[3]); }
                ss += __shfl_xor(ss, 16); ss += __shfl_xor(ss, 32);
                const float rinv = qs / sqrtf(ss * (1.f / 64.f) + EPS);
                pg8::f32x4 y[2][2];
#pragma unroll
                for (int bj = 0; bj < 2; ++bj)
#pragma unroll
                    for (int n = 0; n < 2; ++n) y[bj][n] = acc[ai][bj][m][n] * rinv * gv[bj][n];
                if (lat) {
#pragma unroll
                    for (int e = 0; e < 4; ++e) {
                        { const float x1 = y[0][0][e], x2 = y[0][1][e]; y[0][0][e] = x1 * cr[e] - x2 * sr[e]; y[0][1][e] = x1 * sr[e] + x2 * cr[e]; }
                        { const float rev = colpos * frq[e], f_ = rev - floorf(rev); const float cc = __builtin_amdgcn_cosf(f_), sc = __builtin_amdgcn_sinf(f_);
                          const float x1 = y[1][0][e], x2 = y[1][1][e]; y[1][0][e] = x1 * cc - x2 * sc; y[1][1][e] = x1 * sc + x2 * cc; }
                    }
                }
                bf16* rowp = base + (size_t)t * pitch + 4 * fq;
#pragma unroll
                for (int bj = 0; bj < 2; ++bj)
#pragma unroll
                    for (int n = 0; n < 2; ++n) { const pg8::f32x4 v = y[bj][n]; *(v2u*)(rowp + 32 * bj + 16 * n) = (v2u){pk2(v[0], v[1]), pk2(v[2], v[3])}; }
                asm volatile("" ::: "memory");
            }
        }
    }
};

__device__ __forceinline__ unsigned rev4_14(unsigned k) { unsigned r = __brev(k) >> 18; return ((r & 0x2AAAu) >> 1) | ((r & 0x1555u) << 1); }
__device__ __forceinline__ void fft_block(const Args& a, LAS unsigned char* lds, int item, int wave) {
    const int tid = wave * 64 + fresh_lane();
    const int g = item >> 5, mm = item & 31;
    const float* FT = (const float*)(a.ws + WS_FT); bf16* MIX = (bf16*)(a.ws + WS_MIX);
    LAS f32x2* X = (LAS f32x2*)lds;
    const float* re = FT + (size_t)(64 * g + mm) * NTOK; const float* im = FT + (size_t)(64 * g + 32 + mm) * NTOK;
    for (int i = tid; i < NTOK / 4; i += NTHR) { const f32x4 r4 = *(const f32x4*)(re + 4 * i), i4 = *(const f32x4*)(im + 4 * i);
        X[4 * i] = (f32x2){r4[0], i4[0]}; X[4 * i + 1] = (f32x2){r4[1], i4[1]}; X[4 * i + 2] = (f32x2){r4[2], i4[2]}; X[4 * i + 3] = (f32x2){r4[3], i4[3]}; }
    __syncthreads();
#pragma unroll 1
    for (int s = 0; s < 7; ++s) {
        const int lq = 12 - 2 * s;
        const int Lq = 1 << lq;
        const float invL = 1.f / (float)(4 << lq);
#pragma unroll 2
        for (int i = 0; i < 8; ++i) {
            const int b = tid + NTHR * i, j = b & (Lq - 1), base = ((b >> lq) << (lq + 2)) + j;
            const f32x2 a0 = X[base], a1 = X[base + Lq], a2 = X[base + 2 * Lq], a3 = X[base + 3 * Lq];
            const f32x2 s02 = a0 + a2, d02 = a0 - a2, s13 = a1 + a3, d13 = a1 - a3;
            const f32x2 y0 = s02 + s13, y2 = s02 - s13;
            const f32x2 y1 = (f32x2){d02.x + d13.y, d02.y - d13.x};
            const f32x2 y3 = (f32x2){d02.x - d13.y, d02.y + d13.x};
            const float f1 = (float)j * invL;
            const float c1 = __builtin_amdgcn_cosf(f1), s1 = __builtin_amdgcn_sinf(f1);
            const float c2 = __builtin_amdgcn_cosf(2.f * f1), s2 = __builtin_amdgcn_sinf(2.f * f1);
            const float c3 = __builtin_amdgcn_cosf(3.f * f1), s3 = __builtin_amdgcn_sinf(3.f * f1);
            X[base] = y0;
            X[base + Lq] = (f32x2){y1.x * c1 + y1.y * s1, y1.y * c1 - y1.x * s1};
            X[base + 2 * Lq] = (f32x2){y2.x * c2 + y2.y * s2, y2.y * c2 - y2.x * s2};
            X[base + 3 * Lq] = (f32x2){y3.x * c3 + y3.y * s3, y3.y * c3 - y3.x * s3};
        }
        __syncthreads();
    }
    const int col = 64 * g + 2 * mm;
    for (int k = tid; k < NTOK; k += NTHR) {
        const f32x2 wk = X[rev4_14((unsigned)k)], wn = X[rev4_14((unsigned)((NTOK - k) & (NTOK - 1)))];
        float o0, o1;
        if (mm == 0) { o0 = 0.5f * (wk.x + wn.x); o1 = 0.5f * (wk.y + wn.y); }
        else { o0 = wn.x; o1 = wk.x; }
        *(unsigned*)(MIX + (size_t)k * DM + col) = pk2(o0, o1);
    }
    __syncthreads();
}

struct P3Prob {
    static constexpr int K = DM; static constexpr bool PERM = false;
    const bf16* MIX; const bf16* WoT; const float* x; const float* g1; float* X1; pg8::StaticOrder so;
    __device__ __forceinline__ bool next(int i, pg8::Unit& u) const { return so.next(i, u); }
    __device__ __forceinline__ const char* aptr(const pg8::Unit& u) const { return (const char*)(MIX + (size_t)u.pm * 256 * DM); }
    __device__ __forceinline__ const char* bptr(const pg8::Unit& u) const { return (const char*)(WoT + (size_t)u.pn * 256 * DM); }
    __device__ __forceinline__ void epi(const pg8::f32x4 (&acc)[2][2][4][2], const pg8::Unit& u, int wr, int wc, int fr, int fq) const {
        const int col0 = u.pn * 256 + wc * 32 + 4 * fq;
        pg8::f32x4 gv[2][2];
#pragma unroll
        for (int bj = 0; bj < 2; ++bj)
#pragma unroll
            for (int n = 0; n < 2; ++n) gv[bj][n] = *(const pg8::f32x4*)(g1 + col0 + bj * 128 + n * 16);
#pragma unroll
        for (int ai = 0; ai < 2; ++ai)
#pragma unroll
            for (int m = 0; m < 4; ++m) { const size_t off = (size_t)(u.pm * 256 + ai * 128 + wr * 64 + m * 16 + fr) * DM + col0;
#pragma unroll
                for (int bj = 0; bj < 2; ++bj)
#pragma unroll
                    for (int n = 0; n < 2; ++n) { const pg8::f32x4 bs = *(const pg8::f32x4*)(x + off + bj * 128 + n * 16); *(pg8::f32x4*)(X1 + off + bj * 128 + n * 16) = bs + gv[bj][n] * acc[ai][bj][m][n]; }
                if (m & 1) asm volatile("" ::: "memory"); }
    }
};

__device__ __forceinline__ void p3b_router(const Args& a, LAS unsigned char* lds, int vcu, int G, int wave) {
    const int lane = fresh_lane(), tid = wave * 64 + lane;
    unsigned char* ws = a.ws; const float* MOD = (const float*)(ws + WS_MOD); const float* X1 = (const float*)(ws + WS_X1); bf16* H2 = (bf16*)(ws + WS_H2); float* AFF = (float*)(ws + WS_AFF);
    LAS float* wrt = (LAS float*)lds;
    for (int i = tid; i < 16 * 1024; i += NTHR) { const int col = i >> 4, e = i & 15; wrt[e * 1024 + col] = a.w_router[i]; }
    __syncthreads();
    f32x4 av[4], sh[4];
#pragma unroll
    for (int j = 0; j < 4; ++j) { const int col = 4 * lane + 256 * j; const f32x4 g = *(const f32x4*)(a.norm_ffn_g + col); const f32x4 sc = *(const f32x4*)(MOD + 4 * DM + col); av[j] = g * (sc + 1.f); sh[j] = *(const f32x4*)(MOD + 3 * DM + col); }
    const int gw = vcu * NWAVES + wave, NGW = G * NWAVES;
    for (int m = gw; m < NTOK; m += NGW) {
        const GAS f32x4* xr = (const GAS f32x4*)(X1 + (size_t)m * DM) + lane;
        f32x4 v[4]; float s = 0.f;
#pragma unroll
        for (int j = 0; j < 4; ++j) { v[j] = xr[64 * j]; s += (v[j].x * v[j].x + v[j].y * v[j].y) + (v[j].z * v[j].z + v[j].w * v[j].w); }
        const float rinv = 1.f / sqrtf(wave_sum(s) * (1.f / DM) + EPS);
        GAS unsigned long long* o8 = (GAS unsigned long long*)(H2 + (size_t)m * DM) + lane;
#pragma unroll
        for (int j = 0; j < 4; ++j) { v[j] = v[j] * rinv * av[j] + sh[j]; o8[64 * j] = (unsigned long long)pk2(v[j].x, v[j].y) | ((unsigned long long)pk2(v[j].z, v[j].w) << 32); }
        float lg[16];
#pragma unroll
        for (int e = 0; e < 16; ++e) { float p = 0.f;
#pragma unroll
            for (int j = 0; j < 4; ++j) { const f32x4 w = *(const LAS f32x4*)(wrt + e * 1024 + 4 * lane + 256 * j); p += (v[j].x * w.x + v[j].y * w.y) + (v[j].z * w.z + v[j].w * w.w); }
            lg[e] = wave_sum(p); asm volatile("" ::: "memory"); }
        float mx = lg[0];
#pragma unroll
        for (int e = 1; e < 16; ++e) mx = fmaxf(mx, lg[e]);
        float den = 0.f;
#pragma unroll
        for (int e = 0; e < 16; ++e) { lg[e] = __expf(lg[e] - mx); den += lg[e]; }
        const float rden = 1.f / den;
        float mine = 0.f;
#pragma unroll
        for (int e = 0; e < 16; ++e) mine = (lane == e) ? lg[e] * rden : mine;
        if (lane < 16) AFF[(size_t)lane * NTOK + m] = mine;
    }
}

__device__ __forceinline__ void p4_topk(const Args& a, LAS unsigned char* lds, int e, int wave) {
    const int lane = fresh_lane(), tid = wave * 64 + lane;
    unsigned char* ws = a.ws; const unsigned* AFF = (const unsigned*)(ws + WS_AFF) + (size_t)e * NTOK;
    int* IDX = (int*)(ws + WS_IDX) + e * CAP; float* GATE = (float*)(ws + WS_GATE) + e * CAP; int* TOKSLOT = (int*)(ws + WS_TOKSLOT);
    LAS unsigned* wcnt = (LAS unsigned*)lds;
    LAS unsigned* cg = wcnt + 16;
    LAS unsigned* ce = cg + 256;
    unsigned key[32];
#pragma unroll
    for (int i = 0; i < 32; ++i) key[i] = AFF[i * NTHR + tid];
    unsigned T = 0u;
#pragma unroll 1
    for (int bit = 31; bit >= 0; --bit) {
        const unsigned cand = T | (1u << bit);
        unsigned c = 0u;
#pragma unroll
        for (int i = 0; i < 32; ++i) c += (key[i] >= cand) ? 1u : 0u;
        c = (unsigned)wave_sum((float)c);
        if (lane == 0) wcnt[wave] = c;
        __syncthreads();
        unsigned tot = 0u;
#pragma unroll
        for (int w = 0; w < 8; ++w) tot += wcnt[w];
        if (tot >= (unsigned)CAP) T = cand;
        __syncthreads();
    }
    unsigned long long below = (1ull << lane) - 1ull;
    unsigned rg[32], rq[32];
#pragma unroll
    for (int i = 0; i < 32; ++i) {
        const unsigned long long bg = __ballot(key[i] > T), bq = __ballot(key[i] == T);
        rg[i] = (unsigned)__popcll(bg & below); rq[i] = (unsigned)__popcll(bq & below);
        if (lane == 0) { cg[i * 8 + wave] = (unsigned)__popcll(bg); ce[i * 8 + wave] = (unsigned)__popcll(bq); }
    }
    __syncthreads();
    if (wave == 0) {
        unsigned g4[4], q4[4], sg = 0u, sq = 0u;
#pragma unroll
        for (int k = 0; k < 4; ++k) { g4[k] = cg[4 * lane + k]; q4[k] = ce[4 * lane + k]; sg += g4[k]; sq += q4[k]; }
        unsigned pg = sg, pq = sq;
#pragma unroll
        for (int o = 1; o < 64; o <<= 1) { const unsigned tg = __shfl_up(pg, o), tq = __shfl_up(pq, o); if (lane >= o) { pg += tg; pq += tq; } }
        pg -= sg; pq -= sq;
#pragma unroll
        for (int k = 0; k < 4; ++k) { cg[4 * lane + k] = pg; ce[4 * lane + k] = pq; pg += g4[k]; pq += q4[k]; }
        if (lane == 63) { wcnt[8] = pg; }
    }
    __syncthreads();
    const unsigned ngt = wcnt[8], need = (unsigned)CAP - ngt;
#pragma unroll
    for (int i = 0; i < 32; ++i) {
        const int tok = i * NTHR + tid;
        const unsigned gb = cg[i * 8 + wave] + rg[i], qb = ce[i * 8 + wave] + rq[i];
        const bool sel = key[i] > T || (key[i] == T && qb < need);
        const unsigned slot = gb + (qb < need ? qb : need);
        if (sel) { IDX[slot] = tok; GATE[slot] = __uint_as_float(key[i]); }
        TOKSLOT[tok * 16 + e] = sel ? (int)slot : -1;
    }
}

struct P5Prob {
    static constexpr int K = DM; static constexpr bool PERM = true;
    const bf16* H2; const bf16* WguT; bf16* HID; pg8::StaticOrder so;
    __device__ __forceinline__ bool next(int i, pg8::Unit& u) const { return so.next(i, u); }
    __device__ __forceinline__ const char* aptr(const pg8::Unit&) const { return (const char*)H2; }
    __device__ __forceinline__ const char* bptr(const pg8::Unit& u) const { return (const char*)(WguT + ((size_t)(u.pm >> 3) * 4096 + (size_t)u.pn * 256) * DM); }
    __device__ __forceinline__ void epi(const pg8::f32x4 (&acc)[2][2][4][2], const pg8::Unit& u, int wr, int wc, int fr, int fq) const {
#pragma unroll
        for (int ai = 0; ai < 2; ++ai)
#pragma unroll
            for (int m = 0; m < 4; ++m) { bf16* rowp = HID + (size_t)(u.pm * 256 + ai * 128 + wr * 64 + m * 16 + fr) * DE + u.pn * 128 + wc * 32 + 8 * fq;
                float h[8];
#pragma unroll
                for (int n = 0; n < 2; ++n)
#pragma unroll
                    for (int e = 0; e < 4; ++e) { const float gt = acc[ai][0][m][n][e], up = acc[ai][1][m][n][e]; h[4 * n + e] = gt * __builtin_amdgcn_rcpf(1.f + __builtin_amdgcn_exp2f(-1.4426950408889634f * gt)) * up; }
                *(v4u*)rowp = (v4u){pk2(h[0], h[1]), pk2(h[2], h[3]), pk2(h[4], h[5]), pk2(h[6], h[7])}; }
    }
};
struct P6Prob {
    static constexpr int K = DE; static constexpr bool PERM = true;
    const bf16* HID; const bf16* WdT; const float* GATE; bf16* YE; pg8::StaticOrder so;
    __device__ __forceinline__ bool next(int i, pg8::Unit& u) const { return so.next(i, u); }
    __device__ __forceinline__ const char* aptr(const pg8::Unit& u) const { return (const char*)(HID + (size_t)u.pm * 256 * DE); }
    __device__ __forceinline__ const char* bptr(const pg8::Unit& u) const { return (const char*)(WdT + ((size_t)(u.pm >> 3) * DM + (size_t)u.pn * 256) * DE); }
    __device__ __forceinline__ void epi(const pg8::f32x4 (&acc)[2][2][4][2], const pg8::Unit& u, int wr, int wc, int fr, int fq) const {
#pragma unroll
        for (int ai = 0; ai < 2; ++ai)
#pragma unroll
            for (int m = 0; m < 4; ++m) { const int row = u.pm * 256 + ai * 128 + wr * 64 + m * 16 + fr; const float gt = GATE[row]; bf16* rowp = YE + (size_t)row * DM + u.pn * 256 + wc * 32 + 8 * fq;
#pragma unroll
                for (int bj = 0; bj < 2; ++bj) { const pg8::f32x4 v0 = acc[ai][bj][m][0] * gt, v1 = acc[ai][bj][m][1] * gt;
                    *(v4u*)(rowp + bj * 128) = (v4u){pk2(v0[0], v0[1]), pk2(v0[2], v0[3]), pk2(v1[0], v1[1]), pk2(v1[2], v1[3])}; } }
    }
};

__device__ __forceinline__ void p7_final(const Args& a, int vcu, int G, int wave, unsigned poison) {
    const int lane = fresh_lane();
    unsigned char* ws = a.ws; const float* MOD = (const float*)(ws + WS_MOD); const bf16* YE = (const bf16*)(ws + WS_YE); const int* TOKSLOT = (const int*)(ws + WS_TOKSLOT);
    const float* src = (STEP >= 2) ? (const float*)(ws + WS_X1) : a.x;
    f32x4 g2[4], fg[4];
#pragma unroll
    for (int j = 0; j < 4; ++j) { const int col = 4 * lane + 256 * j; g2[j] = *(const f32x4*)(MOD + 5 * DM + col); fg[j] = *(const f32x4*)(a.final_norm_g + col); }
    const int gw = vcu * NWAVES + wave, NGW = G * NWAVES;
    for (int m = gw; m < NTOK; m += NGW) {
        const GAS f32x4* xr = (const GAS f32x4*)(src + (size_t)m * DM) + lane;
        f32x4 v[4];
#pragma unroll
        for (int j = 0; j < 4; ++j) v[j] = xr[64 * j];
        if (STEP >= 4) {
            const int myslot = lane < 16 ? TOKSLOT[m * 16 + lane] : -1;
            f32x4 s[4];
#pragma unroll
            for (int j = 0; j < 4; ++j) s[j] = (f32x4){0.f, 0.f, 0.f, 0.f};
#pragma unroll 1
            for (int e = 0; e < 16; ++e) {
                const int sl = __builtin_amdgcn_readlane(myslot, e);
                if (sl >= 0) {
                    const GAS v2u* yr = (const GAS v2u*)(YE + ((size_t)e * CAP + sl) * DM) + lane;
#pragma unroll
                    for (int j = 0; j < 4; ++j) { const v2u w = yr[64 * j]; s[j].x += __uint_as_float(w.x << 16); s[j].y += __uint_as_float(w.x & 0xffff0000u); s[j].z += __uint_as_float(w.y << 16); s[j].w += __uint_as_float(w.y & 0xffff0000u); }
                }
            }
#pragma unroll
            for (int j = 0; j < 4; ++j) v[j] += g2[j] * s[j];
        }
        float ss = 0.f;
#pragma unroll
        for (int j = 0; j < 4; ++j) ss += (v[j].x * v[j].x + v[j].y * v[j].y) + (v[j].z * v[j].z + v[j].w * v[j].w);
        const float rinv = 1.f / sqrtf(wave_sum(ss) * (1.f / DM) + EPS);
        GAS f32x4* o = (GAS f32x4*)(a.out + (size_t)m * DM) + lane;
        const float q = __builtin_nanf("");
#pragma unroll
        for (int j = 0; j < 4; ++j) { f32x4 y = v[j] * rinv * fg[j]; if (poison) y = (f32x4){q, q, q, q}; o[64 * j] = y; }
    }
}

__global__ void __launch_bounds__(NTHR, 2) fwd_megakernel(Args args) {
    extern __shared__ __attribute__((aligned(16))) unsigned char lds_raw[];
    LAS unsigned char* lds = (LAS unsigned char*)lds_raw;
    volatile LAS unsigned* MISC = (volatile LAS unsigned*)(lds + MISC_OFF);
    const int wave = __builtin_amdgcn_readfirstlane(threadIdx.x >> 6);
    const int G = gridDim.x; const int bx = blockIdx.x; const int vcu = (G % 8 == 0) ? (bx % 8) * (G / 8) + bx / 8 : bx;
    unsigned char* ws = args.ws;
    gu32* ctl = (gu32*)(ws + WS_CTL);
    { const int l0 = fresh_lane(); if (wave < 2) ((LAS unsigned*)(lds + MISC_OFF))[wave * 64 + l0] = 0u;
      __syncthreads();
    }
    XcdBarrier bar = xcd_barrier_post((unsigned*)(ctl + CW_BAR), MISC + 8, wave == 0 && fresh_lane() == 0);
#define GRID_BAR() xcd_barrier(bar, wave)

    if (STEP >= 2 && PH(0)) p0_prologue(args, lds, vcu, G, wave);
    GRID_BAR();
    if (STEP >= 2 && PH(1)) p0b_modulate(args, vcu, G, wave);
    GRID_BAR();
    if (STEP >= 2 && PH(2)) {
        P1Prob p; p.XN = (bf16*)(ws + WS_XN); p.WinT = (bf16*)(ws + WS_WIN); p.Q = (bf16*)(ws + WS_Q); p.Kb = (bf16*)(ws + WS_K); p.Vb = (bf16*)(ws + WS_V); p.FT = (float*)(ws + WS_FT);
        p.qg = args.q_norm_g; p.kg = args.k_norm_g; p.so.init(NROWS / 256, INW / 256, G, bx);
        pg8::gemm_phase<P1Prob, false, true, true>(lds, p, nullptr, wave);
    }
    GRID_BAR();
    if (STEP >= 2 && PH(3)) {
        for (int item = vcu; item < 128; item += G) fft_block(args, lds, item, wave);
    }
    if (STEP >= 3 && PH(4)) {
        const attn_body::bf16* Qb = (const attn_body::bf16*)(ws + WS_Q); const attn_body::bf16* Kb = (const attn_body::bf16*)(ws + WS_K); const attn_body::bf16* Vb = (const attn_body::bf16*)(ws + WS_V);
        attn_body::bf16* MIX = (attn_body::bf16*)(ws + WS_MIX);
        const int u0 = (G == 256) ? vcu * 3 : vcu, ustep = (G == 256) ? 1 : G, uend = (G == 256) ? vcu * 3 + 3 : 768;
#pragma unroll 1
        for (int u = u0; u < uend; u += ustep) {
            const int kvh = u / 192, w = u % 192, h = kvh * 3 + w / 64, qb = w % 64;
            attn_body::attn_unit<8>(h, kvh, qb, Qb, Kb, Vb, MIX, (char*)lds_raw, wave);
        }
    } else if (STEP == 2) {
        bf16* MIX = (bf16*)(ws + WS_MIX);
        const int gw = vcu * NWAVES + wave, NGW = G * NWAVES, lane = fresh_lane();
        for (int m = gw; m < NTOK; m += NGW) { GAS v4u* o = (GAS v4u*)(MIX + (size_t)m * DM + 256); o[lane] = (v4u){0u, 0u, 0u, 0u}; if (lane < 32) o[64 + lane] = (v4u){0u, 0u, 0u, 0u}; }
    }
    GRID_BAR();
    if (STEP >= 2 && PH(5)) {
        P3Prob p; p.MIX = (bf16*)(ws + WS_MIX); p.WoT = (bf16*)(ws + WS_WOUT); p.x = args.x; p.g1 = (const float*)(ws + WS_MOD) + 2 * DM; p.X1 = (float*)(ws + WS_X1); p.so.init(NTOK / 256, DM / 256, G, bx);
        pg8::gemm_phase<P3Prob, false, true, true>(lds, p, nullptr, wave);
    }
    GRID_BAR();
    if (STEP >= 4 && PH(6)) p3b_router(args, lds, vcu, G, wave);
    GRID_BAR();
    if (STEP >= 4 && PH(7)) {
#pragma unroll 1
        for (int e = vcu; e < NE; e += G) p4_topk(args, lds, e, wave); }
    GRID_BAR();
    if (STEP >= 4 && PH(8)) {
        P5Prob p; p.H2 = (bf16*)(ws + WS_H2); p.WguT = (bf16*)(ws + WS_WGU); p.HID = (bf16*)(ws + WS_HID); p.so.init(NE * CAP / 256, 2 * DE / 256, G, bx);
        LAS unsigned* rowtab = (LAS unsigned*)(lds + XTRA_OFF);
        const int* IDX = (const int*)(ws + WS_IDX);
        { const int tid = wave * 64 + fresh_lane(); pg8::Unit u; for (int i = 0; p.so.next(i, u) && i < 28; ++i) { if (tid < 256) rowtab[i * 256 + tid] = (unsigned)IDX[u.pm * 256 + tid]; } }
        __syncthreads();
        pg8::gemm_phase<P5Prob, true, true, true>(lds, p, rowtab, wave);
    }
    GRID_BAR();
    if (STEP >= 4 && PH(9)) {
        P6Prob p; p.HID = (bf16*)(ws + WS_HID); p.WdT = (bf16*)(ws + WS_WD); p.GATE = (const float*)(ws + WS_GATE); p.YE = (bf16*)(ws + WS_YE); p.so.init(NE * CAP / 256, DM / 256, G, bx);
        pg8::gemm_phase<P6Prob, false, true, true>(lds, p, nullptr, wave);
    }
    GRID_BAR();
    {
        unsigned poison = (__hip_atomic_load(ctl + CW_BAR + XB_TMO, RLX_AGENT) != 0u) || (__hip_atomic_load(ctl + CW_FLAG, RLX_AGENT) != 0u);
        p7_final(args, vcu, G, wave, poison);
    }
}

extern "C" void kernel_launch(void* const* d_in, const int* in_sizes, int n_in, void* d_out, int out_size, void* d_ws, size_t ws_size, hipStream_t stream) {
    static int grid = 0;
    if (grid == 0) {
        if (n_in != 18 || in_sizes[0] != NTOK * DM || out_size != NTOK * DM || ws_size < WS_END) { fprintf(stderr, "kernel_launch: unexpected shapes (n_in %d, in0 %d, out %d, ws %zu)\n", n_in, n_in > 0 ? in_sizes[0] : -1, out_size, ws_size); grid = -1; return; }
        int dev = 0, cus = 0, per_cu = 0;
        if (hipGetDevice(&dev) != hipSuccess || hipDeviceGetAttribute(&cus, hipDeviceAttributeMultiprocessorCount, dev) != hipSuccess) { grid = -1; return; }
        if (hipFuncSetAttribute((const void*)fwd_megakernel, hipFuncAttributeMaxDynamicSharedMemorySize, LDS_BYTES) != hipSuccess) { fprintf(stderr, "kernel_launch: hipFuncSetAttribute failed\n"); grid = -1; return; }
        if (hipOccupancyMaxActiveBlocksPerMultiprocessor(&per_cu, (const void*)fwd_megakernel, NTHR, LDS_BYTES) != hipSuccess || per_cu < 1) { fprintf(stderr, "kernel_launch: occupancy query says %d blocks per CU\n", per_cu); (void)hipGetLastError(); grid = -1; return; }
        grid = cus;
    }
    if (grid < 0) return;
    (void)hipMemsetAsync((char*)d_ws + WS_CTL, 0, CTL_ZERO_BYTES, stream);
    Args a{};
    const float** f = (const float**)&a;
    for (int i = 0; i < 18; ++i) f[i] = (const float*)d_in[i];
    a.out = (float*)d_out; a.ws = (unsigned char*)d_ws;
    hipLaunchKernelGGL(fwd_megakernel, dim3(grid), dim3(NTHR), LDS_BYTES, stream, a);
}
```

```cpp
#include <hip/hip_runtime.h>
#include <hip/hip_bf16.h>
#include <cstdio>
#include <cstdint>
#include <cmath>

#ifndef STEP
#define STEP 4
#endif
#ifndef PROBE
#define PROBE 0
#endif
#ifndef PHMASK
#define PHMASK 0xFFFF
#endif
#define PH(k) ((PHMASK >> (k)) & 1)
#ifndef REPEAT
#define REPEAT 0
#endif
#define REP(k) (((REPEAT >> (k)) & 1) + 1)

constexpr int DM = 1024, NTOK = 16384, NCTX = 256, NROWS = NTOK + NCTX, INW = 1536;
constexpr int NHQ = 12, NHKV = 4, HD = 64, NE = 16, CAP = 2048, DE = 2048, NMOD = 6;
constexpr int NKEYS = NROWS;
constexpr float EPS = 1e-6f;

__device__ __forceinline__ int fresh_lane() { int l; asm volatile("v_mbcnt_lo_u32_b32 %0, -1, 0\n\tv_mbcnt_hi_u32_b32 %0, -1, %0" : "=v"(l)); return l; }

namespace pg8 {
#define PG8_LAS __attribute__((address_space(3)))
typedef unsigned short bf16_t;
typedef short bf16x8 __attribute__((ext_vector_type(8)));
typedef float f32x4 __attribute__((ext_vector_type(4)));
typedef unsigned u32x4 __attribute__((ext_vector_type(4)));
typedef unsigned u32x2 __attribute__((ext_vector_type(2)));
constexpr int BM = 256, BK = 64, HALF = 128, HTB = HALF * BK * 2, STAGE_BYTES = 8 * HTB, NXCD = 8, WGM = 8;

__host__ __device__ __forceinline__ int lds_byte(int r, int c) { const int st = (r >> 4) * 2 + (c >> 5), rr = r & 15, cc = c & 31, ob = rr * 64 + cc * 2; return st * 1024 + (ob ^ (((ob >> 9) & 1) << 5)); }
__host__ __device__ __forceinline__ void stage_rc(int b, int& R, int& C) { const int st = b / 1024, sb = b % 1024, swz = sb ^ (((sb >> 9) & 1) << 5); R = (st >> 1) * 16 + swz / 64; C = (st & 1) * 32 + (swz % 64) / 2; }
__host__ __device__ __forceinline__ int perm32(int rho) { const int n = rho >> 4, i = rho & 15; return 8 * (i >> 2) + 4 * n + (i & 3); }

struct Unit { int pm, pn; };

struct StaticOrder {
    int nM, nN, nwg, G, c;
    __host__ __device__ void init(int nM_, int nN_, int G_, int c_) { nM = nM_; nN = nN_; nwg = nM * nN; G = G_; c = c_; }
    __host__ __device__ bool next(int i, Unit& u) const {
        const long L = (long)i * G + c; if (L >= nwg) return false;
        int wgid = (int)L; { const int q = nwg / NXCD, r = nwg % NXCD, xcd = wgid % NXCD, off = wgid / NXCD; wgid = (xcd < r ? xcd * (q + 1) : r * (q + 1) + (xcd - r) * q) + off; }
        const int nig = WGM * nN, gid = wgid / nig, fm = gid * WGM, gsz = (nM - fm) < WGM ? (nM - fm) : WGM;
        u.pm = fm + ((wgid % nig) % gsz); u.pn = (wgid % nig) / gsz; return true;
    }
};

__device__ __forceinline__ unsigned cvt_pk_bf16(float lo, float hi) { unsigned r; asm volatile("v_cvt_pk_bf16_f32 %0, %1, %2" : "=v"(r) : "v"(lo), "v"(hi)); return r; }

template <class P, bool GATHER, bool ALIGN_EPI, bool SP2>
__device__ __forceinline__ void gemm_phase(PG8_LAS unsigned char* lds, const P& S, const PG8_LAS unsigned* rowtab, int wid) {
    const int lane = fresh_lane(), tid = wid * 64 + lane, wr = wid >> 2, wc = wid & 3, fr = lane & 15, fq = lane >> 4;
    constexpr int K = P::K, nt = K / BK;
    int R0, C0; stage_rc(tid * 16, R0, C0);
    unsigned voffB[2];
#pragma unroll
    for (int i = 0; i < 2; ++i) { const int R = R0 + 64 * i; const int Rb = P::PERM ? ((R & ~31) + perm32(R & 31)) : R; voffB[i] = (unsigned)(Rb * K + C0) * 2u; }
    constexpr size_t kstep = (size_t)(BK * 2);
    constexpr size_t hstep = (size_t)HALF * K * 2;
    const unsigned ldsw = (unsigned)wid * 1024u;
    const int aoff = lds_byte(wr * 64 + fr, fq * 8), boff = lds_byte(wc * 32 + fr, fq * 8);
#define PG8_SA(b, h) (((b) * 2 + (h)) * HTB)
#define PG8_SB(b, h) ((4 + (b) * 2 + (h)) * HTB)
#define PG8_STAGE(bufoff, gbase, voff) do { _Pragma("unroll") for (int _i = 0; _i < 2; ++_i) \
        __builtin_amdgcn_global_load_lds((const unsigned*)((const char*)(gbase) + (voff)[_i]), (PG8_LAS unsigned*)(lds + (bufoff) + ldsw + _i * 8192), 16, 0, 0); } while (0)
#define PG8_LDA(dst, b, h) do { _Pragma("unroll") for (int m = 0; m < 4; ++m) _Pragma("unroll") for (int k = 0; k < 2; ++k) dst[m][k] = *(const PG8_LAS bf16x8*)(lds + PG8_SA(b, h) + aoff + m * 2048 + k * 1024); } while (0)
#define PG8_LDB(dst, b, h) do { _Pragma("unroll") for (int n = 0; n < 2; ++n) _Pragma("unroll") for (int k = 0; k < 2; ++k) dst[n][k] = *(const PG8_LAS bf16x8*)(lds + PG8_SB(b, h) + boff + n * 2048 + k * 1024); } while (0)
#define PG8_MMA(ai, bj, At, Bt) do { __builtin_amdgcn_s_setprio(1); _Pragma("unroll") for (int m = 0; m < 4; ++m) _Pragma("unroll") for (int n = 0; n < 2; ++n) _Pragma("unroll") for (int k = 0; k < 2; ++k) \
        acc[ai][bj][m][n] = __builtin_amdgcn_mfma_f32_16x16x32_bf16(Bt[n][k], At[m][k], acc[ai][bj][m][n], 0, 0, 0); __builtin_amdgcn_s_setprio(0); } while (0)
#define PG8_WAIT_V(n) asm volatile("s_waitcnt vmcnt(" #n ")" ::: "memory")
#define PG8_WAIT_L(n) asm volatile("s_waitcnt lgkmcnt(" #n ")" ::: "memory")
#define PG8_BAR __builtin_amdgcn_s_barrier()
#define PG8_SCHED __builtin_amdgcn_sched_barrier(0)
#define PG8_AOFF(dst, u_, ui_) do { _Pragma("unroll") for (int _h = 0; _h < 2; ++_h) _Pragma("unroll") for (int _i = 0; _i < 2; ++_i) { \
        if constexpr (GATHER) dst[_h][_i] = (unsigned)(rowtab[(ui_) * 256 + _h * HALF + _i * 64 + R0] * (unsigned)K + (unsigned)C0) * 2u; \
        else dst[_h][_i] = (unsigned)((_h * HALF + _i * 64 + R0) * K + C0) * 2u; } } while (0)
    Unit cur, nxt; int ui = 0;
    if (!S.next(0, cur)) return;
    f32x4 acc[2][2][4][2];
#pragma unroll
    for (int a = 0; a < 2; ++a)
#pragma unroll
        for (int b = 0; b < 2; ++b)
#pragma unroll
            for (int m = 0; m < 4; ++m)
#pragma unroll
                for (int n = 0; n < 2; ++n) acc[a][b][m][n] = (f32x4){0.f, 0.f, 0.f, 0.f};
    bf16x8 At[4][2], B0[2][2], B1[2][2];
    unsigned vAc[2][2], vAn[2][2];
    PG8_AOFF(vAc, cur, 0);
    const char* cA = S.aptr(cur); const char* cB = S.bptr(cur);
    if constexpr (SP2) {
        PG8_STAGE(PG8_SB(0, 0), cB, voffB); PG8_STAGE(PG8_SB(0, 1), cB + hstep, voffB); PG8_STAGE(PG8_SA(0, 0), cA, vAc[0]); PG8_STAGE(PG8_SA(0, 1), cA, vAc[1]);
        if (wr == 1) PG8_BAR;
        PG8_WAIT_V(2); PG8_BAR;
        PG8_STAGE(PG8_SB(1, 0), cB + kstep, voffB); PG8_STAGE(PG8_SA(1, 0), cA + kstep, vAc[0]); PG8_STAGE(PG8_SB(1, 1), cB + hstep + kstep, voffB);
        PG8_WAIT_V(6); PG8_BAR;
    } else {
        PG8_STAGE(PG8_SB(0, 0), cB, voffB); PG8_STAGE(PG8_SA(0, 0), cA, vAc[0]); PG8_STAGE(PG8_SB(0, 1), cB + hstep, voffB); PG8_STAGE(PG8_SA(0, 1), cA, vAc[1]);
        if (wr == 1) PG8_BAR;
        PG8_WAIT_V(4); PG8_BAR;
        PG8_STAGE(PG8_SB(1, 0), cB + kstep, voffB); PG8_STAGE(PG8_SA(1, 0), cA + kstep, vAc[0]); PG8_STAGE(PG8_SB(1, 1), cB + hstep + kstep, voffB);
        PG8_WAIT_V(6); PG8_BAR;
    }
    for (;;) {
        const bool has_next = S.next(ui + 1, nxt);
        const char* nA = has_next ? S.aptr(nxt) : cA; const char* nB = has_next ? S.bptr(nxt) : cB;
        if (has_next) { PG8_AOFF(vAn, nxt, ui + 1); }
        else {
#pragma unroll
            for (int h = 0; h < 2; ++h)
#pragma unroll
                for (int i = 0; i < 2; ++i) vAn[h][i] = vAc[h][i];
        }
        for (int t = 0; t < nt; t += 2) {
            const bool last = (t == nt - 2);
            const char* a1 = cA + (size_t)(t + 1) * kstep;
            const char* a2 = last ? nA : cA + (size_t)(t + 2) * kstep; const char* b2 = last ? nB : cB + (size_t)(t + 2) * kstep;
            const char* a3 = a2 + kstep; const char* b3 = b2 + kstep;
            unsigned w2[2][2];
#pragma unroll
            for (int h = 0; h < 2; ++h)
#pragma unroll
                for (int i = 0; i < 2; ++i) w2[h][i] = last ? vAn[h][i] : vAc[h][i];
            if constexpr (SP2) {
            PG8_LDB(B0, 0, 0); PG8_LDB(B1, 0, 1); PG8_SCHED; PG8_LDA(At, 0, 0); PG8_STAGE(PG8_SA(1, 1), a1, vAc[1]);
            PG8_WAIT_V(8); PG8_WAIT_L(0); PG8_BAR; PG8_MMA(0, 0, At, B0); PG8_MMA(0, 1, At, B1); PG8_BAR; PG8_SCHED;
            PG8_LDA(At, 0, 1); PG8_STAGE(PG8_SB(0, 0), b2, voffB); PG8_STAGE(PG8_SB(0, 1), b2 + hstep, voffB); PG8_STAGE(PG8_SA(0, 0), a2, w2[0]);
            PG8_WAIT_V(8); PG8_WAIT_L(0); PG8_BAR; PG8_MMA(1, 0, At, B0); PG8_MMA(1, 1, At, B1); PG8_BAR; PG8_SCHED;
            PG8_LDB(B0, 1, 0); PG8_LDB(B1, 1, 1); PG8_SCHED; PG8_LDA(At, 1, 0); PG8_STAGE(PG8_SA(0, 1), a2, w2[1]);
            PG8_WAIT_V(8); PG8_WAIT_L(0); PG8_BAR; PG8_MMA(0, 0, At, B0); PG8_MMA(0, 1, At, B1); PG8_BAR; PG8_SCHED;
            PG8_LDA(At, 1, 1); PG8_STAGE(PG8_SB(1, 0), b3, voffB); PG8_STAGE(PG8_SB(1, 1), b3 + hstep, voffB); PG8_STAGE(PG8_SA(1, 0), a3, w2[0]);
            PG8_WAIT_V(8); PG8_WAIT_L(0); PG8_BAR; PG8_MMA(1, 0, At, B0); PG8_MMA(1, 1, At, B1); PG8_BAR; PG8_SCHED;
            } else {
            PG8_LDB(B0, 0, 0); PG8_SCHED; PG8_LDA(At, 0, 0); PG8_STAGE(PG8_SA(1, 1), a1, vAc[1]);
            PG8_WAIT_L(8); PG8_BAR; PG8_WAIT_L(0); PG8_MMA(0, 0, At, B0); PG8_BAR; PG8_SCHED;
            PG8_LDB(B1, 0, 1); PG8_STAGE(PG8_SB(0, 0), b2, voffB);
            PG8_BAR; PG8_WAIT_L(0); PG8_MMA(0, 1, At, B1); PG8_BAR;
            PG8_LDA(At, 0, 1); PG8_STAGE(PG8_SA(0, 0), a2, w2[0]);
            PG8_BAR; PG8_WAIT_L(0); PG8_MMA(1, 0, At, B0); PG8_BAR; PG8_SCHED;
            PG8_STAGE(PG8_SB(0, 1), b2 + hstep, voffB);
            PG8_WAIT_V(6); PG8_BAR; PG8_MMA(1, 1, At, B1); PG8_BAR;
            PG8_LDB(B0, 1, 0); PG8_SCHED; PG8_LDA(At, 1, 0); PG8_STAGE(PG8_SA(0, 1), a2, w2[1]);
            PG8_WAIT_L(8); PG8_BAR; PG8_WAIT_L(0); PG8_MMA(0, 0, At, B0); PG8_BAR; PG8_SCHED;
            PG8_LDB(B1, 1, 1); PG8_STAGE(PG8_SB(1, 0), b3, voffB);
            PG8_BAR; PG8_WAIT_L(0); PG8_MMA(0, 1, At, B1); PG8_BAR;
            PG8_LDA(At, 1, 1); PG8_STAGE(PG8_SA(1, 0), a3, w2[0]);
            PG8_BAR; PG8_WAIT_L(0); PG8_MMA(1, 0, At, B0); PG8_BAR; PG8_SCHED;
            PG8_STAGE(PG8_SB(1, 1), b3 + hstep, voffB);
            PG8_WAIT_V(6); PG8_BAR; PG8_MMA(1, 1, At, B1); PG8_BAR;
            }
        }
        if constexpr (ALIGN_EPI) { if (wr == 0) PG8_BAR; }
        { int fr2 = fr, fq2 = fq; asm volatile("" : "+v"(fr2), "+v"(fq2));
          S.epi(acc, cur, wr, wc, fr2, fq2); }
        if (!has_next) break;
#pragma unroll
        for (int a = 0; a < 2; ++a)
#pragma unroll
            for (int b = 0; b < 2; ++b)
#pragma unroll
                for (int m = 0; m < 4; ++m)
#pragma unroll
                    for (int n = 0; n < 2; ++n) acc[a][b][m][n] = (f32x4){0.f, 0.f, 0.f, 0.f};
        cur = nxt; cA = nA; cB = nB; ++ui;
#pragma unroll
        for (int h = 0; h < 2; ++h)
#pragma unroll
            for (int i = 0; i < 2; ++i) vAc[h][i] = vAn[h][i];
        if constexpr (ALIGN_EPI) { if (wr == 1) PG8_BAR; }
    }
    PG8_WAIT_V(0);
    if constexpr (!ALIGN_EPI) { if (wr == 0) PG8_BAR; }
    PG8_BAR;
#undef PG8_SA
#undef PG8_SB
#undef PG8_STAGE
#undef PG8_LDA
#undef PG8_LDB
#undef PG8_MMA
#undef PG8_WAIT_V
#undef PG8_WAIT_L
#undef PG8_BAR
#undef PG8_SCHED
#undef PG8_AOFF
}
}

namespace attn_body {
using bf16 = __hip_bfloat16;
using bf16x8 = __attribute__((ext_vector_type(8))) short;
using s16x4 = __attribute__((ext_vector_type(4))) short;
using f32x16 = __attribute__((ext_vector_type(16))) float;
using u32x4 = __attribute__((ext_vector_type(4))) unsigned;
constexpr int D = 64, QPITCH = NHQ * D, KPITCH = NHKV * D, OPITCH = DM, OCOL0 = 256;
constexpr int NW = 8, QBLK = 32, QB = QBLK * NW, KVBLK = 64, NQB = NTOK / QB, NT = NKEYS / KVBLK;
static_assert(NT % 2 == 0 && NT >= 8, "tile count");
__device__ __forceinline__ int crow(int r, int hi) { return (r & 3) + 8 * (r >> 2) + 4 * hi; }
#define SBAR() __builtin_amdgcn_sched_barrier(0)
constexpr int NSLOT = 3, SLOTB = 8192;
constexpr int LDS_K = 0, LDS_V = NSLOT * SLOTB, LDS_WS = 2 * NSLOT * SLOTB, LDS_OST = LDS_WS + NW * 64 * 4, LDS_BYTES = LDS_OST + NW * 4096;
constexpr float C2 = 0.125f * 1.4426950408889634f;
__device__ __forceinline__ void glds16(const void* gsrc, unsigned lds_dst) { unsigned keep;
  asm volatile("s_mov_b32 %0, m0\n\ts_mov_b32 m0, %2\n\ts_nop 0\n\tglobal_load_lds_dwordx4 %1, off\n\ts_mov_b32 m0, %0" : "=&s"(keep) : "v"(gsrc), "s"(lds_dst) : "memory"); }
__device__ __forceinline__ float max3f(float a, float b, float c) { float r; asm("v_max3_f32 %0, %1, %2, %3" : "=v"(r) : "v"(a), "v"(b), "v"(c)); return r; }
__device__ __forceinline__ float max2f(float a, float b) { float r; asm("v_max_f32_e32 %0, %1, %2" : "=v"(r) : "v"(a), "v"(b)); return r; }
__device__ __forceinline__ float fadd_s(float a, float b) { float r; asm("v_add_f32_e32 %0, %1, %2" : "=v"(r) : "v"(a), "v"(b)); return r; }
__device__ __forceinline__ float fsub_s(float a, float b) { float r; asm("v_sub_f32_e32 %0, %1, %2" : "=v"(r) : "v"(a), "v"(b)); return r; }
typedef float f32x2_t __attribute__((ext_vector_type(2))); typedef __bf16 bf16x2_t __attribute__((ext_vector_type(2)));
__device__ __forceinline__ unsigned cvtpk_s(float lo, float hi) { f32x2_t v = {lo, hi}; bf16x2_t b = __builtin_convertvector(v, bf16x2_t); return __builtin_bit_cast(unsigned, b); }
#define WAIT_BAR(N) asm volatile("s_waitcnt vmcnt(" #N ") lgkmcnt(0)\n\ts_barrier" ::: "memory")

__device__ __forceinline__ void qkt(f32x16& p0, f32x16& p1, const char* Kslot, const bf16x8* qr, const f32x16& negm, int r32, int hi) {
  const char* kb = Kslot + hi * 1024 + r32 * 16;
  #pragma unroll
  for (int d0 = 0; d0 < 4; ++d0) {
    const bf16x8 b0 = *reinterpret_cast<const bf16x8*>(kb + d0 * 2048);
    const bf16x8 b1 = *reinterpret_cast<const bf16x8*>(kb + d0 * 2048 + 512);
    if (d0 == 0) { p0 = __builtin_amdgcn_mfma_f32_32x32x16_bf16(b0, qr[0], negm, 0, 0, 0); p1 = __builtin_amdgcn_mfma_f32_32x32x16_bf16(b1, qr[0], negm, 0, 0, 0); }
    else { p0 = __builtin_amdgcn_mfma_f32_32x32x16_bf16(b0, qr[d0], p0, 0, 0, 0); p1 = __builtin_amdgcn_mfma_f32_32x32x16_bf16(b1, qr[d0], p1, 0, 0, 0); } }
}
typedef __attribute__((address_space(3))) const char* lds_cptr;
typedef short v4i16_t __attribute__((ext_vector_type(4)));
__device__ __forceinline__ void kload8(bf16x8* kf, lds_cptr kp) {
  kf[0] = *(const __attribute__((address_space(3))) bf16x8*)(kp);        kf[1] = *(const __attribute__((address_space(3))) bf16x8*)(kp + 512);
  kf[2] = *(const __attribute__((address_space(3))) bf16x8*)(kp + 2048); kf[3] = *(const __attribute__((address_space(3))) bf16x8*)(kp + 2560);
  kf[4] = *(const __attribute__((address_space(3))) bf16x8*)(kp + 4096); kf[5] = *(const __attribute__((address_space(3))) bf16x8*)(kp + 4608);
  kf[6] = *(const __attribute__((address_space(3))) bf16x8*)(kp + 6144); kf[7] = *(const __attribute__((address_space(3))) bf16x8*)(kp + 6656);
}
__device__ __forceinline__ void kload2(bf16x8* kf, lds_cptr kp, int j) { kf[2 * j] = *(const __attribute__((address_space(3))) bf16x8*)(kp + j * 2048); kf[2 * j + 1] = *(const __attribute__((address_space(3))) bf16x8*)(kp + j * 2048 + 512); }
__device__ __forceinline__ s16x4 vtr(lds_cptr p) { return __builtin_bit_cast(s16x4, __builtin_amdgcn_ds_read_tr16_b64_v4i16((__attribute__((address_space(3))) v4i16_t*)p)); }
__device__ __forceinline__ float rowmax(const f32x16& p0, const f32x16& p1) {
  float a = max3f(p0[0], p0[1], p1[0]), b = max3f(p0[2], p0[3], p1[1]); a = max3f(a, p1[2], p1[3]);
  #pragma unroll
  for (int r = 4; r < 16; r += 4) { a = max3f(a, p0[r], p0[r + 1]); b = max3f(b, p0[r + 2], p0[r + 3]); a = max3f(a, p1[r], p1[r + 1]); b = max3f(b, p1[r + 2], p1[r + 3]); }
  const float m = max2f(a, b);
  auto rr = __builtin_amdgcn_permlane32_swap(__float_as_uint(m), __float_as_uint(m), false, false);
  return max2f(__uint_as_float(rr[0]), __uint_as_float(rr[1]));
}
__device__ __forceinline__ void pv(f32x16* o, int vb, bf16x8 pa0, bf16x8 pa1, bf16x8 pa2, bf16x8 pa3) {
  #pragma unroll
  for (int d0 = 0; d0 < 2; ++d0) { s16x4 lo[4], hi[4];
    #pragma unroll
    for (int ks = 0; ks < 4; ++ks) {
      asm volatile("ds_read_b64_tr_b16 %0,%1 offset:%c2" : "=&v"(lo[ks]) : "v"(vb), "i"(d0 * 4096 + ks * 1024) : "memory");
      asm volatile("ds_read_b64_tr_b16 %0,%1 offset:%c2" : "=&v"(hi[ks]) : "v"(vb), "i"(d0 * 4096 + ks * 1024 + 512) : "memory"); }
    asm volatile("s_waitcnt lgkmcnt(0)" ::: "memory"); SBAR();
    #define PK(k) (bf16x8){lo[k][0], lo[k][1], lo[k][2], lo[k][3], hi[k][0], hi[k][1], hi[k][2], hi[k][3]}
    o[d0] = __builtin_amdgcn_mfma_f32_32x32x16_bf16(pa0, PK(0), o[d0], 0, 0, 0);
    o[d0] = __builtin_amdgcn_mfma_f32_32x32x16_bf16(pa1, PK(1), o[d0], 0, 0, 0);
    o[d0] = __builtin_amdgcn_mfma_f32_32x32x16_bf16(pa2, PK(2), o[d0], 0, 0, 0);
    o[d0] = __builtin_amdgcn_mfma_f32_32x32x16_bf16(pa3, PK(3), o[d0], 0, 0, 0);
    #undef PK
  }
}
#define ATTN_STORE16(p, v) (*(u32x4*)(p) = (v))
template <int THRL> __device__ __forceinline__ void attn_unit(int h, int kvh, int qb, const bf16* Q, const bf16* __restrict__ K, const bf16* __restrict__ V, bf16* O, char* shm, int wid) {
  const int lane = fresh_lane(), r32 = lane & 31, hi = lane >> 5;
  const int q0 = qb * QB;
  const bf16* Qw = Q + (long)(q0 + wid * QBLK) * QPITCH + h * D;
  const bf16* Kh = K + kvh * D, *Vh = V + kvh * D;
  const unsigned lds0 = (unsigned)(uintptr_t)shm;
  float* wsf = (float*)(shm + LDS_WS) + wid * 64;
  const bf16* ksrc = Kh + (long)lane * KPITCH + wid * 8;
  const bf16* vsrc = Vh + (long)(16 * (wid & 3) + (lane >> 2)) * KPITCH + (wid >> 2) * 32 + (lane & 3) * 8;
  const unsigned kdst = lds0 + LDS_K + wid * 1024, vdst = lds0 + LDS_V + wid * 1024;
  #define DMA_K(t, slot) glds16(ksrc + (long)(t) * KVBLK * KPITCH, (unsigned)__builtin_amdgcn_readfirstlane(kdst + (slot)))
  #define DMA_V(t, slot) glds16(vsrc + (long)(t) * KVBLK * KPITCH, (unsigned)__builtin_amdgcn_readfirstlane(vdst + (slot)))
  const int vb0 = (int)(lds0 + LDS_V) + ((lane >> 4) & 1) * 32 + (lane & 3) * 8 + (4 * hi + ((lane & 15) >> 2)) * 64;
  const char* Kbase = shm + LDS_K; bf16x8 kf[8];
  const lds_cptr shm3 = (lds_cptr)shm; const lds_cptr kp0 = shm3 + LDS_K + hi * 1024 + r32 * 16; const lds_cptr vp0 = shm3 + LDS_V + ((lane >> 4) & 1) * 32 + (lane & 3) * 8 + (4 * hi + ((lane & 15) >> 2)) * 64;
  DMA_K(0, 0); DMA_V(0, 0); DMA_K(1, SLOTB);
  bf16x8 qr[4];
  #pragma unroll
  for (int d0 = 0; d0 < 4; ++d0) qr[d0] = *reinterpret_cast<const bf16x8*>(&Qw[(long)r32 * QPITCH + d0 * 16 + hi * 8]);
  float mhat = 0.f, l_reg = 0.f; f32x16 o[2]; o[0] = f32x16{}; o[1] = f32x16{}; f32x16 negm = f32x16{}; asm volatile("" : "+v"(negm));
  bool resc = false;
  #define START(P0, P1) do { const float rm = rowmax(P0, P1); resc = false; \
    { const float dl = rm; mhat = fadd_s(mhat, dl); \
      _Pragma("unroll") for (int r = 0; r < 16; ++r) { P0[r] = fsub_s(P0[r], dl); P1[r] = fsub_s(P1[r], dl); } \
      _Pragma("unroll") for (int r = 0; r < 16; ++r) negm[r] = -mhat; asm volatile("" : "+v"(negm)); } \
    _Pragma("unroll") for (int r = 0; r < 16; ++r) P0[r] = __builtin_amdgcn_exp2f(P0[r]); } while (0)
  #define RESC() do { if (resc) { asm volatile("s_waitcnt lgkmcnt(0)" ::: "memory"); \
      _Pragma("unroll") for (int d_ = 0; d_ < 2; ++d_) _Pragma("unroll") for (int r = 0; r < 16; ++r) o[d_][r] *= wsf[crow(r, hi)]; } } while (0)
  f32x16 pA0, pA1, pB0, pB1;
  int sl_prev = 0, sl_cur = 0, sl_next = SLOTB;
  #define ROT() do { sl_prev = sl_cur; sl_cur = sl_next; sl_next = (sl_next == (NSLOT - 1) * SLOTB) ? 0 : sl_next + SLOTB; } while (0)
  DMA_K(2, 2 * SLOTB);
  WAIT_BAR(3);
  qkt(pA0, pA1, Kbase, qr, negm, r32, hi); asm volatile("s_nop 15\n\ts_nop 7" : "+v"(pA0), "+v"(pA1));
  START(pA0, pA1);
  _Pragma("unroll") for (int r = 0; r < 16; ++r) pA1[r] = __builtin_amdgcn_exp2f(pA1[r]);
  WAIT_BAR(0);
  DMA_K(3, 0); DMA_V(1, SLOTB);
  ROT();
  kload8(kf, kp0 + sl_cur);
  WAIT_BAR(2);
  s16x4 vlo[8], vhi[8]; u32x4 pw0, pw1, pw2, pw3;
  #define PKW(P, B) cvtpk_s(P[B], P[B + 1])
  #define PAF(k) __builtin_bit_cast(bf16x8, pw##k)
  #define VFR(i) (bf16x8){vlo[i][0], vlo[i][1], vlo[i][2], vlo[i][3], vhi[i][0], vhi[i][1], vhi[i][2], vhi[i][3]}
  #define PIN(x) asm volatile("" : "+v"(x))
  #define MX3(a, b, c) __builtin_fmaxf(__builtin_fmaxf((a), (b)), (c))
  #define GAPA(MF, A0, A1, A2, A3, W0, W1, PW) do { MF; sacc += A0; sacc += A1; sacc += A2; sacc += A3; PIN(sacc); W0; W1; PIN(PW); SBAR(); } while (0)
  #define EX(v) __builtin_amdgcn_exp2f(v)
  #define GAPB(MF, X, B) do { MF; X[B] = EX(X[B]); X[B + 1] = EX(X[B + 1]); X[B + 2] = EX(X[B + 2]); X[B + 3] = EX(X[B + 3]); PIN(X); SBAR(); } while (0)
  #define VRD(i) do { vlo[i] = vtr(vp_ + (((i) >> 2) * 4096 + ((i) & 3) * 1024)); vhi[i] = vtr(vp_ + (((i) >> 2) * 4096 + ((i) & 3) * 1024 + 512)); } while (0)
  #define KRD(G, j) do { if (G) { kload2(kf, kp0 + sl_next, j); SBAR(); } } while (0)
  #define STEPM(C0, C1, P0, P1, t, GK, GV, GL) do { SBAR(); \
    const lds_cptr vp_ = vp0 + sl_prev; \
    VRD(0); SBAR(); float sacc = (P0[0] + P0[1]); \
    GAPA(C0 = __builtin_amdgcn_mfma_f32_32x32x16_bf16(kf[0], qr[0], negm, 0, 0, 0), P0[2], P0[3], P0[4], P0[5],     pw0[0] = PKW(P0, 0), pw0[1] = PKW(P0, 2), pw0); \
    VRD(4); SBAR(); GAPA(C1 = __builtin_amdgcn_mfma_f32_32x32x16_bf16(kf[1], qr[0], negm, 0, 0, 0), P0[6], P0[7], P0[8], P0[9],     pw0[2] = PKW(P0, 4), pw0[3] = PKW(P0, 6), pw0); \
    VRD(1); SBAR(); GAPA(C0 = __builtin_amdgcn_mfma_f32_32x32x16_bf16(kf[2], qr[1], C0, 0, 0, 0),   P0[10], P0[11], P0[12], P0[13], pw1[0] = PKW(P0, 8), pw1[1] = PKW(P0, 10), pw1); \
    VRD(5); SBAR(); GAPA(C1 = __builtin_amdgcn_mfma_f32_32x32x16_bf16(kf[3], qr[1], C1, 0, 0, 0),   P0[14], P0[15], P1[0], P1[1],   pw1[2] = PKW(P0, 12), pw1[3] = PKW(P0, 14), pw1); \
    VRD(2); SBAR(); GAPA(C0 = __builtin_amdgcn_mfma_f32_32x32x16_bf16(kf[4], qr[2], C0, 0, 0, 0),   P1[2], P1[3], P1[4], P1[5],     pw2[0] = PKW(P1, 0), pw2[1] = PKW(P1, 2), pw2); \
    VRD(6); SBAR(); GAPA(C1 = __builtin_amdgcn_mfma_f32_32x32x16_bf16(kf[5], qr[2], C1, 0, 0, 0),   P1[6], P1[7], P1[8], P1[9],     pw2[2] = PKW(P1, 4), pw2[3] = PKW(P1, 6), pw2); \
    VRD(3); SBAR(); GAPA(C0 = __builtin_amdgcn_mfma_f32_32x32x16_bf16(kf[6], qr[3], C0, 0, 0, 0),   P1[10], P1[11], P1[12], P1[13], pw3[0] = PKW(P1, 8), pw3[1] = PKW(P1, 10), pw3); \
    VRD(7); SBAR(); GAPA(C1 = __builtin_amdgcn_mfma_f32_32x32x16_bf16(kf[7], qr[3], C1, 0, 0, 0),   P1[14], P1[15], 0.f, 0.f,       pw3[2] = PKW(P1, 12), pw3[3] = PKW(P1, 14), pw3); \
    l_reg += sacc; \
    if (GK) { DMA_K((t) + 3, sl_cur); } if (GV) { DMA_V((t) + 1, sl_next); } \
    { float a = MX3(C0[0], C0[1], C1[0]), b = MX3(C0[2], C0[3], C1[1]); a = MX3(a, C1[2], C1[3]); \
      _Pragma("unroll") for (int r = 4; r < 16; r += 4) { a = MX3(a, C0[r], C0[r + 1]); b = MX3(b, C0[r + 2], C0[r + 3]); a = MX3(a, C1[r], C1[r + 1]); b = MX3(b, C1[r + 2], C1[r + 3]); } \
      float rm = __builtin_fmaxf(a, b); { auto rr = __builtin_amdgcn_permlane32_swap(__float_as_uint(rm), __float_as_uint(rm), false, false); rm = __builtin_fmaxf(__uint_as_float(rr[0]), __uint_as_float(rr[1])); } \
      resc = false; \
      if (__builtin_expect(__any(rm > (float)THRL), 0)) { const float dl = __builtin_fmaxf(rm, 0.f); mhat += dl; \
        _Pragma("unroll") for (int r = 0; r < 16; ++r) { C0[r] -= dl; C1[r] -= dl; } \
        _Pragma("unroll") for (int r = 0; r < 16; ++r) negm[r] = -mhat; asm volatile("" : "+v"(negm)); \
        const float f = __builtin_amdgcn_exp2f(-dl); l_reg *= f; if (hi == 0) wsf[r32] = f; resc = true; } } \
    SBAR(); \
    GAPB(o[0] = __builtin_amdgcn_mfma_f32_32x32x16_bf16(PAF(0), VFR(0), o[0], 0, 0, 0), C0, 0); \
    GAPB(o[1] = __builtin_amdgcn_mfma_f32_32x32x16_bf16(PAF(0), VFR(4), o[1], 0, 0, 0), C0, 4); \
    KRD(GL, 0); GAPB(o[0] = __builtin_amdgcn_mfma_f32_32x32x16_bf16(PAF(1), VFR(1), o[0], 0, 0, 0), C0, 8); \
    KRD(GL, 1); GAPB(o[1] = __builtin_amdgcn_mfma_f32_32x32x16_bf16(PAF(1), VFR(5), o[1], 0, 0, 0), C0, 12); \
    KRD(GL, 2); GAPB(o[0] = __builtin_amdgcn_mfma_f32_32x32x16_bf16(PAF(2), VFR(2), o[0], 0, 0, 0), C1, 0); \
    KRD(GL, 3); GAPB(o[1] = __builtin_amdgcn_mfma_f32_32x32x16_bf16(PAF(2), VFR(6), o[1], 0, 0, 0), C1, 4); \
    GAPB(o[0] = __builtin_amdgcn_mfma_f32_32x32x16_bf16(PAF(3), VFR(3), o[0], 0, 0, 0), C1, 8); \
    GAPB(o[1] = __builtin_amdgcn_mfma_f32_32x32x16_bf16(PAF(3), VFR(7), o[1], 0, 0, 0), C1, 12); \
    } while (0)
  int t = 1;
  for (; t + 5 < NT; t += 2) {
    STEPM(pB0, pB1, pA0, pA1, t, true, true, true);     WAIT_BAR(2); RESC(); ROT();
    STEPM(pA0, pA1, pB0, pB1, t + 1, true, true, true); WAIT_BAR(2); RESC(); ROT();
  }
  #define ENDW(tt) do { if ((tt) + 3 < NT) { WAIT_BAR(2); } else if ((tt) + 2 < NT) { WAIT_BAR(1); } else { WAIT_BAR(0); } } while (0)
  for (; t + 1 < NT; t += 2) {
    STEPM(pB0, pB1, pA0, pA1, t, (t + 3 < NT), (t + 1 < NT), (t + 1 < NT));         ENDW(t);     RESC(); ROT();
    STEPM(pA0, pA1, pB0, pB1, t + 1, (t + 4 < NT), (t + 2 < NT), (t + 2 < NT));     ENDW(t + 1); RESC(); ROT();
  }
  STEPM(pB0, pB1, pA0, pA1, NT - 1, false, false, false); RESC();
  { float sacc = pB0[0] + pB0[1]; _Pragma("unroll") for (int r = 2; r < 16; ++r) sacc += pB0[r]; _Pragma("unroll") for (int r = 0; r < 16; ++r) sacc += pB1[r]; l_reg += sacc;
    pw0 = (u32x4){PKW(pB0, 0), PKW(pB0, 2), PKW(pB0, 4), PKW(pB0, 6)}; pw1 = (u32x4){PKW(pB0, 8), PKW(pB0, 10), PKW(pB0, 12), PKW(pB0, 14)}; pw2 = (u32x4){PKW(pB1, 0), PKW(pB1, 2), PKW(pB1, 4), PKW(pB1, 6)}; pw3 = (u32x4){PKW(pB1, 8), PKW(pB1, 10), PKW(pB1, 12), PKW(pB1, 14)};
    SBAR(); pv(o, vb0 + sl_cur, PAF(0), PAF(1), PAF(2), PAF(3)); }
  #undef PKW
  #undef PAF
  #undef VFR
  #undef PIN
  #undef MX3
  #undef GAPA
  #undef GAPB
  #undef EX
  #undef VRD
  #undef KRD
  #undef STEPM
  #undef ENDW
  { auto rr = __builtin_amdgcn_permlane32_swap(__float_as_uint(l_reg), __float_as_uint(l_reg), false, false); l_reg = __uint_as_float(rr[0]) + __uint_as_float(rr[1]); }
  if (hi == 0) wsf[32 + r32] = l_reg; asm volatile("s_waitcnt lgkmcnt(0)" ::: "memory");
  float rli[16];
  #pragma unroll
  for (int r = 0; r < 16; ++r) rli[r] = __builtin_amdgcn_rcpf(wsf[32 + crow(r, hi)]);
  bf16* Ow = O + (long)(q0 + wid * QBLK) * OPITCH + OCOL0 + h * D;
  { bf16* stg = (bf16*)(shm + LDS_OST) + wid * 2048;
    #pragma unroll
    for (int r = 0; r < 16; ++r) { const int orow = crow(r, hi);
      #pragma unroll
      for (int d0 = 0; d0 < 2; ++d0) stg[orow * 64 + d0 * 32 + r32] = __float2bfloat16(o[d0][r] * rli[r]); }
    asm volatile("s_waitcnt lgkmcnt(0)" ::: "memory");
    #pragma unroll
    for (int i = 0; i < 4; ++i) { const int row = i * 8 + (lane >> 3), ch = lane & 7; const u32x4 v = *(const u32x4*)(stg + row * 64 + ch * 8); ATTN_STORE16(Ow + (long)row * OPITCH + ch * 8, v); } }
  asm volatile("s_waitcnt lgkmcnt(0)\n\ts_barrier" ::: "memory");
  #undef DMA_K
  #undef DMA_V
  #undef START
  #undef RESC
  #undef ROT
}
#undef SBAR
#undef WAIT_BAR
}

constexpr int NWAVES = 8, NTHR = NWAVES * 64;
constexpr size_t MiB = 1u << 20;
constexpr size_t WS_CTL = 0, CTL_ZERO_BYTES = 64 * 1024;
constexpr size_t WS_MOD = 1 * MiB;
constexpr size_t WS_MISC = WS_MOD + 64 * 1024;
constexpr size_t WS_IDX = WS_MISC, WS_GATE = WS_IDX + 128 * 1024, WS_TOKSLOT = WS_GATE + 128 * 1024;
constexpr size_t WS_AFF = 3 * MiB;
constexpr size_t WS_WIN = 4 * MiB;
constexpr size_t WS_WOUT = 7 * MiB;
constexpr size_t WS_WGU = 9 * MiB;
constexpr size_t WS_WD = 137 * MiB;
constexpr size_t WS_X1 = 201 * MiB;
constexpr size_t WS_R1 = 265 * MiB;
constexpr size_t WS_XN = WS_R1;
constexpr size_t WS_Q = WS_XN + (size_t)NROWS * DM * 2;
constexpr size_t WS_K = WS_Q + (size_t)NTOK * 768 * 2;
constexpr size_t WS_V = WS_K + (size_t)NROWS * 256 * 2;
constexpr size_t WS_FT = WS_V + (size_t)NROWS * 256 * 2;
constexpr size_t WS_MIX = WS_FT + (size_t)256 * NTOK * 4;
constexpr size_t WS_HID = WS_R1;
constexpr size_t WS_R2 = 393 * MiB;
constexpr size_t WS_H2 = WS_R2;
constexpr size_t WS_YE = WS_R2;
constexpr size_t WS_END = 457 * MiB;
static_assert(WS_MIX + (size_t)NTOK * DM * 2 <= WS_R1 + 128 * MiB, "R1 map");
static_assert(WS_TOKSLOT + (size_t)NTOK * 16 * 4 <= WS_AFF, "misc map");
constexpr int CW_TMO = 0, CW_FLAG = 2, CW_BAR = 1024;

constexpr int LDS_BYTES = 163840;
constexpr int RING_BYTES = 131072, XTRA_OFF = RING_BYTES;
constexpr int MISC_OFF = LDS_BYTES - 512;

#define GAS __attribute__((address_space(1)))
#define LAS __attribute__((address_space(3)))
typedef unsigned short bf16;
typedef unsigned v4u __attribute__((ext_vector_type(4)));
typedef unsigned v2u __attribute__((ext_vector_type(2)));
typedef float f32x4 __attribute__((ext_vector_type(4)));
typedef float f32x2 __attribute__((ext_vector_type(2)));
typedef GAS unsigned gu32;
#define RLX_AGENT __ATOMIC_RELAXED, __HIP_MEMORY_SCOPE_AGENT
#define LDS_WAIT() asm volatile("s_waitcnt lgkmcnt(0)" ::: "memory")
#define VM_WAIT() asm volatile("s_waitcnt vmcnt(0)" ::: "memory")
__device__ __forceinline__ unsigned f2bf(float f) { unsigned u = __builtin_bit_cast(unsigned, f); return (u + 0x7fffu + ((u >> 16) & 1u)) >> 16; }
__device__ __forceinline__ unsigned pk2(float lo, float hi) { return f2bf(lo) | (f2bf(hi) << 16); }
__device__ __forceinline__ float bf2f(unsigned short b) { return __builtin_bit_cast(float, (unsigned)b << 16); }

#define XB_TMO      128
#define XB_XCNT(j)  (256  + 64 * (j))
#define XB_XSUB(j)  (1280 + 64 * (j))
#define XB_XGEN(j)  (2304 + 64 * (j))
#define XB_TOP      3328
#define XB_TOPGEN   3392
#define XCD_BAR_WORDS 3456
#define XB_SPIN_CAP (1u << 20)
static_assert((CW_BAR + XCD_BAR_WORDS) * 4 <= (int)CTL_ZERO_BYTES, "ctl");
__device__ __forceinline__ unsigned xb_ld(unsigned* p)              { return __hip_atomic_load(p, __ATOMIC_RELAXED, __HIP_MEMORY_SCOPE_AGENT); }
__device__ __forceinline__ unsigned xb_add(unsigned* p, unsigned v) { return __hip_atomic_fetch_add(p, v, __ATOMIC_RELAXED, __HIP_MEMORY_SCOPE_AGENT); }
__device__ __forceinline__ unsigned xb_xcc_id() { return (unsigned)__builtin_amdgcn_s_getreg((3 << 11) | 20) & 0xFu; }
#define XB_SPIN(cond, bar) do { unsigned _sp = 0; while (cond) { __builtin_amdgcn_s_sleep(1); \
    if ((++_sp & 255u) == 0u) { if (xb_ld(&(bar)[XB_TMO])) break; if (_sp > XB_SPIN_CAP) { atomicAdd(&(bar)[XB_TMO], 1u); break; } } } } while (0)
struct XcdBarrier { unsigned* bar; unsigned x; volatile LAS unsigned* st; };
__device__ __forceinline__ XcdBarrier xcd_barrier_post(unsigned* bar, volatile LAS unsigned* st, bool leader) {
    XcdBarrier b; b.bar = bar; b.x = xb_xcc_id(); b.st = st;
    if (leader) (void)xb_add(&bar[XB_XCNT(b.x)], 1u);
    return b;
}
__device__ __forceinline__ void xcd_barrier_complete(unsigned* bar, unsigned x, unsigned& nloc, unsigned& nx) {
    const unsigned G = gridDim.x * gridDim.y * gridDim.z;
    unsigned sum, cnt, mine, sp = 0u;
    for (;;) {
        sum = 0u; cnt = 0u; mine = 0u;
#pragma unroll
        for (unsigned j = 0; j < 16; ++j) { const unsigned c = xb_ld(&bar[XB_XCNT(j)]); sum += c; cnt += (c > 0u) ? 1u : 0u; mine = (j == x) ? c : mine; }
        if (sum == G) break;
        __builtin_amdgcn_s_sleep(1);
        if ((++sp & 255u) == 0u) { if (xb_ld(&bar[XB_TMO])) break; if (sp > XB_SPIN_CAP) { atomicAdd(&bar[XB_TMO], 1u); break; } }
    }
    nloc = mine > 0u ? mine : 1u; nx = cnt > 0u ? cnt : 1u;
}
__device__ __forceinline__ void xcd_barrier(const XcdBarrier& b, int wave) {
    asm volatile("s_waitcnt vmcnt(0)" ::: "memory");
    __syncthreads();
    if (wave == 0 && fresh_lane() == 0) {
        unsigned* bar = b.bar;
        __builtin_amdgcn_s_waitcnt(0);
        unsigned nloc = b.st[0], nx = b.st[1];
        if (nloc == 0u) { xcd_barrier_complete(bar, b.x, nloc, nx); b.st[0] = nloc; b.st[1] = nx; }
        const unsigned old = xb_add(&bar[XB_XSUB(b.x)], 1u);
        const unsigned gen = old / nloc;
        if (old + 1u == (gen + 1u) * nloc) {
            __builtin_amdgcn_fence(__ATOMIC_RELEASE, "agent");
            asm volatile("s_waitcnt vmcnt(0)" ::: "memory");
            const unsigned og = xb_add(&bar[XB_TOP], 1u);
            const unsigned tg = og / nx;
            if (og + 1u == (tg + 1u) * nx) xb_add(&bar[XB_TOPGEN], 1u);
            else XB_SPIN(xb_ld(&bar[XB_TOPGEN]) == tg, bar);
            __builtin_amdgcn_fence(__ATOMIC_ACQUIRE, "agent");
            xb_add(&bar[XB_XGEN(b.x)], 1u);
            asm volatile("s_waitcnt vmcnt(0)" ::: "memory");
        } else {
            XB_SPIN(xb_ld(&bar[XB_XGEN(b.x)]) == gen, bar);
            __builtin_amdgcn_fence(__ATOMIC_ACQUIRE, "agent");
            asm volatile("s_waitcnt vmcnt(0)" ::: "memory");
        }
    }
    __syncthreads();
}

struct Args {
    const float *x, *c, *ctx, *c_ctx, *w_mod, *b_mod, *norm_mix_g, *norm_ffn_g, *w_in, *w_four, *q_norm_g, *k_norm_g, *w_out, *w_router, *w_gate, *w_up, *w_down, *final_norm_g;
    float* out; unsigned char* ws;
};

__device__ __forceinline__ float wave_sum(float v) {
#pragma unroll
    for (int o = 1; o < 64; o <<= 1) v += __shfl_xor(v, o);
    return v;
}

template <class RowMap>
__device__ __forceinline__ void tr_item(const float* __restrict__ W, int ldw, int k0, int n0, bf16* WT, int ldt, int kdst0, const RowMap& drow, LAS float* scr, int lane) {
    const int kq = lane >> 4, nq = lane & 15;
    f32x4 v[16];
#pragma unroll
    for (int it = 0; it < 16; ++it) v[it] = *(const f32x4*)(W + (size_t)(k0 + 4 * it + kq) * ldw + n0 + 4 * nq);
#pragma unroll
    for (int it = 0; it < 16; ++it) { LAS float* s = scr + (4 * it + kq) * 65 + 4 * nq; s[0] = v[it][0]; s[1] = v[it][1]; s[2] = v[it][2]; s[3] = v[it][3]; }
    LDS_WAIT(); asm volatile("" ::: "memory");
    const int c = lane >> 3, nn = lane & 7;
#pragma unroll
    for (int j = 0; j < 8; ++j) { const int n = nn + 8 * j; const LAS float* s = scr + (8 * c) * 65 + n;
        v4u o; o.x = pk2(s[0 * 65], s[1 * 65]); o.y = pk2(s[2 * 65], s[3 * 65]); o.z = pk2(s[4 * 65], s[5 * 65]); o.w = pk2(s[6 * 65], s[7 * 65]);
        *(GAS v4u*)(WT + (size_t)drow(n0 + n) * ldt + kdst0 + k0 + 8 * c) = o; }
    LDS_WAIT(); asm volatile("" ::: "memory");
}
struct RowId { int base; __device__ __forceinline__ int operator()(int n) const { return base + n; } };
struct RowQKV { __device__ __forceinline__ int operator()(int n) const { const int t = n >> 8, w = n & 255, hd = w >> 6, d = w & 63; return 256 + 256 * t + 128 * (d >> 5) + 32 * hd + (d & 31); } };
struct RowGU { int base, up; __device__ __forceinline__ int operator()(int f) const { return base + 256 * (f >> 7) + 128 * up + (f & 127); } };


constexpr int MOE_ITEMS = 3 * 8192;
struct TrDesc { const float* src; bf16* dst; int ldw, ldt; };
__device__ __forceinline__ TrDesc moe_desc(const Args& a, int r) {
    TrDesc d;
    if (r < 16384) { const int up = r >> 13, rr = r & 8191, e = rr >> 9, q = rr & 511, kb = q >> 5, nb = q & 31;
        d.src = (up ? a.w_up : a.w_gate) + (size_t)e * DM * DE + (size_t)(kb * 64) * DE + nb * 64; d.ldw = DE;
        d.dst = (bf16*)(a.ws + WS_WGU) + ((size_t)e * 4096 + 256 * (nb >> 1) + 128 * up + 64 * (nb & 1)) * DM + kb * 64; d.ldt = DM; }
    else { const int rr = r - 16384, e = rr >> 9, q = rr & 511, kb = q >> 4, nb = q & 15;
        d.src = a.w_down + (size_t)e * DE * DM + (size_t)(kb * 64) * DM + nb * 64; d.ldw = DM;
        d.dst = (bf16*)(a.ws + WS_WD) + ((size_t)e * DM + nb * 64) * DE + kb * 64; d.ldt = DE; }
    return d;
}
#define TR_LOAD(v, d) do { _Pragma("unroll") for (int _it = 0; _it < 16; ++_it) v[_it] = *(const f32x4*)((d).src + (size_t)(4 * _it + kq) * (d).ldw + 4 * nq); } while (0)
#define TR_PROC(v, d) do { \
    _Pragma("unroll") for (int _it = 0; _it < 16; ++_it) { LAS float* s_ = scr + (4 * _it + kq) * 65 + 4 * nq; s_[0] = v[_it][0]; s_[1] = v[_it][1]; s_[2] = v[_it][2]; s_[3] = v[_it][3]; } \
    LDS_WAIT(); asm volatile("" ::: "memory"); \
    _Pragma("unroll") for (int _j = 0; _j < 8; ++_j) { const int n_ = nn + 8 * _j; const LAS float* s_ = scr + (8 * c8) * 65 + n_; \
        v4u o_; o_.x = pk2(s_[0 * 65], s_[1 * 65]); o_.y = pk2(s_[2 * 65], s_[3 * 65]); o_.z = pk2(s_[4 * 65], s_[5 * 65]); o_.w = pk2(s_[6 * 65], s_[7 * 65]); \
        *(GAS v4u*)((d).dst + (size_t)n_ * (d).ldt + 8 * c8) = o_; } \
    LDS_WAIT(); asm volatile("" ::: "memory"); } while (0)
__device__ __forceinline__ void moe_convert(const Args& a, LAS float* scr, int lo, int hi, int w, int nw) {
    const int lane = fresh_lane(), kq = lane >> 4, nq = lane & 15, c8 = lane >> 3, nn = lane & 7;
    int it = lo + w; if (it >= hi) return;
    f32x4 va[16], vb[16];
    TrDesc da = moe_desc(a, it), db = da; TR_LOAD(va, da);
    for (;;) {
        int nx = it + nw; bool hn = nx < hi;
        if (hn) { db = moe_desc(a, nx); TR_LOAD(vb, db); }
        TR_PROC(va, da);
        if (!hn) break;
        it = nx; nx = it + nw; hn = nx < hi;
        if (hn) { da = moe_desc(a, nx); TR_LOAD(va, da); }
        TR_PROC(vb, db);
        if (!hn) break;
        it = nx;
    }
}
#ifndef MOE_S0
#define MOE_S0 4096
#endif
#ifndef MOE_S1
#define MOE_S1 2560
#endif
#ifndef MOE_S2
#define MOE_S2 0
#endif
constexpr int MOE_B0 = MOE_S0, MOE_B1 = MOE_B0 + MOE_S1, MOE_B2 = MOE_B1 + MOE_S2;

__host__ __device__ __forceinline__ int four_pos(int mp) { return mp == 0 ? 0 : (mp == 32 ? 1 : (mp < 32 ? 2 * mp : 2 * (64 - mp) + 1)); }

__device__ __forceinline__ void p0_prologue(const Args& a, LAS unsigned char* lds, int vcu, int G, int wave) {
    const int lane = fresh_lane(), tid = wave * 64 + lane;
    unsigned char* ws = a.ws;
    bf16* WinT = (bf16*)(ws + WS_WIN); bf16* WoT = (bf16*)(ws + WS_WOUT);
    float* MOD = (float*)(ws + WS_MOD);
    const int cg = vcu - (G - 24);
    if (cg >= 0) {
        LAS float* sv = (LAS float*)lds;
        LAS float* red = sv + 2048;
        for (int i = tid; i < 1024; i += NTHR) { const float c0 = a.c[i], c1 = a.c_ctx[i]; sv[i] = c0 / (1.f + __expf(-c0)); sv[1024 + i] = c1 / (1.f + __expf(-c1)); }
        __syncthreads();
        const int col = cg * 256 + 4 * lane;
        f32x4 a0 = {0.f, 0.f, 0.f, 0.f}, a1 = {0.f, 0.f, 0.f, 0.f};
        const int kb = wave * 128;
#pragma unroll 16
        for (int k = 0; k < 128; ++k) { const f32x4 w = *(const f32x4*)(a.w_mod + (size_t)(kb + k) * (NMOD * DM) + col); const float s0 = sv[kb + k], s1 = sv[1024 + kb + k]; a0 += w * s0; a1 += w * s1; }
        *(LAS f32x4*)(red + (wave * 2 + 0) * 256 + 4 * lane) = a0; *(LAS f32x4*)(red + (wave * 2 + 1) * 256 + 4 * lane) = a1;
        __syncthreads();
        { const int v = tid >> 8, cc = tid & 255; float s = 0.f;
#pragma unroll
          for (int w = 0; w < 8; ++w) s += red[(w * 2 + v) * 256 + cc];
          MOD[v * (NMOD * DM) + cg * 256 + cc] = s + a.b_mod[cg * 256 + cc]; }
        __syncthreads();
    }
    LAS float* scr = (LAS float*)(lds + wave * 16640);
    constexpr int I_F1 = 256, I_F2 = 256, I_IN = 16 * 20, I_OUT = 12 * 16;
    constexpr int NITEMS = I_F1 + I_F2 + I_IN + I_OUT;
    for (int it = wave * G + vcu; it < NITEMS; it += NWAVES * G) {
        int r = it;
        if (r < I_F1) {
            const int g = r & 3, kb = (r >> 2) & 15, jq = r >> 6, k = kb * 64 + lane;
            LAS float* ct = scr;
            ct[lane] = cospif((float)lane * (1.f / 32.f)); LDS_WAIT(); asm volatile("" ::: "memory");
            float w[64];
#pragma unroll
            for (int c4 = 0; c4 < 16; ++c4) { const f32x4 t = *(const f32x4*)(a.w_in + (size_t)k * INW + 64 * g + 4 * c4); w[4 * c4] = t[0]; w[4 * c4 + 1] = t[1]; w[4 * c4 + 2] = t[2]; w[4 * c4 + 3] = t[3]; }
            for (int j = 16 * jq; j < 16 * jq + 16; ++j) { const int m = j <= 32 ? j : j - 32; const int ph = j <= 32 ? 0 : 48;
                float s = 0.f;
#pragma unroll
                for (int c = 0; c < 64; ++c) s += w[c] * ct[(c * m + ph) & 63];
                WinT[(size_t)(64 * g + j) * DM + k] = (bf16)f2bf(s * (1.f / 1024.f)); }
            LDS_WAIT(); asm volatile("" ::: "memory");
            continue; }
        r -= I_F1;
        if (r < I_F2) {
            const int g = r & 3, jb = (r >> 2) & 15, mq = r >> 6, j = jb * 64 + lane;
            float w[64];
#pragma unroll
            for (int d = 0; d < 64; ++d) w[d] = a.w_out[(size_t)(64 * g + d) * DM + j];
            for (int mp = 16 * mq; mp < 16 * mq + 16; ++mp) { float s = 0.f; const float* wf = a.w_four + (size_t)(g * 64 + mp) * 64;
#pragma unroll
                for (int d = 0; d < 64; ++d) s += wf[d] * w[d];
                WoT[(size_t)j * DM + 64 * g + four_pos(mp)] = (bf16)f2bf(s); }
            continue; }
        r -= I_F2;
        if (r < I_IN) { const int kb = r / 20, nb = r % 20; tr_item(a.w_in + 256, INW, kb * 64, nb * 64, WinT, DM, 0, RowQKV{}, scr, lane); continue; }
        r -= I_IN;
        { const int kb = r / 16, nb = r % 16; tr_item(a.w_out + (size_t)256 * DM, DM, kb * 64, nb * 64, WoT, DM, 256, RowId{0}, scr, lane); }
    }
    if (cg < 0) moe_convert(a, scr, 0, MOE_B0, ((wave + 4) & 7) * (G - 24) + vcu, NWAVES * (G - 24));
}

__device__ __forceinline__ void p0b_modulate(const Args& a, int vcu, int G, int wave) {
    const int lane = fresh_lane();
    unsigned char* ws = a.ws; const float* MOD = (const float*)(ws + WS_MOD); bf16* XN = (bf16*)(ws + WS_XN);
    const int gw = vcu * NWAVES + wave, NGW = G * NWAVES;
    for (int pass = 0; pass < 2; ++pass) {
        const float* md = MOD + pass * (NMOD * DM);
        const int nrows = pass == 0 ? NTOK : NCTX; const float* src = pass == 0 ? a.x : a.ctx; bf16* dst = XN + (size_t)(pass == 0 ? 0 : NTOK) * DM;
        if (gw >= nrows) continue;
        f32x4 av[4], sh[4];
#pragma unroll
        for (int j = 0; j < 4; ++j) { const int col = 4 * lane + 256 * j; const f32x4 g = *(const f32x4*)(a.norm_mix_g + col); const f32x4 sc = *(const f32x4*)(md + DM + col); av[j] = g * (sc + 1.f); sh[j] = *(const f32x4*)(md + col); }
        f32x4 v[4], vn[4];
        { const GAS f32x4* xr = (const GAS f32x4*)(src + (size_t)gw * DM) + lane;
#pragma unroll
          for (int j = 0; j < 4; ++j) v[j] = xr[64 * j]; }
        for (int m = gw; m < nrows; m += NGW) {
            const int mn = m + NGW;
            if (mn < nrows) { const GAS f32x4* xr = (const GAS f32x4*)(src + (size_t)mn * DM) + lane;
#pragma unroll
                for (int j = 0; j < 4; ++j) vn[j] = xr[64 * j]; }
            float s = 0.f;
#pragma unroll
            for (int j = 0; j < 4; ++j) s += (v[j].x * v[j].x + v[j].y * v[j].y) + (v[j].z * v[j].z + v[j].w * v[j].w);
            const float rinv = 1.f / sqrtf(wave_sum(s) * (1.f / DM) + EPS);
            GAS unsigned long long* o8 = (GAS unsigned long long*)(dst + (size_t)m * DM) + lane;
#pragma unroll
            for (int j = 0; j < 4; ++j) { const f32x4 y = v[j] * rinv * av[j] + sh[j]; o8[64 * j] = (unsigned long long)pk2(y.x, y.y) | ((unsigned long long)pk2(y.z, y.w) << 32); }
#pragma unroll
            for (int j = 0; j < 4; ++j) v[j] = vn[j];
        }
    }
}

struct P1Prob {
    static constexpr int K = DM; static constexpr bool PERM = false;
    const bf16* XN; const bf16* WinT; bf16 *Q, *Kb, *Vb; float* FT; const float *qg, *kg; pg8::StaticOrder so;
    __device__ __forceinline__ bool next(int i, pg8::Unit& u) const { return so.next(i, u); }
    __device__ __forceinline__ const char* aptr(const pg8::Unit& u) const { return u.pn == 0 ? (const char*)WinT : (const char*)(XN + (size_t)u.pm * 256 * DM); }
    __device__ __forceinline__ const char* bptr(const pg8::Unit& u) const { return u.pn == 0 ? (const char*)(XN + (size_t)u.pm * 256 * DM) : (const char*)(WinT + (size_t)u.pn * 256 * DM); }
    __device__ __forceinline__ void epi(const pg8::f32x4 (&acc)[2][2][4][2], const pg8::Unit& u, int wr, int wc, int fr, int fq) const {
        if (u.pn == 0) {
            if (u.pm >= NTOK / 256) return;
#pragma unroll
            for (int ai = 0; ai < 2; ++ai)
#pragma unroll
                for (int m = 0; m < 4; ++m) { float* rowp = FT + (size_t)(ai * 128 + wr * 64 + m * 16 + fr) * NTOK + u.pm * 256 + wc * 32 + 4 * fq;
#pragma unroll
                    for (int bj = 0; bj < 2; ++bj)
#pragma unroll
                        for (int n = 0; n < 2; ++n) *(pg8::f32x4*)(rowp + bj * 128 + n * 16) = acc[ai][bj][m][n]; }
            return;
        }
        const bool isq = u.pn <= 3, isv = u.pn == 5, lat = u.pm < NTOK / 256;
        if (isq && !lat) return;
        if (isv) {
#pragma unroll
            for (int ai = 0; ai < 2; ++ai)
#pragma unroll
                for (int m = 0; m < 4; ++m) { const int t = u.pm * 256 + ai * 128 + wr * 64 + m * 16 + fr; bf16* rowp = Vb + (size_t)t * 256 + wc * 64 + 4 * fq;
#pragma unroll
                    for (int bj = 0; bj < 2; ++bj)
#pragma unroll
                        for (int n = 0; n < 2; ++n) { const pg8::f32x4 v = acc[ai][bj][m][n]; *(v2u*)(rowp + 32 * bj + 16 * n) = (v2u){pk2(v[0], v[1]), pk2(v[2], v[3])}; } }
            return;
        }
        const float* gw = isq ? qg : kg;
        pg8::f32x4 gv[2][2];
#pragma unroll
        for (int bj = 0; bj < 2; ++bj)
#pragma unroll
            for (int n = 0; n < 2; ++n) gv[bj][n] = *(const pg8::f32x4*)(gw + 32 * bj + 16 * n + 4 * fq);
        float frq[4];
#pragma unroll
        for (int e = 0; e < 4; ++e) frq[e] = exp2f(-(float)(4 * fq + e) * (13.287712379549449f / 16.f)) * 0.15915494309189535f;
        const float qs = isq ? attn_body::C2 : 1.f;
        bf16* base = isq ? Q + (size_t)((u.pn - 1) * 4 + wc) * 64 : Kb + (size_t)wc * 64; const int pitch = isq ? 768 : 256;
#pragma unroll
        for (int ai = 0; ai < 2; ++ai) {
            float rowpos = (float)(u.pm * 4 + ai * 2 + wr); asm volatile("" : "+v"(rowpos));
            float cr[4], sr[4];
#pragma unroll
            for (int e = 0; e < 4; ++e) { const float rev = rowpos * frq[e], f_ = rev - floorf(rev); cr[e] = __builtin_amdgcn_cosf(f_); sr[e] = __builtin_amdgcn_sinf(f_); }
#pragma unroll
            for (int m = 0; m < 4; ++m) {
                float colpos = (float)(m * 16 + fr); asm volatile("" : "+v"(colpos));
                const int t = u.pm * 256 + ai * 128 + wr * 64 + m * 16 + fr;
                float ss = 0.f;
#pragma unroll
                for (int bj = 0; bj < 2; ++bj)
#pragma unroll
                    for (int n = 0; n < 2; ++n) { const pg8::f32x4 v = acc[ai][bj][m][n]; ss += (v[0] * v[0] + v[1] * v[1]) + (v[2] * v[2] + v[3] * v[3]); }
                ss += __shfl_xor(ss, 16); ss += __shfl_xor(ss, 32);
                const float rinv = qs / sqrtf(ss * (1.f / 64.f) + EPS);
                pg8::f32x4 y[2][2];
#pragma unroll
                for (int bj = 0; bj < 2; ++bj)
#pragma unroll
                    for (int n = 0; n < 2; ++n) y[bj][n] = acc[ai][bj][m][n] * rinv * gv[bj][n];
                if (lat) {
#pragma unroll
                    for (int e = 0; e < 4; ++e) {
                        { const float x1 = y[0][0][e], x2 = y[0][1][e]; y[0][0][e] = x1 * cr[e] - x2 * sr[e]; y[0][1][e] = x1 * sr[e] + x2 * cr[e]; }
                        { const float rev = colpos * frq[e], f_ = rev - floorf(rev); const float cc = __builtin_amdgcn_cosf(f_), sc = __builtin_amdgcn_sinf(f_);
                          const float x1 = y[1][0][e], x2 = y[1][1][e]; y[1][0][e] = x1 * cc - x2 * sc; y[1][1][e] = x1 * sc + x2 * cc; }
                    }
                }
                bf16* rowp = base + (size_t)t * pitch + 4 * fq;
#pragma unroll
                for (int bj = 0; bj < 2; ++bj)
#pragma unroll
                    for (int n = 0; n < 2; ++n) { const pg8::f32x4 v = y[bj][n]; *(v2u*)(rowp + 32 * bj + 16 * n) = (v2u){pk2(v[0], v[1]), pk2(v[2], v[3])}; }
                asm volatile("" ::: "memory");
            }
        }
    }
};

__device__ __forceinline__ unsigned rev4_12(unsigned k) { unsigned r = __brev(k) >> 20; return ((r & 0xAAAu) >> 1) | ((r & 0x555u) << 1); }
__device__ __forceinline__ void fft_block(const Args& a, LAS unsigned char* lds, int item, int wave) {
    const int tid = wave * 64 + fresh_lane();
    const int mm = item & 31, par = (item >> 5) & 1, g = item >> 6;
    const float* FT = (const float*)(a.ws + WS_FT); bf16* MIX = (bf16*)(a.ws + WS_MIX);
    LAS f32x2* X = (LAS f32x2*)lds;
    const float* re = FT + (size_t)(64 * g + mm) * NTOK; const float* im = FT + (size_t)(64 * g + 32 + mm) * NTOK;
#pragma unroll 1
    for (int i = 0; i < 2; ++i) {
        const int j0 = 4 * (tid + NTHR * i);
        f32x4 r4[4], i4[4];
#pragma unroll
        for (int q = 0; q < 4; ++q) { r4[q] = *(const f32x4*)(re + j0 + 4096 * q); i4[q] = *(const f32x4*)(im + j0 + 4096 * q); }
#pragma unroll
        for (int e = 0; e < 4; ++e) {
            const int j = j0 + e;
            const f32x2 a0 = {r4[0][e], i4[0][e]}, a1 = {r4[1][e], i4[1][e]}, a2 = {r4[2][e], i4[2][e]}, a3 = {r4[3][e], i4[3][e]};
            f32x2 ya, yb; float fa, fb;
            if (par == 0) { const f32x2 s02 = a0 + a2, s13 = a1 + a3; ya = s02 + s13; yb = s02 - s13; fa = 0.f; fb = (float)(2 * j) * (1.f / 16384.f); }
            else { const f32x2 d02 = a0 - a2, d13 = a1 - a3; ya = (f32x2){d02.x + d13.y, d02.y - d13.x}; yb = (f32x2){d02.x - d13.y, d02.y + d13.x}; fa = (float)j * (1.f / 16384.f); fb = (float)(3 * j) * (1.f / 16384.f); }
            const float ca = __builtin_amdgcn_cosf(fa), sa = __builtin_amdgcn_sinf(fa), cb = __builtin_amdgcn_cosf(fb), sb = __builtin_amdgcn_sinf(fb);
            X[j] = (f32x2){ya.x * ca + ya.y * sa, ya.y * ca - ya.x * sa};
            X[4096 + j] = (f32x2){yb.x * cb + yb.y * sb, yb.y * cb - yb.x * sb};
        }
    }
    __syncthreads();
#pragma unroll 1
    for (int s = 0; s < 6; ++s) {
        const int lq = 10 - 2 * s;
        const int Lq = 1 << lq;
        const float invL = 1.f / (float)(4 << lq);
#pragma unroll 2
        for (int i = 0; i < 4; ++i) {
            const int b = tid + NTHR * i, j = b & (Lq - 1), base = ((b >> lq) << (lq + 2)) + j;
            const f32x2 a0 = X[base], a1 = X[base + Lq], a2 = X[base + 2 * Lq], a3 = X[base + 3 * Lq];
            const f32x2 s02 = a0 + a2, d02 = a0 - a2, s13 = a1 + a3, d13 = a1 - a3;
            const f32x2 y0 = s02 + s13, y2 = s02 - s13;
            const f32x2 y1 = (f32x2){d02.x + d13.y, d02.y - d13.x};
            const f32x2 y3 = (f32x2){d02.x - d13.y, d02.y + d13.x};
            const float f1 = (float)j * invL;
            const float c1 = __builtin_amdgcn_cosf(f1), s1 = __builtin_amdgcn_sinf(f1);
            const float c2 = __builtin_amdgcn_cosf(2.f * f1), s2 = __builtin_amdgcn_sinf(2.f * f1);
            const float c3 = __builtin_amdgcn_cosf(3.f * f1), s3 = __builtin_amdgcn_sinf(3.f * f1);
            X[base] = y0;
            X[base + Lq] = (f32x2){y1.x * c1 + y1.y * s1, y1.y * c1 - y1.x * s1};
            X[base + 2 * Lq] = (f32x2){y2.x * c2 + y2.y * s2, y2.y * c2 - y2.x * s2};
            X[base + 3 * Lq] = (f32x2){y3.x * c3 + y3.y * s3, y3.y * c3 - y3.x * s3};
        }
        __syncthreads();
    }
    const int col = 64 * g + 2 * mm;
#pragma unroll 1
    for (int i = 0; i < 16; ++i) {
        const int k = 2 * (tid + NTHR * i) + par, kn = (NTOK - k) & (NTOK - 1);
        const f32x2 wk = X[(((k & 3) - par) >> 1) * 4096 + rev4_12((unsigned)(k >> 2))], wn = X[(((kn & 3) - par) >> 1) * 4096 + rev4_12((unsigned)(kn >> 2))];
        float o0, o1;
        if (mm == 0) { o0 = 0.5f * (wk.x + wn.x); o1 = 0.5f * (wk.y + wn.y); }
        else { o0 = wn.x; o1 = wk.x; }
        *(unsigned*)(MIX + (size_t)k * DM + col) = pk2(o0, o1);
    }
    __syncthreads();
}

struct P3Prob {
    static constexpr int K = DM; static constexpr bool PERM = false;
    const bf16* MIX; const bf16* WoT; const float* x; const float* g1; float* X1; pg8::StaticOrder so;
    __device__ __forceinline__ bool next(int i, pg8::Unit& u) const { return so.next(i, u); }
    __device__ __forceinline__ const char* aptr(const pg8::Unit& u) const { return (const char*)(MIX + (size_t)u.pm * 256 * DM); }
    __device__ __forceinline__ const char* bptr(const pg8::Unit& u) const { return (const char*)(WoT + (size_t)u.pn * 256 * DM); }
    __device__ __forceinline__ void epi(const pg8::f32x4 (&acc)[2][2][4][2], const pg8::Unit& u, int wr, int wc, int fr, int fq) const {
        const int col0 = u.pn * 256 + wc * 32 + 4 * fq;
        pg8::f32x4 gv[2][2];
#pragma unroll
        for (int bj = 0; bj < 2; ++bj)
#pragma unroll
            for (int n = 0; n < 2; ++n) gv[bj][n] = *(const pg8::f32x4*)(g1 + col0 + bj * 128 + n * 16);
#pragma unroll
        for (int ai = 0; ai < 2; ++ai)
#pragma unroll
            for (int m = 0; m < 4; ++m) { const size_t off = (size_t)(u.pm * 256 + ai * 128 + wr * 64 + m * 16 + fr) * DM + col0;
#pragma unroll
                for (int bj = 0; bj < 2; ++bj)
#pragma unroll
                    for (int n = 0; n < 2; ++n) { const pg8::f32x4 bs = *(const pg8::f32x4*)(x + off + bj * 128 + n * 16); *(pg8::f32x4*)(X1 + off + bj * 128 + n * 16) = bs + gv[bj][n] * acc[ai][bj][m][n]; }
                if (m & 1) asm volatile("" ::: "memory"); }
    }
};

__device__ __forceinline__ void p3b_router(const Args& a, LAS unsigned char* lds, int vcu, int G, int wave) {
    const int lane = fresh_lane(), tid = wave * 64 + lane;
    unsigned char* ws = a.ws; const float* MOD = (const float*)(ws + WS_MOD); const float* X1 = (const float*)(ws + WS_X1); bf16* H2 = (bf16*)(ws + WS_H2); float* AFF = (float*)(ws + WS_AFF);
    LAS float* wrt = (LAS float*)lds;
    for (int i = tid; i < 16 * 1024; i += NTHR) { const int col = i >> 4, e = i & 15; wrt[e * 1024 + col] = a.w_router[i]; }
    __syncthreads();
    f32x4 av[4], sh[4];
#pragma unroll
    for (int j = 0; j < 4; ++j) { const int col = 4 * lane + 256 * j; const f32x4 g = *(const f32x4*)(a.norm_ffn_g + col); const f32x4 sc = *(const f32x4*)(MOD + 4 * DM + col); av[j] = g * (sc + 1.f); sh[j] = *(const f32x4*)(MOD + 3 * DM + col); }
    const int gw = vcu * NWAVES + wave, NGW = G * NWAVES;
    f32x4 v[4], vn[4];
    if (gw < NTOK) { const GAS f32x4* xr = (const GAS f32x4*)(X1 + (size_t)gw * DM) + lane;
#pragma unroll
        for (int j = 0; j < 4; ++j) v[j] = xr[64 * j]; }
    for (int m = gw; m < NTOK; m += NGW) {
        const int mn = m + NGW;
        if (mn < NTOK) { const GAS f32x4* xr = (const GAS f32x4*)(X1 + (size_t)mn * DM) + lane;
#pragma unroll
            for (int j = 0; j < 4; ++j) vn[j] = xr[64 * j]; }
        float s = 0.f;
#pragma unroll
        for (int j = 0; j < 4; ++j) s += (v[j].x * v[j].x + v[j].y * v[j].y) + (v[j].z * v[j].z + v[j].w * v[j].w);
        const float rinv = 1.f / sqrtf(wave_sum(s) * (1.f / DM) + EPS);
        GAS unsigned long long* o8 = (GAS unsigned long long*)(H2 + (size_t)m * DM) + lane;
#pragma unroll
        for (int j = 0; j < 4; ++j) { v[j] = v[j] * rinv * av[j] + sh[j]; o8[64 * j] = (unsigned long long)pk2(v[j].x, v[j].y) | ((unsigned long long)pk2(v[j].z, v[j].w) << 32); }
        float lg[16];
#pragma unroll
        for (int e0 = 0; e0 < 16; e0 += 4) {
#pragma unroll
            for (int e = e0; e < e0 + 4; ++e) { float p = 0.f;
#pragma unroll
                for (int j = 0; j < 4; ++j) { const f32x4 w = *(const LAS f32x4*)(wrt + e * 1024 + 4 * lane + 256 * j); p += (v[j].x * w.x + v[j].y * w.y) + (v[j].z * w.z + v[j].w * w.w); }
                lg[e] = p; }
            asm volatile("" ::: "memory"); }
        float r8[8], r4[4], r2[2], r1;
        { const bool up = (lane & 32) != 0;
#pragma unroll
          for (int e = 0; e < 8; ++e) { const float snd = up ? lg[e] : lg[e + 8], kp = up ? lg[e + 8] : lg[e]; r8[e] = kp + __shfl_xor(snd, 32); } }
        { const bool up = (lane & 16) != 0;
#pragma unroll
          for (int e = 0; e < 4; ++e) { const float snd = up ? r8[e] : r8[e + 4], kp = up ? r8[e + 4] : r8[e]; r4[e] = kp + __shfl_xor(snd, 16); } }
        { const bool up = (lane & 8) != 0;
#pragma unroll
          for (int e = 0; e < 2; ++e) { const float snd = up ? r4[e] : r4[e + 2], kp = up ? r4[e + 2] : r4[e]; r2[e] = kp + __shfl_xor(snd, 8); } }
        { const bool up = (lane & 4) != 0; const float snd = up ? r2[0] : r2[1], kp = up ? r2[1] : r2[0]; r1 = kp + __shfl_xor(snd, 4); }
        r1 += __shfl_xor(r1, 2); r1 += __shfl_xor(r1, 1);
        float mx = r1;
#pragma unroll
        for (int o = 4; o < 64; o <<= 1) mx = fmaxf(mx, __shfl_xor(mx, o));
        const float ex = __expf(r1 - mx); float den = ex;
#pragma unroll
        for (int o = 4; o < 64; o <<= 1) den += __shfl_xor(den, o);
        if ((lane & 3) == 0) AFF[(size_t)(lane >> 2) * NTOK + m] = ex / den;
#pragma unroll
        for (int j = 0; j < 4; ++j) v[j] = vn[j];
    }
}

__device__ __forceinline__ void p4_topk(const Args& a, LAS unsigned char* lds, int e, int wave) {
    const int lane = fresh_lane(), tid = wave * 64 + lane;
    unsigned char* ws = a.ws; const unsigned* AFF = (const unsigned*)(ws + WS_AFF) + (size_t)e * NTOK;
    int* IDX = (int*)(ws + WS_IDX) + e * CAP; float* GATE = (float*)(ws + WS_GATE) + e * CAP; int* TOKSLOT = (int*)(ws + WS_TOKSLOT);
    LAS unsigned* wcnt = (LAS unsigned*)lds;
    LAS unsigned* cg = wcnt + 16;
    LAS unsigned* ce = cg + 256;
    unsigned key[32];
#pragma unroll
    for (int i = 0; i < 32; ++i) key[i] = AFF[i * NTHR + tid];
    unsigned T = 0u;
#pragma unroll 1
    for (int bit = 30; bit >= 0; --bit) {
        const unsigned cand = T | (1u << bit);
        unsigned c = 0u;
#pragma unroll
        for (int i = 0; i < 32; ++i) c += (unsigned)__popcll(__ballot(key[i] >= cand));
        LAS unsigned* wb = wcnt + 1024 + (bit & 1) * 8;
        if (lane == 0) wb[wave] = c;
        __syncthreads();
        unsigned tot = 0u;
#pragma unroll
        for (int w = 0; w < 8; ++w) tot += wb[w];
        if (tot >= (unsigned)CAP) T = cand;
    }
    __syncthreads();
    unsigned long long below = (1ull << lane) - 1ull;
    unsigned rg[32], rq[32];
#pragma unroll
    for (int i = 0; i < 32; ++i) {
        const unsigned long long bg = __ballot(key[i] > T), bq = __ballot(key[i] == T);
        rg[i] = (unsigned)__popcll(bg & below); rq[i] = (unsigned)__popcll(bq & below);
        if (lane == 0) { cg[i * 8 + wave] = (unsigned)__popcll(bg); ce[i * 8 + wave] = (unsigned)__popcll(bq); }
    }
    __syncthreads();
    if (wave == 0) {
        unsigned g4[4], q4[4], sg = 0u, sq = 0u;
#pragma unroll
        for (int k = 0; k < 4; ++k) { g4[k] = cg[4 * lane + k]; q4[k] = ce[4 * lane + k]; sg += g4[k]; sq += q4[k]; }
        unsigned pg = sg, pq = sq;
#pragma unroll
        for (int o = 1; o < 64; o <<= 1) { const unsigned tg = __shfl_up(pg, o), tq = __shfl_up(pq, o); if (lane >= o) { pg += tg; pq += tq; } }
        pg -= sg; pq -= sq;
#pragma unroll
        for (int k = 0; k < 4; ++k) { cg[4 * lane + k] = pg; ce[4 * lane + k] = pq; pg += g4[k]; pq += q4[k]; }
        if (lane == 63) { wcnt[8] = pg; }
    }
    __syncthreads();
    const unsigned ngt = wcnt[8], need = (unsigned)CAP - ngt;
#pragma unroll
    for (int i = 0; i < 32; ++i) {
        const int tok = i * NTHR + tid;
        const unsigned gb = cg[i * 8 + wave] + rg[i], qb = ce[i * 8 + wave] + rq[i];
        const bool sel = key[i] > T || (key[i] == T && qb < need);
        const unsigned slot = gb + (qb < need ? qb : need);
        if (sel) { IDX[slot] = tok; GATE[slot] = __uint_as_float(key[i]); }
        TOKSLOT[tok * 16 + e] = sel ? (int)slot : -1;
    }
}

struct P5Prob {
    static constexpr int K = DM; static constexpr bool PERM = true;
    const bf16* H2; const bf16* WguT; bf16* HID; pg8::StaticOrder so;
    __device__ __forceinline__ bool next(int i, pg8::Unit& u) const { return so.next(i, u); }
    __device__ __forceinline__ const char* aptr(const pg8::Unit&) const { return (const char*)H2; }
    __device__ __forceinline__ const char* bptr(const pg8::Unit& u) const { return (const char*)(WguT + ((size_t)(u.pm >> 3) * 4096 + (size_t)u.pn * 256) * DM); }
    __device__ __forceinline__ void epi(const pg8::f32x4 (&acc)[2][2][4][2], const pg8::Unit& u, int wr, int wc, int fr, int fq) const {
#pragma unroll
        for (int ai = 0; ai < 2; ++ai)
#pragma unroll
            for (int m = 0; m < 4; ++m) { bf16* rowp = HID + (size_t)(u.pm * 256 + ai * 128 + wr * 64 + m * 16 + fr) * DE + u.pn * 128 + wc * 32 + 8 * fq;
                float h[8];
#pragma unroll
                for (int n = 0; n < 2; ++n)
#pragma unroll
                    for (int e = 0; e < 4; ++e) { const float gt = acc[ai][0][m][n][e], up = acc[ai][1][m][n][e]; h[4 * n + e] = gt * __builtin_amdgcn_rcpf(1.f + __builtin_amdgcn_exp2f(-1.4426950408889634f * gt)) * up; }
                *(v4u*)rowp = (v4u){pk2(h[0], h[1]), pk2(h[2], h[3]), pk2(h[4], h[5]), pk2(h[6], h[7])}; }
    }
};
struct P6Prob {
    static constexpr int K = DE; static constexpr bool PERM = true;
    const bf16* HID; const bf16* WdT; const float* GATE; bf16* YE; pg8::StaticOrder so;
    __device__ __forceinline__ bool next(int i, pg8::Unit& u) const { return so.next(i, u); }
    __device__ __forceinline__ const char* aptr(const pg8::Unit& u) const { return (const char*)(HID + (size_t)u.pm * 256 * DE); }
    __device__ __forceinline__ const char* bptr(const pg8::Unit& u) const { return (const char*)(WdT + ((size_t)(u.pm >> 3) * DM + (size_t)u.pn * 256) * DE); }
    __device__ __forceinline__ void epi(const pg8::f32x4 (&acc)[2][2][4][2], const pg8::Unit& u, int wr, int wc, int fr, int fq) const {
#pragma unroll
        for (int ai = 0; ai < 2; ++ai)
#pragma unroll
            for (int m = 0; m < 4; ++m) { const int row = u.pm * 256 + ai * 128 + wr * 64 + m * 16 + fr; const float gt = GATE[row]; bf16* rowp = YE + (size_t)row * DM + u.pn * 256 + wc * 32 + 8 * fq;
#pragma unroll
                for (int bj = 0; bj < 2; ++bj) { const pg8::f32x4 v0 = acc[ai][bj][m][0] * gt, v1 = acc[ai][bj][m][1] * gt;
                    *(v4u*)(rowp + bj * 128) = (v4u){pk2(v0[0], v0[1]), pk2(v0[2], v0[3]), pk2(v1[0], v1[1]), pk2(v1[2], v1[3])}; } }
    }
};

__device__ __forceinline__ void p7_final(const Args& a, int vcu, int G, int wave, unsigned poison) {
    const int lane = fresh_lane();
    unsigned char* ws = a.ws; const float* MOD = (const float*)(ws + WS_MOD); const bf16* YE = (const bf16*)(ws + WS_YE); const int* TOKSLOT = (const int*)(ws + WS_TOKSLOT);
    const float* src = (STEP >= 2) ? (const float*)(ws + WS_X1) : a.x;
    f32x4 g2[4], fg[4];
#pragma unroll
    for (int j = 0; j < 4; ++j) { const int col = 4 * lane + 256 * j; g2[j] = *(const f32x4*)(MOD + 5 * DM + col); fg[j] = *(const f32x4*)(a.final_norm_g + col); }
    const int gw = vcu * NWAVES + wave, NGW = G * NWAVES;
    for (int m = gw; m < NTOK; m += NGW) {
        const GAS f32x4* xr = (const GAS f32x4*)(src + (size_t)m * DM) + lane;
        f32x4 v[4];
#pragma unroll
        for (int j = 0; j < 4; ++j) v[j] = xr[64 * j];
        if (STEP >= 4) {
            const int myslot = lane < 16 ? TOKSLOT[m * 16 + lane] : -1;
            f32x4 s[4];
#pragma unroll
            for (int j = 0; j < 4; ++j) s[j] = (f32x4){0.f, 0.f, 0.f, 0.f};
#pragma unroll 1
            for (int e = 0; e < 16; ++e) {
                const int sl = __builtin_amdgcn_readlane(myslot, e);
                if (sl >= 0) {
                    const GAS v2u* yr = (const GAS v2u*)(YE + ((size_t)e * CAP + sl) * DM) + lane;
#pragma unroll
                    for (int j = 0; j < 4; ++j) { const v2u w = yr[64 * j]; s[j].x += __uint_as_float(w.x << 16); s[j].y += __uint_as_float(w.x & 0xffff0000u); s[j].z += __uint_as_float(w.y << 16); s[j].w += __uint_as_float(w.y & 0xffff0000u); }
                }
            }
#pragma unroll
            for (int j = 0; j < 4; ++j) v[j] += g2[j] * s[j];
        }
        float ss = 0.f;
#pragma unroll
        for (int j = 0; j < 4; ++j) ss += (v[j].x * v[j].x + v[j].y * v[j].y) + (v[j].z * v[j].z + v[j].w * v[j].w);
        const float rinv = 1.f / sqrtf(wave_sum(ss) * (1.f / DM) + EPS);
        GAS f32x4* o = (GAS f32x4*)(a.out + (size_t)m * DM) + lane;
        const float q = __builtin_nanf("");
#pragma unroll
        for (int j = 0; j < 4; ++j) { f32x4 y = v[j] * rinv * fg[j]; if (poison) y = (f32x4){q, q, q, q}; o[64 * j] = y; }
    }
}


#if PROBE
__device__ __forceinline__ void dsincos(double x, double& sn, double& cs) {
    const double TWO_PI = 6.283185307179586476925286766559; x -= TWO_PI * rint(x / TWO_PI);
    const double x2 = x * x; double ts = x, tc = 1.0; sn = x; cs = 1.0;
#pragma unroll 1
    for (int k = 1; k <= 14; ++k) { tc *= -x2 / (double)((2 * k - 1) * (2 * k)); ts *= -x2 / (double)((2 * k) * (2 * k + 1)); cs += tc; sn += ts; }
}
__device__ __forceinline__ float block_sum(float v, LAS float* red, int wave, int lane) {
    v = wave_sum(v); __syncthreads(); if (lane == 0) red[wave] = v; __syncthreads(); float s = 0.f;
#pragma unroll
    for (int w = 0; w < 8; ++w) s += red[w];
    return s;
}
__device__ __forceinline__ float block_max(float v, LAS float* red, int wave, int lane) {
#pragma unroll
    for (int o = 1; o < 64; o <<= 1) v = fmaxf(v, __shfl_xor(v, o));
    __syncthreads(); if (lane == 0) red[wave] = v; __syncthreads(); float s = red[0];
#pragma unroll
    for (int w = 1; w < 8; ++w) s = fmaxf(s, red[w]);
    return s;
}
__device__ __forceinline__ void probe_qkv(const Args& a, LAS unsigned char* lds, int vcu, int wave) {
    const int lane = fresh_lane(), tid = wave * 64 + lane; unsigned char* ws = a.ws;
    const bf16* XN = (const bf16*)(ws + WS_XN); const bf16* Qb = (const bf16*)(ws + WS_Q); const bf16* Kb = (const bf16*)(ws + WS_K); const bf16* Vb = (const bf16*)(ws + WS_V);
    gu32* ctl = (gu32*)(ws + WS_CTL);
    LAS float* red = (LAS float*)lds; LAS float* raw = red + 16;
    for (int kind = 0; kind < 3; ++kind) {
        const int nrows = kind == 0 ? NTOK : NROWS, nh = kind == 0 ? NHQ : NHKV;
        const int t = (kind == 1 && (vcu & 7) == 3) ? NTOK + (vcu * 37) % NCTX : (vcu * 977 + 131 * kind + 5) % (kind == 0 ? NTOK : NTOK);
        const int h = (vcu * 5 + kind) % nh;
        const int wcol0 = 256 + (kind == 0 ? 0 : (kind == 1 ? 768 : 1024)) + 64 * h;
        { const int d = tid & 63, part = tid >> 6; float sacc = 0.f;
          for (int k = part * 128; k < part * 128 + 128; ++k) sacc += bf2f(XN[(size_t)t * DM + k]) * a.w_in[(size_t)k * INW + wcol0 + d];
          LAS float* part_s = raw + 64; part_s[part * 64 + d] = sacc; __syncthreads();
          if (tid < 64) { float s2 = 0.f; for (int pp = 0; pp < 8; ++pp) s2 += part_s[pp * 64 + tid]; raw[tid] = s2; }
          __syncthreads(); }
        float ref = 0.f, got = 0.f;
        if (tid < 64) {
            const int d = tid; float v = raw[d];
            if (kind < 2) {
                float ss = 0.f; for (int j = 0; j < 64; ++j) ss += raw[j] * raw[j];
                const float* gw = kind == 0 ? a.q_norm_g : a.k_norm_g;
                const float rinv = 1.f / sqrtf(ss / 64.f + EPS);
                if (t < NTOK) {
                    const int half = d >> 5, dd = d & 31, i = dd & 15; const int pos = half == 0 ? (t >> 6) : (t & 63);
                    const double freq = exp2(-(double)i * (13.287712379549449 / 16.0)); double sn, cs; dsincos((double)pos * freq, sn, cs);
                    const float x1 = raw[32 * half + i] * rinv * gw[32 * half + i], x2 = raw[32 * half + 16 + i] * rinv * gw[32 * half + 16 + i];
                    v = dd < 16 ? (float)(x1 * cs - x2 * sn) : (float)(x1 * sn + x2 * cs);
                } else v = v * rinv * gw[d];
                if (kind == 0) v *= attn_body::C2;
            }
            ref = v;
            got = kind == 0 ? bf2f(Qb[(size_t)t * 768 + 64 * h + d]) : (kind == 1 ? bf2f(Kb[(size_t)t * 256 + 64 * h + d]) : bf2f(Vb[(size_t)t * 256 + 64 * h + d]));
        }
        const float mx = block_max(fabsf(ref), red, wave, lane);
        const float err = block_max(fabsf(ref - got), red, wave, lane);
        if (tid == 0 && !(err <= 0.03f * mx + 1e-6f)) __hip_atomic_fetch_or(ctl + CW_FLAG, 1u << kind, RLX_AGENT);
        __syncthreads();
    }
}
__device__ __forceinline__ void probe_attn(const Args& a, LAS unsigned char* lds, int vcu, int wave) {
    const int lane = fresh_lane(), tid = wave * 64 + lane; unsigned char* ws = a.ws;
    const bf16* Qb = (const bf16*)(ws + WS_Q); const bf16* Kb = (const bf16*)(ws + WS_K); const bf16* Vb = (const bf16*)(ws + WS_V); const bf16* MIX = (const bf16*)(ws + WS_MIX);
    gu32* ctl = (gu32*)(ws + WS_CTL);
    LAS float* red = (LAS float*)lds; LAS float* ored = red + 16;
    const int t = (vcu * 613 + 29) % NTOK, h = (vcu * 7 + 3) % NHQ, kvh = h / 3;
    float q[64];
#pragma unroll
    for (int d = 0; d < 64; ++d) q[d] = bf2f(Qb[(size_t)t * 768 + 64 * h + d]);
    float sc[33]; float mx = -1e30f;
#pragma unroll
    for (int i = 0; i < 33; ++i) { const int key = i * NTHR + tid; float s = -1e30f;
        if (key < NKEYS) { s = 0.f; const bf16* kr = Kb + (size_t)key * 256 + 64 * kvh;
#pragma unroll
            for (int d = 0; d < 64; ++d) s += q[d] * bf2f(kr[d]); }
        sc[i] = s; mx = fmaxf(mx, s); }
    mx = block_max(mx, red, wave, lane);
    float den = 0.f; float o[64];
#pragma unroll
    for (int d = 0; d < 64; ++d) o[d] = 0.f;
#pragma unroll
    for (int i = 0; i < 33; ++i) { const int key = i * NTHR + tid;
        if (key < NKEYS) { const float pp = exp2f(sc[i] - mx); den += pp; const bf16* vr = Vb + (size_t)key * 256 + 64 * kvh;
#pragma unroll
            for (int d = 0; d < 64; ++d) o[d] += pp * bf2f(vr[d]); } }
    den = block_sum(den, red, wave, lane);
#pragma unroll
    for (int d = 0; d < 64; ++d) { const float w = wave_sum(o[d]); if (lane == 0) ored[wave * 64 + d] = w; }
    __syncthreads();
    float ref = 0.f, got = 0.f;
    if (tid < 64) { float s = 0.f; for (int w = 0; w < 8; ++w) s += ored[w * 64 + tid]; ref = s / den; got = bf2f(MIX[(size_t)t * DM + 256 + 64 * h + tid]); }
    const float m2 = block_max(fabsf(ref), red, wave, lane);
    const float err = block_max(fabsf(ref - got), red, wave, lane);
    if (tid == 0 && !(err <= 0.03f * m2 + 1e-7f)) __hip_atomic_fetch_or(ctl + CW_FLAG, 8u, RLX_AGENT);
    __syncthreads();
}
#endif

__global__ void __launch_bounds__(NTHR, 2) fwd_megakernel(Args args) {
    extern __shared__ __attribute__((aligned(16))) unsigned char lds_raw[];
    LAS unsigned char* lds = (LAS unsigned char*)lds_raw;
    volatile LAS unsigned* MISC = (volatile LAS unsigned*)(lds + MISC_OFF);
    const int wave = __builtin_amdgcn_readfirstlane(threadIdx.x >> 6);
    const int G = gridDim.x; const int bx = blockIdx.x; const int vcu = (G % 8 == 0) ? (bx % 8) * (G / 8) + bx / 8 : bx;
    unsigned char* ws = args.ws;
    gu32* ctl = (gu32*)(ws + WS_CTL);
    { const int l0 = fresh_lane(); if (wave < 2) ((LAS unsigned*)(lds + MISC_OFF))[wave * 64 + l0] = 0u;
      __syncthreads();
    }
    XcdBarrier bar = xcd_barrier_post((unsigned*)(ctl + CW_BAR), MISC + 8, wave == 0 && fresh_lane() == 0);
#define GRID_BAR() xcd_barrier(bar, wave)

    for (int rep = 0; rep < REP(0); ++rep) {
    if (STEP >= 2 && PH(0)) p0_prologue(args, lds, vcu, G, wave);
    GRID_BAR(); }
    for (int rep = 0; rep < REP(1); ++rep) {
    if (STEP >= 2 && PH(1)) p0b_modulate(args, vcu, G, wave);
    GRID_BAR(); }
    for (int rep = 0; rep < REP(2); ++rep) {
    if (STEP >= 2 && PH(2)) {
        P1Prob p; p.XN = (bf16*)(ws + WS_XN); p.WinT = (bf16*)(ws + WS_WIN); p.Q = (bf16*)(ws + WS_Q); p.Kb = (bf16*)(ws + WS_K); p.Vb = (bf16*)(ws + WS_V); p.FT = (float*)(ws + WS_FT);
        p.qg = args.q_norm_g; p.kg = args.k_norm_g; p.so.init(NROWS / 256, INW / 256, G, bx);
        pg8::gemm_phase<P1Prob, false, true, true>(lds, p, nullptr, wave);
        if (rep == 0 && MOE_S1 > 0) {
            const int nwg = (NROWS / 256) * (INW / 256), maxc = (nwg + G - 1) / G, c0 = nwg - (maxc - 1) * G;
            if (c0 >= G) moe_convert(args, (LAS float*)(lds + wave * 16640), MOE_B0, MOE_B1, bx * NWAVES + wave, G * NWAVES);
            else if (bx >= c0) moe_convert(args, (LAS float*)(lds + wave * 16640), MOE_B0, MOE_B1, (bx - c0) * NWAVES + wave, (G - c0) * NWAVES);
        }
    }
    GRID_BAR(); }
#if PROBE == 1
    probe_qkv(args, lds, vcu, wave);
#endif
    for (int rep = 0; rep < REP(3); ++rep) {
    if (STEP >= 2 && PH(3)) {
        for (int item = vcu; item < 256; item += G) fft_block(args, lds, item, wave);
        if (rep == 0 && MOE_S2 > 0) {
            if (G > 256) { if (vcu >= 256) moe_convert(args, (LAS float*)(lds + wave * 16640), MOE_B1, MOE_B2, (vcu - 256) * NWAVES + wave, (G - 256) * NWAVES); }
            else moe_convert(args, (LAS float*)(lds + wave * 16640), MOE_B1, MOE_B2, vcu * NWAVES + wave, G * NWAVES);
        }
    }
    if (rep + 1 < REP(3)) GRID_BAR(); }
    for (int rep = 0; rep < REP(4); ++rep) {
    if (STEP >= 3 && PH(4)) {
        const attn_body::bf16* Qb = (const attn_body::bf16*)(ws + WS_Q); const attn_body::bf16* Kb = (const attn_body::bf16*)(ws + WS_K); const attn_body::bf16* Vb = (const attn_body::bf16*)(ws + WS_V);
        attn_body::bf16* MIX = (attn_body::bf16*)(ws + WS_MIX);
        const int u0 = (G == 256) ? vcu * 3 : vcu, ustep = (G == 256) ? 1 : G, uend = (G == 256) ? vcu * 3 + 3 : 768;
#pragma unroll 1
        for (int u = u0; u < uend; u += ustep) {
            const int kvh = u / 192, w = u % 192, h = kvh * 3 + w / 64, qb = w % 64;
            attn_body::attn_unit<8>(h, kvh, qb, Qb, Kb, Vb, MIX, (char*)lds_raw, wave);
        }
    } else if (STEP == 2) {
        bf16* MIX = (bf16*)(ws + WS_MIX);
        const int gw = vcu * NWAVES + wave, NGW = G * NWAVES, lane = fresh_lane();
        for (int m = gw; m < NTOK; m += NGW) { GAS v4u* o = (GAS v4u*)(MIX + (size_t)m * DM + 256); o[lane] = (v4u){0u, 0u, 0u, 0u}; if (lane < 32) o[64 + lane] = (v4u){0u, 0u, 0u, 0u}; }
    }
    GRID_BAR(); }
#if PROBE == 2
    probe_attn(args, lds, vcu, wave);
#endif
    for (int rep = 0; rep < REP(5); ++rep) {
    if (STEP >= 2 && PH(5)) {
        P3Prob p; p.MIX = (bf16*)(ws + WS_MIX); p.WoT = (bf16*)(ws + WS_WOUT); p.x = args.x; p.g1 = (const float*)(ws + WS_MOD) + 2 * DM; p.X1 = (float*)(ws + WS_X1); p.so.init(NTOK / 256, DM / 256, G, bx);
        pg8::gemm_phase<P3Prob, false, true, true>(lds, p, nullptr, wave);
    }
    GRID_BAR(); }
    for (int rep = 0; rep < REP(6); ++rep) {
    if (STEP >= 4 && PH(6)) p3b_router(args, lds, vcu, G, wave);
    GRID_BAR(); }
    for (int rep = 0; rep < REP(7); ++rep) {
    if (STEP >= 4 && PH(7)) {
#pragma unroll 1
        for (int e = vcu; e < NE; e += G) p4_topk(args, lds, e, wave);
        if (rep == 0) {
            if (G > NE) { if (vcu >= NE) moe_convert(args, (LAS float*)(lds + wave * 16640), MOE_B2, MOE_ITEMS, (vcu - NE) * NWAVES + wave, (G - NE) * NWAVES); }
            else moe_convert(args, (LAS float*)(lds + wave * 16640), MOE_B2, MOE_ITEMS, vcu * NWAVES + wave, G * NWAVES);
        } }
    GRID_BAR(); }
    for (int rep = 0; rep < REP(8); ++rep) {
    if (STEP >= 4 && PH(8)) {
        P5Prob p; p.H2 = (bf16*)(ws + WS_H2); p.WguT = (bf16*)(ws + WS_WGU); p.HID = (bf16*)(ws + WS_HID); p.so.init(NE * CAP / 256, 2 * DE / 256, G, bx);
        LAS unsigned* rowtab = (LAS unsigned*)(lds + XTRA_OFF);
        const int* IDX = (const int*)(ws + WS_IDX);
        { const int tid = wave * 64 + fresh_lane(); pg8::Unit u; for (int i = 0; p.so.next(i, u) && i < 28; ++i) { if (tid < 256) rowtab[i * 256 + tid] = (unsigned)IDX[u.pm * 256 + tid]; } }
        __syncthreads();
        pg8::gemm_phase<P5Prob, true, true, true>(lds, p, rowtab, wave);
    }
    GRID_BAR(); }
    for (int rep = 0; rep < REP(9); ++rep) {
    if (STEP >= 4 && PH(9)) {
        P6Prob p; p.HID = (bf16*)(ws + WS_HID); p.WdT = (bf16*)(ws + WS_WD); p.GATE = (const float*)(ws + WS_GATE); p.YE = (bf16*)(ws + WS_YE); p.so.init(NE * CAP / 256, DM / 256, G, bx);
        pg8::gemm_phase<P6Prob, false, true, true>(lds, p, nullptr, wave);
    }
    GRID_BAR(); }
    {
        unsigned poison = (__hip_atomic_load(ctl + CW_BAR + XB_TMO, RLX_AGENT) != 0u) || (__hip_atomic_load(ctl + CW_FLAG, RLX_AGENT) != 0u);
        for (int rep = 0; rep < REP(10); ++rep) p7_final(args, vcu, G, wave, poison);
    }
}

extern "C" void kernel_launch(void* const* d_in, const int* in_sizes, int n_in, void* d_out, int out_size, void* d_ws, size_t ws_size, hipStream_t stream) {
    static int grid = 0;
    if (grid == 0) {
        if (n_in != 18 || in_sizes[0] != NTOK * DM || out_size != NTOK * DM || ws_size < WS_END) { fprintf(stderr, "kernel_launch: unexpected shapes (n_in %d, in0 %d, out %d, ws %zu)\n", n_in, n_in > 0 ? in_sizes[0] : -1, out_size, ws_size); grid = -1; return; }
        int dev = 0, cus = 0, per_cu = 0;
        if (hipGetDevice(&dev) != hipSuccess || hipDeviceGetAttribute(&cus, hipDeviceAttributeMultiprocessorCount, dev) != hipSuccess) { grid = -1; return; }
        if (hipFuncSetAttribute((const void*)fwd_megakernel, hipFuncAttributeMaxDynamicSharedMemorySize, LDS_BYTES) != hipSuccess) { fprintf(stderr, "kernel_launch: hipFuncSetAttribute failed\n"); grid = -1; return; }
        if (hipOccupancyMaxActiveBlocksPerMultiprocessor(&per_cu, (const void*)fwd_megakernel, NTHR, LDS_BYTES) != hipSuccess || per_cu < 1) { fprintf(stderr, "kernel_launch: occupancy query says %d blocks per CU\n", per_cu); (void)hipGetLastError(); grid = -1; return; }
        grid = cus;
    }
    if (grid < 0) return;
    (void)hipMemsetAsync((char*)d_ws + WS_CTL, 0, CTL_ZERO_BYTES, stream);
    Args a{};
    const float** f = (const float**)&a;
    for (int i = 0; i < 18; ++i) f[i] = (const float*)d_in[i];
    a.out = (float*)d_out; a.ws = (unsigned char*)d_ws;
    hipLaunchKernelGGL(fwd_megakernel, dim3(grid), dim3(NTHR), LDS_BYTES, stream, a);
}
```

```cpp
#include <hip/hip_runtime.h>
#include <hip/hip_bf16.h>
#include <cstdio>
#include <cstdint>
#include <cmath>

#ifndef STEP
#define STEP 4
#endif
#ifndef PROBE
#define PROBE 0
#endif
#ifndef PHMASK
#define PHMASK 0xFFFF
#endif
#define PH(k) ((PHMASK >> (k)) & 1)
#ifndef REPEAT
#define REPEAT 0
#endif
#define REP(k) (((REPEAT >> (k)) & 1) + 1)

constexpr int DM = 1024, NTOK = 16384, NCTX = 256, NROWS = NTOK + NCTX, INW = 1536;
constexpr int NHQ = 12, NHKV = 4, HD = 64, NE = 16, CAP = 2048, DE = 2048, NMOD = 6;
constexpr int NKEYS = NROWS;
constexpr float EPS = 1e-6f;

__device__ __forceinline__ int fresh_lane() { int l; asm volatile("v_mbcnt_lo_u32_b32 %0, -1, 0\n\tv_mbcnt_hi_u32_b32 %0, -1, %0" : "=v"(l)); return l; }

namespace pg8 {
#define PG8_LAS __attribute__((address_space(3)))
typedef unsigned short bf16_t;
typedef short bf16x8 __attribute__((ext_vector_type(8)));
typedef float f32x4 __attribute__((ext_vector_type(4)));
typedef unsigned u32x4 __attribute__((ext_vector_type(4)));
typedef unsigned u32x2 __attribute__((ext_vector_type(2)));
constexpr int BM = 256, BK = 64, HALF = 128, HTB = HALF * BK * 2, STAGE_BYTES = 8 * HTB, NXCD = 8, WGM = 8;

__host__ __device__ __forceinline__ int lds_byte(int r, int c) { const int st = (r >> 4) * 2 + (c >> 5), rr = r & 15, cc = c & 31, ob = rr * 64 + cc * 2; return st * 1024 + (ob ^ (((ob >> 9) & 1) << 5)); }
__host__ __device__ __forceinline__ void stage_rc(int b, int& R, int& C) { const int st = b / 1024, sb = b % 1024, swz = sb ^ (((sb >> 9) & 1) << 5); R = (st >> 1) * 16 + swz / 64; C = (st & 1) * 32 + (swz % 64) / 2; }
__host__ __device__ __forceinline__ int perm32(int rho) { const int n = rho >> 4, i = rho & 15; return 8 * (i >> 2) + 4 * n + (i & 3); }

struct Unit { int pm, pn; };

struct StaticOrder {
    int nM, nN, nwg, G, c;
    __host__ __device__ void init(int nM_, int nN_, int G_, int c_) { nM = nM_; nN = nN_; nwg = nM * nN; G = G_; c = c_; }
    __host__ __device__ bool next(int i, Unit& u) const {
        const long L = (long)i * G + c; if (L >= nwg) return false;
        int wgid = (int)L; { const int q = nwg / NXCD, r = nwg % NXCD, xcd = wgid % NXCD, off = wgid / NXCD; wgid = (xcd < r ? xcd * (q + 1) : r * (q + 1) + (xcd - r) * q) + off; }
        const int nig = WGM * nN, gid = wgid / nig, fm = gid * WGM, gsz = (nM - fm) < WGM ? (nM - fm) : WGM;
        u.pm = fm + ((wgid % nig) % gsz); u.pn = (wgid % nig) / gsz; return true;
    }
};

__device__ __forceinline__ unsigned cvt_pk_bf16(float lo, float hi) { unsigned r; asm volatile("v_cvt_pk_bf16_f32 %0, %1, %2" : "=v"(r) : "v"(lo), "v"(hi)); return r; }

template <class P, bool GATHER, bool ALIGN_EPI, bool SP2>
__device__ __forceinline__ void gemm_phase(PG8_LAS unsigned char* lds, const P& S, const PG8_LAS unsigned* rowtab, int wid) {
    const int lane = fresh_lane(), tid = wid * 64 + lane, wr = wid >> 2, wc = wid & 3, fr = lane & 15, fq = lane >> 4;
    constexpr int K = P::K, nt = K / BK;
    int R0, C0; stage_rc(tid * 16, R0, C0);
    unsigned voffB[2];
#pragma unroll
    for (int i = 0; i < 2; ++i) { const int R = R0 + 64 * i; const int Rb = P::PERM ? ((R & ~31) + perm32(R & 31)) : R; voffB[i] = (unsigned)(Rb * K + C0) * 2u; }
    constexpr size_t kstep = (size_t)(BK * 2);
    constexpr size_t hstep = (size_t)HALF * K * 2;
    const unsigned ldsw = (unsigned)wid * 1024u;
    const int aoff = lds_byte(wr * 64 + fr, fq * 8), boff = lds_byte(wc * 32 + fr, fq * 8);
#define PG8_SA(b, h) (((b) * 2 + (h)) * HTB)
#define PG8_SB(b, h) ((4 + (b) * 2 + (h)) * HTB)
#define PG8_STAGE(bufoff, gbase, voff) do { _Pragma("unroll") for (int _i = 0; _i < 2; ++_i) \
        __builtin_amdgcn_global_load_lds((const unsigned*)((const char*)(gbase) + (voff)[_i]), (PG8_LAS unsigned*)(lds + (bufoff) + ldsw + _i * 8192), 16, 0, 0); } while (0)
#define PG8_LDA(dst, b, h) do { _Pragma("unroll") for (int m = 0; m < 4; ++m) _Pragma("unroll") for (int k = 0; k < 2; ++k) dst[m][k] = *(const PG8_LAS bf16x8*)(lds + PG8_SA(b, h) + aoff + m * 2048 + k * 1024); } while (0)
#define PG8_LDB(dst, b, h) do { _Pragma("unroll") for (int n = 0; n < 2; ++n) _Pragma("unroll") for (int k = 0; k < 2; ++k) dst[n][k] = *(const PG8_LAS bf16x8*)(lds + PG8_SB(b, h) + boff + n * 2048 + k * 1024); } while (0)
#define PG8_MMA(ai, bj, At, Bt) do { __builtin_amdgcn_s_setprio(1); _Pragma("unroll") for (int m = 0; m < 4; ++m) _Pragma("unroll") for (int n = 0; n < 2; ++n) _Pragma("unroll") for (int k = 0; k < 2; ++k) \
        acc[ai][bj][m][n] = __builtin_amdgcn_mfma_f32_16x16x32_bf16(Bt[n][k], At[m][k], acc[ai][bj][m][n], 0, 0, 0); __builtin_amdgcn_s_setprio(0); } while (0)
#define PG8_WAIT_V(n) asm volatile("s_waitcnt vmcnt(" #n ")" ::: "memory")
#define PG8_WAIT_L(n) asm volatile("s_waitcnt lgkmcnt(" #n ")" ::: "memory")
#define PG8_BAR __builtin_amdgcn_s_barrier()
#define PG8_SCHED __builtin_amdgcn_sched_barrier(0)
#define PG8_AOFF(dst, u_, ui_) do { _Pragma("unroll") for (int _h = 0; _h < 2; ++_h) _Pragma("unroll") for (int _i = 0; _i < 2; ++_i) { \
        if constexpr (GATHER) dst[_h][_i] = (unsigned)(rowtab[(ui_) * 256 + _h * HALF + _i * 64 + R0] * (unsigned)K + (unsigned)C0) * 2u; \
        else dst[_h][_i] = (unsigned)((_h * HALF + _i * 64 + R0) * K + C0) * 2u; } } while (0)
    Unit cur, nxt; int ui = 0;
    if (!S.next(0, cur)) return;
    f32x4 acc[2][2][4][2];
#pragma unroll
    for (int a = 0; a < 2; ++a)
#pragma unroll
        for (int b = 0; b < 2; ++b)
#pragma unroll
            for (int m = 0; m < 4; ++m)
#pragma unroll
                for (int n = 0; n < 2; ++n) acc[a][b][m][n] = (f32x4){0.f, 0.f, 0.f, 0.f};
    bf16x8 At[4][2], B0[2][2], B1[2][2];
    unsigned vAc[2][2], vAn[2][2];
    PG8_AOFF(vAc, cur, 0);
    const char* cA = S.aptr(cur); const char* cB = S.bptr(cur);
    if constexpr (SP2) {
        PG8_STAGE(PG8_SB(0, 0), cB, voffB); PG8_STAGE(PG8_SB(0, 1), cB + hstep, voffB); PG8_STAGE(PG8_SA(0, 0), cA, vAc[0]); PG8_STAGE(PG8_SA(0, 1), cA, vAc[1]);
        if (wr == 1) PG8_BAR;
        PG8_WAIT_V(2); PG8_BAR;
        PG8_STAGE(PG8_SB(1, 0), cB + kstep, voffB); PG8_STAGE(PG8_SA(1, 0), cA + kstep, vAc[0]); PG8_STAGE(PG8_SB(1, 1), cB + hstep + kstep, voffB);
        PG8_WAIT_V(6); PG8_BAR;
    } else {
        PG8_STAGE(PG8_SB(0, 0), cB, voffB); PG8_STAGE(PG8_SA(0, 0), cA, vAc[0]); PG8_STAGE(PG8_SB(0, 1), cB + hstep, voffB); PG8_STAGE(PG8_SA(0, 1), cA, vAc[1]);
        if (wr == 1) PG8_BAR;
        PG8_WAIT_V(4); PG8_BAR;
        PG8_STAGE(PG8_SB(1, 0), cB + kstep, voffB); PG8_STAGE(PG8_SA(1, 0), cA + kstep, vAc[0]); PG8_STAGE(PG8_SB(1, 1), cB + hstep + kstep, voffB);
        PG8_WAIT_V(6); PG8_BAR;
    }
    for (;;) {
        const bool has_next = S.next(ui + 1, nxt);
        const char* nA = has_next ? S.aptr(nxt) : cA; const char* nB = has_next ? S.bptr(nxt) : cB;
        if (has_next) { PG8_AOFF(vAn, nxt, ui + 1); }
        else {
#pragma unroll
            for (int h = 0; h < 2; ++h)
#pragma unroll
                for (int i = 0; i < 2; ++i) vAn[h][i] = vAc[h][i];
        }
        for (int t = 0; t < nt; t += 2) {
            const bool last = (t == nt - 2);
            const char* a1 = cA + (size_t)(t + 1) * kstep;
            const char* a2 = last ? nA : cA + (size_t)(t + 2) * kstep; const char* b2 = last ? nB : cB + (size_t)(t + 2) * kstep;
            const char* a3 = a2 + kstep; const char* b3 = b2 + kstep;
            unsigned w2[2][2];
#pragma unroll
            for (int h = 0; h < 2; ++h)
#pragma unroll
                for (int i = 0; i < 2; ++i) w2[h][i] = last ? vAn[h][i] : vAc[h][i];
            if constexpr (SP2) {
            PG8_LDB(B0, 0, 0); PG8_LDB(B1, 0, 1); PG8_SCHED; PG8_LDA(At, 0, 0); PG8_STAGE(PG8_SA(1, 1), a1, vAc[1]);
            PG8_WAIT_V(8); PG8_WAIT_L(0); PG8_BAR; PG8_MMA(0, 0, At, B0); PG8_MMA(0, 1, At, B1); PG8_BAR; PG8_SCHED;
            PG8_LDA(At, 0, 1); PG8_STAGE(PG8_SB(0, 0), b2, voffB); PG8_STAGE(PG8_SB(0, 1), b2 + hstep, voffB); PG8_STAGE(PG8_SA(0, 0), a2, w2[0]);
            PG8_WAIT_V(8); PG8_WAIT_L(0); PG8_BAR; PG8_MMA(1, 0, At, B0); PG8_MMA(1, 1, At, B1); PG8_BAR; PG8_SCHED;
            PG8_LDB(B0, 1, 0); PG8_LDB(B1, 1, 1); PG8_SCHED; PG8_LDA(At, 1, 0); PG8_STAGE(PG8_SA(0, 1), a2, w2[1]);
            PG8_WAIT_V(8); PG8_WAIT_L(0); PG8_BAR; PG8_MMA(0, 0, At, B0); PG8_MMA(0, 1, At, B1); PG8_BAR; PG8_SCHED;
            PG8_LDA(At, 1, 1); PG8_STAGE(PG8_SB(1, 0), b3, voffB); PG8_STAGE(PG8_SB(1, 1), b3 + hstep, voffB); PG8_STAGE(PG8_SA(1, 0), a3, w2[0]);
            PG8_WAIT_V(8); PG8_WAIT_L(0); PG8_BAR; PG8_MMA(1, 0, At, B0); PG8_MMA(1, 1, At, B1); PG8_BAR; PG8_SCHED;
            } else {
            PG8_LDB(B0, 0, 0); PG8_SCHED; PG8_LDA(At, 0, 0); PG8_STAGE(PG8_SA(1, 1), a1, vAc[1]);
            PG8_WAIT_L(8); PG8_BAR; PG8_WAIT_L(0); PG8_MMA(0, 0, At, B0); PG8_BAR; PG8_SCHED;
            PG8_LDB(B1, 0, 1); PG8_STAGE(PG8_SB(0, 0), b2, voffB);
            PG8_BAR; PG8_WAIT_L(0); PG8_MMA(0, 1, At, B1); PG8_BAR;
            PG8_LDA(At, 0, 1); PG8_STAGE(PG8_SA(0, 0), a2, w2[0]);
            PG8_BAR; PG8_WAIT_L(0); PG8_MMA(1, 0, At, B0); PG8_BAR; PG8_SCHED;
            PG8_STAGE(PG8_SB(0, 1), b2 + hstep, voffB);
            PG8_WAIT_V(6); PG8_BAR; PG8_MMA(1, 1, At, B1); PG8_BAR;
            PG8_LDB(B0, 1, 0); PG8_SCHED; PG8_LDA(At, 1, 0); PG8_STAGE(PG8_SA(0, 1), a2, w2[1]);
            PG8_WAIT_L(8); PG8_BAR; PG8_WAIT_L(0); PG8_MMA(0, 0, At, B0); PG8_BAR; PG8_SCHED;
            PG8_LDB(B1, 1, 1); PG8_STAGE(PG8_SB(1, 0), b3, voffB);
            PG8_BAR; PG8_WAIT_L(0); PG8_MMA(0, 1, At, B1); PG8_BAR;
            PG8_LDA(At, 1, 1); PG8_STAGE(PG8_SA(1, 0), a3, w2[0]);
            PG8_BAR; PG8_WAIT_L(0); PG8_MMA(1, 0, At, B0); PG8_BAR; PG8_SCHED;
            PG8_STAGE(PG8_SB(1, 1), b3 + hstep, voffB);
            PG8_WAIT_V(6); PG8_BAR; PG8_MMA(1, 1, At, B1); PG8_BAR;
            }
        }
        if constexpr (ALIGN_EPI) { if (wr == 0) PG8_BAR; }
        { int fr2 = fr, fq2 = fq; asm volatile("" : "+v"(fr2), "+v"(fq2));
          S.epi(acc, cur, wr, wc, fr2, fq2); }
        if (!has_next) break;
#pragma unroll
        for (int a = 0; a < 2; ++a)
#pragma unroll
            for (int b = 0; b < 2; ++b)
#pragma unroll
                for (int m = 0; m < 4; ++m)
#pragma unroll
                    for (int n = 0; n < 2; ++n) acc[a][b][m][n] = (f32x4){0.f, 0.f, 0.f, 0.f};
        cur = nxt; cA = nA; cB = nB; ++ui;
#pragma unroll
        for (int h = 0; h < 2; ++h)
#pragma unroll
            for (int i = 0; i < 2; ++i) vAc[h][i] = vAn[h][i];
        if constexpr (ALIGN_EPI) { if (wr == 1) PG8_BAR; }
    }
    PG8_WAIT_V(0);
    if constexpr (!ALIGN_EPI) { if (wr == 0) PG8_BAR; }
    PG8_BAR;
#undef PG8_SA
#undef PG8_SB
#undef PG8_STAGE
#undef PG8_LDA
#undef PG8_LDB
#undef PG8_MMA
#undef PG8_WAIT_V
#undef PG8_WAIT_L
#undef PG8_BAR
#undef PG8_SCHED
#undef PG8_AOFF
}
}

namespace attn_body {
using bf16 = __hip_bfloat16;
using bf16x8 = __attribute__((ext_vector_type(8))) short;
using s16x4 = __attribute__((ext_vector_type(4))) short;
using f32x16 = __attribute__((ext_vector_type(16))) float;
using u32x4 = __attribute__((ext_vector_type(4))) unsigned;
constexpr int D = 64, QPITCH = NHQ * D, KPITCH = NHKV * D, OPITCH = DM, OCOL0 = 256;
constexpr int NW = 8, QBLK = 32, QB = QBLK * NW, KVBLK = 64, NQB = NTOK / QB, NT = NKEYS / KVBLK;
static_assert(NT % 2 == 0 && NT >= 8, "tile count");
__device__ __forceinline__ int crow(int r, int hi) { return (r & 3) + 8 * (r >> 2) + 4 * hi; }
#define SBAR() __builtin_amdgcn_sched_barrier(0)
constexpr int NSLOT = 3, SLOTB = 8192;
constexpr int LDS_K = 0, LDS_V = NSLOT * SLOTB, LDS_WS = 2 * NSLOT * SLOTB, LDS_OST = LDS_WS + NW * 64 * 4, LDS_BYTES = LDS_OST + NW * 4096;
constexpr float C2 = 0.125f * 1.4426950408889634f;
__device__ __forceinline__ void glds16(const void* gsrc, unsigned lds_dst) { unsigned keep;
  asm volatile("s_mov_b32 %0, m0\n\ts_mov_b32 m0, %2\n\ts_nop 0\n\tglobal_load_lds_dwordx4 %1, off\n\ts_mov_b32 m0, %0" : "=&s"(keep) : "v"(gsrc), "s"(lds_dst) : "memory"); }
__device__ __forceinline__ float max3f(float a, float b, float c) { float r; asm("v_max3_f32 %0, %1, %2, %3" : "=v"(r) : "v"(a), "v"(b), "v"(c)); return r; }
__device__ __forceinline__ float max2f(float a, float b) { float r; asm("v_max_f32_e32 %0, %1, %2" : "=v"(r) : "v"(a), "v"(b)); return r; }
__device__ __forceinline__ float fadd_s(float a, float b) { float r; asm("v_add_f32_e32 %0, %1, %2" : "=v"(r) : "v"(a), "v"(b)); return r; }
__device__ __forceinline__ float fsub_s(float a, float b) { float r; asm("v_sub_f32_e32 %0, %1, %2" : "=v"(r) : "v"(a), "v"(b)); return r; }
typedef float f32x2_t __attribute__((ext_vector_type(2))); typedef __bf16 bf16x2_t __attribute__((ext_vector_type(2)));
__device__ __forceinline__ unsigned cvtpk_s(float lo, float hi) { f32x2_t v = {lo, hi}; bf16x2_t b = __builtin_convertvector(v, bf16x2_t); return __builtin_bit_cast(unsigned, b); }
#define WAIT_BAR(N) asm volatile("s_waitcnt vmcnt(" #N ") lgkmcnt(0)\n\ts_barrier" ::: "memory")

__device__ __forceinline__ void qkt(f32x16& p0, f32x16& p1, const char* Kslot, const bf16x8* qr, const f32x16& negm, int r32, int hi) {
  const char* kb = Kslot + hi * 1024 + r32 * 16;
  #pragma unroll
  for (int d0 = 0; d0 < 4; ++d0) {
    const bf16x8 b0 = *reinterpret_cast<const bf16x8*>(kb + d0 * 2048);
    const bf16x8 b1 = *reinterpret_cast<const bf16x8*>(kb + d0 * 2048 + 512);
    if (d0 == 0) { p0 = __builtin_amdgcn_mfma_f32_32x32x16_bf16(b0, qr[0], negm, 0, 0, 0); p1 = __builtin_amdgcn_mfma_f32_32x32x16_bf16(b1, qr[0], negm, 0, 0, 0); }
    else { p0 = __builtin_amdgcn_mfma_f32_32x32x16_bf16(b0, qr[d0], p0, 0, 0, 0); p1 = __builtin_amdgcn_mfma_f32_32x32x16_bf16(b1, qr[d0], p1, 0, 0, 0); } }
}
typedef __attribute__((address_space(3))) const char* lds_cptr;
typedef short v4i16_t __attribute__((ext_vector_type(4)));
__device__ __forceinline__ void kload8(bf16x8* kf, lds_cptr kp) {
  kf[0] = *(const __attribute__((address_space(3))) bf16x8*)(kp);        kf[1] = *(const __attribute__((address_space(3))) bf16x8*)(kp + 512);
  kf[2] = *(const __attribute__((address_space(3))) bf16x8*)(kp + 2048); kf[3] = *(const __attribute__((address_space(3))) bf16x8*)(kp + 2560);
  kf[4] = *(const __attribute__((address_space(3))) bf16x8*)(kp + 4096); kf[5] = *(const __attribute__((address_space(3))) bf16x8*)(kp + 4608);
  kf[6] = *(const __attribute__((address_space(3))) bf16x8*)(kp + 6144); kf[7] = *(const __attribute__((address_space(3))) bf16x8*)(kp + 6656);
}
__device__ __forceinline__ void kload2(bf16x8* kf, lds_cptr kp, int j) { kf[2 * j] = *(const __attribute__((address_space(3))) bf16x8*)(kp + j * 2048); kf[2 * j + 1] = *(const __attribute__((address_space(3))) bf16x8*)(kp + j * 2048 + 512); }
__device__ __forceinline__ s16x4 vtr(lds_cptr p) { return __builtin_bit_cast(s16x4, __builtin_amdgcn_ds_read_tr16_b64_v4i16((__attribute__((address_space(3))) v4i16_t*)p)); }
__device__ __forceinline__ float rowmax(const f32x16& p0, const f32x16& p1) {
  float a = max3f(p0[0], p0[1], p1[0]), b = max3f(p0[2], p0[3], p1[1]); a = max3f(a, p1[2], p1[3]);
  #pragma unroll
  for (int r = 4; r < 16; r += 4) { a = max3f(a, p0[r], p0[r + 1]); b = max3f(b, p0[r + 2], p0[r + 3]); a = max3f(a, p1[r], p1[r + 1]); b = max3f(b, p1[r + 2], p1[r + 3]); }
  const float m = max2f(a, b);
  auto rr = __builtin_amdgcn_permlane32_swap(__float_as_uint(m), __float_as_uint(m), false, false);
  return max2f(__uint_as_float(rr[0]), __uint_as_float(rr[1]));
}
__device__ __forceinline__ void pv(f32x16* o, int vb, bf16x8 pa0, bf16x8 pa1, bf16x8 pa2, bf16x8 pa3) {
  #pragma unroll
  for (int d0 = 0; d0 < 2; ++d0) { s16x4 lo[4], hi[4];
    #pragma unroll
    for (int ks = 0; ks < 4; ++ks) {
      asm volatile("ds_read_b64_tr_b16 %0,%1 offset:%c2" : "=&v"(lo[ks]) : "v"(vb), "i"(d0 * 4096 + ks * 1024) : "memory");
      asm volatile("ds_read_b64_tr_b16 %0,%1 offset:%c2" : "=&v"(hi[ks]) : "v"(vb), "i"(d0 * 4096 + ks * 1024 + 512) : "memory"); }
    asm volatile("s_waitcnt lgkmcnt(0)" ::: "memory"); SBAR();
    #define PK(k) (bf16x8){lo[k][0], lo[k][1], lo[k][2], lo[k][3], hi[k][0], hi[k][1], hi[k][2], hi[k][3]}
    o[d0] = __builtin_amdgcn_mfma_f32_32x32x16_bf16(pa0, PK(0), o[d0], 0, 0, 0);
    o[d0] = __builtin_amdgcn_mfma_f32_32x32x16_bf16(pa1, PK(1), o[d0], 0, 0, 0);
    o[d0] = __builtin_amdgcn_mfma_f32_32x32x16_bf16(pa2, PK(2), o[d0], 0, 0, 0);
    o[d0] = __builtin_amdgcn_mfma_f32_32x32x16_bf16(pa3, PK(3), o[d0], 0, 0, 0);
    #undef PK
  }
}
#define ATTN_STORE16(p, v) (*(u32x4*)(p) = (v))
template <int THRL> __device__ __forceinline__ void attn_unit(int h, int kvh, int qb, const bf16* Q, const bf16* __restrict__ K, const bf16* __restrict__ V, bf16* O, char* shm, int wid, float kmax2) {
  const int lane = fresh_lane(), r32 = lane & 31, hi = lane >> 5;
  const int q0 = qb * QB;
  const bf16* Qw = Q + (long)(q0 + wid * QBLK) * QPITCH + h * D;
  const bf16* Kh = K + kvh * D, *Vh = V + kvh * D;
  const unsigned lds0 = (unsigned)(uintptr_t)shm;
  float* wsf = (float*)(shm + LDS_WS) + wid * 64;
  const bf16* ksrc = Kh + (long)lane * KPITCH + wid * 8;
  const bf16* vsrc = Vh + (long)(16 * (wid & 3) + (lane >> 2)) * KPITCH + (wid >> 2) * 32 + (lane & 3) * 8;
  const unsigned kdst = lds0 + LDS_K + wid * 1024, vdst = lds0 + LDS_V + wid * 1024;
  #define DMA_K(t, slot) glds16(ksrc + (long)(t) * KVBLK * KPITCH, (unsigned)__builtin_amdgcn_readfirstlane(kdst + (slot)))
  #define DMA_V(t, slot) glds16(vsrc + (long)(t) * KVBLK * KPITCH, (unsigned)__builtin_amdgcn_readfirstlane(vdst + (slot)))
  const int vb0 = (int)(lds0 + LDS_V) + ((lane >> 4) & 1) * 32 + (lane & 3) * 8 + (4 * hi + ((lane & 15) >> 2)) * 64;
  const char* Kbase = shm + LDS_K; bf16x8 kf[8];
  const lds_cptr shm3 = (lds_cptr)shm; const lds_cptr kp0 = shm3 + LDS_K + hi * 1024 + r32 * 16; const lds_cptr vp0 = shm3 + LDS_V + ((lane >> 4) & 1) * 32 + (lane & 3) * 8 + (4 * hi + ((lane & 15) >> 2)) * 64;
  DMA_K(0, 0); DMA_V(0, 0); DMA_K(1, SLOTB);
  bf16x8 qr[4];
  #pragma unroll
  for (int d0 = 0; d0 < 4; ++d0) qr[d0] = *reinterpret_cast<const bf16x8*>(&Qw[(long)r32 * QPITCH + d0 * 16 + hi * 8]);
  float l_reg = 0.f; f32x16 o[2]; o[0] = f32x16{}; o[1] = f32x16{}; f32x16 negm;
  { float qn2 = 0.f;
    #pragma unroll
    for (int d0 = 0; d0 < 4; ++d0)
      #pragma unroll
      for (int j = 0; j < 8; ++j) { const float f = __uint_as_float((unsigned)(unsigned short)qr[d0][j] << 16); qn2 += f * f; }
    auto rr = __builtin_amdgcn_permlane32_swap(__float_as_uint(qn2), __float_as_uint(qn2), false, false); qn2 = __uint_as_float(rr[0]) + __uint_as_float(rr[1]);
    const float bnd = sqrtf(qn2 * kmax2) * 1.004f + 0.01f;
    #pragma unroll
    for (int r = 0; r < 16; ++r) negm[r] = -bnd;
    asm volatile("" : "+v"(negm)); }
  f32x16 pA0, pA1, pB0, pB1;
  int sl_prev = 0, sl_cur = 0, sl_next = SLOTB;
  #define ROT() do { sl_prev = sl_cur; sl_cur = sl_next; sl_next = (sl_next == (NSLOT - 1) * SLOTB) ? 0 : sl_next + SLOTB; } while (0)
  DMA_K(2, 2 * SLOTB);
  WAIT_BAR(3);
  qkt(pA0, pA1, Kbase, qr, negm, r32, hi); asm volatile("s_nop 15\n\ts_nop 7" : "+v"(pA0), "+v"(pA1));
  _Pragma("unroll") for (int r = 0; r < 16; ++r) { pA0[r] = __builtin_amdgcn_exp2f(pA0[r]); pA1[r] = __builtin_amdgcn_exp2f(pA1[r]); }
  WAIT_BAR(0);
  DMA_K(3, 0); DMA_V(1, SLOTB);
  ROT();
  kload8(kf, kp0 + sl_cur);
  WAIT_BAR(2);
  s16x4 vlo[8], vhi[8]; u32x4 pw0, pw1, pw2, pw3;
  #define PKW(P, B) cvtpk_s(P[B], P[B + 1])
  #define PAF(k) __builtin_bit_cast(bf16x8, pw##k)
  #define VFR(i) (bf16x8){vlo[i][0], vlo[i][1], vlo[i][2], vlo[i][3], vhi[i][0], vhi[i][1], vhi[i][2], vhi[i][3]}
  #define PIN(x) asm volatile("" : "+v"(x))
  #define MX3(a, b, c) __builtin_fmaxf(__builtin_fmaxf((a), (b)), (c))
  #define GAPA(MF, A0, A1, A2, A3, W0, W1, PW) do { MF; sacc += A0; sacc += A1; sacc += A2; sacc += A3; PIN(sacc); W0; W1; PIN(PW); SBAR(); } while (0)
  #define EX(v) __builtin_amdgcn_exp2f(v)
  #define GAPB(MF, X, B) do { MF; X[B] = EX(X[B]); X[B + 1] = EX(X[B + 1]); X[B + 2] = EX(X[B + 2]); X[B + 3] = EX(X[B + 3]); PIN(X); SBAR(); } while (0)
  #define VRD(i) do { vlo[i] = vtr(vp_ + (((i) >> 2) * 4096 + ((i) & 3) * 1024)); vhi[i] = vtr(vp_ + (((i) >> 2) * 4096 + ((i) & 3) * 1024 + 512)); } while (0)
  #define KRD(G, j) do { if (G) { kload2(kf, kp0 + sl_next, j); SBAR(); } } while (0)
  #define STEPM(C0, C1, P0, P1, t, GK, GV, GL) do { SBAR(); \
    const lds_cptr vp_ = vp0 + sl_prev; \
    VRD(0); SBAR(); float sacc = (P0[0] + P0[1]); \
    GAPA(C0 = __builtin_amdgcn_mfma_f32_32x32x16_bf16(kf[0], qr[0], negm, 0, 0, 0), P0[2], P0[3], P0[4], P0[5],     pw0[0] = PKW(P0, 0), pw0[1] = PKW(P0, 2), pw0); \
    VRD(4); SBAR(); GAPA(C1 = __builtin_amdgcn_mfma_f32_32x32x16_bf16(kf[1], qr[0], negm, 0, 0, 0), P0[6], P0[7], P0[8], P0[9],     pw0[2] = PKW(P0, 4), pw0[3] = PKW(P0, 6), pw0); \
    VRD(1); SBAR(); GAPA(C0 = __builtin_amdgcn_mfma_f32_32x32x16_bf16(kf[2], qr[1], C0, 0, 0, 0),   P0[10], P0[11], P0[12], P0[13], pw1[0] = PKW(P0, 8), pw1[1] = PKW(P0, 10), pw1); \
    VRD(5); SBAR(); GAPA(C1 = __builtin_amdgcn_mfma_f32_32x32x16_bf16(kf[3], qr[1], C1, 0, 0, 0),   P0[14], P0[15], P1[0], P1[1],   pw1[2] = PKW(P0, 12), pw1[3] = PKW(P0, 14), pw1); \
    VRD(2); SBAR(); GAPA(C0 = __builtin_amdgcn_mfma_f32_32x32x16_bf16(kf[4], qr[2], C0, 0, 0, 0),   P1[2], P1[3], P1[4], P1[5],     pw2[0] = PKW(P1, 0), pw2[1] = PKW(P1, 2), pw2); \
    VRD(6); SBAR(); GAPA(C1 = __builtin_amdgcn_mfma_f32_32x32x16_bf16(kf[5], qr[2], C1, 0, 0, 0),   P1[6], P1[7], P1[8], P1[9],     pw2[2] = PKW(P1, 4), pw2[3] = PKW(P1, 6), pw2); \
    VRD(3); SBAR(); GAPA(C0 = __builtin_amdgcn_mfma_f32_32x32x16_bf16(kf[6], qr[3], C0, 0, 0, 0),   P1[10], P1[11], P1[12], P1[13], pw3[0] = PKW(P1, 8), pw3[1] = PKW(P1, 10), pw3); \
    VRD(7); SBAR(); GAPA(C1 = __builtin_amdgcn_mfma_f32_32x32x16_bf16(kf[7], qr[3], C1, 0, 0, 0),   P1[14], P1[15], 0.f, 0.f,       pw3[2] = PKW(P1, 12), pw3[3] = PKW(P1, 14), pw3); \
    l_reg += sacc; \
    if (GK) { DMA_K((t) + 3, sl_cur); } if (GV) { DMA_V((t) + 1, sl_next); } \
    SBAR(); \
    GAPB(o[0] = __builtin_amdgcn_mfma_f32_32x32x16_bf16(PAF(0), VFR(0), o[0], 0, 0, 0), C0, 0); \
    GAPB(o[1] = __builtin_amdgcn_mfma_f32_32x32x16_bf16(PAF(0), VFR(4), o[1], 0, 0, 0), C0, 4); \
    KRD(GL, 0); GAPB(o[0] = __builtin_amdgcn_mfma_f32_32x32x16_bf16(PAF(1), VFR(1), o[0], 0, 0, 0), C0, 8); \
    KRD(GL, 1); GAPB(o[1] = __builtin_amdgcn_mfma_f32_32x32x16_bf16(PAF(1), VFR(5), o[1], 0, 0, 0), C0, 12); \
    KRD(GL, 2); GAPB(o[0] = __builtin_amdgcn_mfma_f32_32x32x16_bf16(PAF(2), VFR(2), o[0], 0, 0, 0), C1, 0); \
    KRD(GL, 3); GAPB(o[1] = __builtin_amdgcn_mfma_f32_32x32x16_bf16(PAF(2), VFR(6), o[1], 0, 0, 0), C1, 4); \
    GAPB(o[0] = __builtin_amdgcn_mfma_f32_32x32x16_bf16(PAF(3), VFR(3), o[0], 0, 0, 0), C1, 8); \
    GAPB(o[1] = __builtin_amdgcn_mfma_f32_32x32x16_bf16(PAF(3), VFR(7), o[1], 0, 0, 0), C1, 12); \
    } while (0)
  int t = 1;
  for (; t + 5 < NT; t += 2) {
    STEPM(pB0, pB1, pA0, pA1, t, true, true, true);     WAIT_BAR(2); ROT();
    STEPM(pA0, pA1, pB0, pB1, t + 1, true, true, true); WAIT_BAR(2); ROT();
  }
  #define ENDW(tt) do { if ((tt) + 3 < NT) { WAIT_BAR(2); } else if ((tt) + 2 < NT) { WAIT_BAR(1); } else { WAIT_BAR(0); } } while (0)
  for (; t + 1 < NT; t += 2) {
    STEPM(pB0, pB1, pA0, pA1, t, (t + 3 < NT), (t + 1 < NT), (t + 1 < NT));         ENDW(t);     ROT();
    STEPM(pA0, pA1, pB0, pB1, t + 1, (t + 4 < NT), (t + 2 < NT), (t + 2 < NT));     ENDW(t + 1); ROT();
  }
  STEPM(pB0, pB1, pA0, pA1, NT - 1, false, false, false);
  { float sacc = pB0[0] + pB0[1]; _Pragma("unroll") for (int r = 2; r < 16; ++r) sacc += pB0[r]; _Pragma("unroll") for (int r = 0; r < 16; ++r) sacc += pB1[r]; l_reg += sacc;
    pw0 = (u32x4){PKW(pB0, 0), PKW(pB0, 2), PKW(pB0, 4), PKW(pB0, 6)}; pw1 = (u32x4){PKW(pB0, 8), PKW(pB0, 10), PKW(pB0, 12), PKW(pB0, 14)}; pw2 = (u32x4){PKW(pB1, 0), PKW(pB1, 2), PKW(pB1, 4), PKW(pB1, 6)}; pw3 = (u32x4){PKW(pB1, 8), PKW(pB1, 10), PKW(pB1, 12), PKW(pB1, 14)};
    SBAR(); pv(o, vb0 + sl_cur, PAF(0), PAF(1), PAF(2), PAF(3)); }
  #undef PKW
  #undef PAF
  #undef VFR
  #undef PIN
  #undef MX3
  #undef GAPA
  #undef GAPB
  #undef EX
  #undef VRD
  #undef KRD
  #undef STEPM
  #undef ENDW
  { auto rr = __builtin_amdgcn_permlane32_swap(__float_as_uint(l_reg), __float_as_uint(l_reg), false, false); l_reg = __uint_as_float(rr[0]) + __uint_as_float(rr[1]); }
  if (hi == 0) wsf[32 + r32] = l_reg; asm volatile("s_waitcnt lgkmcnt(0)" ::: "memory");
  float rli[16];
  #pragma unroll
  for (int r = 0; r < 16; ++r) rli[r] = __builtin_amdgcn_rcpf(wsf[32 + crow(r, hi)]);
  bf16* Ow = O + (long)(q0 + wid * QBLK) * OPITCH + OCOL0 + h * D;
  { bf16* stg = (bf16*)(shm + LDS_OST) + wid * 2048;
    #pragma unroll
    for (int r = 0; r < 16; ++r) { const int orow = crow(r, hi);
      #pragma unroll
      for (int d0 = 0; d0 < 2; ++d0) stg[orow * 64 + d0 * 32 + r32] = __float2bfloat16(o[d0][r] * rli[r]); }
    asm volatile("s_waitcnt lgkmcnt(0)" ::: "memory");
    #pragma unroll
    for (int i = 0; i < 4; ++i) { const int row = i * 8 + (lane >> 3), ch = lane & 7; const u32x4 v = *(const u32x4*)(stg + row * 64 + ch * 8); ATTN_STORE16(Ow + (long)row * OPITCH + ch * 8, v); } }
  asm volatile("s_waitcnt lgkmcnt(0)\n\ts_barrier" ::: "memory");
  #undef DMA_K
  #undef DMA_V
  #undef ROT
}
#undef SBAR
#undef WAIT_BAR
}

constexpr int NWAVES = 8, NTHR = NWAVES * 64;
constexpr size_t MiB = 1u << 20;
constexpr size_t WS_CTL = 0, CTL_ZERO_BYTES = 64 * 1024;
constexpr size_t WS_MOD = 1 * MiB;
constexpr size_t WS_MISC = WS_MOD + 64 * 1024;
constexpr size_t WS_IDX = WS_MISC, WS_GATE = WS_IDX + 128 * 1024, WS_TOKSLOT = WS_GATE + 128 * 1024;
constexpr size_t WS_AFF = 3 * MiB;
constexpr size_t WS_WIN = 4 * MiB;
constexpr size_t WS_WOUT = 7 * MiB;
constexpr size_t WS_WGU = 9 * MiB;
constexpr size_t WS_WD = 137 * MiB;
constexpr size_t WS_X1 = 201 * MiB;
constexpr size_t WS_R1 = 265 * MiB;
constexpr size_t WS_XN = WS_R1;
constexpr size_t WS_Q = WS_XN + (size_t)NROWS * DM * 2;
constexpr size_t WS_K = WS_Q + (size_t)NTOK * 768 * 2;
constexpr size_t WS_V = WS_K + (size_t)NROWS * 256 * 2;
constexpr size_t WS_FT = WS_V + (size_t)NROWS * 256 * 2;
constexpr size_t WS_MIX = WS_FT + (size_t)256 * NTOK * 4;
constexpr size_t WS_HID = WS_R1;
constexpr size_t WS_R2 = 393 * MiB;
constexpr size_t WS_H2 = WS_R2;
constexpr size_t WS_YE = WS_R2;
constexpr size_t WS_END = 457 * MiB;
static_assert(WS_MIX + (size_t)NTOK * DM * 2 <= WS_R1 + 128 * MiB, "R1 map");
static_assert(WS_TOKSLOT + (size_t)NTOK * 16 * 4 <= WS_AFF, "misc map");
constexpr int CW_TMO = 0, CW_FLAG = 2, CW_KMAX = 64, CW_BAR = 1024;

constexpr int LDS_BYTES = 163840;
constexpr int RING_BYTES = 131072, XTRA_OFF = RING_BYTES;
constexpr int MISC_OFF = LDS_BYTES - 512;

#define GAS __attribute__((address_space(1)))
#define LAS __attribute__((address_space(3)))
typedef unsigned short bf16;
typedef unsigned v4u __attribute__((ext_vector_type(4)));
typedef unsigned v2u __attribute__((ext_vector_type(2)));
typedef float f32x4 __attribute__((ext_vector_type(4)));
typedef float f32x2 __attribute__((ext_vector_type(2)));
typedef GAS unsigned gu32;
#define RLX_AGENT __ATOMIC_RELAXED, __HIP_MEMORY_SCOPE_AGENT
#define LDS_WAIT() asm volatile("s_waitcnt lgkmcnt(0)" ::: "memory")
#define VM_WAIT() asm volatile("s_waitcnt vmcnt(0)" ::: "memory")
__device__ __forceinline__ unsigned f2bf(float f) { unsigned u = __builtin_bit_cast(unsigned, f); return (u + 0x7fffu + ((u >> 16) & 1u)) >> 16; }
__device__ __forceinline__ unsigned pk2(float lo, float hi) { return f2bf(lo) | (f2bf(hi) << 16); }
__device__ __forceinline__ float bf2f(unsigned short b) { return __builtin_bit_cast(float, (unsigned)b << 16); }

#define XB_TMO      128
#define XB_XCNT(j)  (256  + 64 * (j))
#define XB_XSUB(j)  (1280 + 64 * (j))
#define XB_XGEN(j)  (2304 + 64 * (j))
#define XB_TOP      3328
#define XB_TOPGEN   3392
#define XCD_BAR_WORDS 3456
#define XB_SPIN_CAP (1u << 20)
static_assert((CW_BAR + XCD_BAR_WORDS) * 4 <= (int)CTL_ZERO_BYTES, "ctl");
__device__ __forceinline__ unsigned xb_ld(unsigned* p)              { return __hip_atomic_load(p, __ATOMIC_RELAXED, __HIP_MEMORY_SCOPE_AGENT); }
__device__ __forceinline__ unsigned xb_add(unsigned* p, unsigned v) { return __hip_atomic_fetch_add(p, v, __ATOMIC_RELAXED, __HIP_MEMORY_SCOPE_AGENT); }
__device__ __forceinline__ unsigned xb_xcc_id() { return (unsigned)__builtin_amdgcn_s_getreg((3 << 11) | 20) & 0xFu; }
#define XB_SPIN(cond, bar) do { unsigned _sp = 0; while (cond) { __builtin_amdgcn_s_sleep(1); \
    if ((++_sp & 255u) == 0u) { if (xb_ld(&(bar)[XB_TMO])) break; if (_sp > XB_SPIN_CAP) { atomicAdd(&(bar)[XB_TMO], 1u); break; } } } } while (0)
struct XcdBarrier { unsigned* bar; unsigned x; volatile LAS unsigned* st; };
__device__ __forceinline__ XcdBarrier xcd_barrier_post(unsigned* bar, volatile LAS unsigned* st, bool leader) {
    XcdBarrier b; b.bar = bar; b.x = xb_xcc_id(); b.st = st;
    if (leader) (void)xb_add(&bar[XB_XCNT(b.x)], 1u);
    return b;
}
__device__ __forceinline__ void xcd_barrier_complete(unsigned* bar, unsigned x, unsigned& nloc, unsigned& nx) {
    const unsigned G = gridDim.x * gridDim.y * gridDim.z;
    unsigned sum, cnt, mine, sp = 0u;
    for (;;) {
        sum = 0u; cnt = 0u; mine = 0u;
#pragma unroll
        for (unsigned j = 0; j < 16; ++j) { const unsigned c = xb_ld(&bar[XB_XCNT(j)]); sum += c; cnt += (c > 0u) ? 1u : 0u; mine = (j == x) ? c : mine; }
        if (sum == G) break;
        __builtin_amdgcn_s_sleep(1);
        if ((++sp & 255u) == 0u) { if (xb_ld(&bar[XB_TMO])) break; if (sp > XB_SPIN_CAP) { atomicAdd(&bar[XB_TMO], 1u); break; } }
    }
    nloc = mine > 0u ? mine : 1u; nx = cnt > 0u ? cnt : 1u;
}
__device__ __forceinline__ void xcd_barrier(const XcdBarrier& b, int wave) {
    asm volatile("s_waitcnt vmcnt(0)" ::: "memory");
    __syncthreads();
    if (wave == 0 && fresh_lane() == 0) {
        unsigned* bar = b.bar;
        __builtin_amdgcn_s_waitcnt(0);
        unsigned nloc = b.st[0], nx = b.st[1];
        if (nloc == 0u) { xcd_barrier_complete(bar, b.x, nloc, nx); b.st[0] = nloc; b.st[1] = nx; }
        const unsigned old = xb_add(&bar[XB_XSUB(b.x)], 1u);
        const unsigned gen = old / nloc;
        if (old + 1u == (gen + 1u) * nloc) {
            __builtin_amdgcn_fence(__ATOMIC_RELEASE, "agent");
            asm volatile("s_waitcnt vmcnt(0)" ::: "memory");
            const unsigned og = xb_add(&bar[XB_TOP], 1u);
            const unsigned tg = og / nx;
            if (og + 1u == (tg + 1u) * nx) xb_add(&bar[XB_TOPGEN], 1u);
            else XB_SPIN(xb_ld(&bar[XB_TOPGEN]) == tg, bar);
            __builtin_amdgcn_fence(__ATOMIC_ACQUIRE, "agent");
            xb_add(&bar[XB_XGEN(b.x)], 1u);
            asm volatile("s_waitcnt vmcnt(0)" ::: "memory");
        } else {
            XB_SPIN(xb_ld(&bar[XB_XGEN(b.x)]) == gen, bar);
            __builtin_amdgcn_fence(__ATOMIC_ACQUIRE, "agent");
            asm volatile("s_waitcnt vmcnt(0)" ::: "memory");
        }
    }
    __syncthreads();
}

struct Args {
    const float *x, *c, *ctx, *c_ctx, *w_mod, *b_mod, *norm_mix_g, *norm_ffn_g, *w_in, *w_four, *q_norm_g, *k_norm_g, *w_out, *w_router, *w_gate, *w_up, *w_down, *final_norm_g;
    float* out; unsigned char* ws;
};

__device__ __forceinline__ float wave_sum(float v) {
#pragma unroll
    for (int o = 1; o < 64; o <<= 1) v += __shfl_xor(v, o);
    return v;
}

template <class RowMap>
__device__ __forceinline__ void tr_item(const float* __restrict__ W, int ldw, int k0, int n0, bf16* WT, int ldt, int kdst0, const RowMap& drow, LAS float* scr, int lane) {
    const int kq = lane >> 4, nq = lane & 15;
    f32x4 v[16];
#pragma unroll
    for (int it = 0; it < 16; ++it) v[it] = *(const f32x4*)(W + (size_t)(k0 + 4 * it + kq) * ldw + n0 + 4 * nq);
#pragma unroll
    for (int it = 0; it < 16; ++it) { LAS float* s = scr + (4 * it + kq) * 65 + 4 * nq; s[0] = v[it][0]; s[1] = v[it][1]; s[2] = v[it][2]; s[3] = v[it][3]; }
    LDS_WAIT(); asm volatile("" ::: "memory");
    const int c = lane >> 3, nn = lane & 7;
#pragma unroll
    for (int j = 0; j < 8; ++j) { const int n = nn + 8 * j; const LAS float* s = scr + (8 * c) * 65 + n;
        v4u o; o.x = pk2(s[0 * 65], s[1 * 65]); o.y = pk2(s[2 * 65], s[3 * 65]); o.z = pk2(s[4 * 65], s[5 * 65]); o.w = pk2(s[6 * 65], s[7 * 65]);
        *(GAS v4u*)(WT + (size_t)drow(n0 + n) * ldt + kdst0 + k0 + 8 * c) = o; }
    LDS_WAIT(); asm volatile("" ::: "memory");
}
struct RowId { int base; __device__ __forceinline__ int operator()(int n) const { return base + n; } };
struct RowQKV { __device__ __forceinline__ int operator()(int n) const { const int t = n >> 8, w = n & 255, hd = w >> 6, d = w & 63; return 256 + 256 * t + 128 * (d >> 5) + 32 * hd + (d & 31); } };
struct RowGU { int base, up; __device__ __forceinline__ int operator()(int f) const { return base + 256 * (f >> 7) + 128 * up + (f & 127); } };


constexpr int MOE_ITEMS = 3 * 8192;
struct TrDesc { const float* src; bf16* dst; int ldw, ldt; };
__device__ __forceinline__ TrDesc moe_desc(const Args& a, int r) {
    TrDesc d;
    if (r < 16384) { const int up = r >> 13, rr = r & 8191, e = rr >> 9, q = rr & 511, kb = q >> 5, nb = q & 31;
        d.src = (up ? a.w_up : a.w_gate) + (size_t)e * DM * DE + (size_t)(kb * 64) * DE + nb * 64; d.ldw = DE;
        d.dst = (bf16*)(a.ws + WS_WGU) + ((size_t)e * 4096 + 256 * (nb >> 1) + 128 * up + 64 * (nb & 1)) * DM + kb * 64; d.ldt = DM; }
    else { const int rr = r - 16384, e = rr >> 9, q = rr & 511, kb = q >> 4, nb = q & 15;
        d.src = a.w_down + (size_t)e * DE * DM + (size_t)(kb * 64) * DM + nb * 64; d.ldw = DM;
        d.dst = (bf16*)(a.ws + WS_WD) + ((size_t)e * DM + nb * 64) * DE + kb * 64; d.ldt = DE; }
    return d;
}
#define TR_LOAD(v, d) do { _Pragma("unroll") for (int _it = 0; _it < 16; ++_it) v[_it] = *(const f32x4*)((d).src + (size_t)(4 * _it + kq) * (d).ldw + 4 * nq); } while (0)
#define TR_PROC(v, d) do { \
    _Pragma("unroll") for (int _it = 0; _it < 16; ++_it) { LAS float* s_ = scr + (4 * _it + kq) * 65 + 4 * nq; s_[0] = v[_it][0]; s_[1] = v[_it][1]; s_[2] = v[_it][2]; s_[3] = v[_it][3]; } \
    LDS_WAIT(); asm volatile("" ::: "memory"); \
    _Pragma("unroll") for (int _j = 0; _j < 8; ++_j) { const int n_ = nn + 8 * _j; const LAS float* s_ = scr + (8 * c8) * 65 + n_; \
        v4u o_; o_.x = pk2(s_[0 * 65], s_[1 * 65]); o_.y = pk2(s_[2 * 65], s_[3 * 65]); o_.z = pk2(s_[4 * 65], s_[5 * 65]); o_.w = pk2(s_[6 * 65], s_[7 * 65]); \
        *(GAS v4u*)((d).dst + (size_t)n_ * (d).ldt + 8 * c8) = o_; } \
    LDS_WAIT(); asm volatile("" ::: "memory"); } while (0)
__device__ __forceinline__ void moe_convert(const Args& a, LAS float* scr, int lo, int hi, int w, int nw) {
    const int lane = fresh_lane(), kq = lane >> 4, nq = lane & 15, c8 = lane >> 3, nn = lane & 7;
    int it = lo + w; if (it >= hi) return;
    f32x4 va[16], vb[16];
    TrDesc da = moe_desc(a, it), db = da; TR_LOAD(va, da);
    for (;;) {
        int nx = it + nw; bool hn = nx < hi;
        if (hn) { db = moe_desc(a, nx); TR_LOAD(vb, db); }
        TR_PROC(va, da);
        if (!hn) break;
        it = nx; nx = it + nw; hn = nx < hi;
        if (hn) { da = moe_desc(a, nx); TR_LOAD(va, da); }
        TR_PROC(vb, db);
        if (!hn) break;
        it = nx;
    }
}
#ifndef MOE_S0
#define MOE_S0 4096
#endif
#ifndef MOE_S1
#define MOE_S1 2560
#endif
#ifndef MOE_S2
#define MOE_S2 0
#endif
constexpr int MOE_B0 = MOE_S0, MOE_B1 = MOE_B0 + MOE_S1, MOE_B2 = MOE_B1 + MOE_S2;

__host__ __device__ __forceinline__ int four_pos(int mp) { return mp == 0 ? 0 : (mp == 32 ? 1 : (mp < 32 ? 2 * mp : 2 * (64 - mp) + 1)); }

__device__ __forceinline__ void p0_prologue(const Args& a, LAS unsigned char* lds, int vcu, int G, int wave) {
    const int lane = fresh_lane(), tid = wave * 64 + lane;
    unsigned char* ws = a.ws;
    bf16* WinT = (bf16*)(ws + WS_WIN); bf16* WoT = (bf16*)(ws + WS_WOUT);
    float* MOD = (float*)(ws + WS_MOD);
    const int cg = vcu - (G - 24);
    if (cg >= 0) {
        LAS float* sv = (LAS float*)lds;
        LAS float* red = sv + 2048;
        for (int i = tid; i < 1024; i += NTHR) { const float c0 = a.c[i], c1 = a.c_ctx[i]; sv[i] = c0 / (1.f + __expf(-c0)); sv[1024 + i] = c1 / (1.f + __expf(-c1)); }
        __syncthreads();
        const int col = cg * 256 + 4 * lane;
        f32x4 a0 = {0.f, 0.f, 0.f, 0.f}, a1 = {0.f, 0.f, 0.f, 0.f};
        const int kb = wave * 128;
#pragma unroll 16
        for (int k = 0; k < 128; ++k) { const f32x4 w = *(const f32x4*)(a.w_mod + (size_t)(kb + k) * (NMOD * DM) + col); const float s0 = sv[kb + k], s1 = sv[1024 + kb + k]; a0 += w * s0; a1 += w * s1; }
        *(LAS f32x4*)(red + (wave * 2 + 0) * 256 + 4 * lane) = a0; *(LAS f32x4*)(red + (wave * 2 + 1) * 256 + 4 * lane) = a1;
        __syncthreads();
        { const int v = tid >> 8, cc = tid & 255; float s = 0.f;
#pragma unroll
          for (int w = 0; w < 8; ++w) s += red[(w * 2 + v) * 256 + cc];
          MOD[v * (NMOD * DM) + cg * 256 + cc] = s + a.b_mod[cg * 256 + cc]; }
        __syncthreads();
    }
    LAS float* scr = (LAS float*)(lds + wave * 16640);
    constexpr int I_F1 = 256, I_F2 = 256, I_IN = 16 * 20, I_OUT = 12 * 16;
    constexpr int NITEMS = I_F1 + I_F2 + I_IN + I_OUT;
    for (int it = wave * G + vcu; it < NITEMS; it += NWAVES * G) {
        int r = it;
        if (r < I_F1) {
            const int g = r & 3, kb = (r >> 2) & 15, jq = r >> 6, k = kb * 64 + lane;
            LAS float* ct = scr;
            ct[lane] = cospif((float)lane * (1.f / 32.f)); LDS_WAIT(); asm volatile("" ::: "memory");
            float w[64];
#pragma unroll
            for (int c4 = 0; c4 < 16; ++c4) { const f32x4 t = *(const f32x4*)(a.w_in + (size_t)k * INW + 64 * g + 4 * c4); w[4 * c4] = t[0]; w[4 * c4 + 1] = t[1]; w[4 * c4 + 2] = t[2]; w[4 * c4 + 3] = t[3]; }
            for (int j = 16 * jq; j < 16 * jq + 16; ++j) { const int m = j <= 32 ? j : j - 32; const int ph = j <= 32 ? 0 : 48;
                float s = 0.f;
#pragma unroll
                for (int c = 0; c < 64; ++c) s += w[c] * ct[(c * m + ph) & 63];
                WinT[(size_t)(64 * g + j) * DM + k] = (bf16)f2bf(s * (1.f / 1024.f)); }
            LDS_WAIT(); asm volatile("" ::: "memory");
            continue; }
        r -= I_F1;
        if (r < I_F2) {
            const int g = r & 3, jb = (r >> 2) & 15, mq = r >> 6, j = jb * 64 + lane;
            float w[64];
#pragma unroll
            for (int d = 0; d < 64; ++d) w[d] = a.w_out[(size_t)(64 * g + d) * DM + j];
            for (int mp = 16 * mq; mp < 16 * mq + 16; ++mp) { float s = 0.f; const float* wf = a.w_four + (size_t)(g * 64 + mp) * 64;
#pragma unroll
                for (int d = 0; d < 64; ++d) s += wf[d] * w[d];
                WoT[(size_t)j * DM + 64 * g + four_pos(mp)] = (bf16)f2bf(s); }
            continue; }
        r -= I_F2;
        if (r < I_IN) { const int kb = r / 20, nb = r % 20; tr_item(a.w_in + 256, INW, kb * 64, nb * 64, WinT, DM, 0, RowQKV{}, scr, lane); continue; }
        r -= I_IN;
        { const int kb = r / 16, nb = r % 16; tr_item(a.w_out + (size_t)256 * DM, DM, kb * 64, nb * 64, WoT, DM, 256, RowId{0}, scr, lane); }
    }
    if (cg < 0) moe_convert(a, scr, 0, MOE_B0, ((wave + 4) & 7) * (G - 24) + vcu, NWAVES * (G - 24));
}

__device__ __forceinline__ void p0b_modulate(const Args& a, int vcu, int G, int wave) {
    const int lane = fresh_lane();
    unsigned char* ws = a.ws; const float* MOD = (const float*)(ws + WS_MOD); bf16* XN = (bf16*)(ws + WS_XN);
    const int gw = vcu * NWAVES + wave, NGW = G * NWAVES;
    for (int pass = 0; pass < 2; ++pass) {
        const float* md = MOD + pass * (NMOD * DM);
        const int nrows = pass == 0 ? NTOK : NCTX; const float* src = pass == 0 ? a.x : a.ctx; bf16* dst = XN + (size_t)(pass == 0 ? 0 : NTOK) * DM;
        if (gw >= nrows) continue;
        f32x4 av[4], sh[4];
#pragma unroll
        for (int j = 0; j < 4; ++j) { const int col = 4 * lane + 256 * j; const f32x4 g = *(const f32x4*)(a.norm_mix_g + col); const f32x4 sc = *(const f32x4*)(md + DM + col); av[j] = g * (sc + 1.f); sh[j] = *(const f32x4*)(md + col); }
        f32x4 v[4], vn[4];
        { const GAS f32x4* xr = (const GAS f32x4*)(src + (size_t)gw * DM) + lane;
#pragma unroll
          for (int j = 0; j < 4; ++j) v[j] = xr[64 * j]; }
        for (int m = gw; m < nrows; m += NGW) {
            const int mn = m + NGW;
            if (mn < nrows) { const GAS f32x4* xr = (const GAS f32x4*)(src + (size_t)mn * DM) + lane;
#pragma unroll
                for (int j = 0; j < 4; ++j) vn[j] = xr[64 * j]; }
            float s = 0.f;
#pragma unroll
            for (int j = 0; j < 4; ++j) s += (v[j].x * v[j].x + v[j].y * v[j].y) + (v[j].z * v[j].z + v[j].w * v[j].w);
            const float rinv = 1.f / sqrtf(wave_sum(s) * (1.f / DM) + EPS);
            GAS unsigned long long* o8 = (GAS unsigned long long*)(dst + (size_t)m * DM) + lane;
#pragma unroll
            for (int j = 0; j < 4; ++j) { const f32x4 y = v[j] * rinv * av[j] + sh[j]; o8[64 * j] = (unsigned long long)pk2(y.x, y.y) | ((unsigned long long)pk2(y.z, y.w) << 32); }
#pragma unroll
            for (int j = 0; j < 4; ++j) v[j] = vn[j];
        }
    }
}

struct P1Prob {
    static constexpr int K = DM; static constexpr bool PERM = false;
    const bf16* XN; const bf16* WinT; bf16 *Q, *Kb, *Vb; float* FT; const float *qg, *kg; unsigned* kmax; pg8::StaticOrder so;
    __device__ __forceinline__ bool next(int i, pg8::Unit& u) const { return so.next(i, u); }
    __device__ __forceinline__ const char* aptr(const pg8::Unit& u) const { return u.pn == 0 ? (const char*)WinT : (const char*)(XN + (size_t)u.pm * 256 * DM); }
    __device__ __forceinline__ const char* bptr(const pg8::Unit& u) const { return u.pn == 0 ? (const char*)(XN + (size_t)u.pm * 256 * DM) : (const char*)(WinT + (size_t)u.pn * 256 * DM); }
    __device__ __forceinline__ void epi(const pg8::f32x4 (&acc)[2][2][4][2], const pg8::Unit& u, int wr, int wc, int fr, int fq) const {
        if (u.pn == 0) {
            if (u.pm >= NTOK / 256) return;
#pragma unroll
            for (int ai = 0; ai < 2; ++ai)
#pragma unroll
                for (int m = 0; m < 4; ++m) { float* rowp = FT + (size_t)(ai * 128 + wr * 64 + m * 16 + fr) * NTOK + u.pm * 256 + wc * 32 + 4 * fq;
#pragma unroll
                    for (int bj = 0; bj < 2; ++bj)
#pragma unroll
                        for (int n = 0; n < 2; ++n) *(pg8::f32x4*)(rowp + bj * 128 + n * 16) = acc[ai][bj][m][n]; }
            return;
        }
        const bool isq = u.pn <= 3, isv = u.pn == 5, lat = u.pm < NTOK / 256;
        if (isq && !lat) return;
        if (isv) {
#pragma unroll
            for (int ai = 0; ai < 2; ++ai)
#pragma unroll
                for (int m = 0; m < 4; ++m) { const int t = u.pm * 256 + ai * 128 + wr * 64 + m * 16 + fr; bf16* rowp = Vb + (size_t)t * 256 + wc * 64 + 4 * fq;
#pragma unroll
                    for (int bj = 0; bj < 2; ++bj)
#pragma unroll
                        for (int n = 0; n < 2; ++n) { const pg8::f32x4 v = acc[ai][bj][m][n]; *(v2u*)(rowp + 32 * bj + 16 * n) = (v2u){pk2(v[0], v[1]), pk2(v[2], v[3])}; } }
            return;
        }
        const float* gw = isq ? qg : kg;
        pg8::f32x4 gv[2][2];
#pragma unroll
        for (int bj = 0; bj < 2; ++bj)
#pragma unroll
            for (int n = 0; n < 2; ++n) gv[bj][n] = *(const pg8::f32x4*)(gw + 32 * bj + 16 * n + 4 * fq);
        float frq[4];
#pragma unroll
        for (int e = 0; e < 4; ++e) frq[e] = exp2f(-(float)(4 * fq + e) * (13.287712379549449f / 16.f)) * 0.15915494309189535f;
        const float qs = isq ? attn_body::C2 : 1.f;
        bf16* base = isq ? Q + (size_t)((u.pn - 1) * 4 + wc) * 64 : Kb + (size_t)wc * 64; const int pitch = isq ? 768 : 256;
        float k2max = 0.f;
#pragma unroll
        for (int ai = 0; ai < 2; ++ai) {
            float rowpos = (float)(u.pm * 4 + ai * 2 + wr); asm volatile("" : "+v"(rowpos));
            float cr[4], sr[4];
#pragma unroll
            for (int e = 0; e < 4; ++e) { const float rev = rowpos * frq[e], f_ = rev - floorf(rev); cr[e] = __builtin_amdgcn_cosf(f_); sr[e] = __builtin_amdgcn_sinf(f_); }
#pragma unroll
            for (int m = 0; m < 4; ++m) {
                float colpos = (float)(m * 16 + fr); asm volatile("" : "+v"(colpos));
                const int t = u.pm * 256 + ai * 128 + wr * 64 + m * 16 + fr;
                float ss = 0.f;
#pragma unroll
                for (int bj = 0; bj < 2; ++bj)
#pragma unroll
                    for (int n = 0; n < 2; ++n) { const pg8::f32x4 v = acc[ai][bj][m][n]; ss += (v[0] * v[0] + v[1] * v[1]) + (v[2] * v[2] + v[3] * v[3]); }
                ss += __shfl_xor(ss, 16); ss += __shfl_xor(ss, 32);
                const float rinv = qs / sqrtf(ss * (1.f / 64.f) + EPS);
                pg8::f32x4 y[2][2];
#pragma unroll
                for (int bj = 0; bj < 2; ++bj)
#pragma unroll
                    for (int n = 0; n < 2; ++n) y[bj][n] = acc[ai][bj][m][n] * rinv * gv[bj][n];
                if (lat) {
#pragma unroll
                    for (int e = 0; e < 4; ++e) {
                        { const float x1 = y[0][0][e], x2 = y[0][1][e]; y[0][0][e] = x1 * cr[e] - x2 * sr[e]; y[0][1][e] = x1 * sr[e] + x2 * cr[e]; }
                        { const float rev = colpos * frq[e], f_ = rev - floorf(rev); const float cc = __builtin_amdgcn_cosf(f_), sc = __builtin_amdgcn_sinf(f_);
                          const float x1 = y[1][0][e], x2 = y[1][1][e]; y[1][0][e] = x1 * cc - x2 * sc; y[1][1][e] = x1 * sc + x2 * cc; }
                    }
                }
                bf16* rowp = base + (size_t)t * pitch + 4 * fq;
                ss = 0.f;
#pragma unroll
                for (int bj = 0; bj < 2; ++bj)
#pragma unroll
                    for (int n = 0; n < 2; ++n) { const pg8::f32x4 v = y[bj][n]; const v2u w = (v2u){pk2(v[0], v[1]), pk2(v[2], v[3])}; *(v2u*)(rowp + 32 * bj + 16 * n) = w;
                        if (!isq) { const float b0 = __uint_as_float(w.x << 16), b1 = __uint_as_float(w.x & 0xffff0000u), b2 = __uint_as_float(w.y << 16), b3 = __uint_as_float(w.y & 0xffff0000u); ss += (b0 * b0 + b1 * b1) + (b2 * b2 + b3 * b3); } }
                if (!isq) { float r2 = ss; r2 += __shfl_xor(r2, 16); r2 += __shfl_xor(r2, 32); k2max = fmaxf(k2max, r2); }
                asm volatile("" ::: "memory");
            }
        }
        if (!isq) {
#pragma unroll
            for (int o = 1; o < 16; o <<= 1) k2max = fmaxf(k2max, __shfl_xor(k2max, o));
            if (fr == 0 && fq == 0) __hip_atomic_fetch_max(kmax, __float_as_uint(k2max), __ATOMIC_RELAXED, __HIP_MEMORY_SCOPE_AGENT);
        }
    }
};

__device__ __forceinline__ unsigned rev4_12(unsigned k) { unsigned r = __brev(k) >> 20; return ((r & 0xAAAu) >> 1) | ((r & 0x555u) << 1); }
__device__ __forceinline__ void fft_block(const Args& a, LAS unsigned char* lds, int item, int wave) {
    const int tid = wave * 64 + fresh_lane();
    const int mm = item & 31, par = (item >> 5) & 1, g = item >> 6;
    const float* FT = (const float*)(a.ws + WS_FT); bf16* MIX = (bf16*)(a.ws + WS_MIX);
    LAS f32x2* X = (LAS f32x2*)lds;
    const float* re = FT + (size_t)(64 * g + mm) * NTOK; const float* im = FT + (size_t)(64 * g + 32 + mm) * NTOK;
#pragma unroll 1
    for (int i = 0; i < 2; ++i) {
        const int j0 = 4 * (tid + NTHR * i);
        f32x4 r4[4], i4[4];
#pragma unroll
        for (int q = 0; q < 4; ++q) { r4[q] = *(const f32x4*)(re + j0 + 4096 * q); i4[q] = *(const f32x4*)(im + j0 + 4096 * q); }
#pragma unroll
        for (int e = 0; e < 4; ++e) {
            const int j = j0 + e;
            const f32x2 a0 = {r4[0][e], i4[0][e]}, a1 = {r4[1][e], i4[1][e]}, a2 = {r4[2][e], i4[2][e]}, a3 = {r4[3][e], i4[3][e]};
            f32x2 ya, yb; float fa, fb;
            if (par == 0) { const f32x2 s02 = a0 + a2, s13 = a1 + a3; ya = s02 + s13; yb = s02 - s13; fa = 0.f; fb = (float)(2 * j) * (1.f / 16384.f); }
            else { const f32x2 d02 = a0 - a2, d13 = a1 - a3; ya = (f32x2){d02.x + d13.y, d02.y - d13.x}; yb = (f32x2){d02.x - d13.y, d02.y + d13.x}; fa = (float)j * (1.f / 16384.f); fb = (float)(3 * j) * (1.f / 16384.f); }
            const float ca = __builtin_amdgcn_cosf(fa), sa = __builtin_amdgcn_sinf(fa), cb = __builtin_amdgcn_cosf(fb), sb = __builtin_amdgcn_sinf(fb);
            X[j] = (f32x2){ya.x * ca + ya.y * sa, ya.y * ca - ya.x * sa};
            X[4096 + j] = (f32x2){yb.x * cb + yb.y * sb, yb.y * cb - yb.x * sb};
        }
    }
    __syncthreads();
#pragma unroll 1
    for (int s = 0; s < 6; ++s) {
        const int lq = 10 - 2 * s;
        const int Lq = 1 << lq;
        const float invL = 1.f / (float)(4 << lq);
#pragma unroll 2
        for (int i = 0; i < 4; ++i) {
            const int b = tid + NTHR * i, j = b & (Lq - 1), base = ((b >> lq) << (lq + 2)) + j;
            const f32x2 a0 = X[base], a1 = X[base + Lq], a2 = X[base + 2 * Lq], a3 = X[base + 3 * Lq];
            const f32x2 s02 = a0 + a2, d02 = a0 - a2, s13 = a1 + a3, d13 = a1 - a3;
            const f32x2 y0 = s02 + s13, y2 = s02 - s13;
            const f32x2 y1 = (f32x2){d02.x + d13.y, d02.y - d13.x};
            const f32x2 y3 = (f32x2){d02.x - d13.y, d02.y + d13.x};
            const float f1 = (float)j * invL;
            const float c1 = __builtin_amdgcn_cosf(f1), s1 = __builtin_amdgcn_sinf(f1);
            const float c2 = __builtin_amdgcn_cosf(2.f * f1), s2 = __builtin_amdgcn_sinf(2.f * f1);
            const float c3 = __builtin_amdgcn_cosf(3.f * f1), s3 = __builtin_amdgcn_sinf(3.f * f1);
            X[base] = y0;
            X[base + Lq] = (f32x2){y1.x * c1 + y1.y * s1, y1.y * c1 - y1.x * s1};
            X[base + 2 * Lq] = (f32x2){y2.x * c2 + y2.y * s2, y2.y * c2 - y2.x * s2};
            X[base + 3 * Lq] = (f32x2){y3.x * c3 + y3.y * s3, y3.y * c3 - y3.x * s3};
        }
        __syncthreads();
    }
    const int col = 64 * g + 2 * mm;
#pragma unroll 1
    for (int i = 0; i < 16; ++i) {
        const int k = 2 * (tid + NTHR * i) + par, kn = (NTOK - k) & (NTOK - 1);
        const f32x2 wk = X[(((k & 3) - par) >> 1) * 4096 + rev4_12((unsigned)(k >> 2))], wn = X[(((kn & 3) - par) >> 1) * 4096 + rev4_12((unsigned)(kn >> 2))];
        float o0, o1;
        if (mm == 0) { o0 = 0.5f * (wk.x + wn.x); o1 = 0.5f * (wk.y + wn.y); }
        else { o0 = wn.x; o1 = wk.x; }
        *(unsigned*)(MIX + (size_t)k * DM + col) = pk2(o0, o1);
    }
    __syncthreads();
}

struct P3Prob {
    static constexpr int K = DM; static constexpr bool PERM = false;
    const bf16* MIX; const bf16* WoT; const float* x; const float* g1; float* X1; pg8::StaticOrder so;
    __device__ __forceinline__ bool next(int i, pg8::Unit& u) const { return so.next(i, u); }
    __device__ __forceinline__ const char* aptr(const pg8::Unit& u) const { return (const char*)(MIX + (size_t)u.pm * 256 * DM); }
    __device__ __forceinline__ const char* bptr(const pg8::Unit& u) const { return (const char*)(WoT + (size_t)u.pn * 256 * DM); }
    __device__ __forceinline__ void epi(const pg8::f32x4 (&acc)[2][2][4][2], const pg8::Unit& u, int wr, int wc, int fr, int fq) const {
        const int col0 = u.pn * 256 + wc * 32 + 4 * fq;
        pg8::f32x4 gv[2][2];
#pragma unroll
        for (int bj = 0; bj < 2; ++bj)
#pragma unroll
            for (int n = 0; n < 2; ++n) gv[bj][n] = *(const pg8::f32x4*)(g1 + col0 + bj * 128 + n * 16);
#pragma unroll
        for (int ai = 0; ai < 2; ++ai)
#pragma unroll
            for (int m = 0; m < 4; ++m) { const size_t off = (size_t)(u.pm * 256 + ai * 128 + wr * 64 + m * 16 + fr) * DM + col0;
#pragma unroll
                for (int bj = 0; bj < 2; ++bj)
#pragma unroll
                    for (int n = 0; n < 2; ++n) { const pg8::f32x4 bs = *(const pg8::f32x4*)(x + off + bj * 128 + n * 16); *(pg8::f32x4*)(X1 + off + bj * 128 + n * 16) = bs + gv[bj][n] * acc[ai][bj][m][n]; }
                if (m & 1) asm volatile("" ::: "memory"); }
    }
};

__device__ __forceinline__ void p3b_router(const Args& a, LAS unsigned char* lds, int vcu, int G, int wave) {
    const int lane = fresh_lane(), tid = wave * 64 + lane;
    unsigned char* ws = a.ws; const float* MOD = (const float*)(ws + WS_MOD); const float* X1 = (const float*)(ws + WS_X1); bf16* H2 = (bf16*)(ws + WS_H2); float* AFF = (float*)(ws + WS_AFF);
    LAS float* wrt = (LAS float*)lds;
    { f32x4 t[8];
#pragma unroll
      for (int q = 0; q < 8; ++q) t[q] = *(const f32x4*)(a.w_router + 4 * (tid + NTHR * q));
#pragma unroll
      for (int q = 0; q < 8; ++q) { const int i = 4 * (tid + NTHR * q), col = i >> 4, e = i & 15;
#pragma unroll
          for (int k = 0; k < 4; ++k) wrt[(e + k) * 1024 + col] = t[q][k]; } }
    __syncthreads();
    f32x4 av[4], sh[4];
#pragma unroll
    for (int j = 0; j < 4; ++j) { const int col = 4 * lane + 256 * j; const f32x4 g = *(const f32x4*)(a.norm_ffn_g + col); const f32x4 sc = *(const f32x4*)(MOD + 4 * DM + col); av[j] = g * (sc + 1.f); sh[j] = *(const f32x4*)(MOD + 3 * DM + col); }
    const int gw = vcu * NWAVES + wave, NGW = G * NWAVES;
    f32x4 v[4], vn[4];
    if (gw < NTOK) { const GAS f32x4* xr = (const GAS f32x4*)(X1 + (size_t)gw * DM) + lane;
#pragma unroll
        for (int j = 0; j < 4; ++j) v[j] = xr[64 * j]; }
    for (int m = gw; m < NTOK; m += NGW) {
        const int mn = m + NGW;
        if (mn < NTOK) { const GAS f32x4* xr = (const GAS f32x4*)(X1 + (size_t)mn * DM) + lane;
#pragma unroll
            for (int j = 0; j < 4; ++j) vn[j] = xr[64 * j]; }
        float s = 0.f;
#pragma unroll
        for (int j = 0; j < 4; ++j) s += (v[j].x * v[j].x + v[j].y * v[j].y) + (v[j].z * v[j].z + v[j].w * v[j].w);
        const float rinv = 1.f / sqrtf(wave_sum(s) * (1.f / DM) + EPS);
        GAS unsigned long long* o8 = (GAS unsigned long long*)(H2 + (size_t)m * DM) + lane;
#pragma unroll
        for (int j = 0; j < 4; ++j) { v[j] = v[j] * rinv * av[j] + sh[j]; o8[64 * j] = (unsigned long long)pk2(v[j].x, v[j].y) | ((unsigned long long)pk2(v[j].z, v[j].w) << 32); }
        float lg[16];
#pragma unroll
        for (int e0 = 0; e0 < 16; e0 += 4) {
#pragma unroll
            for (int e = e0; e < e0 + 4; ++e) { float p = 0.f;
#pragma unroll
                for (int j = 0; j < 4; ++j) { const f32x4 w = *(const LAS f32x4*)(wrt + e * 1024 + 4 * lane + 256 * j); p += (v[j].x * w.x + v[j].y * w.y) + (v[j].z * w.z + v[j].w * w.w); }
                lg[e] = p; }
            asm volatile("" ::: "memory"); }
        float r8[8], r4[4], r2[2], r1;
        { const bool up = (lane & 32) != 0;
#pragma unroll
          for (int e = 0; e < 8; ++e) { const float snd = up ? lg[e] : lg[e + 8], kp = up ? lg[e + 8] : lg[e]; r8[e] = kp + __shfl_xor(snd, 32); } }
        { const bool up = (lane & 16) != 0;
#pragma unroll
          for (int e = 0; e < 4; ++e) { const float snd = up ? r8[e] : r8[e + 4], kp = up ? r8[e + 4] : r8[e]; r4[e] = kp + __shfl_xor(snd, 16); } }
        { const bool up = (lane & 8) != 0;
#pragma unroll
          for (int e = 0; e < 2; ++e) { const float snd = up ? r4[e] : r4[e + 2], kp = up ? r4[e + 2] : r4[e]; r2[e] = kp + __shfl_xor(snd, 8); } }
        { const bool up = (lane & 4) != 0; const float snd = up ? r2[0] : r2[1], kp = up ? r2[1] : r2[0]; r1 = kp + __shfl_xor(snd, 4); }
        r1 += __shfl_xor(r1, 2); r1 += __shfl_xor(r1, 1);
        float mx = r1;
#pragma unroll
        for (int o = 4; o < 64; o <<= 1) mx = fmaxf(mx, __shfl_xor(mx, o));
        const float ex = __expf(r1 - mx); float den = ex;
#pragma unroll
        for (int o = 4; o < 64; o <<= 1) den += __shfl_xor(den, o);
        if ((lane & 3) == 0) AFF[(size_t)(lane >> 2) * NTOK + m] = ex / den;
#pragma unroll
        for (int j = 0; j < 4; ++j) v[j] = vn[j];
    }
}

__device__ __forceinline__ void p4_topk(const Args& a, LAS unsigned char* lds, int e, int wave) {
    const int lane = fresh_lane(), tid = wave * 64 + lane;
    unsigned char* ws = a.ws; const unsigned* AFF = (const unsigned*)(ws + WS_AFF) + (size_t)e * NTOK;
    int* IDX = (int*)(ws + WS_IDX) + e * CAP; float* GATE = (float*)(ws + WS_GATE) + e * CAP; int* TOKSLOT = (int*)(ws + WS_TOKSLOT);
    LAS unsigned* wcnt = (LAS unsigned*)lds;
    LAS unsigned* cg = wcnt + 16;
    LAS unsigned* ce = cg + 256;
    unsigned key[32];
#pragma unroll
    for (int i = 0; i < 32; ++i) key[i] = AFF[i * NTHR + tid];
    unsigned T = 0u;
#pragma unroll 1
    for (int bit = 30; bit >= 0; --bit) {
        const unsigned cand = T | (1u << bit);
        unsigned c = 0u;
#pragma unroll
        for (int i = 0; i < 32; ++i) c += (unsigned)__popcll(__ballot(key[i] >= cand));
        LAS unsigned* wb = wcnt + 1024 + (bit & 1) * 8;
        if (lane == 0) wb[wave] = c;
        __syncthreads();
        unsigned tot = 0u;
#pragma unroll
        for (int w = 0; w < 8; ++w) tot += wb[w];
        if (tot >= (unsigned)CAP) T = cand;
    }
    __syncthreads();
    unsigned long long below = (1ull << lane) - 1ull;
    unsigned rg[32], rq[32];
#pragma unroll
    for (int i = 0; i < 32; ++i) {
        const unsigned long long bg = __ballot(key[i] > T), bq = __ballot(key[i] == T);
        rg[i] = (unsigned)__popcll(bg & below); rq[i] = (unsigned)__popcll(bq & below);
        if (lane == 0) { cg[i * 8 + wave] = (unsigned)__popcll(bg); ce[i * 8 + wave] = (unsigned)__popcll(bq); }
    }
    __syncthreads();
    if (wave == 0) {
        unsigned g4[4], q4[4], sg = 0u, sq = 0u;
#pragma unroll
        for (int k = 0; k < 4; ++k) { g4[k] = cg[4 * lane + k]; q4[k] = ce[4 * lane + k]; sg += g4[k]; sq += q4[k]; }
        unsigned pg = sg, pq = sq;
#pragma unroll
        for (int o = 1; o < 64; o <<= 1) { const unsigned tg = __shfl_up(pg, o), tq = __shfl_up(pq, o); if (lane >= o) { pg += tg; pq += tq; } }
        pg -= sg; pq -= sq;
#pragma unroll
        for (int k = 0; k < 4; ++k) { cg[4 * lane + k] = pg; ce[4 * lane + k] = pq; pg += g4[k]; pq += q4[k]; }
        if (lane == 63) { wcnt[8] = pg; }
    }
    __syncthreads();
    const unsigned ngt = wcnt[8], need = (unsigned)CAP - ngt;
#pragma unroll
    for (int i = 0; i < 32; ++i) {
        const int tok = i * NTHR + tid;
        const unsigned gb = cg[i * 8 + wave] + rg[i], qb = ce[i * 8 + wave] + rq[i];
        const bool sel = key[i] > T || (key[i] == T && qb < need);
        const unsigned slot = gb + (qb < need ? qb : need);
        if (sel) { IDX[slot] = tok; GATE[slot] = __uint_as_float(key[i]); }
        TOKSLOT[tok * 16 + e] = sel ? (int)slot : -1;
    }
}

struct P5Prob {
    static constexpr int K = DM; static constexpr bool PERM = true;
    const bf16* H2; const bf16* WguT; bf16* HID; pg8::StaticOrder so;
    __device__ __forceinline__ bool next(int i, pg8::Unit& u) const { return so.next(i, u); }
    __device__ __forceinline__ const char* aptr(const pg8::Unit&) const { return (const char*)H2; }
    __device__ __forceinline__ const char* bptr(const pg8::Unit& u) const { return (const char*)(WguT + ((size_t)(u.pm >> 3) * 4096 + (size_t)u.pn * 256) * DM); }
    __device__ __forceinline__ void epi(const pg8::f32x4 (&acc)[2][2][4][2], const pg8::Unit& u, int wr, int wc, int fr, int fq) const {
#pragma unroll
        for (int ai = 0; ai < 2; ++ai)
#pragma unroll
            for (int m = 0; m < 4; ++m) { bf16* rowp = HID + (size_t)(u.pm * 256 + ai * 128 + wr * 64 + m * 16 + fr) * DE + u.pn * 128 + wc * 32 + 8 * fq;
                float h[8];
#pragma unroll
                for (int n = 0; n < 2; ++n)
#pragma unroll
                    for (int e = 0; e < 4; ++e) { const float gt = acc[ai][0][m][n][e], up = acc[ai][1][m][n][e]; h[4 * n + e] = gt * __builtin_amdgcn_rcpf(1.f + __builtin_amdgcn_exp2f(-1.4426950408889634f * gt)) * up; }
                *(v4u*)rowp = (v4u){pk2(h[0], h[1]), pk2(h[2], h[3]), pk2(h[4], h[5]), pk2(h[6], h[7])}; }
    }
};
struct P6Prob {
    static constexpr int K = DE; static constexpr bool PERM = true;
    const bf16* HID; const bf16* WdT; const float* GATE; bf16* YE; pg8::StaticOrder so;
    __device__ __forceinline__ bool next(int i, pg8::Unit& u) const { return so.next(i, u); }
    __device__ __forceinline__ const char* aptr(const pg8::Unit& u) const { return (const char*)(HID + (size_t)u.pm * 256 * DE); }
    __device__ __forceinline__ const char* bptr(const pg8::Unit& u) const { return (const char*)(WdT + ((size_t)(u.pm >> 3) * DM + (size_t)u.pn * 256) * DE); }
    __device__ __forceinline__ void epi(const pg8::f32x4 (&acc)[2][2][4][2], const pg8::Unit& u, int wr, int wc, int fr, int fq) const {
#pragma unroll
        for (int ai = 0; ai < 2; ++ai)
#pragma unroll
            for (int m = 0; m < 4; ++m) { const int row = u.pm * 256 + ai * 128 + wr * 64 + m * 16 + fr; const float gt = GATE[row]; bf16* rowp = YE + (size_t)row * DM + u.pn * 256 + wc * 32 + 8 * fq;
#pragma unroll
                for (int bj = 0; bj < 2; ++bj) { const pg8::f32x4 v0 = acc[ai][bj][m][0] * gt, v1 = acc[ai][bj][m][1] * gt;
                    *(v4u*)(rowp + bj * 128) = (v4u){pk2(v0[0], v0[1]), pk2(v0[2], v0[3]), pk2(v1[0], v1[1]), pk2(v1[2], v1[3])}; } }
    }
};

__device__ __forceinline__ void p7_final(const Args& a, int vcu, int G, int wave, unsigned poison) {
    const int lane = fresh_lane();
    unsigned char* ws = a.ws; const float* MOD = (const float*)(ws + WS_MOD); const bf16* YE = (const bf16*)(ws + WS_YE); const int* TOKSLOT = (const int*)(ws + WS_TOKSLOT);
    const float* src = (STEP >= 2) ? (const float*)(ws + WS_X1) : a.x;
    f32x4 g2[4], fg[4];
#pragma unroll
    for (int j = 0; j < 4; ++j) { const int col = 4 * lane + 256 * j; g2[j] = *(const f32x4*)(MOD + 5 * DM + col); fg[j] = *(const f32x4*)(a.final_norm_g + col); }
    const int gw = vcu * NWAVES + wave, NGW = G * NWAVES;
    for (int m = gw; m < NTOK; m += NGW) {
        const GAS f32x4* xr = (const GAS f32x4*)(src + (size_t)m * DM) + lane;
        f32x4 v[4];
#pragma unroll
        for (int j = 0; j < 4; ++j) v[j] = xr[64 * j];
        if (STEP >= 4) {
            const int myslot = lane < 16 ? TOKSLOT[m * 16 + lane] : -1;
            f32x4 s[4];
#pragma unroll
            for (int j = 0; j < 4; ++j) s[j] = (f32x4){0.f, 0.f, 0.f, 0.f};
#pragma unroll 1
            for (int e = 0; e < 16; ++e) {
                const int sl = __builtin_amdgcn_readlane(myslot, e);
                if (sl >= 0) {
                    const GAS v2u* yr = (const GAS v2u*)(YE + ((size_t)e * CAP + sl) * DM) + lane;
#pragma unroll
                    for (int j = 0; j < 4; ++j) { const v2u w = yr[64 * j]; s[j].x += __uint_as_float(w.x << 16); s[j].y += __uint_as_float(w.x & 0xffff0000u); s[j].z += __uint_as_float(w.y << 16); s[j].w += __uint_as_float(w.y & 0xffff0000u); }
                }
            }
#pragma unroll
            for (int j = 0; j < 4; ++j) v[j] += g2[j] * s[j];
        }
        float ss = 0.f;
#pragma unroll
        for (int j = 0; j < 4; ++j) ss += (v[j].x * v[j].x + v[j].y * v[j].y) + (v[j].z * v[j].z + v[j].w * v[j].w);
        const float rinv = 1.f / sqrtf(wave_sum(ss) * (1.f / DM) + EPS);
        GAS f32x4* o = (GAS f32x4*)(a.out + (size_t)m * DM) + lane;
        const float q = __builtin_nanf("");
#pragma unroll
        for (int j = 0; j < 4; ++j) { f32x4 y = v[j] * rinv * fg[j]; if (poison) y = (f32x4){q, q, q, q}; o[64 * j] = y; }
    }
}


#if PROBE
__device__ __forceinline__ void dsincos(double x, double& sn, double& cs) {
    const double TWO_PI = 6.283185307179586476925286766559; x -= TWO_PI * rint(x / TWO_PI);
    const double x2 = x * x; double ts = x, tc = 1.0; sn = x; cs = 1.0;
#pragma unroll 1
    for (int k = 1; k <= 14; ++k) { tc *= -x2 / (double)((2 * k - 1) * (2 * k)); ts *= -x2 / (double)((2 * k) * (2 * k + 1)); cs += tc; sn += ts; }
}
__device__ __forceinline__ float block_sum(float v, LAS float* red, int wave, int lane) {
    v = wave_sum(v); __syncthreads(); if (lane == 0) red[wave] = v; __syncthreads(); float s = 0.f;
#pragma unroll
    for (int w = 0; w < 8; ++w) s += red[w];
    return s;
}
__device__ __forceinline__ float block_max(float v, LAS float* red, int wave, int lane) {
#pragma unroll
    for (int o = 1; o < 64; o <<= 1) v = fmaxf(v, __shfl_xor(v, o));
    __syncthreads(); if (lane == 0) red[wave] = v; __syncthreads(); float s = red[0];
#pragma unroll
    for (int w = 1; w < 8; ++w) s = fmaxf(s, red[w]);
    return s;
}
__device__ __forceinline__ void probe_qkv(const Args& a, LAS unsigned char* lds, int vcu, int wave) {
    const int lane = fresh_lane(), tid = wave * 64 + lane; unsigned char* ws = a.ws;
    const bf16* XN = (const bf16*)(ws + WS_XN); const bf16* Qb = (const bf16*)(ws + WS_Q); const bf16* Kb = (const bf16*)(ws + WS_K); const bf16* Vb = (const bf16*)(ws + WS_V);
    gu32* ctl = (gu32*)(ws + WS_CTL);
    LAS float* red = (LAS float*)lds; LAS float* raw = red + 16;
    for (int kind = 0; kind < 3; ++kind) {
        const int nrows = kind == 0 ? NTOK : NROWS, nh = kind == 0 ? NHQ : NHKV;
        const int t = (kind == 1 && (vcu & 7) == 3) ? NTOK + (vcu * 37) % NCTX : (vcu * 977 + 131 * kind + 5) % (kind == 0 ? NTOK : NTOK);
        const int h = (vcu * 5 + kind) % nh;
        const int wcol0 = 256 + (kind == 0 ? 0 : (kind == 1 ? 768 : 1024)) + 64 * h;
        { const int d = tid & 63, part = tid >> 6; float sacc = 0.f;
          for (int k = part * 128; k < part * 128 + 128; ++k) sacc += bf2f(XN[(size_t)t * DM + k]) * a.w_in[(size_t)k * INW + wcol0 + d];
          LAS float* part_s = raw + 64; part_s[part * 64 + d] = sacc; __syncthreads();
          if (tid < 64) { float s2 = 0.f; for (int pp = 0; pp < 8; ++pp) s2 += part_s[pp * 64 + tid]; raw[tid] = s2; }
          __syncthreads(); }
        float ref = 0.f, got = 0.f;
        if (tid < 64) {
            const int d = tid; float v = raw[d];
            if (kind < 2) {
                float ss = 0.f; for (int j = 0; j < 64; ++j) ss += raw[j] * raw[j];
                const float* gw = kind == 0 ? a.q_norm_g : a.k_norm_g;
                const float rinv = 1.f / sqrtf(ss / 64.f + EPS);
                if (t < NTOK) {
                    const int half = d >> 5, dd = d & 31, i = dd & 15; const int pos = half == 0 ? (t >> 6) : (t & 63);
                    const double freq = exp2(-(double)i * (13.287712379549449 / 16.0)); double sn, cs; dsincos((double)pos * freq, sn, cs);
                    const float x1 = raw[32 * half + i] * rinv * gw[32 * half + i], x2 = raw[32 * half + 16 + i] * rinv * gw[32 * half + 16 + i];
                    v = dd < 16 ? (float)(x1 * cs - x2 * sn) : (float)(x1 * sn + x2 * cs);
                } else v = v * rinv * gw[d];
                if (kind == 0) v *= attn_body::C2;
            }
            ref = v;
            got = kind == 0 ? bf2f(Qb[(size_t)t * 768 + 64 * h + d]) : (kind == 1 ? bf2f(Kb[(size_t)t * 256 + 64 * h + d]) : bf2f(Vb[(size_t)t * 256 + 64 * h + d]));
        }
        const float mx = block_max(fabsf(ref), red, wave, lane);
        const float err = block_max(fabsf(ref - got), red, wave, lane);
        if (tid == 0 && !(err <= 0.03f * mx + 1e-6f)) __hip_atomic_fetch_or(ctl + CW_FLAG, 1u << kind, RLX_AGENT);
        __syncthreads();
    }
}
__device__ __forceinline__ void probe_attn(const Args& a, LAS unsigned char* lds, int vcu, int wave) {
    const int lane = fresh_lane(), tid = wave * 64 + lane; unsigned char* ws = a.ws;
    const bf16* Qb = (const bf16*)(ws + WS_Q); const bf16* Kb = (const bf16*)(ws + WS_K); const bf16* Vb = (const bf16*)(ws + WS_V); const bf16* MIX = (const bf16*)(ws + WS_MIX);
    gu32* ctl = (gu32*)(ws + WS_CTL);
    LAS float* red = (LAS float*)lds; LAS float* ored = red + 16;
    const int t = (vcu * 613 + 29) % NTOK, h = (vcu * 7 + 3) % NHQ, kvh = h / 3;
    float q[64];
#pragma unroll
    for (int d = 0; d < 64; ++d) q[d] = bf2f(Qb[(size_t)t * 768 + 64 * h + d]);
    float sc[33]; float mx = -1e30f;
#pragma unroll
    for (int i = 0; i < 33; ++i) { const int key = i * NTHR + tid; float s = -1e30f;
        if (key < NKEYS) { s = 0.f; const bf16* kr = Kb + (size_t)key * 256 + 64 * kvh;
#pragma unroll
            for (int d = 0; d < 64; ++d) s += q[d] * bf2f(kr[d]); }
        sc[i] = s; mx = fmaxf(mx, s); }
    mx = block_max(mx, red, wave, lane);
    float den = 0.f; float o[64];
#pragma unroll
    for (int d = 0; d < 64; ++d) o[d] = 0.f;
#pragma unroll
    for (int i = 0; i < 33; ++i) { const int key = i * NTHR + tid;
        if (key < NKEYS) { const float pp = exp2f(sc[i] - mx); den += pp; const bf16* vr = Vb + (size_t)key * 256 + 64 * kvh;
#pragma unroll
            for (int d = 0; d < 64; ++d) o[d] += pp * bf2f(vr[d]); } }
    den = block_sum(den, red, wave, lane);
#pragma unroll
    for (int d = 0; d < 64; ++d) { const float w = wave_sum(o[d]); if (lane == 0) ored[wave * 64 + d] = w; }
    __syncthreads();
    float ref = 0.f, got = 0.f;
    if (tid < 64) { float s = 0.f; for (int w = 0; w < 8; ++w) s += ored[w * 64 + tid]; ref = s / den; got = bf2f(MIX[(size_t)t * DM + 256 + 64 * h + tid]); }
    const float m2 = block_max(fabsf(ref), red, wave, lane);
    const float err = block_max(fabsf(ref - got), red, wave, lane);
    if (tid == 0 && !(err <= 0.03f * m2 + 1e-7f)) __hip_atomic_fetch_or(ctl + CW_FLAG, 8u, RLX_AGENT);
    __syncthreads();
}
#endif

__global__ void __launch_bounds__(NTHR, 2) fwd_megakernel(Args args) {
    extern __shared__ __attribute__((aligned(16))) unsigned char lds_raw[];
    LAS unsigned char* lds = (LAS unsigned char*)lds_raw;
    volatile LAS unsigned* MISC = (volatile LAS unsigned*)(lds + MISC_OFF);
    const int wave = __builtin_amdgcn_readfirstlane(threadIdx.x >> 6);
    const int G = gridDim.x; const int bx = blockIdx.x; const int vcu = (G % 8 == 0) ? (bx % 8) * (G / 8) + bx / 8 : bx;
    unsigned char* ws = args.ws;
    gu32* ctl = (gu32*)(ws + WS_CTL);
    { const int l0 = fresh_lane(); if (wave < 2) ((LAS unsigned*)(lds + MISC_OFF))[wave * 64 + l0] = 0u;
      __syncthreads();
    }
    XcdBarrier bar = xcd_barrier_post((unsigned*)(ctl + CW_BAR), MISC + 8, wave == 0 && fresh_lane() == 0);
#define GRID_BAR() xcd_barrier(bar, wave)

    for (int rep = 0; rep < REP(0); ++rep) {
    if (STEP >= 2 && PH(0)) p0_prologue(args, lds, vcu, G, wave);
    GRID_BAR(); }
    for (int rep = 0; rep < REP(1); ++rep) {
    if (STEP >= 2 && PH(1)) p0b_modulate(args, vcu, G, wave);
    GRID_BAR(); }
    for (int rep = 0; rep < REP(2); ++rep) {
    if (STEP >= 2 && PH(2)) {
        P1Prob p; p.XN = (bf16*)(ws + WS_XN); p.WinT = (bf16*)(ws + WS_WIN); p.Q = (bf16*)(ws + WS_Q); p.Kb = (bf16*)(ws + WS_K); p.Vb = (bf16*)(ws + WS_V); p.FT = (float*)(ws + WS_FT);
        p.qg = args.q_norm_g; p.kg = args.k_norm_g; p.kmax = (unsigned*)(ctl + CW_KMAX); p.so.init(NROWS / 256, INW / 256, G, bx);
        pg8::gemm_phase<P1Prob, false, true, true>(lds, p, nullptr, wave);
        if (rep == 0 && MOE_S1 > 0) {
            const int nwg = (NROWS / 256) * (INW / 256), maxc = (nwg + G - 1) / G, c0 = nwg - (maxc - 1) * G;
            if (c0 >= G) moe_convert(args, (LAS float*)(lds + wave * 16640), MOE_B0, MOE_B1, bx * NWAVES + wave, G * NWAVES);
            else if (bx >= c0) moe_convert(args, (LAS float*)(lds + wave * 16640), MOE_B0, MOE_B1, (bx - c0) * NWAVES + wave, (G - c0) * NWAVES);
        }
    }
    GRID_BAR(); }
#if PROBE == 1
    probe_qkv(args, lds, vcu, wave);
#endif
    for (int rep = 0; rep < REP(3); ++rep) {
    if (STEP >= 2 && PH(3)) {
        for (int item = vcu; item < 256; item += G) fft_block(args, lds, item, wave);
        if (rep == 0 && MOE_S2 > 0) {
            if (G > 256) { if (vcu >= 256) moe_convert(args, (LAS float*)(lds + wave * 16640), MOE_B1, MOE_B2, (vcu - 256) * NWAVES + wave, (G - 256) * NWAVES); }
            else moe_convert(args, (LAS float*)(lds + wave * 16640), MOE_B1, MOE_B2, vcu * NWAVES + wave, G * NWAVES);
        }
    }
    if (rep + 1 < REP(3)) GRID_BAR(); }
    for (int rep = 0; rep < REP(4); ++rep) {
    if (STEP >= 3 && PH(4)) {
        const attn_body::bf16* Qb = (const attn_body::bf16*)(ws + WS_Q); const attn_body::bf16* Kb = (const attn_body::bf16*)(ws + WS_K); const attn_body::bf16* Vb = (const attn_body::bf16*)(ws + WS_V);
        attn_body::bf16* MIX = (attn_body::bf16*)(ws + WS_MIX);
        const float kmax2 = __uint_as_float(__hip_atomic_load(ctl + CW_KMAX, RLX_AGENT));
        const int u0 = (G == 256) ? vcu * 3 : vcu, ustep = (G == 256) ? 1 : G, uend = (G == 256) ? vcu * 3 + 3 : 768;
#pragma unroll 1
        for (int u = u0; u < uend; u += ustep) {
            const int kvh = u / 192, w = u % 192, h = kvh * 3 + w / 64, qb = w % 64;
            attn_body::attn_unit<8>(h, kvh, qb, Qb, Kb, Vb, MIX, (char*)lds_raw, wave, kmax2);
        }
    } else if (STEP == 2) {
        bf16* MIX = (bf16*)(ws + WS_MIX);
        const int gw = vcu * NWAVES + wave, NGW = G * NWAVES, lane = fresh_lane();
        for (int m = gw; m < NTOK; m += NGW) { GAS v4u* o = (GAS v4u*)(MIX + (size_t)m * DM + 256); o[lane] = (v4u){0u, 0u, 0u, 0u}; if (lane < 32) o[64 + lane] = (v4u){0u, 0u, 0u, 0u}; }
    }
    GRID_BAR(); }
#if PROBE == 2
    probe_attn(args, lds, vcu, wave);
#endif
    for (int rep = 0; rep < REP(5); ++rep) {
    if (STEP >= 2 && PH(5)) {
        P3Prob p; p.MIX = (bf16*)(ws + WS_MIX); p.WoT = (bf16*)(ws + WS_WOUT); p.x = args.x; p.g1 = (const float*)(ws + WS_MOD) + 2 * DM; p.X1 = (float*)(ws + WS_X1); p.so.init(NTOK / 256, DM / 256, G, bx);
        pg8::gemm_phase<P3Prob, false, true, true>(lds, p, nullptr, wave);
    }
    GRID_BAR(); }
    for (int rep = 0; rep < REP(6); ++rep) {
    if (STEP >= 4 && PH(6)) p3b_router(args, lds, vcu, G, wave);
    GRID_BAR(); }
    for (int rep = 0; rep < REP(7); ++rep) {
    if (STEP >= 4 && PH(7)) {
#pragma unroll 1
        for (int e = vcu; e < NE; e += G) p4_topk(args, lds, e, wave);
        if (rep == 0) {
            if (G > NE) { if (vcu >= NE) moe_convert(args, (LAS float*)(lds + wave * 16640), MOE_B2, MOE_ITEMS, (vcu - NE) * NWAVES + wave, (G - NE) * NWAVES); }
            else moe_convert(args, (LAS float*)(lds + wave * 16640), MOE_B2, MOE_ITEMS, vcu * NWAVES + wave, G * NWAVES);
        } }
    GRID_BAR(); }
    for (int rep = 0; rep < REP(8); ++rep) {
    if (STEP >= 4 && PH(8)) {
        P5Prob p; p.H2 = (bf16*)(ws + WS_H2); p.WguT = (bf16*)(ws + WS_WGU); p.HID = (bf16*)(ws + WS_HID); p.so.init(NE * CAP / 256, 2 * DE / 256, G, bx);
        LAS unsigned* rowtab = (LAS unsigned*)(lds + XTRA_OFF);
        const int* IDX = (const int*)(ws + WS_IDX);
        { const int tid = wave * 64 + fresh_lane(); pg8::Unit u; for (int i = 0; p.so.next(i, u) && i < 28; ++i) { if (tid < 256) rowtab[i * 256 + tid] = (unsigned)IDX[u.pm * 256 + tid]; } }
        __syncthreads();
        pg8::gemm_phase<P5Prob, true, true, true>(lds, p, rowtab, wave);
    }
    GRID_BAR(); }
    for (int rep = 0; rep < REP(9); ++rep) {
    if (STEP >= 4 && PH(9)) {
        P6Prob p; p.HID = (bf16*)(ws + WS_HID); p.WdT = (bf16*)(ws + WS_WD); p.GATE = (const float*)(ws + WS_GATE); p.YE = (bf16*)(ws + WS_YE); p.so.init(NE * CAP / 256, DM / 256, G, bx);
        pg8::gemm_phase<P6Prob, false, true, true>(lds, p, nullptr, wave);
    }
    GRID_BAR(); }
    {
        unsigned poison = (__hip_atomic_load(ctl + CW_BAR + XB_TMO, RLX_AGENT) != 0u) || (__hip_atomic_load(ctl + CW_FLAG, RLX_AGENT) != 0u);
        for (int rep = 0; rep < REP(10); ++rep) p7_final(args, vcu, G, wave, poison);
    }
}

extern "C" void kernel_launch(void* const* d_in, const int* in_sizes, int n_in, void* d_out, int out_size, void* d_ws, size_t ws_size, hipStream_t stream) {
    static int grid = 0;
    if (grid == 0) {
        if (n_in != 18 || in_sizes[0] != NTOK * DM || out_size != NTOK * DM || ws_size < WS_END) { fprintf(stderr, "kernel_launch: unexpected shapes (n_in %d, in0 %d, out %d, ws %zu)\n", n_in, n_in > 0 ? in_sizes[0] : -1, out_size, ws_size); grid = -1; return; }
        int dev = 0, cus = 0, per_cu = 0;
        if (hipGetDevice(&dev) != hipSuccess || hipDeviceGetAttribute(&cus, hipDeviceAttributeMultiprocessorCount, dev) != hipSuccess) { grid = -1; return; }
        if (hipFuncSetAttribute((const void*)fwd_megakernel, hipFuncAttributeMaxDynamicSharedMemorySize, LDS_BYTES) != hipSuccess) { fprintf(stderr, "kernel_launch: hipFuncSetAttribute failed\n"); grid = -1; return; }
        if (hipOccupancyMaxActiveBlocksPerMultiprocessor(&per_cu, (const void*)fwd_megakernel, NTHR, LDS_BYTES) != hipSuccess || per_cu < 1) { fprintf(stderr, "kernel_launch: occupancy query says %d blocks per CU\n", per_cu); (void)hipGetLastError(); grid = -1; return; }
        grid = cus;
    }
    if (grid < 0) return;
    (void)hipMemsetAsync((char*)d_ws + WS_CTL, 0, CTL_ZERO_BYTES, stream);
    Args a{};
    const float** f = (const float**)&a;
    for (int i = 0; i < 18; ++i) f[i] = (const float*)d_in[i];
    a.out = (float*)d_out; a.ws = (unsigned char*)d_ws;
    hipLaunchKernelGGL(fwd_megakernel, dim3(grid), dim3(NTHR), LDS_BYTES, stream, a);
}
```

```cpp
#include <hip/hip_runtime.h>
#include <hip/hip_bf16.h>
#include <cstdio>
#include <cstdint>
#include <cmath>

#ifndef STEP
#define STEP 4
#endif
#ifndef PROBE
#define PROBE 0
#endif
#ifndef PHMASK
#define PHMASK 0xFFFF
#endif
#define PH(k) ((PHMASK >> (k)) & 1)
#ifndef REPEAT
#define REPEAT 0
#endif
#define REP(k) (((REPEAT >> (k)) & 1) + 1)

constexpr int DM = 1024, NTOK = 16384, NCTX = 256, NROWS = NTOK + NCTX, INW = 1536;
constexpr int NHQ = 12, NHKV = 4, HD = 64, NE = 16, CAP = 2048, DE = 2048, NMOD = 6;
constexpr int NKEYS = NROWS;
constexpr float EPS = 1e-6f;

__device__ __forceinline__ int fresh_lane() { int l; asm volatile("v_mbcnt_lo_u32_b32 %0, -1, 0\n\tv_mbcnt_hi_u32_b32 %0, -1, %0" : "=v"(l)); return l; }

namespace pg8 {
#define PG8_LAS __attribute__((address_space(3)))
typedef unsigned short bf16_t;
typedef short bf16x8 __attribute__((ext_vector_type(8)));
typedef float f32x4 __attribute__((ext_vector_type(4)));
typedef unsigned u32x4 __attribute__((ext_vector_type(4)));
typedef unsigned u32x2 __attribute__((ext_vector_type(2)));
typedef int v8i __attribute__((ext_vector_type(8)));
constexpr int BM = 256, BK = 64, HALF = 128, HTB = HALF * BK * 2, STAGE_BYTES = 8 * HTB, NXCD = 8, WGM = 8;

__host__ __device__ __forceinline__ int lds_byte(int r, int c) { const int st = (r >> 4) * 2 + (c >> 5), rr = r & 15, cc = c & 31, ob = rr * 64 + cc * 2; return st * 1024 + (ob ^ (((ob >> 9) & 1) << 5)); }
__host__ __device__ __forceinline__ void stage_rc(int b, int& R, int& C) { const int st = b / 1024, sb = b % 1024, swz = sb ^ (((sb >> 9) & 1) << 5); R = (st >> 1) * 16 + swz / 64; C = (st & 1) * 32 + (swz % 64) / 2; }
__host__ __device__ __forceinline__ int perm32(int rho) { const int n = rho >> 4, i = rho & 15; return 8 * (i >> 2) + 4 * n + (i & 3); }

struct Unit { int pm, pn; };

struct StaticOrder {
    int nM, nN, nwg, G, c;
    __host__ __device__ void init(int nM_, int nN_, int G_, int c_) { nM = nM_; nN = nN_; nwg = nM * nN; G = G_; c = c_; }
    __host__ __device__ bool next(int i, Unit& u) const {
        const long L = (long)i * G + c; if (L >= nwg) return false;
        int wgid = (int)L; { const int q = nwg / NXCD, r = nwg % NXCD, xcd = wgid % NXCD, off = wgid / NXCD; wgid = (xcd < r ? xcd * (q + 1) : r * (q + 1) + (xcd - r) * q) + off; }
        const int nig = WGM * nN, gid = wgid / nig, fm = gid * WGM, gsz = (nM - fm) < WGM ? (nM - fm) : WGM;
        u.pm = fm + ((wgid % nig) % gsz); u.pn = (wgid % nig) / gsz; return true;
    }
};

__device__ __forceinline__ unsigned cvt_pk_bf16(float lo, float hi) { unsigned r; asm volatile("v_cvt_pk_bf16_f32 %0, %1, %2" : "=v"(r) : "v"(lo), "v"(hi)); return r; }

template <class P, bool GATHER, bool ALIGN_EPI, bool SP2>
__device__ __forceinline__ void gemm_phase(PG8_LAS unsigned char* lds, const P& S, const PG8_LAS unsigned* rowtab, int wid) {
    const int lane = fresh_lane(), tid = wid * 64 + lane, wr = wid >> 2, wc = wid & 3, fr = lane & 15, fq = lane >> 4;
    constexpr bool F8 = P::FP8; constexpr int ESZ = F8 ? 1 : 2;
    constexpr int K = P::K, nt = F8 ? K / 128 : K / BK;
    int R0, C0; stage_rc(tid * 16, R0, C0);
    unsigned voffB[2];
#pragma unroll
    for (int i = 0; i < 2; ++i) { const int R = R0 + 64 * i; const int Rb = P::PERM ? ((R & ~31) + perm32(R & 31)) : R; voffB[i] = (unsigned)(Rb * K * ESZ + C0 * 2); }
    constexpr size_t kstep = (size_t)(BK * 2);
    constexpr size_t hstep = (size_t)HALF * K * ESZ;
    const unsigned ldsw = (unsigned)wid * 1024u;
    const int aoff = F8 ? lds_byte(wr * 64 + fr, fq * 16) : lds_byte(wr * 64 + fr, fq * 8), boff = F8 ? lds_byte(wc * 32 + fr, fq * 16) : lds_byte(wc * 32 + fr, fq * 8);
#define PG8_SA(b, h) (((b) * 2 + (h)) * HTB)
#define PG8_SB(b, h) ((4 + (b) * 2 + (h)) * HTB)
#define PG8_STAGE(bufoff, gbase, voff) do { _Pragma("unroll") for (int _i = 0; _i < 2; ++_i) \
        __builtin_amdgcn_global_load_lds((const unsigned*)((const char*)(gbase) + (voff)[_i]), (PG8_LAS unsigned*)(lds + (bufoff) + ldsw + _i * 8192), 16, 0, 0); } while (0)
#define PG8_LDA(dst, b, h) do { if constexpr (F8) { _Pragma("unroll") for (int m = 0; m < 4; ++m) { const PG8_LAS u32x4* p_ = (const PG8_LAS u32x4*)(lds + PG8_SA(b, h) + aoff + m * 2048); const u32x4 lo_ = p_[0], hi_ = p_[1]; \
            dst##8[m] = (v8i){(int)lo_.x, (int)lo_.y, (int)lo_.z, (int)lo_.w, (int)hi_.x, (int)hi_.y, (int)hi_.z, (int)hi_.w}; } } \
        else { _Pragma("unroll") for (int m = 0; m < 4; ++m) _Pragma("unroll") for (int k = 0; k < 2; ++k) dst[m][k] = *(const PG8_LAS bf16x8*)(lds + PG8_SA(b, h) + aoff + m * 2048 + k * 1024); } } while (0)
#define PG8_LDB(dst, b, h) do { if constexpr (F8) { _Pragma("unroll") for (int n = 0; n < 2; ++n) { const PG8_LAS u32x4* p_ = (const PG8_LAS u32x4*)(lds + PG8_SB(b, h) + boff + n * 2048); const u32x4 lo_ = p_[0], hi_ = p_[1]; \
            dst##8[n] = (v8i){(int)lo_.x, (int)lo_.y, (int)lo_.z, (int)lo_.w, (int)hi_.x, (int)hi_.y, (int)hi_.z, (int)hi_.w}; } } \
        else { _Pragma("unroll") for (int n = 0; n < 2; ++n) _Pragma("unroll") for (int k = 0; k < 2; ++k) dst[n][k] = *(const PG8_LAS bf16x8*)(lds + PG8_SB(b, h) + boff + n * 2048 + k * 1024); } } while (0)
#define PG8_MMA(ai, bj, At, Bt) do { __builtin_amdgcn_s_setprio(1); if constexpr (F8) { \
        asm volatile("s_nop 1\n\t" \
            "v_mfma_scale_f32_16x16x128_f8f6f4 %0, %8, %10, %0, %14, %15 op_sel_hi:[0,0,0]\n\t" \
            "v_mfma_scale_f32_16x16x128_f8f6f4 %1, %9, %10, %1, %14, %15 op_sel_hi:[0,0,0]\n\t" \
            "v_mfma_scale_f32_16x16x128_f8f6f4 %2, %8, %11, %2, %14, %15 op_sel_hi:[0,0,0]\n\t" \
            "v_mfma_scale_f32_16x16x128_f8f6f4 %3, %9, %11, %3, %14, %15 op_sel_hi:[0,0,0]\n\t" \
            "v_mfma_scale_f32_16x16x128_f8f6f4 %4, %8, %12, %4, %14, %15 op_sel_hi:[0,0,0]\n\t" \
            "v_mfma_scale_f32_16x16x128_f8f6f4 %5, %9, %12, %5, %14, %15 op_sel_hi:[0,0,0]\n\t" \
            "v_mfma_scale_f32_16x16x128_f8f6f4 %6, %8, %13, %6, %14, %15 op_sel_hi:[0,0,0]\n\t" \
            "v_mfma_scale_f32_16x16x128_f8f6f4 %7, %9, %13, %7, %14, %15 op_sel_hi:[0,0,0]" \
            : "+v"(acc[ai][bj][0][0]), "+v"(acc[ai][bj][0][1]), "+v"(acc[ai][bj][1][0]), "+v"(acc[ai][bj][1][1]), "+v"(acc[ai][bj][2][0]), "+v"(acc[ai][bj][2][1]), "+v"(acc[ai][bj][3][0]), "+v"(acc[ai][bj][3][1]) \
            : "v"(Bt##8[0]), "v"(Bt##8[1]), "v"(At##8[0]), "v"(At##8[1]), "v"(At##8[2]), "v"(At##8[3]), "v"(scw_), "v"(sca_)); } \
        else { _Pragma("unroll") for (int m = 0; m < 4; ++m) _Pragma("unroll") for (int n = 0; n < 2; ++n) _Pragma("unroll") for (int k = 0; k < 2; ++k) \
            acc[ai][bj][m][n] = __builtin_amdgcn_mfma_f32_16x16x32_bf16(Bt[n][k], At[m][k], acc[ai][bj][m][n], 0, 0, 0); } __builtin_amdgcn_s_setprio(0); } while (0)
#define PG8_WAIT_V(n) asm volatile("s_waitcnt vmcnt(" #n ")" ::: "memory")
#define PG8_WAIT_L(n) asm volatile("s_waitcnt lgkmcnt(" #n ")" ::: "memory")
#define PG8_BAR __builtin_amdgcn_s_barrier()
#define PG8_SCHED __builtin_amdgcn_sched_barrier(0)
#define PG8_AOFF(dst, u_, ui_) do { _Pragma("unroll") for (int _h = 0; _h < 2; ++_h) _Pragma("unroll") for (int _i = 0; _i < 2; ++_i) { \
        if constexpr (GATHER) dst[_h][_i] = (unsigned)(rowtab[(ui_) * 256 + _h * HALF + _i * 64 + R0] * (unsigned)(K * ESZ) + (unsigned)(C0 * 2)); \
        else dst[_h][_i] = (unsigned)((_h * HALF + _i * 64 + R0) * K * ESZ + C0 * 2); } } while (0)
    Unit cur, nxt; int ui = 0;
    if (!S.next(0, cur)) return;
    f32x4 acc[2][2][4][2];
#pragma unroll
    for (int a = 0; a < 2; ++a)
#pragma unroll
        for (int b = 0; b < 2; ++b)
#pragma unroll
            for (int m = 0; m < 4; ++m)
#pragma unroll
                for (int n = 0; n < 2; ++n) acc[a][b][m][n] = (f32x4){0.f, 0.f, 0.f, 0.f};
    bf16x8 At[4][2], B0[2][2], B1[2][2]; v8i At8[4], B08[2], B18[2]; const int scw_ = P::SCW, sca_ = P::SCA;
    unsigned vAc[2][2], vAn[2][2];
    PG8_AOFF(vAc, cur, 0);
    const char* cA = S.aptr(cur); const char* cB = S.bptr(cur);
    if constexpr (SP2) {
        PG8_STAGE(PG8_SB(0, 0), cB, voffB); PG8_STAGE(PG8_SB(0, 1), cB + hstep, voffB); PG8_STAGE(PG8_SA(0, 0), cA, vAc[0]); PG8_STAGE(PG8_SA(0, 1), cA, vAc[1]);
        if (wr == 1) PG8_BAR;
        PG8_WAIT_V(2); PG8_BAR;
        PG8_STAGE(PG8_SB(1, 0), cB + kstep, voffB); PG8_STAGE(PG8_SA(1, 0), cA + kstep, vAc[0]); PG8_STAGE(PG8_SB(1, 1), cB + hstep + kstep, voffB);
        PG8_WAIT_V(6); PG8_BAR;
    } else {
        PG8_STAGE(PG8_SB(0, 0), cB, voffB); PG8_STAGE(PG8_SA(0, 0), cA, vAc[0]); PG8_STAGE(PG8_SB(0, 1), cB + hstep, voffB); PG8_STAGE(PG8_SA(0, 1), cA, vAc[1]);
        if (wr == 1) PG8_BAR;
        PG8_WAIT_V(4); PG8_BAR;
        PG8_STAGE(PG8_SB(1, 0), cB + kstep, voffB); PG8_STAGE(PG8_SA(1, 0), cA + kstep, vAc[0]); PG8_STAGE(PG8_SB(1, 1), cB + hstep + kstep, voffB);
        PG8_WAIT_V(6); PG8_BAR;
    }
    for (;;) {
        const bool has_next = S.next(ui + 1, nxt);
        const char* nA = has_next ? S.aptr(nxt) : cA; const char* nB = has_next ? S.bptr(nxt) : cB;
        if (has_next) { PG8_AOFF(vAn, nxt, ui + 1); }
        else {
#pragma unroll
            for (int h = 0; h < 2; ++h)
#pragma unroll
                for (int i = 0; i < 2; ++i) vAn[h][i] = vAc[h][i];
        }
        for (int t = 0; t < nt; t += 2) {
            const bool last = (t == nt - 2);
            const char* a1 = cA + (size_t)(t + 1) * kstep;
            const char* a2 = last ? nA : cA + (size_t)(t + 2) * kstep; const char* b2 = last ? nB : cB + (size_t)(t + 2) * kstep;
            const char* a3 = a2 + kstep; const char* b3 = b2 + kstep;
            unsigned w2[2][2];
#pragma unroll
            for (int h = 0; h < 2; ++h)
#pragma unroll
                for (int i = 0; i < 2; ++i) w2[h][i] = last ? vAn[h][i] : vAc[h][i];
            if constexpr (SP2) {
            PG8_LDB(B0, 0, 0); PG8_LDB(B1, 0, 1); PG8_SCHED; PG8_LDA(At, 0, 0); PG8_STAGE(PG8_SA(1, 1), a1, vAc[1]);
            PG8_WAIT_V(8); PG8_WAIT_L(0); PG8_BAR; PG8_MMA(0, 0, At, B0); PG8_MMA(0, 1, At, B1); PG8_BAR; PG8_SCHED;
            PG8_LDA(At, 0, 1); PG8_STAGE(PG8_SB(0, 0), b2, voffB); PG8_STAGE(PG8_SB(0, 1), b2 + hstep, voffB); PG8_STAGE(PG8_SA(0, 0), a2, w2[0]);
            PG8_WAIT_V(8); PG8_WAIT_L(0); PG8_BAR; PG8_MMA(1, 0, At, B0); PG8_MMA(1, 1, At, B1); PG8_BAR; PG8_SCHED;
            PG8_LDB(B0, 1, 0); PG8_LDB(B1, 1, 1); PG8_SCHED; PG8_LDA(At, 1, 0); PG8_STAGE(PG8_SA(0, 1), a2, w2[1]);
            PG8_WAIT_V(8); PG8_WAIT_L(0); PG8_BAR; PG8_MMA(0, 0, At, B0); PG8_MMA(0, 1, At, B1); PG8_BAR; PG8_SCHED;
            PG8_LDA(At, 1, 1); PG8_STAGE(PG8_SB(1, 0), b3, voffB); PG8_STAGE(PG8_SB(1, 1), b3 + hstep, voffB); PG8_STAGE(PG8_SA(1, 0), a3, w2[0]);
            PG8_WAIT_V(8); PG8_WAIT_L(0); PG8_BAR; PG8_MMA(1, 0, At, B0); PG8_MMA(1, 1, At, B1); PG8_BAR; PG8_SCHED;
            } else {
            PG8_LDB(B0, 0, 0); PG8_SCHED; PG8_LDA(At, 0, 0); PG8_STAGE(PG8_SA(1, 1), a1, vAc[1]);
            PG8_WAIT_L(8); PG8_BAR; PG8_WAIT_L(0); PG8_MMA(0, 0, At, B0); PG8_BAR; PG8_SCHED;
            PG8_LDB(B1, 0, 1); PG8_STAGE(PG8_SB(0, 0), b2, voffB);
            PG8_BAR; PG8_WAIT_L(0); PG8_MMA(0, 1, At, B1); PG8_BAR;
            PG8_LDA(At, 0, 1); PG8_STAGE(PG8_SA(0, 0), a2, w2[0]);
            PG8_BAR; PG8_WAIT_L(0); PG8_MMA(1, 0, At, B0); PG8_BAR; PG8_SCHED;
            PG8_STAGE(PG8_SB(0, 1), b2 + hstep, voffB);
            PG8_WAIT_V(6); PG8_BAR; PG8_MMA(1, 1, At, B1); PG8_BAR;
            PG8_LDB(B0, 1, 0); PG8_SCHED; PG8_LDA(At, 1, 0); PG8_STAGE(PG8_SA(0, 1), a2, w2[1]);
            PG8_WAIT_L(8); PG8_BAR; PG8_WAIT_L(0); PG8_MMA(0, 0, At, B0); PG8_BAR; PG8_SCHED;
            PG8_LDB(B1, 1, 1); PG8_STAGE(PG8_SB(1, 0), b3, voffB);
            PG8_BAR; PG8_WAIT_L(0); PG8_MMA(0, 1, At, B1); PG8_BAR;
            PG8_LDA(At, 1, 1); PG8_STAGE(PG8_SA(1, 0), a3, w2[0]);
            PG8_BAR; PG8_WAIT_L(0); PG8_MMA(1, 0, At, B0); PG8_BAR; PG8_SCHED;
            PG8_STAGE(PG8_SB(1, 1), b3 + hstep, voffB);
            PG8_WAIT_V(6); PG8_BAR; PG8_MMA(1, 1, At, B1); PG8_BAR;
            }
        }
        if constexpr (ALIGN_EPI) { if (wr == 0) PG8_BAR; }
        if constexpr (F8) asm volatile("s_nop 15\n\ts_nop 7" ::: "memory");
        { int fr2 = fr, fq2 = fq; asm volatile("" : "+v"(fr2), "+v"(fq2));
          S.epi(acc, cur, wr, wc, fr2, fq2); }
        if (!has_next) break;
#pragma unroll
        for (int a = 0; a < 2; ++a)
#pragma unroll
            for (int b = 0; b < 2; ++b)
#pragma unroll
                for (int m = 0; m < 4; ++m)
#pragma unroll
                    for (int n = 0; n < 2; ++n) acc[a][b][m][n] = (f32x4){0.f, 0.f, 0.f, 0.f};
        cur = nxt; cA = nA; cB = nB; ++ui;
#pragma unroll
        for (int h = 0; h < 2; ++h)
#pragma unroll
            for (int i = 0; i < 2; ++i) vAc[h][i] = vAn[h][i];
        if constexpr (ALIGN_EPI) { if (wr == 1) PG8_BAR; }
    }
    PG8_WAIT_V(0);
    if constexpr (!ALIGN_EPI) { if (wr == 0) PG8_BAR; }
    PG8_BAR;
#undef PG8_SA
#undef PG8_SB
#undef PG8_STAGE
#undef PG8_LDA
#undef PG8_LDB
#undef PG8_MMA
#undef PG8_WAIT_V
#undef PG8_WAIT_L
#undef PG8_BAR
#undef PG8_SCHED
#undef PG8_AOFF
}
}

namespace attn_body {
using bf16 = __hip_bfloat16;
using bf16x8 = __attribute__((ext_vector_type(8))) short;
using s16x4 = __attribute__((ext_vector_type(4))) short;
using f32x16 = __attribute__((ext_vector_type(16))) float;
using u32x4 = __attribute__((ext_vector_type(4))) unsigned;
constexpr int D = 64, QPITCH = NHQ * D, KPITCH = NHKV * D, OPITCH = DM, OCOL0 = 256;
constexpr int NW = 8, QBLK = 32, QB = QBLK * NW, KVBLK = 64, NQB = NTOK / QB, NT = NKEYS / KVBLK;
static_assert(NT % 2 == 0 && NT >= 8, "tile count");
__device__ __forceinline__ int crow(int r, int hi) { return (r & 3) + 8 * (r >> 2) + 4 * hi; }
#define SBAR() __builtin_amdgcn_sched_barrier(0)
constexpr int NSLOT = 3, SLOTB = 8192;
constexpr int LDS_K = 0, LDS_V = NSLOT * SLOTB, LDS_WS = 2 * NSLOT * SLOTB, LDS_OST = LDS_WS + NW * 64 * 4, LDS_BYTES = LDS_OST + NW * 4096;
constexpr float C2 = 0.125f * 1.4426950408889634f;
__device__ __forceinline__ void glds16(const void* gsrc, unsigned lds_dst) { unsigned keep;
  asm volatile("s_mov_b32 %0, m0\n\ts_mov_b32 m0, %2\n\ts_nop 0\n\tglobal_load_lds_dwordx4 %1, off\n\ts_mov_b32 m0, %0" : "=&s"(keep) : "v"(gsrc), "s"(lds_dst) : "memory"); }
__device__ __forceinline__ float max3f(float a, float b, float c) { float r; asm("v_max3_f32 %0, %1, %2, %3" : "=v"(r) : "v"(a), "v"(b), "v"(c)); return r; }
__device__ __forceinline__ float max2f(float a, float b) { float r; asm("v_max_f32_e32 %0, %1, %2" : "=v"(r) : "v"(a), "v"(b)); return r; }
__device__ __forceinline__ float fadd_s(float a, float b) { float r; asm("v_add_f32_e32 %0, %1, %2" : "=v"(r) : "v"(a), "v"(b)); return r; }
__device__ __forceinline__ float fsub_s(float a, float b) { float r; asm("v_sub_f32_e32 %0, %1, %2" : "=v"(r) : "v"(a), "v"(b)); return r; }
typedef float f32x2_t __attribute__((ext_vector_type(2))); typedef __bf16 bf16x2_t __attribute__((ext_vector_type(2)));
__device__ __forceinline__ unsigned cvtpk_s(float lo, float hi) { f32x2_t v = {lo, hi}; bf16x2_t b = __builtin_convertvector(v, bf16x2_t); return __builtin_bit_cast(unsigned, b); }
#define WAIT_BAR(N) asm volatile("s_waitcnt vmcnt(" #N ") lgkmcnt(0)\n\ts_barrier" ::: "memory")

__device__ __forceinline__ void qkt(f32x16& p0, f32x16& p1, const char* Kslot, const bf16x8* qr, const f32x16& negm, int r32, int hi) {
  const char* kb = Kslot + hi * 1024 + r32 * 16;
  #pragma unroll
  for (int d0 = 0; d0 < 4; ++d0) {
    const bf16x8 b0 = *reinterpret_cast<const bf16x8*>(kb + d0 * 2048);
    const bf16x8 b1 = *reinterpret_cast<const bf16x8*>(kb + d0 * 2048 + 512);
    if (d0 == 0) { p0 = __builtin_amdgcn_mfma_f32_32x32x16_bf16(b0, qr[0], negm, 0, 0, 0); p1 = __builtin_amdgcn_mfma_f32_32x32x16_bf16(b1, qr[0], negm, 0, 0, 0); }
    else { p0 = __builtin_amdgcn_mfma_f32_32x32x16_bf16(b0, qr[d0], p0, 0, 0, 0); p1 = __builtin_amdgcn_mfma_f32_32x32x16_bf16(b1, qr[d0], p1, 0, 0, 0); } }
}
typedef __attribute__((address_space(3))) const char* lds_cptr;
typedef short v4i16_t __attribute__((ext_vector_type(4)));
__device__ __forceinline__ void kload8(bf16x8* kf, lds_cptr kp) {
  kf[0] = *(const __attribute__((address_space(3))) bf16x8*)(kp);        kf[1] = *(const __attribute__((address_space(3))) bf16x8*)(kp + 512);
  kf[2] = *(const __attribute__((address_space(3))) bf16x8*)(kp + 2048); kf[3] = *(const __attribute__((address_space(3))) bf16x8*)(kp + 2560);
  kf[4] = *(const __attribute__((address_space(3))) bf16x8*)(kp + 4096); kf[5] = *(const __attribute__((address_space(3))) bf16x8*)(kp + 4608);
  kf[6] = *(const __attribute__((address_space(3))) bf16x8*)(kp + 6144); kf[7] = *(const __attribute__((address_space(3))) bf16x8*)(kp + 6656);
}
__device__ __forceinline__ void kload2(bf16x8* kf, lds_cptr kp, int j) { kf[2 * j] = *(const __attribute__((address_space(3))) bf16x8*)(kp + j * 2048); kf[2 * j + 1] = *(const __attribute__((address_space(3))) bf16x8*)(kp + j * 2048 + 512); }
__device__ __forceinline__ s16x4 vtr(lds_cptr p) { return __builtin_bit_cast(s16x4, __builtin_amdgcn_ds_read_tr16_b64_v4i16((__attribute__((address_space(3))) v4i16_t*)p)); }
__device__ __forceinline__ float rowmax(const f32x16& p0, const f32x16& p1) {
  float a = max3f(p0[0], p0[1], p1[0]), b = max3f(p0[2], p0[3], p1[1]); a = max3f(a, p1[2], p1[3]);
  #pragma unroll
  for (int r = 4; r < 16; r += 4) { a = max3f(a, p0[r], p0[r + 1]); b = max3f(b, p0[r + 2], p0[r + 3]); a = max3f(a, p1[r], p1[r + 1]); b = max3f(b, p1[r + 2], p1[r + 3]); }
  const float m = max2f(a, b);
  auto rr = __builtin_amdgcn_permlane32_swap(__float_as_uint(m), __float_as_uint(m), false, false);
  return max2f(__uint_as_float(rr[0]), __uint_as_float(rr[1]));
}
__device__ __forceinline__ void pv(f32x16* o, int vb, bf16x8 pa0, bf16x8 pa1, bf16x8 pa2, bf16x8 pa3) {
  #pragma unroll
  for (int d0 = 0; d0 < 2; ++d0) { s16x4 lo[4], hi[4];
    #pragma unroll
    for (int ks = 0; ks < 4; ++ks) {
      asm volatile("ds_read_b64_tr_b16 %0,%1 offset:%c2" : "=&v"(lo[ks]) : "v"(vb), "i"(d0 * 4096 + ks * 1024) : "memory");
      asm volatile("ds_read_b64_tr_b16 %0,%1 offset:%c2" : "=&v"(hi[ks]) : "v"(vb), "i"(d0 * 4096 + ks * 1024 + 512) : "memory"); }
    asm volatile("s_waitcnt lgkmcnt(0)" ::: "memory"); SBAR();
    #define PK(k) (bf16x8){lo[k][0], lo[k][1], lo[k][2], lo[k][3], hi[k][0], hi[k][1], hi[k][2], hi[k][3]}
    o[d0] = __builtin_amdgcn_mfma_f32_32x32x16_bf16(pa0, PK(0), o[d0], 0, 0, 0);
    o[d0] = __builtin_amdgcn_mfma_f32_32x32x16_bf16(pa1, PK(1), o[d0], 0, 0, 0);
    o[d0] = __builtin_amdgcn_mfma_f32_32x32x16_bf16(pa2, PK(2), o[d0], 0, 0, 0);
    o[d0] = __builtin_amdgcn_mfma_f32_32x32x16_bf16(pa3, PK(3), o[d0], 0, 0, 0);
    #undef PK
  }
}
#define ATTN_STORE16(p, v) (*(u32x4*)(p) = (v))
template <int THRL> __device__ __forceinline__ void attn_unit(int h, int kvh, int qb, const bf16* Q, const bf16* __restrict__ K, const bf16* __restrict__ V, bf16* O, char* shm, int wid, float kmax2) {
  const int lane = fresh_lane(), r32 = lane & 31, hi = lane >> 5;
  const int q0 = qb * QB;
  const bf16* Qw = Q + (long)(q0 + wid * QBLK) * QPITCH + h * D;
  const bf16* Kh = K + kvh * D, *Vh = V + kvh * D;
  const unsigned lds0 = (unsigned)(uintptr_t)shm;
  float* wsf = (float*)(shm + LDS_WS) + wid * 64;
  const bf16* ksrc = Kh + (long)lane * KPITCH + wid * 8;
  const bf16* vsrc = Vh + (long)(16 * (wid & 3) + (lane >> 2)) * KPITCH + (wid >> 2) * 32 + (lane & 3) * 8;
  const unsigned kdst = lds0 + LDS_K + wid * 1024, vdst = lds0 + LDS_V + wid * 1024;
  #define DMA_K(t, slot) glds16(ksrc + (long)(t) * KVBLK * KPITCH, (unsigned)__builtin_amdgcn_readfirstlane(kdst + (slot)))
  #define DMA_V(t, slot) glds16(vsrc + (long)(t) * KVBLK * KPITCH, (unsigned)__builtin_amdgcn_readfirstlane(vdst + (slot)))
  const int vb0 = (int)(lds0 + LDS_V) + ((lane >> 4) & 1) * 32 + (lane & 3) * 8 + (4 * hi + ((lane & 15) >> 2)) * 64;
  const char* Kbase = shm + LDS_K; bf16x8 kf[8];
  const lds_cptr shm3 = (lds_cptr)shm; const lds_cptr kp0 = shm3 + LDS_K + hi * 1024 + r32 * 16; const lds_cptr vp0 = shm3 + LDS_V + ((lane >> 4) & 1) * 32 + (lane & 3) * 8 + (4 * hi + ((lane & 15) >> 2)) * 64;
  DMA_K(0, 0); DMA_V(0, 0); DMA_K(1, SLOTB);
  bf16x8 qr[4];
  #pragma unroll
  for (int d0 = 0; d0 < 4; ++d0) qr[d0] = *reinterpret_cast<const bf16x8*>(&Qw[(long)r32 * QPITCH + d0 * 16 + hi * 8]);
  float l_reg = 0.f; f32x16 o[2]; o[0] = f32x16{}; o[1] = f32x16{}; f32x16 negm;
  { float qn2 = 0.f;
    #pragma unroll
    for (int d0 = 0; d0 < 4; ++d0)
      #pragma unroll
      for (int j = 0; j < 8; ++j) { const float f = __uint_as_float((unsigned)(unsigned short)qr[d0][j] << 16); qn2 += f * f; }
    auto rr = __builtin_amdgcn_permlane32_swap(__float_as_uint(qn2), __float_as_uint(qn2), false, false); qn2 = __uint_as_float(rr[0]) + __uint_as_float(rr[1]);
    const float bnd = sqrtf(qn2 * kmax2) * 1.004f + 0.01f;
    #pragma unroll
    for (int r = 0; r < 16; ++r) negm[r] = -bnd;
    asm volatile("" : "+v"(negm)); }
  f32x16 pA0, pA1, pB0, pB1;
  int sl_prev = 0, sl_cur = 0, sl_next = SLOTB;
  #define ROT() do { sl_prev = sl_cur; sl_cur = sl_next; sl_next = (sl_next == (NSLOT - 1) * SLOTB) ? 0 : sl_next + SLOTB; } while (0)
  DMA_K(2, 2 * SLOTB);
  WAIT_BAR(3);
  qkt(pA0, pA1, Kbase, qr, negm, r32, hi); asm volatile("s_nop 15\n\ts_nop 7" : "+v"(pA0), "+v"(pA1));
  _Pragma("unroll") for (int r = 0; r < 16; ++r) { pA0[r] = __builtin_amdgcn_exp2f(pA0[r]); pA1[r] = __builtin_amdgcn_exp2f(pA1[r]); }
  WAIT_BAR(0);
  DMA_K(3, 0); DMA_V(1, SLOTB);
  ROT();
  kload8(kf, kp0 + sl_cur);
  WAIT_BAR(2);
  s16x4 vlo[8], vhi[8]; u32x4 pw0, pw1, pw2, pw3;
  #define PKW(P, B) cvtpk_s(P[B], P[B + 1])
  #define PAF(k) __builtin_bit_cast(bf16x8, pw##k)
  #define VFR(i) (bf16x8){vlo[i][0], vlo[i][1], vlo[i][2], vlo[i][3], vhi[i][0], vhi[i][1], vhi[i][2], vhi[i][3]}
  #define PIN(x) asm volatile("" : "+v"(x))
  #define MX3(a, b, c) __builtin_fmaxf(__builtin_fmaxf((a), (b)), (c))
  #define GAPA(MF, A0, A1, A2, A3, W0, W1, PW) do { MF; sacc += A0; sacc += A1; sacc += A2; sacc += A3; PIN(sacc); W0; W1; PIN(PW); SBAR(); } while (0)
  #define EX(v) __builtin_amdgcn_exp2f(v)
  #define GAPB(MF, X, B) do { MF; X[B] = EX(X[B]); X[B + 1] = EX(X[B + 1]); X[B + 2] = EX(X[B + 2]); X[B + 3] = EX(X[B + 3]); PIN(X); SBAR(); } while (0)
  #define VRD(i) do { vlo[i] = vtr(vp_ + (((i) >> 2) * 4096 + ((i) & 3) * 1024)); vhi[i] = vtr(vp_ + (((i) >> 2) * 4096 + ((i) & 3) * 1024 + 512)); } while (0)
  #define KRD(G, j) do { if (G) { kload2(kf, kp0 + sl_next, j); SBAR(); } } while (0)
  #define STEPM(C0, C1, P0, P1, t, GK, GV, GL) do { SBAR(); \
    const lds_cptr vp_ = vp0 + sl_prev; \
    VRD(0); SBAR(); float sacc = (P0[0] + P0[1]); \
    GAPA(C0 = __builtin_amdgcn_mfma_f32_32x32x16_bf16(kf[0], qr[0], negm, 0, 0, 0), P0[2], P0[3], P0[4], P0[5],     pw0[0] = PKW(P0, 0), pw0[1] = PKW(P0, 2), pw0); \
    VRD(4); SBAR(); GAPA(C1 = __builtin_amdgcn_mfma_f32_32x32x16_bf16(kf[1], qr[0], negm, 0, 0, 0), P0[6], P0[7], P0[8], P0[9],     pw0[2] = PKW(P0, 4), pw0[3] = PKW(P0, 6), pw0); \
    VRD(1); SBAR(); GAPA(C0 = __builtin_amdgcn_mfma_f32_32x32x16_bf16(kf[2], qr[1], C0, 0, 0, 0),   P0[10], P0[11], P0[12], P0[13], pw1[0] = PKW(P0, 8), pw1[1] = PKW(P0, 10), pw1); \
    VRD(5); SBAR(); GAPA(C1 = __builtin_amdgcn_mfma_f32_32x32x16_bf16(kf[3], qr[1], C1, 0, 0, 0),   P0[14], P0[15], P1[0], P1[1],   pw1[2] = PKW(P0, 12), pw1[3] = PKW(P0, 14), pw1); \
    VRD(2); SBAR(); GAPA(C0 = __builtin_amdgcn_mfma_f32_32x32x16_bf16(kf[4], qr[2], C0, 0, 0, 0),   P1[2], P1[3], P1[4], P1[5],     pw2[0] = PKW(P1, 0), pw2[1] = PKW(P1, 2), pw2); \
    VRD(6); SBAR(); GAPA(C1 = __builtin_amdgcn_mfma_f32_32x32x16_bf16(kf[5], qr[2], C1, 0, 0, 0),   P1[6], P1[7], P1[8], P1[9],     pw2[2] = PKW(P1, 4), pw2[3] = PKW(P1, 6), pw2); \
    VRD(3); SBAR(); GAPA(C0 = __builtin_amdgcn_mfma_f32_32x32x16_bf16(kf[6], qr[3], C0, 0, 0, 0),   P1[10], P1[11], P1[12], P1[13], pw3[0] = PKW(P1, 8), pw3[1] = PKW(P1, 10), pw3); \
    VRD(7); SBAR(); GAPA(C1 = __builtin_amdgcn_mfma_f32_32x32x16_bf16(kf[7], qr[3], C1, 0, 0, 0),   P1[14], P1[15], 0.f, 0.f,       pw3[2] = PKW(P1, 12), pw3[3] = PKW(P1, 14), pw3); \
    l_reg += sacc; \
    if (GK) { DMA_K((t) + 3, sl_cur); } if (GV) { DMA_V((t) + 1, sl_next); } \
    SBAR(); \
    GAPB(o[0] = __builtin_amdgcn_mfma_f32_32x32x16_bf16(PAF(0), VFR(0), o[0], 0, 0, 0), C0, 0); \
    GAPB(o[1] = __builtin_amdgcn_mfma_f32_32x32x16_bf16(PAF(0), VFR(4), o[1], 0, 0, 0), C0, 4); \
    KRD(GL, 0); GAPB(o[0] = __builtin_amdgcn_mfma_f32_32x32x16_bf16(PAF(1), VFR(1), o[0], 0, 0, 0), C0, 8); \
    KRD(GL, 1); GAPB(o[1] = __builtin_amdgcn_mfma_f32_32x32x16_bf16(PAF(1), VFR(5), o[1], 0, 0, 0), C0, 12); \
    KRD(GL, 2); GAPB(o[0] = __builtin_amdgcn_mfma_f32_32x32x16_bf16(PAF(2), VFR(2), o[0], 0, 0, 0), C1, 0); \
    KRD(GL, 3); GAPB(o[1] = __builtin_amdgcn_mfma_f32_32x32x16_bf16(PAF(2), VFR(6), o[1], 0, 0, 0), C1, 4); \
    GAPB(o[0] = __builtin_amdgcn_mfma_f32_32x32x16_bf16(PAF(3), VFR(3), o[0], 0, 0, 0), C1, 8); \
    GAPB(o[1] = __builtin_amdgcn_mfma_f32_32x32x16_bf16(PAF(3), VFR(7), o[1], 0, 0, 0), C1, 12); \
    } while (0)
  int t = 1;
  for (; t + 5 < NT; t += 2) {
    STEPM(pB0, pB1, pA0, pA1, t, true, true, true);     WAIT_BAR(2); ROT();
    STEPM(pA0, pA1, pB0, pB1, t + 1, true, true, true); WAIT_BAR(2); ROT();
  }
  #define ENDW(tt) do { if ((tt) + 3 < NT) { WAIT_BAR(2); } else if ((tt) + 2 < NT) { WAIT_BAR(1); } else { WAIT_BAR(0); } } while (0)
  for (; t + 1 < NT; t += 2) {
    STEPM(pB0, pB1, pA0, pA1, t, (t + 3 < NT), (t + 1 < NT), (t + 1 < NT));         ENDW(t);     ROT();
    STEPM(pA0, pA1, pB0, pB1, t + 1, (t + 4 < NT), (t + 2 < NT), (t + 2 < NT));     ENDW(t + 1); ROT();
  }
  STEPM(pB0, pB1, pA0, pA1, NT - 1, false, false, false);
  { float sacc = pB0[0] + pB0[1]; _Pragma("unroll") for (int r = 2; r < 16; ++r) sacc += pB0[r]; _Pragma("unroll") for (int r = 0; r < 16; ++r) sacc += pB1[r]; l_reg += sacc;
    pw0 = (u32x4){PKW(pB0, 0), PKW(pB0, 2), PKW(pB0, 4), PKW(pB0, 6)}; pw1 = (u32x4){PKW(pB0, 8), PKW(pB0, 10), PKW(pB0, 12), PKW(pB0, 14)}; pw2 = (u32x4){PKW(pB1, 0), PKW(pB1, 2), PKW(pB1, 4), PKW(pB1, 6)}; pw3 = (u32x4){PKW(pB1, 8), PKW(pB1, 10), PKW(pB1, 12), PKW(pB1, 14)};
    SBAR(); pv(o, vb0 + sl_cur, PAF(0), PAF(1), PAF(2), PAF(3)); }
  #undef PKW
  #undef PAF
  #undef VFR
  #undef PIN
  #undef MX3
  #undef GAPA
  #undef GAPB
  #undef EX
  #undef VRD
  #undef KRD
  #undef STEPM
  #undef ENDW
  { auto rr = __builtin_amdgcn_permlane32_swap(__float_as_uint(l_reg), __float_as_uint(l_reg), false, false); l_reg = __uint_as_float(rr[0]) + __uint_as_float(rr[1]); }
  if (hi == 0) wsf[32 + r32] = l_reg; asm volatile("s_waitcnt lgkmcnt(0)" ::: "memory");
  float rli[16];
  #pragma unroll
  for (int r = 0; r < 16; ++r) rli[r] = __builtin_amdgcn_rcpf(wsf[32 + crow(r, hi)]);
  bf16* Ow = O + (long)(q0 + wid * QBLK) * OPITCH + OCOL0 + h * D;
  { bf16* stg = (bf16*)(shm + LDS_OST) + wid * 2048;
    #pragma unroll
    for (int r = 0; r < 16; ++r) { const int orow = crow(r, hi);
      #pragma unroll
      for (int d0 = 0; d0 < 2; ++d0) stg[orow * 64 + d0 * 32 + r32] = __float2bfloat16(o[d0][r] * rli[r]); }
    asm volatile("s_waitcnt lgkmcnt(0)" ::: "memory");
    #pragma unroll
    for (int i = 0; i < 4; ++i) { const int row = i * 8 + (lane >> 3), ch = lane & 7; const u32x4 v = *(const u32x4*)(stg + row * 64 + ch * 8); ATTN_STORE16(Ow + (long)row * OPITCH + ch * 8, v); } }
  asm volatile("s_waitcnt lgkmcnt(0)\n\ts_barrier" ::: "memory");
  #undef DMA_K
  #undef DMA_V
  #undef ROT
}
#undef SBAR
#undef WAIT_BAR
}

constexpr int NWAVES = 8, NTHR = NWAVES * 64;
constexpr size_t MiB = 1u << 20;
constexpr size_t WS_CTL = 0, CTL_ZERO_BYTES = 64 * 1024;
constexpr size_t WS_MOD = 1 * MiB;
constexpr size_t WS_MISC = WS_MOD + 64 * 1024;
constexpr size_t WS_IDX = WS_MISC, WS_GATE = WS_IDX + 128 * 1024, WS_TOKSLOT = WS_GATE + 128 * 1024;
constexpr size_t WS_AFF = 3 * MiB;
constexpr size_t WS_WIN = 4 * MiB;
constexpr size_t WS_WOUT = 7 * MiB;
constexpr size_t WS_WGU = 9 * MiB;
constexpr size_t WS_WD = 137 * MiB;
constexpr size_t WS_X1 = 201 * MiB;
constexpr size_t WS_R1 = 265 * MiB;
constexpr size_t WS_XN = WS_R1;
constexpr size_t WS_Q = WS_XN + (size_t)NROWS * DM * 2;
constexpr size_t WS_K = WS_Q + (size_t)NTOK * 768 * 2;
constexpr size_t WS_V = WS_K + (size_t)NROWS * 256 * 2;
constexpr size_t WS_FT = WS_V + (size_t)NROWS * 256 * 2;
constexpr size_t WS_MIX = WS_FT + (size_t)256 * NTOK * 4;
constexpr size_t WS_HID = WS_R1;
constexpr size_t WS_R2 = 393 * MiB;
constexpr size_t WS_H2 = WS_R2;
constexpr size_t WS_YE = WS_R2;
constexpr size_t WS_END = 457 * MiB;
static_assert(WS_MIX + (size_t)NTOK * DM * 2 <= WS_R1 + 128 * MiB, "R1 map");
static_assert(WS_TOKSLOT + (size_t)NTOK * 16 * 4 <= WS_AFF, "misc map");
constexpr int CW_TMO = 0, CW_FLAG = 2, CW_KMAX = 64, CW_BAR = 1024;

constexpr int LDS_BYTES = 163840;
constexpr int RING_BYTES = 131072, XTRA_OFF = RING_BYTES;
constexpr int MISC_OFF = LDS_BYTES - 512;

#define GAS __attribute__((address_space(1)))
#define LAS __attribute__((address_space(3)))
typedef unsigned short bf16;
typedef unsigned v4u __attribute__((ext_vector_type(4)));
typedef unsigned v2u __attribute__((ext_vector_type(2)));
typedef float f32x4 __attribute__((ext_vector_type(4)));
typedef float f32x2 __attribute__((ext_vector_type(2)));
typedef GAS unsigned gu32;
#define RLX_AGENT __ATOMIC_RELAXED, __HIP_MEMORY_SCOPE_AGENT
#define LDS_WAIT() asm volatile("s_waitcnt lgkmcnt(0)" ::: "memory")
#define VM_WAIT() asm volatile("s_waitcnt vmcnt(0)" ::: "memory")
__device__ __forceinline__ unsigned f2bf(float f) { unsigned u = __builtin_bit_cast(unsigned, f); return (u + 0x7fffu + ((u >> 16) & 1u)) >> 16; }
__device__ __forceinline__ unsigned pk2(float lo, float hi) { return f2bf(lo) | (f2bf(hi) << 16); }
__device__ __forceinline__ unsigned pk4_fp8(float a, float b, float c, float d) { int p = __builtin_amdgcn_cvt_pk_fp8_f32(a, b, 0, false); p = __builtin_amdgcn_cvt_pk_fp8_f32(c, d, p, true); return (unsigned)p; }
__device__ __forceinline__ float bf2f(unsigned short b) { return __builtin_bit_cast(float, (unsigned)b << 16); }

#define XB_TMO      128
#define XB_XCNT(j)  (256  + 64 * (j))
#define XB_XSUB(j)  (1280 + 64 * (j))
#define XB_XGEN(j)  (2304 + 64 * (j))
#define XB_TOP      3328
#define XB_TOPGEN   3392
#define XCD_BAR_WORDS 3456
#define XB_SPIN_CAP (1u << 20)
static_assert((CW_BAR + XCD_BAR_WORDS) * 4 <= (int)CTL_ZERO_BYTES, "ctl");
__device__ __forceinline__ unsigned xb_ld(unsigned* p)              { return __hip_atomic_load(p, __ATOMIC_RELAXED, __HIP_MEMORY_SCOPE_AGENT); }
__device__ __forceinline__ unsigned xb_add(unsigned* p, unsigned v) { return __hip_atomic_fetch_add(p, v, __ATOMIC_RELAXED, __HIP_MEMORY_SCOPE_AGENT); }
__device__ __forceinline__ unsigned xb_xcc_id() { return (unsigned)__builtin_amdgcn_s_getreg((3 << 11) | 20) & 0xFu; }
#define XB_SPIN(cond, bar) do { unsigned _sp = 0; while (cond) { __builtin_amdgcn_s_sleep(1); \
    if ((++_sp & 255u) == 0u) { if (xb_ld(&(bar)[XB_TMO])) break; if (_sp > XB_SPIN_CAP) { atomicAdd(&(bar)[XB_TMO], 1u); break; } } } } while (0)
struct XcdBarrier { unsigned* bar; unsigned x; volatile LAS unsigned* st; };
__device__ __forceinline__ XcdBarrier xcd_barrier_post(unsigned* bar, volatile LAS unsigned* st, bool leader) {
    XcdBarrier b; b.bar = bar; b.x = xb_xcc_id(); b.st = st;
    if (leader) (void)xb_add(&bar[XB_XCNT(b.x)], 1u);
    return b;
}
__device__ __forceinline__ void xcd_barrier_complete(unsigned* bar, unsigned x, unsigned& nloc, unsigned& nx) {
    const unsigned G = gridDim.x * gridDim.y * gridDim.z;
    unsigned sum, cnt, mine, sp = 0u;
    for (;;) {
        sum = 0u; cnt = 0u; mine = 0u;
#pragma unroll
        for (unsigned j = 0; j < 16; ++j) { const unsigned c = xb_ld(&bar[XB_XCNT(j)]); sum += c; cnt += (c > 0u) ? 1u : 0u; mine = (j == x) ? c : mine; }
        if (sum == G) break;
        __builtin_amdgcn_s_sleep(1);
        if ((++sp & 255u) == 0u) { if (xb_ld(&bar[XB_TMO])) break; if (sp > XB_SPIN_CAP) { atomicAdd(&bar[XB_TMO], 1u); break; } }
    }
    nloc = mine > 0u ? mine : 1u; nx = cnt > 0u ? cnt : 1u;
}
__device__ __forceinline__ void xcd_barrier(const XcdBarrier& b, int wave) {
    asm volatile("s_waitcnt vmcnt(0)" ::: "memory");
    __syncthreads();
    if (wave == 0 && fresh_lane() == 0) {
        unsigned* bar = b.bar;
        __builtin_amdgcn_s_waitcnt(0);
        unsigned nloc = b.st[0], nx = b.st[1];
        if (nloc == 0u) { xcd_barrier_complete(bar, b.x, nloc, nx); b.st[0] = nloc; b.st[1] = nx; }
        const unsigned old = xb_add(&bar[XB_XSUB(b.x)], 1u);
        const unsigned gen = old / nloc;
        if (old + 1u == (gen + 1u) * nloc) {
            __builtin_amdgcn_fence(__ATOMIC_RELEASE, "agent");
            asm volatile("s_waitcnt vmcnt(0)" ::: "memory");
            const unsigned og = xb_add(&bar[XB_TOP], 1u);
            const unsigned tg = og / nx;
            if (og + 1u == (tg + 1u) * nx) xb_add(&bar[XB_TOPGEN], 1u);
            else XB_SPIN(xb_ld(&bar[XB_TOPGEN]) == tg, bar);
            __builtin_amdgcn_fence(__ATOMIC_ACQUIRE, "agent");
            xb_add(&bar[XB_XGEN(b.x)], 1u);
            asm volatile("s_waitcnt vmcnt(0)" ::: "memory");
        } else {
            XB_SPIN(xb_ld(&bar[XB_XGEN(b.x)]) == gen, bar);
            __builtin_amdgcn_fence(__ATOMIC_ACQUIRE, "agent");
            asm volatile("s_waitcnt vmcnt(0)" ::: "memory");
        }
    }
    __syncthreads();
}

struct Args {
    const float *x, *c, *ctx, *c_ctx, *w_mod, *b_mod, *norm_mix_g, *norm_ffn_g, *w_in, *w_four, *q_norm_g, *k_norm_g, *w_out, *w_router, *w_gate, *w_up, *w_down, *final_norm_g;
    float* out; unsigned char* ws;
};

__device__ __forceinline__ float wave_sum(float v) {
#pragma unroll
    for (int o = 1; o < 64; o <<= 1) v += __shfl_xor(v, o);
    return v;
}

template <class RowMap>
__device__ __forceinline__ void tr_item(const float* __restrict__ W, int ldw, int k0, int n0, bf16* WT, int ldt, int kdst0, const RowMap& drow, LAS float* scr, int lane) {
    const int kq = lane >> 4, nq = lane & 15;
    f32x4 v[16];
#pragma unroll
    for (int it = 0; it < 16; ++it) v[it] = *(const f32x4*)(W + (size_t)(k0 + 4 * it + kq) * ldw + n0 + 4 * nq);
#pragma unroll
    for (int it = 0; it < 16; ++it) { LAS float* s = scr + (4 * it + kq) * 65 + 4 * nq; s[0] = v[it][0]; s[1] = v[it][1]; s[2] = v[it][2]; s[3] = v[it][3]; }
    LDS_WAIT(); asm volatile("" ::: "memory");
    const int c = lane >> 3, nn = lane & 7;
#pragma unroll
    for (int j = 0; j < 8; ++j) { const int n = nn + 8 * j; const LAS float* s = scr + (8 * c) * 65 + n;
        v4u o; o.x = pk2(s[0 * 65], s[1 * 65]); o.y = pk2(s[2 * 65], s[3 * 65]); o.z = pk2(s[4 * 65], s[5 * 65]); o.w = pk2(s[6 * 65], s[7 * 65]);
        *(GAS v4u*)(WT + (size_t)drow(n0 + n) * ldt + kdst0 + k0 + 8 * c) = o; }
    LDS_WAIT(); asm volatile("" ::: "memory");
}
struct RowId { int base; __device__ __forceinline__ int operator()(int n) const { return base + n; } };
struct RowQKV { __device__ __forceinline__ int operator()(int n) const { const int t = n >> 8, w = n & 255, hd = w >> 6, d = w & 63; return 256 + 256 * t + 128 * (d >> 5) + 32 * hd + (d & 31); } };
struct RowGU { int base, up; __device__ __forceinline__ int operator()(int f) const { return base + 256 * (f >> 7) + 128 * up + (f & 127); } };


constexpr int MOE_ITEMS = 3 * 8192;
struct TrDesc { const float* src; bf16* dst; int ldw, ldt, f8; };
__device__ __forceinline__ TrDesc moe_desc(const Args& a, int r) {
    TrDesc d;
    if (r < 16384) { const int up = r >> 13, rr = r & 8191, e = rr >> 9, q = rr & 511, kb = q >> 5, nb = q & 31;
        d.src = (up ? a.w_up : a.w_gate) + (size_t)e * DM * DE + (size_t)(kb * 64) * DE + nb * 64; d.ldw = DE;
        d.dst = (bf16*)((unsigned char*)(a.ws + WS_WGU) + ((size_t)e * 4096 + 256 * (nb >> 1) + 128 * up + 64 * (nb & 1)) * DM + kb * 64); d.ldt = DM; d.f8 = 1; }
    else { const int rr = r - 16384, e = rr >> 9, q = rr & 511, kb = q >> 4, nb = q & 15;
        d.src = a.w_down + (size_t)e * DE * DM + (size_t)(kb * 64) * DM + nb * 64; d.ldw = DM;
        d.dst = (bf16*)(a.ws + WS_WD) + ((size_t)e * DM + nb * 64) * DE + kb * 64; d.ldt = DE; d.f8 = 0; }
    return d;
}
#define TR_LOAD(v, d) do { _Pragma("unroll") for (int _it = 0; _it < 16; ++_it) v[_it] = *(const f32x4*)((d).src + (size_t)(4 * _it + kq) * (d).ldw + 4 * nq); } while (0)
#define TR_PROC(v, d) do { \
    _Pragma("unroll") for (int _it = 0; _it < 16; ++_it) { LAS float* s_ = scr + (4 * _it + kq) * 65 + 4 * nq; s_[0] = v[_it][0]; s_[1] = v[_it][1]; s_[2] = v[_it][2]; s_[3] = v[_it][3]; } \
    LDS_WAIT(); asm volatile("" ::: "memory"); \
    if ((d).f8) { _Pragma("unroll") for (int _j = 0; _j < 8; ++_j) { const int n_ = nn + 8 * _j; const LAS float* s_ = scr + (8 * c8) * 65 + n_; \
        v2u o_; o_.x = pk4_fp8(s_[0 * 65] * 32.f, s_[1 * 65] * 32.f, s_[2 * 65] * 32.f, s_[3 * 65] * 32.f); o_.y = pk4_fp8(s_[4 * 65] * 32.f, s_[5 * 65] * 32.f, s_[6 * 65] * 32.f, s_[7 * 65] * 32.f); \
        *(GAS v2u*)((unsigned char*)(d).dst + (size_t)n_ * (d).ldt + 8 * c8) = o_; } } \
    else { _Pragma("unroll") for (int _j = 0; _j < 8; ++_j) { const int n_ = nn + 8 * _j; const LAS float* s_ = scr + (8 * c8) * 65 + n_; \
        v4u o_; o_.x = pk2(s_[0 * 65], s_[1 * 65]); o_.y = pk2(s_[2 * 65], s_[3 * 65]); o_.z = pk2(s_[4 * 65], s_[5 * 65]); o_.w = pk2(s_[6 * 65], s_[7 * 65]); \
        *(GAS v4u*)((d).dst + (size_t)n_ * (d).ldt + 8 * c8) = o_; } } \
    LDS_WAIT(); asm volatile("" ::: "memory"); } while (0)
__device__ __forceinline__ void moe_convert(const Args& a, LAS float* scr, int lo, int hi, int w, int nw) {
    const int lane = fresh_lane(), kq = lane >> 4, nq = lane & 15, c8 = lane >> 3, nn = lane & 7;
    int it = lo + w; if (it >= hi) return;
    f32x4 va[16], vb[16];
    TrDesc da = moe_desc(a, it), db = da; TR_LOAD(va, da);
    for (;;) {
        int nx = it + nw; bool hn = nx < hi;
        if (hn) { db = moe_desc(a, nx); TR_LOAD(vb, db); }
        TR_PROC(va, da);
        if (!hn) break;
        it = nx; nx = it + nw; hn = nx < hi;
        if (hn) { da = moe_desc(a, nx); TR_LOAD(va, da); }
        TR_PROC(vb, db);
        if (!hn) break;
        it = nx;
    }
}
#ifndef MOE_S0
#define MOE_S0 4096
#endif
#ifndef MOE_S1
#define MOE_S1 2560
#endif
#ifndef MOE_S2
#define MOE_S2 0
#endif
constexpr int MOE_B0 = MOE_S0, MOE_B1 = MOE_B0 + MOE_S1, MOE_B2 = MOE_B1 + MOE_S2;

__host__ __device__ __forceinline__ int four_pos(int mp) { return mp == 0 ? 0 : (mp == 32 ? 1 : (mp < 32 ? 2 * mp : 2 * (64 - mp) + 1)); }

__device__ __forceinline__ void p0_prologue(const Args& a, LAS unsigned char* lds, int vcu, int G, int wave) {
    const int lane = fresh_lane(), tid = wave * 64 + lane;
    unsigned char* ws = a.ws;
    bf16* WinT = (bf16*)(ws + WS_WIN); bf16* WoT = (bf16*)(ws + WS_WOUT);
    float* MOD = (float*)(ws + WS_MOD);
    const int cg = vcu - (G - 24);
    if (cg >= 0) {
        LAS float* sv = (LAS float*)lds;
        LAS float* red = sv + 2048;
        for (int i = tid; i < 1024; i += NTHR) { const float c0 = a.c[i], c1 = a.c_ctx[i]; sv[i] = c0 / (1.f + __expf(-c0)); sv[1024 + i] = c1 / (1.f + __expf(-c1)); }
        __syncthreads();
        const int col = cg * 256 + 4 * lane;
        f32x4 a0 = {0.f, 0.f, 0.f, 0.f}, a1 = {0.f, 0.f, 0.f, 0.f};
        const int kb = wave * 128;
#pragma unroll 16
        for (int k = 0; k < 128; ++k) { const f32x4 w = *(const f32x4*)(a.w_mod + (size_t)(kb + k) * (NMOD * DM) + col); const float s0 = sv[kb + k], s1 = sv[1024 + kb + k]; a0 += w * s0; a1 += w * s1; }
        *(LAS f32x4*)(red + (wave * 2 + 0) * 256 + 4 * lane) = a0; *(LAS f32x4*)(red + (wave * 2 + 1) * 256 + 4 * lane) = a1;
        __syncthreads();
        { const int v = tid >> 8, cc = tid & 255; float s = 0.f;
#pragma unroll
          for (int w = 0; w < 8; ++w) s += red[(w * 2 + v) * 256 + cc];
          MOD[v * (NMOD * DM) + cg * 256 + cc] = s + a.b_mod[cg * 256 + cc]; }
        __syncthreads();
    }
    LAS float* scr = (LAS float*)(lds + wave * 16640);
    constexpr int I_F1 = 256, I_F2 = 256, I_IN = 16 * 20, I_OUT = 12 * 16;
    constexpr int NITEMS = I_F1 + I_F2 + I_IN + I_OUT;
    for (int it = wave * G + vcu; it < NITEMS; it += NWAVES * G) {
        int r = it;
        if (r < I_F1) {
            const int g = r & 3, kb = (r >> 2) & 15, jq = r >> 6, k = kb * 64 + lane;
            LAS float* ct = scr;
            ct[lane] = cospif((float)lane * (1.f / 32.f)); LDS_WAIT(); asm volatile("" ::: "memory");
            float w[64];
#pragma unroll
            for (int c4 = 0; c4 < 16; ++c4) { const f32x4 t = *(const f32x4*)(a.w_in + (size_t)k * INW + 64 * g + 4 * c4); w[4 * c4] = t[0]; w[4 * c4 + 1] = t[1]; w[4 * c4 + 2] = t[2]; w[4 * c4 + 3] = t[3]; }
            for (int j = 16 * jq; j < 16 * jq + 16; ++j) { const int m = j <= 32 ? j : j - 32; const int ph = j <= 32 ? 0 : 48;
                float s = 0.f;
#pragma unroll
                for (int c = 0; c < 64; ++c) s += w[c] * ct[(c * m + ph) & 63];
                WinT[(size_t)(64 * g + j) * DM + k] = (bf16)f2bf(s * (1.f / 1024.f)); }
            LDS_WAIT(); asm volatile("" ::: "memory");
            continue; }
        r -= I_F1;
        if (r < I_F2) {
            const int g = r & 3, jb = (r >> 2) & 15, mq = r >> 6, j = jb * 64 + lane;
            float w[64];
#pragma unroll
            for (int d = 0; d < 64; ++d) w[d] = a.w_out[(size_t)(64 * g + d) * DM + j];
            for (int mp = 16 * mq; mp < 16 * mq + 16; ++mp) { float s = 0.f; const float* wf = a.w_four + (size_t)(g * 64 + mp) * 64;
#pragma unroll
                for (int d = 0; d < 64; ++d) s += wf[d] * w[d];
                WoT[(size_t)j * DM + 64 * g + four_pos(mp)] = (bf16)f2bf(s); }
            continue; }
        r -= I_F2;
        if (r < I_IN) { const int kb = r / 20, nb = r % 20; tr_item(a.w_in + 256, INW, kb * 64, nb * 64, WinT, DM, 0, RowQKV{}, scr, lane); continue; }
        r -= I_IN;
        { const int kb = r / 16, nb = r % 16; tr_item(a.w_out + (size_t)256 * DM, DM, kb * 64, nb * 64, WoT, DM, 256, RowId{0}, scr, lane); }
    }
    if (cg < 0) moe_convert(a, scr, 0, MOE_B0, ((wave + 4) & 7) * (G - 24) + vcu, NWAVES * (G - 24));
}

__device__ __forceinline__ void p0b_modulate(const Args& a, int vcu, int G, int wave) {
    const int lane = fresh_lane();
    unsigned char* ws = a.ws; const float* MOD = (const float*)(ws + WS_MOD); bf16* XN = (bf16*)(ws + WS_XN);
    const int gw = vcu * NWAVES + wave, NGW = G * NWAVES;
    for (int pass = 0; pass < 2; ++pass) {
        const float* md = MOD + pass * (NMOD * DM);
        const int nrows = pass == 0 ? NTOK : NCTX; const float* src = pass == 0 ? a.x : a.ctx; bf16* dst = XN + (size_t)(pass == 0 ? 0 : NTOK) * DM;
        if (gw >= nrows) continue;
        f32x4 av[4], sh[4];
#pragma unroll
        for (int j = 0; j < 4; ++j) { const int col = 4 * lane + 256 * j; const f32x4 g = *(const f32x4*)(a.norm_mix_g + col); const f32x4 sc = *(const f32x4*)(md + DM + col); av[j] = g * (sc + 1.f); sh[j] = *(const f32x4*)(md + col); }
        f32x4 v[4], vn[4];
        { const GAS f32x4* xr = (const GAS f32x4*)(src + (size_t)gw * DM) + lane;
#pragma unroll
          for (int j = 0; j < 4; ++j) v[j] = xr[64 * j]; }
        for (int m = gw; m < nrows; m += NGW) {
            const int mn = m + NGW;
            if (mn < nrows) { const GAS f32x4* xr = (const GAS f32x4*)(src + (size_t)mn * DM) + lane;
#pragma unroll
                for (int j = 0; j < 4; ++j) vn[j] = xr[64 * j]; }
            float s = 0.f;
#pragma unroll
            for (int j = 0; j < 4; ++j) s += (v[j].x * v[j].x + v[j].y * v[j].y) + (v[j].z * v[j].z + v[j].w * v[j].w);
            const float rinv = 1.f / sqrtf(wave_sum(s) * (1.f / DM) + EPS);
            GAS unsigned long long* o8 = (GAS unsigned long long*)(dst + (size_t)m * DM) + lane;
#pragma unroll
            for (int j = 0; j < 4; ++j) { const f32x4 y = v[j] * rinv * av[j] + sh[j]; o8[64 * j] = (unsigned long long)pk2(y.x, y.y) | ((unsigned long long)pk2(y.z, y.w) << 32); }
#pragma unroll
            for (int j = 0; j < 4; ++j) v[j] = vn[j];
        }
    }
}

struct P1Prob {
    static constexpr int K = DM; static constexpr bool PERM = false, FP8 = false; static constexpr int SCW = 0, SCA = 0;
    const bf16* XN; const bf16* WinT; bf16 *Q, *Kb, *Vb; float* FT; const float *qg, *kg; unsigned* kmax; pg8::StaticOrder so;
    __device__ __forceinline__ bool next(int i, pg8::Unit& u) const { return so.next(i, u); }
    __device__ __forceinline__ const char* aptr(const pg8::Unit& u) const { return u.pn == 0 ? (const char*)WinT : (const char*)(XN + (size_t)u.pm * 256 * DM); }
    __device__ __forceinline__ const char* bptr(const pg8::Unit& u) const { return u.pn == 0 ? (const char*)(XN + (size_t)u.pm * 256 * DM) : (const char*)(WinT + (size_t)u.pn * 256 * DM); }
    __device__ __forceinline__ void epi(const pg8::f32x4 (&acc)[2][2][4][2], const pg8::Unit& u, int wr, int wc, int fr, int fq) const {
        if (u.pn == 0) {
            if (u.pm >= NTOK / 256) return;
#pragma unroll
            for (int ai = 0; ai < 2; ++ai)
#pragma unroll
                for (int m = 0; m < 4; ++m) { float* rowp = FT + (size_t)(ai * 128 + wr * 64 + m * 16 + fr) * NTOK + u.pm * 256 + wc * 32 + 4 * fq;
#pragma unroll
                    for (int bj = 0; bj < 2; ++bj)
#pragma unroll
                        for (int n = 0; n < 2; ++n) *(pg8::f32x4*)(rowp + bj * 128 + n * 16) = acc[ai][bj][m][n]; }
            return;
        }
        const bool isq = u.pn <= 3, isv = u.pn == 5, lat = u.pm < NTOK / 256;
        if (isq && !lat) return;
        if (isv) {
#pragma unroll
            for (int ai = 0; ai < 2; ++ai)
#pragma unroll
                for (int m = 0; m < 4; ++m) { const int t = u.pm * 256 + ai * 128 + wr * 64 + m * 16 + fr; bf16* rowp = Vb + (size_t)t * 256 + wc * 64 + 4 * fq;
#pragma unroll
                    for (int bj = 0; bj < 2; ++bj)
#pragma unroll
                        for (int n = 0; n < 2; ++n) { const pg8::f32x4 v = acc[ai][bj][m][n]; *(v2u*)(rowp + 32 * bj + 16 * n) = (v2u){pk2(v[0], v[1]), pk2(v[2], v[3])}; } }
            return;
        }
        const float* gw = isq ? qg : kg;
        pg8::f32x4 gv[2][2];
#pragma unroll
        for (int bj = 0; bj < 2; ++bj)
#pragma unroll
            for (int n = 0; n < 2; ++n) gv[bj][n] = *(const pg8::f32x4*)(gw + 32 * bj + 16 * n + 4 * fq);
        float frq[4];
#pragma unroll
        for (int e = 0; e < 4; ++e) frq[e] = exp2f(-(float)(4 * fq + e) * (13.287712379549449f / 16.f)) * 0.15915494309189535f;
        const float qs = isq ? attn_body::C2 : 1.f;
        bf16* base = isq ? Q + (size_t)((u.pn - 1) * 4 + wc) * 64 : Kb + (size_t)wc * 64; const int pitch = isq ? 768 : 256;
        float k2max = 0.f;
#pragma unroll
        for (int ai = 0; ai < 2; ++ai) {
            float rowpos = (float)(u.pm * 4 + ai * 2 + wr); asm volatile("" : "+v"(rowpos));
            float cr[4], sr[4];
#pragma unroll
            for (int e = 0; e < 4; ++e) { const float rev = rowpos * frq[e], f_ = rev - floorf(rev); cr[e] = __builtin_amdgcn_cosf(f_); sr[e] = __builtin_amdgcn_sinf(f_); }
#pragma unroll
            for (int m = 0; m < 4; ++m) {
                float colpos = (float)(m * 16 + fr); asm volatile("" : "+v"(colpos));
                const int t = u.pm * 256 + ai * 128 + wr * 64 + m * 16 + fr;
                float ss = 0.f;
#pragma unroll
                for (int bj = 0; bj < 2; ++bj)
#pragma unroll
                    for (int n = 0; n < 2; ++n) { const pg8::f32x4 v = acc[ai][bj][m][n]; ss += (v[0] * v[0] + v[1] * v[1]) + (v[2] * v[2] + v[3] * v[3]); }
                ss += __shfl_xor(ss, 16); ss += __shfl_xor(ss, 32);
                const float rinv = qs / sqrtf(ss * (1.f / 64.f) + EPS);
                pg8::f32x4 y[2][2];
#pragma unroll
                for (int bj = 0; bj < 2; ++bj)
#pragma unroll
                    for (int n = 0; n < 2; ++n) y[bj][n] = acc[ai][bj][m][n] * rinv * gv[bj][n];
                if (lat) {
#pragma unroll
                    for (int e = 0; e < 4; ++e) {
                        { const float x1 = y[0][0][e], x2 = y[0][1][e]; y[0][0][e] = x1 * cr[e] - x2 * sr[e]; y[0][1][e] = x1 * sr[e] + x2 * cr[e]; }
                        { const float rev = colpos * frq[e], f_ = rev - floorf(rev); const float cc = __builtin_amdgcn_cosf(f_), sc = __builtin_amdgcn_sinf(f_);
                          const float x1 = y[1][0][e], x2 = y[1][1][e]; y[1][0][e] = x1 * cc - x2 * sc; y[1][1][e] = x1 * sc + x2 * cc; }
                    }
                }
                bf16* rowp = base + (size_t)t * pitch + 4 * fq;
                ss = 0.f;
#pragma unroll
                for (int bj = 0; bj < 2; ++bj)
#pragma unroll
                    for (int n = 0; n < 2; ++n) { const pg8::f32x4 v = y[bj][n]; const v2u w = (v2u){pk2(v[0], v[1]), pk2(v[2], v[3])}; *(v2u*)(rowp + 32 * bj + 16 * n) = w;
                        if (!isq) { const float b0 = __uint_as_float(w.x << 16), b1 = __uint_as_float(w.x & 0xffff0000u), b2 = __uint_as_float(w.y << 16), b3 = __uint_as_float(w.y & 0xffff0000u); ss += (b0 * b0 + b1 * b1) + (b2 * b2 + b3 * b3); } }
                if (!isq) { float r2 = ss; r2 += __shfl_xor(r2, 16); r2 += __shfl_xor(r2, 32); k2max = fmaxf(k2max, r2); }
                asm volatile("" ::: "memory");
            }
        }
        if (!isq) {
#pragma unroll
            for (int o = 1; o < 16; o <<= 1) k2max = fmaxf(k2max, __shfl_xor(k2max, o));
            if (fr == 0 && fq == 0) __hip_atomic_fetch_max(kmax, __float_as_uint(k2max), __ATOMIC_RELAXED, __HIP_MEMORY_SCOPE_AGENT);
        }
    }
};

__device__ __forceinline__ unsigned rev4_12(unsigned k) { unsigned r = __brev(k) >> 20; return ((r & 0xAAAu) >> 1) | ((r & 0x555u) << 1); }
__device__ __forceinline__ void fft_block(const Args& a, LAS unsigned char* lds, int item, int wave) {
    const int tid = wave * 64 + fresh_lane();
    const int mm = item & 31, par = (item >> 5) & 1, g = item >> 6;
    const float* FT = (const float*)(a.ws + WS_FT); bf16* MIX = (bf16*)(a.ws + WS_MIX);
    LAS f32x2* X = (LAS f32x2*)lds;
    const float* re = FT + (size_t)(64 * g + mm) * NTOK; const float* im = FT + (size_t)(64 * g + 32 + mm) * NTOK;
#pragma unroll 1
    for (int i = 0; i < 2; ++i) {
        const int j0 = 4 * (tid + NTHR * i);
        f32x4 r4[4], i4[4];
#pragma unroll
        for (int q = 0; q < 4; ++q) { r4[q] = *(const f32x4*)(re + j0 + 4096 * q); i4[q] = *(const f32x4*)(im + j0 + 4096 * q); }
#pragma unroll
        for (int e = 0; e < 4; ++e) {
            const int j = j0 + e;
            const f32x2 a0 = {r4[0][e], i4[0][e]}, a1 = {r4[1][e], i4[1][e]}, a2 = {r4[2][e], i4[2][e]}, a3 = {r4[3][e], i4[3][e]};
            f32x2 ya, yb; float fa, fb;
            if (par == 0) { const f32x2 s02 = a0 + a2, s13 = a1 + a3; ya = s02 + s13; yb = s02 - s13; fa = 0.f; fb = (float)(2 * j) * (1.f / 16384.f); }
            else { const f32x2 d02 = a0 - a2, d13 = a1 - a3; ya = (f32x2){d02.x + d13.y, d02.y - d13.x}; yb = (f32x2){d02.x - d13.y, d02.y + d13.x}; fa = (float)j * (1.f / 16384.f); fb = (float)(3 * j) * (1.f / 16384.f); }
            const float ca = __builtin_amdgcn_cosf(fa), sa = __builtin_amdgcn_sinf(fa), cb = __builtin_amdgcn_cosf(fb), sb = __builtin_amdgcn_sinf(fb);
            X[j] = (f32x2){ya.x * ca + ya.y * sa, ya.y * ca - ya.x * sa};
            X[4096 + j] = (f32x2){yb.x * cb + yb.y * sb, yb.y * cb - yb.x * sb};
        }
    }
    __syncthreads();
#pragma unroll 1
    for (int s = 0; s < 6; ++s) {
        const int lq = 10 - 2 * s;
        const int Lq = 1 << lq;
        const float invL = 1.f / (float)(4 << lq);
#pragma unroll 2
        for (int i = 0; i < 4; ++i) {
            const int b = tid + NTHR * i, j = b & (Lq - 1), base = ((b >> lq) << (lq + 2)) + j;
            const f32x2 a0 = X[base], a1 = X[base + Lq], a2 = X[base + 2 * Lq], a3 = X[base + 3 * Lq];
            const f32x2 s02 = a0 + a2, d02 = a0 - a2, s13 = a1 + a3, d13 = a1 - a3;
            const f32x2 y0 = s02 + s13, y2 = s02 - s13;
            const f32x2 y1 = (f32x2){d02.x + d13.y, d02.y - d13.x};
            const f32x2 y3 = (f32x2){d02.x - d13.y, d02.y + d13.x};
            const float f1 = (float)j * invL;
            const float c1 = __builtin_amdgcn_cosf(f1), s1 = __builtin_amdgcn_sinf(f1);
            const float c2 = __builtin_amdgcn_cosf(2.f * f1), s2 = __builtin_amdgcn_sinf(2.f * f1);
            const float c3 = __builtin_amdgcn_cosf(3.f * f1), s3 = __builtin_amdgcn_sinf(3.f * f1);
            X[base] = y0;
            X[base + Lq] = (f32x2){y1.x * c1 + y1.y * s1, y1.y * c1 - y1.x * s1};
            X[base + 2 * Lq] = (f32x2){y2.x * c2 + y2.y * s2, y2.y * c2 - y2.x * s2};
            X[base + 3 * Lq] = (f32x2){y3.x * c3 + y3.y * s3, y3.y * c3 - y3.x * s3};
        }
        __syncthreads();
    }
    const int col = 64 * g + 2 * mm;
#pragma unroll 1
    for (int i = 0; i < 16; ++i) {
        const int k = 2 * (tid + NTHR * i) + par, kn = (NTOK - k) & (NTOK - 1);
        const f32x2 wk = X[(((k & 3) - par) >> 1) * 4096 + rev4_12((unsigned)(k >> 2))], wn = X[(((kn & 3) - par) >> 1) * 4096 + rev4_12((unsigned)(kn >> 2))];
        float o0, o1;
        if (mm == 0) { o0 = 0.5f * (wk.x + wn.x); o1 = 0.5f * (wk.y + wn.y); }
        else { o0 = wn.x; o1 = wk.x; }
        *(unsigned*)(MIX + (size_t)k * DM + col) = pk2(o0, o1);
    }
    __syncthreads();
}

struct P3Prob {
    static constexpr int K = DM; static constexpr bool PERM = false, FP8 = false; static constexpr int SCW = 0, SCA = 0;
    const bf16* MIX; const bf16* WoT; const float* x; const float* g1; float* X1; pg8::StaticOrder so;
    __device__ __forceinline__ bool next(int i, pg8::Unit& u) const { return so.next(i, u); }
    __device__ __forceinline__ const char* aptr(const pg8::Unit& u) const { return (const char*)(MIX + (size_t)u.pm * 256 * DM); }
    __device__ __forceinline__ const char* bptr(const pg8::Unit& u) const { return (const char*)(WoT + (size_t)u.pn * 256 * DM); }
    __device__ __forceinline__ void epi(const pg8::f32x4 (&acc)[2][2][4][2], const pg8::Unit& u, int wr, int wc, int fr, int fq) const {
        const int col0 = u.pn * 256 + wc * 32 + 4 * fq;
        pg8::f32x4 gv[2][2];
#pragma unroll
        for (int bj = 0; bj < 2; ++bj)
#pragma unroll
            for (int n = 0; n < 2; ++n) gv[bj][n] = *(const pg8::f32x4*)(g1 + col0 + bj * 128 + n * 16);
#pragma unroll
        for (int ai = 0; ai < 2; ++ai)
#pragma unroll
            for (int m = 0; m < 4; ++m) { const size_t off = (size_t)(u.pm * 256 + ai * 128 + wr * 64 + m * 16 + fr) * DM + col0;
#pragma unroll
                for (int bj = 0; bj < 2; ++bj)
#pragma unroll
                    for (int n = 0; n < 2; ++n) { const pg8::f32x4 bs = *(const pg8::f32x4*)(x + off + bj * 128 + n * 16); *(pg8::f32x4*)(X1 + off + bj * 128 + n * 16) = bs + gv[bj][n] * acc[ai][bj][m][n]; }
                if (m & 1) asm volatile("" ::: "memory"); }
    }
};

__device__ __forceinline__ void p3b_router(const Args& a, LAS unsigned char* lds, int vcu, int G, int wave) {
    const int lane = fresh_lane(), tid = wave * 64 + lane;
    unsigned char* ws = a.ws; const float* MOD = (const float*)(ws + WS_MOD); const float* X1 = (const float*)(ws + WS_X1); bf16* H2 = (bf16*)(ws + WS_H2); float* AFF = (float*)(ws + WS_AFF);
    LAS float* wrt = (LAS float*)lds;
    { f32x4 t[8];
#pragma unroll
      for (int q = 0; q < 8; ++q) t[q] = *(const f32x4*)(a.w_router + 4 * (tid + NTHR * q));
#pragma unroll
      for (int q = 0; q < 8; ++q) { const int i = 4 * (tid + NTHR * q), col = i >> 4, e = i & 15;
#pragma unroll
          for (int k = 0; k < 4; ++k) wrt[(e + k) * 1024 + col] = t[q][k]; } }
    __syncthreads();
    f32x4 av[4], sh[4];
#pragma unroll
    for (int j = 0; j < 4; ++j) { const int col = 4 * lane + 256 * j; const f32x4 g = *(const f32x4*)(a.norm_ffn_g + col); const f32x4 sc = *(const f32x4*)(MOD + 4 * DM + col); av[j] = g * (sc + 1.f); sh[j] = *(const f32x4*)(MOD + 3 * DM + col); }
    const int gw = vcu * NWAVES + wave, NGW = G * NWAVES;
    f32x4 v[4], vn[4];
    if (gw < NTOK) { const GAS f32x4* xr = (const GAS f32x4*)(X1 + (size_t)gw * DM) + lane;
#pragma unroll
        for (int j = 0; j < 4; ++j) v[j] = xr[64 * j]; }
    for (int m = gw; m < NTOK; m += NGW) {
        const int mn = m + NGW;
        if (mn < NTOK) { const GAS f32x4* xr = (const GAS f32x4*)(X1 + (size_t)mn * DM) + lane;
#pragma unroll
            for (int j = 0; j < 4; ++j) vn[j] = xr[64 * j]; }
        float s = 0.f;
#pragma unroll
        for (int j = 0; j < 4; ++j) s += (v[j].x * v[j].x + v[j].y * v[j].y) + (v[j].z * v[j].z + v[j].w * v[j].w);
        const float rinv = 1.f / sqrtf(wave_sum(s) * (1.f / DM) + EPS);
        GAS unsigned* o4 = (GAS unsigned*)((unsigned char*)H2 + (size_t)m * DM) + lane;
#pragma unroll
        for (int j = 0; j < 4; ++j) { v[j] = v[j] * rinv * av[j] + sh[j]; o4[64 * j] = pk4_fp8(v[j].x, v[j].y, v[j].z, v[j].w); }
        float lg[16];
#pragma unroll
        for (int e0 = 0; e0 < 16; e0 += 4) {
#pragma unroll
            for (int e = e0; e < e0 + 4; ++e) { float p = 0.f;
#pragma unroll
                for (int j = 0; j < 4; ++j) { const f32x4 w = *(const LAS f32x4*)(wrt + e * 1024 + 4 * lane + 256 * j); p += (v[j].x * w.x + v[j].y * w.y) + (v[j].z * w.z + v[j].w * w.w); }
                lg[e] = p; }
            asm volatile("" ::: "memory"); }
        float r8[8], r4[4], r2[2], r1;
        { const bool up = (lane & 32) != 0;
#pragma unroll
          for (int e = 0; e < 8; ++e) { const float snd = up ? lg[e] : lg[e + 8], kp = up ? lg[e + 8] : lg[e]; r8[e] = kp + __shfl_xor(snd, 32); } }
        { const bool up = (lane & 16) != 0;
#pragma unroll
          for (int e = 0; e < 4; ++e) { const float snd = up ? r8[e] : r8[e + 4], kp = up ? r8[e + 4] : r8[e]; r4[e] = kp + __shfl_xor(snd, 16); } }
        { const bool up = (lane & 8) != 0;
#pragma unroll
          for (int e = 0; e < 2; ++e) { const float snd = up ? r4[e] : r4[e + 2], kp = up ? r4[e + 2] : r4[e]; r2[e] = kp + __shfl_xor(snd, 8); } }
        { const bool up = (lane & 4) != 0; const float snd = up ? r2[0] : r2[1], kp = up ? r2[1] : r2[0]; r1 = kp + __shfl_xor(snd, 4); }
        r1 += __shfl_xor(r1, 2); r1 += __shfl_xor(r1, 1);
        float mx = r1;
#pragma unroll
        for (int o = 4; o < 64; o <<= 1) mx = fmaxf(mx, __shfl_xor(mx, o));
        const float ex = __expf(r1 - mx); float den = ex;
#pragma unroll
        for (int o = 4; o < 64; o <<= 1) den += __shfl_xor(den, o);
        if ((lane & 3) == 0) AFF[(size_t)(lane >> 2) * NTOK + m] = ex / den;
#pragma unroll
        for (int j = 0; j < 4; ++j) v[j] = vn[j];
    }
}

__device__ __forceinline__ void p4_topk(const Args& a, LAS unsigned char* lds, int e, int wave) {
    const int lane = fresh_lane(), tid = wave * 64 + lane;
    unsigned char* ws = a.ws; const unsigned* AFF = (const unsigned*)(ws + WS_AFF) + (size_t)e * NTOK;
    int* IDX = (int*)(ws + WS_IDX) + e * CAP; float* GATE = (float*)(ws + WS_GATE) + e * CAP; int* TOKSLOT = (int*)(ws + WS_TOKSLOT);
    LAS unsigned* wcnt = (LAS unsigned*)lds;
    LAS unsigned* cg = wcnt + 16;
    LAS unsigned* ce = cg + 256;
    unsigned key[32];
#pragma unroll
    for (int i = 0; i < 32; ++i) key[i] = AFF[i * NTHR + tid];
    unsigned T = 0u;
#pragma unroll 1
    for (int bit = 30; bit >= 0; --bit) {
        const unsigned cand = T | (1u << bit);
        unsigned c = 0u;
#pragma unroll
        for (int i = 0; i < 32; ++i) c += (unsigned)__popcll(__ballot(key[i] >= cand));
        LAS unsigned* wb = wcnt + 1024 + (bit & 1) * 8;
        if (lane == 0) wb[wave] = c;
        __syncthreads();
        unsigned tot = 0u;
#pragma unroll
        for (int w = 0; w < 8; ++w) tot += wb[w];
        if (tot >= (unsigned)CAP) T = cand;
    }
    __syncthreads();
    unsigned long long below = (1ull << lane) - 1ull;
    unsigned rg[32], rq[32];
#pragma unroll
    for (int i = 0; i < 32; ++i) {
        const unsigned long long bg = __ballot(key[i] > T), bq = __ballot(key[i] == T);
        rg[i] = (unsigned)__popcll(bg & below); rq[i] = (unsigned)__popcll(bq & below);
        if (lane == 0) { cg[i * 8 + wave] = (unsigned)__popcll(bg); ce[i * 8 + wave] = (unsigned)__popcll(bq); }
    }
    __syncthreads();
    if (wave == 0) {
        unsigned g4[4], q4[4], sg = 0u, sq = 0u;
#pragma unroll
        for (int k = 0; k < 4; ++k) { g4[k] = cg[4 * lane + k]; q4[k] = ce[4 * lane + k]; sg += g4[k]; sq += q4[k]; }
        unsigned pg = sg, pq = sq;
#pragma unroll
        for (int o = 1; o < 64; o <<= 1) { const unsigned tg = __shfl_up(pg, o), tq = __shfl_up(pq, o); if (lane >= o) { pg += tg; pq += tq; } }
        pg -= sg; pq -= sq;
#pragma unroll
        for (int k = 0; k < 4; ++k) { cg[4 * lane + k] = pg; ce[4 * lane + k] = pq; pg += g4[k]; pq += q4[k]; }
        if (lane == 63) { wcnt[8] = pg; }
    }
    __syncthreads();
    const unsigned ngt = wcnt[8], need = (unsigned)CAP - ngt;
#pragma unroll
    for (int i = 0; i < 32; ++i) {
        const int tok = i * NTHR + tid;
        const unsigned gb = cg[i * 8 + wave] + rg[i], qb = ce[i * 8 + wave] + rq[i];
        const bool sel = key[i] > T || (key[i] == T && qb < need);
        const unsigned slot = gb + (qb < need ? qb : need);
        if (sel) { IDX[slot] = tok; GATE[slot] = __uint_as_float(key[i]); }
        TOKSLOT[tok * 16 + e] = sel ? (int)slot : -1;
    }
}

struct P5Prob {
    static constexpr int K = DM; static constexpr bool PERM = true, FP8 = true; static constexpr int SCW = 0x7A7A7A7A, SCA = 0x7F7F7F7F;
    const unsigned char* H2; const unsigned char* WguT; bf16* HID; pg8::StaticOrder so;
    __device__ __forceinline__ bool next(int i, pg8::Unit& u) const { return so.next(i, u); }
    __device__ __forceinline__ const char* aptr(const pg8::Unit&) const { return (const char*)H2; }
    __device__ __forceinline__ const char* bptr(const pg8::Unit& u) const { return (const char*)(WguT + ((size_t)(u.pm >> 3) * 4096 + (size_t)u.pn * 256) * DM); }
    __device__ __forceinline__ void epi(const pg8::f32x4 (&acc)[2][2][4][2], const pg8::Unit& u, int wr, int wc, int fr, int fq) const {
#pragma unroll
        for (int ai = 0; ai < 2; ++ai)
#pragma unroll
            for (int m = 0; m < 4; ++m) { bf16* rowp = HID + (size_t)(u.pm * 256 + ai * 128 + wr * 64 + m * 16 + fr) * DE + u.pn * 128 + wc * 32 + 8 * fq;
                float h[8];
#pragma unroll
                for (int n = 0; n < 2; ++n)
#pragma unroll
                    for (int e = 0; e < 4; ++e) { const float gt = acc[ai][0][m][n][e], up = acc[ai][1][m][n][e]; h[4 * n + e] = gt * __builtin_amdgcn_rcpf(1.f + __builtin_amdgcn_exp2f(-1.4426950408889634f * gt)) * up; }
                *(v4u*)rowp = (v4u){pk2(h[0], h[1]), pk2(h[2], h[3]), pk2(h[4], h[5]), pk2(h[6], h[7])}; }
    }
};
struct P6Prob {
    static constexpr int K = DE; static constexpr bool PERM = true, FP8 = false; static constexpr int SCW = 0, SCA = 0;
    const bf16* HID; const bf16* WdT; const float* GATE; bf16* YE; pg8::StaticOrder so;
    __device__ __forceinline__ bool next(int i, pg8::Unit& u) const { return so.next(i, u); }
    __device__ __forceinline__ const char* aptr(const pg8::Unit& u) const { return (const char*)(HID + (size_t)u.pm * 256 * DE); }
    __device__ __forceinline__ const char* bptr(const pg8::Unit& u) const { return (const char*)(WdT + ((size_t)(u.pm >> 3) * DM + (size_t)u.pn * 256) * DE); }
    __device__ __forceinline__ void epi(const pg8::f32x4 (&acc)[2][2][4][2], const pg8::Unit& u, int wr, int wc, int fr, int fq) const {
#pragma unroll
        for (int ai = 0; ai < 2; ++ai)
#pragma unroll
            for (int m = 0; m < 4; ++m) { const int row = u.pm * 256 + ai * 128 + wr * 64 + m * 16 + fr; const float gt = GATE[row]; bf16* rowp = YE + (size_t)row * DM + u.pn * 256 + wc * 32 + 8 * fq;
#pragma unroll
                for (int bj = 0; bj < 2; ++bj) { const pg8::f32x4 v0 = acc[ai][bj][m][0] * gt, v1 = acc[ai][bj][m][1] * gt;
                    *(v4u*)(rowp + bj * 128) = (v4u){pk2(v0[0], v0[1]), pk2(v0[2], v0[3]), pk2(v1[0], v1[1]), pk2(v1[2], v1[3])}; } }
    }
};

__device__ __forceinline__ void p7_final(const Args& a, int vcu, int G, int wave, unsigned poison) {
    const int lane = fresh_lane();
    unsigned char* ws = a.ws; const float* MOD = (const float*)(ws + WS_MOD); const bf16* YE = (const bf16*)(ws + WS_YE); const int* TOKSLOT = (const int*)(ws + WS_TOKSLOT);
    const float* src = (STEP >= 2) ? (const float*)(ws + WS_X1) : a.x;
    f32x4 g2[4], fg[4];
#pragma unroll
    for (int j = 0; j < 4; ++j) { const int col = 4 * lane + 256 * j; g2[j] = *(const f32x4*)(MOD + 5 * DM + col); fg[j] = *(const f32x4*)(a.final_norm_g + col); }
    const int gw = vcu * NWAVES + wave, NGW = G * NWAVES;
    for (int m = gw; m < NTOK; m += NGW) {
        const GAS f32x4* xr = (const GAS f32x4*)(src + (size_t)m * DM) + lane;
        f32x4 v[4];
#pragma unroll
        for (int j = 0; j < 4; ++j) v[j] = xr[64 * j];
        if (STEP >= 4) {
            const int myslot = lane < 16 ? TOKSLOT[m * 16 + lane] : -1;
            f32x4 s[4];
#pragma unroll
            for (int j = 0; j < 4; ++j) s[j] = (f32x4){0.f, 0.f, 0.f, 0.f};
#pragma unroll 1
            for (int e = 0; e < 16; ++e) {
                const int sl = __builtin_amdgcn_readlane(myslot, e);
                if (sl >= 0) {
                    const GAS v2u* yr = (const GAS v2u*)(YE + ((size_t)e * CAP + sl) * DM) + lane;
#pragma unroll
                    for (int j = 0; j < 4; ++j) { const v2u w = yr[64 * j]; s[j].x += __uint_as_float(w.x << 16); s[j].y += __uint_as_float(w.x & 0xffff0000u); s[j].z += __uint_as_float(w.y << 16); s[j].w += __uint_as_float(w.y & 0xffff0000u); }
                }
            }
#pragma unroll
            for (int j = 0; j < 4; ++j) v[j] += g2[j] * s[j];
        }
        float ss = 0.f;
#pragma unroll
        for (int j = 0; j < 4; ++j) ss += (v[j].x * v[j].x + v[j].y * v[j].y) + (v[j].z * v[j].z + v[j].w * v[j].w);
        const float rinv = 1.f / sqrtf(wave_sum(ss) * (1.f / DM) + EPS);
        GAS f32x4* o = (GAS f32x4*)(a.out + (size_t)m * DM) + lane;
        const float q = __builtin_nanf("");
#pragma unroll
        for (int j = 0; j < 4; ++j) { f32x4 y = v[j] * rinv * fg[j]; if (poison) y = (f32x4){q, q, q, q}; o[64 * j] = y; }
    }
}


#if PROBE
__device__ __forceinline__ void dsincos(double x, double& sn, double& cs) {
    const double TWO_PI = 6.283185307179586476925286766559; x -= TWO_PI * rint(x / TWO_PI);
    const double x2 = x * x; double ts = x, tc = 1.0; sn = x; cs = 1.0;
#pragma unroll 1
    for (int k = 1; k <= 14; ++k) { tc *= -x2 / (double)((2 * k - 1) * (2 * k)); ts *= -x2 / (double)((2 * k) * (2 * k + 1)); cs += tc; sn += ts; }
}
__device__ __forceinline__ float block_sum(float v, LAS float* red, int wave, int lane) {
    v = wave_sum(v); __syncthreads(); if (lane == 0) red[wave] = v; __syncthreads(); float s = 0.f;
#pragma unroll
    for (int w = 0; w < 8; ++w) s += red[w];
    return s;
}
__device__ __forceinline__ float block_max(float v, LAS float* red, int wave, int lane) {
#pragma unroll
    for (int o = 1; o < 64; o <<= 1) v = fmaxf(v, __shfl_xor(v, o));
    __syncthreads(); if (lane == 0) red[wave] = v; __syncthreads(); float s = red[0];
#pragma unroll
    for (int w = 1; w < 8; ++w) s = fmaxf(s, red[w]);
    return s;
}
__device__ __forceinline__ void probe_qkv(const Args& a, LAS unsigned char* lds, int vcu, int wave) {
    const int lane = fresh_lane(), tid = wave * 64 + lane; unsigned char* ws = a.ws;
    const bf16* XN = (const bf16*)(ws + WS_XN); const bf16* Qb = (const bf16*)(ws + WS_Q); const bf16* Kb = (const bf16*)(ws + WS_K); const bf16* Vb = (const bf16*)(ws + WS_V);
    gu32* ctl = (gu32*)(ws + WS_CTL);
    LAS float* red = (LAS float*)lds; LAS float* raw = red + 16;
    for (int kind = 0; kind < 3; ++kind) {
        const int nrows = kind == 0 ? NTOK : NROWS, nh = kind == 0 ? NHQ : NHKV;
        const int t = (kind == 1 && (vcu & 7) == 3) ? NTOK + (vcu * 37) % NCTX : (vcu * 977 + 131 * kind + 5) % (kind == 0 ? NTOK : NTOK);
        const int h = (vcu * 5 + kind) % nh;
        const int wcol0 = 256 + (kind == 0 ? 0 : (kind == 1 ? 768 : 1024)) + 64 * h;
        { const int d = tid & 63, part = tid >> 6; float sacc = 0.f;
          for (int k = part * 128; k < part * 128 + 128; ++k) sacc += bf2f(XN[(size_t)t * DM + k]) * a.w_in[(size_t)k * INW + wcol0 + d];
          LAS float* part_s = raw + 64; part_s[part * 64 + d] = sacc; __syncthreads();
          if (tid < 64) { float s2 = 0.f; for (int pp = 0; pp < 8; ++pp) s2 += part_s[pp * 64 + tid]; raw[tid] = s2; }
          __syncthreads(); }
        float ref = 0.f, got = 0.f;
        if (tid < 64) {
            const int d = tid; float v = raw[d];
            if (kind < 2) {
                float ss = 0.f; for (int j = 0; j < 64; ++j) ss += raw[j] * raw[j];
                const float* gw = kind == 0 ? a.q_norm_g : a.k_norm_g;
                const float rinv = 1.f / sqrtf(ss / 64.f + EPS);
                if (t < NTOK) {
                    const int half = d >> 5, dd = d & 31, i = dd & 15; const int pos = half == 0 ? (t >> 6) : (t & 63);
                    const double freq = exp2(-(double)i * (13.287712379549449 / 16.0)); double sn, cs; dsincos((double)pos * freq, sn, cs);
                    const float x1 = raw[32 * half + i] * rinv * gw[32 * half + i], x2 = raw[32 * half + 16 + i] * rinv * gw[32 * half + 16 + i];
                    v = dd < 16 ? (float)(x1 * cs - x2 * sn) : (float)(x1 * sn + x2 * cs);
                } else v = v * rinv * gw[d];
                if (kind == 0) v *= attn_body::C2;
            }
            ref = v;
            got = kind == 0 ? bf2f(Qb[(size_t)t * 768 + 64 * h + d]) : (kind == 1 ? bf2f(Kb[(size_t)t * 256 + 64 * h + d]) : bf2f(Vb[(size_t)t * 256 + 64 * h + d]));
        }
        const float mx = block_max(fabsf(ref), red, wave, lane);
        const float err = block_max(fabsf(ref - got), red, wave, lane);
        if (tid == 0 && !(err <= 0.03f * mx + 1e-6f)) __hip_atomic_fetch_or(ctl + CW_FLAG, 1u << kind, RLX_AGENT);
        __syncthreads();
    }
}
__device__ __forceinline__ void probe_attn(const Args& a, LAS unsigned char* lds, int vcu, int wave) {
    const int lane = fresh_lane(), tid = wave * 64 + lane; unsigned char* ws = a.ws;
    const bf16* Qb = (const bf16*)(ws + WS_Q); const bf16* Kb = (const bf16*)(ws + WS_K); const bf16* Vb = (const bf16*)(ws + WS_V); const bf16* MIX = (const bf16*)(ws + WS_MIX);
    gu32* ctl = (gu32*)(ws + WS_CTL);
    LAS float* red = (LAS float*)lds; LAS float* ored = red + 16;
    const int t = (vcu * 613 + 29) % NTOK, h = (vcu * 7 + 3) % NHQ, kvh = h / 3;
    float q[64];
#pragma unroll
    for (int d = 0; d < 64; ++d) q[d] = bf2f(Qb[(size_t)t * 768 + 64 * h + d]);
    float sc[33]; float mx = -1e30f;
#pragma unroll
    for (int i = 0; i < 33; ++i) { const int key = i * NTHR + tid; float s = -1e30f;
        if (key < NKEYS) { s = 0.f; const bf16* kr = Kb + (size_t)key * 256 + 64 * kvh;
#pragma unroll
            for (int d = 0; d < 64; ++d) s += q[d] * bf2f(kr[d]); }
        sc[i] = s; mx = fmaxf(mx, s); }
    mx = block_max(mx, red, wave, lane);
    float den = 0.f; float o[64];
#pragma unroll
    for (int d = 0; d < 64; ++d) o[d] = 0.f;
#pragma unroll
    for (int i = 0; i < 33; ++i) { const int key = i * NTHR + tid;
        if (key < NKEYS) { const float pp = exp2f(sc[i] - mx); den += pp; const bf16* vr = Vb + (size_t)key * 256 + 64 * kvh;
#pragma unroll
            for (int d = 0; d < 64; ++d) o[d] += pp * bf2f(vr[d]); } }
    den = block_sum(den, red, wave, lane);
#pragma unroll
    for (int d = 0; d < 64; ++d) { const float w = wave_sum(o[d]); if (lane == 0) ored[wave * 64 + d] = w; }
    __syncthreads();
    float ref = 0.f, got = 0.f;
    if (tid < 64) { float s = 0.f; for (int w = 0; w < 8; ++w) s += ored[w * 64 + tid]; ref = s / den; got = bf2f(MIX[(size_t)t * DM + 256 + 64 * h + tid]); }
    const float m2 = block_max(fabsf(ref), red, wave, lane);
    const float err = block_max(fabsf(ref - got), red, wave, lane);
    if (tid == 0 && !(err <= 0.03f * m2 + 1e-7f)) __hip_atomic_fetch_or(ctl + CW_FLAG, 8u, RLX_AGENT);
    __syncthreads();
}
#endif

__global__ void __launch_bounds__(NTHR, 2) fwd_megakernel(Args args) {
    extern __shared__ __attribute__((aligned(16))) unsigned char lds_raw[];
    LAS unsigned char* lds = (LAS unsigned char*)lds_raw;
    volatile LAS unsigned* MISC = (volatile LAS unsigned*)(lds + MISC_OFF);
    const int wave = __builtin_amdgcn_readfirstlane(threadIdx.x >> 6);
    const int G = gridDim.x; const int bx = blockIdx.x; const int vcu = (G % 8 == 0) ? (bx % 8) * (G / 8) + bx / 8 : bx;
    unsigned char* ws = args.ws;
    gu32* ctl = (gu32*)(ws + WS_CTL);
    { const int l0 = fresh_lane(); if (wave < 2) ((LAS unsigned*)(lds + MISC_OFF))[wave * 64 + l0] = 0u;
      __syncthreads();
    }
    XcdBarrier bar = xcd_barrier_post((unsigned*)(ctl + CW_BAR), MISC + 8, wave == 0 && fresh_lane() == 0);
#define GRID_BAR() xcd_barrier(bar, wave)

    for (int rep = 0; rep < REP(0); ++rep) {
    if (STEP >= 2 && PH(0)) p0_prologue(args, lds, vcu, G, wave);
    GRID_BAR(); }
    for (int rep = 0; rep < REP(1); ++rep) {
    if (STEP >= 2 && PH(1)) p0b_modulate(args, vcu, G, wave);
    GRID_BAR(); }
    for (int rep = 0; rep < REP(2); ++rep) {
    if (STEP >= 2 && PH(2)) {
        P1Prob p; p.XN = (bf16*)(ws + WS_XN); p.WinT = (bf16*)(ws + WS_WIN); p.Q = (bf16*)(ws + WS_Q); p.Kb = (bf16*)(ws + WS_K); p.Vb = (bf16*)(ws + WS_V); p.FT = (float*)(ws + WS_FT);
        p.qg = args.q_norm_g; p.kg = args.k_norm_g; p.kmax = (unsigned*)(ctl + CW_KMAX); p.so.init(NROWS / 256, INW / 256, G, bx);
        pg8::gemm_phase<P1Prob, false, true, true>(lds, p, nullptr, wave);
        if (rep == 0 && MOE_S1 > 0) {
            const int nwg = (NROWS / 256) * (INW / 256), maxc = (nwg + G - 1) / G, c0 = nwg - (maxc - 1) * G;
            if (c0 >= G) moe_convert(args, (LAS float*)(lds + wave * 16640), MOE_B0, MOE_B1, bx * NWAVES + wave, G * NWAVES);
            else if (bx >= c0) moe_convert(args, (LAS float*)(lds + wave * 16640), MOE_B0, MOE_B1, (bx - c0) * NWAVES + wave, (G - c0) * NWAVES);
        }
    }
    GRID_BAR(); }
#if PROBE == 1
    probe_qkv(args, lds, vcu, wave);
#endif
    for (int rep = 0; rep < REP(3); ++rep) {
    if (STEP >= 2 && PH(3)) {
        for (int item = vcu; item < 256; item += G) fft_block(args, lds, item, wave);
        if (rep == 0 && MOE_S2 > 0) {
            if (G > 256) { if (vcu >= 256) moe_convert(args, (LAS float*)(lds + wave * 16640), MOE_B1, MOE_B2, (vcu - 256) * NWAVES + wave, (G - 256) * NWAVES); }
            else moe_convert(args, (LAS float*)(lds + wave * 16640), MOE_B1, MOE_B2, vcu * NWAVES + wave, G * NWAVES);
        }
    }
    if (rep + 1 < REP(3)) GRID_BAR(); }
    for (int rep = 0; rep < REP(4); ++rep) {
    if (STEP >= 3 && PH(4)) {
        const attn_body::bf16* Qb = (const attn_body::bf16*)(ws + WS_Q); const attn_body::bf16* Kb = (const attn_body::bf16*)(ws + WS_K); const attn_body::bf16* Vb = (const attn_body::bf16*)(ws + WS_V);
        attn_body::bf16* MIX = (attn_body::bf16*)(ws + WS_MIX);
        const float kmax2 = __uint_as_float(__hip_atomic_load(ctl + CW_KMAX, RLX_AGENT));
        const int u0 = (G == 256) ? vcu * 3 : vcu, ustep = (G == 256) ? 1 : G, uend = (G == 256) ? vcu * 3 + 3 : 768;
#pragma unroll 1
        for (int u = u0; u < uend; u += ustep) {
            const int kvh = u / 192, w = u % 192, h = kvh * 3 + w / 64, qb = w % 64;
            attn_body::attn_unit<8>(h, kvh, qb, Qb, Kb, Vb, MIX, (char*)lds_raw, wave, kmax2);
        }
    } else if (STEP == 2) {
        bf16* MIX = (bf16*)(ws + WS_MIX);
        const int gw = vcu * NWAVES + wave, NGW = G * NWAVES, lane = fresh_lane();
        for (int m = gw; m < NTOK; m += NGW) { GAS v4u* o = (GAS v4u*)(MIX + (size_t)m * DM + 256); o[lane] = (v4u){0u, 0u, 0u, 0u}; if (lane < 32) o[64 + lane] = (v4u){0u, 0u, 0u, 0u}; }
    }
    GRID_BAR(); }
#if PROBE == 2
    probe_attn(args, lds, vcu, wave);
#endif
    for (int rep = 0; rep < REP(5); ++rep) {
    if (STEP >= 2 && PH(5)) {
        P3Prob p; p.MIX = (bf16*)(ws + WS_MIX); p.WoT = (bf16*)(ws + WS_WOUT); p.x = args.x; p.g1 = (const float*)(ws + WS_MOD) + 2 * DM; p.X1 = (float*)(ws + WS_X1); p.so.init(NTOK / 256, DM / 256, G, bx);
        pg8::gemm_phase<P3Prob, false, true, true>(lds, p, nullptr, wave);
    }
    GRID_BAR(); }
    for (int rep = 0; rep < REP(6); ++rep) {
    if (STEP >= 4 && PH(6)) p3b_router(args, lds, vcu, G, wave);
    GRID_BAR(); }
    for (int rep = 0; rep < REP(7); ++rep) {
    if (STEP >= 4 && PH(7)) {
#pragma unroll 1
        for (int e = vcu; e < NE; e += G) p4_topk(args, lds, e, wave);
        if (rep == 0) {
            if (G > NE) { if (vcu >= NE) moe_convert(args, (LAS float*)(lds + wave * 16640), MOE_B2, MOE_ITEMS, (vcu - NE) * NWAVES + wave, (G - NE) * NWAVES); }
            else moe_convert(args, (LAS float*)(lds + wave * 16640), MOE_B2, MOE_ITEMS, vcu * NWAVES + wave, G * NWAVES);
        } }
    GRID_BAR(); }
    for (int rep = 0; rep < REP(8); ++rep) {
    if (STEP >= 4 && PH(8)) {
        P5Prob p; p.H2 = (const unsigned char*)(ws + WS_H2); p.WguT = (const unsigned char*)(ws + WS_WGU); p.HID = (bf16*)(ws + WS_HID); p.so.init(NE * CAP / 256, 2 * DE / 256, G, bx);
        LAS unsigned* rowtab = (LAS unsigned*)(lds + XTRA_OFF);
        const int* IDX = (const int*)(ws + WS_IDX);
        { const int tid = wave * 64 + fresh_lane(); pg8::Unit u; for (int i = 0; p.so.next(i, u) && i < 28; ++i) { if (tid < 256) rowtab[i * 256 + tid] = (unsigned)IDX[u.pm * 256 + tid]; } }
        __syncthreads();
        pg8::gemm_phase<P5Prob, true, true, true>(lds, p, rowtab, wave);
    }
    GRID_BAR(); }
    for (int rep = 0; rep < REP(9); ++rep) {
    if (STEP >= 4 && PH(9)) {
        P6Prob p; p.HID = (bf16*)(ws + WS_HID); p.WdT = (bf16*)(ws + WS_WD); p.GATE = (const float*)(ws + WS_GATE); p.YE = (bf16*)(ws + WS_YE); p.so.init(NE * CAP / 256, DM / 256, G, bx);
        pg8::gemm_phase<P6Prob, false, true, true>(lds, p, nullptr, wave);
    }
    GRID_BAR(); }
    {
        unsigned poison = (__hip_atomic_load(ctl + CW_BAR + XB_TMO, RLX_AGENT) != 0u) || (__hip_atomic_load(ctl + CW_FLAG, RLX_AGENT) != 0u);
        for (int rep = 0; rep < REP(10); ++rep) p7_final(args, vcu, G, wave, poison);
    }
}

extern "C" void kernel_launch(void* const* d_in, const int* in_sizes, int n_in, void* d_out, int out_size, void* d_ws, size_t ws_size, hipStream_t stream) {
    static int grid = 0;
    if (grid == 0) {
        if (n_in != 18 || in_sizes[0] != NTOK * DM || out_size != NTOK * DM || ws_size < WS_END) { fprintf(stderr, "kernel_launch: unexpected shapes (n_in %d, in0 %d, out %d, ws %zu)\n", n_in, n_in > 0 ? in_sizes[0] : -1, out_size, ws_size); grid = -1; return; }
        int dev = 0, cus = 0, per_cu = 0;
        if (hipGetDevice(&dev) != hipSuccess || hipDeviceGetAttribute(&cus, hipDeviceAttributeMultiprocessorCount, dev) != hipSuccess) { grid = -1; return; }
        if (hipFuncSetAttribute((const void*)fwd_megakernel, hipFuncAttributeMaxDynamicSharedMemorySize, LDS_BYTES) != hipSuccess) { fprintf(stderr, "kernel_launch: hipFuncSetAttribute failed\n"); grid = -1; return; }
        if (hipOccupancyMaxActiveBlocksPerMultiprocessor(&per_cu, (const void*)fwd_megakernel, NTHR, LDS_BYTES) != hipSuccess || per_cu < 1) { fprintf(stderr, "kernel_launch: occupancy query says %d blocks per CU\n", per_cu); (void)hipGetLastError(); grid = -1; return; }
        grid = cus;
    }
    if (grid < 0) return;
    (void)hipMemsetAsync((char*)d_ws + WS_CTL, 0, CTL_ZERO_BYTES, stream);
    Args a{};
    const float** f = (const float**)&a;
    for (int i = 0; i < 18; ++i) f[i] = (const float*)d_in[i];
    a.out = (float*)d_out; a.ws = (unsigned char*)d_ws;
    hipLaunchKernelGGL(fwd_megakernel, dim3(grid), dim3(NTHR), LDS_BYTES, stream, a);
}
```

```cpp
#include <hip/hip_runtime.h>
#include <hip/hip_bf16.h>
#include <cstdio>
#include <cstdint>
#include <cmath>

#ifndef STEP
#define STEP 4
#endif
#ifndef PROBE
#define PROBE 0
#endif
#ifndef PHMASK
#define PHMASK 0xFFFF
#endif
#define PH(k) ((PHMASK >> (k)) & 1)
#ifndef REPEAT
#define REPEAT 0
#endif
#define REP(k) (((REPEAT >> (k)) & 1) + 1)

constexpr int DM = 1024, NTOK = 16384, NCTX = 256, NROWS = NTOK + NCTX, INW = 1536;
constexpr int NHQ = 12, NHKV = 4, HD = 64, NE = 16, CAP = 2048, DE = 2048, NMOD = 6;
constexpr int NKEYS = NROWS;
constexpr float EPS = 1e-6f;

__device__ __forceinline__ int fresh_lane() { int l; asm volatile("v_mbcnt_lo_u32_b32 %0, -1, 0\n\tv_mbcnt_hi_u32_b32 %0, -1, %0" : "=v"(l)); return l; }

namespace pg8 {
#define PG8_LAS __attribute__((address_space(3)))
typedef unsigned short bf16_t;
typedef short bf16x8 __attribute__((ext_vector_type(8)));
typedef float f32x4 __attribute__((ext_vector_type(4)));
typedef unsigned u32x4 __attribute__((ext_vector_type(4)));
typedef unsigned u32x2 __attribute__((ext_vector_type(2)));
typedef int v8i __attribute__((ext_vector_type(8)));
constexpr int BM = 256, BK = 64, HALF = 128, HTB = HALF * BK * 2, STAGE_BYTES = 8 * HTB, NXCD = 8, WGM = 8;

__host__ __device__ __forceinline__ int lds_byte(int r, int c) { const int st = (r >> 4) * 2 + (c >> 5), rr = r & 15, cc = c & 31, ob = rr * 64 + cc * 2; return st * 1024 + (ob ^ (((ob >> 9) & 1) << 5)); }
__host__ __device__ __forceinline__ void stage_rc(int b, int& R, int& C) { const int st = b / 1024, sb = b % 1024, swz = sb ^ (((sb >> 9) & 1) << 5); R = (st >> 1) * 16 + swz / 64; C = (st & 1) * 32 + (swz % 64) / 2; }
__host__ __device__ __forceinline__ int perm32(int rho) { const int n = rho >> 4, i = rho & 15; return 8 * (i >> 2) + 4 * n + (i & 3); }

struct Unit { int pm, pn; };

struct StaticOrder {
    int nM, nN, nwg, G, c;
    __host__ __device__ void init(int nM_, int nN_, int G_, int c_) { nM = nM_; nN = nN_; nwg = nM * nN; G = G_; c = c_; }
    __host__ __device__ bool next(int i, Unit& u) const {
        const long L = (long)i * G + c; if (L >= nwg) return false;
        int wgid = (int)L; { const int q = nwg / NXCD, r = nwg % NXCD, xcd = wgid % NXCD, off = wgid / NXCD; wgid = (xcd < r ? xcd * (q + 1) : r * (q + 1) + (xcd - r) * q) + off; }
        const int nig = WGM * nN, gid = wgid / nig, fm = gid * WGM, gsz = (nM - fm) < WGM ? (nM - fm) : WGM;
        u.pm = fm + ((wgid % nig) % gsz); u.pn = (wgid % nig) / gsz; return true;
    }
};

__device__ __forceinline__ unsigned cvt_pk_bf16(float lo, float hi) { unsigned r; asm volatile("v_cvt_pk_bf16_f32 %0, %1, %2" : "=v"(r) : "v"(lo), "v"(hi)); return r; }

template <class P, bool GATHER, bool ALIGN_EPI, bool SP2>
__device__ __forceinline__ void gemm_phase(PG8_LAS unsigned char* lds, const P& S, const PG8_LAS unsigned* rowtab, int wid) {
    const int lane = fresh_lane(), tid = wid * 64 + lane, wr = wid >> 2, wc = wid & 3, fr = lane & 15, fq = lane >> 4;
    constexpr bool F8 = P::FP8; constexpr int ESZ = F8 ? 1 : 2;
    constexpr int K = P::K, nt = F8 ? K / 128 : K / BK;
    int R0, C0; stage_rc(tid * 16, R0, C0);
    unsigned voffB[2];
#pragma unroll
    for (int i = 0; i < 2; ++i) { const int R = R0 + 64 * i; const int Rb = P::PERM ? ((R & ~31) + perm32(R & 31)) : R; voffB[i] = (unsigned)(Rb * K * ESZ + C0 * 2); }
    constexpr size_t kstep = (size_t)(BK * 2);
    constexpr size_t hstep = (size_t)HALF * K * ESZ;
    const unsigned ldsw = (unsigned)wid * 1024u;
    const int aoff = F8 ? lds_byte(wr * 64 + fr, fq * 16) : lds_byte(wr * 64 + fr, fq * 8), boff = F8 ? lds_byte(wc * 32 + fr, fq * 16) : lds_byte(wc * 32 + fr, fq * 8);
#define PG8_SA(b, h) (((b) * 2 + (h)) * HTB)
#define PG8_SB(b, h) ((4 + (b) * 2 + (h)) * HTB)
#define PG8_STAGE(bufoff, gbase, voff) do { _Pragma("unroll") for (int _i = 0; _i < 2; ++_i) \
        __builtin_amdgcn_global_load_lds((const unsigned*)((const char*)(gbase) + (voff)[_i]), (PG8_LAS unsigned*)(lds + (bufoff) + ldsw + _i * 8192), 16, 0, 0); } while (0)
#define PG8_LDA(dst, b, h) do { if constexpr (F8) { _Pragma("unroll") for (int m = 0; m < 4; ++m) { const PG8_LAS u32x4* p_ = (const PG8_LAS u32x4*)(lds + PG8_SA(b, h) + aoff + m * 2048); const u32x4 lo_ = p_[0], hi_ = p_[1]; \
            dst##8[m] = (v8i){(int)lo_.x, (int)lo_.y, (int)lo_.z, (int)lo_.w, (int)hi_.x, (int)hi_.y, (int)hi_.z, (int)hi_.w}; } } \
        else { _Pragma("unroll") for (int m = 0; m < 4; ++m) _Pragma("unroll") for (int k = 0; k < 2; ++k) dst[m][k] = *(const PG8_LAS bf16x8*)(lds + PG8_SA(b, h) + aoff + m * 2048 + k * 1024); } } while (0)
#define PG8_LDB(dst, b, h) do { if constexpr (F8) { _Pragma("unroll") for (int n = 0; n < 2; ++n) { const PG8_LAS u32x4* p_ = (const PG8_LAS u32x4*)(lds + PG8_SB(b, h) + boff + n * 2048); const u32x4 lo_ = p_[0], hi_ = p_[1]; \
            dst##8[n] = (v8i){(int)lo_.x, (int)lo_.y, (int)lo_.z, (int)lo_.w, (int)hi_.x, (int)hi_.y, (int)hi_.z, (int)hi_.w}; } } \
        else { _Pragma("unroll") for (int n = 0; n < 2; ++n) _Pragma("unroll") for (int k = 0; k < 2; ++k) dst[n][k] = *(const PG8_LAS bf16x8*)(lds + PG8_SB(b, h) + boff + n * 2048 + k * 1024); } } while (0)
#define PG8_MMA(ai, bj, At, Bt) do { __builtin_amdgcn_s_setprio(1); if constexpr (F8) { \
        asm volatile("s_nop 1\n\t" \
            "v_mfma_scale_f32_16x16x128_f8f6f4 %0, %8, %10, %0, %14, %15 op_sel_hi:[0,0,0]\n\t" \
            "v_mfma_scale_f32_16x16x128_f8f6f4 %1, %9, %10, %1, %14, %15 op_sel_hi:[0,0,0]\n\t" \
            "v_mfma_scale_f32_16x16x128_f8f6f4 %2, %8, %11, %2, %14, %15 op_sel_hi:[0,0,0]\n\t" \
            "v_mfma_scale_f32_16x16x128_f8f6f4 %3, %9, %11, %3, %14, %15 op_sel_hi:[0,0,0]\n\t" \
            "v_mfma_scale_f32_16x16x128_f8f6f4 %4, %8, %12, %4, %14, %15 op_sel_hi:[0,0,0]\n\t" \
            "v_mfma_scale_f32_16x16x128_f8f6f4 %5, %9, %12, %5, %14, %15 op_sel_hi:[0,0,0]\n\t" \
            "v_mfma_scale_f32_16x16x128_f8f6f4 %6, %8, %13, %6, %14, %15 op_sel_hi:[0,0,0]\n\t" \
            "v_mfma_scale_f32_16x16x128_f8f6f4 %7, %9, %13, %7, %14, %15 op_sel_hi:[0,0,0]" \
            : "+v"(acc[ai][bj][0][0]), "+v"(acc[ai][bj][0][1]), "+v"(acc[ai][bj][1][0]), "+v"(acc[ai][bj][1][1]), "+v"(acc[ai][bj][2][0]), "+v"(acc[ai][bj][2][1]), "+v"(acc[ai][bj][3][0]), "+v"(acc[ai][bj][3][1]) \
            : "v"(Bt##8[0]), "v"(Bt##8[1]), "v"(At##8[0]), "v"(At##8[1]), "v"(At##8[2]), "v"(At##8[3]), "v"(scw_), "v"(sca_)); } \
        else { _Pragma("unroll") for (int m = 0; m < 4; ++m) _Pragma("unroll") for (int n = 0; n < 2; ++n) _Pragma("unroll") for (int k = 0; k < 2; ++k) \
            acc[ai][bj][m][n] = __builtin_amdgcn_mfma_f32_16x16x32_bf16(Bt[n][k], At[m][k], acc[ai][bj][m][n], 0, 0, 0); } __builtin_amdgcn_s_setprio(0); } while (0)
#define PG8_WAIT_V(n) asm volatile("s_waitcnt vmcnt(" #n ")" ::: "memory")
#define PG8_WAIT_L(n) asm volatile("s_waitcnt lgkmcnt(" #n ")" ::: "memory")
#define PG8_BAR __builtin_amdgcn_s_barrier()
#define PG8_SCHED __builtin_amdgcn_sched_barrier(0)
#define PG8_AOFF(dst, u_, ui_) do { _Pragma("unroll") for (int _h = 0; _h < 2; ++_h) _Pragma("unroll") for (int _i = 0; _i < 2; ++_i) { \
        if constexpr (GATHER) dst[_h][_i] = (unsigned)(rowtab[(ui_) * 256 + _h * HALF + _i * 64 + R0] * (unsigned)(K * ESZ) + (unsigned)(C0 * 2)); \
        else dst[_h][_i] = (unsigned)((_h * HALF + _i * 64 + R0) * K * ESZ + C0 * 2); } } while (0)
    Unit cur, nxt; int ui = 0;
    if (!S.next(0, cur)) return;
    f32x4 acc[2][2][4][2];
#pragma unroll
    for (int a = 0; a < 2; ++a)
#pragma unroll
        for (int b = 0; b < 2; ++b)
#pragma unroll
            for (int m = 0; m < 4; ++m)
#pragma unroll
                for (int n = 0; n < 2; ++n) acc[a][b][m][n] = (f32x4){0.f, 0.f, 0.f, 0.f};
    bf16x8 At[4][2], B0[2][2], B1[2][2]; v8i At8[4], B08[2], B18[2]; const int scw_ = P::SCW, sca_ = P::SCA;
    unsigned vAc[2][2], vAn[2][2];
    PG8_AOFF(vAc, cur, 0);
    const char* cA = S.aptr(cur); const char* cB = S.bptr(cur);
    if constexpr (SP2) {
        PG8_STAGE(PG8_SB(0, 0), cB, voffB); PG8_STAGE(PG8_SB(0, 1), cB + hstep, voffB); PG8_STAGE(PG8_SA(0, 0), cA, vAc[0]); PG8_STAGE(PG8_SA(0, 1), cA, vAc[1]);
        if (wr == 1) PG8_BAR;
        PG8_WAIT_V(2); PG8_BAR;
        PG8_STAGE(PG8_SB(1, 0), cB + kstep, voffB); PG8_STAGE(PG8_SA(1, 0), cA + kstep, vAc[0]); PG8_STAGE(PG8_SB(1, 1), cB + hstep + kstep, voffB);
        PG8_WAIT_V(6); PG8_BAR;
    } else {
        PG8_STAGE(PG8_SB(0, 0), cB, voffB); PG8_STAGE(PG8_SA(0, 0), cA, vAc[0]); PG8_STAGE(PG8_SB(0, 1), cB + hstep, voffB); PG8_STAGE(PG8_SA(0, 1), cA, vAc[1]);
        if (wr == 1) PG8_BAR;
        PG8_WAIT_V(4); PG8_BAR;
        PG8_STAGE(PG8_SB(1, 0), cB + kstep, voffB); PG8_STAGE(PG8_SA(1, 0), cA + kstep, vAc[0]); PG8_STAGE(PG8_SB(1, 1), cB + hstep + kstep, voffB);
        PG8_WAIT_V(6); PG8_BAR;
    }
    for (;;) {
        const bool has_next = S.next(ui + 1, nxt);
        const char* nA = has_next ? S.aptr(nxt) : cA; const char* nB = has_next ? S.bptr(nxt) : cB;
        if (has_next) { PG8_AOFF(vAn, nxt, ui + 1); }
        else {
#pragma unroll
            for (int h = 0; h < 2; ++h)
#pragma unroll
                for (int i = 0; i < 2; ++i) vAn[h][i] = vAc[h][i];
        }
        for (int t = 0; t < nt; t += 2) {
            const bool last = (t == nt - 2);
            const char* a1 = cA + (size_t)(t + 1) * kstep;
            const char* a2 = last ? nA : cA + (size_t)(t + 2) * kstep; const char* b2 = last ? nB : cB + (size_t)(t + 2) * kstep;
            const char* a3 = a2 + kstep; const char* b3 = b2 + kstep;
            unsigned w2[2][2];
#pragma unroll
            for (int h = 0; h < 2; ++h)
#pragma unroll
                for (int i = 0; i < 2; ++i) w2[h][i] = last ? vAn[h][i] : vAc[h][i];
            if constexpr (SP2) {
            PG8_LDB(B0, 0, 0); PG8_LDB(B1, 0, 1); PG8_SCHED; PG8_LDA(At, 0, 0); PG8_STAGE(PG8_SA(1, 1), a1, vAc[1]);
            PG8_WAIT_V(8); PG8_WAIT_L(0); PG8_BAR; PG8_MMA(0, 0, At, B0); PG8_MMA(0, 1, At, B1); PG8_BAR; PG8_SCHED;
            PG8_LDA(At, 0, 1); PG8_STAGE(PG8_SB(0, 0), b2, voffB); PG8_STAGE(PG8_SB(0, 1), b2 + hstep, voffB); PG8_STAGE(PG8_SA(0, 0), a2, w2[0]);
            PG8_WAIT_V(8); PG8_WAIT_L(0); PG8_BAR; PG8_MMA(1, 0, At, B0); PG8_MMA(1, 1, At, B1); PG8_BAR; PG8_SCHED;
            PG8_LDB(B0, 1, 0); PG8_LDB(B1, 1, 1); PG8_SCHED; PG8_LDA(At, 1, 0); PG8_STAGE(PG8_SA(0, 1), a2, w2[1]);
            PG8_WAIT_V(8); PG8_WAIT_L(0); PG8_BAR; PG8_MMA(0, 0, At, B0); PG8_MMA(0, 1, At, B1); PG8_BAR; PG8_SCHED;
            PG8_LDA(At, 1, 1); PG8_STAGE(PG8_SB(1, 0), b3, voffB); PG8_STAGE(PG8_SB(1, 1), b3 + hstep, voffB); PG8_STAGE(PG8_SA(1, 0), a3, w2[0]);
            PG8_WAIT_V(8); PG8_WAIT_L(0); PG8_BAR; PG8_MMA(1, 0, At, B0); PG8_MMA(1, 1, At, B1); PG8_BAR; PG8_SCHED;
            } else {
            PG8_LDB(B0, 0, 0); PG8_SCHED; PG8_LDA(At, 0, 0); PG8_STAGE(PG8_SA(1, 1), a1, vAc[1]);
            PG8_WAIT_L(8); PG8_BAR; PG8_WAIT_L(0); PG8_MMA(0, 0, At, B0); PG8_BAR; PG8_SCHED;
            PG8_LDB(B1, 0, 1); PG8_STAGE(PG8_SB(0, 0), b2, voffB);
            PG8_BAR; PG8_WAIT_L(0); PG8_MMA(0, 1, At, B1); PG8_BAR;
            PG8_LDA(At, 0, 1); PG8_STAGE(PG8_SA(0, 0), a2, w2[0]);
            PG8_BAR; PG8_WAIT_L(0); PG8_MMA(1, 0, At, B0); PG8_BAR; PG8_SCHED;
            PG8_STAGE(PG8_SB(0, 1), b2 + hstep, voffB);
            PG8_WAIT_V(6); PG8_BAR; PG8_MMA(1, 1, At, B1); PG8_BAR;
            PG8_LDB(B0, 1, 0); PG8_SCHED; PG8_LDA(At, 1, 0); PG8_STAGE(PG8_SA(0, 1), a2, w2[1]);
            PG8_WAIT_L(8); PG8_BAR; PG8_WAIT_L(0); PG8_MMA(0, 0, At, B0); PG8_BAR; PG8_SCHED;
            PG8_LDB(B1, 1, 1); PG8_STAGE(PG8_SB(1, 0), b3, voffB);
            PG8_BAR; PG8_WAIT_L(0); PG8_MMA(0, 1, At, B1); PG8_BAR;
            PG8_LDA(At, 1, 1); PG8_STAGE(PG8_SA(1, 0), a3, w2[0]);
            PG8_BAR; PG8_WAIT_L(0); PG8_MMA(1, 0, At, B0); PG8_BAR; PG8_SCHED;
            PG8_STAGE(PG8_SB(1, 1), b3 + hstep, voffB);
            PG8_WAIT_V(6); PG8_BAR; PG8_MMA(1, 1, At, B1); PG8_BAR;
            }
        }
        if constexpr (ALIGN_EPI) { if (wr == 0) PG8_BAR; }
        if constexpr (F8) asm volatile("s_nop 15\n\ts_nop 7" ::: "memory");
        { int fr2 = fr, fq2 = fq; asm volatile("" : "+v"(fr2), "+v"(fq2));
          S.epi(acc, cur, wr, wc, fr2, fq2); }
        if (!has_next) break;
#pragma unroll
        for (int a = 0; a < 2; ++a)
#pragma unroll
            for (int b = 0; b < 2; ++b)
#pragma unroll
                for (int m = 0; m < 4; ++m)
#pragma unroll
                    for (int n = 0; n < 2; ++n) acc[a][b][m][n] = (f32x4){0.f, 0.f, 0.f, 0.f};
        cur = nxt; cA = nA; cB = nB; ++ui;
#pragma unroll
        for (int h = 0; h < 2; ++h)
#pragma unroll
            for (int i = 0; i < 2; ++i) vAc[h][i] = vAn[h][i];
        if constexpr (ALIGN_EPI) { if (wr == 1) PG8_BAR; }
    }
    PG8_WAIT_V(0);
    if constexpr (!ALIGN_EPI) { if (wr == 0) PG8_BAR; }
    PG8_BAR;
#undef PG8_SA
#undef PG8_SB
#undef PG8_STAGE
#undef PG8_LDA
#undef PG8_LDB
#undef PG8_MMA
#undef PG8_WAIT_V
#undef PG8_WAIT_L
#undef PG8_BAR
#undef PG8_SCHED
#undef PG8_AOFF
}
}

namespace attn_body {
using bf16 = __hip_bfloat16;
using bf16x8 = __attribute__((ext_vector_type(8))) short;
using s16x4 = __attribute__((ext_vector_type(4))) short;
using f32x16 = __attribute__((ext_vector_type(16))) float;
using u32x4 = __attribute__((ext_vector_type(4))) unsigned;
constexpr int D = 64, QPITCH = NHQ * D, KPITCH = NHKV * D, OPITCH = DM, OCOL0 = 256;
constexpr int NW = 8, QBLK = 32, QB = QBLK * NW, KVBLK = 64, NQB = NTOK / QB, NT = NKEYS / KVBLK;
static_assert(NT % 2 == 0 && NT >= 8, "tile count");
__device__ __forceinline__ int crow(int r, int hi) { return (r & 3) + 8 * (r >> 2) + 4 * hi; }
#define SBAR() __builtin_amdgcn_sched_barrier(0)
constexpr int NSLOT = 3, SLOTB = 8192;
constexpr int LDS_K = 0, LDS_V = NSLOT * SLOTB, LDS_WS = 2 * NSLOT * SLOTB, LDS_OST = LDS_WS + NW * 64 * 4, LDS_BYTES = LDS_OST + NW * 4096;
constexpr float C2 = 0.125f * 1.4426950408889634f;
__device__ __forceinline__ void glds16(const void* gsrc, unsigned lds_dst) { unsigned keep;
  asm volatile("s_mov_b32 %0, m0\n\ts_mov_b32 m0, %2\n\ts_nop 0\n\tglobal_load_lds_dwordx4 %1, off\n\ts_mov_b32 m0, %0" : "=&s"(keep) : "v"(gsrc), "s"(lds_dst) : "memory"); }
__device__ __forceinline__ float max3f(float a, float b, float c) { float r; asm("v_max3_f32 %0, %1, %2, %3" : "=v"(r) : "v"(a), "v"(b), "v"(c)); return r; }
__device__ __forceinline__ float max2f(float a, float b) { float r; asm("v_max_f32_e32 %0, %1, %2" : "=v"(r) : "v"(a), "v"(b)); return r; }
__device__ __forceinline__ float fadd_s(float a, float b) { float r; asm("v_add_f32_e32 %0, %1, %2" : "=v"(r) : "v"(a), "v"(b)); return r; }
__device__ __forceinline__ float fsub_s(float a, float b) { float r; asm("v_sub_f32_e32 %0, %1, %2" : "=v"(r) : "v"(a), "v"(b)); return r; }
typedef float f32x2_t __attribute__((ext_vector_type(2))); typedef __bf16 bf16x2_t __attribute__((ext_vector_type(2)));
__device__ __forceinline__ unsigned cvtpk_s(float lo, float hi) { f32x2_t v = {lo, hi}; bf16x2_t b = __builtin_convertvector(v, bf16x2_t); return __builtin_bit_cast(unsigned, b); }
#define WAIT_BAR(N) asm volatile("s_waitcnt vmcnt(" #N ") lgkmcnt(0)\n\ts_barrier" ::: "memory")

__device__ __forceinline__ void qkt(f32x16& p0, f32x16& p1, const char* Kslot, const bf16x8* qr, const f32x16& negm, int r32, int hi) {
  const char* kb = Kslot + hi * 1024 + r32 * 16;
  #pragma unroll
  for (int d0 = 0; d0 < 4; ++d0) {
    const bf16x8 b0 = *reinterpret_cast<const bf16x8*>(kb + d0 * 2048);
    const bf16x8 b1 = *reinterpret_cast<const bf16x8*>(kb + d0 * 2048 + 512);
    if (d0 == 0) { p0 = __builtin_amdgcn_mfma_f32_32x32x16_bf16(b0, qr[0], negm, 0, 0, 0); p1 = __builtin_amdgcn_mfma_f32_32x32x16_bf16(b1, qr[0], negm, 0, 0, 0); }
    else { p0 = __builtin_amdgcn_mfma_f32_32x32x16_bf16(b0, qr[d0], p0, 0, 0, 0); p1 = __builtin_amdgcn_mfma_f32_32x32x16_bf16(b1, qr[d0], p1, 0, 0, 0); } }
}
typedef __attribute__((address_space(3))) const char* lds_cptr;
typedef short v4i16_t __attribute__((ext_vector_type(4)));
__device__ __forceinline__ void kload8(bf16x8* kf, lds_cptr kp) {
  kf[0] = *(const __attribute__((address_space(3))) bf16x8*)(kp);        kf[1] = *(const __attribute__((address_space(3))) bf16x8*)(kp + 512);
  kf[2] = *(const __attribute__((address_space(3))) bf16x8*)(kp + 2048); kf[3] = *(const __attribute__((address_space(3))) bf16x8*)(kp + 2560);
  kf[4] = *(const __attribute__((address_space(3))) bf16x8*)(kp + 4096); kf[5] = *(const __attribute__((address_space(3))) bf16x8*)(kp + 4608);
  kf[6] = *(const __attribute__((address_space(3))) bf16x8*)(kp + 6144); kf[7] = *(const __attribute__((address_space(3))) bf16x8*)(kp + 6656);
}
__device__ __forceinline__ void kload2(bf16x8* kf, lds_cptr kp, int j) { kf[2 * j] = *(const __attribute__((address_space(3))) bf16x8*)(kp + j * 2048); kf[2 * j + 1] = *(const __attribute__((address_space(3))) bf16x8*)(kp + j * 2048 + 512); }
__device__ __forceinline__ s16x4 vtr(lds_cptr p) { return __builtin_bit_cast(s16x4, __builtin_amdgcn_ds_read_tr16_b64_v4i16((__attribute__((address_space(3))) v4i16_t*)p)); }
__device__ __forceinline__ float rowmax(const f32x16& p0, const f32x16& p1) {
  float a = max3f(p0[0], p0[1], p1[0]), b = max3f(p0[2], p0[3], p1[1]); a = max3f(a, p1[2], p1[3]);
  #pragma unroll
  for (int r = 4; r < 16; r += 4) { a = max3f(a, p0[r], p0[r + 1]); b = max3f(b, p0[r + 2], p0[r + 3]); a = max3f(a, p1[r], p1[r + 1]); b = max3f(b, p1[r + 2], p1[r + 3]); }
  const float m = max2f(a, b);
  auto rr = __builtin_amdgcn_permlane32_swap(__float_as_uint(m), __float_as_uint(m), false, false);
  return max2f(__uint_as_float(rr[0]), __uint_as_float(rr[1]));
}
__device__ __forceinline__ void pv(f32x16* o, int vb, bf16x8 pa0, bf16x8 pa1, bf16x8 pa2, bf16x8 pa3) {
  #pragma unroll
  for (int d0 = 0; d0 < 2; ++d0) { s16x4 lo[4], hi[4];
    #pragma unroll
    for (int ks = 0; ks < 4; ++ks) {
      asm volatile("ds_read_b64_tr_b16 %0,%1 offset:%c2" : "=&v"(lo[ks]) : "v"(vb), "i"(d0 * 4096 + ks * 1024) : "memory");
      asm volatile("ds_read_b64_tr_b16 %0,%1 offset:%c2" : "=&v"(hi[ks]) : "v"(vb), "i"(d0 * 4096 + ks * 1024 + 512) : "memory"); }
    asm volatile("s_waitcnt lgkmcnt(0)" ::: "memory"); SBAR();
    #define PK(k) (bf16x8){lo[k][0], lo[k][1], lo[k][2], lo[k][3], hi[k][0], hi[k][1], hi[k][2], hi[k][3]}
    o[d0] = __builtin_amdgcn_mfma_f32_32x32x16_bf16(pa0, PK(0), o[d0], 0, 0, 0);
    o[d0] = __builtin_amdgcn_mfma_f32_32x32x16_bf16(pa1, PK(1), o[d0], 0, 0, 0);
    o[d0] = __builtin_amdgcn_mfma_f32_32x32x16_bf16(pa2, PK(2), o[d0], 0, 0, 0);
    o[d0] = __builtin_amdgcn_mfma_f32_32x32x16_bf16(pa3, PK(3), o[d0], 0, 0, 0);
    #undef PK
  }
}
#define ATTN_STORE16(p, v) (*(u32x4*)(p) = (v))
template <int THRL> __device__ __forceinline__ void attn_unit(int h, int kvh, int qb, const bf16* Q, const bf16* __restrict__ K, const bf16* __restrict__ V, bf16* O, char* shm, int wid, float kmax2) {
  const int lane = fresh_lane(), r32 = lane & 31, hi = lane >> 5;
  const int q0 = qb * QB;
  const bf16* Qw = Q + (long)(q0 + wid * QBLK) * QPITCH + h * D;
  const bf16* Kh = K + kvh * D, *Vh = V + kvh * D;
  const unsigned lds0 = (unsigned)(uintptr_t)shm;
  float* wsf = (float*)(shm + LDS_WS) + wid * 64;
  const bf16* ksrc = Kh + (long)lane * KPITCH + wid * 8;
  const bf16* vsrc = Vh + (long)(16 * (wid & 3) + (lane >> 2)) * KPITCH + (wid >> 2) * 32 + (lane & 3) * 8;
  const unsigned kdst = lds0 + LDS_K + wid * 1024, vdst = lds0 + LDS_V + wid * 1024;
  #define DMA_K(t, slot) glds16(ksrc + (long)(t) * KVBLK * KPITCH, (unsigned)__builtin_amdgcn_readfirstlane(kdst + (slot)))
  #define DMA_V(t, slot) glds16(vsrc + (long)(t) * KVBLK * KPITCH, (unsigned)__builtin_amdgcn_readfirstlane(vdst + (slot)))
  const int vb0 = (int)(lds0 + LDS_V) + ((lane >> 4) & 1) * 32 + (lane & 3) * 8 + (4 * hi + ((lane & 15) >> 2)) * 64;
  const char* Kbase = shm + LDS_K; bf16x8 kf[8];
  const lds_cptr shm3 = (lds_cptr)shm; const lds_cptr kp0 = shm3 + LDS_K + hi * 1024 + r32 * 16; const lds_cptr vp0 = shm3 + LDS_V + ((lane >> 4) & 1) * 32 + (lane & 3) * 8 + (4 * hi + ((lane & 15) >> 2)) * 64;
  DMA_K(0, 0); DMA_V(0, 0); DMA_K(1, SLOTB);
  bf16x8 qr[4];
  #pragma unroll
  for (int d0 = 0; d0 < 4; ++d0) qr[d0] = *reinterpret_cast<const bf16x8*>(&Qw[(long)r32 * QPITCH + d0 * 16 + hi * 8]);
  float l_reg = 0.f; f32x16 o[2]; o[0] = f32x16{}; o[1] = f32x16{}; f32x16 negm;
  { float qn2 = 0.f;
    #pragma unroll
    for (int d0 = 0; d0 < 4; ++d0)
      #pragma unroll
      for (int j = 0; j < 8; ++j) { const float f = __uint_as_float((unsigned)(unsigned short)qr[d0][j] << 16); qn2 += f * f; }
    auto rr = __builtin_amdgcn_permlane32_swap(__float_as_uint(qn2), __float_as_uint(qn2), false, false); qn2 = __uint_as_float(rr[0]) + __uint_as_float(rr[1]);
    const float bnd = sqrtf(qn2 * kmax2) * 1.004f + 0.01f;
    #pragma unroll
    for (int r = 0; r < 16; ++r) negm[r] = -bnd;
    asm volatile("" : "+v"(negm)); }
  f32x16 pA0, pA1, pB0, pB1;
  int sl_prev = 0, sl_cur = 0, sl_next = SLOTB;
  #define ROT() do { sl_prev = sl_cur; sl_cur = sl_next; sl_next = (sl_next == (NSLOT - 1) * SLOTB) ? 0 : sl_next + SLOTB; } while (0)
  DMA_K(2, 2 * SLOTB);
  WAIT_BAR(3);
  qkt(pA0, pA1, Kbase, qr, negm, r32, hi); asm volatile("s_nop 15\n\ts_nop 7" : "+v"(pA0), "+v"(pA1));
  _Pragma("unroll") for (int r = 0; r < 16; ++r) { pA0[r] = __builtin_amdgcn_exp2f(pA0[r]); pA1[r] = __builtin_amdgcn_exp2f(pA1[r]); }
  WAIT_BAR(0);
  DMA_K(3, 0); DMA_V(1, SLOTB);
  ROT();
  kload8(kf, kp0 + sl_cur);
  WAIT_BAR(2);
  s16x4 vlo[8], vhi[8]; u32x4 pw0, pw1, pw2, pw3;
  #define PKW(P, B) cvtpk_s(P[B], P[B + 1])
  #define PAF(k) __builtin_bit_cast(bf16x8, pw##k)
  #define VFR(i) (bf16x8){vlo[i][0], vlo[i][1], vlo[i][2], vlo[i][3], vhi[i][0], vhi[i][1], vhi[i][2], vhi[i][3]}
  #define PIN(x) asm volatile("" : "+v"(x))
  #define MX3(a, b, c) __builtin_fmaxf(__builtin_fmaxf((a), (b)), (c))
  #define GAPA(MF, A0, A1, A2, A3, W0, W1, PW) do { MF; sacc += A0; sacc += A1; sacc += A2; sacc += A3; PIN(sacc); W0; W1; PIN(PW); SBAR(); } while (0)
  #define EX(v) __builtin_amdgcn_exp2f(v)
  #define GAPB(MF, X, B) do { MF; X[B] = EX(X[B]); X[B + 1] = EX(X[B + 1]); X[B + 2] = EX(X[B + 2]); X[B + 3] = EX(X[B + 3]); PIN(X); SBAR(); } while (0)
  #define VRD(i) do { vlo[i] = vtr(vp_ + (((i) >> 2) * 4096 + ((i) & 3) * 1024)); vhi[i] = vtr(vp_ + (((i) >> 2) * 4096 + ((i) & 3) * 1024 + 512)); } while (0)
  #define KRD(G, j) do { if (G) { kload2(kf, kp0 + sl_next, j); SBAR(); } } while (0)
  #define STEPM(C0, C1, P0, P1, t, GK, GV, GL) do { SBAR(); \
    const lds_cptr vp_ = vp0 + sl_prev; \
    VRD(0); SBAR(); float sacc = (P0[0] + P0[1]); \
    GAPA(C0 = __builtin_amdgcn_mfma_f32_32x32x16_bf16(kf[0], qr[0], negm, 0, 0, 0), P0[2], P0[3], P0[4], P0[5],     pw0[0] = PKW(P0, 0), pw0[1] = PKW(P0, 2), pw0); \
    VRD(4); SBAR(); GAPA(C1 = __builtin_amdgcn_mfma_f32_32x32x16_bf16(kf[1], qr[0], negm, 0, 0, 0), P0[6], P0[7], P0[8], P0[9],     pw0[2] = PKW(P0, 4), pw0[3] = PKW(P0, 6), pw0); \
    VRD(1); SBAR(); GAPA(C0 = __builtin_amdgcn_mfma_f32_32x32x16_bf16(kf[2], qr[1], C0, 0, 0, 0),   P0[10], P0[11], P0[12], P0[13], pw1[0] = PKW(P0, 8), pw1[1] = PKW(P0, 10), pw1); \
    VRD(5); SBAR(); GAPA(C1 = __builtin_amdgcn_mfma_f32_32x32x16_bf16(kf[3], qr[1], C1, 0, 0, 0),   P0[14], P0[15], P1[0], P1[1],   pw1[2] = PKW(P0, 12), pw1[3] = PKW(P0, 14), pw1); \
    VRD(2); SBAR(); GAPA(C0 = __builtin_amdgcn_mfma_f32_32x32x16_bf16(kf[4], qr[2], C0, 0, 0, 0),   P1[2], P1[3], P1[4], P1[5],     pw2[0] = PKW(P1, 0), pw2[1] = PKW(P1, 2), pw2); \
    VRD(6); SBAR(); GAPA(C1 = __builtin_amdgcn_mfma_f32_32x32x16_bf16(kf[5], qr[2], C1, 0, 0, 0),   P1[6], P1[7], P1[8], P1[9],     pw2[2] = PKW(P1, 4), pw2[3] = PKW(P1, 6), pw2); \
    VRD(3); SBAR(); GAPA(C0 = __builtin_amdgcn_mfma_f32_32x32x16_bf16(kf[6], qr[3], C0, 0, 0, 0),   P1[10], P1[11], P1[12], P1[13], pw3[0] = PKW(P1, 8), pw3[1] = PKW(P1, 10), pw3); \
    VRD(7); SBAR(); GAPA(C1 = __builtin_amdgcn_mfma_f32_32x32x16_bf16(kf[7], qr[3], C1, 0, 0, 0),   P1[14], P1[15], 0.f, 0.f,       pw3[2] = PKW(P1, 12), pw3[3] = PKW(P1, 14), pw3); \
    l_reg += sacc; \
    if (GK) { DMA_K((t) + 3, sl_cur); } if (GV) { DMA_V((t) + 1, sl_next); } \
    SBAR(); \
    GAPB(o[0] = __builtin_amdgcn_mfma_f32_32x32x16_bf16(PAF(0), VFR(0), o[0], 0, 0, 0), C0, 0); \
    GAPB(o[1] = __builtin_amdgcn_mfma_f32_32x32x16_bf16(PAF(0), VFR(4), o[1], 0, 0, 0), C0, 4); \
    KRD(GL, 0); GAPB(o[0] = __builtin_amdgcn_mfma_f32_32x32x16_bf16(PAF(1), VFR(1), o[0], 0, 0, 0), C0, 8); \
    KRD(GL, 1); GAPB(o[1] = __builtin_amdgcn_mfma_f32_32x32x16_bf16(PAF(1), VFR(5), o[1], 0, 0, 0), C0, 12); \
    KRD(GL, 2); GAPB(o[0] = __builtin_amdgcn_mfma_f32_32x32x16_bf16(PAF(2), VFR(2), o[0], 0, 0, 0), C1, 0); \
    KRD(GL, 3); GAPB(o[1] = __builtin_amdgcn_mfma_f32_32x32x16_bf16(PAF(2), VFR(6), o[1], 0, 0, 0), C1, 4); \
    GAPB(o[0] = __builtin_amdgcn_mfma_f32_32x32x16_bf16(PAF(3), VFR(3), o[0], 0, 0, 0), C1, 8); \
    GAPB(o[1] = __builtin_amdgcn_mfma_f32_32x32x16_bf16(PAF(3), VFR(7), o[1], 0, 0, 0), C1, 12); \
    } while (0)
  int t = 1;
  for (; t + 5 < NT; t += 2) {
    STEPM(pB0, pB1, pA0, pA1, t, true, true, true);     WAIT_BAR(2); ROT();
    STEPM(pA0, pA1, pB0, pB1, t + 1, true, true, true); WAIT_BAR(2); ROT();
  }
  #define ENDW(tt) do { if ((tt) + 3 < NT) { WAIT_BAR(2); } else if ((tt) + 2 < NT) { WAIT_BAR(1); } else { WAIT_BAR(0); } } while (0)
  for (; t + 1 < NT; t += 2) {
    STEPM(pB0, pB1, pA0, pA1, t, (t + 3 < NT), (t + 1 < NT), (t + 1 < NT));         ENDW(t);     ROT();
    STEPM(pA0, pA1, pB0, pB1, t + 1, (t + 4 < NT), (t + 2 < NT), (t + 2 < NT));     ENDW(t + 1); ROT();
  }
  STEPM(pB0, pB1, pA0, pA1, NT - 1, false, false, false);
  { float sacc = pB0[0] + pB0[1]; _Pragma("unroll") for (int r = 2; r < 16; ++r) sacc += pB0[r]; _Pragma("unroll") for (int r = 0; r < 16; ++r) sacc += pB1[r]; l_reg += sacc;
    pw0 = (u32x4){PKW(pB0, 0), PKW(pB0, 2), PKW(pB0, 4), PKW(pB0, 6)}; pw1 = (u32x4){PKW(pB0, 8), PKW(pB0, 10), PKW(pB0, 12), PKW(pB0, 14)}; pw2 = (u32x4){PKW(pB1, 0), PKW(pB1, 2), PKW(pB1, 4), PKW(pB1, 6)}; pw3 = (u32x4){PKW(pB1, 8), PKW(pB1, 10), PKW(pB1, 12), PKW(pB1, 14)};
    SBAR(); pv(o, vb0 + sl_cur, PAF(0), PAF(1), PAF(2), PAF(3)); }
  #undef PKW
  #undef PAF
  #undef VFR
  #undef PIN
  #undef MX3
  #undef GAPA
  #undef GAPB
  #undef EX
  #undef VRD
  #undef KRD
  #undef STEPM
  #undef ENDW
  { auto rr = __builtin_amdgcn_permlane32_swap(__float_as_uint(l_reg), __float_as_uint(l_reg), false, false); l_reg = __uint_as_float(rr[0]) + __uint_as_float(rr[1]); }
  if (hi == 0) wsf[32 + r32] = l_reg; asm volatile("s_waitcnt lgkmcnt(0)" ::: "memory");
  float rli[16];
  #pragma unroll
  for (int r = 0; r < 16; ++r) rli[r] = __builtin_amdgcn_rcpf(wsf[32 + crow(r, hi)]);
  bf16* Ow = O + (long)(q0 + wid * QBLK) * OPITCH + OCOL0 + h * D;
  { bf16* stg = (bf16*)(shm + LDS_OST) + wid * 2048;
    #pragma unroll
    for (int r = 0; r < 16; ++r) { const int orow = crow(r, hi);
      #pragma unroll
      for (int d0 = 0; d0 < 2; ++d0) stg[orow * 64 + d0 * 32 + r32] = __float2bfloat16(o[d0][r] * rli[r]); }
    asm volatile("s_waitcnt lgkmcnt(0)" ::: "memory");
    #pragma unroll
    for (int i = 0; i < 4; ++i) { const int row = i * 8 + (lane >> 3), ch = lane & 7; const u32x4 v = *(const u32x4*)(stg + row * 64 + ch * 8); ATTN_STORE16(Ow + (long)row * OPITCH + ch * 8, v); } }
  asm volatile("s_waitcnt lgkmcnt(0)\n\ts_barrier" ::: "memory");
  #undef DMA_K
  #undef DMA_V
  #undef ROT
}
#undef SBAR
#undef WAIT_BAR
}

constexpr int NWAVES = 8, NTHR = NWAVES * 64;
constexpr size_t MiB = 1u << 20;
constexpr size_t WS_CTL = 0, CTL_ZERO_BYTES = 64 * 1024;
constexpr size_t WS_MOD = 1 * MiB;
constexpr size_t WS_MISC = WS_MOD + 64 * 1024;
constexpr size_t WS_IDX = WS_MISC, WS_GATE = WS_IDX + 128 * 1024, WS_TOKSLOT = WS_GATE + 128 * 1024;
constexpr size_t WS_AFF = 3 * MiB;
constexpr size_t WS_WIN = 4 * MiB;
constexpr size_t WS_WOUT = 7 * MiB;
constexpr size_t WS_WGU = 9 * MiB;
constexpr size_t WS_WD = 137 * MiB;
constexpr size_t WS_X1 = 201 * MiB;
constexpr size_t WS_R1 = 265 * MiB;
constexpr size_t WS_XN = WS_R1;
constexpr size_t WS_Q = WS_XN + (size_t)NROWS * DM * 2;
constexpr size_t WS_K = WS_Q + (size_t)NTOK * 768 * 2;
constexpr size_t WS_V = WS_K + (size_t)NROWS * 256 * 2;
constexpr size_t WS_FT = WS_V + (size_t)NROWS * 256 * 2;
constexpr size_t WS_MIX = WS_FT + (size_t)256 * NTOK * 4;
constexpr size_t WS_HID = WS_R1;
constexpr size_t WS_R2 = 393 * MiB;
constexpr size_t WS_H2 = WS_R2;
constexpr size_t WS_YE = WS_R2;
constexpr size_t WS_END = 457 * MiB;
static_assert(WS_MIX + (size_t)NTOK * DM * 2 <= WS_R1 + 128 * MiB, "R1 map");
static_assert(WS_TOKSLOT + (size_t)NTOK * 16 * 4 <= WS_AFF, "misc map");
constexpr int CW_TMO = 0, CW_FLAG = 2, CW_KMAX = 64, CW_BAR = 1024;

constexpr int LDS_BYTES = 163840;
constexpr int RING_BYTES = 131072, XTRA_OFF = RING_BYTES;
constexpr int MISC_OFF = LDS_BYTES - 512;

#define GAS __attribute__((address_space(1)))
#define LAS __attribute__((address_space(3)))
typedef unsigned short bf16;
typedef unsigned v4u __attribute__((ext_vector_type(4)));
typedef unsigned v2u __attribute__((ext_vector_type(2)));
typedef float f32x4 __attribute__((ext_vector_type(4)));
typedef float f32x2 __attribute__((ext_vector_type(2)));
typedef GAS unsigned gu32;
#define RLX_AGENT __ATOMIC_RELAXED, __HIP_MEMORY_SCOPE_AGENT
#define LDS_WAIT() asm volatile("s_waitcnt lgkmcnt(0)" ::: "memory")
#define VM_WAIT() asm volatile("s_waitcnt vmcnt(0)" ::: "memory")
__device__ __forceinline__ unsigned f2bf(float f) { unsigned u = __builtin_bit_cast(unsigned, f); return (u + 0x7fffu + ((u >> 16) & 1u)) >> 16; }
__device__ __forceinline__ unsigned pk2(float lo, float hi) { return f2bf(lo) | (f2bf(hi) << 16); }
__device__ __forceinline__ unsigned pk4_fp8(float a, float b, float c, float d) { int p = __builtin_amdgcn_cvt_pk_fp8_f32(a, b, 0, false); p = __builtin_amdgcn_cvt_pk_fp8_f32(c, d, p, true); return (unsigned)p; }
__device__ __forceinline__ float bf2f(unsigned short b) { return __builtin_bit_cast(float, (unsigned)b << 16); }

#define XB_TMO      128
#define XB_XCNT(j)  (256  + 64 * (j))
#define XB_XSUB(j)  (1280 + 64 * (j))
#define XB_XGEN(j)  (2304 + 64 * (j))
#define XB_TOP      3328
#define XB_TOPGEN   3392
#define XCD_BAR_WORDS 3456
#define XB_SPIN_CAP (1u << 20)
static_assert((CW_BAR + XCD_BAR_WORDS) * 4 <= (int)CTL_ZERO_BYTES, "ctl");
__device__ __forceinline__ unsigned xb_ld(unsigned* p)              { return __hip_atomic_load(p, __ATOMIC_RELAXED, __HIP_MEMORY_SCOPE_AGENT); }
__device__ __forceinline__ unsigned xb_add(unsigned* p, unsigned v) { return __hip_atomic_fetch_add(p, v, __ATOMIC_RELAXED, __HIP_MEMORY_SCOPE_AGENT); }
__device__ __forceinline__ unsigned xb_xcc_id() { return (unsigned)__builtin_amdgcn_s_getreg((3 << 11) | 20) & 0xFu; }
#define XB_SPIN(cond, bar) do { unsigned _sp = 0; while (cond) { __builtin_amdgcn_s_sleep(1); \
    if ((++_sp & 255u) == 0u) { if (xb_ld(&(bar)[XB_TMO])) break; if (_sp > XB_SPIN_CAP) { atomicAdd(&(bar)[XB_TMO], 1u); break; } } } } while (0)
struct XcdBarrier { unsigned* bar; unsigned x; volatile LAS unsigned* st; };
__device__ __forceinline__ XcdBarrier xcd_barrier_post(unsigned* bar, volatile LAS unsigned* st, bool leader) {
    XcdBarrier b; b.bar = bar; b.x = xb_xcc_id(); b.st = st;
    if (leader) (void)xb_add(&bar[XB_XCNT(b.x)], 1u);
    return b;
}
__device__ __forceinline__ void xcd_barrier_complete(unsigned* bar, unsigned x, unsigned& nloc, unsigned& nx) {
    const unsigned G = gridDim.x * gridDim.y * gridDim.z;
    unsigned sum, cnt, mine, sp = 0u;
    for (;;) {
        sum = 0u; cnt = 0u; mine = 0u;
#pragma unroll
        for (unsigned j = 0; j < 16; ++j) { const unsigned c = xb_ld(&bar[XB_XCNT(j)]); sum += c; cnt += (c > 0u) ? 1u : 0u; mine = (j == x) ? c : mine; }
        if (sum == G) break;
        __builtin_amdgcn_s_sleep(1);
        if ((++sp & 255u) == 0u) { if (xb_ld(&bar[XB_TMO])) break; if (sp > XB_SPIN_CAP) { atomicAdd(&bar[XB_TMO], 1u); break; } }
    }
    nloc = mine > 0u ? mine : 1u; nx = cnt > 0u ? cnt : 1u;
}
__device__ __forceinline__ void xcd_barrier(const XcdBarrier& b, int wave) {
    asm volatile("s_waitcnt vmcnt(0)" ::: "memory");
    __syncthreads();
    if (wave == 0 && fresh_lane() == 0) {
        unsigned* bar = b.bar;
        __builtin_amdgcn_s_waitcnt(0);
        unsigned nloc = b.st[0], nx = b.st[1];
        if (nloc == 0u) { xcd_barrier_complete(bar, b.x, nloc, nx); b.st[0] = nloc; b.st[1] = nx; }
        const unsigned old = xb_add(&bar[XB_XSUB(b.x)], 1u);
        const unsigned gen = old / nloc;
        if (old + 1u == (gen + 1u) * nloc) {
            __builtin_amdgcn_fence(__ATOMIC_RELEASE, "agent");
            asm volatile("s_waitcnt vmcnt(0)" ::: "memory");
            const unsigned og = xb_add(&bar[XB_TOP], 1u);
            const unsigned tg = og / nx;
            if (og + 1u == (tg + 1u) * nx) xb_add(&bar[XB_TOPGEN], 1u);
            else XB_SPIN(xb_ld(&bar[XB_TOPGEN]) == tg, bar);
            __builtin_amdgcn_fence(__ATOMIC_ACQUIRE, "agent");
            xb_add(&bar[XB_XGEN(b.x)], 1u);
            asm volatile("s_waitcnt vmcnt(0)" ::: "memory");
        } else {
            XB_SPIN(xb_ld(&bar[XB_XGEN(b.x)]) == gen, bar);
            __builtin_amdgcn_fence(__ATOMIC_ACQUIRE, "agent");
            asm volatile("s_waitcnt vmcnt(0)" ::: "memory");
        }
    }
    __syncthreads();
}

struct Args {
    const float *x, *c, *ctx, *c_ctx, *w_mod, *b_mod, *norm_mix_g, *norm_ffn_g, *w_in, *w_four, *q_norm_g, *k_norm_g, *w_out, *w_router, *w_gate, *w_up, *w_down, *final_norm_g;
    float* out; unsigned char* ws;
};

__device__ __forceinline__ float wave_sum(float v) {
#pragma unroll
    for (int o = 1; o < 64; o <<= 1) v += __shfl_xor(v, o);
    return v;
}

template <class RowMap>
__device__ __forceinline__ void tr_item(const float* __restrict__ W, int ldw, int k0, int n0, bf16* WT, int ldt, int kdst0, const RowMap& drow, LAS float* scr, int lane) {
    const int kq = lane >> 4, nq = lane & 15;
    f32x4 v[16];
#pragma unroll
    for (int it = 0; it < 16; ++it) v[it] = *(const f32x4*)(W + (size_t)(k0 + 4 * it + kq) * ldw + n0 + 4 * nq);
#pragma unroll
    for (int it = 0; it < 16; ++it) { LAS float* s = scr + (4 * it + kq) * 65 + 4 * nq; s[0] = v[it][0]; s[1] = v[it][1]; s[2] = v[it][2]; s[3] = v[it][3]; }
    LDS_WAIT(); asm volatile("" ::: "memory");
    const int c = lane >> 3, nn = lane & 7;
#pragma unroll
    for (int j = 0; j < 8; ++j) { const int n = nn + 8 * j; const LAS float* s = scr + (8 * c) * 65 + n;
        v4u o; o.x = pk2(s[0 * 65], s[1 * 65]); o.y = pk2(s[2 * 65], s[3 * 65]); o.z = pk2(s[4 * 65], s[5 * 65]); o.w = pk2(s[6 * 65], s[7 * 65]);
        *(GAS v4u*)(WT + (size_t)drow(n0 + n) * ldt + kdst0 + k0 + 8 * c) = o; }
    LDS_WAIT(); asm volatile("" ::: "memory");
}
struct RowId { int base; __device__ __forceinline__ int operator()(int n) const { return base + n; } };
struct RowQKV { __device__ __forceinline__ int operator()(int n) const { const int t = n >> 8, w = n & 255, hd = w >> 6, d = w & 63; return 256 + 256 * t + 128 * (d >> 5) + 32 * hd + (d & 31); } };
struct RowGU { int base, up; __device__ __forceinline__ int operator()(int f) const { return base + 256 * (f >> 7) + 128 * up + (f & 127); } };


constexpr int MOE_ITEMS = 3 * 8192;
struct TrDesc { const float* src; bf16* dst; int ldw, ldt, f8; };
__device__ __forceinline__ TrDesc moe_desc(const Args& a, int r) {
    TrDesc d;
    if (r < 16384) { const int up = r >> 13, rr = r & 8191, e = rr >> 9, q = rr & 511, kb = q >> 5, nb = q & 31;
        d.src = (up ? a.w_up : a.w_gate) + (size_t)e * DM * DE + (size_t)(kb * 64) * DE + nb * 64; d.ldw = DE;
        d.dst = (bf16*)((unsigned char*)(a.ws + WS_WGU) + ((size_t)e * 4096 + 256 * (nb >> 1) + 128 * up + 64 * (nb & 1)) * DM + kb * 64); d.ldt = DM; d.f8 = 1; }
    else { const int rr = r - 16384, e = rr >> 9, q = rr & 511, kb = q >> 4, nb = q & 15;
        d.src = a.w_down + (size_t)e * DE * DM + (size_t)(kb * 64) * DM + nb * 64; d.ldw = DM;
        d.dst = (bf16*)((unsigned char*)(a.ws + WS_WD) + ((size_t)e * DM + nb * 64) * DE + kb * 64); d.ldt = DE; d.f8 = 1; }
    return d;
}
#define TR_LOAD(v, d) do { _Pragma("unroll") for (int _it = 0; _it < 16; ++_it) v[_it] = *(const f32x4*)((d).src + (size_t)(4 * _it + kq) * (d).ldw + 4 * nq); } while (0)
#define TR_PROC(v, d) do { \
    _Pragma("unroll") for (int _it = 0; _it < 16; ++_it) { LAS float* s_ = scr + (4 * _it + kq) * 65 + 4 * nq; s_[0] = v[_it][0]; s_[1] = v[_it][1]; s_[2] = v[_it][2]; s_[3] = v[_it][3]; } \
    LDS_WAIT(); asm volatile("" ::: "memory"); \
    if ((d).f8) { _Pragma("unroll") for (int _j = 0; _j < 8; ++_j) { const int n_ = nn + 8 * _j; const LAS float* s_ = scr + (8 * c8) * 65 + n_; \
        v2u o_; o_.x = pk4_fp8(s_[0 * 65] * 32.f, s_[1 * 65] * 32.f, s_[2 * 65] * 32.f, s_[3 * 65] * 32.f); o_.y = pk4_fp8(s_[4 * 65] * 32.f, s_[5 * 65] * 32.f, s_[6 * 65] * 32.f, s_[7 * 65] * 32.f); \
        *(GAS v2u*)((unsigned char*)(d).dst + (size_t)n_ * (d).ldt + 8 * c8) = o_; } } \
    else { _Pragma("unroll") for (int _j = 0; _j < 8; ++_j) { const int n_ = nn + 8 * _j; const LAS float* s_ = scr + (8 * c8) * 65 + n_; \
        v4u o_; o_.x = pk2(s_[0 * 65], s_[1 * 65]); o_.y = pk2(s_[2 * 65], s_[3 * 65]); o_.z = pk2(s_[4 * 65], s_[5 * 65]); o_.w = pk2(s_[6 * 65], s_[7 * 65]); \
        *(GAS v4u*)((d).dst + (size_t)n_ * (d).ldt + 8 * c8) = o_; } } \
    LDS_WAIT(); asm volatile("" ::: "memory"); } while (0)
__device__ __forceinline__ void moe_convert(const Args& a, LAS float* scr, int lo, int hi, int w, int nw) {
    const int lane = fresh_lane(), kq = lane >> 4, nq = lane & 15, c8 = lane >> 3, nn = lane & 7;
    int it = lo + w; if (it >= hi) return;
    f32x4 va[16], vb[16];
    TrDesc da = moe_desc(a, it), db = da; TR_LOAD(va, da);
    for (;;) {
        int nx = it + nw; bool hn = nx < hi;
        if (hn) { db = moe_desc(a, nx); TR_LOAD(vb, db); }
        TR_PROC(va, da);
        if (!hn) break;
        it = nx; nx = it + nw; hn = nx < hi;
        if (hn) { da = moe_desc(a, nx); TR_LOAD(va, da); }
        TR_PROC(vb, db);
        if (!hn) break;
        it = nx;
    }
}
#ifndef MOE_S0
#define MOE_S0 4096
#endif
#ifndef MOE_S1
#define MOE_S1 2560
#endif
#ifndef MOE_S2
#define MOE_S2 0
#endif
constexpr int MOE_B0 = MOE_S0, MOE_B1 = MOE_B0 + MOE_S1, MOE_B2 = MOE_B1 + MOE_S2;

__host__ __device__ __forceinline__ int four_pos(int mp) { return mp == 0 ? 0 : (mp == 32 ? 1 : (mp < 32 ? 2 * mp : 2 * (64 - mp) + 1)); }

__device__ __forceinline__ void p0_prologue(const Args& a, LAS unsigned char* lds, int vcu, int G, int wave) {
    const int lane = fresh_lane(), tid = wave * 64 + lane;
    unsigned char* ws = a.ws;
    bf16* WinT = (bf16*)(ws + WS_WIN); bf16* WoT = (bf16*)(ws + WS_WOUT);
    float* MOD = (float*)(ws + WS_MOD);
    const int cg = vcu - (G - 24);
    if (cg >= 0) {
        LAS float* sv = (LAS float*)lds;
        LAS float* red = sv + 2048;
        for (int i = tid; i < 1024; i += NTHR) { const float c0 = a.c[i], c1 = a.c_ctx[i]; sv[i] = c0 / (1.f + __expf(-c0)); sv[1024 + i] = c1 / (1.f + __expf(-c1)); }
        __syncthreads();
        const int col = cg * 256 + 4 * lane;
        f32x4 a0 = {0.f, 0.f, 0.f, 0.f}, a1 = {0.f, 0.f, 0.f, 0.f};
        const int kb = wave * 128;
#pragma unroll 16
        for (int k = 0; k < 128; ++k) { const f32x4 w = *(const f32x4*)(a.w_mod + (size_t)(kb + k) * (NMOD * DM) + col); const float s0 = sv[kb + k], s1 = sv[1024 + kb + k]; a0 += w * s0; a1 += w * s1; }
        *(LAS f32x4*)(red + (wave * 2 + 0) * 256 + 4 * lane) = a0; *(LAS f32x4*)(red + (wave * 2 + 1) * 256 + 4 * lane) = a1;
        __syncthreads();
        { const int v = tid >> 8, cc = tid & 255; float s = 0.f;
#pragma unroll
          for (int w = 0; w < 8; ++w) s += red[(w * 2 + v) * 256 + cc];
          MOD[v * (NMOD * DM) + cg * 256 + cc] = s + a.b_mod[cg * 256 + cc]; }
        __syncthreads();
    }
    LAS float* scr = (LAS float*)(lds + wave * 16640);
    constexpr int I_F1 = 256, I_F2 = 256, I_IN = 16 * 20, I_OUT = 12 * 16;
    constexpr int NITEMS = I_F1 + I_F2 + I_IN + I_OUT;
    for (int it = wave * G + vcu; it < NITEMS; it += NWAVES * G) {
        int r = it;
        if (r < I_F1) {
            const int g = r & 3, kb = (r >> 2) & 15, jq = r >> 6, k = kb * 64 + lane;
            LAS float* ct = scr;
            ct[lane] = cospif((float)lane * (1.f / 32.f)); LDS_WAIT(); asm volatile("" ::: "memory");
            float w[64];
#pragma unroll
            for (int c4 = 0; c4 < 16; ++c4) { const f32x4 t = *(const f32x4*)(a.w_in + (size_t)k * INW + 64 * g + 4 * c4); w[4 * c4] = t[0]; w[4 * c4 + 1] = t[1]; w[4 * c4 + 2] = t[2]; w[4 * c4 + 3] = t[3]; }
            for (int j = 16 * jq; j < 16 * jq + 16; ++j) { const int m = j <= 32 ? j : j - 32; const int ph = j <= 32 ? 0 : 48;
                float s = 0.f;
#pragma unroll
                for (int c = 0; c < 64; ++c) s += w[c] * ct[(c * m + ph) & 63];
                WinT[(size_t)(64 * g + j) * DM + k] = (bf16)f2bf(s * (1.f / 1024.f)); }
            LDS_WAIT(); asm volatile("" ::: "memory");
            continue; }
        r -= I_F1;
        if (r < I_F2) {
            const int g = r & 3, jb = (r >> 2) & 15, mq = r >> 6, j = jb * 64 + lane;
            float w[64];
#pragma unroll
            for (int d = 0; d < 64; ++d) w[d] = a.w_out[(size_t)(64 * g + d) * DM + j];
            for (int mp = 16 * mq; mp < 16 * mq + 16; ++mp) { float s = 0.f; const float* wf = a.w_four + (size_t)(g * 64 + mp) * 64;
#pragma unroll
                for (int d = 0; d < 64; ++d) s += wf[d] * w[d];
                WoT[(size_t)j * DM + 64 * g + four_pos(mp)] = (bf16)f2bf(s); }
            continue; }
        r -= I_F2;
        if (r < I_IN) { const int kb = r / 20, nb = r % 20; tr_item(a.w_in + 256, INW, kb * 64, nb * 64, WinT, DM, 0, RowQKV{}, scr, lane); continue; }
        r -= I_IN;
        { const int kb = r / 16, nb = r % 16; tr_item(a.w_out + (size_t)256 * DM, DM, kb * 64, nb * 64, WoT, DM, 256, RowId{0}, scr, lane); }
    }
    if (cg < 0) moe_convert(a, scr, 0, MOE_B0, ((wave + 4) & 7) * (G - 24) + vcu, NWAVES * (G - 24));
}

__device__ __forceinline__ void p0b_modulate(const Args& a, int vcu, int G, int wave) {
    const int lane = fresh_lane();
    unsigned char* ws = a.ws; const float* MOD = (const float*)(ws + WS_MOD); bf16* XN = (bf16*)(ws + WS_XN);
    const int gw = vcu * NWAVES + wave, NGW = G * NWAVES;
    for (int pass = 0; pass < 2; ++pass) {
        const float* md = MOD + pass * (NMOD * DM);
        const int nrows = pass == 0 ? NTOK : NCTX; const float* src = pass == 0 ? a.x : a.ctx; bf16* dst = XN + (size_t)(pass == 0 ? 0 : NTOK) * DM;
        if (gw >= nrows) continue;
        f32x4 av[4], sh[4];
#pragma unroll
        for (int j = 0; j < 4; ++j) { const int col = 4 * lane + 256 * j; const f32x4 g = *(const f32x4*)(a.norm_mix_g + col); const f32x4 sc = *(const f32x4*)(md + DM + col); av[j] = g * (sc + 1.f); sh[j] = *(const f32x4*)(md + col); }
        f32x4 v[4], vn[4];
        { const GAS f32x4* xr = (const GAS f32x4*)(src + (size_t)gw * DM) + lane;
#pragma unroll
          for (int j = 0; j < 4; ++j) v[j] = xr[64 * j]; }
        for (int m = gw; m < nrows; m += NGW) {
            const int mn = m + NGW;
            if (mn < nrows) { const GAS f32x4* xr = (const GAS f32x4*)(src + (size_t)mn * DM) + lane;
#pragma unroll
                for (int j = 0; j < 4; ++j) vn[j] = xr[64 * j]; }
            float s = 0.f;
#pragma unroll
            for (int j = 0; j < 4; ++j) s += (v[j].x * v[j].x + v[j].y * v[j].y) + (v[j].z * v[j].z + v[j].w * v[j].w);
            const float rinv = 1.f / sqrtf(wave_sum(s) * (1.f / DM) + EPS);
            GAS unsigned long long* o8 = (GAS unsigned long long*)(dst + (size_t)m * DM) + lane;
#pragma unroll
            for (int j = 0; j < 4; ++j) { const f32x4 y = v[j] * rinv * av[j] + sh[j]; o8[64 * j] = (unsigned long long)pk2(y.x, y.y) | ((unsigned long long)pk2(y.z, y.w) << 32); }
#pragma unroll
            for (int j = 0; j < 4; ++j) v[j] = vn[j];
        }
    }
}

struct P1Prob {
    static constexpr int K = DM; static constexpr bool PERM = false, FP8 = false; static constexpr int SCW = 0, SCA = 0;
    const bf16* XN; const bf16* WinT; bf16 *Q, *Kb, *Vb; float* FT; const float *qg, *kg; unsigned* kmax; pg8::StaticOrder so;
    __device__ __forceinline__ bool next(int i, pg8::Unit& u) const { return so.next(i, u); }
    __device__ __forceinline__ const char* aptr(const pg8::Unit& u) const { return u.pn == 0 ? (const char*)WinT : (const char*)(XN + (size_t)u.pm * 256 * DM); }
    __device__ __forceinline__ const char* bptr(const pg8::Unit& u) const { return u.pn == 0 ? (const char*)(XN + (size_t)u.pm * 256 * DM) : (const char*)(WinT + (size_t)u.pn * 256 * DM); }
    __device__ __forceinline__ void epi(const pg8::f32x4 (&acc)[2][2][4][2], const pg8::Unit& u, int wr, int wc, int fr, int fq) const {
        if (u.pn == 0) {
            if (u.pm >= NTOK / 256) return;
#pragma unroll
            for (int ai = 0; ai < 2; ++ai)
#pragma unroll
                for (int m = 0; m < 4; ++m) { float* rowp = FT + (size_t)(ai * 128 + wr * 64 + m * 16 + fr) * NTOK + u.pm * 256 + wc * 32 + 4 * fq;
#pragma unroll
                    for (int bj = 0; bj < 2; ++bj)
#pragma unroll
                        for (int n = 0; n < 2; ++n) *(pg8::f32x4*)(rowp + bj * 128 + n * 16) = acc[ai][bj][m][n]; }
            return;
        }
        const bool isq = u.pn <= 3, isv = u.pn == 5, lat = u.pm < NTOK / 256;
        if (isq && !lat) return;
        if (isv) {
#pragma unroll
            for (int ai = 0; ai < 2; ++ai)
#pragma unroll
                for (int m = 0; m < 4; ++m) { const int t = u.pm * 256 + ai * 128 + wr * 64 + m * 16 + fr; bf16* rowp = Vb + (size_t)t * 256 + wc * 64 + 4 * fq;
#pragma unroll
                    for (int bj = 0; bj < 2; ++bj)
#pragma unroll
                        for (int n = 0; n < 2; ++n) { const pg8::f32x4 v = acc[ai][bj][m][n]; *(v2u*)(rowp + 32 * bj + 16 * n) = (v2u){pk2(v[0], v[1]), pk2(v[2], v[3])}; } }
            return;
        }
        const float* gw = isq ? qg : kg;
        pg8::f32x4 gv[2][2];
#pragma unroll
        for (int bj = 0; bj < 2; ++bj)
#pragma unroll
            for (int n = 0; n < 2; ++n) gv[bj][n] = *(const pg8::f32x4*)(gw + 32 * bj + 16 * n + 4 * fq);
        float frq[4];
#pragma unroll
        for (int e = 0; e < 4; ++e) frq[e] = exp2f(-(float)(4 * fq + e) * (13.287712379549449f / 16.f)) * 0.15915494309189535f;
        const float qs = isq ? attn_body::C2 : 1.f;
        bf16* base = isq ? Q + (size_t)((u.pn - 1) * 4 + wc) * 64 : Kb + (size_t)wc * 64; const int pitch = isq ? 768 : 256;
        float k2max = 0.f;
#pragma unroll
        for (int ai = 0; ai < 2; ++ai) {
            float rowpos = (float)(u.pm * 4 + ai * 2 + wr); asm volatile("" : "+v"(rowpos));
            float cr[4], sr[4];
#pragma unroll
            for (int e = 0; e < 4; ++e) { const float rev = rowpos * frq[e], f_ = rev - floorf(rev); cr[e] = __builtin_amdgcn_cosf(f_); sr[e] = __builtin_amdgcn_sinf(f_); }
#pragma unroll
            for (int m = 0; m < 4; ++m) {
                float colpos = (float)(m * 16 + fr); asm volatile("" : "+v"(colpos));
                const int t = u.pm * 256 + ai * 128 + wr * 64 + m * 16 + fr;
                float ss = 0.f;
#pragma unroll
                for (int bj = 0; bj < 2; ++bj)
#pragma unroll
                    for (int n = 0; n < 2; ++n) { const pg8::f32x4 v = acc[ai][bj][m][n]; ss += (v[0] * v[0] + v[1] * v[1]) + (v[2] * v[2] + v[3] * v[3]); }
                ss += __shfl_xor(ss, 16); ss += __shfl_xor(ss, 32);
                const float rinv = qs / sqrtf(ss * (1.f / 64.f) + EPS);
                pg8::f32x4 y[2][2];
#pragma unroll
                for (int bj = 0; bj < 2; ++bj)
#pragma unroll
                    for (int n = 0; n < 2; ++n) y[bj][n] = acc[ai][bj][m][n] * rinv * gv[bj][n];
                if (lat) {
#pragma unroll
                    for (int e = 0; e < 4; ++e) {
                        { const float x1 = y[0][0][e], x2 = y[0][1][e]; y[0][0][e] = x1 * cr[e] - x2 * sr[e]; y[0][1][e] = x1 * sr[e] + x2 * cr[e]; }
                        { const float rev = colpos * frq[e], f_ = rev - floorf(rev); const float cc = __builtin_amdgcn_cosf(f_), sc = __builtin_amdgcn_sinf(f_);
                          const float x1 = y[1][0][e], x2 = y[1][1][e]; y[1][0][e] = x1 * cc - x2 * sc; y[1][1][e] = x1 * sc + x2 * cc; }
                    }
                }
                bf16* rowp = base + (size_t)t * pitch + 4 * fq;
                ss = 0.f;
#pragma unroll
                for (int bj = 0; bj < 2; ++bj)
#pragma unroll
                    for (int n = 0; n < 2; ++n) { const pg8::f32x4 v = y[bj][n]; const v2u w = (v2u){pk2(v[0], v[1]), pk2(v[2], v[3])}; *(v2u*)(rowp + 32 * bj + 16 * n) = w;
                        if (!isq) { const float b0 = __uint_as_float(w.x << 16), b1 = __uint_as_float(w.x & 0xffff0000u), b2 = __uint_as_float(w.y << 16), b3 = __uint_as_float(w.y & 0xffff0000u); ss += (b0 * b0 + b1 * b1) + (b2 * b2 + b3 * b3); } }
                if (!isq) { float r2 = ss; r2 += __shfl_xor(r2, 16); r2 += __shfl_xor(r2, 32); k2max = fmaxf(k2max, r2); }
                asm volatile("" ::: "memory");
            }
        }
        if (!isq) {
#pragma unroll
            for (int o = 1; o < 16; o <<= 1) k2max = fmaxf(k2max, __shfl_xor(k2max, o));
            if (fr == 0 && fq == 0) __hip_atomic_fetch_max(kmax, __float_as_uint(k2max), __ATOMIC_RELAXED, __HIP_MEMORY_SCOPE_AGENT);
        }
    }
};

__device__ __forceinline__ unsigned rev4_12(unsigned k) { unsigned r = __brev(k) >> 20; return ((r & 0xAAAu) >> 1) | ((r & 0x555u) << 1); }
__device__ __forceinline__ void fft_block(const Args& a, LAS unsigned char* lds, int item, int wave) {
    const int tid = wave * 64 + fresh_lane();
    const int mm = item & 31, par = (item >> 5) & 1, g = item >> 6;
    const float* FT = (const float*)(a.ws + WS_FT); bf16* MIX = (bf16*)(a.ws + WS_MIX);
    LAS f32x2* X = (LAS f32x2*)lds;
    const float* re = FT + (size_t)(64 * g + mm) * NTOK; const float* im = FT + (size_t)(64 * g + 32 + mm) * NTOK;
#pragma unroll 1
    for (int i = 0; i < 2; ++i) {
        const int j0 = 4 * (tid + NTHR * i);
        f32x4 r4[4], i4[4];
#pragma unroll
        for (int q = 0; q < 4; ++q) { r4[q] = *(const f32x4*)(re + j0 + 4096 * q); i4[q] = *(const f32x4*)(im + j0 + 4096 * q); }
#pragma unroll
        for (int e = 0; e < 4; ++e) {
            const int j = j0 + e;
            const f32x2 a0 = {r4[0][e], i4[0][e]}, a1 = {r4[1][e], i4[1][e]}, a2 = {r4[2][e], i4[2][e]}, a3 = {r4[3][e], i4[3][e]};
            f32x2 ya, yb; float fa, fb;
            if (par == 0) { const f32x2 s02 = a0 + a2, s13 = a1 + a3; ya = s02 + s13; yb = s02 - s13; fa = 0.f; fb = (float)(2 * j) * (1.f / 16384.f); }
            else { const f32x2 d02 = a0 - a2, d13 = a1 - a3; ya = (f32x2){d02.x + d13.y, d02.y - d13.x}; yb = (f32x2){d02.x - d13.y, d02.y + d13.x}; fa = (float)j * (1.f / 16384.f); fb = (float)(3 * j) * (1.f / 16384.f); }
            const float ca = __builtin_amdgcn_cosf(fa), sa = __builtin_amdgcn_sinf(fa), cb = __builtin_amdgcn_cosf(fb), sb = __builtin_amdgcn_sinf(fb);
            X[j] = (f32x2){ya.x * ca + ya.y * sa, ya.y * ca - ya.x * sa};
            X[4096 + j] = (f32x2){yb.x * cb + yb.y * sb, yb.y * cb - yb.x * sb};
        }
    }
    __syncthreads();
#pragma unroll 1
    for (int s = 0; s < 6; ++s) {
        const int lq = 10 - 2 * s;
        const int Lq = 1 << lq;
        const float invL = 1.f / (float)(4 << lq);
#pragma unroll 2
        for (int i = 0; i < 4; ++i) {
            const int b = tid + NTHR * i, j = b & (Lq - 1), base = ((b >> lq) << (lq + 2)) + j;
            const f32x2 a0 = X[base], a1 = X[base + Lq], a2 = X[base + 2 * Lq], a3 = X[base + 3 * Lq];
            const f32x2 s02 = a0 + a2, d02 = a0 - a2, s13 = a1 + a3, d13 = a1 - a3;
            const f32x2 y0 = s02 + s13, y2 = s02 - s13;
            const f32x2 y1 = (f32x2){d02.x + d13.y, d02.y - d13.x};
            const f32x2 y3 = (f32x2){d02.x - d13.y, d02.y + d13.x};
            const float f1 = (float)j * invL;
            const float c1 = __builtin_amdgcn_cosf(f1), s1 = __builtin_amdgcn_sinf(f1);
            const float c2 = __builtin_amdgcn_cosf(2.f * f1), s2 = __builtin_amdgcn_sinf(2.f * f1);
            const float c3 = __builtin_amdgcn_cosf(3.f * f1), s3 = __builtin_amdgcn_sinf(3.f * f1);
            X[base] = y0;
            X[base + Lq] = (f32x2){y1.x * c1 + y1.y * s1, y1.y * c1 - y1.x * s1};
            X[base + 2 * Lq] = (f32x2){y2.x * c2 + y2.y * s2, y2.y * c2 - y2.x * s2};
            X[base + 3 * Lq] = (f32x2){y3.x * c3 + y3.y * s3, y3.y * c3 - y3.x * s3};
        }
        __syncthreads();
    }
    const int col = 64 * g + 2 * mm;
#pragma unroll 1
    for (int i = 0; i < 16; ++i) {
        const int k = 2 * (tid + NTHR * i) + par, kn = (NTOK - k) & (NTOK - 1);
        const f32x2 wk = X[(((k & 3) - par) >> 1) * 4096 + rev4_12((unsigned)(k >> 2))], wn = X[(((kn & 3) - par) >> 1) * 4096 + rev4_12((unsigned)(kn >> 2))];
        float o0, o1;
        if (mm == 0) { o0 = 0.5f * (wk.x + wn.x); o1 = 0.5f * (wk.y + wn.y); }
        else { o0 = wn.x; o1 = wk.x; }
        *(unsigned*)(MIX + (size_t)k * DM + col) = pk2(o0, o1);
    }
    __syncthreads();
}

struct P3Prob {
    static constexpr int K = DM; static constexpr bool PERM = false, FP8 = false; static constexpr int SCW = 0, SCA = 0;
    const bf16* MIX; const bf16* WoT; const float* x; const float* g1; float* X1; pg8::StaticOrder so;
    __device__ __forceinline__ bool next(int i, pg8::Unit& u) const { return so.next(i, u); }
    __device__ __forceinline__ const char* aptr(const pg8::Unit& u) const { return (const char*)(MIX + (size_t)u.pm * 256 * DM); }
    __device__ __forceinline__ const char* bptr(const pg8::Unit& u) const { return (const char*)(WoT + (size_t)u.pn * 256 * DM); }
    __device__ __forceinline__ void epi(const pg8::f32x4 (&acc)[2][2][4][2], const pg8::Unit& u, int wr, int wc, int fr, int fq) const {
        const int col0 = u.pn * 256 + wc * 32 + 4 * fq;
        pg8::f32x4 gv[2][2];
#pragma unroll
        for (int bj = 0; bj < 2; ++bj)
#pragma unroll
            for (int n = 0; n < 2; ++n) gv[bj][n] = *(const pg8::f32x4*)(g1 + col0 + bj * 128 + n * 16);
#pragma unroll
        for (int ai = 0; ai < 2; ++ai)
#pragma unroll
            for (int m = 0; m < 4; ++m) { const size_t off = (size_t)(u.pm * 256 + ai * 128 + wr * 64 + m * 16 + fr) * DM + col0;
#pragma unroll
                for (int bj = 0; bj < 2; ++bj)
#pragma unroll
                    for (int n = 0; n < 2; ++n) { const pg8::f32x4 bs = *(const pg8::f32x4*)(x + off + bj * 128 + n * 16); *(pg8::f32x4*)(X1 + off + bj * 128 + n * 16) = bs + gv[bj][n] * acc[ai][bj][m][n]; }
                if (m & 1) asm volatile("" ::: "memory"); }
    }
};

__device__ __forceinline__ void p3b_router(const Args& a, LAS unsigned char* lds, int vcu, int G, int wave) {
    const int lane = fresh_lane(), tid = wave * 64 + lane;
    unsigned char* ws = a.ws; const float* MOD = (const float*)(ws + WS_MOD); const float* X1 = (const float*)(ws + WS_X1); bf16* H2 = (bf16*)(ws + WS_H2); float* AFF = (float*)(ws + WS_AFF);
    LAS float* wrt = (LAS float*)lds;
    { f32x4 t[8];
#pragma unroll
      for (int q = 0; q < 8; ++q) t[q] = *(const f32x4*)(a.w_router + 4 * (tid + NTHR * q));
#pragma unroll
      for (int q = 0; q < 8; ++q) { const int i = 4 * (tid + NTHR * q), col = i >> 4, e = i & 15;
#pragma unroll
          for (int k = 0; k < 4; ++k) wrt[(e + k) * 1024 + col] = t[q][k]; } }
    __syncthreads();
    f32x4 av[4], sh[4];
#pragma unroll
    for (int j = 0; j < 4; ++j) { const int col = 4 * lane + 256 * j; const f32x4 g = *(const f32x4*)(a.norm_ffn_g + col); const f32x4 sc = *(const f32x4*)(MOD + 4 * DM + col); av[j] = g * (sc + 1.f); sh[j] = *(const f32x4*)(MOD + 3 * DM + col); }
    const int gw = vcu * NWAVES + wave, NGW = G * NWAVES;
    f32x4 v[4], vn[4];
    if (gw < NTOK) { const GAS f32x4* xr = (const GAS f32x4*)(X1 + (size_t)gw * DM) + lane;
#pragma unroll
        for (int j = 0; j < 4; ++j) v[j] = xr[64 * j]; }
    for (int m = gw; m < NTOK; m += NGW) {
        const int mn = m + NGW;
        if (mn < NTOK) { const GAS f32x4* xr = (const GAS f32x4*)(X1 + (size_t)mn * DM) + lane;
#pragma unroll
            for (int j = 0; j < 4; ++j) vn[j] = xr[64 * j]; }
        float s = 0.f;
#pragma unroll
        for (int j = 0; j < 4; ++j) s += (v[j].x * v[j].x + v[j].y * v[j].y) + (v[j].z * v[j].z + v[j].w * v[j].w);
        const float rinv = 1.f / sqrtf(wave_sum(s) * (1.f / DM) + EPS);
        GAS unsigned* o4 = (GAS unsigned*)((unsigned char*)H2 + (size_t)m * DM) + lane;
#pragma unroll
        for (int j = 0; j < 4; ++j) { v[j] = v[j] * rinv * av[j] + sh[j]; o4[64 * j] = pk4_fp8(v[j].x, v[j].y, v[j].z, v[j].w); }
        float lg[16];
#pragma unroll
        for (int e0 = 0; e0 < 16; e0 += 4) {
#pragma unroll
            for (int e = e0; e < e0 + 4; ++e) { float p = 0.f;
#pragma unroll
                for (int j = 0; j < 4; ++j) { const f32x4 w = *(const LAS f32x4*)(wrt + e * 1024 + 4 * lane + 256 * j); p += (v[j].x * w.x + v[j].y * w.y) + (v[j].z * w.z + v[j].w * w.w); }
                lg[e] = p; }
            asm volatile("" ::: "memory"); }
        float r8[8], r4[4], r2[2], r1;
        { const bool up = (lane & 32) != 0;
#pragma unroll
          for (int e = 0; e < 8; ++e) { const float snd = up ? lg[e] : lg[e + 8], kp = up ? lg[e + 8] : lg[e]; r8[e] = kp + __shfl_xor(snd, 32); } }
        { const bool up = (lane & 16) != 0;
#pragma unroll
          for (int e = 0; e < 4; ++e) { const float snd = up ? r8[e] : r8[e + 4], kp = up ? r8[e + 4] : r8[e]; r4[e] = kp + __shfl_xor(snd, 16); } }
        { const bool up = (lane & 8) != 0;
#pragma unroll
          for (int e = 0; e < 2; ++e) { const float snd = up ? r4[e] : r4[e + 2], kp = up ? r4[e + 2] : r4[e]; r2[e] = kp + __shfl_xor(snd, 8); } }
        { const bool up = (lane & 4) != 0; const float snd = up ? r2[0] : r2[1], kp = up ? r2[1] : r2[0]; r1 = kp + __shfl_xor(snd, 4); }
        r1 += __shfl_xor(r1, 2); r1 += __shfl_xor(r1, 1);
        float mx = r1;
#pragma unroll
        for (int o = 4; o < 64; o <<= 1) mx = fmaxf(mx, __shfl_xor(mx, o));
        const float ex = __expf(r1 - mx); float den = ex;
#pragma unroll
        for (int o = 4; o < 64; o <<= 1) den += __shfl_xor(den, o);
        if ((lane & 3) == 0) AFF[(size_t)(lane >> 2) * NTOK + m] = ex / den;
#pragma unroll
        for (int j = 0; j < 4; ++j) v[j] = vn[j];
    }
}

__device__ __forceinline__ void p4_topk(const Args& a, LAS unsigned char* lds, int e, int wave) {
    const int lane = fresh_lane(), tid = wave * 64 + lane;
    unsigned char* ws = a.ws; const unsigned* AFF = (const unsigned*)(ws + WS_AFF) + (size_t)e * NTOK;
    int* IDX = (int*)(ws + WS_IDX) + e * CAP; float* GATE = (float*)(ws + WS_GATE) + e * CAP; int* TOKSLOT = (int*)(ws + WS_TOKSLOT);
    LAS unsigned* wcnt = (LAS unsigned*)lds;
    LAS unsigned* cg = wcnt + 16;
    LAS unsigned* ce = cg + 256;
    unsigned key[32];
#pragma unroll
    for (int i = 0; i < 32; ++i) key[i] = AFF[i * NTHR + tid];
    unsigned T = 0u;
#pragma unroll 1
    for (int bit = 30; bit >= 0; --bit) {
        const unsigned cand = T | (1u << bit);
        unsigned c = 0u;
#pragma unroll
        for (int i = 0; i < 32; ++i) c += (unsigned)__popcll(__ballot(key[i] >= cand));
        LAS unsigned* wb = wcnt + 1024 + (bit & 1) * 8;
        if (lane == 0) wb[wave] = c;
        __syncthreads();
        unsigned tot = 0u;
#pragma unroll
        for (int w = 0; w < 8; ++w) tot += wb[w];
        if (tot >= (unsigned)CAP) T = cand;
    }
    __syncthreads();
    unsigned long long below = (1ull << lane) - 1ull;
    unsigned rg[32], rq[32];
#pragma unroll
    for (int i = 0; i < 32; ++i) {
        const unsigned long long bg = __ballot(key[i] > T), bq = __ballot(key[i] == T);
        rg[i] = (unsigned)__popcll(bg & below); rq[i] = (unsigned)__popcll(bq & below);
        if (lane == 0) { cg[i * 8 + wave] = (unsigned)__popcll(bg); ce[i * 8 + wave] = (unsigned)__popcll(bq); }
    }
    __syncthreads();
    if (wave == 0) {
        unsigned g4[4], q4[4], sg = 0u, sq = 0u;
#pragma unroll
        for (int k = 0; k < 4; ++k) { g4[k] = cg[4 * lane + k]; q4[k] = ce[4 * lane + k]; sg += g4[k]; sq += q4[k]; }
        unsigned pg = sg, pq = sq;
#pragma unroll
        for (int o = 1; o < 64; o <<= 1) { const unsigned tg = __shfl_up(pg, o), tq = __shfl_up(pq, o); if (lane >= o) { pg += tg; pq += tq; } }
        pg -= sg; pq -= sq;
#pragma unroll
        for (int k = 0; k < 4; ++k) { cg[4 * lane + k] = pg; ce[4 * lane + k] = pq; pg += g4[k]; pq += q4[k]; }
        if (lane == 63) { wcnt[8] = pg; }
    }
    __syncthreads();
    const unsigned ngt = wcnt[8], need = (unsigned)CAP - ngt;
#pragma unroll
    for (int i = 0; i < 32; ++i) {
        const int tok = i * NTHR + tid;
        const unsigned gb = cg[i * 8 + wave] + rg[i], qb = ce[i * 8 + wave] + rq[i];
        const bool sel = key[i] > T || (key[i] == T && qb < need);
        const unsigned slot = gb + (qb < need ? qb : need);
        if (sel) { IDX[slot] = tok; GATE[slot] = __uint_as_float(key[i]); }
        TOKSLOT[tok * 16 + e] = sel ? (int)slot : -1;
    }
}

struct P5Prob {
    static constexpr int K = DM; static constexpr bool PERM = true, FP8 = true; static constexpr int SCW = 0x7A7A7A7A, SCA = 0x7F7F7F7F;
    const unsigned char* H2; const unsigned char* WguT; unsigned char* HID; pg8::StaticOrder so;
    __device__ __forceinline__ bool next(int i, pg8::Unit& u) const { return so.next(i, u); }
    __device__ __forceinline__ const char* aptr(const pg8::Unit&) const { return (const char*)H2; }
    __device__ __forceinline__ const char* bptr(const pg8::Unit& u) const { return (const char*)(WguT + ((size_t)(u.pm >> 3) * 4096 + (size_t)u.pn * 256) * DM); }
    __device__ __forceinline__ void epi(const pg8::f32x4 (&acc)[2][2][4][2], const pg8::Unit& u, int wr, int wc, int fr, int fq) const {
#pragma unroll
        for (int ai = 0; ai < 2; ++ai)
#pragma unroll
            for (int m = 0; m < 4; ++m) { unsigned char* rowp = HID + (size_t)(u.pm * 256 + ai * 128 + wr * 64 + m * 16 + fr) * DE + u.pn * 128 + wc * 32 + 8 * fq;
                float h[8];
#pragma unroll
                for (int n = 0; n < 2; ++n)
#pragma unroll
                    for (int e = 0; e < 4; ++e) { const float gt = acc[ai][0][m][n][e], up = acc[ai][1][m][n][e]; h[4 * n + e] = gt * __builtin_amdgcn_rcpf(1.f + __builtin_amdgcn_exp2f(-1.4426950408889634f * gt)) * up; }
                *(v2u*)rowp = (v2u){pk4_fp8(h[0], h[1], h[2], h[3]), pk4_fp8(h[4], h[5], h[6], h[7])}; }
    }
};
struct P6Prob {
    static constexpr int K = DE; static constexpr bool PERM = true, FP8 = true; static constexpr int SCW = 0x7A7A7A7A, SCA = 0x7F7F7F7F;
    const unsigned char* HID; const unsigned char* WdT; const float* GATE; bf16* YE; pg8::StaticOrder so;
    __device__ __forceinline__ bool next(int i, pg8::Unit& u) const { return so.next(i, u); }
    __device__ __forceinline__ const char* aptr(const pg8::Unit& u) const { return (const char*)(HID + (size_t)u.pm * 256 * DE); }
    __device__ __forceinline__ const char* bptr(const pg8::Unit& u) const { return (const char*)(WdT + ((size_t)(u.pm >> 3) * DM + (size_t)u.pn * 256) * DE); }
    __device__ __forceinline__ void epi(const pg8::f32x4 (&acc)[2][2][4][2], const pg8::Unit& u, int wr, int wc, int fr, int fq) const {
#pragma unroll
        for (int ai = 0; ai < 2; ++ai)
#pragma unroll
            for (int m = 0; m < 4; ++m) { const int row = u.pm * 256 + ai * 128 + wr * 64 + m * 16 + fr; const float gt = GATE[row]; bf16* rowp = YE + (size_t)row * DM + u.pn * 256 + wc * 32 + 8 * fq;
#pragma unroll
                for (int bj = 0; bj < 2; ++bj) { const pg8::f32x4 v0 = acc[ai][bj][m][0] * gt, v1 = acc[ai][bj][m][1] * gt;
                    *(v4u*)(rowp + bj * 128) = (v4u){pk2(v0[0], v0[1]), pk2(v0[2], v0[3]), pk2(v1[0], v1[1]), pk2(v1[2], v1[3])}; } }
    }
};

__device__ __forceinline__ void p7_final(const Args& a, int vcu, int G, int wave, unsigned poison) {
    const int lane = fresh_lane();
    unsigned char* ws = a.ws; const float* MOD = (const float*)(ws + WS_MOD); const bf16* YE = (const bf16*)(ws + WS_YE); const int* TOKSLOT = (const int*)(ws + WS_TOKSLOT);
    const float* src = (STEP >= 2) ? (const float*)(ws + WS_X1) : a.x;
    f32x4 g2[4], fg[4];
#pragma unroll
    for (int j = 0; j < 4; ++j) { const int col = 4 * lane + 256 * j; g2[j] = *(const f32x4*)(MOD + 5 * DM + col); fg[j] = *(const f32x4*)(a.final_norm_g + col); }
    const int gw = vcu * NWAVES + wave, NGW = G * NWAVES;
    for (int m = gw; m < NTOK; m += NGW) {
        const GAS f32x4* xr = (const GAS f32x4*)(src + (size_t)m * DM) + lane;
        f32x4 v[4];
#pragma unroll
        for (int j = 0; j < 4; ++j) v[j] = xr[64 * j];
        if (STEP >= 4) {
            const int myslot = lane < 16 ? TOKSLOT[m * 16 + lane] : -1;
            f32x4 s[4];
#pragma unroll
            for (int j = 0; j < 4; ++j) s[j] = (f32x4){0.f, 0.f, 0.f, 0.f};
#pragma unroll 1
            for (int e = 0; e < 16; ++e) {
                const int sl = __builtin_amdgcn_readlane(myslot, e);
                if (sl >= 0) {
                    const GAS v2u* yr = (const GAS v2u*)(YE + ((size_t)e * CAP + sl) * DM) + lane;
#pragma unroll
                    for (int j = 0; j < 4; ++j) { const v2u w = yr[64 * j]; s[j].x += __uint_as_float(w.x << 16); s[j].y += __uint_as_float(w.x & 0xffff0000u); s[j].z += __uint_as_float(w.y << 16); s[j].w += __uint_as_float(w.y & 0xffff0000u); }
                }
            }
#pragma unroll
            for (int j = 0; j < 4; ++j) v[j] += g2[j] * s[j];
        }
        float ss = 0.f;
#pragma unroll
        for (int j = 0; j < 4; ++j) ss += (v[j].x * v[j].x + v[j].y * v[j].y) + (v[j].z * v[j].z + v[j].w * v[j].w);
        const float rinv = 1.f / sqrtf(wave_sum(ss) * (1.f / DM) + EPS);
        GAS f32x4* o = (GAS f32x4*)(a.out + (size_t)m * DM) + lane;
        const float q = __builtin_nanf("");
#pragma unroll
        for (int j = 0; j < 4; ++j) { f32x4 y = v[j] * rinv * fg[j]; if (poison) y = (f32x4){q, q, q, q}; o[64 * j] = y; }
    }
}


#if PROBE
__device__ __forceinline__ void dsincos(double x, double& sn, double& cs) {
    const double TWO_PI = 6.283185307179586476925286766559; x -= TWO_PI * rint(x / TWO_PI);
    const double x2 = x * x; double ts = x, tc = 1.0; sn = x; cs = 1.0;
#pragma unroll 1
    for (int k = 1; k <= 14; ++k) { tc *= -x2 / (double)((2 * k - 1) * (2 * k)); ts *= -x2 / (double)((2 * k) * (2 * k + 1)); cs += tc; sn += ts; }
}
__device__ __forceinline__ float block_sum(float v, LAS float* red, int wave, int lane) {
    v = wave_sum(v); __syncthreads(); if (lane == 0) red[wave] = v; __syncthreads(); float s = 0.f;
#pragma unroll
    for (int w = 0; w < 8; ++w) s += red[w];
    return s;
}
__device__ __forceinline__ float block_max(float v, LAS float* red, int wave, int lane) {
#pragma unroll
    for (int o = 1; o < 64; o <<= 1) v = fmaxf(v, __shfl_xor(v, o));
    __syncthreads(); if (lane == 0) red[wave] = v; __syncthreads(); float s = red[0];
#pragma unroll
    for (int w = 1; w < 8; ++w) s = fmaxf(s, red[w]);
    return s;
}
__device__ __forceinline__ void probe_qkv(const Args& a, LAS unsigned char* lds, int vcu, int wave) {
    const int lane = fresh_lane(), tid = wave * 64 + lane; unsigned char* ws = a.ws;
    const bf16* XN = (const bf16*)(ws + WS_XN); const bf16* Qb = (const bf16*)(ws + WS_Q); const bf16* Kb = (const bf16*)(ws + WS_K); const bf16* Vb = (const bf16*)(ws + WS_V);
    gu32* ctl = (gu32*)(ws + WS_CTL);
    LAS float* red = (LAS float*)lds; LAS float* raw = red + 16;
    for (int kind = 0; kind < 3; ++kind) {
        const int nrows = kind == 0 ? NTOK : NROWS, nh = kind == 0 ? NHQ : NHKV;
        const int t = (kind == 1 && (vcu & 7) == 3) ? NTOK + (vcu * 37) % NCTX : (vcu * 977 + 131 * kind + 5) % (kind == 0 ? NTOK : NTOK);
        const int h = (vcu * 5 + kind) % nh;
        const int wcol0 = 256 + (kind == 0 ? 0 : (kind == 1 ? 768 : 1024)) + 64 * h;
        { const int d = tid & 63, part = tid >> 6; float sacc = 0.f;
          for (int k = part * 128; k < part * 128 + 128; ++k) sacc += bf2f(XN[(size_t)t * DM + k]) * a.w_in[(size_t)k * INW + wcol0 + d];
          LAS float* part_s = raw + 64; part_s[part * 64 + d] = sacc; __syncthreads();
          if (tid < 64) { float s2 = 0.f; for (int pp = 0; pp < 8; ++pp) s2 += part_s[pp * 64 + tid]; raw[tid] = s2; }
          __syncthreads(); }
        float ref = 0.f, got = 0.f;
        if (tid < 64) {
            const int d = tid; float v = raw[d];
            if (kind < 2) {
                float ss = 0.f; for (int j = 0; j < 64; ++j) ss += raw[j] * raw[j];
                const float* gw = kind == 0 ? a.q_norm_g : a.k_norm_g;
                const float rinv = 1.f / sqrtf(ss / 64.f + EPS);
                if (t < NTOK) {
                    const int half = d >> 5, dd = d & 31, i = dd & 15; const int pos = half == 0 ? (t >> 6) : (t & 63);
                    const double freq = exp2(-(double)i * (13.287712379549449 / 16.0)); double sn, cs; dsincos((double)pos * freq, sn, cs);
                    const float x1 = raw[32 * half + i] * rinv * gw[32 * half + i], x2 = raw[32 * half + 16 + i] * rinv * gw[32 * half + 16 + i];
                    v = dd < 16 ? (float)(x1 * cs - x2 * sn) : (float)(x1 * sn + x2 * cs);
                } else v = v * rinv * gw[d];
                if (kind == 0) v *= attn_body::C2;
            }
            ref = v;
            got = kind == 0 ? bf2f(Qb[(size_t)t * 768 + 64 * h + d]) : (kind == 1 ? bf2f(Kb[(size_t)t * 256 + 64 * h + d]) : bf2f(Vb[(size_t)t * 256 + 64 * h + d]));
        }
        const float mx = block_max(fabsf(ref), red, wave, lane);
        const float err = block_max(fabsf(ref - got), red, wave, lane);
        if (tid == 0 && !(err <= 0.03f * mx + 1e-6f)) __hip_atomic_fetch_or(ctl + CW_FLAG, 1u << kind, RLX_AGENT);
        __syncthreads();
    }
}
__device__ __forceinline__ void probe_attn(const Args& a, LAS unsigned char* lds, int vcu, int wave) {
    const int lane = fresh_lane(), tid = wave * 64 + lane; unsigned char* ws = a.ws;
    const bf16* Qb = (const bf16*)(ws + WS_Q); const bf16* Kb = (const bf16*)(ws + WS_K); const bf16* Vb = (const bf16*)(ws + WS_V); const bf16* MIX = (const bf16*)(ws + WS_MIX);
    gu32* ctl = (gu32*)(ws + WS_CTL);
    LAS float* red = (LAS float*)lds; LAS float* ored = red + 16;
    const int t = (vcu * 613 + 29) % NTOK, h = (vcu * 7 + 3) % NHQ, kvh = h / 3;
    float q[64];
#pragma unroll
    for (int d = 0; d < 64; ++d) q[d] = bf2f(Qb[(size_t)t * 768 + 64 * h + d]);
    float sc[33]; float mx = -1e30f;
#pragma unroll
    for (int i = 0; i < 33; ++i) { const int key = i * NTHR + tid; float s = -1e30f;
        if (key < NKEYS) { s = 0.f; const bf16* kr = Kb + (size_t)key * 256 + 64 * kvh;
#pragma unroll
            for (int d = 0; d < 64; ++d) s += q[d] * bf2f(kr[d]); }
        sc[i] = s; mx = fmaxf(mx, s); }
    mx = block_max(mx, red, wave, lane);
    float den = 0.f; float o[64];
#pragma unroll
    for (int d = 0; d < 64; ++d) o[d] = 0.f;
#pragma unroll
    for (int i = 0; i < 33; ++i) { const int key = i * NTHR + tid;
        if (key < NKEYS) { const float pp = exp2f(sc[i] - mx); den += pp; const bf16* vr = Vb + (size_t)key * 256 + 64 * kvh;
#pragma unroll
            for (int d = 0; d < 64; ++d) o[d] += pp * bf2f(vr[d]); } }
    den = block_sum(den, red, wave, lane);
#pragma unroll
    for (int d = 0; d < 64; ++d) { const float w = wave_sum(o[d]); if (lane == 0) ored[wave * 64 + d] = w; }
    __syncthreads();
    float ref = 0.f, got = 0.f;
    if (tid < 64) { float s = 0.f; for (int w = 0; w < 8; ++w) s += ored[w * 64 + tid]; ref = s / den; got = bf2f(MIX[(size_t)t * DM + 256 + 64 * h + tid]); }
    const float m2 = block_max(fabsf(ref), red, wave, lane);
    const float err = block_max(fabsf(ref - got), red, wave, lane);
    if (tid == 0 && !(err <= 0.03f * m2 + 1e-7f)) __hip_atomic_fetch_or(ctl + CW_FLAG, 8u, RLX_AGENT);
    __syncthreads();
}
#endif

__global__ void __launch_bounds__(NTHR, 2) fwd_megakernel(Args args) {
    extern __shared__ __attribute__((aligned(16))) unsigned char lds_raw[];
    LAS unsigned char* lds = (LAS unsigned char*)lds_raw;
    volatile LAS unsigned* MISC = (volatile LAS unsigned*)(lds + MISC_OFF);
    const int wave = __builtin_amdgcn_readfirstlane(threadIdx.x >> 6);
    const int G = gridDim.x; const int bx = blockIdx.x; const int vcu = (G % 8 == 0) ? (bx % 8) * (G / 8) + bx / 8 : bx;
    unsigned char* ws = args.ws;
    gu32* ctl = (gu32*)(ws + WS_CTL);
    { const int l0 = fresh_lane(); if (wave < 2) ((LAS unsigned*)(lds + MISC_OFF))[wave * 64 + l0] = 0u;
      __syncthreads();
    }
    XcdBarrier bar = xcd_barrier_post((unsigned*)(ctl + CW_BAR), MISC + 8, wave == 0 && fresh_lane() == 0);
#define GRID_BAR() xcd_barrier(bar, wave)

    for (int rep = 0; rep < REP(0); ++rep) {
    if (STEP >= 2 && PH(0)) p0_prologue(args, lds, vcu, G, wave);
    GRID_BAR(); }
    for (int rep = 0; rep < REP(1); ++rep) {
    if (STEP >= 2 && PH(1)) p0b_modulate(args, vcu, G, wave);
    GRID_BAR(); }
    for (int rep = 0; rep < REP(2); ++rep) {
    if (STEP >= 2 && PH(2)) {
        P1Prob p; p.XN = (bf16*)(ws + WS_XN); p.WinT = (bf16*)(ws + WS_WIN); p.Q = (bf16*)(ws + WS_Q); p.Kb = (bf16*)(ws + WS_K); p.Vb = (bf16*)(ws + WS_V); p.FT = (float*)(ws + WS_FT);
        p.qg = args.q_norm_g; p.kg = args.k_norm_g; p.kmax = (unsigned*)(ctl + CW_KMAX); p.so.init(NROWS / 256, INW / 256, G, bx);
        pg8::gemm_phase<P1Prob, false, true, true>(lds, p, nullptr, wave);
        if (rep == 0 && MOE_S1 > 0) {
            const int nwg = (NROWS / 256) * (INW / 256), maxc = (nwg + G - 1) / G, c0 = nwg - (maxc - 1) * G;
            if (c0 >= G) moe_convert(args, (LAS float*)(lds + wave * 16640), MOE_B0, MOE_B1, bx * NWAVES + wave, G * NWAVES);
            else if (bx >= c0) moe_convert(args, (LAS float*)(lds + wave * 16640), MOE_B0, MOE_B1, (bx - c0) * NWAVES + wave, (G - c0) * NWAVES);
        }
    }
    GRID_BAR(); }
#if PROBE == 1
    probe_qkv(args, lds, vcu, wave);
#endif
    for (int rep = 0; rep < REP(3); ++rep) {
    if (STEP >= 2 && PH(3)) {
        for (int item = vcu; item < 256; item += G) fft_block(args, lds, item, wave);
        if (rep == 0 && MOE_S2 > 0) {
            if (G > 256) { if (vcu >= 256) moe_convert(args, (LAS float*)(lds + wave * 16640), MOE_B1, MOE_B2, (vcu - 256) * NWAVES + wave, (G - 256) * NWAVES); }
            else moe_convert(args, (LAS float*)(lds + wave * 16640), MOE_B1, MOE_B2, vcu * NWAVES + wave, G * NWAVES);
        }
    }
    if (rep + 1 < REP(3)) GRID_BAR(); }
    for (int rep = 0; rep < REP(4); ++rep) {
    if (STEP >= 3 && PH(4)) {
        const attn_body::bf16* Qb = (const attn_body::bf16*)(ws + WS_Q); const attn_body::bf16* Kb = (const attn_body::bf16*)(ws + WS_K); const attn_body::bf16* Vb = (const attn_body::bf16*)(ws + WS_V);
        attn_body::bf16* MIX = (attn_body::bf16*)(ws + WS_MIX);
        const float kmax2 = __uint_as_float(__hip_atomic_load(ctl + CW_KMAX, RLX_AGENT));
        const int u0 = (G == 256) ? vcu * 3 : vcu, ustep = (G == 256) ? 1 : G, uend = (G == 256) ? vcu * 3 + 3 : 768;
#pragma unroll 1
        for (int u = u0; u < uend; u += ustep) {
            const int kvh = u / 192, w = u % 192, h = kvh * 3 + w / 64, qb = w % 64;
            attn_body::attn_unit<8>(h, kvh, qb, Qb, Kb, Vb, MIX, (char*)lds_raw, wave, kmax2);
        }
    } else if (STEP == 2) {
        bf16* MIX = (bf16*)(ws + WS_MIX);
        const int gw = vcu * NWAVES + wave, NGW = G * NWAVES, lane = fresh_lane();
        for (int m = gw; m < NTOK; m += NGW) { GAS v4u* o = (GAS v4u*)(MIX + (size_t)m * DM + 256); o[lane] = (v4u){0u, 0u, 0u, 0u}; if (lane < 32) o[64 + lane] = (v4u){0u, 0u, 0u, 0u}; }
    }
    GRID_BAR(); }
#if PROBE == 2
    probe_attn(args, lds, vcu, wave);
#endif
    for (int rep = 0; rep < REP(5); ++rep) {
    if (STEP >= 2 && PH(5)) {
        P3Prob p; p.MIX = (bf16*)(ws + WS_MIX); p.WoT = (bf16*)(ws + WS_WOUT); p.x = args.x; p.g1 = (const float*)(ws + WS_MOD) + 2 * DM; p.X1 = (float*)(ws + WS_X1); p.so.init(NTOK / 256, DM / 256, G, bx);
        pg8::gemm_phase<P3Prob, false, true, true>(lds, p, nullptr, wave);
    }
    GRID_BAR(); }
    for (int rep = 0; rep < REP(6); ++rep) {
    if (STEP >= 4 && PH(6)) p3b_router(args, lds, vcu, G, wave);
    GRID_BAR(); }
    for (int rep = 0; rep < REP(7); ++rep) {
    if (STEP >= 4 && PH(7)) {
#pragma unroll 1
        for (int e = vcu; e < NE; e += G) p4_topk(args, lds, e, wave);
        if (rep == 0) {
            if (G > NE) { if (vcu >= NE) moe_convert(args, (LAS float*)(lds + wave * 16640), MOE_B2, MOE_ITEMS, (vcu - NE) * NWAVES + wave, (G - NE) * NWAVES); }
            else moe_convert(args, (LAS float*)(lds + wave * 16640), MOE_B2, MOE_ITEMS, vcu * NWAVES + wave, G * NWAVES);
        } }
    GRID_BAR(); }
    for (int rep = 0; rep < REP(8); ++rep) {
    if (STEP >= 4 && PH(8)) {
        P5Prob p; p.H2 = (const unsigned char*)(ws + WS_H2); p.WguT = (const unsigned char*)(ws + WS_WGU); p.HID = (unsigned char*)(ws + WS_HID); p.so.init(NE * CAP / 256, 2 * DE / 256, G, bx);
        LAS unsigned* rowtab = (LAS unsigned*)(lds + XTRA_OFF);
        const int* IDX = (const int*)(ws + WS_IDX);
        { const int tid = wave * 64 + fresh_lane(); pg8::Unit u; for (int i = 0; p.so.next(i, u) && i < 28; ++i) { if (tid < 256) rowtab[i * 256 + tid] = (unsigned)IDX[u.pm * 256 + tid]; } }
        __syncthreads();
        pg8::gemm_phase<P5Prob, true, true, true>(lds, p, rowtab, wave);
    }
    GRID_BAR(); }
    for (int rep = 0; rep < REP(9); ++rep) {
    if (STEP >= 4 && PH(9)) {
        P6Prob p; p.HID = (const unsigned char*)(ws + WS_HID); p.WdT = (const unsigned char*)(ws + WS_WD); p.GATE = (const float*)(ws + WS_GATE); p.YE = (bf16*)(ws + WS_YE); p.so.init(NE * CAP / 256, DM / 256, G, bx);
        pg8::gemm_phase<P6Prob, false, true, true>(lds, p, nullptr, wave);
    }
    GRID_BAR(); }
    {
        unsigned poison = (__hip_atomic_load(ctl + CW_BAR + XB_TMO, RLX_AGENT) != 0u) || (__hip_atomic_load(ctl + CW_FLAG, RLX_AGENT) != 0u);
        for (int rep = 0; rep < REP(10); ++rep) p7_final(args, vcu, G, wave, poison);
    }
}

extern "C" void kernel_launch(void* const* d_in, const int* in_sizes, int n_in, void* d_out, int out_size, void* d_ws, size_t ws_size, hipStream_t stream) {
    static int grid = 0;
    if (grid == 0) {
        if (n_in != 18 || in_sizes[0] != NTOK * DM || out_size != NTOK * DM || ws_size < WS_END) { fprintf(stderr, "kernel_launch: unexpected shapes (n_in %d, in0 %d, out %d, ws %zu)\n", n_in, n_in > 0 ? in_sizes[0] : -1, out_size, ws_size); grid = -1; return; }
        int dev = 0, cus = 0, per_cu = 0;
        if (hipGetDevice(&dev) != hipSuccess || hipDeviceGetAttribute(&cus, hipDeviceAttributeMultiprocessorCount, dev) != hipSuccess) { grid = -1; return; }
        if (hipFuncSetAttribute((const void*)fwd_megakernel, hipFuncAttributeMaxDynamicSharedMemorySize, LDS_BYTES) != hipSuccess) { fprintf(stderr, "kernel_launch: hipFuncSetAttribute failed\n"); grid = -1; return; }
        if (hipOccupancyMaxActiveBlocksPerMultiprocessor(&per_cu, (const void*)fwd_megakernel, NTHR, LDS_BYTES) != hipSuccess || per_cu < 1) { fprintf(stderr, "kernel_launch: occupancy query says %d blocks per CU\n", per_cu); (void)hipGetLastError(); grid = -1; return; }
        grid = cus;
    }
    if (grid < 0) return;
    (void)hipMemsetAsync((char*)d_ws + WS_CTL, 0, CTL_ZERO_BYTES, stream);
    Args a{};
    const float** f = (const float**)&a;
    for (int i = 0; i < 18; ++i) f[i] = (const float*)d_in[i];
    a.out = (float*)d_out; a.ws = (unsigned char*)d_ws;
    hipLaunchKernelGGL(fwd_megakernel, dim3(grid), dim3(NTHR), LDS_BYTES, stream, a);
}
```

```cpp
#include <hip/hip_runtime.h>
#include <hip/hip_bf16.h>
#include <cstdio>
#include <cstdint>
#include <cmath>

#ifndef STEP
#define STEP 4
#endif
#ifndef PROBE
#define PROBE 0
#endif
#ifndef PHMASK
#define PHMASK 0xFFFF
#endif
#define PH(k) ((PHMASK >> (k)) & 1)
#ifndef ATTN_F8
#define ATTN_F8 1
#endif
#ifndef REPEAT
#define REPEAT 0
#endif
#define REP(k) (((REPEAT >> (k)) & 1) + 1)

constexpr int DM = 1024, NTOK = 16384, NCTX = 256, NROWS = NTOK + NCTX, INW = 1536;
constexpr int NHQ = 12, NHKV = 4, HD = 64, NE = 16, CAP = 2048, DE = 2048, NMOD = 6;
constexpr int NKEYS = NROWS;
constexpr float EPS = 1e-6f;

__device__ __forceinline__ int fresh_lane() { int l; asm volatile("v_mbcnt_lo_u32_b32 %0, -1, 0\n\tv_mbcnt_hi_u32_b32 %0, -1, %0" : "=v"(l)); return l; }

namespace pg8 {
#define PG8_LAS __attribute__((address_space(3)))
typedef unsigned short bf16_t;
typedef short bf16x8 __attribute__((ext_vector_type(8)));
typedef float f32x4 __attribute__((ext_vector_type(4)));
typedef unsigned u32x4 __attribute__((ext_vector_type(4)));
typedef unsigned u32x2 __attribute__((ext_vector_type(2)));
typedef int v8i __attribute__((ext_vector_type(8)));
constexpr int BM = 256, BK = 64, HALF = 128, HTB = HALF * BK * 2, STAGE_BYTES = 8 * HTB, NXCD = 8, WGM = 8;

__host__ __device__ __forceinline__ int lds_byte(int r, int c) { const int st = (r >> 4) * 2 + (c >> 5), rr = r & 15, cc = c & 31, ob = rr * 64 + cc * 2; return st * 1024 + (ob ^ (((ob >> 9) & 1) << 5)); }
__host__ __device__ __forceinline__ void stage_rc(int b, int& R, int& C) { const int st = b / 1024, sb = b % 1024, swz = sb ^ (((sb >> 9) & 1) << 5); R = (st >> 1) * 16 + swz / 64; C = (st & 1) * 32 + (swz % 64) / 2; }
__host__ __device__ __forceinline__ int perm32(int rho) { const int n = rho >> 4, i = rho & 15; return 8 * (i >> 2) + 4 * n + (i & 3); }

struct Unit { int pm, pn; };

struct StaticOrder {
    int nM, nN, nwg, G, c;
    __host__ __device__ void init(int nM_, int nN_, int G_, int c_) { nM = nM_; nN = nN_; nwg = nM * nN; G = G_; c = c_; }
    __host__ __device__ bool next(int i, Unit& u) const {
        const long L = (long)i * G + c; if (L >= nwg) return false;
        int wgid = (int)L; { const int q = nwg / NXCD, r = nwg % NXCD, xcd = wgid % NXCD, off = wgid / NXCD; wgid = (xcd < r ? xcd * (q + 1) : r * (q + 1) + (xcd - r) * q) + off; }
        const int nig = WGM * nN, gid = wgid / nig, fm = gid * WGM, gsz = (nM - fm) < WGM ? (nM - fm) : WGM;
        u.pm = fm + ((wgid % nig) % gsz); u.pn = (wgid % nig) / gsz; return true;
    }
};

__device__ __forceinline__ unsigned cvt_pk_bf16(float lo, float hi) { unsigned r; asm volatile("v_cvt_pk_bf16_f32 %0, %1, %2" : "=v"(r) : "v"(lo), "v"(hi)); return r; }

template <class P, bool GATHER, bool ALIGN_EPI, bool SP2>
__device__ __forceinline__ void gemm_phase(PG8_LAS unsigned char* lds, const P& S, const PG8_LAS unsigned* rowtab, int wid) {
    const int lane = fresh_lane(), tid = wid * 64 + lane, wr = wid >> 2, wc = wid & 3, fr = lane & 15, fq = lane >> 4;
    constexpr bool F8 = P::FP8; constexpr int ESZ = F8 ? 1 : 2;
    constexpr int K = P::K, nt = F8 ? K / 128 : K / BK;
    int R0, C0; stage_rc(tid * 16, R0, C0);
    unsigned voffB[2];
#pragma unroll
    for (int i = 0; i < 2; ++i) { const int R = R0 + 64 * i; const int Rb = P::PERM ? ((R & ~31) + perm32(R & 31)) : R; voffB[i] = (unsigned)(Rb * K * ESZ + C0 * 2); }
    constexpr size_t kstep = (size_t)(BK * 2);
    constexpr size_t hstep = (size_t)HALF * K * ESZ;
    const unsigned ldsw = (unsigned)wid * 1024u;
    const int aoff = F8 ? lds_byte(wr * 64 + fr, fq * 16) : lds_byte(wr * 64 + fr, fq * 8), boff = F8 ? lds_byte(wc * 32 + fr, fq * 16) : lds_byte(wc * 32 + fr, fq * 8);
#define PG8_SA(b, h) (((b) * 2 + (h)) * HTB)
#define PG8_SB(b, h) ((4 + (b) * 2 + (h)) * HTB)
#define PG8_STAGE(bufoff, gbase, voff) do { _Pragma("unroll") for (int _i = 0; _i < 2; ++_i) \
        __builtin_amdgcn_global_load_lds((const unsigned*)((const char*)(gbase) + (voff)[_i]), (PG8_LAS unsigned*)(lds + (bufoff) + ldsw + _i * 8192), 16, 0, 0); } while (0)
#define PG8_LDA(dst, b, h) do { if constexpr (F8) { _Pragma("unroll") for (int m = 0; m < 4; ++m) { const PG8_LAS u32x4* p_ = (const PG8_LAS u32x4*)(lds + PG8_SA(b, h) + aoff + m * 2048); const u32x4 lo_ = p_[0], hi_ = p_[1]; \
            dst##8[m] = (v8i){(int)lo_.x, (int)lo_.y, (int)lo_.z, (int)lo_.w, (int)hi_.x, (int)hi_.y, (int)hi_.z, (int)hi_.w}; } } \
        else { _Pragma("unroll") for (int m = 0; m < 4; ++m) _Pragma("unroll") for (int k = 0; k < 2; ++k) dst[m][k] = *(const PG8_LAS bf16x8*)(lds + PG8_SA(b, h) + aoff + m * 2048 + k * 1024); } } while (0)
#define PG8_LDB(dst, b, h) do { if constexpr (F8) { _Pragma("unroll") for (int n = 0; n < 2; ++n) { const PG8_LAS u32x4* p_ = (const PG8_LAS u32x4*)(lds + PG8_SB(b, h) + boff + n * 2048); const u32x4 lo_ = p_[0], hi_ = p_[1]; \
            dst##8[n] = (v8i){(int)lo_.x, (int)lo_.y, (int)lo_.z, (int)lo_.w, (int)hi_.x, (int)hi_.y, (int)hi_.z, (int)hi_.w}; } } \
        else { _Pragma("unroll") for (int n = 0; n < 2; ++n) _Pragma("unroll") for (int k = 0; k < 2; ++k) dst[n][k] = *(const PG8_LAS bf16x8*)(lds + PG8_SB(b, h) + boff + n * 2048 + k * 1024); } } while (0)
#define PG8_MMA(ai, bj, At, Bt) do { __builtin_amdgcn_s_setprio(1); if constexpr (F8) { \
        asm volatile("s_nop 1\n\t" \
            "v_mfma_scale_f32_16x16x128_f8f6f4 %0, %8, %10, %0, %14, %15 op_sel_hi:[0,0,0]\n\t" \
            "v_mfma_scale_f32_16x16x128_f8f6f4 %1, %9, %10, %1, %14, %15 op_sel_hi:[0,0,0]\n\t" \
            "v_mfma_scale_f32_16x16x128_f8f6f4 %2, %8, %11, %2, %14, %15 op_sel_hi:[0,0,0]\n\t" \
            "v_mfma_scale_f32_16x16x128_f8f6f4 %3, %9, %11, %3, %14, %15 op_sel_hi:[0,0,0]\n\t" \
            "v_mfma_scale_f32_16x16x128_f8f6f4 %4, %8, %12, %4, %14, %15 op_sel_hi:[0,0,0]\n\t" \
            "v_mfma_scale_f32_16x16x128_f8f6f4 %5, %9, %12, %5, %14, %15 op_sel_hi:[0,0,0]\n\t" \
            "v_mfma_scale_f32_16x16x128_f8f6f4 %6, %8, %13, %6, %14, %15 op_sel_hi:[0,0,0]\n\t" \
            "v_mfma_scale_f32_16x16x128_f8f6f4 %7, %9, %13, %7, %14, %15 op_sel_hi:[0,0,0]" \
            : "+v"(acc[ai][bj][0][0]), "+v"(acc[ai][bj][0][1]), "+v"(acc[ai][bj][1][0]), "+v"(acc[ai][bj][1][1]), "+v"(acc[ai][bj][2][0]), "+v"(acc[ai][bj][2][1]), "+v"(acc[ai][bj][3][0]), "+v"(acc[ai][bj][3][1]) \
            : "v"(Bt##8[0]), "v"(Bt##8[1]), "v"(At##8[0]), "v"(At##8[1]), "v"(At##8[2]), "v"(At##8[3]), "v"(scw_), "v"(sca_)); } \
        else { _Pragma("unroll") for (int m = 0; m < 4; ++m) _Pragma("unroll") for (int n = 0; n < 2; ++n) _Pragma("unroll") for (int k = 0; k < 2; ++k) \
            acc[ai][bj][m][n] = __builtin_amdgcn_mfma_f32_16x16x32_bf16(Bt[n][k], At[m][k], acc[ai][bj][m][n], 0, 0, 0); } __builtin_amdgcn_s_setprio(0); } while (0)
#define PG8_WAIT_V(n) asm volatile("s_waitcnt vmcnt(" #n ")" ::: "memory")
#define PG8_WAIT_L(n) asm volatile("s_waitcnt lgkmcnt(" #n ")" ::: "memory")
#define PG8_BAR __builtin_amdgcn_s_barrier()
#define PG8_SCHED __builtin_amdgcn_sched_barrier(0)
#define PG8_AOFF(dst, u_, ui_) do { _Pragma("unroll") for (int _h = 0; _h < 2; ++_h) _Pragma("unroll") for (int _i = 0; _i < 2; ++_i) { \
        if constexpr (GATHER) dst[_h][_i] = (unsigned)(rowtab[(ui_) * 256 + _h * HALF + _i * 64 + R0] * (unsigned)(K * ESZ) + (unsigned)(C0 * 2)); \
        else dst[_h][_i] = (unsigned)((_h * HALF + _i * 64 + R0) * K * ESZ + C0 * 2); } } while (0)
    Unit cur, nxt; int ui = 0;
    if (!S.next(0, cur)) return;
    f32x4 acc[2][2][4][2];
#pragma unroll
    for (int a = 0; a < 2; ++a)
#pragma unroll
        for (int b = 0; b < 2; ++b)
#pragma unroll
            for (int m = 0; m < 4; ++m)
#pragma unroll
                for (int n = 0; n < 2; ++n) acc[a][b][m][n] = (f32x4){0.f, 0.f, 0.f, 0.f};
    bf16x8 At[4][2], B0[2][2], B1[2][2]; v8i At8[4], B08[2], B18[2]; const int scw_ = P::SCW, sca_ = P::SCA;
    unsigned vAc[2][2], vAn[2][2];
    PG8_AOFF(vAc, cur, 0);
    const char* cA = S.aptr(cur); const char* cB = S.bptr(cur);
    if constexpr (SP2) {
        PG8_STAGE(PG8_SB(0, 0), cB, voffB); PG8_STAGE(PG8_SB(0, 1), cB + hstep, voffB); PG8_STAGE(PG8_SA(0, 0), cA, vAc[0]); PG8_STAGE(PG8_SA(0, 1), cA, vAc[1]);
        if (wr == 1) PG8_BAR;
        PG8_WAIT_V(2); PG8_BAR;
        PG8_STAGE(PG8_SB(1, 0), cB + kstep, voffB); PG8_STAGE(PG8_SA(1, 0), cA + kstep, vAc[0]); PG8_STAGE(PG8_SB(1, 1), cB + hstep + kstep, voffB);
        PG8_WAIT_V(6); PG8_BAR;
    } else {
        PG8_STAGE(PG8_SB(0, 0), cB, voffB); PG8_STAGE(PG8_SA(0, 0), cA, vAc[0]); PG8_STAGE(PG8_SB(0, 1), cB + hstep, voffB); PG8_STAGE(PG8_SA(0, 1), cA, vAc[1]);
        if (wr == 1) PG8_BAR;
        PG8_WAIT_V(4); PG8_BAR;
        PG8_STAGE(PG8_SB(1, 0), cB + kstep, voffB); PG8_STAGE(PG8_SA(1, 0), cA + kstep, vAc[0]); PG8_STAGE(PG8_SB(1, 1), cB + hstep + kstep, voffB);
        PG8_WAIT_V(6); PG8_BAR;
    }
    for (;;) {
        const bool has_next = S.next(ui + 1, nxt);
        const char* nA = has_next ? S.aptr(nxt) : cA; const char* nB = has_next ? S.bptr(nxt) : cB;
        if (has_next) { PG8_AOFF(vAn, nxt, ui + 1); }
        else {
#pragma unroll
            for (int h = 0; h < 2; ++h)
#pragma unroll
                for (int i = 0; i < 2; ++i) vAn[h][i] = vAc[h][i];
        }
        for (int t = 0; t < nt; t += 2) {
            const bool last = (t == nt - 2);
            const char* a1 = cA + (size_t)(t + 1) * kstep;
            const char* a2 = last ? nA : cA + (size_t)(t + 2) * kstep; const char* b2 = last ? nB : cB + (size_t)(t + 2) * kstep;
            const char* a3 = a2 + kstep; const char* b3 = b2 + kstep;
            unsigned w2[2][2];
#pragma unroll
            for (int h = 0; h < 2; ++h)
#pragma unroll
                for (int i = 0; i < 2; ++i) w2[h][i] = last ? vAn[h][i] : vAc[h][i];
            if constexpr (SP2) {
            PG8_LDB(B0, 0, 0); PG8_LDB(B1, 0, 1); PG8_SCHED; PG8_LDA(At, 0, 0); PG8_STAGE(PG8_SA(1, 1), a1, vAc[1]);
            PG8_WAIT_V(8); PG8_WAIT_L(0); PG8_BAR; PG8_MMA(0, 0, At, B0); PG8_MMA(0, 1, At, B1); PG8_BAR; PG8_SCHED;
            PG8_LDA(At, 0, 1); PG8_STAGE(PG8_SB(0, 0), b2, voffB); PG8_STAGE(PG8_SB(0, 1), b2 + hstep, voffB); PG8_STAGE(PG8_SA(0, 0), a2, w2[0]);
            PG8_WAIT_V(8); PG8_WAIT_L(0); PG8_BAR; PG8_MMA(1, 0, At, B0); PG8_MMA(1, 1, At, B1); PG8_BAR; PG8_SCHED;
            PG8_LDB(B0, 1, 0); PG8_LDB(B1, 1, 1); PG8_SCHED; PG8_LDA(At, 1, 0); PG8_STAGE(PG8_SA(0, 1), a2, w2[1]);
            PG8_WAIT_V(8); PG8_WAIT_L(0); PG8_BAR; PG8_MMA(0, 0, At, B0); PG8_MMA(0, 1, At, B1); PG8_BAR; PG8_SCHED;
            PG8_LDA(At, 1, 1); PG8_STAGE(PG8_SB(1, 0), b3, voffB); PG8_STAGE(PG8_SB(1, 1), b3 + hstep, voffB); PG8_STAGE(PG8_SA(1, 0), a3, w2[0]);
            PG8_WAIT_V(8); PG8_WAIT_L(0); PG8_BAR; PG8_MMA(1, 0, At, B0); PG8_MMA(1, 1, At, B1); PG8_BAR; PG8_SCHED;
            } else {
            PG8_LDB(B0, 0, 0); PG8_SCHED; PG8_LDA(At, 0, 0); PG8_STAGE(PG8_SA(1, 1), a1, vAc[1]);
            PG8_WAIT_L(8); PG8_BAR; PG8_WAIT_L(0); PG8_MMA(0, 0, At, B0); PG8_BAR; PG8_SCHED;
            PG8_LDB(B1, 0, 1); PG8_STAGE(PG8_SB(0, 0), b2, voffB);
            PG8_BAR; PG8_WAIT_L(0); PG8_MMA(0, 1, At, B1); PG8_BAR;
            PG8_LDA(At, 0, 1); PG8_STAGE(PG8_SA(0, 0), a2, w2[0]);
            PG8_BAR; PG8_WAIT_L(0); PG8_MMA(1, 0, At, B0); PG8_BAR; PG8_SCHED;
            PG8_STAGE(PG8_SB(0, 1), b2 + hstep, voffB);
            PG8_WAIT_V(6); PG8_BAR; PG8_MMA(1, 1, At, B1); PG8_BAR;
            PG8_LDB(B0, 1, 0); PG8_SCHED; PG8_LDA(At, 1, 0); PG8_STAGE(PG8_SA(0, 1), a2, w2[1]);
            PG8_WAIT_L(8); PG8_BAR; PG8_WAIT_L(0); PG8_MMA(0, 0, At, B0); PG8_BAR; PG8_SCHED;
            PG8_LDB(B1, 1, 1); PG8_STAGE(PG8_SB(1, 0), b3, voffB);
            PG8_BAR; PG8_WAIT_L(0); PG8_MMA(0, 1, At, B1); PG8_BAR;
            PG8_LDA(At, 1, 1); PG8_STAGE(PG8_SA(1, 0), a3, w2[0]);
            PG8_BAR; PG8_WAIT_L(0); PG8_MMA(1, 0, At, B0); PG8_BAR; PG8_SCHED;
            PG8_STAGE(PG8_SB(1, 1), b3 + hstep, voffB);
            PG8_WAIT_V(6); PG8_BAR; PG8_MMA(1, 1, At, B1); PG8_BAR;
            }
        }
        if constexpr (ALIGN_EPI) { if (wr == 0) PG8_BAR; }
        if constexpr (F8) asm volatile("s_nop 15\n\ts_nop 7" ::: "memory");
        { int fr2 = fr, fq2 = fq; asm volatile("" : "+v"(fr2), "+v"(fq2));
          S.epi(acc, cur, wr, wc, fr2, fq2); }
        if (!has_next) break;
#pragma unroll
        for (int a = 0; a < 2; ++a)
#pragma unroll
            for (int b = 0; b < 2; ++b)
#pragma unroll
                for (int m = 0; m < 4; ++m)
#pragma unroll
                    for (int n = 0; n < 2; ++n) acc[a][b][m][n] = (f32x4){0.f, 0.f, 0.f, 0.f};
        cur = nxt; cA = nA; cB = nB; ++ui;
#pragma unroll
        for (int h = 0; h < 2; ++h)
#pragma unroll
            for (int i = 0; i < 2; ++i) vAc[h][i] = vAn[h][i];
        if constexpr (ALIGN_EPI) { if (wr == 1) PG8_BAR; }
    }
    PG8_WAIT_V(0);
    if constexpr (!ALIGN_EPI) { if (wr == 0) PG8_BAR; }
    PG8_BAR;
#undef PG8_SA
#undef PG8_SB
#undef PG8_STAGE
#undef PG8_LDA
#undef PG8_LDB
#undef PG8_MMA
#undef PG8_WAIT_V
#undef PG8_WAIT_L
#undef PG8_BAR
#undef PG8_SCHED
#undef PG8_AOFF
}
}

namespace attn_body {
using bf16 = __hip_bfloat16;
using bf16x8 = __attribute__((ext_vector_type(8))) short;
using s16x4 = __attribute__((ext_vector_type(4))) short;
using f32x16 = __attribute__((ext_vector_type(16))) float;
using u32x4 = __attribute__((ext_vector_type(4))) unsigned;
constexpr int D = 64, QPITCH = NHQ * D, KPITCH = NHKV * D, OPITCH = DM, OCOL0 = 256;
constexpr int NW = 8, QBLK = 32, QB = QBLK * NW, KVBLK = 64, NQB = NTOK / QB, NT = NKEYS / KVBLK;
static_assert(NT % 2 == 0 && NT >= 8, "tile count");
__device__ __forceinline__ int crow(int r, int hi) { return (r & 3) + 8 * (r >> 2) + 4 * hi; }
#define SBAR() __builtin_amdgcn_sched_barrier(0)
constexpr int NSLOT = 3, SLOTB = 8192;
constexpr int LDS_K = 0, LDS_V = NSLOT * SLOTB, LDS_WS = 2 * NSLOT * SLOTB, LDS_OST = LDS_WS + NW * 64 * 4, LDS_BYTES = LDS_OST + NW * 4096;
constexpr float C2 = 0.125f * 1.4426950408889634f;
__device__ __forceinline__ void glds16(const void* gsrc, unsigned lds_dst) { unsigned keep;
  asm volatile("s_mov_b32 %0, m0\n\ts_mov_b32 m0, %2\n\ts_nop 0\n\tglobal_load_lds_dwordx4 %1, off\n\ts_mov_b32 m0, %0" : "=&s"(keep) : "v"(gsrc), "s"(lds_dst) : "memory"); }
__device__ __forceinline__ float max3f(float a, float b, float c) { float r; asm("v_max3_f32 %0, %1, %2, %3" : "=v"(r) : "v"(a), "v"(b), "v"(c)); return r; }
__device__ __forceinline__ float max2f(float a, float b) { float r; asm("v_max_f32_e32 %0, %1, %2" : "=v"(r) : "v"(a), "v"(b)); return r; }
__device__ __forceinline__ float fadd_s(float a, float b) { float r; asm("v_add_f32_e32 %0, %1, %2" : "=v"(r) : "v"(a), "v"(b)); return r; }
__device__ __forceinline__ float fsub_s(float a, float b) { float r; asm("v_sub_f32_e32 %0, %1, %2" : "=v"(r) : "v"(a), "v"(b)); return r; }
typedef float f32x2_t __attribute__((ext_vector_type(2))); typedef __bf16 bf16x2_t __attribute__((ext_vector_type(2)));
__device__ __forceinline__ unsigned cvtpk_s(float lo, float hi) { f32x2_t v = {lo, hi}; bf16x2_t b = __builtin_convertvector(v, bf16x2_t); return __builtin_bit_cast(unsigned, b); }
#define WAIT_BAR(N) asm volatile("s_waitcnt vmcnt(" #N ") lgkmcnt(0)\n\ts_barrier" ::: "memory")

__device__ __forceinline__ void qkt(f32x16& p0, f32x16& p1, const char* Kslot, const bf16x8* qr, const f32x16& negm, int r32, int hi) {
  const char* kb = Kslot + hi * 1024 + r32 * 16;
  #pragma unroll
  for (int d0 = 0; d0 < 4; ++d0) {
    const bf16x8 b0 = *reinterpret_cast<const bf16x8*>(kb + d0 * 2048);
    const bf16x8 b1 = *reinterpret_cast<const bf16x8*>(kb + d0 * 2048 + 512);
    if (d0 == 0) { p0 = __builtin_amdgcn_mfma_f32_32x32x16_bf16(b0, qr[0], negm, 0, 0, 0); p1 = __builtin_amdgcn_mfma_f32_32x32x16_bf16(b1, qr[0], negm, 0, 0, 0); }
    else { p0 = __builtin_amdgcn_mfma_f32_32x32x16_bf16(b0, qr[d0], p0, 0, 0, 0); p1 = __builtin_amdgcn_mfma_f32_32x32x16_bf16(b1, qr[d0], p1, 0, 0, 0); } }
}
typedef __attribute__((address_space(3))) const char* lds_cptr;
typedef short v4i16_t __attribute__((ext_vector_type(4)));
__device__ __forceinline__ void kload8(bf16x8* kf, lds_cptr kp) {
  kf[0] = *(const __attribute__((address_space(3))) bf16x8*)(kp);        kf[1] = *(const __attribute__((address_space(3))) bf16x8*)(kp + 512);
  kf[2] = *(const __attribute__((address_space(3))) bf16x8*)(kp + 2048); kf[3] = *(const __attribute__((address_space(3))) bf16x8*)(kp + 2560);
  kf[4] = *(const __attribute__((address_space(3))) bf16x8*)(kp + 4096); kf[5] = *(const __attribute__((address_space(3))) bf16x8*)(kp + 4608);
  kf[6] = *(const __attribute__((address_space(3))) bf16x8*)(kp + 6144); kf[7] = *(const __attribute__((address_space(3))) bf16x8*)(kp + 6656);
}
__device__ __forceinline__ void kload2(bf16x8* kf, lds_cptr kp, int j) { kf[2 * j] = *(const __attribute__((address_space(3))) bf16x8*)(kp + j * 2048); kf[2 * j + 1] = *(const __attribute__((address_space(3))) bf16x8*)(kp + j * 2048 + 512); }
__device__ __forceinline__ s16x4 vtr(lds_cptr p) { return __builtin_bit_cast(s16x4, __builtin_amdgcn_ds_read_tr16_b64_v4i16((__attribute__((address_space(3))) v4i16_t*)p)); }
__device__ __forceinline__ float rowmax(const f32x16& p0, const f32x16& p1) {
  float a = max3f(p0[0], p0[1], p1[0]), b = max3f(p0[2], p0[3], p1[1]); a = max3f(a, p1[2], p1[3]);
  #pragma unroll
  for (int r = 4; r < 16; r += 4) { a = max3f(a, p0[r], p0[r + 1]); b = max3f(b, p0[r + 2], p0[r + 3]); a = max3f(a, p1[r], p1[r + 1]); b = max3f(b, p1[r + 2], p1[r + 3]); }
  const float m = max2f(a, b);
  auto rr = __builtin_amdgcn_permlane32_swap(__float_as_uint(m), __float_as_uint(m), false, false);
  return max2f(__uint_as_float(rr[0]), __uint_as_float(rr[1]));
}
__device__ __forceinline__ void pv(f32x16* o, int vb, bf16x8 pa0, bf16x8 pa1, bf16x8 pa2, bf16x8 pa3) {
  #pragma unroll
  for (int d0 = 0; d0 < 2; ++d0) { s16x4 lo[4], hi[4];
    #pragma unroll
    for (int ks = 0; ks < 4; ++ks) {
      asm volatile("ds_read_b64_tr_b16 %0,%1 offset:%c2" : "=&v"(lo[ks]) : "v"(vb), "i"(d0 * 4096 + ks * 1024) : "memory");
      asm volatile("ds_read_b64_tr_b16 %0,%1 offset:%c2" : "=&v"(hi[ks]) : "v"(vb), "i"(d0 * 4096 + ks * 1024 + 512) : "memory"); }
    asm volatile("s_waitcnt lgkmcnt(0)" ::: "memory"); SBAR();
    #define PK(k) (bf16x8){lo[k][0], lo[k][1], lo[k][2], lo[k][3], hi[k][0], hi[k][1], hi[k][2], hi[k][3]}
    o[d0] = __builtin_amdgcn_mfma_f32_32x32x16_bf16(pa0, PK(0), o[d0], 0, 0, 0);
    o[d0] = __builtin_amdgcn_mfma_f32_32x32x16_bf16(pa1, PK(1), o[d0], 0, 0, 0);
    o[d0] = __builtin_amdgcn_mfma_f32_32x32x16_bf16(pa2, PK(2), o[d0], 0, 0, 0);
    o[d0] = __builtin_amdgcn_mfma_f32_32x32x16_bf16(pa3, PK(3), o[d0], 0, 0, 0);
    #undef PK
  }
}
#define ATTN_STORE16(p, v) (*(u32x4*)(p) = (v))
template <int THRL> __device__ __forceinline__ void attn_unit(int h, int kvh, int qb, const bf16* Q, const bf16* __restrict__ K, const bf16* __restrict__ V, bf16* O, char* shm, int wid, float kmax2) {
  const int lane = fresh_lane(), r32 = lane & 31, hi = lane >> 5;
  const int q0 = qb * QB;
  const bf16* Qw = Q + (long)(q0 + wid * QBLK) * QPITCH + h * D;
  const bf16* Kh = K + kvh * D, *Vh = V + kvh * D;
  const unsigned lds0 = (unsigned)(uintptr_t)shm;
  float* wsf = (float*)(shm + LDS_WS) + wid * 64;
  const bf16* ksrc = Kh + (long)lane * KPITCH + wid * 8;
  const bf16* vsrc = Vh + (long)(16 * (wid & 3) + (lane >> 2)) * KPITCH + (wid >> 2) * 32 + (lane & 3) * 8;
  const unsigned kdst = lds0 + LDS_K + wid * 1024, vdst = lds0 + LDS_V + wid * 1024;
  #define DMA_K(t, slot) glds16(ksrc + (long)(t) * KVBLK * KPITCH, (unsigned)__builtin_amdgcn_readfirstlane(kdst + (slot)))
  #define DMA_V(t, slot) glds16(vsrc + (long)(t) * KVBLK * KPITCH, (unsigned)__builtin_amdgcn_readfirstlane(vdst + (slot)))
  const int vb0 = (int)(lds0 + LDS_V) + ((lane >> 4) & 1) * 32 + (lane & 3) * 8 + (4 * hi + ((lane & 15) >> 2)) * 64;
  const char* Kbase = shm + LDS_K; bf16x8 kf[8];
  const lds_cptr shm3 = (lds_cptr)shm; const lds_cptr kp0 = shm3 + LDS_K + hi * 1024 + r32 * 16; const lds_cptr vp0 = shm3 + LDS_V + ((lane >> 4) & 1) * 32 + (lane & 3) * 8 + (4 * hi + ((lane & 15) >> 2)) * 64;
  DMA_K(0, 0); DMA_V(0, 0); DMA_K(1, SLOTB);
  bf16x8 qr[4];
  #pragma unroll
  for (int d0 = 0; d0 < 4; ++d0) qr[d0] = *reinterpret_cast<const bf16x8*>(&Qw[(long)r32 * QPITCH + d0 * 16 + hi * 8]);
  float l_reg = 0.f; f32x16 o[2]; o[0] = f32x16{}; o[1] = f32x16{}; f32x16 negm;
  { float qn2 = 0.f;
    #pragma unroll
    for (int d0 = 0; d0 < 4; ++d0)
      #pragma unroll
      for (int j = 0; j < 8; ++j) { const float f = __uint_as_float((unsigned)(unsigned short)qr[d0][j] << 16); qn2 += f * f; }
    auto rr = __builtin_amdgcn_permlane32_swap(__float_as_uint(qn2), __float_as_uint(qn2), false, false); qn2 = __uint_as_float(rr[0]) + __uint_as_float(rr[1]);
    const float bnd = sqrtf(qn2 * kmax2) * 1.004f + 0.01f;
    #pragma unroll
    for (int r = 0; r < 16; ++r) negm[r] = -bnd;
    asm volatile("" : "+v"(negm)); }
  f32x16 pA0, pA1, pB0, pB1;
  int sl_prev = 0, sl_cur = 0, sl_next = SLOTB;
  #define ROT() do { sl_prev = sl_cur; sl_cur = sl_next; sl_next = (sl_next == (NSLOT - 1) * SLOTB) ? 0 : sl_next + SLOTB; } while (0)
  DMA_K(2, 2 * SLOTB);
  WAIT_BAR(3);
  qkt(pA0, pA1, Kbase, qr, negm, r32, hi); asm volatile("s_nop 15\n\ts_nop 7" : "+v"(pA0), "+v"(pA1));
  _Pragma("unroll") for (int r = 0; r < 16; ++r) { pA0[r] = __builtin_amdgcn_exp2f(pA0[r]); pA1[r] = __builtin_amdgcn_exp2f(pA1[r]); }
  WAIT_BAR(0);
  DMA_K(3, 0); DMA_V(1, SLOTB);
  ROT();
  kload8(kf, kp0 + sl_cur);
  WAIT_BAR(2);
  s16x4 vlo[8], vhi[8]; u32x4 pw0, pw1, pw2, pw3;
  #define PKW(P, B) cvtpk_s(P[B], P[B + 1])
  #define PAF(k) __builtin_bit_cast(bf16x8, pw##k)
  #define VFR(i) (bf16x8){vlo[i][0], vlo[i][1], vlo[i][2], vlo[i][3], vhi[i][0], vhi[i][1], vhi[i][2], vhi[i][3]}
  #define PIN(x) asm volatile("" : "+v"(x))
  #define MX3(a, b, c) __builtin_fmaxf(__builtin_fmaxf((a), (b)), (c))
  #define GAPA(MF, A0, A1, A2, A3, W0, W1, PW) do { MF; sacc += A0; sacc += A1; sacc += A2; sacc += A3; PIN(sacc); W0; W1; PIN(PW); SBAR(); } while (0)
  #define EX(v) __builtin_amdgcn_exp2f(v)
  #define GAPB(MF, X, B) do { MF; X[B] = EX(X[B]); X[B + 1] = EX(X[B + 1]); X[B + 2] = EX(X[B + 2]); X[B + 3] = EX(X[B + 3]); PIN(X); SBAR(); } while (0)
  #define VRD(i) do { vlo[i] = vtr(vp_ + (((i) >> 2) * 4096 + ((i) & 3) * 1024)); vhi[i] = vtr(vp_ + (((i) >> 2) * 4096 + ((i) & 3) * 1024 + 512)); } while (0)
  #define KRD(G, j) do { if (G) { kload2(kf, kp0 + sl_next, j); SBAR(); } } while (0)
  #define STEPM(C0, C1, P0, P1, t, GK, GV, GL) do { SBAR(); \
    const lds_cptr vp_ = vp0 + sl_prev; \
    VRD(0); SBAR(); float sacc = (P0[0] + P0[1]); \
    GAPA(C0 = __builtin_amdgcn_mfma_f32_32x32x16_bf16(kf[0], qr[0], negm, 0, 0, 0), P0[2], P0[3], P0[4], P0[5],     pw0[0] = PKW(P0, 0), pw0[1] = PKW(P0, 2), pw0); \
    VRD(4); SBAR(); GAPA(C1 = __builtin_amdgcn_mfma_f32_32x32x16_bf16(kf[1], qr[0], negm, 0, 0, 0), P0[6], P0[7], P0[8], P0[9],     pw0[2] = PKW(P0, 4), pw0[3] = PKW(P0, 6), pw0); \
    VRD(1); SBAR(); GAPA(C0 = __builtin_amdgcn_mfma_f32_32x32x16_bf16(kf[2], qr[1], C0, 0, 0, 0),   P0[10], P0[11], P0[12], P0[13], pw1[0] = PKW(P0, 8), pw1[1] = PKW(P0, 10), pw1); \
    VRD(5); SBAR(); GAPA(C1 = __builtin_amdgcn_mfma_f32_32x32x16_bf16(kf[3], qr[1], C1, 0, 0, 0),   P0[14], P0[15], P1[0], P1[1],   pw1[2] = PKW(P0, 12), pw1[3] = PKW(P0, 14), pw1); \
    VRD(2); SBAR(); GAPA(C0 = __builtin_amdgcn_mfma_f32_32x32x16_bf16(kf[4], qr[2], C0, 0, 0, 0),   P1[2], P1[3], P1[4], P1[5],     pw2[0] = PKW(P1, 0), pw2[1] = PKW(P1, 2), pw2); \
    VRD(6); SBAR(); GAPA(C1 = __builtin_amdgcn_mfma_f32_32x32x16_bf16(kf[5], qr[2], C1, 0, 0, 0),   P1[6], P1[7], P1[8], P1[9],     pw2[2] = PKW(P1, 4), pw2[3] = PKW(P1, 6), pw2); \
    VRD(3); SBAR(); GAPA(C0 = __builtin_amdgcn_mfma_f32_32x32x16_bf16(kf[6], qr[3], C0, 0, 0, 0),   P1[10], P1[11], P1[12], P1[13], pw3[0] = PKW(P1, 8), pw3[1] = PKW(P1, 10), pw3); \
    VRD(7); SBAR(); GAPA(C1 = __builtin_amdgcn_mfma_f32_32x32x16_bf16(kf[7], qr[3], C1, 0, 0, 0),   P1[14], P1[15], 0.f, 0.f,       pw3[2] = PKW(P1, 12), pw3[3] = PKW(P1, 14), pw3); \
    l_reg += sacc; \
    if (GK) { DMA_K((t) + 3, sl_cur); } if (GV) { DMA_V((t) + 1, sl_next); } \
    SBAR(); \
    GAPB(o[0] = __builtin_amdgcn_mfma_f32_32x32x16_bf16(PAF(0), VFR(0), o[0], 0, 0, 0), C0, 0); \
    GAPB(o[1] = __builtin_amdgcn_mfma_f32_32x32x16_bf16(PAF(0), VFR(4), o[1], 0, 0, 0), C0, 4); \
    KRD(GL, 0); GAPB(o[0] = __builtin_amdgcn_mfma_f32_32x32x16_bf16(PAF(1), VFR(1), o[0], 0, 0, 0), C0, 8); \
    KRD(GL, 1); GAPB(o[1] = __builtin_amdgcn_mfma_f32_32x32x16_bf16(PAF(1), VFR(5), o[1], 0, 0, 0), C0, 12); \
    KRD(GL, 2); GAPB(o[0] = __builtin_amdgcn_mfma_f32_32x32x16_bf16(PAF(2), VFR(2), o[0], 0, 0, 0), C1, 0); \
    KRD(GL, 3); GAPB(o[1] = __builtin_amdgcn_mfma_f32_32x32x16_bf16(PAF(2), VFR(6), o[1], 0, 0, 0), C1, 4); \
    GAPB(o[0] = __builtin_amdgcn_mfma_f32_32x32x16_bf16(PAF(3), VFR(3), o[0], 0, 0, 0), C1, 8); \
    GAPB(o[1] = __builtin_amdgcn_mfma_f32_32x32x16_bf16(PAF(3), VFR(7), o[1], 0, 0, 0), C1, 12); \
    } while (0)
  int t = 1;
  for (; t + 5 < NT; t += 2) {
    STEPM(pB0, pB1, pA0, pA1, t, true, true, true);     WAIT_BAR(2); ROT();
    STEPM(pA0, pA1, pB0, pB1, t + 1, true, true, true); WAIT_BAR(2); ROT();
  }
  #define ENDW(tt) do { if ((tt) + 3 < NT) { WAIT_BAR(2); } else if ((tt) + 2 < NT) { WAIT_BAR(1); } else { WAIT_BAR(0); } } while (0)
  for (; t + 1 < NT; t += 2) {
    STEPM(pB0, pB1, pA0, pA1, t, (t + 3 < NT), (t + 1 < NT), (t + 1 < NT));         ENDW(t);     ROT();
    STEPM(pA0, pA1, pB0, pB1, t + 1, (t + 4 < NT), (t + 2 < NT), (t + 2 < NT));     ENDW(t + 1); ROT();
  }
  STEPM(pB0, pB1, pA0, pA1, NT - 1, false, false, false);
  { float sacc = pB0[0] + pB0[1]; _Pragma("unroll") for (int r = 2; r < 16; ++r) sacc += pB0[r]; _Pragma("unroll") for (int r = 0; r < 16; ++r) sacc += pB1[r]; l_reg += sacc;
    pw0 = (u32x4){PKW(pB0, 0), PKW(pB0, 2), PKW(pB0, 4), PKW(pB0, 6)}; pw1 = (u32x4){PKW(pB0, 8), PKW(pB0, 10), PKW(pB0, 12), PKW(pB0, 14)}; pw2 = (u32x4){PKW(pB1, 0), PKW(pB1, 2), PKW(pB1, 4), PKW(pB1, 6)}; pw3 = (u32x4){PKW(pB1, 8), PKW(pB1, 10), PKW(pB1, 12), PKW(pB1, 14)};
    SBAR(); pv(o, vb0 + sl_cur, PAF(0), PAF(1), PAF(2), PAF(3)); }
  #undef PKW
  #undef PAF
  #undef VFR
  #undef PIN
  #undef MX3
  #undef GAPA
  #undef GAPB
  #undef EX
  #undef VRD
  #undef KRD
  #undef STEPM
  #undef ENDW
  { auto rr = __builtin_amdgcn_permlane32_swap(__float_as_uint(l_reg), __float_as_uint(l_reg), false, false); l_reg = __uint_as_float(rr[0]) + __uint_as_float(rr[1]); }
  if (hi == 0) wsf[32 + r32] = l_reg; asm volatile("s_waitcnt lgkmcnt(0)" ::: "memory");
  float rli[16];
  #pragma unroll
  for (int r = 0; r < 16; ++r) rli[r] = __builtin_amdgcn_rcpf(wsf[32 + crow(r, hi)]);
  bf16* Ow = O + (long)(q0 + wid * QBLK) * OPITCH + OCOL0 + h * D;
  { bf16* stg = (bf16*)(shm + LDS_OST) + wid * 2048;
    #pragma unroll
    for (int r = 0; r < 16; ++r) { const int orow = crow(r, hi);
      #pragma unroll
      for (int d0 = 0; d0 < 2; ++d0) stg[orow * 64 + d0 * 32 + r32] = __float2bfloat16(o[d0][r] * rli[r]); }
    asm volatile("s_waitcnt lgkmcnt(0)" ::: "memory");
    #pragma unroll
    for (int i = 0; i < 4; ++i) { const int row = i * 8 + (lane >> 3), ch = lane & 7; const u32x4 v = *(const u32x4*)(stg + row * 64 + ch * 8); ATTN_STORE16(Ow + (long)row * OPITCH + ch * 8, v); } }
  asm volatile("s_waitcnt lgkmcnt(0)\n\ts_barrier" ::: "memory");
  #undef DMA_K
  #undef DMA_V
  #undef ROT
}
#undef SBAR
#undef WAIT_BAR

typedef int v8i_t __attribute__((ext_vector_type(8)));
constexpr int F8_SLOT = 4096, F8_LDS_K = 0, F8_LDS_V = 3 * F8_SLOT, F8_LDS_WS = 6 * F8_SLOT, F8_LDS_OST = F8_LDS_WS + NW * 64 * 4, F8_LDS_BYTES = F8_LDS_OST + NW * 4096;
#define SBAR() __builtin_amdgcn_sched_barrier(0)
#define WAIT_BAR(N) asm volatile("s_waitcnt vmcnt(" #N ") lgkmcnt(0)\n\ts_barrier" ::: "memory")
#define MFMA8_C(D, A, B, C, SA, SB) asm volatile("s_nop 1\n\tv_mfma_scale_f32_32x32x64_f8f6f4 %0, %1, %2, %3, %4, %5 op_sel_hi:[0,0,0]" : "=&v"(D) : "v"(A), "v"(B), "v"(C), "v"(SA), "v"(SB))
#define MFMA8_ACC(D, A, B, SA, SB) asm volatile("s_nop 1\n\tv_mfma_scale_f32_32x32x64_f8f6f4 %0, %1, %2, %0, %3, %4 op_sel_hi:[0,0,0]" : "+v"(D) : "v"(A), "v"(B), "v"(SA), "v"(SB))
__device__ __forceinline__ v8i_t lds_frag32(lds_cptr p) { const u32x4 lo = *(const __attribute__((address_space(3))) u32x4*)p, hi = *(const __attribute__((address_space(3))) u32x4*)(p + 16);
  return (v8i_t){(int)lo.x, (int)lo.y, (int)lo.z, (int)lo.w, (int)hi.x, (int)hi.y, (int)hi.z, (int)hi.w}; }
__device__ __forceinline__ unsigned pk4f8(float a, float b, float c, float d) { int p = __builtin_amdgcn_cvt_pk_fp8_f32(a, b, 0, false); p = __builtin_amdgcn_cvt_pk_fp8_f32(c, d, p, true); return (unsigned)p; }
__device__ __forceinline__ void attn_unit_f8(int h, int kvh, int qb, const unsigned char* Q8, const unsigned char* __restrict__ K8, const unsigned char* __restrict__ VT8, bf16* O, char* shm, int wid, float kmax2) {
  const int lane = fresh_lane(), r32 = lane & 31, hi = lane >> 5; const bool kwave = wid < 4;
  const int q0 = qb * QB;
  const unsigned lds0 = (unsigned)(uintptr_t)shm;
  float* wsf = (float*)(shm + F8_LDS_WS) + wid * 64;
  const int krow = 16 * (wid & 3) + (lane >> 2), kch = (lane & 3) ^ (2 * ((krow >> 2) & 1));
  const unsigned char* dsrc = kwave ? K8 + (size_t)krow * KPITCH + kvh * D + 16 * kch : VT8 + (size_t)kvh * (NT * 4096) + 1024 * (wid & 3) + 16 * lane;
  const long dstep = kwave ? (long)KVBLK * KPITCH : 4096;
  const unsigned ddst = lds0 + (kwave ? F8_LDS_K : F8_LDS_V) + (wid & 3) * 1024;
  #define DMA_T(t, slot) glds16(dsrc + (long)(t) * dstep, (unsigned)__builtin_amdgcn_readfirstlane(ddst + (slot)))
  const lds_cptr shm3 = (lds_cptr)shm;
  const lds_cptr kp0 = shm3 + F8_LDS_K + r32 * 64 + 32 * (hi ^ ((r32 >> 2) & 1));
  const lds_cptr vp0 = shm3 + F8_LDS_V + r32 * 64 + 32 * (hi ^ ((r32 >> 2) & 1));
  v8i_t qf;
  { const unsigned char* qp = Q8 + (size_t)(q0 + wid * QBLK + r32) * QPITCH + h * D + 32 * hi; const u32x4 lo = *(const u32x4*)qp, hi4 = *(const u32x4*)(qp + 16);
    qf = (v8i_t){(int)lo.x, (int)lo.y, (int)lo.z, (int)lo.w, (int)hi4.x, (int)hi4.y, (int)hi4.z, (int)hi4.w}; }
  DMA_T(0, 0); if (kwave) { DMA_T(1, F8_SLOT); DMA_T(2, 2 * F8_SLOT); }
  float l_reg = 0.f; f32x16 o[2]; o[0] = f32x16{}; o[1] = f32x16{}; f32x16 negm;
  { float qn2 = 0.f;
    #pragma unroll
    for (int i = 0; i < 8; ++i) { const float f0 = __builtin_amdgcn_cvt_f32_fp8(qf[i], 0), f1 = __builtin_amdgcn_cvt_f32_fp8(qf[i], 1), f2 = __builtin_amdgcn_cvt_f32_fp8(qf[i], 2), f3 = __builtin_amdgcn_cvt_f32_fp8(qf[i], 3);
      qn2 += ((f0 * f0 + f1 * f1) + (f2 * f2 + f3 * f3)) * (1.f / 256.f); }
    auto rr = __builtin_amdgcn_permlane32_swap(__float_as_uint(qn2), __float_as_uint(qn2), false, false); qn2 = __uint_as_float(rr[0]) + __uint_as_float(rr[1]);
    const float bnd = sqrtf(qn2 * kmax2) * 1.004f + 0.01f;
    #pragma unroll
    for (int r = 0; r < 16; ++r) negm[r] = 8.f - bnd;
    asm volatile("" : "+v"(negm)); }
  int sQ = 0x7B7B7B7B, sONE = 0x7F7F7F7F; asm volatile("" : "+v"(sQ), "+v"(sONE));
  f32x16 pA0, pA1, pB0, pB1; v8i_t kf0, kf1, vf0, vf1, pw;
  int sl_prev = 0, sl_cur = 0, sl_next = F8_SLOT;
  #define ROT() do { sl_prev = sl_cur; sl_cur = sl_next; sl_next = (sl_next == 2 * F8_SLOT) ? 0 : sl_next + F8_SLOT; } while (0)
  #define PIN(x) asm volatile("" : "+v"(x))
  WAIT_BAR(0);
  kf0 = lds_frag32(kp0); kf1 = lds_frag32(kp0 + 2048);
  asm volatile("s_waitcnt lgkmcnt(0)" ::: "memory");
  MFMA8_C(pA0, kf0, qf, negm, sONE, sQ); MFMA8_C(pA1, kf1, qf, negm, sONE, sQ);
  asm volatile("s_nop 15\n\ts_nop 15\n\ts_nop 7" : "+v"(pA0), "+v"(pA1));
  #pragma unroll
  for (int r = 0; r < 16; ++r) { pA0[r] = __builtin_amdgcn_exp2f(pA0[r]); pA1[r] = __builtin_amdgcn_exp2f(pA1[r]); }
  WAIT_BAR(0);
  if (kwave) { DMA_T(3, 0); } else { DMA_T(1, F8_SLOT); }
  ROT();
  kf0 = lds_frag32(kp0 + sl_cur); kf1 = lds_frag32(kp0 + sl_cur + 2048);
  WAIT_BAR(1);
  #define STEP8(C0, C1, P0, P1, t, GK, GV, GL) do { SBAR(); \
    vf0 = lds_frag32(vp0 + sl_prev); vf1 = lds_frag32(vp0 + sl_prev + 2048); SBAR(); \
    MFMA8_C(C0, kf0, qf, negm, sONE, sQ); \
    { float sa = P0[0] + P0[1]; _Pragma("unroll") for (int r = 2; r < 16; ++r) sa += P0[r]; l_reg += sa; } \
    pw[0] = (int)pk4f8(P0[0], P0[1], P0[2], P0[3]); pw[1] = (int)pk4f8(P0[4], P0[5], P0[6], P0[7]); pw[2] = (int)pk4f8(P0[8], P0[9], P0[10], P0[11]); pw[3] = (int)pk4f8(P0[12], P0[13], P0[14], P0[15]); \
    PIN(l_reg); PIN(pw); SBAR(); \
    MFMA8_C(C1, kf1, qf, negm, sONE, sQ); \
    { float sb = P1[0] + P1[1]; _Pragma("unroll") for (int r = 2; r < 16; ++r) sb += P1[r]; l_reg += sb; } \
    pw[4] = (int)pk4f8(P1[0], P1[1], P1[2], P1[3]); pw[5] = (int)pk4f8(P1[4], P1[5], P1[6], P1[7]); pw[6] = (int)pk4f8(P1[8], P1[9], P1[10], P1[11]); pw[7] = (int)pk4f8(P1[12], P1[13], P1[14], P1[15]); \
    PIN(l_reg); PIN(pw); SBAR(); \
    if (kwave) { if (GK) { DMA_T((t) + 3, sl_cur); } } else { if (GV) { DMA_T((t) + 1, sl_next); } } \
    asm volatile("s_waitcnt lgkmcnt(0)" ::: "memory"); \
    MFMA8_ACC(o[0], pw, vf0, sONE, sONE); \
    asm volatile("" : "+v"(C0)); \
    _Pragma("unroll") for (int r = 0; r < 16; ++r) C0[r] = __builtin_amdgcn_exp2f(C0[r]); \
    PIN(C0); SBAR(); \
    MFMA8_ACC(o[1], pw, vf1, sONE, sONE); \
    asm volatile("" : "+v"(C1)); \
    if (GL) { kf0 = lds_frag32(kp0 + sl_next); kf1 = lds_frag32(kp0 + sl_next + 2048); } \
    _Pragma("unroll") for (int r = 0; r < 16; ++r) C1[r] = __builtin_amdgcn_exp2f(C1[r]); \
    PIN(C1); SBAR(); } while (0)
  int t = 1;
  #pragma unroll 1
  for (; t + 5 < NT; t += 2) {
    STEP8(pB0, pB1, pA0, pA1, t, true, true, true);     WAIT_BAR(1); ROT();
    STEP8(pA0, pA1, pB0, pB1, t + 1, true, true, true); WAIT_BAR(1); ROT();
  }
  for (; t + 1 < NT; t += 2) {
    STEP8(pB0, pB1, pA0, pA1, t, (t + 3 < NT), (t + 1 < NT), (t + 1 < NT));         WAIT_BAR(0); ROT();
    STEP8(pA0, pA1, pB0, pB1, t + 1, (t + 4 < NT), (t + 2 < NT), (t + 2 < NT));     WAIT_BAR(0); ROT();
  }
  STEP8(pB0, pB1, pA0, pA1, NT - 1, false, false, false);
  { float sa = pB0[0] + pB0[1], sb = pB1[0] + pB1[1];
    #pragma unroll
    for (int r = 2; r < 16; ++r) { sa += pB0[r]; sb += pB1[r]; }
    l_reg += sa + sb;
    pw[0] = (int)pk4f8(pB0[0], pB0[1], pB0[2], pB0[3]); pw[1] = (int)pk4f8(pB0[4], pB0[5], pB0[6], pB0[7]); pw[2] = (int)pk4f8(pB0[8], pB0[9], pB0[10], pB0[11]); pw[3] = (int)pk4f8(pB0[12], pB0[13], pB0[14], pB0[15]);
    pw[4] = (int)pk4f8(pB1[0], pB1[1], pB1[2], pB1[3]); pw[5] = (int)pk4f8(pB1[4], pB1[5], pB1[6], pB1[7]); pw[6] = (int)pk4f8(pB1[8], pB1[9], pB1[10], pB1[11]); pw[7] = (int)pk4f8(pB1[12], pB1[13], pB1[14], pB1[15]);
    vf0 = lds_frag32(vp0 + sl_cur); vf1 = lds_frag32(vp0 + sl_cur + 2048);
    asm volatile("s_waitcnt lgkmcnt(0)" ::: "memory");
    MFMA8_ACC(o[0], pw, vf0, sONE, sONE); MFMA8_ACC(o[1], pw, vf1, sONE, sONE);
    asm volatile("s_nop 15\n\ts_nop 15\n\ts_nop 7" : "+v"(o[0]), "+v"(o[1])); }
  #undef STEP8
  #undef PIN
  #undef ROT
  { auto rr = __builtin_amdgcn_permlane32_swap(__float_as_uint(l_reg), __float_as_uint(l_reg), false, false); l_reg = __uint_as_float(rr[0]) + __uint_as_float(rr[1]); }
  if (hi == 0) wsf[32 + r32] = l_reg; asm volatile("s_waitcnt lgkmcnt(0)" ::: "memory");
  float rli[16];
  #pragma unroll
  for (int r = 0; r < 16; ++r) rli[r] = __builtin_amdgcn_rcpf(wsf[32 + crow(r, hi)]);
  bf16* Ow = O + (long)(q0 + wid * QBLK) * OPITCH + OCOL0 + h * D;
  { bf16* stg = (bf16*)(shm + F8_LDS_OST) + wid * 2048;
    #pragma unroll
    for (int r = 0; r < 16; ++r) { const int orow = crow(r, hi);
      #pragma unroll
      for (int d0 = 0; d0 < 2; ++d0) stg[orow * 64 + d0 * 32 + r32] = __float2bfloat16(o[d0][r] * rli[r]); }
    asm volatile("s_waitcnt lgkmcnt(0)" ::: "memory");
    #pragma unroll
    for (int i = 0; i < 4; ++i) { const int row = i * 8 + (lane >> 3), ch = lane & 7; const u32x4 v = *(const u32x4*)(stg + row * 64 + ch * 8); ATTN_STORE16(Ow + (long)row * OPITCH + ch * 8, v); } }
  asm volatile("s_waitcnt vmcnt(0) lgkmcnt(0)\n\ts_barrier" ::: "memory");
  #undef DMA_T
}
#undef MFMA8_C
#undef MFMA8_ACC
#undef SBAR
#undef WAIT_BAR
}

constexpr int NWAVES = 8, NTHR = NWAVES * 64;
constexpr size_t MiB = 1u << 20;
constexpr size_t WS_CTL = 0, CTL_ZERO_BYTES = 64 * 1024;
constexpr size_t WS_MOD = 1 * MiB;
constexpr size_t WS_MISC = WS_MOD + 64 * 1024;
constexpr size_t WS_IDX = WS_MISC, WS_GATE = WS_IDX + 128 * 1024, WS_TOKSLOT = WS_GATE + 128 * 1024;
constexpr size_t WS_AFF = 3 * MiB;
constexpr size_t WS_WIN = 4 * MiB;
constexpr size_t WS_WOUT = 7 * MiB;
constexpr size_t WS_WGU = 9 * MiB;
constexpr size_t WS_WD = 137 * MiB;
constexpr size_t WS_X1 = 201 * MiB;
constexpr size_t WS_R1 = 265 * MiB;
constexpr size_t WS_XN = WS_R1;
constexpr size_t WS_Q = WS_XN + (size_t)NROWS * DM * 2;
constexpr size_t WS_K = WS_Q + (size_t)NTOK * 768 * 2;
constexpr size_t WS_V = WS_K + (size_t)NROWS * 256 * 2;
constexpr size_t WS_FT = WS_V + (size_t)NROWS * 256 * 2;
constexpr size_t WS_MIX = WS_FT + (size_t)256 * NTOK * 4;
constexpr size_t WS_HID = WS_R1;
constexpr size_t WS_R2 = 393 * MiB;
constexpr size_t WS_H2 = WS_R2;
constexpr size_t WS_YE = WS_R2;
constexpr size_t WS_END = 457 * MiB;
static_assert(WS_MIX + (size_t)NTOK * DM * 2 <= WS_R1 + 128 * MiB, "R1 map");
static_assert(WS_TOKSLOT + (size_t)NTOK * 16 * 4 <= WS_AFF, "misc map");
constexpr int CW_TMO = 0, CW_FLAG = 2, CW_KMAX = 64, CW_BAR = 1024;

constexpr int LDS_BYTES = 163840;
constexpr int RING_BYTES = 131072, XTRA_OFF = RING_BYTES;
constexpr int MISC_OFF = LDS_BYTES - 512;

#define GAS __attribute__((address_space(1)))
#define LAS __attribute__((address_space(3)))
typedef unsigned short bf16;
typedef unsigned v4u __attribute__((ext_vector_type(4)));
typedef unsigned v2u __attribute__((ext_vector_type(2)));
typedef float f32x4 __attribute__((ext_vector_type(4)));
typedef float f32x2 __attribute__((ext_vector_type(2)));
typedef GAS unsigned gu32;
#define RLX_AGENT __ATOMIC_RELAXED, __HIP_MEMORY_SCOPE_AGENT
#define LDS_WAIT() asm volatile("s_waitcnt lgkmcnt(0)" ::: "memory")
#define VM_WAIT() asm volatile("s_waitcnt vmcnt(0)" ::: "memory")
__device__ __forceinline__ unsigned f2bf(float f) { unsigned u = __builtin_bit_cast(unsigned, f); return (u + 0x7fffu + ((u >> 16) & 1u)) >> 16; }
__device__ __forceinline__ unsigned pk2(float lo, float hi) { return f2bf(lo) | (f2bf(hi) << 16); }
__device__ __forceinline__ unsigned pk4_fp8(float a, float b, float c, float d) { int p = __builtin_amdgcn_cvt_pk_fp8_f32(a, b, 0, false); p = __builtin_amdgcn_cvt_pk_fp8_f32(c, d, p, true); return (unsigned)p; }
__device__ __forceinline__ float bf2f(unsigned short b) { return __builtin_bit_cast(float, (unsigned)b << 16); }

#define XB_TMO      128
#define XB_XCNT(j)  (256  + 64 * (j))
#define XB_XSUB(j)  (1280 + 64 * (j))
#define XB_XGEN(j)  (2304 + 64 * (j))
#define XB_TOP      3328
#define XB_TOPGEN   3392
#define XCD_BAR_WORDS 3456
#define XB_SPIN_CAP (1u << 20)
static_assert((CW_BAR + XCD_BAR_WORDS) * 4 <= (int)CTL_ZERO_BYTES, "ctl");
__device__ __forceinline__ unsigned xb_ld(unsigned* p)              { return __hip_atomic_load(p, __ATOMIC_RELAXED, __HIP_MEMORY_SCOPE_AGENT); }
__device__ __forceinline__ unsigned xb_add(unsigned* p, unsigned v) { return __hip_atomic_fetch_add(p, v, __ATOMIC_RELAXED, __HIP_MEMORY_SCOPE_AGENT); }
__device__ __forceinline__ unsigned xb_xcc_id() { return (unsigned)__builtin_amdgcn_s_getreg((3 << 11) | 20) & 0xFu; }
#define XB_SPIN(cond, bar) do { unsigned _sp = 0; while (cond) { __builtin_amdgcn_s_sleep(1); \
    if ((++_sp & 255u) == 0u) { if (xb_ld(&(bar)[XB_TMO])) break; if (_sp > XB_SPIN_CAP) { atomicAdd(&(bar)[XB_TMO], 1u); break; } } } } while (0)
struct XcdBarrier { unsigned* bar; unsigned x; volatile LAS unsigned* st; };
__device__ __forceinline__ XcdBarrier xcd_barrier_post(unsigned* bar, volatile LAS unsigned* st, bool leader) {
    XcdBarrier b; b.bar = bar; b.x = xb_xcc_id(); b.st = st;
    if (leader) (void)xb_add(&bar[XB_XCNT(b.x)], 1u);
    return b;
}
__device__ __forceinline__ void xcd_barrier_complete(unsigned* bar, unsigned x, unsigned& nloc, unsigned& nx) {
    const unsigned G = gridDim.x * gridDim.y * gridDim.z;
    unsigned sum, cnt, mine, sp = 0u;
    for (;;) {
        sum = 0u; cnt = 0u; mine = 0u;
#pragma unroll
        for (unsigned j = 0; j < 16; ++j) { const unsigned c = xb_ld(&bar[XB_XCNT(j)]); sum += c; cnt += (c > 0u) ? 1u : 0u; mine = (j == x) ? c : mine; }
        if (sum == G) break;
        __builtin_amdgcn_s_sleep(1);
        if ((++sp & 255u) == 0u) { if (xb_ld(&bar[XB_TMO])) break; if (sp > XB_SPIN_CAP) { atomicAdd(&bar[XB_TMO], 1u); break; } }
    }
    nloc = mine > 0u ? mine : 1u; nx = cnt > 0u ? cnt : 1u;
}
__device__ __forceinline__ void xcd_barrier(const XcdBarrier& b, int wave) {
    asm volatile("s_waitcnt vmcnt(0)" ::: "memory");
    __syncthreads();
    if (wave == 0 && fresh_lane() == 0) {
        unsigned* bar = b.bar;
        __builtin_amdgcn_s_waitcnt(0);
        unsigned nloc = b.st[0], nx = b.st[1];
        if (nloc == 0u) { xcd_barrier_complete(bar, b.x, nloc, nx); b.st[0] = nloc; b.st[1] = nx; }
        const unsigned old = xb_add(&bar[XB_XSUB(b.x)], 1u);
        const unsigned gen = old / nloc;
        if (old + 1u == (gen + 1u) * nloc) {
            __builtin_amdgcn_fence(__ATOMIC_RELEASE, "agent");
            asm volatile("s_waitcnt vmcnt(0)" ::: "memory");
            const unsigned og = xb_add(&bar[XB_TOP], 1u);
            const unsigned tg = og / nx;
            if (og + 1u == (tg + 1u) * nx) xb_add(&bar[XB_TOPGEN], 1u);
            else XB_SPIN(xb_ld(&bar[XB_TOPGEN]) == tg, bar);
            __builtin_amdgcn_fence(__ATOMIC_ACQUIRE, "agent");
            xb_add(&bar[XB_XGEN(b.x)], 1u);
            asm volatile("s_waitcnt vmcnt(0)" ::: "memory");
        } else {
            XB_SPIN(xb_ld(&bar[XB_XGEN(b.x)]) == gen, bar);
            __builtin_amdgcn_fence(__ATOMIC_ACQUIRE, "agent");
            asm volatile("s_waitcnt vmcnt(0)" ::: "memory");
        }
    }
    __syncthreads();
}

struct Args {
    const float *x, *c, *ctx, *c_ctx, *w_mod, *b_mod, *norm_mix_g, *norm_ffn_g, *w_in, *w_four, *q_norm_g, *k_norm_g, *w_out, *w_router, *w_gate, *w_up, *w_down, *final_norm_g;
    float* out; unsigned char* ws;
};

__device__ __forceinline__ float wave_sum(float v) {
#pragma unroll
    for (int o = 1; o < 64; o <<= 1) v += __shfl_xor(v, o);
    return v;
}

template <class RowMap>
__device__ __forceinline__ void tr_item(const float* __restrict__ W, int ldw, int k0, int n0, bf16* WT, int ldt, int kdst0, const RowMap& drow, LAS float* scr, int lane) {
    const int kq = lane >> 4, nq = lane & 15;
    f32x4 v[16];
#pragma unroll
    for (int it = 0; it < 16; ++it) v[it] = *(const f32x4*)(W + (size_t)(k0 + 4 * it + kq) * ldw + n0 + 4 * nq);
#pragma unroll
    for (int it = 0; it < 16; ++it) { LAS float* s = scr + (4 * it + kq) * 65 + 4 * nq; s[0] = v[it][0]; s[1] = v[it][1]; s[2] = v[it][2]; s[3] = v[it][3]; }
    LDS_WAIT(); asm volatile("" ::: "memory");
    const int c = lane >> 3, nn = lane & 7;
#pragma unroll
    for (int j = 0; j < 8; ++j) { const int n = nn + 8 * j; const LAS float* s = scr + (8 * c) * 65 + n;
        v4u o; o.x = pk2(s[0 * 65], s[1 * 65]); o.y = pk2(s[2 * 65], s[3 * 65]); o.z = pk2(s[4 * 65], s[5 * 65]); o.w = pk2(s[6 * 65], s[7 * 65]);
        *(GAS v4u*)(WT + (size_t)drow(n0 + n) * ldt + kdst0 + k0 + 8 * c) = o; }
    LDS_WAIT(); asm volatile("" ::: "memory");
}
struct RowId { int base; __device__ __forceinline__ int operator()(int n) const { return base + n; } };
struct RowQKV { __device__ __forceinline__ int operator()(int n) const { const int t = n >> 8, w = n & 255, hd = w >> 6, d = w & 63; return 256 + 256 * t + 128 * (d >> 5) + 32 * hd + (d & 31); } };
struct RowGU { int base, up; __device__ __forceinline__ int operator()(int f) const { return base + 256 * (f >> 7) + 128 * up + (f & 127); } };


constexpr int MOE_ITEMS = 3 * 8192;
struct TrDesc { const float* src; bf16* dst; int ldw, ldt, f8; };
__device__ __forceinline__ TrDesc moe_desc(const Args& a, int r) {
    TrDesc d;
    if (r < 16384) { const int up = r >> 13, rr = r & 8191, e = rr >> 9, q = rr & 511, kb = q >> 5, nb = q & 31;
        d.src = (up ? a.w_up : a.w_gate) + (size_t)e * DM * DE + (size_t)(kb * 64) * DE + nb * 64; d.ldw = DE;
        d.dst = (bf16*)((unsigned char*)(a.ws + WS_WGU) + ((size_t)e * 4096 + 256 * (nb >> 1) + 128 * up + 64 * (nb & 1)) * DM + kb * 64); d.ldt = DM; d.f8 = 1; }
    else { const int rr = r - 16384, e = rr >> 9, q = rr & 511, kb = q >> 4, nb = q & 15;
        d.src = a.w_down + (size_t)e * DE * DM + (size_t)(kb * 64) * DM + nb * 64; d.ldw = DM;
        d.dst = (bf16*)((unsigned char*)(a.ws + WS_WD) + ((size_t)e * DM + nb * 64) * DE + kb * 64); d.ldt = DE; d.f8 = 1; }
    return d;
}
#define TR_LOAD(v, d) do { _Pragma("unroll") for (int _it = 0; _it < 16; ++_it) v[_it] = *(const f32x4*)((d).src + (size_t)(4 * _it + kq) * (d).ldw + 4 * nq); } while (0)
#define TR_PROC(v, d) do { \
    _Pragma("unroll") for (int _it = 0; _it < 16; ++_it) { LAS float* s_ = scr + (4 * _it + kq) * 65 + 4 * nq; s_[0] = v[_it][0]; s_[1] = v[_it][1]; s_[2] = v[_it][2]; s_[3] = v[_it][3]; } \
    LDS_WAIT(); asm volatile("" ::: "memory"); \
    if ((d).f8) { _Pragma("unroll") for (int _j = 0; _j < 8; ++_j) { const int n_ = nn + 8 * _j; const LAS float* s_ = scr + (8 * c8) * 65 + n_; \
        v2u o_; o_.x = pk4_fp8(s_[0 * 65] * 32.f, s_[1 * 65] * 32.f, s_[2 * 65] * 32.f, s_[3 * 65] * 32.f); o_.y = pk4_fp8(s_[4 * 65] * 32.f, s_[5 * 65] * 32.f, s_[6 * 65] * 32.f, s_[7 * 65] * 32.f); \
        *(GAS v2u*)((unsigned char*)(d).dst + (size_t)n_ * (d).ldt + 8 * c8) = o_; } } \
    else { _Pragma("unroll") for (int _j = 0; _j < 8; ++_j) { const int n_ = nn + 8 * _j; const LAS float* s_ = scr + (8 * c8) * 65 + n_; \
        v4u o_; o_.x = pk2(s_[0 * 65], s_[1 * 65]); o_.y = pk2(s_[2 * 65], s_[3 * 65]); o_.z = pk2(s_[4 * 65], s_[5 * 65]); o_.w = pk2(s_[6 * 65], s_[7 * 65]); \
        *(GAS v4u*)((d).dst + (size_t)n_ * (d).ldt + 8 * c8) = o_; } } \
    LDS_WAIT(); asm volatile("" ::: "memory"); } while (0)
__device__ __forceinline__ void moe_convert(const Args& a, LAS float* scr, int lo, int hi, int w, int nw) {
    const int lane = fresh_lane(), kq = lane >> 4, nq = lane & 15, c8 = lane >> 3, nn = lane & 7;
    int it = lo + w; if (it >= hi) return;
    f32x4 va[16], vb[16];
    TrDesc da = moe_desc(a, it), db = da; TR_LOAD(va, da);
    for (;;) {
        int nx = it + nw; bool hn = nx < hi;
        if (hn) { db = moe_desc(a, nx); TR_LOAD(vb, db); }
        TR_PROC(va, da);
        if (!hn) break;
        it = nx; nx = it + nw; hn = nx < hi;
        if (hn) { da = moe_desc(a, nx); TR_LOAD(va, da); }
        TR_PROC(vb, db);
        if (!hn) break;
        it = nx;
    }
}
#ifndef MOE_S0
#define MOE_S0 4096
#endif
#ifndef MOE_S1
#define MOE_S1 2560
#endif
#ifndef MOE_S2
#define MOE_S2 0
#endif
constexpr int MOE_B0 = MOE_S0, MOE_B1 = MOE_B0 + MOE_S1, MOE_B2 = MOE_B1 + MOE_S2;

__host__ __device__ __forceinline__ int four_pos(int mp) { return mp == 0 ? 0 : (mp == 32 ? 1 : (mp < 32 ? 2 * mp : 2 * (64 - mp) + 1)); }

__device__ __forceinline__ void p0_prologue(const Args& a, LAS unsigned char* lds, int vcu, int G, int wave) {
    const int lane = fresh_lane(), tid = wave * 64 + lane;
    unsigned char* ws = a.ws;
    bf16* WinT = (bf16*)(ws + WS_WIN); bf16* WoT = (bf16*)(ws + WS_WOUT);
    float* MOD = (float*)(ws + WS_MOD);
    const int cg = vcu - (G - 24);
    if (cg >= 0) {
        LAS float* sv = (LAS float*)lds;
        LAS float* red = sv + 2048;
        for (int i = tid; i < 1024; i += NTHR) { const float c0 = a.c[i], c1 = a.c_ctx[i]; sv[i] = c0 / (1.f + __expf(-c0)); sv[1024 + i] = c1 / (1.f + __expf(-c1)); }
        __syncthreads();
        const int col = cg * 256 + 4 * lane;
        f32x4 a0 = {0.f, 0.f, 0.f, 0.f}, a1 = {0.f, 0.f, 0.f, 0.f};
        const int kb = wave * 128;
#pragma unroll 16
        for (int k = 0; k < 128; ++k) { const f32x4 w = *(const f32x4*)(a.w_mod + (size_t)(kb + k) * (NMOD * DM) + col); const float s0 = sv[kb + k], s1 = sv[1024 + kb + k]; a0 += w * s0; a1 += w * s1; }
        *(LAS f32x4*)(red + (wave * 2 + 0) * 256 + 4 * lane) = a0; *(LAS f32x4*)(red + (wave * 2 + 1) * 256 + 4 * lane) = a1;
        __syncthreads();
        { const int v = tid >> 8, cc = tid & 255; float s = 0.f;
#pragma unroll
          for (int w = 0; w < 8; ++w) s += red[(w * 2 + v) * 256 + cc];
          MOD[v * (NMOD * DM) + cg * 256 + cc] = s + a.b_mod[cg * 256 + cc]; }
        __syncthreads();
    }
    LAS float* scr = (LAS float*)(lds + wave * 16640);
    constexpr int I_F1 = 256, I_F2 = 256, I_IN = 16 * 20, I_OUT = 12 * 16;
    constexpr int NITEMS = I_F1 + I_F2 + I_IN + I_OUT;
    for (int it = wave * G + vcu; it < NITEMS; it += NWAVES * G) {
        int r = it;
        if (r < I_F1) {
            const int g = r & 3, kb = (r >> 2) & 15, jq = r >> 6, k = kb * 64 + lane;
            LAS float* ct = scr;
            ct[lane] = cospif((float)lane * (1.f / 32.f)); LDS_WAIT(); asm volatile("" ::: "memory");
            float w[64];
#pragma unroll
            for (int c4 = 0; c4 < 16; ++c4) { const f32x4 t = *(const f32x4*)(a.w_in + (size_t)k * INW + 64 * g + 4 * c4); w[4 * c4] = t[0]; w[4 * c4 + 1] = t[1]; w[4 * c4 + 2] = t[2]; w[4 * c4 + 3] = t[3]; }
            for (int j = 16 * jq; j < 16 * jq + 16; ++j) { const int m = j <= 32 ? j : j - 32; const int ph = j <= 32 ? 0 : 48;
                float s = 0.f;
#pragma unroll
                for (int c = 0; c < 64; ++c) s += w[c] * ct[(c * m + ph) & 63];
                WinT[(size_t)(64 * g + j) * DM + k] = (bf16)f2bf(s * (1.f / 1024.f)); }
            LDS_WAIT(); asm volatile("" ::: "memory");
            continue; }
        r -= I_F1;
        if (r < I_F2) {
            const int g = r & 3, jb = (r >> 2) & 15, mq = r >> 6, j = jb * 64 + lane;
            float w[64];
#pragma unroll
            for (int d = 0; d < 64; ++d) w[d] = a.w_out[(size_t)(64 * g + d) * DM + j];
            for (int mp = 16 * mq; mp < 16 * mq + 16; ++mp) { float s = 0.f; const float* wf = a.w_four + (size_t)(g * 64 + mp) * 64;
#pragma unroll
                for (int d = 0; d < 64; ++d) s += wf[d] * w[d];
                WoT[(size_t)j * DM + 64 * g + four_pos(mp)] = (bf16)f2bf(s); }
            continue; }
        r -= I_F2;
        if (r < I_IN) { const int kb = r / 20, nb = r % 20; tr_item(a.w_in + 256, INW, kb * 64, nb * 64, WinT, DM, 0, RowQKV{}, scr, lane); continue; }
        r -= I_IN;
        { const int kb = r / 16, nb = r % 16; tr_item(a.w_out + (size_t)256 * DM, DM, kb * 64, nb * 64, WoT, DM, 256, RowId{0}, scr, lane); }
    }
    if (cg < 0) moe_convert(a, scr, 0, MOE_B0, ((wave + 4) & 7) * (G - 24) + vcu, NWAVES * (G - 24));
}

__device__ __forceinline__ void p0b_modulate(const Args& a, int vcu, int G, int wave) {
    const int lane = fresh_lane();
    unsigned char* ws = a.ws; const float* MOD = (const float*)(ws + WS_MOD); bf16* XN = (bf16*)(ws + WS_XN);
    const int gw = vcu * NWAVES + wave, NGW = G * NWAVES;
    for (int pass = 0; pass < 2; ++pass) {
        const float* md = MOD + pass * (NMOD * DM);
        const int nrows = pass == 0 ? NTOK : NCTX; const float* src = pass == 0 ? a.x : a.ctx; bf16* dst = XN + (size_t)(pass == 0 ? 0 : NTOK) * DM;
        if (gw >= nrows) continue;
        f32x4 av[4], sh[4];
#pragma unroll
        for (int j = 0; j < 4; ++j) { const int col = 4 * lane + 256 * j; const f32x4 g = *(const f32x4*)(a.norm_mix_g + col); const f32x4 sc = *(const f32x4*)(md + DM + col); av[j] = g * (sc + 1.f); sh[j] = *(const f32x4*)(md + col); }
        f32x4 v[4], vn[4];
        { const GAS f32x4* xr = (const GAS f32x4*)(src + (size_t)gw * DM) + lane;
#pragma unroll
          for (int j = 0; j < 4; ++j) v[j] = xr[64 * j]; }
        for (int m = gw; m < nrows; m += NGW) {
            const int mn = m + NGW;
            if (mn < nrows) { const GAS f32x4* xr = (const GAS f32x4*)(src + (size_t)mn * DM) + lane;
#pragma unroll
                for (int j = 0; j < 4; ++j) vn[j] = xr[64 * j]; }
            float s = 0.f;
#pragma unroll
            for (int j = 0; j < 4; ++j) s += (v[j].x * v[j].x + v[j].y * v[j].y) + (v[j].z * v[j].z + v[j].w * v[j].w);
            const float rinv = 1.f / sqrtf(wave_sum(s) * (1.f / DM) + EPS);
            GAS unsigned long long* o8 = (GAS unsigned long long*)(dst + (size_t)m * DM) + lane;
#pragma unroll
            for (int j = 0; j < 4; ++j) { const f32x4 y = v[j] * rinv * av[j] + sh[j]; o8[64 * j] = (unsigned long long)pk2(y.x, y.y) | ((unsigned long long)pk2(y.z, y.w) << 32); }
#pragma unroll
            for (int j = 0; j < 4; ++j) v[j] = vn[j];
        }
    }
}

struct P1Prob {
    static constexpr int K = DM; static constexpr bool PERM = false, FP8 = false; static constexpr int SCW = 0, SCA = 0;
    const bf16* XN; const bf16* WinT; bf16 *Q, *Kb, *Vb; float* FT; const float *qg, *kg; unsigned* kmax; pg8::StaticOrder so;
    __device__ __forceinline__ bool next(int i, pg8::Unit& u) const { return so.next(i, u); }
    __device__ __forceinline__ const char* aptr(const pg8::Unit& u) const { return u.pn == 0 ? (const char*)WinT : (const char*)(XN + (size_t)u.pm * 256 * DM); }
    __device__ __forceinline__ const char* bptr(const pg8::Unit& u) const { return u.pn == 0 ? (const char*)(XN + (size_t)u.pm * 256 * DM) : (const char*)(WinT + (size_t)u.pn * 256 * DM); }
    __device__ __forceinline__ void epi(const pg8::f32x4 (&acc)[2][2][4][2], const pg8::Unit& u, int wr, int wc, int fr, int fq) const {
        if (u.pn == 0) {
            if (u.pm >= NTOK / 256) return;
#pragma unroll
            for (int ai = 0; ai < 2; ++ai)
#pragma unroll
                for (int m = 0; m < 4; ++m) { float* rowp = FT + (size_t)(ai * 128 + wr * 64 + m * 16 + fr) * NTOK + u.pm * 256 + wc * 32 + 4 * fq;
#pragma unroll
                    for (int bj = 0; bj < 2; ++bj)
#pragma unroll
                        for (int n = 0; n < 2; ++n) *(pg8::f32x4*)(rowp + bj * 128 + n * 16) = acc[ai][bj][m][n]; }
            return;
        }
        const bool isq = u.pn <= 3, isv = u.pn == 5, lat = u.pm < NTOK / 256;
        if (isq && !lat) return;
        if (isv) {
#if ATTN_F8
            unsigned char* V8 = (unsigned char*)Vb;
#pragma unroll
            for (int ai = 0; ai < 2; ++ai)
#pragma unroll
                for (int m = 0; m < 4; ++m) { const int t = u.pm * 256 + ai * 128 + wr * 64 + m * 16 + fr; const int key = t & 63, tile = t >> 6, k5 = key & 31;
                    const int hk = (k5 >> 2) & 1, j = (k5 & 3) + 4 * (k5 >> 3) + 16 * (key >> 5);
                    unsigned char* tb = V8 + ((size_t)(wc * (NKEYS / 64) + tile) * 64) * 64 + 32 * (hk ^ (fq & 1)) + j;
#pragma unroll
                    for (int bj = 0; bj < 2; ++bj)
#pragma unroll
                        for (int n = 0; n < 2; ++n) { const pg8::f32x4 v = acc[ai][bj][m][n]; const unsigned w = pk4_fp8(v[0], v[1], v[2], v[3]); const int d0 = 32 * bj + 16 * n + 4 * fq;
#pragma unroll
                            for (int e = 0; e < 4; ++e) tb[(size_t)(d0 + e) * 64] = (unsigned char)(w >> (8 * e)); } }
#else
#pragma unroll
            for (int ai = 0; ai < 2; ++ai)
#pragma unroll
                for (int m = 0; m < 4; ++m) { const int t = u.pm * 256 + ai * 128 + wr * 64 + m * 16 + fr; bf16* rowp = Vb + (size_t)t * 256 + wc * 64 + 4 * fq;
#pragma unroll
                    for (int bj = 0; bj < 2; ++bj)
#pragma unroll
                        for (int n = 0; n < 2; ++n) { const pg8::f32x4 v = acc[ai][bj][m][n]; *(v2u*)(rowp + 32 * bj + 16 * n) = (v2u){pk2(v[0], v[1]), pk2(v[2], v[3])}; } }
#endif
            return;
        }
        const float* gw = isq ? qg : kg;
        pg8::f32x4 gv[2][2];
#pragma unroll
        for (int bj = 0; bj < 2; ++bj)
#pragma unroll
            for (int n = 0; n < 2; ++n) gv[bj][n] = *(const pg8::f32x4*)(gw + 32 * bj + 16 * n + 4 * fq);
        float frq[4];
#pragma unroll
        for (int e = 0; e < 4; ++e) frq[e] = exp2f(-(float)(4 * fq + e) * (13.287712379549449f / 16.f)) * 0.15915494309189535f;
        const float qs = isq ? attn_body::C2 * (ATTN_F8 ? 16.f : 1.f) : 1.f;
#if ATTN_F8
        bf16* base = (bf16*)((unsigned char*)(isq ? Q : Kb) + (size_t)(isq ? (u.pn - 1) * 4 + wc : wc) * 64); const int pitch = isq ? 768 : 256;
#else
        bf16* base = isq ? Q + (size_t)((u.pn - 1) * 4 + wc) * 64 : Kb + (size_t)wc * 64; const int pitch = isq ? 768 : 256;
#endif
        float k2max = 0.f;
#pragma unroll
        for (int ai = 0; ai < 2; ++ai) {
            float rowpos = (float)(u.pm * 4 + ai * 2 + wr); asm volatile("" : "+v"(rowpos));
            float cr[4], sr[4];
#pragma unroll
            for (int e = 0; e < 4; ++e) { const float rev = rowpos * frq[e], f_ = rev - floorf(rev); cr[e] = __builtin_amdgcn_cosf(f_); sr[e] = __builtin_amdgcn_sinf(f_); }
#pragma unroll
            for (int m = 0; m < 4; ++m) {
                float colpos = (float)(m * 16 + fr); asm volatile("" : "+v"(colpos));
                const int t = u.pm * 256 + ai * 128 + wr * 64 + m * 16 + fr;
                float ss = 0.f;
#pragma unroll
                for (int bj = 0; bj < 2; ++bj)
#pragma unroll
                    for (int n = 0; n < 2; ++n) { const pg8::f32x4 v = acc[ai][bj][m][n]; ss += (v[0] * v[0] + v[1] * v[1]) + (v[2] * v[2] + v[3] * v[3]); }
                ss += __shfl_xor(ss, 16); ss += __shfl_xor(ss, 32);
                const float rinv = qs / sqrtf(ss * (1.f / 64.f) + EPS);
                pg8::f32x4 y[2][2];
#pragma unroll
                for (int bj = 0; bj < 2; ++bj)
#pragma unroll
                    for (int n = 0; n < 2; ++n) y[bj][n] = acc[ai][bj][m][n] * rinv * gv[bj][n];
                if (lat) {
#pragma unroll
                    for (int e = 0; e < 4; ++e) {
                        { const float x1 = y[0][0][e], x2 = y[0][1][e]; y[0][0][e] = x1 * cr[e] - x2 * sr[e]; y[0][1][e] = x1 * sr[e] + x2 * cr[e]; }
                        { const float rev = colpos * frq[e], f_ = rev - floorf(rev); const float cc = __builtin_amdgcn_cosf(f_), sc = __builtin_amdgcn_sinf(f_);
                          const float x1 = y[1][0][e], x2 = y[1][1][e]; y[1][0][e] = x1 * cc - x2 * sc; y[1][1][e] = x1 * sc + x2 * cc; }
                    }
                }
                ss = 0.f;
#if ATTN_F8
                unsigned char* rowp8 = (unsigned char*)base + ((size_t)t * pitch + 4 * fq);
#pragma unroll
                for (int bj = 0; bj < 2; ++bj)
#pragma unroll
                    for (int n = 0; n < 2; ++n) { const pg8::f32x4 v = y[bj][n]; const unsigned w = pk4_fp8(v[0], v[1], v[2], v[3]); *(unsigned*)(rowp8 + 32 * bj + 16 * n) = w;
                        if (!isq) { const float b0 = __builtin_amdgcn_cvt_f32_fp8((int)w, 0), b1 = __builtin_amdgcn_cvt_f32_fp8((int)w, 1), b2 = __builtin_amdgcn_cvt_f32_fp8((int)w, 2), b3 = __builtin_amdgcn_cvt_f32_fp8((int)w, 3); ss += (b0 * b0 + b1 * b1) + (b2 * b2 + b3 * b3); } }
#else
                bf16* rowp = base + (size_t)t * pitch + 4 * fq;
#pragma unroll
                for (int bj = 0; bj < 2; ++bj)
#pragma unroll
                    for (int n = 0; n < 2; ++n) { const pg8::f32x4 v = y[bj][n]; const v2u w = (v2u){pk2(v[0], v[1]), pk2(v[2], v[3])}; *(v2u*)(rowp + 32 * bj + 16 * n) = w;
                        if (!isq) { const float b0 = __uint_as_float(w.x << 16), b1 = __uint_as_float(w.x & 0xffff0000u), b2 = __uint_as_float(w.y << 16), b3 = __uint_as_float(w.y & 0xffff0000u); ss += (b0 * b0 + b1 * b1) + (b2 * b2 + b3 * b3); } }
#endif
                if (!isq) { float r2 = ss; r2 += __shfl_xor(r2, 16); r2 += __shfl_xor(r2, 32); k2max = fmaxf(k2max, r2); }
                asm volatile("" ::: "memory");
            }
        }
        if (!isq) {
#pragma unroll
            for (int o = 1; o < 16; o <<= 1) k2max = fmaxf(k2max, __shfl_xor(k2max, o));
            if (fr == 0 && fq == 0) __hip_atomic_fetch_max(kmax, __float_as_uint(k2max), __ATOMIC_RELAXED, __HIP_MEMORY_SCOPE_AGENT);
        }
    }
};

__device__ __forceinline__ unsigned rev4_12(unsigned k) { unsigned r = __brev(k) >> 20; return ((r & 0xAAAu) >> 1) | ((r & 0x555u) << 1); }
__device__ __forceinline__ void fft_block(const Args& a, LAS unsigned char* lds, int item, int wave) {
    const int tid = wave * 64 + fresh_lane();
    const int mm = item & 31, par = (item >> 5) & 1, g = item >> 6;
    const float* FT = (const float*)(a.ws + WS_FT); bf16* MIX = (bf16*)(a.ws + WS_MIX);
    LAS f32x2* X = (LAS f32x2*)lds;
    const float* re = FT + (size_t)(64 * g + mm) * NTOK; const float* im = FT + (size_t)(64 * g + 32 + mm) * NTOK;
#pragma unroll 1
    for (int i = 0; i < 2; ++i) {
        const int j0 = 4 * (tid + NTHR * i);
        f32x4 r4[4], i4[4];
#pragma unroll
        for (int q = 0; q < 4; ++q) { r4[q] = *(const f32x4*)(re + j0 + 4096 * q); i4[q] = *(const f32x4*)(im + j0 + 4096 * q); }
#pragma unroll
        for (int e = 0; e < 4; ++e) {
            const int j = j0 + e;
            const f32x2 a0 = {r4[0][e], i4[0][e]}, a1 = {r4[1][e], i4[1][e]}, a2 = {r4[2][e], i4[2][e]}, a3 = {r4[3][e], i4[3][e]};
            f32x2 ya, yb; float fa, fb;
            if (par == 0) { const f32x2 s02 = a0 + a2, s13 = a1 + a3; ya = s02 + s13; yb = s02 - s13; fa = 0.f; fb = (float)(2 * j) * (1.f / 16384.f); }
            else { const f32x2 d02 = a0 - a2, d13 = a1 - a3; ya = (f32x2){d02.x + d13.y, d02.y - d13.x}; yb = (f32x2){d02.x - d13.y, d02.y + d13.x}; fa = (float)j * (1.f / 16384.f); fb = (float)(3 * j) * (1.f / 16384.f); }
            const float ca = __builtin_amdgcn_cosf(fa), sa = __builtin_amdgcn_sinf(fa), cb = __builtin_amdgcn_cosf(fb), sb = __builtin_amdgcn_sinf(fb);
            X[j] = (f32x2){ya.x * ca + ya.y * sa, ya.y * ca - ya.x * sa};
            X[4096 + j] = (f32x2){yb.x * cb + yb.y * sb, yb.y * cb - yb.x * sb};
        }
    }
    __syncthreads();
#pragma unroll 1
    for (int s = 0; s < 6; ++s) {
        const int lq = 10 - 2 * s;
        const int Lq = 1 << lq;
        const float invL = 1.f / (float)(4 << lq);
#pragma unroll 2
        for (int i = 0; i < 4; ++i) {
            const int b = tid + NTHR * i, j = b & (Lq - 1), base = ((b >> lq) << (lq + 2)) + j;
            const f32x2 a0 = X[base], a1 = X[base + Lq], a2 = X[base + 2 * Lq], a3 = X[base + 3 * Lq];
            const f32x2 s02 = a0 + a2, d02 = a0 - a2, s13 = a1 + a3, d13 = a1 - a3;
            const f32x2 y0 = s02 + s13, y2 = s02 - s13;
            const f32x2 y1 = (f32x2){d02.x + d13.y, d02.y - d13.x};
            const f32x2 y3 = (f32x2){d02.x - d13.y, d02.y + d13.x};
            const float f1 = (float)j * invL;
            const float c1 = __builtin_amdgcn_cosf(f1), s1 = __builtin_amdgcn_sinf(f1);
            const float c2 = __builtin_amdgcn_cosf(2.f * f1), s2 = __builtin_amdgcn_sinf(2.f * f1);
            const float c3 = __builtin_amdgcn_cosf(3.f * f1), s3 = __builtin_amdgcn_sinf(3.f * f1);
            X[base] = y0;
            X[base + Lq] = (f32x2){y1.x * c1 + y1.y * s1, y1.y * c1 - y1.x * s1};
            X[base + 2 * Lq] = (f32x2){y2.x * c2 + y2.y * s2, y2.y * c2 - y2.x * s2};
            X[base + 3 * Lq] = (f32x2){y3.x * c3 + y3.y * s3, y3.y * c3 - y3.x * s3};
        }
        __syncthreads();
    }
    const int col = 64 * g + 2 * mm;
#pragma unroll 1
    for (int i = 0; i < 16; ++i) {
        const int k = 2 * (tid + NTHR * i) + par, kn = (NTOK - k) & (NTOK - 1);
        const f32x2 wk = X[(((k & 3) - par) >> 1) * 4096 + rev4_12((unsigned)(k >> 2))], wn = X[(((kn & 3) - par) >> 1) * 4096 + rev4_12((unsigned)(kn >> 2))];
        float o0, o1;
        if (mm == 0) { o0 = 0.5f * (wk.x + wn.x); o1 = 0.5f * (wk.y + wn.y); }
        else { o0 = wn.x; o1 = wk.x; }
        *(unsigned*)(MIX + (size_t)k * DM + col) = pk2(o0, o1);
    }
    __syncthreads();
}

struct P3Prob {
    static constexpr int K = DM; static constexpr bool PERM = false, FP8 = false; static constexpr int SCW = 0, SCA = 0;
    const bf16* MIX; const bf16* WoT; const float* x; const float* g1; float* X1; pg8::StaticOrder so;
    __device__ __forceinline__ bool next(int i, pg8::Unit& u) const { return so.next(i, u); }
    __device__ __forceinline__ const char* aptr(const pg8::Unit& u) const { return (const char*)(MIX + (size_t)u.pm * 256 * DM); }
    __device__ __forceinline__ const char* bptr(const pg8::Unit& u) const { return (const char*)(WoT + (size_t)u.pn * 256 * DM); }
    __device__ __forceinline__ void epi(const pg8::f32x4 (&acc)[2][2][4][2], const pg8::Unit& u, int wr, int wc, int fr, int fq) const {
        const int col0 = u.pn * 256 + wc * 32 + 4 * fq;
        pg8::f32x4 gv[2][2];
#pragma unroll
        for (int bj = 0; bj < 2; ++bj)
#pragma unroll
            for (int n = 0; n < 2; ++n) gv[bj][n] = *(const pg8::f32x4*)(g1 + col0 + bj * 128 + n * 16);
#pragma unroll
        for (int ai = 0; ai < 2; ++ai)
#pragma unroll
            for (int m = 0; m < 4; ++m) { const size_t off = (size_t)(u.pm * 256 + ai * 128 + wr * 64 + m * 16 + fr) * DM + col0;
#pragma unroll
                for (int bj = 0; bj < 2; ++bj)
#pragma unroll
                    for (int n = 0; n < 2; ++n) { const pg8::f32x4 bs = *(const pg8::f32x4*)(x + off + bj * 128 + n * 16); *(pg8::f32x4*)(X1 + off + bj * 128 + n * 16) = bs + gv[bj][n] * acc[ai][bj][m][n]; }
                if (m & 1) asm volatile("" ::: "memory"); }
    }
};

__device__ __forceinline__ void p3b_router(const Args& a, LAS unsigned char* lds, int vcu, int G, int wave) {
    const int lane = fresh_lane(), tid = wave * 64 + lane;
    unsigned char* ws = a.ws; const float* MOD = (const float*)(ws + WS_MOD); const float* X1 = (const float*)(ws + WS_X1); bf16* H2 = (bf16*)(ws + WS_H2); float* AFF = (float*)(ws + WS_AFF);
    LAS float* wrt = (LAS float*)lds;
    { f32x4 t[8];
#pragma unroll
      for (int q = 0; q < 8; ++q) t[q] = *(const f32x4*)(a.w_router + 4 * (tid + NTHR * q));
#pragma unroll
      for (int q = 0; q < 8; ++q) { const int i = 4 * (tid + NTHR * q), col = i >> 4, e = i & 15;
#pragma unroll
          for (int k = 0; k < 4; ++k) wrt[(e + k) * 1024 + col] = t[q][k]; } }
    __syncthreads();
    f32x4 av[4], sh[4];
#pragma unroll
    for (int j = 0; j < 4; ++j) { const int col = 4 * lane + 256 * j; const f32x4 g = *(const f32x4*)(a.norm_ffn_g + col); const f32x4 sc = *(const f32x4*)(MOD + 4 * DM + col); av[j] = g * (sc + 1.f); sh[j] = *(const f32x4*)(MOD + 3 * DM + col); }
    const int gw = vcu * NWAVES + wave, NGW = G * NWAVES;
    f32x4 v[4], vn[4];
    if (gw < NTOK) { const GAS f32x4* xr = (const GAS f32x4*)(X1 + (size_t)gw * DM) + lane;
#pragma unroll
        for (int j = 0; j < 4; ++j) v[j] = xr[64 * j]; }
    for (int m = gw; m < NTOK; m += NGW) {
        const int mn = m + NGW;
        if (mn < NTOK) { const GAS f32x4* xr = (const GAS f32x4*)(X1 + (size_t)mn * DM) + lane;
#pragma unroll
            for (int j = 0; j < 4; ++j) vn[j] = xr[64 * j]; }
        float s = 0.f;
#pragma unroll
        for (int j = 0; j < 4; ++j) s += (v[j].x * v[j].x + v[j].y * v[j].y) + (v[j].z * v[j].z + v[j].w * v[j].w);
        const float rinv = 1.f / sqrtf(wave_sum(s) * (1.f / DM) + EPS);
        GAS unsigned* o4 = (GAS unsigned*)((unsigned char*)H2 + (size_t)m * DM) + lane;
#pragma unroll
        for (int j = 0; j < 4; ++j) { v[j] = v[j] * rinv * av[j] + sh[j]; o4[64 * j] = pk4_fp8(v[j].x, v[j].y, v[j].z, v[j].w); }
        float lg[16];
#pragma unroll
        for (int e0 = 0; e0 < 16; e0 += 4) {
#pragma unroll
            for (int e = e0; e < e0 + 4; ++e) { float p = 0.f;
#pragma unroll
                for (int j = 0; j < 4; ++j) { const f32x4 w = *(const LAS f32x4*)(wrt + e * 1024 + 4 * lane + 256 * j); p += (v[j].x * w.x + v[j].y * w.y) + (v[j].z * w.z + v[j].w * w.w); }
                lg[e] = p; }
            asm volatile("" ::: "memory"); }
        float r8[8], r4[4], r2[2], r1;
        { const bool up = (lane & 32) != 0;
#pragma unroll
          for (int e = 0; e < 8; ++e) { const float snd = up ? lg[e] : lg[e + 8], kp = up ? lg[e + 8] : lg[e]; r8[e] = kp + __shfl_xor(snd, 32); } }
        { const bool up = (lane & 16) != 0;
#pragma unroll
          for (int e = 0; e < 4; ++e) { const float snd = up ? r8[e] : r8[e + 4], kp = up ? r8[e + 4] : r8[e]; r4[e] = kp + __shfl_xor(snd, 16); } }
        { const bool up = (lane & 8) != 0;
#pragma unroll
          for (int e = 0; e < 2; ++e) { const float snd = up ? r4[e] : r4[e + 2], kp = up ? r4[e + 2] : r4[e]; r2[e] = kp + __shfl_xor(snd, 8); } }
        { const bool up = (lane & 4) != 0; const float snd = up ? r2[0] : r2[1], kp = up ? r2[1] : r2[0]; r1 = kp + __shfl_xor(snd, 4); }
        r1 += __shfl_xor(r1, 2); r1 += __shfl_xor(r1, 1);
        float mx = r1;
#pragma unroll
        for (int o = 4; o < 64; o <<= 1) mx = fmaxf(mx, __shfl_xor(mx, o));
        const float ex = __expf(r1 - mx); float den = ex;
#pragma unroll
        for (int o = 4; o < 64; o <<= 1) den += __shfl_xor(den, o);
        if ((lane & 3) == 0) AFF[(size_t)(lane >> 2) * NTOK + m] = ex / den;
#pragma unroll
        for (int j = 0; j < 4; ++j) v[j] = vn[j];
    }
}

__device__ __forceinline__ void p4_topk(const Args& a, LAS unsigned char* lds, int e, int wave) {
    const int lane = fresh_lane(), tid = wave * 64 + lane;
    unsigned char* ws = a.ws; const unsigned* AFF = (const unsigned*)(ws + WS_AFF) + (size_t)e * NTOK;
    int* IDX = (int*)(ws + WS_IDX) + e * CAP; float* GATE = (float*)(ws + WS_GATE) + e * CAP; int* TOKSLOT = (int*)(ws + WS_TOKSLOT);
    LAS unsigned* wcnt = (LAS unsigned*)lds;
    LAS unsigned* cg = wcnt + 16;
    LAS unsigned* ce = cg + 256;
    unsigned key[32];
#pragma unroll
    for (int i = 0; i < 32; ++i) key[i] = AFF[i * NTHR + tid];
    unsigned T = 0u;
#pragma unroll 1
    for (int bit = 30; bit >= 0; --bit) {
        const unsigned cand = T | (1u << bit);
        unsigned c = 0u;
#pragma unroll
        for (int i = 0; i < 32; ++i) c += (unsigned)__popcll(__ballot(key[i] >= cand));
        LAS unsigned* wb = wcnt + 1024 + (bit & 1) * 8;
        if (lane == 0) wb[wave] = c;
        __syncthreads();
        unsigned tot = 0u;
#pragma unroll
        for (int w = 0; w < 8; ++w) tot += wb[w];
        if (tot >= (unsigned)CAP) T = cand;
    }
    __syncthreads();
    unsigned long long below = (1ull << lane) - 1ull;
    unsigned rg[32], rq[32];
#pragma unroll
    for (int i = 0; i < 32; ++i) {
        const unsigned long long bg = __ballot(key[i] > T), bq = __ballot(key[i] == T);
        rg[i] = (unsigned)__popcll(bg & below); rq[i] = (unsigned)__popcll(bq & below);
        if (lane == 0) { cg[i * 8 + wave] = (unsigned)__popcll(bg); ce[i * 8 + wave] = (unsigned)__popcll(bq); }
    }
    __syncthreads();
    if (wave == 0) {
        unsigned g4[4], q4[4], sg = 0u, sq = 0u;
#pragma unroll
        for (int k = 0; k < 4; ++k) { g4[k] = cg[4 * lane + k]; q4[k] = ce[4 * lane + k]; sg += g4[k]; sq += q4[k]; }
        unsigned pg = sg, pq = sq;
#pragma unroll
        for (int o = 1; o < 64; o <<= 1) { const unsigned tg = __shfl_up(pg, o), tq = __shfl_up(pq, o); if (lane >= o) { pg += tg; pq += tq; } }
        pg -= sg; pq -= sq;
#pragma unroll
        for (int k = 0; k < 4; ++k) { cg[4 * lane + k] = pg; ce[4 * lane + k] = pq; pg += g4[k]; pq += q4[k]; }
        if (lane == 63) { wcnt[8] = pg; }
    }
    __syncthreads();
    const unsigned ngt = wcnt[8], need = (unsigned)CAP - ngt;
#pragma unroll
    for (int i = 0; i < 32; ++i) {
        const int tok = i * NTHR + tid;
        const unsigned gb = cg[i * 8 + wave] + rg[i], qb = ce[i * 8 + wave] + rq[i];
        const bool sel = key[i] > T || (key[i] == T && qb < need);
        const unsigned slot = gb + (qb < need ? qb : need);
        if (sel) { IDX[slot] = tok; GATE[slot] = __uint_as_float(key[i]); }
        TOKSLOT[tok * 16 + e] = sel ? (int)slot : -1;
    }
}

struct P5Prob {
    static constexpr int K = DM; static constexpr bool PERM = true, FP8 = true; static constexpr int SCW = 0x7A7A7A7A, SCA = 0x7F7F7F7F;
    const unsigned char* H2; const unsigned char* WguT; unsigned char* HID; pg8::StaticOrder so;
    __device__ __forceinline__ bool next(int i, pg8::Unit& u) const { return so.next(i, u); }
    __device__ __forceinline__ const char* aptr(const pg8::Unit&) const { return (const char*)H2; }
    __device__ __forceinline__ const char* bptr(const pg8::Unit& u) const { return (const char*)(WguT + ((size_t)(u.pm >> 3) * 4096 + (size_t)u.pn * 256) * DM); }
    __device__ __forceinline__ void epi(const pg8::f32x4 (&acc)[2][2][4][2], const pg8::Unit& u, int wr, int wc, int fr, int fq) const {
#pragma unroll
        for (int ai = 0; ai < 2; ++ai)
#pragma unroll
            for (int m = 0; m < 4; ++m) { unsigned char* rowp = HID + (size_t)(u.pm * 256 + ai * 128 + wr * 64 + m * 16 + fr) * DE + u.pn * 128 + wc * 32 + 8 * fq;
                float h[8];
#pragma unroll
                for (int n = 0; n < 2; ++n)
#pragma unroll
                    for (int e = 0; e < 4; ++e) { const float gt = acc[ai][0][m][n][e], up = acc[ai][1][m][n][e]; h[4 * n + e] = gt * __builtin_amdgcn_rcpf(1.f + __builtin_amdgcn_exp2f(-1.4426950408889634f * gt)) * up; }
                *(v2u*)rowp = (v2u){pk4_fp8(h[0], h[1], h[2], h[3]), pk4_fp8(h[4], h[5], h[6], h[7])}; }
    }
};
struct P6Prob {
    static constexpr int K = DE; static constexpr bool PERM = true, FP8 = true; static constexpr int SCW = 0x7A7A7A7A, SCA = 0x7F7F7F7F;
    const unsigned char* HID; const unsigned char* WdT; const float* GATE; bf16* YE; pg8::StaticOrder so;
    __device__ __forceinline__ bool next(int i, pg8::Unit& u) const { return so.next(i, u); }
    __device__ __forceinline__ const char* aptr(const pg8::Unit& u) const { return (const char*)(HID + (size_t)u.pm * 256 * DE); }
    __device__ __forceinline__ const char* bptr(const pg8::Unit& u) const { return (const char*)(WdT + ((size_t)(u.pm >> 3) * DM + (size_t)u.pn * 256) * DE); }
    __device__ __forceinline__ void epi(const pg8::f32x4 (&acc)[2][2][4][2], const pg8::Unit& u, int wr, int wc, int fr, int fq) const {
#pragma unroll
        for (int ai = 0; ai < 2; ++ai)
#pragma unroll
            for (int m = 0; m < 4; ++m) { const int row = u.pm * 256 + ai * 128 + wr * 64 + m * 16 + fr; const float gt = GATE[row]; bf16* rowp = YE + (size_t)row * DM + u.pn * 256 + wc * 32 + 8 * fq;
#pragma unroll
                for (int bj = 0; bj < 2; ++bj) { const pg8::f32x4 v0 = acc[ai][bj][m][0] * gt, v1 = acc[ai][bj][m][1] * gt;
                    *(v4u*)(rowp + bj * 128) = (v4u){pk2(v0[0], v0[1]), pk2(v0[2], v0[3]), pk2(v1[0], v1[1]), pk2(v1[2], v1[3])}; } }
    }
};

__device__ __forceinline__ void p7_final(const Args& a, int vcu, int G, int wave, unsigned poison) {
    const int lane = fresh_lane();
    unsigned char* ws = a.ws; const float* MOD = (const float*)(ws + WS_MOD); const bf16* YE = (const bf16*)(ws + WS_YE); const int* TOKSLOT = (const int*)(ws + WS_TOKSLOT);
    const float* src = (STEP >= 2) ? (const float*)(ws + WS_X1) : a.x;
    f32x4 g2[4], fg[4];
#pragma unroll
    for (int j = 0; j < 4; ++j) { const int col = 4 * lane + 256 * j; g2[j] = *(const f32x4*)(MOD + 5 * DM + col); fg[j] = *(const f32x4*)(a.final_norm_g + col); }
    const int gw = vcu * NWAVES + wave, NGW = G * NWAVES;
    for (int m = gw; m < NTOK; m += NGW) {
        const GAS f32x4* xr = (const GAS f32x4*)(src + (size_t)m * DM) + lane;
        f32x4 v[4];
#pragma unroll
        for (int j = 0; j < 4; ++j) v[j] = xr[64 * j];
        if (STEP >= 4) {
            const int myslot = lane < 16 ? TOKSLOT[m * 16 + lane] : -1;
            f32x4 s[4];
#pragma unroll
            for (int j = 0; j < 4; ++j) s[j] = (f32x4){0.f, 0.f, 0.f, 0.f};
#pragma unroll 1
            for (int e = 0; e < 16; ++e) {
                const int sl = __builtin_amdgcn_readlane(myslot, e);
                if (sl >= 0) {
                    const GAS v2u* yr = (const GAS v2u*)(YE + ((size_t)e * CAP + sl) * DM) + lane;
#pragma unroll
                    for (int j = 0; j < 4; ++j) { const v2u w = yr[64 * j]; s[j].x += __uint_as_float(w.x << 16); s[j].y += __uint_as_float(w.x & 0xffff0000u); s[j].z += __uint_as_float(w.y << 16); s[j].w += __uint_as_float(w.y & 0xffff0000u); }
                }
            }
#pragma unroll
            for (int j = 0; j < 4; ++j) v[j] += g2[j] * s[j];
        }
        float ss = 0.f;
#pragma unroll
        for (int j = 0; j < 4; ++j) ss += (v[j].x * v[j].x + v[j].y * v[j].y) + (v[j].z * v[j].z + v[j].w * v[j].w);
        const float rinv = 1.f / sqrtf(wave_sum(ss) * (1.f / DM) + EPS);
        GAS f32x4* o = (GAS f32x4*)(a.out + (size_t)m * DM) + lane;
        const float q = __builtin_nanf("");
#pragma unroll
        for (int j = 0; j < 4; ++j) { f32x4 y = v[j] * rinv * fg[j]; if (poison) y = (f32x4){q, q, q, q}; o[64 * j] = y; }
    }
}


#if PROBE
__device__ __forceinline__ void dsincos(double x, double& sn, double& cs) {
    const double TWO_PI = 6.283185307179586476925286766559; x -= TWO_PI * rint(x / TWO_PI);
    const double x2 = x * x; double ts = x, tc = 1.0; sn = x; cs = 1.0;
#pragma unroll 1
    for (int k = 1; k <= 14; ++k) { tc *= -x2 / (double)((2 * k - 1) * (2 * k)); ts *= -x2 / (double)((2 * k) * (2 * k + 1)); cs += tc; sn += ts; }
}
__device__ __forceinline__ float block_sum(float v, LAS float* red, int wave, int lane) {
    v = wave_sum(v); __syncthreads(); if (lane == 0) red[wave] = v; __syncthreads(); float s = 0.f;
#pragma unroll
    for (int w = 0; w < 8; ++w) s += red[w];
    return s;
}
__device__ __forceinline__ float block_max(float v, LAS float* red, int wave, int lane) {
#pragma unroll
    for (int o = 1; o < 64; o <<= 1) v = fmaxf(v, __shfl_xor(v, o));
    __syncthreads(); if (lane == 0) red[wave] = v; __syncthreads(); float s = red[0];
#pragma unroll
    for (int w = 1; w < 8; ++w) s = fmaxf(s, red[w]);
    return s;
}
__device__ __forceinline__ void probe_qkv(const Args& a, LAS unsigned char* lds, int vcu, int wave) {
    const int lane = fresh_lane(), tid = wave * 64 + lane; unsigned char* ws = a.ws;
    const bf16* XN = (const bf16*)(ws + WS_XN); const bf16* Qb = (const bf16*)(ws + WS_Q); const bf16* Kb = (const bf16*)(ws + WS_K); const bf16* Vb = (const bf16*)(ws + WS_V);
    gu32* ctl = (gu32*)(ws + WS_CTL);
    LAS float* red = (LAS float*)lds; LAS float* raw = red + 16;
    for (int kind = 0; kind < 3; ++kind) {
        const int nrows = kind == 0 ? NTOK : NROWS, nh = kind == 0 ? NHQ : NHKV;
        const int t = (kind == 1 && (vcu & 7) == 3) ? NTOK + (vcu * 37) % NCTX : (vcu * 977 + 131 * kind + 5) % (kind == 0 ? NTOK : NTOK);
        const int h = (vcu * 5 + kind) % nh;
        const int wcol0 = 256 + (kind == 0 ? 0 : (kind == 1 ? 768 : 1024)) + 64 * h;
        { const int d = tid & 63, part = tid >> 6; float sacc = 0.f;
          for (int k = part * 128; k < part * 128 + 128; ++k) sacc += bf2f(XN[(size_t)t * DM + k]) * a.w_in[(size_t)k * INW + wcol0 + d];
          LAS float* part_s = raw + 64; part_s[part * 64 + d] = sacc; __syncthreads();
          if (tid < 64) { float s2 = 0.f; for (int pp = 0; pp < 8; ++pp) s2 += part_s[pp * 64 + tid]; raw[tid] = s2; }
          __syncthreads(); }
        float ref = 0.f, got = 0.f;
        if (tid < 64) {
            const int d = tid; float v = raw[d];
            if (kind < 2) {
                float ss = 0.f; for (int j = 0; j < 64; ++j) ss += raw[j] * raw[j];
                const float* gw = kind == 0 ? a.q_norm_g : a.k_norm_g;
                const float rinv = 1.f / sqrtf(ss / 64.f + EPS);
                if (t < NTOK) {
                    const int half = d >> 5, dd = d & 31, i = dd & 15; const int pos = half == 0 ? (t >> 6) : (t & 63);
                    const double freq = exp2(-(double)i * (13.287712379549449 / 16.0)); double sn, cs; dsincos((double)pos * freq, sn, cs);
                    const float x1 = raw[32 * half + i] * rinv * gw[32 * half + i], x2 = raw[32 * half + 16 + i] * rinv * gw[32 * half + 16 + i];
                    v = dd < 16 ? (float)(x1 * cs - x2 * sn) : (float)(x1 * sn + x2 * cs);
                } else v = v * rinv * gw[d];
                if (kind == 0) v *= attn_body::C2;
            }
            ref = v;
#if ATTN_F8
            { const unsigned char* Q8 = (const unsigned char*)Qb; const unsigned char* K8 = (const unsigned char*)Kb; const unsigned char* V8 = (const unsigned char*)Vb;
              if (kind == 0) got = __builtin_amdgcn_cvt_f32_fp8((int)Q8[(size_t)t * 768 + 64 * h + d], 0) * (1.f / 16.f);
              else if (kind == 1) got = __builtin_amdgcn_cvt_f32_fp8((int)K8[(size_t)t * 256 + 64 * h + d], 0);
              else { const int kk = t & 63, tile = t >> 6, k5 = kk & 31, hk = (k5 >> 2) & 1, j = (k5 & 3) + 4 * (k5 >> 3) + 16 * (kk >> 5);
                     got = __builtin_amdgcn_cvt_f32_fp8((int)V8[(((size_t)(h * (NKEYS / 64) + tile) * 64) + d) * 64 + 32 * (hk ^ ((d >> 2) & 1)) + j], 0); } }
#else
            got = kind == 0 ? bf2f(Qb[(size_t)t * 768 + 64 * h + d]) : (kind == 1 ? bf2f(Kb[(size_t)t * 256 + 64 * h + d]) : bf2f(Vb[(size_t)t * 256 + 64 * h + d]));
#endif
        }
        const float mx = block_max(fabsf(ref), red, wave, lane);
        const float err = block_max(fabsf(ref - got), red, wave, lane);
        if (tid == 0 && !(err <= (ATTN_F8 ? 0.07f : 0.03f) * mx + 1e-6f)) __hip_atomic_fetch_or(ctl + CW_FLAG, 1u << kind, RLX_AGENT);
        __syncthreads();
    }
}
__device__ __forceinline__ void probe_attn(const Args& a, LAS unsigned char* lds, int vcu, int wave) {
    const int lane = fresh_lane(), tid = wave * 64 + lane; unsigned char* ws = a.ws;
    const bf16* Qb = (const bf16*)(ws + WS_Q); const bf16* Kb = (const bf16*)(ws + WS_K); const bf16* Vb = (const bf16*)(ws + WS_V); const bf16* MIX = (const bf16*)(ws + WS_MIX);
    gu32* ctl = (gu32*)(ws + WS_CTL);
    LAS float* red = (LAS float*)lds; LAS float* ored = red + 16;
    const int t = (vcu * 613 + 29) % NTOK, h = (vcu * 7 + 3) % NHQ, kvh = h / 3;
    float q[64];
#if ATTN_F8
    const unsigned char* Q8 = (const unsigned char*)Qb; const unsigned char* K8 = (const unsigned char*)Kb; const unsigned char* V8 = (const unsigned char*)Vb;
#pragma unroll
    for (int d = 0; d < 64; ++d) q[d] = __builtin_amdgcn_cvt_f32_fp8((int)Q8[(size_t)t * 768 + 64 * h + d], 0) * (1.f / 16.f);
#else
#pragma unroll
    for (int d = 0; d < 64; ++d) q[d] = bf2f(Qb[(size_t)t * 768 + 64 * h + d]);
#endif
    float sc[33]; float mx = -1e30f;
#pragma unroll
    for (int i = 0; i < 33; ++i) { const int key = i * NTHR + tid; float s = -1e30f;
#if ATTN_F8
        if (key < NKEYS) { s = 0.f; const unsigned char* kr = K8 + (size_t)key * 256 + 64 * kvh;
#pragma unroll
            for (int d = 0; d < 64; ++d) s += q[d] * __builtin_amdgcn_cvt_f32_fp8((int)kr[d], 0); }
#else
        if (key < NKEYS) { s = 0.f; const bf16* kr = Kb + (size_t)key * 256 + 64 * kvh;
#pragma unroll
            for (int d = 0; d < 64; ++d) s += q[d] * bf2f(kr[d]); }
#endif
        sc[i] = s; mx = fmaxf(mx, s); }
    mx = block_max(mx, red, wave, lane);
    float den = 0.f; float o[64];
#pragma unroll
    for (int d = 0; d < 64; ++d) o[d] = 0.f;
#pragma unroll
    for (int i = 0; i < 33; ++i) { const int key = i * NTHR + tid;
#if ATTN_F8
        if (key < NKEYS) { const float pp = exp2f(sc[i] - mx); den += pp; const int kk = key & 63, tile = key >> 6, k5 = kk & 31, hk = (k5 >> 2) & 1, j = (k5 & 3) + 4 * (k5 >> 3) + 16 * (kk >> 5);
            const unsigned char* vb = V8 + ((size_t)(kvh * (NKEYS / 64) + tile) * 64) * 64;
#pragma unroll
            for (int d = 0; d < 64; ++d) o[d] += pp * __builtin_amdgcn_cvt_f32_fp8((int)vb[d * 64 + 32 * (hk ^ ((d >> 2) & 1)) + j], 0); } }
#else
        if (key < NKEYS) { const float pp = exp2f(sc[i] - mx); den += pp; const bf16* vr = Vb + (size_t)key * 256 + 64 * kvh;
#pragma unroll
            for (int d = 0; d < 64; ++d) o[d] += pp * bf2f(vr[d]); } }
#endif
    den = block_sum(den, red, wave, lane);
#pragma unroll
    for (int d = 0; d < 64; ++d) { const float w = wave_sum(o[d]); if (lane == 0) ored[wave * 64 + d] = w; }
    __syncthreads();
    float ref = 0.f, got = 0.f;
    if (tid < 64) { float s = 0.f; for (int w = 0; w < 8; ++w) s += ored[w * 64 + tid]; ref = s / den; got = bf2f(MIX[(size_t)t * DM + 256 + 64 * h + tid]); }
    const float m2 = block_max(fabsf(ref), red, wave, lane);
    const float err = block_max(fabsf(ref - got), red, wave, lane);
    if (tid == 0 && !(err <= 0.03f * m2 + 1e-7f)) __hip_atomic_fetch_or(ctl + CW_FLAG, 8u, RLX_AGENT);
    __syncthreads();
}
#endif

__global__ void __launch_bounds__(NTHR, 2) fwd_megakernel(Args args) {
    extern __shared__ __attribute__((aligned(16))) unsigned char lds_raw[];
    LAS unsigned char* lds = (LAS unsigned char*)lds_raw;
    volatile LAS unsigned* MISC = (volatile LAS unsigned*)(lds + MISC_OFF);
    const int wave = __builtin_amdgcn_readfirstlane(threadIdx.x >> 6);
    const int G = gridDim.x; const int bx = blockIdx.x; const int vcu = (G % 8 == 0) ? (bx % 8) * (G / 8) + bx / 8 : bx;
    unsigned char* ws = args.ws;
    gu32* ctl = (gu32*)(ws + WS_CTL);
    { const int l0 = fresh_lane(); if (wave < 2) ((LAS unsigned*)(lds + MISC_OFF))[wave * 64 + l0] = 0u;
      __syncthreads();
    }
    XcdBarrier bar = xcd_barrier_post((unsigned*)(ctl + CW_BAR), MISC + 8, wave == 0 && fresh_lane() == 0);
#define GRID_BAR() xcd_barrier(bar, wave)

    for (int rep = 0; rep < REP(0); ++rep) {
    if (STEP >= 2 && PH(0)) p0_prologue(args, lds, vcu, G, wave);
    GRID_BAR(); }
    for (int rep = 0; rep < REP(1); ++rep) {
    if (STEP >= 2 && PH(1)) p0b_modulate(args, vcu, G, wave);
    GRID_BAR(); }
    for (int rep = 0; rep < REP(2); ++rep) {
    if (STEP >= 2 && PH(2)) {
        P1Prob p; p.XN = (bf16*)(ws + WS_XN); p.WinT = (bf16*)(ws + WS_WIN); p.Q = (bf16*)(ws + WS_Q); p.Kb = (bf16*)(ws + WS_K); p.Vb = (bf16*)(ws + WS_V); p.FT = (float*)(ws + WS_FT);
        p.qg = args.q_norm_g; p.kg = args.k_norm_g; p.kmax = (unsigned*)(ctl + CW_KMAX); p.so.init(NROWS / 256, INW / 256, G, bx);
        pg8::gemm_phase<P1Prob, false, true, true>(lds, p, nullptr, wave);
        if (rep == 0 && MOE_S1 > 0) {
            const int nwg = (NROWS / 256) * (INW / 256), maxc = (nwg + G - 1) / G, c0 = nwg - (maxc - 1) * G;
            if (c0 >= G) moe_convert(args, (LAS float*)(lds + wave * 16640), MOE_B0, MOE_B1, bx * NWAVES + wave, G * NWAVES);
            else if (bx >= c0) moe_convert(args, (LAS float*)(lds + wave * 16640), MOE_B0, MOE_B1, (bx - c0) * NWAVES + wave, (G - c0) * NWAVES);
        }
    }
    GRID_BAR(); }
#if PROBE == 1
    probe_qkv(args, lds, vcu, wave);
#endif
    for (int rep = 0; rep < REP(3); ++rep) {
    if (STEP >= 2 && PH(3)) {
        for (int item = vcu; item < 256; item += G) fft_block(args, lds, item, wave);
        if (rep == 0 && MOE_S2 > 0) {
            if (G > 256) { if (vcu >= 256) moe_convert(args, (LAS float*)(lds + wave * 16640), MOE_B1, MOE_B2, (vcu - 256) * NWAVES + wave, (G - 256) * NWAVES); }
            else moe_convert(args, (LAS float*)(lds + wave * 16640), MOE_B1, MOE_B2, vcu * NWAVES + wave, G * NWAVES);
        }
    }
    if (rep + 1 < REP(3)) GRID_BAR(); }
    for (int rep = 0; rep < REP(4); ++rep) {
    if (STEP >= 3 && PH(4)) {
        const attn_body::bf16* Qb = (const attn_body::bf16*)(ws + WS_Q); const attn_body::bf16* Kb = (const attn_body::bf16*)(ws + WS_K); const attn_body::bf16* Vb = (const attn_body::bf16*)(ws + WS_V);
        attn_body::bf16* MIX = (attn_body::bf16*)(ws + WS_MIX);
        const float kmax2 = __uint_as_float(__hip_atomic_load(ctl + CW_KMAX, RLX_AGENT));
        const int u0 = (G == 256) ? vcu * 3 : vcu, ustep = (G == 256) ? 1 : G, uend = (G == 256) ? vcu * 3 + 3 : 768;
#pragma unroll 1
        for (int u = u0; u < uend; u += ustep) {
            const int kvh = u / 192, w = u % 192, h = kvh * 3 + w / 64, qb = w % 64;
#if ATTN_F8
            attn_body::attn_unit_f8(h, kvh, qb, (const unsigned char*)Qb, (const unsigned char*)Kb, (const unsigned char*)Vb, MIX, (char*)lds_raw, wave, kmax2);
#else
            attn_body::attn_unit<8>(h, kvh, qb, Qb, Kb, Vb, MIX, (char*)lds_raw, wave, kmax2);
#endif
        }
    } else if (STEP == 2) {
        bf16* MIX = (bf16*)(ws + WS_MIX);
        const int gw = vcu * NWAVES + wave, NGW = G * NWAVES, lane = fresh_lane();
        for (int m = gw; m < NTOK; m += NGW) { GAS v4u* o = (GAS v4u*)(MIX + (size_t)m * DM + 256); o[lane] = (v4u){0u, 0u, 0u, 0u}; if (lane < 32) o[64 + lane] = (v4u){0u, 0u, 0u, 0u}; }
    }
    GRID_BAR(); }
#if PROBE == 2
    probe_attn(args, lds, vcu, wave);
#endif
    for (int rep = 0; rep < REP(5); ++rep) {
    if (STEP >= 2 && PH(5)) {
        P3Prob p; p.MIX = (bf16*)(ws + WS_MIX); p.WoT = (bf16*)(ws + WS_WOUT); p.x = args.x; p.g1 = (const float*)(ws + WS_MOD) + 2 * DM; p.X1 = (float*)(ws + WS_X1); p.so.init(NTOK / 256, DM / 256, G, bx);
        pg8::gemm_phase<P3Prob, false, true, true>(lds, p, nullptr, wave);
    }
    GRID_BAR(); }
    for (int rep = 0; rep < REP(6); ++rep) {
    if (STEP >= 4 && PH(6)) p3b_router(args, lds, vcu, G, wave);
    GRID_BAR(); }
    for (int rep = 0; rep < REP(7); ++rep) {
    if (STEP >= 4 && PH(7)) {
#pragma unroll 1
        for (int e = vcu; e < NE; e += G) p4_topk(args, lds, e, wave);
        if (rep == 0) {
            if (G > NE) { if (vcu >= NE) moe_convert(args, (LAS float*)(lds + wave * 16640), MOE_B2, MOE_ITEMS, (vcu - NE) * NWAVES + wave, (G - NE) * NWAVES); }
            else moe_convert(args, (LAS float*)(lds + wave * 16640), MOE_B2, MOE_ITEMS, vcu * NWAVES + wave, G * NWAVES);
        } }
    GRID_BAR(); }
    for (int rep = 0; rep < REP(8); ++rep) {
    if (STEP >= 4 && PH(8)) {
        P5Prob p; p.H2 = (const unsigned char*)(ws + WS_H2); p.WguT = (const unsigned char*)(ws + WS_WGU); p.HID = (unsigned char*)(ws + WS_HID); p.so.init(NE * CAP / 256, 2 * DE / 256, G, bx);
        LAS unsigned* rowtab = (LAS unsigned*)(lds + XTRA_OFF);
        const int* IDX = (const int*)(ws + WS_IDX);
        { const int tid = wave * 64 + fresh_lane(); pg8::Unit u; for (int i = 0; p.so.next(i, u) && i < 28; ++i) { if (tid < 256) rowtab[i * 256 + tid] = (unsigned)IDX[u.pm * 256 + tid]; } }
        __syncthreads();
        pg8::gemm_phase<P5Prob, true, true, true>(lds, p, rowtab, wave);
    }
    GRID_BAR(); }
    for (int rep = 0; rep < REP(9); ++rep) {
    if (STEP >= 4 && PH(9)) {
        P6Prob p; p.HID = (const unsigned char*)(ws + WS_HID); p.WdT = (const unsigned char*)(ws + WS_WD); p.GATE = (const float*)(ws + WS_GATE); p.YE = (bf16*)(ws + WS_YE); p.so.init(NE * CAP / 256, DM / 256, G, bx);
        pg8::gemm_phase<P6Prob, false, true, true>(lds, p, nullptr, wave);
    }
    GRID_BAR(); }
    {
        unsigned poison = (__hip_atomic_load(ctl + CW_BAR + XB_TMO, RLX_AGENT) != 0u) || (__hip_atomic_load(ctl + CW_FLAG, RLX_AGENT) != 0u);
        for (int rep = 0; rep < REP(10); ++rep) p7_final(args, vcu, G, wave, poison);
    }
}

extern "C" void kernel_launch(void* const* d_in, const int* in_sizes, int n_in, void* d_out, int out_size, void* d_ws, size_t ws_size, hipStream_t stream) {
    static int grid = 0;
    if (grid == 0) {
        if (n_in != 18 || in_sizes[0] != NTOK * DM || out_size != NTOK * DM || ws_size < WS_END) { fprintf(stderr, "kernel_launch: unexpected shapes (n_in %d, in0 %d, out %d, ws %zu)\n", n_in, n_in > 0 ? in_sizes[0] : -1, out_size, ws_size); grid = -1; return; }
        int dev = 0, cus = 0, per_cu = 0;
        if (hipGetDevice(&dev) != hipSuccess || hipDeviceGetAttribute(&cus, hipDeviceAttributeMultiprocessorCount, dev) != hipSuccess) { grid = -1; return; }
        if (hipFuncSetAttribute((const void*)fwd_megakernel, hipFuncAttributeMaxDynamicSharedMemorySize, LDS_BYTES) != hipSuccess) { fprintf(stderr, "kernel_launch: hipFuncSetAttribute failed\n"); grid = -1; return; }
        if (hipOccupancyMaxActiveBlocksPerMultiprocessor(&per_cu, (const void*)fwd_megakernel, NTHR, LDS_BYTES) != hipSuccess || per_cu < 1) { fprintf(stderr, "kernel_launch: occupancy query says %d blocks per CU\n", per_cu); (void)hipGetLastError(); grid = -1; return; }
        grid = cus;
    }
    if (grid < 0) return;
    (void)hipMemsetAsync((char*)d_ws + WS_CTL, 0, CTL_ZERO_BYTES, stream);
    Args a{};
    const float** f = (const float**)&a;
    for (int i = 0; i < 18; ++i) f[i] = (const float*)d_in[i];
    a.out = (float*)d_out; a.ws = (unsigned char*)d_ws;
    hipLaunchKernelGGL(fwd_megakernel, dim3(grid), dim3(NTHR), LDS_BYTES, stream, a);
}
```

```cpp
#include <hip/hip_runtime.h>
#include <hip/hip_bf16.h>
#include <cstdio>
#include <cstdint>
#include <cmath>

#ifndef STEP
#define STEP 4
#endif
#ifndef PROBE
#define PROBE 0
#endif
#ifndef PHMASK
#define PHMASK 0xFFFF
#endif
#define PH(k) ((PHMASK >> (k)) & 1)
#ifndef ATTN_F8
#define ATTN_F8 1
#endif
#ifndef REPEAT
#define REPEAT 0
#endif
#define REP(k) (((REPEAT >> (k)) & 1) + 1)

constexpr int DM = 1024, NTOK = 16384, NCTX = 256, NROWS = NTOK + NCTX, INW = 1536;
constexpr int NHQ = 12, NHKV = 4, HD = 64, NE = 16, CAP = 2048, DE = 2048, NMOD = 6;
constexpr int NKEYS = NROWS;
constexpr float EPS = 1e-6f;

__device__ __forceinline__ int fresh_lane() { int l; asm volatile("v_mbcnt_lo_u32_b32 %0, -1, 0\n\tv_mbcnt_hi_u32_b32 %0, -1, %0" : "=v"(l)); return l; }

namespace pg8 {
#define PG8_LAS __attribute__((address_space(3)))
typedef unsigned short bf16_t;
typedef short bf16x8 __attribute__((ext_vector_type(8)));
typedef float f32x4 __attribute__((ext_vector_type(4)));
typedef unsigned u32x4 __attribute__((ext_vector_type(4)));
typedef unsigned u32x2 __attribute__((ext_vector_type(2)));
typedef int v8i __attribute__((ext_vector_type(8)));
constexpr int BM = 256, BK = 64, HALF = 128, HTB = HALF * BK * 2, STAGE_BYTES = 8 * HTB, NXCD = 8, WGM = 8;

__host__ __device__ __forceinline__ int lds_byte(int r, int c) { const int st = (r >> 4) * 2 + (c >> 5), rr = r & 15, cc = c & 31, ob = rr * 64 + cc * 2; return st * 1024 + (ob ^ (((ob >> 9) & 1) << 5)); }
__host__ __device__ __forceinline__ void stage_rc(int b, int& R, int& C) { const int st = b / 1024, sb = b % 1024, swz = sb ^ (((sb >> 9) & 1) << 5); R = (st >> 1) * 16 + swz / 64; C = (st & 1) * 32 + (swz % 64) / 2; }
__host__ __device__ __forceinline__ int perm32(int rho) { const int n = rho >> 4, i = rho & 15; return 8 * (i >> 2) + 4 * n + (i & 3); }

struct Unit { int pm, pn; };

struct StaticOrder {
    int nM, nN, nwg, G, c;
    __host__ __device__ void init(int nM_, int nN_, int G_, int c_) { nM = nM_; nN = nN_; nwg = nM * nN; G = G_; c = c_; }
    __host__ __device__ bool next(int i, Unit& u) const {
        const long L = (long)i * G + c; if (L >= nwg) return false;
        int wgid = (int)L; { const int q = nwg / NXCD, r = nwg % NXCD, xcd = wgid % NXCD, off = wgid / NXCD; wgid = (xcd < r ? xcd * (q + 1) : r * (q + 1) + (xcd - r) * q) + off; }
        const int nig = WGM * nN, gid = wgid / nig, fm = gid * WGM, gsz = (nM - fm) < WGM ? (nM - fm) : WGM;
        u.pm = fm + ((wgid % nig) % gsz); u.pn = (wgid % nig) / gsz; return true;
    }
};

__device__ __forceinline__ unsigned cvt_pk_bf16(float lo, float hi) { unsigned r; asm volatile("v_cvt_pk_bf16_f32 %0, %1, %2" : "=v"(r) : "v"(lo), "v"(hi)); return r; }

template <class P, bool GATHER, bool ALIGN_EPI, bool SP2>
__device__ __forceinline__ void gemm_phase(PG8_LAS unsigned char* lds, const P& S, const PG8_LAS unsigned* rowtab, int wid) {
    const int lane = fresh_lane(), tid = wid * 64 + lane, wr = wid >> 2, wc = wid & 3, fr = lane & 15, fq = lane >> 4;
    constexpr bool F8 = P::FP8; constexpr int ESZ = F8 ? 1 : 2;
    constexpr int K = P::K, nt = F8 ? K / 128 : K / BK;
    int R0, C0; stage_rc(tid * 16, R0, C0);
    unsigned voffB[2];
#pragma unroll
    for (int i = 0; i < 2; ++i) { const int R = R0 + 64 * i; const int Rb = P::PERM ? ((R & ~31) + perm32(R & 31)) : R; voffB[i] = (unsigned)(Rb * K * ESZ + C0 * 2); }
    constexpr size_t kstep = (size_t)(BK * 2);
    constexpr size_t hstep = (size_t)HALF * K * ESZ;
    const unsigned ldsw = (unsigned)wid * 1024u;
    const int aoff = F8 ? lds_byte(wr * 64 + fr, fq * 16) : lds_byte(wr * 64 + fr, fq * 8), boff = F8 ? lds_byte(wc * 32 + fr, fq * 16) : lds_byte(wc * 32 + fr, fq * 8);
#define PG8_SA(b, h) (((b) * 2 + (h)) * HTB)
#define PG8_SB(b, h) ((4 + (b) * 2 + (h)) * HTB)
#define PG8_STAGE(bufoff, gbase, voff) do { _Pragma("unroll") for (int _i = 0; _i < 2; ++_i) \
        __builtin_amdgcn_global_load_lds((const unsigned*)((const char*)(gbase) + (voff)[_i]), (PG8_LAS unsigned*)(lds + (bufoff) + ldsw + _i * 8192), 16, 0, 0); } while (0)
#define PG8_LDA(dst, b, h) do { if constexpr (F8) { _Pragma("unroll") for (int m = 0; m < 4; ++m) { const PG8_LAS u32x4* p_ = (const PG8_LAS u32x4*)(lds + PG8_SA(b, h) + aoff + m * 2048); const u32x4 lo_ = p_[0], hi_ = p_[1]; \
            dst##8[m] = (v8i){(int)lo_.x, (int)lo_.y, (int)lo_.z, (int)lo_.w, (int)hi_.x, (int)hi_.y, (int)hi_.z, (int)hi_.w}; } } \
        else { _Pragma("unroll") for (int m = 0; m < 4; ++m) _Pragma("unroll") for (int k = 0; k < 2; ++k) dst[m][k] = *(const PG8_LAS bf16x8*)(lds + PG8_SA(b, h) + aoff + m * 2048 + k * 1024); } } while (0)
#define PG8_LDB(dst, b, h) do { if constexpr (F8) { _Pragma("unroll") for (int n = 0; n < 2; ++n) { const PG8_LAS u32x4* p_ = (const PG8_LAS u32x4*)(lds + PG8_SB(b, h) + boff + n * 2048); const u32x4 lo_ = p_[0], hi_ = p_[1]; \
            dst##8[n] = (v8i){(int)lo_.x, (int)lo_.y, (int)lo_.z, (int)lo_.w, (int)hi_.x, (int)hi_.y, (int)hi_.z, (int)hi_.w}; } } \
        else { _Pragma("unroll") for (int n = 0; n < 2; ++n) _Pragma("unroll") for (int k = 0; k < 2; ++k) dst[n][k] = *(const PG8_LAS bf16x8*)(lds + PG8_SB(b, h) + boff + n * 2048 + k * 1024); } } while (0)
#define PG8_MMA(ai, bj, At, Bt) do { __builtin_amdgcn_s_setprio(1); if constexpr (F8) { \
        asm volatile("s_nop 1\n\t" \
            "v_mfma_scale_f32_16x16x128_f8f6f4 %0, %8, %10, %0, %14, %15 op_sel_hi:[0,0,0]\n\t" \
            "v_mfma_scale_f32_16x16x128_f8f6f4 %1, %9, %10, %1, %14, %15 op_sel_hi:[0,0,0]\n\t" \
            "v_mfma_scale_f32_16x16x128_f8f6f4 %2, %8, %11, %2, %14, %15 op_sel_hi:[0,0,0]\n\t" \
            "v_mfma_scale_f32_16x16x128_f8f6f4 %3, %9, %11, %3, %14, %15 op_sel_hi:[0,0,0]\n\t" \
            "v_mfma_scale_f32_16x16x128_f8f6f4 %4, %8, %12, %4, %14, %15 op_sel_hi:[0,0,0]\n\t" \
            "v_mfma_scale_f32_16x16x128_f8f6f4 %5, %9, %12, %5, %14, %15 op_sel_hi:[0,0,0]\n\t" \
            "v_mfma_scale_f32_16x16x128_f8f6f4 %6, %8, %13, %6, %14, %15 op_sel_hi:[0,0,0]\n\t" \
            "v_mfma_scale_f32_16x16x128_f8f6f4 %7, %9, %13, %7, %14, %15 op_sel_hi:[0,0,0]" \
            : "+v"(acc[ai][bj][0][0]), "+v"(acc[ai][bj][0][1]), "+v"(acc[ai][bj][1][0]), "+v"(acc[ai][bj][1][1]), "+v"(acc[ai][bj][2][0]), "+v"(acc[ai][bj][2][1]), "+v"(acc[ai][bj][3][0]), "+v"(acc[ai][bj][3][1]) \
            : "v"(Bt##8[0]), "v"(Bt##8[1]), "v"(At##8[0]), "v"(At##8[1]), "v"(At##8[2]), "v"(At##8[3]), "v"(scw_), "v"(sca_)); } \
        else { _Pragma("unroll") for (int m = 0; m < 4; ++m) _Pragma("unroll") for (int n = 0; n < 2; ++n) _Pragma("unroll") for (int k = 0; k < 2; ++k) \
            acc[ai][bj][m][n] = __builtin_amdgcn_mfma_f32_16x16x32_bf16(Bt[n][k], At[m][k], acc[ai][bj][m][n], 0, 0, 0); } __builtin_amdgcn_s_setprio(0); } while (0)
#define PG8_WAIT_V(n) asm volatile("s_waitcnt vmcnt(" #n ")" ::: "memory")
#define PG8_WAIT_L(n) asm volatile("s_waitcnt lgkmcnt(" #n ")" ::: "memory")
#define PG8_BAR __builtin_amdgcn_s_barrier()
#define PG8_SCHED __builtin_amdgcn_sched_barrier(0)
#define PG8_AOFF(dst, u_, ui_) do { _Pragma("unroll") for (int _h = 0; _h < 2; ++_h) _Pragma("unroll") for (int _i = 0; _i < 2; ++_i) { \
        if constexpr (GATHER) dst[_h][_i] = (unsigned)(rowtab[(ui_) * 256 + _h * HALF + _i * 64 + R0] * (unsigned)(K * ESZ) + (unsigned)(C0 * 2)); \
        else dst[_h][_i] = (unsigned)((_h * HALF + _i * 64 + R0) * K * ESZ + C0 * 2); } } while (0)
    Unit cur, nxt; int ui = 0;
    if (!S.next(0, cur)) return;
    f32x4 acc[2][2][4][2];
#pragma unroll
    for (int a = 0; a < 2; ++a)
#pragma unroll
        for (int b = 0; b < 2; ++b)
#pragma unroll
            for (int m = 0; m < 4; ++m)
#pragma unroll
                for (int n = 0; n < 2; ++n) acc[a][b][m][n] = (f32x4){0.f, 0.f, 0.f, 0.f};
    bf16x8 At[4][2], B0[2][2], B1[2][2]; v8i At8[4], B08[2], B18[2]; const int scw_ = P::SCW, sca_ = P::SCA;
    unsigned vAc[2][2], vAn[2][2];
    PG8_AOFF(vAc, cur, 0);
    const char* cA = S.aptr(cur); const char* cB = S.bptr(cur);
    if constexpr (SP2) {
        PG8_STAGE(PG8_SB(0, 0), cB, voffB); PG8_STAGE(PG8_SB(0, 1), cB + hstep, voffB); PG8_STAGE(PG8_SA(0, 0), cA, vAc[0]); PG8_STAGE(PG8_SA(0, 1), cA, vAc[1]);
        if (wr == 1) PG8_BAR;
        PG8_WAIT_V(2); PG8_BAR;
        PG8_STAGE(PG8_SB(1, 0), cB + kstep, voffB); PG8_STAGE(PG8_SA(1, 0), cA + kstep, vAc[0]); PG8_STAGE(PG8_SB(1, 1), cB + hstep + kstep, voffB);
        PG8_WAIT_V(6); PG8_BAR;
    } else {
        PG8_STAGE(PG8_SB(0, 0), cB, voffB); PG8_STAGE(PG8_SA(0, 0), cA, vAc[0]); PG8_STAGE(PG8_SB(0, 1), cB + hstep, voffB); PG8_STAGE(PG8_SA(0, 1), cA, vAc[1]);
        if (wr == 1) PG8_BAR;
        PG8_WAIT_V(4); PG8_BAR;
        PG8_STAGE(PG8_SB(1, 0), cB + kstep, voffB); PG8_STAGE(PG8_SA(1, 0), cA + kstep, vAc[0]); PG8_STAGE(PG8_SB(1, 1), cB + hstep + kstep, voffB);
        PG8_WAIT_V(6); PG8_BAR;
    }
    for (;;) {
        const bool has_next = S.next(ui + 1, nxt);
        const char* nA = has_next ? S.aptr(nxt) : cA; const char* nB = has_next ? S.bptr(nxt) : cB;
        if (has_next) { PG8_AOFF(vAn, nxt, ui + 1); }
        else {
#pragma unroll
            for (int h = 0; h < 2; ++h)
#pragma unroll
                for (int i = 0; i < 2; ++i) vAn[h][i] = vAc[h][i];
        }
        for (int t = 0; t < nt; t += 2) {
            const bool last = (t == nt - 2);
            const char* a1 = cA + (size_t)(t + 1) * kstep;
            const char* a2 = last ? nA : cA + (size_t)(t + 2) * kstep; const char* b2 = last ? nB : cB + (size_t)(t + 2) * kstep;
            const char* a3 = a2 + kstep; const char* b3 = b2 + kstep;
            unsigned w2[2][2];
#pragma unroll
            for (int h = 0; h < 2; ++h)
#pragma unroll
                for (int i = 0; i < 2; ++i) w2[h][i] = last ? vAn[h][i] : vAc[h][i];
            if constexpr (SP2) {
            PG8_LDB(B0, 0, 0); PG8_LDB(B1, 0, 1); PG8_SCHED; PG8_LDA(At, 0, 0); PG8_STAGE(PG8_SA(1, 1), a1, vAc[1]);
            PG8_WAIT_V(8); PG8_WAIT_L(0); PG8_BAR; PG8_MMA(0, 0, At, B0); PG8_MMA(0, 1, At, B1); PG8_BAR; PG8_SCHED;
            PG8_LDA(At, 0, 1); PG8_STAGE(PG8_SB(0, 0), b2, voffB); PG8_STAGE(PG8_SB(0, 1), b2 + hstep, voffB); PG8_STAGE(PG8_SA(0, 0), a2, w2[0]);
            PG8_WAIT_V(8); PG8_WAIT_L(0); PG8_BAR; PG8_MMA(1, 0, At, B0); PG8_MMA(1, 1, At, B1); PG8_BAR; PG8_SCHED;
            PG8_LDB(B0, 1, 0); PG8_LDB(B1, 1, 1); PG8_SCHED; PG8_LDA(At, 1, 0); PG8_STAGE(PG8_SA(0, 1), a2, w2[1]);
            PG8_WAIT_V(8); PG8_WAIT_L(0); PG8_BAR; PG8_MMA(0, 0, At, B0); PG8_MMA(0, 1, At, B1); PG8_BAR; PG8_SCHED;
            PG8_LDA(At, 1, 1); PG8_STAGE(PG8_SB(1, 0), b3, voffB); PG8_STAGE(PG8_SB(1, 1), b3 + hstep, voffB); PG8_STAGE(PG8_SA(1, 0), a3, w2[0]);
            PG8_WAIT_V(8); PG8_WAIT_L(0); PG8_BAR; PG8_MMA(1, 0, At, B0); PG8_MMA(1, 1, At, B1); PG8_BAR; PG8_SCHED;
            } else {
            PG8_LDB(B0, 0, 0); PG8_SCHED; PG8_LDA(At, 0, 0); PG8_STAGE(PG8_SA(1, 1), a1, vAc[1]);
            PG8_WAIT_L(8); PG8_BAR; PG8_WAIT_L(0); PG8_MMA(0, 0, At, B0); PG8_BAR; PG8_SCHED;
            PG8_LDB(B1, 0, 1); PG8_STAGE(PG8_SB(0, 0), b2, voffB);
            PG8_BAR; PG8_WAIT_L(0); PG8_MMA(0, 1, At, B1); PG8_BAR;
            PG8_LDA(At, 0, 1); PG8_STAGE(PG8_SA(0, 0), a2, w2[0]);
            PG8_BAR; PG8_WAIT_L(0); PG8_MMA(1, 0, At, B0); PG8_BAR; PG8_SCHED;
            PG8_STAGE(PG8_SB(0, 1), b2 + hstep, voffB);
            PG8_WAIT_V(6); PG8_BAR; PG8_MMA(1, 1, At, B1); PG8_BAR;
            PG8_LDB(B0, 1, 0); PG8_SCHED; PG8_LDA(At, 1, 0); PG8_STAGE(PG8_SA(0, 1), a2, w2[1]);
            PG8_WAIT_L(8); PG8_BAR; PG8_WAIT_L(0); PG8_MMA(0, 0, At, B0); PG8_BAR; PG8_SCHED;
            PG8_LDB(B1, 1, 1); PG8_STAGE(PG8_SB(1, 0), b3, voffB);
            PG8_BAR; PG8_WAIT_L(0); PG8_MMA(0, 1, At, B1); PG8_BAR;
            PG8_LDA(At, 1, 1); PG8_STAGE(PG8_SA(1, 0), a3, w2[0]);
            PG8_BAR; PG8_WAIT_L(0); PG8_MMA(1, 0, At, B0); PG8_BAR; PG8_SCHED;
            PG8_STAGE(PG8_SB(1, 1), b3 + hstep, voffB);
            PG8_WAIT_V(6); PG8_BAR; PG8_MMA(1, 1, At, B1); PG8_BAR;
            }
        }
        if constexpr (ALIGN_EPI) { if (wr == 0) PG8_BAR; }
        if constexpr (F8) asm volatile("s_nop 15\n\ts_nop 7" ::: "memory");
        { int fr2 = fr, fq2 = fq; asm volatile("" : "+v"(fr2), "+v"(fq2));
          S.epi(acc, cur, wr, wc, fr2, fq2); }
        if (!has_next) break;
#pragma unroll
        for (int a = 0; a < 2; ++a)
#pragma unroll
            for (int b = 0; b < 2; ++b)
#pragma unroll
                for (int m = 0; m < 4; ++m)
#pragma unroll
                    for (int n = 0; n < 2; ++n) acc[a][b][m][n] = (f32x4){0.f, 0.f, 0.f, 0.f};
        cur = nxt; cA = nA; cB = nB; ++ui;
#pragma unroll
        for (int h = 0; h < 2; ++h)
#pragma unroll
            for (int i = 0; i < 2; ++i) vAc[h][i] = vAn[h][i];
        if constexpr (ALIGN_EPI) { if (wr == 1) PG8_BAR; }
    }
    PG8_WAIT_V(0);
    if constexpr (!ALIGN_EPI) { if (wr == 0) PG8_BAR; }
    PG8_BAR;
#undef PG8_SA
#undef PG8_SB
#undef PG8_STAGE
#undef PG8_LDA
#undef PG8_LDB
#undef PG8_MMA
#undef PG8_WAIT_V
#undef PG8_WAIT_L
#undef PG8_BAR
#undef PG8_SCHED
#undef PG8_AOFF
}
}

namespace attn_body {
using bf16 = __hip_bfloat16;
using bf16x8 = __attribute__((ext_vector_type(8))) short;
using s16x4 = __attribute__((ext_vector_type(4))) short;
using f32x16 = __attribute__((ext_vector_type(16))) float;
using u32x4 = __attribute__((ext_vector_type(4))) unsigned;
constexpr int D = 64, QPITCH = NHQ * D, KPITCH = NHKV * D, OPITCH = DM, OCOL0 = 256;
constexpr int NW = 8, QBLK = 32, QB = QBLK * NW, KVBLK = 64, NQB = NTOK / QB, NT = NKEYS / KVBLK;
static_assert(NT % 2 == 0 && NT >= 8, "tile count");
__device__ __forceinline__ int crow(int r, int hi) { return (r & 3) + 8 * (r >> 2) + 4 * hi; }
#define SBAR() __builtin_amdgcn_sched_barrier(0)
constexpr int NSLOT = 3, SLOTB = 8192;
constexpr int LDS_K = 0, LDS_V = NSLOT * SLOTB, LDS_WS = 2 * NSLOT * SLOTB, LDS_OST = LDS_WS + NW * 64 * 4, LDS_BYTES = LDS_OST + NW * 4096;
constexpr float C2 = 0.125f * 1.4426950408889634f;
__device__ __forceinline__ void glds16(const void* gsrc, unsigned lds_dst) { unsigned keep;
  asm volatile("s_mov_b32 %0, m0\n\ts_mov_b32 m0, %2\n\ts_nop 0\n\tglobal_load_lds_dwordx4 %1, off\n\ts_mov_b32 m0, %0" : "=&s"(keep) : "v"(gsrc), "s"(lds_dst) : "memory"); }
__device__ __forceinline__ float max3f(float a, float b, float c) { float r; asm("v_max3_f32 %0, %1, %2, %3" : "=v"(r) : "v"(a), "v"(b), "v"(c)); return r; }
__device__ __forceinline__ float max2f(float a, float b) { float r; asm("v_max_f32_e32 %0, %1, %2" : "=v"(r) : "v"(a), "v"(b)); return r; }
__device__ __forceinline__ float fadd_s(float a, float b) { float r; asm("v_add_f32_e32 %0, %1, %2" : "=v"(r) : "v"(a), "v"(b)); return r; }
__device__ __forceinline__ float fsub_s(float a, float b) { float r; asm("v_sub_f32_e32 %0, %1, %2" : "=v"(r) : "v"(a), "v"(b)); return r; }
typedef float f32x2_t __attribute__((ext_vector_type(2))); typedef __bf16 bf16x2_t __attribute__((ext_vector_type(2)));
__device__ __forceinline__ unsigned cvtpk_s(float lo, float hi) { f32x2_t v = {lo, hi}; bf16x2_t b = __builtin_convertvector(v, bf16x2_t); return __builtin_bit_cast(unsigned, b); }
#define WAIT_BAR(N) asm volatile("s_waitcnt vmcnt(" #N ") lgkmcnt(0)\n\ts_barrier" ::: "memory")

__device__ __forceinline__ void qkt(f32x16& p0, f32x16& p1, const char* Kslot, const bf16x8* qr, const f32x16& negm, int r32, int hi) {
  const char* kb = Kslot + hi * 1024 + r32 * 16;
  #pragma unroll
  for (int d0 = 0; d0 < 4; ++d0) {
    const bf16x8 b0 = *reinterpret_cast<const bf16x8*>(kb + d0 * 2048);
    const bf16x8 b1 = *reinterpret_cast<const bf16x8*>(kb + d0 * 2048 + 512);
    if (d0 == 0) { p0 = __builtin_amdgcn_mfma_f32_32x32x16_bf16(b0, qr[0], negm, 0, 0, 0); p1 = __builtin_amdgcn_mfma_f32_32x32x16_bf16(b1, qr[0], negm, 0, 0, 0); }
    else { p0 = __builtin_amdgcn_mfma_f32_32x32x16_bf16(b0, qr[d0], p0, 0, 0, 0); p1 = __builtin_amdgcn_mfma_f32_32x32x16_bf16(b1, qr[d0], p1, 0, 0, 0); } }
}
typedef __attribute__((address_space(3))) const char* lds_cptr;
typedef short v4i16_t __attribute__((ext_vector_type(4)));
__device__ __forceinline__ void kload8(bf16x8* kf, lds_cptr kp) {
  kf[0] = *(const __attribute__((address_space(3))) bf16x8*)(kp);        kf[1] = *(const __attribute__((address_space(3))) bf16x8*)(kp + 512);
  kf[2] = *(const __attribute__((address_space(3))) bf16x8*)(kp + 2048); kf[3] = *(const __attribute__((address_space(3))) bf16x8*)(kp + 2560);
  kf[4] = *(const __attribute__((address_space(3))) bf16x8*)(kp + 4096); kf[5] = *(const __attribute__((address_space(3))) bf16x8*)(kp + 4608);
  kf[6] = *(const __attribute__((address_space(3))) bf16x8*)(kp + 6144); kf[7] = *(const __attribute__((address_space(3))) bf16x8*)(kp + 6656);
}
__device__ __forceinline__ void kload2(bf16x8* kf, lds_cptr kp, int j) { kf[2 * j] = *(const __attribute__((address_space(3))) bf16x8*)(kp + j * 2048); kf[2 * j + 1] = *(const __attribute__((address_space(3))) bf16x8*)(kp + j * 2048 + 512); }
__device__ __forceinline__ s16x4 vtr(lds_cptr p) { return __builtin_bit_cast(s16x4, __builtin_amdgcn_ds_read_tr16_b64_v4i16((__attribute__((address_space(3))) v4i16_t*)p)); }
__device__ __forceinline__ float rowmax(const f32x16& p0, const f32x16& p1) {
  float a = max3f(p0[0], p0[1], p1[0]), b = max3f(p0[2], p0[3], p1[1]); a = max3f(a, p1[2], p1[3]);
  #pragma unroll
  for (int r = 4; r < 16; r += 4) { a = max3f(a, p0[r], p0[r + 1]); b = max3f(b, p0[r + 2], p0[r + 3]); a = max3f(a, p1[r], p1[r + 1]); b = max3f(b, p1[r + 2], p1[r + 3]); }
  const float m = max2f(a, b);
  auto rr = __builtin_amdgcn_permlane32_swap(__float_as_uint(m), __float_as_uint(m), false, false);
  return max2f(__uint_as_float(rr[0]), __uint_as_float(rr[1]));
}
__device__ __forceinline__ void pv(f32x16* o, int vb, bf16x8 pa0, bf16x8 pa1, bf16x8 pa2, bf16x8 pa3) {
  #pragma unroll
  for (int d0 = 0; d0 < 2; ++d0) { s16x4 lo[4], hi[4];
    #pragma unroll
    for (int ks = 0; ks < 4; ++ks) {
      asm volatile("ds_read_b64_tr_b16 %0,%1 offset:%c2" : "=&v"(lo[ks]) : "v"(vb), "i"(d0 * 4096 + ks * 1024) : "memory");
      asm volatile("ds_read_b64_tr_b16 %0,%1 offset:%c2" : "=&v"(hi[ks]) : "v"(vb), "i"(d0 * 4096 + ks * 1024 + 512) : "memory"); }
    asm volatile("s_waitcnt lgkmcnt(0)" ::: "memory"); SBAR();
    #define PK(k) (bf16x8){lo[k][0], lo[k][1], lo[k][2], lo[k][3], hi[k][0], hi[k][1], hi[k][2], hi[k][3]}
    o[d0] = __builtin_amdgcn_mfma_f32_32x32x16_bf16(pa0, PK(0), o[d0], 0, 0, 0);
    o[d0] = __builtin_amdgcn_mfma_f32_32x32x16_bf16(pa1, PK(1), o[d0], 0, 0, 0);
    o[d0] = __builtin_amdgcn_mfma_f32_32x32x16_bf16(pa2, PK(2), o[d0], 0, 0, 0);
    o[d0] = __builtin_amdgcn_mfma_f32_32x32x16_bf16(pa3, PK(3), o[d0], 0, 0, 0);
    #undef PK
  }
}
#define ATTN_STORE16(p, v) (*(u32x4*)(p) = (v))
template <int THRL> __device__ __forceinline__ void attn_unit(int h, int kvh, int qb, const bf16* Q, const bf16* __restrict__ K, const bf16* __restrict__ V, bf16* O, char* shm, int wid, float kmax2) {
  const int lane = fresh_lane(), r32 = lane & 31, hi = lane >> 5;
  const int q0 = qb * QB;
  const bf16* Qw = Q + (long)(q0 + wid * QBLK) * QPITCH + h * D;
  const bf16* Kh = K + kvh * D, *Vh = V + kvh * D;
  const unsigned lds0 = (unsigned)(uintptr_t)shm;
  float* wsf = (float*)(shm + LDS_WS) + wid * 64;
  const bf16* ksrc = Kh + (long)lane * KPITCH + wid * 8;
  const bf16* vsrc = Vh + (long)(16 * (wid & 3) + (lane >> 2)) * KPITCH + (wid >> 2) * 32 + (lane & 3) * 8;
  const unsigned kdst = lds0 + LDS_K + wid * 1024, vdst = lds0 + LDS_V + wid * 1024;
  #define DMA_K(t, slot) glds16(ksrc + (long)(t) * KVBLK * KPITCH, (unsigned)__builtin_amdgcn_readfirstlane(kdst + (slot)))
  #define DMA_V(t, slot) glds16(vsrc + (long)(t) * KVBLK * KPITCH, (unsigned)__builtin_amdgcn_readfirstlane(vdst + (slot)))
  const int vb0 = (int)(lds0 + LDS_V) + ((lane >> 4) & 1) * 32 + (lane & 3) * 8 + (4 * hi + ((lane & 15) >> 2)) * 64;
  const char* Kbase = shm + LDS_K; bf16x8 kf[8];
  const lds_cptr shm3 = (lds_cptr)shm; const lds_cptr kp0 = shm3 + LDS_K + hi * 1024 + r32 * 16; const lds_cptr vp0 = shm3 + LDS_V + ((lane >> 4) & 1) * 32 + (lane & 3) * 8 + (4 * hi + ((lane & 15) >> 2)) * 64;
  DMA_K(0, 0); DMA_V(0, 0); DMA_K(1, SLOTB);
  bf16x8 qr[4];
  #pragma unroll
  for (int d0 = 0; d0 < 4; ++d0) qr[d0] = *reinterpret_cast<const bf16x8*>(&Qw[(long)r32 * QPITCH + d0 * 16 + hi * 8]);
  float l_reg = 0.f; f32x16 o[2]; o[0] = f32x16{}; o[1] = f32x16{}; f32x16 negm;
  { float qn2 = 0.f;
    #pragma unroll
    for (int d0 = 0; d0 < 4; ++d0)
      #pragma unroll
      for (int j = 0; j < 8; ++j) { const float f = __uint_as_float((unsigned)(unsigned short)qr[d0][j] << 16); qn2 += f * f; }
    auto rr = __builtin_amdgcn_permlane32_swap(__float_as_uint(qn2), __float_as_uint(qn2), false, false); qn2 = __uint_as_float(rr[0]) + __uint_as_float(rr[1]);
    const float bnd = sqrtf(qn2 * kmax2) * 1.004f + 0.01f;
    #pragma unroll
    for (int r = 0; r < 16; ++r) negm[r] = -bnd;
    asm volatile("" : "+v"(negm)); }
  f32x16 pA0, pA1, pB0, pB1;
  int sl_prev = 0, sl_cur = 0, sl_next = SLOTB;
  #define ROT() do { sl_prev = sl_cur; sl_cur = sl_next; sl_next = (sl_next == (NSLOT - 1) * SLOTB) ? 0 : sl_next + SLOTB; } while (0)
  DMA_K(2, 2 * SLOTB);
  WAIT_BAR(3);
  qkt(pA0, pA1, Kbase, qr, negm, r32, hi); asm volatile("s_nop 15\n\ts_nop 7" : "+v"(pA0), "+v"(pA1));
  _Pragma("unroll") for (int r = 0; r < 16; ++r) { pA0[r] = __builtin_amdgcn_exp2f(pA0[r]); pA1[r] = __builtin_amdgcn_exp2f(pA1[r]); }
  WAIT_BAR(0);
  DMA_K(3, 0); DMA_V(1, SLOTB);
  ROT();
  kload8(kf, kp0 + sl_cur);
  WAIT_BAR(2);
  s16x4 vlo[8], vhi[8]; u32x4 pw0, pw1, pw2, pw3;
  #define PKW(P, B) cvtpk_s(P[B], P[B + 1])
  #define PAF(k) __builtin_bit_cast(bf16x8, pw##k)
  #define VFR(i) (bf16x8){vlo[i][0], vlo[i][1], vlo[i][2], vlo[i][3], vhi[i][0], vhi[i][1], vhi[i][2], vhi[i][3]}
  #define PIN(x) asm volatile("" : "+v"(x))
  #define MX3(a, b, c) __builtin_fmaxf(__builtin_fmaxf((a), (b)), (c))
  #define GAPA(MF, A0, A1, A2, A3, W0, W1, PW) do { MF; sacc += A0; sacc += A1; sacc += A2; sacc += A3; PIN(sacc); W0; W1; PIN(PW); SBAR(); } while (0)
  #define EX(v) __builtin_amdgcn_exp2f(v)
  #define GAPB(MF, X, B) do { MF; X[B] = EX(X[B]); X[B + 1] = EX(X[B + 1]); X[B + 2] = EX(X[B + 2]); X[B + 3] = EX(X[B + 3]); PIN(X); SBAR(); } while (0)
  #define VRD(i) do { vlo[i] = vtr(vp_ + (((i) >> 2) * 4096 + ((i) & 3) * 1024)); vhi[i] = vtr(vp_ + (((i) >> 2) * 4096 + ((i) & 3) * 1024 + 512)); } while (0)
  #define KRD(G, j) do { if (G) { kload2(kf, kp0 + sl_next, j); SBAR(); } } while (0)
  #define STEPM(C0, C1, P0, P1, t, GK, GV, GL) do { SBAR(); \
    const lds_cptr vp_ = vp0 + sl_prev; \
    VRD(0); SBAR(); float sacc = (P0[0] + P0[1]); \
    GAPA(C0 = __builtin_amdgcn_mfma_f32_32x32x16_bf16(kf[0], qr[0], negm, 0, 0, 0), P0[2], P0[3], P0[4], P0[5],     pw0[0] = PKW(P0, 0), pw0[1] = PKW(P0, 2), pw0); \
    VRD(4); SBAR(); GAPA(C1 = __builtin_amdgcn_mfma_f32_32x32x16_bf16(kf[1], qr[0], negm, 0, 0, 0), P0[6], P0[7], P0[8], P0[9],     pw0[2] = PKW(P0, 4), pw0[3] = PKW(P0, 6), pw0); \
    VRD(1); SBAR(); GAPA(C0 = __builtin_amdgcn_mfma_f32_32x32x16_bf16(kf[2], qr[1], C0, 0, 0, 0),   P0[10], P0[11], P0[12], P0[13], pw1[0] = PKW(P0, 8), pw1[1] = PKW(P0, 10), pw1); \
    VRD(5); SBAR(); GAPA(C1 = __builtin_amdgcn_mfma_f32_32x32x16_bf16(kf[3], qr[1], C1, 0, 0, 0),   P0[14], P0[15], P1[0], P1[1],   pw1[2] = PKW(P0, 12), pw1[3] = PKW(P0, 14), pw1); \
    VRD(2); SBAR(); GAPA(C0 = __builtin_amdgcn_mfma_f32_32x32x16_bf16(kf[4], qr[2], C0, 0, 0, 0),   P1[2], P1[3], P1[4], P1[5],     pw2[0] = PKW(P1, 0), pw2[1] = PKW(P1, 2), pw2); \
    VRD(6); SBAR(); GAPA(C1 = __builtin_amdgcn_mfma_f32_32x32x16_bf16(kf[5], qr[2], C1, 0, 0, 0),   P1[6], P1[7], P1[8], P1[9],     pw2[2] = PKW(P1, 4), pw2[3] = PKW(P1, 6), pw2); \
    VRD(3); SBAR(); GAPA(C0 = __builtin_amdgcn_mfma_f32_32x32x16_bf16(kf[6], qr[3], C0, 0, 0, 0),   P1[10], P1[11], P1[12], P1[13], pw3[0] = PKW(P1, 8), pw3[1] = PKW(P1, 10), pw3); \
    VRD(7); SBAR(); GAPA(C1 = __builtin_amdgcn_mfma_f32_32x32x16_bf16(kf[7], qr[3], C1, 0, 0, 0),   P1[14], P1[15], 0.f, 0.f,       pw3[2] = PKW(P1, 12), pw3[3] = PKW(P1, 14), pw3); \
    l_reg += sacc; \
    if (GK) { DMA_K((t) + 3, sl_cur); } if (GV) { DMA_V((t) + 1, sl_next); } \
    SBAR(); \
    GAPB(o[0] = __builtin_amdgcn_mfma_f32_32x32x16_bf16(PAF(0), VFR(0), o[0], 0, 0, 0), C0, 0); \
    GAPB(o[1] = __builtin_amdgcn_mfma_f32_32x32x16_bf16(PAF(0), VFR(4), o[1], 0, 0, 0), C0, 4); \
    KRD(GL, 0); GAPB(o[0] = __builtin_amdgcn_mfma_f32_32x32x16_bf16(PAF(1), VFR(1), o[0], 0, 0, 0), C0, 8); \
    KRD(GL, 1); GAPB(o[1] = __builtin_amdgcn_mfma_f32_32x32x16_bf16(PAF(1), VFR(5), o[1], 0, 0, 0), C0, 12); \
    KRD(GL, 2); GAPB(o[0] = __builtin_amdgcn_mfma_f32_32x32x16_bf16(PAF(2), VFR(2), o[0], 0, 0, 0), C1, 0); \
    KRD(GL, 3); GAPB(o[1] = __builtin_amdgcn_mfma_f32_32x32x16_bf16(PAF(2), VFR(6), o[1], 0, 0, 0), C1, 4); \
    GAPB(o[0] = __builtin_amdgcn_mfma_f32_32x32x16_bf16(PAF(3), VFR(3), o[0], 0, 0, 0), C1, 8); \
    GAPB(o[1] = __builtin_amdgcn_mfma_f32_32x32x16_bf16(PAF(3), VFR(7), o[1], 0, 0, 0), C1, 12); \
    } while (0)
  int t = 1;
  for (; t + 5 < NT; t += 2) {
    STEPM(pB0, pB1, pA0, pA1, t, true, true, true);     WAIT_BAR(2); ROT();
    STEPM(pA0, pA1, pB0, pB1, t + 1, true, true, true); WAIT_BAR(2); ROT();
  }
  #define ENDW(tt) do { if ((tt) + 3 < NT) { WAIT_BAR(2); } else if ((tt) + 2 < NT) { WAIT_BAR(1); } else { WAIT_BAR(0); } } while (0)
  for (; t + 1 < NT; t += 2) {
    STEPM(pB0, pB1, pA0, pA1, t, (t + 3 < NT), (t + 1 < NT), (t + 1 < NT));         ENDW(t);     ROT();
    STEPM(pA0, pA1, pB0, pB1, t + 1, (t + 4 < NT), (t + 2 < NT), (t + 2 < NT));     ENDW(t + 1); ROT();
  }
  STEPM(pB0, pB1, pA0, pA1, NT - 1, false, false, false);
  { float sacc = pB0[0] + pB0[1]; _Pragma("unroll") for (int r = 2; r < 16; ++r) sacc += pB0[r]; _Pragma("unroll") for (int r = 0; r < 16; ++r) sacc += pB1[r]; l_reg += sacc;
    pw0 = (u32x4){PKW(pB0, 0), PKW(pB0, 2), PKW(pB0, 4), PKW(pB0, 6)}; pw1 = (u32x4){PKW(pB0, 8), PKW(pB0, 10), PKW(pB0, 12), PKW(pB0, 14)}; pw2 = (u32x4){PKW(pB1, 0), PKW(pB1, 2), PKW(pB1, 4), PKW(pB1, 6)}; pw3 = (u32x4){PKW(pB1, 8), PKW(pB1, 10), PKW(pB1, 12), PKW(pB1, 14)};
    SBAR(); pv(o, vb0 + sl_cur, PAF(0), PAF(1), PAF(2), PAF(3)); }
  #undef PKW
  #undef PAF
  #undef VFR
  #undef PIN
  #undef MX3
  #undef GAPA
  #undef GAPB
  #undef EX
  #undef VRD
  #undef KRD
  #undef STEPM
  #undef ENDW
  { auto rr = __builtin_amdgcn_permlane32_swap(__float_as_uint(l_reg), __float_as_uint(l_reg), false, false); l_reg = __uint_as_float(rr[0]) + __uint_as_float(rr[1]); }
  if (hi == 0) wsf[32 + r32] = l_reg; asm volatile("s_waitcnt lgkmcnt(0)" ::: "memory");
  float rli[16];
  #pragma unroll
  for (int r = 0; r < 16; ++r) rli[r] = __builtin_amdgcn_rcpf(wsf[32 + crow(r, hi)]);
  bf16* Ow = O + (long)(q0 + wid * QBLK) * OPITCH + OCOL0 + h * D;
  { bf16* stg = (bf16*)(shm + LDS_OST) + wid * 2048;
    #pragma unroll
    for (int r = 0; r < 16; ++r) { const int orow = crow(r, hi);
      #pragma unroll
      for (int d0 = 0; d0 < 2; ++d0) stg[orow * 64 + d0 * 32 + r32] = __float2bfloat16(o[d0][r] * rli[r]); }
    asm volatile("s_waitcnt lgkmcnt(0)" ::: "memory");
    #pragma unroll
    for (int i = 0; i < 4; ++i) { const int row = i * 8 + (lane >> 3), ch = lane & 7; const u32x4 v = *(const u32x4*)(stg + row * 64 + ch * 8); ATTN_STORE16(Ow + (long)row * OPITCH + ch * 8, v); } }
  asm volatile("s_waitcnt lgkmcnt(0)\n\ts_barrier" ::: "memory");
  #undef DMA_K
  #undef DMA_V
  #undef ROT
}
#undef SBAR
#undef WAIT_BAR

typedef int v8i_t __attribute__((ext_vector_type(8)));
constexpr int F8_SLOT = 4096, F8_LDS_K = 0, F8_LDS_V = 3 * F8_SLOT, F8_LDS_WS = 6 * F8_SLOT, F8_LDS_OST = F8_LDS_WS + NW * 64 * 4, F8_LDS_BYTES = F8_LDS_OST + NW * 4096;
#define SBAR() __builtin_amdgcn_sched_barrier(0)
#define WAIT_BAR(N) asm volatile("s_waitcnt vmcnt(" #N ") lgkmcnt(0)\n\ts_barrier" ::: "memory")
#define MFMA8_C(D, A, B, C, SA, SB) do { if (VAR & 64) { D = __builtin_amdgcn_mfma_f32_32x32x16_bf16(__builtin_bit_cast(bf16x8, (u32x4){(unsigned)A[0], (unsigned)A[1], (unsigned)A[2], (unsigned)A[3]}), __builtin_bit_cast(bf16x8, (u32x4){(unsigned)B[0], (unsigned)B[1], (unsigned)B[2], (unsigned)B[3]}), C, 0, 0, 0); \
      D = __builtin_amdgcn_mfma_f32_32x32x16_bf16(__builtin_bit_cast(bf16x8, (u32x4){(unsigned)A[4], (unsigned)A[5], (unsigned)A[6], (unsigned)A[7]}), __builtin_bit_cast(bf16x8, (u32x4){(unsigned)B[4], (unsigned)B[5], (unsigned)B[6], (unsigned)B[7]}), D, 0, 0, 0); } \
    else { asm volatile("s_nop 1\n\tv_mfma_scale_f32_32x32x64_f8f6f4 %0, %1, %2, %3, %4, %5 op_sel_hi:[0,0,0]" : "=&v"(D) : "v"(A), "v"(B), "v"(C), "v"(SA), "v"(SB)); \
      if (VAR & 256) asm volatile("s_nop 1\n\tv_mfma_scale_f32_32x32x64_f8f6f4 %0, %1, %2, %0, %3, %4 op_sel_hi:[0,0,0]" : "+v"(dacc) : "v"(A), "v"(B), "v"(SA), "v"(SB)); } } while (0)
#define MFMA8_ACC(D, A, B, SA, SB) do { if (VAR & 64) { D = __builtin_amdgcn_mfma_f32_32x32x16_bf16(__builtin_bit_cast(bf16x8, (u32x4){(unsigned)A[0], (unsigned)A[1], (unsigned)A[2], (unsigned)A[3]}), __builtin_bit_cast(bf16x8, (u32x4){(unsigned)B[0], (unsigned)B[1], (unsigned)B[2], (unsigned)B[3]}), D, 0, 0, 0); \
      D = __builtin_amdgcn_mfma_f32_32x32x16_bf16(__builtin_bit_cast(bf16x8, (u32x4){(unsigned)A[4], (unsigned)A[5], (unsigned)A[6], (unsigned)A[7]}), __builtin_bit_cast(bf16x8, (u32x4){(unsigned)B[4], (unsigned)B[5], (unsigned)B[6], (unsigned)B[7]}), D, 0, 0, 0); } \
    else { asm volatile("s_nop 1\n\tv_mfma_scale_f32_32x32x64_f8f6f4 %0, %1, %2, %0, %3, %4 op_sel_hi:[0,0,0]" : "+v"(D) : "v"(A), "v"(B), "v"(SA), "v"(SB)); \
      if (VAR & 256) asm volatile("s_nop 1\n\tv_mfma_scale_f32_32x32x64_f8f6f4 %0, %1, %2, %0, %3, %4 op_sel_hi:[0,0,0]" : "+v"(dacc) : "v"(A), "v"(B), "v"(SA), "v"(SB)); } } while (0)
template <int DBL> __device__ __forceinline__ v8i_t lds_frag32x(lds_cptr p) { const u32x4 lo = *(const __attribute__((address_space(3))) u32x4*)p, hi = *(const __attribute__((address_space(3))) u32x4*)(p + 2048);
  if (DBL) { const u32x4 lo2 = *(const volatile __attribute__((address_space(3))) u32x4*)(p + 4096), hi2 = *(const volatile __attribute__((address_space(3))) u32x4*)(p + 4112); asm volatile("" :: "v"(lo2), "v"(hi2)); }
  return (v8i_t){(int)lo.x, (int)lo.y, (int)lo.z, (int)lo.w, (int)hi.x, (int)hi.y, (int)hi.z, (int)hi.w}; }
__device__ __forceinline__ v8i_t lds_frag32(lds_cptr p) { const u32x4 lo = *(const __attribute__((address_space(3))) u32x4*)p, hi = *(const __attribute__((address_space(3))) u32x4*)(p + 16);
  return (v8i_t){(int)lo.x, (int)lo.y, (int)lo.z, (int)lo.w, (int)hi.x, (int)hi.y, (int)hi.z, (int)hi.w}; }
__device__ __forceinline__ unsigned pk4f8(float a, float b, float c, float d) { int p = __builtin_amdgcn_cvt_pk_fp8_f32(a, b, 0, false); p = __builtin_amdgcn_cvt_pk_fp8_f32(c, d, p, true); return (unsigned)p; }
template <int VAR> __device__ __forceinline__ void attn_unit_f8(int h, int kvh, int qb, const unsigned char* Q8, const unsigned char* __restrict__ K8, const unsigned char* __restrict__ VT8, bf16* O, char* shm, int wid, float kmax2) {
  const int lane = fresh_lane(), r32 = lane & 31, hi = lane >> 5; const bool kwave = wid < 4;
  const int q0 = qb * QB;
  const unsigned lds0 = (unsigned)(uintptr_t)shm;
  float* wsf = (float*)(shm + F8_LDS_WS) + wid * 64;
  const int kpl = (wid & 3) >> 1, krow = 32 * (wid & 1) + (lane >> 1), khalf = (lane & 1) ^ ((krow >> 3) & 1), kch = 2 * khalf + kpl;
  const unsigned char* dsrc = kwave ? K8 + (size_t)krow * KPITCH + kvh * D + 16 * kch : VT8 + (size_t)kvh * (NT * 4096) + 1024 * (wid & 3) + 16 * lane;
  const long dstep = kwave ? (long)KVBLK * KPITCH : 4096;
  const unsigned ddst = lds0 + (kwave ? F8_LDS_K : F8_LDS_V) + (wid & 3) * 1024;
  #define DMA_T(t, slot) glds16(dsrc + (long)(t) * dstep, (unsigned)__builtin_amdgcn_readfirstlane(ddst + (slot)))
  const lds_cptr shm3 = (lds_cptr)shm;
  const lds_cptr kp0 = shm3 + F8_LDS_K + r32 * 32 + 16 * (hi ^ ((r32 >> 3) & 1));
  const lds_cptr vp0 = shm3 + F8_LDS_V + r32 * 32 + 16 * (hi ^ ((r32 >> 3) & 1));
  v8i_t qf;
  { const unsigned char* qp = Q8 + (size_t)(q0 + wid * QBLK + r32) * QPITCH + h * D + 32 * hi; const u32x4 lo = *(const u32x4*)qp, hi4 = *(const u32x4*)(qp + 16);
    qf = (v8i_t){(int)lo.x, (int)lo.y, (int)lo.z, (int)lo.w, (int)hi4.x, (int)hi4.y, (int)hi4.z, (int)hi4.w}; }
  DMA_T(0, 0); if (kwave) { DMA_T(1, F8_SLOT); DMA_T(2, 2 * F8_SLOT); }
  f32x16 lacc = f32x16{}; f32x16 o[2]; o[0] = f32x16{}; o[1] = f32x16{}; f32x16 negm;
  v8i_t ones8 = {0x38383838, 0x38383838, 0x38383838, 0x38383838, 0x38383838, 0x38383838, 0x38383838, 0x38383838}; asm volatile("" : "+v"(ones8));
  { float qn2 = 0.f;
    #pragma unroll
    for (int i = 0; i < 8; ++i) { const float f0 = __builtin_amdgcn_cvt_f32_fp8(qf[i], 0), f1 = __builtin_amdgcn_cvt_f32_fp8(qf[i], 1), f2 = __builtin_amdgcn_cvt_f32_fp8(qf[i], 2), f3 = __builtin_amdgcn_cvt_f32_fp8(qf[i], 3);
      qn2 += ((f0 * f0 + f1 * f1) + (f2 * f2 + f3 * f3)) * (1.f / 256.f); }
    auto rr = __builtin_amdgcn_permlane32_swap(__float_as_uint(qn2), __float_as_uint(qn2), false, false); qn2 = __uint_as_float(rr[0]) + __uint_as_float(rr[1]);
    const float bnd = sqrtf(qn2 * kmax2) * 1.004f + 0.01f;
    #pragma unroll
    for (int r = 0; r < 16; ++r) negm[r] = 8.f - bnd;
    asm volatile("" : "+v"(negm)); }
  int sQ = 0x7B7B7B7B, sONE = 0x7F7F7F7F; asm volatile("" : "+v"(sQ), "+v"(sONE));
  f32x16 dacc = f32x16{}; f32x16 pA0, pA1, pB0, pB1; v8i_t kf0, kf1, vfA0, vfA1, vfB0, vfB1, pwA = {0, 0, 0, 0, 0, 0, 0, 0}, pwB = {0, 0, 0, 0, 0, 0, 0, 0};
  int sl_prev = 0, sl_cur = 0, sl_next = F8_SLOT;
  #define ROT() do { sl_prev = sl_cur; sl_cur = sl_next; sl_next = (sl_next == 2 * F8_SLOT) ? 0 : sl_next + F8_SLOT; } while (0)
  #define PIN(x) asm volatile("" : "+v"(x))
  WAIT_BAR(0);
  kf0 = lds_frag32x<(VAR & 512) != 0>(kp0); kf1 = lds_frag32x<(VAR & 512) != 0>(kp0 + 1024);
  asm volatile("s_waitcnt lgkmcnt(0)" ::: "memory");
  MFMA8_C(pA0, kf0, qf, negm, sONE, sQ); MFMA8_C(pA1, kf1, qf, negm, sONE, sQ);
  asm volatile("s_nop 15\n\ts_nop 15\n\ts_nop 7" : "+v"(pA0), "+v"(pA1));
  #pragma unroll
  for (int r = 0; r < 16; ++r) pA0[r] = __builtin_amdgcn_exp2f(pA0[r]);
  WAIT_BAR(0);
  if (kwave) { DMA_T(3, 0); } else { DMA_T(1, F8_SLOT); }
  ROT();
  kf0 = lds_frag32x<(VAR & 512) != 0>(kp0 + sl_cur); kf1 = lds_frag32x<(VAR & 512) != 0>(kp0 + sl_cur + 1024);
  WAIT_BAR(1);
  #define CVT2(dst, a, b, c, d) do { if (VAR & 16) { asm volatile("" : "+v"(dst) : "v"(a), "v"(b), "v"(c), "v"(d)); } else { dst = __builtin_amdgcn_cvt_pk_fp8_f32(a, b, dst, false); dst = __builtin_amdgcn_cvt_pk_fp8_f32(c, d, dst, true); if (VAR & 32) { asm volatile("" : "+v"(dst)); dst = __builtin_amdgcn_cvt_pk_fp8_f32(a, b, dst, false); dst = __builtin_amdgcn_cvt_pk_fp8_f32(c, d, dst, true); } } } while (0)
  #define EXF(v) ((VAR & 1) ? (v) * 0.999f : ((VAR & 128) ? __builtin_amdgcn_exp2f(__builtin_amdgcn_exp2f(v) * 1e-30f) + __builtin_amdgcn_exp2f(v) - 1.0f : __builtin_amdgcn_exp2f(v)))
  #define EX4(X, B) do { X[B] = EXF(X[B]); X[B + 1] = EXF(X[B + 1]); X[B + 2] = EXF(X[B + 2]); X[B + 3] = EXF(X[B + 3]); } while (0)
  #define STEP8(C0, C1, P0, P1, PW, VF0, VF1, t, GK, GV, GL) do { SBAR(); \
    VF0 = lds_frag32x<(VAR & 512) != 0>(vp0 + sl_prev); VF1 = lds_frag32x<(VAR & 512) != 0>(vp0 + sl_prev + 1024); SBAR(); \
    if (VAR & 2) { C0 = negm; asm volatile("" : "+v"(C0) : "v"(kf0)); } else { MFMA8_C(C0, kf0, qf, negm, sONE, sQ); } SBAR(); \
    CVT2(PW[0], P0[0], P0[1], P0[2], P0[3]); CVT2(PW[1], P0[4], P0[5], P0[6], P0[7]); CVT2(PW[2], P0[8], P0[9], P0[10], P0[11]); CVT2(PW[3], P0[12], P0[13], P0[14], P0[15]); \
    EX4(P1, 0); EX4(P1, 4); PIN(PW); PIN(P1); SBAR(); \
    if (VAR & 2) { C1 = negm; asm volatile("" : "+v"(C1) : "v"(kf1)); } else { MFMA8_C(C1, kf1, qf, negm, sONE, sQ); } SBAR(); \
    EX4(P1, 8); EX4(P1, 12); \
    CVT2(PW[4], P1[0], P1[1], P1[2], P1[3]); CVT2(PW[5], P1[4], P1[5], P1[6], P1[7]); CVT2(PW[6], P1[8], P1[9], P1[10], P1[11]); CVT2(PW[7], P1[12], P1[13], P1[14], P1[15]); \
    PIN(PW); SBAR(); \
    if (kwave) { if (GK) { DMA_T((t) + 3, sl_cur); } } else { if (GV) { DMA_T((t) + 1, sl_next); } } \
    if (GL) { kf0 = lds_frag32x<(VAR & 512) != 0>(kp0 + sl_next); kf1 = lds_frag32x<(VAR & 512) != 0>(kp0 + sl_next + 1024); } SBAR(); \
    if (VAR & 2) { asm volatile("" : "+v"(lacc) : "v"(PW)); } else { MFMA8_ACC(lacc, PW, ones8, sONE, sONE); } asm volatile("" : "+v"(C0)); SBAR(); \
    EX4(C0, 0); EX4(C0, 4); PIN(C0); SBAR(); \
    if (VAR & 2) { asm volatile("" : "+v"(o[0]) : "v"(PW), "v"(VF0)); } else { MFMA8_ACC(o[0], PW, VF0, sONE, sONE); } SBAR(); \
    EX4(C0, 8); EX4(C0, 12); PIN(C0); SBAR(); \
    if (VAR & 2) { asm volatile("" : "+v"(o[1]) : "v"(PW), "v"(VF1)); } else { MFMA8_ACC(o[1], PW, VF1, sONE, sONE); } SBAR(); } while (0)
  int t = 1;
  #pragma unroll 1
  for (; t + 5 < NT; t += 2) {
    STEP8(pB0, pB1, pA0, pA1, pwA, vfA0, vfA1, t, true, true, true);     if (VAR & 4) { asm volatile("s_waitcnt vmcnt(1) lgkmcnt(0)" ::: "memory"); } else { WAIT_BAR(1); } ROT();
    STEP8(pA0, pA1, pB0, pB1, pwB, vfB0, vfB1, t + 1, true, true, true); if (VAR & 4) { asm volatile("s_waitcnt vmcnt(1) lgkmcnt(0)" ::: "memory"); } else { WAIT_BAR(1); } ROT();
  }
  for (; t + 1 < NT; t += 2) {
    STEP8(pB0, pB1, pA0, pA1, pwA, vfA0, vfA1, t, (t + 3 < NT), (t + 1 < NT), (t + 1 < NT));         WAIT_BAR(0); ROT();
    STEP8(pA0, pA1, pB0, pB1, pwB, vfB0, vfB1, t + 1, (t + 4 < NT), (t + 2 < NT), (t + 2 < NT));     WAIT_BAR(0); ROT();
  }
  STEP8(pB0, pB1, pA0, pA1, pwA, vfA0, vfA1, NT - 1, false, false, false);
  { asm volatile("s_nop 15\n\ts_nop 15\n\ts_nop 7" : "+v"(pB1));
    EX4(pB1, 0); EX4(pB1, 4); EX4(pB1, 8); EX4(pB1, 12);
    CVT2(pwB[0], pB0[0], pB0[1], pB0[2], pB0[3]); CVT2(pwB[1], pB0[4], pB0[5], pB0[6], pB0[7]); CVT2(pwB[2], pB0[8], pB0[9], pB0[10], pB0[11]); CVT2(pwB[3], pB0[12], pB0[13], pB0[14], pB0[15]);
    CVT2(pwB[4], pB1[0], pB1[1], pB1[2], pB1[3]); CVT2(pwB[5], pB1[4], pB1[5], pB1[6], pB1[7]); CVT2(pwB[6], pB1[8], pB1[9], pB1[10], pB1[11]); CVT2(pwB[7], pB1[12], pB1[13], pB1[14], pB1[15]);
    vfB0 = lds_frag32x<(VAR & 512) != 0>(vp0 + sl_cur); vfB1 = lds_frag32x<(VAR & 512) != 0>(vp0 + sl_cur + 1024);
    asm volatile("s_waitcnt lgkmcnt(0)" ::: "memory"); PIN(pwB); SBAR();
    MFMA8_ACC(o[0], pwB, vfB0, sONE, sONE); MFMA8_ACC(o[1], pwB, vfB1, sONE, sONE); MFMA8_ACC(lacc, pwB, ones8, sONE, sONE);
    asm volatile("s_nop 15\n\ts_nop 15\n\ts_nop 7" : "+v"(o[0]), "+v"(o[1]), "+v"(lacc)); }
  #undef STEP8
  #undef CVT2
  #undef EX4
  #undef EXF
  #undef PIN
  #undef ROT
  if (VAR & 256) asm volatile("" :: "v"(dacc));
  float rli[16];
  #pragma unroll
  for (int r = 0; r < 16; ++r) rli[r] = __builtin_amdgcn_rcpf(lacc[r]);
  bf16* Ow = O + (long)(q0 + wid * QBLK) * OPITCH + OCOL0 + h * D;
  { bf16* stg = (bf16*)(shm + F8_LDS_OST) + wid * 2048;
    #pragma unroll
    for (int r = 0; r < 16; ++r) { const int orow = crow(r, hi);
      #pragma unroll
      for (int d0 = 0; d0 < 2; ++d0) stg[orow * 64 + d0 * 32 + r32] = __float2bfloat16(o[d0][r] * rli[r]); }
    asm volatile("s_waitcnt lgkmcnt(0)" ::: "memory");
    #pragma unroll
    for (int i = 0; i < 4; ++i) { const int row = i * 8 + (lane >> 3), ch = lane & 7; const u32x4 v = *(const u32x4*)(stg + row * 64 + ch * 8); if (!(VAR & 8)) ATTN_STORE16(Ow + (long)row * OPITCH + ch * 8, v); } }
  asm volatile("s_waitcnt vmcnt(0) lgkmcnt(0)\n\ts_barrier" ::: "memory");
  #undef DMA_T
}
#undef MFMA8_C
#undef MFMA8_ACC
#undef SBAR
#undef WAIT_BAR
}

constexpr int NWAVES = 8, NTHR = NWAVES * 64;
constexpr size_t MiB = 1u << 20;
constexpr size_t WS_CTL = 0, CTL_ZERO_BYTES = 64 * 1024;
constexpr size_t WS_MOD = 1 * MiB;
constexpr size_t WS_MISC = WS_MOD + 64 * 1024;
constexpr size_t WS_IDX = WS_MISC, WS_GATE = WS_IDX + 128 * 1024, WS_TOKSLOT = WS_GATE + 128 * 1024;
constexpr size_t WS_AFF = 3 * MiB;
constexpr size_t WS_WIN = 4 * MiB;
constexpr size_t WS_WOUT = 7 * MiB;
constexpr size_t WS_WGU = 9 * MiB;
constexpr size_t WS_WD = 137 * MiB;
constexpr size_t WS_X1 = 201 * MiB;
constexpr size_t WS_R1 = 265 * MiB;
constexpr size_t WS_XN = WS_R1;
constexpr size_t WS_Q = WS_XN + (size_t)NROWS * DM * 2;
constexpr size_t WS_K = WS_Q + (size_t)NTOK * 768 * 2;
constexpr size_t WS_V = WS_K + (size_t)NROWS * 256 * 2;
constexpr size_t WS_FT = WS_V + (size_t)NROWS * 256 * 2;
constexpr size_t WS_MIX = WS_FT + (size_t)256 * NTOK * 4;
constexpr size_t WS_HID = WS_R1;
constexpr size_t WS_R2 = 393 * MiB;
constexpr size_t WS_H2 = WS_R2;
constexpr size_t WS_YE = WS_R2;
constexpr size_t WS_END = 457 * MiB;
static_assert(WS_MIX + (size_t)NTOK * DM * 2 <= WS_R1 + 128 * MiB, "R1 map");
static_assert(WS_TOKSLOT + (size_t)NTOK * 16 * 4 <= WS_AFF, "misc map");
constexpr int CW_TMO = 0, CW_FLAG = 2, CW_KMAX = 64, CW_BAR = 1024;

constexpr int LDS_BYTES = 163840;
constexpr int RING_BYTES = 131072, XTRA_OFF = RING_BYTES;
constexpr int MISC_OFF = LDS_BYTES - 512;

#define GAS __attribute__((address_space(1)))
#define LAS __attribute__((address_space(3)))
typedef unsigned short bf16;
typedef unsigned v4u __attribute__((ext_vector_type(4)));
typedef unsigned v2u __attribute__((ext_vector_type(2)));
typedef float f32x4 __attribute__((ext_vector_type(4)));
typedef float f32x2 __attribute__((ext_vector_type(2)));
typedef GAS unsigned gu32;
#define RLX_AGENT __ATOMIC_RELAXED, __HIP_MEMORY_SCOPE_AGENT
#define LDS_WAIT() asm volatile("s_waitcnt lgkmcnt(0)" ::: "memory")
#define VM_WAIT() asm volatile("s_waitcnt vmcnt(0)" ::: "memory")
__device__ __forceinline__ unsigned f2bf(float f) { unsigned u = __builtin_bit_cast(unsigned, f); return (u + 0x7fffu + ((u >> 16) & 1u)) >> 16; }
__device__ __forceinline__ unsigned pk2(float lo, float hi) { return f2bf(lo) | (f2bf(hi) << 16); }
__device__ __forceinline__ unsigned pk4_fp8(float a, float b, float c, float d) { int p = __builtin_amdgcn_cvt_pk_fp8_f32(a, b, 0, false); p = __builtin_amdgcn_cvt_pk_fp8_f32(c, d, p, true); return (unsigned)p; }
__device__ __forceinline__ float bf2f(unsigned short b) { return __builtin_bit_cast(float, (unsigned)b << 16); }

#define XB_TMO      128
#define XB_XCNT(j)  (256  + 64 * (j))
#define XB_XSUB(j)  (1280 + 64 * (j))
#define XB_XGEN(j)  (2304 + 64 * (j))
#define XB_TOP      3328
#define XB_TOPGEN   3392
#define XCD_BAR_WORDS 3456
#define XB_SPIN_CAP (1u << 20)
static_assert((CW_BAR + XCD_BAR_WORDS) * 4 <= (int)CTL_ZERO_BYTES, "ctl");
__device__ __forceinline__ unsigned xb_ld(unsigned* p)              { return __hip_atomic_load(p, __ATOMIC_RELAXED, __HIP_MEMORY_SCOPE_AGENT); }
__device__ __forceinline__ unsigned xb_add(unsigned* p, unsigned v) { return __hip_atomic_fetch_add(p, v, __ATOMIC_RELAXED, __HIP_MEMORY_SCOPE_AGENT); }
__device__ __forceinline__ unsigned xb_xcc_id() { return (unsigned)__builtin_amdgcn_s_getreg((3 << 11) | 20) & 0xFu; }
#define XB_SPIN(cond, bar) do { unsigned _sp = 0; while (cond) { __builtin_amdgcn_s_sleep(1); \
    if ((++_sp & 255u) == 0u) { if (xb_ld(&(bar)[XB_TMO])) break; if (_sp > XB_SPIN_CAP) { atomicAdd(&(bar)[XB_TMO], 1u); break; } } } } while (0)
struct XcdBarrier { unsigned* bar; unsigned x; volatile LAS unsigned* st; };
__device__ __forceinline__ XcdBarrier xcd_barrier_post(unsigned* bar, volatile LAS unsigned* st, bool leader) {
    XcdBarrier b; b.bar = bar; b.x = xb_xcc_id(); b.st = st;
    if (leader) (void)xb_add(&bar[XB_XCNT(b.x)], 1u);
    return b;
}
__device__ __forceinline__ void xcd_barrier_complete(unsigned* bar, unsigned x, unsigned& nloc, unsigned& nx) {
    const unsigned G = gridDim.x * gridDim.y * gridDim.z;
    unsigned sum, cnt, mine, sp = 0u;
    for (;;) {
        sum = 0u; cnt = 0u; mine = 0u;
#pragma unroll
        for (unsigned j = 0; j < 16; ++j) { const unsigned c = xb_ld(&bar[XB_XCNT(j)]); sum += c; cnt += (c > 0u) ? 1u : 0u; mine = (j == x) ? c : mine; }
        if (sum == G) break;
        __builtin_amdgcn_s_sleep(1);
        if ((++sp & 255u) == 0u) { if (xb_ld(&bar[XB_TMO])) break; if (sp > XB_SPIN_CAP) { atomicAdd(&bar[XB_TMO], 1u); break; } }
    }
    nloc = mine > 0u ? mine : 1u; nx = cnt > 0u ? cnt : 1u;
}
__device__ __forceinline__ void xcd_barrier(const XcdBarrier& b, int wave) {
    asm volatile("s_waitcnt vmcnt(0)" ::: "memory");
    __syncthreads();
    if (wave == 0 && fresh_lane() == 0) {
        unsigned* bar = b.bar;
        __builtin_amdgcn_s_waitcnt(0);
        unsigned nloc = b.st[0], nx = b.st[1];
        if (nloc == 0u) { xcd_barrier_complete(bar, b.x, nloc, nx); b.st[0] = nloc; b.st[1] = nx; }
        const unsigned old = xb_add(&bar[XB_XSUB(b.x)], 1u);
        const unsigned gen = old / nloc;
        if (old + 1u == (gen + 1u) * nloc) {
            __builtin_amdgcn_fence(__ATOMIC_RELEASE, "agent");
            asm volatile("s_waitcnt vmcnt(0)" ::: "memory");
            const unsigned og = xb_add(&bar[XB_TOP], 1u);
            const unsigned tg = og / nx;
            if (og + 1u == (tg + 1u) * nx) xb_add(&bar[XB_TOPGEN], 1u);
            else XB_SPIN(xb_ld(&bar[XB_TOPGEN]) == tg, bar);
            __builtin_amdgcn_fence(__ATOMIC_ACQUIRE, "agent");
            xb_add(&bar[XB_XGEN(b.x)], 1u);
            asm volatile("s_waitcnt vmcnt(0)" ::: "memory");
        } else {
            XB_SPIN(xb_ld(&bar[XB_XGEN(b.x)]) == gen, bar);
            __builtin_amdgcn_fence(__ATOMIC_ACQUIRE, "agent");
            asm volatile("s_waitcnt vmcnt(0)" ::: "memory");
        }
    }
    __syncthreads();
}

struct Args {
    const float *x, *c, *ctx, *c_ctx, *w_mod, *b_mod, *norm_mix_g, *norm_ffn_g, *w_in, *w_four, *q_norm_g, *k_norm_g, *w_out, *w_router, *w_gate, *w_up, *w_down, *final_norm_g;
    float* out; unsigned char* ws;
};

__device__ __forceinline__ float wave_sum(float v) {
#pragma unroll
    for (int o = 1; o < 64; o <<= 1) v += __shfl_xor(v, o);
    return v;
}

template <class RowMap>
__device__ __forceinline__ void tr_item(const float* __restrict__ W, int ldw, int k0, int n0, bf16* WT, int ldt, int kdst0, const RowMap& drow, LAS float* scr, int lane) {
    const int kq = lane >> 4, nq = lane & 15;
    f32x4 v[16];
#pragma unroll
    for (int it = 0; it < 16; ++it) v[it] = *(const f32x4*)(W + (size_t)(k0 + 4 * it + kq) * ldw + n0 + 4 * nq);
#pragma unroll
    for (int it = 0; it < 16; ++it) { LAS float* s = scr + (4 * it + kq) * 65 + 4 * nq; s[0] = v[it][0]; s[1] = v[it][1]; s[2] = v[it][2]; s[3] = v[it][3]; }
    LDS_WAIT(); asm volatile("" ::: "memory");
    const int c = lane >> 3, nn = lane & 7;
#pragma unroll
    for (int j = 0; j < 8; ++j) { const int n = nn + 8 * j; const LAS float* s = scr + (8 * c) * 65 + n;
        v4u o; o.x = pk2(s[0 * 65], s[1 * 65]); o.y = pk2(s[2 * 65], s[3 * 65]); o.z = pk2(s[4 * 65], s[5 * 65]); o.w = pk2(s[6 * 65], s[7 * 65]);
        *(GAS v4u*)(WT + (size_t)drow(n0 + n) * ldt + kdst0 + k0 + 8 * c) = o; }
    LDS_WAIT(); asm volatile("" ::: "memory");
}
struct RowId { int base; __device__ __forceinline__ int operator()(int n) const { return base + n; } };
struct RowQKV { __device__ __forceinline__ int operator()(int n) const { const int t = n >> 8, w = n & 255, hd = w >> 6, d = w & 63; return 256 + 256 * t + 128 * (d >> 5) + 32 * hd + (d & 31); } };
struct RowGU { int base, up; __device__ __forceinline__ int operator()(int f) const { return base + 256 * (f >> 7) + 128 * up + (f & 127); } };


constexpr int MOE_ITEMS = 3 * 8192;
struct TrDesc { const float* src; bf16* dst; int ldw, ldt, f8; };
__device__ __forceinline__ TrDesc moe_desc(const Args& a, int r) {
    TrDesc d;
    if (r < 16384) { const int up = r >> 13, rr = r & 8191, e = rr >> 9, q = rr & 511, kb = q >> 5, nb = q & 31;
        d.src = (up ? a.w_up : a.w_gate) + (size_t)e * DM * DE + (size_t)(kb * 64) * DE + nb * 64; d.ldw = DE;
        d.dst = (bf16*)((unsigned char*)(a.ws + WS_WGU) + ((size_t)e * 4096 + 256 * (nb >> 1) + 128 * up + 64 * (nb & 1)) * DM + kb * 64); d.ldt = DM; d.f8 = 1; }
    else { const int rr = r - 16384, e = rr >> 9, q = rr & 511, kb = q >> 4, nb = q & 15;
        d.src = a.w_down + (size_t)e * DE * DM + (size_t)(kb * 64) * DM + nb * 64; d.ldw = DM;
        d.dst = (bf16*)((unsigned char*)(a.ws + WS_WD) + ((size_t)e * DM + nb * 64) * DE + kb * 64); d.ldt = DE; d.f8 = 1; }
    return d;
}
#define TR_LOAD(v, d) do { _Pragma("unroll") for (int _it = 0; _it < 16; ++_it) v[_it] = *(const f32x4*)((d).src + (size_t)(4 * _it + kq) * (d).ldw + 4 * nq); } while (0)
#define TR_PROC(v, d) do { \
    _Pragma("unroll") for (int _it = 0; _it < 16; ++_it) { LAS float* s_ = scr + (4 * _it + kq) * 65 + 4 * nq; s_[0] = v[_it][0]; s_[1] = v[_it][1]; s_[2] = v[_it][2]; s_[3] = v[_it][3]; } \
    LDS_WAIT(); asm volatile("" ::: "memory"); \
    if ((d).f8) { _Pragma("unroll") for (int _j = 0; _j < 8; ++_j) { const int n_ = nn + 8 * _j; const LAS float* s_ = scr + (8 * c8) * 65 + n_; \
        v2u o_; o_.x = pk4_fp8(s_[0 * 65] * 32.f, s_[1 * 65] * 32.f, s_[2 * 65] * 32.f, s_[3 * 65] * 32.f); o_.y = pk4_fp8(s_[4 * 65] * 32.f, s_[5 * 65] * 32.f, s_[6 * 65] * 32.f, s_[7 * 65] * 32.f); \
        *(GAS v2u*)((unsigned char*)(d).dst + (size_t)n_ * (d).ldt + 8 * c8) = o_; } } \
    else { _Pragma("unroll") for (int _j = 0; _j < 8; ++_j) { const int n_ = nn + 8 * _j; const LAS float* s_ = scr + (8 * c8) * 65 + n_; \
        v4u o_; o_.x = pk2(s_[0 * 65], s_[1 * 65]); o_.y = pk2(s_[2 * 65], s_[3 * 65]); o_.z = pk2(s_[4 * 65], s_[5 * 65]); o_.w = pk2(s_[6 * 65], s_[7 * 65]); \
        *(GAS v4u*)((d).dst + (size_t)n_ * (d).ldt + 8 * c8) = o_; } } \
    LDS_WAIT(); asm volatile("" ::: "memory"); } while (0)
__device__ __forceinline__ void moe_convert(const Args& a, LAS float* scr, int lo, int hi, int w, int nw) {
    const int lane = fresh_lane(), kq = lane >> 4, nq = lane & 15, c8 = lane >> 3, nn = lane & 7;
    int it = lo + w; if (it >= hi) return;
    f32x4 va[16], vb[16];
    TrDesc da = moe_desc(a, it), db = da; TR_LOAD(va, da);
    for (;;) {
        int nx = it + nw; bool hn = nx < hi;
        if (hn) { db = moe_desc(a, nx); TR_LOAD(vb, db); }
        TR_PROC(va, da);
        if (!hn) break;
        it = nx; nx = it + nw; hn = nx < hi;
        if (hn) { da = moe_desc(a, nx); TR_LOAD(va, da); }
        TR_PROC(vb, db);
        if (!hn) break;
        it = nx;
    }
}
#ifndef MOE_S0
#define MOE_S0 4096
#endif
#ifndef MOE_S1
#define MOE_S1 2560
#endif
#ifndef MOE_S2
#define MOE_S2 0
#endif
constexpr int MOE_B0 = MOE_S0, MOE_B1 = MOE_B0 + MOE_S1, MOE_B2 = MOE_B1 + MOE_S2;

__host__ __device__ __forceinline__ int four_pos(int mp) { return mp == 0 ? 0 : (mp == 32 ? 1 : (mp < 32 ? 2 * mp : 2 * (64 - mp) + 1)); }

__device__ __forceinline__ void p0_prologue(const Args& a, LAS unsigned char* lds, int vcu, int G, int wave) {
    const int lane = fresh_lane(), tid = wave * 64 + lane;
    unsigned char* ws = a.ws;
    bf16* WinT = (bf16*)(ws + WS_WIN); bf16* WoT = (bf16*)(ws + WS_WOUT);
    float* MOD = (float*)(ws + WS_MOD);
    const int cg = vcu - (G - 24);
    if (cg >= 0) {
        LAS float* sv = (LAS float*)lds;
        LAS float* red = sv + 2048;
        for (int i = tid; i < 1024; i += NTHR) { const float c0 = a.c[i], c1 = a.c_ctx[i]; sv[i] = c0 / (1.f + __expf(-c0)); sv[1024 + i] = c1 / (1.f + __expf(-c1)); }
        __syncthreads();
        const int col = cg * 256 + 4 * lane;
        f32x4 a0 = {0.f, 0.f, 0.f, 0.f}, a1 = {0.f, 0.f, 0.f, 0.f};
        const int kb = wave * 128;
#pragma unroll 16
        for (int k = 0; k < 128; ++k) { const f32x4 w = *(const f32x4*)(a.w_mod + (size_t)(kb + k) * (NMOD * DM) + col); const float s0 = sv[kb + k], s1 = sv[1024 + kb + k]; a0 += w * s0; a1 += w * s1; }
        *(LAS f32x4*)(red + (wave * 2 + 0) * 256 + 4 * lane) = a0; *(LAS f32x4*)(red + (wave * 2 + 1) * 256 + 4 * lane) = a1;
        __syncthreads();
        { const int v = tid >> 8, cc = tid & 255; float s = 0.f;
#pragma unroll
          for (int w = 0; w < 8; ++w) s += red[(w * 2 + v) * 256 + cc];
          MOD[v * (NMOD * DM) + cg * 256 + cc] = s + a.b_mod[cg * 256 + cc]; }
        __syncthreads();
    }
    LAS float* scr = (LAS float*)(lds + wave * 16640);
    constexpr int I_F1 = 256, I_F2 = 256, I_IN = 16 * 20, I_OUT = 12 * 16;
    constexpr int NITEMS = I_F1 + I_F2 + I_IN + I_OUT;
    for (int it = wave * G + vcu; it < NITEMS; it += NWAVES * G) {
        int r = it;
        if (r < I_F1) {
            const int g = r & 3, kb = (r >> 2) & 15, jq = r >> 6, k = kb * 64 + lane;
            LAS float* ct = scr;
            ct[lane] = cospif((float)lane * (1.f / 32.f)); LDS_WAIT(); asm volatile("" ::: "memory");
            float w[64];
#pragma unroll
            for (int c4 = 0; c4 < 16; ++c4) { const f32x4 t = *(const f32x4*)(a.w_in + (size_t)k * INW + 64 * g + 4 * c4); w[4 * c4] = t[0]; w[4 * c4 + 1] = t[1]; w[4 * c4 + 2] = t[2]; w[4 * c4 + 3] = t[3]; }
            for (int j = 16 * jq; j < 16 * jq + 16; ++j) { const int m = j <= 32 ? j : j - 32; const int ph = j <= 32 ? 0 : 48;
                float s = 0.f;
#pragma unroll
                for (int c = 0; c < 64; ++c) s += w[c] * ct[(c * m + ph) & 63];
                WinT[(size_t)(64 * g + j) * DM + k] = (bf16)f2bf(s * (1.f / 1024.f)); }
            LDS_WAIT(); asm volatile("" ::: "memory");
            continue; }
        r -= I_F1;
        if (r < I_F2) {
            const int g = r & 3, jb = (r >> 2) & 15, mq = r >> 6, j = jb * 64 + lane;
            float w[64];
#pragma unroll
            for (int d = 0; d < 64; ++d) w[d] = a.w_out[(size_t)(64 * g + d) * DM + j];
            for (int mp = 16 * mq; mp < 16 * mq + 16; ++mp) { float s = 0.f; const float* wf = a.w_four + (size_t)(g * 64 + mp) * 64;
#pragma unroll
                for (int d = 0; d < 64; ++d) s += wf[d] * w[d];
                WoT[(size_t)j * DM + 64 * g + four_pos(mp)] = (bf16)f2bf(s); }
            continue; }
        r -= I_F2;
        if (r < I_IN) { const int kb = r / 20, nb = r % 20; tr_item(a.w_in + 256, INW, kb * 64, nb * 64, WinT, DM, 0, RowQKV{}, scr, lane); continue; }
        r -= I_IN;
        { const int kb = r / 16, nb = r % 16; tr_item(a.w_out + (size_t)256 * DM, DM, kb * 64, nb * 64, WoT, DM, 256, RowId{0}, scr, lane); }
    }
    if (cg < 0) moe_convert(a, scr, 0, MOE_B0, ((wave + 4) & 7) * (G - 24) + vcu, NWAVES * (G - 24));
}

__device__ __forceinline__ void p0b_modulate(const Args& a, int vcu, int G, int wave) {
    const int lane = fresh_lane();
    unsigned char* ws = a.ws; const float* MOD = (const float*)(ws + WS_MOD); bf16* XN = (bf16*)(ws + WS_XN);
    const int gw = vcu * NWAVES + wave, NGW = G * NWAVES;
    for (int pass = 0; pass < 2; ++pass) {
        const float* md = MOD + pass * (NMOD * DM);
        const int nrows = pass == 0 ? NTOK : NCTX; const float* src = pass == 0 ? a.x : a.ctx; bf16* dst = XN + (size_t)(pass == 0 ? 0 : NTOK) * DM;
        if (gw >= nrows) continue;
        f32x4 av[4], sh[4];
#pragma unroll
        for (int j = 0; j < 4; ++j) { const int col = 4 * lane + 256 * j; const f32x4 g = *(const f32x4*)(a.norm_mix_g + col); const f32x4 sc = *(const f32x4*)(md + DM + col); av[j] = g * (sc + 1.f); sh[j] = *(const f32x4*)(md + col); }
        f32x4 v[4], vn[4];
        { const GAS f32x4* xr = (const GAS f32x4*)(src + (size_t)gw * DM) + lane;
#pragma unroll
          for (int j = 0; j < 4; ++j) v[j] = xr[64 * j]; }
        for (int m = gw; m < nrows; m += NGW) {
            const int mn = m + NGW;
            if (mn < nrows) { const GAS f32x4* xr = (const GAS f32x4*)(src + (size_t)mn * DM) + lane;
#pragma unroll
                for (int j = 0; j < 4; ++j) vn[j] = xr[64 * j]; }
            float s = 0.f;
#pragma unroll
            for (int j = 0; j < 4; ++j) s += (v[j].x * v[j].x + v[j].y * v[j].y) + (v[j].z * v[j].z + v[j].w * v[j].w);
            const float rinv = 1.f / sqrtf(wave_sum(s) * (1.f / DM) + EPS);
            GAS unsigned long long* o8 = (GAS unsigned long long*)(dst + (size_t)m * DM) + lane;
#pragma unroll
            for (int j = 0; j < 4; ++j) { const f32x4 y = v[j] * rinv * av[j] + sh[j]; o8[64 * j] = (unsigned long long)pk2(y.x, y.y) | ((unsigned long long)pk2(y.z, y.w) << 32); }
#pragma unroll
            for (int j = 0; j < 4; ++j) v[j] = vn[j];
        }
    }
}

struct P1Prob {
    static constexpr int K = DM; static constexpr bool PERM = false, FP8 = false; static constexpr int SCW = 0, SCA = 0;
    const bf16* XN; const bf16* WinT; bf16 *Q, *Kb, *Vb; float* FT; const float *qg, *kg; unsigned* kmax; pg8::StaticOrder so;
    __device__ __forceinline__ bool next(int i, pg8::Unit& u) const { return so.next(i, u); }
    __device__ __forceinline__ bool swapped(const pg8::Unit& u) const { return u.pn == 0 || (ATTN_F8 && u.pn == 5); }
    __device__ __forceinline__ const char* aptr(const pg8::Unit& u) const { return swapped(u) ? (const char*)(WinT + (size_t)u.pn * 256 * DM) : (const char*)(XN + (size_t)u.pm * 256 * DM); }
    __device__ __forceinline__ const char* bptr(const pg8::Unit& u) const { return swapped(u) ? (const char*)(XN + (size_t)u.pm * 256 * DM) : (const char*)(WinT + (size_t)u.pn * 256 * DM); }
    __device__ __forceinline__ void epi(const pg8::f32x4 (&acc)[2][2][4][2], const pg8::Unit& u, int wr, int wc, int fr, int fq) const {
        if (u.pn == 0) {
            if (u.pm >= NTOK / 256) return;
#pragma unroll
            for (int ai = 0; ai < 2; ++ai)
#pragma unroll
                for (int m = 0; m < 4; ++m) { float* rowp = FT + (size_t)(ai * 128 + wr * 64 + m * 16 + fr) * NTOK + u.pm * 256 + wc * 32 + 4 * fq;
#pragma unroll
                    for (int bj = 0; bj < 2; ++bj)
#pragma unroll
                        for (int n = 0; n < 2; ++n) *(pg8::f32x4*)(rowp + bj * 128 + n * 16) = acc[ai][bj][m][n]; }
            return;
        }
        const bool isq = u.pn <= 3, isv = u.pn == 5, lat = u.pm < NTOK / 256;
        if (isq && !lat) return;
        if (isv) {
#if ATTN_F8
            unsigned char* V8 = (unsigned char*)Vb;
#pragma unroll
            for (int ai = 0; ai < 2; ++ai)
#pragma unroll
                for (int m = 0; m < 4; ++m) { const int kvh_ = 2 * wr + (m >> 1), d = 32 * ai + 16 * (m & 1) + fr;
#pragma unroll
                    for (int bj = 0; bj < 2; ++bj)
#pragma unroll
                        for (int n = 0; n < 2; ++n) { const int t0 = u.pm * 256 + 128 * bj + 32 * wc + 16 * n + 4 * fq, key0 = t0 & 63, tile = t0 >> 6, k5 = key0 & 31, hk = (k5 >> 2) & 1, j0 = 4 * (k5 >> 3) + 16 * (key0 >> 5);
                            const pg8::f32x4 v = acc[ai][bj][m][n];
                            *(unsigned*)(V8 + (size_t)(kvh_ * (NKEYS / 64) + tile) * 4096 + (j0 >> 4) * 2048 + d * 32 + 16 * (hk ^ ((d >> 3) & 1)) + (j0 & 15)) = pk4_fp8(v[0], v[1], v[2], v[3]); } }
#else
#pragma unroll
            for (int ai = 0; ai < 2; ++ai)
#pragma unroll
                for (int m = 0; m < 4; ++m) { const int t = u.pm * 256 + ai * 128 + wr * 64 + m * 16 + fr; bf16* rowp = Vb + (size_t)t * 256 + wc * 64 + 4 * fq;
#pragma unroll
                    for (int bj = 0; bj < 2; ++bj)
#pragma unroll
                        for (int n = 0; n < 2; ++n) { const pg8::f32x4 v = acc[ai][bj][m][n]; *(v2u*)(rowp + 32 * bj + 16 * n) = (v2u){pk2(v[0], v[1]), pk2(v[2], v[3])}; } }
#endif
            return;
        }
        const float* gw = isq ? qg : kg;
        pg8::f32x4 gv[2][2];
#pragma unroll
        for (int bj = 0; bj < 2; ++bj)
#pragma unroll
            for (int n = 0; n < 2; ++n) gv[bj][n] = *(const pg8::f32x4*)(gw + 32 * bj + 16 * n + 4 * fq);
        float frq[4];
#pragma unroll
        for (int e = 0; e < 4; ++e) frq[e] = exp2f(-(float)(4 * fq + e) * (13.287712379549449f / 16.f)) * 0.15915494309189535f;
        const float qs = isq ? attn_body::C2 * (ATTN_F8 ? 16.f : 1.f) : 1.f;
#if ATTN_F8
        bf16* base = (bf16*)((unsigned char*)(isq ? Q : Kb) + (size_t)(isq ? (u.pn - 1) * 4 + wc : wc) * 64); const int pitch = isq ? 768 : 256;
#else
        bf16* base = isq ? Q + (size_t)((u.pn - 1) * 4 + wc) * 64 : Kb + (size_t)wc * 64; const int pitch = isq ? 768 : 256;
#endif
        float k2max = 0.f;
#pragma unroll
        for (int ai = 0; ai < 2; ++ai) {
            float rowpos = (float)(u.pm * 4 + ai * 2 + wr); asm volatile("" : "+v"(rowpos));
            float cr[4], sr[4];
#pragma unroll
            for (int e = 0; e < 4; ++e) { const float rev = rowpos * frq[e], f_ = rev - floorf(rev); cr[e] = __builtin_amdgcn_cosf(f_); sr[e] = __builtin_amdgcn_sinf(f_); }
#pragma unroll
            for (int m = 0; m < 4; ++m) {
                float colpos = (float)(m * 16 + fr); asm volatile("" : "+v"(colpos));
                const int t = u.pm * 256 + ai * 128 + wr * 64 + m * 16 + fr;
                float ss = 0.f;
#pragma unroll
                for (int bj = 0; bj < 2; ++bj)
#pragma unroll
                    for (int n = 0; n < 2; ++n) { const pg8::f32x4 v = acc[ai][bj][m][n]; ss += (v[0] * v[0] + v[1] * v[1]) + (v[2] * v[2] + v[3] * v[3]); }
                ss += __shfl_xor(ss, 16); ss += __shfl_xor(ss, 32);
                const float rinv = qs / sqrtf(ss * (1.f / 64.f) + EPS);
                pg8::f32x4 y[2][2];
#pragma unroll
                for (int bj = 0; bj < 2; ++bj)
#pragma unroll
                    for (int n = 0; n < 2; ++n) y[bj][n] = acc[ai][bj][m][n] * rinv * gv[bj][n];
                if (lat) {
#pragma unroll
                    for (int e = 0; e < 4; ++e) {
                        { const float x1 = y[0][0][e], x2 = y[0][1][e]; y[0][0][e] = x1 * cr[e] - x2 * sr[e]; y[0][1][e] = x1 * sr[e] + x2 * cr[e]; }
                        { const float rev = colpos * frq[e], f_ = rev - floorf(rev); const float cc = __builtin_amdgcn_cosf(f_), sc = __builtin_amdgcn_sinf(f_);
                          const float x1 = y[1][0][e], x2 = y[1][1][e]; y[1][0][e] = x1 * cc - x2 * sc; y[1][1][e] = x1 * sc + x2 * cc; }
                    }
                }
                ss = 0.f;
#if ATTN_F8
                unsigned char* rowp8 = (unsigned char*)base + ((size_t)t * pitch + 4 * fq);
#pragma unroll
                for (int bj = 0; bj < 2; ++bj)
#pragma unroll
                    for (int n = 0; n < 2; ++n) { const pg8::f32x4 v = y[bj][n]; const unsigned w = pk4_fp8(v[0], v[1], v[2], v[3]); *(unsigned*)(rowp8 + 32 * bj + 16 * n) = w;
                        if (!isq) { const float b0 = __builtin_amdgcn_cvt_f32_fp8((int)w, 0), b1 = __builtin_amdgcn_cvt_f32_fp8((int)w, 1), b2 = __builtin_amdgcn_cvt_f32_fp8((int)w, 2), b3 = __builtin_amdgcn_cvt_f32_fp8((int)w, 3); ss += (b0 * b0 + b1 * b1) + (b2 * b2 + b3 * b3); } }
#else
                bf16* rowp = base + (size_t)t * pitch + 4 * fq;
#pragma unroll
                for (int bj = 0; bj < 2; ++bj)
#pragma unroll
                    for (int n = 0; n < 2; ++n) { const pg8::f32x4 v = y[bj][n]; const v2u w = (v2u){pk2(v[0], v[1]), pk2(v[2], v[3])}; *(v2u*)(rowp + 32 * bj + 16 * n) = w;
                        if (!isq) { const float b0 = __uint_as_float(w.x << 16), b1 = __uint_as_float(w.x & 0xffff0000u), b2 = __uint_as_float(w.y << 16), b3 = __uint_as_float(w.y & 0xffff0000u); ss += (b0 * b0 + b1 * b1) + (b2 * b2 + b3 * b3); } }
#endif
                if (!isq) { float r2 = ss; r2 += __shfl_xor(r2, 16); r2 += __shfl_xor(r2, 32); k2max = fmaxf(k2max, r2); }
                asm volatile("" ::: "memory");
            }
        }
        if (!isq) {
#pragma unroll
            for (int o = 1; o < 16; o <<= 1) k2max = fmaxf(k2max, __shfl_xor(k2max, o));
            if (fr == 0 && fq == 0) __hip_atomic_fetch_max(kmax, __float_as_uint(k2max), __ATOMIC_RELAXED, __HIP_MEMORY_SCOPE_AGENT);
        }
    }
};

__device__ __forceinline__ unsigned rev4_12(unsigned k) { unsigned r = __brev(k) >> 20; return ((r & 0xAAAu) >> 1) | ((r & 0x555u) << 1); }
__device__ __forceinline__ void fft_block(const Args& a, LAS unsigned char* lds, int item, int wave) {
    const int tid = wave * 64 + fresh_lane();
    const int mm = item & 31, par = (item >> 5) & 1, g = item >> 6;
    const float* FT = (const float*)(a.ws + WS_FT); bf16* MIX = (bf16*)(a.ws + WS_MIX);
    LAS f32x2* X = (LAS f32x2*)lds;
    const float* re = FT + (size_t)(64 * g + mm) * NTOK; const float* im = FT + (size_t)(64 * g + 32 + mm) * NTOK;
#pragma unroll 1
    for (int i = 0; i < 2; ++i) {
        const int j0 = 4 * (tid + NTHR * i);
        f32x4 r4[4], i4[4];
#pragma unroll
        for (int q = 0; q < 4; ++q) { r4[q] = *(const f32x4*)(re + j0 + 4096 * q); i4[q] = *(const f32x4*)(im + j0 + 4096 * q); }
#pragma unroll
        for (int e = 0; e < 4; ++e) {
            const int j = j0 + e;
            const f32x2 a0 = {r4[0][e], i4[0][e]}, a1 = {r4[1][e], i4[1][e]}, a2 = {r4[2][e], i4[2][e]}, a3 = {r4[3][e], i4[3][e]};
            f32x2 ya, yb; float fa, fb;
            if (par == 0) { const f32x2 s02 = a0 + a2, s13 = a1 + a3; ya = s02 + s13; yb = s02 - s13; fa = 0.f; fb = (float)(2 * j) * (1.f / 16384.f); }
            else { const f32x2 d02 = a0 - a2, d13 = a1 - a3; ya = (f32x2){d02.x + d13.y, d02.y - d13.x}; yb = (f32x2){d02.x - d13.y, d02.y + d13.x}; fa = (float)j * (1.f / 16384.f); fb = (float)(3 * j) * (1.f / 16384.f); }
            const float ca = __builtin_amdgcn_cosf(fa), sa = __builtin_amdgcn_sinf(fa), cb = __builtin_amdgcn_cosf(fb), sb = __builtin_amdgcn_sinf(fb);
            X[j] = (f32x2){ya.x * ca + ya.y * sa, ya.y * ca - ya.x * sa};
            X[4096 + j] = (f32x2){yb.x * cb + yb.y * sb, yb.y * cb - yb.x * sb};
        }
    }
    __syncthreads();
#pragma unroll 1
    for (int s = 0; s < 6; ++s) {
        const int lq = 10 - 2 * s;
        const int Lq = 1 << lq;
        const float invL = 1.f / (float)(4 << lq);
#pragma unroll 2
        for (int i = 0; i < 4; ++i) {
            const int b = tid + NTHR * i, j = b & (Lq - 1), base = ((b >> lq) << (lq + 2)) + j;
            const f32x2 a0 = X[base], a1 = X[base + Lq], a2 = X[base + 2 * Lq], a3 = X[base + 3 * Lq];
            const f32x2 s02 = a0 + a2, d02 = a0 - a2, s13 = a1 + a3, d13 = a1 - a3;
            const f32x2 y0 = s02 + s13, y2 = s02 - s13;
            const f32x2 y1 = (f32x2){d02.x + d13.y, d02.y - d13.x};
            const f32x2 y3 = (f32x2){d02.x - d13.y, d02.y + d13.x};
            const float f1 = (float)j * invL;
            const float c1 = __builtin_amdgcn_cosf(f1), s1 = __builtin_amdgcn_sinf(f1);
            const float c2 = __builtin_amdgcn_cosf(2.f * f1), s2 = __builtin_amdgcn_sinf(2.f * f1);
            const float c3 = __builtin_amdgcn_cosf(3.f * f1), s3 = __builtin_amdgcn_sinf(3.f * f1);
            X[base] = y0;
            X[base + Lq] = (f32x2){y1.x * c1 + y1.y * s1, y1.y * c1 - y1.x * s1};
            X[base + 2 * Lq] = (f32x2){y2.x * c2 + y2.y * s2, y2.y * c2 - y2.x * s2};
            X[base + 3 * Lq] = (f32x2){y3.x * c3 + y3.y * s3, y3.y * c3 - y3.x * s3};
        }
        __syncthreads();
    }
    const int col = 64 * g + 2 * mm;
#pragma unroll 1
    for (int i = 0; i < 16; ++i) {
        const int k = 2 * (tid + NTHR * i) + par, kn = (NTOK - k) & (NTOK - 1);
        const f32x2 wk = X[(((k & 3) - par) >> 1) * 4096 + rev4_12((unsigned)(k >> 2))], wn = X[(((kn & 3) - par) >> 1) * 4096 + rev4_12((unsigned)(kn >> 2))];
        float o0, o1;
        if (mm == 0) { o0 = 0.5f * (wk.x + wn.x); o1 = 0.5f * (wk.y + wn.y); }
        else { o0 = wn.x; o1 = wk.x; }
        *(unsigned*)(MIX + (size_t)k * DM + col) = pk2(o0, o1);
    }
    __syncthreads();
}

struct P3Prob {
    static constexpr int K = DM; static constexpr bool PERM = false, FP8 = false; static constexpr int SCW = 0, SCA = 0;
    const bf16* MIX; const bf16* WoT; const float* x; const float* g1; float* X1; pg8::StaticOrder so;
    __device__ __forceinline__ bool next(int i, pg8::Unit& u) const { return so.next(i, u); }
    __device__ __forceinline__ const char* aptr(const pg8::Unit& u) const { return (const char*)(MIX + (size_t)u.pm * 256 * DM); }
    __device__ __forceinline__ const char* bptr(const pg8::Unit& u) const { return (const char*)(WoT + (size_t)u.pn * 256 * DM); }
    __device__ __forceinline__ void epi(const pg8::f32x4 (&acc)[2][2][4][2], const pg8::Unit& u, int wr, int wc, int fr, int fq) const {
        const int col0 = u.pn * 256 + wc * 32 + 4 * fq;
        pg8::f32x4 gv[2][2];
#pragma unroll
        for (int bj = 0; bj < 2; ++bj)
#pragma unroll
            for (int n = 0; n < 2; ++n) gv[bj][n] = *(const pg8::f32x4*)(g1 + col0 + bj * 128 + n * 16);
#pragma unroll
        for (int ai = 0; ai < 2; ++ai)
#pragma unroll
            for (int m = 0; m < 4; ++m) { const size_t off = (size_t)(u.pm * 256 + ai * 128 + wr * 64 + m * 16 + fr) * DM + col0;
#pragma unroll
                for (int bj = 0; bj < 2; ++bj)
#pragma unroll
                    for (int n = 0; n < 2; ++n) { const pg8::f32x4 bs = *(const pg8::f32x4*)(x + off + bj * 128 + n * 16); *(pg8::f32x4*)(X1 + off + bj * 128 + n * 16) = bs + gv[bj][n] * acc[ai][bj][m][n]; }
                if (m & 1) asm volatile("" ::: "memory"); }
    }
};

__device__ __forceinline__ void p3b_router(const Args& a, LAS unsigned char* lds, int vcu, int G, int wave) {
    const int lane = fresh_lane(), tid = wave * 64 + lane;
    unsigned char* ws = a.ws; const float* MOD = (const float*)(ws + WS_MOD); const float* X1 = (const float*)(ws + WS_X1); bf16* H2 = (bf16*)(ws + WS_H2); float* AFF = (float*)(ws + WS_AFF);
    LAS float* wrt = (LAS float*)lds;
    { f32x4 t[8];
#pragma unroll
      for (int q = 0; q < 8; ++q) t[q] = *(const f32x4*)(a.w_router + 4 * (tid + NTHR * q));
#pragma unroll
      for (int q = 0; q < 8; ++q) { const int i = 4 * (tid + NTHR * q), col = i >> 4, e = i & 15;
#pragma unroll
          for (int k = 0; k < 4; ++k) wrt[(e + k) * 1024 + col] = t[q][k]; } }
    __syncthreads();
    f32x4 av[4], sh[4];
#pragma unroll
    for (int j = 0; j < 4; ++j) { const int col = 4 * lane + 256 * j; const f32x4 g = *(const f32x4*)(a.norm_ffn_g + col); const f32x4 sc = *(const f32x4*)(MOD + 4 * DM + col); av[j] = g * (sc + 1.f); sh[j] = *(const f32x4*)(MOD + 3 * DM + col); }
    const int gw = vcu * NWAVES + wave, NGW = G * NWAVES;
    f32x4 v[4], vn[4];
    if (gw < NTOK) { const GAS f32x4* xr = (const GAS f32x4*)(X1 + (size_t)gw * DM) + lane;
#pragma unroll
        for (int j = 0; j < 4; ++j) v[j] = xr[64 * j]; }
    for (int m = gw; m < NTOK; m += NGW) {
        const int mn = m + NGW;
        if (mn < NTOK) { const GAS f32x4* xr = (const GAS f32x4*)(X1 + (size_t)mn * DM) + lane;
#pragma unroll
            for (int j = 0; j < 4; ++j) vn[j] = xr[64 * j]; }
        float s = 0.f;
#pragma unroll
        for (int j = 0; j < 4; ++j) s += (v[j].x * v[j].x + v[j].y * v[j].y) + (v[j].z * v[j].z + v[j].w * v[j].w);
        const float rinv = 1.f / sqrtf(wave_sum(s) * (1.f / DM) + EPS);
        GAS unsigned* o4 = (GAS unsigned*)((unsigned char*)H2 + (size_t)m * DM) + lane;
#pragma unroll
        for (int j = 0; j < 4; ++j) { v[j] = v[j] * rinv * av[j] + sh[j]; o4[64 * j] = pk4_fp8(v[j].x, v[j].y, v[j].z, v[j].w); }
        float lg[16];
#pragma unroll
        for (int e0 = 0; e0 < 16; e0 += 4) {
#pragma unroll
            for (int e = e0; e < e0 + 4; ++e) { float p = 0.f;
#pragma unroll
                for (int j = 0; j < 4; ++j) { const f32x4 w = *(const LAS f32x4*)(wrt + e * 1024 + 4 * lane + 256 * j); p += (v[j].x * w.x + v[j].y * w.y) + (v[j].z * w.z + v[j].w * w.w); }
                lg[e] = p; }
            asm volatile("" ::: "memory"); }
        float r8[8], r4[4], r2[2], r1;
        { const bool up = (lane & 32) != 0;
#pragma unroll
          for (int e = 0; e < 8; ++e) { const float snd = up ? lg[e] : lg[e + 8], kp = up ? lg[e + 8] : lg[e]; r8[e] = kp + __shfl_xor(snd, 32); } }
        { const bool up = (lane & 16) != 0;
#pragma unroll
          for (int e = 0; e < 4; ++e) { const float snd = up ? r8[e] : r8[e + 4], kp = up ? r8[e + 4] : r8[e]; r4[e] = kp + __shfl_xor(snd, 16); } }
        { const bool up = (lane & 8) != 0;
#pragma unroll
          for (int e = 0; e < 2; ++e) { const float snd = up ? r4[e] : r4[e + 2], kp = up ? r4[e + 2] : r4[e]; r2[e] = kp + __shfl_xor(snd, 8); } }
        { const bool up = (lane & 4) != 0; const float snd = up ? r2[0] : r2[1], kp = up ? r2[1] : r2[0]; r1 = kp + __shfl_xor(snd, 4); }
        r1 += __shfl_xor(r1, 2); r1 += __shfl_xor(r1, 1);
        float mx = r1;
#pragma unroll
        for (int o = 4; o < 64; o <<= 1) mx = fmaxf(mx, __shfl_xor(mx, o));
        const float ex = __expf(r1 - mx); float den = ex;
#pragma unroll
        for (int o = 4; o < 64; o <<= 1) den += __shfl_xor(den, o);
        if ((lane & 3) == 0) AFF[(size_t)(lane >> 2) * NTOK + m] = ex / den;
#pragma unroll
        for (int j = 0; j < 4; ++j) v[j] = vn[j];
    }
}

__device__ __forceinline__ void p4_topk(const Args& a, LAS unsigned char* lds, int e, int wave) {
    const int lane = fresh_lane(), tid = wave * 64 + lane;
    unsigned char* ws = a.ws; const unsigned* AFF = (const unsigned*)(ws + WS_AFF) + (size_t)e * NTOK;
    int* IDX = (int*)(ws + WS_IDX) + e * CAP; float* GATE = (float*)(ws + WS_GATE) + e * CAP; int* TOKSLOT = (int*)(ws + WS_TOKSLOT);
    LAS unsigned* wcnt = (LAS unsigned*)lds;
    LAS unsigned* cg = wcnt + 16;
    LAS unsigned* ce = cg + 256;
    unsigned key[32];
#pragma unroll
    for (int i = 0; i < 32; ++i) key[i] = AFF[i * NTHR + tid];
    unsigned T = 0u;
#pragma unroll 1
    for (int bit = 30; bit >= 0; --bit) {
        const unsigned cand = T | (1u << bit);
        unsigned c = 0u;
#pragma unroll
        for (int i = 0; i < 32; ++i) c += (unsigned)__popcll(__ballot(key[i] >= cand));
        LAS unsigned* wb = wcnt + 1024 + (bit & 1) * 8;
        if (lane == 0) wb[wave] = c;
        __syncthreads();
        unsigned tot = 0u;
#pragma unroll
        for (int w = 0; w < 8; ++w) tot += wb[w];
        if (tot >= (unsigned)CAP) T = cand;
    }
    __syncthreads();
    unsigned long long below = (1ull << lane) - 1ull;
    unsigned rg[32], rq[32];
#pragma unroll
    for (int i = 0; i < 32; ++i) {
        const unsigned long long bg = __ballot(key[i] > T), bq = __ballot(key[i] == T);
        rg[i] = (unsigned)__popcll(bg & below); rq[i] = (unsigned)__popcll(bq & below);
        if (lane == 0) { cg[i * 8 + wave] = (unsigned)__popcll(bg); ce[i * 8 + wave] = (unsigned)__popcll(bq); }
    }
    __syncthreads();
    if (wave == 0) {
        unsigned g4[4], q4[4], sg = 0u, sq = 0u;
#pragma unroll
        for (int k = 0; k < 4; ++k) { g4[k] = cg[4 * lane + k]; q4[k] = ce[4 * lane + k]; sg += g4[k]; sq += q4[k]; }
        unsigned pg = sg, pq = sq;
#pragma unroll
        for (int o = 1; o < 64; o <<= 1) { const unsigned tg = __shfl_up(pg, o), tq = __shfl_up(pq, o); if (lane >= o) { pg += tg; pq += tq; } }
        pg -= sg; pq -= sq;
#pragma unroll
        for (int k = 0; k < 4; ++k) { cg[4 * lane + k] = pg; ce[4 * lane + k] = pq; pg += g4[k]; pq += q4[k]; }
        if (lane == 63) { wcnt[8] = pg; }
    }
    __syncthreads();
    const unsigned ngt = wcnt[8], need = (unsigned)CAP - ngt;
#pragma unroll
    for (int i = 0; i < 32; ++i) {
        const int tok = i * NTHR + tid;
        const unsigned gb = cg[i * 8 + wave] + rg[i], qb = ce[i * 8 + wave] + rq[i];
        const bool sel = key[i] > T || (key[i] == T && qb < need);
        const unsigned slot = gb + (qb < need ? qb : need);
        if (sel) { IDX[slot] = tok; GATE[slot] = __uint_as_float(key[i]); }
        TOKSLOT[tok * 16 + e] = sel ? (int)slot : -1;
    }
}

struct P5Prob {
    static constexpr int K = DM; static constexpr bool PERM = true, FP8 = true; static constexpr int SCW = 0x7A7A7A7A, SCA = 0x7F7F7F7F;
    const unsigned char* H2; const unsigned char* WguT; unsigned char* HID; pg8::StaticOrder so;
    __device__ __forceinline__ bool next(int i, pg8::Unit& u) const { return so.next(i, u); }
    __device__ __forceinline__ const char* aptr(const pg8::Unit&) const { return (const char*)H2; }
    __device__ __forceinline__ const char* bptr(const pg8::Unit& u) const { return (const char*)(WguT + ((size_t)(u.pm >> 3) * 4096 + (size_t)u.pn * 256) * DM); }
    __device__ __forceinline__ void epi(const pg8::f32x4 (&acc)[2][2][4][2], const pg8::Unit& u, int wr, int wc, int fr, int fq) const {
#pragma unroll
        for (int ai = 0; ai < 2; ++ai)
#pragma unroll
            for (int m = 0; m < 4; ++m) { unsigned char* rowp = HID + (size_t)(u.pm * 256 + ai * 128 + wr * 64 + m * 16 + fr) * DE + u.pn * 128 + wc * 32 + 8 * fq;
                float h[8];
#pragma unroll
                for (int n = 0; n < 2; ++n)
#pragma unroll
                    for (int e = 0; e < 4; ++e) { const float gt = acc[ai][0][m][n][e], up = acc[ai][1][m][n][e]; h[4 * n + e] = gt * __builtin_amdgcn_rcpf(1.f + __builtin_amdgcn_exp2f(-1.4426950408889634f * gt)) * up; }
                *(v2u*)rowp = (v2u){pk4_fp8(h[0], h[1], h[2], h[3]), pk4_fp8(h[4], h[5], h[6], h[7])}; }
    }
};
struct P6Prob {
    static constexpr int K = DE; static constexpr bool PERM = true, FP8 = true; static constexpr int SCW = 0x7A7A7A7A, SCA = 0x7F7F7F7F;
    const unsigned char* HID; const unsigned char* WdT; const float* GATE; bf16* YE; pg8::StaticOrder so;
    __device__ __forceinline__ bool next(int i, pg8::Unit& u) const { return so.next(i, u); }
    __device__ __forceinline__ const char* aptr(const pg8::Unit& u) const { return (const char*)(HID + (size_t)u.pm * 256 * DE); }
    __device__ __forceinline__ const char* bptr(const pg8::Unit& u) const { return (const char*)(WdT + ((size_t)(u.pm >> 3) * DM + (size_t)u.pn * 256) * DE); }
    __device__ __forceinline__ void epi(const pg8::f32x4 (&acc)[2][2][4][2], const pg8::Unit& u, int wr, int wc, int fr, int fq) const {
#pragma unroll
        for (int ai = 0; ai < 2; ++ai)
#pragma unroll
            for (int m = 0; m < 4; ++m) { const int row = u.pm * 256 + ai * 128 + wr * 64 + m * 16 + fr; const float gt = GATE[row]; bf16* rowp = YE + (size_t)row * DM + u.pn * 256 + wc * 32 + 8 * fq;
#pragma unroll
                for (int bj = 0; bj < 2; ++bj) { const pg8::f32x4 v0 = acc[ai][bj][m][0] * gt, v1 = acc[ai][bj][m][1] * gt;
                    *(v4u*)(rowp + bj * 128) = (v4u){pk2(v0[0], v0[1]), pk2(v0[2], v0[3]), pk2(v1[0], v1[1]), pk2(v1[2], v1[3])}; } }
    }
};

__device__ __forceinline__ void p7_final(const Args& a, int vcu, int G, int wave, unsigned poison) {
    const int lane = fresh_lane();
    unsigned char* ws = a.ws; const float* MOD = (const float*)(ws + WS_MOD); const bf16* YE = (const bf16*)(ws + WS_YE); const int* TOKSLOT = (const int*)(ws + WS_TOKSLOT);
    const float* src = (STEP >= 2) ? (const float*)(ws + WS_X1) : a.x;
    f32x4 g2[4], fg[4];
#pragma unroll
    for (int j = 0; j < 4; ++j) { const int col = 4 * lane + 256 * j; g2[j] = *(const f32x4*)(MOD + 5 * DM + col); fg[j] = *(const f32x4*)(a.final_norm_g + col); }
    const int gw = vcu * NWAVES + wave, NGW = G * NWAVES;
    for (int m = gw; m < NTOK; m += NGW) {
        const GAS f32x4* xr = (const GAS f32x4*)(src + (size_t)m * DM) + lane;
        f32x4 v[4];
#pragma unroll
        for (int j = 0; j < 4; ++j) v[j] = xr[64 * j];
        if (STEP >= 4) {
            const int myslot = lane < 16 ? TOKSLOT[m * 16 + lane] : -1;
            f32x4 s[4];
#pragma unroll
            for (int j = 0; j < 4; ++j) s[j] = (f32x4){0.f, 0.f, 0.f, 0.f};
#pragma unroll 1
            for (int e = 0; e < 16; ++e) {
                const int sl = __builtin_amdgcn_readlane(myslot, e);
                if (sl >= 0) {
                    const GAS v2u* yr = (const GAS v2u*)(YE + ((size_t)e * CAP + sl) * DM) + lane;
#pragma unroll
                    for (int j = 0; j < 4; ++j) { const v2u w = yr[64 * j]; s[j].x += __uint_as_float(w.x << 16); s[j].y += __uint_as_float(w.x & 0xffff0000u); s[j].z += __uint_as_float(w.y << 16); s[j].w += __uint_as_float(w.y & 0xffff0000u); }
                }
            }
#pragma unroll
            for (int j = 0; j < 4; ++j) v[j] += g2[j] * s[j];
        }
        float ss = 0.f;
#pragma unroll
        for (int j = 0; j < 4; ++j) ss += (v[j].x * v[j].x + v[j].y * v[j].y) + (v[j].z * v[j].z + v[j].w * v[j].w);
        const float rinv = 1.f / sqrtf(wave_sum(ss) * (1.f / DM) + EPS);
        GAS f32x4* o = (GAS f32x4*)(a.out + (size_t)m * DM) + lane;
        const float q = __builtin_nanf("");
#pragma unroll
        for (int j = 0; j < 4; ++j) { f32x4 y = v[j] * rinv * fg[j]; if (poison) y = (f32x4){q, q, q, q}; o[64 * j] = y; }
    }
}


#if PROBE
__device__ __forceinline__ void dsincos(double x, double& sn, double& cs) {
    const double TWO_PI = 6.283185307179586476925286766559; x -= TWO_PI * rint(x / TWO_PI);
    const double x2 = x * x; double ts = x, tc = 1.0; sn = x; cs = 1.0;
#pragma unroll 1
    for (int k = 1; k <= 14; ++k) { tc *= -x2 / (double)((2 * k - 1) * (2 * k)); ts *= -x2 / (double)((2 * k) * (2 * k + 1)); cs += tc; sn += ts; }
}
__device__ __forceinline__ float block_sum(float v, LAS float* red, int wave, int lane) {
    v = wave_sum(v); __syncthreads(); if (lane == 0) red[wave] = v; __syncthreads(); float s = 0.f;
#pragma unroll
    for (int w = 0; w < 8; ++w) s += red[w];
    return s;
}
__device__ __forceinline__ float block_max(float v, LAS float* red, int wave, int lane) {
#pragma unroll
    for (int o = 1; o < 64; o <<= 1) v = fmaxf(v, __shfl_xor(v, o));
    __syncthreads(); if (lane == 0) red[wave] = v; __syncthreads(); float s = red[0];
#pragma unroll
    for (int w = 1; w < 8; ++w) s = fmaxf(s, red[w]);
    return s;
}
__device__ __forceinline__ void probe_qkv(const Args& a, LAS unsigned char* lds, int vcu, int wave) {
    const int lane = fresh_lane(), tid = wave * 64 + lane; unsigned char* ws = a.ws;
    const bf16* XN = (const bf16*)(ws + WS_XN); const bf16* Qb = (const bf16*)(ws + WS_Q); const bf16* Kb = (const bf16*)(ws + WS_K); const bf16* Vb = (const bf16*)(ws + WS_V);
    gu32* ctl = (gu32*)(ws + WS_CTL);
    LAS float* red = (LAS float*)lds; LAS float* raw = red + 16;
    for (int kind = 0; kind < 3; ++kind) {
        const int nrows = kind == 0 ? NTOK : NROWS, nh = kind == 0 ? NHQ : NHKV;
        const int t = (kind == 1 && (vcu & 7) == 3) ? NTOK + (vcu * 37) % NCTX : (vcu * 977 + 131 * kind + 5) % (kind == 0 ? NTOK : NTOK);
        const int h = (vcu * 5 + kind) % nh;
        const int wcol0 = 256 + (kind == 0 ? 0 : (kind == 1 ? 768 : 1024)) + 64 * h;
        { const int d = tid & 63, part = tid >> 6; float sacc = 0.f;
          for (int k = part * 128; k < part * 128 + 128; ++k) sacc += bf2f(XN[(size_t)t * DM + k]) * a.w_in[(size_t)k * INW + wcol0 + d];
          LAS float* part_s = raw + 64; part_s[part * 64 + d] = sacc; __syncthreads();
          if (tid < 64) { float s2 = 0.f; for (int pp = 0; pp < 8; ++pp) s2 += part_s[pp * 64 + tid]; raw[tid] = s2; }
          __syncthreads(); }
        float ref = 0.f, got = 0.f;
        if (tid < 64) {
            const int d = tid; float v = raw[d];
            if (kind < 2) {
                float ss = 0.f; for (int j = 0; j < 64; ++j) ss += raw[j] * raw[j];
                const float* gw = kind == 0 ? a.q_norm_g : a.k_norm_g;
                const float rinv = 1.f / sqrtf(ss / 64.f + EPS);
                if (t < NTOK) {
                    const int half = d >> 5, dd = d & 31, i = dd & 15; const int pos = half == 0 ? (t >> 6) : (t & 63);
                    const double freq = exp2(-(double)i * (13.287712379549449 / 16.0)); double sn, cs; dsincos((double)pos * freq, sn, cs);
                    const float x1 = raw[32 * half + i] * rinv * gw[32 * half + i], x2 = raw[32 * half + 16 + i] * rinv * gw[32 * half + 16 + i];
                    v = dd < 16 ? (float)(x1 * cs - x2 * sn) : (float)(x1 * sn + x2 * cs);
                } else v = v * rinv * gw[d];
                if (kind == 0) v *= attn_body::C2;
            }
            ref = v;
#if ATTN_F8
            { const unsigned char* Q8 = (const unsigned char*)Qb; const unsigned char* K8 = (const unsigned char*)Kb; const unsigned char* V8 = (const unsigned char*)Vb;
              if (kind == 0) got = __builtin_amdgcn_cvt_f32_fp8((int)Q8[(size_t)t * 768 + 64 * h + d], 0) * (1.f / 16.f);
              else if (kind == 1) got = __builtin_amdgcn_cvt_f32_fp8((int)K8[(size_t)t * 256 + 64 * h + d], 0);
              else { const int kk = t & 63, tile = t >> 6, k5 = kk & 31, hk = (k5 >> 2) & 1, j = (k5 & 3) + 4 * (k5 >> 3) + 16 * (kk >> 5);
                     got = __builtin_amdgcn_cvt_f32_fp8((int)V8[(size_t)(h * (NKEYS / 64) + tile) * 4096 + (j >> 4) * 2048 + d * 32 + 16 * (hk ^ ((d >> 3) & 1)) + (j & 15)], 0); } }
#else
            got = kind == 0 ? bf2f(Qb[(size_t)t * 768 + 64 * h + d]) : (kind == 1 ? bf2f(Kb[(size_t)t * 256 + 64 * h + d]) : bf2f(Vb[(size_t)t * 256 + 64 * h + d]));
#endif
        }
        const float mx = block_max(fabsf(ref), red, wave, lane);
        const float err = block_max(fabsf(ref - got), red, wave, lane);
        if (tid == 0 && !(err <= (ATTN_F8 ? 0.07f : 0.03f) * mx + 1e-6f)) __hip_atomic_fetch_or(ctl + CW_FLAG, 1u << kind, RLX_AGENT);
        __syncthreads();
    }
}
__device__ __forceinline__ void probe_attn(const Args& a, LAS unsigned char* lds, int vcu, int wave) {
    const int lane = fresh_lane(), tid = wave * 64 + lane; unsigned char* ws = a.ws;
    const bf16* Qb = (const bf16*)(ws + WS_Q); const bf16* Kb = (const bf16*)(ws + WS_K); const bf16* Vb = (const bf16*)(ws + WS_V); const bf16* MIX = (const bf16*)(ws + WS_MIX);
    gu32* ctl = (gu32*)(ws + WS_CTL);
    LAS float* red = (LAS float*)lds; LAS float* ored = red + 16;
    const int t = (vcu * 613 + 29) % NTOK, h = (vcu * 7 + 3) % NHQ, kvh = h / 3;
    float q[64];
#if ATTN_F8
    const unsigned char* Q8 = (const unsigned char*)Qb; const unsigned char* K8 = (const unsigned char*)Kb; const unsigned char* V8 = (const unsigned char*)Vb;
#pragma unroll
    for (int d = 0; d < 64; ++d) q[d] = __builtin_amdgcn_cvt_f32_fp8((int)Q8[(size_t)t * 768 + 64 * h + d], 0) * (1.f / 16.f);
#else
#pragma unroll
    for (int d = 0; d < 64; ++d) q[d] = bf2f(Qb[(size_t)t * 768 + 64 * h + d]);
#endif
    float sc[33]; float mx = -1e30f;
#pragma unroll
    for (int i = 0; i < 33; ++i) { const int key = i * NTHR + tid; float s = -1e30f;
#if ATTN_F8
        if (key < NKEYS) { s = 0.f; const unsigned char* kr = K8 + (size_t)key * 256 + 64 * kvh;
#pragma unroll
            for (int d = 0; d < 64; ++d) s += q[d] * __builtin_amdgcn_cvt_f32_fp8((int)kr[d], 0); }
#else
        if (key < NKEYS) { s = 0.f; const bf16* kr = Kb + (size_t)key * 256 + 64 * kvh;
#pragma unroll
            for (int d = 0; d < 64; ++d) s += q[d] * bf2f(kr[d]); }
#endif
        sc[i] = s; mx = fmaxf(mx, s); }
    mx = block_max(mx, red, wave, lane);
    float den = 0.f; float o[64];
#pragma unroll
    for (int d = 0; d < 64; ++d) o[d] = 0.f;
#pragma unroll
    for (int i = 0; i < 33; ++i) { const int key = i * NTHR + tid;
#if ATTN_F8
        if (key < NKEYS) { const float pp = exp2f(sc[i] - mx); den += pp; const int kk = key & 63, tile = key >> 6, k5 = kk & 31, hk = (k5 >> 2) & 1, j = (k5 & 3) + 4 * (k5 >> 3) + 16 * (kk >> 5);
            const unsigned char* vb = V8 + (size_t)(kvh * (NKEYS / 64) + tile) * 4096 + (j >> 4) * 2048 + (j & 15);
#pragma unroll
            for (int d = 0; d < 64; ++d) o[d] += pp * __builtin_amdgcn_cvt_f32_fp8((int)vb[d * 32 + 16 * (hk ^ ((d >> 3) & 1))], 0); } }
#else
        if (key < NKEYS) { const float pp = exp2f(sc[i] - mx); den += pp; const bf16* vr = Vb + (size_t)key * 256 + 64 * kvh;
#pragma unroll
            for (int d = 0; d < 64; ++d) o[d] += pp * bf2f(vr[d]); } }
#endif
    den = block_sum(den, red, wave, lane);
#pragma unroll
    for (int d = 0; d < 64; ++d) { const float w = wave_sum(o[d]); if (lane == 0) ored[wave * 64 + d] = w; }
    __syncthreads();
    float ref = 0.f, got = 0.f;
    if (tid < 64) { float s = 0.f; for (int w = 0; w < 8; ++w) s += ored[w * 64 + tid]; ref = s / den; got = bf2f(MIX[(size_t)t * DM + 256 + 64 * h + tid]); }
    const float m2 = block_max(fabsf(ref), red, wave, lane);
    const float err = block_max(fabsf(ref - got), red, wave, lane);
    if (tid == 0 && !(err <= 0.03f * m2 + 1e-7f)) __hip_atomic_fetch_or(ctl + CW_FLAG, 8u, RLX_AGENT);
    __syncthreads();
}
#endif

__global__ void __launch_bounds__(NTHR, 2) fwd_megakernel(Args args) {
    extern __shared__ __attribute__((aligned(16))) unsigned char lds_raw[];
    LAS unsigned char* lds = (LAS unsigned char*)lds_raw;
    volatile LAS unsigned* MISC = (volatile LAS unsigned*)(lds + MISC_OFF);
    const int wave = __builtin_amdgcn_readfirstlane(threadIdx.x >> 6);
    const int G = gridDim.x; const int bx = blockIdx.x; const int vcu = (G % 8 == 0) ? (bx % 8) * (G / 8) + bx / 8 : bx;
    unsigned char* ws = args.ws;
    gu32* ctl = (gu32*)(ws + WS_CTL);
    { const int l0 = fresh_lane(); if (wave < 2) ((LAS unsigned*)(lds + MISC_OFF))[wave * 64 + l0] = 0u;
      __syncthreads();
    }
    XcdBarrier bar = xcd_barrier_post((unsigned*)(ctl + CW_BAR), MISC + 8, wave == 0 && fresh_lane() == 0);
#define GRID_BAR() xcd_barrier(bar, wave)

    for (int rep = 0; rep < REP(0); ++rep) {
    if (STEP >= 2 && PH(0)) p0_prologue(args, lds, vcu, G, wave);
    GRID_BAR(); }
    for (int rep = 0; rep < REP(1); ++rep) {
    if (STEP >= 2 && PH(1)) p0b_modulate(args, vcu, G, wave);
    GRID_BAR(); }
    for (int rep = 0; rep < REP(2); ++rep) {
    if (STEP >= 2 && PH(2)) {
        P1Prob p; p.XN = (bf16*)(ws + WS_XN); p.WinT = (bf16*)(ws + WS_WIN); p.Q = (bf16*)(ws + WS_Q); p.Kb = (bf16*)(ws + WS_K); p.Vb = (bf16*)(ws + WS_V); p.FT = (float*)(ws + WS_FT);
        p.qg = args.q_norm_g; p.kg = args.k_norm_g; p.kmax = (unsigned*)(ctl + CW_KMAX); p.so.init(NROWS / 256, INW / 256, G, bx);
        pg8::gemm_phase<P1Prob, false, true, true>(lds, p, nullptr, wave);
        if (rep == 0 && MOE_S1 > 0) {
            const int nwg = (NROWS / 256) * (INW / 256), maxc = (nwg + G - 1) / G, c0 = nwg - (maxc - 1) * G;
            if (c0 >= G) moe_convert(args, (LAS float*)(lds + wave * 16640), MOE_B0, MOE_B1, bx * NWAVES + wave, G * NWAVES);
            else if (bx >= c0) moe_convert(args, (LAS float*)(lds + wave * 16640), MOE_B0, MOE_B1, (bx - c0) * NWAVES + wave, (G - c0) * NWAVES);
        }
    }
    GRID_BAR(); }
#if PROBE == 1
    probe_qkv(args, lds, vcu, wave);
#endif
    if (REP(12) > 1) {
        P1Prob p; p.XN = (bf16*)(ws + WS_XN); p.WinT = (bf16*)(ws + WS_WIN); p.Q = (bf16*)(ws + WS_Q); p.Kb = (bf16*)(ws + WS_K); p.Vb = (bf16*)(ws + WS_V); p.FT = (float*)(ws + WS_FT);
        p.qg = args.q_norm_g; p.kg = args.k_norm_g; p.kmax = (unsigned*)(ctl + CW_KMAX); p.so.init(NROWS / 256, INW / 256, G, bx);
        pg8::gemm_phase<P1Prob, false, true, true>(lds, p, nullptr, wave);
        GRID_BAR(); }
    for (int rep = 0; rep < REP(3); ++rep) {
    if (STEP >= 2 && PH(3)) {
        for (int item = vcu; item < 256; item += G) fft_block(args, lds, item, wave);
        if (rep == 0 && MOE_S2 > 0) {
            if (G > 256) { if (vcu >= 256) moe_convert(args, (LAS float*)(lds + wave * 16640), MOE_B1, MOE_B2, (vcu - 256) * NWAVES + wave, (G - 256) * NWAVES); }
            else moe_convert(args, (LAS float*)(lds + wave * 16640), MOE_B1, MOE_B2, vcu * NWAVES + wave, G * NWAVES);
        }
    }
    if (rep + 1 < REP(3)) GRID_BAR(); }
    for (int rep = 0; rep < REP(4); ++rep) {
    if (STEP >= 3 && PH(4)) {
        const attn_body::bf16* Qb = (const attn_body::bf16*)(ws + WS_Q); const attn_body::bf16* Kb = (const attn_body::bf16*)(ws + WS_K); const attn_body::bf16* Vb = (const attn_body::bf16*)(ws + WS_V);
        attn_body::bf16* MIX = (attn_body::bf16*)(ws + WS_MIX);
        const float kmax2 = __uint_as_float(__hip_atomic_load(ctl + CW_KMAX, RLX_AGENT));
        const int u0 = (G == 256) ? vcu * 3 : vcu, ustep = (G == 256) ? 1 : G, uend = (G == 256) ? vcu * 3 + 3 : 768;
#pragma unroll 1
        for (int u = u0; u < uend; u += ustep) {
            const int kvh = u / 192, w = u % 192, h = kvh * 3 + w / 64, qb = w % 64;
#if ATTN_F8
            attn_body::attn_unit_f8<0>(h, kvh, qb, (const unsigned char*)Qb, (const unsigned char*)Kb, (const unsigned char*)Vb, MIX, (char*)lds_raw, wave, kmax2);
#ifdef DUMMYVAR
            attn_body::attn_unit_f8<(DUMMYVAR) | 8>(h, kvh, qb, (const unsigned char*)Qb, (const unsigned char*)Kb, (const unsigned char*)Vb, MIX, (char*)lds_raw, wave, kmax2);
#endif
#else
            attn_body::attn_unit<8>(h, kvh, qb, Qb, Kb, Vb, MIX, (char*)lds_raw, wave, kmax2);
#endif
        }
    } else if (STEP == 2) {
        bf16* MIX = (bf16*)(ws + WS_MIX);
        const int gw = vcu * NWAVES + wave, NGW = G * NWAVES, lane = fresh_lane();
        for (int m = gw; m < NTOK; m += NGW) { GAS v4u* o = (GAS v4u*)(MIX + (size_t)m * DM + 256); o[lane] = (v4u){0u, 0u, 0u, 0u}; if (lane < 32) o[64 + lane] = (v4u){0u, 0u, 0u, 0u}; }
    }
    GRID_BAR(); }
#if PROBE == 2
    probe_attn(args, lds, vcu, wave);
#endif
    for (int rep = 0; rep < REP(5); ++rep) {
    if (STEP >= 2 && PH(5)) {
        P3Prob p; p.MIX = (bf16*)(ws + WS_MIX); p.WoT = (bf16*)(ws + WS_WOUT); p.x = args.x; p.g1 = (const float*)(ws + WS_MOD) + 2 * DM; p.X1 = (float*)(ws + WS_X1); p.so.init(NTOK / 256, DM / 256, G, bx);
        pg8::gemm_phase<P3Prob, false, true, true>(lds, p, nullptr, wave);
    }
    GRID_BAR(); }
    for (int rep = 0; rep < REP(6); ++rep) {
    if (STEP >= 4 && PH(6)) p3b_router(args, lds, vcu, G, wave);
    GRID_BAR(); }
    for (int rep = 0; rep < REP(7); ++rep) {
    if (STEP >= 4 && PH(7)) {
#pragma unroll 1
        for (int e = vcu; e < NE; e += G) p4_topk(args, lds, e, wave);
        if (rep == 0) {
            if (G > NE) { if (vcu >= NE) moe_convert(args, (LAS float*)(lds + wave * 16640), MOE_B2, MOE_ITEMS, (vcu - NE) * NWAVES + wave, (G - NE) * NWAVES); }
            else moe_convert(args, (LAS float*)(lds + wave * 16640), MOE_B2, MOE_ITEMS, vcu * NWAVES + wave, G * NWAVES);
        } }
    GRID_BAR(); }
    if (REP(11) > 1) {
        moe_convert(args, (LAS float*)(lds + wave * 16640), MOE_B2, MOE_ITEMS, vcu * NWAVES + wave, G * NWAVES);
        GRID_BAR(); }
    for (int rep = 0; rep < REP(8); ++rep) {
    if (STEP >= 4 && PH(8)) {
        P5Prob p; p.H2 = (const unsigned char*)(ws + WS_H2); p.WguT = (const unsigned char*)(ws + WS_WGU); p.HID = (unsigned char*)(ws + WS_HID); p.so.init(NE * CAP / 256, 2 * DE / 256, G, bx);
        LAS unsigned* rowtab = (LAS unsigned*)(lds + XTRA_OFF);
        const int* IDX = (const int*)(ws + WS_IDX);
        { const int tid = wave * 64 + fresh_lane(); pg8::Unit u; for (int i = 0; p.so.next(i, u) && i < 28; ++i) { if (tid < 256) rowtab[i * 256 + tid] = (unsigned)IDX[u.pm * 256 + tid]; } }
        __syncthreads();
        pg8::gemm_phase<P5Prob, true, true, true>(lds, p, rowtab, wave);
    }
    GRID_BAR(); }
    for (int rep = 0; rep < REP(9); ++rep) {
    if (STEP >= 4 && PH(9)) {
        P6Prob p; p.HID = (const unsigned char*)(ws + WS_HID); p.WdT = (const unsigned char*)(ws + WS_WD); p.GATE = (const float*)(ws + WS_GATE); p.YE = (bf16*)(ws + WS_YE); p.so.init(NE * CAP / 256, DM / 256, G, bx);
        pg8::gemm_phase<P6Prob, false, true, true>(lds, p, nullptr, wave);
    }
    GRID_BAR(); }
    {
        unsigned poison = (__hip_atomic_load(ctl + CW_BAR + XB_TMO, RLX_AGENT) != 0u) || (__hip_atomic_load(ctl + CW_FLAG, RLX_AGENT) != 0u);
        for (int rep = 0; rep < REP(10); ++rep) p7_final(args, vcu, G, wave, poison);
    }
}

extern "C" void kernel_launch(void* const* d_in, const int* in_sizes, int n_in, void* d_out, int out_size, void* d_ws, size_t ws_size, hipStream_t stream) {
    static int grid = 0;
    if (grid == 0) {
        if (n_in != 18 || in_sizes[0] != NTOK * DM || out_size != NTOK * DM || ws_size < WS_END) { fprintf(stderr, "kernel_launch: unexpected shapes (n_in %d, in0 %d, out %d, ws %zu)\n", n_in, n_in > 0 ? in_sizes[0] : -1, out_size, ws_size); grid = -1; return; }
        int dev = 0, cus = 0, per_cu = 0;
        if (hipGetDevice(&dev) != hipSuccess || hipDeviceGetAttribute(&cus, hipDeviceAttributeMultiprocessorCount, dev) != hipSuccess) { grid = -1; return; }
        if (hipFuncSetAttribute((const void*)fwd_megakernel, hipFuncAttributeMaxDynamicSharedMemorySize, LDS_BYTES) != hipSuccess) { fprintf(stderr, "kernel_launch: hipFuncSetAttribute failed\n"); grid = -1; return; }
        if (hipOccupancyMaxActiveBlocksPerMultiprocessor(&per_cu, (const void*)fwd_megakernel, NTHR, LDS_BYTES) != hipSuccess || per_cu < 1) { fprintf(stderr, "kernel_launch: occupancy query says %d blocks per CU\n", per_cu); (void)hipGetLastError(); grid = -1; return; }
        grid = cus;
    }
    if (grid < 0) return;
    (void)hipMemsetAsync((char*)d_ws + WS_CTL, 0, CTL_ZERO_BYTES, stream);
    Args a{};
    const float** f = (const float**)&a;
    for (int i = 0; i < 18; ++i) f[i] = (const float*)d_in[i];
    a.out = (float*)d_out; a.ws = (unsigned char*)d_ws;
    hipLaunchKernelGGL(fwd_megakernel, dim3(grid), dim3(NTHR), LDS_BYTES, stream, a);
}
```

```cpp
#include <hip/hip_runtime.h>
#include <hip/hip_bf16.h>
#include <cstdio>
#include <cstdint>
#include <cmath>

#ifndef STEP
#define STEP 4
#endif
#ifndef PROBE
#define PROBE 0
#endif
#ifndef PHMASK
#define PHMASK 0xFFFF
#endif
#define PH(k) ((PHMASK >> (k)) & 1)
#ifndef ATTN_F8
#define ATTN_F8 1
#endif
#ifndef REPEAT
#define REPEAT 0
#endif
#define REP(k) (((REPEAT >> (k)) & 1) + 1)

constexpr int DM = 1024, NTOK = 16384, NCTX = 256, NROWS = NTOK + NCTX, INW = 1536;
constexpr int NHQ = 12, NHKV = 4, HD = 64, NE = 16, CAP = 2048, DE = 2048, NMOD = 6;
constexpr int NKEYS = NROWS;
constexpr float EPS = 1e-6f;

__device__ __forceinline__ int fresh_lane() { int l; asm volatile("v_mbcnt_lo_u32_b32 %0, -1, 0\n\tv_mbcnt_hi_u32_b32 %0, -1, %0" : "=v"(l)); return l; }

namespace pg8 {
#define PG8_LAS __attribute__((address_space(3)))
typedef unsigned short bf16_t;
typedef short bf16x8 __attribute__((ext_vector_type(8)));
typedef float f32x4 __attribute__((ext_vector_type(4)));
typedef unsigned u32x4 __attribute__((ext_vector_type(4)));
typedef unsigned u32x2 __attribute__((ext_vector_type(2)));
typedef int v8i __attribute__((ext_vector_type(8)));
constexpr int BM = 256, BK = 64, HALF = 128, HTB = HALF * BK * 2, STAGE_BYTES = 8 * HTB, NXCD = 8, WGM = 8;

__host__ __device__ __forceinline__ int lds_byte(int r, int c) { const int st = (r >> 4) * 2 + (c >> 5), rr = r & 15, cc = c & 31, ob = rr * 64 + cc * 2; return st * 1024 + (ob ^ (((ob >> 9) & 1) << 5)); }
__host__ __device__ __forceinline__ void stage_rc(int b, int& R, int& C) { const int st = b / 1024, sb = b % 1024, swz = sb ^ (((sb >> 9) & 1) << 5); R = (st >> 1) * 16 + swz / 64; C = (st & 1) * 32 + (swz % 64) / 2; }
__host__ __device__ __forceinline__ int perm32(int rho) { const int n = rho >> 4, i = rho & 15; return 8 * (i >> 2) + 4 * n + (i & 3); }

struct Unit { int pm, pn; };

struct StaticOrder {
    int nM, nN, nwg, G, c;
    __host__ __device__ void init(int nM_, int nN_, int G_, int c_) { nM = nM_; nN = nN_; nwg = nM * nN; G = G_; c = c_; }
    __host__ __device__ bool next(int i, Unit& u) const {
        const long L = (long)i * G + c; if (L >= nwg) return false;
        int wgid = (int)L; { const int q = nwg / NXCD, r = nwg % NXCD, xcd = wgid % NXCD, off = wgid / NXCD; wgid = (xcd < r ? xcd * (q + 1) : r * (q + 1) + (xcd - r) * q) + off; }
        const int nig = WGM * nN, gid = wgid / nig, fm = gid * WGM, gsz = (nM - fm) < WGM ? (nM - fm) : WGM;
        u.pm = fm + ((wgid % nig) % gsz); u.pn = (wgid % nig) / gsz; return true;
    }
};

__device__ __forceinline__ unsigned cvt_pk_bf16(float lo, float hi) { unsigned r; asm volatile("v_cvt_pk_bf16_f32 %0, %1, %2" : "=v"(r) : "v"(lo), "v"(hi)); return r; }

template <class P, bool GATHER, bool ALIGN_EPI, bool SP2>
__device__ __forceinline__ void gemm_phase(PG8_LAS unsigned char* lds, const P& S, const PG8_LAS unsigned* rowtab, int wid) {
    const int lane = fresh_lane(), tid = wid * 64 + lane, wr = wid >> 2, wc = wid & 3, fr = lane & 15, fq = lane >> 4;
    constexpr bool F8 = P::FP8; constexpr int ESZ = F8 ? 1 : 2;
    constexpr int K = P::K, nt = F8 ? K / 128 : K / BK;
    int R0, C0; stage_rc(tid * 16, R0, C0);
    unsigned voffB[2];
#pragma unroll
    for (int i = 0; i < 2; ++i) { const int R = R0 + 64 * i; const int Rb = P::PERM ? ((R & ~31) + perm32(R & 31)) : R; voffB[i] = (unsigned)(Rb * K * ESZ + C0 * 2); }
    constexpr size_t kstep = (size_t)(BK * 2);
    constexpr size_t hstep = (size_t)HALF * K * ESZ;
    const unsigned ldsw = (unsigned)wid * 1024u;
    const int aoff = F8 ? lds_byte(wr * 64 + fr, fq * 16) : lds_byte(wr * 64 + fr, fq * 8), boff = F8 ? lds_byte(wc * 32 + fr, fq * 16) : lds_byte(wc * 32 + fr, fq * 8);
#define PG8_SA(b, h) (((b) * 2 + (h)) * HTB)
#define PG8_SB(b, h) ((4 + (b) * 2 + (h)) * HTB)
#define PG8_STAGE(bufoff, gbase, voff) do { _Pragma("unroll") for (int _i = 0; _i < 2; ++_i) \
        __builtin_amdgcn_global_load_lds((const unsigned*)((const char*)(gbase) + (voff)[_i]), (PG8_LAS unsigned*)(lds + (bufoff) + ldsw + _i * 8192), 16, 0, 0); } while (0)
#define PG8_LDA(dst, b, h) do { if constexpr (F8) { _Pragma("unroll") for (int m = 0; m < 4; ++m) { const PG8_LAS u32x4* p_ = (const PG8_LAS u32x4*)(lds + PG8_SA(b, h) + aoff + m * 2048); const u32x4 lo_ = p_[0], hi_ = p_[1]; \
            dst##8[m] = (v8i){(int)lo_.x, (int)lo_.y, (int)lo_.z, (int)lo_.w, (int)hi_.x, (int)hi_.y, (int)hi_.z, (int)hi_.w}; } } \
        else { _Pragma("unroll") for (int m = 0; m < 4; ++m) _Pragma("unroll") for (int k = 0; k < 2; ++k) dst[m][k] = *(const PG8_LAS bf16x8*)(lds + PG8_SA(b, h) + aoff + m * 2048 + k * 1024); } } while (0)
#define PG8_LDB(dst, b, h) do { if constexpr (F8) { _Pragma("unroll") for (int n = 0; n < 2; ++n) { const PG8_LAS u32x4* p_ = (const PG8_LAS u32x4*)(lds + PG8_SB(b, h) + boff + n * 2048); const u32x4 lo_ = p_[0], hi_ = p_[1]; \
            dst##8[n] = (v8i){(int)lo_.x, (int)lo_.y, (int)lo_.z, (int)lo_.w, (int)hi_.x, (int)hi_.y, (int)hi_.z, (int)hi_.w}; } } \
        else { _Pragma("unroll") for (int n = 0; n < 2; ++n) _Pragma("unroll") for (int k = 0; k < 2; ++k) dst[n][k] = *(const PG8_LAS bf16x8*)(lds + PG8_SB(b, h) + boff + n * 2048 + k * 1024); } } while (0)
#define PG8_MMA(ai, bj, At, Bt) do { __builtin_amdgcn_s_setprio(1); if constexpr (F8) { \
        asm volatile("s_nop 1\n\t" \
            "v_mfma_scale_f32_16x16x128_f8f6f4 %0, %8, %10, %0, %14, %15 op_sel_hi:[0,0,0]\n\t" \
            "v_mfma_scale_f32_16x16x128_f8f6f4 %1, %9, %10, %1, %14, %15 op_sel_hi:[0,0,0]\n\t" \
            "v_mfma_scale_f32_16x16x128_f8f6f4 %2, %8, %11, %2, %14, %15 op_sel_hi:[0,0,0]\n\t" \
            "v_mfma_scale_f32_16x16x128_f8f6f4 %3, %9, %11, %3, %14, %15 op_sel_hi:[0,0,0]\n\t" \
            "v_mfma_scale_f32_16x16x128_f8f6f4 %4, %8, %12, %4, %14, %15 op_sel_hi:[0,0,0]\n\t" \
            "v_mfma_scale_f32_16x16x128_f8f6f4 %5, %9, %12, %5, %14, %15 op_sel_hi:[0,0,0]\n\t" \
            "v_mfma_scale_f32_16x16x128_f8f6f4 %6, %8, %13, %6, %14, %15 op_sel_hi:[0,0,0]\n\t" \
            "v_mfma_scale_f32_16x16x128_f8f6f4 %7, %9, %13, %7, %14, %15 op_sel_hi:[0,0,0]" \
            : "+v"(acc[ai][bj][0][0]), "+v"(acc[ai][bj][0][1]), "+v"(acc[ai][bj][1][0]), "+v"(acc[ai][bj][1][1]), "+v"(acc[ai][bj][2][0]), "+v"(acc[ai][bj][2][1]), "+v"(acc[ai][bj][3][0]), "+v"(acc[ai][bj][3][1]) \
            : "v"(Bt##8[0]), "v"(Bt##8[1]), "v"(At##8[0]), "v"(At##8[1]), "v"(At##8[2]), "v"(At##8[3]), "v"(scw_), "v"(sca_)); } \
        else { _Pragma("unroll") for (int m = 0; m < 4; ++m) _Pragma("unroll") for (int n = 0; n < 2; ++n) _Pragma("unroll") for (int k = 0; k < 2; ++k) \
            acc[ai][bj][m][n] = __builtin_amdgcn_mfma_f32_16x16x32_bf16(Bt[n][k], At[m][k], acc[ai][bj][m][n], 0, 0, 0); } __builtin_amdgcn_s_setprio(0); } while (0)
#define PG8_WAIT_V(n) asm volatile("s_waitcnt vmcnt(" #n ")" ::: "memory")
#define PG8_WAIT_L(n) asm volatile("s_waitcnt lgkmcnt(" #n ")" ::: "memory")
#define PG8_BAR __builtin_amdgcn_s_barrier()
#define PG8_SCHED __builtin_amdgcn_sched_barrier(0)
#define PG8_AOFF(dst, u_, ui_) do { _Pragma("unroll") for (int _h = 0; _h < 2; ++_h) _Pragma("unroll") for (int _i = 0; _i < 2; ++_i) { \
        if constexpr (GATHER) dst[_h][_i] = (unsigned)(rowtab[(ui_) * 256 + _h * HALF + _i * 64 + R0] * (unsigned)(K * ESZ) + (unsigned)(C0 * 2)); \
        else dst[_h][_i] = (unsigned)((_h * HALF + _i * 64 + R0) * K * ESZ + C0 * 2); } } while (0)
    Unit cur, nxt; int ui = 0;
    if (!S.next(0, cur)) return;
    f32x4 acc[2][2][4][2];
#pragma unroll
    for (int a = 0; a < 2; ++a)
#pragma unroll
        for (int b = 0; b < 2; ++b)
#pragma unroll
            for (int m = 0; m < 4; ++m)
#pragma unroll
                for (int n = 0; n < 2; ++n) acc[a][b][m][n] = (f32x4){0.f, 0.f, 0.f, 0.f};
    bf16x8 At[4][2], B0[2][2], B1[2][2]; v8i At8[4], B08[2], B18[2]; const int scw_ = P::SCW, sca_ = P::SCA;
    unsigned vAc[2][2], vAn[2][2];
    PG8_AOFF(vAc, cur, 0);
    const char* cA = S.aptr(cur); const char* cB = S.bptr(cur);
    if constexpr (SP2) {
        PG8_STAGE(PG8_SB(0, 0), cB, voffB); PG8_STAGE(PG8_SB(0, 1), cB + hstep, voffB); PG8_STAGE(PG8_SA(0, 0), cA, vAc[0]); PG8_STAGE(PG8_SA(0, 1), cA, vAc[1]);
        if (wr == 1) PG8_BAR;
        PG8_WAIT_V(2); PG8_BAR;
        PG8_STAGE(PG8_SB(1, 0), cB + kstep, voffB); PG8_STAGE(PG8_SA(1, 0), cA + kstep, vAc[0]); PG8_STAGE(PG8_SB(1, 1), cB + hstep + kstep, voffB);
        PG8_WAIT_V(6); PG8_BAR;
    } else {
        PG8_STAGE(PG8_SB(0, 0), cB, voffB); PG8_STAGE(PG8_SA(0, 0), cA, vAc[0]); PG8_STAGE(PG8_SB(0, 1), cB + hstep, voffB); PG8_STAGE(PG8_SA(0, 1), cA, vAc[1]);
        if (wr == 1) PG8_BAR;
        PG8_WAIT_V(4); PG8_BAR;
        PG8_STAGE(PG8_SB(1, 0), cB + kstep, voffB); PG8_STAGE(PG8_SA(1, 0), cA + kstep, vAc[0]); PG8_STAGE(PG8_SB(1, 1), cB + hstep + kstep, voffB);
        PG8_WAIT_V(6); PG8_BAR;
    }
    for (;;) {
        const bool has_next = S.next(ui + 1, nxt);
        const char* nA = has_next ? S.aptr(nxt) : cA; const char* nB = has_next ? S.bptr(nxt) : cB;
        if (has_next) { PG8_AOFF(vAn, nxt, ui + 1); }
        else {
#pragma unroll
            for (int h = 0; h < 2; ++h)
#pragma unroll
                for (int i = 0; i < 2; ++i) vAn[h][i] = vAc[h][i];
        }
        for (int t = 0; t < nt; t += 2) {
            const bool last = (t == nt - 2);
            const char* a1 = cA + (size_t)(t + 1) * kstep;
            const char* a2 = last ? nA : cA + (size_t)(t + 2) * kstep; const char* b2 = last ? nB : cB + (size_t)(t + 2) * kstep;
            const char* a3 = a2 + kstep; const char* b3 = b2 + kstep;
            unsigned w2[2][2];
#pragma unroll
            for (int h = 0; h < 2; ++h)
#pragma unroll
                for (int i = 0; i < 2; ++i) w2[h][i] = last ? vAn[h][i] : vAc[h][i];
            if constexpr (SP2) {
            PG8_LDB(B0, 0, 0); PG8_LDB(B1, 0, 1); PG8_SCHED; PG8_LDA(At, 0, 0); PG8_STAGE(PG8_SA(1, 1), a1, vAc[1]);
            PG8_WAIT_V(8); PG8_WAIT_L(0); PG8_BAR; PG8_MMA(0, 0, At, B0); PG8_MMA(0, 1, At, B1); PG8_BAR; PG8_SCHED;
            PG8_LDA(At, 0, 1); PG8_STAGE(PG8_SB(0, 0), b2, voffB); PG8_STAGE(PG8_SB(0, 1), b2 + hstep, voffB); PG8_STAGE(PG8_SA(0, 0), a2, w2[0]);
            PG8_WAIT_V(8); PG8_WAIT_L(0); PG8_BAR; PG8_MMA(1, 0, At, B0); PG8_MMA(1, 1, At, B1); PG8_BAR; PG8_SCHED;
            PG8_LDB(B0, 1, 0); PG8_LDB(B1, 1, 1); PG8_SCHED; PG8_LDA(At, 1, 0); PG8_STAGE(PG8_SA(0, 1), a2, w2[1]);
            PG8_WAIT_V(8); PG8_WAIT_L(0); PG8_BAR; PG8_MMA(0, 0, At, B0); PG8_MMA(0, 1, At, B1); PG8_BAR; PG8_SCHED;
            PG8_LDA(At, 1, 1); PG8_STAGE(PG8_SB(1, 0), b3, voffB); PG8_STAGE(PG8_SB(1, 1), b3 + hstep, voffB); PG8_STAGE(PG8_SA(1, 0), a3, w2[0]);
            PG8_WAIT_V(8); PG8_WAIT_L(0); PG8_BAR; PG8_MMA(1, 0, At, B0); PG8_MMA(1, 1, At, B1); PG8_BAR; PG8_SCHED;
            } else {
            PG8_LDB(B0, 0, 0); PG8_SCHED; PG8_LDA(At, 0, 0); PG8_STAGE(PG8_SA(1, 1), a1, vAc[1]);
            PG8_WAIT_L(8); PG8_BAR; PG8_WAIT_L(0); PG8_MMA(0, 0, At, B0); PG8_BAR; PG8_SCHED;
            PG8_LDB(B1, 0, 1); PG8_STAGE(PG8_SB(0, 0), b2, voffB);
            PG8_BAR; PG8_WAIT_L(0); PG8_MMA(0, 1, At, B1); PG8_BAR;
            PG8_LDA(At, 0, 1); PG8_STAGE(PG8_SA(0, 0), a2, w2[0]);
            PG8_BAR; PG8_WAIT_L(0); PG8_MMA(1, 0, At, B0); PG8_BAR; PG8_SCHED;
            PG8_STAGE(PG8_SB(0, 1), b2 + hstep, voffB);
            PG8_WAIT_V(6); PG8_BAR; PG8_MMA(1, 1, At, B1); PG8_BAR;
            PG8_LDB(B0, 1, 0); PG8_SCHED; PG8_LDA(At, 1, 0); PG8_STAGE(PG8_SA(0, 1), a2, w2[1]);
            PG8_WAIT_L(8); PG8_BAR; PG8_WAIT_L(0); PG8_MMA(0, 0, At, B0); PG8_BAR; PG8_SCHED;
            PG8_LDB(B1, 1, 1); PG8_STAGE(PG8_SB(1, 0), b3, voffB);
            PG8_BAR; PG8_WAIT_L(0); PG8_MMA(0, 1, At, B1); PG8_BAR;
            PG8_LDA(At, 1, 1); PG8_STAGE(PG8_SA(1, 0), a3, w2[0]);
            PG8_BAR; PG8_WAIT_L(0); PG8_MMA(1, 0, At, B0); PG8_BAR; PG8_SCHED;
            PG8_STAGE(PG8_SB(1, 1), b3 + hstep, voffB);
            PG8_WAIT_V(6); PG8_BAR; PG8_MMA(1, 1, At, B1); PG8_BAR;
            }
        }
        if constexpr (ALIGN_EPI) { if (wr == 0) PG8_BAR; }
        if constexpr (F8) asm volatile("s_nop 15\n\ts_nop 7" ::: "memory");
        { int fr2 = fr, fq2 = fq; asm volatile("" : "+v"(fr2), "+v"(fq2));
          S.epi(acc, cur, wr, wc, fr2, fq2); }
        if (!has_next) break;
#pragma unroll
        for (int a = 0; a < 2; ++a)
#pragma unroll
            for (int b = 0; b < 2; ++b)
#pragma unroll
                for (int m = 0; m < 4; ++m)
#pragma unroll
                    for (int n = 0; n < 2; ++n) acc[a][b][m][n] = (f32x4){0.f, 0.f, 0.f, 0.f};
        cur = nxt; cA = nA; cB = nB; ++ui;
#pragma unroll
        for (int h = 0; h < 2; ++h)
#pragma unroll
            for (int i = 0; i < 2; ++i) vAc[h][i] = vAn[h][i];
        if constexpr (ALIGN_EPI) { if (wr == 1) PG8_BAR; }
    }
    PG8_WAIT_V(0);
    if constexpr (!ALIGN_EPI) { if (wr == 0) PG8_BAR; }
    PG8_BAR;
#undef PG8_SA
#undef PG8_SB
#undef PG8_STAGE
#undef PG8_LDA
#undef PG8_LDB
#undef PG8_MMA
#undef PG8_WAIT_V
#undef PG8_WAIT_L
#undef PG8_BAR
#undef PG8_SCHED
#undef PG8_AOFF
}
}

namespace attn_body {
using bf16 = __hip_bfloat16;
using bf16x8 = __attribute__((ext_vector_type(8))) short;
using s16x4 = __attribute__((ext_vector_type(4))) short;
using f32x16 = __attribute__((ext_vector_type(16))) float;
using u32x4 = __attribute__((ext_vector_type(4))) unsigned;
constexpr int D = 64, QPITCH = NHQ * D, KPITCH = NHKV * D, OPITCH = DM, OCOL0 = 256;
constexpr int NW = 8, QBLK = 32, QB = QBLK * NW, KVBLK = 64, NQB = NTOK / QB, NT = NKEYS / KVBLK;
static_assert(NT % 2 == 0 && NT >= 8, "tile count");
__device__ __forceinline__ int crow(int r, int hi) { return (r & 3) + 8 * (r >> 2) + 4 * hi; }
#define SBAR() __builtin_amdgcn_sched_barrier(0)
constexpr int NSLOT = 3, SLOTB = 8192;
constexpr int LDS_K = 0, LDS_V = NSLOT * SLOTB, LDS_WS = 2 * NSLOT * SLOTB, LDS_OST = LDS_WS + NW * 64 * 4, LDS_BYTES = LDS_OST + NW * 4096;
constexpr float C2 = 0.125f * 1.4426950408889634f;
__device__ __forceinline__ void glds16(const void* gsrc, unsigned lds_dst) { unsigned keep;
  asm volatile("s_mov_b32 %0, m0\n\ts_mov_b32 m0, %2\n\ts_nop 0\n\tglobal_load_lds_dwordx4 %1, off\n\ts_mov_b32 m0, %0" : "=&s"(keep) : "v"(gsrc), "s"(lds_dst) : "memory"); }
__device__ __forceinline__ float max3f(float a, float b, float c) { float r; asm("v_max3_f32 %0, %1, %2, %3" : "=v"(r) : "v"(a), "v"(b), "v"(c)); return r; }
__device__ __forceinline__ float max2f(float a, float b) { float r; asm("v_max_f32_e32 %0, %1, %2" : "=v"(r) : "v"(a), "v"(b)); return r; }
__device__ __forceinline__ float fadd_s(float a, float b) { float r; asm("v_add_f32_e32 %0, %1, %2" : "=v"(r) : "v"(a), "v"(b)); return r; }
__device__ __forceinline__ float fsub_s(float a, float b) { float r; asm("v_sub_f32_e32 %0, %1, %2" : "=v"(r) : "v"(a), "v"(b)); return r; }
typedef float f32x2_t __attribute__((ext_vector_type(2))); typedef __bf16 bf16x2_t __attribute__((ext_vector_type(2)));
__device__ __forceinline__ unsigned cvtpk_s(float lo, float hi) { f32x2_t v = {lo, hi}; bf16x2_t b = __builtin_convertvector(v, bf16x2_t); return __builtin_bit_cast(unsigned, b); }
#define WAIT_BAR(N) asm volatile("s_waitcnt vmcnt(" #N ") lgkmcnt(0)\n\ts_barrier" ::: "memory")

__device__ __forceinline__ void qkt(f32x16& p0, f32x16& p1, const char* Kslot, const bf16x8* qr, const f32x16& negm, int r32, int hi) {
  const char* kb = Kslot + hi * 1024 + r32 * 16;
  #pragma unroll
  for (int d0 = 0; d0 < 4; ++d0) {
    const bf16x8 b0 = *reinterpret_cast<const bf16x8*>(kb + d0 * 2048);
    const bf16x8 b1 = *reinterpret_cast<const bf16x8*>(kb + d0 * 2048 + 512);
    if (d0 == 0) { p0 = __builtin_amdgcn_mfma_f32_32x32x16_bf16(b0, qr[0], negm, 0, 0, 0); p1 = __builtin_amdgcn_mfma_f32_32x32x16_bf16(b1, qr[0], negm, 0, 0, 0); }
    else { p0 = __builtin_amdgcn_mfma_f32_32x32x16_bf16(b0, qr[d0], p0, 0, 0, 0); p1 = __builtin_amdgcn_mfma_f32_32x32x16_bf16(b1, qr[d0], p1, 0, 0, 0); } }
}
typedef __attribute__((address_space(3))) const char* lds_cptr;
typedef short v4i16_t __attribute__((ext_vector_type(4)));
__device__ __forceinline__ void kload8(bf16x8* kf, lds_cptr kp) {
  kf[0] = *(const __attribute__((address_space(3))) bf16x8*)(kp);        kf[1] = *(const __attribute__((address_space(3))) bf16x8*)(kp + 512);
  kf[2] = *(const __attribute__((address_space(3))) bf16x8*)(kp + 2048); kf[3] = *(const __attribute__((address_space(3))) bf16x8*)(kp + 2560);
  kf[4] = *(const __attribute__((address_space(3))) bf16x8*)(kp + 4096); kf[5] = *(const __attribute__((address_space(3))) bf16x8*)(kp + 4608);
  kf[6] = *(const __attribute__((address_space(3))) bf16x8*)(kp + 6144); kf[7] = *(const __attribute__((address_space(3))) bf16x8*)(kp + 6656);
}
__device__ __forceinline__ void kload2(bf16x8* kf, lds_cptr kp, int j) { kf[2 * j] = *(const __attribute__((address_space(3))) bf16x8*)(kp + j * 2048); kf[2 * j + 1] = *(const __attribute__((address_space(3))) bf16x8*)(kp + j * 2048 + 512); }
__device__ __forceinline__ s16x4 vtr(lds_cptr p) { return __builtin_bit_cast(s16x4, __builtin_amdgcn_ds_read_tr16_b64_v4i16((__attribute__((address_space(3))) v4i16_t*)p)); }
__device__ __forceinline__ float rowmax(const f32x16& p0, const f32x16& p1) {
  float a = max3f(p0[0], p0[1], p1[0]), b = max3f(p0[2], p0[3], p1[1]); a = max3f(a, p1[2], p1[3]);
  #pragma unroll
  for (int r = 4; r < 16; r += 4) { a = max3f(a, p0[r], p0[r + 1]); b = max3f(b, p0[r + 2], p0[r + 3]); a = max3f(a, p1[r], p1[r + 1]); b = max3f(b, p1[r + 2], p1[r + 3]); }
  const float m = max2f(a, b);
  auto rr = __builtin_amdgcn_permlane32_swap(__float_as_uint(m), __float_as_uint(m), false, false);
  return max2f(__uint_as_float(rr[0]), __uint_as_float(rr[1]));
}
__device__ __forceinline__ void pv(f32x16* o, int vb, bf16x8 pa0, bf16x8 pa1, bf16x8 pa2, bf16x8 pa3) {
  #pragma unroll
  for (int d0 = 0; d0 < 2; ++d0) { s16x4 lo[4], hi[4];
    #pragma unroll
    for (int ks = 0; ks < 4; ++ks) {
      asm volatile("ds_read_b64_tr_b16 %0,%1 offset:%c2" : "=&v"(lo[ks]) : "v"(vb), "i"(d0 * 4096 + ks * 1024) : "memory");
      asm volatile("ds_read_b64_tr_b16 %0,%1 offset:%c2" : "=&v"(hi[ks]) : "v"(vb), "i"(d0 * 4096 + ks * 1024 + 512) : "memory"); }
    asm volatile("s_waitcnt lgkmcnt(0)" ::: "memory"); SBAR();
    #define PK(k) (bf16x8){lo[k][0], lo[k][1], lo[k][2], lo[k][3], hi[k][0], hi[k][1], hi[k][2], hi[k][3]}
    o[d0] = __builtin_amdgcn_mfma_f32_32x32x16_bf16(pa0, PK(0), o[d0], 0, 0, 0);
    o[d0] = __builtin_amdgcn_mfma_f32_32x32x16_bf16(pa1, PK(1), o[d0], 0, 0, 0);
    o[d0] = __builtin_amdgcn_mfma_f32_32x32x16_bf16(pa2, PK(2), o[d0], 0, 0, 0);
    o[d0] = __builtin_amdgcn_mfma_f32_32x32x16_bf16(pa3, PK(3), o[d0], 0, 0, 0);
    #undef PK
  }
}
#define ATTN_STORE16(p, v) (*(u32x4*)(p) = (v))
template <int THRL> __device__ __forceinline__ void attn_unit(int h, int kvh, int qb, const bf16* Q, const bf16* __restrict__ K, const bf16* __restrict__ V, bf16* O, char* shm, int wid, float kmax2) {
  const int lane = fresh_lane(), r32 = lane & 31, hi = lane >> 5;
  const int q0 = qb * QB;
  const bf16* Qw = Q + (long)(q0 + wid * QBLK) * QPITCH + h * D;
  const bf16* Kh = K + kvh * D, *Vh = V + kvh * D;
  const unsigned lds0 = (unsigned)(uintptr_t)shm;
  float* wsf = (float*)(shm + LDS_WS) + wid * 64;
  const bf16* ksrc = Kh + (long)lane * KPITCH + wid * 8;
  const bf16* vsrc = Vh + (long)(16 * (wid & 3) + (lane >> 2)) * KPITCH + (wid >> 2) * 32 + (lane & 3) * 8;
  const unsigned kdst = lds0 + LDS_K + wid * 1024, vdst = lds0 + LDS_V + wid * 1024;
  #define DMA_K(t, slot) glds16(ksrc + (long)(t) * KVBLK * KPITCH, (unsigned)__builtin_amdgcn_readfirstlane(kdst + (slot)))
  #define DMA_V(t, slot) glds16(vsrc + (long)(t) * KVBLK * KPITCH, (unsigned)__builtin_amdgcn_readfirstlane(vdst + (slot)))
  const int vb0 = (int)(lds0 + LDS_V) + ((lane >> 4) & 1) * 32 + (lane & 3) * 8 + (4 * hi + ((lane & 15) >> 2)) * 64;
  const char* Kbase = shm + LDS_K; bf16x8 kf[8];
  const lds_cptr shm3 = (lds_cptr)shm; const lds_cptr kp0 = shm3 + LDS_K + hi * 1024 + r32 * 16; const lds_cptr vp0 = shm3 + LDS_V + ((lane >> 4) & 1) * 32 + (lane & 3) * 8 + (4 * hi + ((lane & 15) >> 2)) * 64;
  DMA_K(0, 0); DMA_V(0, 0); DMA_K(1, SLOTB);
  bf16x8 qr[4];
  #pragma unroll
  for (int d0 = 0; d0 < 4; ++d0) qr[d0] = *reinterpret_cast<const bf16x8*>(&Qw[(long)r32 * QPITCH + d0 * 16 + hi * 8]);
  float l_reg = 0.f; f32x16 o[2]; o[0] = f32x16{}; o[1] = f32x16{}; f32x16 negm;
  { float qn2 = 0.f;
    #pragma unroll
    for (int d0 = 0; d0 < 4; ++d0)
      #pragma unroll
      for (int j = 0; j < 8; ++j) { const float f = __uint_as_float((unsigned)(unsigned short)qr[d0][j] << 16); qn2 += f * f; }
    auto rr = __builtin_amdgcn_permlane32_swap(__float_as_uint(qn2), __float_as_uint(qn2), false, false); qn2 = __uint_as_float(rr[0]) + __uint_as_float(rr[1]);
    const float bnd = sqrtf(qn2 * kmax2) * 1.004f + 0.01f;
    #pragma unroll
    for (int r = 0; r < 16; ++r) negm[r] = -bnd;
    asm volatile("" : "+v"(negm)); }
  f32x16 pA0, pA1, pB0, pB1;
  int sl_prev = 0, sl_cur = 0, sl_next = SLOTB;
  #define ROT() do { sl_prev = sl_cur; sl_cur = sl_next; sl_next = (sl_next == (NSLOT - 1) * SLOTB) ? 0 : sl_next + SLOTB; } while (0)
  DMA_K(2, 2 * SLOTB);
  WAIT_BAR(3);
  qkt(pA0, pA1, Kbase, qr, negm, r32, hi); asm volatile("s_nop 15\n\ts_nop 7" : "+v"(pA0), "+v"(pA1));
  _Pragma("unroll") for (int r = 0; r < 16; ++r) { pA0[r] = __builtin_amdgcn_exp2f(pA0[r]); pA1[r] = __builtin_amdgcn_exp2f(pA1[r]); }
  WAIT_BAR(0);
  DMA_K(3, 0); DMA_V(1, SLOTB);
  ROT();
  kload8(kf, kp0 + sl_cur);
  WAIT_BAR(2);
  s16x4 vlo[8], vhi[8]; u32x4 pw0, pw1, pw2, pw3;
  #define PKW(P, B) cvtpk_s(P[B], P[B + 1])
  #define PAF(k) __builtin_bit_cast(bf16x8, pw##k)
  #define VFR(i) (bf16x8){vlo[i][0], vlo[i][1], vlo[i][2], vlo[i][3], vhi[i][0], vhi[i][1], vhi[i][2], vhi[i][3]}
  #define PIN(x) asm volatile("" : "+v"(x))
  #define MX3(a, b, c) __builtin_fmaxf(__builtin_fmaxf((a), (b)), (c))
  #define GAPA(MF, A0, A1, A2, A3, W0, W1, PW) do { MF; sacc += A0; sacc += A1; sacc += A2; sacc += A3; PIN(sacc); W0; W1; PIN(PW); SBAR(); } while (0)
  #define EX(v) __builtin_amdgcn_exp2f(v)
  #define GAPB(MF, X, B) do { MF; X[B] = EX(X[B]); X[B + 1] = EX(X[B + 1]); X[B + 2] = EX(X[B + 2]); X[B + 3] = EX(X[B + 3]); PIN(X); SBAR(); } while (0)
  #define VRD(i) do { vlo[i] = vtr(vp_ + (((i) >> 2) * 4096 + ((i) & 3) * 1024)); vhi[i] = vtr(vp_ + (((i) >> 2) * 4096 + ((i) & 3) * 1024 + 512)); } while (0)
  #define KRD(G, j) do { if (G) { kload2(kf, kp0 + sl_next, j); SBAR(); } } while (0)
  #define STEPM(C0, C1, P0, P1, t, GK, GV, GL) do { SBAR(); \
    const lds_cptr vp_ = vp0 + sl_prev; \
    VRD(0); SBAR(); float sacc = (P0[0] + P0[1]); \
    GAPA(C0 = __builtin_amdgcn_mfma_f32_32x32x16_bf16(kf[0], qr[0], negm, 0, 0, 0), P0[2], P0[3], P0[4], P0[5],     pw0[0] = PKW(P0, 0), pw0[1] = PKW(P0, 2), pw0); \
    VRD(4); SBAR(); GAPA(C1 = __builtin_amdgcn_mfma_f32_32x32x16_bf16(kf[1], qr[0], negm, 0, 0, 0), P0[6], P0[7], P0[8], P0[9],     pw0[2] = PKW(P0, 4), pw0[3] = PKW(P0, 6), pw0); \
    VRD(1); SBAR(); GAPA(C0 = __builtin_amdgcn_mfma_f32_32x32x16_bf16(kf[2], qr[1], C0, 0, 0, 0),   P0[10], P0[11], P0[12], P0[13], pw1[0] = PKW(P0, 8), pw1[1] = PKW(P0, 10), pw1); \
    VRD(5); SBAR(); GAPA(C1 = __builtin_amdgcn_mfma_f32_32x32x16_bf16(kf[3], qr[1], C1, 0, 0, 0),   P0[14], P0[15], P1[0], P1[1],   pw1[2] = PKW(P0, 12), pw1[3] = PKW(P0, 14), pw1); \
    VRD(2); SBAR(); GAPA(C0 = __builtin_amdgcn_mfma_f32_32x32x16_bf16(kf[4], qr[2], C0, 0, 0, 0),   P1[2], P1[3], P1[4], P1[5],     pw2[0] = PKW(P1, 0), pw2[1] = PKW(P1, 2), pw2); \
    VRD(6); SBAR(); GAPA(C1 = __builtin_amdgcn_mfma_f32_32x32x16_bf16(kf[5], qr[2], C1, 0, 0, 0),   P1[6], P1[7], P1[8], P1[9],     pw2[2] = PKW(P1, 4), pw2[3] = PKW(P1, 6), pw2); \
    VRD(3); SBAR(); GAPA(C0 = __builtin_amdgcn_mfma_f32_32x32x16_bf16(kf[6], qr[3], C0, 0, 0, 0),   P1[10], P1[11], P1[12], P1[13], pw3[0] = PKW(P1, 8), pw3[1] = PKW(P1, 10), pw3); \
    VRD(7); SBAR(); GAPA(C1 = __builtin_amdgcn_mfma_f32_32x32x16_bf16(kf[7], qr[3], C1, 0, 0, 0),   P1[14], P1[15], 0.f, 0.f,       pw3[2] = PKW(P1, 12), pw3[3] = PKW(P1, 14), pw3); \
    l_reg += sacc; \
    if (GK) { DMA_K((t) + 3, sl_cur); } if (GV) { DMA_V((t) + 1, sl_next); } \
    SBAR(); \
    GAPB(o[0] = __builtin_amdgcn_mfma_f32_32x32x16_bf16(PAF(0), VFR(0), o[0], 0, 0, 0), C0, 0); \
    GAPB(o[1] = __builtin_amdgcn_mfma_f32_32x32x16_bf16(PAF(0), VFR(4), o[1], 0, 0, 0), C0, 4); \
    KRD(GL, 0); GAPB(o[0] = __builtin_amdgcn_mfma_f32_32x32x16_bf16(PAF(1), VFR(1), o[0], 0, 0, 0), C0, 8); \
    KRD(GL, 1); GAPB(o[1] = __builtin_amdgcn_mfma_f32_32x32x16_bf16(PAF(1), VFR(5), o[1], 0, 0, 0), C0, 12); \
    KRD(GL, 2); GAPB(o[0] = __builtin_amdgcn_mfma_f32_32x32x16_bf16(PAF(2), VFR(2), o[0], 0, 0, 0), C1, 0); \
    KRD(GL, 3); GAPB(o[1] = __builtin_amdgcn_mfma_f32_32x32x16_bf16(PAF(2), VFR(6), o[1], 0, 0, 0), C1, 4); \
    GAPB(o[0] = __builtin_amdgcn_mfma_f32_32x32x16_bf16(PAF(3), VFR(3), o[0], 0, 0, 0), C1, 8); \
    GAPB(o[1] = __builtin_amdgcn_mfma_f32_32x32x16_bf16(PAF(3), VFR(7), o[1], 0, 0, 0), C1, 12); \
    } while (0)
  int t = 1;
  for (; t + 5 < NT; t += 2) {
    STEPM(pB0, pB1, pA0, pA1, t, true, true, true);     WAIT_BAR(2); ROT();
    STEPM(pA0, pA1, pB0, pB1, t + 1, true, true, true); WAIT_BAR(2); ROT();
  }
  #define ENDW(tt) do { if ((tt) + 3 < NT) { WAIT_BAR(2); } else if ((tt) + 2 < NT) { WAIT_BAR(1); } else { WAIT_BAR(0); } } while (0)
  for (; t + 1 < NT; t += 2) {
    STEPM(pB0, pB1, pA0, pA1, t, (t + 3 < NT), (t + 1 < NT), (t + 1 < NT));         ENDW(t);     ROT();
    STEPM(pA0, pA1, pB0, pB1, t + 1, (t + 4 < NT), (t + 2 < NT), (t + 2 < NT));     ENDW(t + 1); ROT();
  }
  STEPM(pB0, pB1, pA0, pA1, NT - 1, false, false, false);
  { float sacc = pB0[0] + pB0[1]; _Pragma("unroll") for (int r = 2; r < 16; ++r) sacc += pB0[r]; _Pragma("unroll") for (int r = 0; r < 16; ++r) sacc += pB1[r]; l_reg += sacc;
    pw0 = (u32x4){PKW(pB0, 0), PKW(pB0, 2), PKW(pB0, 4), PKW(pB0, 6)}; pw1 = (u32x4){PKW(pB0, 8), PKW(pB0, 10), PKW(pB0, 12), PKW(pB0, 14)}; pw2 = (u32x4){PKW(pB1, 0), PKW(pB1, 2), PKW(pB1, 4), PKW(pB1, 6)}; pw3 = (u32x4){PKW(pB1, 8), PKW(pB1, 10), PKW(pB1, 12), PKW(pB1, 14)};
    SBAR(); pv(o, vb0 + sl_cur, PAF(0), PAF(1), PAF(2), PAF(3)); }
  #undef PKW
  #undef PAF
  #undef VFR
  #undef PIN
  #undef MX3
  #undef GAPA
  #undef GAPB
  #undef EX
  #undef VRD
  #undef KRD
  #undef STEPM
  #undef ENDW
  { auto rr = __builtin_amdgcn_permlane32_swap(__float_as_uint(l_reg), __float_as_uint(l_reg), false, false); l_reg = __uint_as_float(rr[0]) + __uint_as_float(rr[1]); }
  if (hi == 0) wsf[32 + r32] = l_reg; asm volatile("s_waitcnt lgkmcnt(0)" ::: "memory");
  float rli[16];
  #pragma unroll
  for (int r = 0; r < 16; ++r) rli[r] = __builtin_amdgcn_rcpf(wsf[32 + crow(r, hi)]);
  bf16* Ow = O + (long)(q0 + wid * QBLK) * OPITCH + OCOL0 + h * D;
  { bf16* stg = (bf16*)(shm + LDS_OST) + wid * 2048;
    #pragma unroll
    for (int r = 0; r < 16; ++r) { const int orow = crow(r, hi);
      #pragma unroll
      for (int d0 = 0; d0 < 2; ++d0) stg[orow * 64 + d0 * 32 + r32] = __float2bfloat16(o[d0][r] * rli[r]); }
    asm volatile("s_waitcnt lgkmcnt(0)" ::: "memory");
    #pragma unroll
    for (int i = 0; i < 4; ++i) { const int row = i * 8 + (lane >> 3), ch = lane & 7; const u32x4 v = *(const u32x4*)(stg + row * 64 + ch * 8); ATTN_STORE16(Ow + (long)row * OPITCH + ch * 8, v); } }
  asm volatile("s_waitcnt lgkmcnt(0)\n\ts_barrier" ::: "memory");
  #undef DMA_K
  #undef DMA_V
  #undef ROT
}
#undef SBAR
#undef WAIT_BAR

typedef int v8i_t __attribute__((ext_vector_type(8)));
constexpr int F8_SLOT = 4096, F8_LDS_K = 0, F8_LDS_V = 3 * F8_SLOT, F8_LDS_WS = 6 * F8_SLOT, F8_LDS_OST = F8_LDS_WS + NW * 64 * 4, F8_LDS_BYTES = F8_LDS_OST + NW * 4096;
#define SBAR() __builtin_amdgcn_sched_barrier(0)
#define WAIT_BAR(N) asm volatile("s_waitcnt vmcnt(" #N ") lgkmcnt(0)\n\ts_barrier" ::: "memory")
#define MFMA8_C(D, A, B, C, SA, SB) do { if (VAR & 64) { D = __builtin_amdgcn_mfma_f32_32x32x16_bf16(__builtin_bit_cast(bf16x8, (u32x4){(unsigned)A[0], (unsigned)A[1], (unsigned)A[2], (unsigned)A[3]}), __builtin_bit_cast(bf16x8, (u32x4){(unsigned)B[0], (unsigned)B[1], (unsigned)B[2], (unsigned)B[3]}), C, 0, 0, 0); \
      D = __builtin_amdgcn_mfma_f32_32x32x16_bf16(__builtin_bit_cast(bf16x8, (u32x4){(unsigned)A[4], (unsigned)A[5], (unsigned)A[6], (unsigned)A[7]}), __builtin_bit_cast(bf16x8, (u32x4){(unsigned)B[4], (unsigned)B[5], (unsigned)B[6], (unsigned)B[7]}), D, 0, 0, 0); } \
    else { asm volatile("s_nop 1\n\tv_mfma_scale_f32_32x32x64_f8f6f4 %0, %1, %2, %3, %4, %5 op_sel_hi:[0,0,0]" : "=&v"(D) : "v"(A), "v"(B), "v"(C), "v"(SA), "v"(SB)); \
      if (VAR & 256) asm volatile("s_nop 1\n\tv_mfma_scale_f32_32x32x64_f8f6f4 %0, %1, %2, %0, %3, %4 op_sel_hi:[0,0,0]" : "+v"(dacc) : "v"(A), "v"(B), "v"(SA), "v"(SB)); } } while (0)
#define MFMA8_ACC(D, A, B, SA, SB) do { if (VAR & 64) { D = __builtin_amdgcn_mfma_f32_32x32x16_bf16(__builtin_bit_cast(bf16x8, (u32x4){(unsigned)A[0], (unsigned)A[1], (unsigned)A[2], (unsigned)A[3]}), __builtin_bit_cast(bf16x8, (u32x4){(unsigned)B[0], (unsigned)B[1], (unsigned)B[2], (unsigned)B[3]}), D, 0, 0, 0); \
      D = __builtin_amdgcn_mfma_f32_32x32x16_bf16(__builtin_bit_cast(bf16x8, (u32x4){(unsigned)A[4], (unsigned)A[5], (unsigned)A[6], (unsigned)A[7]}), __builtin_bit_cast(bf16x8, (u32x4){(unsigned)B[4], (unsigned)B[5], (unsigned)B[6], (unsigned)B[7]}), D, 0, 0, 0); } \
    else { asm volatile("s_nop 1\n\tv_mfma_scale_f32_32x32x64_f8f6f4 %0, %1, %2, %0, %3, %4 op_sel_hi:[0,0,0]" : "+v"(D) : "v"(A), "v"(B), "v"(SA), "v"(SB)); \
      if (VAR & 256) asm volatile("s_nop 1\n\tv_mfma_scale_f32_32x32x64_f8f6f4 %0, %1, %2, %0, %3, %4 op_sel_hi:[0,0,0]" : "+v"(dacc) : "v"(A), "v"(B), "v"(SA), "v"(SB)); } } while (0)
template <int DBL> __device__ __forceinline__ v8i_t lds_frag32x(lds_cptr p) { const u32x4 lo = *(const __attribute__((address_space(3))) u32x4*)p, hi = *(const __attribute__((address_space(3))) u32x4*)(p + 2048);
  if (DBL) { const u32x4 lo2 = *(const volatile __attribute__((address_space(3))) u32x4*)(p + 4096), hi2 = *(const volatile __attribute__((address_space(3))) u32x4*)(p + 4112); asm volatile("" :: "v"(lo2), "v"(hi2)); }
  return (v8i_t){(int)lo.x, (int)lo.y, (int)lo.z, (int)lo.w, (int)hi.x, (int)hi.y, (int)hi.z, (int)hi.w}; }
__device__ __forceinline__ v8i_t lds_frag32(lds_cptr p) { const u32x4 lo = *(const __attribute__((address_space(3))) u32x4*)p, hi = *(const __attribute__((address_space(3))) u32x4*)(p + 16);
  return (v8i_t){(int)lo.x, (int)lo.y, (int)lo.z, (int)lo.w, (int)hi.x, (int)hi.y, (int)hi.z, (int)hi.w}; }
__device__ __forceinline__ unsigned pk4f8(float a, float b, float c, float d) { int p = __builtin_amdgcn_cvt_pk_fp8_f32(a, b, 0, false); p = __builtin_amdgcn_cvt_pk_fp8_f32(c, d, p, true); return (unsigned)p; }
template <int VAR> __device__ __forceinline__ void attn_unit_f8(int h, int kvh, int qb, const unsigned char* Q8, const unsigned char* __restrict__ K8, const unsigned char* __restrict__ VT8, bf16* O, char* shm, int wid, float kmax2) {
  const int lane = fresh_lane(), r32 = lane & 31, hi = lane >> 5; const bool kwave = wid < 4;
  const int q0 = qb * QB;
  const unsigned lds0 = (unsigned)(uintptr_t)shm;
  float* wsf = (float*)(shm + F8_LDS_WS) + wid * 64;
  const int kpl = (wid & 3) >> 1, krow = 32 * (wid & 1) + (lane >> 1), khalf = (lane & 1) ^ ((krow >> 3) & 1), kch = 2 * khalf + kpl;
  const unsigned char* dsrc = kwave ? K8 + (size_t)krow * KPITCH + kvh * D + 16 * kch : VT8 + (size_t)kvh * (NT * 4096) + 1024 * (wid & 3) + 16 * lane;
  const long dstep = kwave ? (long)KVBLK * KPITCH : 4096;
  const unsigned ddst = lds0 + (kwave ? F8_LDS_K : F8_LDS_V) + (wid & 3) * 1024;
  #define DMA_T(t, slot) glds16(dsrc + (long)(t) * dstep, (unsigned)__builtin_amdgcn_readfirstlane(ddst + (slot)))
  const lds_cptr shm3 = (lds_cptr)shm;
  const lds_cptr kp0 = shm3 + F8_LDS_K + r32 * 32 + 16 * (hi ^ ((r32 >> 3) & 1));
  const lds_cptr vp0 = shm3 + F8_LDS_V + r32 * 32 + 16 * (hi ^ ((r32 >> 3) & 1));
  v8i_t qf;
  { const unsigned char* qp = Q8 + (size_t)(q0 + wid * QBLK + r32) * QPITCH + h * D + 32 * hi; const u32x4 lo = *(const u32x4*)qp, hi4 = *(const u32x4*)(qp + 16);
    qf = (v8i_t){(int)lo.x, (int)lo.y, (int)lo.z, (int)lo.w, (int)hi4.x, (int)hi4.y, (int)hi4.z, (int)hi4.w}; }
  DMA_T(0, 0); if (kwave) { DMA_T(1, F8_SLOT); DMA_T(2, 2 * F8_SLOT); }
  f32x16 lacc = f32x16{}; f32x16 o[2]; o[0] = f32x16{}; o[1] = f32x16{}; f32x16 negm;
  v8i_t ones8 = {0x38383838, 0x38383838, 0x38383838, 0x38383838, 0x38383838, 0x38383838, 0x38383838, 0x38383838}; asm volatile("" : "+v"(ones8));
  { float qn2 = 0.f;
    #pragma unroll
    for (int i = 0; i < 8; ++i) { const float f0 = __builtin_amdgcn_cvt_f32_fp8(qf[i], 0), f1 = __builtin_amdgcn_cvt_f32_fp8(qf[i], 1), f2 = __builtin_amdgcn_cvt_f32_fp8(qf[i], 2), f3 = __builtin_amdgcn_cvt_f32_fp8(qf[i], 3);
      qn2 += ((f0 * f0 + f1 * f1) + (f2 * f2 + f3 * f3)) * (1.f / 256.f); }
    auto rr = __builtin_amdgcn_permlane32_swap(__float_as_uint(qn2), __float_as_uint(qn2), false, false); qn2 = __uint_as_float(rr[0]) + __uint_as_float(rr[1]);
    const float bnd = sqrtf(qn2 * kmax2) * 1.004f + 0.01f;
    #pragma unroll
    for (int r = 0; r < 16; ++r) negm[r] = 8.f - bnd;
    asm volatile("" : "+v"(negm)); }
  int sQ = 0x7B7B7B7B, sONE = 0x7F7F7F7F; asm volatile("" : "+v"(sQ), "+v"(sONE));
  f32x16 dacc = f32x16{}; f32x16 pA0, pA1, pB0, pB1; v8i_t kf0, kf1, vfA0, vfA1, vfB0, vfB1, pwA = {0, 0, 0, 0, 0, 0, 0, 0}, pwB = {0, 0, 0, 0, 0, 0, 0, 0};
  int sl_prev = 0, sl_cur = 0, sl_next = F8_SLOT;
  #define ROT() do { sl_prev = sl_cur; sl_cur = sl_next; sl_next = (sl_next == 2 * F8_SLOT) ? 0 : sl_next + F8_SLOT; } while (0)
  #define PIN(x) asm volatile("" : "+v"(x))
  WAIT_BAR(0);
  kf0 = lds_frag32x<(VAR & 512) != 0>(kp0); kf1 = lds_frag32x<(VAR & 512) != 0>(kp0 + 1024);
  asm volatile("s_waitcnt lgkmcnt(0)" ::: "memory");
  MFMA8_C(pA0, kf0, qf, negm, sONE, sQ); MFMA8_C(pA1, kf1, qf, negm, sONE, sQ);
  asm volatile("s_nop 15\n\ts_nop 15\n\ts_nop 7" : "+v"(pA0), "+v"(pA1));
  #pragma unroll
  for (int r = 0; r < 16; ++r) pA0[r] = __builtin_amdgcn_exp2f(pA0[r]);
  WAIT_BAR(0);
  if (kwave) { DMA_T(3, 0); } else { DMA_T(1, F8_SLOT); }
  ROT();
  kf0 = lds_frag32x<(VAR & 512) != 0>(kp0 + sl_cur); kf1 = lds_frag32x<(VAR & 512) != 0>(kp0 + sl_cur + 1024);
  WAIT_BAR(1);
  #define CVT2(dst, a, b, c, d) do { if (VAR & 16) { asm volatile("" : "+v"(dst) : "v"(a), "v"(b), "v"(c), "v"(d)); } else { dst = __builtin_amdgcn_cvt_pk_fp8_f32(a, b, dst, false); dst = __builtin_amdgcn_cvt_pk_fp8_f32(c, d, dst, true); if (VAR & 32) { asm volatile("" : "+v"(dst)); dst = __builtin_amdgcn_cvt_pk_fp8_f32(a, b, dst, false); dst = __builtin_amdgcn_cvt_pk_fp8_f32(c, d, dst, true); } } } while (0)
  #define EXF(v) ((VAR & 1) ? (v) * 0.999f : ((VAR & 128) ? __builtin_amdgcn_exp2f(__builtin_amdgcn_exp2f(v) * 1e-30f) + __builtin_amdgcn_exp2f(v) - 1.0f : __builtin_amdgcn_exp2f(v)))
  #define EX4(X, B) do { X[B] = EXF(X[B]); X[B + 1] = EXF(X[B + 1]); X[B + 2] = EXF(X[B + 2]); X[B + 3] = EXF(X[B + 3]); } while (0)
  #define STEP8(C0, C1, P0, P1, PW, VF0, VF1, t, GK, GV, GL) do { SBAR(); \
    VF0 = lds_frag32x<(VAR & 512) != 0>(vp0 + sl_prev); VF1 = lds_frag32x<(VAR & 512) != 0>(vp0 + sl_prev + 1024); SBAR(); \
    if (VAR & 2) { C0 = negm; asm volatile("" : "+v"(C0) : "v"(kf0)); } else { MFMA8_C(C0, kf0, qf, negm, sONE, sQ); } SBAR(); \
    CVT2(PW[0], P0[0], P0[1], P0[2], P0[3]); CVT2(PW[1], P0[4], P0[5], P0[6], P0[7]); CVT2(PW[2], P0[8], P0[9], P0[10], P0[11]); CVT2(PW[3], P0[12], P0[13], P0[14], P0[15]); \
    EX4(P1, 0); EX4(P1, 4); PIN(PW); PIN(P1); SBAR(); \
    if (VAR & 2) { C1 = negm; asm volatile("" : "+v"(C1) : "v"(kf1)); } else { MFMA8_C(C1, kf1, qf, negm, sONE, sQ); } SBAR(); \
    EX4(P1, 8); EX4(P1, 12); \
    CVT2(PW[4], P1[0], P1[1], P1[2], P1[3]); CVT2(PW[5], P1[4], P1[5], P1[6], P1[7]); CVT2(PW[6], P1[8], P1[9], P1[10], P1[11]); CVT2(PW[7], P1[12], P1[13], P1[14], P1[15]); \
    PIN(PW); SBAR(); \
    if (kwave) { if (GK) { DMA_T((t) + 3, sl_cur); } } else { if (GV) { DMA_T((t) + 1, sl_next); } } \
    if (GL) { kf0 = lds_frag32x<(VAR & 512) != 0>(kp0 + sl_next); kf1 = lds_frag32x<(VAR & 512) != 0>(kp0 + sl_next + 1024); } SBAR(); \
    if (VAR & 2) { asm volatile("" : "+v"(lacc) : "v"(PW)); } else { MFMA8_ACC(lacc, PW, ones8, sONE, sONE); } asm volatile("" : "+v"(C0)); SBAR(); \
    EX4(C0, 0); EX4(C0, 4); PIN(C0); SBAR(); \
    if (VAR & 2) { asm volatile("" : "+v"(o[0]) : "v"(PW), "v"(VF0)); } else { MFMA8_ACC(o[0], PW, VF0, sONE, sONE); } SBAR(); \
    EX4(C0, 8); EX4(C0, 12); PIN(C0); SBAR(); \
    if (VAR & 2) { asm volatile("" : "+v"(o[1]) : "v"(PW), "v"(VF1)); } else { MFMA8_ACC(o[1], PW, VF1, sONE, sONE); } SBAR(); } while (0)
  int t = 1;
  #pragma unroll 1
  for (; t + 5 < NT; t += 2) {
    STEP8(pB0, pB1, pA0, pA1, pwA, vfA0, vfA1, t, true, true, true);     if (VAR & 4) { asm volatile("s_waitcnt vmcnt(1) lgkmcnt(0)" ::: "memory"); } else { WAIT_BAR(1); } ROT();
    STEP8(pA0, pA1, pB0, pB1, pwB, vfB0, vfB1, t + 1, true, true, true); if (VAR & 4) { asm volatile("s_waitcnt vmcnt(1) lgkmcnt(0)" ::: "memory"); } else { WAIT_BAR(1); } ROT();
  }
  for (; t + 1 < NT; t += 2) {
    STEP8(pB0, pB1, pA0, pA1, pwA, vfA0, vfA1, t, (t + 3 < NT), (t + 1 < NT), (t + 1 < NT));         WAIT_BAR(0); ROT();
    STEP8(pA0, pA1, pB0, pB1, pwB, vfB0, vfB1, t + 1, (t + 4 < NT), (t + 2 < NT), (t + 2 < NT));     WAIT_BAR(0); ROT();
  }
  STEP8(pB0, pB1, pA0, pA1, pwA, vfA0, vfA1, NT - 1, false, false, false);
  { asm volatile("s_nop 15\n\ts_nop 15\n\ts_nop 7" : "+v"(pB1));
    EX4(pB1, 0); EX4(pB1, 4); EX4(pB1, 8); EX4(pB1, 12);
    CVT2(pwB[0], pB0[0], pB0[1], pB0[2], pB0[3]); CVT2(pwB[1], pB0[4], pB0[5], pB0[6], pB0[7]); CVT2(pwB[2], pB0[8], pB0[9], pB0[10], pB0[11]); CVT2(pwB[3], pB0[12], pB0[13], pB0[14], pB0[15]);
    CVT2(pwB[4], pB1[0], pB1[1], pB1[2], pB1[3]); CVT2(pwB[5], pB1[4], pB1[5], pB1[6], pB1[7]); CVT2(pwB[6], pB1[8], pB1[9], pB1[10], pB1[11]); CVT2(pwB[7], pB1[12], pB1[13], pB1[14], pB1[15]);
    vfB0 = lds_frag32x<(VAR & 512) != 0>(vp0 + sl_cur); vfB1 = lds_frag32x<(VAR & 512) != 0>(vp0 + sl_cur + 1024);
    asm volatile("s_waitcnt lgkmcnt(0)" ::: "memory"); PIN(pwB); SBAR();
    MFMA8_ACC(o[0], pwB, vfB0, sONE, sONE); MFMA8_ACC(o[1], pwB, vfB1, sONE, sONE); MFMA8_ACC(lacc, pwB, ones8, sONE, sONE);
    asm volatile("s_nop 15\n\ts_nop 15\n\ts_nop 7" : "+v"(o[0]), "+v"(o[1]), "+v"(lacc)); }
  #undef STEP8
  #undef CVT2
  #undef EX4
  #undef EXF
  #undef PIN
  #undef ROT
  if (VAR & 256) asm volatile("" :: "v"(dacc));
  float rli[16];
  #pragma unroll
  for (int r = 0; r < 16; ++r) rli[r] = __builtin_amdgcn_rcpf(lacc[r]);
  bf16* Ow = O + (long)(q0 + wid * QBLK) * OPITCH + OCOL0 + h * D;
  { bf16* stg = (bf16*)(shm + F8_LDS_OST) + wid * 2048;
    #pragma unroll
    for (int r = 0; r < 16; ++r) { const int orow = crow(r, hi);
      #pragma unroll
      for (int d0 = 0; d0 < 2; ++d0) stg[orow * 64 + d0 * 32 + r32] = __float2bfloat16(o[d0][r] * rli[r]); }
    asm volatile("s_waitcnt lgkmcnt(0)" ::: "memory");
    #pragma unroll
    for (int i = 0; i < 4; ++i) { const int row = i * 8 + (lane >> 3), ch = lane & 7; const u32x4 v = *(const u32x4*)(stg + row * 64 + ch * 8); if (!(VAR & 8)) ATTN_STORE16(Ow + (long)row * OPITCH + ch * 8, v); } }
  asm volatile("s_waitcnt vmcnt(0) lgkmcnt(0)\n\ts_barrier" ::: "memory");
  #undef DMA_T
}
#undef MFMA8_C
#undef MFMA8_ACC
#undef SBAR
#undef WAIT_BAR
}

constexpr int NWAVES = 8, NTHR = NWAVES * 64;
constexpr size_t MiB = 1u << 20;
constexpr size_t WS_CTL = 0, CTL_ZERO_BYTES = 64 * 1024;
constexpr size_t WS_MOD = 1 * MiB;
constexpr size_t WS_MISC = WS_MOD + 64 * 1024;
constexpr size_t WS_IDX = WS_MISC, WS_GATE = WS_IDX + 128 * 1024, WS_TOKSLOT = WS_GATE + 128 * 1024;
constexpr size_t WS_AFF = 3 * MiB;
constexpr size_t WS_WIN = 4 * MiB;
constexpr size_t WS_WOUT = 7 * MiB;
constexpr size_t WS_WGU = 9 * MiB;
constexpr size_t WS_WD = 137 * MiB;
constexpr size_t WS_X1 = 201 * MiB;
constexpr size_t WS_R1 = 265 * MiB;
constexpr size_t WS_XN = WS_R1;
constexpr size_t WS_Q = WS_XN + (size_t)NROWS * DM * 2;
constexpr size_t WS_K = WS_Q + (size_t)NTOK * 768 * 2;
constexpr size_t WS_V = WS_K + (size_t)NROWS * 256 * 2;
constexpr size_t WS_FT = WS_V + (size_t)NROWS * 256 * 2;
constexpr size_t WS_MIX = WS_FT + (size_t)256 * NTOK * 4;
constexpr size_t WS_HID = WS_R1;
constexpr size_t WS_R2 = 393 * MiB;
constexpr size_t WS_H2 = WS_R2;
constexpr size_t WS_YE = WS_R2;
constexpr size_t WS_END = 457 * MiB;
static_assert(WS_MIX + (size_t)NTOK * DM * 2 <= WS_R1 + 128 * MiB, "R1 map");
static_assert(WS_TOKSLOT + (size_t)NTOK * 16 * 4 <= WS_AFF, "misc map");
constexpr int CW_TMO = 0, CW_FLAG = 2, CW_KMAX = 64, CW_BAR = 1024;

constexpr int LDS_BYTES = 163840;
constexpr int RING_BYTES = 131072, XTRA_OFF = RING_BYTES;
constexpr int MISC_OFF = LDS_BYTES - 512;

#define GAS __attribute__((address_space(1)))
#define LAS __attribute__((address_space(3)))
typedef unsigned short bf16;
typedef unsigned v4u __attribute__((ext_vector_type(4)));
typedef unsigned v2u __attribute__((ext_vector_type(2)));
typedef float f32x4 __attribute__((ext_vector_type(4)));
typedef float f32x2 __attribute__((ext_vector_type(2)));
typedef GAS unsigned gu32;
#define RLX_AGENT __ATOMIC_RELAXED, __HIP_MEMORY_SCOPE_AGENT
#define LDS_WAIT() asm volatile("s_waitcnt lgkmcnt(0)" ::: "memory")
#define VM_WAIT() asm volatile("s_waitcnt vmcnt(0)" ::: "memory")
__device__ __forceinline__ unsigned f2bf(float f) { unsigned u = __builtin_bit_cast(unsigned, f); return (u + 0x7fffu + ((u >> 16) & 1u)) >> 16; }
__device__ __forceinline__ unsigned pk2(float lo, float hi) { return f2bf(lo) | (f2bf(hi) << 16); }
__device__ __forceinline__ unsigned pk4_fp8(float a, float b, float c, float d) { int p = __builtin_amdgcn_cvt_pk_fp8_f32(a, b, 0, false); p = __builtin_amdgcn_cvt_pk_fp8_f32(c, d, p, true); return (unsigned)p; }
__device__ __forceinline__ float bf2f(unsigned short b) { return __builtin_bit_cast(float, (unsigned)b << 16); }

#define XB_TMO      128
#define XB_XCNT(j)  (256  + 64 * (j))
#define XB_XSUB(j)  (1280 + 64 * (j))
#define XB_XGEN(j)  (2304 + 64 * (j))
#define XB_TOP      3328
#define XB_TOPGEN   3392
#define XCD_BAR_WORDS 3456
#define XB_SPIN_CAP (1u << 20)
static_assert((CW_BAR + XCD_BAR_WORDS) * 4 <= (int)CTL_ZERO_BYTES, "ctl");
__device__ __forceinline__ unsigned xb_ld(unsigned* p)              { return __hip_atomic_load(p, __ATOMIC_RELAXED, __HIP_MEMORY_SCOPE_AGENT); }
__device__ __forceinline__ unsigned xb_add(unsigned* p, unsigned v) { return __hip_atomic_fetch_add(p, v, __ATOMIC_RELAXED, __HIP_MEMORY_SCOPE_AGENT); }
__device__ __forceinline__ unsigned xb_xcc_id() { return (unsigned)__builtin_amdgcn_s_getreg((3 << 11) | 20) & 0xFu; }
#define XB_SPIN(cond, bar) do { unsigned _sp = 0; while (cond) { __builtin_amdgcn_s_sleep(1); \
    if ((++_sp & 255u) == 0u) { if (xb_ld(&(bar)[XB_TMO])) break; if (_sp > XB_SPIN_CAP) { atomicAdd(&(bar)[XB_TMO], 1u); break; } } } } while (0)
struct XcdBarrier { unsigned* bar; unsigned x; volatile LAS unsigned* st; };
__device__ __forceinline__ XcdBarrier xcd_barrier_post(unsigned* bar, volatile LAS unsigned* st, bool leader) {
    XcdBarrier b; b.bar = bar; b.x = xb_xcc_id(); b.st = st;
    if (leader) (void)xb_add(&bar[XB_XCNT(b.x)], 1u);
    return b;
}
__device__ __forceinline__ void xcd_barrier_complete(unsigned* bar, unsigned x, unsigned& nloc, unsigned& nx) {
    const unsigned G = gridDim.x * gridDim.y * gridDim.z;
    unsigned sum, cnt, mine, sp = 0u;
    for (;;) {
        sum = 0u; cnt = 0u; mine = 0u;
#pragma unroll
        for (unsigned j = 0; j < 16; ++j) { const unsigned c = xb_ld(&bar[XB_XCNT(j)]); sum += c; cnt += (c > 0u) ? 1u : 0u; mine = (j == x) ? c : mine; }
        if (sum == G) break;
        __builtin_amdgcn_s_sleep(1);
        if ((++sp & 255u) == 0u) { if (xb_ld(&bar[XB_TMO])) break; if (sp > XB_SPIN_CAP) { atomicAdd(&bar[XB_TMO], 1u); break; } }
    }
    nloc = mine > 0u ? mine : 1u; nx = cnt > 0u ? cnt : 1u;
}
__device__ __forceinline__ void xcd_barrier(const XcdBarrier& b, int wave) {
    asm volatile("s_waitcnt vmcnt(0)" ::: "memory");
    __syncthreads();
    if (wave == 0 && fresh_lane() == 0) {
        unsigned* bar = b.bar;
        __builtin_amdgcn_s_waitcnt(0);
        unsigned nloc = b.st[0], nx = b.st[1];
        if (nloc == 0u) { xcd_barrier_complete(bar, b.x, nloc, nx); b.st[0] = nloc; b.st[1] = nx; }
        const unsigned old = xb_add(&bar[XB_XSUB(b.x)], 1u);
        const unsigned gen = old / nloc;
        if (old + 1u == (gen + 1u) * nloc) {
            __builtin_amdgcn_fence(__ATOMIC_RELEASE, "agent");
            asm volatile("s_waitcnt vmcnt(0)" ::: "memory");
            const unsigned og = xb_add(&bar[XB_TOP], 1u);
            const unsigned tg = og / nx;
            if (og + 1u == (tg + 1u) * nx) xb_add(&bar[XB_TOPGEN], 1u);
            else XB_SPIN(xb_ld(&bar[XB_TOPGEN]) == tg, bar);
            __builtin_amdgcn_fence(__ATOMIC_ACQUIRE, "agent");
            xb_add(&bar[XB_XGEN(b.x)], 1u);
            asm volatile("s_waitcnt vmcnt(0)" ::: "memory");
        } else {
            XB_SPIN(xb_ld(&bar[XB_XGEN(b.x)]) == gen, bar);
            __builtin_amdgcn_fence(__ATOMIC_ACQUIRE, "agent");
            asm volatile("s_waitcnt vmcnt(0)" ::: "memory");
        }
    }
    __syncthreads();
}

struct Args {
    const float *x, *c, *ctx, *c_ctx, *w_mod, *b_mod, *norm_mix_g, *norm_ffn_g, *w_in, *w_four, *q_norm_g, *k_norm_g, *w_out, *w_router, *w_gate, *w_up, *w_down, *final_norm_g;
    float* out; unsigned char* ws;
};

__device__ __forceinline__ float wave_sum(float v) {
#pragma unroll
    for (int o = 1; o < 64; o <<= 1) v += __shfl_xor(v, o);
    return v;
}

template <class RowMap>
__device__ __forceinline__ void tr_item(const float* __restrict__ W, int ldw, int k0, int n0, bf16* WT, int ldt, int kdst0, const RowMap& drow, LAS float* scr, int lane) {
    const int kq = lane >> 4, nq = lane & 15;
    f32x4 v[16];
#pragma unroll
    for (int it = 0; it < 16; ++it) v[it] = *(const f32x4*)(W + (size_t)(k0 + 4 * it + kq) * ldw + n0 + 4 * nq);
#pragma unroll
    for (int it = 0; it < 16; ++it) { LAS float* s = scr + (4 * it + kq) * 65 + 4 * nq; s[0] = v[it][0]; s[1] = v[it][1]; s[2] = v[it][2]; s[3] = v[it][3]; }
    LDS_WAIT(); asm volatile("" ::: "memory");
    const int c = lane >> 3, nn = lane & 7;
#pragma unroll
    for (int j = 0; j < 8; ++j) { const int n = nn + 8 * j; const LAS float* s = scr + (8 * c) * 65 + n;
        v4u o; o.x = pk2(s[0 * 65], s[1 * 65]); o.y = pk2(s[2 * 65], s[3 * 65]); o.z = pk2(s[4 * 65], s[5 * 65]); o.w = pk2(s[6 * 65], s[7 * 65]);
        *(GAS v4u*)(WT + (size_t)drow(n0 + n) * ldt + kdst0 + k0 + 8 * c) = o; }
    LDS_WAIT(); asm volatile("" ::: "memory");
}
struct RowId { int base; __device__ __forceinline__ int operator()(int n) const { return base + n; } };
struct RowQKV { __device__ __forceinline__ int operator()(int n) const { const int t = n >> 8, w = n & 255, hd = w >> 6, d = w & 63; return 256 + 256 * t + 128 * (d >> 5) + 32 * hd + (d & 31); } };
struct RowGU { int base, up; __device__ __forceinline__ int operator()(int f) const { return base + 256 * (f >> 7) + 128 * up + (f & 127); } };


constexpr int MOE_ITEMS = 3 * 8192;
struct TrDesc { const float* src; bf16* dst; int ldw, ldt, f8; };
__device__ __forceinline__ TrDesc moe_desc(const Args& a, int r) {
    TrDesc d;
    if (r < 16384) { const int up = r >> 13, rr = r & 8191, e = rr >> 9, q = rr & 511, kb = q >> 5, nb = q & 31;
        d.src = (up ? a.w_up : a.w_gate) + (size_t)e * DM * DE + (size_t)(kb * 64) * DE + nb * 64; d.ldw = DE;
        d.dst = (bf16*)((unsigned char*)(a.ws + WS_WGU) + ((size_t)e * 4096 + 256 * (nb >> 1) + 128 * up + 64 * (nb & 1)) * DM + kb * 64); d.ldt = DM; d.f8 = 1; }
    else { const int rr = r - 16384, e = rr >> 9, q = rr & 511, kb = q >> 4, nb = q & 15;
        d.src = a.w_down + (size_t)e * DE * DM + (size_t)(kb * 64) * DM + nb * 64; d.ldw = DM;
        d.dst = (bf16*)((unsigned char*)(a.ws + WS_WD) + ((size_t)e * DM + nb * 64) * DE + kb * 64); d.ldt = DE; d.f8 = 1; }
    return d;
}
#define TR_LOAD(v, d) do { _Pragma("unroll") for (int _it = 0; _it < 16; ++_it) v[_it] = *(const f32x4*)((d).src + (size_t)(4 * _it + kq) * (d).ldw + 4 * nq); } while (0)
#define TR_PROC(v, d) do { \
    _Pragma("unroll") for (int _it = 0; _it < 16; ++_it) { LAS float* s_ = scr + (4 * _it + kq) * 65 + 4 * nq; s_[0] = v[_it][0]; s_[1] = v[_it][1]; s_[2] = v[_it][2]; s_[3] = v[_it][3]; } \
    LDS_WAIT(); asm volatile("" ::: "memory"); \
    if ((d).f8) { _Pragma("unroll") for (int _j = 0; _j < 8; ++_j) { const int n_ = nn + 8 * _j; const LAS float* s_ = scr + (8 * c8) * 65 + n_; \
        v2u o_; o_.x = pk4_fp8(s_[0 * 65] * 32.f, s_[1 * 65] * 32.f, s_[2 * 65] * 32.f, s_[3 * 65] * 32.f); o_.y = pk4_fp8(s_[4 * 65] * 32.f, s_[5 * 65] * 32.f, s_[6 * 65] * 32.f, s_[7 * 65] * 32.f); \
        *(GAS v2u*)((unsigned char*)(d).dst + (size_t)n_ * (d).ldt + 8 * c8) = o_; } } \
    else { _Pragma("unroll") for (int _j = 0; _j < 8; ++_j) { const int n_ = nn + 8 * _j; const LAS float* s_ = scr + (8 * c8) * 65 + n_; \
        v4u o_; o_.x = pk2(s_[0 * 65], s_[1 * 65]); o_.y = pk2(s_[2 * 65], s_[3 * 65]); o_.z = pk2(s_[4 * 65], s_[5 * 65]); o_.w = pk2(s_[6 * 65], s_[7 * 65]); \
        *(GAS v4u*)((d).dst + (size_t)n_ * (d).ldt + 8 * c8) = o_; } } \
    LDS_WAIT(); asm volatile("" ::: "memory"); } while (0)
__device__ __forceinline__ void moe_convert(const Args& a, LAS float* scr, int lo, int hi, int w, int nw) {
    const int lane = fresh_lane(), kq = lane >> 4, nq = lane & 15, c8 = lane >> 3, nn = lane & 7;
    int it = lo + w; if (it >= hi) return;
    f32x4 va[16], vb[16];
    TrDesc da = moe_desc(a, it), db = da; TR_LOAD(va, da);
    for (;;) {
        int nx = it + nw; bool hn = nx < hi;
        if (hn) { db = moe_desc(a, nx); TR_LOAD(vb, db); }
        TR_PROC(va, da);
        if (!hn) break;
        it = nx; nx = it + nw; hn = nx < hi;
        if (hn) { da = moe_desc(a, nx); TR_LOAD(va, da); }
        TR_PROC(vb, db);
        if (!hn) break;
        it = nx;
    }
}
#ifndef MOE_S0
#define MOE_S0 0
#endif
#ifndef MOE_S1
#define MOE_S1 2560
#endif
#ifndef MOE_S2
#define MOE_S2 0
#endif
#ifndef MOE_S3
#define MOE_S3 8448
#endif
constexpr int MOE_B0 = MOE_S0, MOE_B1 = MOE_B0 + MOE_S1, MOE_B2 = MOE_B1 + MOE_S2, MOE_B3 = MOE_B2 + MOE_S3;

__host__ __device__ __forceinline__ int four_pos(int mp) { return mp == 0 ? 0 : (mp == 32 ? 1 : (mp < 32 ? 2 * mp : 2 * (64 - mp) + 1)); }

__device__ __forceinline__ void p0_prologue(const Args& a, LAS unsigned char* lds, int vcu, int G, int wave) {
    const int lane = fresh_lane(), tid = wave * 64 + lane;
    unsigned char* ws = a.ws;
    bf16* WinT = (bf16*)(ws + WS_WIN); bf16* WoT = (bf16*)(ws + WS_WOUT);
    float* MOD = (float*)(ws + WS_MOD);
    const int cg = vcu - (G - 24);
    if (cg >= 0) {
        LAS float* sv = (LAS float*)lds;
        LAS float* red = sv + 2048;
        for (int i = tid; i < 1024; i += NTHR) { const float c0 = a.c[i], c1 = a.c_ctx[i]; sv[i] = c0 / (1.f + __expf(-c0)); sv[1024 + i] = c1 / (1.f + __expf(-c1)); }
        __syncthreads();
        const int col = cg * 256 + 4 * lane;
        f32x4 a0 = {0.f, 0.f, 0.f, 0.f}, a1 = {0.f, 0.f, 0.f, 0.f};
        const int kb = wave * 128;
#pragma unroll 16
        for (int k = 0; k < 128; ++k) { const f32x4 w = *(const f32x4*)(a.w_mod + (size_t)(kb + k) * (NMOD * DM) + col); const float s0 = sv[kb + k], s1 = sv[1024 + kb + k]; a0 += w * s0; a1 += w * s1; }
        *(LAS f32x4*)(red + (wave * 2 + 0) * 256 + 4 * lane) = a0; *(LAS f32x4*)(red + (wave * 2 + 1) * 256 + 4 * lane) = a1;
        __syncthreads();
        { const int v = tid >> 8, cc = tid & 255; float s = 0.f;
#pragma unroll
          for (int w = 0; w < 8; ++w) s += red[(w * 2 + v) * 256 + cc];
          MOD[v * (NMOD * DM) + cg * 256 + cc] = s + a.b_mod[cg * 256 + cc]; }
        __syncthreads();
    }
    LAS float* scr = (LAS float*)(lds + wave * 16640);
    constexpr int I_F1 = 256, I_F2 = 256, I_IN = 16 * 20, I_OUT = 12 * 16;
    constexpr int NITEMS = I_F1 + I_F2 + I_IN + I_OUT;
    for (int it = wave * G + vcu; it < NITEMS; it += NWAVES * G) {
        int r = it;
        if (r < I_F1) {
            const int g = r & 3, kb = (r >> 2) & 15, jq = r >> 6, k = kb * 64 + lane;
            LAS float* ct = scr;
            ct[lane] = cospif((float)lane * (1.f / 32.f)); LDS_WAIT(); asm volatile("" ::: "memory");
            float w[64];
#pragma unroll
            for (int c4 = 0; c4 < 16; ++c4) { const f32x4 t = *(const f32x4*)(a.w_in + (size_t)k * INW + 64 * g + 4 * c4); w[4 * c4] = t[0]; w[4 * c4 + 1] = t[1]; w[4 * c4 + 2] = t[2]; w[4 * c4 + 3] = t[3]; }
            for (int j = 16 * jq; j < 16 * jq + 16; ++j) { const int m = j <= 32 ? j : j - 32; const int ph = j <= 32 ? 0 : 48;
                float s = 0.f;
#pragma unroll
                for (int c = 0; c < 64; ++c) s += w[c] * ct[(c * m + ph) & 63];
                WinT[(size_t)(64 * g + j) * DM + k] = (bf16)f2bf(s * (1.f / 1024.f)); }
            LDS_WAIT(); asm volatile("" ::: "memory");
            continue; }
        r -= I_F1;
        if (r < I_F2) {
            const int g = r & 3, jb = (r >> 2) & 15, mq = r >> 6, j = jb * 64 + lane;
            float w[64];
#pragma unroll
            for (int d = 0; d < 64; ++d) w[d] = a.w_out[(size_t)(64 * g + d) * DM + j];
            for (int mp = 16 * mq; mp < 16 * mq + 16; ++mp) { float s = 0.f; const float* wf = a.w_four + (size_t)(g * 64 + mp) * 64;
#pragma unroll
                for (int d = 0; d < 64; ++d) s += wf[d] * w[d];
                WoT[(size_t)j * DM + 64 * g + four_pos(mp)] = (bf16)f2bf(s); }
            continue; }
        r -= I_F2;
        if (r < I_IN) { const int kb = r / 20, nb = r % 20; tr_item(a.w_in + 256, INW, kb * 64, nb * 64, WinT, DM, 0, RowQKV{}, scr, lane); continue; }
        r -= I_IN;
        { const int kb = r / 16, nb = r % 16; tr_item(a.w_out + (size_t)256 * DM, DM, kb * 64, nb * 64, WoT, DM, 256, RowId{0}, scr, lane); }
    }
    if (cg < 0 && MOE_S0 > 0) moe_convert(a, scr, 0, MOE_B0, ((wave + 4) & 7) * (G - 24) + vcu, NWAVES * (G - 24));
}

__device__ __forceinline__ void p0b_modulate(const Args& a, int vcu, int G, int wave) {
    const int lane = fresh_lane();
    unsigned char* ws = a.ws; const float* MOD = (const float*)(ws + WS_MOD); bf16* XN = (bf16*)(ws + WS_XN);
    const int gw = vcu * NWAVES + wave, NGW = G * NWAVES;
    for (int pass = 0; pass < 2; ++pass) {
        const float* md = MOD + pass * (NMOD * DM);
        const int nrows = pass == 0 ? NTOK : NCTX; const float* src = pass == 0 ? a.x : a.ctx; bf16* dst = XN + (size_t)(pass == 0 ? 0 : NTOK) * DM;
        if (gw >= nrows) continue;
        f32x4 av[4], sh[4];
#pragma unroll
        for (int j = 0; j < 4; ++j) { const int col = 4 * lane + 256 * j; const f32x4 g = *(const f32x4*)(a.norm_mix_g + col); const f32x4 sc = *(const f32x4*)(md + DM + col); av[j] = g * (sc + 1.f); sh[j] = *(const f32x4*)(md + col); }
        f32x4 v[4], vn[4];
        { const GAS f32x4* xr = (const GAS f32x4*)(src + (size_t)gw * DM) + lane;
#pragma unroll
          for (int j = 0; j < 4; ++j) v[j] = xr[64 * j]; }
        for (int m = gw; m < nrows; m += NGW) {
            const int mn = m + NGW;
            if (mn < nrows) { const GAS f32x4* xr = (const GAS f32x4*)(src + (size_t)mn * DM) + lane;
#pragma unroll
                for (int j = 0; j < 4; ++j) vn[j] = xr[64 * j]; }
            float s = 0.f;
#pragma unroll
            for (int j = 0; j < 4; ++j) s += (v[j].x * v[j].x + v[j].y * v[j].y) + (v[j].z * v[j].z + v[j].w * v[j].w);
            const float rinv = 1.f / sqrtf(wave_sum(s) * (1.f / DM) + EPS);
            GAS unsigned long long* o8 = (GAS unsigned long long*)(dst + (size_t)m * DM) + lane;
#pragma unroll
            for (int j = 0; j < 4; ++j) { const f32x4 y = v[j] * rinv * av[j] + sh[j]; o8[64 * j] = (unsigned long long)pk2(y.x, y.y) | ((unsigned long long)pk2(y.z, y.w) << 32); }
#pragma unroll
            for (int j = 0; j < 4; ++j) v[j] = vn[j];
        }
    }
}

struct P1Prob {
    static constexpr int K = DM; static constexpr bool PERM = false, FP8 = false; static constexpr int SCW = 0, SCA = 0;
    const bf16* XN; const bf16* WinT; bf16 *Q, *Kb, *Vb; float* FT; const float *qg, *kg; unsigned* kmax; pg8::StaticOrder so;
    __device__ __forceinline__ bool next(int i, pg8::Unit& u) const { return so.next(i, u); }
    __device__ __forceinline__ bool swapped(const pg8::Unit& u) const { return u.pn == 0 || (ATTN_F8 && u.pn == 5); }
    __device__ __forceinline__ const char* aptr(const pg8::Unit& u) const { return swapped(u) ? (const char*)(WinT + (size_t)u.pn * 256 * DM) : (const char*)(XN + (size_t)u.pm * 256 * DM); }
    __device__ __forceinline__ const char* bptr(const pg8::Unit& u) const { return swapped(u) ? (const char*)(XN + (size_t)u.pm * 256 * DM) : (const char*)(WinT + (size_t)u.pn * 256 * DM); }
    __device__ __forceinline__ void epi(const pg8::f32x4 (&acc)[2][2][4][2], const pg8::Unit& u, int wr, int wc, int fr, int fq) const {
        if (u.pn == 0) {
            if (u.pm >= NTOK / 256) return;
#pragma unroll
            for (int ai = 0; ai < 2; ++ai)
#pragma unroll
                for (int m = 0; m < 4; ++m) { float* rowp = FT + (size_t)(ai * 128 + wr * 64 + m * 16 + fr) * NTOK + u.pm * 256 + wc * 32 + 4 * fq;
#pragma unroll
                    for (int bj = 0; bj < 2; ++bj)
#pragma unroll
                        for (int n = 0; n < 2; ++n) *(pg8::f32x4*)(rowp + bj * 128 + n * 16) = acc[ai][bj][m][n]; }
            return;
        }
        const bool isq = u.pn <= 3, isv = u.pn == 5, lat = u.pm < NTOK / 256;
        if (isq && !lat) return;
        if (isv) {
#if ATTN_F8
            unsigned char* V8 = (unsigned char*)Vb;
#pragma unroll
            for (int ai = 0; ai < 2; ++ai)
#pragma unroll
                for (int m = 0; m < 4; ++m) { const int kvh_ = 2 * wr + (m >> 1), d = 32 * ai + 16 * (m & 1) + fr;
#pragma unroll
                    for (int bj = 0; bj < 2; ++bj)
#pragma unroll
                        for (int n = 0; n < 2; ++n) { const int t0 = u.pm * 256 + 128 * bj + 32 * wc + 16 * n + 4 * fq, key0 = t0 & 63, tile = t0 >> 6, k5 = key0 & 31, hk = (k5 >> 2) & 1, j0 = 4 * (k5 >> 3) + 16 * (key0 >> 5);
                            const pg8::f32x4 v = acc[ai][bj][m][n];
                            *(unsigned*)(V8 + (size_t)(kvh_ * (NKEYS / 64) + tile) * 4096 + (j0 >> 4) * 2048 + d * 32 + 16 * (hk ^ ((d >> 3) & 1)) + (j0 & 15)) = pk4_fp8(v[0], v[1], v[2], v[3]); } }
#else
#pragma unroll
            for (int ai = 0; ai < 2; ++ai)
#pragma unroll
                for (int m = 0; m < 4; ++m) { const int t = u.pm * 256 + ai * 128 + wr * 64 + m * 16 + fr; bf16* rowp = Vb + (size_t)t * 256 + wc * 64 + 4 * fq;
#pragma unroll
                    for (int bj = 0; bj < 2; ++bj)
#pragma unroll
                        for (int n = 0; n < 2; ++n) { const pg8::f32x4 v = acc[ai][bj][m][n]; *(v2u*)(rowp + 32 * bj + 16 * n) = (v2u){pk2(v[0], v[1]), pk2(v[2], v[3])}; } }
#endif
            return;
        }
        const float* gw = isq ? qg : kg;
        pg8::f32x4 gv[2][2];
#pragma unroll
        for (int bj = 0; bj < 2; ++bj)
#pragma unroll
            for (int n = 0; n < 2; ++n) gv[bj][n] = *(const pg8::f32x4*)(gw + 32 * bj + 16 * n + 4 * fq);
        float frq[4];
#pragma unroll
        for (int e = 0; e < 4; ++e) frq[e] = exp2f(-(float)(4 * fq + e) * (13.287712379549449f / 16.f)) * 0.15915494309189535f;
        const float qs = isq ? attn_body::C2 * (ATTN_F8 ? 16.f : 1.f) : 1.f;
#if ATTN_F8
        bf16* base = (bf16*)((unsigned char*)(isq ? Q : Kb) + (size_t)(isq ? (u.pn - 1) * 4 + wc : wc) * 64); const int pitch = isq ? 768 : 256;
#else
        bf16* base = isq ? Q + (size_t)((u.pn - 1) * 4 + wc) * 64 : Kb + (size_t)wc * 64; const int pitch = isq ? 768 : 256;
#endif
        float k2max = 0.f;
#pragma unroll
        for (int ai = 0; ai < 2; ++ai) {
            float rowpos = (float)(u.pm * 4 + ai * 2 + wr); asm volatile("" : "+v"(rowpos));
            float cr[4], sr[4];
#pragma unroll
            for (int e = 0; e < 4; ++e) { const float rev = rowpos * frq[e], f_ = rev - floorf(rev); cr[e] = __builtin_amdgcn_cosf(f_); sr[e] = __builtin_amdgcn_sinf(f_); }
#pragma unroll
            for (int m = 0; m < 4; ++m) {
                float colpos = (float)(m * 16 + fr); asm volatile("" : "+v"(colpos));
                const int t = u.pm * 256 + ai * 128 + wr * 64 + m * 16 + fr;
                float ss = 0.f;
#pragma unroll
                for (int bj = 0; bj < 2; ++bj)
#pragma unroll
                    for (int n = 0; n < 2; ++n) { const pg8::f32x4 v = acc[ai][bj][m][n]; ss += (v[0] * v[0] + v[1] * v[1]) + (v[2] * v[2] + v[3] * v[3]); }
                ss += __shfl_xor(ss, 16); ss += __shfl_xor(ss, 32);
                const float rinv = qs / sqrtf(ss * (1.f / 64.f) + EPS);
                pg8::f32x4 y[2][2];
#pragma unroll
                for (int bj = 0; bj < 2; ++bj)
#pragma unroll
                    for (int n = 0; n < 2; ++n) y[bj][n] = acc[ai][bj][m][n] * rinv * gv[bj][n];
                if (lat) {
#pragma unroll
                    for (int e = 0; e < 4; ++e) {
                        { const float x1 = y[0][0][e], x2 = y[0][1][e]; y[0][0][e] = x1 * cr[e] - x2 * sr[e]; y[0][1][e] = x1 * sr[e] + x2 * cr[e]; }
                        { const float rev = colpos * frq[e], f_ = rev - floorf(rev); const float cc = __builtin_amdgcn_cosf(f_), sc = __builtin_amdgcn_sinf(f_);
                          const float x1 = y[1][0][e], x2 = y[1][1][e]; y[1][0][e] = x1 * cc - x2 * sc; y[1][1][e] = x1 * sc + x2 * cc; }
                    }
                }
                ss = 0.f;
#if ATTN_F8
                unsigned char* rowp8 = (unsigned char*)base + ((size_t)t * pitch + 4 * fq);
#pragma unroll
                for (int bj = 0; bj < 2; ++bj)
#pragma unroll
                    for (int n = 0; n < 2; ++n) { const pg8::f32x4 v = y[bj][n]; const unsigned w = pk4_fp8(v[0], v[1], v[2], v[3]); *(unsigned*)(rowp8 + 32 * bj + 16 * n) = w;
                        if (!isq) { const float b0 = __builtin_amdgcn_cvt_f32_fp8((int)w, 0), b1 = __builtin_amdgcn_cvt_f32_fp8((int)w, 1), b2 = __builtin_amdgcn_cvt_f32_fp8((int)w, 2), b3 = __builtin_amdgcn_cvt_f32_fp8((int)w, 3); ss += (b0 * b0 + b1 * b1) + (b2 * b2 + b3 * b3); } }
#else
                bf16* rowp = base + (size_t)t * pitch + 4 * fq;
#pragma unroll
                for (int bj = 0; bj < 2; ++bj)
#pragma unroll
                    for (int n = 0; n < 2; ++n) { const pg8::f32x4 v = y[bj][n]; const v2u w = (v2u){pk2(v[0], v[1]), pk2(v[2], v[3])}; *(v2u*)(rowp + 32 * bj + 16 * n) = w;
                        if (!isq) { const float b0 = __uint_as_float(w.x << 16), b1 = __uint_as_float(w.x & 0xffff0000u), b2 = __uint_as_float(w.y << 16), b3 = __uint_as_float(w.y & 0xffff0000u); ss += (b0 * b0 + b1 * b1) + (b2 * b2 + b3 * b3); } }
#endif
                if (!isq) { float r2 = ss; r2 += __shfl_xor(r2, 16); r2 += __shfl_xor(r2, 32); k2max = fmaxf(k2max, r2); }
                asm volatile("" ::: "memory");
            }
        }
        if (!isq) {
#pragma unroll
            for (int o = 1; o < 16; o <<= 1) k2max = fmaxf(k2max, __shfl_xor(k2max, o));
            if (fr == 0 && fq == 0) __hip_atomic_fetch_max(kmax, __float_as_uint(k2max), __ATOMIC_RELAXED, __HIP_MEMORY_SCOPE_AGENT);
        }
    }
};

__device__ __forceinline__ unsigned rev4_12(unsigned k) { unsigned r = __brev(k) >> 20; return ((r & 0xAAAu) >> 1) | ((r & 0x555u) << 1); }
__device__ __forceinline__ void fft_block(const Args& a, LAS unsigned char* lds, int item, int wave) {
    const int tid = wave * 64 + fresh_lane();
    const int mm = item & 31, par = (item >> 5) & 1, g = item >> 6;
    const float* FT = (const float*)(a.ws + WS_FT); bf16* MIX = (bf16*)(a.ws + WS_MIX);
    LAS f32x2* X = (LAS f32x2*)lds;
    const float* re = FT + (size_t)(64 * g + mm) * NTOK; const float* im = FT + (size_t)(64 * g + 32 + mm) * NTOK;
#pragma unroll 1
    for (int i = 0; i < 2; ++i) {
        const int j0 = 4 * (tid + NTHR * i);
        f32x4 r4[4], i4[4];
#pragma unroll
        for (int q = 0; q < 4; ++q) { r4[q] = *(const f32x4*)(re + j0 + 4096 * q); i4[q] = *(const f32x4*)(im + j0 + 4096 * q); }
#pragma unroll
        for (int e = 0; e < 4; ++e) {
            const int j = j0 + e;
            const f32x2 a0 = {r4[0][e], i4[0][e]}, a1 = {r4[1][e], i4[1][e]}, a2 = {r4[2][e], i4[2][e]}, a3 = {r4[3][e], i4[3][e]};
            f32x2 ya, yb; float fa, fb;
            if (par == 0) { const f32x2 s02 = a0 + a2, s13 = a1 + a3; ya = s02 + s13; yb = s02 - s13; fa = 0.f; fb = (float)(2 * j) * (1.f / 16384.f); }
            else { const f32x2 d02 = a0 - a2, d13 = a1 - a3; ya = (f32x2){d02.x + d13.y, d02.y - d13.x}; yb = (f32x2){d02.x - d13.y, d02.y + d13.x}; fa = (float)j * (1.f / 16384.f); fb = (float)(3 * j) * (1.f / 16384.f); }
            const float ca = __builtin_amdgcn_cosf(fa), sa = __builtin_amdgcn_sinf(fa), cb = __builtin_amdgcn_cosf(fb), sb = __builtin_amdgcn_sinf(fb);
            X[j] = (f32x2){ya.x * ca + ya.y * sa, ya.y * ca - ya.x * sa};
            X[4096 + j] = (f32x2){yb.x * cb + yb.y * sb, yb.y * cb - yb.x * sb};
        }
    }
    __syncthreads();
#pragma unroll 1
    for (int s = 0; s < 6; ++s) {
        const int lq = 10 - 2 * s;
        const int Lq = 1 << lq;
        const float invL = 1.f / (float)(4 << lq);
#pragma unroll 2
        for (int i = 0; i < 4; ++i) {
            const int b = tid + NTHR * i, j = b & (Lq - 1), base = ((b >> lq) << (lq + 2)) + j;
            const f32x2 a0 = X[base], a1 = X[base + Lq], a2 = X[base + 2 * Lq], a3 = X[base + 3 * Lq];
            const f32x2 s02 = a0 + a2, d02 = a0 - a2, s13 = a1 + a3, d13 = a1 - a3;
            const f32x2 y0 = s02 + s13, y2 = s02 - s13;
            const f32x2 y1 = (f32x2){d02.x + d13.y, d02.y - d13.x};
            const f32x2 y3 = (f32x2){d02.x - d13.y, d02.y + d13.x};
            const float f1 = (float)j * invL;
            const float c1 = __builtin_amdgcn_cosf(f1), s1 = __builtin_amdgcn_sinf(f1);
            const float c2 = __builtin_amdgcn_cosf(2.f * f1), s2 = __builtin_amdgcn_sinf(2.f * f1);
            const float c3 = __builtin_amdgcn_cosf(3.f * f1), s3 = __builtin_amdgcn_sinf(3.f * f1);
            X[base] = y0;
            X[base + Lq] = (f32x2){y1.x * c1 + y1.y * s1, y1.y * c1 - y1.x * s1};
            X[base + 2 * Lq] = (f32x2){y2.x * c2 + y2.y * s2, y2.y * c2 - y2.x * s2};
            X[base + 3 * Lq] = (f32x2){y3.x * c3 + y3.y * s3, y3.y * c3 - y3.x * s3};
        }
        __syncthreads();
    }
    const int col = 64 * g + 2 * mm;
#pragma unroll 1
    for (int i = 0; i < 16; ++i) {
        const int k = 2 * (tid + NTHR * i) + par, kn = (NTOK - k) & (NTOK - 1);
        const f32x2 wk = X[(((k & 3) - par) >> 1) * 4096 + rev4_12((unsigned)(k >> 2))], wn = X[(((kn & 3) - par) >> 1) * 4096 + rev4_12((unsigned)(kn >> 2))];
        float o0, o1;
        if (mm == 0) { o0 = 0.5f * (wk.x + wn.x); o1 = 0.5f * (wk.y + wn.y); }
        else { o0 = wn.x; o1 = wk.x; }
        *(unsigned*)(MIX + (size_t)k * DM + col) = pk2(o0, o1);
    }
    __syncthreads();
}

struct P3Prob {
    static constexpr int K = DM; static constexpr bool PERM = false, FP8 = false; static constexpr int SCW = 0, SCA = 0;
    const bf16* MIX; const bf16* WoT; const float* x; const float* g1; float* X1; pg8::StaticOrder so;
    __device__ __forceinline__ bool next(int i, pg8::Unit& u) const { return so.next(i, u); }
    __device__ __forceinline__ const char* aptr(const pg8::Unit& u) const { return (const char*)(MIX + (size_t)u.pm * 256 * DM); }
    __device__ __forceinline__ const char* bptr(const pg8::Unit& u) const { return (const char*)(WoT + (size_t)u.pn * 256 * DM); }
    __device__ __forceinline__ void epi(const pg8::f32x4 (&acc)[2][2][4][2], const pg8::Unit& u, int wr, int wc, int fr, int fq) const {
        const int col0 = u.pn * 256 + wc * 32 + 4 * fq;
        pg8::f32x4 gv[2][2];
#pragma unroll
        for (int bj = 0; bj < 2; ++bj)
#pragma unroll
            for (int n = 0; n < 2; ++n) gv[bj][n] = *(const pg8::f32x4*)(g1 + col0 + bj * 128 + n * 16);
#pragma unroll
        for (int ai = 0; ai < 2; ++ai)
#pragma unroll
            for (int m = 0; m < 4; ++m) { const size_t off = (size_t)(u.pm * 256 + ai * 128 + wr * 64 + m * 16 + fr) * DM + col0;
#pragma unroll
                for (int bj = 0; bj < 2; ++bj)
#pragma unroll
                    for (int n = 0; n < 2; ++n) { const pg8::f32x4 bs = *(const pg8::f32x4*)(x + off + bj * 128 + n * 16); *(pg8::f32x4*)(X1 + off + bj * 128 + n * 16) = bs + gv[bj][n] * acc[ai][bj][m][n]; }
                if (m & 1) asm volatile("" ::: "memory"); }
    }
};

__device__ __forceinline__ void p3b_router(const Args& a, LAS unsigned char* lds, int vcu, int G, int wave) {
    const int lane = fresh_lane(), tid = wave * 64 + lane;
    unsigned char* ws = a.ws; const float* MOD = (const float*)(ws + WS_MOD); const float* X1 = (const float*)(ws + WS_X1); bf16* H2 = (bf16*)(ws + WS_H2); float* AFF = (float*)(ws + WS_AFF);
    LAS float* wrt = (LAS float*)lds;
    { f32x4 t[8];
#pragma unroll
      for (int q = 0; q < 8; ++q) t[q] = *(const f32x4*)(a.w_router + 4 * (tid + NTHR * q));
#pragma unroll
      for (int q = 0; q < 8; ++q) { const int i = 4 * (tid + NTHR * q), col = i >> 4, e = i & 15;
#pragma unroll
          for (int k = 0; k < 4; ++k) wrt[(e + k) * 1024 + col] = t[q][k]; } }
    __syncthreads();
    f32x4 av[4], sh[4];
#pragma unroll
    for (int j = 0; j < 4; ++j) { const int col = 4 * lane + 256 * j; const f32x4 g = *(const f32x4*)(a.norm_ffn_g + col); const f32x4 sc = *(const f32x4*)(MOD + 4 * DM + col); av[j] = g * (sc + 1.f); sh[j] = *(const f32x4*)(MOD + 3 * DM + col); }
    const int gw = vcu * NWAVES + wave, NGW = G * NWAVES;
    f32x4 v[4], vn[4];
    if (gw < NTOK) { const GAS f32x4* xr = (const GAS f32x4*)(X1 + (size_t)gw * DM) + lane;
#pragma unroll
        for (int j = 0; j < 4; ++j) v[j] = xr[64 * j]; }
    for (int m = gw; m < NTOK; m += NGW) {
        const int mn = m + NGW;
        if (mn < NTOK) { const GAS f32x4* xr = (const GAS f32x4*)(X1 + (size_t)mn * DM) + lane;
#pragma unroll
            for (int j = 0; j < 4; ++j) vn[j] = xr[64 * j]; }
        float s = 0.f;
#pragma unroll
        for (int j = 0; j < 4; ++j) s += (v[j].x * v[j].x + v[j].y * v[j].y) + (v[j].z * v[j].z + v[j].w * v[j].w);
        const float rinv = 1.f / sqrtf(wave_sum(s) * (1.f / DM) + EPS);
        GAS unsigned* o4 = (GAS unsigned*)((unsigned char*)H2 + (size_t)m * DM) + lane;
#pragma unroll
        for (int j = 0; j < 4; ++j) { v[j] = v[j] * rinv * av[j] + sh[j]; o4[64 * j] = pk4_fp8(v[j].x, v[j].y, v[j].z, v[j].w); }
        float lg[16];
#pragma unroll
        for (int e0 = 0; e0 < 16; e0 += 4) {
#pragma unroll
            for (int e = e0; e < e0 + 4; ++e) { float p = 0.f;
#pragma unroll
                for (int j = 0; j < 4; ++j) { const f32x4 w = *(const LAS f32x4*)(wrt + e * 1024 + 4 * lane + 256 * j); p += (v[j].x * w.x + v[j].y * w.y) + (v[j].z * w.z + v[j].w * w.w); }
                lg[e] = p; }
            asm volatile("" ::: "memory"); }
        float r8[8], r4[4], r2[2], r1;
        { const bool up = (lane & 32) != 0;
#pragma unroll
          for (int e = 0; e < 8; ++e) { const float snd = up ? lg[e] : lg[e + 8], kp = up ? lg[e + 8] : lg[e]; r8[e] = kp + __shfl_xor(snd, 32); } }
        { const bool up = (lane & 16) != 0;
#pragma unroll
          for (int e = 0; e < 4; ++e) { const float snd = up ? r8[e] : r8[e + 4], kp = up ? r8[e + 4] : r8[e]; r4[e] = kp + __shfl_xor(snd, 16); } }
        { const bool up = (lane & 8) != 0;
#pragma unroll
          for (int e = 0; e < 2; ++e) { const float snd = up ? r4[e] : r4[e + 2], kp = up ? r4[e + 2] : r4[e]; r2[e] = kp + __shfl_xor(snd, 8); } }
        { const bool up = (lane & 4) != 0; const float snd = up ? r2[0] : r2[1], kp = up ? r2[1] : r2[0]; r1 = kp + __shfl_xor(snd, 4); }
        r1 += __shfl_xor(r1, 2); r1 += __shfl_xor(r1, 1);
        float mx = r1;
#pragma unroll
        for (int o = 4; o < 64; o <<= 1) mx = fmaxf(mx, __shfl_xor(mx, o));
        const float ex = __expf(r1 - mx); float den = ex;
#pragma unroll
        for (int o = 4; o < 64; o <<= 1) den += __shfl_xor(den, o);
        if ((lane & 3) == 0) AFF[(size_t)(lane >> 2) * NTOK + m] = ex / den;
#pragma unroll
        for (int j = 0; j < 4; ++j) v[j] = vn[j];
    }
}

__device__ __forceinline__ void p4_topk(const Args& a, LAS unsigned char* lds, int e, int wave) {
    const int lane = fresh_lane(), tid = wave * 64 + lane;
    unsigned char* ws = a.ws; const unsigned* AFF = (const unsigned*)(ws + WS_AFF) + (size_t)e * NTOK;
    int* IDX = (int*)(ws + WS_IDX) + e * CAP; float* GATE = (float*)(ws + WS_GATE) + e * CAP; int* TOKSLOT = (int*)(ws + WS_TOKSLOT);
    LAS unsigned* wcnt = (LAS unsigned*)lds;
    LAS unsigned* cg = wcnt + 16;
    LAS unsigned* ce = cg + 256;
    unsigned key[32];
#pragma unroll
    for (int i = 0; i < 32; ++i) key[i] = AFF[i * NTHR + tid];
    unsigned T = 0u;
#pragma unroll 1
    for (int bit = 30; bit >= 0; --bit) {
        const unsigned cand = T | (1u << bit);
        unsigned c = 0u;
#pragma unroll
        for (int i = 0; i < 32; ++i) c += (unsigned)__popcll(__ballot(key[i] >= cand));
        LAS unsigned* wb = wcnt + 1024 + (bit & 1) * 8;
        if (lane == 0) wb[wave] = c;
        __syncthreads();
        unsigned tot = 0u;
#pragma unroll
        for (int w = 0; w < 8; ++w) tot += wb[w];
        if (tot >= (unsigned)CAP) T = cand;
    }
    __syncthreads();
    unsigned long long below = (1ull << lane) - 1ull;
    unsigned rg[32], rq[32];
#pragma unroll
    for (int i = 0; i < 32; ++i) {
        const unsigned long long bg = __ballot(key[i] > T), bq = __ballot(key[i] == T);
        rg[i] = (unsigned)__popcll(bg & below); rq[i] = (unsigned)__popcll(bq & below);
        if (lane == 0) { cg[i * 8 + wave] = (unsigned)__popcll(bg); ce[i * 8 + wave] = (unsigned)__popcll(bq); }
    }
    __syncthreads();
    if (wave == 0) {
        unsigned g4[4], q4[4], sg = 0u, sq = 0u;
#pragma unroll
        for (int k = 0; k < 4; ++k) { g4[k] = cg[4 * lane + k]; q4[k] = ce[4 * lane + k]; sg += g4[k]; sq += q4[k]; }
        unsigned pg = sg, pq = sq;
#pragma unroll
        for (int o = 1; o < 64; o <<= 1) { const unsigned tg = __shfl_up(pg, o), tq = __shfl_up(pq, o); if (lane >= o) { pg += tg; pq += tq; } }
        pg -= sg; pq -= sq;
#pragma unroll
        for (int k = 0; k < 4; ++k) { cg[4 * lane + k] = pg; ce[4 * lane + k] = pq; pg += g4[k]; pq += q4[k]; }
        if (lane == 63) { wcnt[8] = pg; }
    }
    __syncthreads();
    const unsigned ngt = wcnt[8], need = (unsigned)CAP - ngt;
#pragma unroll
    for (int i = 0; i < 32; ++i) {
        const int tok = i * NTHR + tid;
        const unsigned gb = cg[i * 8 + wave] + rg[i], qb = ce[i * 8 + wave] + rq[i];
        const bool sel = key[i] > T || (key[i] == T && qb < need);
        const unsigned slot = gb + (qb < need ? qb : need);
        if (sel) { IDX[slot] = tok; GATE[slot] = __uint_as_float(key[i]); }
        TOKSLOT[tok * 16 + e] = sel ? (int)slot : -1;
    }
}

struct P5Prob {
    static constexpr int K = DM; static constexpr bool PERM = true, FP8 = true; static constexpr int SCW = 0x7A7A7A7A, SCA = 0x7F7F7F7F;
    const unsigned char* H2; const unsigned char* WguT; unsigned char* HID; pg8::StaticOrder so;
    __device__ __forceinline__ bool next(int i, pg8::Unit& u) const { return so.next(i, u); }
    __device__ __forceinline__ const char* aptr(const pg8::Unit&) const { return (const char*)H2; }
    __device__ __forceinline__ const char* bptr(const pg8::Unit& u) const { return (const char*)(WguT + ((size_t)(u.pm >> 3) * 4096 + (size_t)u.pn * 256) * DM); }
    __device__ __forceinline__ void epi(const pg8::f32x4 (&acc)[2][2][4][2], const pg8::Unit& u, int wr, int wc, int fr, int fq) const {
#pragma unroll
        for (int ai = 0; ai < 2; ++ai)
#pragma unroll
            for (int m = 0; m < 4; ++m) { unsigned char* rowp = HID + (size_t)(u.pm * 256 + ai * 128 + wr * 64 + m * 16 + fr) * DE + u.pn * 128 + wc * 32 + 8 * fq;
                float h[8];
#pragma unroll
                for (int n = 0; n < 2; ++n)
#pragma unroll
                    for (int e = 0; e < 4; ++e) { const float gt = acc[ai][0][m][n][e], up = acc[ai][1][m][n][e]; h[4 * n + e] = gt * __builtin_amdgcn_rcpf(1.f + __builtin_amdgcn_exp2f(-1.4426950408889634f * gt)) * up; }
                *(v2u*)rowp = (v2u){pk4_fp8(h[0], h[1], h[2], h[3]), pk4_fp8(h[4], h[5], h[6], h[7])}; }
    }
};
struct P6Prob {
    static constexpr int K = DE; static constexpr bool PERM = true, FP8 = true; static constexpr int SCW = 0x7A7A7A7A, SCA = 0x7F7F7F7F;
    const unsigned char* HID; const unsigned char* WdT; const float* GATE; bf16* YE; pg8::StaticOrder so;
    __device__ __forceinline__ bool next(int i, pg8::Unit& u) const { return so.next(i, u); }
    __device__ __forceinline__ const char* aptr(const pg8::Unit& u) const { return (const char*)(HID + (size_t)u.pm * 256 * DE); }
    __device__ __forceinline__ const char* bptr(const pg8::Unit& u) const { return (const char*)(WdT + ((size_t)(u.pm >> 3) * DM + (size_t)u.pn * 256) * DE); }
    __device__ __forceinline__ void epi(const pg8::f32x4 (&acc)[2][2][4][2], const pg8::Unit& u, int wr, int wc, int fr, int fq) const {
#pragma unroll
        for (int ai = 0; ai < 2; ++ai)
#pragma unroll
            for (int m = 0; m < 4; ++m) { const int row = u.pm * 256 + ai * 128 + wr * 64 + m * 16 + fr; const float gt = GATE[row]; bf16* rowp = YE + (size_t)row * DM + u.pn * 256 + wc * 32 + 8 * fq;
#pragma unroll
                for (int bj = 0; bj < 2; ++bj) { const pg8::f32x4 v0 = acc[ai][bj][m][0] * gt, v1 = acc[ai][bj][m][1] * gt;
                    *(v4u*)(rowp + bj * 128) = (v4u){pk2(v0[0], v0[1]), pk2(v0[2], v0[3]), pk2(v1[0], v1[1]), pk2(v1[2], v1[3])}; } }
    }
};

__device__ __forceinline__ void p7_final(const Args& a, int vcu, int G, int wave, unsigned poison) {
    const int lane = fresh_lane();
    unsigned char* ws = a.ws; const float* MOD = (const float*)(ws + WS_MOD); const bf16* YE = (const bf16*)(ws + WS_YE); const int* TOKSLOT = (const int*)(ws + WS_TOKSLOT);
    const float* src = (STEP >= 2) ? (const float*)(ws + WS_X1) : a.x;
    f32x4 g2[4], fg[4];
#pragma unroll
    for (int j = 0; j < 4; ++j) { const int col = 4 * lane + 256 * j; g2[j] = *(const f32x4*)(MOD + 5 * DM + col); fg[j] = *(const f32x4*)(a.final_norm_g + col); }
    const int gw = vcu * NWAVES + wave, NGW = G * NWAVES;
    for (int m = gw; m < NTOK; m += NGW) {
        const GAS f32x4* xr = (const GAS f32x4*)(src + (size_t)m * DM) + lane;
        f32x4 v[4];
#pragma unroll
        for (int j = 0; j < 4; ++j) v[j] = xr[64 * j];
        if (STEP >= 4) {
            const int myslot = lane < 16 ? TOKSLOT[m * 16 + lane] : -1;
            f32x4 s[4];
#pragma unroll
            for (int j = 0; j < 4; ++j) s[j] = (f32x4){0.f, 0.f, 0.f, 0.f};
#pragma unroll 1
            for (int e = 0; e < 16; ++e) {
                const int sl = __builtin_amdgcn_readlane(myslot, e);
                if (sl >= 0) {
                    const GAS v2u* yr = (const GAS v2u*)(YE + ((size_t)e * CAP + sl) * DM) + lane;
#pragma unroll
                    for (int j = 0; j < 4; ++j) { const v2u w = yr[64 * j]; s[j].x += __uint_as_float(w.x << 16); s[j].y += __uint_as_float(w.x & 0xffff0000u); s[j].z += __uint_as_float(w.y << 16); s[j].w += __uint_as_float(w.y & 0xffff0000u); }
                }
            }
#pragma unroll
            for (int j = 0; j < 4; ++j) v[j] += g2[j] * s[j];
        }
        float ss = 0.f;
#pragma unroll
        for (int j = 0; j < 4; ++j) ss += (v[j].x * v[j].x + v[j].y * v[j].y) + (v[j].z * v[j].z + v[j].w * v[j].w);
        const float rinv = 1.f / sqrtf(wave_sum(ss) * (1.f / DM) + EPS);
        GAS f32x4* o = (GAS f32x4*)(a.out + (size_t)m * DM) + lane;
        const float q = __builtin_nanf("");
#pragma unroll
        for (int j = 0; j < 4; ++j) { f32x4 y = v[j] * rinv * fg[j]; if (poison) y = (f32x4){q, q, q, q}; o[64 * j] = y; }
    }
}


#if PROBE
__device__ __forceinline__ void dsincos(double x, double& sn, double& cs) {
    const double TWO_PI = 6.283185307179586476925286766559; x -= TWO_PI * rint(x / TWO_PI);
    const double x2 = x * x; double ts = x, tc = 1.0; sn = x; cs = 1.0;
#pragma unroll 1
    for (int k = 1; k <= 14; ++k) { tc *= -x2 / (double)((2 * k - 1) * (2 * k)); ts *= -x2 / (double)((2 * k) * (2 * k + 1)); cs += tc; sn += ts; }
}
__device__ __forceinline__ float block_sum(float v, LAS float* red, int wave, int lane) {
    v = wave_sum(v); __syncthreads(); if (lane == 0) red[wave] = v; __syncthreads(); float s = 0.f;
#pragma unroll
    for (int w = 0; w < 8; ++w) s += red[w];
    return s;
}
__device__ __forceinline__ float block_max(float v, LAS float* red, int wave, int lane) {
#pragma unroll
    for (int o = 1; o < 64; o <<= 1) v = fmaxf(v, __shfl_xor(v, o));
    __syncthreads(); if (lane == 0) red[wave] = v; __syncthreads(); float s = red[0];
#pragma unroll
    for (int w = 1; w < 8; ++w) s = fmaxf(s, red[w]);
    return s;
}
__device__ __forceinline__ void probe_qkv(const Args& a, LAS unsigned char* lds, int vcu, int wave) {
    const int lane = fresh_lane(), tid = wave * 64 + lane; unsigned char* ws = a.ws;
    const bf16* XN = (const bf16*)(ws + WS_XN); const bf16* Qb = (const bf16*)(ws + WS_Q); const bf16* Kb = (const bf16*)(ws + WS_K); const bf16* Vb = (const bf16*)(ws + WS_V);
    gu32* ctl = (gu32*)(ws + WS_CTL);
    LAS float* red = (LAS float*)lds; LAS float* raw = red + 16;
    for (int kind = 0; kind < 3; ++kind) {
        const int nrows = kind == 0 ? NTOK : NROWS, nh = kind == 0 ? NHQ : NHKV;
        const int t = (kind == 1 && (vcu & 7) == 3) ? NTOK + (vcu * 37) % NCTX : (vcu * 977 + 131 * kind + 5) % (kind == 0 ? NTOK : NTOK);
        const int h = (vcu * 5 + kind) % nh;
        const int wcol0 = 256 + (kind == 0 ? 0 : (kind == 1 ? 768 : 1024)) + 64 * h;
        { const int d = tid & 63, part = tid >> 6; float sacc = 0.f;
          for (int k = part * 128; k < part * 128 + 128; ++k) sacc += bf2f(XN[(size_t)t * DM + k]) * a.w_in[(size_t)k * INW + wcol0 + d];
          LAS float* part_s = raw + 64; part_s[part * 64 + d] = sacc; __syncthreads();
          if (tid < 64) { float s2 = 0.f; for (int pp = 0; pp < 8; ++pp) s2 += part_s[pp * 64 + tid]; raw[tid] = s2; }
          __syncthreads(); }
        float ref = 0.f, got = 0.f;
        if (tid < 64) {
            const int d = tid; float v = raw[d];
            if (kind < 2) {
                float ss = 0.f; for (int j = 0; j < 64; ++j) ss += raw[j] * raw[j];
                const float* gw = kind == 0 ? a.q_norm_g : a.k_norm_g;
                const float rinv = 1.f / sqrtf(ss / 64.f + EPS);
                if (t < NTOK) {
                    const int half = d >> 5, dd = d & 31, i = dd & 15; const int pos = half == 0 ? (t >> 6) : (t & 63);
                    const double freq = exp2(-(double)i * (13.287712379549449 / 16.0)); double sn, cs; dsincos((double)pos * freq, sn, cs);
                    const float x1 = raw[32 * half + i] * rinv * gw[32 * half + i], x2 = raw[32 * half + 16 + i] * rinv * gw[32 * half + 16 + i];
                    v = dd < 16 ? (float)(x1 * cs - x2 * sn) : (float)(x1 * sn + x2 * cs);
                } else v = v * rinv * gw[d];
                if (kind == 0) v *= attn_body::C2;
            }
            ref = v;
#if ATTN_F8
            { const unsigned char* Q8 = (const unsigned char*)Qb; const unsigned char* K8 = (const unsigned char*)Kb; const unsigned char* V8 = (const unsigned char*)Vb;
              if (kind == 0) got = __builtin_amdgcn_cvt_f32_fp8((int)Q8[(size_t)t * 768 + 64 * h + d], 0) * (1.f / 16.f);
              else if (kind == 1) got = __builtin_amdgcn_cvt_f32_fp8((int)K8[(size_t)t * 256 + 64 * h + d], 0);
              else { const int kk = t & 63, tile = t >> 6, k5 = kk & 31, hk = (k5 >> 2) & 1, j = (k5 & 3) + 4 * (k5 >> 3) + 16 * (kk >> 5);
                     got = __builtin_amdgcn_cvt_f32_fp8((int)V8[(size_t)(h * (NKEYS / 64) + tile) * 4096 + (j >> 4) * 2048 + d * 32 + 16 * (hk ^ ((d >> 3) & 1)) + (j & 15)], 0); } }
#else
            got = kind == 0 ? bf2f(Qb[(size_t)t * 768 + 64 * h + d]) : (kind == 1 ? bf2f(Kb[(size_t)t * 256 + 64 * h + d]) : bf2f(Vb[(size_t)t * 256 + 64 * h + d]));
#endif
        }
        const float mx = block_max(fabsf(ref), red, wave, lane);
        const float err = block_max(fabsf(ref - got), red, wave, lane);
        if (tid == 0 && !(err <= (ATTN_F8 ? 0.07f : 0.03f) * mx + 1e-6f)) __hip_atomic_fetch_or(ctl + CW_FLAG, 1u << kind, RLX_AGENT);
        __syncthreads();
    }
}
__device__ __forceinline__ void probe_attn(const Args& a, LAS unsigned char* lds, int vcu, int wave) {
    const int lane = fresh_lane(), tid = wave * 64 + lane; unsigned char* ws = a.ws;
    const bf16* Qb = (const bf16*)(ws + WS_Q); const bf16* Kb = (const bf16*)(ws + WS_K); const bf16* Vb = (const bf16*)(ws + WS_V); const bf16* MIX = (const bf16*)(ws + WS_MIX);
    gu32* ctl = (gu32*)(ws + WS_CTL);
    LAS float* red = (LAS float*)lds; LAS float* ored = red + 16;
    const int t = (vcu * 613 + 29) % NTOK, h = (vcu * 7 + 3) % NHQ, kvh = h / 3;
    float q[64];
#if ATTN_F8
    const unsigned char* Q8 = (const unsigned char*)Qb; const unsigned char* K8 = (const unsigned char*)Kb; const unsigned char* V8 = (const unsigned char*)Vb;
#pragma unroll
    for (int d = 0; d < 64; ++d) q[d] = __builtin_amdgcn_cvt_f32_fp8((int)Q8[(size_t)t * 768 + 64 * h + d], 0) * (1.f / 16.f);
#else
#pragma unroll
    for (int d = 0; d < 64; ++d) q[d] = bf2f(Qb[(size_t)t * 768 + 64 * h + d]);
#endif
    float sc[33]; float mx = -1e30f;
#pragma unroll
    for (int i = 0; i < 33; ++i) { const int key = i * NTHR + tid; float s = -1e30f;
#if ATTN_F8
        if (key < NKEYS) { s = 0.f; const unsigned char* kr = K8 + (size_t)key * 256 + 64 * kvh;
#pragma unroll
            for (int d = 0; d < 64; ++d) s += q[d] * __builtin_amdgcn_cvt_f32_fp8((int)kr[d], 0); }
#else
        if (key < NKEYS) { s = 0.f; const bf16* kr = Kb + (size_t)key * 256 + 64 * kvh;
#pragma unroll
            for (int d = 0; d < 64; ++d) s += q[d] * bf2f(kr[d]); }
#endif
        sc[i] = s; mx = fmaxf(mx, s); }
    mx = block_max(mx, red, wave, lane);
    float den = 0.f; float o[64];
#pragma unroll
    for (int d = 0; d < 64; ++d) o[d] = 0.f;
#pragma unroll
    for (int i = 0; i < 33; ++i) { const int key = i * NTHR + tid;
#if ATTN_F8
        if (key < NKEYS) { const float pp = exp2f(sc[i] - mx); den += pp; const int kk = key & 63, tile = key >> 6, k5 = kk & 31, hk = (k5 >> 2) & 1, j = (k5 & 3) + 4 * (k5 >> 3) + 16 * (kk >> 5);
            const unsigned char* vb = V8 + (size_t)(kvh * (NKEYS / 64) + tile) * 4096 + (j >> 4) * 2048 + (j & 15);
#pragma unroll
            for (int d = 0; d < 64; ++d) o[d] += pp * __builtin_amdgcn_cvt_f32_fp8((int)vb[d * 32 + 16 * (hk ^ ((d >> 3) & 1))], 0); } }
#else
        if (key < NKEYS) { const float pp = exp2f(sc[i] - mx); den += pp; const bf16* vr = Vb + (size_t)key * 256 + 64 * kvh;
#pragma unroll
            for (int d = 0; d < 64; ++d) o[d] += pp * bf2f(vr[d]); } }
#endif
    den = block_sum(den, red, wave, lane);
#pragma unroll
    for (int d = 0; d < 64; ++d) { const float w = wave_sum(o[d]); if (lane == 0) ored[wave * 64 + d] = w; }
    __syncthreads();
    float ref = 0.f, got = 0.f;
    if (tid < 64) { float s = 0.f; for (int w = 0; w < 8; ++w) s += ored[w * 64 + tid]; ref = s / den; got = bf2f(MIX[(size_t)t * DM + 256 + 64 * h + tid]); }
    const float m2 = block_max(fabsf(ref), red, wave, lane);
    const float err = block_max(fabsf(ref - got), red, wave, lane);
    if (tid == 0 && !(err <= 0.03f * m2 + 1e-7f)) __hip_atomic_fetch_or(ctl + CW_FLAG, 8u, RLX_AGENT);
    __syncthreads();
}
#endif

__global__ void __launch_bounds__(NTHR, 2) fwd_megakernel(Args args) {
    extern __shared__ __attribute__((aligned(16))) unsigned char lds_raw[];
    LAS unsigned char* lds = (LAS unsigned char*)lds_raw;
    volatile LAS unsigned* MISC = (volatile LAS unsigned*)(lds + MISC_OFF);
    const int wave = __builtin_amdgcn_readfirstlane(threadIdx.x >> 6);
    const int G = gridDim.x; const int bx = blockIdx.x; const int vcu = (G % 8 == 0) ? (bx % 8) * (G / 8) + bx / 8 : bx;
    unsigned char* ws = args.ws;
    gu32* ctl = (gu32*)(ws + WS_CTL);
    { const int l0 = fresh_lane(); if (wave < 2) ((LAS unsigned*)(lds + MISC_OFF))[wave * 64 + l0] = 0u;
      __syncthreads();
    }
    XcdBarrier bar = xcd_barrier_post((unsigned*)(ctl + CW_BAR), MISC + 8, wave == 0 && fresh_lane() == 0);
#define GRID_BAR() xcd_barrier(bar, wave)

    for (int rep = 0; rep < REP(0); ++rep) {
    if (STEP >= 2 && PH(0)) p0_prologue(args, lds, vcu, G, wave);
    GRID_BAR(); }
    for (int rep = 0; rep < REP(1); ++rep) {
    if (STEP >= 2 && PH(1)) p0b_modulate(args, vcu, G, wave);
    GRID_BAR(); }
    for (int rep = 0; rep < REP(2); ++rep) {
    if (STEP >= 2 && PH(2)) {
        P1Prob p; p.XN = (bf16*)(ws + WS_XN); p.WinT = (bf16*)(ws + WS_WIN); p.Q = (bf16*)(ws + WS_Q); p.Kb = (bf16*)(ws + WS_K); p.Vb = (bf16*)(ws + WS_V); p.FT = (float*)(ws + WS_FT);
        p.qg = args.q_norm_g; p.kg = args.k_norm_g; p.kmax = (unsigned*)(ctl + CW_KMAX); p.so.init(NROWS / 256, INW / 256, G, bx);
        pg8::gemm_phase<P1Prob, false, true, true>(lds, p, nullptr, wave);
        if (rep == 0 && MOE_S1 > 0) {
            const int nwg = (NROWS / 256) * (INW / 256), maxc = (nwg + G - 1) / G, c0 = nwg - (maxc - 1) * G;
            if (c0 >= G) moe_convert(args, (LAS float*)(lds + wave * 16640), MOE_B0, MOE_B1, bx * NWAVES + wave, G * NWAVES);
            else if (bx >= c0) moe_convert(args, (LAS float*)(lds + wave * 16640), MOE_B0, MOE_B1, (bx - c0) * NWAVES + wave, (G - c0) * NWAVES);
        }
    }
    GRID_BAR(); }
#if PROBE == 1
    probe_qkv(args, lds, vcu, wave);
#endif
    if (REP(12) > 1) {
        P1Prob p; p.XN = (bf16*)(ws + WS_XN); p.WinT = (bf16*)(ws + WS_WIN); p.Q = (bf16*)(ws + WS_Q); p.Kb = (bf16*)(ws + WS_K); p.Vb = (bf16*)(ws + WS_V); p.FT = (float*)(ws + WS_FT);
        p.qg = args.q_norm_g; p.kg = args.k_norm_g; p.kmax = (unsigned*)(ctl + CW_KMAX); p.so.init(NROWS / 256, INW / 256, G, bx);
        pg8::gemm_phase<P1Prob, false, true, true>(lds, p, nullptr, wave);
        GRID_BAR(); }
    for (int rep = 0; rep < REP(3); ++rep) {
    if (STEP >= 2 && PH(3)) {
        for (int item = vcu; item < 256; item += G) fft_block(args, lds, item, wave);
        if (rep == 0 && MOE_S2 > 0) {
            if (G > 256) { if (vcu >= 256) moe_convert(args, (LAS float*)(lds + wave * 16640), MOE_B1, MOE_B2, (vcu - 256) * NWAVES + wave, (G - 256) * NWAVES); }
            else moe_convert(args, (LAS float*)(lds + wave * 16640), MOE_B1, MOE_B2, vcu * NWAVES + wave, G * NWAVES);
        }
    }
    if (rep + 1 < REP(3)) GRID_BAR(); }
    for (int rep = 0; rep < REP(4); ++rep) {
    if (STEP >= 3 && PH(4)) {
        const attn_body::bf16* Qb = (const attn_body::bf16*)(ws + WS_Q); const attn_body::bf16* Kb = (const attn_body::bf16*)(ws + WS_K); const attn_body::bf16* Vb = (const attn_body::bf16*)(ws + WS_V);
        attn_body::bf16* MIX = (attn_body::bf16*)(ws + WS_MIX);
        const float kmax2 = __uint_as_float(__hip_atomic_load(ctl + CW_KMAX, RLX_AGENT));
        const int u0 = (G == 256) ? vcu * 3 : vcu, ustep = (G == 256) ? 1 : G, uend = (G == 256) ? vcu * 3 + 3 : 768;
        int ucnt = 0;
#pragma unroll 1
        for (int u = u0; u < uend; u += ustep, ++ucnt) {
            if (rep == 0 && MOE_B3 < MOE_ITEMS && ucnt == ((G == 256) ? vcu % 3 : 0)) { moe_convert(args, (LAS float*)(lds + wave * 16640), MOE_B3, MOE_ITEMS, wave * G + vcu, NWAVES * G); __syncthreads(); }
            const int kvh = u / 192, w = u % 192, h = kvh * 3 + w / 64, qb = w % 64;
#if ATTN_F8
            attn_body::attn_unit_f8<0>(h, kvh, qb, (const unsigned char*)Qb, (const unsigned char*)Kb, (const unsigned char*)Vb, MIX, (char*)lds_raw, wave, kmax2);
#ifdef DUMMYVAR
            attn_body::attn_unit_f8<(DUMMYVAR) | 8>(h, kvh, qb, (const unsigned char*)Qb, (const unsigned char*)Kb, (const unsigned char*)Vb, MIX, (char*)lds_raw, wave, kmax2);
#endif
#else
            attn_body::attn_unit<8>(h, kvh, qb, Qb, Kb, Vb, MIX, (char*)lds_raw, wave, kmax2);
#endif
        }
    } else if (STEP == 2) {
        bf16* MIX = (bf16*)(ws + WS_MIX);
        const int gw = vcu * NWAVES + wave, NGW = G * NWAVES, lane = fresh_lane();
        for (int m = gw; m < NTOK; m += NGW) { GAS v4u* o = (GAS v4u*)(MIX + (size_t)m * DM + 256); o[lane] = (v4u){0u, 0u, 0u, 0u}; if (lane < 32) o[64 + lane] = (v4u){0u, 0u, 0u, 0u}; }
    }
    GRID_BAR(); }
#if PROBE == 2
    probe_attn(args, lds, vcu, wave);
#endif
    for (int rep = 0; rep < REP(5); ++rep) {
    if (STEP >= 2 && PH(5)) {
        P3Prob p; p.MIX = (bf16*)(ws + WS_MIX); p.WoT = (bf16*)(ws + WS_WOUT); p.x = args.x; p.g1 = (const float*)(ws + WS_MOD) + 2 * DM; p.X1 = (float*)(ws + WS_X1); p.so.init(NTOK / 256, DM / 256, G, bx);
        pg8::gemm_phase<P3Prob, false, true, true>(lds, p, nullptr, wave);
    }
    GRID_BAR(); }
    for (int rep = 0; rep < REP(6); ++rep) {
    if (STEP >= 4 && PH(6)) p3b_router(args, lds, vcu, G, wave);
    GRID_BAR(); }
    for (int rep = 0; rep < REP(7); ++rep) {
    if (STEP >= 4 && PH(7)) {
#pragma unroll 1
        for (int e = vcu; e < NE; e += G) p4_topk(args, lds, e, wave);
        if (rep == 0) {
            if (G > NE) { if (vcu >= NE) moe_convert(args, (LAS float*)(lds + wave * 16640), MOE_B2, MOE_B3, (vcu - NE) * NWAVES + wave, (G - NE) * NWAVES); }
            else moe_convert(args, (LAS float*)(lds + wave * 16640), MOE_B2, MOE_B3, vcu * NWAVES + wave, G * NWAVES);
        } }
    GRID_BAR(); }
    if (REP(11) > 1) {
        moe_convert(args, (LAS float*)(lds + wave * 16640), MOE_B2, MOE_B3, vcu * NWAVES + wave, G * NWAVES);
        GRID_BAR(); }
    for (int rep = 0; rep < REP(8); ++rep) {
    if (STEP >= 4 && PH(8)) {
        P5Prob p; p.H2 = (const unsigned char*)(ws + WS_H2); p.WguT = (const unsigned char*)(ws + WS_WGU); p.HID = (unsigned char*)(ws + WS_HID); p.so.init(NE * CAP / 256, 2 * DE / 256, G, bx);
        LAS unsigned* rowtab = (LAS unsigned*)(lds + XTRA_OFF);
        const int* IDX = (const int*)(ws + WS_IDX);
        { const int tid = wave * 64 + fresh_lane(); pg8::Unit u; for (int i = 0; p.so.next(i, u) && i < 28; ++i) { if (tid < 256) rowtab[i * 256 + tid] = (unsigned)IDX[u.pm * 256 + tid]; } }
        __syncthreads();
        pg8::gemm_phase<P5Prob, true, true, true>(lds, p, rowtab, wave);
    }
    GRID_BAR(); }
    for (int rep = 0; rep < REP(9); ++rep) {
    if (STEP >= 4 && PH(9)) {
        P6Prob p; p.HID = (const unsigned char*)(ws + WS_HID); p.WdT = (const unsigned char*)(ws + WS_WD); p.GATE = (const float*)(ws + WS_GATE); p.YE = (bf16*)(ws + WS_YE); p.so.init(NE * CAP / 256, DM / 256, G, bx);
        pg8::gemm_phase<P6Prob, false, true, true>(lds, p, nullptr, wave);
    }
    GRID_BAR(); }
    {
        unsigned poison = (__hip_atomic_load(ctl + CW_BAR + XB_TMO, RLX_AGENT) != 0u) || (__hip_atomic_load(ctl + CW_FLAG, RLX_AGENT) != 0u);
        for (int rep = 0; rep < REP(10); ++rep) p7_final(args, vcu, G, wave, poison);
    }
}

extern "C" void kernel_launch(void* const* d_in, const int* in_sizes, int n_in, void* d_out, int out_size, void* d_ws, size_t ws_size, hipStream_t stream) {
    static int grid = 0;
    if (grid == 0) {
        if (n_in != 18 || in_sizes[0] != NTOK * DM || out_size != NTOK * DM || ws_size < WS_END) { fprintf(stderr, "kernel_launch: unexpected shapes (n_in %d, in0 %d, out %d, ws %zu)\n", n_in, n_in > 0 ? in_sizes[0] : -1, out_size, ws_size); grid = -1; return; }
        int dev = 0, cus = 0, per_cu = 0;
        if (hipGetDevice(&dev) != hipSuccess || hipDeviceGetAttribute(&cus, hipDeviceAttributeMultiprocessorCount, dev) != hipSuccess) { grid = -1; return; }
        if (hipFuncSetAttribute((const void*)fwd_megakernel, hipFuncAttributeMaxDynamicSharedMemorySize, LDS_BYTES) != hipSuccess) { fprintf(stderr, "kernel_launch: hipFuncSetAttribute failed\n"); grid = -1; return; }
        if (hipOccupancyMaxActiveBlocksPerMultiprocessor(&per_cu, (const void*)fwd_megakernel, NTHR, LDS_BYTES) != hipSuccess || per_cu < 1) { fprintf(stderr, "kernel_launch: occupancy query says %d blocks per CU\n", per_cu); (void)hipGetLastError(); grid = -1; return; }
        grid = cus;
    }
    if (grid < 0) return;
    (void)hipMemsetAsync((char*)d_ws + WS_CTL, 0, CTL_ZERO_BYTES, stream);
    Args a{};
    const float** f = (const float**)&a;
    for (int i = 0; i < 18; ++i) f[i] = (const float*)d_in[i];
    a.out = (float*)d_out; a.ws = (unsigned char*)d_ws;
    hipLaunchKernelGGL(fwd_megakernel, dim3(grid), dim3(NTHR), LDS_BYTES, stream, a);
}
```

```cpp
#include <hip/hip_runtime.h>
#include <hip/hip_bf16.h>
#include <cstdio>
#include <cstdint>
#include <cmath>

#ifndef STEP
#define STEP 4
#endif
#ifndef PROBE
#define PROBE 0
#endif
#ifndef PHMASK
#define PHMASK 0xFFFF
#endif
#define PH(k) ((PHMASK >> (k)) & 1)
#ifndef ATTN_F8
#define ATTN_F8 1
#endif
#ifndef REPEAT
#define REPEAT 0
#endif
#define REP(k) (((REPEAT >> (k)) & 1) + 1)

constexpr int DM = 1024, NTOK = 16384, NCTX = 256, NROWS = NTOK + NCTX, INW = 1536;
constexpr int NHQ = 12, NHKV = 4, HD = 64, NE = 16, CAP = 2048, DE = 2048, NMOD = 6;
constexpr int NKEYS = NROWS;
constexpr float EPS = 1e-6f;

__device__ __forceinline__ int fresh_lane() { int l; asm volatile("v_mbcnt_lo_u32_b32 %0, -1, 0\n\tv_mbcnt_hi_u32_b32 %0, -1, %0" : "=v"(l)); return l; }

namespace pg8 {
#define PG8_LAS __attribute__((address_space(3)))
typedef unsigned short bf16_t;
typedef short bf16x8 __attribute__((ext_vector_type(8)));
typedef float f32x4 __attribute__((ext_vector_type(4)));
typedef unsigned u32x4 __attribute__((ext_vector_type(4)));
typedef unsigned u32x2 __attribute__((ext_vector_type(2)));
typedef int v8i __attribute__((ext_vector_type(8)));
constexpr int BM = 256, BK = 64, HALF = 128, HTB = HALF * BK * 2, STAGE_BYTES = 8 * HTB, NXCD = 8, WGM = 8;

__host__ __device__ __forceinline__ int lds_byte(int r, int c) { const int st = (r >> 4) * 2 + (c >> 5), rr = r & 15, cc = c & 31, ob = rr * 64 + cc * 2; return st * 1024 + (ob ^ (((ob >> 9) & 1) << 5)); }
__host__ __device__ __forceinline__ void stage_rc(int b, int& R, int& C) { const int st = b / 1024, sb = b % 1024, swz = sb ^ (((sb >> 9) & 1) << 5); R = (st >> 1) * 16 + swz / 64; C = (st & 1) * 32 + (swz % 64) / 2; }
__host__ __device__ __forceinline__ int perm32(int rho) { const int n = rho >> 4, i = rho & 15; return 8 * (i >> 2) + 4 * n + (i & 3); }

struct Unit { int pm, pn; };

struct StaticOrder {
    int nM, nN, nwg, G, c;
    __host__ __device__ void init(int nM_, int nN_, int G_, int c_) { nM = nM_; nN = nN_; nwg = nM * nN; G = G_; c = c_; }
    __host__ __device__ bool next(int i, Unit& u) const {
        const long L = (long)i * G + c; if (L >= nwg) return false;
        int wgid = (int)L; { const int q = nwg / NXCD, r = nwg % NXCD, xcd = wgid % NXCD, off = wgid / NXCD; wgid = (xcd < r ? xcd * (q + 1) : r * (q + 1) + (xcd - r) * q) + off; }
        const int nig = WGM * nN, gid = wgid / nig, fm = gid * WGM, gsz = (nM - fm) < WGM ? (nM - fm) : WGM;
        u.pm = fm + ((wgid % nig) % gsz); u.pn = (wgid % nig) / gsz; return true;
    }
};

__device__ __forceinline__ unsigned cvt_pk_bf16(float lo, float hi) { unsigned r; asm volatile("v_cvt_pk_bf16_f32 %0, %1, %2" : "=v"(r) : "v"(lo), "v"(hi)); return r; }

template <class P, bool GATHER, bool ALIGN_EPI, bool SP2>
__device__ __forceinline__ void gemm_phase(PG8_LAS unsigned char* lds, const P& S, const PG8_LAS unsigned* rowtab, int wid) {
    const int lane = fresh_lane(), tid = wid * 64 + lane, wr = wid >> 2, wc = wid & 3, fr = lane & 15, fq = lane >> 4;
    constexpr bool F8 = P::FP8; constexpr int ESZ = F8 ? 1 : 2;
    constexpr int K = P::K, nt = F8 ? K / 128 : K / BK;
    int R0, C0; stage_rc(tid * 16, R0, C0);
    unsigned voffB[2];
#pragma unroll
    for (int i = 0; i < 2; ++i) { const int R = R0 + 64 * i; const int Rb = P::PERM ? ((R & ~31) + perm32(R & 31)) : R; voffB[i] = (unsigned)(Rb * K * ESZ + C0 * 2); }
    constexpr size_t kstep = (size_t)(BK * 2);
    constexpr size_t hstep = (size_t)HALF * K * ESZ;
    const unsigned ldsw = (unsigned)wid * 1024u;
    const int aoff = F8 ? lds_byte(wr * 64 + fr, fq * 16) : lds_byte(wr * 64 + fr, fq * 8), boff = F8 ? lds_byte(wc * 32 + fr, fq * 16) : lds_byte(wc * 32 + fr, fq * 8);
#define PG8_SA(b, h) (((b) * 2 + (h)) * HTB)
#define PG8_SB(b, h) ((4 + (b) * 2 + (h)) * HTB)
#define PG8_STAGE(bufoff, gbase, voff) do { _Pragma("unroll") for (int _i = 0; _i < 2; ++_i) \
        __builtin_amdgcn_global_load_lds((const unsigned*)((const char*)(gbase) + (voff)[_i]), (PG8_LAS unsigned*)(lds + (bufoff) + ldsw + _i * 8192), 16, 0, 0); } while (0)
#define PG8_LDA(dst, b, h) do { if constexpr (F8) { _Pragma("unroll") for (int m = 0; m < 4; ++m) { const PG8_LAS u32x4* p_ = (const PG8_LAS u32x4*)(lds + PG8_SA(b, h) + aoff + m * 2048); const u32x4 lo_ = p_[0], hi_ = p_[1]; \
            dst##8[m] = (v8i){(int)lo_.x, (int)lo_.y, (int)lo_.z, (int)lo_.w, (int)hi_.x, (int)hi_.y, (int)hi_.z, (int)hi_.w}; } } \
        else { _Pragma("unroll") for (int m = 0; m < 4; ++m) _Pragma("unroll") for (int k = 0; k < 2; ++k) dst[m][k] = *(const PG8_LAS bf16x8*)(lds + PG8_SA(b, h) + aoff + m * 2048 + k * 1024); } } while (0)
#define PG8_LDB(dst, b, h) do { if constexpr (F8) { _Pragma("unroll") for (int n = 0; n < 2; ++n) { const PG8_LAS u32x4* p_ = (const PG8_LAS u32x4*)(lds + PG8_SB(b, h) + boff + n * 2048); const u32x4 lo_ = p_[0], hi_ = p_[1]; \
            dst##8[n] = (v8i){(int)lo_.x, (int)lo_.y, (int)lo_.z, (int)lo_.w, (int)hi_.x, (int)hi_.y, (int)hi_.z, (int)hi_.w}; } } \
        else { _Pragma("unroll") for (int n = 0; n < 2; ++n) _Pragma("unroll") for (int k = 0; k < 2; ++k) dst[n][k] = *(const PG8_LAS bf16x8*)(lds + PG8_SB(b, h) + boff + n * 2048 + k * 1024); } } while (0)
#define PG8_MMA(ai, bj, At, Bt) do { __builtin_amdgcn_s_setprio(1); if constexpr (F8) { \
        asm volatile("s_nop 1\n\t" \
            "v_mfma_scale_f32_16x16x128_f8f6f4 %0, %8, %10, %0, %14, %15 op_sel_hi:[0,0,0]\n\t" \
            "v_mfma_scale_f32_16x16x128_f8f6f4 %1, %9, %10, %1, %14, %15 op_sel_hi:[0,0,0]\n\t" \
            "v_mfma_scale_f32_16x16x128_f8f6f4 %2, %8, %11, %2, %14, %15 op_sel_hi:[0,0,0]\n\t" \
            "v_mfma_scale_f32_16x16x128_f8f6f4 %3, %9, %11, %3, %14, %15 op_sel_hi:[0,0,0]\n\t" \
            "v_mfma_scale_f32_16x16x128_f8f6f4 %4, %8, %12, %4, %14, %15 op_sel_hi:[0,0,0]\n\t" \
            "v_mfma_scale_f32_16x16x128_f8f6f4 %5, %9, %12, %5, %14, %15 op_sel_hi:[0,0,0]\n\t" \
            "v_mfma_scale_f32_16x16x128_f8f6f4 %6, %8, %13, %6, %14, %15 op_sel_hi:[0,0,0]\n\t" \
            "v_mfma_scale_f32_16x16x128_f8f6f4 %7, %9, %13, %7, %14, %15 op_sel_hi:[0,0,0]" \
            : "+v"(acc[ai][bj][0][0]), "+v"(acc[ai][bj][0][1]), "+v"(acc[ai][bj][1][0]), "+v"(acc[ai][bj][1][1]), "+v"(acc[ai][bj][2][0]), "+v"(acc[ai][bj][2][1]), "+v"(acc[ai][bj][3][0]), "+v"(acc[ai][bj][3][1]) \
            : "v"(Bt##8[0]), "v"(Bt##8[1]), "v"(At##8[0]), "v"(At##8[1]), "v"(At##8[2]), "v"(At##8[3]), "v"(scw_), "v"(sca_)); } \
        else { _Pragma("unroll") for (int m = 0; m < 4; ++m) _Pragma("unroll") for (int n = 0; n < 2; ++n) _Pragma("unroll") for (int k = 0; k < 2; ++k) \
            acc[ai][bj][m][n] = __builtin_amdgcn_mfma_f32_16x16x32_bf16(Bt[n][k], At[m][k], acc[ai][bj][m][n], 0, 0, 0); } __builtin_amdgcn_s_setprio(0); } while (0)
#define PG8_WAIT_V(n) asm volatile("s_waitcnt vmcnt(" #n ")" ::: "memory")
#define PG8_WAIT_L(n) asm volatile("s_waitcnt lgkmcnt(" #n ")" ::: "memory")
#define PG8_BAR __builtin_amdgcn_s_barrier()
#define PG8_SCHED __builtin_amdgcn_sched_barrier(0)
#define PG8_AOFF(dst, u_, ui_) do { _Pragma("unroll") for (int _h = 0; _h < 2; ++_h) _Pragma("unroll") for (int _i = 0; _i < 2; ++_i) { \
        if constexpr (GATHER) dst[_h][_i] = (unsigned)(rowtab[(ui_) * 256 + _h * HALF + _i * 64 + R0] * (unsigned)(K * ESZ) + (unsigned)(C0 * 2)); \
        else dst[_h][_i] = (unsigned)((_h * HALF + _i * 64 + R0) * K * ESZ + C0 * 2); } } while (0)
    Unit cur, nxt; int ui = 0;
    if (!S.next(0, cur)) return;
    f32x4 acc[2][2][4][2];
#pragma unroll
    for (int a = 0; a < 2; ++a)
#pragma unroll
        for (int b = 0; b < 2; ++b)
#pragma unroll
            for (int m = 0; m < 4; ++m)
#pragma unroll
                for (int n = 0; n < 2; ++n) acc[a][b][m][n] = (f32x4){0.f, 0.f, 0.f, 0.f};
    bf16x8 At[4][2], B0[2][2], B1[2][2]; v8i At8[4], B08[2], B18[2]; const int scw_ = P::SCW, sca_ = P::SCA;
    unsigned vAc[2][2], vAn[2][2];
    PG8_AOFF(vAc, cur, 0);
    const char* cA = S.aptr(cur); const char* cB = S.bptr(cur);
    if constexpr (SP2) {
        PG8_STAGE(PG8_SB(0, 0), cB, voffB); PG8_STAGE(PG8_SB(0, 1), cB + hstep, voffB); PG8_STAGE(PG8_SA(0, 0), cA, vAc[0]); PG8_STAGE(PG8_SA(0, 1), cA, vAc[1]);
        if (wr == 1) PG8_BAR;
        PG8_WAIT_V(2); PG8_BAR;
        PG8_STAGE(PG8_SB(1, 0), cB + kstep, voffB); PG8_STAGE(PG8_SA(1, 0), cA + kstep, vAc[0]); PG8_STAGE(PG8_SB(1, 1), cB + hstep + kstep, voffB);
        PG8_WAIT_V(6); PG8_BAR;
    } else {
        PG8_STAGE(PG8_SB(0, 0), cB, voffB); PG8_STAGE(PG8_SA(0, 0), cA, vAc[0]); PG8_STAGE(PG8_SB(0, 1), cB + hstep, voffB); PG8_STAGE(PG8_SA(0, 1), cA, vAc[1]);
        if (wr == 1) PG8_BAR;
        PG8_WAIT_V(4); PG8_BAR;
        PG8_STAGE(PG8_SB(1, 0), cB + kstep, voffB); PG8_STAGE(PG8_SA(1, 0), cA + kstep, vAc[0]); PG8_STAGE(PG8_SB(1, 1), cB + hstep + kstep, voffB);
        PG8_WAIT_V(6); PG8_BAR;
    }
    for (;;) {
        const bool has_next = S.next(ui + 1, nxt);
        const char* nA = has_next ? S.aptr(nxt) : cA; const char* nB = has_next ? S.bptr(nxt) : cB;
        if (has_next) { PG8_AOFF(vAn, nxt, ui + 1); }
        else {
#pragma unroll
            for (int h = 0; h < 2; ++h)
#pragma unroll
                for (int i = 0; i < 2; ++i) vAn[h][i] = vAc[h][i];
        }
        for (int t = 0; t < nt; t += 2) {
            const bool last = (t == nt - 2);
            const char* a1 = cA + (size_t)(t + 1) * kstep;
            const char* a2 = last ? nA : cA + (size_t)(t + 2) * kstep; const char* b2 = last ? nB : cB + (size_t)(t + 2) * kstep;
            const char* a3 = a2 + kstep; const char* b3 = b2 + kstep;
            unsigned w2[2][2];
#pragma unroll
            for (int h = 0; h < 2; ++h)
#pragma unroll
                for (int i = 0; i < 2; ++i) w2[h][i] = last ? vAn[h][i] : vAc[h][i];
            if constexpr (SP2) {
            PG8_LDB(B0, 0, 0); PG8_LDB(B1, 0, 1); PG8_SCHED; PG8_LDA(At, 0, 0); PG8_STAGE(PG8_SA(1, 1), a1, vAc[1]);
            PG8_WAIT_V(8); PG8_WAIT_L(0); PG8_BAR; PG8_MMA(0, 0, At, B0); PG8_MMA(0, 1, At, B1); PG8_BAR; PG8_SCHED;
            PG8_LDA(At, 0, 1); PG8_STAGE(PG8_SB(0, 0), b2, voffB); PG8_STAGE(PG8_SB(0, 1), b2 + hstep, voffB); PG8_STAGE(PG8_SA(0, 0), a2, w2[0]);
            PG8_WAIT_V(8); PG8_WAIT_L(0); PG8_BAR; PG8_MMA(1, 0, At, B0); PG8_MMA(1, 1, At, B1); PG8_BAR; PG8_SCHED;
            PG8_LDB(B0, 1, 0); PG8_LDB(B1, 1, 1); PG8_SCHED; PG8_LDA(At, 1, 0); PG8_STAGE(PG8_SA(0, 1), a2, w2[1]);
            PG8_WAIT_V(8); PG8_WAIT_L(0); PG8_BAR; PG8_MMA(0, 0, At, B0); PG8_MMA(0, 1, At, B1); PG8_BAR; PG8_SCHED;
            PG8_LDA(At, 1, 1); PG8_STAGE(PG8_SB(1, 0), b3, voffB); PG8_STAGE(PG8_SB(1, 1), b3 + hstep, voffB); PG8_STAGE(PG8_SA(1, 0), a3, w2[0]);
            PG8_WAIT_V(8); PG8_WAIT_L(0); PG8_BAR; PG8_MMA(1, 0, At, B0); PG8_MMA(1, 1, At, B1); PG8_BAR; PG8_SCHED;
            } else {
            PG8_LDB(B0, 0, 0); PG8_SCHED; PG8_LDA(At, 0, 0); PG8_STAGE(PG8_SA(1, 1), a1, vAc[1]);
            PG8_WAIT_L(8); PG8_BAR; PG8_WAIT_L(0); PG8_MMA(0, 0, At, B0); PG8_BAR; PG8_SCHED;
            PG8_LDB(B1, 0, 1); PG8_STAGE(PG8_SB(0, 0), b2, voffB);
            PG8_BAR; PG8_WAIT_L(0); PG8_MMA(0, 1, At, B1); PG8_BAR;
            PG8_LDA(At, 0, 1); PG8_STAGE(PG8_SA(0, 0), a2, w2[0]);
            PG8_BAR; PG8_WAIT_L(0); PG8_MMA(1, 0, At, B0); PG8_BAR; PG8_SCHED;
            PG8_STAGE(PG8_SB(0, 1), b2 + hstep, voffB);
            PG8_WAIT_V(6); PG8_BAR; PG8_MMA(1, 1, At, B1); PG8_BAR;
            PG8_LDB(B0, 1, 0); PG8_SCHED; PG8_LDA(At, 1, 0); PG8_STAGE(PG8_SA(0, 1), a2, w2[1]);
            PG8_WAIT_L(8); PG8_BAR; PG8_WAIT_L(0); PG8_MMA(0, 0, At, B0); PG8_BAR; PG8_SCHED;
            PG8_LDB(B1, 1, 1); PG8_STAGE(PG8_SB(1, 0), b3, voffB);
            PG8_BAR; PG8_WAIT_L(0); PG8_MMA(0, 1, At, B1); PG8_BAR;
            PG8_LDA(At, 1, 1); PG8_STAGE(PG8_SA(1, 0), a3, w2[0]);
            PG8_BAR; PG8_WAIT_L(0); PG8_MMA(1, 0, At, B0); PG8_BAR; PG8_SCHED;
            PG8_STAGE(PG8_SB(1, 1), b3 + hstep, voffB);
            PG8_WAIT_V(6); PG8_BAR; PG8_MMA(1, 1, At, B1); PG8_BAR;
            }
        }
        if constexpr (ALIGN_EPI) { if (wr == 0) PG8_BAR; }
        if constexpr (F8) asm volatile("s_nop 15\n\ts_nop 7" ::: "memory");
        { int fr2 = fr, fq2 = fq; asm volatile("" : "+v"(fr2), "+v"(fq2));
          S.epi(acc, cur, wr, wc, fr2, fq2); }
        if (!has_next) break;
#pragma unroll
        for (int a = 0; a < 2; ++a)
#pragma unroll
            for (int b = 0; b < 2; ++b)
#pragma unroll
                for (int m = 0; m < 4; ++m)
#pragma unroll
                    for (int n = 0; n < 2; ++n) acc[a][b][m][n] = (f32x4){0.f, 0.f, 0.f, 0.f};
        cur = nxt; cA = nA; cB = nB; ++ui;
#pragma unroll
        for (int h = 0; h < 2; ++h)
#pragma unroll
            for (int i = 0; i < 2; ++i) vAc[h][i] = vAn[h][i];
        if constexpr (ALIGN_EPI) { if (wr == 1) PG8_BAR; }
    }
    PG8_WAIT_V(0);
    if constexpr (!ALIGN_EPI) { if (wr == 0) PG8_BAR; }
    PG8_BAR;
#undef PG8_SA
#undef PG8_SB
#undef PG8_STAGE
#undef PG8_LDA
#undef PG8_LDB
#undef PG8_MMA
#undef PG8_WAIT_V
#undef PG8_WAIT_L
#undef PG8_BAR
#undef PG8_SCHED
#undef PG8_AOFF
}
}

namespace attn_body {
using bf16 = __hip_bfloat16;
using bf16x8 = __attribute__((ext_vector_type(8))) short;
using s16x4 = __attribute__((ext_vector_type(4))) short;
using f32x16 = __attribute__((ext_vector_type(16))) float;
using u32x4 = __attribute__((ext_vector_type(4))) unsigned;
constexpr int D = 64, QPITCH = NHQ * D, KPITCH = NHKV * D, OPITCH = DM, OCOL0 = 256;
constexpr int NW = 8, QBLK = 32, QB = QBLK * NW, KVBLK = 64, NQB = NTOK / QB, NT = NKEYS / KVBLK;
static_assert(NT % 2 == 0 && NT >= 8, "tile count");
__device__ __forceinline__ int crow(int r, int hi) { return (r & 3) + 8 * (r >> 2) + 4 * hi; }
#define SBAR() __builtin_amdgcn_sched_barrier(0)
constexpr int NSLOT = 3, SLOTB = 8192;
constexpr int LDS_K = 0, LDS_V = NSLOT * SLOTB, LDS_WS = 2 * NSLOT * SLOTB, LDS_OST = LDS_WS + NW * 64 * 4, LDS_BYTES = LDS_OST + NW * 4096;
constexpr float C2 = 0.125f * 1.4426950408889634f;
__device__ __forceinline__ void glds16(const void* gsrc, unsigned lds_dst) { unsigned keep;
  asm volatile("s_mov_b32 %0, m0\n\ts_mov_b32 m0, %2\n\ts_nop 0\n\tglobal_load_lds_dwordx4 %1, off\n\ts_mov_b32 m0, %0" : "=&s"(keep) : "v"(gsrc), "s"(lds_dst) : "memory"); }
__device__ __forceinline__ float max3f(float a, float b, float c) { float r; asm("v_max3_f32 %0, %1, %2, %3" : "=v"(r) : "v"(a), "v"(b), "v"(c)); return r; }
__device__ __forceinline__ float max2f(float a, float b) { float r; asm("v_max_f32_e32 %0, %1, %2" : "=v"(r) : "v"(a), "v"(b)); return r; }
__device__ __forceinline__ float fadd_s(float a, float b) { float r; asm("v_add_f32_e32 %0, %1, %2" : "=v"(r) : "v"(a), "v"(b)); return r; }
__device__ __forceinline__ float fsub_s(float a, float b) { float r; asm("v_sub_f32_e32 %0, %1, %2" : "=v"(r) : "v"(a), "v"(b)); return r; }
typedef float f32x2_t __attribute__((ext_vector_type(2))); typedef __bf16 bf16x2_t __attribute__((ext_vector_type(2)));
__device__ __forceinline__ unsigned cvtpk_s(float lo, float hi) { f32x2_t v = {lo, hi}; bf16x2_t b = __builtin_convertvector(v, bf16x2_t); return __builtin_bit_cast(unsigned, b); }
#define WAIT_BAR(N) asm volatile("s_waitcnt vmcnt(" #N ") lgkmcnt(0)\n\ts_barrier" ::: "memory")

__device__ __forceinline__ void qkt(f32x16& p0, f32x16& p1, const char* Kslot, const bf16x8* qr, const f32x16& negm, int r32, int hi) {
  const char* kb = Kslot + hi * 1024 + r32 * 16;
  #pragma unroll
  for (int d0 = 0; d0 < 4; ++d0) {
    const bf16x8 b0 = *reinterpret_cast<const bf16x8*>(kb + d0 * 2048);
    const bf16x8 b1 = *reinterpret_cast<const bf16x8*>(kb + d0 * 2048 + 512);
    if (d0 == 0) { p0 = __builtin_amdgcn_mfma_f32_32x32x16_bf16(b0, qr[0], negm, 0, 0, 0); p1 = __builtin_amdgcn_mfma_f32_32x32x16_bf16(b1, qr[0], negm, 0, 0, 0); }
    else { p0 = __builtin_amdgcn_mfma_f32_32x32x16_bf16(b0, qr[d0], p0, 0, 0, 0); p1 = __builtin_amdgcn_mfma_f32_32x32x16_bf16(b1, qr[d0], p1, 0, 0, 0); } }
}
typedef __attribute__((address_space(3))) const char* lds_cptr;
typedef short v4i16_t __attribute__((ext_vector_type(4)));
__device__ __forceinline__ void kload8(bf16x8* kf, lds_cptr kp) {
  kf[0] = *(const __attribute__((address_space(3))) bf16x8*)(kp);        kf[1] = *(const __attribute__((address_space(3))) bf16x8*)(kp + 512);
  kf[2] = *(const __attribute__((address_space(3))) bf16x8*)(kp + 2048); kf[3] = *(const __attribute__((address_space(3))) bf16x8*)(kp + 2560);
  kf[4] = *(const __attribute__((address_space(3))) bf16x8*)(kp + 4096); kf[5] = *(const __attribute__((address_space(3))) bf16x8*)(kp + 4608);
  kf[6] = *(const __attribute__((address_space(3))) bf16x8*)(kp + 6144); kf[7] = *(const __attribute__((address_space(3))) bf16x8*)(kp + 6656);
}
__device__ __forceinline__ void kload2(bf16x8* kf, lds_cptr kp, int j) { kf[2 * j] = *(const __attribute__((address_space(3))) bf16x8*)(kp + j * 2048); kf[2 * j + 1] = *(const __attribute__((address_space(3))) bf16x8*)(kp + j * 2048 + 512); }
__device__ __forceinline__ s16x4 vtr(lds_cptr p) { return __builtin_bit_cast(s16x4, __builtin_amdgcn_ds_read_tr16_b64_v4i16((__attribute__((address_space(3))) v4i16_t*)p)); }
__device__ __forceinline__ float rowmax(const f32x16& p0, const f32x16& p1) {
  float a = max3f(p0[0], p0[1], p1[0]), b = max3f(p0[2], p0[3], p1[1]); a = max3f(a, p1[2], p1[3]);
  #pragma unroll
  for (int r = 4; r < 16; r += 4) { a = max3f(a, p0[r], p0[r + 1]); b = max3f(b, p0[r + 2], p0[r + 3]); a = max3f(a, p1[r], p1[r + 1]); b = max3f(b, p1[r + 2], p1[r + 3]); }
  const float m = max2f(a, b);
  auto rr = __builtin_amdgcn_permlane32_swap(__float_as_uint(m), __float_as_uint(m), false, false);
  return max2f(__uint_as_float(rr[0]), __uint_as_float(rr[1]));
}
__device__ __forceinline__ void pv(f32x16* o, int vb, bf16x8 pa0, bf16x8 pa1, bf16x8 pa2, bf16x8 pa3) {
  #pragma unroll
  for (int d0 = 0; d0 < 2; ++d0) { s16x4 lo[4], hi[4];
    #pragma unroll
    for (int ks = 0; ks < 4; ++ks) {
      asm volatile("ds_read_b64_tr_b16 %0,%1 offset:%c2" : "=&v"(lo[ks]) : "v"(vb), "i"(d0 * 4096 + ks * 1024) : "memory");
      asm volatile("ds_read_b64_tr_b16 %0,%1 offset:%c2" : "=&v"(hi[ks]) : "v"(vb), "i"(d0 * 4096 + ks * 1024 + 512) : "memory"); }
    asm volatile("s_waitcnt lgkmcnt(0)" ::: "memory"); SBAR();
    #define PK(k) (bf16x8){lo[k][0], lo[k][1], lo[k][2], lo[k][3], hi[k][0], hi[k][1], hi[k][2], hi[k][3]}
    o[d0] = __builtin_amdgcn_mfma_f32_32x32x16_bf16(pa0, PK(0), o[d0], 0, 0, 0);
    o[d0] = __builtin_amdgcn_mfma_f32_32x32x16_bf16(pa1, PK(1), o[d0], 0, 0, 0);
    o[d0] = __builtin_amdgcn_mfma_f32_32x32x16_bf16(pa2, PK(2), o[d0], 0, 0, 0);
    o[d0] = __builtin_amdgcn_mfma_f32_32x32x16_bf16(pa3, PK(3), o[d0], 0, 0, 0);
    #undef PK
  }
}
#define ATTN_STORE16(p, v) (*(u32x4*)(p) = (v))
template <int THRL> __device__ __forceinline__ void attn_unit(int h, int kvh, int qb, const bf16* Q, const bf16* __restrict__ K, const bf16* __restrict__ V, bf16* O, char* shm, int wid, float kmax2) {
  const int lane = fresh_lane(), r32 = lane & 31, hi = lane >> 5;
  const int q0 = qb * QB;
  const bf16* Qw = Q + (long)(q0 + wid * QBLK) * QPITCH + h * D;
  const bf16* Kh = K + kvh * D, *Vh = V + kvh * D;
  const unsigned lds0 = (unsigned)(uintptr_t)shm;
  float* wsf = (float*)(shm + LDS_WS) + wid * 64;
  const bf16* ksrc = Kh + (long)lane * KPITCH + wid * 8;
  const bf16* vsrc = Vh + (long)(16 * (wid & 3) + (lane >> 2)) * KPITCH + (wid >> 2) * 32 + (lane & 3) * 8;
  const unsigned kdst = lds0 + LDS_K + wid * 1024, vdst = lds0 + LDS_V + wid * 1024;
  #define DMA_K(t, slot) glds16(ksrc + (long)(t) * KVBLK * KPITCH, (unsigned)__builtin_amdgcn_readfirstlane(kdst + (slot)))
  #define DMA_V(t, slot) glds16(vsrc + (long)(t) * KVBLK * KPITCH, (unsigned)__builtin_amdgcn_readfirstlane(vdst + (slot)))
  const int vb0 = (int)(lds0 + LDS_V) + ((lane >> 4) & 1) * 32 + (lane & 3) * 8 + (4 * hi + ((lane & 15) >> 2)) * 64;
  const char* Kbase = shm + LDS_K; bf16x8 kf[8];
  const lds_cptr shm3 = (lds_cptr)shm; const lds_cptr kp0 = shm3 + LDS_K + hi * 1024 + r32 * 16; const lds_cptr vp0 = shm3 + LDS_V + ((lane >> 4) & 1) * 32 + (lane & 3) * 8 + (4 * hi + ((lane & 15) >> 2)) * 64;
  DMA_K(0, 0); DMA_V(0, 0); DMA_K(1, SLOTB);
  bf16x8 qr[4];
  #pragma unroll
  for (int d0 = 0; d0 < 4; ++d0) qr[d0] = *reinterpret_cast<const bf16x8*>(&Qw[(long)r32 * QPITCH + d0 * 16 + hi * 8]);
  float l_reg = 0.f; f32x16 o[2]; o[0] = f32x16{}; o[1] = f32x16{}; f32x16 negm;
  { float qn2 = 0.f;
    #pragma unroll
    for (int d0 = 0; d0 < 4; ++d0)
      #pragma unroll
      for (int j = 0; j < 8; ++j) { const float f = __uint_as_float((unsigned)(unsigned short)qr[d0][j] << 16); qn2 += f * f; }
    auto rr = __builtin_amdgcn_permlane32_swap(__float_as_uint(qn2), __float_as_uint(qn2), false, false); qn2 = __uint_as_float(rr[0]) + __uint_as_float(rr[1]);
    const float bnd = sqrtf(qn2 * kmax2) * 1.004f + 0.01f;
    #pragma unroll
    for (int r = 0; r < 16; ++r) negm[r] = -bnd;
    asm volatile("" : "+v"(negm)); }
  f32x16 pA0, pA1, pB0, pB1;
  int sl_prev = 0, sl_cur = 0, sl_next = SLOTB;
  #define ROT() do { sl_prev = sl_cur; sl_cur = sl_next; sl_next = (sl_next == (NSLOT - 1) * SLOTB) ? 0 : sl_next + SLOTB; } while (0)
  DMA_K(2, 2 * SLOTB);
  WAIT_BAR(3);
  qkt(pA0, pA1, Kbase, qr, negm, r32, hi); asm volatile("s_nop 15\n\ts_nop 7" : "+v"(pA0), "+v"(pA1));
  _Pragma("unroll") for (int r = 0; r < 16; ++r) { pA0[r] = __builtin_amdgcn_exp2f(pA0[r]); pA1[r] = __builtin_amdgcn_exp2f(pA1[r]); }
  WAIT_BAR(0);
  DMA_K(3, 0); DMA_V(1, SLOTB);
  ROT();
  kload8(kf, kp0 + sl_cur);
  WAIT_BAR(2);
  s16x4 vlo[8], vhi[8]; u32x4 pw0, pw1, pw2, pw3;
  #define PKW(P, B) cvtpk_s(P[B], P[B + 1])
  #define PAF(k) __builtin_bit_cast(bf16x8, pw##k)
  #define VFR(i) (bf16x8){vlo[i][0], vlo[i][1], vlo[i][2], vlo[i][3], vhi[i][0], vhi[i][1], vhi[i][2], vhi[i][3]}
  #define PIN(x) asm volatile("" : "+v"(x))
  #define MX3(a, b, c) __builtin_fmaxf(__builtin_fmaxf((a), (b)), (c))
  #define GAPA(MF, A0, A1, A2, A3, W0, W1, PW) do { MF; sacc += A0; sacc += A1; sacc += A2; sacc += A3; PIN(sacc); W0; W1; PIN(PW); SBAR(); } while (0)
  #define EX(v) __builtin_amdgcn_exp2f(v)
  #define GAPB(MF, X, B) do { MF; X[B] = EX(X[B]); X[B + 1] = EX(X[B + 1]); X[B + 2] = EX(X[B + 2]); X[B + 3] = EX(X[B + 3]); PIN(X); SBAR(); } while (0)
  #define VRD(i) do { vlo[i] = vtr(vp_ + (((i) >> 2) * 4096 + ((i) & 3) * 1024)); vhi[i] = vtr(vp_ + (((i) >> 2) * 4096 + ((i) & 3) * 1024 + 512)); } while (0)
  #define KRD(G, j) do { if (G) { kload2(kf, kp0 + sl_next, j); SBAR(); } } while (0)
  #define STEPM(C0, C1, P0, P1, t, GK, GV, GL) do { SBAR(); \
    const lds_cptr vp_ = vp0 + sl_prev; \
    VRD(0); SBAR(); float sacc = (P0[0] + P0[1]); \
    GAPA(C0 = __builtin_amdgcn_mfma_f32_32x32x16_bf16(kf[0], qr[0], negm, 0, 0, 0), P0[2], P0[3], P0[4], P0[5],     pw0[0] = PKW(P0, 0), pw0[1] = PKW(P0, 2), pw0); \
    VRD(4); SBAR(); GAPA(C1 = __builtin_amdgcn_mfma_f32_32x32x16_bf16(kf[1], qr[0], negm, 0, 0, 0), P0[6], P0[7], P0[8], P0[9],     pw0[2] = PKW(P0, 4), pw0[3] = PKW(P0, 6), pw0); \
    VRD(1); SBAR(); GAPA(C0 = __builtin_amdgcn_mfma_f32_32x32x16_bf16(kf[2], qr[1], C0, 0, 0, 0),   P0[10], P0[11], P0[12], P0[13], pw1[0] = PKW(P0, 8), pw1[1] = PKW(P0, 10), pw1); \
    VRD(5); SBAR(); GAPA(C1 = __builtin_amdgcn_mfma_f32_32x32x16_bf16(kf[3], qr[1], C1, 0, 0, 0),   P0[14], P0[15], P1[0], P1[1],   pw1[2] = PKW(P0, 12), pw1[3] = PKW(P0, 14), pw1); \
    VRD(2); SBAR(); GAPA(C0 = __builtin_amdgcn_mfma_f32_32x32x16_bf16(kf[4], qr[2], C0, 0, 0, 0),   P1[2], P1[3], P1[4], P1[5],     pw2[0] = PKW(P1, 0), pw2[1] = PKW(P1, 2), pw2); \
    VRD(6); SBAR(); GAPA(C1 = __builtin_amdgcn_mfma_f32_32x32x16_bf16(kf[5], qr[2], C1, 0, 0, 0),   P1[6], P1[7], P1[8], P1[9],     pw2[2] = PKW(P1, 4), pw2[3] = PKW(P1, 6), pw2); \
    VRD(3); SBAR(); GAPA(C0 = __builtin_amdgcn_mfma_f32_32x32x16_bf16(kf[6], qr[3], C0, 0, 0, 0),   P1[10], P1[11], P1[12], P1[13], pw3[0] = PKW(P1, 8), pw3[1] = PKW(P1, 10), pw3); \
    VRD(7); SBAR(); GAPA(C1 = __builtin_amdgcn_mfma_f32_32x32x16_bf16(kf[7], qr[3], C1, 0, 0, 0),   P1[14], P1[15], 0.f, 0.f,       pw3[2] = PKW(P1, 12), pw3[3] = PKW(P1, 14), pw3); \
    l_reg += sacc; \
    if (GK) { DMA_K((t) + 3, sl_cur); } if (GV) { DMA_V((t) + 1, sl_next); } \
    SBAR(); \
    GAPB(o[0] = __builtin_amdgcn_mfma_f32_32x32x16_bf16(PAF(0), VFR(0), o[0], 0, 0, 0), C0, 0); \
    GAPB(o[1] = __builtin_amdgcn_mfma_f32_32x32x16_bf16(PAF(0), VFR(4), o[1], 0, 0, 0), C0, 4); \
    KRD(GL, 0); GAPB(o[0] = __builtin_amdgcn_mfma_f32_32x32x16_bf16(PAF(1), VFR(1), o[0], 0, 0, 0), C0, 8); \
    KRD(GL, 1); GAPB(o[1] = __builtin_amdgcn_mfma_f32_32x32x16_bf16(PAF(1), VFR(5), o[1], 0, 0, 0), C0, 12); \
    KRD(GL, 2); GAPB(o[0] = __builtin_amdgcn_mfma_f32_32x32x16_bf16(PAF(2), VFR(2), o[0], 0, 0, 0), C1, 0); \
    KRD(GL, 3); GAPB(o[1] = __builtin_amdgcn_mfma_f32_32x32x16_bf16(PAF(2), VFR(6), o[1], 0, 0, 0), C1, 4); \
    GAPB(o[0] = __builtin_amdgcn_mfma_f32_32x32x16_bf16(PAF(3), VFR(3), o[0], 0, 0, 0), C1, 8); \
    GAPB(o[1] = __builtin_amdgcn_mfma_f32_32x32x16_bf16(PAF(3), VFR(7), o[1], 0, 0, 0), C1, 12); \
    } while (0)
  int t = 1;
  for (; t + 5 < NT; t += 2) {
    STEPM(pB0, pB1, pA0, pA1, t, true, true, true);     WAIT_BAR(2); ROT();
    STEPM(pA0, pA1, pB0, pB1, t + 1, true, true, true); WAIT_BAR(2); ROT();
  }
  #define ENDW(tt) do { if ((tt) + 3 < NT) { WAIT_BAR(2); } else if ((tt) + 2 < NT) { WAIT_BAR(1); } else { WAIT_BAR(0); } } while (0)
  for (; t + 1 < NT; t += 2) {
    STEPM(pB0, pB1, pA0, pA1, t, (t + 3 < NT), (t + 1 < NT), (t + 1 < NT));         ENDW(t);     ROT();
    STEPM(pA0, pA1, pB0, pB1, t + 1, (t + 4 < NT), (t + 2 < NT), (t + 2 < NT));     ENDW(t + 1); ROT();
  }
  STEPM(pB0, pB1, pA0, pA1, NT - 1, false, false, false);
  { float sacc = pB0[0] + pB0[1]; _Pragma("unroll") for (int r = 2; r < 16; ++r) sacc += pB0[r]; _Pragma("unroll") for (int r = 0; r < 16; ++r) sacc += pB1[r]; l_reg += sacc;
    pw0 = (u32x4){PKW(pB0, 0), PKW(pB0, 2), PKW(pB0, 4), PKW(pB0, 6)}; pw1 = (u32x4){PKW(pB0, 8), PKW(pB0, 10), PKW(pB0, 12), PKW(pB0, 14)}; pw2 = (u32x4){PKW(pB1, 0), PKW(pB1, 2), PKW(pB1, 4), PKW(pB1, 6)}; pw3 = (u32x4){PKW(pB1, 8), PKW(pB1, 10), PKW(pB1, 12), PKW(pB1, 14)};
    SBAR(); pv(o, vb0 + sl_cur, PAF(0), PAF(1), PAF(2), PAF(3)); }
  #undef PKW
  #undef PAF
  #undef VFR
  #undef PIN
  #undef MX3
  #undef GAPA
  #undef GAPB
  #undef EX
  #undef VRD
  #undef KRD
  #undef STEPM
  #undef ENDW
  { auto rr = __builtin_amdgcn_permlane32_swap(__float_as_uint(l_reg), __float_as_uint(l_reg), false, false); l_reg = __uint_as_float(rr[0]) + __uint_as_float(rr[1]); }
  if (hi == 0) wsf[32 + r32] = l_reg; asm volatile("s_waitcnt lgkmcnt(0)" ::: "memory");
  float rli[16];
  #pragma unroll
  for (int r = 0; r < 16; ++r) rli[r] = __builtin_amdgcn_rcpf(wsf[32 + crow(r, hi)]);
  bf16* Ow = O + (long)(q0 + wid * QBLK) * OPITCH + OCOL0 + h * D;
  { bf16* stg = (bf16*)(shm + LDS_OST) + wid * 2048;
    #pragma unroll
    for (int r = 0; r < 16; ++r) { const int orow = crow(r, hi);
      #pragma unroll
      for (int d0 = 0; d0 < 2; ++d0) stg[orow * 64 + d0 * 32 + r32] = __float2bfloat16(o[d0][r] * rli[r]); }
    asm volatile("s_waitcnt lgkmcnt(0)" ::: "memory");
    #pragma unroll
    for (int i = 0; i < 4; ++i) { const int row = i * 8 + (lane >> 3), ch = lane & 7; const u32x4 v = *(const u32x4*)(stg + row * 64 + ch * 8); ATTN_STORE16(Ow + (long)row * OPITCH + ch * 8, v); } }
  asm volatile("s_waitcnt lgkmcnt(0)\n\ts_barrier" ::: "memory");
  #undef DMA_K
  #undef DMA_V
  #undef ROT
}
#undef SBAR
#undef WAIT_BAR

typedef int v8i_t __attribute__((ext_vector_type(8)));
constexpr int F8_SLOT = 4096, F8_LDS_K = 0, F8_LDS_V = 3 * F8_SLOT, F8_LDS_WS = 6 * F8_SLOT, F8_LDS_OST = F8_LDS_WS + NW * 64 * 4, F8_LDS_BYTES = F8_LDS_OST + NW * 4096;
#define SBAR() __builtin_amdgcn_sched_barrier(0)
#define WAIT_BAR(N) asm volatile("s_waitcnt vmcnt(" #N ") lgkmcnt(0)\n\ts_barrier" ::: "memory")
#define MFMA8_C(D, A, B, C, SA, SB) do { if (VAR & 64) { D = __builtin_amdgcn_mfma_f32_32x32x16_bf16(__builtin_bit_cast(bf16x8, (u32x4){(unsigned)A[0], (unsigned)A[1], (unsigned)A[2], (unsigned)A[3]}), __builtin_bit_cast(bf16x8, (u32x4){(unsigned)B[0], (unsigned)B[1], (unsigned)B[2], (unsigned)B[3]}), C, 0, 0, 0); \
      D = __builtin_amdgcn_mfma_f32_32x32x16_bf16(__builtin_bit_cast(bf16x8, (u32x4){(unsigned)A[4], (unsigned)A[5], (unsigned)A[6], (unsigned)A[7]}), __builtin_bit_cast(bf16x8, (u32x4){(unsigned)B[4], (unsigned)B[5], (unsigned)B[6], (unsigned)B[7]}), D, 0, 0, 0); } \
    else { asm volatile("s_nop 1\n\tv_mfma_scale_f32_32x32x64_f8f6f4 %0, %1, %2, %3, %4, %5 op_sel_hi:[0,0,0]" : "=&v"(D) : "v"(A), "v"(B), "v"(C), "v"(SA), "v"(SB)); \
      if (VAR & 256) asm volatile("s_nop 1\n\tv_mfma_scale_f32_32x32x64_f8f6f4 %0, %1, %2, %0, %3, %4 op_sel_hi:[0,0,0]" : "+v"(dacc) : "v"(A), "v"(B), "v"(SA), "v"(SB)); } } while (0)
#define MFMA8_ACC(D, A, B, SA, SB) do { if (VAR & 64) { D = __builtin_amdgcn_mfma_f32_32x32x16_bf16(__builtin_bit_cast(bf16x8, (u32x4){(unsigned)A[0], (unsigned)A[1], (unsigned)A[2], (unsigned)A[3]}), __builtin_bit_cast(bf16x8, (u32x4){(unsigned)B[0], (unsigned)B[1], (unsigned)B[2], (unsigned)B[3]}), D, 0, 0, 0); \
      D = __builtin_amdgcn_mfma_f32_32x32x16_bf16(__builtin_bit_cast(bf16x8, (u32x4){(unsigned)A[4], (unsigned)A[5], (unsigned)A[6], (unsigned)A[7]}), __builtin_bit_cast(bf16x8, (u32x4){(unsigned)B[4], (unsigned)B[5], (unsigned)B[6], (unsigned)B[7]}), D, 0, 0, 0); } \
    else { asm volatile("s_nop 1\n\tv_mfma_scale_f32_32x32x64_f8f6f4 %0, %1, %2, %0, %3, %4 op_sel_hi:[0,0,0]" : "+v"(D) : "v"(A), "v"(B), "v"(SA), "v"(SB)); \
      if (VAR & 256) asm volatile("s_nop 1\n\tv_mfma_scale_f32_32x32x64_f8f6f4 %0, %1, %2, %0, %3, %4 op_sel_hi:[0,0,0]" : "+v"(dacc) : "v"(A), "v"(B), "v"(SA), "v"(SB)); } } while (0)
template <int DBL> __device__ __forceinline__ v8i_t lds_frag32x(lds_cptr p) { const u32x4 lo = *(const __attribute__((address_space(3))) u32x4*)p, hi = *(const __attribute__((address_space(3))) u32x4*)(p + 2048);
  if (DBL) { const u32x4 lo2 = *(const volatile __attribute__((address_space(3))) u32x4*)(p + 4096), hi2 = *(const volatile __attribute__((address_space(3))) u32x4*)(p + 4112); asm volatile("" :: "v"(lo2), "v"(hi2)); }
  return (v8i_t){(int)lo.x, (int)lo.y, (int)lo.z, (int)lo.w, (int)hi.x, (int)hi.y, (int)hi.z, (int)hi.w}; }
__device__ __forceinline__ v8i_t lds_frag32(lds_cptr p) { const u32x4 lo = *(const __attribute__((address_space(3))) u32x4*)p, hi = *(const __attribute__((address_space(3))) u32x4*)(p + 16);
  return (v8i_t){(int)lo.x, (int)lo.y, (int)lo.z, (int)lo.w, (int)hi.x, (int)hi.y, (int)hi.z, (int)hi.w}; }
__device__ __forceinline__ unsigned pk4f8(float a, float b, float c, float d) { int p = __builtin_amdgcn_cvt_pk_fp8_f32(a, b, 0, false); p = __builtin_amdgcn_cvt_pk_fp8_f32(c, d, p, true); return (unsigned)p; }
template <int VAR> __device__ __forceinline__ void attn_unit_f8(int h, int kvh, int qb, const unsigned char* Q8, const unsigned char* __restrict__ K8, const unsigned char* __restrict__ VT8, bf16* O, char* shm, int wid, float kmax2) {
  const int lane = fresh_lane(), r32 = lane & 31, hi = lane >> 5; const bool kwave = wid < 4;
  const int q0 = qb * QB;
  const unsigned lds0 = (unsigned)(uintptr_t)shm;
  float* wsf = (float*)(shm + F8_LDS_WS) + wid * 64;
  const int kpl = (wid & 3) >> 1, krow = 32 * (wid & 1) + (lane >> 1), khalf = (lane & 1) ^ ((krow >> 3) & 1), kch = 2 * khalf + kpl;
  const unsigned char* dsrc = kwave ? K8 + (size_t)krow * KPITCH + kvh * D + 16 * kch : VT8 + (size_t)kvh * (NT * 4096) + 1024 * (wid & 3) + 16 * lane;
  const long dstep = kwave ? (long)KVBLK * KPITCH : 4096;
  const unsigned ddst = lds0 + (kwave ? F8_LDS_K : F8_LDS_V) + (wid & 3) * 1024;
  #define DMA_T(t, slot) glds16(dsrc + (long)(t) * dstep, (unsigned)__builtin_amdgcn_readfirstlane(ddst + (slot)))
  const lds_cptr shm3 = (lds_cptr)shm;
  const lds_cptr kp0 = shm3 + F8_LDS_K + r32 * 32 + 16 * (hi ^ ((r32 >> 3) & 1));
  const lds_cptr vp0 = shm3 + F8_LDS_V + r32 * 32 + 16 * (hi ^ ((r32 >> 3) & 1));
  v8i_t qf;
  { const unsigned char* qp = Q8 + (size_t)(q0 + wid * QBLK + r32) * QPITCH + h * D + 32 * hi; const u32x4 lo = *(const u32x4*)qp, hi4 = *(const u32x4*)(qp + 16);
    qf = (v8i_t){(int)lo.x, (int)lo.y, (int)lo.z, (int)lo.w, (int)hi4.x, (int)hi4.y, (int)hi4.z, (int)hi4.w}; }
  DMA_T(0, 0); if (kwave) { DMA_T(1, F8_SLOT); DMA_T(2, 2 * F8_SLOT); }
  f32x16 lacc = f32x16{}; f32x16 o[2]; o[0] = f32x16{}; o[1] = f32x16{}; f32x16 negm;
  v8i_t ones8 = {0x38383838, 0x38383838, 0x38383838, 0x38383838, 0x38383838, 0x38383838, 0x38383838, 0x38383838}; asm volatile("" : "+v"(ones8));
  { float qn2 = 0.f;
    #pragma unroll
    for (int i = 0; i < 8; ++i) { const float f0 = __builtin_amdgcn_cvt_f32_fp8(qf[i], 0), f1 = __builtin_amdgcn_cvt_f32_fp8(qf[i], 1), f2 = __builtin_amdgcn_cvt_f32_fp8(qf[i], 2), f3 = __builtin_amdgcn_cvt_f32_fp8(qf[i], 3);
      qn2 += ((f0 * f0 + f1 * f1) + (f2 * f2 + f3 * f3)) * (1.f / 256.f); }
    auto rr = __builtin_amdgcn_permlane32_swap(__float_as_uint(qn2), __float_as_uint(qn2), false, false); qn2 = __uint_as_float(rr[0]) + __uint_as_float(rr[1]);
    const float bnd = sqrtf(qn2 * kmax2) * 1.004f + 0.01f;
    #pragma unroll
    for (int r = 0; r < 16; ++r) negm[r] = 8.f - bnd;
    asm volatile("" : "+v"(negm)); }
  int sQ = 0x7B7B7B7B, sONE = 0x7F7F7F7F; asm volatile("" : "+v"(sQ), "+v"(sONE));
  f32x16 dacc = f32x16{}; f32x16 pA0, pA1, pB0, pB1; v8i_t kf0, kf1, vfA0, vfA1, vfB0, vfB1, pwA = {0, 0, 0, 0, 0, 0, 0, 0}, pwB = {0, 0, 0, 0, 0, 0, 0, 0};
  int sl_prev = 0, sl_cur = 0, sl_next = F8_SLOT;
  #define ROT() do { sl_prev = sl_cur; sl_cur = sl_next; sl_next = (sl_next == 2 * F8_SLOT) ? 0 : sl_next + F8_SLOT; } while (0)
  #define PIN(x) asm volatile("" : "+v"(x))
  WAIT_BAR(0);
  kf0 = lds_frag32x<(VAR & 512) != 0>(kp0); kf1 = lds_frag32x<(VAR & 512) != 0>(kp0 + 1024);
  asm volatile("s_waitcnt lgkmcnt(0)" ::: "memory");
  MFMA8_C(pA0, kf0, qf, negm, sONE, sQ); MFMA8_C(pA1, kf1, qf, negm, sONE, sQ);
  asm volatile("s_nop 15\n\ts_nop 15\n\ts_nop 7" : "+v"(pA0), "+v"(pA1));
  #pragma unroll
  for (int r = 0; r < 16; ++r) pA0[r] = __builtin_amdgcn_exp2f(pA0[r]);
  WAIT_BAR(0);
  if (kwave) { DMA_T(3, 0); } else { DMA_T(1, F8_SLOT); }
  ROT();
  kf0 = lds_frag32x<(VAR & 512) != 0>(kp0 + sl_cur); kf1 = lds_frag32x<(VAR & 512) != 0>(kp0 + sl_cur + 1024);
  WAIT_BAR(1);
  #define CVT2(dst, a, b, c, d) do { if (VAR & 16) { asm volatile("" : "+v"(dst) : "v"(a), "v"(b), "v"(c), "v"(d)); } else { dst = __builtin_amdgcn_cvt_pk_fp8_f32(a, b, dst, false); dst = __builtin_amdgcn_cvt_pk_fp8_f32(c, d, dst, true); if (VAR & 32) { asm volatile("" : "+v"(dst)); dst = __builtin_amdgcn_cvt_pk_fp8_f32(a, b, dst, false); dst = __builtin_amdgcn_cvt_pk_fp8_f32(c, d, dst, true); } } } while (0)
  #define EXF(v) ((VAR & 1) ? (v) * 0.999f : ((VAR & 128) ? __builtin_amdgcn_exp2f(__builtin_amdgcn_exp2f(v) * 1e-30f) + __builtin_amdgcn_exp2f(v) - 1.0f : __builtin_amdgcn_exp2f(v)))
  #define EX4(X, B) do { X[B] = EXF(X[B]); X[B + 1] = EXF(X[B + 1]); X[B + 2] = EXF(X[B + 2]); X[B + 3] = EXF(X[B + 3]); } while (0)
  #define STEP8(C0, C1, P0, P1, PW, VF0, VF1, t, GK, GV, GL) do { SBAR(); \
    VF0 = lds_frag32x<(VAR & 512) != 0>(vp0 + sl_prev); VF1 = lds_frag32x<(VAR & 512) != 0>(vp0 + sl_prev + 1024); SBAR(); \
    if (VAR & 2) { C0 = negm; asm volatile("" : "+v"(C0) : "v"(kf0)); } else { MFMA8_C(C0, kf0, qf, negm, sONE, sQ); } SBAR(); \
    CVT2(PW[0], P0[0], P0[1], P0[2], P0[3]); CVT2(PW[1], P0[4], P0[5], P0[6], P0[7]); CVT2(PW[2], P0[8], P0[9], P0[10], P0[11]); CVT2(PW[3], P0[12], P0[13], P0[14], P0[15]); \
    EX4(P1, 0); EX4(P1, 4); PIN(PW); PIN(P1); SBAR(); \
    if (VAR & 2) { C1 = negm; asm volatile("" : "+v"(C1) : "v"(kf1)); } else { MFMA8_C(C1, kf1, qf, negm, sONE, sQ); } SBAR(); \
    EX4(P1, 8); EX4(P1, 12); \
    CVT2(PW[4], P1[0], P1[1], P1[2], P1[3]); CVT2(PW[5], P1[4], P1[5], P1[6], P1[7]); CVT2(PW[6], P1[8], P1[9], P1[10], P1[11]); CVT2(PW[7], P1[12], P1[13], P1[14], P1[15]); \
    PIN(PW); SBAR(); \
    if (kwave) { if (GK) { DMA_T((t) + 3, sl_cur); } } else { if (GV) { DMA_T((t) + 1, sl_next); } } \
    if (GL) { kf0 = lds_frag32x<(VAR & 512) != 0>(kp0 + sl_next); kf1 = lds_frag32x<(VAR & 512) != 0>(kp0 + sl_next + 1024); } SBAR(); \
    if (VAR & 2) { asm volatile("" : "+v"(lacc) : "v"(PW)); } else { MFMA8_ACC(lacc, PW, ones8, sONE, sONE); } asm volatile("" : "+v"(C0)); SBAR(); \
    EX4(C0, 0); EX4(C0, 4); PIN(C0); SBAR(); \
    if (VAR & 2) { asm volatile("" : "+v"(o[0]) : "v"(PW), "v"(VF0)); } else { MFMA8_ACC(o[0], PW, VF0, sONE, sONE); } SBAR(); \
    EX4(C0, 8); EX4(C0, 12); PIN(C0); SBAR(); \
    if (VAR & 2) { asm volatile("" : "+v"(o[1]) : "v"(PW), "v"(VF1)); } else { MFMA8_ACC(o[1], PW, VF1, sONE, sONE); } SBAR(); } while (0)
  int t = 1;
  #pragma unroll 1
  for (; t + 5 < NT; t += 2) {
    STEP8(pB0, pB1, pA0, pA1, pwA, vfA0, vfA1, t, true, true, true);     if (VAR & 4) { asm volatile("s_waitcnt vmcnt(1) lgkmcnt(0)" ::: "memory"); } else { WAIT_BAR(1); } ROT();
    STEP8(pA0, pA1, pB0, pB1, pwB, vfB0, vfB1, t + 1, true, true, true); if (VAR & 4) { asm volatile("s_waitcnt vmcnt(1) lgkmcnt(0)" ::: "memory"); } else { WAIT_BAR(1); } ROT();
  }
  for (; t + 1 < NT; t += 2) {
    STEP8(pB0, pB1, pA0, pA1, pwA, vfA0, vfA1, t, (t + 3 < NT), (t + 1 < NT), (t + 1 < NT));         WAIT_BAR(0); ROT();
    STEP8(pA0, pA1, pB0, pB1, pwB, vfB0, vfB1, t + 1, (t + 4 < NT), (t + 2 < NT), (t + 2 < NT));     WAIT_BAR(0); ROT();
  }
  STEP8(pB0, pB1, pA0, pA1, pwA, vfA0, vfA1, NT - 1, false, false, false);
  { asm volatile("s_nop 15\n\ts_nop 15\n\ts_nop 7" : "+v"(pB1));
    EX4(pB1, 0); EX4(pB1, 4); EX4(pB1, 8); EX4(pB1, 12);
    CVT2(pwB[0], pB0[0], pB0[1], pB0[2], pB0[3]); CVT2(pwB[1], pB0[4], pB0[5], pB0[6], pB0[7]); CVT2(pwB[2], pB0[8], pB0[9], pB0[10], pB0[11]); CVT2(pwB[3], pB0[12], pB0[13], pB0[14], pB0[15]);
    CVT2(pwB[4], pB1[0], pB1[1], pB1[2], pB1[3]); CVT2(pwB[5], pB1[4], pB1[5], pB1[6], pB1[7]); CVT2(pwB[6], pB1[8], pB1[9], pB1[10], pB1[11]); CVT2(pwB[7], pB1[12], pB1[13], pB1[14], pB1[15]);
    vfB0 = lds_frag32x<(VAR & 512) != 0>(vp0 + sl_cur); vfB1 = lds_frag32x<(VAR & 512) != 0>(vp0 + sl_cur + 1024);
    asm volatile("s_waitcnt lgkmcnt(0)" ::: "memory"); PIN(pwB); SBAR();
    MFMA8_ACC(o[0], pwB, vfB0, sONE, sONE); MFMA8_ACC(o[1], pwB, vfB1, sONE, sONE); MFMA8_ACC(lacc, pwB, ones8, sONE, sONE);
    asm volatile("s_nop 15\n\ts_nop 15\n\ts_nop 7" : "+v"(o[0]), "+v"(o[1]), "+v"(lacc)); }
  #undef STEP8
  #undef CVT2
  #undef EX4
  #undef EXF
  #undef PIN
  #undef ROT
  if (VAR & 256) asm volatile("" :: "v"(dacc));
  float rli[16];
  #pragma unroll
  for (int r = 0; r < 16; ++r) rli[r] = __builtin_amdgcn_rcpf(lacc[r]);
  bf16* Ow = O + (long)(q0 + wid * QBLK) * OPITCH + OCOL0 + h * D;
  { bf16* stg = (bf16*)(shm + F8_LDS_OST) + wid * 2048;
    #pragma unroll
    for (int r = 0; r < 16; ++r) { const int orow = crow(r, hi);
      #pragma unroll
      for (int d0 = 0; d0 < 2; ++d0) stg[orow * 64 + d0 * 32 + r32] = __float2bfloat16(o[d0][r] * rli[r]); }
    asm volatile("s_waitcnt lgkmcnt(0)" ::: "memory");
    #pragma unroll
    for (int i = 0; i < 4; ++i) { const int row = i * 8 + (lane >> 3), ch = lane & 7; const u32x4 v = *(const u32x4*)(stg + row * 64 + ch * 8); if (!(VAR & 8)) ATTN_STORE16(Ow + (long)row * OPITCH + ch * 8, v); } }
  asm volatile("s_waitcnt vmcnt(0) lgkmcnt(0)\n\ts_barrier" ::: "memory");
  #undef DMA_T
}
#undef MFMA8_C
#undef MFMA8_ACC
#undef SBAR
#undef WAIT_BAR
}

constexpr int NWAVES = 8, NTHR = NWAVES * 64;
constexpr size_t MiB = 1u << 20;
constexpr size_t WS_CTL = 0, CTL_ZERO_BYTES = 64 * 1024;
constexpr size_t WS_MOD = 1 * MiB;
constexpr size_t WS_MISC = WS_MOD + 64 * 1024;
constexpr size_t WS_IDX = WS_MISC, WS_GATE = WS_IDX + 128 * 1024, WS_TOKSLOT = WS_GATE + 128 * 1024;
constexpr size_t WS_AFF = 3 * MiB;
constexpr size_t WS_WIN = 4 * MiB;
constexpr size_t WS_WOUT = 7 * MiB;
constexpr size_t WS_WGU = 9 * MiB;
constexpr size_t WS_WD = 137 * MiB;
constexpr size_t WS_X1 = 201 * MiB;
constexpr size_t WS_R1 = 265 * MiB;
constexpr size_t WS_XN = WS_R1;
constexpr size_t WS_Q = WS_XN + (size_t)NROWS * DM * 2;
constexpr size_t WS_K = WS_Q + (size_t)NTOK * 768 * 2;
constexpr size_t WS_V = WS_K + (size_t)NROWS * 256 * 2;
constexpr size_t WS_FT = WS_V + (size_t)NROWS * 256 * 2;
constexpr size_t WS_MIX = WS_FT + (size_t)256 * NTOK * 4;
constexpr size_t WS_HID = WS_R1;
constexpr size_t WS_R2 = 393 * MiB;
constexpr size_t WS_H2 = WS_R2;
constexpr size_t WS_YE = WS_R2;
constexpr size_t WS_END = 457 * MiB;
static_assert(WS_MIX + (size_t)NTOK * DM * 2 <= WS_R1 + 128 * MiB, "R1 map");
static_assert(WS_TOKSLOT + (size_t)NTOK * 16 * 4 <= WS_AFF, "misc map");
constexpr int CW_TMO = 0, CW_FLAG = 2, CW_KMAX = 64, CW_BAR = 1024;

constexpr int LDS_BYTES = 163840;
constexpr int RING_BYTES = 131072, XTRA_OFF = RING_BYTES;
constexpr int MISC_OFF = LDS_BYTES - 512;

#define GAS __attribute__((address_space(1)))
#define LAS __attribute__((address_space(3)))
typedef unsigned short bf16;
typedef unsigned v4u __attribute__((ext_vector_type(4)));
typedef unsigned v2u __attribute__((ext_vector_type(2)));
typedef float f32x4 __attribute__((ext_vector_type(4)));
typedef float f32x2 __attribute__((ext_vector_type(2)));
typedef GAS unsigned gu32;
#define RLX_AGENT __ATOMIC_RELAXED, __HIP_MEMORY_SCOPE_AGENT
#define LDS_WAIT() asm volatile("s_waitcnt lgkmcnt(0)" ::: "memory")
#define VM_WAIT() asm volatile("s_waitcnt vmcnt(0)" ::: "memory")
__device__ __forceinline__ unsigned f2bf(float f) { unsigned u = __builtin_bit_cast(unsigned, f); return (u + 0x7fffu + ((u >> 16) & 1u)) >> 16; }
__device__ __forceinline__ unsigned pk2(float lo, float hi) { return f2bf(lo) | (f2bf(hi) << 16); }
__device__ __forceinline__ unsigned pk4_fp8(float a, float b, float c, float d) { int p = __builtin_amdgcn_cvt_pk_fp8_f32(a, b, 0, false); p = __builtin_amdgcn_cvt_pk_fp8_f32(c, d, p, true); return (unsigned)p; }
__device__ __forceinline__ float bf2f(unsigned short b) { return __builtin_bit_cast(float, (unsigned)b << 16); }

#define XB_TMO      128
#define XB_XCNT(j)  (256  + 64 * (j))
#define XB_XSUB(j)  (1280 + 64 * (j))
#define XB_XGEN(j)  (2304 + 64 * (j))
#define XB_TOP      3328
#define XB_TOPGEN   3392
#define XCD_BAR_WORDS 3456
#define XB_SPIN_CAP (1u << 20)
static_assert((CW_BAR + XCD_BAR_WORDS) * 4 <= (int)CTL_ZERO_BYTES, "ctl");
__device__ __forceinline__ unsigned xb_ld(unsigned* p)              { return __hip_atomic_load(p, __ATOMIC_RELAXED, __HIP_MEMORY_SCOPE_AGENT); }
__device__ __forceinline__ unsigned xb_add(unsigned* p, unsigned v) { return __hip_atomic_fetch_add(p, v, __ATOMIC_RELAXED, __HIP_MEMORY_SCOPE_AGENT); }
__device__ __forceinline__ unsigned xb_xcc_id() { return (unsigned)__builtin_amdgcn_s_getreg((3 << 11) | 20) & 0xFu; }
#define XB_SPIN(cond, bar) do { unsigned _sp = 0; while (cond) { __builtin_amdgcn_s_sleep(1); \
    if ((++_sp & 255u) == 0u) { if (xb_ld(&(bar)[XB_TMO])) break; if (_sp > XB_SPIN_CAP) { atomicAdd(&(bar)[XB_TMO], 1u); break; } } } } while (0)
struct XcdBarrier { unsigned* bar; unsigned x; volatile LAS unsigned* st; };
__device__ __forceinline__ XcdBarrier xcd_barrier_post(unsigned* bar, volatile LAS unsigned* st, bool leader) {
    XcdBarrier b; b.bar = bar; b.x = xb_xcc_id(); b.st = st;
    if (leader) (void)xb_add(&bar[XB_XCNT(b.x)], 1u);
    return b;
}
__device__ __forceinline__ void xcd_barrier_complete(unsigned* bar, unsigned x, unsigned& nloc, unsigned& nx) {
    const unsigned G = gridDim.x * gridDim.y * gridDim.z;
    unsigned sum, cnt, mine, sp = 0u;
    for (;;) {
        sum = 0u; cnt = 0u; mine = 0u;
#pragma unroll
        for (unsigned j = 0; j < 16; ++j) { const unsigned c = xb_ld(&bar[XB_XCNT(j)]); sum += c; cnt += (c > 0u) ? 1u : 0u; mine = (j == x) ? c : mine; }
        if (sum == G) break;
        __builtin_amdgcn_s_sleep(1);
        if ((++sp & 255u) == 0u) { if (xb_ld(&bar[XB_TMO])) break; if (sp > XB_SPIN_CAP) { atomicAdd(&bar[XB_TMO], 1u); break; } }
    }
    nloc = mine > 0u ? mine : 1u; nx = cnt > 0u ? cnt : 1u;
}
__device__ __forceinline__ void xcd_barrier(const XcdBarrier& b, int wave) {
    asm volatile("s_waitcnt vmcnt(0)" ::: "memory");
    __syncthreads();
    if (wave == 0 && fresh_lane() == 0) {
        unsigned* bar = b.bar;
        __builtin_amdgcn_s_waitcnt(0);
        unsigned nloc = b.st[0], nx = b.st[1];
        if (nloc == 0u) { xcd_barrier_complete(bar, b.x, nloc, nx); b.st[0] = nloc; b.st[1] = nx; }
        const unsigned old = xb_add(&bar[XB_XSUB(b.x)], 1u);
        const unsigned gen = old / nloc;
        if (old + 1u == (gen + 1u) * nloc) {
            __builtin_amdgcn_fence(__ATOMIC_RELEASE, "agent");
            asm volatile("s_waitcnt vmcnt(0)" ::: "memory");
            const unsigned og = xb_add(&bar[XB_TOP], 1u);
            const unsigned tg = og / nx;
            if (og + 1u == (tg + 1u) * nx) xb_add(&bar[XB_TOPGEN], 1u);
            else XB_SPIN(xb_ld(&bar[XB_TOPGEN]) == tg, bar);
            __builtin_amdgcn_fence(__ATOMIC_ACQUIRE, "agent");
            xb_add(&bar[XB_XGEN(b.x)], 1u);
            asm volatile("s_waitcnt vmcnt(0)" ::: "memory");
        } else {
            XB_SPIN(xb_ld(&bar[XB_XGEN(b.x)]) == gen, bar);
            __builtin_amdgcn_fence(__ATOMIC_ACQUIRE, "agent");
            asm volatile("s_waitcnt vmcnt(0)" ::: "memory");
        }
    }
    __syncthreads();
}

struct Args {
    const float *x, *c, *ctx, *c_ctx, *w_mod, *b_mod, *norm_mix_g, *norm_ffn_g, *w_in, *w_four, *q_norm_g, *k_norm_g, *w_out, *w_router, *w_gate, *w_up, *w_down, *final_norm_g;
    float* out; unsigned char* ws;
};

__device__ __forceinline__ float wave_sum(float v) {
#pragma unroll
    for (int o = 1; o < 64; o <<= 1) v += __shfl_xor(v, o);
    return v;
}

template <class RowMap>
__device__ __forceinline__ void tr_item(const float* __restrict__ W, int ldw, int k0, int n0, bf16* WT, int ldt, int kdst0, const RowMap& drow, LAS float* scr, int lane) {
    const int kq = lane >> 4, nq = lane & 15;
    f32x4 v[16];
#pragma unroll
    for (int it = 0; it < 16; ++it) v[it] = *(const f32x4*)(W + (size_t)(k0 + 4 * it + kq) * ldw + n0 + 4 * nq);
#pragma unroll
    for (int it = 0; it < 16; ++it) { LAS float* s = scr + (4 * it + kq) * 65 + 4 * nq; s[0] = v[it][0]; s[1] = v[it][1]; s[2] = v[it][2]; s[3] = v[it][3]; }
    LDS_WAIT(); asm volatile("" ::: "memory");
    const int c = lane >> 3, nn = lane & 7;
#pragma unroll
    for (int j = 0; j < 8; ++j) { const int n = nn + 8 * j; const LAS float* s = scr + (8 * c) * 65 + n;
        v4u o; o.x = pk2(s[0 * 65], s[1 * 65]); o.y = pk2(s[2 * 65], s[3 * 65]); o.z = pk2(s[4 * 65], s[5 * 65]); o.w = pk2(s[6 * 65], s[7 * 65]);
        *(GAS v4u*)(WT + (size_t)drow(n0 + n) * ldt + kdst0 + k0 + 8 * c) = o; }
    LDS_WAIT(); asm volatile("" ::: "memory");
}
struct RowId { int base; __device__ __forceinline__ int operator()(int n) const { return base + n; } };
struct RowQKV { __device__ __forceinline__ int operator()(int n) const { const int t = n >> 8, w = n & 255, hd = w >> 6, d = w & 63; return 256 + 256 * t + 128 * (d >> 5) + 32 * hd + (d & 31); } };
struct RowGU { int base, up; __device__ __forceinline__ int operator()(int f) const { return base + 256 * (f >> 7) + 128 * up + (f & 127); } };


constexpr int MOE_ITEMS = 3 * 8192;
struct TrDesc { const float* src; bf16* dst; int ldw, ldt, f8; };
__device__ __forceinline__ TrDesc moe_desc(const Args& a, int r) {
    TrDesc d;
    if (r < 16384) { const int up = r >> 13, rr = r & 8191, e = rr >> 9, q = rr & 511, kb = q >> 5, nb = q & 31;
        d.src = (up ? a.w_up : a.w_gate) + (size_t)e * DM * DE + (size_t)(kb * 64) * DE + nb * 64; d.ldw = DE;
        d.dst = (bf16*)((unsigned char*)(a.ws + WS_WGU) + ((size_t)e * 4096 + 256 * (nb >> 1) + 128 * up + 64 * (nb & 1)) * DM + kb * 64); d.ldt = DM; d.f8 = 1; }
    else { const int rr = r - 16384, e = rr >> 9, q = rr & 511, kb = q >> 4, nb = q & 15;
        d.src = a.w_down + (size_t)e * DE * DM + (size_t)(kb * 64) * DM + nb * 64; d.ldw = DM;
        d.dst = (bf16*)((unsigned char*)(a.ws + WS_WD) + ((size_t)e * DM + nb * 64) * DE + kb * 64); d.ldt = DE; d.f8 = 1; }
    return d;
}
#define TR_LOAD(v, d) do { _Pragma("unroll") for (int _it = 0; _it < 16; ++_it) v[_it] = *(const f32x4*)((d).src + (size_t)(4 * _it + kq) * (d).ldw + 4 * nq); } while (0)
#define TR_PROC(v, d) do { \
    _Pragma("unroll") for (int _it = 0; _it < 16; ++_it) { LAS float* s_ = scr + (4 * _it + kq) * 65 + 4 * nq; s_[0] = v[_it][0]; s_[1] = v[_it][1]; s_[2] = v[_it][2]; s_[3] = v[_it][3]; } \
    LDS_WAIT(); asm volatile("" ::: "memory"); \
    if ((d).f8) { _Pragma("unroll") for (int _j = 0; _j < 8; ++_j) { const int n_ = nn + 8 * _j; const LAS float* s_ = scr + (8 * c8) * 65 + n_; \
        v2u o_; o_.x = pk4_fp8(s_[0 * 65] * 32.f, s_[1 * 65] * 32.f, s_[2 * 65] * 32.f, s_[3 * 65] * 32.f); o_.y = pk4_fp8(s_[4 * 65] * 32.f, s_[5 * 65] * 32.f, s_[6 * 65] * 32.f, s_[7 * 65] * 32.f); \
        *(GAS v2u*)((unsigned char*)(d).dst + (size_t)n_ * (d).ldt + 8 * c8) = o_; } } \
    else { _Pragma("unroll") for (int _j = 0; _j < 8; ++_j) { const int n_ = nn + 8 * _j; const LAS float* s_ = scr + (8 * c8) * 65 + n_; \
        v4u o_; o_.x = pk2(s_[0 * 65], s_[1 * 65]); o_.y = pk2(s_[2 * 65], s_[3 * 65]); o_.z = pk2(s_[4 * 65], s_[5 * 65]); o_.w = pk2(s_[6 * 65], s_[7 * 65]); \
        *(GAS v4u*)((d).dst + (size_t)n_ * (d).ldt + 8 * c8) = o_; } } \
    LDS_WAIT(); asm volatile("" ::: "memory"); } while (0)
__device__ __forceinline__ void moe_convert(const Args& a, LAS float* scr, int lo, int hi, int w, int nw) {
    const int lane = fresh_lane(), kq = lane >> 4, nq = lane & 15, c8 = lane >> 3, nn = lane & 7;
    int it = lo + w; if (it >= hi) return;
    f32x4 va[16], vb[16];
    TrDesc da = moe_desc(a, it), db = da; TR_LOAD(va, da);
    for (;;) {
        int nx = it + nw; bool hn = nx < hi;
        if (hn) { db = moe_desc(a, nx); TR_LOAD(vb, db); }
        TR_PROC(va, da);
        if (!hn) break;
        it = nx; nx = it + nw; hn = nx < hi;
        if (hn) { da = moe_desc(a, nx); TR_LOAD(va, da); }
        TR_PROC(vb, db);
        if (!hn) break;
        it = nx;
    }
}
#ifndef MOE_S0
#define MOE_S0 0
#endif
#ifndef MOE_S1
#define MOE_S1 2560
#endif
#ifndef MOE_S2
#define MOE_S2 0
#endif
#ifndef MOE_S3
#define MOE_S3 8448
#endif
constexpr int MOE_B0 = MOE_S0, MOE_B1 = MOE_B0 + MOE_S1, MOE_B2 = MOE_B1 + MOE_S2, MOE_B3 = MOE_B2 + MOE_S3;

__host__ __device__ __forceinline__ int four_pos(int mp) { return mp == 0 ? 0 : (mp == 32 ? 1 : (mp < 32 ? 2 * mp : 2 * (64 - mp) + 1)); }

__device__ __forceinline__ void p0_prologue(const Args& a, LAS unsigned char* lds, int vcu, int G, int wave) {
    const int lane = fresh_lane(), tid = wave * 64 + lane;
    unsigned char* ws = a.ws;
    bf16* WinT = (bf16*)(ws + WS_WIN); bf16* WoT = (bf16*)(ws + WS_WOUT);
    float* MOD = (float*)(ws + WS_MOD);
    for (int item = vcu; item < 256; item += G) {
        LAS float* red = (LAS float*)lds;
        f32x4 a0 = {0.f, 0.f, 0.f, 0.f}, a1 = {0.f, 0.f, 0.f, 0.f};
        if (lane < 60) {
            const int rr = lane / 6, cq = lane % 6, col = item * 24 + 4 * cq;
#pragma unroll
            for (int it = 0; it < 13; ++it) { const int k = wave * 128 + it * 10 + rr;
                if (it * 10 + rr < 128) { const f32x4 w = *(const f32x4*)(a.w_mod + (size_t)k * (NMOD * DM) + col); const float c0 = a.c[k], c1 = a.c_ctx[k];
                    const float s0 = c0 / (1.f + __expf(-c0)), s1 = c1 / (1.f + __expf(-c1)); a0 += w * s0; a1 += w * s1; } }
        }
        *(LAS f32x4*)(red + ((wave * 2 + 0) * 64 + lane) * 4) = a0; *(LAS f32x4*)(red + ((wave * 2 + 1) * 64 + lane) * 4) = a1;
        __syncthreads();
        if (tid < 48) { const int v = tid / 24, cc = tid % 24, cq = cc >> 2, e = cc & 3; float sum = 0.f;
            for (int w = 0; w < 8; ++w)
#pragma unroll
                for (int r = 0; r < 10; ++r) sum += red[((w * 2 + v) * 64 + r * 6 + cq) * 4 + e];
            MOD[v * (NMOD * DM) + item * 24 + cc] = sum + a.b_mod[item * 24 + cc]; }
        __syncthreads();
    }
    const int cg = -1;
    LAS float* scr = (LAS float*)(lds + wave * 16640);
    constexpr int I_F1 = 256, I_F2 = 256, I_IN = 16 * 20, I_OUT = 12 * 16;
    constexpr int NITEMS = I_F1 + I_F2 + I_IN + I_OUT;
    for (int it = wave * G + vcu; it < NITEMS; it += NWAVES * G) {
        int r = it;
        if (r < I_F1) {
            const int g = r & 3, kb = (r >> 2) & 15, jq = r >> 6, k = kb * 64 + lane;
            LAS float* ct = scr;
            ct[lane] = cospif((float)lane * (1.f / 32.f)); LDS_WAIT(); asm volatile("" ::: "memory");
            float w[64];
#pragma unroll
            for (int c4 = 0; c4 < 16; ++c4) { const f32x4 t = *(const f32x4*)(a.w_in + (size_t)k * INW + 64 * g + 4 * c4); w[4 * c4] = t[0]; w[4 * c4 + 1] = t[1]; w[4 * c4 + 2] = t[2]; w[4 * c4 + 3] = t[3]; }
            for (int j = 16 * jq; j < 16 * jq + 16; ++j) { const int m = j <= 32 ? j : j - 32; const int ph = j <= 32 ? 0 : 48;
                float s = 0.f;
#pragma unroll
                for (int c = 0; c < 64; ++c) s += w[c] * ct[(c * m + ph) & 63];
                WinT[(size_t)(64 * g + j) * DM + k] = (bf16)f2bf(s * (1.f / 1024.f)); }
            LDS_WAIT(); asm volatile("" ::: "memory");
            continue; }
        r -= I_F1;
        if (r < I_F2) {
            const int g = r & 3, jb = (r >> 2) & 15, mq = r >> 6, j = jb * 64 + lane;
            float w[64];
#pragma unroll
            for (int d = 0; d < 64; ++d) w[d] = a.w_out[(size_t)(64 * g + d) * DM + j];
            for (int mp = 16 * mq; mp < 16 * mq + 16; ++mp) { float s = 0.f; const float* wf = a.w_four + (size_t)(g * 64 + mp) * 64;
#pragma unroll
                for (int d = 0; d < 64; ++d) s += wf[d] * w[d];
                WoT[(size_t)j * DM + 64 * g + four_pos(mp)] = (bf16)f2bf(s); }
            continue; }
        r -= I_F2;
        if (r < I_IN) { const int kb = r / 20, nb = r % 20; tr_item(a.w_in + 256, INW, kb * 64, nb * 64, WinT, DM, 0, RowQKV{}, scr, lane); continue; }
        r -= I_IN;
        { const int kb = r / 16, nb = r % 16; tr_item(a.w_out + (size_t)256 * DM, DM, kb * 64, nb * 64, WoT, DM, 256, RowId{0}, scr, lane); }
    }
    if (cg < 0 && MOE_S0 > 0) moe_convert(a, scr, 0, MOE_B0, ((wave + 4) & 7) * (G - 24) + vcu, NWAVES * (G - 24));
}

__device__ __forceinline__ void p0b_modulate(const Args& a, int vcu, int G, int wave) {
    const int lane = fresh_lane();
    unsigned char* ws = a.ws; const float* MOD = (const float*)(ws + WS_MOD); bf16* XN = (bf16*)(ws + WS_XN);
    const int gw = vcu * NWAVES + wave, NGW = G * NWAVES;
    for (int pass = 0; pass < 2; ++pass) {
        const float* md = MOD + pass * (NMOD * DM);
        const int nrows = pass == 0 ? NTOK : NCTX; const float* src = pass == 0 ? a.x : a.ctx; bf16* dst = XN + (size_t)(pass == 0 ? 0 : NTOK) * DM;
        if (gw >= nrows) continue;
        f32x4 av[4], sh[4];
#pragma unroll
        for (int j = 0; j < 4; ++j) { const int col = 4 * lane + 256 * j; const f32x4 g = *(const f32x4*)(a.norm_mix_g + col); const f32x4 sc = *(const f32x4*)(md + DM + col); av[j] = g * (sc + 1.f); sh[j] = *(const f32x4*)(md + col); }
        f32x4 v[4], vn[4];
        { const GAS f32x4* xr = (const GAS f32x4*)(src + (size_t)gw * DM) + lane;
#pragma unroll
          for (int j = 0; j < 4; ++j) v[j] = xr[64 * j]; }
        for (int m = gw; m < nrows; m += NGW) {
            const int mn = m + NGW;
            if (mn < nrows) { const GAS f32x4* xr = (const GAS f32x4*)(src + (size_t)mn * DM) + lane;
#pragma unroll
                for (int j = 0; j < 4; ++j) vn[j] = xr[64 * j]; }
            float s = 0.f;
#pragma unroll
            for (int j = 0; j < 4; ++j) s += (v[j].x * v[j].x + v[j].y * v[j].y) + (v[j].z * v[j].z + v[j].w * v[j].w);
            const float rinv = 1.f / sqrtf(wave_sum(s) * (1.f / DM) + EPS);
            GAS unsigned long long* o8 = (GAS unsigned long long*)(dst + (size_t)m * DM) + lane;
#pragma unroll
            for (int j = 0; j < 4; ++j) { const f32x4 y = v[j] * rinv * av[j] + sh[j]; o8[64 * j] = (unsigned long long)pk2(y.x, y.y) | ((unsigned long long)pk2(y.z, y.w) << 32); }
#pragma unroll
            for (int j = 0; j < 4; ++j) v[j] = vn[j];
        }
    }
}

struct P1Prob {
    static constexpr int K = DM; static constexpr bool PERM = false, FP8 = false; static constexpr int SCW = 0, SCA = 0;
    const bf16* XN; const bf16* WinT; bf16 *Q, *Kb, *Vb; float* FT; const float *qg, *kg; unsigned* kmax; pg8::StaticOrder so;
    __device__ __forceinline__ bool next(int i, pg8::Unit& u) const { return so.next(i, u); }
    __device__ __forceinline__ bool swapped(const pg8::Unit& u) const { return u.pn == 0 || (ATTN_F8 && u.pn == 5); }
    __device__ __forceinline__ const char* aptr(const pg8::Unit& u) const { return swapped(u) ? (const char*)(WinT + (size_t)u.pn * 256 * DM) : (const char*)(XN + (size_t)u.pm * 256 * DM); }
    __device__ __forceinline__ const char* bptr(const pg8::Unit& u) const { return swapped(u) ? (const char*)(XN + (size_t)u.pm * 256 * DM) : (const char*)(WinT + (size_t)u.pn * 256 * DM); }
    __device__ __forceinline__ void epi(const pg8::f32x4 (&acc)[2][2][4][2], const pg8::Unit& u, int wr, int wc, int fr, int fq) const {
        if (u.pn == 0) {
            if (u.pm >= NTOK / 256) return;
#pragma unroll
            for (int ai = 0; ai < 2; ++ai)
#pragma unroll
                for (int m = 0; m < 4; ++m) { float* rowp = FT + (size_t)(ai * 128 + wr * 64 + m * 16 + fr) * NTOK + u.pm * 256 + wc * 32 + 4 * fq;
#pragma unroll
                    for (int bj = 0; bj < 2; ++bj)
#pragma unroll
                        for (int n = 0; n < 2; ++n) *(pg8::f32x4*)(rowp + bj * 128 + n * 16) = acc[ai][bj][m][n]; }
            return;
        }
        const bool isq = u.pn <= 3, isv = u.pn == 5, lat = u.pm < NTOK / 256;
        if (isq && !lat) return;
        if (isv) {
#if ATTN_F8
            unsigned char* V8 = (unsigned char*)Vb;
#pragma unroll
            for (int ai = 0; ai < 2; ++ai)
#pragma unroll
                for (int m = 0; m < 4; ++m) { const int kvh_ = 2 * wr + (m >> 1), d = 32 * ai + 16 * (m & 1) + fr;
#pragma unroll
                    for (int bj = 0; bj < 2; ++bj)
#pragma unroll
                        for (int n = 0; n < 2; ++n) { const int t0 = u.pm * 256 + 128 * bj + 32 * wc + 16 * n + 4 * fq, key0 = t0 & 63, tile = t0 >> 6, k5 = key0 & 31, hk = (k5 >> 2) & 1, j0 = 4 * (k5 >> 3) + 16 * (key0 >> 5);
                            const pg8::f32x4 v = acc[ai][bj][m][n];
                            *(unsigned*)(V8 + (size_t)(kvh_ * (NKEYS / 64) + tile) * 4096 + (j0 >> 4) * 2048 + d * 32 + 16 * (hk ^ ((d >> 3) & 1)) + (j0 & 15)) = pk4_fp8(v[0], v[1], v[2], v[3]); } }
#else
#pragma unroll
            for (int ai = 0; ai < 2; ++ai)
#pragma unroll
                for (int m = 0; m < 4; ++m) { const int t = u.pm * 256 + ai * 128 + wr * 64 + m * 16 + fr; bf16* rowp = Vb + (size_t)t * 256 + wc * 64 + 4 * fq;
#pragma unroll
                    for (int bj = 0; bj < 2; ++bj)
#pragma unroll
                        for (int n = 0; n < 2; ++n) { const pg8::f32x4 v = acc[ai][bj][m][n]; *(v2u*)(rowp + 32 * bj + 16 * n) = (v2u){pk2(v[0], v[1]), pk2(v[2], v[3])}; } }
#endif
            return;
        }
        const float* gw = isq ? qg : kg;
        pg8::f32x4 gv[2][2];
#pragma unroll
        for (int bj = 0; bj < 2; ++bj)
#pragma unroll
            for (int n = 0; n < 2; ++n) gv[bj][n] = *(const pg8::f32x4*)(gw + 32 * bj + 16 * n + 4 * fq);
        float frq[4];
#pragma unroll
        for (int e = 0; e < 4; ++e) frq[e] = exp2f(-(float)(4 * fq + e) * (13.287712379549449f / 16.f)) * 0.15915494309189535f;
        const float qs = isq ? attn_body::C2 * (ATTN_F8 ? 16.f : 1.f) : 1.f;
#if ATTN_F8
        bf16* base = (bf16*)((unsigned char*)(isq ? Q : Kb) + (size_t)(isq ? (u.pn - 1) * 4 + wc : wc) * 64); const int pitch = isq ? 768 : 256;
#else
        bf16* base = isq ? Q + (size_t)((u.pn - 1) * 4 + wc) * 64 : Kb + (size_t)wc * 64; const int pitch = isq ? 768 : 256;
#endif
        float k2max = 0.f;
#pragma unroll
        for (int ai = 0; ai < 2; ++ai) {
            float rowpos = (float)(u.pm * 4 + ai * 2 + wr); asm volatile("" : "+v"(rowpos));
            float cr[4], sr[4];
#pragma unroll
            for (int e = 0; e < 4; ++e) { const float rev = rowpos * frq[e], f_ = rev - floorf(rev); cr[e] = __builtin_amdgcn_cosf(f_); sr[e] = __builtin_amdgcn_sinf(f_); }
#pragma unroll
            for (int m = 0; m < 4; ++m) {
                float colpos = (float)(m * 16 + fr); asm volatile("" : "+v"(colpos));
                const int t = u.pm * 256 + ai * 128 + wr * 64 + m * 16 + fr;
                float ss = 0.f;
#pragma unroll
                for (int bj = 0; bj < 2; ++bj)
#pragma unroll
                    for (int n = 0; n < 2; ++n) { const pg8::f32x4 v = acc[ai][bj][m][n]; ss += (v[0] * v[0] + v[1] * v[1]) + (v[2] * v[2] + v[3] * v[3]); }
                ss += __shfl_xor(ss, 16); ss += __shfl_xor(ss, 32);
                const float rinv = qs / sqrtf(ss * (1.f / 64.f) + EPS);
                pg8::f32x4 y[2][2];
#pragma unroll
                for (int bj = 0; bj < 2; ++bj)
#pragma unroll
                    for (int n = 0; n < 2; ++n) y[bj][n] = acc[ai][bj][m][n] * rinv * gv[bj][n];
                if (lat) {
#pragma unroll
                    for (int e = 0; e < 4; ++e) {
                        { const float x1 = y[0][0][e], x2 = y[0][1][e]; y[0][0][e] = x1 * cr[e] - x2 * sr[e]; y[0][1][e] = x1 * sr[e] + x2 * cr[e]; }
                        { const float rev = colpos * frq[e], f_ = rev - floorf(rev); const float cc = __builtin_amdgcn_cosf(f_), sc = __builtin_amdgcn_sinf(f_);
                          const float x1 = y[1][0][e], x2 = y[1][1][e]; y[1][0][e] = x1 * cc - x2 * sc; y[1][1][e] = x1 * sc + x2 * cc; }
                    }
                }
                ss = 0.f;
#if ATTN_F8
                unsigned char* rowp8 = (unsigned char*)base + ((size_t)t * pitch + 4 * fq);
#pragma unroll
                for (int bj = 0; bj < 2; ++bj)
#pragma unroll
                    for (int n = 0; n < 2; ++n) { const pg8::f32x4 v = y[bj][n]; const unsigned w = pk4_fp8(v[0], v[1], v[2], v[3]); *(unsigned*)(rowp8 + 32 * bj + 16 * n) = w;
                        if (!isq) { const float b0 = __builtin_amdgcn_cvt_f32_fp8((int)w, 0), b1 = __builtin_amdgcn_cvt_f32_fp8((int)w, 1), b2 = __builtin_amdgcn_cvt_f32_fp8((int)w, 2), b3 = __builtin_amdgcn_cvt_f32_fp8((int)w, 3); ss += (b0 * b0 + b1 * b1) + (b2 * b2 + b3 * b3); } }
#else
                bf16* rowp = base + (size_t)t * pitch + 4 * fq;
#pragma unroll
                for (int bj = 0; bj < 2; ++bj)
#pragma unroll
                    for (int n = 0; n < 2; ++n) { const pg8::f32x4 v = y[bj][n]; const v2u w = (v2u){pk2(v[0], v[1]), pk2(v[2], v[3])}; *(v2u*)(rowp + 32 * bj + 16 * n) = w;
                        if (!isq) { const float b0 = __uint_as_float(w.x << 16), b1 = __uint_as_float(w.x & 0xffff0000u), b2 = __uint_as_float(w.y << 16), b3 = __uint_as_float(w.y & 0xffff0000u); ss += (b0 * b0 + b1 * b1) + (b2 * b2 + b3 * b3); } }
#endif
                if (!isq) { float r2 = ss; r2 += __shfl_xor(r2, 16); r2 += __shfl_xor(r2, 32); k2max = fmaxf(k2max, r2); }
                asm volatile("" ::: "memory");
            }
        }
        if (!isq) {
#pragma unroll
            for (int o = 1; o < 16; o <<= 1) k2max = fmaxf(k2max, __shfl_xor(k2max, o));
            if (fr == 0 && fq == 0) __hip_atomic_fetch_max(kmax, __float_as_uint(k2max), __ATOMIC_RELAXED, __HIP_MEMORY_SCOPE_AGENT);
        }
    }
};

__device__ __forceinline__ unsigned rev4_12(unsigned k) { unsigned r = __brev(k) >> 20; return ((r & 0xAAAu) >> 1) | ((r & 0x555u) << 1); }
__device__ __forceinline__ void fft_block(const Args& a, LAS unsigned char* lds, int item, int wave) {
    const int tid = wave * 64 + fresh_lane();
    const int mm = item & 31, par = (item >> 5) & 1, g = item >> 6;
    const float* FT = (const float*)(a.ws + WS_FT); bf16* MIX = (bf16*)(a.ws + WS_MIX);
    LAS f32x2* X = (LAS f32x2*)lds;
    const float* re = FT + (size_t)(64 * g + mm) * NTOK; const float* im = FT + (size_t)(64 * g + 32 + mm) * NTOK;
#pragma unroll 1
    for (int i = 0; i < 2; ++i) {
        const int j0 = 4 * (tid + NTHR * i);
        f32x4 r4[4], i4[4];
#pragma unroll
        for (int q = 0; q < 4; ++q) { r4[q] = *(const f32x4*)(re + j0 + 4096 * q); i4[q] = *(const f32x4*)(im + j0 + 4096 * q); }
#pragma unroll
        for (int e = 0; e < 4; ++e) {
            const int j = j0 + e;
            const f32x2 a0 = {r4[0][e], i4[0][e]}, a1 = {r4[1][e], i4[1][e]}, a2 = {r4[2][e], i4[2][e]}, a3 = {r4[3][e], i4[3][e]};
            f32x2 ya, yb; float fa, fb;
            if (par == 0) { const f32x2 s02 = a0 + a2, s13 = a1 + a3; ya = s02 + s13; yb = s02 - s13; fa = 0.f; fb = (float)(2 * j) * (1.f / 16384.f); }
            else { const f32x2 d02 = a0 - a2, d13 = a1 - a3; ya = (f32x2){d02.x + d13.y, d02.y - d13.x}; yb = (f32x2){d02.x - d13.y, d02.y + d13.x}; fa = (float)j * (1.f / 16384.f); fb = (float)(3 * j) * (1.f / 16384.f); }
            const float ca = __builtin_amdgcn_cosf(fa), sa = __builtin_amdgcn_sinf(fa), cb = __builtin_amdgcn_cosf(fb), sb = __builtin_amdgcn_sinf(fb);
            X[j] = (f32x2){ya.x * ca + ya.y * sa, ya.y * ca - ya.x * sa};
            X[4096 + j] = (f32x2){yb.x * cb + yb.y * sb, yb.y * cb - yb.x * sb};
        }
    }
    __syncthreads();
#pragma unroll 1
    for (int s = 0; s < 6; ++s) {
        const int lq = 10 - 2 * s;
        const int Lq = 1 << lq;
        const float invL = 1.f / (float)(4 << lq);
#pragma unroll 2
        for (int i = 0; i < 4; ++i) {
            const int b = tid + NTHR * i, j = b & (Lq - 1), base = ((b >> lq) << (lq + 2)) + j;
            const f32x2 a0 = X[base], a1 = X[base + Lq], a2 = X[base + 2 * Lq], a3 = X[base + 3 * Lq];
            const f32x2 s02 = a0 + a2, d02 = a0 - a2, s13 = a1 + a3, d13 = a1 - a3;
            const f32x2 y0 = s02 + s13, y2 = s02 - s13;
            const f32x2 y1 = (f32x2){d02.x + d13.y, d02.y - d13.x};
            const f32x2 y3 = (f32x2){d02.x - d13.y, d02.y + d13.x};
            const float f1 = (float)j * invL;
            const float c1 = __builtin_amdgcn_cosf(f1), s1 = __builtin_amdgcn_sinf(f1);
            const float c2 = __builtin_amdgcn_cosf(2.f * f1), s2 = __builtin_amdgcn_sinf(2.f * f1);
            const float c3 = __builtin_amdgcn_cosf(3.f * f1), s3 = __builtin_amdgcn_sinf(3.f * f1);
            X[base] = y0;
            X[base + Lq] = (f32x2){y1.x * c1 + y1.y * s1, y1.y * c1 - y1.x * s1};
            X[base + 2 * Lq] = (f32x2){y2.x * c2 + y2.y * s2, y2.y * c2 - y2.x * s2};
            X[base + 3 * Lq] = (f32x2){y3.x * c3 + y3.y * s3, y3.y * c3 - y3.x * s3};
        }
        __syncthreads();
    }
    const int col = 64 * g + 2 * mm;
#pragma unroll 1
    for (int i = 0; i < 16; ++i) {
        const int k = 2 * (tid + NTHR * i) + par, kn = (NTOK - k) & (NTOK - 1);
        const f32x2 wk = X[(((k & 3) - par) >> 1) * 4096 + rev4_12((unsigned)(k >> 2))], wn = X[(((kn & 3) - par) >> 1) * 4096 + rev4_12((unsigned)(kn >> 2))];
        float o0, o1;
        if (mm == 0) { o0 = 0.5f * (wk.x + wn.x); o1 = 0.5f * (wk.y + wn.y); }
        else { o0 = wn.x; o1 = wk.x; }
        *(unsigned*)(MIX + (size_t)k * DM + col) = pk2(o0, o1);
    }
    __syncthreads();
}

struct P3Prob {
    static constexpr int K = DM; static constexpr bool PERM = false, FP8 = false; static constexpr int SCW = 0, SCA = 0;
    const bf16* MIX; const bf16* WoT; const float* x; const float* g1; float* X1; pg8::StaticOrder so;
    __device__ __forceinline__ bool next(int i, pg8::Unit& u) const { return so.next(i, u); }
    __device__ __forceinline__ const char* aptr(const pg8::Unit& u) const { return (const char*)(MIX + (size_t)u.pm * 256 * DM); }
    __device__ __forceinline__ const char* bptr(const pg8::Unit& u) const { return (const char*)(WoT + (size_t)u.pn * 256 * DM); }
    __device__ __forceinline__ void epi(const pg8::f32x4 (&acc)[2][2][4][2], const pg8::Unit& u, int wr, int wc, int fr, int fq) const {
        const int col0 = u.pn * 256 + wc * 32 + 4 * fq;
        pg8::f32x4 gv[2][2];
#pragma unroll
        for (int bj = 0; bj < 2; ++bj)
#pragma unroll
            for (int n = 0; n < 2; ++n) gv[bj][n] = *(const pg8::f32x4*)(g1 + col0 + bj * 128 + n * 16);
#pragma unroll
        for (int ai = 0; ai < 2; ++ai)
#pragma unroll
            for (int m = 0; m < 4; ++m) { const size_t off = (size_t)(u.pm * 256 + ai * 128 + wr * 64 + m * 16 + fr) * DM + col0;
#pragma unroll
                for (int bj = 0; bj < 2; ++bj)
#pragma unroll
                    for (int n = 0; n < 2; ++n) { const pg8::f32x4 bs = *(const pg8::f32x4*)(x + off + bj * 128 + n * 16); *(pg8::f32x4*)(X1 + off + bj * 128 + n * 16) = bs + gv[bj][n] * acc[ai][bj][m][n]; }
                if (m & 1) asm volatile("" ::: "memory"); }
    }
};

__device__ __forceinline__ void p3b_router(const Args& a, LAS unsigned char* lds, int vcu, int G, int wave) {
    const int lane = fresh_lane(), tid = wave * 64 + lane;
    unsigned char* ws = a.ws; const float* MOD = (const float*)(ws + WS_MOD); const float* X1 = (const float*)(ws + WS_X1); bf16* H2 = (bf16*)(ws + WS_H2); float* AFF = (float*)(ws + WS_AFF);
    LAS float* wrt = (LAS float*)lds;
    { f32x4 t[8];
#pragma unroll
      for (int q = 0; q < 8; ++q) t[q] = *(const f32x4*)(a.w_router + 4 * (tid + NTHR * q));
#pragma unroll
      for (int q = 0; q < 8; ++q) { const int i = 4 * (tid + NTHR * q), col = i >> 4, e = i & 15;
#pragma unroll
          for (int k = 0; k < 4; ++k) wrt[(e + k) * 1024 + col] = t[q][k]; } }
    __syncthreads();
    f32x4 av[4], sh[4];
#pragma unroll
    for (int j = 0; j < 4; ++j) { const int col = 4 * lane + 256 * j; const f32x4 g = *(const f32x4*)(a.norm_ffn_g + col); const f32x4 sc = *(const f32x4*)(MOD + 4 * DM + col); av[j] = g * (sc + 1.f); sh[j] = *(const f32x4*)(MOD + 3 * DM + col); }
    const int gw = vcu * NWAVES + wave, NGW = G * NWAVES;
    f32x4 v[4], vn[4];
    if (gw < NTOK) { const GAS f32x4* xr = (const GAS f32x4*)(X1 + (size_t)gw * DM) + lane;
#pragma unroll
        for (int j = 0; j < 4; ++j) v[j] = xr[64 * j]; }
    for (int m = gw; m < NTOK; m += NGW) {
        const int mn = m + NGW;
        if (mn < NTOK) { const GAS f32x4* xr = (const GAS f32x4*)(X1 + (size_t)mn * DM) + lane;
#pragma unroll
            for (int j = 0; j < 4; ++j) vn[j] = xr[64 * j]; }
        float s = 0.f;
#pragma unroll
        for (int j = 0; j < 4; ++j) s += (v[j].x * v[j].x + v[j].y * v[j].y) + (v[j].z * v[j].z + v[j].w * v[j].w);
        const float rinv = 1.f / sqrtf(wave_sum(s) * (1.f / DM) + EPS);
        GAS unsigned* o4 = (GAS unsigned*)((unsigned char*)H2 + (size_t)m * DM) + lane;
#pragma unroll
        for (int j = 0; j < 4; ++j) { v[j] = v[j] * rinv * av[j] + sh[j]; o4[64 * j] = pk4_fp8(v[j].x, v[j].y, v[j].z, v[j].w); }
        float lg[16];
#pragma unroll
        for (int e0 = 0; e0 < 16; e0 += 4) {
#pragma unroll
            for (int e = e0; e < e0 + 4; ++e) { float p = 0.f;
#pragma unroll
                for (int j = 0; j < 4; ++j) { const f32x4 w = *(const LAS f32x4*)(wrt + e * 1024 + 4 * lane + 256 * j); p += (v[j].x * w.x + v[j].y * w.y) + (v[j].z * w.z + v[j].w * w.w); }
                lg[e] = p; }
            asm volatile("" ::: "memory"); }
        float r8[8], r4[4], r2[2], r1;
        { const bool up = (lane & 32) != 0;
#pragma unroll
          for (int e = 0; e < 8; ++e) { const float snd = up ? lg[e] : lg[e + 8], kp = up ? lg[e + 8] : lg[e]; r8[e] = kp + __shfl_xor(snd, 32); } }
        { const bool up = (lane & 16) != 0;
#pragma unroll
          for (int e = 0; e < 4; ++e) { const float snd = up ? r8[e] : r8[e + 4], kp = up ? r8[e + 4] : r8[e]; r4[e] = kp + __shfl_xor(snd, 16); } }
        { const bool up = (lane & 8) != 0;
#pragma unroll
          for (int e = 0; e < 2; ++e) { const float snd = up ? r4[e] : r4[e + 2], kp = up ? r4[e + 2] : r4[e]; r2[e] = kp + __shfl_xor(snd, 8); } }
        { const bool up = (lane & 4) != 0; const float snd = up ? r2[0] : r2[1], kp = up ? r2[1] : r2[0]; r1 = kp + __shfl_xor(snd, 4); }
        r1 += __shfl_xor(r1, 2); r1 += __shfl_xor(r1, 1);
        float mx = r1;
#pragma unroll
        for (int o = 4; o < 64; o <<= 1) mx = fmaxf(mx, __shfl_xor(mx, o));
        const float ex = __expf(r1 - mx); float den = ex;
#pragma unroll
        for (int o = 4; o < 64; o <<= 1) den += __shfl_xor(den, o);
        if ((lane & 3) == 0) AFF[(size_t)(lane >> 2) * NTOK + m] = ex / den;
#pragma unroll
        for (int j = 0; j < 4; ++j) v[j] = vn[j];
    }
}

__device__ __forceinline__ void p4_topk(const Args& a, LAS unsigned char* lds, int e, int wave) {
    const int lane = fresh_lane(), tid = wave * 64 + lane;
    unsigned char* ws = a.ws; const unsigned* AFF = (const unsigned*)(ws + WS_AFF) + (size_t)e * NTOK;
    int* IDX = (int*)(ws + WS_IDX) + e * CAP; float* GATE = (float*)(ws + WS_GATE) + e * CAP; int* TOKSLOT = (int*)(ws + WS_TOKSLOT);
    LAS unsigned* wcnt = (LAS unsigned*)lds;
    LAS unsigned* cg = wcnt + 16;
    LAS unsigned* ce = cg + 256;
    unsigned key[32];
#pragma unroll
    for (int i = 0; i < 32; ++i) key[i] = AFF[i * NTHR + tid];
    unsigned T = 0u;
#pragma unroll 1
    for (int bit = 30; bit >= 0; --bit) {
        const unsigned cand = T | (1u << bit);
        unsigned c = 0u;
#pragma unroll
        for (int i = 0; i < 32; ++i) c += (unsigned)__popcll(__ballot(key[i] >= cand));
        LAS unsigned* wb = wcnt + 1024 + (bit & 1) * 8;
        if (lane == 0) wb[wave] = c;
        __syncthreads();
        unsigned tot = 0u;
#pragma unroll
        for (int w = 0; w < 8; ++w) tot += wb[w];
        if (tot >= (unsigned)CAP) T = cand;
    }
    __syncthreads();
    unsigned long long below = (1ull << lane) - 1ull;
    unsigned rg[32], rq[32];
#pragma unroll
    for (int i = 0; i < 32; ++i) {
        const unsigned long long bg = __ballot(key[i] > T), bq = __ballot(key[i] == T);
        rg[i] = (unsigned)__popcll(bg & below); rq[i] = (unsigned)__popcll(bq & below);
        if (lane == 0) { cg[i * 8 + wave] = (unsigned)__popcll(bg); ce[i * 8 + wave] = (unsigned)__popcll(bq); }
    }
    __syncthreads();
    if (wave == 0) {
        unsigned g4[4], q4[4], sg = 0u, sq = 0u;
#pragma unroll
        for (int k = 0; k < 4; ++k) { g4[k] = cg[4 * lane + k]; q4[k] = ce[4 * lane + k]; sg += g4[k]; sq += q4[k]; }
        unsigned pg = sg, pq = sq;
#pragma unroll
        for (int o = 1; o < 64; o <<= 1) { const unsigned tg = __shfl_up(pg, o), tq = __shfl_up(pq, o); if (lane >= o) { pg += tg; pq += tq; } }
        pg -= sg; pq -= sq;
#pragma unroll
        for (int k = 0; k < 4; ++k) { cg[4 * lane + k] = pg; ce[4 * lane + k] = pq; pg += g4[k]; pq += q4[k]; }
        if (lane == 63) { wcnt[8] = pg; }
    }
    __syncthreads();
    const unsigned ngt = wcnt[8], need = (unsigned)CAP - ngt;
#pragma unroll
    for (int i = 0; i < 32; ++i) {
        const int tok = i * NTHR + tid;
        const unsigned gb = cg[i * 8 + wave] + rg[i], qb = ce[i * 8 + wave] + rq[i];
        const bool sel = key[i] > T || (key[i] == T && qb < need);
        const unsigned slot = gb + (qb < need ? qb : need);
        if (sel) { IDX[slot] = tok; GATE[slot] = __uint_as_float(key[i]); }
        TOKSLOT[tok * 16 + e] = sel ? (int)slot : -1;
    }
}

struct P5Prob {
    static constexpr int K = DM; static constexpr bool PERM = true, FP8 = true; static constexpr int SCW = 0x7A7A7A7A, SCA = 0x7F7F7F7F;
    const unsigned char* H2; const unsigned char* WguT; unsigned char* HID; pg8::StaticOrder so;
    __device__ __forceinline__ bool next(int i, pg8::Unit& u) const { return so.next(i, u); }
    __device__ __forceinline__ const char* aptr(const pg8::Unit&) const { return (const char*)H2; }
    __device__ __forceinline__ const char* bptr(const pg8::Unit& u) const { return (const char*)(WguT + ((size_t)(u.pm >> 3) * 4096 + (size_t)u.pn * 256) * DM); }
    __device__ __forceinline__ void epi(const pg8::f32x4 (&acc)[2][2][4][2], const pg8::Unit& u, int wr, int wc, int fr, int fq) const {
#pragma unroll
        for (int ai = 0; ai < 2; ++ai)
#pragma unroll
            for (int m = 0; m < 4; ++m) { unsigned char* rowp = HID + (size_t)(u.pm * 256 + ai * 128 + wr * 64 + m * 16 + fr) * DE + u.pn * 128 + wc * 32 + 8 * fq;
                float h[8];
#pragma unroll
                for (int n = 0; n < 2; ++n)
#pragma unroll
                    for (int e = 0; e < 4; ++e) { const float gt = acc[ai][0][m][n][e], up = acc[ai][1][m][n][e]; h[4 * n + e] = gt * __builtin_amdgcn_rcpf(1.f + __builtin_amdgcn_exp2f(-1.4426950408889634f * gt)) * up; }
                *(v2u*)rowp = (v2u){pk4_fp8(h[0], h[1], h[2], h[3]), pk4_fp8(h[4], h[5], h[6], h[7])}; }
    }
};
struct P6Prob {
    static constexpr int K = DE; static constexpr bool PERM = true, FP8 = true; static constexpr int SCW = 0x7A7A7A7A, SCA = 0x7F7F7F7F;
    const unsigned char* HID; const unsigned char* WdT; const float* GATE; bf16* YE; pg8::StaticOrder so;
    __device__ __forceinline__ bool next(int i, pg8::Unit& u) const { return so.next(i, u); }
    __device__ __forceinline__ const char* aptr(const pg8::Unit& u) const { return (const char*)(HID + (size_t)u.pm * 256 * DE); }
    __device__ __forceinline__ const char* bptr(const pg8::Unit& u) const { return (const char*)(WdT + ((size_t)(u.pm >> 3) * DM + (size_t)u.pn * 256) * DE); }
    __device__ __forceinline__ void epi(const pg8::f32x4 (&acc)[2][2][4][2], const pg8::Unit& u, int wr, int wc, int fr, int fq) const {
#pragma unroll
        for (int ai = 0; ai < 2; ++ai)
#pragma unroll
            for (int m = 0; m < 4; ++m) { const int row = u.pm * 256 + ai * 128 + wr * 64 + m * 16 + fr; const float gt = GATE[row]; bf16* rowp = YE + (size_t)row * DM + u.pn * 256 + wc * 32 + 8 * fq;
#pragma unroll
                for (int bj = 0; bj < 2; ++bj) { const pg8::f32x4 v0 = acc[ai][bj][m][0] * gt, v1 = acc[ai][bj][m][1] * gt;
                    *(v4u*)(rowp + bj * 128) = (v4u){pk2(v0[0], v0[1]), pk2(v0[2], v0[3]), pk2(v1[0], v1[1]), pk2(v1[2], v1[3])}; } }
    }
};

__device__ __forceinline__ void p7_final(const Args& a, int vcu, int G, int wave, unsigned poison) {
    const int lane = fresh_lane();
    unsigned char* ws = a.ws; const float* MOD = (const float*)(ws + WS_MOD); const bf16* YE = (const bf16*)(ws + WS_YE); const int* TOKSLOT = (const int*)(ws + WS_TOKSLOT);
    const float* src = (STEP >= 2) ? (const float*)(ws + WS_X1) : a.x;
    f32x4 g2[4], fg[4];
#pragma unroll
    for (int j = 0; j < 4; ++j) { const int col = 4 * lane + 256 * j; g2[j] = *(const f32x4*)(MOD + 5 * DM + col); fg[j] = *(const f32x4*)(a.final_norm_g + col); }
    const int gw = vcu * NWAVES + wave, NGW = G * NWAVES;
    for (int m = gw; m < NTOK; m += NGW) {
        const GAS f32x4* xr = (const GAS f32x4*)(src + (size_t)m * DM) + lane;
        f32x4 v[4];
#pragma unroll
        for (int j = 0; j < 4; ++j) v[j] = xr[64 * j];
        if (STEP >= 4) {
            const int myslot = lane < 16 ? TOKSLOT[m * 16 + lane] : -1;
            f32x4 s[4];
#pragma unroll
            for (int j = 0; j < 4; ++j) s[j] = (f32x4){0.f, 0.f, 0.f, 0.f};
#pragma unroll 1
            for (int e = 0; e < 16; ++e) {
                const int sl = __builtin_amdgcn_readlane(myslot, e);
                if (sl >= 0) {
                    const GAS v2u* yr = (const GAS v2u*)(YE + ((size_t)e * CAP + sl) * DM) + lane;
#pragma unroll
                    for (int j = 0; j < 4; ++j) { const v2u w = yr[64 * j]; s[j].x += __uint_as_float(w.x << 16); s[j].y += __uint_as_float(w.x & 0xffff0000u); s[j].z += __uint_as_float(w.y << 16); s[j].w += __uint_as_float(w.y & 0xffff0000u); }
                }
            }
#pragma unroll
            for (int j = 0; j < 4; ++j) v[j] += g2[j] * s[j];
        }
        float ss = 0.f;
#pragma unroll
        for (int j = 0; j < 4; ++j) ss += (v[j].x * v[j].x + v[j].y * v[j].y) + (v[j].z * v[j].z + v[j].w * v[j].w);
        const float rinv = 1.f / sqrtf(wave_sum(ss) * (1.f / DM) + EPS);
        GAS f32x4* o = (GAS f32x4*)(a.out + (size_t)m * DM) + lane;
        const float q = __builtin_nanf("");
#pragma unroll
        for (int j = 0; j < 4; ++j) { f32x4 y = v[j] * rinv * fg[j]; if (poison) y = (f32x4){q, q, q, q}; o[64 * j] = y; }
    }
}


#if PROBE
__device__ __forceinline__ void dsincos(double x, double& sn, double& cs) {
    const double TWO_PI = 6.283185307179586476925286766559; x -= TWO_PI * rint(x / TWO_PI);
    const double x2 = x * x; double ts = x, tc = 1.0; sn = x; cs = 1.0;
#pragma unroll 1
    for (int k = 1; k <= 14; ++k) { tc *= -x2 / (double)((2 * k - 1) * (2 * k)); ts *= -x2 / (double)((2 * k) * (2 * k + 1)); cs += tc; sn += ts; }
}
__device__ __forceinline__ float block_sum(float v, LAS float* red, int wave, int lane) {
    v = wave_sum(v); __syncthreads(); if (lane == 0) red[wave] = v; __syncthreads(); float s = 0.f;
#pragma unroll
    for (int w = 0; w < 8; ++w) s += red[w];
    return s;
}
__device__ __forceinline__ float block_max(float v, LAS float* red, int wave, int lane) {
#pragma unroll
    for (int o = 1; o < 64; o <<= 1) v = fmaxf(v, __shfl_xor(v, o));
    __syncthreads(); if (lane == 0) red[wave] = v; __syncthreads(); float s = red[0];
#pragma unroll
    for (int w = 1; w < 8; ++w) s = fmaxf(s, red[w]);
    return s;
}
__device__ __forceinline__ void probe_qkv(const Args& a, LAS unsigned char* lds, int vcu, int wave) {
    const int lane = fresh_lane(), tid = wave * 64 + lane; unsigned char* ws = a.ws;
    const bf16* XN = (const bf16*)(ws + WS_XN); const bf16* Qb = (const bf16*)(ws + WS_Q); const bf16* Kb = (const bf16*)(ws + WS_K); const bf16* Vb = (const bf16*)(ws + WS_V);
    gu32* ctl = (gu32*)(ws + WS_CTL);
    LAS float* red = (LAS float*)lds; LAS float* raw = red + 16;
    for (int kind = 0; kind < 3; ++kind) {
        const int nrows = kind == 0 ? NTOK : NROWS, nh = kind == 0 ? NHQ : NHKV;
        const int t = (kind == 1 && (vcu & 7) == 3) ? NTOK + (vcu * 37) % NCTX : (vcu * 977 + 131 * kind + 5) % (kind == 0 ? NTOK : NTOK);
        const int h = (vcu * 5 + kind) % nh;
        const int wcol0 = 256 + (kind == 0 ? 0 : (kind == 1 ? 768 : 1024)) + 64 * h;
        { const int d = tid & 63, part = tid >> 6; float sacc = 0.f;
          for (int k = part * 128; k < part * 128 + 128; ++k) sacc += bf2f(XN[(size_t)t * DM + k]) * a.w_in[(size_t)k * INW + wcol0 + d];
          LAS float* part_s = raw + 64; part_s[part * 64 + d] = sacc; __syncthreads();
          if (tid < 64) { float s2 = 0.f; for (int pp = 0; pp < 8; ++pp) s2 += part_s[pp * 64 + tid]; raw[tid] = s2; }
          __syncthreads(); }
        float ref = 0.f, got = 0.f;
        if (tid < 64) {
            const int d = tid; float v = raw[d];
            if (kind < 2) {
                float ss = 0.f; for (int j = 0; j < 64; ++j) ss += raw[j] * raw[j];
                const float* gw = kind == 0 ? a.q_norm_g : a.k_norm_g;
                const float rinv = 1.f / sqrtf(ss / 64.f + EPS);
                if (t < NTOK) {
                    const int half = d >> 5, dd = d & 31, i = dd & 15; const int pos = half == 0 ? (t >> 6) : (t & 63);
                    const double freq = exp2(-(double)i * (13.287712379549449 / 16.0)); double sn, cs; dsincos((double)pos * freq, sn, cs);
                    const float x1 = raw[32 * half + i] * rinv * gw[32 * half + i], x2 = raw[32 * half + 16 + i] * rinv * gw[32 * half + 16 + i];
                    v = dd < 16 ? (float)(x1 * cs - x2 * sn) : (float)(x1 * sn + x2 * cs);
                } else v = v * rinv * gw[d];
                if (kind == 0) v *= attn_body::C2;
            }
            ref = v;
#if ATTN_F8
            { const unsigned char* Q8 = (const unsigned char*)Qb; const unsigned char* K8 = (const unsigned char*)Kb; const unsigned char* V8 = (const unsigned char*)Vb;
              if (kind == 0) got = __builtin_amdgcn_cvt_f32_fp8((int)Q8[(size_t)t * 768 + 64 * h + d], 0) * (1.f / 16.f);
              else if (kind == 1) got = __builtin_amdgcn_cvt_f32_fp8((int)K8[(size_t)t * 256 + 64 * h + d], 0);
              else { const int kk = t & 63, tile = t >> 6, k5 = kk & 31, hk = (k5 >> 2) & 1, j = (k5 & 3) + 4 * (k5 >> 3) + 16 * (kk >> 5);
                     got = __builtin_amdgcn_cvt_f32_fp8((int)V8[(size_t)(h * (NKEYS / 64) + tile) * 4096 + (j >> 4) * 2048 + d * 32 + 16 * (hk ^ ((d >> 3) & 1)) + (j & 15)], 0); } }
#else
            got = kind == 0 ? bf2f(Qb[(size_t)t * 768 + 64 * h + d]) : (kind == 1 ? bf2f(Kb[(size_t)t * 256 + 64 * h + d]) : bf2f(Vb[(size_t)t * 256 + 64 * h + d]));
#endif
        }
        const float mx = block_max(fabsf(ref), red, wave, lane);
        const float err = block_max(fabsf(ref - got), red, wave, lane);
        if (tid == 0 && !(err <= (ATTN_F8 ? 0.07f : 0.03f) * mx + 1e-6f)) __hip_atomic_fetch_or(ctl + CW_FLAG, 1u << kind, RLX_AGENT);
        __syncthreads();
    }
}
__device__ __forceinline__ void probe_attn(const Args& a, LAS unsigned char* lds, int vcu, int wave) {
    const int lane = fresh_lane(), tid = wave * 64 + lane; unsigned char* ws = a.ws;
    const bf16* Qb = (const bf16*)(ws + WS_Q); const bf16* Kb = (const bf16*)(ws + WS_K); const bf16* Vb = (const bf16*)(ws + WS_V); const bf16* MIX = (const bf16*)(ws + WS_MIX);
    gu32* ctl = (gu32*)(ws + WS_CTL);
    LAS float* red = (LAS float*)lds; LAS float* ored = red + 16;
    const int t = (vcu * 613 + 29) % NTOK, h = (vcu * 7 + 3) % NHQ, kvh = h / 3;
    float q[64];
#if ATTN_F8
    const unsigned char* Q8 = (const unsigned char*)Qb; const unsigned char* K8 = (const unsigned char*)Kb; const unsigned char* V8 = (const unsigned char*)Vb;
#pragma unroll
    for (int d = 0; d < 64; ++d) q[d] = __builtin_amdgcn_cvt_f32_fp8((int)Q8[(size_t)t * 768 + 64 * h + d], 0) * (1.f / 16.f);
#else
#pragma unroll
    for (int d = 0; d < 64; ++d) q[d] = bf2f(Qb[(size_t)t * 768 + 64 * h + d]);
#endif
    float sc[33]; float mx = -1e30f;
#pragma unroll
    for (int i = 0; i < 33; ++i) { const int key = i * NTHR + tid; float s = -1e30f;
#if ATTN_F8
        if (key < NKEYS) { s = 0.f; const unsigned char* kr = K8 + (size_t)key * 256 + 64 * kvh;
#pragma unroll
            for (int d = 0; d < 64; ++d) s += q[d] * __builtin_amdgcn_cvt_f32_fp8((int)kr[d], 0); }
#else
        if (key < NKEYS) { s = 0.f; const bf16* kr = Kb + (size_t)key * 256 + 64 * kvh;
#pragma unroll
            for (int d = 0; d < 64; ++d) s += q[d] * bf2f(kr[d]); }
#endif
        sc[i] = s; mx = fmaxf(mx, s); }
    mx = block_max(mx, red, wave, lane);
    float den = 0.f; float o[64];
#pragma unroll
    for (int d = 0; d < 64; ++d) o[d] = 0.f;
#pragma unroll
    for (int i = 0; i < 33; ++i) { const int key = i * NTHR + tid;
#if ATTN_F8
        if (key < NKEYS) { const float pp = exp2f(sc[i] - mx); den += pp; const int kk = key & 63, tile = key >> 6, k5 = kk & 31, hk = (k5 >> 2) & 1, j = (k5 & 3) + 4 * (k5 >> 3) + 16 * (kk >> 5);
            const unsigned char* vb = V8 + (size_t)(kvh * (NKEYS / 64) + tile) * 4096 + (j >> 4) * 2048 + (j & 15);
#pragma unroll
            for (int d = 0; d < 64; ++d) o[d] += pp * __builtin_amdgcn_cvt_f32_fp8((int)vb[d * 32 + 16 * (hk ^ ((d >> 3) & 1))], 0); } }
#else
        if (key < NKEYS) { const float pp = exp2f(sc[i] - mx); den += pp; const bf16* vr = Vb + (size_t)key * 256 + 64 * kvh;
#pragma unroll
            for (int d = 0; d < 64; ++d) o[d] += pp * bf2f(vr[d]); } }
#endif
    den = block_sum(den, red, wave, lane);
#pragma unroll
    for (int d = 0; d < 64; ++d) { const float w = wave_sum(o[d]); if (lane == 0) ored[wave * 64 + d] = w; }
    __syncthreads();
    float ref = 0.f, got = 0.f;
    if (tid < 64) { float s = 0.f; for (int w = 0; w < 8; ++w) s += ored[w * 64 + tid]; ref = s / den; got = bf2f(MIX[(size_t)t * DM + 256 + 64 * h + tid]); }
    const float m2 = block_max(fabsf(ref), red, wave, lane);
    const float err = block_max(fabsf(ref - got), red, wave, lane);
    if (tid == 0 && !(err <= 0.03f * m2 + 1e-7f)) __hip_atomic_fetch_or(ctl + CW_FLAG, 8u, RLX_AGENT);
    __syncthreads();
}
#endif

__global__ void __launch_bounds__(NTHR, 2) fwd_megakernel(Args args) {
    extern __shared__ __attribute__((aligned(16))) unsigned char lds_raw[];
    LAS unsigned char* lds = (LAS unsigned char*)lds_raw;
    volatile LAS unsigned* MISC = (volatile LAS unsigned*)(lds + MISC_OFF);
    const int wave = __builtin_amdgcn_readfirstlane(threadIdx.x >> 6);
    const int G = gridDim.x; const int bx = blockIdx.x; const int vcu = (G % 8 == 0) ? (bx % 8) * (G / 8) + bx / 8 : bx;
    unsigned char* ws = args.ws;
    gu32* ctl = (gu32*)(ws + WS_CTL);
    { const int l0 = fresh_lane(); if (wave < 2) ((LAS unsigned*)(lds + MISC_OFF))[wave * 64 + l0] = 0u;
      __syncthreads();
    }
    XcdBarrier bar = xcd_barrier_post((unsigned*)(ctl + CW_BAR), MISC + 8, wave == 0 && fresh_lane() == 0);
#define GRID_BAR() xcd_barrier(bar, wave)

    for (int rep = 0; rep < REP(0); ++rep) {
    if (STEP >= 2 && PH(0)) p0_prologue(args, lds, vcu, G, wave);
    GRID_BAR(); }
    for (int rep = 0; rep < REP(1); ++rep) {
    if (STEP >= 2 && PH(1)) p0b_modulate(args, vcu, G, wave);
    GRID_BAR(); }
    for (int rep = 0; rep < REP(2); ++rep) {
    if (STEP >= 2 && PH(2)) {
        P1Prob p; p.XN = (bf16*)(ws + WS_XN); p.WinT = (bf16*)(ws + WS_WIN); p.Q = (bf16*)(ws + WS_Q); p.Kb = (bf16*)(ws + WS_K); p.Vb = (bf16*)(ws + WS_V); p.FT = (float*)(ws + WS_FT);
        p.qg = args.q_norm_g; p.kg = args.k_norm_g; p.kmax = (unsigned*)(ctl + CW_KMAX); p.so.init(NROWS / 256, INW / 256, G, bx);
        pg8::gemm_phase<P1Prob, false, true, true>(lds, p, nullptr, wave);
        if (rep == 0 && MOE_S1 > 0) {
            const int nwg = (NROWS / 256) * (INW / 256), maxc = (nwg + G - 1) / G, c0 = nwg - (maxc - 1) * G;
            if (c0 >= G) moe_convert(args, (LAS float*)(lds + wave * 16640), MOE_B0, MOE_B1, bx * NWAVES + wave, G * NWAVES);
            else if (bx >= c0) moe_convert(args, (LAS float*)(lds + wave * 16640), MOE_B0, MOE_B1, (bx - c0) * NWAVES + wave, (G - c0) * NWAVES);
        }
    }
    GRID_BAR(); }
#if PROBE == 1
    probe_qkv(args, lds, vcu, wave);
#endif
    if (REP(12) > 1) {
        P1Prob p; p.XN = (bf16*)(ws + WS_XN); p.WinT = (bf16*)(ws + WS_WIN); p.Q = (bf16*)(ws + WS_Q); p.Kb = (bf16*)(ws + WS_K); p.Vb = (bf16*)(ws + WS_V); p.FT = (float*)(ws + WS_FT);
        p.qg = args.q_norm_g; p.kg = args.k_norm_g; p.kmax = (unsigned*)(ctl + CW_KMAX); p.so.init(NROWS / 256, INW / 256, G, bx);
        pg8::gemm_phase<P1Prob, false, true, true>(lds, p, nullptr, wave);
        GRID_BAR(); }
    for (int rep = 0; rep < REP(3); ++rep) {
    if (STEP >= 2 && PH(3)) {
        for (int item = vcu; item < 256; item += G) fft_block(args, lds, item, wave);
        if (rep == 0 && MOE_S2 > 0) {
            if (G > 256) { if (vcu >= 256) moe_convert(args, (LAS float*)(lds + wave * 16640), MOE_B1, MOE_B2, (vcu - 256) * NWAVES + wave, (G - 256) * NWAVES); }
            else moe_convert(args, (LAS float*)(lds + wave * 16640), MOE_B1, MOE_B2, vcu * NWAVES + wave, G * NWAVES);
        }
    }
    if (rep + 1 < REP(3)) GRID_BAR(); }
    for (int rep = 0; rep < REP(4); ++rep) {
    if (STEP >= 3 && PH(4)) {
        const attn_body::bf16* Qb = (const attn_body::bf16*)(ws + WS_Q); const attn_body::bf16* Kb = (const attn_body::bf16*)(ws + WS_K); const attn_body::bf16* Vb = (const attn_body::bf16*)(ws + WS_V);
        attn_body::bf16* MIX = (attn_body::bf16*)(ws + WS_MIX);
        const float kmax2 = __uint_as_float(__hip_atomic_load(ctl + CW_KMAX, RLX_AGENT));
        const int u0 = (G == 256) ? vcu * 3 : vcu, ustep = (G == 256) ? 1 : G, uend = (G == 256) ? vcu * 3 + 3 : 768;
        int ucnt = 0;
#pragma unroll 1
        for (int u = u0; u < uend; u += ustep, ++ucnt) {
            if (rep == 0 && MOE_B3 < MOE_ITEMS && ucnt == ((G == 256) ? vcu % 3 : 0)) { moe_convert(args, (LAS float*)(lds + wave * 16640), MOE_B3, MOE_ITEMS, wave * G + vcu, NWAVES * G); __syncthreads(); }
            const int kvh = u / 192, w = u % 192, h = kvh * 3 + w / 64, qb = w % 64;
#if ATTN_F8
            attn_body::attn_unit_f8<0>(h, kvh, qb, (const unsigned char*)Qb, (const unsigned char*)Kb, (const unsigned char*)Vb, MIX, (char*)lds_raw, wave, kmax2);
#ifdef DUMMYVAR
            attn_body::attn_unit_f8<(DUMMYVAR) | 8>(h, kvh, qb, (const unsigned char*)Qb, (const unsigned char*)Kb, (const unsigned char*)Vb, MIX, (char*)lds_raw, wave, kmax2);
#endif
#else
            attn_body::attn_unit<8>(h, kvh, qb, Qb, Kb, Vb, MIX, (char*)lds_raw, wave, kmax2);
#endif
        }
    } else if (STEP == 2) {
        bf16* MIX = (bf16*)(ws + WS_MIX);
        const int gw = vcu * NWAVES + wave, NGW = G * NWAVES, lane = fresh_lane();
        for (int m = gw; m < NTOK; m += NGW) { GAS v4u* o = (GAS v4u*)(MIX + (size_t)m * DM + 256); o[lane] = (v4u){0u, 0u, 0u, 0u}; if (lane < 32) o[64 + lane] = (v4u){0u, 0u, 0u, 0u}; }
    }
    GRID_BAR(); }
#if PROBE == 2
    probe_attn(args, lds, vcu, wave);
#endif
    for (int rep = 0; rep < REP(5); ++rep) {
    if (STEP >= 2 && PH(5)) {
        P3Prob p; p.MIX = (bf16*)(ws + WS_MIX); p.WoT = (bf16*)(ws + WS_WOUT); p.x = args.x; p.g1 = (const float*)(ws + WS_MOD) + 2 * DM; p.X1 = (float*)(ws + WS_X1); p.so.init(NTOK / 256, DM / 256, G, bx);
        pg8::gemm_phase<P3Prob, false, true, true>(lds, p, nullptr, wave);
    }
    GRID_BAR(); }
    for (int rep = 0; rep < REP(6); ++rep) {
    if (STEP >= 4 && PH(6)) p3b_router(args, lds, vcu, G, wave);
    GRID_BAR(); }
    for (int rep = 0; rep < REP(7); ++rep) {
    if (STEP >= 4 && PH(7)) {
#pragma unroll 1
        for (int e = vcu; e < NE; e += G) p4_topk(args, lds, e, wave);
        if (rep == 0) {
            if (G > NE) { if (vcu >= NE) moe_convert(args, (LAS float*)(lds + wave * 16640), MOE_B2, MOE_B3, (vcu - NE) * NWAVES + wave, (G - NE) * NWAVES); }
            else moe_convert(args, (LAS float*)(lds + wave * 16640), MOE_B2, MOE_B3, vcu * NWAVES + wave, G * NWAVES);
        } }
    GRID_BAR(); }
    if (REP(11) > 1) {
        moe_convert(args, (LAS float*)(lds + wave * 16640), MOE_B2, MOE_B3, vcu * NWAVES + wave, G * NWAVES);
        GRID_BAR(); }
    for (int rep = 0; rep < REP(8); ++rep) {
    if (STEP >= 4 && PH(8)) {
        P5Prob p; p.H2 = (const unsigned char*)(ws + WS_H2); p.WguT = (const unsigned char*)(ws + WS_WGU); p.HID = (unsigned char*)(ws + WS_HID); p.so.init(NE * CAP / 256, 2 * DE / 256, G, bx);
        LAS unsigned* rowtab = (LAS unsigned*)(lds + XTRA_OFF);
        const int* IDX = (const int*)(ws + WS_IDX);
        { const int tid = wave * 64 + fresh_lane(); pg8::Unit u; for (int i = 0; p.so.next(i, u) && i < 28; ++i) { if (tid < 256) rowtab[i * 256 + tid] = (unsigned)IDX[u.pm * 256 + tid]; } }
        __syncthreads();
        pg8::gemm_phase<P5Prob, true, true, true>(lds, p, rowtab, wave);
    }
    GRID_BAR(); }
    for (int rep = 0; rep < REP(9); ++rep) {
    if (STEP >= 4 && PH(9)) {
        P6Prob p; p.HID = (const unsigned char*)(ws + WS_HID); p.WdT = (const unsigned char*)(ws + WS_WD); p.GATE = (const float*)(ws + WS_GATE); p.YE = (bf16*)(ws + WS_YE); p.so.init(NE * CAP / 256, DM / 256, G, bx);
        pg8::gemm_phase<P6Prob, false, true, true>(lds, p, nullptr, wave);
    }
    GRID_BAR(); }
    {
        unsigned poison = (__hip_atomic_load(ctl + CW_BAR + XB_TMO, RLX_AGENT) != 0u) || (__hip_atomic_load(ctl + CW_FLAG, RLX_AGENT) != 0u);
        for (int rep = 0; rep < REP(10); ++rep) p7_final(args, vcu, G, wave, poison);
    }
}

extern "C" void kernel_launch(void* const* d_in, const int* in_sizes, int n_in, void* d_out, int out_size, void* d_ws, size_t ws_size, hipStream_t stream) {
    static int grid = 0;
    if (grid == 0) {
        if (n_in != 18 || in_sizes[0] != NTOK * DM || out_size != NTOK * DM || ws_size < WS_END) { fprintf(stderr, "kernel_launch: unexpected shapes (n_in %d, in0 %d, out %d, ws %zu)\n", n_in, n_in > 0 ? in_sizes[0] : -1, out_size, ws_size); grid = -1; return; }
        int dev = 0, cus = 0, per_cu = 0;
        if (hipGetDevice(&dev) != hipSuccess || hipDeviceGetAttribute(&cus, hipDeviceAttributeMultiprocessorCount, dev) != hipSuccess) { grid = -1; return; }
        if (hipFuncSetAttribute((const void*)fwd_megakernel, hipFuncAttributeMaxDynamicSharedMemorySize, LDS_BYTES) != hipSuccess) { fprintf(stderr, "kernel_launch: hipFuncSetAttribute failed\n"); grid = -1; return; }
        if (hipOccupancyMaxActiveBlocksPerMultiprocessor(&per_cu, (const void*)fwd_megakernel, NTHR, LDS_BYTES) != hipSuccess || per_cu < 1) { fprintf(stderr, "kernel_launch: occupancy query says %d blocks per CU\n", per_cu); (void)hipGetLastError(); grid = -1; return; }
        grid = cus;
    }
    if (grid < 0) return;
    (void)hipMemsetAsync((char*)d_ws + WS_CTL, 0, CTL_ZERO_BYTES, stream);
    Args a{};
    const float** f = (const float**)&a;
    for (int i = 0; i < 18; ++i) f[i] = (const float*)d_in[i];
    a.out = (float*)d_out; a.ws = (unsigned char*)d_ws;
    hipLaunchKernelGGL(fwd_megakernel, dim3(grid), dim3(NTHR), LDS_BYTES, stream, a);
}
```

```cpp
#include <hip/hip_runtime.h>
#include <hip/hip_bf16.h>
#include <cstdio>
#include <cstdint>
#include <cmath>

#ifndef STEP
#define STEP 4
#endif
#ifndef PROBE
#define PROBE 0
#endif
#ifndef PHMASK
#define PHMASK 0xFFFF
#endif
#define PH(k) ((PHMASK >> (k)) & 1)
#ifndef ATTN_F8
#define ATTN_F8 1
#endif
#ifndef REPEAT
#define REPEAT 0
#endif
#define REP(k) (((REPEAT >> (k)) & 1) + 1)

constexpr int DM = 1024, NTOK = 16384, NCTX = 256, NROWS = NTOK + NCTX, INW = 1536;
constexpr int NHQ = 12, NHKV = 4, HD = 64, NE = 16, CAP = 2048, DE = 2048, NMOD = 6;
constexpr int NKEYS = NROWS;
constexpr float EPS = 1e-6f;

__device__ __forceinline__ int fresh_lane() { int l; asm volatile("v_mbcnt_lo_u32_b32 %0, -1, 0\n\tv_mbcnt_hi_u32_b32 %0, -1, %0" : "=v"(l)); return l; }

namespace pg8 {
#define PG8_LAS __attribute__((address_space(3)))
typedef unsigned short bf16_t;
typedef short bf16x8 __attribute__((ext_vector_type(8)));
typedef float f32x4 __attribute__((ext_vector_type(4)));
typedef unsigned u32x4 __attribute__((ext_vector_type(4)));
typedef unsigned u32x2 __attribute__((ext_vector_type(2)));
typedef int v8i __attribute__((ext_vector_type(8)));
constexpr int BM = 256, BK = 64, HALF = 128, HTB = HALF * BK * 2, STAGE_BYTES = 8 * HTB, NXCD = 8, WGM = 8;

__host__ __device__ __forceinline__ int lds_byte(int r, int c) { const int st = (r >> 4) * 2 + (c >> 5), rr = r & 15, cc = c & 31, ob = rr * 64 + cc * 2; return st * 1024 + (ob ^ (((ob >> 9) & 1) << 5)); }
__host__ __device__ __forceinline__ void stage_rc(int b, int& R, int& C) { const int st = b / 1024, sb = b % 1024, swz = sb ^ (((sb >> 9) & 1) << 5); R = (st >> 1) * 16 + swz / 64; C = (st & 1) * 32 + (swz % 64) / 2; }
__host__ __device__ __forceinline__ int perm32(int rho) { const int n = rho >> 4, i = rho & 15; return 8 * (i >> 2) + 4 * n + (i & 3); }

struct Unit { int pm, pn; };

struct StaticOrder {
    int nM, nN, nwg, G, c;
    __host__ __device__ void init(int nM_, int nN_, int G_, int c_) { nM = nM_; nN = nN_; nwg = nM * nN; G = G_; c = c_; }
    __host__ __device__ bool next(int i, Unit& u) const {
        const long L = (long)i * G + c; if (L >= nwg) return false;
        int wgid = (int)L; { const int q = nwg / NXCD, r = nwg % NXCD, xcd = wgid % NXCD, off = wgid / NXCD; wgid = (xcd < r ? xcd * (q + 1) : r * (q + 1) + (xcd - r) * q) + off; }
        const int nig = WGM * nN, gid = wgid / nig, fm = gid * WGM, gsz = (nM - fm) < WGM ? (nM - fm) : WGM;
        u.pm = fm + ((wgid % nig) % gsz); u.pn = (wgid % nig) / gsz; return true;
    }
};

__device__ __forceinline__ unsigned cvt_pk_bf16(float lo, float hi) { unsigned r; asm volatile("v_cvt_pk_bf16_f32 %0, %1, %2" : "=v"(r) : "v"(lo), "v"(hi)); return r; }

template <class P, bool GATHER, bool ALIGN_EPI, bool SP2>
__device__ __forceinline__ void gemm_phase(PG8_LAS unsigned char* lds, const P& S, const PG8_LAS unsigned* rowtab, int wid) {
    const int lane = fresh_lane(), tid = wid * 64 + lane, wr = wid >> 2, wc = wid & 3, fr = lane & 15, fq = lane >> 4;
    constexpr bool F8 = P::FP8; constexpr int ESZ = F8 ? 1 : 2;
    constexpr int K = P::K, nt = F8 ? K / 128 : K / BK;
    int R0, C0; stage_rc(tid * 16, R0, C0);
    unsigned voffB[2];
#pragma unroll
    for (int i = 0; i < 2; ++i) { const int R = R0 + 64 * i; const int Rb = P::PERM ? ((R & ~31) + perm32(R & 31)) : R; voffB[i] = (unsigned)(Rb * K * ESZ + C0 * 2); }
    constexpr size_t kstep = (size_t)(BK * 2);
    constexpr size_t hstep = (size_t)HALF * K * ESZ;
    const unsigned ldsw = (unsigned)wid * 1024u;
    const int aoff = F8 ? lds_byte(wr * 64 + fr, fq * 16) : lds_byte(wr * 64 + fr, fq * 8), boff = F8 ? lds_byte(wc * 32 + fr, fq * 16) : lds_byte(wc * 32 + fr, fq * 8);
#define PG8_SA(b, h) (((b) * 2 + (h)) * HTB)
#define PG8_SB(b, h) ((4 + (b) * 2 + (h)) * HTB)
#define PG8_STAGE(bufoff, gbase, voff) do { _Pragma("unroll") for (int _i = 0; _i < 2; ++_i) \
        __builtin_amdgcn_global_load_lds((const unsigned*)((const char*)(gbase) + (voff)[_i]), (PG8_LAS unsigned*)(lds + (bufoff) + ldsw + _i * 8192), 16, 0, 0); } while (0)
#define PG8_LDA(dst, b, h) do { if constexpr (F8) { _Pragma("unroll") for (int m = 0; m < 4; ++m) { const PG8_LAS u32x4* p_ = (const PG8_LAS u32x4*)(lds + PG8_SA(b, h) + aoff + m * 2048); const u32x4 lo_ = p_[0], hi_ = p_[1]; \
            dst##8[m] = (v8i){(int)lo_.x, (int)lo_.y, (int)lo_.z, (int)lo_.w, (int)hi_.x, (int)hi_.y, (int)hi_.z, (int)hi_.w}; } } \
        else { _Pragma("unroll") for (int m = 0; m < 4; ++m) _Pragma("unroll") for (int k = 0; k < 2; ++k) dst[m][k] = *(const PG8_LAS bf16x8*)(lds + PG8_SA(b, h) + aoff + m * 2048 + k * 1024); } } while (0)
#define PG8_LDB(dst, b, h) do { if constexpr (F8) { _Pragma("unroll") for (int n = 0; n < 2; ++n) { const PG8_LAS u32x4* p_ = (const PG8_LAS u32x4*)(lds + PG8_SB(b, h) + boff + n * 2048); const u32x4 lo_ = p_[0], hi_ = p_[1]; \
            dst##8[n] = (v8i){(int)lo_.x, (int)lo_.y, (int)lo_.z, (int)lo_.w, (int)hi_.x, (int)hi_.y, (int)hi_.z, (int)hi_.w}; } } \
        else { _Pragma("unroll") for (int n = 0; n < 2; ++n) _Pragma("unroll") for (int k = 0; k < 2; ++k) dst[n][k] = *(const PG8_LAS bf16x8*)(lds + PG8_SB(b, h) + boff + n * 2048 + k * 1024); } } while (0)
#define PG8_MMA(ai, bj, At, Bt) do { __builtin_amdgcn_s_setprio(1); if constexpr (F8) { \
        asm volatile("s_nop 1\n\t" \
            "v_mfma_scale_f32_16x16x128_f8f6f4 %0, %8, %10, %0, %14, %15 op_sel_hi:[0,0,0]\n\t" \
            "v_mfma_scale_f32_16x16x128_f8f6f4 %1, %9, %10, %1, %14, %15 op_sel_hi:[0,0,0]\n\t" \
            "v_mfma_scale_f32_16x16x128_f8f6f4 %2, %8, %11, %2, %14, %15 op_sel_hi:[0,0,0]\n\t" \
            "v_mfma_scale_f32_16x16x128_f8f6f4 %3, %9, %11, %3, %14, %15 op_sel_hi:[0,0,0]\n\t" \
            "v_mfma_scale_f32_16x16x128_f8f6f4 %4, %8, %12, %4, %14, %15 op_sel_hi:[0,0,0]\n\t" \
            "v_mfma_scale_f32_16x16x128_f8f6f4 %5, %9, %12, %5, %14, %15 op_sel_hi:[0,0,0]\n\t" \
            "v_mfma_scale_f32_16x16x128_f8f6f4 %6, %8, %13, %6, %14, %15 op_sel_hi:[0,0,0]\n\t" \
            "v_mfma_scale_f32_16x16x128_f8f6f4 %7, %9, %13, %7, %14, %15 op_sel_hi:[0,0,0]" \
            : "+v"(acc[ai][bj][0][0]), "+v"(acc[ai][bj][0][1]), "+v"(acc[ai][bj][1][0]), "+v"(acc[ai][bj][1][1]), "+v"(acc[ai][bj][2][0]), "+v"(acc[ai][bj][2][1]), "+v"(acc[ai][bj][3][0]), "+v"(acc[ai][bj][3][1]) \
            : "v"(Bt##8[0]), "v"(Bt##8[1]), "v"(At##8[0]), "v"(At##8[1]), "v"(At##8[2]), "v"(At##8[3]), "v"(scw_), "v"(sca_)); } \
        else { _Pragma("unroll") for (int m = 0; m < 4; ++m) _Pragma("unroll") for (int n = 0; n < 2; ++n) _Pragma("unroll") for (int k = 0; k < 2; ++k) \
            acc[ai][bj][m][n] = __builtin_amdgcn_mfma_f32_16x16x32_bf16(Bt[n][k], At[m][k], acc[ai][bj][m][n], 0, 0, 0); } __builtin_amdgcn_s_setprio(0); } while (0)
#define PG8_WAIT_V(n) asm volatile("s_waitcnt vmcnt(" #n ")" ::: "memory")
#define PG8_WAIT_L(n) asm volatile("s_waitcnt lgkmcnt(" #n ")" ::: "memory")
#define PG8_BAR __builtin_amdgcn_s_barrier()
#define PG8_SCHED __builtin_amdgcn_sched_barrier(0)
#define PG8_AOFF(dst, u_, ui_) do { _Pragma("unroll") for (int _h = 0; _h < 2; ++_h) _Pragma("unroll") for (int _i = 0; _i < 2; ++_i) { \
        if constexpr (GATHER) dst[_h][_i] = (unsigned)(rowtab[(ui_) * 256 + _h * HALF + _i * 64 + R0] * (unsigned)(K * ESZ) + (unsigned)(C0 * 2)); \
        else dst[_h][_i] = (unsigned)((_h * HALF + _i * 64 + R0) * K * ESZ + C0 * 2); } } while (0)
    Unit cur, nxt; int ui = 0;
    if (!S.next(0, cur)) return;
    f32x4 acc[2][2][4][2];
#pragma unroll
    for (int a = 0; a < 2; ++a)
#pragma unroll
        for (int b = 0; b < 2; ++b)
#pragma unroll
            for (int m = 0; m < 4; ++m)
#pragma unroll
                for (int n = 0; n < 2; ++n) acc[a][b][m][n] = (f32x4){0.f, 0.f, 0.f, 0.f};
    bf16x8 At[4][2], B0[2][2], B1[2][2]; v8i At8[4], B08[2], B18[2]; const int scw_ = P::SCW, sca_ = P::SCA;
    unsigned vAc[2][2], vAn[2][2];
    PG8_AOFF(vAc, cur, 0);
    const char* cA = S.aptr(cur); const char* cB = S.bptr(cur);
    if constexpr (SP2) {
        PG8_STAGE(PG8_SB(0, 0), cB, voffB); PG8_STAGE(PG8_SB(0, 1), cB + hstep, voffB); PG8_STAGE(PG8_SA(0, 0), cA, vAc[0]); PG8_STAGE(PG8_SA(0, 1), cA, vAc[1]);
        if (wr == 1) PG8_BAR;
        PG8_WAIT_V(2); PG8_BAR;
        PG8_STAGE(PG8_SB(1, 0), cB + kstep, voffB); PG8_STAGE(PG8_SA(1, 0), cA + kstep, vAc[0]); PG8_STAGE(PG8_SB(1, 1), cB + hstep + kstep, voffB);
        PG8_WAIT_V(6); PG8_BAR;
    } else {
        PG8_STAGE(PG8_SB(0, 0), cB, voffB); PG8_STAGE(PG8_SA(0, 0), cA, vAc[0]); PG8_STAGE(PG8_SB(0, 1), cB + hstep, voffB); PG8_STAGE(PG8_SA(0, 1), cA, vAc[1]);
        if (wr == 1) PG8_BAR;
        PG8_WAIT_V(4); PG8_BAR;
        PG8_STAGE(PG8_SB(1, 0), cB + kstep, voffB); PG8_STAGE(PG8_SA(1, 0), cA + kstep, vAc[0]); PG8_STAGE(PG8_SB(1, 1), cB + hstep + kstep, voffB);
        PG8_WAIT_V(6); PG8_BAR;
    }
    for (;;) {
        const bool has_next = S.next(ui + 1, nxt);
        const char* nA = has_next ? S.aptr(nxt) : cA; const char* nB = has_next ? S.bptr(nxt) : cB;
        if (has_next) { PG8_AOFF(vAn, nxt, ui + 1); }
        else {
#pragma unroll
            for (int h = 0; h < 2; ++h)
#pragma unroll
                for (int i = 0; i < 2; ++i) vAn[h][i] = vAc[h][i];
        }
        for (int t = 0; t < nt; t += 2) {
            const bool last = (t == nt - 2);
            const char* a1 = cA + (size_t)(t + 1) * kstep;
            const char* a2 = last ? nA : cA + (size_t)(t + 2) * kstep; const char* b2 = last ? nB : cB + (size_t)(t + 2) * kstep;
            const char* a3 = a2 + kstep; const char* b3 = b2 + kstep;
            unsigned w2[2][2];
#pragma unroll
            for (int h = 0; h < 2; ++h)
#pragma unroll
                for (int i = 0; i < 2; ++i) w2[h][i] = last ? vAn[h][i] : vAc[h][i];
            if constexpr (SP2) {
            PG8_LDB(B0, 0, 0); PG8_LDB(B1, 0, 1); PG8_SCHED; PG8_LDA(At, 0, 0); PG8_STAGE(PG8_SA(1, 1), a1, vAc[1]);
            PG8_WAIT_V(8); PG8_WAIT_L(0); PG8_BAR; PG8_MMA(0, 0, At, B0); PG8_MMA(0, 1, At, B1); PG8_BAR; PG8_SCHED;
            PG8_LDA(At, 0, 1); PG8_STAGE(PG8_SB(0, 0), b2, voffB); PG8_STAGE(PG8_SB(0, 1), b2 + hstep, voffB); PG8_STAGE(PG8_SA(0, 0), a2, w2[0]);
            PG8_WAIT_V(8); PG8_WAIT_L(0); PG8_BAR; PG8_MMA(1, 0, At, B0); PG8_MMA(1, 1, At, B1); PG8_BAR; PG8_SCHED;
            PG8_LDB(B0, 1, 0); PG8_LDB(B1, 1, 1); PG8_SCHED; PG8_LDA(At, 1, 0); PG8_STAGE(PG8_SA(0, 1), a2, w2[1]);
            PG8_WAIT_V(8); PG8_WAIT_L(0); PG8_BAR; PG8_MMA(0, 0, At, B0); PG8_MMA(0, 1, At, B1); PG8_BAR; PG8_SCHED;
            PG8_LDA(At, 1, 1); PG8_STAGE(PG8_SB(1, 0), b3, voffB); PG8_STAGE(PG8_SB(1, 1), b3 + hstep, voffB); PG8_STAGE(PG8_SA(1, 0), a3, w2[0]);
            PG8_WAIT_V(8); PG8_WAIT_L(0); PG8_BAR; PG8_MMA(1, 0, At, B0); PG8_MMA(1, 1, At, B1); PG8_BAR; PG8_SCHED;
            } else {
            PG8_LDB(B0, 0, 0); PG8_SCHED; PG8_LDA(At, 0, 0); PG8_STAGE(PG8_SA(1, 1), a1, vAc[1]);
            PG8_WAIT_L(8); PG8_BAR; PG8_WAIT_L(0); PG8_MMA(0, 0, At, B0); PG8_BAR; PG8_SCHED;
            PG8_LDB(B1, 0, 1); PG8_STAGE(PG8_SB(0, 0), b2, voffB);
            PG8_BAR; PG8_WAIT_L(0); PG8_MMA(0, 1, At, B1); PG8_BAR;
            PG8_LDA(At, 0, 1); PG8_STAGE(PG8_SA(0, 0), a2, w2[0]);
            PG8_BAR; PG8_WAIT_L(0); PG8_MMA(1, 0, At, B0); PG8_BAR; PG8_SCHED;
            PG8_STAGE(PG8_SB(0, 1), b2 + hstep, voffB);
            PG8_WAIT_V(6); PG8_BAR; PG8_MMA(1, 1, At, B1); PG8_BAR;
            PG8_LDB(B0, 1, 0); PG8_SCHED; PG8_LDA(At, 1, 0); PG8_STAGE(PG8_SA(0, 1), a2, w2[1]);
            PG8_WAIT_L(8); PG8_BAR; PG8_WAIT_L(0); PG8_MMA(0, 0, At, B0); PG8_BAR; PG8_SCHED;
            PG8_LDB(B1, 1, 1); PG8_STAGE(PG8_SB(1, 0), b3, voffB);
            PG8_BAR; PG8_WAIT_L(0); PG8_MMA(0, 1, At, B1); PG8_BAR;
            PG8_LDA(At, 1, 1); PG8_STAGE(PG8_SA(1, 0), a3, w2[0]);
            PG8_BAR; PG8_WAIT_L(0); PG8_MMA(1, 0, At, B0); PG8_BAR; PG8_SCHED;
            PG8_STAGE(PG8_SB(1, 1), b3 + hstep, voffB);
            PG8_WAIT_V(6); PG8_BAR; PG8_MMA(1, 1, At, B1); PG8_BAR;
            }
        }
        if constexpr (ALIGN_EPI) { if (wr == 0) PG8_BAR; }
        if constexpr (F8) asm volatile("s_nop 15\n\ts_nop 7" ::: "memory");
        { int fr2 = fr, fq2 = fq; asm volatile("" : "+v"(fr2), "+v"(fq2));
          S.epi(acc, cur, wr, wc, fr2, fq2); }
        if (!has_next) break;
#pragma unroll
        for (int a = 0; a < 2; ++a)
#pragma unroll
            for (int b = 0; b < 2; ++b)
#pragma unroll
                for (int m = 0; m < 4; ++m)
#pragma unroll
                    for (int n = 0; n < 2; ++n) acc[a][b][m][n] = (f32x4){0.f, 0.f, 0.f, 0.f};
        cur = nxt; cA = nA; cB = nB; ++ui;
#pragma unroll
        for (int h = 0; h < 2; ++h)
#pragma unroll
            for (int i = 0; i < 2; ++i) vAc[h][i] = vAn[h][i];
        if constexpr (ALIGN_EPI) { if (wr == 1) PG8_BAR; }
    }
    PG8_WAIT_V(0);
    if constexpr (!ALIGN_EPI) { if (wr == 0) PG8_BAR; }
    PG8_BAR;
#undef PG8_SA
#undef PG8_SB
#undef PG8_STAGE
#undef PG8_LDA
#undef PG8_LDB
#undef PG8_MMA
#undef PG8_WAIT_V
#undef PG8_WAIT_L
#undef PG8_BAR
#undef PG8_SCHED
#undef PG8_AOFF
}
}

namespace attn_body {
using bf16 = __hip_bfloat16;
using bf16x8 = __attribute__((ext_vector_type(8))) short;
using s16x4 = __attribute__((ext_vector_type(4))) short;
using f32x16 = __attribute__((ext_vector_type(16))) float;
using u32x4 = __attribute__((ext_vector_type(4))) unsigned;
constexpr int D = 64, QPITCH = NHQ * D, KPITCH = NHKV * D, OPITCH = DM, OCOL0 = 256;
constexpr int NW = 8, QBLK = 32, QB = QBLK * NW, KVBLK = 64, NQB = NTOK / QB, NT = NKEYS / KVBLK;
static_assert(NT % 2 == 0 && NT >= 8, "tile count");
__device__ __forceinline__ int crow(int r, int hi) { return (r & 3) + 8 * (r >> 2) + 4 * hi; }
#define SBAR() __builtin_amdgcn_sched_barrier(0)
constexpr int NSLOT = 3, SLOTB = 8192;
constexpr int LDS_K = 0, LDS_V = NSLOT * SLOTB, LDS_WS = 2 * NSLOT * SLOTB, LDS_OST = LDS_WS + NW * 64 * 4, LDS_BYTES = LDS_OST + NW * 4096;
constexpr float C2 = 0.125f * 1.4426950408889634f;
__device__ __forceinline__ void glds16(const void* gsrc, unsigned lds_dst) { unsigned keep;
  asm volatile("s_mov_b32 %0, m0\n\ts_mov_b32 m0, %2\n\ts_nop 0\n\tglobal_load_lds_dwordx4 %1, off\n\ts_mov_b32 m0, %0" : "=&s"(keep) : "v"(gsrc), "s"(lds_dst) : "memory"); }
__device__ __forceinline__ float max3f(float a, float b, float c) { float r; asm("v_max3_f32 %0, %1, %2, %3" : "=v"(r) : "v"(a), "v"(b), "v"(c)); return r; }
__device__ __forceinline__ float max2f(float a, float b) { float r; asm("v_max_f32_e32 %0, %1, %2" : "=v"(r) : "v"(a), "v"(b)); return r; }
__device__ __forceinline__ float fadd_s(float a, float b) { float r; asm("v_add_f32_e32 %0, %1, %2" : "=v"(r) : "v"(a), "v"(b)); return r; }
__device__ __forceinline__ float fsub_s(float a, float b) { float r; asm("v_sub_f32_e32 %0, %1, %2" : "=v"(r) : "v"(a), "v"(b)); return r; }
typedef float f32x2_t __attribute__((ext_vector_type(2))); typedef __bf16 bf16x2_t __attribute__((ext_vector_type(2)));
__device__ __forceinline__ unsigned cvtpk_s(float lo, float hi) { f32x2_t v = {lo, hi}; bf16x2_t b = __builtin_convertvector(v, bf16x2_t); return __builtin_bit_cast(unsigned, b); }
#define WAIT_BAR(N) asm volatile("s_waitcnt vmcnt(" #N ") lgkmcnt(0)\n\ts_barrier" ::: "memory")

__device__ __forceinline__ void qkt(f32x16& p0, f32x16& p1, const char* Kslot, const bf16x8* qr, const f32x16& negm, int r32, int hi) {
  const char* kb = Kslot + hi * 1024 + r32 * 16;
  #pragma unroll
  for (int d0 = 0; d0 < 4; ++d0) {
    const bf16x8 b0 = *reinterpret_cast<const bf16x8*>(kb + d0 * 2048);
    const bf16x8 b1 = *reinterpret_cast<const bf16x8*>(kb + d0 * 2048 + 512);
    if (d0 == 0) { p0 = __builtin_amdgcn_mfma_f32_32x32x16_bf16(b0, qr[0], negm, 0, 0, 0); p1 = __builtin_amdgcn_mfma_f32_32x32x16_bf16(b1, qr[0], negm, 0, 0, 0); }
    else { p0 = __builtin_amdgcn_mfma_f32_32x32x16_bf16(b0, qr[d0], p0, 0, 0, 0); p1 = __builtin_amdgcn_mfma_f32_32x32x16_bf16(b1, qr[d0], p1, 0, 0, 0); } }
}
typedef __attribute__((address_space(3))) const char* lds_cptr;
typedef short v4i16_t __attribute__((ext_vector_type(4)));
__device__ __forceinline__ void kload8(bf16x8* kf, lds_cptr kp) {
  kf[0] = *(const __attribute__((address_space(3))) bf16x8*)(kp);        kf[1] = *(const __attribute__((address_space(3))) bf16x8*)(kp + 512);
  kf[2] = *(const __attribute__((address_space(3))) bf16x8*)(kp + 2048); kf[3] = *(const __attribute__((address_space(3))) bf16x8*)(kp + 2560);
  kf[4] = *(const __attribute__((address_space(3))) bf16x8*)(kp + 4096); kf[5] = *(const __attribute__((address_space(3))) bf16x8*)(kp + 4608);
  kf[6] = *(const __attribute__((address_space(3))) bf16x8*)(kp + 6144); kf[7] = *(const __attribute__((address_space(3))) bf16x8*)(kp + 6656);
}
__device__ __forceinline__ void kload2(bf16x8* kf, lds_cptr kp, int j) { kf[2 * j] = *(const __attribute__((address_space(3))) bf16x8*)(kp + j * 2048); kf[2 * j + 1] = *(const __attribute__((address_space(3))) bf16x8*)(kp + j * 2048 + 512); }
__device__ __forceinline__ s16x4 vtr(lds_cptr p) { return __builtin_bit_cast(s16x4, __builtin_amdgcn_ds_read_tr16_b64_v4i16((__attribute__((address_space(3))) v4i16_t*)p)); }
__device__ __forceinline__ float rowmax(const f32x16& p0, const f32x16& p1) {
  float a = max3f(p0[0], p0[1], p1[0]), b = max3f(p0[2], p0[3], p1[1]); a = max3f(a, p1[2], p1[3]);
  #pragma unroll
  for (int r = 4; r < 16; r += 4) { a = max3f(a, p0[r], p0[r + 1]); b = max3f(b, p0[r + 2], p0[r + 3]); a = max3f(a, p1[r], p1[r + 1]); b = max3f(b, p1[r + 2], p1[r + 3]); }
  const float m = max2f(a, b);
  auto rr = __builtin_amdgcn_permlane32_swap(__float_as_uint(m), __float_as_uint(m), false, false);
  return max2f(__uint_as_float(rr[0]), __uint_as_float(rr[1]));
}
__device__ __forceinline__ void pv(f32x16* o, int vb, bf16x8 pa0, bf16x8 pa1, bf16x8 pa2, bf16x8 pa3) {
  #pragma unroll
  for (int d0 = 0; d0 < 2; ++d0) { s16x4 lo[4], hi[4];
    #pragma unroll
    for (int ks = 0; ks < 4; ++ks) {
      asm volatile("ds_read_b64_tr_b16 %0,%1 offset:%c2" : "=&v"(lo[ks]) : "v"(vb), "i"(d0 * 4096 + ks * 1024) : "memory");
      asm volatile("ds_read_b64_tr_b16 %0,%1 offset:%c2" : "=&v"(hi[ks]) : "v"(vb), "i"(d0 * 4096 + ks * 1024 + 512) : "memory"); }
    asm volatile("s_waitcnt lgkmcnt(0)" ::: "memory"); SBAR();
    #define PK(k) (bf16x8){lo[k][0], lo[k][1], lo[k][2], lo[k][3], hi[k][0], hi[k][1], hi[k][2], hi[k][3]}
    o[d0] = __builtin_amdgcn_mfma_f32_32x32x16_bf16(pa0, PK(0), o[d0], 0, 0, 0);
    o[d0] = __builtin_amdgcn_mfma_f32_32x32x16_bf16(pa1, PK(1), o[d0], 0, 0, 0);
    o[d0] = __builtin_amdgcn_mfma_f32_32x32x16_bf16(pa2, PK(2), o[d0], 0, 0, 0);
    o[d0] = __builtin_amdgcn_mfma_f32_32x32x16_bf16(pa3, PK(3), o[d0], 0, 0, 0);
    #undef PK
  }
}
#define ATTN_STORE16(p, v) (*(u32x4*)(p) = (v))
template <int THRL> __device__ __forceinline__ void attn_unit(int h, int kvh, int qb, const bf16* Q, const bf16* __restrict__ K, const bf16* __restrict__ V, bf16* O, char* shm, int wid, float kmax2) {
  const int lane = fresh_lane(), r32 = lane & 31, hi = lane >> 5;
  const int q0 = qb * QB;
  const bf16* Qw = Q + (long)(q0 + wid * QBLK) * QPITCH + h * D;
  const bf16* Kh = K + kvh * D, *Vh = V + kvh * D;
  const unsigned lds0 = (unsigned)(uintptr_t)shm;
  float* wsf = (float*)(shm + LDS_WS) + wid * 64;
  const bf16* ksrc = Kh + (long)lane * KPITCH + wid * 8;
  const bf16* vsrc = Vh + (long)(16 * (wid & 3) + (lane >> 2)) * KPITCH + (wid >> 2) * 32 + (lane & 3) * 8;
  const unsigned kdst = lds0 + LDS_K + wid * 1024, vdst = lds0 + LDS_V + wid * 1024;
  #define DMA_K(t, slot) glds16(ksrc + (long)(t) * KVBLK * KPITCH, (unsigned)__builtin_amdgcn_readfirstlane(kdst + (slot)))
  #define DMA_V(t, slot) glds16(vsrc + (long)(t) * KVBLK * KPITCH, (unsigned)__builtin_amdgcn_readfirstlane(vdst + (slot)))
  const int vb0 = (int)(lds0 + LDS_V) + ((lane >> 4) & 1) * 32 + (lane & 3) * 8 + (4 * hi + ((lane & 15) >> 2)) * 64;
  const char* Kbase = shm + LDS_K; bf16x8 kf[8];
  const lds_cptr shm3 = (lds_cptr)shm; const lds_cptr kp0 = shm3 + LDS_K + hi * 1024 + r32 * 16; const lds_cptr vp0 = shm3 + LDS_V + ((lane >> 4) & 1) * 32 + (lane & 3) * 8 + (4 * hi + ((lane & 15) >> 2)) * 64;
  DMA_K(0, 0); DMA_V(0, 0); DMA_K(1, SLOTB);
  bf16x8 qr[4];
  #pragma unroll
  for (int d0 = 0; d0 < 4; ++d0) qr[d0] = *reinterpret_cast<const bf16x8*>(&Qw[(long)r32 * QPITCH + d0 * 16 + hi * 8]);
  float l_reg = 0.f; f32x16 o[2]; o[0] = f32x16{}; o[1] = f32x16{}; f32x16 negm;
  { float qn2 = 0.f;
    #pragma unroll
    for (int d0 = 0; d0 < 4; ++d0)
      #pragma unroll
      for (int j = 0; j < 8; ++j) { const float f = __uint_as_float((unsigned)(unsigned short)qr[d0][j] << 16); qn2 += f * f; }
    auto rr = __builtin_amdgcn_permlane32_swap(__float_as_uint(qn2), __float_as_uint(qn2), false, false); qn2 = __uint_as_float(rr[0]) + __uint_as_float(rr[1]);
    const float bnd = sqrtf(qn2 * kmax2) * 1.004f + 0.01f;
    #pragma unroll
    for (int r = 0; r < 16; ++r) negm[r] = -bnd;
    asm volatile("" : "+v"(negm)); }
  f32x16 pA0, pA1, pB0, pB1;
  int sl_prev = 0, sl_cur = 0, sl_next = SLOTB;
  #define ROT() do { sl_prev = sl_cur; sl_cur = sl_next; sl_next = (sl_next == (NSLOT - 1) * SLOTB) ? 0 : sl_next + SLOTB; } while (0)
  DMA_K(2, 2 * SLOTB);
  WAIT_BAR(3);
  qkt(pA0, pA1, Kbase, qr, negm, r32, hi); asm volatile("s_nop 15\n\ts_nop 7" : "+v"(pA0), "+v"(pA1));
  _Pragma("unroll") for (int r = 0; r < 16; ++r) { pA0[r] = __builtin_amdgcn_exp2f(pA0[r]); pA1[r] = __builtin_amdgcn_exp2f(pA1[r]); }
  WAIT_BAR(0);
  DMA_K(3, 0); DMA_V(1, SLOTB);
  ROT();
  kload8(kf, kp0 + sl_cur);
  WAIT_BAR(2);
  s16x4 vlo[8], vhi[8]; u32x4 pw0, pw1, pw2, pw3;
  #define PKW(P, B) cvtpk_s(P[B], P[B + 1])
  #define PAF(k) __builtin_bit_cast(bf16x8, pw##k)
  #define VFR(i) (bf16x8){vlo[i][0], vlo[i][1], vlo[i][2], vlo[i][3], vhi[i][0], vhi[i][1], vhi[i][2], vhi[i][3]}
  #define PIN(x) asm volatile("" : "+v"(x))
  #define MX3(a, b, c) __builtin_fmaxf(__builtin_fmaxf((a), (b)), (c))
  #define GAPA(MF, A0, A1, A2, A3, W0, W1, PW) do { MF; sacc += A0; sacc += A1; sacc += A2; sacc += A3; PIN(sacc); W0; W1; PIN(PW); SBAR(); } while (0)
  #define EX(v) __builtin_amdgcn_exp2f(v)
  #define GAPB(MF, X, B) do { MF; X[B] = EX(X[B]); X[B + 1] = EX(X[B + 1]); X[B + 2] = EX(X[B + 2]); X[B + 3] = EX(X[B + 3]); PIN(X); SBAR(); } while (0)
  #define VRD(i) do { vlo[i] = vtr(vp_ + (((i) >> 2) * 4096 + ((i) & 3) * 1024)); vhi[i] = vtr(vp_ + (((i) >> 2) * 4096 + ((i) & 3) * 1024 + 512)); } while (0)
  #define KRD(G, j) do { if (G) { kload2(kf, kp0 + sl_next, j); SBAR(); } } while (0)
  #define STEPM(C0, C1, P0, P1, t, GK, GV, GL) do { SBAR(); \
    const lds_cptr vp_ = vp0 + sl_prev; \
    VRD(0); SBAR(); float sacc = (P0[0] + P0[1]); \
    GAPA(C0 = __builtin_amdgcn_mfma_f32_32x32x16_bf16(kf[0], qr[0], negm, 0, 0, 0), P0[2], P0[3], P0[4], P0[5],     pw0[0] = PKW(P0, 0), pw0[1] = PKW(P0, 2), pw0); \
    VRD(4); SBAR(); GAPA(C1 = __builtin_amdgcn_mfma_f32_32x32x16_bf16(kf[1], qr[0], negm, 0, 0, 0), P0[6], P0[7], P0[8], P0[9],     pw0[2] = PKW(P0, 4), pw0[3] = PKW(P0, 6), pw0); \
    VRD(1); SBAR(); GAPA(C0 = __builtin_amdgcn_mfma_f32_32x32x16_bf16(kf[2], qr[1], C0, 0, 0, 0),   P0[10], P0[11], P0[12], P0[13], pw1[0] = PKW(P0, 8), pw1[1] = PKW(P0, 10), pw1); \
    VRD(5); SBAR(); GAPA(C1 = __builtin_amdgcn_mfma_f32_32x32x16_bf16(kf[3], qr[1], C1, 0, 0, 0),   P0[14], P0[15], P1[0], P1[1],   pw1[2] = PKW(P0, 12), pw1[3] = PKW(P0, 14), pw1); \
    VRD(2); SBAR(); GAPA(C0 = __builtin_amdgcn_mfma_f32_32x32x16_bf16(kf[4], qr[2], C0, 0, 0, 0),   P1[2], P1[3], P1[4], P1[5],     pw2[0] = PKW(P1, 0), pw2[1] = PKW(P1, 2), pw2); \
    VRD(6); SBAR(); GAPA(C1 = __builtin_amdgcn_mfma_f32_32x32x16_bf16(kf[5], qr[2], C1, 0, 0, 0),   P1[6], P1[7], P1[8], P1[9],     pw2[2] = PKW(P1, 4), pw2[3] = PKW(P1, 6), pw2); \
    VRD(3); SBAR(); GAPA(C0 = __builtin_amdgcn_mfma_f32_32x32x16_bf16(kf[6], qr[3], C0, 0, 0, 0),   P1[10], P1[11], P1[12], P1[13], pw3[0] = PKW(P1, 8), pw3[1] = PKW(P1, 10), pw3); \
    VRD(7); SBAR(); GAPA(C1 = __builtin_amdgcn_mfma_f32_32x32x16_bf16(kf[7], qr[3], C1, 0, 0, 0),   P1[14], P1[15], 0.f, 0.f,       pw3[2] = PKW(P1, 12), pw3[3] = PKW(P1, 14), pw3); \
    l_reg += sacc; \
    if (GK) { DMA_K((t) + 3, sl_cur); } if (GV) { DMA_V((t) + 1, sl_next); } \
    SBAR(); \
    GAPB(o[0] = __builtin_amdgcn_mfma_f32_32x32x16_bf16(PAF(0), VFR(0), o[0], 0, 0, 0), C0, 0); \
    GAPB(o[1] = __builtin_amdgcn_mfma_f32_32x32x16_bf16(PAF(0), VFR(4), o[1], 0, 0, 0), C0, 4); \
    KRD(GL, 0); GAPB(o[0] = __builtin_amdgcn_mfma_f32_32x32x16_bf16(PAF(1), VFR(1), o[0], 0, 0, 0), C0, 8); \
    KRD(GL, 1); GAPB(o[1] = __builtin_amdgcn_mfma_f32_32x32x16_bf16(PAF(1), VFR(5), o[1], 0, 0, 0), C0, 12); \
    KRD(GL, 2); GAPB(o[0] = __builtin_amdgcn_mfma_f32_32x32x16_bf16(PAF(2), VFR(2), o[0], 0, 0, 0), C1, 0); \
    KRD(GL, 3); GAPB(o[1] = __builtin_amdgcn_mfma_f32_32x32x16_bf16(PAF(2), VFR(6), o[1], 0, 0, 0), C1, 4); \
    GAPB(o[0] = __builtin_amdgcn_mfma_f32_32x32x16_bf16(PAF(3), VFR(3), o[0], 0, 0, 0), C1, 8); \
    GAPB(o[1] = __builtin_amdgcn_mfma_f32_32x32x16_bf16(PAF(3), VFR(7), o[1], 0, 0, 0), C1, 12); \
    } while (0)
  int t = 1;
  for (; t + 5 < NT; t += 2) {
    STEPM(pB0, pB1, pA0, pA1, t, true, true, true);     WAIT_BAR(2); ROT();
    STEPM(pA0, pA1, pB0, pB1, t + 1, true, true, true); WAIT_BAR(2); ROT();
  }
  #define ENDW(tt) do { if ((tt) + 3 < NT) { WAIT_BAR(2); } else if ((tt) + 2 < NT) { WAIT_BAR(1); } else { WAIT_BAR(0); } } while (0)
  for (; t + 1 < NT; t += 2) {
    STEPM(pB0, pB1, pA0, pA1, t, (t + 3 < NT), (t + 1 < NT), (t + 1 < NT));         ENDW(t);     ROT();
    STEPM(pA0, pA1, pB0, pB1, t + 1, (t + 4 < NT), (t + 2 < NT), (t + 2 < NT));     ENDW(t + 1); ROT();
  }
  STEPM(pB0, pB1, pA0, pA1, NT - 1, false, false, false);
  { float sacc = pB0[0] + pB0[1]; _Pragma("unroll") for (int r = 2; r < 16; ++r) sacc += pB0[r]; _Pragma("unroll") for (int r = 0; r < 16; ++r) sacc += pB1[r]; l_reg += sacc;
    pw0 = (u32x4){PKW(pB0, 0), PKW(pB0, 2), PKW(pB0, 4), PKW(pB0, 6)}; pw1 = (u32x4){PKW(pB0, 8), PKW(pB0, 10), PKW(pB0, 12), PKW(pB0, 14)}; pw2 = (u32x4){PKW(pB1, 0), PKW(pB1, 2), PKW(pB1, 4), PKW(pB1, 6)}; pw3 = (u32x4){PKW(pB1, 8), PKW(pB1, 10), PKW(pB1, 12), PKW(pB1, 14)};
    SBAR(); pv(o, vb0 + sl_cur, PAF(0), PAF(1), PAF(2), PAF(3)); }
  #undef PKW
  #undef PAF
  #undef VFR
  #undef PIN
  #undef MX3
  #undef GAPA
  #undef GAPB
  #undef EX
  #undef VRD
  #undef KRD
  #undef STEPM
  #undef ENDW
  { auto rr = __builtin_amdgcn_permlane32_swap(__float_as_uint(l_reg), __float_as_uint(l_reg), false, false); l_reg = __uint_as_float(rr[0]) + __uint_as_float(rr[1]); }
  if (hi == 0) wsf[32 + r32] = l_reg; asm volatile("s_waitcnt lgkmcnt(0)" ::: "memory");
  float rli[16];
  #pragma unroll
  for (int r = 0; r < 16; ++r) rli[r] = __builtin_amdgcn_rcpf(wsf[32 + crow(r, hi)]);
  bf16* Ow = O + (long)(q0 + wid * QBLK) * OPITCH + OCOL0 + h * D;
  { bf16* stg = (bf16*)(shm + LDS_OST) + wid * 2048;
    #pragma unroll
    for (int r = 0; r < 16; ++r) { const int orow = crow(r, hi);
      #pragma unroll
      for (int d0 = 0; d0 < 2; ++d0) stg[orow * 64 + d0 * 32 + r32] = __float2bfloat16(o[d0][r] * rli[r]); }
    asm volatile("s_waitcnt lgkmcnt(0)" ::: "memory");
    #pragma unroll
    for (int i = 0; i < 4; ++i) { const int row = i * 8 + (lane >> 3), ch = lane & 7; const u32x4 v = *(const u32x4*)(stg + row * 64 + ch * 8); ATTN_STORE16(Ow + (long)row * OPITCH + ch * 8, v); } }
  asm volatile("s_waitcnt lgkmcnt(0)\n\ts_barrier" ::: "memory");
  #undef DMA_K
  #undef DMA_V
  #undef ROT
}
#undef SBAR
#undef WAIT_BAR

typedef int v8i_t __attribute__((ext_vector_type(8)));
constexpr int F8_SLOT = 4096, F8_LDS_K = 0, F8_LDS_V = 3 * F8_SLOT, F8_LDS_WS = 6 * F8_SLOT, F8_LDS_OST = F8_LDS_WS + NW * 64 * 4, F8_LDS_BYTES = F8_LDS_OST + NW * 4096;
#define SBAR() __builtin_amdgcn_sched_barrier(0)
#define WAIT_BAR(N) asm volatile("s_waitcnt vmcnt(" #N ") lgkmcnt(0)\n\ts_barrier" ::: "memory")
#define MFMA8_C(D, A, B, C, SA, SB) do { if (VAR & 64) { D = __builtin_amdgcn_mfma_f32_32x32x16_bf16(__builtin_bit_cast(bf16x8, (u32x4){(unsigned)A[0], (unsigned)A[1], (unsigned)A[2], (unsigned)A[3]}), __builtin_bit_cast(bf16x8, (u32x4){(unsigned)B[0], (unsigned)B[1], (unsigned)B[2], (unsigned)B[3]}), C, 0, 0, 0); \
      D = __builtin_amdgcn_mfma_f32_32x32x16_bf16(__builtin_bit_cast(bf16x8, (u32x4){(unsigned)A[4], (unsigned)A[5], (unsigned)A[6], (unsigned)A[7]}), __builtin_bit_cast(bf16x8, (u32x4){(unsigned)B[4], (unsigned)B[5], (unsigned)B[6], (unsigned)B[7]}), D, 0, 0, 0); } \
    else { asm volatile("s_nop 1\n\tv_mfma_scale_f32_32x32x64_f8f6f4 %0, %1, %2, %3, %4, %5 op_sel_hi:[0,0,0]" : "=&v"(D) : "v"(A), "v"(B), "v"(C), "v"(SA), "v"(SB)); \
      if (VAR & 256) asm volatile("s_nop 1\n\tv_mfma_scale_f32_32x32x64_f8f6f4 %0, %1, %2, %0, %3, %4 op_sel_hi:[0,0,0]" : "+v"(dacc) : "v"(A), "v"(B), "v"(SA), "v"(SB)); } } while (0)
#define MFMA8_ACC(D, A, B, SA, SB) do { if (VAR & 64) { D = __builtin_amdgcn_mfma_f32_32x32x16_bf16(__builtin_bit_cast(bf16x8, (u32x4){(unsigned)A[0], (unsigned)A[1], (unsigned)A[2], (unsigned)A[3]}), __builtin_bit_cast(bf16x8, (u32x4){(unsigned)B[0], (unsigned)B[1], (unsigned)B[2], (unsigned)B[3]}), D, 0, 0, 0); \
      D = __builtin_amdgcn_mfma_f32_32x32x16_bf16(__builtin_bit_cast(bf16x8, (u32x4){(unsigned)A[4], (unsigned)A[5], (unsigned)A[6], (unsigned)A[7]}), __builtin_bit_cast(bf16x8, (u32x4){(unsigned)B[4], (unsigned)B[5], (unsigned)B[6], (unsigned)B[7]}), D, 0, 0, 0); } \
    else { asm volatile("s_nop 1\n\tv_mfma_scale_f32_32x32x64_f8f6f4 %0, %1, %2, %0, %3, %4 op_sel_hi:[0,0,0]" : "+v"(D) : "v"(A), "v"(B), "v"(SA), "v"(SB)); \
      if (VAR & 256) asm volatile("s_nop 1\n\tv_mfma_scale_f32_32x32x64_f8f6f4 %0, %1, %2, %0, %3, %4 op_sel_hi:[0,0,0]" : "+v"(dacc) : "v"(A), "v"(B), "v"(SA), "v"(SB)); } } while (0)
template <int DBL> __device__ __forceinline__ v8i_t lds_frag32x(lds_cptr p) { const u32x4 lo = *(const __attribute__((address_space(3))) u32x4*)p, hi = *(const __attribute__((address_space(3))) u32x4*)(p + 2048);
  if (DBL) { const u32x4 lo2 = *(const volatile __attribute__((address_space(3))) u32x4*)(p + 4096), hi2 = *(const volatile __attribute__((address_space(3))) u32x4*)(p + 4112); asm volatile("" :: "v"(lo2), "v"(hi2)); }
  return (v8i_t){(int)lo.x, (int)lo.y, (int)lo.z, (int)lo.w, (int)hi.x, (int)hi.y, (int)hi.z, (int)hi.w}; }
__device__ __forceinline__ v8i_t lds_frag32(lds_cptr p) { const u32x4 lo = *(const __attribute__((address_space(3))) u32x4*)p, hi = *(const __attribute__((address_space(3))) u32x4*)(p + 16);
  return (v8i_t){(int)lo.x, (int)lo.y, (int)lo.z, (int)lo.w, (int)hi.x, (int)hi.y, (int)hi.z, (int)hi.w}; }
__device__ __forceinline__ unsigned pk4f8(float a, float b, float c, float d) { int p = __builtin_amdgcn_cvt_pk_fp8_f32(a, b, 0, false); p = __builtin_amdgcn_cvt_pk_fp8_f32(c, d, p, true); return (unsigned)p; }
template <int VAR> __device__ __forceinline__ void attn_unit_f8(int h, int kvh, int qb, const unsigned char* Q8, const unsigned char* __restrict__ K8, const unsigned char* __restrict__ VT8, bf16* O, char* shm, int wid, float kmax2) {
  const int lane = fresh_lane(), r32 = lane & 31, hi = lane >> 5; const bool kwave = wid < 4;
  const int q0 = qb * QB;
  const unsigned lds0 = (unsigned)(uintptr_t)shm;
  float* wsf = (float*)(shm + F8_LDS_WS) + wid * 64;
  const int kpl = (wid & 3) >> 1, krow = 32 * (wid & 1) + (lane >> 1), khalf = (lane & 1) ^ ((krow >> 3) & 1), kch = 2 * khalf + kpl;
  const unsigned char* dsrc = kwave ? K8 + (size_t)krow * KPITCH + kvh * D + 16 * kch : VT8 + (size_t)kvh * (NT * 4096) + 1024 * (wid & 3) + 16 * lane;
  const long dstep = kwave ? (long)KVBLK * KPITCH : 4096;
  const unsigned ddst = lds0 + (kwave ? F8_LDS_K : F8_LDS_V) + (wid & 3) * 1024;
  const int doff = kwave ? 3 : 1;
  #define DMA_T(t, slot) glds16(dsrc + (long)(t) * dstep, (unsigned)__builtin_amdgcn_readfirstlane(ddst + (slot)))
  const lds_cptr shm3 = (lds_cptr)shm;
  const lds_cptr kp0 = shm3 + F8_LDS_K + r32 * 32 + 16 * (hi ^ ((r32 >> 3) & 1));
  const lds_cptr vp0 = shm3 + F8_LDS_V + r32 * 32 + 16 * (hi ^ ((r32 >> 3) & 1));
  v8i_t qf;
  { const unsigned char* qp = Q8 + (size_t)(q0 + wid * QBLK + r32) * QPITCH + h * D + 32 * hi; const u32x4 lo = *(const u32x4*)qp, hi4 = *(const u32x4*)(qp + 16);
    qf = (v8i_t){(int)lo.x, (int)lo.y, (int)lo.z, (int)lo.w, (int)hi4.x, (int)hi4.y, (int)hi4.z, (int)hi4.w}; }
  DMA_T(0, 0); if (kwave) { DMA_T(1, F8_SLOT); DMA_T(2, 2 * F8_SLOT); }
  f32x16 lacc = f32x16{}; f32x16 o[2]; o[0] = f32x16{}; o[1] = f32x16{}; f32x16 negm;
  v8i_t ones8 = {0x38383838, 0x38383838, 0x38383838, 0x38383838, 0x38383838, 0x38383838, 0x38383838, 0x38383838}; asm volatile("" : "+v"(ones8));
  { float qn2 = 0.f;
    #pragma unroll
    for (int i = 0; i < 8; ++i) { const float f0 = __builtin_amdgcn_cvt_f32_fp8(qf[i], 0), f1 = __builtin_amdgcn_cvt_f32_fp8(qf[i], 1), f2 = __builtin_amdgcn_cvt_f32_fp8(qf[i], 2), f3 = __builtin_amdgcn_cvt_f32_fp8(qf[i], 3);
      qn2 += ((f0 * f0 + f1 * f1) + (f2 * f2 + f3 * f3)) * (1.f / 256.f); }
    auto rr = __builtin_amdgcn_permlane32_swap(__float_as_uint(qn2), __float_as_uint(qn2), false, false); qn2 = __uint_as_float(rr[0]) + __uint_as_float(rr[1]);
    const float bnd = sqrtf(qn2 * kmax2) * 1.004f + 0.01f;
    #pragma unroll
    for (int r = 0; r < 16; ++r) negm[r] = 8.f - bnd;
    asm volatile("" : "+v"(negm)); }
  int sQ = 0x7B7B7B7B, sONE = 0x7F7F7F7F; asm volatile("" : "+v"(sQ), "+v"(sONE));
  f32x16 dacc = f32x16{}; f32x16 pA0, pA1, pB0, pB1; v8i_t kf0, kf1, vfA0, vfA1, vfB0, vfB1, pwA = {0, 0, 0, 0, 0, 0, 0, 0}, pwB = {0, 0, 0, 0, 0, 0, 0, 0};
  int sl_prev = 0, sl_cur = 0, sl_next = F8_SLOT;
  #define ROT() do { sl_prev = sl_cur; sl_cur = sl_next; sl_next = (sl_next == 2 * F8_SLOT) ? 0 : sl_next + F8_SLOT; } while (0)
  #define PIN(x) asm volatile("" : "+v"(x))
  WAIT_BAR(0);
  kf0 = lds_frag32x<(VAR & 512) != 0>(kp0); kf1 = lds_frag32x<(VAR & 512) != 0>(kp0 + 1024);
  asm volatile("s_waitcnt lgkmcnt(0)" ::: "memory");
  MFMA8_C(pA0, kf0, qf, negm, sONE, sQ); MFMA8_C(pA1, kf1, qf, negm, sONE, sQ);
  asm volatile("s_nop 15\n\ts_nop 15\n\ts_nop 7" : "+v"(pA0), "+v"(pA1));
  #pragma unroll
  for (int r = 0; r < 16; ++r) pA0[r] = __builtin_amdgcn_exp2f(pA0[r]);
  WAIT_BAR(0);
  if (kwave) { DMA_T(3, 0); } else { DMA_T(1, F8_SLOT); }
  ROT();
  kf0 = lds_frag32x<(VAR & 512) != 0>(kp0 + sl_cur); kf1 = lds_frag32x<(VAR & 512) != 0>(kp0 + sl_cur + 1024);
  WAIT_BAR(1);
  #define CVT2(dst, a, b, c, d) do { if (VAR & 16) { asm volatile("" : "+v"(dst) : "v"(a), "v"(b), "v"(c), "v"(d)); } else { dst = __builtin_amdgcn_cvt_pk_fp8_f32(a, b, dst, false); dst = __builtin_amdgcn_cvt_pk_fp8_f32(c, d, dst, true); if (VAR & 32) { asm volatile("" : "+v"(dst)); dst = __builtin_amdgcn_cvt_pk_fp8_f32(a, b, dst, false); dst = __builtin_amdgcn_cvt_pk_fp8_f32(c, d, dst, true); } } } while (0)
  #define EXF(v) ((VAR & 1) ? (v) * 0.999f : ((VAR & 128) ? __builtin_amdgcn_exp2f(__builtin_amdgcn_exp2f(v) * 1e-30f) + __builtin_amdgcn_exp2f(v) - 1.0f : __builtin_amdgcn_exp2f(v)))
  #define EX4(X, B) do { X[B] = EXF(X[B]); X[B + 1] = EXF(X[B + 1]); X[B + 2] = EXF(X[B + 2]); X[B + 3] = EXF(X[B + 3]); } while (0)
  #define STEP8(C0, C1, P0, P1, PW, VF0, VF1, t, GK, GV, GL) do { SBAR(); \
    VF0 = lds_frag32x<(VAR & 512) != 0>(vp0 + sl_prev); VF1 = lds_frag32x<(VAR & 512) != 0>(vp0 + sl_prev + 1024); SBAR(); \
    if (VAR & 2) { C0 = negm; asm volatile("" : "+v"(C0) : "v"(kf0)); } else { MFMA8_C(C0, kf0, qf, negm, sONE, sQ); } SBAR(); \
    CVT2(PW[0], P0[0], P0[1], P0[2], P0[3]); CVT2(PW[1], P0[4], P0[5], P0[6], P0[7]); CVT2(PW[2], P0[8], P0[9], P0[10], P0[11]); CVT2(PW[3], P0[12], P0[13], P0[14], P0[15]); \
    EX4(P1, 0); EX4(P1, 4); PIN(PW); PIN(P1); SBAR(); \
    if (VAR & 2) { C1 = negm; asm volatile("" : "+v"(C1) : "v"(kf1)); } else { MFMA8_C(C1, kf1, qf, negm, sONE, sQ); } SBAR(); \
    EX4(P1, 8); EX4(P1, 12); \
    CVT2(PW[4], P1[0], P1[1], P1[2], P1[3]); CVT2(PW[5], P1[4], P1[5], P1[6], P1[7]); CVT2(PW[6], P1[8], P1[9], P1[10], P1[11]); CVT2(PW[7], P1[12], P1[13], P1[14], P1[15]); \
    PIN(PW); SBAR(); \
    if ((GK) && (GV)) { DMA_T((t) + doff, kwave ? sl_cur : sl_next); }     \
    else if (kwave) { if (GK) { DMA_T((t) + 3, sl_cur); } } else { if (GV) { DMA_T((t) + 1, sl_next); } } \
    if (GL) { kf0 = lds_frag32x<(VAR & 512) != 0>(kp0 + sl_next); kf1 = lds_frag32x<(VAR & 512) != 0>(kp0 + sl_next + 1024); } SBAR(); \
    if (VAR & 2) { asm volatile("" : "+v"(lacc) : "v"(PW)); } else { MFMA8_ACC(lacc, PW, ones8, sONE, sONE); } asm volatile("" : "+v"(C0)); SBAR(); \
    EX4(C0, 0); EX4(C0, 4); PIN(C0); SBAR(); \
    if (VAR & 2) { asm volatile("" : "+v"(o[0]) : "v"(PW), "v"(VF0)); } else { MFMA8_ACC(o[0], PW, VF0, sONE, sONE); } SBAR(); \
    EX4(C0, 8); EX4(C0, 12); PIN(C0); SBAR(); \
    if (VAR & 2) { asm volatile("" : "+v"(o[1]) : "v"(PW), "v"(VF1)); } else { MFMA8_ACC(o[1], PW, VF1, sONE, sONE); } SBAR(); } while (0)
  int t = 1;
  #pragma unroll 1
  for (; t + 5 < NT; t += 2) {
    STEP8(pB0, pB1, pA0, pA1, pwA, vfA0, vfA1, t, true, true, true);     if (VAR & 4) { asm volatile("s_waitcnt vmcnt(1) lgkmcnt(0)" ::: "memory"); } else { WAIT_BAR(1); } ROT();
    STEP8(pA0, pA1, pB0, pB1, pwB, vfB0, vfB1, t + 1, true, true, true); if (VAR & 4) { asm volatile("s_waitcnt vmcnt(1) lgkmcnt(0)" ::: "memory"); } else { WAIT_BAR(1); } ROT();
  }
  for (; t + 1 < NT; t += 2) {
    STEP8(pB0, pB1, pA0, pA1, pwA, vfA0, vfA1, t, (t + 3 < NT), (t + 1 < NT), (t + 1 < NT));         WAIT_BAR(0); ROT();
    STEP8(pA0, pA1, pB0, pB1, pwB, vfB0, vfB1, t + 1, (t + 4 < NT), (t + 2 < NT), (t + 2 < NT));     WAIT_BAR(0); ROT();
  }
  STEP8(pB0, pB1, pA0, pA1, pwA, vfA0, vfA1, NT - 1, false, false, false);
  { asm volatile("s_nop 15\n\ts_nop 15\n\ts_nop 7" : "+v"(pB1));
    EX4(pB1, 0); EX4(pB1, 4); EX4(pB1, 8); EX4(pB1, 12);
    CVT2(pwB[0], pB0[0], pB0[1], pB0[2], pB0[3]); CVT2(pwB[1], pB0[4], pB0[5], pB0[6], pB0[7]); CVT2(pwB[2], pB0[8], pB0[9], pB0[10], pB0[11]); CVT2(pwB[3], pB0[12], pB0[13], pB0[14], pB0[15]);
    CVT2(pwB[4], pB1[0], pB1[1], pB1[2], pB1[3]); CVT2(pwB[5], pB1[4], pB1[5], pB1[6], pB1[7]); CVT2(pwB[6], pB1[8], pB1[9], pB1[10], pB1[11]); CVT2(pwB[7], pB1[12], pB1[13], pB1[14], pB1[15]);
    vfB0 = lds_frag32x<(VAR & 512) != 0>(vp0 + sl_cur); vfB1 = lds_frag32x<(VAR & 512) != 0>(vp0 + sl_cur + 1024);
    asm volatile("s_waitcnt lgkmcnt(0)" ::: "memory"); PIN(pwB); SBAR();
    MFMA8_ACC(o[0], pwB, vfB0, sONE, sONE); MFMA8_ACC(o[1], pwB, vfB1, sONE, sONE); MFMA8_ACC(lacc, pwB, ones8, sONE, sONE);
    asm volatile("s_nop 15\n\ts_nop 15\n\ts_nop 7" : "+v"(o[0]), "+v"(o[1]), "+v"(lacc)); }
  #undef STEP8
  #undef CVT2
  #undef EX4
  #undef EXF
  #undef PIN
  #undef ROT
  if (VAR & 256) asm volatile("" :: "v"(dacc));
  float rli[16];
  #pragma unroll
  for (int r = 0; r < 16; ++r) rli[r] = __builtin_amdgcn_rcpf(lacc[r]);
  bf16* Ow = O + (long)(q0 + wid * QBLK) * OPITCH + OCOL0 + h * D;
  { bf16* stg = (bf16*)(shm + F8_LDS_OST) + wid * 2048;
    #pragma unroll
    for (int r = 0; r < 16; ++r) { const int orow = crow(r, hi);
      #pragma unroll
      for (int d0 = 0; d0 < 2; ++d0) stg[orow * 64 + d0 * 32 + r32] = __float2bfloat16(o[d0][r] * rli[r]); }
    asm volatile("s_waitcnt lgkmcnt(0)" ::: "memory");
    #pragma unroll
    for (int i = 0; i < 4; ++i) { const int row = i * 8 + (lane >> 3), ch = lane & 7; const u32x4 v = *(const u32x4*)(stg + row * 64 + ch * 8); if (!(VAR & 8)) ATTN_STORE16(Ow + (long)row * OPITCH + ch * 8, v); } }
  asm volatile("s_waitcnt vmcnt(0) lgkmcnt(0)\n\ts_barrier" ::: "memory");
  #undef DMA_T
}
#undef MFMA8_C
#undef MFMA8_ACC
#undef SBAR
#undef WAIT_BAR
}

constexpr int NWAVES = 8, NTHR = NWAVES * 64;
constexpr size_t MiB = 1u << 20;
constexpr size_t WS_CTL = 0, CTL_ZERO_BYTES = 64 * 1024;
constexpr size_t WS_MOD = 1 * MiB;
constexpr size_t WS_MISC = WS_MOD + 64 * 1024;
constexpr size_t WS_IDX = WS_MISC, WS_GATE = WS_IDX + 128 * 1024, WS_TOKSLOT = WS_GATE + 128 * 1024;
constexpr size_t WS_AFF = 3 * MiB;
constexpr size_t WS_WIN = 4 * MiB;
constexpr size_t WS_WOUT = 7 * MiB;
constexpr size_t WS_WGU = 9 * MiB;
constexpr size_t WS_WD = 137 * MiB;
constexpr size_t WS_X1 = 201 * MiB;
constexpr size_t WS_R1 = 265 * MiB;
constexpr size_t WS_XN = WS_R1;
constexpr size_t WS_Q = WS_XN + (size_t)NROWS * DM * 2;
constexpr size_t WS_K = WS_Q + (size_t)NTOK * 768 * 2;
constexpr size_t WS_V = WS_K + (size_t)NROWS * 256 * 2;
constexpr size_t WS_FT = WS_V + (size_t)NROWS * 256 * 2;
constexpr size_t WS_MIX = WS_FT + (size_t)256 * NTOK * 4;
constexpr size_t WS_HID = WS_R1;
constexpr size_t WS_R2 = 393 * MiB;
constexpr size_t WS_H2 = WS_R2;
constexpr size_t WS_YE = WS_R2;
constexpr size_t WS_END = 457 * MiB;
static_assert(WS_MIX + (size_t)NTOK * DM * 2 <= WS_R1 + 128 * MiB, "R1 map");
static_assert(WS_TOKSLOT + (size_t)NTOK * 16 * 4 <= WS_AFF, "misc map");
constexpr int CW_TMO = 0, CW_FLAG = 2, CW_KMAX = 64, CW_BAR = 1024;

constexpr int LDS_BYTES = 163840;
constexpr int RING_BYTES = 131072, XTRA_OFF = RING_BYTES;
constexpr int MISC_OFF = LDS_BYTES - 512;

#define GAS __attribute__((address_space(1)))
#define LAS __attribute__((address_space(3)))
typedef unsigned short bf16;
typedef unsigned v4u __attribute__((ext_vector_type(4)));
typedef unsigned v2u __attribute__((ext_vector_type(2)));
typedef float f32x4 __attribute__((ext_vector_type(4)));
typedef float f32x2 __attribute__((ext_vector_type(2)));
typedef GAS unsigned gu32;
#define RLX_AGENT __ATOMIC_RELAXED, __HIP_MEMORY_SCOPE_AGENT
#define LDS_WAIT() asm volatile("s_waitcnt lgkmcnt(0)" ::: "memory")
#define VM_WAIT() asm volatile("s_waitcnt vmcnt(0)" ::: "memory")
__device__ __forceinline__ unsigned f2bf(float f) { unsigned u = __builtin_bit_cast(unsigned, f); return (u + 0x7fffu + ((u >> 16) & 1u)) >> 16; }
__device__ __forceinline__ unsigned pk2(float lo, float hi) { return f2bf(lo) | (f2bf(hi) << 16); }
__device__ __forceinline__ unsigned pk4_fp8(float a, float b, float c, float d) { int p = __builtin_amdgcn_cvt_pk_fp8_f32(a, b, 0, false); p = __builtin_amdgcn_cvt_pk_fp8_f32(c, d, p, true); return (unsigned)p; }
__device__ __forceinline__ float bf2f(unsigned short b) { return __builtin_bit_cast(float, (unsigned)b << 16); }

#define XB_TMO      128
#define XB_XCNT(j)  (256  + 64 * (j))
#define XB_XSUB(j)  (1280 + 64 * (j))
#define XB_XGEN(j)  (2304 + 64 * (j))
#define XB_TOP      3328
#define XB_TOPGEN   3392
#define XCD_BAR_WORDS 3456
#define XB_SPIN_CAP (1u << 20)
static_assert((CW_BAR + XCD_BAR_WORDS) * 4 <= (int)CTL_ZERO_BYTES, "ctl");
__device__ __forceinline__ unsigned xb_ld(unsigned* p)              { return __hip_atomic_load(p, __ATOMIC_RELAXED, __HIP_MEMORY_SCOPE_AGENT); }
__device__ __forceinline__ unsigned xb_add(unsigned* p, unsigned v) { return __hip_atomic_fetch_add(p, v, __ATOMIC_RELAXED, __HIP_MEMORY_SCOPE_AGENT); }
__device__ __forceinline__ unsigned xb_xcc_id() { return (unsigned)__builtin_amdgcn_s_getreg((3 << 11) | 20) & 0xFu; }
#define XB_SPIN(cond, bar) do { unsigned _sp = 0; while (cond) { __builtin_amdgcn_s_sleep(1); \
    if ((++_sp & 255u) == 0u) { if (xb_ld(&(bar)[XB_TMO])) break; if (_sp > XB_SPIN_CAP) { atomicAdd(&(bar)[XB_TMO], 1u); break; } } } } while (0)
struct XcdBarrier { unsigned* bar; unsigned x; volatile LAS unsigned* st; };
__device__ __forceinline__ XcdBarrier xcd_barrier_post(unsigned* bar, volatile LAS unsigned* st, bool leader) {
    XcdBarrier b; b.bar = bar; b.x = xb_xcc_id(); b.st = st;
    if (leader) (void)xb_add(&bar[XB_XCNT(b.x)], 1u);
    return b;
}
__device__ __forceinline__ void xcd_barrier_complete(unsigned* bar, unsigned x, unsigned& nloc, unsigned& nx) {
    const unsigned G = gridDim.x * gridDim.y * gridDim.z;
    unsigned sum, cnt, mine, sp = 0u;
    for (;;) {
        sum = 0u; cnt = 0u; mine = 0u;
#pragma unroll
        for (unsigned j = 0; j < 16; ++j) { const unsigned c = xb_ld(&bar[XB_XCNT(j)]); sum += c; cnt += (c > 0u) ? 1u : 0u; mine = (j == x) ? c : mine; }
        if (sum == G) break;
        __builtin_amdgcn_s_sleep(1);
        if ((++sp & 255u) == 0u) { if (xb_ld(&bar[XB_TMO])) break; if (sp > XB_SPIN_CAP) { atomicAdd(&bar[XB_TMO], 1u); break; } }
    }
    nloc = mine > 0u ? mine : 1u; nx = cnt > 0u ? cnt : 1u;
}
__device__ __forceinline__ void xcd_barrier(const XcdBarrier& b, int wave) {
    asm volatile("s_waitcnt vmcnt(0)" ::: "memory");
    __syncthreads();
    if (wave == 0 && fresh_lane() == 0) {
        unsigned* bar = b.bar;
        __builtin_amdgcn_s_waitcnt(0);
        unsigned nloc = b.st[0], nx = b.st[1];
        if (nloc == 0u) { xcd_barrier_complete(bar, b.x, nloc, nx); b.st[0] = nloc; b.st[1] = nx; }
        const unsigned old = xb_add(&bar[XB_XSUB(b.x)], 1u);
        const unsigned gen = old / nloc;
        if (old + 1u == (gen + 1u) * nloc) {
            __builtin_amdgcn_fence(__ATOMIC_RELEASE, "agent");
            asm volatile("s_waitcnt vmcnt(0)" ::: "memory");
            const unsigned og = xb_add(&bar[XB_TOP], 1u);
            const unsigned tg = og / nx;
            if (og + 1u == (tg + 1u) * nx) xb_add(&bar[XB_TOPGEN], 1u);
            else XB_SPIN(xb_ld(&bar[XB_TOPGEN]) == tg, bar);
            __builtin_amdgcn_fence(__ATOMIC_ACQUIRE, "agent");
            xb_add(&bar[XB_XGEN(b.x)], 1u);
            asm volatile("s_waitcnt vmcnt(0)" ::: "memory");
        } else {
            XB_SPIN(xb_ld(&bar[XB_XGEN(b.x)]) == gen, bar);
            __builtin_amdgcn_fence(__ATOMIC_ACQUIRE, "agent");
            asm volatile("s_waitcnt vmcnt(0)" ::: "memory");
        }
    }
    __syncthreads();
}

struct Args {
    const float *x, *c, *ctx, *c_ctx, *w_mod, *b_mod, *norm_mix_g, *norm_ffn_g, *w_in, *w_four, *q_norm_g, *k_norm_g, *w_out, *w_router, *w_gate, *w_up, *w_down, *final_norm_g;
    float* out; unsigned char* ws;
};

__device__ __forceinline__ float wave_sum(float v) {
#pragma unroll
    for (int o = 1; o < 64; o <<= 1) v += __shfl_xor(v, o);
    return v;
}

template <class RowMap>
__device__ __forceinline__ void tr_item(const float* __restrict__ W, int ldw, int k0, int n0, bf16* WT, int ldt, int kdst0, const RowMap& drow, LAS float* scr, int lane) {
    const int kq = lane >> 4, nq = lane & 15;
    f32x4 v[16];
#pragma unroll
    for (int it = 0; it < 16; ++it) v[it] = *(const f32x4*)(W + (size_t)(k0 + 4 * it + kq) * ldw + n0 + 4 * nq);
#pragma unroll
    for (int it = 0; it < 16; ++it) { LAS float* s = scr + (4 * it + kq) * 65 + 4 * nq; s[0] = v[it][0]; s[1] = v[it][1]; s[2] = v[it][2]; s[3] = v[it][3]; }
    LDS_WAIT(); asm volatile("" ::: "memory");
    const int c = lane >> 3, nn = lane & 7;
#pragma unroll
    for (int j = 0; j < 8; ++j) { const int n = nn + 8 * j; const LAS float* s = scr + (8 * c) * 65 + n;
        v4u o; o.x = pk2(s[0 * 65], s[1 * 65]); o.y = pk2(s[2 * 65], s[3 * 65]); o.z = pk2(s[4 * 65], s[5 * 65]); o.w = pk2(s[6 * 65], s[7 * 65]);
        *(GAS v4u*)(WT + (size_t)drow(n0 + n) * ldt + kdst0 + k0 + 8 * c) = o; }
    LDS_WAIT(); asm volatile("" ::: "memory");
}
struct RowId { int base; __device__ __forceinline__ int operator()(int n) const { return base + n; } };
struct RowQKV { __device__ __forceinline__ int operator()(int n) const { const int t = n >> 8, w = n & 255, hd = w >> 6, d = w & 63; return 256 + 256 * t + 128 * (d >> 5) + 32 * hd + (d & 31); } };
struct RowGU { int base, up; __device__ __forceinline__ int operator()(int f) const { return base + 256 * (f >> 7) + 128 * up + (f & 127); } };


constexpr int MOE_ITEMS = 3 * 8192;
struct TrDesc { const float* src; bf16* dst; int ldw, ldt, f8; };
__device__ __forceinline__ TrDesc moe_desc(const Args& a, int r) {
    TrDesc d;
    if (r < 16384) { const int up = r >> 13, rr = r & 8191, e = rr >> 9, q = rr & 511, kb = q >> 5, nb = q & 31;
        d.src = (up ? a.w_up : a.w_gate) + (size_t)e * DM * DE + (size_t)(kb * 64) * DE + nb * 64; d.ldw = DE;
        d.dst = (bf16*)((unsigned char*)(a.ws + WS_WGU) + ((size_t)e * 4096 + 256 * (nb >> 1) + 128 * up + 64 * (nb & 1)) * DM + kb * 64); d.ldt = DM; d.f8 = 1; }
    else { const int rr = r - 16384, e = rr >> 9, q = rr & 511, kb = q >> 4, nb = q & 15;
        d.src = a.w_down + (size_t)e * DE * DM + (size_t)(kb * 64) * DM + nb * 64; d.ldw = DM;
        d.dst = (bf16*)((unsigned char*)(a.ws + WS_WD) + ((size_t)e * DM + nb * 64) * DE + kb * 64); d.ldt = DE; d.f8 = 1; }
    return d;
}
#define TR_LOAD(v, d) do { _Pragma("unroll") for (int _it = 0; _it < 16; ++_it) v[_it] = *(const f32x4*)((d).src + (size_t)(4 * _it + kq) * (d).ldw + 4 * nq); } while (0)
#define TR_PROC(v, d) do { \
    _Pragma("unroll") for (int _it = 0; _it < 16; ++_it) { LAS float* s_ = scr + (4 * _it + kq) * 65 + 4 * nq; s_[0] = v[_it][0]; s_[1] = v[_it][1]; s_[2] = v[_it][2]; s_[3] = v[_it][3]; } \
    LDS_WAIT(); asm volatile("" ::: "memory"); \
    if ((d).f8) { _Pragma("unroll") for (int _j = 0; _j < 8; ++_j) { const int n_ = nn + 8 * _j; const LAS float* s_ = scr + (8 * c8) * 65 + n_; \
        v2u o_; o_.x = pk4_fp8(s_[0 * 65] * 32.f, s_[1 * 65] * 32.f, s_[2 * 65] * 32.f, s_[3 * 65] * 32.f); o_.y = pk4_fp8(s_[4 * 65] * 32.f, s_[5 * 65] * 32.f, s_[6 * 65] * 32.f, s_[7 * 65] * 32.f); \
        *(GAS v2u*)((unsigned char*)(d).dst + (size_t)n_ * (d).ldt + 8 * c8) = o_; } } \
    else { _Pragma("unroll") for (int _j = 0; _j < 8; ++_j) { const int n_ = nn + 8 * _j; const LAS float* s_ = scr + (8 * c8) * 65 + n_; \
        v4u o_; o_.x = pk2(s_[0 * 65], s_[1 * 65]); o_.y = pk2(s_[2 * 65], s_[3 * 65]); o_.z = pk2(s_[4 * 65], s_[5 * 65]); o_.w = pk2(s_[6 * 65], s_[7 * 65]); \
        *(GAS v4u*)((d).dst + (size_t)n_ * (d).ldt + 8 * c8) = o_; } } \
    LDS_WAIT(); asm volatile("" ::: "memory"); } while (0)
__device__ __forceinline__ void moe_convert(const Args& a, LAS float* scr, int lo, int hi, int w, int nw) {
    const int lane = fresh_lane(), kq = lane >> 4, nq = lane & 15, c8 = lane >> 3, nn = lane & 7;
    int it = lo + w; if (it >= hi) return;
    f32x4 va[16], vb[16];
    TrDesc da = moe_desc(a, it), db = da; TR_LOAD(va, da);
    for (;;) {
        int nx = it + nw; bool hn = nx < hi;
        if (hn) { db = moe_desc(a, nx); TR_LOAD(vb, db); }
        TR_PROC(va, da);
        if (!hn) break;
        it = nx; nx = it + nw; hn = nx < hi;
        if (hn) { da = moe_desc(a, nx); TR_LOAD(va, da); }
        TR_PROC(vb, db);
        if (!hn) break;
        it = nx;
    }
}
#ifndef MOE_S0
#define MOE_S0 0
#endif
#ifndef MOE_S1
#define MOE_S1 4096
#endif
#ifndef MOE_S2
#define MOE_S2 0
#endif
#ifndef MOE_S3
#define MOE_S3 9472
#endif
constexpr int MOE_B0 = MOE_S0, MOE_B1 = MOE_B0 + MOE_S1, MOE_B2 = MOE_B1 + MOE_S2, MOE_B3 = MOE_B2 + MOE_S3;

__host__ __device__ __forceinline__ int four_pos(int mp) { return mp == 0 ? 0 : (mp == 32 ? 1 : (mp < 32 ? 2 * mp : 2 * (64 - mp) + 1)); }

__device__ __forceinline__ void p0_prologue(const Args& a, LAS unsigned char* lds, int vcu, int G, int wave) {
    const int lane = fresh_lane(), tid = wave * 64 + lane;
    unsigned char* ws = a.ws;
    bf16* WinT = (bf16*)(ws + WS_WIN); bf16* WoT = (bf16*)(ws + WS_WOUT);
    float* MOD = (float*)(ws + WS_MOD);
    for (int item = vcu; item < 256; item += G) {
        LAS float* red = (LAS float*)lds;
        f32x4 a0 = {0.f, 0.f, 0.f, 0.f}, a1 = {0.f, 0.f, 0.f, 0.f};
        if (lane < 60) {
            const int rr = lane / 6, cq = lane % 6, col = item * 24 + 4 * cq;
#pragma unroll
            for (int it = 0; it < 13; ++it) { const int k = wave * 128 + it * 10 + rr;
                if (it * 10 + rr < 128) { const f32x4 w = *(const f32x4*)(a.w_mod + (size_t)k * (NMOD * DM) + col); const float c0 = a.c[k], c1 = a.c_ctx[k];
                    const float s0 = c0 / (1.f + __expf(-c0)), s1 = c1 / (1.f + __expf(-c1)); a0 += w * s0; a1 += w * s1; } }
        }
        *(LAS f32x4*)(red + ((wave * 2 + 0) * 64 + lane) * 4) = a0; *(LAS f32x4*)(red + ((wave * 2 + 1) * 64 + lane) * 4) = a1;
        __syncthreads();
        if (tid < 48) { const int v = tid / 24, cc = tid % 24, cq = cc >> 2, e = cc & 3; float sum = 0.f;
            for (int w = 0; w < 8; ++w)
#pragma unroll
                for (int r = 0; r < 10; ++r) sum += red[((w * 2 + v) * 64 + r * 6 + cq) * 4 + e];
            MOD[v * (NMOD * DM) + item * 24 + cc] = sum + a.b_mod[item * 24 + cc]; }
        __syncthreads();
    }
    const int cg = -1;
    LAS float* scr = (LAS float*)(lds + wave * 16640);
    constexpr int I_F1 = 256, I_F2 = 256, I_IN = 16 * 20, I_OUT = 12 * 16;
    constexpr int NITEMS = I_F1 + I_F2 + I_IN + I_OUT;
    for (int it = wave * G + vcu; it < NITEMS; it += NWAVES * G) {
        int r = it;
        if (r < I_F1) {
            const int g = r & 3, kb = (r >> 2) & 15, jq = r >> 6, k = kb * 64 + lane;
            LAS float* ct = scr;
            ct[lane] = cospif((float)lane * (1.f / 32.f)); LDS_WAIT(); asm volatile("" ::: "memory");
            float w[64];
#pragma unroll
            for (int c4 = 0; c4 < 16; ++c4) { const f32x4 t = *(const f32x4*)(a.w_in + (size_t)k * INW + 64 * g + 4 * c4); w[4 * c4] = t[0]; w[4 * c4 + 1] = t[1]; w[4 * c4 + 2] = t[2]; w[4 * c4 + 3] = t[3]; }
            for (int j = 16 * jq; j < 16 * jq + 16; ++j) { const int m = j <= 32 ? j : j - 32; const int ph = j <= 32 ? 0 : 48;
                float s = 0.f;
#pragma unroll
                for (int c = 0; c < 64; ++c) s += w[c] * ct[(c * m + ph) & 63];
                WinT[(size_t)(64 * g + j) * DM + k] = (bf16)f2bf(s * (1.f / 1024.f)); }
            LDS_WAIT(); asm volatile("" ::: "memory");
            continue; }
        r -= I_F1;
        if (r < I_F2) {
            const int g = r & 3, jb = (r >> 2) & 15, mq = r >> 6, j = jb * 64 + lane;
            float w[64];
#pragma unroll
            for (int d = 0; d < 64; ++d) w[d] = a.w_out[(size_t)(64 * g + d) * DM + j];
            for (int mp = 16 * mq; mp < 16 * mq + 16; ++mp) { float s = 0.f; const float* wf = a.w_four + (size_t)(g * 64 + mp) * 64;
#pragma unroll
                for (int d = 0; d < 64; ++d) s += wf[d] * w[d];
                WoT[(size_t)j * DM + 64 * g + four_pos(mp)] = (bf16)f2bf(s); }
            continue; }
        r -= I_F2;
        if (r < I_IN) { const int kb = r / 20, nb = r % 20; tr_item(a.w_in + 256, INW, kb * 64, nb * 64, WinT, DM, 0, RowQKV{}, scr, lane); continue; }
        r -= I_IN;
        { const int kb = r / 16, nb = r % 16; tr_item(a.w_out + (size_t)256 * DM, DM, kb * 64, nb * 64, WoT, DM, 256, RowId{0}, scr, lane); }
    }
    if (cg < 0 && MOE_S0 > 0) moe_convert(a, scr, 0, MOE_B0, ((wave + 4) & 7) * (G - 24) + vcu, NWAVES * (G - 24));
}

__device__ __forceinline__ void p0b_modulate(const Args& a, int vcu, int G, int wave) {
    const int lane = fresh_lane();
    unsigned char* ws = a.ws; const float* MOD = (const float*)(ws + WS_MOD); bf16* XN = (bf16*)(ws + WS_XN);
    const int gw = vcu * NWAVES + wave, NGW = G * NWAVES;
    for (int pass = 0; pass < 2; ++pass) {
        const float* md = MOD + pass * (NMOD * DM);
        const int nrows = pass == 0 ? NTOK : NCTX; const float* src = pass == 0 ? a.x : a.ctx; bf16* dst = XN + (size_t)(pass == 0 ? 0 : NTOK) * DM;
        if (gw >= nrows) continue;
        f32x4 av[4], sh[4];
#pragma unroll
        for (int j = 0; j < 4; ++j) { const int col = 4 * lane + 256 * j; const f32x4 g = *(const f32x4*)(a.norm_mix_g + col); const f32x4 sc = *(const f32x4*)(md + DM + col); av[j] = g * (sc + 1.f); sh[j] = *(const f32x4*)(md + col); }
        f32x4 v[4], vn[4];
        { const GAS f32x4* xr = (const GAS f32x4*)(src + (size_t)gw * DM) + lane;
#pragma unroll
          for (int j = 0; j < 4; ++j) v[j] = xr[64 * j]; }
        for (int m = gw; m < nrows; m += NGW) {
            const int mn = m + NGW;
            if (mn < nrows) { const GAS f32x4* xr = (const GAS f32x4*)(src + (size_t)mn * DM) + lane;
#pragma unroll
                for (int j = 0; j < 4; ++j) vn[j] = xr[64 * j]; }
            float s = 0.f;
#pragma unroll
            for (int j = 0; j < 4; ++j) s += (v[j].x * v[j].x + v[j].y * v[j].y) + (v[j].z * v[j].z + v[j].w * v[j].w);
            const float rinv = 1.f / sqrtf(wave_sum(s) * (1.f / DM) + EPS);
            GAS unsigned long long* o8 = (GAS unsigned long long*)(dst + (size_t)m * DM) + lane;
#pragma unroll
            for (int j = 0; j < 4; ++j) { const f32x4 y = v[j] * rinv * av[j] + sh[j]; o8[64 * j] = (unsigned long long)pk2(y.x, y.y) | ((unsigned long long)pk2(y.z, y.w) << 32); }
#pragma unroll
            for (int j = 0; j < 4; ++j) v[j] = vn[j];
        }
    }
}

struct P1Prob {
    static constexpr int K = DM; static constexpr bool PERM = false, FP8 = false; static constexpr int SCW = 0, SCA = 0;
    const bf16* XN; const bf16* WinT; bf16 *Q, *Kb, *Vb; float* FT; const float *qg, *kg; unsigned* kmax; pg8::StaticOrder so;
    __device__ __forceinline__ bool next(int i, pg8::Unit& u) const { return so.next(i, u); }
    __device__ __forceinline__ bool swapped(const pg8::Unit& u) const { return u.pn == 0 || (ATTN_F8 && u.pn == 5); }
    __device__ __forceinline__ const char* aptr(const pg8::Unit& u) const { return swapped(u) ? (const char*)(WinT + (size_t)u.pn * 256 * DM) : (const char*)(XN + (size_t)u.pm * 256 * DM); }
    __device__ __forceinline__ const char* bptr(const pg8::Unit& u) const { return swapped(u) ? (const char*)(XN + (size_t)u.pm * 256 * DM) : (const char*)(WinT + (size_t)u.pn * 256 * DM); }
    __device__ __forceinline__ void epi(const pg8::f32x4 (&acc)[2][2][4][2], const pg8::Unit& u, int wr, int wc, int fr, int fq) const {
        if (u.pn == 0) {
            if (u.pm >= NTOK / 256) return;
#pragma unroll
            for (int ai = 0; ai < 2; ++ai)
#pragma unroll
                for (int m = 0; m < 4; ++m) { float* rowp = FT + (size_t)(ai * 128 + wr * 64 + m * 16 + fr) * NTOK + u.pm * 256 + wc * 32 + 4 * fq;
#pragma unroll
                    for (int bj = 0; bj < 2; ++bj)
#pragma unroll
                        for (int n = 0; n < 2; ++n) *(pg8::f32x4*)(rowp + bj * 128 + n * 16) = acc[ai][bj][m][n]; }
            return;
        }
        const bool isq = u.pn <= 3, isv = u.pn == 5, lat = u.pm < NTOK / 256;
        if (isq && !lat) return;
        if (isv) {
#if ATTN_F8
            unsigned char* V8 = (unsigned char*)Vb;
#pragma unroll
            for (int ai = 0; ai < 2; ++ai)
#pragma unroll
                for (int m = 0; m < 4; ++m) { const int kvh_ = 2 * wr + (m >> 1), d = 32 * ai + 16 * (m & 1) + fr;
#pragma unroll
                    for (int bj = 0; bj < 2; ++bj)
#pragma unroll
                        for (int n = 0; n < 2; ++n) { const int t0 = u.pm * 256 + 128 * bj + 32 * wc + 16 * n + 4 * fq, key0 = t0 & 63, tile = t0 >> 6, k5 = key0 & 31, hk = (k5 >> 2) & 1, j0 = 4 * (k5 >> 3) + 16 * (key0 >> 5);
                            const pg8::f32x4 v = acc[ai][bj][m][n];
                            *(unsigned*)(V8 + (size_t)(kvh_ * (NKEYS / 64) + tile) * 4096 + (j0 >> 4) * 2048 + d * 32 + 16 * (hk ^ ((d >> 3) & 1)) + (j0 & 15)) = pk4_fp8(v[0], v[1], v[2], v[3]); } }
#else
#pragma unroll
            for (int ai = 0; ai < 2; ++ai)
#pragma unroll
                for (int m = 0; m < 4; ++m) { const int t = u.pm * 256 + ai * 128 + wr * 64 + m * 16 + fr; bf16* rowp = Vb + (size_t)t * 256 + wc * 64 + 4 * fq;
#pragma unroll
                    for (int bj = 0; bj < 2; ++bj)
#pragma unroll
                        for (int n = 0; n < 2; ++n) { const pg8::f32x4 v = acc[ai][bj][m][n]; *(v2u*)(rowp + 32 * bj + 16 * n) = (v2u){pk2(v[0], v[1]), pk2(v[2], v[3])}; } }
#endif
            return;
        }
        const float* gw = isq ? qg : kg;
        pg8::f32x4 gv[2][2];
#pragma unroll
        for (int bj = 0; bj < 2; ++bj)
#pragma unroll
            for (int n = 0; n < 2; ++n) gv[bj][n] = *(const pg8::f32x4*)(gw + 32 * bj + 16 * n + 4 * fq);
        float frq[4];
#pragma unroll
        for (int e = 0; e < 4; ++e) frq[e] = exp2f(-(float)(4 * fq + e) * (13.287712379549449f / 16.f)) * 0.15915494309189535f;
        const float qs = isq ? attn_body::C2 * (ATTN_F8 ? 16.f : 1.f) : 1.f;
#if ATTN_F8
        bf16* base = (bf16*)((unsigned char*)(isq ? Q : Kb) + (size_t)(isq ? (u.pn - 1) * 4 + wc : wc) * 64); const int pitch = isq ? 768 : 256;
#else
        bf16* base = isq ? Q + (size_t)((u.pn - 1) * 4 + wc) * 64 : Kb + (size_t)wc * 64; const int pitch = isq ? 768 : 256;
#endif
        float k2max = 0.f;
#pragma unroll
        for (int ai = 0; ai < 2; ++ai) {
            float rowpos = (float)(u.pm * 4 + ai * 2 + wr); asm volatile("" : "+v"(rowpos));
            float cr[4], sr[4];
#pragma unroll
            for (int e = 0; e < 4; ++e) { const float rev = rowpos * frq[e], f_ = rev - floorf(rev); cr[e] = __builtin_amdgcn_cosf(f_); sr[e] = __builtin_amdgcn_sinf(f_); }
#pragma unroll
            for (int m = 0; m < 4; ++m) {
                float colpos = (float)(m * 16 + fr); asm volatile("" : "+v"(colpos));
                const int t = u.pm * 256 + ai * 128 + wr * 64 + m * 16 + fr;
                float ss = 0.f;
#pragma unroll
                for (int bj = 0; bj < 2; ++bj)
#pragma unroll
                    for (int n = 0; n < 2; ++n) { const pg8::f32x4 v = acc[ai][bj][m][n]; ss += (v[0] * v[0] + v[1] * v[1]) + (v[2] * v[2] + v[3] * v[3]); }
                ss += __shfl_xor(ss, 16); ss += __shfl_xor(ss, 32);
                const float rinv = qs / sqrtf(ss * (1.f / 64.f) + EPS);
                pg8::f32x4 y[2][2];
#pragma unroll
                for (int bj = 0; bj < 2; ++bj)
#pragma unroll
                    for (int n = 0; n < 2; ++n) y[bj][n] = acc[ai][bj][m][n] * rinv * gv[bj][n];
                if (lat) {
#pragma unroll
                    for (int e = 0; e < 4; ++e) {
                        { const float x1 = y[0][0][e], x2 = y[0][1][e]; y[0][0][e] = x1 * cr[e] - x2 * sr[e]; y[0][1][e] = x1 * sr[e] + x2 * cr[e]; }
                        { const float rev = colpos * frq[e], f_ = rev - floorf(rev); const float cc = __builtin_amdgcn_cosf(f_), sc = __builtin_amdgcn_sinf(f_);
                          const float x1 = y[1][0][e], x2 = y[1][1][e]; y[1][0][e] = x1 * cc - x2 * sc; y[1][1][e] = x1 * sc + x2 * cc; }
                    }
                }
                ss = 0.f;
#if ATTN_F8
                unsigned char* rowp8 = (unsigned char*)base + ((size_t)t * pitch + 4 * fq);
#pragma unroll
                for (int bj = 0; bj < 2; ++bj)
#pragma unroll
                    for (int n = 0; n < 2; ++n) { const pg8::f32x4 v = y[bj][n]; const unsigned w = pk4_fp8(v[0], v[1], v[2], v[3]); *(unsigned*)(rowp8 + 32 * bj + 16 * n) = w;
                        if (!isq) { const float b0 = __builtin_amdgcn_cvt_f32_fp8((int)w, 0), b1 = __builtin_amdgcn_cvt_f32_fp8((int)w, 1), b2 = __builtin_amdgcn_cvt_f32_fp8((int)w, 2), b3 = __builtin_amdgcn_cvt_f32_fp8((int)w, 3); ss += (b0 * b0 + b1 * b1) + (b2 * b2 + b3 * b3); } }
#else
                bf16* rowp = base + (size_t)t * pitch + 4 * fq;
#pragma unroll
                for (int bj = 0; bj < 2; ++bj)
#pragma unroll
                    for (int n = 0; n < 2; ++n) { const pg8::f32x4 v = y[bj][n]; const v2u w = (v2u){pk2(v[0], v[1]), pk2(v[2], v[3])}; *(v2u*)(rowp + 32 * bj + 16 * n) = w;
                        if (!isq) { const float b0 = __uint_as_float(w.x << 16), b1 = __uint_as_float(w.x & 0xffff0000u), b2 = __uint_as_float(w.y << 16), b3 = __uint_as_float(w.y & 0xffff0000u); ss += (b0 * b0 + b1 * b1) + (b2 * b2 + b3 * b3); } }
#endif
                if (!isq) { float r2 = ss; r2 += __shfl_xor(r2, 16); r2 += __shfl_xor(r2, 32); k2max = fmaxf(k2max, r2); }
                asm volatile("" ::: "memory");
            }
        }
        if (!isq) {
#pragma unroll
            for (int o = 1; o < 16; o <<= 1) k2max = fmaxf(k2max, __shfl_xor(k2max, o));
            if (fr == 0 && fq == 0) __hip_atomic_fetch_max(kmax, __float_as_uint(k2max), __ATOMIC_RELAXED, __HIP_MEMORY_SCOPE_AGENT);
        }
    }
};

__device__ __forceinline__ unsigned rev4_12(unsigned k) { unsigned r = __brev(k) >> 20; return ((r & 0xAAAu) >> 1) | ((r & 0x555u) << 1); }
__device__ __forceinline__ void fft_block(const Args& a, LAS unsigned char* lds, int item, int wave) {
    const int tid = wave * 64 + fresh_lane();
    const int mm = item & 31, par = (item >> 5) & 1, g = item >> 6;
    const float* FT = (const float*)(a.ws + WS_FT); bf16* MIX = (bf16*)(a.ws + WS_MIX);
    LAS f32x2* X = (LAS f32x2*)lds;
    const float* re = FT + (size_t)(64 * g + mm) * NTOK; const float* im = FT + (size_t)(64 * g + 32 + mm) * NTOK;
#pragma unroll 1
    for (int i = 0; i < 2; ++i) {
        const int j0 = 4 * (tid + NTHR * i);
        f32x4 r4[4], i4[4];
#pragma unroll
        for (int q = 0; q < 4; ++q) { r4[q] = *(const f32x4*)(re + j0 + 4096 * q); i4[q] = *(const f32x4*)(im + j0 + 4096 * q); }
#pragma unroll
        for (int e = 0; e < 4; ++e) {
            const int j = j0 + e;
            const f32x2 a0 = {r4[0][e], i4[0][e]}, a1 = {r4[1][e], i4[1][e]}, a2 = {r4[2][e], i4[2][e]}, a3 = {r4[3][e], i4[3][e]};
            f32x2 ya, yb; float fa, fb;
            if (par == 0) { const f32x2 s02 = a0 + a2, s13 = a1 + a3; ya = s02 + s13; yb = s02 - s13; fa = 0.f; fb = (float)(2 * j) * (1.f / 16384.f); }
            else { const f32x2 d02 = a0 - a2, d13 = a1 - a3; ya = (f32x2){d02.x + d13.y, d02.y - d13.x}; yb = (f32x2){d02.x - d13.y, d02.y + d13.x}; fa = (float)j * (1.f / 16384.f); fb = (float)(3 * j) * (1.f / 16384.f); }
            const float ca = __builtin_amdgcn_cosf(fa), sa = __builtin_amdgcn_sinf(fa), cb = __builtin_amdgcn_cosf(fb), sb = __builtin_amdgcn_sinf(fb);
            X[j] = (f32x2){ya.x * ca + ya.y * sa, ya.y * ca - ya.x * sa};
            X[4096 + j] = (f32x2){yb.x * cb + yb.y * sb, yb.y * cb - yb.x * sb};
        }
    }
    __syncthreads();
#pragma unroll 1
    for (int s = 0; s < 6; ++s) {
        const int lq = 10 - 2 * s;
        const int Lq = 1 << lq;
        const float invL = 1.f / (float)(4 << lq);
#pragma unroll 2
        for (int i = 0; i < 4; ++i) {
            const int b = tid + NTHR * i, j = b & (Lq - 1), base = ((b >> lq) << (lq + 2)) + j;
            const f32x2 a0 = X[base], a1 = X[base + Lq], a2 = X[base + 2 * Lq], a3 = X[base + 3 * Lq];
            const f32x2 s02 = a0 + a2, d02 = a0 - a2, s13 = a1 + a3, d13 = a1 - a3;
            const f32x2 y0 = s02 + s13, y2 = s02 - s13;
            const f32x2 y1 = (f32x2){d02.x + d13.y, d02.y - d13.x};
            const f32x2 y3 = (f32x2){d02.x - d13.y, d02.y + d13.x};
            const float f1 = (float)j * invL;
            const float c1 = __builtin_amdgcn_cosf(f1), s1 = __builtin_amdgcn_sinf(f1);
            const float c2 = __builtin_amdgcn_cosf(2.f * f1), s2 = __builtin_amdgcn_sinf(2.f * f1);
            const float c3 = __builtin_amdgcn_cosf(3.f * f1), s3 = __builtin_amdgcn_sinf(3.f * f1);
            X[base] = y0;
            X[base + Lq] = (f32x2){y1.x * c1 + y1.y * s1, y1.y * c1 - y1.x * s1};
            X[base + 2 * Lq] = (f32x2){y2.x * c2 + y2.y * s2, y2.y * c2 - y2.x * s2};
            X[base + 3 * Lq] = (f32x2){y3.x * c3 + y3.y * s3, y3.y * c3 - y3.x * s3};
        }
        __syncthreads();
    }
    const int col = 64 * g + 2 * mm;
#pragma unroll 1
    for (int i = 0; i < 16; ++i) {
        const int k = 2 * (tid + NTHR * i) + par, kn = (NTOK - k) & (NTOK - 1);
        const f32x2 wk = X[(((k & 3) - par) >> 1) * 4096 + rev4_12((unsigned)(k >> 2))], wn = X[(((kn & 3) - par) >> 1) * 4096 + rev4_12((unsigned)(kn >> 2))];
        float o0, o1;
        if (mm == 0) { o0 = 0.5f * (wk.x + wn.x); o1 = 0.5f * (wk.y + wn.y); }
        else { o0 = wn.x; o1 = wk.x; }
        *(unsigned*)(MIX + (size_t)k * DM + col) = pk2(o0, o1);
    }
    __syncthreads();
}

struct P3Prob {
    static constexpr int K = DM; static constexpr bool PERM = false, FP8 = false; static constexpr int SCW = 0, SCA = 0;
    const bf16* MIX; const bf16* WoT; const float* x; const float* g1; float* X1; pg8::StaticOrder so;
    __device__ __forceinline__ bool next(int i, pg8::Unit& u) const { return so.next(i, u); }
    __device__ __forceinline__ const char* aptr(const pg8::Unit& u) const { return (const char*)(MIX + (size_t)u.pm * 256 * DM); }
    __device__ __forceinline__ const char* bptr(const pg8::Unit& u) const { return (const char*)(WoT + (size_t)u.pn * 256 * DM); }
    __device__ __forceinline__ void epi(const pg8::f32x4 (&acc)[2][2][4][2], const pg8::Unit& u, int wr, int wc, int fr, int fq) const {
        const int col0 = u.pn * 256 + wc * 32 + 4 * fq;
        pg8::f32x4 gv[2][2];
#pragma unroll
        for (int bj = 0; bj < 2; ++bj)
#pragma unroll
            for (int n = 0; n < 2; ++n) gv[bj][n] = *(const pg8::f32x4*)(g1 + col0 + bj * 128 + n * 16);
#pragma unroll
        for (int ai = 0; ai < 2; ++ai)
#pragma unroll
            for (int m = 0; m < 4; ++m) { const size_t off = (size_t)(u.pm * 256 + ai * 128 + wr * 64 + m * 16 + fr) * DM + col0;
#pragma unroll
                for (int bj = 0; bj < 2; ++bj)
#pragma unroll
                    for (int n = 0; n < 2; ++n) { const pg8::f32x4 bs = *(const pg8::f32x4*)(x + off + bj * 128 + n * 16); *(pg8::f32x4*)(X1 + off + bj * 128 + n * 16) = bs + gv[bj][n] * acc[ai][bj][m][n]; }
                if (m & 1) asm volatile("" ::: "memory"); }
    }
};

__device__ __forceinline__ void p3b_router(const Args& a, LAS unsigned char* lds, int vcu, int G, int wave) {
    const int lane = fresh_lane(), tid = wave * 64 + lane;
    unsigned char* ws = a.ws; const float* MOD = (const float*)(ws + WS_MOD); const float* X1 = (const float*)(ws + WS_X1); bf16* H2 = (bf16*)(ws + WS_H2); float* AFF = (float*)(ws + WS_AFF);
    LAS float* wrt = (LAS float*)lds;
    { f32x4 t[8];
#pragma unroll
      for (int q = 0; q < 8; ++q) t[q] = *(const f32x4*)(a.w_router + 4 * (tid + NTHR * q));
#pragma unroll
      for (int q = 0; q < 8; ++q) { const int i = 4 * (tid + NTHR * q), col = i >> 4, e = i & 15;
#pragma unroll
          for (int k = 0; k < 4; ++k) wrt[(e + k) * 1024 + col] = t[q][k]; } }
    __syncthreads();
    f32x4 av[4], sh[4];
#pragma unroll
    for (int j = 0; j < 4; ++j) { const int col = 4 * lane + 256 * j; const f32x4 g = *(const f32x4*)(a.norm_ffn_g + col); const f32x4 sc = *(const f32x4*)(MOD + 4 * DM + col); av[j] = g * (sc + 1.f); sh[j] = *(const f32x4*)(MOD + 3 * DM + col); }
    const int gw = vcu * NWAVES + wave, NGW = G * NWAVES;
#pragma unroll 1
    for (int m0 = 4 * gw; m0 < NTOK; m0 += 4 * NGW) {
        f32x4 v[4][4];
#pragma unroll
        for (int r = 0; r < 4; ++r) { const GAS f32x4* xr = (const GAS f32x4*)(X1 + (size_t)(m0 + r) * DM) + lane;
#pragma unroll
            for (int j = 0; j < 4; ++j) v[r][j] = xr[64 * j]; }
        float ss[4];
#pragma unroll
        for (int r = 0; r < 4; ++r) { float t = 0.f;
#pragma unroll
            for (int j = 0; j < 4; ++j) t += (v[r][j].x * v[r][j].x + v[r][j].y * v[r][j].y) + (v[r][j].z * v[r][j].z + v[r][j].w * v[r][j].w);
            ss[r] = t; }
#pragma unroll
        for (int o = 1; o < 64; o <<= 1)
#pragma unroll
            for (int r = 0; r < 4; ++r) ss[r] += __shfl_xor(ss[r], o);
#pragma unroll
        for (int r = 0; r < 4; ++r) { const float rinv = 1.f / sqrtf(ss[r] * (1.f / DM) + EPS);
            GAS unsigned* o4 = (GAS unsigned*)((unsigned char*)H2 + (size_t)(m0 + r) * DM) + lane;
#pragma unroll
            for (int j = 0; j < 4; ++j) { v[r][j] = v[r][j] * rinv * av[j] + sh[j]; o4[64 * j] = pk4_fp8(v[r][j].x, v[r][j].y, v[r][j].z, v[r][j].w); } }
        float lg[4][16];
#pragma unroll
        for (int e = 0; e < 16; ++e) { f32x4 w[4];
#pragma unroll
            for (int j = 0; j < 4; ++j) w[j] = *(const LAS f32x4*)(wrt + e * 1024 + 4 * lane + 256 * j);
#pragma unroll
            for (int r = 0; r < 4; ++r) { float p = 0.f;
#pragma unroll
                for (int j = 0; j < 4; ++j) p += (v[r][j].x * w[j].x + v[r][j].y * w[j].y) + (v[r][j].z * w[j].z + v[r][j].w * w[j].w);
                lg[r][e] = p; }
            if ((e & 3) == 3) asm volatile("" ::: "memory"); }
        float r1[4];
#pragma unroll
        for (int r = 0; r < 4; ++r) {
            float r8[8], r4[4], r2[2];
            { const bool up = (lane & 32) != 0;
#pragma unroll
              for (int e = 0; e < 8; ++e) { const float snd = up ? lg[r][e] : lg[r][e + 8], kp = up ? lg[r][e + 8] : lg[r][e]; r8[e] = kp + __shfl_xor(snd, 32); } }
            { const bool up = (lane & 16) != 0;
#pragma unroll
              for (int e = 0; e < 4; ++e) { const float snd = up ? r8[e] : r8[e + 4], kp = up ? r8[e + 4] : r8[e]; r4[e] = kp + __shfl_xor(snd, 16); } }
            { const bool up = (lane & 8) != 0;
#pragma unroll
              for (int e = 0; e < 2; ++e) { const float snd = up ? r4[e] : r4[e + 2], kp = up ? r4[e + 2] : r4[e]; r2[e] = kp + __shfl_xor(snd, 8); } }
            { const bool up = (lane & 4) != 0; const float snd = up ? r2[0] : r2[1], kp = up ? r2[1] : r2[0]; r1[r] = kp + __shfl_xor(snd, 4); }
        }
#pragma unroll
        for (int r = 0; r < 4; ++r) r1[r] += __shfl_xor(r1[r], 2);
#pragma unroll
        for (int r = 0; r < 4; ++r) r1[r] += __shfl_xor(r1[r], 1);
        float mx[4], ex[4], den[4];
#pragma unroll
        for (int r = 0; r < 4; ++r) mx[r] = r1[r];
#pragma unroll
        for (int o = 4; o < 64; o <<= 1)
#pragma unroll
            for (int r = 0; r < 4; ++r) mx[r] = fmaxf(mx[r], __shfl_xor(mx[r], o));
#pragma unroll
        for (int r = 0; r < 4; ++r) { ex[r] = __expf(r1[r] - mx[r]); den[r] = ex[r]; }
#pragma unroll
        for (int o = 4; o < 64; o <<= 1)
#pragma unroll
            for (int r = 0; r < 4; ++r) den[r] += __shfl_xor(den[r], o);
        float mine = ex[0] / den[0];
#pragma unroll
        for (int r = 1; r < 4; ++r) mine = ((lane & 3) == r) ? ex[r] / den[r] : mine;
        AFF[(size_t)(lane >> 2) * NTOK + m0 + (lane & 3)] = mine;
    }
}

__device__ __forceinline__ void p4_topk(const Args& a, LAS unsigned char* lds, int e, int wave) {
    const int lane = fresh_lane(), tid = wave * 64 + lane;
    unsigned char* ws = a.ws; const unsigned* AFF = (const unsigned*)(ws + WS_AFF) + (size_t)e * NTOK;
    int* IDX = (int*)(ws + WS_IDX) + e * CAP; float* GATE = (float*)(ws + WS_GATE) + e * CAP; int* TOKSLOT = (int*)(ws + WS_TOKSLOT);
    LAS unsigned* wcnt = (LAS unsigned*)lds;
    LAS unsigned* cg = wcnt + 16;
    LAS unsigned* ce = cg + 256;
    unsigned key[32];
#pragma unroll
    for (int i = 0; i < 32; ++i) key[i] = AFF[i * NTHR + tid];
    unsigned T = 0u;
#pragma unroll 1
    for (int bit = 30; bit >= 0; --bit) {
        const unsigned cand = T | (1u << bit);
        unsigned c = 0u;
#pragma unroll
        for (int i = 0; i < 32; ++i) c += (unsigned)__popcll(__ballot(key[i] >= cand));
        LAS unsigned* wb = wcnt + 1024 + (bit & 1) * 8;
        if (lane == 0) wb[wave] = c;
        __syncthreads();
        unsigned tot = 0u;
#pragma unroll
        for (int w = 0; w < 8; ++w) tot += wb[w];
        if (tot >= (unsigned)CAP) T = cand;
    }
    __syncthreads();
    unsigned long long below = (1ull << lane) - 1ull;
    unsigned rg[32], rq[32];
#pragma unroll
    for (int i = 0; i < 32; ++i) {
        const unsigned long long bg = __ballot(key[i] > T), bq = __ballot(key[i] == T);
        rg[i] = (unsigned)__popcll(bg & below); rq[i] = (unsigned)__popcll(bq & below);
        if (lane == 0) { cg[i * 8 + wave] = (unsigned)__popcll(bg); ce[i * 8 + wave] = (unsigned)__popcll(bq); }
    }
    __syncthreads();
    if (wave == 0) {
        unsigned g4[4], q4[4], sg = 0u, sq = 0u;
#pragma unroll
        for (int k = 0; k < 4; ++k) { g4[k] = cg[4 * lane + k]; q4[k] = ce[4 * lane + k]; sg += g4[k]; sq += q4[k]; }
        unsigned pg = sg, pq = sq;
#pragma unroll
        for (int o = 1; o < 64; o <<= 1) { const unsigned tg = __shfl_up(pg, o), tq = __shfl_up(pq, o); if (lane >= o) { pg += tg; pq += tq; } }
        pg -= sg; pq -= sq;
#pragma unroll
        for (int k = 0; k < 4; ++k) { cg[4 * lane + k] = pg; ce[4 * lane + k] = pq; pg += g4[k]; pq += q4[k]; }
        if (lane == 63) { wcnt[8] = pg; }
    }
    __syncthreads();
    const unsigned ngt = wcnt[8], need = (unsigned)CAP - ngt;
#pragma unroll
    for (int i = 0; i < 32; ++i) {
        const int tok = i * NTHR + tid;
        const unsigned gb = cg[i * 8 + wave] + rg[i], qb = ce[i * 8 + wave] + rq[i];
        const bool sel = key[i] > T || (key[i] == T && qb < need);
        const unsigned slot = gb + (qb < need ? qb : need);
        if (sel) { IDX[slot] = tok; GATE[slot] = __uint_as_float(key[i]); }
        TOKSLOT[tok * 16 + e] = sel ? (int)slot : -1;
    }
}

struct P5Prob {
    static constexpr int K = DM; static constexpr bool PERM = true, FP8 = true; static constexpr int SCW = 0x7A7A7A7A, SCA = 0x7F7F7F7F;
    const unsigned char* H2; const unsigned char* WguT; unsigned char* HID; pg8::StaticOrder so;
    __device__ __forceinline__ bool next(int i, pg8::Unit& u) const { return so.next(i, u); }
    __device__ __forceinline__ const char* aptr(const pg8::Unit&) const { return (const char*)H2; }
    __device__ __forceinline__ const char* bptr(const pg8::Unit& u) const { return (const char*)(WguT + ((size_t)(u.pm >> 3) * 4096 + (size_t)u.pn * 256) * DM); }
    __device__ __forceinline__ void epi(const pg8::f32x4 (&acc)[2][2][4][2], const pg8::Unit& u, int wr, int wc, int fr, int fq) const {
#pragma unroll
        for (int ai = 0; ai < 2; ++ai)
#pragma unroll
            for (int m = 0; m < 4; ++m) { unsigned char* rowp = HID + (size_t)(u.pm * 256 + ai * 128 + wr * 64 + m * 16 + fr) * DE + u.pn * 128 + wc * 32 + 8 * fq;
                float h[8];
#pragma unroll
                for (int n = 0; n < 2; ++n)
#pragma unroll
                    for (int e = 0; e < 4; ++e) { const float gt = acc[ai][0][m][n][e], up = acc[ai][1][m][n][e]; h[4 * n + e] = gt * __builtin_amdgcn_rcpf(1.f + __builtin_amdgcn_exp2f(-1.4426950408889634f * gt)) * up; }
                *(v2u*)rowp = (v2u){pk4_fp8(h[0], h[1], h[2], h[3]), pk4_fp8(h[4], h[5], h[6], h[7])}; }
    }
};
struct P6Prob {
    static constexpr int K = DE; static constexpr bool PERM = true, FP8 = true; static constexpr int SCW = 0x7A7A7A7A, SCA = 0x7F7F7F7F;
    const unsigned char* HID; const unsigned char* WdT; const float* GATE; bf16* YE; pg8::StaticOrder so;
    __device__ __forceinline__ bool next(int i, pg8::Unit& u) const { return so.next(i, u); }
    __device__ __forceinline__ const char* aptr(const pg8::Unit& u) const { return (const char*)(HID + (size_t)u.pm * 256 * DE); }
    __device__ __forceinline__ const char* bptr(const pg8::Unit& u) const { return (const char*)(WdT + ((size_t)(u.pm >> 3) * DM + (size_t)u.pn * 256) * DE); }
    __device__ __forceinline__ void epi(const pg8::f32x4 (&acc)[2][2][4][2], const pg8::Unit& u, int wr, int wc, int fr, int fq) const {
#pragma unroll
        for (int ai = 0; ai < 2; ++ai)
#pragma unroll
            for (int m = 0; m < 4; ++m) { const int row = u.pm * 256 + ai * 128 + wr * 64 + m * 16 + fr; const float gt = GATE[row]; bf16* rowp = YE + (size_t)row * DM + u.pn * 256 + wc * 32 + 8 * fq;
#pragma unroll
                for (int bj = 0; bj < 2; ++bj) { const pg8::f32x4 v0 = acc[ai][bj][m][0] * gt, v1 = acc[ai][bj][m][1] * gt;
                    *(v4u*)(rowp + bj * 128) = (v4u){pk2(v0[0], v0[1]), pk2(v0[2], v0[3]), pk2(v1[0], v1[1]), pk2(v1[2], v1[3])}; } }
    }
};

__device__ __forceinline__ void p7_final(const Args& a, int vcu, int G, int wave, unsigned poison) {
    const int lane = fresh_lane();
    unsigned char* ws = a.ws; const float* MOD = (const float*)(ws + WS_MOD); const bf16* YE = (const bf16*)(ws + WS_YE); const int* TOKSLOT = (const int*)(ws + WS_TOKSLOT);
    const float* src = (STEP >= 2) ? (const float*)(ws + WS_X1) : a.x;
    f32x4 g2[4], fg[4];
#pragma unroll
    for (int j = 0; j < 4; ++j) { const int col = 4 * lane + 256 * j; g2[j] = *(const f32x4*)(MOD + 5 * DM + col); fg[j] = *(const f32x4*)(a.final_norm_g + col); }
    const int gw = vcu * NWAVES + wave, NGW = G * NWAVES;
    for (int m = gw; m < NTOK; m += NGW) {
        const GAS f32x4* xr = (const GAS f32x4*)(src + (size_t)m * DM) + lane;
        f32x4 v[4];
#pragma unroll
        for (int j = 0; j < 4; ++j) v[j] = xr[64 * j];
        if (STEP >= 4) {
            const int myslot = lane < 16 ? TOKSLOT[m * 16 + lane] : -1;
            f32x4 s[4];
#pragma unroll
            for (int j = 0; j < 4; ++j) s[j] = (f32x4){0.f, 0.f, 0.f, 0.f};
#pragma unroll 1
            for (int e = 0; e < 16; ++e) {
                const int sl = __builtin_amdgcn_readlane(myslot, e);
                if (sl >= 0) {
                    const GAS v2u* yr = (const GAS v2u*)(YE + ((size_t)e * CAP + sl) * DM) + lane;
#pragma unroll
                    for (int j = 0; j < 4; ++j) { const v2u w = yr[64 * j]; s[j].x += __uint_as_float(w.x << 16); s[j].y += __uint_as_float(w.x & 0xffff0000u); s[j].z += __uint_as_float(w.y << 16); s[j].w += __uint_as_float(w.y & 0xffff0000u); }
                }
            }
#pragma unroll
            for (int j = 0; j < 4; ++j) v[j] += g2[j] * s[j];
        }
        float ss = 0.f;
#pragma unroll
        for (int j = 0; j < 4; ++j) ss += (v[j].x * v[j].x + v[j].y * v[j].y) + (v[j].z * v[j].z + v[j].w * v[j].w);
        const float rinv = 1.f / sqrtf(wave_sum(ss) * (1.f / DM) + EPS);
        GAS f32x4* o = (GAS f32x4*)(a.out + (size_t)m * DM) + lane;
        const float q = __builtin_nanf("");
#pragma unroll
        for (int j = 0; j < 4; ++j) { f32x4 y = v[j] * rinv * fg[j]; if (poison) y = (f32x4){q, q, q, q}; o[64 * j] = y; }
    }
}


#if PROBE
__device__ __forceinline__ void dsincos(double x, double& sn, double& cs) {
    const double TWO_PI = 6.283185307179586476925286766559; x -= TWO_PI * rint(x / TWO_PI);
    const double x2 = x * x; double ts = x, tc = 1.0; sn = x; cs = 1.0;
#pragma unroll 1
    for (int k = 1; k <= 14; ++k) { tc *= -x2 / (double)((2 * k - 1) * (2 * k)); ts *= -x2 / (double)((2 * k) * (2 * k + 1)); cs += tc; sn += ts; }
}
__device__ __forceinline__ float block_sum(float v, LAS float* red, int wave, int lane) {
    v = wave_sum(v); __syncthreads(); if (lane == 0) red[wave] = v; __syncthreads(); float s = 0.f;
#pragma unroll
    for (int w = 0; w < 8; ++w) s += red[w];
    return s;
}
__device__ __forceinline__ float block_max(float v, LAS float* red, int wave, int lane) {
#pragma unroll
    for (int o = 1; o < 64; o <<= 1) v = fmaxf(v, __shfl_xor(v, o));
    __syncthreads(); if (lane == 0) red[wave] = v; __syncthreads(); float s = red[0];
#pragma unroll
    for (int w = 1; w < 8; ++w) s = fmaxf(s, red[w]);
    return s;
}
__device__ __forceinline__ void probe_qkv(const Args& a, LAS unsigned char* lds, int vcu, int wave) {
    const int lane = fresh_lane(), tid = wave * 64 + lane; unsigned char* ws = a.ws;
    const bf16* XN = (const bf16*)(ws + WS_XN); const bf16* Qb = (const bf16*)(ws + WS_Q); const bf16* Kb = (const bf16*)(ws + WS_K); const bf16* Vb = (const bf16*)(ws + WS_V);
    gu32* ctl = (gu32*)(ws + WS_CTL);
    LAS float* red = (LAS float*)lds; LAS float* raw = red + 16;
    for (int kind = 0; kind < 3; ++kind) {
        const int nrows = kind == 0 ? NTOK : NROWS, nh = kind == 0 ? NHQ : NHKV;
        const int t = (kind == 1 && (vcu & 7) == 3) ? NTOK + (vcu * 37) % NCTX : (vcu * 977 + 131 * kind + 5) % (kind == 0 ? NTOK : NTOK);
        const int h = (vcu * 5 + kind) % nh;
        const int wcol0 = 256 + (kind == 0 ? 0 : (kind == 1 ? 768 : 1024)) + 64 * h;
        { const int d = tid & 63, part = tid >> 6; float sacc = 0.f;
          for (int k = part * 128; k < part * 128 + 128; ++k) sacc += bf2f(XN[(size_t)t * DM + k]) * a.w_in[(size_t)k * INW + wcol0 + d];
          LAS float* part_s = raw + 64; part_s[part * 64 + d] = sacc; __syncthreads();
          if (tid < 64) { float s2 = 0.f; for (int pp = 0; pp < 8; ++pp) s2 += part_s[pp * 64 + tid]; raw[tid] = s2; }
          __syncthreads(); }
        float ref = 0.f, got = 0.f;
        if (tid < 64) {
            const int d = tid; float v = raw[d];
            if (kind < 2) {
                float ss = 0.f; for (int j = 0; j < 64; ++j) ss += raw[j] * raw[j];
                const float* gw = kind == 0 ? a.q_norm_g : a.k_norm_g;
                const float rinv = 1.f / sqrtf(ss / 64.f + EPS);
                if (t < NTOK) {
                    const int half = d >> 5, dd = d & 31, i = dd & 15; const int pos = half == 0 ? (t >> 6) : (t & 63);
                    const double freq = exp2(-(double)i * (13.287712379549449 / 16.0)); double sn, cs; dsincos((double)pos * freq, sn, cs);
                    const float x1 = raw[32 * half + i] * rinv * gw[32 * half + i], x2 = raw[32 * half + 16 + i] * rinv * gw[32 * half + 16 + i];
                    v = dd < 16 ? (float)(x1 * cs - x2 * sn) : (float)(x1 * sn + x2 * cs);
                } else v = v * rinv * gw[d];
                if (kind == 0) v *= attn_body::C2;
            }
            ref = v;
#if ATTN_F8
            { const unsigned char* Q8 = (const unsigned char*)Qb; const unsigned char* K8 = (const unsigned char*)Kb; const unsigned char* V8 = (const unsigned char*)Vb;
              if (kind == 0) got = __builtin_amdgcn_cvt_f32_fp8((int)Q8[(size_t)t * 768 + 64 * h + d], 0) * (1.f / 16.f);
              else if (kind == 1) got = __builtin_amdgcn_cvt_f32_fp8((int)K8[(size_t)t * 256 + 64 * h + d], 0);
              else { const int kk = t & 63, tile = t >> 6, k5 = kk & 31, hk = (k5 >> 2) & 1, j = (k5 & 3) + 4 * (k5 >> 3) + 16 * (kk >> 5);
                     got = __builtin_amdgcn_cvt_f32_fp8((int)V8[(size_t)(h * (NKEYS / 64) + tile) * 4096 + (j >> 4) * 2048 + d * 32 + 16 * (hk ^ ((d >> 3) & 1)) + (j & 15)], 0); } }
#else
            got = kind == 0 ? bf2f(Qb[(size_t)t * 768 + 64 * h + d]) : (kind == 1 ? bf2f(Kb[(size_t)t * 256 + 64 * h + d]) : bf2f(Vb[(size_t)t * 256 + 64 * h + d]));
#endif
        }
        const float mx = block_max(fabsf(ref), red, wave, lane);
        const float err = block_max(fabsf(ref - got), red, wave, lane);
        if (tid == 0 && !(err <= (ATTN_F8 ? 0.07f : 0.03f) * mx + 1e-6f)) __hip_atomic_fetch_or(ctl + CW_FLAG, 1u << kind, RLX_AGENT);
        __syncthreads();
    }
}
__device__ __forceinline__ void probe_attn(const Args& a, LAS unsigned char* lds, int vcu, int wave) {
    const int lane = fresh_lane(), tid = wave * 64 + lane; unsigned char* ws = a.ws;
    const bf16* Qb = (const bf16*)(ws + WS_Q); const bf16* Kb = (const bf16*)(ws + WS_K); const bf16* Vb = (const bf16*)(ws + WS_V); const bf16* MIX = (const bf16*)(ws + WS_MIX);
    gu32* ctl = (gu32*)(ws + WS_CTL);
    LAS float* red = (LAS float*)lds; LAS float* ored = red + 16;
    const int t = (vcu * 613 + 29) % NTOK, h = (vcu * 7 + 3) % NHQ, kvh = h / 3;
    float q[64];
#if ATTN_F8
    const unsigned char* Q8 = (const unsigned char*)Qb; const unsigned char* K8 = (const unsigned char*)Kb; const unsigned char* V8 = (const unsigned char*)Vb;
#pragma unroll
    for (int d = 0; d < 64; ++d) q[d] = __builtin_amdgcn_cvt_f32_fp8((int)Q8[(size_t)t * 768 + 64 * h + d], 0) * (1.f / 16.f);
#else
#pragma unroll
    for (int d = 0; d < 64; ++d) q[d] = bf2f(Qb[(size_t)t * 768 + 64 * h + d]);
#endif
    float sc[33]; float mx = -1e30f;
#pragma unroll
    for (int i = 0; i < 33; ++i) { const int key = i * NTHR + tid; float s = -1e30f;
#if ATTN_F8
        if (key < NKEYS) { s = 0.f; const unsigned char* kr = K8 + (size_t)key * 256 + 64 * kvh;
#pragma unroll
            for (int d = 0; d < 64; ++d) s += q[d] * __builtin_amdgcn_cvt_f32_fp8((int)kr[d], 0); }
#else
        if (key < NKEYS) { s = 0.f; const bf16* kr = Kb + (size_t)key * 256 + 64 * kvh;
#pragma unroll
            for (int d = 0; d < 64; ++d) s += q[d] * bf2f(kr[d]); }
#endif
        sc[i] = s; mx = fmaxf(mx, s); }
    mx = block_max(mx, red, wave, lane);
    float den = 0.f; float o[64];
#pragma unroll
    for (int d = 0; d < 64; ++d) o[d] = 0.f;
#pragma unroll
    for (int i = 0; i < 33; ++i) { const int key = i * NTHR + tid;
#if ATTN_F8
        if (key < NKEYS) { const float pp = exp2f(sc[i] - mx); den += pp; const int kk = key & 63, tile = key >> 6, k5 = kk & 31, hk = (k5 >> 2) & 1, j = (k5 & 3) + 4 * (k5 >> 3) + 16 * (kk >> 5);
            const unsigned char* vb = V8 + (size_t)(kvh * (NKEYS / 64) + tile) * 4096 + (j >> 4) * 2048 + (j & 15);
#pragma unroll
            for (int d = 0; d < 64; ++d) o[d] += pp * __builtin_amdgcn_cvt_f32_fp8((int)vb[d * 32 + 16 * (hk ^ ((d >> 3) & 1))], 0); } }
#else
        if (key < NKEYS) { const float pp = exp2f(sc[i] - mx); den += pp; const bf16* vr = Vb + (size_t)key * 256 + 64 * kvh;
#pragma unroll
            for (int d = 0; d < 64; ++d) o[d] += pp * bf2f(vr[d]); } }
#endif
    den = block_sum(den, red, wave, lane);
#pragma unroll
    for (int d = 0; d < 64; ++d) { const float w = wave_sum(o[d]); if (lane == 0) ored[wave * 64 + d] = w; }
    __syncthreads();
    float ref = 0.f, got = 0.f;
    if (tid < 64) { float s = 0.f; for (int w = 0; w < 8; ++w) s += ored[w * 64 + tid]; ref = s / den; got = bf2f(MIX[(size_t)t * DM + 256 + 64 * h + tid]); }
    const float m2 = block_max(fabsf(ref), red, wave, lane);
    const float err = block_max(fabsf(ref - got), red, wave, lane);
    if (tid == 0 && !(err <= 0.03f * m2 + 1e-7f)) __hip_atomic_fetch_or(ctl + CW_FLAG, 8u, RLX_AGENT);
    __syncthreads();
}
#endif

__global__ void __launch_bounds__(NTHR, 2) fwd_megakernel(Args args) {
    extern __shared__ __attribute__((aligned(16))) unsigned char lds_raw[];
    LAS unsigned char* lds = (LAS unsigned char*)lds_raw;
    volatile LAS unsigned* MISC = (volatile LAS unsigned*)(lds + MISC_OFF);
    const int wave = __builtin_amdgcn_readfirstlane(threadIdx.x >> 6);
    const int G = gridDim.x; const int bx = blockIdx.x; const int vcu = (G % 8 == 0) ? (bx % 8) * (G / 8) + bx / 8 : bx;
    unsigned char* ws = args.ws;
    gu32* ctl = (gu32*)(ws + WS_CTL);
    { const int l0 = fresh_lane(); if (wave < 2) ((LAS unsigned*)(lds + MISC_OFF))[wave * 64 + l0] = 0u;
      __syncthreads();
    }
    XcdBarrier bar = xcd_barrier_post((unsigned*)(ctl + CW_BAR), MISC + 8, wave == 0 && fresh_lane() == 0);
#define GRID_BAR() xcd_barrier(bar, wave)

    for (int rep = 0; rep < REP(0); ++rep) {
    if (STEP >= 2 && PH(0)) p0_prologue(args, lds, vcu, G, wave);
    GRID_BAR(); }
    for (int rep = 0; rep < REP(1); ++rep) {
    if (STEP >= 2 && PH(1)) p0b_modulate(args, vcu, G, wave);
    GRID_BAR(); }
    for (int rep = 0; rep < REP(2); ++rep) {
    if (STEP >= 2 && PH(2)) {
        P1Prob p; p.XN = (bf16*)(ws + WS_XN); p.WinT = (bf16*)(ws + WS_WIN); p.Q = (bf16*)(ws + WS_Q); p.Kb = (bf16*)(ws + WS_K); p.Vb = (bf16*)(ws + WS_V); p.FT = (float*)(ws + WS_FT);
        p.qg = args.q_norm_g; p.kg = args.k_norm_g; p.kmax = (unsigned*)(ctl + CW_KMAX); p.so.init(NROWS / 256, INW / 256, G, bx);
        pg8::gemm_phase<P1Prob, false, true, true>(lds, p, nullptr, wave);
        if (rep == 0 && MOE_S1 > 0) {
            const int nwg = (NROWS / 256) * (INW / 256), maxc = (nwg + G - 1) / G, c0 = nwg - (maxc - 1) * G;
            if (c0 >= G) moe_convert(args, (LAS float*)(lds + wave * 16640), MOE_B0, MOE_B1, bx * NWAVES + wave, G * NWAVES);
            else if (bx >= c0) moe_convert(args, (LAS float*)(lds + wave * 16640), MOE_B0, MOE_B1, (bx - c0) * NWAVES + wave, (G - c0) * NWAVES);
        }
    }
    GRID_BAR(); }
#if PROBE == 1
    probe_qkv(args, lds, vcu, wave);
#endif
    if (REP(12) > 1) {
        P1Prob p; p.XN = (bf16*)(ws + WS_XN); p.WinT = (bf16*)(ws + WS_WIN); p.Q = (bf16*)(ws + WS_Q); p.Kb = (bf16*)(ws + WS_K); p.Vb = (bf16*)(ws + WS_V); p.FT = (float*)(ws + WS_FT);
        p.qg = args.q_norm_g; p.kg = args.k_norm_g; p.kmax = (unsigned*)(ctl + CW_KMAX); p.so.init(NROWS / 256, INW / 256, G, bx);
        pg8::gemm_phase<P1Prob, false, true, true>(lds, p, nullptr, wave);
        GRID_BAR(); }
    for (int rep = 0; rep < REP(3); ++rep) {
    if (STEP >= 2 && PH(3)) {
        for (int item = vcu; item < 256; item += G) fft_block(args, lds, item, wave);
        if (rep == 0 && MOE_S2 > 0) {
            if (G > 256) { if (vcu >= 256) moe_convert(args, (LAS float*)(lds + wave * 16640), MOE_B1, MOE_B2, (vcu - 256) * NWAVES + wave, (G - 256) * NWAVES); }
            else moe_convert(args, (LAS float*)(lds + wave * 16640), MOE_B1, MOE_B2, vcu * NWAVES + wave, G * NWAVES);
        }
    }
    if (rep + 1 < REP(3)) GRID_BAR(); }
    for (int rep = 0; rep < REP(4); ++rep) {
    if (STEP >= 3 && PH(4)) {
        const attn_body::bf16* Qb = (const attn_body::bf16*)(ws + WS_Q); const attn_body::bf16* Kb = (const attn_body::bf16*)(ws + WS_K); const attn_body::bf16* Vb = (const attn_body::bf16*)(ws + WS_V);
        attn_body::bf16* MIX = (attn_body::bf16*)(ws + WS_MIX);
        const float kmax2 = __uint_as_float(__hip_atomic_load(ctl + CW_KMAX, RLX_AGENT));
        const int u0 = (G == 256) ? vcu * 3 : vcu, ustep = (G == 256) ? 1 : G, uend = (G == 256) ? vcu * 3 + 3 : 768;
        int ucnt = 0;
#pragma unroll 1
        for (int u = u0; u < uend; u += ustep, ++ucnt) {
            if (rep == 0 && MOE_B3 < MOE_ITEMS && ucnt == ((G == 256) ? vcu % 3 : 0)) { moe_convert(args, (LAS float*)(lds + wave * 16640), MOE_B3, MOE_ITEMS, wave * G + vcu, NWAVES * G); __syncthreads(); }
            const int kvh = u / 192, w = u % 192, h = kvh * 3 + w / 64, qb = w % 64;
#if ATTN_F8
            attn_body::attn_unit_f8<0>(h, kvh, qb, (const unsigned char*)Qb, (const unsigned char*)Kb, (const unsigned char*)Vb, MIX, (char*)lds_raw, wave, kmax2);
#ifdef DUMMYVAR
            attn_body::attn_unit_f8<(DUMMYVAR) | 8>(h, kvh, qb, (const unsigned char*)Qb, (const unsigned char*)Kb, (const unsigned char*)Vb, MIX, (char*)lds_raw, wave, kmax2);
#endif
#else
            attn_body::attn_unit<8>(h, kvh, qb, Qb, Kb, Vb, MIX, (char*)lds_raw, wave, kmax2);
#endif
        }
    } else if (STEP == 2) {
        bf16* MIX = (bf16*)(ws + WS_MIX);
        const int gw = vcu * NWAVES + wave, NGW = G * NWAVES, lane = fresh_lane();
        for (int m = gw; m < NTOK; m += NGW) { GAS v4u* o = (GAS v4u*)(MIX + (size_t)m * DM + 256); o[lane] = (v4u){0u, 0u, 0u, 0u}; if (lane < 32) o[64 + lane] = (v4u){0u, 0u, 0u, 0u}; }
    }
    GRID_BAR(); }
#if PROBE == 2
    probe_attn(args, lds, vcu, wave);
#endif
    for (int rep = 0; rep < REP(5); ++rep) {
    if (STEP >= 2 && PH(5)) {
        P3Prob p; p.MIX = (bf16*)(ws + WS_MIX); p.WoT = (bf16*)(ws + WS_WOUT); p.x = args.x; p.g1 = (const float*)(ws + WS_MOD) + 2 * DM; p.X1 = (float*)(ws + WS_X1); p.so.init(NTOK / 256, DM / 256, G, bx);
        pg8::gemm_phase<P3Prob, false, true, true>(lds, p, nullptr, wave);
    }
    GRID_BAR(); }
    for (int rep = 0; rep < REP(6); ++rep) {
    if (STEP >= 4 && PH(6)) p3b_router(args, lds, vcu, G, wave);
    GRID_BAR(); }
    for (int rep = 0; rep < REP(7); ++rep) {
    if (STEP >= 4 && PH(7)) {
#pragma unroll 1
        for (int e = vcu; e < NE; e += G) p4_topk(args, lds, e, wave);
        if (rep == 0) {
            if (G > NE) { if (vcu >= NE) moe_convert(args, (LAS float*)(lds + wave * 16640), MOE_B2, MOE_B3, (vcu - NE) * NWAVES + wave, (G - NE) * NWAVES); }
            else moe_convert(args, (LAS float*)(lds + wave * 16640), MOE_B2, MOE_B3, vcu * NWAVES + wave, G * NWAVES);
        } }
    GRID_BAR(); }
    if (REP(11) > 1) {
        moe_convert(args, (LAS float*)(lds + wave * 16640), MOE_B2, MOE_B3, vcu * NWAVES + wave, G * NWAVES);
        GRID_BAR(); }
    for (int rep = 0; rep < REP(8); ++rep) {
    if (STEP >= 4 && PH(8)) {
        P5Prob p; p.H2 = (const unsigned char*)(ws + WS_H2); p.WguT = (const unsigned char*)(ws + WS_WGU); p.HID = (unsigned char*)(ws + WS_HID); p.so.init(NE * CAP / 256, 2 * DE / 256, G, bx);
        LAS unsigned* rowtab = (LAS unsigned*)(lds + XTRA_OFF);
        const int* IDX = (const int*)(ws + WS_IDX);
        { const int tid = wave * 64 + fresh_lane(); pg8::Unit u; for (int i = 0; p.so.next(i, u) && i < 28; ++i) { if (tid < 256) rowtab[i * 256 + tid] = (unsigned)IDX[u.pm * 256 + tid]; } }
        __syncthreads();
        pg8::gemm_phase<P5Prob, true, true, true>(lds, p, rowtab, wave);
    }
    GRID_BAR(); }
    for (int rep = 0; rep < REP(9); ++rep) {
    if (STEP >= 4 && PH(9)) {
        P6Prob p; p.HID = (const unsigned char*)(ws + WS_HID); p.WdT = (const unsigned char*)(ws + WS_WD); p.GATE = (const float*)(ws + WS_GATE); p.YE = (bf16*)(ws + WS_YE); p.so.init(NE * CAP / 256, DM / 256, G, bx);
        pg8::gemm_phase<P6Prob, false, true, true>(lds, p, nullptr, wave);
    }
    GRID_BAR(); }
    {
        unsigned poison = (__hip_atomic_load(ctl + CW_BAR + XB_TMO, RLX_AGENT) != 0u) || (__hip_atomic_load(ctl + CW_FLAG, RLX_AGENT) != 0u);
        for (int rep = 0; rep < REP(10); ++rep) p7_final(args, vcu, G, wave, poison);
    }
}

extern "C" void kernel_launch(void* const* d_in, const int* in_sizes, int n_in, void* d_out, int out_size, void* d_ws, size_t ws_size, hipStream_t stream) {
    static int grid = 0;
    if (grid == 0) {
        if (n_in != 18 || in_sizes[0] != NTOK * DM || out_size != NTOK * DM || ws_size < WS_END) { fprintf(stderr, "kernel_launch: unexpected shapes (n_in %d, in0 %d, out %d, ws %zu)\n", n_in, n_in > 0 ? in_sizes[0] : -1, out_size, ws_size); grid = -1; return; }
        int dev = 0, cus = 0, per_cu = 0;
        if (hipGetDevice(&dev) != hipSuccess || hipDeviceGetAttribute(&cus, hipDeviceAttributeMultiprocessorCount, dev) != hipSuccess) { grid = -1; return; }
        if (hipFuncSetAttribute((const void*)fwd_megakernel, hipFuncAttributeMaxDynamicSharedMemorySize, LDS_BYTES) != hipSuccess) { fprintf(stderr, "kernel_launch: hipFuncSetAttribute failed\n"); grid = -1; return; }
        if (hipOccupancyMaxActiveBlocksPerMultiprocessor(&per_cu, (const void*)fwd_megakernel, NTHR, LDS_BYTES) != hipSuccess || per_cu < 1) { fprintf(stderr, "kernel_launch: occupancy query says %d blocks per CU\n", per_cu); (void)hipGetLastError(); grid = -1; return; }
        grid = cus;
    }
    if (grid < 0) return;
    (void)hipMemsetAsync((char*)d_ws + WS_CTL, 0, CTL_ZERO_BYTES, stream);
    Args a{};
    const float** f = (const float**)&a;
    for (int i = 0; i < 18; ++i) f[i] = (const float*)d_in[i];
    a.out = (float*)d_out; a.ws = (unsigned char*)d_ws;
    hipLaunchKernelGGL(fwd_megakernel, dim3(grid), dim3(NTHR), LDS_BYTES, stream, a);
}
```

```cpp
#include <hip/hip_runtime.h>
#include <hip/hip_bf16.h>
#include <cstdio>
#include <cstdint>
#include <cmath>

#ifndef STEP
#define STEP 4
#endif
#ifndef PROBE
#define PROBE 0
#endif
#ifndef PHMASK
#define PHMASK 0xFFFF
#endif
#define PH(k) ((PHMASK >> (k)) & 1)
#ifndef ATTN_F8
#define ATTN_F8 1
#endif
#ifndef REPEAT
#define REPEAT 0
#endif
#define REP(k) (((REPEAT >> (k)) & 1) + 1)

constexpr int DM = 1024, NTOK = 16384, NCTX = 256, NROWS = NTOK + NCTX, INW = 1536;
constexpr int NHQ = 12, NHKV = 4, HD = 64, NE = 16, CAP = 2048, DE = 2048, NMOD = 6;
constexpr int NKEYS = NROWS;
constexpr float EPS = 1e-6f;

__device__ __forceinline__ int fresh_lane() { int l; asm volatile("v_mbcnt_lo_u32_b32 %0, -1, 0\n\tv_mbcnt_hi_u32_b32 %0, -1, %0" : "=v"(l)); return l; }

namespace pg8 {
#define PG8_LAS __attribute__((address_space(3)))
typedef unsigned short bf16_t;
typedef short bf16x8 __attribute__((ext_vector_type(8)));
typedef float f32x4 __attribute__((ext_vector_type(4)));
typedef unsigned u32x4 __attribute__((ext_vector_type(4)));
typedef unsigned u32x2 __attribute__((ext_vector_type(2)));
typedef int v8i __attribute__((ext_vector_type(8)));
constexpr int BM = 256, BK = 64, HALF = 128, HTB = HALF * BK * 2, STAGE_BYTES = 8 * HTB, NXCD = 8, WGM = 8;

__host__ __device__ __forceinline__ int lds_byte(int r, int c) { const int st = (r >> 4) * 2 + (c >> 5), rr = r & 15, cc = c & 31, ob = rr * 64 + cc * 2; return st * 1024 + (ob ^ (((ob >> 9) & 1) << 5)); }
__host__ __device__ __forceinline__ void stage_rc(int b, int& R, int& C) { const int st = b / 1024, sb = b % 1024, swz = sb ^ (((sb >> 9) & 1) << 5); R = (st >> 1) * 16 + swz / 64; C = (st & 1) * 32 + (swz % 64) / 2; }
__host__ __device__ __forceinline__ int perm32(int rho) { const int n = rho >> 4, i = rho & 15; return 8 * (i >> 2) + 4 * n + (i & 3); }

struct Unit { int pm, pn; };

struct StaticOrder {
    int nM, nN, nwg, G, c;
    __host__ __device__ void init(int nM_, int nN_, int G_, int c_) { nM = nM_; nN = nN_; nwg = nM * nN; G = G_; c = c_; }
    __host__ __device__ bool next(int i, Unit& u) const {
        const long L = (long)i * G + c; if (L >= nwg) return false;
        int wgid = (int)L; { const int q = nwg / NXCD, r = nwg % NXCD, xcd = wgid % NXCD, off = wgid / NXCD; wgid = (xcd < r ? xcd * (q + 1) : r * (q + 1) + (xcd - r) * q) + off; }
        const int nig = WGM * nN, gid = wgid / nig, fm = gid * WGM, gsz = (nM - fm) < WGM ? (nM - fm) : WGM;
        u.pm = fm + ((wgid % nig) % gsz); u.pn = (wgid % nig) / gsz; return true;
    }
};

__device__ __forceinline__ unsigned cvt_pk_bf16(float lo, float hi) { unsigned r; asm volatile("v_cvt_pk_bf16_f32 %0, %1, %2" : "=v"(r) : "v"(lo), "v"(hi)); return r; }

template <class P, bool GATHER, bool ALIGN_EPI, bool SP2>
__device__ __forceinline__ void gemm_phase(PG8_LAS unsigned char* lds, const P& S, const PG8_LAS unsigned* rowtab, int wid) {
    const int lane = fresh_lane(), tid = wid * 64 + lane, wr = wid >> 2, wc = wid & 3, fr = lane & 15, fq = lane >> 4;
    constexpr bool F8 = P::FP8; constexpr int ESZ = F8 ? 1 : 2;
    constexpr int K = P::K, nt = F8 ? K / 128 : K / BK;
    int R0, C0; stage_rc(tid * 16, R0, C0);
    unsigned voffB[2];
#pragma unroll
    for (int i = 0; i < 2; ++i) { const int R = R0 + 64 * i; const int Rb = P::PERM ? ((R & ~31) + perm32(R & 31)) : R; voffB[i] = (unsigned)(Rb * K * ESZ + C0 * 2); }
    constexpr size_t kstep = (size_t)(BK * 2);
    constexpr size_t hstep = (size_t)HALF * K * ESZ;
    const unsigned ldsw = (unsigned)wid * 1024u;
    const int aoff = F8 ? lds_byte(wr * 64 + fr, fq * 16) : lds_byte(wr * 64 + fr, fq * 8), boff = F8 ? lds_byte(wc * 32 + fr, fq * 16) : lds_byte(wc * 32 + fr, fq * 8);
#define PG8_SA(b, h) (((b) * 2 + (h)) * HTB)
#define PG8_SB(b, h) ((4 + (b) * 2 + (h)) * HTB)
#define PG8_STAGE(bufoff, gbase, voff) do { _Pragma("unroll") for (int _i = 0; _i < 2; ++_i) \
        __builtin_amdgcn_global_load_lds((const unsigned*)((const char*)(gbase) + (voff)[_i]), (PG8_LAS unsigned*)(lds + (bufoff) + ldsw + _i * 8192), 16, 0, 0); } while (0)
#define PG8_LDA(dst, b, h) do { if constexpr (F8) { _Pragma("unroll") for (int m = 0; m < 4; ++m) { const PG8_LAS u32x4* p_ = (const PG8_LAS u32x4*)(lds + PG8_SA(b, h) + aoff + m * 2048); const u32x4 lo_ = p_[0], hi_ = p_[1]; \
            dst##8[m] = (v8i){(int)lo_.x, (int)lo_.y, (int)lo_.z, (int)lo_.w, (int)hi_.x, (int)hi_.y, (int)hi_.z, (int)hi_.w}; } } \
        else { _Pragma("unroll") for (int m = 0; m < 4; ++m) _Pragma("unroll") for (int k = 0; k < 2; ++k) dst[m][k] = *(const PG8_LAS bf16x8*)(lds + PG8_SA(b, h) + aoff + m * 2048 + k * 1024); } } while (0)
#define PG8_LDB(dst, b, h) do { if constexpr (F8) { _Pragma("unroll") for (int n = 0; n < 2; ++n) { const PG8_LAS u32x4* p_ = (const PG8_LAS u32x4*)(lds + PG8_SB(b, h) + boff + n * 2048); const u32x4 lo_ = p_[0], hi_ = p_[1]; \
            dst##8[n] = (v8i){(int)lo_.x, (int)lo_.y, (int)lo_.z, (int)lo_.w, (int)hi_.x, (int)hi_.y, (int)hi_.z, (int)hi_.w}; } } \
        else { _Pragma("unroll") for (int n = 0; n < 2; ++n) _Pragma("unroll") for (int k = 0; k < 2; ++k) dst[n][k] = *(const PG8_LAS bf16x8*)(lds + PG8_SB(b, h) + boff + n * 2048 + k * 1024); } } while (0)
#define PG8_MMA(ai, bj, At, Bt) do { __builtin_amdgcn_s_setprio(1); if constexpr (F8) { \
        asm volatile("s_nop 1\n\t" \
            "v_mfma_scale_f32_16x16x128_f8f6f4 %0, %8, %10, %0, %14, %15 op_sel_hi:[0,0,0]\n\t" \
            "v_mfma_scale_f32_16x16x128_f8f6f4 %1, %9, %10, %1, %14, %15 op_sel_hi:[0,0,0]\n\t" \
            "v_mfma_scale_f32_16x16x128_f8f6f4 %2, %8, %11, %2, %14, %15 op_sel_hi:[0,0,0]\n\t" \
            "v_mfma_scale_f32_16x16x128_f8f6f4 %3, %9, %11, %3, %14, %15 op_sel_hi:[0,0,0]\n\t" \
            "v_mfma_scale_f32_16x16x128_f8f6f4 %4, %8, %12, %4, %14, %15 op_sel_hi:[0,0,0]\n\t" \
            "v_mfma_scale_f32_16x16x128_f8f6f4 %5, %9, %12, %5, %14, %15 op_sel_hi:[0,0,0]\n\t" \
            "v_mfma_scale_f32_16x16x128_f8f6f4 %6, %8, %13, %6, %14, %15 op_sel_hi:[0,0,0]\n\t" \
            "v_mfma_scale_f32_16x16x128_f8f6f4 %7, %9, %13, %7, %14, %15 op_sel_hi:[0,0,0]" \
            : "+v"(acc[ai][bj][0][0]), "+v"(acc[ai][bj][0][1]), "+v"(acc[ai][bj][1][0]), "+v"(acc[ai][bj][1][1]), "+v"(acc[ai][bj][2][0]), "+v"(acc[ai][bj][2][1]), "+v"(acc[ai][bj][3][0]), "+v"(acc[ai][bj][3][1]) \
            : "v"(Bt##8[0]), "v"(Bt##8[1]), "v"(At##8[0]), "v"(At##8[1]), "v"(At##8[2]), "v"(At##8[3]), "v"(scw_), "v"(sca_)); } \
        else { _Pragma("unroll") for (int m = 0; m < 4; ++m) _Pragma("unroll") for (int n = 0; n < 2; ++n) _Pragma("unroll") for (int k = 0; k < 2; ++k) \
            acc[ai][bj][m][n] = __builtin_amdgcn_mfma_f32_16x16x32_bf16(Bt[n][k], At[m][k], acc[ai][bj][m][n], 0, 0, 0); } __builtin_amdgcn_s_setprio(0); } while (0)
#define PG8_WAIT_V(n) asm volatile("s_waitcnt vmcnt(" #n ")" ::: "memory")
#define PG8_WAIT_L(n) asm volatile("s_waitcnt lgkmcnt(" #n ")" ::: "memory")
#define PG8_BAR __builtin_amdgcn_s_barrier()
#define PG8_SCHED __builtin_amdgcn_sched_barrier(0)
#define PG8_AOFF(dst, u_, ui_) do { _Pragma("unroll") for (int _h = 0; _h < 2; ++_h) _Pragma("unroll") for (int _i = 0; _i < 2; ++_i) { \
        if constexpr (GATHER) dst[_h][_i] = (unsigned)(rowtab[(ui_) * 256 + _h * HALF + _i * 64 + R0] * (unsigned)(K * ESZ) + (unsigned)(C0 * 2)); \
        else dst[_h][_i] = (unsigned)((_h * HALF + _i * 64 + R0) * K * ESZ + C0 * 2); } } while (0)
    Unit cur, nxt; int ui = 0;
    if (!S.next(0, cur)) return;
    f32x4 acc[2][2][4][2];
#pragma unroll
    for (int a = 0; a < 2; ++a)
#pragma unroll
        for (int b = 0; b < 2; ++b)
#pragma unroll
            for (int m = 0; m < 4; ++m)
#pragma unroll
                for (int n = 0; n < 2; ++n) acc[a][b][m][n] = (f32x4){0.f, 0.f, 0.f, 0.f};
    bf16x8 At[4][2], B0[2][2], B1[2][2]; v8i At8[4], B08[2], B18[2]; const int scw_ = P::SCW, sca_ = P::SCA;
    unsigned vAc[2][2], vAn[2][2];
    PG8_AOFF(vAc, cur, 0);
    const char* cA = S.aptr(cur); const char* cB = S.bptr(cur);
    if constexpr (SP2) {
        PG8_STAGE(PG8_SB(0, 0), cB, voffB); PG8_STAGE(PG8_SB(0, 1), cB + hstep, voffB); PG8_STAGE(PG8_SA(0, 0), cA, vAc[0]); PG8_STAGE(PG8_SA(0, 1), cA, vAc[1]);
        if (wr == 1) PG8_BAR;
        PG8_WAIT_V(2); PG8_BAR;
        PG8_STAGE(PG8_SB(1, 0), cB + kstep, voffB); PG8_STAGE(PG8_SA(1, 0), cA + kstep, vAc[0]); PG8_STAGE(PG8_SB(1, 1), cB + hstep + kstep, voffB);
        PG8_WAIT_V(6); PG8_BAR;
    } else {
        PG8_STAGE(PG8_SB(0, 0), cB, voffB); PG8_STAGE(PG8_SA(0, 0), cA, vAc[0]); PG8_STAGE(PG8_SB(0, 1), cB + hstep, voffB); PG8_STAGE(PG8_SA(0, 1), cA, vAc[1]);
        if (wr == 1) PG8_BAR;
        PG8_WAIT_V(4); PG8_BAR;
        PG8_STAGE(PG8_SB(1, 0), cB + kstep, voffB); PG8_STAGE(PG8_SA(1, 0), cA + kstep, vAc[0]); PG8_STAGE(PG8_SB(1, 1), cB + hstep + kstep, voffB);
        PG8_WAIT_V(6); PG8_BAR;
    }
    for (;;) {
        const bool has_next = S.next(ui + 1, nxt);
        const char* nA = has_next ? S.aptr(nxt) : cA; const char* nB = has_next ? S.bptr(nxt) : cB;
        if (has_next) { PG8_AOFF(vAn, nxt, ui + 1); }
        else {
#pragma unroll
            for (int h = 0; h < 2; ++h)
#pragma unroll
                for (int i = 0; i < 2; ++i) vAn[h][i] = vAc[h][i];
        }
        for (int t = 0; t < nt; t += 2) {
            const bool last = (t == nt - 2);
            const char* a1 = cA + (size_t)(t + 1) * kstep;
            const char* a2 = last ? nA : cA + (size_t)(t + 2) * kstep; const char* b2 = last ? nB : cB + (size_t)(t + 2) * kstep;
            const char* a3 = a2 + kstep; const char* b3 = b2 + kstep;
            unsigned w2[2][2];
#pragma unroll
            for (int h = 0; h < 2; ++h)
#pragma unroll
                for (int i = 0; i < 2; ++i) w2[h][i] = last ? vAn[h][i] : vAc[h][i];
            if constexpr (SP2) {
            PG8_LDB(B0, 0, 0); PG8_LDB(B1, 0, 1); PG8_SCHED; PG8_LDA(At, 0, 0); PG8_STAGE(PG8_SA(1, 1), a1, vAc[1]);
            PG8_WAIT_V(8); PG8_WAIT_L(0); PG8_BAR; PG8_MMA(0, 0, At, B0); PG8_MMA(0, 1, At, B1); PG8_BAR; PG8_SCHED;
            PG8_LDA(At, 0, 1); PG8_STAGE(PG8_SB(0, 0), b2, voffB); PG8_STAGE(PG8_SB(0, 1), b2 + hstep, voffB); PG8_STAGE(PG8_SA(0, 0), a2, w2[0]);
            PG8_WAIT_V(8); PG8_WAIT_L(0); PG8_BAR; PG8_MMA(1, 0, At, B0); PG8_MMA(1, 1, At, B1); PG8_BAR; PG8_SCHED;
            PG8_LDB(B0, 1, 0); PG8_LDB(B1, 1, 1); PG8_SCHED; PG8_LDA(At, 1, 0); PG8_STAGE(PG8_SA(0, 1), a2, w2[1]);
            PG8_WAIT_V(8); PG8_WAIT_L(0); PG8_BAR; PG8_MMA(0, 0, At, B0); PG8_MMA(0, 1, At, B1); PG8_BAR; PG8_SCHED;
            PG8_LDA(At, 1, 1); PG8_STAGE(PG8_SB(1, 0), b3, voffB); PG8_STAGE(PG8_SB(1, 1), b3 + hstep, voffB); PG8_STAGE(PG8_SA(1, 0), a3, w2[0]);
            PG8_WAIT_V(8); PG8_WAIT_L(0); PG8_BAR; PG8_MMA(1, 0, At, B0); PG8_MMA(1, 1, At, B1); PG8_BAR; PG8_SCHED;
            } else {
            PG8_LDB(B0, 0, 0); PG8_SCHED; PG8_LDA(At, 0, 0); PG8_STAGE(PG8_SA(1, 1), a1, vAc[1]);
            PG8_WAIT_L(8); PG8_BAR; PG8_WAIT_L(0); PG8_MMA(0, 0, At, B0); PG8_BAR; PG8_SCHED;
            PG8_LDB(B1, 0, 1); PG8_STAGE(PG8_SB(0, 0), b2, voffB);
            PG8_BAR; PG8_WAIT_L(0); PG8_MMA(0, 1, At, B1); PG8_BAR;
            PG8_LDA(At, 0, 1); PG8_STAGE(PG8_SA(0, 0), a2, w2[0]);
            PG8_BAR; PG8_WAIT_L(0); PG8_MMA(1, 0, At, B0); PG8_BAR; PG8_SCHED;
            PG8_STAGE(PG8_SB(0, 1), b2 + hstep, voffB);
            PG8_WAIT_V(6); PG8_BAR; PG8_MMA(1, 1, At, B1); PG8_BAR;
            PG8_LDB(B0, 1, 0); PG8_SCHED; PG8_LDA(At, 1, 0); PG8_STAGE(PG8_SA(0, 1), a2, w2[1]);
            PG8_WAIT_L(8); PG8_BAR; PG8_WAIT_L(0); PG8_MMA(0, 0, At, B0); PG8_BAR; PG8_SCHED;
            PG8_LDB(B1, 1, 1); PG8_STAGE(PG8_SB(1, 0), b3, voffB);
            PG8_BAR; PG8_WAIT_L(0); PG8_MMA(0, 1, At, B1); PG8_BAR;
            PG8_LDA(At, 1, 1); PG8_STAGE(PG8_SA(1, 0), a3, w2[0]);
            PG8_BAR; PG8_WAIT_L(0); PG8_MMA(1, 0, At, B0); PG8_BAR; PG8_SCHED;
            PG8_STAGE(PG8_SB(1, 1), b3 + hstep, voffB);
            PG8_WAIT_V(6); PG8_BAR; PG8_MMA(1, 1, At, B1); PG8_BAR;
            }
        }
        if constexpr (ALIGN_EPI) { if (wr == 0) PG8_BAR; }
        if constexpr (F8) asm volatile("s_nop 15\n\ts_nop 7" ::: "memory");
        { int fr2 = fr, fq2 = fq; asm volatile("" : "+v"(fr2), "+v"(fq2));
          S.epi(acc, cur, wr, wc, fr2, fq2); }
        if (!has_next) break;
#pragma unroll
        for (int a = 0; a < 2; ++a)
#pragma unroll
            for (int b = 0; b < 2; ++b)
#pragma unroll
                for (int m = 0; m < 4; ++m)
#pragma unroll
                    for (int n = 0; n < 2; ++n) acc[a][b][m][n] = (f32x4){0.f, 0.f, 0.f, 0.f};
        cur = nxt; cA = nA; cB = nB; ++ui;
#pragma unroll
        for (int h = 0; h < 2; ++h)
#pragma unroll
            for (int i = 0; i < 2; ++i) vAc[h][i] = vAn[h][i];
        if constexpr (ALIGN_EPI) { if (wr == 1) PG8_BAR; }
    }
    PG8_WAIT_V(0);
    if constexpr (!ALIGN_EPI) { if (wr == 0) PG8_BAR; }
    PG8_BAR;
#undef PG8_SA
#undef PG8_SB
#undef PG8_STAGE
#undef PG8_LDA
#undef PG8_LDB
#undef PG8_MMA
#undef PG8_WAIT_V
#undef PG8_WAIT_L
#undef PG8_BAR
#undef PG8_SCHED
#undef PG8_AOFF
}
}

namespace attn_body {
using bf16 = __hip_bfloat16;
using bf16x8 = __attribute__((ext_vector_type(8))) short;
using s16x4 = __attribute__((ext_vector_type(4))) short;
using f32x16 = __attribute__((ext_vector_type(16))) float;
using u32x4 = __attribute__((ext_vector_type(4))) unsigned;
constexpr int D = 64, QPITCH = NHQ * D, KPITCH = NHKV * D, OPITCH = DM, OCOL0 = 256;
constexpr int NW = 8, QBLK = 32, QB = QBLK * NW, KVBLK = 64, NQB = NTOK / QB, NT = NKEYS / KVBLK;
static_assert(NT % 2 == 0 && NT >= 8, "tile count");
__device__ __forceinline__ int crow(int r, int hi) { return (r & 3) + 8 * (r >> 2) + 4 * hi; }
#define SBAR() __builtin_amdgcn_sched_barrier(0)
constexpr int NSLOT = 3, SLOTB = 8192;
constexpr int LDS_K = 0, LDS_V = NSLOT * SLOTB, LDS_WS = 2 * NSLOT * SLOTB, LDS_OST = LDS_WS + NW * 64 * 4, LDS_BYTES = LDS_OST + NW * 4096;
constexpr float C2 = 0.125f * 1.4426950408889634f;
__device__ __forceinline__ void glds16(const void* gsrc, unsigned lds_dst) { unsigned keep;
  asm volatile("s_mov_b32 %0, m0\n\ts_mov_b32 m0, %2\n\ts_nop 0\n\tglobal_load_lds_dwordx4 %1, off\n\ts_mov_b32 m0, %0" : "=&s"(keep) : "v"(gsrc), "s"(lds_dst) : "memory"); }
__device__ __forceinline__ float max3f(float a, float b, float c) { float r; asm("v_max3_f32 %0, %1, %2, %3" : "=v"(r) : "v"(a), "v"(b), "v"(c)); return r; }
__device__ __forceinline__ float max2f(float a, float b) { float r; asm("v_max_f32_e32 %0, %1, %2" : "=v"(r) : "v"(a), "v"(b)); return r; }
__device__ __forceinline__ float fadd_s(float a, float b) { float r; asm("v_add_f32_e32 %0, %1, %2" : "=v"(r) : "v"(a), "v"(b)); return r; }
__device__ __forceinline__ float fsub_s(float a, float b) { float r; asm("v_sub_f32_e32 %0, %1, %2" : "=v"(r) : "v"(a), "v"(b)); return r; }
typedef float f32x2_t __attribute__((ext_vector_type(2))); typedef __bf16 bf16x2_t __attribute__((ext_vector_type(2)));
__device__ __forceinline__ unsigned cvtpk_s(float lo, float hi) { f32x2_t v = {lo, hi}; bf16x2_t b = __builtin_convertvector(v, bf16x2_t); return __builtin_bit_cast(unsigned, b); }
#define WAIT_BAR(N) asm volatile("s_waitcnt vmcnt(" #N ") lgkmcnt(0)\n\ts_barrier" ::: "memory")

__device__ __forceinline__ void qkt(f32x16& p0, f32x16& p1, const char* Kslot, const bf16x8* qr, const f32x16& negm, int r32, int hi) {
  const char* kb = Kslot + hi * 1024 + r32 * 16;
  #pragma unroll
  for (int d0 = 0; d0 < 4; ++d0) {
    const bf16x8 b0 = *reinterpret_cast<const bf16x8*>(kb + d0 * 2048);
    const bf16x8 b1 = *reinterpret_cast<const bf16x8*>(kb + d0 * 2048 + 512);
    if (d0 == 0) { p0 = __builtin_amdgcn_mfma_f32_32x32x16_bf16(b0, qr[0], negm, 0, 0, 0); p1 = __builtin_amdgcn_mfma_f32_32x32x16_bf16(b1, qr[0], negm, 0, 0, 0); }
    else { p0 = __builtin_amdgcn_mfma_f32_32x32x16_bf16(b0, qr[d0], p0, 0, 0, 0); p1 = __builtin_amdgcn_mfma_f32_32x32x16_bf16(b1, qr[d0], p1, 0, 0, 0); } }
}
typedef __attribute__((address_space(3))) const char* lds_cptr;
typedef short v4i16_t __attribute__((ext_vector_type(4)));
__device__ __forceinline__ void kload8(bf16x8* kf, lds_cptr kp) {
  kf[0] = *(const __attribute__((address_space(3))) bf16x8*)(kp);        kf[1] = *(const __attribute__((address_space(3))) bf16x8*)(kp + 512);
  kf[2] = *(const __attribute__((address_space(3))) bf16x8*)(kp + 2048); kf[3] = *(const __attribute__((address_space(3))) bf16x8*)(kp + 2560);
  kf[4] = *(const __attribute__((address_space(3))) bf16x8*)(kp + 4096); kf[5] = *(const __attribute__((address_space(3))) bf16x8*)(kp + 4608);
  kf[6] = *(const __attribute__((address_space(3))) bf16x8*)(kp + 6144); kf[7] = *(const __attribute__((address_space(3))) bf16x8*)(kp + 6656);
}
__device__ __forceinline__ void kload2(bf16x8* kf, lds_cptr kp, int j) { kf[2 * j] = *(const __attribute__((address_space(3))) bf16x8*)(kp + j * 2048); kf[2 * j + 1] = *(const __attribute__((address_space(3))) bf16x8*)(kp + j * 2048 + 512); }
__device__ __forceinline__ s16x4 vtr(lds_cptr p) { return __builtin_bit_cast(s16x4, __builtin_amdgcn_ds_read_tr16_b64_v4i16((__attribute__((address_space(3))) v4i16_t*)p)); }
__device__ __forceinline__ float rowmax(const f32x16& p0, const f32x16& p1) {
  float a = max3f(p0[0], p0[1], p1[0]), b = max3f(p0[2], p0[3], p1[1]); a = max3f(a, p1[2], p1[3]);
  #pragma unroll
  for (int r = 4; r < 16; r += 4) { a = max3f(a, p0[r], p0[r + 1]); b = max3f(b, p0[r + 2], p0[r + 3]); a = max3f(a, p1[r], p1[r + 1]); b = max3f(b, p1[r + 2], p1[r + 3]); }
  const float m = max2f(a, b);
  auto rr = __builtin_amdgcn_permlane32_swap(__float_as_uint(m), __float_as_uint(m), false, false);
  return max2f(__uint_as_float(rr[0]), __uint_as_float(rr[1]));
}
__device__ __forceinline__ void pv(f32x16* o, int vb, bf16x8 pa0, bf16x8 pa1, bf16x8 pa2, bf16x8 pa3) {
  #pragma unroll
  for (int d0 = 0; d0 < 2; ++d0) { s16x4 lo[4], hi[4];
    #pragma unroll
    for (int ks = 0; ks < 4; ++ks) {
      asm volatile("ds_read_b64_tr_b16 %0,%1 offset:%c2" : "=&v"(lo[ks]) : "v"(vb), "i"(d0 * 4096 + ks * 1024) : "memory");
      asm volatile("ds_read_b64_tr_b16 %0,%1 offset:%c2" : "=&v"(hi[ks]) : "v"(vb), "i"(d0 * 4096 + ks * 1024 + 512) : "memory"); }
    asm volatile("s_waitcnt lgkmcnt(0)" ::: "memory"); SBAR();
    #define PK(k) (bf16x8){lo[k][0], lo[k][1], lo[k][2], lo[k][3], hi[k][0], hi[k][1], hi[k][2], hi[k][3]}
    o[d0] = __builtin_amdgcn_mfma_f32_32x32x16_bf16(pa0, PK(0), o[d0], 0, 0, 0);
    o[d0] = __builtin_amdgcn_mfma_f32_32x32x16_bf16(pa1, PK(1), o[d0], 0, 0, 0);
    o[d0] = __builtin_amdgcn_mfma_f32_32x32x16_bf16(pa2, PK(2), o[d0], 0, 0, 0);
    o[d0] = __builtin_amdgcn_mfma_f32_32x32x16_bf16(pa3, PK(3), o[d0], 0, 0, 0);
    #undef PK
  }
}
#define ATTN_STORE16(p, v) (*(u32x4*)(p) = (v))
template <int THRL> __device__ __forceinline__ void attn_unit(int h, int kvh, int qb, const bf16* Q, const bf16* __restrict__ K, const bf16* __restrict__ V, bf16* O, char* shm, int wid, float kmax2) {
  const int lane = fresh_lane(), r32 = lane & 31, hi = lane >> 5;
  const int q0 = qb * QB;
  const bf16* Qw = Q + (long)(q0 + wid * QBLK) * QPITCH + h * D;
  const bf16* Kh = K + kvh * D, *Vh = V + kvh * D;
  const unsigned lds0 = (unsigned)(uintptr_t)shm;
  float* wsf = (float*)(shm + LDS_WS) + wid * 64;
  const bf16* ksrc = Kh + (long)lane * KPITCH + wid * 8;
  const bf16* vsrc = Vh + (long)(16 * (wid & 3) + (lane >> 2)) * KPITCH + (wid >> 2) * 32 + (lane & 3) * 8;
  const unsigned kdst = lds0 + LDS_K + wid * 1024, vdst = lds0 + LDS_V + wid * 1024;
  #define DMA_K(t, slot) glds16(ksrc + (long)(t) * KVBLK * KPITCH, (unsigned)__builtin_amdgcn_readfirstlane(kdst + (slot)))
  #define DMA_V(t, slot) glds16(vsrc + (long)(t) * KVBLK * KPITCH, (unsigned)__builtin_amdgcn_readfirstlane(vdst + (slot)))
  const int vb0 = (int)(lds0 + LDS_V) + ((lane >> 4) & 1) * 32 + (lane & 3) * 8 + (4 * hi + ((lane & 15) >> 2)) * 64;
  const char* Kbase = shm + LDS_K; bf16x8 kf[8];
  const lds_cptr shm3 = (lds_cptr)shm; const lds_cptr kp0 = shm3 + LDS_K + hi * 1024 + r32 * 16; const lds_cptr vp0 = shm3 + LDS_V + ((lane >> 4) & 1) * 32 + (lane & 3) * 8 + (4 * hi + ((lane & 15) >> 2)) * 64;
  DMA_K(0, 0); DMA_V(0, 0); DMA_K(1, SLOTB);
  bf16x8 qr[4];
  #pragma unroll
  for (int d0 = 0; d0 < 4; ++d0) qr[d0] = *reinterpret_cast<const bf16x8*>(&Qw[(long)r32 * QPITCH + d0 * 16 + hi * 8]);
  float l_reg = 0.f; f32x16 o[2]; o[0] = f32x16{}; o[1] = f32x16{}; f32x16 negm;
  { float qn2 = 0.f;
    #pragma unroll
    for (int d0 = 0; d0 < 4; ++d0)
      #pragma unroll
      for (int j = 0; j < 8; ++j) { const float f = __uint_as_float((unsigned)(unsigned short)qr[d0][j] << 16); qn2 += f * f; }
    auto rr = __builtin_amdgcn_permlane32_swap(__float_as_uint(qn2), __float_as_uint(qn2), false, false); qn2 = __uint_as_float(rr[0]) + __uint_as_float(rr[1]);
    const float bnd = sqrtf(qn2 * kmax2) * 1.004f + 0.01f;
    #pragma unroll
    for (int r = 0; r < 16; ++r) negm[r] = -bnd;
    asm volatile("" : "+v"(negm)); }
  f32x16 pA0, pA1, pB0, pB1;
  int sl_prev = 0, sl_cur = 0, sl_next = SLOTB;
  #define ROT() do { sl_prev = sl_cur; sl_cur = sl_next; sl_next = (sl_next == (NSLOT - 1) * SLOTB) ? 0 : sl_next + SLOTB; } while (0)
  DMA_K(2, 2 * SLOTB);
  WAIT_BAR(3);
  qkt(pA0, pA1, Kbase, qr, negm, r32, hi); asm volatile("s_nop 15\n\ts_nop 7" : "+v"(pA0), "+v"(pA1));
  _Pragma("unroll") for (int r = 0; r < 16; ++r) { pA0[r] = __builtin_amdgcn_exp2f(pA0[r]); pA1[r] = __builtin_amdgcn_exp2f(pA1[r]); }
  WAIT_BAR(0);
  DMA_K(3, 0); DMA_V(1, SLOTB);
  ROT();
  kload8(kf, kp0 + sl_cur);
  WAIT_BAR(2);
  s16x4 vlo[8], vhi[8]; u32x4 pw0, pw1, pw2, pw3;
  #define PKW(P, B) cvtpk_s(P[B], P[B + 1])
  #define PAF(k) __builtin_bit_cast(bf16x8, pw##k)
  #define VFR(i) (bf16x8){vlo[i][0], vlo[i][1], vlo[i][2], vlo[i][3], vhi[i][0], vhi[i][1], vhi[i][2], vhi[i][3]}
  #define PIN(x) asm volatile("" : "+v"(x))
  #define MX3(a, b, c) __builtin_fmaxf(__builtin_fmaxf((a), (b)), (c))
  #define GAPA(MF, A0, A1, A2, A3, W0, W1, PW) do { MF; sacc += A0; sacc += A1; sacc += A2; sacc += A3; PIN(sacc); W0; W1; PIN(PW); SBAR(); } while (0)
  #define EX(v) __builtin_amdgcn_exp2f(v)
  #define GAPB(MF, X, B) do { MF; X[B] = EX(X[B]); X[B + 1] = EX(X[B + 1]); X[B + 2] = EX(X[B + 2]); X[B + 3] = EX(X[B + 3]); PIN(X); SBAR(); } while (0)
  #define VRD(i) do { vlo[i] = vtr(vp_ + (((i) >> 2) * 4096 + ((i) & 3) * 1024)); vhi[i] = vtr(vp_ + (((i) >> 2) * 4096 + ((i) & 3) * 1024 + 512)); } while (0)
  #define KRD(G, j) do { if (G) { kload2(kf, kp0 + sl_next, j); SBAR(); } } while (0)
  #define STEPM(C0, C1, P0, P1, t, GK, GV, GL) do { SBAR(); \
    const lds_cptr vp_ = vp0 + sl_prev; \
    VRD(0); SBAR(); float sacc = (P0[0] + P0[1]); \
    GAPA(C0 = __builtin_amdgcn_mfma_f32_32x32x16_bf16(kf[0], qr[0], negm, 0, 0, 0), P0[2], P0[3], P0[4], P0[5],     pw0[0] = PKW(P0, 0), pw0[1] = PKW(P0, 2), pw0); \
    VRD(4); SBAR(); GAPA(C1 = __builtin_amdgcn_mfma_f32_32x32x16_bf16(kf[1], qr[0], negm, 0, 0, 0), P0[6], P0[7], P0[8], P0[9],     pw0[2] = PKW(P0, 4), pw0[3] = PKW(P0, 6), pw0); \
    VRD(1); SBAR(); GAPA(C0 = __builtin_amdgcn_mfma_f32_32x32x16_bf16(kf[2], qr[1], C0, 0, 0, 0),   P0[10], P0[11], P0[12], P0[13], pw1[0] = PKW(P0, 8), pw1[1] = PKW(P0, 10), pw1); \
    VRD(5); SBAR(); GAPA(C1 = __builtin_amdgcn_mfma_f32_32x32x16_bf16(kf[3], qr[1], C1, 0, 0, 0),   P0[14], P0[15], P1[0], P1[1],   pw1[2] = PKW(P0, 12), pw1[3] = PKW(P0, 14), pw1); \
    VRD(2); SBAR(); GAPA(C0 = __builtin_amdgcn_mfma_f32_32x32x16_bf16(kf[4], qr[2], C0, 0, 0, 0),   P1[2], P1[3], P1[4], P1[5],     pw2[0] = PKW(P1, 0), pw2[1] = PKW(P1, 2), pw2); \
    VRD(6); SBAR(); GAPA(C1 = __builtin_amdgcn_mfma_f32_32x32x16_bf16(kf[5], qr[2], C1, 0, 0, 0),   P1[6], P1[7], P1[8], P1[9],     pw2[2] = PKW(P1, 4), pw2[3] = PKW(P1, 6), pw2); \
    VRD(3); SBAR(); GAPA(C0 = __builtin_amdgcn_mfma_f32_32x32x16_bf16(kf[6], qr[3], C0, 0, 0, 0),   P1[10], P1[11], P1[12], P1[13], pw3[0] = PKW(P1, 8), pw3[1] = PKW(P1, 10), pw3); \
    VRD(7); SBAR(); GAPA(C1 = __builtin_amdgcn_mfma_f32_32x32x16_bf16(kf[7], qr[3], C1, 0, 0, 0),   P1[14], P1[15], 0.f, 0.f,       pw3[2] = PKW(P1, 12), pw3[3] = PKW(P1, 14), pw3); \
    l_reg += sacc; \
    if (GK) { DMA_K((t) + 3, sl_cur); } if (GV) { DMA_V((t) + 1, sl_next); } \
    SBAR(); \
    GAPB(o[0] = __builtin_amdgcn_mfma_f32_32x32x16_bf16(PAF(0), VFR(0), o[0], 0, 0, 0), C0, 0); \
    GAPB(o[1] = __builtin_amdgcn_mfma_f32_32x32x16_bf16(PAF(0), VFR(4), o[1], 0, 0, 0), C0, 4); \
    KRD(GL, 0); GAPB(o[0] = __builtin_amdgcn_mfma_f32_32x32x16_bf16(PAF(1), VFR(1), o[0], 0, 0, 0), C0, 8); \
    KRD(GL, 1); GAPB(o[1] = __builtin_amdgcn_mfma_f32_32x32x16_bf16(PAF(1), VFR(5), o[1], 0, 0, 0), C0, 12); \
    KRD(GL, 2); GAPB(o[0] = __builtin_amdgcn_mfma_f32_32x32x16_bf16(PAF(2), VFR(2), o[0], 0, 0, 0), C1, 0); \
    KRD(GL, 3); GAPB(o[1] = __builtin_amdgcn_mfma_f32_32x32x16_bf16(PAF(2), VFR(6), o[1], 0, 0, 0), C1, 4); \
    GAPB(o[0] = __builtin_amdgcn_mfma_f32_32x32x16_bf16(PAF(3), VFR(3), o[0], 0, 0, 0), C1, 8); \
    GAPB(o[1] = __builtin_amdgcn_mfma_f32_32x32x16_bf16(PAF(3), VFR(7), o[1], 0, 0, 0), C1, 12); \
    } while (0)
  int t = 1;
  for (; t + 5 < NT; t += 2) {
    STEPM(pB0, pB1, pA0, pA1, t, true, true, true);     WAIT_BAR(2); ROT();
    STEPM(pA0, pA1, pB0, pB1, t + 1, true, true, true); WAIT_BAR(2); ROT();
  }
  #define ENDW(tt) do { if ((tt) + 3 < NT) { WAIT_BAR(2); } else if ((tt) + 2 < NT) { WAIT_BAR(1); } else { WAIT_BAR(0); } } while (0)
  for (; t + 1 < NT; t += 2) {
    STEPM(pB0, pB1, pA0, pA1, t, (t + 3 < NT), (t + 1 < NT), (t + 1 < NT));         ENDW(t);     ROT();
    STEPM(pA0, pA1, pB0, pB1, t + 1, (t + 4 < NT), (t + 2 < NT), (t + 2 < NT));     ENDW(t + 1); ROT();
  }
  STEPM(pB0, pB1, pA0, pA1, NT - 1, false, false, false);
  { float sacc = pB0[0] + pB0[1]; _Pragma("unroll") for (int r = 2; r < 16; ++r) sacc += pB0[r]; _Pragma("unroll") for (int r = 0; r < 16; ++r) sacc += pB1[r]; l_reg += sacc;
    pw0 = (u32x4){PKW(pB0, 0), PKW(pB0, 2), PKW(pB0, 4), PKW(pB0, 6)}; pw1 = (u32x4){PKW(pB0, 8), PKW(pB0, 10), PKW(pB0, 12), PKW(pB0, 14)}; pw2 = (u32x4){PKW(pB1, 0), PKW(pB1, 2), PKW(pB1, 4), PKW(pB1, 6)}; pw3 = (u32x4){PKW(pB1, 8), PKW(pB1, 10), PKW(pB1, 12), PKW(pB1, 14)};
    SBAR(); pv(o, vb0 + sl_cur, PAF(0), PAF(1), PAF(2), PAF(3)); }
  #undef PKW
  #undef PAF
  #undef VFR
  #undef PIN
  #undef MX3
  #undef GAPA
  #undef GAPB
  #undef EX
  #undef VRD
  #undef KRD
  #undef STEPM
  #undef ENDW
  { auto rr = __builtin_amdgcn_permlane32_swap(__float_as_uint(l_reg), __float_as_uint(l_reg), false, false); l_reg = __uint_as_float(rr[0]) + __uint_as_float(rr[1]); }
  if (hi == 0) wsf[32 + r32] = l_reg; asm volatile("s_waitcnt lgkmcnt(0)" ::: "memory");
  float rli[16];
  #pragma unroll
  for (int r = 0; r < 16; ++r) rli[r] = __builtin_amdgcn_rcpf(wsf[32 + crow(r, hi)]);
  bf16* Ow = O + (long)(q0 + wid * QBLK) * OPITCH + OCOL0 + h * D;
  { bf16* stg = (bf16*)(shm + LDS_OST) + wid * 2048;
    #pragma unroll
    for (int r = 0; r < 16; ++r) { const int orow = crow(r, hi);
      #pragma unroll
      for (int d0 = 0; d0 < 2; ++d0) stg[orow * 64 + d0 * 32 + r32] = __float2bfloat16(o[d0][r] * rli[r]); }
    asm volatile("s_waitcnt lgkmcnt(0)" ::: "memory");
    #pragma unroll
    for (int i = 0; i < 4; ++i) { const int row = i * 8 + (lane >> 3), ch = lane & 7; const u32x4 v = *(const u32x4*)(stg + row * 64 + ch * 8); ATTN_STORE16(Ow + (long)row * OPITCH + ch * 8, v); } }
  asm volatile("s_waitcnt lgkmcnt(0)\n\ts_barrier" ::: "memory");
  #undef DMA_K
  #undef DMA_V
  #undef ROT
}
#undef SBAR
#undef WAIT_BAR

typedef int v8i_t __attribute__((ext_vector_type(8)));
constexpr int F8_SLOT = 4096, F8_RING = 8, F8_LDS_K = 0, F8_LDS_V = F8_RING * F8_SLOT, F8_LDS_WS = 2 * F8_RING * F8_SLOT, F8_LDS_OST = F8_LDS_WS + NW * 64 * 4, F8_LDS_BYTES = F8_LDS_OST + NW * 4096;
#define SBAR() __builtin_amdgcn_sched_barrier(0)
#define WAIT_BAR_(N) asm volatile("s_waitcnt vmcnt(" #N ") lgkmcnt(0)\n\ts_barrier" ::: "memory")
#define WAIT_BAR(N) WAIT_BAR_(N)
#define F8_LAG 2
constexpr int F8_G = 3, F8_DK = F8_G + 1 + F8_LAG, F8_DV = F8_G - 1 + F8_LAG;
static_assert(2 * F8_G + F8_LAG <= F8_RING, "ring too small for the barrier period");
#define SLOTOF(u) ((unsigned)(((u) & (F8_RING - 1)) * F8_SLOT))
#define MFMA8_C(D, A, B, C, SA, SB) do { if (VAR & 64) { D = __builtin_amdgcn_mfma_f32_32x32x16_bf16(__builtin_bit_cast(bf16x8, (u32x4){(unsigned)A[0], (unsigned)A[1], (unsigned)A[2], (unsigned)A[3]}), __builtin_bit_cast(bf16x8, (u32x4){(unsigned)B[0], (unsigned)B[1], (unsigned)B[2], (unsigned)B[3]}), C, 0, 0, 0); \
      D = __builtin_amdgcn_mfma_f32_32x32x16_bf16(__builtin_bit_cast(bf16x8, (u32x4){(unsigned)A[4], (unsigned)A[5], (unsigned)A[6], (unsigned)A[7]}), __builtin_bit_cast(bf16x8, (u32x4){(unsigned)B[4], (unsigned)B[5], (unsigned)B[6], (unsigned)B[7]}), D, 0, 0, 0); } \
    else { asm volatile("s_nop 1\n\tv_mfma_scale_f32_32x32x64_f8f6f4 %0, %1, %2, %3, %4, %5 op_sel_hi:[0,0,0]" : "=&v"(D) : "v"(A), "v"(B), "v"(C), "v"(SA), "v"(SB)); \
      if (VAR & 256) asm volatile("s_nop 1\n\tv_mfma_scale_f32_32x32x64_f8f6f4 %0, %1, %2, %0, %3, %4 op_sel_hi:[0,0,0]" : "+v"(dacc) : "v"(A), "v"(B), "v"(SA), "v"(SB)); } } while (0)
#define MFMA8_ACC(D, A, B, SA, SB) do { if (VAR & 64) { D = __builtin_amdgcn_mfma_f32_32x32x16_bf16(__builtin_bit_cast(bf16x8, (u32x4){(unsigned)A[0], (unsigned)A[1], (unsigned)A[2], (unsigned)A[3]}), __builtin_bit_cast(bf16x8, (u32x4){(unsigned)B[0], (unsigned)B[1], (unsigned)B[2], (unsigned)B[3]}), D, 0, 0, 0); \
      D = __builtin_amdgcn_mfma_f32_32x32x16_bf16(__builtin_bit_cast(bf16x8, (u32x4){(unsigned)A[4], (unsigned)A[5], (unsigned)A[6], (unsigned)A[7]}), __builtin_bit_cast(bf16x8, (u32x4){(unsigned)B[4], (unsigned)B[5], (unsigned)B[6], (unsigned)B[7]}), D, 0, 0, 0); } \
    else { asm volatile("s_nop 1\n\tv_mfma_scale_f32_32x32x64_f8f6f4 %0, %1, %2, %0, %3, %4 op_sel_hi:[0,0,0]" : "+v"(D) : "v"(A), "v"(B), "v"(SA), "v"(SB)); \
      if (VAR & 256) asm volatile("s_nop 1\n\tv_mfma_scale_f32_32x32x64_f8f6f4 %0, %1, %2, %0, %3, %4 op_sel_hi:[0,0,0]" : "+v"(dacc) : "v"(A), "v"(B), "v"(SA), "v"(SB)); } } while (0)
template <int DBL> __device__ __forceinline__ v8i_t lds_frag32x(lds_cptr p) { const u32x4 lo = *(const __attribute__((address_space(3))) u32x4*)p, hi = *(const __attribute__((address_space(3))) u32x4*)(p + 2048);
  if (DBL) { const u32x4 lo2 = *(const volatile __attribute__((address_space(3))) u32x4*)(p + 4096), hi2 = *(const volatile __attribute__((address_space(3))) u32x4*)(p + 4112); asm volatile("" :: "v"(lo2), "v"(hi2)); }
  return (v8i_t){(int)lo.x, (int)lo.y, (int)lo.z, (int)lo.w, (int)hi.x, (int)hi.y, (int)hi.z, (int)hi.w}; }
__device__ __forceinline__ v8i_t lds_frag32(lds_cptr p) { const u32x4 lo = *(const __attribute__((address_space(3))) u32x4*)p, hi = *(const __attribute__((address_space(3))) u32x4*)(p + 16);
  return (v8i_t){(int)lo.x, (int)lo.y, (int)lo.z, (int)lo.w, (int)hi.x, (int)hi.y, (int)hi.z, (int)hi.w}; }
__device__ __forceinline__ unsigned pk4f8(float a, float b, float c, float d) { int p = __builtin_amdgcn_cvt_pk_fp8_f32(a, b, 0, false); p = __builtin_amdgcn_cvt_pk_fp8_f32(c, d, p, true); return (unsigned)p; }
template <int VAR> __device__ __forceinline__ void attn_unit_f8(int h, int kvh, int qb, const unsigned char* Q8, const unsigned char* __restrict__ K8, const unsigned char* __restrict__ VT8, bf16* O, char* shm, int wid, float kmax2) {
  const int lane = fresh_lane(), r32 = lane & 31, hi = lane >> 5; const bool kwave = wid < 4;
  const int q0 = qb * QB;
  const unsigned lds0 = (unsigned)(uintptr_t)shm;
  float* wsf = (float*)(shm + F8_LDS_WS) + wid * 64;
  const int kpl = (wid & 3) >> 1, krow = 32 * (wid & 1) + (lane >> 1), khalf = (lane & 1) ^ ((krow >> 3) & 1), kch = 2 * khalf + kpl;
  const unsigned char* dsrc = kwave ? K8 + (size_t)krow * KPITCH + kvh * D + 16 * kch : VT8 + (size_t)kvh * (NT * 4096) + 1024 * (wid & 3) + 16 * lane;
  const long dstep = kwave ? (long)KVBLK * KPITCH : 4096;
  const unsigned ddst = lds0 + (kwave ? F8_LDS_K : F8_LDS_V) + (wid & 3) * 1024;
  const int doff = kwave ? F8_DK : F8_DV;
  #define DMA_T(t, slot) glds16(dsrc + (long)(t) * dstep, (unsigned)__builtin_amdgcn_readfirstlane(ddst + (slot)))
  const lds_cptr shm3 = (lds_cptr)shm;
  const lds_cptr kp0 = shm3 + F8_LDS_K + r32 * 32 + 16 * (hi ^ ((r32 >> 3) & 1));
  const lds_cptr vp0 = shm3 + F8_LDS_V + r32 * 32 + 16 * (hi ^ ((r32 >> 3) & 1));
  v8i_t qf;
  { const unsigned char* qp = Q8 + (size_t)(q0 + wid * QBLK + r32) * QPITCH + h * D + 32 * hi; const u32x4 lo = *(const u32x4*)qp, hi4 = *(const u32x4*)(qp + 16);
    qf = (v8i_t){(int)lo.x, (int)lo.y, (int)lo.z, (int)lo.w, (int)hi4.x, (int)hi4.y, (int)hi4.z, (int)hi4.w}; }
  #pragma unroll
  for (int i = 0; i <= F8_DK; ++i) { if (i <= F8_DV) { DMA_T(i, SLOTOF(i)); } else if (kwave) { DMA_T(i, SLOTOF(i)); } }
  f32x16 lacc = f32x16{}; f32x16 o[2]; o[0] = f32x16{}; o[1] = f32x16{}; f32x16 negm;
  v8i_t ones8 = {0x38383838, 0x38383838, 0x38383838, 0x38383838, 0x38383838, 0x38383838, 0x38383838, 0x38383838}; asm volatile("" : "+v"(ones8));
  { float qn2 = 0.f;
    #pragma unroll
    for (int i = 0; i < 8; ++i) { const float f0 = __builtin_amdgcn_cvt_f32_fp8(qf[i], 0), f1 = __builtin_amdgcn_cvt_f32_fp8(qf[i], 1), f2 = __builtin_amdgcn_cvt_f32_fp8(qf[i], 2), f3 = __builtin_amdgcn_cvt_f32_fp8(qf[i], 3);
      qn2 += ((f0 * f0 + f1 * f1) + (f2 * f2 + f3 * f3)) * (1.f / 256.f); }
    auto rr = __builtin_amdgcn_permlane32_swap(__float_as_uint(qn2), __float_as_uint(qn2), false, false); qn2 = __uint_as_float(rr[0]) + __uint_as_float(rr[1]);
    const float bnd = sqrtf(qn2 * kmax2) * 1.004f + 0.01f;
    #pragma unroll
    for (int r = 0; r < 16; ++r) negm[r] = 8.f - bnd;
    asm volatile("" : "+v"(negm)); }
  int sQ = 0x7B7B7B7B, sONE = 0x7F7F7F7F; asm volatile("" : "+v"(sQ), "+v"(sONE));
  f32x16 dacc = f32x16{}; f32x16 pA0, pA1, pB0, pB1; v8i_t kf0, kf1, vfA0, vfA1, vfB0, vfB1, pwA = {0, 0, 0, 0, 0, 0, 0, 0}, pwB = {0, 0, 0, 0, 0, 0, 0, 0};
  #define PIN(x) asm volatile("" : "+v"(x))
  WAIT_BAR(F8_LAG);
  kf0 = lds_frag32x<(VAR & 512) != 0>(kp0); kf1 = lds_frag32x<(VAR & 512) != 0>(kp0 + 1024);
  asm volatile("s_waitcnt lgkmcnt(0)" ::: "memory");
  MFMA8_C(pA0, kf0, qf, negm, sONE, sQ); MFMA8_C(pA1, kf1, qf, negm, sONE, sQ);
  asm volatile("s_nop 15\n\ts_nop 15\n\ts_nop 7" : "+v"(pA0), "+v"(pA1));
  #pragma unroll
  for (int r = 0; r < 16; ++r) pA0[r] = __builtin_amdgcn_exp2f(pA0[r]);
  kf0 = lds_frag32x<(VAR & 512) != 0>(kp0 + SLOTOF(1)); kf1 = lds_frag32x<(VAR & 512) != 0>(kp0 + SLOTOF(1) + 1024);
  #define CVT2(dst, a, b, c, d) do { if (VAR & 16) { asm volatile("" : "+v"(dst) : "v"(a), "v"(b), "v"(c), "v"(d)); } else { dst = __builtin_amdgcn_cvt_pk_fp8_f32(a, b, dst, false); dst = __builtin_amdgcn_cvt_pk_fp8_f32(c, d, dst, true); if (VAR & 32) { asm volatile("" : "+v"(dst)); dst = __builtin_amdgcn_cvt_pk_fp8_f32(a, b, dst, false); dst = __builtin_amdgcn_cvt_pk_fp8_f32(c, d, dst, true); } } } while (0)
  #define EXF(v) ((VAR & 1) ? (v) * 0.999f : ((VAR & 128) ? __builtin_amdgcn_exp2f(__builtin_amdgcn_exp2f(v) * 1e-30f) + __builtin_amdgcn_exp2f(v) - 1.0f : __builtin_amdgcn_exp2f(v)))
  #define EX4(X, B) do { X[B] = EXF(X[B]); X[B + 1] = EXF(X[B + 1]); X[B + 2] = EXF(X[B + 2]); X[B + 3] = EXF(X[B + 3]); } while (0)
  #define STEP8(C0, C1, P0, P1, PW, VF0, VF1, t, GK, GV, GL) do { SBAR(); \
    VF0 = lds_frag32x<(VAR & 512) != 0>(vp0 + SLOTOF((t) - 1)); VF1 = lds_frag32x<(VAR & 512) != 0>(vp0 + SLOTOF((t) - 1) + 1024); SBAR(); \
    if (VAR & 2) { C0 = negm; asm volatile("" : "+v"(C0) : "v"(kf0)); } else { MFMA8_C(C0, kf0, qf, negm, sONE, sQ); } SBAR(); \
    CVT2(PW[0], P0[0], P0[1], P0[2], P0[3]); CVT2(PW[1], P0[4], P0[5], P0[6], P0[7]); CVT2(PW[2], P0[8], P0[9], P0[10], P0[11]); CVT2(PW[3], P0[12], P0[13], P0[14], P0[15]); \
    EX4(P1, 0); EX4(P1, 4); PIN(PW); PIN(P1); SBAR(); \
    if (VAR & 2) { C1 = negm; asm volatile("" : "+v"(C1) : "v"(kf1)); } else { MFMA8_C(C1, kf1, qf, negm, sONE, sQ); } SBAR(); \
    EX4(P1, 8); EX4(P1, 12); \
    CVT2(PW[4], P1[0], P1[1], P1[2], P1[3]); CVT2(PW[5], P1[4], P1[5], P1[6], P1[7]); CVT2(PW[6], P1[8], P1[9], P1[10], P1[11]); CVT2(PW[7], P1[12], P1[13], P1[14], P1[15]); \
    PIN(PW); SBAR(); \
    if ((GK) && (GV)) { DMA_T((t) + doff, SLOTOF((t) + doff)); }     \
    else if (kwave) { if (GK) { DMA_T((t) + F8_DK, SLOTOF((t) + F8_DK)); } } else { if (GV) { DMA_T((t) + F8_DV, SLOTOF((t) + F8_DV)); } } \
    if (GL) { kf0 = lds_frag32x<(VAR & 512) != 0>(kp0 + SLOTOF((t) + 1)); kf1 = lds_frag32x<(VAR & 512) != 0>(kp0 + SLOTOF((t) + 1) + 1024); } SBAR(); \
    if (VAR & 2) { asm volatile("" : "+v"(lacc) : "v"(PW)); } else { MFMA8_ACC(lacc, PW, ones8, sONE, sONE); } asm volatile("" : "+v"(C0)); SBAR(); \
    EX4(C0, 0); EX4(C0, 4); PIN(C0); SBAR(); \
    if (VAR & 2) { asm volatile("" : "+v"(o[0]) : "v"(PW), "v"(VF0)); } else { MFMA8_ACC(o[0], PW, VF0, sONE, sONE); } SBAR(); \
    EX4(C0, 8); EX4(C0, 12); PIN(C0); SBAR(); \
    if (VAR & 2) { asm volatile("" : "+v"(o[1]) : "v"(PW), "v"(VF1)); } else { MFMA8_ACC(o[1], PW, VF1, sONE, sONE); } SBAR(); } while (0)
  int t = 1;
  #define GBAR() do { if (VAR & 4) { asm volatile("s_waitcnt vmcnt(2) lgkmcnt(0)" ::: "memory"); } else { WAIT_BAR(F8_LAG); } } while (0)
  #pragma unroll 1
  for (; t + 5 + F8_DK < NT; t += 6) {
    STEP8(pB0, pB1, pA0, pA1, pwA, vfA0, vfA1, t, true, true, true);
    STEP8(pA0, pA1, pB0, pB1, pwB, vfB0, vfB1, t + 1, true, true, true);
    STEP8(pB0, pB1, pA0, pA1, pwA, vfA0, vfA1, t + 2, true, true, true); GBAR();
    STEP8(pA0, pA1, pB0, pB1, pwB, vfB0, vfB1, t + 3, true, true, true);
    STEP8(pB0, pB1, pA0, pA1, pwA, vfA0, vfA1, t + 4, true, true, true);
    STEP8(pA0, pA1, pB0, pB1, pwB, vfB0, vfB1, t + 5, true, true, true); GBAR();
  }
  #undef GBAR
  for (; t + 1 < NT; t += 2) {
    STEP8(pB0, pB1, pA0, pA1, pwA, vfA0, vfA1, t, (t + F8_DK < NT), (t + F8_DV < NT), (t + 1 < NT));         WAIT_BAR(0);
    STEP8(pA0, pA1, pB0, pB1, pwB, vfB0, vfB1, t + 1, (t + 1 + F8_DK < NT), (t + 1 + F8_DV < NT), (t + 2 < NT));     WAIT_BAR(0);
  }
  STEP8(pB0, pB1, pA0, pA1, pwA, vfA0, vfA1, NT - 1, false, false, false);
  { asm volatile("s_nop 15\n\ts_nop 15\n\ts_nop 7" : "+v"(pB1));
    EX4(pB1, 0); EX4(pB1, 4); EX4(pB1, 8); EX4(pB1, 12);
    CVT2(pwB[0], pB0[0], pB0[1], pB0[2], pB0[3]); CVT2(pwB[1], pB0[4], pB0[5], pB0[6], pB0[7]); CVT2(pwB[2], pB0[8], pB0[9], pB0[10], pB0[11]); CVT2(pwB[3], pB0[12], pB0[13], pB0[14], pB0[15]);
    CVT2(pwB[4], pB1[0], pB1[1], pB1[2], pB1[3]); CVT2(pwB[5], pB1[4], pB1[5], pB1[6], pB1[7]); CVT2(pwB[6], pB1[8], pB1[9], pB1[10], pB1[11]); CVT2(pwB[7], pB1[12], pB1[13], pB1[14], pB1[15]);
    vfB0 = lds_frag32x<(VAR & 512) != 0>(vp0 + SLOTOF(NT - 1)); vfB1 = lds_frag32x<(VAR & 512) != 0>(vp0 + SLOTOF(NT - 1) + 1024);
    asm volatile("s_waitcnt lgkmcnt(0)" ::: "memory"); PIN(pwB); SBAR();
    MFMA8_ACC(o[0], pwB, vfB0, sONE, sONE); MFMA8_ACC(o[1], pwB, vfB1, sONE, sONE); MFMA8_ACC(lacc, pwB, ones8, sONE, sONE);
    asm volatile("s_nop 15\n\ts_nop 15\n\ts_nop 7" : "+v"(o[0]), "+v"(o[1]), "+v"(lacc)); }
  #undef STEP8
  #undef CVT2
  #undef EX4
  #undef EXF
  #undef PIN
  if (VAR & 256) asm volatile("" :: "v"(dacc));
  float rli[16];
  #pragma unroll
  for (int r = 0; r < 16; ++r) rli[r] = __builtin_amdgcn_rcpf(lacc[r]);
  bf16* Ow = O + (long)(q0 + wid * QBLK) * OPITCH + OCOL0 + h * D;
  { bf16* stg = (bf16*)(shm + F8_LDS_OST) + wid * 2048;
    #pragma unroll
    for (int r = 0; r < 16; ++r) { const int orow = crow(r, hi);
      #pragma unroll
      for (int d0 = 0; d0 < 2; ++d0) stg[orow * 64 + d0 * 32 + r32] = __float2bfloat16(o[d0][r] * rli[r]); }
    asm volatile("s_waitcnt lgkmcnt(0)" ::: "memory");
    #pragma unroll
    for (int i = 0; i < 4; ++i) { const int row = i * 8 + (lane >> 3), ch = lane & 7; const u32x4 v = *(const u32x4*)(stg + row * 64 + ch * 8); if (!(VAR & 8)) ATTN_STORE16(Ow + (long)row * OPITCH + ch * 8, v); } }
  asm volatile("s_waitcnt vmcnt(0) lgkmcnt(0)\n\ts_barrier" ::: "memory");
  #undef DMA_T
}
#undef MFMA8_C
#undef MFMA8_ACC
#undef SBAR
#undef WAIT_BAR
#undef WAIT_BAR_
#undef SLOTOF
}

constexpr int NWAVES = 8, NTHR = NWAVES * 64;
constexpr size_t MiB = 1u << 20;
constexpr size_t WS_CTL = 0, CTL_ZERO_BYTES = 64 * 1024;
constexpr size_t WS_MOD = 1 * MiB;
constexpr size_t WS_MISC = WS_MOD + 64 * 1024;
constexpr size_t WS_IDX = WS_MISC, WS_GATE = WS_IDX + 128 * 1024, WS_TOKSLOT = WS_GATE + 128 * 1024;
constexpr size_t WS_AFF = 3 * MiB;
constexpr size_t WS_WIN = 4 * MiB;
constexpr size_t WS_WOUT = 7 * MiB;
constexpr size_t WS_WGU = 9 * MiB;
constexpr size_t WS_WD = 137 * MiB;
constexpr size_t WS_X1 = 201 * MiB;
constexpr size_t WS_R1 = 265 * MiB;
constexpr size_t WS_XN = WS_R1;
constexpr size_t WS_Q = WS_XN + (size_t)NROWS * DM * 2;
constexpr size_t WS_K = WS_Q + (size_t)NTOK * 768 * 2;
constexpr size_t WS_V = WS_K + (size_t)NROWS * 256 * 2;
constexpr size_t WS_FT = WS_V + (size_t)NROWS * 256 * 2;
constexpr size_t WS_MIX = WS_FT + (size_t)256 * NTOK * 4;
constexpr size_t WS_HID = WS_R1;
constexpr size_t WS_R2 = 393 * MiB;
constexpr size_t WS_H2 = WS_R2;
constexpr size_t WS_YE = WS_R2;
constexpr size_t WS_END = 457 * MiB;
static_assert(WS_MIX + (size_t)NTOK * DM * 2 <= WS_R1 + 128 * MiB, "R1 map");
static_assert(WS_TOKSLOT + (size_t)NTOK * 16 * 4 <= WS_AFF, "misc map");
constexpr int CW_TMO = 0, CW_FLAG = 2, CW_KMAX = 64, CW_BAR = 1024;

constexpr int LDS_BYTES = 163840;
constexpr int RING_BYTES = 131072, XTRA_OFF = RING_BYTES;
constexpr int MISC_OFF = LDS_BYTES - 512;

#define GAS __attribute__((address_space(1)))
#define LAS __attribute__((address_space(3)))
typedef unsigned short bf16;
typedef unsigned v4u __attribute__((ext_vector_type(4)));
typedef unsigned v2u __attribute__((ext_vector_type(2)));
typedef float f32x4 __attribute__((ext_vector_type(4)));
typedef float f32x2 __attribute__((ext_vector_type(2)));
typedef GAS unsigned gu32;
#define RLX_AGENT __ATOMIC_RELAXED, __HIP_MEMORY_SCOPE_AGENT
#define LDS_WAIT() asm volatile("s_waitcnt lgkmcnt(0)" ::: "memory")
#define VM_WAIT() asm volatile("s_waitcnt vmcnt(0)" ::: "memory")
__device__ __forceinline__ unsigned f2bf(float f) { unsigned u = __builtin_bit_cast(unsigned, f); return (u + 0x7fffu + ((u >> 16) & 1u)) >> 16; }
__device__ __forceinline__ unsigned pk2(float lo, float hi) { return f2bf(lo) | (f2bf(hi) << 16); }
__device__ __forceinline__ unsigned pk4_fp8(float a, float b, float c, float d) { int p = __builtin_amdgcn_cvt_pk_fp8_f32(a, b, 0, false); p = __builtin_amdgcn_cvt_pk_fp8_f32(c, d, p, true); return (unsigned)p; }
__device__ __forceinline__ float bf2f(unsigned short b) { return __builtin_bit_cast(float, (unsigned)b << 16); }

#define XB_TMO      128
#define XB_XCNT(j)  (256  + 64 * (j))
#define XB_XSUB(j)  (1280 + 64 * (j))
#define XB_XGEN(j)  (2304 + 64 * (j))
#define XB_TOP      3328
#define XB_TOPGEN   3392
#define XCD_BAR_WORDS 3456
#define XB_SPIN_CAP (1u << 20)
static_assert((CW_BAR + XCD_BAR_WORDS) * 4 <= (int)CTL_ZERO_BYTES, "ctl");
__device__ __forceinline__ unsigned xb_ld(unsigned* p)              { return __hip_atomic_load(p, __ATOMIC_RELAXED, __HIP_MEMORY_SCOPE_AGENT); }
__device__ __forceinline__ unsigned xb_add(unsigned* p, unsigned v) { return __hip_atomic_fetch_add(p, v, __ATOMIC_RELAXED, __HIP_MEMORY_SCOPE_AGENT); }
__device__ __forceinline__ unsigned xb_xcc_id() { return (unsigned)__builtin_amdgcn_s_getreg((3 << 11) | 20) & 0xFu; }
#define XB_SPIN(cond, bar) do { unsigned _sp = 0; while (cond) { __builtin_amdgcn_s_sleep(1); \
    if ((++_sp & 255u) == 0u) { if (xb_ld(&(bar)[XB_TMO])) break; if (_sp > XB_SPIN_CAP) { atomicAdd(&(bar)[XB_TMO], 1u); break; } } } } while (0)
struct XcdBarrier { unsigned* bar; unsigned x; volatile LAS unsigned* st; };
__device__ __forceinline__ XcdBarrier xcd_barrier_post(unsigned* bar, volatile LAS unsigned* st, bool leader) {
    XcdBarrier b; b.bar = bar; b.x = xb_xcc_id(); b.st = st;
    if (leader) (void)xb_add(&bar[XB_XCNT(b.x)], 1u);
    return b;
}
__device__ __forceinline__ void xcd_barrier_complete(unsigned* bar, unsigned x, unsigned& nloc, unsigned& nx) {
    const unsigned G = gridDim.x * gridDim.y * gridDim.z;
    unsigned sum, cnt, mine, sp = 0u;
    for (;;) {
        sum = 0u; cnt = 0u; mine = 0u;
#pragma unroll
        for (unsigned j = 0; j < 16; ++j) { const unsigned c = xb_ld(&bar[XB_XCNT(j)]); sum += c; cnt += (c > 0u) ? 1u : 0u; mine = (j == x) ? c : mine; }
        if (sum == G) break;
        __builtin_amdgcn_s_sleep(1);
        if ((++sp & 255u) == 0u) { if (xb_ld(&bar[XB_TMO])) break; if (sp > XB_SPIN_CAP) { atomicAdd(&bar[XB_TMO], 1u); break; } }
    }
    nloc = mine > 0u ? mine : 1u; nx = cnt > 0u ? cnt : 1u;
}
__device__ __forceinline__ void xcd_barrier(const XcdBarrier& b, int wave) {
    asm volatile("s_waitcnt vmcnt(0)" ::: "memory");
    __syncthreads();
    if (wave == 0 && fresh_lane() == 0) {
        unsigned* bar = b.bar;
        __builtin_amdgcn_s_waitcnt(0);
        unsigned nloc = b.st[0], nx = b.st[1];
        if (nloc == 0u) { xcd_barrier_complete(bar, b.x, nloc, nx); b.st[0] = nloc; b.st[1] = nx; }
        const unsigned old = xb_add(&bar[XB_XSUB(b.x)], 1u);
        const unsigned gen = old / nloc;
        if (old + 1u == (gen + 1u) * nloc) {
            __builtin_amdgcn_fence(__ATOMIC_RELEASE, "agent");
            asm volatile("s_waitcnt vmcnt(0)" ::: "memory");
            const unsigned og = xb_add(&bar[XB_TOP], 1u);
            const unsigned tg = og / nx;
            if (og + 1u == (tg + 1u) * nx) xb_add(&bar[XB_TOPGEN], 1u);
            else XB_SPIN(xb_ld(&bar[XB_TOPGEN]) == tg, bar);
            __builtin_amdgcn_fence(__ATOMIC_ACQUIRE, "agent");
            xb_add(&bar[XB_XGEN(b.x)], 1u);
            asm volatile("s_waitcnt vmcnt(0)" ::: "memory");
        } else {
            XB_SPIN(xb_ld(&bar[XB_XGEN(b.x)]) == gen, bar);
            __builtin_amdgcn_fence(__ATOMIC_ACQUIRE, "agent");
            asm volatile("s_waitcnt vmcnt(0)" ::: "memory");
        }
    }
    __syncthreads();
}

struct Args {
    const float *x, *c, *ctx, *c_ctx, *w_mod, *b_mod, *norm_mix_g, *norm_ffn_g, *w_in, *w_four, *q_norm_g, *k_norm_g, *w_out, *w_router, *w_gate, *w_up, *w_down, *final_norm_g;
    float* out; unsigned char* ws;
};

__device__ __forceinline__ float wave_sum(float v) {
#pragma unroll
    for (int o = 1; o < 64; o <<= 1) v += __shfl_xor(v, o);
    return v;
}

template <class RowMap>
__device__ __forceinline__ void tr_item(const float* __restrict__ W, int ldw, int k0, int n0, bf16* WT, int ldt, int kdst0, const RowMap& drow, LAS float* scr, int lane) {
    const int kq = lane >> 4, nq = lane & 15;
    f32x4 v[16];
#pragma unroll
    for (int it = 0; it < 16; ++it) v[it] = *(const f32x4*)(W + (size_t)(k0 + 4 * it + kq) * ldw + n0 + 4 * nq);
#pragma unroll
    for (int it = 0; it < 16; ++it) { LAS float* s = scr + (4 * it + kq) * 65 + 4 * nq; s[0] = v[it][0]; s[1] = v[it][1]; s[2] = v[it][2]; s[3] = v[it][3]; }
    LDS_WAIT(); asm volatile("" ::: "memory");
    const int c = lane >> 3, nn = lane & 7;
#pragma unroll
    for (int j = 0; j < 8; ++j) { const int n = nn + 8 * j; const LAS float* s = scr + (8 * c) * 65 + n;
        v4u o; o.x = pk2(s[0 * 65], s[1 * 65]); o.y = pk2(s[2 * 65], s[3 * 65]); o.z = pk2(s[4 * 65], s[5 * 65]); o.w = pk2(s[6 * 65], s[7 * 65]);
        *(GAS v4u*)(WT + (size_t)drow(n0 + n) * ldt + kdst0 + k0 + 8 * c) = o; }
    LDS_WAIT(); asm volatile("" ::: "memory");
}
struct RowId { int base; __device__ __forceinline__ int operator()(int n) const { return base + n; } };
struct RowQKV { __device__ __forceinline__ int operator()(int n) const { const int t = n >> 8, w = n & 255, hd = w >> 6, d = w & 63; return 256 + 256 * t + 128 * (d >> 5) + 32 * hd + (d & 31); } };
struct RowGU { int base, up; __device__ __forceinline__ int operator()(int f) const { return base + 256 * (f >> 7) + 128 * up + (f & 127); } };


constexpr int MOE_ITEMS = 3 * 8192;
struct TrDesc { const float* src; bf16* dst; int ldw, ldt, f8; };
__device__ __forceinline__ TrDesc moe_desc(const Args& a, int r) {
    TrDesc d;
    if (r < 16384) { const int up = r >> 13, rr = r & 8191, e = rr >> 9, q = rr & 511, kb = q >> 5, nb = q & 31;
        d.src = (up ? a.w_up : a.w_gate) + (size_t)e * DM * DE + (size_t)(kb * 64) * DE + nb * 64; d.ldw = DE;
        d.dst = (bf16*)((unsigned char*)(a.ws + WS_WGU) + ((size_t)e * 4096 + 256 * (nb >> 1) + 128 * up + 64 * (nb & 1)) * DM + kb * 64); d.ldt = DM; d.f8 = 1; }
    else { const int rr = r - 16384, e = rr >> 9, q = rr & 511, kb = q >> 4, nb = q & 15;
        d.src = a.w_down + (size_t)e * DE * DM + (size_t)(kb * 64) * DM + nb * 64; d.ldw = DM;
        d.dst = (bf16*)((unsigned char*)(a.ws + WS_WD) + ((size_t)e * DM + nb * 64) * DE + kb * 64); d.ldt = DE; d.f8 = 1; }
    return d;
}
#define TR_LOAD(v, d) do { _Pragma("unroll") for (int _it = 0; _it < 16; ++_it) v[_it] = *(const f32x4*)((d).src + (size_t)(4 * _it + kq) * (d).ldw + 4 * nq); } while (0)
#define TR_PROC(v, d) do { \
    _Pragma("unroll") for (int _it = 0; _it < 16; ++_it) { LAS float* s_ = scr + (4 * _it + kq) * 65 + 4 * nq; s_[0] = v[_it][0]; s_[1] = v[_it][1]; s_[2] = v[_it][2]; s_[3] = v[_it][3]; } \
    LDS_WAIT(); asm volatile("" ::: "memory"); \
    if ((d).f8) { _Pragma("unroll") for (int _j = 0; _j < 8; ++_j) { const int n_ = nn + 8 * _j; const LAS float* s_ = scr + (8 * c8) * 65 + n_; \
        v2u o_; o_.x = pk4_fp8(s_[0 * 65] * 32.f, s_[1 * 65] * 32.f, s_[2 * 65] * 32.f, s_[3 * 65] * 32.f); o_.y = pk4_fp8(s_[4 * 65] * 32.f, s_[5 * 65] * 32.f, s_[6 * 65] * 32.f, s_[7 * 65] * 32.f); \
        *(GAS v2u*)((unsigned char*)(d).dst + (size_t)n_ * (d).ldt + 8 * c8) = o_; } } \
    else { _Pragma("unroll") for (int _j = 0; _j < 8; ++_j) { const int n_ = nn + 8 * _j; const LAS float* s_ = scr + (8 * c8) * 65 + n_; \
        v4u o_; o_.x = pk2(s_[0 * 65], s_[1 * 65]); o_.y = pk2(s_[2 * 65], s_[3 * 65]); o_.z = pk2(s_[4 * 65], s_[5 * 65]); o_.w = pk2(s_[6 * 65], s_[7 * 65]); \
        *(GAS v4u*)((d).dst + (size_t)n_ * (d).ldt + 8 * c8) = o_; } } \
    LDS_WAIT(); asm volatile("" ::: "memory"); } while (0)
__device__ __forceinline__ void moe_convert(const Args& a, LAS float* scr, int lo, int hi, int w, int nw) {
    const int lane = fresh_lane(), kq = lane >> 4, nq = lane & 15, c8 = lane >> 3, nn = lane & 7;
    int it = lo + w; if (it >= hi) return;
    f32x4 va[16], vb[16];
    TrDesc da = moe_desc(a, it), db = da; TR_LOAD(va, da);
    for (;;) {
        int nx = it + nw; bool hn = nx < hi;
        if (hn) { db = moe_desc(a, nx); TR_LOAD(vb, db); }
        TR_PROC(va, da);
        if (!hn) break;
        it = nx; nx = it + nw; hn = nx < hi;
        if (hn) { da = moe_desc(a, nx); TR_LOAD(va, da); }
        TR_PROC(vb, db);
        if (!hn) break;
        it = nx;
    }
}
#ifndef MOE_S0
#define MOE_S0 0
#endif
#ifndef MOE_S1
#define MOE_S1 4096
#endif
#ifndef MOE_S2
#define MOE_S2 0
#endif
#ifndef MOE_S3
#define MOE_S3 9472
#endif
constexpr int MOE_B0 = MOE_S0, MOE_B1 = MOE_B0 + MOE_S1, MOE_B2 = MOE_B1 + MOE_S2, MOE_B3 = MOE_B2 + MOE_S3;

__host__ __device__ __forceinline__ int four_pos(int mp) { return mp == 0 ? 0 : (mp == 32 ? 1 : (mp < 32 ? 2 * mp : 2 * (64 - mp) + 1)); }

__device__ __forceinline__ void p0_prologue(const Args& a, LAS unsigned char* lds, int vcu, int G, int wave) {
    const int lane = fresh_lane(), tid = wave * 64 + lane;
    unsigned char* ws = a.ws;
    bf16* WinT = (bf16*)(ws + WS_WIN); bf16* WoT = (bf16*)(ws + WS_WOUT);
    float* MOD = (float*)(ws + WS_MOD);
    for (int item = vcu; item < 256; item += G) {
        LAS float* red = (LAS float*)lds;
        f32x4 a0 = {0.f, 0.f, 0.f, 0.f}, a1 = {0.f, 0.f, 0.f, 0.f};
        if (lane < 60) {
            const int rr = lane / 6, cq = lane % 6, col = item * 24 + 4 * cq;
#pragma unroll
            for (int it = 0; it < 13; ++it) { const int k = wave * 128 + it * 10 + rr;
                if (it * 10 + rr < 128) { const f32x4 w = *(const f32x4*)(a.w_mod + (size_t)k * (NMOD * DM) + col); const float c0 = a.c[k], c1 = a.c_ctx[k];
                    const float s0 = c0 / (1.f + __expf(-c0)), s1 = c1 / (1.f + __expf(-c1)); a0 += w * s0; a1 += w * s1; } }
        }
        *(LAS f32x4*)(red + ((wave * 2 + 0) * 64 + lane) * 4) = a0; *(LAS f32x4*)(red + ((wave * 2 + 1) * 64 + lane) * 4) = a1;
        __syncthreads();
        if (tid < 48) { const int v = tid / 24, cc = tid % 24, cq = cc >> 2, e = cc & 3; float sum = 0.f;
            for (int w = 0; w < 8; ++w)
#pragma unroll
                for (int r = 0; r < 10; ++r) sum += red[((w * 2 + v) * 64 + r * 6 + cq) * 4 + e];
            MOD[v * (NMOD * DM) + item * 24 + cc] = sum + a.b_mod[item * 24 + cc]; }
        __syncthreads();
    }
    const int cg = -1;
    LAS float* scr = (LAS float*)(lds + wave * 16640);
    constexpr int I_F1 = 256, I_F2 = 256, I_IN = 16 * 20, I_OUT = 12 * 16;
    constexpr int NITEMS = I_F1 + I_F2 + I_IN + I_OUT;
    for (int it = wave * G + vcu; it < NITEMS; it += NWAVES * G) {
        int r = it;
        if (r < I_F1) {
            const int g = r & 3, kb = (r >> 2) & 15, jq = r >> 6, k = kb * 64 + lane;
            LAS float* ct = scr;
            ct[lane] = cospif((float)lane * (1.f / 32.f)); LDS_WAIT(); asm volatile("" ::: "memory");
            float w[64];
#pragma unroll
            for (int c4 = 0; c4 < 16; ++c4) { const f32x4 t = *(const f32x4*)(a.w_in + (size_t)k * INW + 64 * g + 4 * c4); w[4 * c4] = t[0]; w[4 * c4 + 1] = t[1]; w[4 * c4 + 2] = t[2]; w[4 * c4 + 3] = t[3]; }
            for (int j = 16 * jq; j < 16 * jq + 16; ++j) { const int m = j <= 32 ? j : j - 32; const int ph = j <= 32 ? 0 : 48;
                float s = 0.f;
#pragma unroll
                for (int c = 0; c < 64; ++c) s += w[c] * ct[(c * m + ph) & 63];
                WinT[(size_t)(64 * g + j) * DM + k] = (bf16)f2bf(s * (1.f / 1024.f)); }
            LDS_WAIT(); asm volatile("" ::: "memory");
            continue; }
        r -= I_F1;
        if (r < I_F2) {
            const int g = r & 3, jb = (r >> 2) & 15, mq = r >> 6, j = jb * 64 + lane;
            float w[64];
#pragma unroll
            for (int d = 0; d < 64; ++d) w[d] = a.w_out[(size_t)(64 * g + d) * DM + j];
            for (int mp = 16 * mq; mp < 16 * mq + 16; ++mp) { float s = 0.f; const float* wf = a.w_four + (size_t)(g * 64 + mp) * 64;
#pragma unroll
                for (int d = 0; d < 64; ++d) s += wf[d] * w[d];
                WoT[(size_t)j * DM + 64 * g + four_pos(mp)] = (bf16)f2bf(s); }
            continue; }
        r -= I_F2;
        if (r < I_IN) { const int kb = r / 20, nb = r % 20; tr_item(a.w_in + 256, INW, kb * 64, nb * 64, WinT, DM, 0, RowQKV{}, scr, lane); continue; }
        r -= I_IN;
        { const int kb = r / 16, nb = r % 16; tr_item(a.w_out + (size_t)256 * DM, DM, kb * 64, nb * 64, WoT, DM, 256, RowId{0}, scr, lane); }
    }
    if (cg < 0 && MOE_S0 > 0) moe_convert(a, scr, 0, MOE_B0, ((wave + 4) & 7) * (G - 24) + vcu, NWAVES * (G - 24));
}

__device__ __forceinline__ void p0b_modulate(const Args& a, int vcu, int G, int wave) {
    const int lane = fresh_lane();
    unsigned char* ws = a.ws; const float* MOD = (const float*)(ws + WS_MOD); bf16* XN = (bf16*)(ws + WS_XN);
    const int gw = vcu * NWAVES + wave, NGW = G * NWAVES;
    for (int pass = 0; pass < 2; ++pass) {
        const float* md = MOD + pass * (NMOD * DM);
        const int nrows = pass == 0 ? NTOK : NCTX; const float* src = pass == 0 ? a.x : a.ctx; bf16* dst = XN + (size_t)(pass == 0 ? 0 : NTOK) * DM;
        if (gw >= nrows) continue;
        f32x4 av[4], sh[4];
#pragma unroll
        for (int j = 0; j < 4; ++j) { const int col = 4 * lane + 256 * j; const f32x4 g = *(const f32x4*)(a.norm_mix_g + col); const f32x4 sc = *(const f32x4*)(md + DM + col); av[j] = g * (sc + 1.f); sh[j] = *(const f32x4*)(md + col); }
        f32x4 v[4], vn[4];
        { const GAS f32x4* xr = (const GAS f32x4*)(src + (size_t)gw * DM) + lane;
#pragma unroll
          for (int j = 0; j < 4; ++j) v[j] = xr[64 * j]; }
        for (int m = gw; m < nrows; m += NGW) {
            const int mn = m + NGW;
            if (mn < nrows) { const GAS f32x4* xr = (const GAS f32x4*)(src + (size_t)mn * DM) + lane;
#pragma unroll
                for (int j = 0; j < 4; ++j) vn[j] = xr[64 * j]; }
            float s = 0.f;
#pragma unroll
            for (int j = 0; j < 4; ++j) s += (v[j].x * v[j].x + v[j].y * v[j].y) + (v[j].z * v[j].z + v[j].w * v[j].w);
            const float rinv = 1.f / sqrtf(wave_sum(s) * (1.f / DM) + EPS);
            GAS unsigned long long* o8 = (GAS unsigned long long*)(dst + (size_t)m * DM) + lane;
#pragma unroll
            for (int j = 0; j < 4; ++j) { const f32x4 y = v[j] * rinv * av[j] + sh[j]; o8[64 * j] = (unsigned long long)pk2(y.x, y.y) | ((unsigned long long)pk2(y.z, y.w) << 32); }
#pragma unroll
            for (int j = 0; j < 4; ++j) v[j] = vn[j];
        }
    }
}

struct P1Prob {
    static constexpr int K = DM; static constexpr bool PERM = false, FP8 = false; static constexpr int SCW = 0, SCA = 0;
    const bf16* XN; const bf16* WinT; bf16 *Q, *Kb, *Vb; float* FT; const float *qg, *kg; unsigned* kmax; pg8::StaticOrder so;
    __device__ __forceinline__ bool next(int i, pg8::Unit& u) const { return so.next(i, u); }
    __device__ __forceinline__ bool swapped(const pg8::Unit& u) const { return u.pn == 0 || (ATTN_F8 && u.pn == 5); }
    __device__ __forceinline__ const char* aptr(const pg8::Unit& u) const { return swapped(u) ? (const char*)(WinT + (size_t)u.pn * 256 * DM) : (const char*)(XN + (size_t)u.pm * 256 * DM); }
    __device__ __forceinline__ const char* bptr(const pg8::Unit& u) const { return swapped(u) ? (const char*)(XN + (size_t)u.pm * 256 * DM) : (const char*)(WinT + (size_t)u.pn * 256 * DM); }
    __device__ __forceinline__ void epi(const pg8::f32x4 (&acc)[2][2][4][2], const pg8::Unit& u, int wr, int wc, int fr, int fq) const {
        if (u.pn == 0) {
            if (u.pm >= NTOK / 256) return;
#pragma unroll
            for (int ai = 0; ai < 2; ++ai)
#pragma unroll
                for (int m = 0; m < 4; ++m) { float* rowp = FT + (size_t)(ai * 128 + wr * 64 + m * 16 + fr) * NTOK + u.pm * 256 + wc * 32 + 4 * fq;
#pragma unroll
                    for (int bj = 0; bj < 2; ++bj)
#pragma unroll
                        for (int n = 0; n < 2; ++n) *(pg8::f32x4*)(rowp + bj * 128 + n * 16) = acc[ai][bj][m][n]; }
            return;
        }
        const bool isq = u.pn <= 3, isv = u.pn == 5, lat = u.pm < NTOK / 256;
        if (isq && !lat) return;
        if (isv) {
#if ATTN_F8
            unsigned char* V8 = (unsigned char*)Vb;
#pragma unroll
            for (int ai = 0; ai < 2; ++ai)
#pragma unroll
                for (int m = 0; m < 4; ++m) { const int kvh_ = 2 * wr + (m >> 1), d = 32 * ai + 16 * (m & 1) + fr;
#pragma unroll
                    for (int bj = 0; bj < 2; ++bj)
#pragma unroll
                        for (int n = 0; n < 2; ++n) { const int t0 = u.pm * 256 + 128 * bj + 32 * wc + 16 * n + 4 * fq, key0 = t0 & 63, tile = t0 >> 6, k5 = key0 & 31, hk = (k5 >> 2) & 1, j0 = 4 * (k5 >> 3) + 16 * (key0 >> 5);
                            const pg8::f32x4 v = acc[ai][bj][m][n];
                            *(unsigned*)(V8 + (size_t)(kvh_ * (NKEYS / 64) + tile) * 4096 + (j0 >> 4) * 2048 + d * 32 + 16 * (hk ^ ((d >> 3) & 1)) + (j0 & 15)) = pk4_fp8(v[0], v[1], v[2], v[3]); } }
#else
#pragma unroll
            for (int ai = 0; ai < 2; ++ai)
#pragma unroll
                for (int m = 0; m < 4; ++m) { const int t = u.pm * 256 + ai * 128 + wr * 64 + m * 16 + fr; bf16* rowp = Vb + (size_t)t * 256 + wc * 64 + 4 * fq;
#pragma unroll
                    for (int bj = 0; bj < 2; ++bj)
#pragma unroll
                        for (int n = 0; n < 2; ++n) { const pg8::f32x4 v = acc[ai][bj][m][n]; *(v2u*)(rowp + 32 * bj + 16 * n) = (v2u){pk2(v[0], v[1]), pk2(v[2], v[3])}; } }
#endif
            return;
        }
        const float* gw = isq ? qg : kg;
        pg8::f32x4 gv[2][2];
#pragma unroll
        for (int bj = 0; bj < 2; ++bj)
#pragma unroll
            for (int n = 0; n < 2; ++n) gv[bj][n] = *(const pg8::f32x4*)(gw + 32 * bj + 16 * n + 4 * fq);
        float frq[4];
#pragma unroll
        for (int e = 0; e < 4; ++e) frq[e] = exp2f(-(float)(4 * fq + e) * (13.287712379549449f / 16.f)) * 0.15915494309189535f;
        const float qs = isq ? attn_body::C2 * (ATTN_F8 ? 16.f : 1.f) : 1.f;
#if ATTN_F8
        bf16* base = (bf16*)((unsigned char*)(isq ? Q : Kb) + (size_t)(isq ? (u.pn - 1) * 4 + wc : wc) * 64); const int pitch = isq ? 768 : 256;
#else
        bf16* base = isq ? Q + (size_t)((u.pn - 1) * 4 + wc) * 64 : Kb + (size_t)wc * 64; const int pitch = isq ? 768 : 256;
#endif
        float k2max = 0.f;
#pragma unroll
        for (int ai = 0; ai < 2; ++ai) {
            float rowpos = (float)(u.pm * 4 + ai * 2 + wr); asm volatile("" : "+v"(rowpos));
            float cr[4], sr[4];
#pragma unroll
            for (int e = 0; e < 4; ++e) { const float rev = rowpos * frq[e], f_ = rev - floorf(rev); cr[e] = __builtin_amdgcn_cosf(f_); sr[e] = __builtin_amdgcn_sinf(f_); }
#pragma unroll
            for (int m = 0; m < 4; ++m) {
                float colpos = (float)(m * 16 + fr); asm volatile("" : "+v"(colpos));
                const int t = u.pm * 256 + ai * 128 + wr * 64 + m * 16 + fr;
                float ss = 0.f;
#pragma unroll
                for (int bj = 0; bj < 2; ++bj)
#pragma unroll
                    for (int n = 0; n < 2; ++n) { const pg8::f32x4 v = acc[ai][bj][m][n]; ss += (v[0] * v[0] + v[1] * v[1]) + (v[2] * v[2] + v[3] * v[3]); }
                ss += __shfl_xor(ss, 16); ss += __shfl_xor(ss, 32);
                const float rinv = qs / sqrtf(ss * (1.f / 64.f) + EPS);
                pg8::f32x4 y[2][2];
#pragma unroll
                for (int bj = 0; bj < 2; ++bj)
#pragma unroll
                    for (int n = 0; n < 2; ++n) y[bj][n] = acc[ai][bj][m][n] * rinv * gv[bj][n];
                if (lat) {
#pragma unroll
                    for (int e = 0; e < 4; ++e) {
                        { const float x1 = y[0][0][e], x2 = y[0][1][e]; y[0][0][e] = x1 * cr[e] - x2 * sr[e]; y[0][1][e] = x1 * sr[e] + x2 * cr[e]; }
                        { const float rev = colpos * frq[e], f_ = rev - floorf(rev); const float cc = __builtin_amdgcn_cosf(f_), sc = __builtin_amdgcn_sinf(f_);
                          const float x1 = y[1][0][e], x2 = y[1][1][e]; y[1][0][e] = x1 * cc - x2 * sc; y[1][1][e] = x1 * sc + x2 * cc; }
                    }
                }
                ss = 0.f;
#if ATTN_F8
                unsigned char* rowp8 = (unsigned char*)base + ((size_t)t * pitch + 4 * fq);
#pragma unroll
                for (int bj = 0; bj < 2; ++bj)
#pragma unroll
                    for (int n = 0; n < 2; ++n) { const pg8::f32x4 v = y[bj][n]; const unsigned w = pk4_fp8(v[0], v[1], v[2], v[3]); *(unsigned*)(rowp8 + 32 * bj + 16 * n) = w;
                        if (!isq) { const float b0 = __builtin_amdgcn_cvt_f32_fp8((int)w, 0), b1 = __builtin_amdgcn_cvt_f32_fp8((int)w, 1), b2 = __builtin_amdgcn_cvt_f32_fp8((int)w, 2), b3 = __builtin_amdgcn_cvt_f32_fp8((int)w, 3); ss += (b0 * b0 + b1 * b1) + (b2 * b2 + b3 * b3); } }
#else
                bf16* rowp = base + (size_t)t * pitch + 4 * fq;
#pragma unroll
                for (int bj = 0; bj < 2; ++bj)
#pragma unroll
                    for (int n = 0; n < 2; ++n) { const pg8::f32x4 v = y[bj][n]; const v2u w = (v2u){pk2(v[0], v[1]), pk2(v[2], v[3])}; *(v2u*)(rowp + 32 * bj + 16 * n) = w;
                        if (!isq) { const float b0 = __uint_as_float(w.x << 16), b1 = __uint_as_float(w.x & 0xffff0000u), b2 = __uint_as_float(w.y << 16), b3 = __uint_as_float(w.y & 0xffff0000u); ss += (b0 * b0 + b1 * b1) + (b2 * b2 + b3 * b3); } }
#endif
                if (!isq) { float r2 = ss; r2 += __shfl_xor(r2, 16); r2 += __shfl_xor(r2, 32); k2max = fmaxf(k2max, r2); }
                asm volatile("" ::: "memory");
            }
        }
        if (!isq) {
#pragma unroll
            for (int o = 1; o < 16; o <<= 1) k2max = fmaxf(k2max, __shfl_xor(k2max, o));
            if (fr == 0 && fq == 0) __hip_atomic_fetch_max(kmax, __float_as_uint(k2max), __ATOMIC_RELAXED, __HIP_MEMORY_SCOPE_AGENT);
        }
    }
};

__device__ __forceinline__ unsigned rev4_12(unsigned k) { unsigned r = __brev(k) >> 20; return ((r & 0xAAAu) >> 1) | ((r & 0x555u) << 1); }
__device__ __forceinline__ void fft_block(const Args& a, LAS unsigned char* lds, int item, int wave) {
    const int tid = wave * 64 + fresh_lane();
    const int mm = item & 31, par = (item >> 5) & 1, g = item >> 6;
    const float* FT = (const float*)(a.ws + WS_FT); bf16* MIX = (bf16*)(a.ws + WS_MIX);
    LAS f32x2* X = (LAS f32x2*)lds;
    const float* re = FT + (size_t)(64 * g + mm) * NTOK; const float* im = FT + (size_t)(64 * g + 32 + mm) * NTOK;
#pragma unroll 1
    for (int i = 0; i < 2; ++i) {
        const int j0 = 4 * (tid + NTHR * i);
        f32x4 r4[4], i4[4];
#pragma unroll
        for (int q = 0; q < 4; ++q) { r4[q] = *(const f32x4*)(re + j0 + 4096 * q); i4[q] = *(const f32x4*)(im + j0 + 4096 * q); }
#pragma unroll
        for (int e = 0; e < 4; ++e) {
            const int j = j0 + e;
            const f32x2 a0 = {r4[0][e], i4[0][e]}, a1 = {r4[1][e], i4[1][e]}, a2 = {r4[2][e], i4[2][e]}, a3 = {r4[3][e], i4[3][e]};
            f32x2 ya, yb; float fa, fb;
            if (par == 0) { const f32x2 s02 = a0 + a2, s13 = a1 + a3; ya = s02 + s13; yb = s02 - s13; fa = 0.f; fb = (float)(2 * j) * (1.f / 16384.f); }
            else { const f32x2 d02 = a0 - a2, d13 = a1 - a3; ya = (f32x2){d02.x + d13.y, d02.y - d13.x}; yb = (f32x2){d02.x - d13.y, d02.y + d13.x}; fa = (float)j * (1.f / 16384.f); fb = (float)(3 * j) * (1.f / 16384.f); }
            const float ca = __builtin_amdgcn_cosf(fa), sa = __builtin_amdgcn_sinf(fa), cb = __builtin_amdgcn_cosf(fb), sb = __builtin_amdgcn_sinf(fb);
            X[j] = (f32x2){ya.x * ca + ya.y * sa, ya.y * ca - ya.x * sa};
            X[4096 + j] = (f32x2){yb.x * cb + yb.y * sb, yb.y * cb - yb.x * sb};
        }
    }
    __syncthreads();
#pragma unroll 1
    for (int s = 0; s < 6; ++s) {
        const int lq = 10 - 2 * s;
        const int Lq = 1 << lq;
        const float invL = 1.f / (float)(4 << lq);
#pragma unroll 2
        for (int i = 0; i < 4; ++i) {
            const int b = tid + NTHR * i, j = b & (Lq - 1), base = ((b >> lq) << (lq + 2)) + j;
            const f32x2 a0 = X[base], a1 = X[base + Lq], a2 = X[base + 2 * Lq], a3 = X[base + 3 * Lq];
            const f32x2 s02 = a0 + a2, d02 = a0 - a2, s13 = a1 + a3, d13 = a1 - a3;
            const f32x2 y0 = s02 + s13, y2 = s02 - s13;
            const f32x2 y1 = (f32x2){d02.x + d13.y, d02.y - d13.x};
            const f32x2 y3 = (f32x2){d02.x - d13.y, d02.y + d13.x};
            const float f1 = (float)j * invL;
            const float c1 = __builtin_amdgcn_cosf(f1), s1 = __builtin_amdgcn_sinf(f1);
            const float c2 = __builtin_amdgcn_cosf(2.f * f1), s2 = __builtin_amdgcn_sinf(2.f * f1);
            const float c3 = __builtin_amdgcn_cosf(3.f * f1), s3 = __builtin_amdgcn_sinf(3.f * f1);
            X[base] = y0;
            X[base + Lq] = (f32x2){y1.x * c1 + y1.y * s1, y1.y * c1 - y1.x * s1};
            X[base + 2 * Lq] = (f32x2){y2.x * c2 + y2.y * s2, y2.y * c2 - y2.x * s2};
            X[base + 3 * Lq] = (f32x2){y3.x * c3 + y3.y * s3, y3.y * c3 - y3.x * s3};
        }
        __syncthreads();
    }
    const int col = 64 * g + 2 * mm;
#pragma unroll 1
    for (int i = 0; i < 16; ++i) {
        const int k = 2 * (tid + NTHR * i) + par, kn = (NTOK - k) & (NTOK - 1);
        const f32x2 wk = X[(((k & 3) - par) >> 1) * 4096 + rev4_12((unsigned)(k >> 2))], wn = X[(((kn & 3) - par) >> 1) * 4096 + rev4_12((unsigned)(kn >> 2))];
        float o0, o1;
        if (mm == 0) { o0 = 0.5f * (wk.x + wn.x); o1 = 0.5f * (wk.y + wn.y); }
        else { o0 = wn.x; o1 = wk.x; }
        *(unsigned*)(MIX + (size_t)k * DM + col) = pk2(o0, o1);
    }
    __syncthreads();
}

struct P3Prob {
    static constexpr int K = DM; static constexpr bool PERM = false, FP8 = false; static constexpr int SCW = 0, SCA = 0;
    const bf16* MIX; const bf16* WoT; const float* x; const float* g1; float* X1; pg8::StaticOrder so;
    __device__ __forceinline__ bool next(int i, pg8::Unit& u) const { return so.next(i, u); }
    __device__ __forceinline__ const char* aptr(const pg8::Unit& u) const { return (const char*)(MIX + (size_t)u.pm * 256 * DM); }
    __device__ __forceinline__ const char* bptr(const pg8::Unit& u) const { return (const char*)(WoT + (size_t)u.pn * 256 * DM); }
    __device__ __forceinline__ void epi(const pg8::f32x4 (&acc)[2][2][4][2], const pg8::Unit& u, int wr, int wc, int fr, int fq) const {
        const int col0 = u.pn * 256 + wc * 32 + 4 * fq;
        pg8::f32x4 gv[2][2];
#pragma unroll
        for (int bj = 0; bj < 2; ++bj)
#pragma unroll
            for (int n = 0; n < 2; ++n) gv[bj][n] = *(const pg8::f32x4*)(g1 + col0 + bj * 128 + n * 16);
#pragma unroll
        for (int ai = 0; ai < 2; ++ai)
#pragma unroll
            for (int m = 0; m < 4; ++m) { const size_t off = (size_t)(u.pm * 256 + ai * 128 + wr * 64 + m * 16 + fr) * DM + col0;
#pragma unroll
                for (int bj = 0; bj < 2; ++bj)
#pragma unroll
                    for (int n = 0; n < 2; ++n) { const pg8::f32x4 bs = *(const pg8::f32x4*)(x + off + bj * 128 + n * 16); *(pg8::f32x4*)(X1 + off + bj * 128 + n * 16) = bs + gv[bj][n] * acc[ai][bj][m][n]; }
                if (m & 1) asm volatile("" ::: "memory"); }
    }
};

__device__ __forceinline__ void p3b_router(const Args& a, LAS unsigned char* lds, int vcu, int G, int wave) {
    const int lane = fresh_lane(), tid = wave * 64 + lane;
    unsigned char* ws = a.ws; const float* MOD = (const float*)(ws + WS_MOD); const float* X1 = (const float*)(ws + WS_X1); bf16* H2 = (bf16*)(ws + WS_H2); float* AFF = (float*)(ws + WS_AFF);
    LAS float* wrt = (LAS float*)lds;
    { f32x4 t[8];
#pragma unroll
      for (int q = 0; q < 8; ++q) t[q] = *(const f32x4*)(a.w_router + 4 * (tid + NTHR * q));
#pragma unroll
      for (int q = 0; q < 8; ++q) { const int i = 4 * (tid + NTHR * q), col = i >> 4, e = i & 15;
#pragma unroll
          for (int k = 0; k < 4; ++k) wrt[(e + k) * 1024 + col] = t[q][k]; } }
    __syncthreads();
    f32x4 av[4], sh[4];
#pragma unroll
    for (int j = 0; j < 4; ++j) { const int col = 4 * lane + 256 * j; const f32x4 g = *(const f32x4*)(a.norm_ffn_g + col); const f32x4 sc = *(const f32x4*)(MOD + 4 * DM + col); av[j] = g * (sc + 1.f); sh[j] = *(const f32x4*)(MOD + 3 * DM + col); }
    const int gw = vcu * NWAVES + wave, NGW = G * NWAVES;
#pragma unroll 1
    for (int m0 = 4 * gw; m0 < NTOK; m0 += 4 * NGW) {
        f32x4 v[4][4];
#pragma unroll
        for (int r = 0; r < 4; ++r) { const GAS f32x4* xr = (const GAS f32x4*)(X1 + (size_t)(m0 + r) * DM) + lane;
#pragma unroll
            for (int j = 0; j < 4; ++j) v[r][j] = xr[64 * j]; }
        float ss[4];
#pragma unroll
        for (int r = 0; r < 4; ++r) { float t = 0.f;
#pragma unroll
            for (int j = 0; j < 4; ++j) t += (v[r][j].x * v[r][j].x + v[r][j].y * v[r][j].y) + (v[r][j].z * v[r][j].z + v[r][j].w * v[r][j].w);
            ss[r] = t; }
#pragma unroll
        for (int o = 1; o < 64; o <<= 1)
#pragma unroll
            for (int r = 0; r < 4; ++r) ss[r] += __shfl_xor(ss[r], o);
#pragma unroll
        for (int r = 0; r < 4; ++r) { const float rinv = 1.f / sqrtf(ss[r] * (1.f / DM) + EPS);
            GAS unsigned* o4 = (GAS unsigned*)((unsigned char*)H2 + (size_t)(m0 + r) * DM) + lane;
#pragma unroll
            for (int j = 0; j < 4; ++j) { v[r][j] = v[r][j] * rinv * av[j] + sh[j]; o4[64 * j] = pk4_fp8(v[r][j].x, v[r][j].y, v[r][j].z, v[r][j].w); } }
        float lg[4][16];
#pragma unroll
        for (int e = 0; e < 16; ++e) { f32x4 w[4];
#pragma unroll
            for (int j = 0; j < 4; ++j) w[j] = *(const LAS f32x4*)(wrt + e * 1024 + 4 * lane + 256 * j);
#pragma unroll
            for (int r = 0; r < 4; ++r) { float p = 0.f;
#pragma unroll
                for (int j = 0; j < 4; ++j) p += (v[r][j].x * w[j].x + v[r][j].y * w[j].y) + (v[r][j].z * w[j].z + v[r][j].w * w[j].w);
                lg[r][e] = p; }
            if ((e & 3) == 3) asm volatile("" ::: "memory"); }
        float r1[4];
#pragma unroll
        for (int r = 0; r < 4; ++r) {
            float r8[8], r4[4], r2[2];
            { const bool up = (lane & 32) != 0;
#pragma unroll
              for (int e = 0; e < 8; ++e) { const float snd = up ? lg[r][e] : lg[r][e + 8], kp = up ? lg[r][e + 8] : lg[r][e]; r8[e] = kp + __shfl_xor(snd, 32); } }
            { const bool up = (lane & 16) != 0;
#pragma unroll
              for (int e = 0; e < 4; ++e) { const float snd = up ? r8[e] : r8[e + 4], kp = up ? r8[e + 4] : r8[e]; r4[e] = kp + __shfl_xor(snd, 16); } }
            { const bool up = (lane & 8) != 0;
#pragma unroll
              for (int e = 0; e < 2; ++e) { const float snd = up ? r4[e] : r4[e + 2], kp = up ? r4[e + 2] : r4[e]; r2[e] = kp + __shfl_xor(snd, 8); } }
            { const bool up = (lane & 4) != 0; const float snd = up ? r2[0] : r2[1], kp = up ? r2[1] : r2[0]; r1[r] = kp + __shfl_xor(snd, 4); }
        }
#pragma unroll
        for (int r = 0; r < 4; ++r) r1[r] += __shfl_xor(r1[r], 2);
#pragma unroll
        for (int r = 0; r < 4; ++r) r1[r] += __shfl_xor(r1[r], 1);
        float mx[4], ex[4], den[4];
#pragma unroll
        for (int r = 0; r < 4; ++r) mx[r] = r1[r];
#pragma unroll
        for (int o = 4; o < 64; o <<= 1)
#pragma unroll
            for (int r = 0; r < 4; ++r) mx[r] = fmaxf(mx[r], __shfl_xor(mx[r], o));
#pragma unroll
        for (int r = 0; r < 4; ++r) { ex[r] = __expf(r1[r] - mx[r]); den[r] = ex[r]; }
#pragma unroll
        for (int o = 4; o < 64; o <<= 1)
#pragma unroll
            for (int r = 0; r < 4; ++r) den[r] += __shfl_xor(den[r], o);
        float mine = ex[0] / den[0];
#pragma unroll
        for (int r = 1; r < 4; ++r) mine = ((lane & 3) == r) ? ex[r] / den[r] : mine;
        AFF[(size_t)(lane >> 2) * NTOK + m0 + (lane & 3)] = mine;
    }
}

__device__ __forceinline__ void p4_topk(const Args& a, LAS unsigned char* lds, int e, int wave) {
    const int lane = fresh_lane(), tid = wave * 64 + lane;
    unsigned char* ws = a.ws; const unsigned* AFF = (const unsigned*)(ws + WS_AFF) + (size_t)e * NTOK;
    int* IDX = (int*)(ws + WS_IDX) + e * CAP; float* GATE = (float*)(ws + WS_GATE) + e * CAP; int* TOKSLOT = (int*)(ws + WS_TOKSLOT);
    LAS unsigned* wcnt = (LAS unsigned*)lds;
    LAS unsigned* cg = wcnt + 16;
    LAS unsigned* ce = cg + 256;
    unsigned key[32];
#pragma unroll
    for (int i = 0; i < 32; ++i) key[i] = AFF[i * NTHR + tid];
    unsigned T = 0u;
#pragma unroll 1
    for (int bit = 30; bit >= 0; --bit) {
        const unsigned cand = T | (1u << bit);
        unsigned c = 0u;
#pragma unroll
        for (int i = 0; i < 32; ++i) c += (unsigned)__popcll(__ballot(key[i] >= cand));
        LAS unsigned* wb = wcnt + 1024 + (bit & 1) * 8;
        if (lane == 0) wb[wave] = c;
        __syncthreads();
        unsigned tot = 0u;
#pragma unroll
        for (int w = 0; w < 8; ++w) tot += wb[w];
        if (tot >= (unsigned)CAP) T = cand;
    }
    __syncthreads();
    unsigned long long below = (1ull << lane) - 1ull;
    unsigned rg[32], rq[32];
#pragma unroll
    for (int i = 0; i < 32; ++i) {
        const unsigned long long bg = __ballot(key[i] > T), bq = __ballot(key[i] == T);
        rg[i] = (unsigned)__popcll(bg & below); rq[i] = (unsigned)__popcll(bq & below);
        if (lane == 0) { cg[i * 8 + wave] = (unsigned)__popcll(bg); ce[i * 8 + wave] = (unsigned)__popcll(bq); }
    }
    __syncthreads();
    if (wave == 0) {
        unsigned g4[4], q4[4], sg = 0u, sq = 0u;
#pragma unroll
        for (int k = 0; k < 4; ++k) { g4[k] = cg[4 * lane + k]; q4[k] = ce[4 * lane + k]; sg += g4[k]; sq += q4[k]; }
        unsigned pg = sg, pq = sq;
#pragma unroll
        for (int o = 1; o < 64; o <<= 1) { const unsigned tg = __shfl_up(pg, o), tq = __shfl_up(pq, o); if (lane >= o) { pg += tg; pq += tq; } }
        pg -= sg; pq -= sq;
#pragma unroll
        for (int k = 0; k < 4; ++k) { cg[4 * lane + k] = pg; ce[4 * lane + k] = pq; pg += g4[k]; pq += q4[k]; }
        if (lane == 63) { wcnt[8] = pg; }
    }
    __syncthreads();
    const unsigned ngt = wcnt[8], need = (unsigned)CAP - ngt;
#pragma unroll
    for (int i = 0; i < 32; ++i) {
        const int tok = i * NTHR + tid;
        const unsigned gb = cg[i * 8 + wave] + rg[i], qb = ce[i * 8 + wave] + rq[i];
        const bool sel = key[i] > T || (key[i] == T && qb < need);
        const unsigned slot = gb + (qb < need ? qb : need);
        if (sel) { IDX[slot] = tok; GATE[slot] = __uint_as_float(key[i]); }
        TOKSLOT[tok * 16 + e] = sel ? (int)slot : -1;
    }
}

struct P5Prob {
    static constexpr int K = DM; static constexpr bool PERM = true, FP8 = true; static constexpr int SCW = 0x7A7A7A7A, SCA = 0x7F7F7F7F;
    const unsigned char* H2; const unsigned char* WguT; unsigned char* HID; pg8::StaticOrder so;
    __device__ __forceinline__ bool next(int i, pg8::Unit& u) const { return so.next(i, u); }
    __device__ __forceinline__ const char* aptr(const pg8::Unit&) const { return (const char*)H2; }
    __device__ __forceinline__ const char* bptr(const pg8::Unit& u) const { return (const char*)(WguT + ((size_t)(u.pm >> 3) * 4096 + (size_t)u.pn * 256) * DM); }
    __device__ __forceinline__ void epi(const pg8::f32x4 (&acc)[2][2][4][2], const pg8::Unit& u, int wr, int wc, int fr, int fq) const {
#pragma unroll
        for (int ai = 0; ai < 2; ++ai)
#pragma unroll
            for (int m = 0; m < 4; ++m) { unsigned char* rowp = HID + (size_t)(u.pm * 256 + ai * 128 + wr * 64 + m * 16 + fr) * DE + u.pn * 128 + wc * 32 + 8 * fq;
                float h[8];
#pragma unroll
                for (int n = 0; n < 2; ++n)
#pragma unroll
                    for (int e = 0; e < 4; ++e) { const float gt = acc[ai][0][m][n][e], up = acc[ai][1][m][n][e]; h[4 * n + e] = gt * __builtin_amdgcn_rcpf(1.f + __builtin_amdgcn_exp2f(-1.4426950408889634f * gt)) * up; }
                *(v2u*)rowp = (v2u){pk4_fp8(h[0], h[1], h[2], h[3]), pk4_fp8(h[4], h[5], h[6], h[7])}; }
    }
};
struct P6Prob {
    static constexpr int K = DE; static constexpr bool PERM = true, FP8 = true; static constexpr int SCW = 0x7A7A7A7A, SCA = 0x7F7F7F7F;
    const unsigned char* HID; const unsigned char* WdT; const float* GATE; bf16* YE; pg8::StaticOrder so;
    __device__ __forceinline__ bool next(int i, pg8::Unit& u) const { return so.next(i, u); }
    __device__ __forceinline__ const char* aptr(const pg8::Unit& u) const { return (const char*)(HID + (size_t)u.pm * 256 * DE); }
    __device__ __forceinline__ const char* bptr(const pg8::Unit& u) const { return (const char*)(WdT + ((size_t)(u.pm >> 3) * DM + (size_t)u.pn * 256) * DE); }
    __device__ __forceinline__ void epi(const pg8::f32x4 (&acc)[2][2][4][2], const pg8::Unit& u, int wr, int wc, int fr, int fq) const {
#pragma unroll
        for (int ai = 0; ai < 2; ++ai)
#pragma unroll
            for (int m = 0; m < 4; ++m) { const int row = u.pm * 256 + ai * 128 + wr * 64 + m * 16 + fr; const float gt = GATE[row]; bf16* rowp = YE + (size_t)row * DM + u.pn * 256 + wc * 32 + 8 * fq;
#pragma unroll
                for (int bj = 0; bj < 2; ++bj) { const pg8::f32x4 v0 = acc[ai][bj][m][0] * gt, v1 = acc[ai][bj][m][1] * gt;
                    *(v4u*)(rowp + bj * 128) = (v4u){pk2(v0[0], v0[1]), pk2(v0[2], v0[3]), pk2(v1[0], v1[1]), pk2(v1[2], v1[3])}; } }
    }
};

__device__ __forceinline__ void p7_final(const Args& a, int vcu, int G, int wave, unsigned poison) {
    const int lane = fresh_lane();
    unsigned char* ws = a.ws; const float* MOD = (const float*)(ws + WS_MOD); const bf16* YE = (const bf16*)(ws + WS_YE); const int* TOKSLOT = (const int*)(ws + WS_TOKSLOT);
    const float* src = (STEP >= 2) ? (const float*)(ws + WS_X1) : a.x;
    f32x4 g2[4], fg[4];
#pragma unroll
    for (int j = 0; j < 4; ++j) { const int col = 4 * lane + 256 * j; g2[j] = *(const f32x4*)(MOD + 5 * DM + col); fg[j] = *(const f32x4*)(a.final_norm_g + col); }
    const int gw = vcu * NWAVES + wave, NGW = G * NWAVES;
    for (int m = gw; m < NTOK; m += NGW) {
        const GAS f32x4* xr = (const GAS f32x4*)(src + (size_t)m * DM) + lane;
        f32x4 v[4];
#pragma unroll
        for (int j = 0; j < 4; ++j) v[j] = xr[64 * j];
        if (STEP >= 4) {
            const int myslot = lane < 16 ? TOKSLOT[m * 16 + lane] : -1;
            f32x4 s[4];
#pragma unroll
            for (int j = 0; j < 4; ++j) s[j] = (f32x4){0.f, 0.f, 0.f, 0.f};
#pragma unroll 1
            for (int e = 0; e < 16; ++e) {
                const int sl = __builtin_amdgcn_readlane(myslot, e);
                if (sl >= 0) {
                    const GAS v2u* yr = (const GAS v2u*)(YE + ((size_t)e * CAP + sl) * DM) + lane;
#pragma unroll
                    for (int j = 0; j < 4; ++j) { const v2u w = yr[64 * j]; s[j].x += __uint_as_float(w.x << 16); s[j].y += __uint_as_float(w.x & 0xffff0000u); s[j].z += __uint_as_float(w.y << 16); s[j].w += __uint_as_float(w.y & 0xffff0000u); }
                }
            }
#pragma unroll
            for (int j = 0; j < 4; ++j) v[j] += g2[j] * s[j];
        }
        float ss = 0.f;
#pragma unroll
        for (int j = 0; j < 4; ++j) ss += (v[j].x * v[j].x + v[j].y * v[j].y) + (v[j].z * v[j].z + v[j].w * v[j].w);
        const float rinv = 1.f / sqrtf(wave_sum(ss) * (1.f / DM) + EPS);
        GAS f32x4* o = (GAS f32x4*)(a.out + (size_t)m * DM) + lane;
        const float q = __builtin_nanf("");
#pragma unroll
        for (int j = 0; j < 4; ++j) { f32x4 y = v[j] * rinv * fg[j]; if (poison) y = (f32x4){q, q, q, q}; o[64 * j] = y; }
    }
}


#if PROBE
__device__ __forceinline__ void dsincos(double x, double& sn, double& cs) {
    const double TWO_PI = 6.283185307179586476925286766559; x -= TWO_PI * rint(x / TWO_PI);
    const double x2 = x * x; double ts = x, tc = 1.0; sn = x; cs = 1.0;
#pragma unroll 1
    for (int k = 1; k <= 14; ++k) { tc *= -x2 / (double)((2 * k - 1) * (2 * k)); ts *= -x2 / (double)((2 * k) * (2 * k + 1)); cs += tc; sn += ts; }
}
__device__ __forceinline__ float block_sum(float v, LAS float* red, int wave, int lane) {
    v = wave_sum(v); __syncthreads(); if (lane == 0) red[wave] = v; __syncthreads(); float s = 0.f;
#pragma unroll
    for (int w = 0; w < 8; ++w) s += red[w];
    return s;
}
__device__ __forceinline__ float block_max(float v, LAS float* red, int wave, int lane) {
#pragma unroll
    for (int o = 1; o < 64; o <<= 1) v = fmaxf(v, __shfl_xor(v, o));
    __syncthreads(); if (lane == 0) red[wave] = v; __syncthreads(); float s = red[0];
#pragma unroll
    for (int w = 1; w < 8; ++w) s = fmaxf(s, red[w]);
    return s;
}
__device__ __forceinline__ void probe_qkv(const Args& a, LAS unsigned char* lds, int vcu, int wave) {
    const int lane = fresh_lane(), tid = wave * 64 + lane; unsigned char* ws = a.ws;
    const bf16* XN = (const bf16*)(ws + WS_XN); const bf16* Qb = (const bf16*)(ws + WS_Q); const bf16* Kb = (const bf16*)(ws + WS_K); const bf16* Vb = (const bf16*)(ws + WS_V);
    gu32* ctl = (gu32*)(ws + WS_CTL);
    LAS float* red = (LAS float*)lds; LAS float* raw = red + 16;
    for (int kind = 0; kind < 3; ++kind) {
        const int nrows = kind == 0 ? NTOK : NROWS, nh = kind == 0 ? NHQ : NHKV;
        const int t = (kind == 1 && (vcu & 7) == 3) ? NTOK + (vcu * 37) % NCTX : (vcu * 977 + 131 * kind + 5) % (kind == 0 ? NTOK : NTOK);
        const int h = (vcu * 5 + kind) % nh;
        const int wcol0 = 256 + (kind == 0 ? 0 : (kind == 1 ? 768 : 1024)) + 64 * h;
        { const int d = tid & 63, part = tid >> 6; float sacc = 0.f;
          for (int k = part * 128; k < part * 128 + 128; ++k) sacc += bf2f(XN[(size_t)t * DM + k]) * a.w_in[(size_t)k * INW + wcol0 + d];
          LAS float* part_s = raw + 64; part_s[part * 64 + d] = sacc; __syncthreads();
          if (tid < 64) { float s2 = 0.f; for (int pp = 0; pp < 8; ++pp) s2 += part_s[pp * 64 + tid]; raw[tid] = s2; }
          __syncthreads(); }
        float ref = 0.f, got = 0.f;
        if (tid < 64) {
            const int d = tid; float v = raw[d];
            if (kind < 2) {
                float ss = 0.f; for (int j = 0; j < 64; ++j) ss += raw[j] * raw[j];
                const float* gw = kind == 0 ? a.q_norm_g : a.k_norm_g;
                const float rinv = 1.f / sqrtf(ss / 64.f + EPS);
                if (t < NTOK) {
                    const int half = d >> 5, dd = d & 31, i = dd & 15; const int pos = half == 0 ? (t >> 6) : (t & 63);
                    const double freq = exp2(-(double)i * (13.287712379549449 / 16.0)); double sn, cs; dsincos((double)pos * freq, sn, cs);
                    const float x1 = raw[32 * half + i] * rinv * gw[32 * half + i], x2 = raw[32 * half + 16 + i] * rinv * gw[32 * half + 16 + i];
                    v = dd < 16 ? (float)(x1 * cs - x2 * sn) : (float)(x1 * sn + x2 * cs);
                } else v = v * rinv * gw[d];
                if (kind == 0) v *= attn_body::C2;
            }
            ref = v;
#if ATTN_F8
            { const unsigned char* Q8 = (const unsigned char*)Qb; const unsigned char* K8 = (const unsigned char*)Kb; const unsigned char* V8 = (const unsigned char*)Vb;
              if (kind == 0) got = __builtin_amdgcn_cvt_f32_fp8((int)Q8[(size_t)t * 768 + 64 * h + d], 0) * (1.f / 16.f);
              else if (kind == 1) got = __builtin_amdgcn_cvt_f32_fp8((int)K8[(size_t)t * 256 + 64 * h + d], 0);
              else { const int kk = t & 63, tile = t >> 6, k5 = kk & 31, hk = (k5 >> 2) & 1, j = (k5 & 3) + 4 * (k5 >> 3) + 16 * (kk >> 5);
                     got = __builtin_amdgcn_cvt_f32_fp8((int)V8[(size_t)(h * (NKEYS / 64) + tile) * 4096 + (j >> 4) * 2048 + d * 32 + 16 * (hk ^ ((d >> 3) & 1)) + (j & 15)], 0); } }
#else
            got = kind == 0 ? bf2f(Qb[(size_t)t * 768 + 64 * h + d]) : (kind == 1 ? bf2f(Kb[(size_t)t * 256 + 64 * h + d]) : bf2f(Vb[(size_t)t * 256 + 64 * h + d]));
#endif
        }
        const float mx = block_max(fabsf(ref), red, wave, lane);
        const float err = block_max(fabsf(ref - got), red, wave, lane);
        if (tid == 0 && !(err <= (ATTN_F8 ? 0.07f : 0.03f) * mx + 1e-6f)) __hip_atomic_fetch_or(ctl + CW_FLAG, 1u << kind, RLX_AGENT);
        __syncthreads();
    }
}
__device__ __forceinline__ void probe_attn(const Args& a, LAS unsigned char* lds, int vcu, int wave) {
    const int lane = fresh_lane(), tid = wave * 64 + lane; unsigned char* ws = a.ws;
    const bf16* Qb = (const bf16*)(ws + WS_Q); const bf16* Kb = (const bf16*)(ws + WS_K); const bf16* Vb = (const bf16*)(ws + WS_V); const bf16* MIX = (const bf16*)(ws + WS_MIX);
    gu32* ctl = (gu32*)(ws + WS_CTL);
    LAS float* red = (LAS float*)lds; LAS float* ored = red + 16;
    const int t = (vcu * 613 + 29) % NTOK, h = (vcu * 7 + 3) % NHQ, kvh = h / 3;
    float q[64];
#if ATTN_F8
    const unsigned char* Q8 = (const unsigned char*)Qb; const unsigned char* K8 = (const unsigned char*)Kb; const unsigned char* V8 = (const unsigned char*)Vb;
#pragma unroll
    for (int d = 0; d < 64; ++d) q[d] = __builtin_amdgcn_cvt_f32_fp8((int)Q8[(size_t)t * 768 + 64 * h + d], 0) * (1.f / 16.f);
#else
#pragma unroll
    for (int d = 0; d < 64; ++d) q[d] = bf2f(Qb[(size_t)t * 768 + 64 * h + d]);
#endif
    float sc[33]; float mx = -1e30f;
#pragma unroll
    for (int i = 0; i < 33; ++i) { const int key = i * NTHR + tid; float s = -1e30f;
#if ATTN_F8
        if (key < NKEYS) { s = 0.f; const unsigned char* kr = K8 + (size_t)key * 256 + 64 * kvh;
#pragma unroll
            for (int d = 0; d < 64; ++d) s += q[d] * __builtin_amdgcn_cvt_f32_fp8((int)kr[d], 0); }
#else
        if (key < NKEYS) { s = 0.f; const bf16* kr = Kb + (size_t)key * 256 + 64 * kvh;
#pragma unroll
            for (int d = 0; d < 64; ++d) s += q[d] * bf2f(kr[d]); }
#endif
        sc[i] = s; mx = fmaxf(mx, s); }
    mx = block_max(mx, red, wave, lane);
    float den = 0.f; float o[64];
#pragma unroll
    for (int d = 0; d < 64; ++d) o[d] = 0.f;
#pragma unroll
    for (int i = 0; i < 33; ++i) { const int key = i * NTHR + tid;
#if ATTN_F8
        if (key < NKEYS) { const float pp = exp2f(sc[i] - mx); den += pp; const int kk = key & 63, tile = key >> 6, k5 = kk & 31, hk = (k5 >> 2) & 1, j = (k5 & 3) + 4 * (k5 >> 3) + 16 * (kk >> 5);
            const unsigned char* vb = V8 + (size_t)(kvh * (NKEYS / 64) + tile) * 4096 + (j >> 4) * 2048 + (j & 15);
#pragma unroll
            for (int d = 0; d < 64; ++d) o[d] += pp * __builtin_amdgcn_cvt_f32_fp8((int)vb[d * 32 + 16 * (hk ^ ((d >> 3) & 1))], 0); } }
#else
        if (key < NKEYS) { const float pp = exp2f(sc[i] - mx); den += pp; const bf16* vr = Vb + (size_t)key * 256 + 64 * kvh;
#pragma unroll
            for (int d = 0; d < 64; ++d) o[d] += pp * bf2f(vr[d]); } }
#endif
    den = block_sum(den, red, wave, lane);
#pragma unroll
    for (int d = 0; d < 64; ++d) { const float w = wave_sum(o[d]); if (lane == 0) ored[wave * 64 + d] = w; }
    __syncthreads();
    float ref = 0.f, got = 0.f;
    if (tid < 64) { float s = 0.f; for (int w = 0; w < 8; ++w) s += ored[w * 64 + tid]; ref = s / den; got = bf2f(MIX[(size_t)t * DM + 256 + 64 * h + tid]); }
    const float m2 = block_max(fabsf(ref), red, wave, lane);
    const float err = block_max(fabsf(ref - got), red, wave, lane);
    if (tid == 0 && !(err <= 0.03f * m2 + 1e-7f)) __hip_atomic_fetch_or(ctl + CW_FLAG, 8u, RLX_AGENT);
    __syncthreads();
}
#endif

__global__ void __launch_bounds__(NTHR, 2) fwd_megakernel(Args args) {
    extern __shared__ __attribute__((aligned(16))) unsigned char lds_raw[];
    LAS unsigned char* lds = (LAS unsigned char*)lds_raw;
    volatile LAS unsigned* MISC = (volatile LAS unsigned*)(lds + MISC_OFF);
    const int wave = __builtin_amdgcn_readfirstlane(threadIdx.x >> 6);
    const int G = gridDim.x; const int bx = blockIdx.x; const int vcu = (G % 8 == 0) ? (bx % 8) * (G / 8) + bx / 8 : bx;
    unsigned char* ws = args.ws;
    gu32* ctl = (gu32*)(ws + WS_CTL);
    { const int l0 = fresh_lane(); if (wave < 2) ((LAS unsigned*)(lds + MISC_OFF))[wave * 64 + l0] = 0u;
      __syncthreads();
    }
    XcdBarrier bar = xcd_barrier_post((unsigned*)(ctl + CW_BAR), MISC + 8, wave == 0 && fresh_lane() == 0);
#define GRID_BAR() xcd_barrier(bar, wave)

    for (int rep = 0; rep < REP(0); ++rep) {
    if (STEP >= 2 && PH(0)) p0_prologue(args, lds, vcu, G, wave);
    GRID_BAR(); }
    for (int rep = 0; rep < REP(1); ++rep) {
    if (STEP >= 2 && PH(1)) p0b_modulate(args, vcu, G, wave);
    GRID_BAR(); }
    for (int rep = 0; rep < REP(2); ++rep) {
    if (STEP >= 2 && PH(2)) {
        P1Prob p; p.XN = (bf16*)(ws + WS_XN); p.WinT = (bf16*)(ws + WS_WIN); p.Q = (bf16*)(ws + WS_Q); p.Kb = (bf16*)(ws + WS_K); p.Vb = (bf16*)(ws + WS_V); p.FT = (float*)(ws + WS_FT);
        p.qg = args.q_norm_g; p.kg = args.k_norm_g; p.kmax = (unsigned*)(ctl + CW_KMAX); p.so.init(NROWS / 256, INW / 256, G, bx);
        pg8::gemm_phase<P1Prob, false, true, true>(lds, p, nullptr, wave);
        if (rep == 0 && MOE_S1 > 0) {
            const int nwg = (NROWS / 256) * (INW / 256), maxc = (nwg + G - 1) / G, c0 = nwg - (maxc - 1) * G;
            if (c0 >= G) moe_convert(args, (LAS float*)(lds + wave * 16640), MOE_B0, MOE_B1, bx * NWAVES + wave, G * NWAVES);
            else if (bx >= c0) moe_convert(args, (LAS float*)(lds + wave * 16640), MOE_B0, MOE_B1, (bx - c0) * NWAVES + wave, (G - c0) * NWAVES);
        }
    }
    GRID_BAR(); }
#if PROBE == 1
    probe_qkv(args, lds, vcu, wave);
#endif
    if (REP(12) > 1) {
        P1Prob p; p.XN = (bf16*)(ws + WS_XN); p.WinT = (bf16*)(ws + WS_WIN); p.Q = (bf16*)(ws + WS_Q); p.Kb = (bf16*)(ws + WS_K); p.Vb = (bf16*)(ws + WS_V); p.FT = (float*)(ws + WS_FT);
        p.qg = args.q_norm_g; p.kg = args.k_norm_g; p.kmax = (unsigned*)(ctl + CW_KMAX); p.so.init(NROWS / 256, INW / 256, G, bx);
        pg8::gemm_phase<P1Prob, false, true, true>(lds, p, nullptr, wave);
        GRID_BAR(); }
    for (int rep = 0; rep < REP(3); ++rep) {
    if (STEP >= 2 && PH(3)) {
        for (int item = vcu; item < 256; item += G) fft_block(args, lds, item, wave);
        if (rep == 0 && MOE_S2 > 0) {
            if (G > 256) { if (vcu >= 256) moe_convert(args, (LAS float*)(lds + wave * 16640), MOE_B1, MOE_B2, (vcu - 256) * NWAVES + wave, (G - 256) * NWAVES); }
            else moe_convert(args, (LAS float*)(lds + wave * 16640), MOE_B1, MOE_B2, vcu * NWAVES + wave, G * NWAVES);
        }
    }
    if (rep + 1 < REP(3)) GRID_BAR(); }
    for (int rep = 0; rep < REP(4); ++rep) {
    if (STEP >= 3 && PH(4)) {
        const attn_body::bf16* Qb = (const attn_body::bf16*)(ws + WS_Q); const attn_body::bf16* Kb = (const attn_body::bf16*)(ws + WS_K); const attn_body::bf16* Vb = (const attn_body::bf16*)(ws + WS_V);
        attn_body::bf16* MIX = (attn_body::bf16*)(ws + WS_MIX);
        const float kmax2 = __uint_as_float(__hip_atomic_load(ctl + CW_KMAX, RLX_AGENT));
        const int u0 = (G == 256) ? vcu * 3 : vcu, ustep = (G == 256) ? 1 : G, uend = (G == 256) ? vcu * 3 + 3 : 768;
        int ucnt = 0;
#pragma unroll 1
        for (int u = u0; u < uend; u += ustep, ++ucnt) {
            if (rep == 0 && MOE_B3 < MOE_ITEMS && ucnt == ((G == 256) ? vcu % 3 : 0)) { moe_convert(args, (LAS float*)(lds + wave * 16640), MOE_B3, MOE_ITEMS, wave * G + vcu, NWAVES * G); __syncthreads(); }
            const int kvh = u / 192, w = u % 192, h = kvh * 3 + w / 64, qb = w % 64;
#if ATTN_F8
            attn_body::attn_unit_f8<0>(h, kvh, qb, (const unsigned char*)Qb, (const unsigned char*)Kb, (const unsigned char*)Vb, MIX, (char*)lds_raw, wave, kmax2);
#ifdef DUMMYVAR
            attn_body::attn_unit_f8<(DUMMYVAR) | 8>(h, kvh, qb, (const unsigned char*)Qb, (const unsigned char*)Kb, (const unsigned char*)Vb, MIX, (char*)lds_raw, wave, kmax2);
#endif
#else
            attn_body::attn_unit<8>(h, kvh, qb, Qb, Kb, Vb, MIX, (char*)lds_raw, wave, kmax2);
#endif
        }
    } else if (STEP == 2) {
        bf16* MIX = (bf16*)(ws + WS_MIX);
        const int gw = vcu * NWAVES + wave, NGW = G * NWAVES, lane = fresh_lane();
        for (int m = gw; m < NTOK; m += NGW) { GAS v4u* o = (GAS v4u*)(MIX + (size_t)m * DM + 256); o[lane] = (v4u){0u, 0u, 0u, 0u}; if (lane < 32) o[64 + lane] = (v4u){0u, 0u, 0u, 0u}; }
    }
    GRID_BAR(); }
#if PROBE == 2
    probe_attn(args, lds, vcu, wave);
#endif
    for (int rep = 0; rep < REP(5); ++rep) {
    if (STEP >= 2 && PH(5)) {
        P3Prob p; p.MIX = (bf16*)(ws + WS_MIX); p.WoT = (bf16*)(ws + WS_WOUT); p.x = args.x; p.g1 = (const float*)(ws + WS_MOD) + 2 * DM; p.X1 = (float*)(ws + WS_X1); p.so.init(NTOK / 256, DM / 256, G, bx);
        pg8::gemm_phase<P3Prob, false, true, true>(lds, p, nullptr, wave);
    }
    GRID_BAR(); }
    for (int rep = 0; rep < REP(6); ++rep) {
    if (STEP >= 4 && PH(6)) p3b_router(args, lds, vcu, G, wave);
    GRID_BAR(); }
    for (int rep = 0; rep < REP(7); ++rep) {
    if (STEP >= 4 && PH(7)) {
#pragma unroll 1
        for (int e = vcu; e < NE; e += G) p4_topk(args, lds, e, wave);
        if (rep == 0) {
            if (G > NE) { if (vcu >= NE) moe_convert(args, (LAS float*)(lds + wave * 16640), MOE_B2, MOE_B3, (vcu - NE) * NWAVES + wave, (G - NE) * NWAVES); }
            else moe_convert(args, (LAS float*)(lds + wave * 16640), MOE_B2, MOE_B3, vcu * NWAVES + wave, G * NWAVES);
        } }
    GRID_BAR(); }
    if (REP(11) > 1) {
        moe_convert(args, (LAS float*)(lds + wave * 16640), MOE_B2, MOE_B3, vcu * NWAVES + wave, G * NWAVES);
        GRID_BAR(); }
    for (int rep = 0; rep < REP(8); ++rep) {
    if (STEP >= 4 && PH(8)) {
        P5Prob p; p.H2 = (const unsigned char*)(ws + WS_H2); p.WguT = (const unsigned char*)(ws + WS_WGU); p.HID = (unsigned char*)(ws + WS_HID); p.so.init(NE * CAP / 256, 2 * DE / 256, G, bx);
        LAS unsigned* rowtab = (LAS unsigned*)(lds + XTRA_OFF);
        const int* IDX = (const int*)(ws + WS_IDX);
        { const int tid = wave * 64 + fresh_lane(); pg8::Unit u; for (int i = 0; p.so.next(i, u) && i < 28; ++i) { if (tid < 256) rowtab[i * 256 + tid] = (unsigned)IDX[u.pm * 256 + tid]; } }
        __syncthreads();
        pg8::gemm_phase<P5Prob, true, true, true>(lds, p, rowtab, wave);
    }
    GRID_BAR(); }
    for (int rep = 0; rep < REP(9); ++rep) {
    if (STEP >= 4 && PH(9)) {
        P6Prob p; p.HID = (const unsigned char*)(ws + WS_HID); p.WdT = (const unsigned char*)(ws + WS_WD); p.GATE = (const float*)(ws + WS_GATE); p.YE = (bf16*)(ws + WS_YE); p.so.init(NE * CAP / 256, DM / 256, G, bx);
        pg8::gemm_phase<P6Prob, false, true, true>(lds, p, nullptr, wave);
    }
    GRID_BAR(); }
    {
        unsigned poison = (__hip_atomic_load(ctl + CW_BAR + XB_TMO, RLX_AGENT) != 0u) || (__hip_atomic_load(ctl + CW_FLAG, RLX_AGENT) != 0u);
        for (int rep = 0; rep < REP(10); ++rep) p7_final(args, vcu, G, wave, poison);
    }
}

extern "C" void kernel_launch(void* const* d_in, const int* in_sizes, int n_in, void* d_out, int out_size, void* d_ws, size_t ws_size, hipStream_t stream) {
    static int grid = 0;
    if (grid == 0) {
        if (n_in != 18 || in_sizes[0] != NTOK * DM || out_size != NTOK * DM || ws_size < WS_END) { fprintf(stderr, "kernel_launch: unexpected shapes (n_in %d, in0 %d, out %d, ws %zu)\n", n_in, n_in > 0 ? in_sizes[0] : -1, out_size, ws_size); grid = -1; return; }
        int dev = 0, cus = 0, per_cu = 0;
        if (hipGetDevice(&dev) != hipSuccess || hipDeviceGetAttribute(&cus, hipDeviceAttributeMultiprocessorCount, dev) != hipSuccess) { grid = -1; return; }
        if (hipFuncSetAttribute((const void*)fwd_megakernel, hipFuncAttributeMaxDynamicSharedMemorySize, LDS_BYTES) != hipSuccess) { fprintf(stderr, "kernel_launch: hipFuncSetAttribute failed\n"); grid = -1; return; }
        if (hipOccupancyMaxActiveBlocksPerMultiprocessor(&per_cu, (const void*)fwd_megakernel, NTHR, LDS_BYTES) != hipSuccess || per_cu < 1) { fprintf(stderr, "kernel_launch: occupancy query says %d blocks per CU\n", per_cu); (void)hipGetLastError(); grid = -1; return; }
        grid = cus;
    }
    if (grid < 0) return;
    (void)hipMemsetAsync((char*)d_ws + WS_CTL, 0, CTL_ZERO_BYTES, stream);
    Args a{};
    const float** f = (const float**)&a;
    for (int i = 0; i < 18; ++i) f[i] = (const float*)d_in[i];
    a.out = (float*)d_out; a.ws = (unsigned char*)d_ws;
    hipLaunchKernelGGL(fwd_megakernel, dim3(grid), dim3(NTHR), LDS_BYTES, stream, a);
}
```

```cpp
#include <hip/hip_runtime.h>
#include <hip/hip_bf16.h>
#include <cstdio>
#include <cstdint>
#include <cmath>

#ifndef STEP
#define STEP 4
#endif
#ifndef PROBE
#define PROBE 0
#endif
#ifndef PHMASK
#define PHMASK 0xFFFF
#endif
#define PH(k) ((PHMASK >> (k)) & 1)
#ifndef ATTN_F8
#define ATTN_F8 1
#endif
#ifndef REPEAT
#define REPEAT 0
#endif
#define REP(k) (((REPEAT >> (k)) & 1) + 1)

constexpr int DM = 1024, NTOK = 16384, NCTX = 256, NROWS = NTOK + NCTX, INW = 1536;
constexpr int NHQ = 12, NHKV = 4, HD = 64, NE = 16, CAP = 2048, DE = 2048, NMOD = 6;
constexpr int NKEYS = NROWS;
constexpr float EPS = 1e-6f;

__device__ __forceinline__ int fresh_lane() { int l; asm volatile("v_mbcnt_lo_u32_b32 %0, -1, 0\n\tv_mbcnt_hi_u32_b32 %0, -1, %0" : "=v"(l)); return l; }

namespace pg8 {
#define PG8_LAS __attribute__((address_space(3)))
typedef unsigned short bf16_t;
typedef short bf16x8 __attribute__((ext_vector_type(8)));
typedef float f32x4 __attribute__((ext_vector_type(4)));
typedef unsigned u32x4 __attribute__((ext_vector_type(4)));
typedef unsigned u32x2 __attribute__((ext_vector_type(2)));
typedef int v8i __attribute__((ext_vector_type(8)));
constexpr int BM = 256, BK = 64, HALF = 128, HTB = HALF * BK * 2, STAGE_BYTES = 8 * HTB, NXCD = 8, WGM = 8;

__host__ __device__ __forceinline__ int lds_byte(int r, int c) { const int st = (r >> 4) * 2 + (c >> 5), rr = r & 15, cc = c & 31, ob = rr * 64 + cc * 2; return st * 1024 + (ob ^ (((ob >> 9) & 1) << 5)); }
__host__ __device__ __forceinline__ void stage_rc(int b, int& R, int& C) { const int st = b / 1024, sb = b % 1024, swz = sb ^ (((sb >> 9) & 1) << 5); R = (st >> 1) * 16 + swz / 64; C = (st & 1) * 32 + (swz % 64) / 2; }
__host__ __device__ __forceinline__ int perm32(int rho) { const int n = rho >> 4, i = rho & 15; return 8 * (i >> 2) + 4 * n + (i & 3); }

struct Unit { int pm, pn; };

struct StaticOrder {
    int nM, nN, nwg, G, c;
    __host__ __device__ void init(int nM_, int nN_, int G_, int c_) { nM = nM_; nN = nN_; nwg = nM * nN; G = G_; c = c_; }
    __host__ __device__ bool next(int i, Unit& u) const {
        const long L = (long)i * G + c; if (L >= nwg) return false;
        int wgid = (int)L; { const int q = nwg / NXCD, r = nwg % NXCD, xcd = wgid % NXCD, off = wgid / NXCD; wgid = (xcd < r ? xcd * (q + 1) : r * (q + 1) + (xcd - r) * q) + off; }
        const int nig = WGM * nN, gid = wgid / nig, fm = gid * WGM, gsz = (nM - fm) < WGM ? (nM - fm) : WGM;
        u.pm = fm + ((wgid % nig) % gsz); u.pn = (wgid % nig) / gsz; return true;
    }
};

__device__ __forceinline__ unsigned cvt_pk_bf16(float lo, float hi) { unsigned r; asm volatile("v_cvt_pk_bf16_f32 %0, %1, %2" : "=v"(r) : "v"(lo), "v"(hi)); return r; }

template <class P, bool GATHER, bool ALIGN_EPI, bool SP2>
__device__ __forceinline__ void gemm_phase(PG8_LAS unsigned char* lds, const P& S, const PG8_LAS unsigned* rowtab, int wid) {
    const int lane = fresh_lane(), tid = wid * 64 + lane, wr = wid >> 2, wc = wid & 3, fr = lane & 15, fq = lane >> 4;
    constexpr bool F8 = P::FP8; constexpr int ESZ = F8 ? 1 : 2;
    constexpr int K = P::K, nt = F8 ? K / 128 : K / BK;
    int R0, C0; stage_rc(tid * 16, R0, C0);
    unsigned voffB[2];
#pragma unroll
    for (int i = 0; i < 2; ++i) { const int R = R0 + 64 * i; const int Rb = P::PERM ? ((R & ~31) + perm32(R & 31)) : R; voffB[i] = (unsigned)(Rb * K * ESZ + C0 * 2); }
    constexpr size_t kstep = (size_t)(BK * 2);
    constexpr size_t hstep = (size_t)HALF * K * ESZ;
    const unsigned ldsw = (unsigned)wid * 1024u;
    const int aoff = F8 ? lds_byte(wr * 64 + fr, fq * 16) : lds_byte(wr * 64 + fr, fq * 8), boff = F8 ? lds_byte(wc * 32 + fr, fq * 16) : lds_byte(wc * 32 + fr, fq * 8);
#define PG8_SA(b, h) (((b) * 2 + (h)) * HTB)
#define PG8_SB(b, h) ((4 + (b) * 2 + (h)) * HTB)
#define PG8_STAGE(bufoff, gbase, voff) do { _Pragma("unroll") for (int _i = 0; _i < 2; ++_i) \
        __builtin_amdgcn_global_load_lds((const unsigned*)((const char*)(gbase) + (voff)[_i]), (PG8_LAS unsigned*)(lds + (bufoff) + ldsw + _i * 8192), 16, 0, 0); } while (0)
#define PG8_LDA(dst, b, h) do { if constexpr (F8) { _Pragma("unroll") for (int m = 0; m < 4; ++m) { const PG8_LAS u32x4* p_ = (const PG8_LAS u32x4*)(lds + PG8_SA(b, h) + aoff + m * 2048); const u32x4 lo_ = p_[0], hi_ = p_[1]; \
            dst##8[m] = (v8i){(int)lo_.x, (int)lo_.y, (int)lo_.z, (int)lo_.w, (int)hi_.x, (int)hi_.y, (int)hi_.z, (int)hi_.w}; } } \
        else { _Pragma("unroll") for (int m = 0; m < 4; ++m) _Pragma("unroll") for (int k = 0; k < 2; ++k) dst[m][k] = *(const PG8_LAS bf16x8*)(lds + PG8_SA(b, h) + aoff + m * 2048 + k * 1024); } } while (0)
#define PG8_LDB(dst, b, h) do { if constexpr (F8) { _Pragma("unroll") for (int n = 0; n < 2; ++n) { const PG8_LAS u32x4* p_ = (const PG8_LAS u32x4*)(lds + PG8_SB(b, h) + boff + n * 2048); const u32x4 lo_ = p_[0], hi_ = p_[1]; \
            dst##8[n] = (v8i){(int)lo_.x, (int)lo_.y, (int)lo_.z, (int)lo_.w, (int)hi_.x, (int)hi_.y, (int)hi_.z, (int)hi_.w}; } } \
        else { _Pragma("unroll") for (int n = 0; n < 2; ++n) _Pragma("unroll") for (int k = 0; k < 2; ++k) dst[n][k] = *(const PG8_LAS bf16x8*)(lds + PG8_SB(b, h) + boff + n * 2048 + k * 1024); } } while (0)
#define PG8_MMA(ai, bj, At, Bt) do { __builtin_amdgcn_s_setprio(1); if constexpr (F8) { \
        asm volatile("s_nop 1\n\t" \
            "v_mfma_scale_f32_16x16x128_f8f6f4 %0, %8, %10, %0, %14, %15 op_sel_hi:[0,0,0]\n\t" \
            "v_mfma_scale_f32_16x16x128_f8f6f4 %1, %9, %10, %1, %14, %15 op_sel_hi:[0,0,0]\n\t" \
            "v_mfma_scale_f32_16x16x128_f8f6f4 %2, %8, %11, %2, %14, %15 op_sel_hi:[0,0,0]\n\t" \
            "v_mfma_scale_f32_16x16x128_f8f6f4 %3, %9, %11, %3, %14, %15 op_sel_hi:[0,0,0]\n\t" \
            "v_mfma_scale_f32_16x16x128_f8f6f4 %4, %8, %12, %4, %14, %15 op_sel_hi:[0,0,0]\n\t" \
            "v_mfma_scale_f32_16x16x128_f8f6f4 %5, %9, %12, %5, %14, %15 op_sel_hi:[0,0,0]\n\t" \
            "v_mfma_scale_f32_16x16x128_f8f6f4 %6, %8, %13, %6, %14, %15 op_sel_hi:[0,0,0]\n\t" \
            "v_mfma_scale_f32_16x16x128_f8f6f4 %7, %9, %13, %7, %14, %15 op_sel_hi:[0,0,0]" \
            : "+v"(acc[ai][bj][0][0]), "+v"(acc[ai][bj][0][1]), "+v"(acc[ai][bj][1][0]), "+v"(acc[ai][bj][1][1]), "+v"(acc[ai][bj][2][0]), "+v"(acc[ai][bj][2][1]), "+v"(acc[ai][bj][3][0]), "+v"(acc[ai][bj][3][1]) \
            : "v"(Bt##8[0]), "v"(Bt##8[1]), "v"(At##8[0]), "v"(At##8[1]), "v"(At##8[2]), "v"(At##8[3]), "v"(scw_), "v"(sca_)); } \
        else { _Pragma("unroll") for (int m = 0; m < 4; ++m) _Pragma("unroll") for (int n = 0; n < 2; ++n) _Pragma("unroll") for (int k = 0; k < 2; ++k) \
            acc[ai][bj][m][n] = __builtin_amdgcn_mfma_f32_16x16x32_bf16(Bt[n][k], At[m][k], acc[ai][bj][m][n], 0, 0, 0); } __builtin_amdgcn_s_setprio(0); } while (0)
#define PG8_WAIT_V(n) asm volatile("s_waitcnt vmcnt(" #n ")" ::: "memory")
#define PG8_WAIT_L(n) asm volatile("s_waitcnt lgkmcnt(" #n ")" ::: "memory")
#define PG8_BAR __builtin_amdgcn_s_barrier()
#define PG8_SCHED __builtin_amdgcn_sched_barrier(0)
#define PG8_AOFF(dst, u_, ui_) do { _Pragma("unroll") for (int _h = 0; _h < 2; ++_h) _Pragma("unroll") for (int _i = 0; _i < 2; ++_i) { \
        if constexpr (GATHER) dst[_h][_i] = (unsigned)(rowtab[(ui_) * 256 + _h * HALF + _i * 64 + R0] * (unsigned)(K * ESZ) + (unsigned)(C0 * 2)); \
        else dst[_h][_i] = (unsigned)((_h * HALF + _i * 64 + R0) * K * ESZ + C0 * 2); } } while (0)
    Unit cur, nxt; int ui = 0;
    if (!S.next(0, cur)) return;
    f32x4 acc[2][2][4][2];
#pragma unroll
    for (int a = 0; a < 2; ++a)
#pragma unroll
        for (int b = 0; b < 2; ++b)
#pragma unroll
            for (int m = 0; m < 4; ++m)
#pragma unroll
                for (int n = 0; n < 2; ++n) acc[a][b][m][n] = (f32x4){0.f, 0.f, 0.f, 0.f};
    bf16x8 At[4][2], B0[2][2], B1[2][2]; v8i At8[4], B08[2], B18[2]; const int scw_ = P::SCW, sca_ = P::SCA;
    unsigned vAc[2][2], vAn[2][2];
    PG8_AOFF(vAc, cur, 0);
    const char* cA = S.aptr(cur); const char* cB = S.bptr(cur);
    if constexpr (SP2) {
        PG8_STAGE(PG8_SB(0, 0), cB, voffB); PG8_STAGE(PG8_SB(0, 1), cB + hstep, voffB); PG8_STAGE(PG8_SA(0, 0), cA, vAc[0]); PG8_STAGE(PG8_SA(0, 1), cA, vAc[1]);
        if (wr == 1) PG8_BAR;
        PG8_WAIT_V(2); PG8_BAR;
        PG8_STAGE(PG8_SB(1, 0), cB + kstep, voffB); PG8_STAGE(PG8_SA(1, 0), cA + kstep, vAc[0]); PG8_STAGE(PG8_SB(1, 1), cB + hstep + kstep, voffB);
        PG8_WAIT_V(6); PG8_BAR;
    } else {
        PG8_STAGE(PG8_SB(0, 0), cB, voffB); PG8_STAGE(PG8_SA(0, 0), cA, vAc[0]); PG8_STAGE(PG8_SB(0, 1), cB + hstep, voffB); PG8_STAGE(PG8_SA(0, 1), cA, vAc[1]);
        if (wr == 1) PG8_BAR;
        PG8_WAIT_V(4); PG8_BAR;
        PG8_STAGE(PG8_SB(1, 0), cB + kstep, voffB); PG8_STAGE(PG8_SA(1, 0), cA + kstep, vAc[0]); PG8_STAGE(PG8_SB(1, 1), cB + hstep + kstep, voffB);
        PG8_WAIT_V(6); PG8_BAR;
    }
    for (;;) {
        const bool has_next = S.next(ui + 1, nxt);
        const char* nA = has_next ? S.aptr(nxt) : cA; const char* nB = has_next ? S.bptr(nxt) : cB;
        if (has_next) { PG8_AOFF(vAn, nxt, ui + 1); }
        else {
#pragma unroll
            for (int h = 0; h < 2; ++h)
#pragma unroll
                for (int i = 0; i < 2; ++i) vAn[h][i] = vAc[h][i];
        }
        for (int t = 0; t < nt; t += 2) {
            const bool last = (t == nt - 2);
            const char* a1 = cA + (size_t)(t + 1) * kstep;
            const char* a2 = last ? nA : cA + (size_t)(t + 2) * kstep; const char* b2 = last ? nB : cB + (size_t)(t + 2) * kstep;
            const char* a3 = a2 + kstep; const char* b3 = b2 + kstep;
            unsigned w2[2][2];
#pragma unroll
            for (int h = 0; h < 2; ++h)
#pragma unroll
                for (int i = 0; i < 2; ++i) w2[h][i] = last ? vAn[h][i] : vAc[h][i];
            if constexpr (SP2) {
            PG8_LDB(B0, 0, 0); PG8_LDB(B1, 0, 1); PG8_SCHED; PG8_LDA(At, 0, 0); PG8_STAGE(PG8_SA(1, 1), a1, vAc[1]);
            PG8_WAIT_V(8); PG8_WAIT_L(0); PG8_BAR; PG8_MMA(0, 0, At, B0); PG8_MMA(0, 1, At, B1); PG8_BAR; PG8_SCHED;
            PG8_LDA(At, 0, 1); PG8_STAGE(PG8_SB(0, 0), b2, voffB); PG8_STAGE(PG8_SB(0, 1), b2 + hstep, voffB); PG8_STAGE(PG8_SA(0, 0), a2, w2[0]);
            PG8_WAIT_V(8); PG8_WAIT_L(0); PG8_BAR; PG8_MMA(1, 0, At, B0); PG8_MMA(1, 1, At, B1); PG8_BAR; PG8_SCHED;
            PG8_LDB(B0, 1, 0); PG8_LDB(B1, 1, 1); PG8_SCHED; PG8_LDA(At, 1, 0); PG8_STAGE(PG8_SA(0, 1), a2, w2[1]);
            PG8_WAIT_V(8); PG8_WAIT_L(0); PG8_BAR; PG8_MMA(0, 0, At, B0); PG8_MMA(0, 1, At, B1); PG8_BAR; PG8_SCHED;
            PG8_LDA(At, 1, 1); PG8_STAGE(PG8_SB(1, 0), b3, voffB); PG8_STAGE(PG8_SB(1, 1), b3 + hstep, voffB); PG8_STAGE(PG8_SA(1, 0), a3, w2[0]);
            PG8_WAIT_V(8); PG8_WAIT_L(0); PG8_BAR; PG8_MMA(1, 0, At, B0); PG8_MMA(1, 1, At, B1); PG8_BAR; PG8_SCHED;
            } else {
            PG8_LDB(B0, 0, 0); PG8_SCHED; PG8_LDA(At, 0, 0); PG8_STAGE(PG8_SA(1, 1), a1, vAc[1]);
            PG8_WAIT_L(8); PG8_BAR; PG8_WAIT_L(0); PG8_MMA(0, 0, At, B0); PG8_BAR; PG8_SCHED;
            PG8_LDB(B1, 0, 1); PG8_STAGE(PG8_SB(0, 0), b2, voffB);
            PG8_BAR; PG8_WAIT_L(0); PG8_MMA(0, 1, At, B1); PG8_BAR;
            PG8_LDA(At, 0, 1); PG8_STAGE(PG8_SA(0, 0), a2, w2[0]);
            PG8_BAR; PG8_WAIT_L(0); PG8_MMA(1, 0, At, B0); PG8_BAR; PG8_SCHED;
            PG8_STAGE(PG8_SB(0, 1), b2 + hstep, voffB);
            PG8_WAIT_V(6); PG8_BAR; PG8_MMA(1, 1, At, B1); PG8_BAR;
            PG8_LDB(B0, 1, 0); PG8_SCHED; PG8_LDA(At, 1, 0); PG8_STAGE(PG8_SA(0, 1), a2, w2[1]);
            PG8_WAIT_L(8); PG8_BAR; PG8_WAIT_L(0); PG8_MMA(0, 0, At, B0); PG8_BAR; PG8_SCHED;
            PG8_LDB(B1, 1, 1); PG8_STAGE(PG8_SB(1, 0), b3, voffB);
            PG8_BAR; PG8_WAIT_L(0); PG8_MMA(0, 1, At, B1); PG8_BAR;
            PG8_LDA(At, 1, 1); PG8_STAGE(PG8_SA(1, 0), a3, w2[0]);
            PG8_BAR; PG8_WAIT_L(0); PG8_MMA(1, 0, At, B0); PG8_BAR; PG8_SCHED;
            PG8_STAGE(PG8_SB(1, 1), b3 + hstep, voffB);
            PG8_WAIT_V(6); PG8_BAR; PG8_MMA(1, 1, At, B1); PG8_BAR;
            }
        }
        if constexpr (ALIGN_EPI) { if (wr == 0) PG8_BAR; }
        if constexpr (F8) asm volatile("s_nop 15\n\ts_nop 7" ::: "memory");
        { int fr2 = fr, fq2 = fq; asm volatile("" : "+v"(fr2), "+v"(fq2));
          S.epi(acc, cur, wr, wc, fr2, fq2); }
        if (!has_next) break;
#pragma unroll
        for (int a = 0; a < 2; ++a)
#pragma unroll
            for (int b = 0; b < 2; ++b)
#pragma unroll
                for (int m = 0; m < 4; ++m)
#pragma unroll
                    for (int n = 0; n < 2; ++n) acc[a][b][m][n] = (f32x4){0.f, 0.f, 0.f, 0.f};
        cur = nxt; cA = nA; cB = nB; ++ui;
#pragma unroll
        for (int h = 0; h < 2; ++h)
#pragma unroll
            for (int i = 0; i < 2; ++i) vAc[h][i] = vAn[h][i];
        if constexpr (ALIGN_EPI) { if (wr == 1) PG8_BAR; }
    }
    PG8_WAIT_V(0);
    if constexpr (!ALIGN_EPI) { if (wr == 0) PG8_BAR; }
    PG8_BAR;
#undef PG8_SA
#undef PG8_SB
#undef PG8_STAGE
#undef PG8_LDA
#undef PG8_LDB
#undef PG8_MMA
#undef PG8_WAIT_V
#undef PG8_WAIT_L
#undef PG8_BAR
#undef PG8_SCHED
#undef PG8_AOFF
}
}

namespace attn_body {
using bf16 = __hip_bfloat16;
using bf16x8 = __attribute__((ext_vector_type(8))) short;
using s16x4 = __attribute__((ext_vector_type(4))) short;
using f32x16 = __attribute__((ext_vector_type(16))) float;
using u32x4 = __attribute__((ext_vector_type(4))) unsigned;
constexpr int D = 64, QPITCH = NHQ * D, KPITCH = NHKV * D, OPITCH = DM, OCOL0 = 256;
constexpr int NW = 8, QBLK = 32, QB = QBLK * NW, KVBLK = 64, NQB = NTOK / QB, NT = NKEYS / KVBLK;
static_assert(NT % 2 == 0 && NT >= 8, "tile count");
__device__ __forceinline__ int crow(int r, int hi) { return (r & 3) + 8 * (r >> 2) + 4 * hi; }
#define SBAR() __builtin_amdgcn_sched_barrier(0)
constexpr int NSLOT = 3, SLOTB = 8192;
constexpr int LDS_K = 0, LDS_V = NSLOT * SLOTB, LDS_WS = 2 * NSLOT * SLOTB, LDS_OST = LDS_WS + NW * 64 * 4, LDS_BYTES = LDS_OST + NW * 4096;
constexpr float C2 = 0.125f * 1.4426950408889634f;
__device__ __forceinline__ void glds16(const void* gsrc, unsigned lds_dst) { unsigned keep;
  asm volatile("s_mov_b32 %0, m0\n\ts_mov_b32 m0, %2\n\ts_nop 0\n\tglobal_load_lds_dwordx4 %1, off\n\ts_mov_b32 m0, %0" : "=&s"(keep) : "v"(gsrc), "s"(lds_dst) : "memory"); }
__device__ __forceinline__ float max3f(float a, float b, float c) { float r; asm("v_max3_f32 %0, %1, %2, %3" : "=v"(r) : "v"(a), "v"(b), "v"(c)); return r; }
__device__ __forceinline__ float max2f(float a, float b) { float r; asm("v_max_f32_e32 %0, %1, %2" : "=v"(r) : "v"(a), "v"(b)); return r; }
__device__ __forceinline__ float fadd_s(float a, float b) { float r; asm("v_add_f32_e32 %0, %1, %2" : "=v"(r) : "v"(a), "v"(b)); return r; }
__device__ __forceinline__ float fsub_s(float a, float b) { float r; asm("v_sub_f32_e32 %0, %1, %2" : "=v"(r) : "v"(a), "v"(b)); return r; }
typedef float f32x2_t __attribute__((ext_vector_type(2))); typedef __bf16 bf16x2_t __attribute__((ext_vector_type(2)));
__device__ __forceinline__ unsigned cvtpk_s(float lo, float hi) { f32x2_t v = {lo, hi}; bf16x2_t b = __builtin_convertvector(v, bf16x2_t); return __builtin_bit_cast(unsigned, b); }
#define WAIT_BAR(N) asm volatile("s_waitcnt vmcnt(" #N ") lgkmcnt(0)\n\ts_barrier" ::: "memory")

__device__ __forceinline__ void qkt(f32x16& p0, f32x16& p1, const char* Kslot, const bf16x8* qr, const f32x16& negm, int r32, int hi) {
  const char* kb = Kslot + hi * 1024 + r32 * 16;
  #pragma unroll
  for (int d0 = 0; d0 < 4; ++d0) {
    const bf16x8 b0 = *reinterpret_cast<const bf16x8*>(kb + d0 * 2048);
    const bf16x8 b1 = *reinterpret_cast<const bf16x8*>(kb + d0 * 2048 + 512);
    if (d0 == 0) { p0 = __builtin_amdgcn_mfma_f32_32x32x16_bf16(b0, qr[0], negm, 0, 0, 0); p1 = __builtin_amdgcn_mfma_f32_32x32x16_bf16(b1, qr[0], negm, 0, 0, 0); }
    else { p0 = __builtin_amdgcn_mfma_f32_32x32x16_bf16(b0, qr[d0], p0, 0, 0, 0); p1 = __builtin_amdgcn_mfma_f32_32x32x16_bf16(b1, qr[d0], p1, 0, 0, 0); } }
}
typedef __attribute__((address_space(3))) const char* lds_cptr;
typedef short v4i16_t __attribute__((ext_vector_type(4)));
__device__ __forceinline__ void kload8(bf16x8* kf, lds_cptr kp) {
  kf[0] = *(const __attribute__((address_space(3))) bf16x8*)(kp);        kf[1] = *(const __attribute__((address_space(3))) bf16x8*)(kp + 512);
  kf[2] = *(const __attribute__((address_space(3))) bf16x8*)(kp + 2048); kf[3] = *(const __attribute__((address_space(3))) bf16x8*)(kp + 2560);
  kf[4] = *(const __attribute__((address_space(3))) bf16x8*)(kp + 4096); kf[5] = *(const __attribute__((address_space(3))) bf16x8*)(kp + 4608);
  kf[6] = *(const __attribute__((address_space(3))) bf16x8*)(kp + 6144); kf[7] = *(const __attribute__((address_space(3))) bf16x8*)(kp + 6656);
}
__device__ __forceinline__ void kload2(bf16x8* kf, lds_cptr kp, int j) { kf[2 * j] = *(const __attribute__((address_space(3))) bf16x8*)(kp + j * 2048); kf[2 * j + 1] = *(const __attribute__((address_space(3))) bf16x8*)(kp + j * 2048 + 512); }
__device__ __forceinline__ s16x4 vtr(lds_cptr p) { return __builtin_bit_cast(s16x4, __builtin_amdgcn_ds_read_tr16_b64_v4i16((__attribute__((address_space(3))) v4i16_t*)p)); }
__device__ __forceinline__ float rowmax(const f32x16& p0, const f32x16& p1) {
  float a = max3f(p0[0], p0[1], p1[0]), b = max3f(p0[2], p0[3], p1[1]); a = max3f(a, p1[2], p1[3]);
  #pragma unroll
  for (int r = 4; r < 16; r += 4) { a = max3f(a, p0[r], p0[r + 1]); b = max3f(b, p0[r + 2], p0[r + 3]); a = max3f(a, p1[r], p1[r + 1]); b = max3f(b, p1[r + 2], p1[r + 3]); }
  const float m = max2f(a, b);
  auto rr = __builtin_amdgcn_permlane32_swap(__float_as_uint(m), __float_as_uint(m), false, false);
  return max2f(__uint_as_float(rr[0]), __uint_as_float(rr[1]));
}
__device__ __forceinline__ void pv(f32x16* o, int vb, bf16x8 pa0, bf16x8 pa1, bf16x8 pa2, bf16x8 pa3) {
  #pragma unroll
  for (int d0 = 0; d0 < 2; ++d0) { s16x4 lo[4], hi[4];
    #pragma unroll
    for (int ks = 0; ks < 4; ++ks) {
      asm volatile("ds_read_b64_tr_b16 %0,%1 offset:%c2" : "=&v"(lo[ks]) : "v"(vb), "i"(d0 * 4096 + ks * 1024) : "memory");
      asm volatile("ds_read_b64_tr_b16 %0,%1 offset:%c2" : "=&v"(hi[ks]) : "v"(vb), "i"(d0 * 4096 + ks * 1024 + 512) : "memory"); }
    asm volatile("s_waitcnt lgkmcnt(0)" ::: "memory"); SBAR();
    #define PK(k) (bf16x8){lo[k][0], lo[k][1], lo[k][2], lo[k][3], hi[k][0], hi[k][1], hi[k][2], hi[k][3]}
    o[d0] = __builtin_amdgcn_mfma_f32_32x32x16_bf16(pa0, PK(0), o[d0], 0, 0, 0);
    o[d0] = __builtin_amdgcn_mfma_f32_32x32x16_bf16(pa1, PK(1), o[d0], 0, 0, 0);
    o[d0] = __builtin_amdgcn_mfma_f32_32x32x16_bf16(pa2, PK(2), o[d0], 0, 0, 0);
    o[d0] = __builtin_amdgcn_mfma_f32_32x32x16_bf16(pa3, PK(3), o[d0], 0, 0, 0);
    #undef PK
  }
}
#define ATTN_STORE16(p, v) (*(u32x4*)(p) = (v))
template <int THRL> __device__ __forceinline__ void attn_unit(int h, int kvh, int qb, const bf16* Q, const bf16* __restrict__ K, const bf16* __restrict__ V, bf16* O, char* shm, int wid, float kmax2) {
  const int lane = fresh_lane(), r32 = lane & 31, hi = lane >> 5;
  const int q0 = qb * QB;
  const bf16* Qw = Q + (long)(q0 + wid * QBLK) * QPITCH + h * D;
  const bf16* Kh = K + kvh * D, *Vh = V + kvh * D;
  const unsigned lds0 = (unsigned)(uintptr_t)shm;
  float* wsf = (float*)(shm + LDS_WS) + wid * 64;
  const bf16* ksrc = Kh + (long)lane * KPITCH + wid * 8;
  const bf16* vsrc = Vh + (long)(16 * (wid & 3) + (lane >> 2)) * KPITCH + (wid >> 2) * 32 + (lane & 3) * 8;
  const unsigned kdst = lds0 + LDS_K + wid * 1024, vdst = lds0 + LDS_V + wid * 1024;
  #define DMA_K(t, slot) glds16(ksrc + (long)(t) * KVBLK * KPITCH, (unsigned)__builtin_amdgcn_readfirstlane(kdst + (slot)))
  #define DMA_V(t, slot) glds16(vsrc + (long)(t) * KVBLK * KPITCH, (unsigned)__builtin_amdgcn_readfirstlane(vdst + (slot)))
  const int vb0 = (int)(lds0 + LDS_V) + ((lane >> 4) & 1) * 32 + (lane & 3) * 8 + (4 * hi + ((lane & 15) >> 2)) * 64;
  const char* Kbase = shm + LDS_K; bf16x8 kf[8];
  const lds_cptr shm3 = (lds_cptr)shm; const lds_cptr kp0 = shm3 + LDS_K + hi * 1024 + r32 * 16; const lds_cptr vp0 = shm3 + LDS_V + ((lane >> 4) & 1) * 32 + (lane & 3) * 8 + (4 * hi + ((lane & 15) >> 2)) * 64;
  DMA_K(0, 0); DMA_V(0, 0); DMA_K(1, SLOTB);
  bf16x8 qr[4];
  #pragma unroll
  for (int d0 = 0; d0 < 4; ++d0) qr[d0] = *reinterpret_cast<const bf16x8*>(&Qw[(long)r32 * QPITCH + d0 * 16 + hi * 8]);
  float l_reg = 0.f; f32x16 o[2]; o[0] = f32x16{}; o[1] = f32x16{}; f32x16 negm;
  { float qn2 = 0.f;
    #pragma unroll
    for (int d0 = 0; d0 < 4; ++d0)
      #pragma unroll
      for (int j = 0; j < 8; ++j) { const float f = __uint_as_float((unsigned)(unsigned short)qr[d0][j] << 16); qn2 += f * f; }
    auto rr = __builtin_amdgcn_permlane32_swap(__float_as_uint(qn2), __float_as_uint(qn2), false, false); qn2 = __uint_as_float(rr[0]) + __uint_as_float(rr[1]);
    const float bnd = sqrtf(qn2 * kmax2) * 1.004f + 0.01f;
    #pragma unroll
    for (int r = 0; r < 16; ++r) negm[r] = -bnd;
    asm volatile("" : "+v"(negm)); }
  f32x16 pA0, pA1, pB0, pB1;
  int sl_prev = 0, sl_cur = 0, sl_next = SLOTB;
  #define ROT() do { sl_prev = sl_cur; sl_cur = sl_next; sl_next = (sl_next == (NSLOT - 1) * SLOTB) ? 0 : sl_next + SLOTB; } while (0)
  DMA_K(2, 2 * SLOTB);
  WAIT_BAR(3);
  qkt(pA0, pA1, Kbase, qr, negm, r32, hi); asm volatile("s_nop 15\n\ts_nop 7" : "+v"(pA0), "+v"(pA1));
  _Pragma("unroll") for (int r = 0; r < 16; ++r) { pA0[r] = __builtin_amdgcn_exp2f(pA0[r]); pA1[r] = __builtin_amdgcn_exp2f(pA1[r]); }
  WAIT_BAR(0);
  DMA_K(3, 0); DMA_V(1, SLOTB);
  ROT();
  kload8(kf, kp0 + sl_cur);
  WAIT_BAR(2);
  s16x4 vlo[8], vhi[8]; u32x4 pw0, pw1, pw2, pw3;
  #define PKW(P, B) cvtpk_s(P[B], P[B + 1])
  #define PAF(k) __builtin_bit_cast(bf16x8, pw##k)
  #define VFR(i) (bf16x8){vlo[i][0], vlo[i][1], vlo[i][2], vlo[i][3], vhi[i][0], vhi[i][1], vhi[i][2], vhi[i][3]}
  #define PIN(x) asm volatile("" : "+v"(x))
  #define MX3(a, b, c) __builtin_fmaxf(__builtin_fmaxf((a), (b)), (c))
  #define GAPA(MF, A0, A1, A2, A3, W0, W1, PW) do { MF; sacc += A0; sacc += A1; sacc += A2; sacc += A3; PIN(sacc); W0; W1; PIN(PW); SBAR(); } while (0)
  #define EX(v) __builtin_amdgcn_exp2f(v)
  #define GAPB(MF, X, B) do { MF; X[B] = EX(X[B]); X[B + 1] = EX(X[B + 1]); X[B + 2] = EX(X[B + 2]); X[B + 3] = EX(X[B + 3]); PIN(X); SBAR(); } while (0)
  #define VRD(i) do { vlo[i] = vtr(vp_ + (((i) >> 2) * 4096 + ((i) & 3) * 1024)); vhi[i] = vtr(vp_ + (((i) >> 2) * 4096 + ((i) & 3) * 1024 + 512)); } while (0)
  #define KRD(G, j) do { if (G) { kload2(kf, kp0 + sl_next, j); SBAR(); } } while (0)
  #define STEPM(C0, C1, P0, P1, t, GK, GV, GL) do { SBAR(); \
    const lds_cptr vp_ = vp0 + sl_prev; \
    VRD(0); SBAR(); float sacc = (P0[0] + P0[1]); \
    GAPA(C0 = __builtin_amdgcn_mfma_f32_32x32x16_bf16(kf[0], qr[0], negm, 0, 0, 0), P0[2], P0[3], P0[4], P0[5],     pw0[0] = PKW(P0, 0), pw0[1] = PKW(P0, 2), pw0); \
    VRD(4); SBAR(); GAPA(C1 = __builtin_amdgcn_mfma_f32_32x32x16_bf16(kf[1], qr[0], negm, 0, 0, 0), P0[6], P0[7], P0[8], P0[9],     pw0[2] = PKW(P0, 4), pw0[3] = PKW(P0, 6), pw0); \
    VRD(1); SBAR(); GAPA(C0 = __builtin_amdgcn_mfma_f32_32x32x16_bf16(kf[2], qr[1], C0, 0, 0, 0),   P0[10], P0[11], P0[12], P0[13], pw1[0] = PKW(P0, 8), pw1[1] = PKW(P0, 10), pw1); \
    VRD(5); SBAR(); GAPA(C1 = __builtin_amdgcn_mfma_f32_32x32x16_bf16(kf[3], qr[1], C1, 0, 0, 0),   P0[14], P0[15], P1[0], P1[1],   pw1[2] = PKW(P0, 12), pw1[3] = PKW(P0, 14), pw1); \
    VRD(2); SBAR(); GAPA(C0 = __builtin_amdgcn_mfma_f32_32x32x16_bf16(kf[4], qr[2], C0, 0, 0, 0),   P1[2], P1[3], P1[4], P1[5],     pw2[0] = PKW(P1, 0), pw2[1] = PKW(P1, 2), pw2); \
    VRD(6); SBAR(); GAPA(C1 = __builtin_amdgcn_mfma_f32_32x32x16_bf16(kf[5], qr[2], C1, 0, 0, 0),   P1[6], P1[7], P1[8], P1[9],     pw2[2] = PKW(P1, 4), pw2[3] = PKW(P1, 6), pw2); \
    VRD(3); SBAR(); GAPA(C0 = __builtin_amdgcn_mfma_f32_32x32x16_bf16(kf[6], qr[3], C0, 0, 0, 0),   P1[10], P1[11], P1[12], P1[13], pw3[0] = PKW(P1, 8), pw3[1] = PKW(P1, 10), pw3); \
    VRD(7); SBAR(); GAPA(C1 = __builtin_amdgcn_mfma_f32_32x32x16_bf16(kf[7], qr[3], C1, 0, 0, 0),   P1[14], P1[15], 0.f, 0.f,       pw3[2] = PKW(P1, 12), pw3[3] = PKW(P1, 14), pw3); \
    l_reg += sacc; \
    if (GK) { DMA_K((t) + 3, sl_cur); } if (GV) { DMA_V((t) + 1, sl_next); } \
    SBAR(); \
    GAPB(o[0] = __builtin_amdgcn_mfma_f32_32x32x16_bf16(PAF(0), VFR(0), o[0], 0, 0, 0), C0, 0); \
    GAPB(o[1] = __builtin_amdgcn_mfma_f32_32x32x16_bf16(PAF(0), VFR(4), o[1], 0, 0, 0), C0, 4); \
    KRD(GL, 0); GAPB(o[0] = __builtin_amdgcn_mfma_f32_32x32x16_bf16(PAF(1), VFR(1), o[0], 0, 0, 0), C0, 8); \
    KRD(GL, 1); GAPB(o[1] = __builtin_amdgcn_mfma_f32_32x32x16_bf16(PAF(1), VFR(5), o[1], 0, 0, 0), C0, 12); \
    KRD(GL, 2); GAPB(o[0] = __builtin_amdgcn_mfma_f32_32x32x16_bf16(PAF(2), VFR(2), o[0], 0, 0, 0), C1, 0); \
    KRD(GL, 3); GAPB(o[1] = __builtin_amdgcn_mfma_f32_32x32x16_bf16(PAF(2), VFR(6), o[1], 0, 0, 0), C1, 4); \
    GAPB(o[0] = __builtin_amdgcn_mfma_f32_32x32x16_bf16(PAF(3), VFR(3), o[0], 0, 0, 0), C1, 8); \
    GAPB(o[1] = __builtin_amdgcn_mfma_f32_32x32x16_bf16(PAF(3), VFR(7), o[1], 0, 0, 0), C1, 12); \
    } while (0)
  int t = 1;
  for (; t + 5 < NT; t += 2) {
    STEPM(pB0, pB1, pA0, pA1, t, true, true, true);     WAIT_BAR(2); ROT();
    STEPM(pA0, pA1, pB0, pB1, t + 1, true, true, true); WAIT_BAR(2); ROT();
  }
  #define ENDW(tt) do { if ((tt) + 3 < NT) { WAIT_BAR(2); } else if ((tt) + 2 < NT) { WAIT_BAR(1); } else { WAIT_BAR(0); } } while (0)
  for (; t + 1 < NT; t += 2) {
    STEPM(pB0, pB1, pA0, pA1, t, (t + 3 < NT), (t + 1 < NT), (t + 1 < NT));         ENDW(t);     ROT();
    STEPM(pA0, pA1, pB0, pB1, t + 1, (t + 4 < NT), (t + 2 < NT), (t + 2 < NT));     ENDW(t + 1); ROT();
  }
  STEPM(pB0, pB1, pA0, pA1, NT - 1, false, false, false);
  { float sacc = pB0[0] + pB0[1]; _Pragma("unroll") for (int r = 2; r < 16; ++r) sacc += pB0[r]; _Pragma("unroll") for (int r = 0; r < 16; ++r) sacc += pB1[r]; l_reg += sacc;
    pw0 = (u32x4){PKW(pB0, 0), PKW(pB0, 2), PKW(pB0, 4), PKW(pB0, 6)}; pw1 = (u32x4){PKW(pB0, 8), PKW(pB0, 10), PKW(pB0, 12), PKW(pB0, 14)}; pw2 = (u32x4){PKW(pB1, 0), PKW(pB1, 2), PKW(pB1, 4), PKW(pB1, 6)}; pw3 = (u32x4){PKW(pB1, 8), PKW(pB1, 10), PKW(pB1, 12), PKW(pB1, 14)};
    SBAR(); pv(o, vb0 + sl_cur, PAF(0), PAF(1), PAF(2), PAF(3)); }
  #undef PKW
  #undef PAF
  #undef VFR
  #undef PIN
  #undef MX3
  #undef GAPA
  #undef GAPB
  #undef EX
  #undef VRD
  #undef KRD
  #undef STEPM
  #undef ENDW
  { auto rr = __builtin_amdgcn_permlane32_swap(__float_as_uint(l_reg), __float_as_uint(l_reg), false, false); l_reg = __uint_as_float(rr[0]) + __uint_as_float(rr[1]); }
  if (hi == 0) wsf[32 + r32] = l_reg; asm volatile("s_waitcnt lgkmcnt(0)" ::: "memory");
  float rli[16];
  #pragma unroll
  for (int r = 0; r < 16; ++r) rli[r] = __builtin_amdgcn_rcpf(wsf[32 + crow(r, hi)]);
  bf16* Ow = O + (long)(q0 + wid * QBLK) * OPITCH + OCOL0 + h * D;
  { bf16* stg = (bf16*)(shm + LDS_OST) + wid * 2048;
    #pragma unroll
    for (int r = 0; r < 16; ++r) { const int orow = crow(r, hi);
      #pragma unroll
      for (int d0 = 0; d0 < 2; ++d0) stg[orow * 64 + d0 * 32 + r32] = __float2bfloat16(o[d0][r] * rli[r]); }
    asm volatile("s_waitcnt lgkmcnt(0)" ::: "memory");
    #pragma unroll
    for (int i = 0; i < 4; ++i) { const int row = i * 8 + (lane >> 3), ch = lane & 7; const u32x4 v = *(const u32x4*)(stg + row * 64 + ch * 8); ATTN_STORE16(Ow + (long)row * OPITCH + ch * 8, v); } }
  asm volatile("s_waitcnt lgkmcnt(0)\n\ts_barrier" ::: "memory");
  #undef DMA_K
  #undef DMA_V
  #undef ROT
}
#undef SBAR
#undef WAIT_BAR

typedef int v8i_t __attribute__((ext_vector_type(8)));
typedef short v2s_t __attribute__((ext_vector_type(2)));
typedef _Float16 v2h_t __attribute__((ext_vector_type(2)));
constexpr int F8_SLOT = 4096, F8_RING = 8, F8_LDS_K = 0, F8_LDS_V = F8_RING * F8_SLOT, F8_LDS_WS = 2 * F8_RING * F8_SLOT, F8_LDS_OST = F8_LDS_WS + NW * 64 * 4, F8_LDS_BYTES = F8_LDS_OST + NW * 4096;
#define SBAR() __builtin_amdgcn_sched_barrier(0)
#define WAIT_BAR_(N) asm volatile("s_waitcnt vmcnt(" #N ") lgkmcnt(0)\n\ts_barrier" ::: "memory")
#define WAIT_BAR(N) WAIT_BAR_(N)
#define F8_LAG 2
constexpr int F8_G = 3, F8_DK = F8_G + 1 + F8_LAG, F8_DV = F8_G - 1 + F8_LAG;
static_assert(2 * F8_G + F8_LAG <= F8_RING, "ring too small for the barrier period");
#define SLOTOF(u) ((unsigned)(((u) & (F8_RING - 1)) * F8_SLOT))
#define MFMA8_C(D, A, B, C, SA, SB) do { if (VAR & 64) { D = __builtin_amdgcn_mfma_f32_32x32x16_bf16(__builtin_bit_cast(bf16x8, (u32x4){(unsigned)A[0], (unsigned)A[1], (unsigned)A[2], (unsigned)A[3]}), __builtin_bit_cast(bf16x8, (u32x4){(unsigned)B[0], (unsigned)B[1], (unsigned)B[2], (unsigned)B[3]}), C, 0, 0, 0); \
      D = __builtin_amdgcn_mfma_f32_32x32x16_bf16(__builtin_bit_cast(bf16x8, (u32x4){(unsigned)A[4], (unsigned)A[5], (unsigned)A[6], (unsigned)A[7]}), __builtin_bit_cast(bf16x8, (u32x4){(unsigned)B[4], (unsigned)B[5], (unsigned)B[6], (unsigned)B[7]}), D, 0, 0, 0); } \
    else { asm volatile("s_nop 1\n\tv_mfma_scale_f32_32x32x64_f8f6f4 %0, %1, %2, %3, %4, %5 op_sel_hi:[0,0,0]" : "=&v"(D) : "v"(A), "v"(B), "v"(C), "v"(SA), "v"(SB)); \
      if (VAR & 256) asm volatile("s_nop 1\n\tv_mfma_scale_f32_32x32x64_f8f6f4 %0, %1, %2, %0, %3, %4 op_sel_hi:[0,0,0]" : "+v"(dacc) : "v"(A), "v"(B), "v"(SA), "v"(SB)); } } while (0)
#define MFMA8_ACC(D, A, B, SA, SB) do { if (VAR & 64) { D = __builtin_amdgcn_mfma_f32_32x32x16_bf16(__builtin_bit_cast(bf16x8, (u32x4){(unsigned)A[0], (unsigned)A[1], (unsigned)A[2], (unsigned)A[3]}), __builtin_bit_cast(bf16x8, (u32x4){(unsigned)B[0], (unsigned)B[1], (unsigned)B[2], (unsigned)B[3]}), D, 0, 0, 0); \
      D = __builtin_amdgcn_mfma_f32_32x32x16_bf16(__builtin_bit_cast(bf16x8, (u32x4){(unsigned)A[4], (unsigned)A[5], (unsigned)A[6], (unsigned)A[7]}), __builtin_bit_cast(bf16x8, (u32x4){(unsigned)B[4], (unsigned)B[5], (unsigned)B[6], (unsigned)B[7]}), D, 0, 0, 0); } \
    else { asm volatile("s_nop 1\n\tv_mfma_scale_f32_32x32x64_f8f6f4 %0, %1, %2, %0, %3, %4 op_sel_hi:[0,0,0]" : "+v"(D) : "v"(A), "v"(B), "v"(SA), "v"(SB)); \
      if (VAR & 256) asm volatile("s_nop 1\n\tv_mfma_scale_f32_32x32x64_f8f6f4 %0, %1, %2, %0, %3, %4 op_sel_hi:[0,0,0]" : "+v"(dacc) : "v"(A), "v"(B), "v"(SA), "v"(SB)); } } while (0)
template <int DBL> __device__ __forceinline__ v8i_t lds_frag32x(lds_cptr p) { const u32x4 lo = *(const __attribute__((address_space(3))) u32x4*)p, hi = *(const __attribute__((address_space(3))) u32x4*)(p + 2048);
  if (DBL) { const u32x4 lo2 = *(const volatile __attribute__((address_space(3))) u32x4*)(p + 4096), hi2 = *(const volatile __attribute__((address_space(3))) u32x4*)(p + 4112); asm volatile("" :: "v"(lo2), "v"(hi2)); }
  return (v8i_t){(int)lo.x, (int)lo.y, (int)lo.z, (int)lo.w, (int)hi.x, (int)hi.y, (int)hi.z, (int)hi.w}; }
__device__ __forceinline__ v8i_t lds_frag32(lds_cptr p) { const u32x4 lo = *(const __attribute__((address_space(3))) u32x4*)p, hi = *(const __attribute__((address_space(3))) u32x4*)(p + 16);
  return (v8i_t){(int)lo.x, (int)lo.y, (int)lo.z, (int)lo.w, (int)hi.x, (int)hi.y, (int)hi.z, (int)hi.w}; }
__device__ __forceinline__ unsigned pk4f8(float a, float b, float c, float d) { int p = __builtin_amdgcn_cvt_pk_fp8_f32(a, b, 0, false); p = __builtin_amdgcn_cvt_pk_fp8_f32(c, d, p, true); return (unsigned)p; }
template <int VAR> __device__ __forceinline__ void attn_unit_f8(int h, int kvh, int qb, const unsigned char* Q8, const unsigned char* __restrict__ K8, const unsigned char* __restrict__ VT8, bf16* O, char* shm, int wid, float kmax2) {
  const int lane = fresh_lane(), r32 = lane & 31, hi = lane >> 5; const bool kwave = wid < 4;
  const int q0 = qb * QB;
  const unsigned lds0 = (unsigned)(uintptr_t)shm;
  float* wsf = (float*)(shm + F8_LDS_WS) + wid * 64;
  const int kpl = (wid & 3) >> 1, krow = 32 * (wid & 1) + (lane >> 1), khalf = (lane & 1) ^ ((krow >> 3) & 1), kch = 2 * khalf + kpl;
  const unsigned char* dsrc = kwave ? K8 + (size_t)krow * KPITCH + kvh * D + 16 * kch : VT8 + (size_t)kvh * (NT * 4096) + 1024 * (wid & 3) + 16 * lane;
  const long dstep = kwave ? (long)KVBLK * KPITCH : 4096;
  const unsigned ddst = lds0 + (kwave ? F8_LDS_K : F8_LDS_V) + (wid & 3) * 1024;
  const int doff = kwave ? F8_DK : F8_DV;
  #define DMA_T(t, slot) glds16(dsrc + (long)(t) * dstep, (unsigned)__builtin_amdgcn_readfirstlane(ddst + (slot)))
  const lds_cptr shm3 = (lds_cptr)shm;
  const lds_cptr kp0 = shm3 + F8_LDS_K + r32 * 32 + 16 * (hi ^ ((r32 >> 3) & 1));
  const lds_cptr vp0 = shm3 + F8_LDS_V + r32 * 32 + 16 * (hi ^ ((r32 >> 3) & 1));
  v8i_t qf;
  { const unsigned char* qp = Q8 + (size_t)(q0 + wid * QBLK + r32) * QPITCH + h * D + 32 * hi; const u32x4 lo = *(const u32x4*)qp, hi4 = *(const u32x4*)(qp + 16);
    qf = (v8i_t){(int)lo.x, (int)lo.y, (int)lo.z, (int)lo.w, (int)hi4.x, (int)hi4.y, (int)hi4.z, (int)hi4.w}; }
  #pragma unroll
  for (int i = 0; i <= F8_DK; ++i) { if (i <= F8_DV) { DMA_T(i, SLOTOF(i)); } else if (kwave) { DMA_T(i, SLOTOF(i)); } }
  f32x16 lacc = f32x16{}; f32x16 o[2]; o[0] = f32x16{}; o[1] = f32x16{}; f32x16 negm;
  v8i_t ones8 = {0x38383838, 0x38383838, 0x38383838, 0x38383838, 0x38383838, 0x38383838, 0x38383838, 0x38383838}; asm volatile("" : "+v"(ones8));
  { float qn2 = 0.f;
    #pragma unroll
    for (int i = 0; i < 8; ++i) { const float f0 = __builtin_amdgcn_cvt_f32_fp8(qf[i], 0), f1 = __builtin_amdgcn_cvt_f32_fp8(qf[i], 1), f2 = __builtin_amdgcn_cvt_f32_fp8(qf[i], 2), f3 = __builtin_amdgcn_cvt_f32_fp8(qf[i], 3);
      qn2 += ((f0 * f0 + f1 * f1) + (f2 * f2 + f3 * f3)) * (1.f / 256.f); }
    auto rr = __builtin_amdgcn_permlane32_swap(__float_as_uint(qn2), __float_as_uint(qn2), false, false); qn2 = __uint_as_float(rr[0]) + __uint_as_float(rr[1]);
    const float bnd = sqrtf(qn2 * kmax2) * 1.004f + 0.01f;
    #pragma unroll
    for (int r = 0; r < 16; ++r) negm[r] = 8.f - bnd;
    asm volatile("" : "+v"(negm)); }
  int sQ = 0x7B7B7B7B, sONE = 0x7F7F7F7F; asm volatile("" : "+v"(sQ), "+v"(sONE));
  f32x16 dacc = f32x16{}; f32x16 pA0, pA1, pB0, pB1; v8i_t kf0, kf1, vfA0, vfA1, vfB0, vfB1, pwA = {0, 0, 0, 0, 0, 0, 0, 0}, pwB = {0, 0, 0, 0, 0, 0, 0, 0};
  #define PIN(x) asm volatile("" : "+v"(x))
  WAIT_BAR(F8_LAG);
  kf0 = lds_frag32x<(VAR & 512) != 0>(kp0); kf1 = lds_frag32x<(VAR & 512) != 0>(kp0 + 1024);
  asm volatile("s_waitcnt lgkmcnt(0)" ::: "memory");
  MFMA8_C(pA0, kf0, qf, negm, sONE, sQ); MFMA8_C(pA1, kf1, qf, negm, sONE, sQ);
  asm volatile("s_nop 15\n\ts_nop 15\n\ts_nop 7" : "+v"(pA0), "+v"(pA1));
  #pragma unroll
  for (int r = 0; r < 16; ++r) pA0[r] = __builtin_amdgcn_exp2f(pA0[r]);
  #define CVT2P(dst, a, b, c, d) do { dst = __builtin_amdgcn_cvt_pk_fp8_f32(a, b, dst, false); dst = __builtin_amdgcn_cvt_pk_fp8_f32(c, d, dst, true); } while (0)
  CVT2P(pwA[0], pA0[0], pA0[1], pA0[2], pA0[3]); CVT2P(pwA[1], pA0[4], pA0[5], pA0[6], pA0[7]); CVT2P(pwA[2], pA0[8], pA0[9], pA0[10], pA0[11]); CVT2P(pwA[3], pA0[12], pA0[13], pA0[14], pA0[15]);
  #undef CVT2P
  kf0 = lds_frag32x<(VAR & 512) != 0>(kp0 + SLOTOF(1)); kf1 = lds_frag32x<(VAR & 512) != 0>(kp0 + SLOTOF(1) + 1024);
  #define CVT2(dst, a, b, c, d) do { if (VAR & 1024) { v2s_t r_ = __builtin_bit_cast(v2s_t, dst); r_ = __builtin_amdgcn_cvt_scalef32_pk_fp8_f32(r_, a, b, 1.0f, false); r_ = __builtin_amdgcn_cvt_scalef32_pk_fp8_f32(r_, c, d, 1.0f, true); dst = __builtin_bit_cast(int, r_); } \
    else if (VAR & 2048) { v2s_t r_ = __builtin_bit_cast(v2s_t, dst); const v2h_t h0_ = __builtin_bit_cast(v2h_t, __builtin_amdgcn_cvt_pkrtz(a, b)), h1_ = __builtin_bit_cast(v2h_t, __builtin_amdgcn_cvt_pkrtz(c, d)); r_ = __builtin_amdgcn_cvt_scalef32_pk_fp8_f16(r_, h0_, 1.0f, false); r_ = __builtin_amdgcn_cvt_scalef32_pk_fp8_f16(r_, h1_, 1.0f, true); dst = __builtin_bit_cast(int, r_); } \
    else if (VAR & 16) { asm volatile("" : "+v"(dst) : "v"(a), "v"(b), "v"(c), "v"(d)); } else { dst = __builtin_amdgcn_cvt_pk_fp8_f32(a, b, dst, false); dst = __builtin_amdgcn_cvt_pk_fp8_f32(c, d, dst, true); if (VAR & 32) { asm volatile("" : "+v"(dst)); dst = __builtin_amdgcn_cvt_pk_fp8_f32(a, b, dst, false); dst = __builtin_amdgcn_cvt_pk_fp8_f32(c, d, dst, true); } } } while (0)
  #define EXF(v) ((VAR & 1) ? (v) * 0.999f : ((VAR & 128) ? __builtin_amdgcn_exp2f(__builtin_amdgcn_exp2f(v) * 1e-30f) + __builtin_amdgcn_exp2f(v) - 1.0f : __builtin_amdgcn_exp2f(v)))
  #define EX4(X, B) do { X[B] = EXF(X[B]); X[B + 1] = EXF(X[B + 1]); X[B + 2] = EXF(X[B + 2]); X[B + 3] = EXF(X[B + 3]); } while (0)
  #define STEP8(C0, C1, P1, PW, PWN, VF0, VF1, t, GK, GV, GL) do { SBAR(); \
    VF0 = lds_frag32x<(VAR & 512) != 0>(vp0 + SLOTOF((t) - 1)); VF1 = lds_frag32x<(VAR & 512) != 0>(vp0 + SLOTOF((t) - 1) + 1024); SBAR(); \
    if (VAR & 2) { C0 = negm; asm volatile("" : "+v"(C0) : "v"(kf0)); } else { MFMA8_C(C0, kf0, qf, negm, sONE, sQ); } SBAR(); \
    EX4(P1, 0); EX4(P1, 4); EX4(P1, 8); PIN(P1); SBAR(); \
    if (VAR & 2) { C1 = negm; asm volatile("" : "+v"(C1) : "v"(kf1)); } else { MFMA8_C(C1, kf1, qf, negm, sONE, sQ); } SBAR(); \
    EX4(P1, 12); \
    CVT2(PW[4], P1[0], P1[1], P1[2], P1[3]); CVT2(PW[5], P1[4], P1[5], P1[6], P1[7]); CVT2(PW[6], P1[8], P1[9], P1[10], P1[11]); CVT2(PW[7], P1[12], P1[13], P1[14], P1[15]); \
    PIN(PW); SBAR(); \
    if ((GK) && (GV)) { DMA_T((t) + doff, SLOTOF((t) + doff)); }     \
    else if (kwave) { if (GK) { DMA_T((t) + F8_DK, SLOTOF((t) + F8_DK)); } } else { if (GV) { DMA_T((t) + F8_DV, SLOTOF((t) + F8_DV)); } } \
    if (GL) { kf0 = lds_frag32x<(VAR & 512) != 0>(kp0 + SLOTOF((t) + 1)); kf1 = lds_frag32x<(VAR & 512) != 0>(kp0 + SLOTOF((t) + 1) + 1024); } SBAR(); \
    if (VAR & 2) { asm volatile("" : "+v"(lacc) : "v"(PW)); } else { MFMA8_ACC(lacc, PW, ones8, sONE, sONE); } asm volatile("" : "+v"(C0)); SBAR(); \
    EX4(C0, 0); EX4(C0, 4); PIN(C0); SBAR(); \
    if (VAR & 2) { asm volatile("" : "+v"(o[0]) : "v"(PW), "v"(VF0)); } else { MFMA8_ACC(o[0], PW, VF0, sONE, sONE); } SBAR(); \
    EX4(C0, 8); EX4(C0, 12); PIN(C0); SBAR(); \
    if (VAR & 2) { asm volatile("" : "+v"(o[1]) : "v"(PW), "v"(VF1)); } else { MFMA8_ACC(o[1], PW, VF1, sONE, sONE); } SBAR(); \
    CVT2(PWN[0], C0[0], C0[1], C0[2], C0[3]); CVT2(PWN[1], C0[4], C0[5], C0[6], C0[7]); CVT2(PWN[2], C0[8], C0[9], C0[10], C0[11]); CVT2(PWN[3], C0[12], C0[13], C0[14], C0[15]); PIN(PWN); SBAR(); } while (0)
  int t = 1;
  #define GBAR() do { if (VAR & 4) { asm volatile("s_waitcnt vmcnt(2) lgkmcnt(0)" ::: "memory"); } else { WAIT_BAR(F8_LAG); } } while (0)
  #pragma unroll 1
  for (; t + 5 + F8_DK < NT; t += 6) {
    STEP8(pB0, pB1, pA1, pwA, pwB, vfA0, vfA1, t, true, true, true);
    STEP8(pA0, pA1, pB1, pwB, pwA, vfB0, vfB1, t + 1, true, true, true);
    STEP8(pB0, pB1, pA1, pwA, pwB, vfA0, vfA1, t + 2, true, true, true); GBAR();
    STEP8(pA0, pA1, pB1, pwB, pwA, vfB0, vfB1, t + 3, true, true, true);
    STEP8(pB0, pB1, pA1, pwA, pwB, vfA0, vfA1, t + 4, true, true, true);
    STEP8(pA0, pA1, pB1, pwB, pwA, vfB0, vfB1, t + 5, true, true, true); GBAR();
  }
  #undef GBAR
  for (; t + 1 < NT; t += 2) {
    STEP8(pB0, pB1, pA1, pwA, pwB, vfA0, vfA1, t, (t + F8_DK < NT), (t + F8_DV < NT), (t + 1 < NT));         WAIT_BAR(0);
    STEP8(pA0, pA1, pB1, pwB, pwA, vfB0, vfB1, t + 1, (t + 1 + F8_DK < NT), (t + 1 + F8_DV < NT), (t + 2 < NT));     WAIT_BAR(0);
  }
  STEP8(pB0, pB1, pA1, pwA, pwB, vfA0, vfA1, NT - 1, false, false, false);
  { asm volatile("s_nop 15\n\ts_nop 15\n\ts_nop 7" : "+v"(pB1));
    EX4(pB1, 0); EX4(pB1, 4); EX4(pB1, 8); EX4(pB1, 12);
    CVT2(pwB[4], pB1[0], pB1[1], pB1[2], pB1[3]); CVT2(pwB[5], pB1[4], pB1[5], pB1[6], pB1[7]); CVT2(pwB[6], pB1[8], pB1[9], pB1[10], pB1[11]); CVT2(pwB[7], pB1[12], pB1[13], pB1[14], pB1[15]);
    vfB0 = lds_frag32x<(VAR & 512) != 0>(vp0 + SLOTOF(NT - 1)); vfB1 = lds_frag32x<(VAR & 512) != 0>(vp0 + SLOTOF(NT - 1) + 1024);
    asm volatile("s_waitcnt lgkmcnt(0)" ::: "memory"); PIN(pwB); SBAR();
    MFMA8_ACC(o[0], pwB, vfB0, sONE, sONE); MFMA8_ACC(o[1], pwB, vfB1, sONE, sONE); MFMA8_ACC(lacc, pwB, ones8, sONE, sONE);
    asm volatile("s_nop 15\n\ts_nop 15\n\ts_nop 7" : "+v"(o[0]), "+v"(o[1]), "+v"(lacc)); }
  #undef STEP8
  #undef CVT2
  #undef EX4
  #undef EXF
  #undef PIN
  if (VAR & 256) asm volatile("" :: "v"(dacc));
  float rli[16];
  #pragma unroll
  for (int r = 0; r < 16; ++r) rli[r] = __builtin_amdgcn_rcpf(lacc[r]);
  bf16* Ow = O + (long)(q0 + wid * QBLK) * OPITCH + OCOL0 + h * D;
  { bf16* stg = (bf16*)(shm + F8_LDS_OST) + wid * 2048;
    #pragma unroll
    for (int r = 0; r < 16; ++r) { const int orow = crow(r, hi);
      #pragma unroll
      for (int d0 = 0; d0 < 2; ++d0) stg[orow * 64 + d0 * 32 + r32] = __float2bfloat16(o[d0][r] * rli[r]); }
    asm volatile("s_waitcnt lgkmcnt(0)" ::: "memory");
    #pragma unroll
    for (int i = 0; i < 4; ++i) { const int row = i * 8 + (lane >> 3), ch = lane & 7; const u32x4 v = *(const u32x4*)(stg + row * 64 + ch * 8); if (!(VAR & 8)) ATTN_STORE16(Ow + (long)row * OPITCH + ch * 8, v); } }
  asm volatile("s_waitcnt vmcnt(0) lgkmcnt(0)\n\ts_barrier" ::: "memory");
  #undef DMA_T
}
#undef MFMA8_C
#undef MFMA8_ACC
#undef SBAR
#undef WAIT_BAR
#undef WAIT_BAR_
#undef SLOTOF
}

constexpr int NWAVES = 8, NTHR = NWAVES * 64;
constexpr size_t MiB = 1u << 20;
constexpr size_t WS_CTL = 0, CTL_ZERO_BYTES = 64 * 1024;
constexpr size_t WS_MOD = 1 * MiB;
constexpr size_t WS_MISC = WS_MOD + 64 * 1024;
constexpr size_t WS_IDX = WS_MISC, WS_GATE = WS_IDX + 128 * 1024, WS_TOKSLOT = WS_GATE + 128 * 1024;
constexpr size_t WS_AFF = 3 * MiB;
constexpr size_t WS_WIN = 4 * MiB;
constexpr size_t WS_WOUT = 7 * MiB;
constexpr size_t WS_WGU = 9 * MiB;
constexpr size_t WS_WD = 137 * MiB;
constexpr size_t WS_X1 = 201 * MiB;
constexpr size_t WS_R1 = 265 * MiB;
constexpr size_t WS_XN = WS_R1;
constexpr size_t WS_Q = WS_XN + (size_t)NROWS * DM * 2;
constexpr size_t WS_K = WS_Q + (size_t)NTOK * 768 * 2;
constexpr size_t WS_V = WS_K + (size_t)NROWS * 256 * 2;
constexpr size_t WS_FT = WS_V + (size_t)NROWS * 256 * 2;
constexpr size_t WS_MIX = WS_FT + (size_t)256 * NTOK * 4;
constexpr size_t WS_HID = WS_R1;
constexpr size_t WS_R2 = 393 * MiB;
constexpr size_t WS_H2 = WS_R2;
constexpr size_t WS_YE = WS_R2;
constexpr size_t WS_END = 457 * MiB;
static_assert(WS_MIX + (size_t)NTOK * DM * 2 <= WS_R1 + 128 * MiB, "R1 map");
static_assert(WS_TOKSLOT + (size_t)NTOK * 16 * 4 <= WS_AFF, "misc map");
constexpr int CW_TMO = 0, CW_FLAG = 2, CW_KMAX = 64, CW_BAR = 1024;

constexpr int LDS_BYTES = 163840;
constexpr int RING_BYTES = 131072, XTRA_OFF = RING_BYTES;
constexpr int MISC_OFF = LDS_BYTES - 512;

#define GAS __attribute__((address_space(1)))
#define LAS __attribute__((address_space(3)))
typedef unsigned short bf16;
typedef unsigned v4u __attribute__((ext_vector_type(4)));
typedef unsigned v2u __attribute__((ext_vector_type(2)));
typedef float f32x4 __attribute__((ext_vector_type(4)));
typedef float f32x2 __attribute__((ext_vector_type(2)));
typedef GAS unsigned gu32;
#define RLX_AGENT __ATOMIC_RELAXED, __HIP_MEMORY_SCOPE_AGENT
#define LDS_WAIT() asm volatile("s_waitcnt lgkmcnt(0)" ::: "memory")
#define VM_WAIT() asm volatile("s_waitcnt vmcnt(0)" ::: "memory")
__device__ __forceinline__ unsigned f2bf(float f) { unsigned u = __builtin_bit_cast(unsigned, f); return (u + 0x7fffu + ((u >> 16) & 1u)) >> 16; }
__device__ __forceinline__ unsigned pk2(float lo, float hi) { return f2bf(lo) | (f2bf(hi) << 16); }
__device__ __forceinline__ unsigned pk4_fp8(float a, float b, float c, float d) { int p = __builtin_amdgcn_cvt_pk_fp8_f32(a, b, 0, false); p = __builtin_amdgcn_cvt_pk_fp8_f32(c, d, p, true); return (unsigned)p; }
__device__ __forceinline__ float bf2f(unsigned short b) { return __builtin_bit_cast(float, (unsigned)b << 16); }

#define XB_TMO      128
#define XB_XCNT(j)  (256  + 64 * (j))
#define XB_XSUB(j)  (1280 + 64 * (j))
#define XB_XGEN(j)  (2304 + 64 * (j))
#define XB_TOP      3328
#define XB_TOPGEN   3392
#define XCD_BAR_WORDS 3456
#define XB_SPIN_CAP (1u << 20)
static_assert((CW_BAR + XCD_BAR_WORDS) * 4 <= (int)CTL_ZERO_BYTES, "ctl");
__device__ __forceinline__ unsigned xb_ld(unsigned* p)              { return __hip_atomic_load(p, __ATOMIC_RELAXED, __HIP_MEMORY_SCOPE_AGENT); }
__device__ __forceinline__ unsigned xb_add(unsigned* p, unsigned v) { return __hip_atomic_fetch_add(p, v, __ATOMIC_RELAXED, __HIP_MEMORY_SCOPE_AGENT); }
__device__ __forceinline__ unsigned xb_xcc_id() { return (unsigned)__builtin_amdgcn_s_getreg((3 << 11) | 20) & 0xFu; }
#define XB_SPIN(cond, bar) do { unsigned _sp = 0; while (cond) { __builtin_amdgcn_s_sleep(1); \
    if ((++_sp & 255u) == 0u) { if (xb_ld(&(bar)[XB_TMO])) break; if (_sp > XB_SPIN_CAP) { atomicAdd(&(bar)[XB_TMO], 1u); break; } } } } while (0)
struct XcdBarrier { unsigned* bar; unsigned x; volatile LAS unsigned* st; };
__device__ __forceinline__ XcdBarrier xcd_barrier_post(unsigned* bar, volatile LAS unsigned* st, bool leader) {
    XcdBarrier b; b.bar = bar; b.x = xb_xcc_id(); b.st = st;
    if (leader) (void)xb_add(&bar[XB_XCNT(b.x)], 1u);
    return b;
}
__device__ __forceinline__ void xcd_barrier_complete(unsigned* bar, unsigned x, unsigned& nloc, unsigned& nx) {
    const unsigned G = gridDim.x * gridDim.y * gridDim.z;
    unsigned sum, cnt, mine, sp = 0u;
    for (;;) {
        sum = 0u; cnt = 0u; mine = 0u;
#pragma unroll
        for (unsigned j = 0; j < 16; ++j) { const unsigned c = xb_ld(&bar[XB_XCNT(j)]); sum += c; cnt += (c > 0u) ? 1u : 0u; mine = (j == x) ? c : mine; }
        if (sum == G) break;
        __builtin_amdgcn_s_sleep(1);
        if ((++sp & 255u) == 0u) { if (xb_ld(&bar[XB_TMO])) break; if (sp > XB_SPIN_CAP) { atomicAdd(&bar[XB_TMO], 1u); break; } }
    }
    nloc = mine > 0u ? mine : 1u; nx = cnt > 0u ? cnt : 1u;
}
__device__ __forceinline__ void xcd_barrier(const XcdBarrier& b, int wave) {
    asm volatile("s_waitcnt vmcnt(0)" ::: "memory");
    __syncthreads();
    if (wave == 0 && fresh_lane() == 0) {
        unsigned* bar = b.bar;
        __builtin_amdgcn_s_waitcnt(0);
        unsigned nloc = b.st[0], nx = b.st[1];
        if (nloc == 0u) { xcd_barrier_complete(bar, b.x, nloc, nx); b.st[0] = nloc; b.st[1] = nx; }
        const unsigned old = xb_add(&bar[XB_XSUB(b.x)], 1u);
        const unsigned gen = old / nloc;
        if (old + 1u == (gen + 1u) * nloc) {
            __builtin_amdgcn_fence(__ATOMIC_RELEASE, "agent");
            asm volatile("s_waitcnt vmcnt(0)" ::: "memory");
            const unsigned og = xb_add(&bar[XB_TOP], 1u);
            const unsigned tg = og / nx;
            if (og + 1u == (tg + 1u) * nx) xb_add(&bar[XB_TOPGEN], 1u);
            else XB_SPIN(xb_ld(&bar[XB_TOPGEN]) == tg, bar);
            __builtin_amdgcn_fence(__ATOMIC_ACQUIRE, "agent");
            xb_add(&bar[XB_XGEN(b.x)], 1u);
            asm volatile("s_waitcnt vmcnt(0)" ::: "memory");
        } else {
            XB_SPIN(xb_ld(&bar[XB_XGEN(b.x)]) == gen, bar);
            __builtin_amdgcn_fence(__ATOMIC_ACQUIRE, "agent");
            asm volatile("s_waitcnt vmcnt(0)" ::: "memory");
        }
    }
    __syncthreads();
}

struct Args {
    const float *x, *c, *ctx, *c_ctx, *w_mod, *b_mod, *norm_mix_g, *norm_ffn_g, *w_in, *w_four, *q_norm_g, *k_norm_g, *w_out, *w_router, *w_gate, *w_up, *w_down, *final_norm_g;
    float* out; unsigned char* ws;
};

__device__ __forceinline__ float wave_sum(float v) {
#pragma unroll
    for (int o = 1; o < 64; o <<= 1) v += __shfl_xor(v, o);
    return v;
}

template <class RowMap>
__device__ __forceinline__ void tr_item(const float* __restrict__ W, int ldw, int k0, int n0, bf16* WT, int ldt, int kdst0, const RowMap& drow, LAS float* scr, int lane) {
    const int kq = lane >> 4, nq = lane & 15;
    f32x4 v[16];
#pragma unroll
    for (int it = 0; it < 16; ++it) v[it] = *(const f32x4*)(W + (size_t)(k0 + 4 * it + kq) * ldw + n0 + 4 * nq);
#pragma unroll
    for (int it = 0; it < 16; ++it) { LAS float* s = scr + (4 * it + kq) * 65 + 4 * nq; s[0] = v[it][0]; s[1] = v[it][1]; s[2] = v[it][2]; s[3] = v[it][3]; }
    LDS_WAIT(); asm volatile("" ::: "memory");
    const int c = lane >> 3, nn = lane & 7;
#pragma unroll
    for (int j = 0; j < 8; ++j) { const int n = nn + 8 * j; const LAS float* s = scr + (8 * c) * 65 + n;
        v4u o; o.x = pk2(s[0 * 65], s[1 * 65]); o.y = pk2(s[2 * 65], s[3 * 65]); o.z = pk2(s[4 * 65], s[5 * 65]); o.w = pk2(s[6 * 65], s[7 * 65]);
        *(GAS v4u*)(WT + (size_t)drow(n0 + n) * ldt + kdst0 + k0 + 8 * c) = o; }
    LDS_WAIT(); asm volatile("" ::: "memory");
}
struct RowId { int base; __device__ __forceinline__ int operator()(int n) const { return base + n; } };
struct RowQKV { __device__ __forceinline__ int operator()(int n) const { const int t = n >> 8, w = n & 255, hd = w >> 6, d = w & 63; return 256 + 256 * t + 128 * (d >> 5) + 32 * hd + (d & 31); } };
struct RowGU { int base, up; __device__ __forceinline__ int operator()(int f) const { return base + 256 * (f >> 7) + 128 * up + (f & 127); } };


constexpr int MOE_ITEMS = 3 * 8192;
struct TrDesc { const float* src; bf16* dst; int ldw, ldt, f8; };
__device__ __forceinline__ TrDesc moe_desc(const Args& a, int r) {
    TrDesc d;
    if (r < 16384) { const int up = r >> 13, rr = r & 8191, e = rr >> 9, q = rr & 511, kb = q >> 5, nb = q & 31;
        d.src = (up ? a.w_up : a.w_gate) + (size_t)e * DM * DE + (size_t)(kb * 64) * DE + nb * 64; d.ldw = DE;
        d.dst = (bf16*)((unsigned char*)(a.ws + WS_WGU) + ((size_t)e * 4096 + 256 * (nb >> 1) + 128 * up + 64 * (nb & 1)) * DM + kb * 64); d.ldt = DM; d.f8 = 1; }
    else { const int rr = r - 16384, e = rr >> 9, q = rr & 511, kb = q >> 4, nb = q & 15;
        d.src = a.w_down + (size_t)e * DE * DM + (size_t)(kb * 64) * DM + nb * 64; d.ldw = DM;
        d.dst = (bf16*)((unsigned char*)(a.ws + WS_WD) + ((size_t)e * DM + nb * 64) * DE + kb * 64); d.ldt = DE; d.f8 = 1; }
    return d;
}
#define TR_LOAD(v, d) do { _Pragma("unroll") for (int _it = 0; _it < 16; ++_it) v[_it] = *(const f32x4*)((d).src + (size_t)(4 * _it + kq) * (d).ldw + 4 * nq); } while (0)
#define TR_PROC(v, d) do { \
    _Pragma("unroll") for (int _it = 0; _it < 16; ++_it) { LAS float* s_ = scr + (4 * _it + kq) * 65 + 4 * nq; s_[0] = v[_it][0]; s_[1] = v[_it][1]; s_[2] = v[_it][2]; s_[3] = v[_it][3]; } \
    LDS_WAIT(); asm volatile("" ::: "memory"); \
    if ((d).f8) { _Pragma("unroll") for (int _j = 0; _j < 8; ++_j) { const int n_ = nn + 8 * _j; const LAS float* s_ = scr + (8 * c8) * 65 + n_; \
        v2u o_; o_.x = pk4_fp8(s_[0 * 65] * 32.f, s_[1 * 65] * 32.f, s_[2 * 65] * 32.f, s_[3 * 65] * 32.f); o_.y = pk4_fp8(s_[4 * 65] * 32.f, s_[5 * 65] * 32.f, s_[6 * 65] * 32.f, s_[7 * 65] * 32.f); \
        *(GAS v2u*)((unsigned char*)(d).dst + (size_t)n_ * (d).ldt + 8 * c8) = o_; } } \
    else { _Pragma("unroll") for (int _j = 0; _j < 8; ++_j) { const int n_ = nn + 8 * _j; const LAS float* s_ = scr + (8 * c8) * 65 + n_; \
        v4u o_; o_.x = pk2(s_[0 * 65], s_[1 * 65]); o_.y = pk2(s_[2 * 65], s_[3 * 65]); o_.z = pk2(s_[4 * 65], s_[5 * 65]); o_.w = pk2(s_[6 * 65], s_[7 * 65]); \
        *(GAS v4u*)((d).dst + (size_t)n_ * (d).ldt + 8 * c8) = o_; } } \
    LDS_WAIT(); asm volatile("" ::: "memory"); } while (0)
__device__ __forceinline__ void moe_convert(const Args& a, LAS float* scr, int lo, int hi, int w, int nw) {
    const int lane = fresh_lane(), kq = lane >> 4, nq = lane & 15, c8 = lane >> 3, nn = lane & 7;
    int it = lo + w; if (it >= hi) return;
    f32x4 va[16], vb[16];
    TrDesc da = moe_desc(a, it), db = da; TR_LOAD(va, da);
    for (;;) {
        int nx = it + nw; bool hn = nx < hi;
        if (hn) { db = moe_desc(a, nx); TR_LOAD(vb, db); }
        TR_PROC(va, da);
        if (!hn) break;
        it = nx; nx = it + nw; hn = nx < hi;
        if (hn) { da = moe_desc(a, nx); TR_LOAD(va, da); }
        TR_PROC(vb, db);
        if (!hn) break;
        it = nx;
    }
}
#ifndef MOE_S0
#define MOE_S0 0
#endif
#ifndef MOE_S1
#define MOE_S1 4096
#endif
#ifndef MOE_S2
#define MOE_S2 0
#endif
#ifndef MOE_S3
#define MOE_S3 9472
#endif
constexpr int MOE_B0 = MOE_S0, MOE_B1 = MOE_B0 + MOE_S1, MOE_B2 = MOE_B1 + MOE_S2, MOE_B3 = MOE_B2 + MOE_S3;

__host__ __device__ __forceinline__ int four_pos(int mp) { return mp == 0 ? 0 : (mp == 32 ? 1 : (mp < 32 ? 2 * mp : 2 * (64 - mp) + 1)); }

__device__ __forceinline__ void p0_prologue(const Args& a, LAS unsigned char* lds, int vcu, int G, int wave) {
    const int lane = fresh_lane(), tid = wave * 64 + lane;
    unsigned char* ws = a.ws;
    bf16* WinT = (bf16*)(ws + WS_WIN); bf16* WoT = (bf16*)(ws + WS_WOUT);
    float* MOD = (float*)(ws + WS_MOD);
    for (int item = vcu; item < 256; item += G) {
        LAS float* red = (LAS float*)lds;
        f32x4 a0 = {0.f, 0.f, 0.f, 0.f}, a1 = {0.f, 0.f, 0.f, 0.f};
        if (lane < 60) {
            const int rr = lane / 6, cq = lane % 6, col = item * 24 + 4 * cq;
#pragma unroll
            for (int it = 0; it < 13; ++it) { const int k = wave * 128 + it * 10 + rr;
                if (it * 10 + rr < 128) { const f32x4 w = *(const f32x4*)(a.w_mod + (size_t)k * (NMOD * DM) + col); const float c0 = a.c[k], c1 = a.c_ctx[k];
                    const float s0 = c0 / (1.f + __expf(-c0)), s1 = c1 / (1.f + __expf(-c1)); a0 += w * s0; a1 += w * s1; } }
        }
        *(LAS f32x4*)(red + ((wave * 2 + 0) * 64 + lane) * 4) = a0; *(LAS f32x4*)(red + ((wave * 2 + 1) * 64 + lane) * 4) = a1;
        __syncthreads();
        if (tid < 48) { const int v = tid / 24, cc = tid % 24, cq = cc >> 2, e = cc & 3; float sum = 0.f;
            for (int w = 0; w < 8; ++w)
#pragma unroll
                for (int r = 0; r < 10; ++r) sum += red[((w * 2 + v) * 64 + r * 6 + cq) * 4 + e];
            MOD[v * (NMOD * DM) + item * 24 + cc] = sum + a.b_mod[item * 24 + cc]; }
        __syncthreads();
    }
    const int cg = -1;
    LAS float* scr = (LAS float*)(lds + wave * 16640);
    constexpr int I_F1 = 256, I_F2 = 256, I_IN = 16 * 20, I_OUT = 12 * 16;
    constexpr int NITEMS = I_F1 + I_F2 + I_IN + I_OUT;
    for (int it = wave * G + vcu; it < NITEMS; it += NWAVES * G) {
        int r = it;
        if (r < I_F1) {
            const int g = r & 3, kb = (r >> 2) & 15, jq = r >> 6, k = kb * 64 + lane;
            LAS float* ct = scr;
            ct[lane] = cospif((float)lane * (1.f / 32.f)); LDS_WAIT(); asm volatile("" ::: "memory");
            float w[64];
#pragma unroll
            for (int c4 = 0; c4 < 16; ++c4) { const f32x4 t = *(const f32x4*)(a.w_in + (size_t)k * INW + 64 * g + 4 * c4); w[4 * c4] = t[0]; w[4 * c4 + 1] = t[1]; w[4 * c4 + 2] = t[2]; w[4 * c4 + 3] = t[3]; }
            for (int j = 16 * jq; j < 16 * jq + 16; ++j) { const int m = j <= 32 ? j : j - 32; const int ph = j <= 32 ? 0 : 48;
                float s = 0.f;
#pragma unroll
                for (int c = 0; c < 64; ++c) s += w[c] * ct[(c * m + ph) & 63];
                WinT[(size_t)(64 * g + j) * DM + k] = (bf16)f2bf(s * (1.f / 1024.f)); }
            LDS_WAIT(); asm volatile("" ::: "memory");
            continue; }
        r -= I_F1;
        if (r < I_F2) {
            const int g = r & 3, jb = (r >> 2) & 15, mq = r >> 6, j = jb * 64 + lane;
            float w[64];
#pragma unroll
            for (int d = 0; d < 64; ++d) w[d] = a.w_out[(size_t)(64 * g + d) * DM + j];
            for (int mp = 16 * mq; mp < 16 * mq + 16; ++mp) { float s = 0.f; const float* wf = a.w_four + (size_t)(g * 64 + mp) * 64;
#pragma unroll
                for (int d = 0; d < 64; ++d) s += wf[d] * w[d];
                WoT[(size_t)j * DM + 64 * g + four_pos(mp)] = (bf16)f2bf(s); }
            continue; }
        r -= I_F2;
        if (r < I_IN) { const int kb = r / 20, nb = r % 20; tr_item(a.w_in + 256, INW, kb * 64, nb * 64, WinT, DM, 0, RowQKV{}, scr, lane); continue; }
        r -= I_IN;
        { const int kb = r / 16, nb = r % 16; tr_item(a.w_out + (size_t)256 * DM, DM, kb * 64, nb * 64, WoT, DM, 256, RowId{0}, scr, lane); }
    }
    if (cg < 0 && MOE_S0 > 0) moe_convert(a, scr, 0, MOE_B0, ((wave + 4) & 7) * (G - 24) + vcu, NWAVES * (G - 24));
}

__device__ __forceinline__ void p0b_modulate(const Args& a, int vcu, int G, int wave) {
    const int lane = fresh_lane();
    unsigned char* ws = a.ws; const float* MOD = (const float*)(ws + WS_MOD); bf16* XN = (bf16*)(ws + WS_XN);
    const int gw = vcu * NWAVES + wave, NGW = G * NWAVES;
    for (int pass = 0; pass < 2; ++pass) {
        const float* md = MOD + pass * (NMOD * DM);
        const int nrows = pass == 0 ? NTOK : NCTX; const float* src = pass == 0 ? a.x : a.ctx; bf16* dst = XN + (size_t)(pass == 0 ? 0 : NTOK) * DM;
        if (gw >= nrows) continue;
        f32x4 av[4], sh[4];
#pragma unroll
        for (int j = 0; j < 4; ++j) { const int col = 4 * lane + 256 * j; const f32x4 g = *(const f32x4*)(a.norm_mix_g + col); const f32x4 sc = *(const f32x4*)(md + DM + col); av[j] = g * (sc + 1.f); sh[j] = *(const f32x4*)(md + col); }
        f32x4 v[4], vn[4];
        { const GAS f32x4* xr = (const GAS f32x4*)(src + (size_t)gw * DM) + lane;
#pragma unroll
          for (int j = 0; j < 4; ++j) v[j] = xr[64 * j]; }
        for (int m = gw; m < nrows; m += NGW) {
            const int mn = m + NGW;
            if (mn < nrows) { const GAS f32x4* xr = (const GAS f32x4*)(src + (size_t)mn * DM) + lane;
#pragma unroll
                for (int j = 0; j < 4; ++j) vn[j] = xr[64 * j]; }
            float s = 0.f;
#pragma unroll
            for (int j = 0; j < 4; ++j) s += (v[j].x * v[j].x + v[j].y * v[j].y) + (v[j].z * v[j].z + v[j].w * v[j].w);
            const float rinv = 1.f / sqrtf(wave_sum(s) * (1.f / DM) + EPS);
            GAS unsigned long long* o8 = (GAS unsigned long long*)(dst + (size_t)m * DM) + lane;
#pragma unroll
            for (int j = 0; j < 4; ++j) { const f32x4 y = v[j] * rinv * av[j] + sh[j]; o8[64 * j] = (unsigned long long)pk2(y.x, y.y) | ((unsigned long long)pk2(y.z, y.w) << 32); }
#pragma unroll
            for (int j = 0; j < 4; ++j) v[j] = vn[j];
        }
    }
}

struct P1Prob {
    static constexpr int K = DM; static constexpr bool PERM = false, FP8 = false; static constexpr int SCW = 0, SCA = 0;
    const bf16* XN; const bf16* WinT; bf16 *Q, *Kb, *Vb; float* FT; const float *qg, *kg; unsigned* kmax; pg8::StaticOrder so;
    __device__ __forceinline__ bool next(int i, pg8::Unit& u) const { return so.next(i, u); }
    __device__ __forceinline__ bool swapped(const pg8::Unit& u) const { return u.pn == 0 || (ATTN_F8 && u.pn == 5); }
    __device__ __forceinline__ const char* aptr(const pg8::Unit& u) const { return swapped(u) ? (const char*)(WinT + (size_t)u.pn * 256 * DM) : (const char*)(XN + (size_t)u.pm * 256 * DM); }
    __device__ __forceinline__ const char* bptr(const pg8::Unit& u) const { return swapped(u) ? (const char*)(XN + (size_t)u.pm * 256 * DM) : (const char*)(WinT + (size_t)u.pn * 256 * DM); }
    __device__ __forceinline__ void epi(const pg8::f32x4 (&acc)[2][2][4][2], const pg8::Unit& u, int wr, int wc, int fr, int fq) const {
        if (u.pn == 0) {
            if (u.pm >= NTOK / 256) return;
#pragma unroll
            for (int ai = 0; ai < 2; ++ai)
#pragma unroll
                for (int m = 0; m < 4; ++m) { float* rowp = FT + (size_t)(ai * 128 + wr * 64 + m * 16 + fr) * NTOK + u.pm * 256 + wc * 32 + 4 * fq;
#pragma unroll
                    for (int bj = 0; bj < 2; ++bj)
#pragma unroll
                        for (int n = 0; n < 2; ++n) *(pg8::f32x4*)(rowp + bj * 128 + n * 16) = acc[ai][bj][m][n]; }
            return;
        }
        const bool isq = u.pn <= 3, isv = u.pn == 5, lat = u.pm < NTOK / 256;
        if (isq && !lat) return;
        if (isv) {
#if ATTN_F8
            unsigned char* V8 = (unsigned char*)Vb;
#pragma unroll
            for (int ai = 0; ai < 2; ++ai)
#pragma unroll
                for (int m = 0; m < 4; ++m) { const int kvh_ = 2 * wr + (m >> 1), d = 32 * ai + 16 * (m & 1) + fr;
#pragma unroll
                    for (int bj = 0; bj < 2; ++bj)
#pragma unroll
                        for (int n = 0; n < 2; ++n) { const int t0 = u.pm * 256 + 128 * bj + 32 * wc + 16 * n + 4 * fq, key0 = t0 & 63, tile = t0 >> 6, k5 = key0 & 31, hk = (k5 >> 2) & 1, j0 = 4 * (k5 >> 3) + 16 * (key0 >> 5);
                            const pg8::f32x4 v = acc[ai][bj][m][n];
                            *(unsigned*)(V8 + (size_t)(kvh_ * (NKEYS / 64) + tile) * 4096 + (j0 >> 4) * 2048 + d * 32 + 16 * (hk ^ ((d >> 3) & 1)) + (j0 & 15)) = pk4_fp8(v[0], v[1], v[2], v[3]); } }
#else
#pragma unroll
            for (int ai = 0; ai < 2; ++ai)
#pragma unroll
                for (int m = 0; m < 4; ++m) { const int t = u.pm * 256 + ai * 128 + wr * 64 + m * 16 + fr; bf16* rowp = Vb + (size_t)t * 256 + wc * 64 + 4 * fq;
#pragma unroll
                    for (int bj = 0; bj < 2; ++bj)
#pragma unroll
                        for (int n = 0; n < 2; ++n) { const pg8::f32x4 v = acc[ai][bj][m][n]; *(v2u*)(rowp + 32 * bj + 16 * n) = (v2u){pk2(v[0], v[1]), pk2(v[2], v[3])}; } }
#endif
            return;
        }
        const float* gw = isq ? qg : kg;
        pg8::f32x4 gv[2][2];
#pragma unroll
        for (int bj = 0; bj < 2; ++bj)
#pragma unroll
            for (int n = 0; n < 2; ++n) gv[bj][n] = *(const pg8::f32x4*)(gw + 32 * bj + 16 * n + 4 * fq);
        float frq[4];
#pragma unroll
        for (int e = 0; e < 4; ++e) frq[e] = exp2f(-(float)(4 * fq + e) * (13.287712379549449f / 16.f)) * 0.15915494309189535f;
        const float qs = isq ? attn_body::C2 * (ATTN_F8 ? 16.f : 1.f) : 1.f;
#if ATTN_F8
        bf16* base = (bf16*)((unsigned char*)(isq ? Q : Kb) + (size_t)(isq ? (u.pn - 1) * 4 + wc : wc) * 64); const int pitch = isq ? 768 : 256;
#else
        bf16* base = isq ? Q + (size_t)((u.pn - 1) * 4 + wc) * 64 : Kb + (size_t)wc * 64; const int pitch = isq ? 768 : 256;
#endif
        float k2max = 0.f;
#pragma unroll
        for (int ai = 0; ai < 2; ++ai) {
            float rowpos = (float)(u.pm * 4 + ai * 2 + wr); asm volatile("" : "+v"(rowpos));
            float cr[4], sr[4];
#pragma unroll
            for (int e = 0; e < 4; ++e) { const float rev = rowpos * frq[e], f_ = rev - floorf(rev); cr[e] = __builtin_amdgcn_cosf(f_); sr[e] = __builtin_amdgcn_sinf(f_); }
#pragma unroll
            for (int m = 0; m < 4; ++m) {
                float colpos = (float)(m * 16 + fr); asm volatile("" : "+v"(colpos));
                const int t = u.pm * 256 + ai * 128 + wr * 64 + m * 16 + fr;
                float ss = 0.f;
#pragma unroll
                for (int bj = 0; bj < 2; ++bj)
#pragma unroll
                    for (int n = 0; n < 2; ++n) { const pg8::f32x4 v = acc[ai][bj][m][n]; ss += (v[0] * v[0] + v[1] * v[1]) + (v[2] * v[2] + v[3] * v[3]); }
                ss += __shfl_xor(ss, 16); ss += __shfl_xor(ss, 32);
                const float rinv = qs / sqrtf(ss * (1.f / 64.f) + EPS);
                pg8::f32x4 y[2][2];
#pragma unroll
                for (int bj = 0; bj < 2; ++bj)
#pragma unroll
                    for (int n = 0; n < 2; ++n) y[bj][n] = acc[ai][bj][m][n] * rinv * gv[bj][n];
                if (lat) {
#pragma unroll
                    for (int e = 0; e < 4; ++e) {
                        { const float x1 = y[0][0][e], x2 = y[0][1][e]; y[0][0][e] = x1 * cr[e] - x2 * sr[e]; y[0][1][e] = x1 * sr[e] + x2 * cr[e]; }
                        { const float rev = colpos * frq[e], f_ = rev - floorf(rev); const float cc = __builtin_amdgcn_cosf(f_), sc = __builtin_amdgcn_sinf(f_);
                          const float x1 = y[1][0][e], x2 = y[1][1][e]; y[1][0][e] = x1 * cc - x2 * sc; y[1][1][e] = x1 * sc + x2 * cc; }
                    }
                }
                ss = 0.f;
#if ATTN_F8
                unsigned char* rowp8 = (unsigned char*)base + ((size_t)t * pitch + 4 * fq);
#pragma unroll
                for (int bj = 0; bj < 2; ++bj)
#pragma unroll
                    for (int n = 0; n < 2; ++n) { const pg8::f32x4 v = y[bj][n]; const unsigned w = pk4_fp8(v[0], v[1], v[2], v[3]); *(unsigned*)(rowp8 + 32 * bj + 16 * n) = w;
                        if (!isq) { const float b0 = __builtin_amdgcn_cvt_f32_fp8((int)w, 0), b1 = __builtin_amdgcn_cvt_f32_fp8((int)w, 1), b2 = __builtin_amdgcn_cvt_f32_fp8((int)w, 2), b3 = __builtin_amdgcn_cvt_f32_fp8((int)w, 3); ss += (b0 * b0 + b1 * b1) + (b2 * b2 + b3 * b3); } }
#else
                bf16* rowp = base + (size_t)t * pitch + 4 * fq;
#pragma unroll
                for (int bj = 0; bj < 2; ++bj)
#pragma unroll
                    for (int n = 0; n < 2; ++n) { const pg8::f32x4 v = y[bj][n]; const v2u w = (v2u){pk2(v[0], v[1]), pk2(v[2], v[3])}; *(v2u*)(rowp + 32 * bj + 16 * n) = w;
                        if (!isq) { const float b0 = __uint_as_float(w.x << 16), b1 = __uint_as_float(w.x & 0xffff0000u), b2 = __uint_as_float(w.y << 16), b3 = __uint_as_float(w.y & 0xffff0000u); ss += (b0 * b0 + b1 * b1) + (b2 * b2 + b3 * b3); } }
#endif
                if (!isq) { float r2 = ss; r2 += __shfl_xor(r2, 16); r2 += __shfl_xor(r2, 32); k2max = fmaxf(k2max, r2); }
                asm volatile("" ::: "memory");
            }
        }
        if (!isq) {
#pragma unroll
            for (int o = 1; o < 16; o <<= 1) k2max = fmaxf(k2max, __shfl_xor(k2max, o));
            if (fr == 0 && fq == 0) __hip_atomic_fetch_max(kmax, __float_as_uint(k2max), __ATOMIC_RELAXED, __HIP_MEMORY_SCOPE_AGENT);
        }
    }
};

__device__ __forceinline__ unsigned rev4_12(unsigned k) { unsigned r = __brev(k) >> 20; return ((r & 0xAAAu) >> 1) | ((r & 0x555u) << 1); }
__device__ __forceinline__ void fft_block(const Args& a, LAS unsigned char* lds, int item, int wave) {
    const int tid = wave * 64 + fresh_lane();
    const int mm = item & 31, par = (item >> 5) & 1, g = item >> 6;
    const float* FT = (const float*)(a.ws + WS_FT); bf16* MIX = (bf16*)(a.ws + WS_MIX);
    LAS f32x2* X = (LAS f32x2*)lds;
    const float* re = FT + (size_t)(64 * g + mm) * NTOK; const float* im = FT + (size_t)(64 * g + 32 + mm) * NTOK;
#pragma unroll 1
    for (int i = 0; i < 2; ++i) {
        const int j0 = 4 * (tid + NTHR * i);
        f32x4 r4[4], i4[4];
#pragma unroll
        for (int q = 0; q < 4; ++q) { r4[q] = *(const f32x4*)(re + j0 + 4096 * q); i4[q] = *(const f32x4*)(im + j0 + 4096 * q); }
#pragma unroll
        for (int e = 0; e < 4; ++e) {
            const int j = j0 + e;
            const f32x2 a0 = {r4[0][e], i4[0][e]}, a1 = {r4[1][e], i4[1][e]}, a2 = {r4[2][e], i4[2][e]}, a3 = {r4[3][e], i4[3][e]};
            f32x2 ya, yb; float fa, fb;
            if (par == 0) { const f32x2 s02 = a0 + a2, s13 = a1 + a3; ya = s02 + s13; yb = s02 - s13; fa = 0.f; fb = (float)(2 * j) * (1.f / 16384.f); }
            else { const f32x2 d02 = a0 - a2, d13 = a1 - a3; ya = (f32x2){d02.x + d13.y, d02.y - d13.x}; yb = (f32x2){d02.x - d13.y, d02.y + d13.x}; fa = (float)j * (1.f / 16384.f); fb = (float)(3 * j) * (1.f / 16384.f); }
            const float ca = __builtin_amdgcn_cosf(fa), sa = __builtin_amdgcn_sinf(fa), cb = __builtin_amdgcn_cosf(fb), sb = __builtin_amdgcn_sinf(fb);
            X[j] = (f32x2){ya.x * ca + ya.y * sa, ya.y * ca - ya.x * sa};
            X[4096 + j] = (f32x2){yb.x * cb + yb.y * sb, yb.y * cb - yb.x * sb};
        }
    }
    __syncthreads();
#pragma unroll 1
    for (int s = 0; s < 6; ++s) {
        const int lq = 10 - 2 * s;
        const int Lq = 1 << lq;
        const float invL = 1.f / (float)(4 << lq);
#pragma unroll 2
        for (int i = 0; i < 4; ++i) {
            const int b = tid + NTHR * i, j = b & (Lq - 1), base = ((b >> lq) << (lq + 2)) + j;
            const f32x2 a0 = X[base], a1 = X[base + Lq], a2 = X[base + 2 * Lq], a3 = X[base + 3 * Lq];
            const f32x2 s02 = a0 + a2, d02 = a0 - a2, s13 = a1 + a3, d13 = a1 - a3;
            const f32x2 y0 = s02 + s13, y2 = s02 - s13;
            const f32x2 y1 = (f32x2){d02.x + d13.y, d02.y - d13.x};
            const f32x2 y3 = (f32x2){d02.x - d13.y, d02.y + d13.x};
            const float f1 = (float)j * invL;
            const float c1 = __builtin_amdgcn_cosf(f1), s1 = __builtin_amdgcn_sinf(f1);
            const float c2 = __builtin_amdgcn_cosf(2.f * f1), s2 = __builtin_amdgcn_sinf(2.f * f1);
            const float c3 = __builtin_amdgcn_cosf(3.f * f1), s3 = __builtin_amdgcn_sinf(3.f * f1);
            X[base] = y0;
            X[base + Lq] = (f32x2){y1.x * c1 + y1.y * s1, y1.y * c1 - y1.x * s1};
            X[base + 2 * Lq] = (f32x2){y2.x * c2 + y2.y * s2, y2.y * c2 - y2.x * s2};
            X[base + 3 * Lq] = (f32x2){y3.x * c3 + y3.y * s3, y3.y * c3 - y3.x * s3};
        }
        __syncthreads();
    }
    const int col = 64 * g + 2 * mm;
#pragma unroll 1
    for (int i = 0; i < 16; ++i) {
        const int k = 2 * (tid + NTHR * i) + par, kn = (NTOK - k) & (NTOK - 1);
        const f32x2 wk = X[(((k & 3) - par) >> 1) * 4096 + rev4_12((unsigned)(k >> 2))], wn = X[(((kn & 3) - par) >> 1) * 4096 + rev4_12((unsigned)(kn >> 2))];
        float o0, o1;
        if (mm == 0) { o0 = 0.5f * (wk.x + wn.x); o1 = 0.5f * (wk.y + wn.y); }
        else { o0 = wn.x; o1 = wk.x; }
        *(unsigned*)(MIX + (size_t)k * DM + col) = pk2(o0, o1);
    }
    __syncthreads();
}

struct P3Prob {
    static constexpr int K = DM; static constexpr bool PERM = false, FP8 = false; static constexpr int SCW = 0, SCA = 0;
    const bf16* MIX; const bf16* WoT; const float* x; const float* g1; float* X1; pg8::StaticOrder so;
    __device__ __forceinline__ bool next(int i, pg8::Unit& u) const { return so.next(i, u); }
    __device__ __forceinline__ const char* aptr(const pg8::Unit& u) const { return (const char*)(MIX + (size_t)u.pm * 256 * DM); }
    __device__ __forceinline__ const char* bptr(const pg8::Unit& u) const { return (const char*)(WoT + (size_t)u.pn * 256 * DM); }
    __device__ __forceinline__ void epi(const pg8::f32x4 (&acc)[2][2][4][2], const pg8::Unit& u, int wr, int wc, int fr, int fq) const {
        const int col0 = u.pn * 256 + wc * 32 + 4 * fq;
        pg8::f32x4 gv[2][2];
#pragma unroll
        for (int bj = 0; bj < 2; ++bj)
#pragma unroll
            for (int n = 0; n < 2; ++n) gv[bj][n] = *(const pg8::f32x4*)(g1 + col0 + bj * 128 + n * 16);
#pragma unroll
        for (int ai = 0; ai < 2; ++ai)
#pragma unroll
            for (int m = 0; m < 4; ++m) { const size_t off = (size_t)(u.pm * 256 + ai * 128 + wr * 64 + m * 16 + fr) * DM + col0;
#pragma unroll
                for (int bj = 0; bj < 2; ++bj)
#pragma unroll
                    for (int n = 0; n < 2; ++n) { const pg8::f32x4 bs = *(const pg8::f32x4*)(x + off + bj * 128 + n * 16); *(pg8::f32x4*)(X1 + off + bj * 128 + n * 16) = bs + gv[bj][n] * acc[ai][bj][m][n]; }
                if (m & 1) asm volatile("" ::: "memory"); }
    }
};

__device__ __forceinline__ void p3b_router(const Args& a, LAS unsigned char* lds, int vcu, int G, int wave) {
    const int lane = fresh_lane(), tid = wave * 64 + lane;
    unsigned char* ws = a.ws; const float* MOD = (const float*)(ws + WS_MOD); const float* X1 = (const float*)(ws + WS_X1); bf16* H2 = (bf16*)(ws + WS_H2); float* AFF = (float*)(ws + WS_AFF);
    LAS float* wrt = (LAS float*)lds;
    { f32x4 t[8];
#pragma unroll
      for (int q = 0; q < 8; ++q) t[q] = *(const f32x4*)(a.w_router + 4 * (tid + NTHR * q));
#pragma unroll
      for (int q = 0; q < 8; ++q) { const int i = 4 * (tid + NTHR * q), col = i >> 4, e = i & 15;
#pragma unroll
          for (int k = 0; k < 4; ++k) wrt[(e + k) * 1024 + col] = t[q][k]; } }
    __syncthreads();
    f32x4 av[4], sh[4];
#pragma unroll
    for (int j = 0; j < 4; ++j) { const int col = 4 * lane + 256 * j; const f32x4 g = *(const f32x4*)(a.norm_ffn_g + col); const f32x4 sc = *(const f32x4*)(MOD + 4 * DM + col); av[j] = g * (sc + 1.f); sh[j] = *(const f32x4*)(MOD + 3 * DM + col); }
    const int gw = vcu * NWAVES + wave, NGW = G * NWAVES;
#pragma unroll 1
    for (int m0 = 4 * gw; m0 < NTOK; m0 += 4 * NGW) {
        f32x4 v[4][4];
#pragma unroll
        for (int r = 0; r < 4; ++r) { const GAS f32x4* xr = (const GAS f32x4*)(X1 + (size_t)(m0 + r) * DM) + lane;
#pragma unroll
            for (int j = 0; j < 4; ++j) v[r][j] = xr[64 * j]; }
        float ss[4];
#pragma unroll
        for (int r = 0; r < 4; ++r) { float t = 0.f;
#pragma unroll
            for (int j = 0; j < 4; ++j) t += (v[r][j].x * v[r][j].x + v[r][j].y * v[r][j].y) + (v[r][j].z * v[r][j].z + v[r][j].w * v[r][j].w);
            ss[r] = t; }
#pragma unroll
        for (int o = 1; o < 64; o <<= 1)
#pragma unroll
            for (int r = 0; r < 4; ++r) ss[r] += __shfl_xor(ss[r], o);
#pragma unroll
        for (int r = 0; r < 4; ++r) { const float rinv = 1.f / sqrtf(ss[r] * (1.f / DM) + EPS);
            GAS unsigned* o4 = (GAS unsigned*)((unsigned char*)H2 + (size_t)(m0 + r) * DM) + lane;
#pragma unroll
            for (int j = 0; j < 4; ++j) { v[r][j] = v[r][j] * rinv * av[j] + sh[j]; o4[64 * j] = pk4_fp8(v[r][j].x, v[r][j].y, v[r][j].z, v[r][j].w); } }
        float lg[4][16];
#pragma unroll
        for (int e = 0; e < 16; ++e) { f32x4 w[4];
#pragma unroll
            for (int j = 0; j < 4; ++j) w[j] = *(const LAS f32x4*)(wrt + e * 1024 + 4 * lane + 256 * j);
#pragma unroll
            for (int r = 0; r < 4; ++r) { float p = 0.f;
#pragma unroll
                for (int j = 0; j < 4; ++j) p += (v[r][j].x * w[j].x + v[r][j].y * w[j].y) + (v[r][j].z * w[j].z + v[r][j].w * w[j].w);
                lg[r][e] = p; }
            if ((e & 3) == 3) asm volatile("" ::: "memory"); }
        float r1[4];
#pragma unroll
        for (int r = 0; r < 4; ++r) {
            float r8[8], r4[4], r2[2];
            { const bool up = (lane & 32) != 0;
#pragma unroll
              for (int e = 0; e < 8; ++e) { const float snd = up ? lg[r][e] : lg[r][e + 8], kp = up ? lg[r][e + 8] : lg[r][e]; r8[e] = kp + __shfl_xor(snd, 32); } }
            { const bool up = (lane & 16) != 0;
#pragma unroll
              for (int e = 0; e < 4; ++e) { const float snd = up ? r8[e] : r8[e + 4], kp = up ? r8[e + 4] : r8[e]; r4[e] = kp + __shfl_xor(snd, 16); } }
            { const bool up = (lane & 8) != 0;
#pragma unroll
              for (int e = 0; e < 2; ++e) { const float snd = up ? r4[e] : r4[e + 2], kp = up ? r4[e + 2] : r4[e]; r2[e] = kp + __shfl_xor(snd, 8); } }
            { const bool up = (lane & 4) != 0; const float snd = up ? r2[0] : r2[1], kp = up ? r2[1] : r2[0]; r1[r] = kp + __shfl_xor(snd, 4); }
        }
#pragma unroll
        for (int r = 0; r < 4; ++r) r1[r] += __shfl_xor(r1[r], 2);
#pragma unroll
        for (int r = 0; r < 4; ++r) r1[r] += __shfl_xor(r1[r], 1);
        float mx[4], ex[4], den[4];
#pragma unroll
        for (int r = 0; r < 4; ++r) mx[r] = r1[r];
#pragma unroll
        for (int o = 4; o < 64; o <<= 1)
#pragma unroll
            for (int r = 0; r < 4; ++r) mx[r] = fmaxf(mx[r], __shfl_xor(mx[r], o));
#pragma unroll
        for (int r = 0; r < 4; ++r) { ex[r] = __expf(r1[r] - mx[r]); den[r] = ex[r]; }
#pragma unroll
        for (int o = 4; o < 64; o <<= 1)
#pragma unroll
            for (int r = 0; r < 4; ++r) den[r] += __shfl_xor(den[r], o);
        float mine = ex[0] / den[0];
#pragma unroll
        for (int r = 1; r < 4; ++r) mine = ((lane & 3) == r) ? ex[r] / den[r] : mine;
        AFF[(size_t)(lane >> 2) * NTOK + m0 + (lane & 3)] = mine;
    }
}

__device__ __forceinline__ void p4_topk(const Args& a, LAS unsigned char* lds, int e, int wave) {
    const int lane = fresh_lane(), tid = wave * 64 + lane;
    unsigned char* ws = a.ws; const unsigned* AFF = (const unsigned*)(ws + WS_AFF) + (size_t)e * NTOK;
    int* IDX = (int*)(ws + WS_IDX) + e * CAP; float* GATE = (float*)(ws + WS_GATE) + e * CAP; int* TOKSLOT = (int*)(ws + WS_TOKSLOT);
    LAS unsigned* wcnt = (LAS unsigned*)lds;
    LAS unsigned* cg = wcnt + 16;
    LAS unsigned* ce = cg + 256;
    unsigned key[32];
#pragma unroll
    for (int i = 0; i < 32; ++i) key[i] = AFF[i * NTHR + tid];
    unsigned T = 0u;
#pragma unroll 1
    for (int bit = 30; bit >= 0; --bit) {
        const unsigned cand = T | (1u << bit);
        unsigned c = 0u;
#pragma unroll
        for (int i = 0; i < 32; ++i) c += (unsigned)__popcll(__ballot(key[i] >= cand));
        LAS unsigned* wb = wcnt + 1024 + (bit & 1) * 8;
        if (lane == 0) wb[wave] = c;
        __syncthreads();
        unsigned tot = 0u;
#pragma unroll
        for (int w = 0; w < 8; ++w) tot += wb[w];
        if (tot >= (unsigned)CAP) T = cand;
    }
    __syncthreads();
    unsigned long long below = (1ull << lane) - 1ull;
    unsigned rg[32], rq[32];
#pragma unroll
    for (int i = 0; i < 32; ++i) {
        const unsigned long long bg = __ballot(key[i] > T), bq = __ballot(key[i] == T);
        rg[i] = (unsigned)__popcll(bg & below); rq[i] = (unsigned)__popcll(bq & below);
        if (lane == 0) { cg[i * 8 + wave] = (unsigned)__popcll(bg); ce[i * 8 + wave] = (unsigned)__popcll(bq); }
    }
    __syncthreads();
    if (wave == 0) {
        unsigned g4[4], q4[4], sg = 0u, sq = 0u;
#pragma unroll
        for (int k = 0; k < 4; ++k) { g4[k] = cg[4 * lane + k]; q4[k] = ce[4 * lane + k]; sg += g4[k]; sq += q4[k]; }
        unsigned pg = sg, pq = sq;
#pragma unroll
        for (int o = 1; o < 64; o <<= 1) { const unsigned tg = __shfl_up(pg, o), tq = __shfl_up(pq, o); if (lane >= o) { pg += tg; pq += tq; } }
        pg -= sg; pq -= sq;
#pragma unroll
        for (int k = 0; k < 4; ++k) { cg[4 * lane + k] = pg; ce[4 * lane + k] = pq; pg += g4[k]; pq += q4[k]; }
        if (lane == 63) { wcnt[8] = pg; }
    }
    __syncthreads();
    const unsigned ngt = wcnt[8], need = (unsigned)CAP - ngt;
#pragma unroll
    for (int i = 0; i < 32; ++i) {
        const int tok = i * NTHR + tid;
        const unsigned gb = cg[i * 8 + wave] + rg[i], qb = ce[i * 8 + wave] + rq[i];
        const bool sel = key[i] > T || (key[i] == T && qb < need);
        const unsigned slot = gb + (qb < need ? qb : need);
        if (sel) { IDX[slot] = tok; GATE[slot] = __uint_as_float(key[i]); }
        TOKSLOT[tok * 16 + e] = sel ? (int)slot : -1;
    }
}

struct P5Prob {
    static constexpr int K = DM; static constexpr bool PERM = true, FP8 = true; static constexpr int SCW = 0x7A7A7A7A, SCA = 0x7F7F7F7F;
    const unsigned char* H2; const unsigned char* WguT; unsigned char* HID; pg8::StaticOrder so;
    __device__ __forceinline__ bool next(int i, pg8::Unit& u) const { return so.next(i, u); }
    __device__ __forceinline__ const char* aptr(const pg8::Unit&) const { return (const char*)H2; }
    __device__ __forceinline__ const char* bptr(const pg8::Unit& u) const { return (const char*)(WguT + ((size_t)(u.pm >> 3) * 4096 + (size_t)u.pn * 256) * DM); }
    __device__ __forceinline__ void epi(const pg8::f32x4 (&acc)[2][2][4][2], const pg8::Unit& u, int wr, int wc, int fr, int fq) const {
#pragma unroll
        for (int ai = 0; ai < 2; ++ai)
#pragma unroll
            for (int m = 0; m < 4; ++m) { unsigned char* rowp = HID + (size_t)(u.pm * 256 + ai * 128 + wr * 64 + m * 16 + fr) * DE + u.pn * 128 + wc * 32 + 8 * fq;
                float h[8];
#pragma unroll
                for (int n = 0; n < 2; ++n)
#pragma unroll
                    for (int e = 0; e < 4; ++e) { const float gt = acc[ai][0][m][n][e], up = acc[ai][1][m][n][e]; h[4 * n + e] = gt * __builtin_amdgcn_rcpf(1.f + __builtin_amdgcn_exp2f(-1.4426950408889634f * gt)) * up; }
                *(v2u*)rowp = (v2u){pk4_fp8(h[0], h[1], h[2], h[3]), pk4_fp8(h[4], h[5], h[6], h[7])}; }
    }
};
struct P6Prob {
    static constexpr int K = DE; static constexpr bool PERM = true, FP8 = true; static constexpr int SCW = 0x7A7A7A7A, SCA = 0x7F7F7F7F;
    const unsigned char* HID; const unsigned char* WdT; const float* GATE; bf16* YE; pg8::StaticOrder so;
    __device__ __forceinline__ bool next(int i, pg8::Unit& u) const { return so.next(i, u); }
    __device__ __forceinline__ const char* aptr(const pg8::Unit& u) const { return (const char*)(HID + (size_t)u.pm * 256 * DE); }
    __device__ __forceinline__ const char* bptr(const pg8::Unit& u) const { return (const char*)(WdT + ((size_t)(u.pm >> 3) * DM + (size_t)u.pn * 256) * DE); }
    __device__ __forceinline__ void epi(const pg8::f32x4 (&acc)[2][2][4][2], const pg8::Unit& u, int wr, int wc, int fr, int fq) const {
#pragma unroll
        for (int ai = 0; ai < 2; ++ai)
#pragma unroll
            for (int m = 0; m < 4; ++m) { const int row = u.pm * 256 + ai * 128 + wr * 64 + m * 16 + fr; const float gt = GATE[row]; bf16* rowp = YE + (size_t)row * DM + u.pn * 256 + wc * 32 + 8 * fq;
#pragma unroll
                for (int bj = 0; bj < 2; ++bj) { const pg8::f32x4 v0 = acc[ai][bj][m][0] * gt, v1 = acc[ai][bj][m][1] * gt;
                    *(v4u*)(rowp + bj * 128) = (v4u){pk2(v0[0], v0[1]), pk2(v0[2], v0[3]), pk2(v1[0], v1[1]), pk2(v1[2], v1[3])}; } }
    }
};

__device__ __forceinline__ void p7_final(const Args& a, int vcu, int G, int wave, unsigned poison) {
    const int lane = fresh_lane();
    unsigned char* ws = a.ws; const float* MOD = (const float*)(ws + WS_MOD); const bf16* YE = (const bf16*)(ws + WS_YE); const int* TOKSLOT = (const int*)(ws + WS_TOKSLOT);
    const float* src = (STEP >= 2) ? (const float*)(ws + WS_X1) : a.x;
    f32x4 g2[4], fg[4];
#pragma unroll
    for (int j = 0; j < 4; ++j) { const int col = 4 * lane + 256 * j; g2[j] = *(const f32x4*)(MOD + 5 * DM + col); fg[j] = *(const f32x4*)(a.final_norm_g + col); }
    const int gw = vcu * NWAVES + wave, NGW = G * NWAVES;
    for (int m = gw; m < NTOK; m += NGW) {
        const GAS f32x4* xr = (const GAS f32x4*)(src + (size_t)m * DM) + lane;
        f32x4 v[4];
#pragma unroll
        for (int j = 0; j < 4; ++j) v[j] = xr[64 * j];
        if (STEP >= 4) {
            const int myslot = lane < 16 ? TOKSLOT[m * 16 + lane] : -1;
            f32x4 s[4];
#pragma unroll
            for (int j = 0; j < 4; ++j) s[j] = (f32x4){0.f, 0.f, 0.f, 0.f};
#pragma unroll 1
            for (int e = 0; e < 16; ++e) {
                const int sl = __builtin_amdgcn_readlane(myslot, e);
                if (sl >= 0) {
                    const GAS v2u* yr = (const GAS v2u*)(YE + ((size_t)e * CAP + sl) * DM) + lane;
#pragma unroll
                    for (int j = 0; j < 4; ++j) { const v2u w = yr[64 * j]; s[j].x += __uint_as_float(w.x << 16); s[j].y += __uint_as_float(w.x & 0xffff0000u); s[j].z += __uint_as_float(w.y << 16); s[j].w += __uint_as_float(w.y & 0xffff0000u); }
                }
            }
#pragma unroll
            for (int j = 0; j < 4; ++j) v[j] += g2[j] * s[j];
        }
        float ss = 0.f;
#pragma unroll
        for (int j = 0; j < 4; ++j) ss += (v[j].x * v[j].x + v[j].y * v[j].y) + (v[j].z * v[j].z + v[j].w * v[j].w);
        const float rinv = 1.f / sqrtf(wave_sum(ss) * (1.f / DM) + EPS);
        GAS f32x4* o = (GAS f32x4*)(a.out + (size_t)m * DM) + lane;
        const float q = __builtin_nanf("");
#pragma unroll
        for (int j = 0; j < 4; ++j) { f32x4 y = v[j] * rinv * fg[j]; if (poison) y = (f32x4){q, q, q, q}; o[64 * j] = y; }
    }
}


#if PROBE
__device__ __forceinline__ void dsincos(double x, double& sn, double& cs) {
    const double TWO_PI = 6.283185307179586476925286766559; x -= TWO_PI * rint(x / TWO_PI);
    const double x2 = x * x; double ts = x, tc = 1.0; sn = x; cs = 1.0;
#pragma unroll 1
    for (int k = 1; k <= 14; ++k) { tc *= -x2 / (double)((2 * k - 1) * (2 * k)); ts *= -x2 / (double)((2 * k) * (2 * k + 1)); cs += tc; sn += ts; }
}
__device__ __forceinline__ float block_sum(float v, LAS float* red, int wave, int lane) {
    v = wave_sum(v); __syncthreads(); if (lane == 0) red[wave] = v; __syncthreads(); float s = 0.f;
#pragma unroll
    for (int w = 0; w < 8; ++w) s += red[w];
    return s;
}
__device__ __forceinline__ float block_max(float v, LAS float* red, int wave, int lane) {
#pragma unroll
    for (int o = 1; o < 64; o <<= 1) v = fmaxf(v, __shfl_xor(v, o));
    __syncthreads(); if (lane == 0) red[wave] = v; __syncthreads(); float s = red[0];
#pragma unroll
    for (int w = 1; w < 8; ++w) s = fmaxf(s, red[w]);
    return s;
}
__device__ __forceinline__ void probe_qkv(const Args& a, LAS unsigned char* lds, int vcu, int wave) {
    const int lane = fresh_lane(), tid = wave * 64 + lane; unsigned char* ws = a.ws;
    const bf16* XN = (const bf16*)(ws + WS_XN); const bf16* Qb = (const bf16*)(ws + WS_Q); const bf16* Kb = (const bf16*)(ws + WS_K); const bf16* Vb = (const bf16*)(ws + WS_V);
    gu32* ctl = (gu32*)(ws + WS_CTL);
    LAS float* red = (LAS float*)lds; LAS float* raw = red + 16;
    for (int kind = 0; kind < 3; ++kind) {
        const int nrows = kind == 0 ? NTOK : NROWS, nh = kind == 0 ? NHQ : NHKV;
        const int t = (kind == 1 && (vcu & 7) == 3) ? NTOK + (vcu * 37) % NCTX : (vcu * 977 + 131 * kind + 5) % (kind == 0 ? NTOK : NTOK);
        const int h = (vcu * 5 + kind) % nh;
        const int wcol0 = 256 + (kind == 0 ? 0 : (kind == 1 ? 768 : 1024)) + 64 * h;
        { const int d = tid & 63, part = tid >> 6; float sacc = 0.f;
          for (int k = part * 128; k < part * 128 + 128; ++k) sacc += bf2f(XN[(size_t)t * DM + k]) * a.w_in[(size_t)k * INW + wcol0 + d];
          LAS float* part_s = raw + 64; part_s[part * 64 + d] = sacc; __syncthreads();
          if (tid < 64) { float s2 = 0.f; for (int pp = 0; pp < 8; ++pp) s2 += part_s[pp * 64 + tid]; raw[tid] = s2; }
          __syncthreads(); }
        float ref = 0.f, got = 0.f;
        if (tid < 64) {
            const int d = tid; float v = raw[d];
            if (kind < 2) {
                float ss = 0.f; for (int j = 0; j < 64; ++j) ss += raw[j] * raw[j];
                const float* gw = kind == 0 ? a.q_norm_g : a.k_norm_g;
                const float rinv = 1.f / sqrtf(ss / 64.f + EPS);
                if (t < NTOK) {
                    const int half = d >> 5, dd = d & 31, i = dd & 15; const int pos = half == 0 ? (t >> 6) : (t & 63);
                    const double freq = exp2(-(double)i * (13.287712379549449 / 16.0)); double sn, cs; dsincos((double)pos * freq, sn, cs);
                    const float x1 = raw[32 * half + i] * rinv * gw[32 * half + i], x2 = raw[32 * half + 16 + i] * rinv * gw[32 * half + 16 + i];
                    v = dd < 16 ? (float)(x1 * cs - x2 * sn) : (float)(x1 * sn + x2 * cs);
                } else v = v * rinv * gw[d];
                if (kind == 0) v *= attn_body::C2;
            }
            ref = v;
#if ATTN_F8
            { const unsigned char* Q8 = (const unsigned char*)Qb; const unsigned char* K8 = (const unsigned char*)Kb; const unsigned char* V8 = (const unsigned char*)Vb;
              if (kind == 0) got = __builtin_amdgcn_cvt_f32_fp8((int)Q8[(size_t)t * 768 + 64 * h + d], 0) * (1.f / 16.f);
              else if (kind == 1) got = __builtin_amdgcn_cvt_f32_fp8((int)K8[(size_t)t * 256 + 64 * h + d], 0);
              else { const int kk = t & 63, tile = t >> 6, k5 = kk & 31, hk = (k5 >> 2) & 1, j = (k5 & 3) + 4 * (k5 >> 3) + 16 * (kk >> 5);
                     got = __builtin_amdgcn_cvt_f32_fp8((int)V8[(size_t)(h * (NKEYS / 64) + tile) * 4096 + (j >> 4) * 2048 + d * 32 + 16 * (hk ^ ((d >> 3) & 1)) + (j & 15)], 0); } }
#else
            got = kind == 0 ? bf2f(Qb[(size_t)t * 768 + 64 * h + d]) : (kind == 1 ? bf2f(Kb[(size_t)t * 256 + 64 * h + d]) : bf2f(Vb[(size_t)t * 256 + 64 * h + d]));
#endif
        }
        const float mx = block_max(fabsf(ref), red, wave, lane);
        const float err = block_max(fabsf(ref - got), red, wave, lane);
        if (tid == 0 && !(err <= (ATTN_F8 ? 0.07f : 0.03f) * mx + 1e-6f)) __hip_atomic_fetch_or(ctl + CW_FLAG, 1u << kind, RLX_AGENT);
        __syncthreads();
    }
}
__device__ __forceinline__ void probe_attn(const Args& a, LAS unsigned char* lds, int vcu, int wave) {
    const int lane = fresh_lane(), tid = wave * 64 + lane; unsigned char* ws = a.ws;
    const bf16* Qb = (const bf16*)(ws + WS_Q); const bf16* Kb = (const bf16*)(ws + WS_K); const bf16* Vb = (const bf16*)(ws + WS_V); const bf16* MIX = (const bf16*)(ws + WS_MIX);
    gu32* ctl = (gu32*)(ws + WS_CTL);
    LAS float* red = (LAS float*)lds; LAS float* ored = red + 16;
    const int t = (vcu * 613 + 29) % NTOK, h = (vcu * 7 + 3) % NHQ, kvh = h / 3;
    float q[64];
#if ATTN_F8
    const unsigned char* Q8 = (const unsigned char*)Qb; const unsigned char* K8 = (const unsigned char*)Kb; const unsigned char* V8 = (const unsigned char*)Vb;
#pragma unroll
    for (int d = 0; d < 64; ++d) q[d] = __builtin_amdgcn_cvt_f32_fp8((int)Q8[(size_t)t * 768 + 64 * h + d], 0) * (1.f / 16.f);
#else
#pragma unroll
    for (int d = 0; d < 64; ++d) q[d] = bf2f(Qb[(size_t)t * 768 + 64 * h + d]);
#endif
    float sc[33]; float mx = -1e30f;
#pragma unroll
    for (int i = 0; i < 33; ++i) { const int key = i * NTHR + tid; float s = -1e30f;
#if ATTN_F8
        if (key < NKEYS) { s = 0.f; const unsigned char* kr = K8 + (size_t)key * 256 + 64 * kvh;
#pragma unroll
            for (int d = 0; d < 64; ++d) s += q[d] * __builtin_amdgcn_cvt_f32_fp8((int)kr[d], 0); }
#else
        if (key < NKEYS) { s = 0.f; const bf16* kr = Kb + (size_t)key * 256 + 64 * kvh;
#pragma unroll
            for (int d = 0; d < 64; ++d) s += q[d] * bf2f(kr[d]); }
#endif
        sc[i] = s; mx = fmaxf(mx, s); }
    mx = block_max(mx, red, wave, lane);
    float den = 0.f; float o[64];
#pragma unroll
    for (int d = 0; d < 64; ++d) o[d] = 0.f;
#pragma unroll
    for (int i = 0; i < 33; ++i) { const int key = i * NTHR + tid;
#if ATTN_F8
        if (key < NKEYS) { const float pp = exp2f(sc[i] - mx); den += pp; const int kk = key & 63, tile = key >> 6, k5 = kk & 31, hk = (k5 >> 2) & 1, j = (k5 & 3) + 4 * (k5 >> 3) + 16 * (kk >> 5);
            const unsigned char* vb = V8 + (size_t)(kvh * (NKEYS / 64) + tile) * 4096 + (j >> 4) * 2048 + (j & 15);
#pragma unroll
            for (int d = 0; d < 64; ++d) o[d] += pp * __builtin_amdgcn_cvt_f32_fp8((int)vb[d * 32 + 16 * (hk ^ ((d >> 3) & 1))], 0); } }
#else
        if (key < NKEYS) { const float pp = exp2f(sc[i] - mx); den += pp; const bf16* vr = Vb + (size_t)key * 256 + 64 * kvh;
#pragma unroll
            for (int d = 0; d < 64; ++d) o[d] += pp * bf2f(vr[d]); } }
#endif
    den = block_sum(den, red, wave, lane);
#pragma unroll
    for (int d = 0; d < 64; ++d) { const float w = wave_sum(o[d]); if (lane == 0) ored[wave * 64 + d] = w; }
    __syncthreads();
    float ref = 0.f, got = 0.f;
    if (tid < 64) { float s = 0.f; for (int w = 0; w < 8; ++w) s += ored[w * 64 + tid]; ref = s / den; got = bf2f(MIX[(size_t)t * DM + 256 + 64 * h + tid]); }
    const float m2 = block_max(fabsf(ref), red, wave, lane);
    const float err = block_max(fabsf(ref - got), red, wave, lane);
    if (tid == 0 && !(err <= 0.03f * m2 + 1e-7f)) __hip_atomic_fetch_or(ctl + CW_FLAG, 8u, RLX_AGENT);
    __syncthreads();
}
#endif

__global__ void __launch_bounds__(NTHR, 2) fwd_megakernel(Args args) {
    extern __shared__ __attribute__((aligned(16))) unsigned char lds_raw[];
    LAS unsigned char* lds = (LAS unsigned char*)lds_raw;
    volatile LAS unsigned* MISC = (volatile LAS unsigned*)(lds + MISC_OFF);
    const int wave = __builtin_amdgcn_readfirstlane(threadIdx.x >> 6);
    const int G = gridDim.x; const int bx = blockIdx.x; const int vcu = (G % 8 == 0) ? (bx % 8) * (G / 8) + bx / 8 : bx;
    unsigned char* ws = args.ws;
    gu32* ctl = (gu32*)(ws + WS_CTL);
    { const int l0 = fresh_lane(); if (wave < 2) ((LAS unsigned*)(lds + MISC_OFF))[wave * 64 + l0] = 0u;
      __syncthreads();
    }
    XcdBarrier bar = xcd_barrier_post((unsigned*)(ctl + CW_BAR), MISC + 8, wave == 0 && fresh_lane() == 0);
#define GRID_BAR() xcd_barrier(bar, wave)

    for (int rep = 0; rep < REP(0); ++rep) {
    if (STEP >= 2 && PH(0)) p0_prologue(args, lds, vcu, G, wave);
    GRID_BAR(); }
    for (int rep = 0; rep < REP(1); ++rep) {
    if (STEP >= 2 && PH(1)) p0b_modulate(args, vcu, G, wave);
    GRID_BAR(); }
    for (int rep = 0; rep < REP(2); ++rep) {
    if (STEP >= 2 && PH(2)) {
        P1Prob p; p.XN = (bf16*)(ws + WS_XN); p.WinT = (bf16*)(ws + WS_WIN); p.Q = (bf16*)(ws + WS_Q); p.Kb = (bf16*)(ws + WS_K); p.Vb = (bf16*)(ws + WS_V); p.FT = (float*)(ws + WS_FT);
        p.qg = args.q_norm_g; p.kg = args.k_norm_g; p.kmax = (unsigned*)(ctl + CW_KMAX); p.so.init(NROWS / 256, INW / 256, G, bx);
        pg8::gemm_phase<P1Prob, false, true, true>(lds, p, nullptr, wave);
        if (rep == 0 && MOE_S1 > 0) {
            const int nwg = (NROWS / 256) * (INW / 256), maxc = (nwg + G - 1) / G, c0 = nwg - (maxc - 1) * G;
            if (c0 >= G) moe_convert(args, (LAS float*)(lds + wave * 16640), MOE_B0, MOE_B1, bx * NWAVES + wave, G * NWAVES);
            else if (bx >= c0) moe_convert(args, (LAS float*)(lds + wave * 16640), MOE_B0, MOE_B1, (bx - c0) * NWAVES + wave, (G - c0) * NWAVES);
        }
    }
    GRID_BAR(); }
#if PROBE == 1
    probe_qkv(args, lds, vcu, wave);
#endif
    if (REP(12) > 1) {
        P1Prob p; p.XN = (bf16*)(ws + WS_XN); p.WinT = (bf16*)(ws + WS_WIN); p.Q = (bf16*)(ws + WS_Q); p.Kb = (bf16*)(ws + WS_K); p.Vb = (bf16*)(ws + WS_V); p.FT = (float*)(ws + WS_FT);
        p.qg = args.q_norm_g; p.kg = args.k_norm_g; p.kmax = (unsigned*)(ctl + CW_KMAX); p.so.init(NROWS / 256, INW / 256, G, bx);
        pg8::gemm_phase<P1Prob, false, true, true>(lds, p, nullptr, wave);
        GRID_BAR(); }
    for (int rep = 0; rep < REP(3); ++rep) {
    if (STEP >= 2 && PH(3)) {
        for (int item = vcu; item < 256; item += G) fft_block(args, lds, item, wave);
        if (rep == 0 && MOE_S2 > 0) {
            if (G > 256) { if (vcu >= 256) moe_convert(args, (LAS float*)(lds + wave * 16640), MOE_B1, MOE_B2, (vcu - 256) * NWAVES + wave, (G - 256) * NWAVES); }
            else moe_convert(args, (LAS float*)(lds + wave * 16640), MOE_B1, MOE_B2, vcu * NWAVES + wave, G * NWAVES);
        }
    }
    if (rep + 1 < REP(3)) GRID_BAR(); }
    for (int rep = 0; rep < REP(4); ++rep) {
    if (STEP >= 3 && PH(4)) {
        const attn_body::bf16* Qb = (const attn_body::bf16*)(ws + WS_Q); const attn_body::bf16* Kb = (const attn_body::bf16*)(ws + WS_K); const attn_body::bf16* Vb = (const attn_body::bf16*)(ws + WS_V);
        attn_body::bf16* MIX = (attn_body::bf16*)(ws + WS_MIX);
        const float kmax2 = __uint_as_float(__hip_atomic_load(ctl + CW_KMAX, RLX_AGENT));
        const int u0 = (G == 256) ? vcu * 3 : vcu, ustep = (G == 256) ? 1 : G, uend = (G == 256) ? vcu * 3 + 3 : 768;
        int ucnt = 0;
#pragma unroll 1
        for (int u = u0; u < uend; u += ustep, ++ucnt) {
            if (rep == 0 && MOE_B3 < MOE_ITEMS && ucnt == ((G == 256) ? vcu % 3 : 0)) { moe_convert(args, (LAS float*)(lds + wave * 16640), MOE_B3, MOE_ITEMS, wave * G + vcu, NWAVES * G); __syncthreads(); }
            const int kvh = u / 192, w = u % 192, h = kvh * 3 + w / 64, qb = w % 64;
#if ATTN_F8
            attn_body::attn_unit_f8<0>(h, kvh, qb, (const unsigned char*)Qb, (const unsigned char*)Kb, (const unsigned char*)Vb, MIX, (char*)lds_raw, wave, kmax2);
#ifdef DUMMYVAR
            attn_body::attn_unit_f8<(DUMMYVAR) | 8>(h, kvh, qb, (const unsigned char*)Qb, (const unsigned char*)Kb, (const unsigned char*)Vb, MIX, (char*)lds_raw, wave, kmax2);
#endif
#else
            attn_body::attn_unit<8>(h, kvh, qb, Qb, Kb, Vb, MIX, (char*)lds_raw, wave, kmax2);
#endif
        }
    } else if (STEP == 2) {
        bf16* MIX = (bf16*)(ws + WS_MIX);
        const int gw = vcu * NWAVES + wave, NGW = G * NWAVES, lane = fresh_lane();
        for (int m = gw; m < NTOK; m += NGW) { GAS v4u* o = (GAS v4u*)(MIX + (size_t)m * DM + 256); o[lane] = (v4u){0u, 0u, 0u, 0u}; if (lane < 32) o[64 + lane] = (v4u){0u, 0u, 0u, 0u}; }
    }
    GRID_BAR(); }
#if PROBE == 2
    probe_attn(args, lds, vcu, wave);
#endif
    for (int rep = 0; rep < REP(5); ++rep) {
    if (STEP >= 2 && PH(5)) {
        P3Prob p; p.MIX = (bf16*)(ws + WS_MIX); p.WoT = (bf16*)(ws + WS_WOUT); p.x = args.x; p.g1 = (const float*)(ws + WS_MOD) + 2 * DM; p.X1 = (float*)(ws + WS_X1); p.so.init(NTOK / 256, DM / 256, G, bx);
        pg8::gemm_phase<P3Prob, false, true, true>(lds, p, nullptr, wave);
    }
    GRID_BAR(); }
    for (int rep = 0; rep < REP(6); ++rep) {
    if (STEP >= 4 && PH(6)) p3b_router(args, lds, vcu, G, wave);
    GRID_BAR(); }
    for (int rep = 0; rep < REP(7); ++rep) {
    if (STEP >= 4 && PH(7)) {
#pragma unroll 1
        for (int e = vcu; e < NE; e += G) p4_topk(args, lds, e, wave);
        if (rep == 0) {
            if (G > NE) { if (vcu >= NE) moe_convert(args, (LAS float*)(lds + wave * 16640), MOE_B2, MOE_B3, (vcu - NE) * NWAVES + wave, (G - NE) * NWAVES); }
            else moe_convert(args, (LAS float*)(lds + wave * 16640), MOE_B2, MOE_B3, vcu * NWAVES + wave, G * NWAVES);
        } }
    GRID_BAR(); }
    if (REP(11) > 1) {
        moe_convert(args, (LAS float*)(lds + wave * 16640), MOE_B2, MOE_B3, vcu * NWAVES + wave, G * NWAVES);
        GRID_BAR(); }
    for (int rep = 0; rep < REP(8); ++rep) {
    if (STEP >= 4 && PH(8)) {
        P5Prob p; p.H2 = (const unsigned char*)(ws + WS_H2); p.WguT = (const unsigned char*)(ws + WS_WGU); p.HID = (unsigned char*)(ws + WS_HID); p.so.init(NE * CAP / 256, 2 * DE / 256, G, bx);
        LAS unsigned* rowtab = (LAS unsigned*)(lds + XTRA_OFF);
        const int* IDX = (const int*)(ws + WS_IDX);
        { const int tid = wave * 64 + fresh_lane(); pg8::Unit u; for (int i = 0; p.so.next(i, u) && i < 28; ++i) { if (tid < 256) rowtab[i * 256 + tid] = (unsigned)IDX[u.pm * 256 + tid]; } }
        __syncthreads();
        pg8::gemm_phase<P5Prob, true, true, true>(lds, p, rowtab, wave);
    }
    GRID_BAR(); }
    for (int rep = 0; rep < REP(9); ++rep) {
    if (STEP >= 4 && PH(9)) {
        P6Prob p; p.HID = (const unsigned char*)(ws + WS_HID); p.WdT = (const unsigned char*)(ws + WS_WD); p.GATE = (const float*)(ws + WS_GATE); p.YE = (bf16*)(ws + WS_YE); p.so.init(NE * CAP / 256, DM / 256, G, bx);
        pg8::gemm_phase<P6Prob, false, true, true>(lds, p, nullptr, wave);
    }
    GRID_BAR(); }
    {
        unsigned poison = (__hip_atomic_load(ctl + CW_BAR + XB_TMO, RLX_AGENT) != 0u) || (__hip_atomic_load(ctl + CW_FLAG, RLX_AGENT) != 0u);
        for (int rep = 0; rep < REP(10); ++rep) p7_final(args, vcu, G, wave, poison);
    }
}

extern "C" void kernel_launch(void* const* d_in, const int* in_sizes, int n_in, void* d_out, int out_size, void* d_ws, size_t ws_size, hipStream_t stream) {
    static int grid = 0;
    if (grid == 0) {
        if (n_in != 18 || in_sizes[0] != NTOK * DM || out_size != NTOK * DM || ws_size < WS_END) { fprintf(stderr, "kernel_launch: unexpected shapes (n_in %d, in0 %d, out %d, ws %zu)\n", n_in, n_in > 0 ? in_sizes[0] : -1, out_size, ws_size); grid = -1; return; }
        int dev = 0, cus = 0, per_cu = 0;
        if (hipGetDevice(&dev) != hipSuccess || hipDeviceGetAttribute(&cus, hipDeviceAttributeMultiprocessorCount, dev) != hipSuccess) { grid = -1; return; }
        if (hipFuncSetAttribute((const void*)fwd_megakernel, hipFuncAttributeMaxDynamicSharedMemorySize, LDS_BYTES) != hipSuccess) { fprintf(stderr, "kernel_launch: hipFuncSetAttribute failed\n"); grid = -1; return; }
        if (hipOccupancyMaxActiveBlocksPerMultiprocessor(&per_cu, (const void*)fwd_megakernel, NTHR, LDS_BYTES) != hipSuccess || per_cu < 1) { fprintf(stderr, "kernel_launch: occupancy query says %d blocks per CU\n", per_cu); (void)hipGetLastError(); grid = -1; return; }
        grid = cus;
    }
    if (grid < 0) return;
    (void)hipMemsetAsync((char*)d_ws + WS_CTL, 0, CTL_ZERO_BYTES, stream);
    Args a{};
    const float** f = (const float**)&a;
    for (int i = 0; i < 18; ++i) f[i] = (const float*)d_in[i];
    a.out = (float*)d_out; a.ws = (unsigned char*)d_ws;
    hipLaunchKernelGGL(fwd_megakernel, dim3(grid), dim3(NTHR), LDS_BYTES, stream, a);
}
```

```cpp
#include <hip/hip_runtime.h>
#include <hip/hip_bf16.h>
#include <cstdio>
#include <cstdint>
#include <cmath>

#ifndef STEP
#define STEP 4
#endif
#ifndef PROBE
#define PROBE 0
#endif
#ifndef PHMASK
#define PHMASK 0xFFFF
#endif
#define PH(k) ((PHMASK >> (k)) & 1)
#ifndef ATTN_F8
#define ATTN_F8 1
#endif
#ifndef REPEAT
#define REPEAT 0
#endif
#define REP(k) (((REPEAT >> (k)) & 1) + 1)

constexpr int DM = 1024, NTOK = 16384, NCTX = 256, NROWS = NTOK + NCTX, INW = 1536;
constexpr int NHQ = 12, NHKV = 4, HD = 64, NE = 16, CAP = 2048, DE = 2048, NMOD = 6;
constexpr int NKEYS = NROWS;
constexpr float EPS = 1e-6f;

__device__ __forceinline__ int fresh_lane() { int l; asm volatile("v_mbcnt_lo_u32_b32 %0, -1, 0\n\tv_mbcnt_hi_u32_b32 %0, -1, %0" : "=v"(l)); return l; }

namespace pg8 {
#define PG8_LAS __attribute__((address_space(3)))
typedef unsigned short bf16_t;
typedef short bf16x8 __attribute__((ext_vector_type(8)));
typedef float f32x4 __attribute__((ext_vector_type(4)));
typedef unsigned u32x4 __attribute__((ext_vector_type(4)));
typedef unsigned u32x2 __attribute__((ext_vector_type(2)));
typedef int v8i __attribute__((ext_vector_type(8)));
constexpr int BM = 256, BK = 64, HALF = 128, HTB = HALF * BK * 2, STAGE_BYTES = 8 * HTB, NXCD = 8, WGM = 8;

__host__ __device__ __forceinline__ int lds_byte(int r, int c) { const int st = (r >> 4) * 2 + (c >> 5), rr = r & 15, cc = c & 31, ob = rr * 64 + cc * 2; return st * 1024 + (ob ^ (((ob >> 9) & 1) << 5)); }
__host__ __device__ __forceinline__ void stage_rc(int b, int& R, int& C) { const int st = b / 1024, sb = b % 1024, swz = sb ^ (((sb >> 9) & 1) << 5); R = (st >> 1) * 16 + swz / 64; C = (st & 1) * 32 + (swz % 64) / 2; }
__host__ __device__ __forceinline__ int perm32(int rho) { const int n = rho >> 4, i = rho & 15; return 8 * (i >> 2) + 4 * n + (i & 3); }

struct Unit { int pm, pn; };

struct StaticOrder {
    int nM, nN, nwg, G, c;
    __host__ __device__ void init(int nM_, int nN_, int G_, int c_) { nM = nM_; nN = nN_; nwg = nM * nN; G = G_; c = c_; }
    __host__ __device__ bool next(int i, Unit& u) const {
        const long L = (long)i * G + c; if (L >= nwg) return false;
        int wgid = (int)L; { const int q = nwg / NXCD, r = nwg % NXCD, xcd = wgid % NXCD, off = wgid / NXCD; wgid = (xcd < r ? xcd * (q + 1) : r * (q + 1) + (xcd - r) * q) + off; }
        const int nig = WGM * nN, gid = wgid / nig, fm = gid * WGM, gsz = (nM - fm) < WGM ? (nM - fm) : WGM;
        u.pm = fm + ((wgid % nig) % gsz); u.pn = (wgid % nig) / gsz; return true;
    }
};

__device__ __forceinline__ unsigned cvt_pk_bf16(float lo, float hi) { unsigned r; asm volatile("v_cvt_pk_bf16_f32 %0, %1, %2" : "=v"(r) : "v"(lo), "v"(hi)); return r; }

template <class P, bool GATHER, bool ALIGN_EPI, bool SP2>
__device__ __forceinline__ void gemm_phase(PG8_LAS unsigned char* lds, const P& S, const PG8_LAS unsigned* rowtab, int wid) {
    const int lane = fresh_lane(), tid = wid * 64 + lane, wr = wid >> 2, wc = wid & 3, fr = lane & 15, fq = lane >> 4;
    constexpr bool F8 = P::FP8; constexpr int ESZ = F8 ? 1 : 2;
    constexpr int K = P::K, nt = F8 ? K / 128 : K / BK;
    int R0, C0; stage_rc(tid * 16, R0, C0);
    unsigned voffB[2];
#pragma unroll
    for (int i = 0; i < 2; ++i) { const int R = R0 + 64 * i; const int Rb = P::PERM ? ((R & ~31) + perm32(R & 31)) : R; voffB[i] = (unsigned)(Rb * K * ESZ + C0 * 2); }
    constexpr size_t kstep = (size_t)(BK * 2);
    constexpr size_t hstep = (size_t)HALF * K * ESZ;
    const unsigned ldsw = (unsigned)wid * 1024u;
    const int aoff = lds_byte(wr * 64 + fr, fq * 8), boff = lds_byte(wc * 32 + fr, fq * 8);
#define PG8_SA(b, h) (((b) * 2 + (h)) * HTB)
#define PG8_SB(b, h) ((4 + (b) * 2 + (h)) * HTB)
#define PG8_STAGE(bufoff, gbase, voff) do { _Pragma("unroll") for (int _i = 0; _i < 2; ++_i) \
        __builtin_amdgcn_global_load_lds((const unsigned*)((const char*)(gbase) + (voff)[_i]), (PG8_LAS unsigned*)(lds + (bufoff) + ldsw + _i * 8192), 16, 0, 0); } while (0)
#define PG8_LDA(dst, b, h) do { if constexpr (F8) { _Pragma("unroll") for (int m = 0; m < 4; ++m) { const PG8_LAS u32x4* p_ = (const PG8_LAS u32x4*)(lds + PG8_SA(b, h) + aoff + m * 2048); const u32x4 lo_ = p_[0], hi_ = p_[64]; \
            dst##8[m] = (v8i){(int)lo_.x, (int)lo_.y, (int)lo_.z, (int)lo_.w, (int)hi_.x, (int)hi_.y, (int)hi_.z, (int)hi_.w}; } } \
        else { _Pragma("unroll") for (int m = 0; m < 4; ++m) _Pragma("unroll") for (int k = 0; k < 2; ++k) dst[m][k] = *(const PG8_LAS bf16x8*)(lds + PG8_SA(b, h) + aoff + m * 2048 + k * 1024); } } while (0)
#define PG8_LDB(dst, b, h) do { if constexpr (F8) { _Pragma("unroll") for (int n = 0; n < 2; ++n) { const PG8_LAS u32x4* p_ = (const PG8_LAS u32x4*)(lds + PG8_SB(b, h) + boff + n * 2048); const u32x4 lo_ = p_[0], hi_ = p_[64]; \
            dst##8[n] = (v8i){(int)lo_.x, (int)lo_.y, (int)lo_.z, (int)lo_.w, (int)hi_.x, (int)hi_.y, (int)hi_.z, (int)hi_.w}; } } \
        else { _Pragma("unroll") for (int n = 0; n < 2; ++n) _Pragma("unroll") for (int k = 0; k < 2; ++k) dst[n][k] = *(const PG8_LAS bf16x8*)(lds + PG8_SB(b, h) + boff + n * 2048 + k * 1024); } } while (0)
#define PG8_MMA(ai, bj, At, Bt) do { __builtin_amdgcn_s_setprio(1); if constexpr (F8) { \
        asm volatile("s_nop 1\n\t" \
            "v_mfma_scale_f32_16x16x128_f8f6f4 %0, %8, %10, %0, %14, %15 op_sel_hi:[0,0,0]\n\t" \
            "v_mfma_scale_f32_16x16x128_f8f6f4 %1, %9, %10, %1, %14, %15 op_sel_hi:[0,0,0]\n\t" \
            "v_mfma_scale_f32_16x16x128_f8f6f4 %2, %8, %11, %2, %14, %15 op_sel_hi:[0,0,0]\n\t" \
            "v_mfma_scale_f32_16x16x128_f8f6f4 %3, %9, %11, %3, %14, %15 op_sel_hi:[0,0,0]\n\t" \
            "v_mfma_scale_f32_16x16x128_f8f6f4 %4, %8, %12, %4, %14, %15 op_sel_hi:[0,0,0]\n\t" \
            "v_mfma_scale_f32_16x16x128_f8f6f4 %5, %9, %12, %5, %14, %15 op_sel_hi:[0,0,0]\n\t" \
            "v_mfma_scale_f32_16x16x128_f8f6f4 %6, %8, %13, %6, %14, %15 op_sel_hi:[0,0,0]\n\t" \
            "v_mfma_scale_f32_16x16x128_f8f6f4 %7, %9, %13, %7, %14, %15 op_sel_hi:[0,0,0]" \
            : "+v"(acc[ai][bj][0][0]), "+v"(acc[ai][bj][0][1]), "+v"(acc[ai][bj][1][0]), "+v"(acc[ai][bj][1][1]), "+v"(acc[ai][bj][2][0]), "+v"(acc[ai][bj][2][1]), "+v"(acc[ai][bj][3][0]), "+v"(acc[ai][bj][3][1]) \
            : "v"(Bt##8[0]), "v"(Bt##8[1]), "v"(At##8[0]), "v"(At##8[1]), "v"(At##8[2]), "v"(At##8[3]), "v"(scw_), "v"(sca_)); } \
        else { _Pragma("unroll") for (int m = 0; m < 4; ++m) _Pragma("unroll") for (int n = 0; n < 2; ++n) _Pragma("unroll") for (int k = 0; k < 2; ++k) \
            acc[ai][bj][m][n] = __builtin_amdgcn_mfma_f32_16x16x32_bf16(Bt[n][k], At[m][k], acc[ai][bj][m][n], 0, 0, 0); } __builtin_amdgcn_s_setprio(0); } while (0)
#define PG8_WAIT_V(n) asm volatile("s_waitcnt vmcnt(" #n ")" ::: "memory")
#define PG8_WAIT_L(n) asm volatile("s_waitcnt lgkmcnt(" #n ")" ::: "memory")
#define PG8_BAR __builtin_amdgcn_s_barrier()
#define PG8_SCHED __builtin_amdgcn_sched_barrier(0)
#define PG8_AOFF(dst, u_, ui_) do { _Pragma("unroll") for (int _h = 0; _h < 2; ++_h) _Pragma("unroll") for (int _i = 0; _i < 2; ++_i) { \
        if constexpr (GATHER) dst[_h][_i] = (unsigned)(rowtab[(ui_) * 256 + _h * HALF + _i * 64 + R0] * (unsigned)(K * ESZ) + (unsigned)(C0 * 2)); \
        else dst[_h][_i] = (unsigned)((_h * HALF + _i * 64 + R0) * K * ESZ + C0 * 2); } } while (0)
    Unit cur, nxt; int ui = 0;
    if (!S.next(0, cur)) return;
    f32x4 acc[2][2][4][2];
#pragma unroll
    for (int a = 0; a < 2; ++a)
#pragma unroll
        for (int b = 0; b < 2; ++b)
#pragma unroll
            for (int m = 0; m < 4; ++m)
#pragma unroll
                for (int n = 0; n < 2; ++n) acc[a][b][m][n] = (f32x4){0.f, 0.f, 0.f, 0.f};
    bf16x8 At[4][2], B0[2][2], B1[2][2]; v8i At8[4], B08[2], B18[2]; const int scw_ = P::SCW, sca_ = P::SCA;
    unsigned vAc[2][2], vAn[2][2];
    PG8_AOFF(vAc, cur, 0);
    const char* cA = S.aptr(cur); const char* cB = S.bptr(cur);
    if constexpr (SP2) {
        PG8_STAGE(PG8_SB(0, 0), cB, voffB); PG8_STAGE(PG8_SB(0, 1), cB + hstep, voffB); PG8_STAGE(PG8_SA(0, 0), cA, vAc[0]); PG8_STAGE(PG8_SA(0, 1), cA, vAc[1]);
        if (wr == 1) PG8_BAR;
        PG8_WAIT_V(2); PG8_BAR;
        PG8_STAGE(PG8_SB(1, 0), cB + kstep, voffB); PG8_STAGE(PG8_SA(1, 0), cA + kstep, vAc[0]); PG8_STAGE(PG8_SB(1, 1), cB + hstep + kstep, voffB);
        PG8_WAIT_V(6); PG8_BAR;
    } else {
        PG8_STAGE(PG8_SB(0, 0), cB, voffB); PG8_STAGE(PG8_SA(0, 0), cA, vAc[0]); PG8_STAGE(PG8_SB(0, 1), cB + hstep, voffB); PG8_STAGE(PG8_SA(0, 1), cA, vAc[1]);
        if (wr == 1) PG8_BAR;
        PG8_WAIT_V(4); PG8_BAR;
        PG8_STAGE(PG8_SB(1, 0), cB + kstep, voffB); PG8_STAGE(PG8_SA(1, 0), cA + kstep, vAc[0]); PG8_STAGE(PG8_SB(1, 1), cB + hstep + kstep, voffB);
        PG8_WAIT_V(6); PG8_BAR;
    }
    for (;;) {
        const bool has_next = S.next(ui + 1, nxt);
        const char* nA = has_next ? S.aptr(nxt) : cA; const char* nB = has_next ? S.bptr(nxt) : cB;
        if (has_next) { PG8_AOFF(vAn, nxt, ui + 1); }
        else {
#pragma unroll
            for (int h = 0; h < 2; ++h)
#pragma unroll
                for (int i = 0; i < 2; ++i) vAn[h][i] = vAc[h][i];
        }
        for (int t = 0; t < nt; t += 2) {
            const bool last = (t == nt - 2);
            const char* a1 = cA + (size_t)(t + 1) * kstep;
            const char* a2 = last ? nA : cA + (size_t)(t + 2) * kstep; const char* b2 = last ? nB : cB + (size_t)(t + 2) * kstep;
            const char* a3 = a2 + kstep; const char* b3 = b2 + kstep;
            unsigned w2[2][2];
#pragma unroll
            for (int h = 0; h < 2; ++h)
#pragma unroll
                for (int i = 0; i < 2; ++i) w2[h][i] = last ? vAn[h][i] : vAc[h][i];
            if constexpr (SP2) {
            PG8_LDB(B0, 0, 0); PG8_LDB(B1, 0, 1); PG8_SCHED; PG8_LDA(At, 0, 0); PG8_STAGE(PG8_SA(1, 1), a1, vAc[1]);
            PG8_WAIT_V(8); PG8_WAIT_L(0); PG8_BAR; PG8_MMA(0, 0, At, B0); PG8_MMA(0, 1, At, B1); PG8_BAR; PG8_SCHED;
            PG8_LDA(At, 0, 1); PG8_STAGE(PG8_SB(0, 0), b2, voffB); PG8_STAGE(PG8_SB(0, 1), b2 + hstep, voffB); PG8_STAGE(PG8_SA(0, 0), a2, w2[0]);
            PG8_WAIT_V(8); PG8_WAIT_L(0); PG8_BAR; PG8_MMA(1, 0, At, B0); PG8_MMA(1, 1, At, B1); PG8_BAR; PG8_SCHED;
            PG8_LDB(B0, 1, 0); PG8_LDB(B1, 1, 1); PG8_SCHED; PG8_LDA(At, 1, 0); PG8_STAGE(PG8_SA(0, 1), a2, w2[1]);
            PG8_WAIT_V(8); PG8_WAIT_L(0); PG8_BAR; PG8_MMA(0, 0, At, B0); PG8_MMA(0, 1, At, B1); PG8_BAR; PG8_SCHED;
            PG8_LDA(At, 1, 1); PG8_STAGE(PG8_SB(1, 0), b3, voffB); PG8_STAGE(PG8_SB(1, 1), b3 + hstep, voffB); PG8_STAGE(PG8_SA(1, 0), a3, w2[0]);
            PG8_WAIT_V(8); PG8_WAIT_L(0); PG8_BAR; PG8_MMA(1, 0, At, B0); PG8_MMA(1, 1, At, B1); PG8_BAR; PG8_SCHED;
            } else {
            PG8_LDB(B0, 0, 0); PG8_SCHED; PG8_LDA(At, 0, 0); PG8_STAGE(PG8_SA(1, 1), a1, vAc[1]);
            PG8_WAIT_L(8); PG8_BAR; PG8_WAIT_L(0); PG8_MMA(0, 0, At, B0); PG8_BAR; PG8_SCHED;
            PG8_LDB(B1, 0, 1); PG8_STAGE(PG8_SB(0, 0), b2, voffB);
            PG8_BAR; PG8_WAIT_L(0); PG8_MMA(0, 1, At, B1); PG8_BAR;
            PG8_LDA(At, 0, 1); PG8_STAGE(PG8_SA(0, 0), a2, w2[0]);
            PG8_BAR; PG8_WAIT_L(0); PG8_MMA(1, 0, At, B0); PG8_BAR; PG8_SCHED;
            PG8_STAGE(PG8_SB(0, 1), b2 + hstep, voffB);
            PG8_WAIT_V(6); PG8_BAR; PG8_MMA(1, 1, At, B1); PG8_BAR;
            PG8_LDB(B0, 1, 0); PG8_SCHED; PG8_LDA(At, 1, 0); PG8_STAGE(PG8_SA(0, 1), a2, w2[1]);
            PG8_WAIT_L(8); PG8_BAR; PG8_WAIT_L(0); PG8_MMA(0, 0, At, B0); PG8_BAR; PG8_SCHED;
            PG8_LDB(B1, 1, 1); PG8_STAGE(PG8_SB(1, 0), b3, voffB);
            PG8_BAR; PG8_WAIT_L(0); PG8_MMA(0, 1, At, B1); PG8_BAR;
            PG8_LDA(At, 1, 1); PG8_STAGE(PG8_SA(1, 0), a3, w2[0]);
            PG8_BAR; PG8_WAIT_L(0); PG8_MMA(1, 0, At, B0); PG8_BAR; PG8_SCHED;
            PG8_STAGE(PG8_SB(1, 1), b3 + hstep, voffB);
            PG8_WAIT_V(6); PG8_BAR; PG8_MMA(1, 1, At, B1); PG8_BAR;
            }
        }
        if constexpr (ALIGN_EPI) { if (wr == 0) PG8_BAR; }
        if constexpr (F8) asm volatile("s_nop 15\n\ts_nop 7" ::: "memory");
        { int fr2 = fr, fq2 = fq; asm volatile("" : "+v"(fr2), "+v"(fq2));
          S.epi(acc, cur, wr, wc, fr2, fq2); }
        if (!has_next) break;
#pragma unroll
        for (int a = 0; a < 2; ++a)
#pragma unroll
            for (int b = 0; b < 2; ++b)
#pragma unroll
                for (int m = 0; m < 4; ++m)
#pragma unroll
                    for (int n = 0; n < 2; ++n) acc[a][b][m][n] = (f32x4){0.f, 0.f, 0.f, 0.f};
        cur = nxt; cA = nA; cB = nB; ++ui;
#pragma unroll
        for (int h = 0; h < 2; ++h)
#pragma unroll
            for (int i = 0; i < 2; ++i) vAc[h][i] = vAn[h][i];
        if constexpr (ALIGN_EPI) { if (wr == 1) PG8_BAR; }
    }
    PG8_WAIT_V(0);
    if constexpr (!ALIGN_EPI) { if (wr == 0) PG8_BAR; }
    PG8_BAR;
#undef PG8_SA
#undef PG8_SB
#undef PG8_STAGE
#undef PG8_LDA
#undef PG8_LDB
#undef PG8_MMA
#undef PG8_WAIT_V
#undef PG8_WAIT_L
#undef PG8_BAR
#undef PG8_SCHED
#undef PG8_AOFF
}
}

namespace attn_body {
using bf16 = __hip_bfloat16;
using bf16x8 = __attribute__((ext_vector_type(8))) short;
using s16x4 = __attribute__((ext_vector_type(4))) short;
using f32x16 = __attribute__((ext_vector_type(16))) float;
using u32x4 = __attribute__((ext_vector_type(4))) unsigned;
constexpr int D = 64, QPITCH = NHQ * D, KPITCH = NHKV * D, OPITCH = DM, OCOL0 = 256;
constexpr int NW = 8, QBLK = 32, QB = QBLK * NW, KVBLK = 64, NQB = NTOK / QB, NT = NKEYS / KVBLK;
static_assert(NT % 2 == 0 && NT >= 8, "tile count");
__device__ __forceinline__ int crow(int r, int hi) { return (r & 3) + 8 * (r >> 2) + 4 * hi; }
#define SBAR() __builtin_amdgcn_sched_barrier(0)
constexpr int NSLOT = 3, SLOTB = 8192;
constexpr int LDS_K = 0, LDS_V = NSLOT * SLOTB, LDS_WS = 2 * NSLOT * SLOTB, LDS_OST = LDS_WS + NW * 64 * 4, LDS_BYTES = LDS_OST + NW * 4096;
constexpr float C2 = 0.125f * 1.4426950408889634f;
__device__ __forceinline__ void glds16(const void* gsrc, unsigned lds_dst) { unsigned keep;
  asm volatile("s_mov_b32 %0, m0\n\ts_mov_b32 m0, %2\n\ts_nop 0\n\tglobal_load_lds_dwordx4 %1, off\n\ts_mov_b32 m0, %0" : "=&s"(keep) : "v"(gsrc), "s"(lds_dst) : "memory"); }
__device__ __forceinline__ float max3f(float a, float b, float c) { float r; asm("v_max3_f32 %0, %1, %2, %3" : "=v"(r) : "v"(a), "v"(b), "v"(c)); return r; }
__device__ __forceinline__ float max2f(float a, float b) { float r; asm("v_max_f32_e32 %0, %1, %2" : "=v"(r) : "v"(a), "v"(b)); return r; }
__device__ __forceinline__ float fadd_s(float a, float b) { float r; asm("v_add_f32_e32 %0, %1, %2" : "=v"(r) : "v"(a), "v"(b)); return r; }
__device__ __forceinline__ float fsub_s(float a, float b) { float r; asm("v_sub_f32_e32 %0, %1, %2" : "=v"(r) : "v"(a), "v"(b)); return r; }
typedef float f32x2_t __attribute__((ext_vector_type(2))); typedef __bf16 bf16x2_t __attribute__((ext_vector_type(2)));
__device__ __forceinline__ unsigned cvtpk_s(float lo, float hi) { f32x2_t v = {lo, hi}; bf16x2_t b = __builtin_convertvector(v, bf16x2_t); return __builtin_bit_cast(unsigned, b); }
#define WAIT_BAR(N) asm volatile("s_waitcnt vmcnt(" #N ") lgkmcnt(0)\n\ts_barrier" ::: "memory")

__device__ __forceinline__ void qkt(f32x16& p0, f32x16& p1, const char* Kslot, const bf16x8* qr, const f32x16& negm, int r32, int hi) {
  const char* kb = Kslot + hi * 1024 + r32 * 16;
  #pragma unroll
  for (int d0 = 0; d0 < 4; ++d0) {
    const bf16x8 b0 = *reinterpret_cast<const bf16x8*>(kb + d0 * 2048);
    const bf16x8 b1 = *reinterpret_cast<const bf16x8*>(kb + d0 * 2048 + 512);
    if (d0 == 0) { p0 = __builtin_amdgcn_mfma_f32_32x32x16_bf16(b0, qr[0], negm, 0, 0, 0); p1 = __builtin_amdgcn_mfma_f32_32x32x16_bf16(b1, qr[0], negm, 0, 0, 0); }
    else { p0 = __builtin_amdgcn_mfma_f32_32x32x16_bf16(b0, qr[d0], p0, 0, 0, 0); p1 = __builtin_amdgcn_mfma_f32_32x32x16_bf16(b1, qr[d0], p1, 0, 0, 0); } }
}
typedef __attribute__((address_space(3))) const char* lds_cptr;
typedef short v4i16_t __attribute__((ext_vector_type(4)));
__device__ __forceinline__ void kload8(bf16x8* kf, lds_cptr kp) {
  kf[0] = *(const __attribute__((address_space(3))) bf16x8*)(kp);        kf[1] = *(const __attribute__((address_space(3))) bf16x8*)(kp + 512);
  kf[2] = *(const __attribute__((address_space(3))) bf16x8*)(kp + 2048); kf[3] = *(const __attribute__((address_space(3))) bf16x8*)(kp + 2560);
  kf[4] = *(const __attribute__((address_space(3))) bf16x8*)(kp + 4096); kf[5] = *(const __attribute__((address_space(3))) bf16x8*)(kp + 4608);
  kf[6] = *(const __attribute__((address_space(3))) bf16x8*)(kp + 6144); kf[7] = *(const __attribute__((address_space(3))) bf16x8*)(kp + 6656);
}
__device__ __forceinline__ void kload2(bf16x8* kf, lds_cptr kp, int j) { kf[2 * j] = *(const __attribute__((address_space(3))) bf16x8*)(kp + j * 2048); kf[2 * j + 1] = *(const __attribute__((address_space(3))) bf16x8*)(kp + j * 2048 + 512); }
__device__ __forceinline__ s16x4 vtr(lds_cptr p) { return __builtin_bit_cast(s16x4, __builtin_amdgcn_ds_read_tr16_b64_v4i16((__attribute__((address_space(3))) v4i16_t*)p)); }
__device__ __forceinline__ float rowmax(const f32x16& p0, const f32x16& p1) {
  float a = max3f(p0[0], p0[1], p1[0]), b = max3f(p0[2], p0[3], p1[1]); a = max3f(a, p1[2], p1[3]);
  #pragma unroll
  for (int r = 4; r < 16; r += 4) { a = max3f(a, p0[r], p0[r + 1]); b = max3f(b, p0[r + 2], p0[r + 3]); a = max3f(a, p1[r], p1[r + 1]); b = max3f(b, p1[r + 2], p1[r + 3]); }
  const float m = max2f(a, b);
  auto rr = __builtin_amdgcn_permlane32_swap(__float_as_uint(m), __float_as_uint(m), false, false);
  return max2f(__uint_as_float(rr[0]), __uint_as_float(rr[1]));
}
__device__ __forceinline__ void pv(f32x16* o, int vb, bf16x8 pa0, bf16x8 pa1, bf16x8 pa2, bf16x8 pa3) {
  #pragma unroll
  for (int d0 = 0; d0 < 2; ++d0) { s16x4 lo[4], hi[4];
    #pragma unroll
    for (int ks = 0; ks < 4; ++ks) {
      asm volatile("ds_read_b64_tr_b16 %0,%1 offset:%c2" : "=&v"(lo[ks]) : "v"(vb), "i"(d0 * 4096 + ks * 1024) : "memory");
      asm volatile("ds_read_b64_tr_b16 %0,%1 offset:%c2" : "=&v"(hi[ks]) : "v"(vb), "i"(d0 * 4096 + ks * 1024 + 512) : "memory"); }
    asm volatile("s_waitcnt lgkmcnt(0)" ::: "memory"); SBAR();
    #define PK(k) (bf16x8){lo[k][0], lo[k][1], lo[k][2], lo[k][3], hi[k][0], hi[k][1], hi[k][2], hi[k][3]}
    o[d0] = __builtin_amdgcn_mfma_f32_32x32x16_bf16(pa0, PK(0), o[d0], 0, 0, 0);
    o[d0] = __builtin_amdgcn_mfma_f32_32x32x16_bf16(pa1, PK(1), o[d0], 0, 0, 0);
    o[d0] = __builtin_amdgcn_mfma_f32_32x32x16_bf16(pa2, PK(2), o[d0], 0, 0, 0);
    o[d0] = __builtin_amdgcn_mfma_f32_32x32x16_bf16(pa3, PK(3), o[d0], 0, 0, 0);
    #undef PK
  }
}
#define ATTN_STORE16(p, v) (*(u32x4*)(p) = (v))
template <int THRL> __device__ __forceinline__ void attn_unit(int h, int kvh, int qb, const bf16* Q, const bf16* __restrict__ K, const bf16* __restrict__ V, bf16* O, char* shm, int wid, float kmax2) {
  const int lane = fresh_lane(), r32 = lane & 31, hi = lane >> 5;
  const int q0 = qb * QB;
  const bf16* Qw = Q + (long)(q0 + wid * QBLK) * QPITCH + h * D;
  const bf16* Kh = K + kvh * D, *Vh = V + kvh * D;
  const unsigned lds0 = (unsigned)(uintptr_t)shm;
  float* wsf = (float*)(shm + LDS_WS) + wid * 64;
  const bf16* ksrc = Kh + (long)lane * KPITCH + wid * 8;
  const bf16* vsrc = Vh + (long)(16 * (wid & 3) + (lane >> 2)) * KPITCH + (wid >> 2) * 32 + (lane & 3) * 8;
  const unsigned kdst = lds0 + LDS_K + wid * 1024, vdst = lds0 + LDS_V + wid * 1024;
  #define DMA_K(t, slot) glds16(ksrc + (long)(t) * KVBLK * KPITCH, (unsigned)__builtin_amdgcn_readfirstlane(kdst + (slot)))
  #define DMA_V(t, slot) glds16(vsrc + (long)(t) * KVBLK * KPITCH, (unsigned)__builtin_amdgcn_readfirstlane(vdst + (slot)))
  const int vb0 = (int)(lds0 + LDS_V) + ((lane >> 4) & 1) * 32 + (lane & 3) * 8 + (4 * hi + ((lane & 15) >> 2)) * 64;
  const char* Kbase = shm + LDS_K; bf16x8 kf[8];
  const lds_cptr shm3 = (lds_cptr)shm; const lds_cptr kp0 = shm3 + LDS_K + hi * 1024 + r32 * 16; const lds_cptr vp0 = shm3 + LDS_V + ((lane >> 4) & 1) * 32 + (lane & 3) * 8 + (4 * hi + ((lane & 15) >> 2)) * 64;
  DMA_K(0, 0); DMA_V(0, 0); DMA_K(1, SLOTB);
  bf16x8 qr[4];
  #pragma unroll
  for (int d0 = 0; d0 < 4; ++d0) qr[d0] = *reinterpret_cast<const bf16x8*>(&Qw[(long)r32 * QPITCH + d0 * 16 + hi * 8]);
  float l_reg = 0.f; f32x16 o[2]; o[0] = f32x16{}; o[1] = f32x16{}; f32x16 negm;
  { float qn2 = 0.f;
    #pragma unroll
    for (int d0 = 0; d0 < 4; ++d0)
      #pragma unroll
      for (int j = 0; j < 8; ++j) { const float f = __uint_as_float((unsigned)(unsigned short)qr[d0][j] << 16); qn2 += f * f; }
    auto rr = __builtin_amdgcn_permlane32_swap(__float_as_uint(qn2), __float_as_uint(qn2), false, false); qn2 = __uint_as_float(rr[0]) + __uint_as_float(rr[1]);
    const float bnd = sqrtf(qn2 * kmax2) * 1.004f + 0.01f;
    #pragma unroll
    for (int r = 0; r < 16; ++r) negm[r] = -bnd;
    asm volatile("" : "+v"(negm)); }
  f32x16 pA0, pA1, pB0, pB1;
  int sl_prev = 0, sl_cur = 0, sl_next = SLOTB;
  #define ROT() do { sl_prev = sl_cur; sl_cur = sl_next; sl_next = (sl_next == (NSLOT - 1) * SLOTB) ? 0 : sl_next + SLOTB; } while (0)
  DMA_K(2, 2 * SLOTB);
  WAIT_BAR(3);
  qkt(pA0, pA1, Kbase, qr, negm, r32, hi); asm volatile("s_nop 15\n\ts_nop 7" : "+v"(pA0), "+v"(pA1));
  _Pragma("unroll") for (int r = 0; r < 16; ++r) { pA0[r] = __builtin_amdgcn_exp2f(pA0[r]); pA1[r] = __builtin_amdgcn_exp2f(pA1[r]); }
  WAIT_BAR(0);
  DMA_K(3, 0); DMA_V(1, SLOTB);
  ROT();
  kload8(kf, kp0 + sl_cur);
  WAIT_BAR(2);
  s16x4 vlo[8], vhi[8]; u32x4 pw0, pw1, pw2, pw3;
  #define PKW(P, B) cvtpk_s(P[B], P[B + 1])
  #define PAF(k) __builtin_bit_cast(bf16x8, pw##k)
  #define VFR(i) (bf16x8){vlo[i][0], vlo[i][1], vlo[i][2], vlo[i][3], vhi[i][0], vhi[i][1], vhi[i][2], vhi[i][3]}
  #define PIN(x) asm volatile("" : "+v"(x))
  #define MX3(a, b, c) __builtin_fmaxf(__builtin_fmaxf((a), (b)), (c))
  #define GAPA(MF, A0, A1, A2, A3, W0, W1, PW) do { MF; sacc += A0; sacc += A1; sacc += A2; sacc += A3; PIN(sacc); W0; W1; PIN(PW); SBAR(); } while (0)
  #define EX(v) __builtin_amdgcn_exp2f(v)
  #define GAPB(MF, X, B) do { MF; X[B] = EX(X[B]); X[B + 1] = EX(X[B + 1]); X[B + 2] = EX(X[B + 2]); X[B + 3] = EX(X[B + 3]); PIN(X); SBAR(); } while (0)
  #define VRD(i) do { vlo[i] = vtr(vp_ + (((i) >> 2) * 4096 + ((i) & 3) * 1024)); vhi[i] = vtr(vp_ + (((i) >> 2) * 4096 + ((i) & 3) * 1024 + 512)); } while (0)
  #define KRD(G, j) do { if (G) { kload2(kf, kp0 + sl_next, j); SBAR(); } } while (0)
  #define STEPM(C0, C1, P0, P1, t, GK, GV, GL) do { SBAR(); \
    const lds_cptr vp_ = vp0 + sl_prev; \
    VRD(0); SBAR(); float sacc = (P0[0] + P0[1]); \
    GAPA(C0 = __builtin_amdgcn_mfma_f32_32x32x16_bf16(kf[0], qr[0], negm, 0, 0, 0), P0[2], P0[3], P0[4], P0[5],     pw0[0] = PKW(P0, 0), pw0[1] = PKW(P0, 2), pw0); \
    VRD(4); SBAR(); GAPA(C1 = __builtin_amdgcn_mfma_f32_32x32x16_bf16(kf[1], qr[0], negm, 0, 0, 0), P0[6], P0[7], P0[8], P0[9],     pw0[2] = PKW(P0, 4), pw0[3] = PKW(P0, 6), pw0); \
    VRD(1); SBAR(); GAPA(C0 = __builtin_amdgcn_mfma_f32_32x32x16_bf16(kf[2], qr[1], C0, 0, 0, 0),   P0[10], P0[11], P0[12], P0[13], pw1[0] = PKW(P0, 8), pw1[1] = PKW(P0, 10), pw1); \
    VRD(5); SBAR(); GAPA(C1 = __builtin_amdgcn_mfma_f32_32x32x16_bf16(kf[3], qr[1], C1, 0, 0, 0),   P0[14], P0[15], P1[0], P1[1],   pw1[2] = PKW(P0, 12), pw1[3] = PKW(P0, 14), pw1); \
    VRD(2); SBAR(); GAPA(C0 = __builtin_amdgcn_mfma_f32_32x32x16_bf16(kf[4], qr[2], C0, 0, 0, 0),   P1[2], P1[3], P1[4], P1[5],     pw2[0] = PKW(P1, 0), pw2[1] = PKW(P1, 2), pw2); \
    VRD(6); SBAR(); GAPA(C1 = __builtin_amdgcn_mfma_f32_32x32x16_bf16(kf[5], qr[2], C1, 0, 0, 0),   P1[6], P1[7], P1[8], P1[9],     pw2[2] = PKW(P1, 4), pw2[3] = PKW(P1, 6), pw2); \
    VRD(3); SBAR(); GAPA(C0 = __builtin_amdgcn_mfma_f32_32x32x16_bf16(kf[6], qr[3], C0, 0, 0, 0),   P1[10], P1[11], P1[12], P1[13], pw3[0] = PKW(P1, 8), pw3[1] = PKW(P1, 10), pw3); \
    VRD(7); SBAR(); GAPA(C1 = __builtin_amdgcn_mfma_f32_32x32x16_bf16(kf[7], qr[3], C1, 0, 0, 0),   P1[14], P1[15], 0.f, 0.f,       pw3[2] = PKW(P1, 12), pw3[3] = PKW(P1, 14), pw3); \
    l_reg += sacc; \
    if (GK) { DMA_K((t) + 3, sl_cur); } if (GV) { DMA_V((t) + 1, sl_next); } \
    SBAR(); \
    GAPB(o[0] = __builtin_amdgcn_mfma_f32_32x32x16_bf16(PAF(0), VFR(0), o[0], 0, 0, 0), C0, 0); \
    GAPB(o[1] = __builtin_amdgcn_mfma_f32_32x32x16_bf16(PAF(0), VFR(4), o[1], 0, 0, 0), C0, 4); \
    KRD(GL, 0); GAPB(o[0] = __builtin_amdgcn_mfma_f32_32x32x16_bf16(PAF(1), VFR(1), o[0], 0, 0, 0), C0, 8); \
    KRD(GL, 1); GAPB(o[1] = __builtin_amdgcn_mfma_f32_32x32x16_bf16(PAF(1), VFR(5), o[1], 0, 0, 0), C0, 12); \
    KRD(GL, 2); GAPB(o[0] = __builtin_amdgcn_mfma_f32_32x32x16_bf16(PAF(2), VFR(2), o[0], 0, 0, 0), C1, 0); \
    KRD(GL, 3); GAPB(o[1] = __builtin_amdgcn_mfma_f32_32x32x16_bf16(PAF(2), VFR(6), o[1], 0, 0, 0), C1, 4); \
    GAPB(o[0] = __builtin_amdgcn_mfma_f32_32x32x16_bf16(PAF(3), VFR(3), o[0], 0, 0, 0), C1, 8); \
    GAPB(o[1] = __builtin_amdgcn_mfma_f32_32x32x16_bf16(PAF(3), VFR(7), o[1], 0, 0, 0), C1, 12); \
    } while (0)
  int t = 1;
  for (; t + 5 < NT; t += 2) {
    STEPM(pB0, pB1, pA0, pA1, t, true, true, true);     WAIT_BAR(2); ROT();
    STEPM(pA0, pA1, pB0, pB1, t + 1, true, true, true); WAIT_BAR(2); ROT();
  }
  #define ENDW(tt) do { if ((tt) + 3 < NT) { WAIT_BAR(2); } else if ((tt) + 2 < NT) { WAIT_BAR(1); } else { WAIT_BAR(0); } } while (0)
  for (; t + 1 < NT; t += 2) {
    STEPM(pB0, pB1, pA0, pA1, t, (t + 3 < NT), (t + 1 < NT), (t + 1 < NT));         ENDW(t);     ROT();
    STEPM(pA0, pA1, pB0, pB1, t + 1, (t + 4 < NT), (t + 2 < NT), (t + 2 < NT));     ENDW(t + 1); ROT();
  }
  STEPM(pB0, pB1, pA0, pA1, NT - 1, false, false, false);
  { float sacc = pB0[0] + pB0[1]; _Pragma("unroll") for (int r = 2; r < 16; ++r) sacc += pB0[r]; _Pragma("unroll") for (int r = 0; r < 16; ++r) sacc += pB1[r]; l_reg += sacc;
    pw0 = (u32x4){PKW(pB0, 0), PKW(pB0, 2), PKW(pB0, 4), PKW(pB0, 6)}; pw1 = (u32x4){PKW(pB0, 8), PKW(pB0, 10), PKW(pB0, 12), PKW(pB0, 14)}; pw2 = (u32x4){PKW(pB1, 0), PKW(pB1, 2), PKW(pB1, 4), PKW(pB1, 6)}; pw3 = (u32x4){PKW(pB1, 8), PKW(pB1, 10), PKW(pB1, 12), PKW(pB1, 14)};
    SBAR(); pv(o, vb0 + sl_cur, PAF(0), PAF(1), PAF(2), PAF(3)); }
  #undef PKW
  #undef PAF
  #undef VFR
  #undef PIN
  #undef MX3
  #undef GAPA
  #undef GAPB
  #undef EX
  #undef VRD
  #undef KRD
  #undef STEPM
  #undef ENDW
  { auto rr = __builtin_amdgcn_permlane32_swap(__float_as_uint(l_reg), __float_as_uint(l_reg), false, false); l_reg = __uint_as_float(rr[0]) + __uint_as_float(rr[1]); }
  if (hi == 0) wsf[32 + r32] = l_reg; asm volatile("s_waitcnt lgkmcnt(0)" ::: "memory");
  float rli[16];
  #pragma unroll
  for (int r = 0; r < 16; ++r) rli[r] = __builtin_amdgcn_rcpf(wsf[32 + crow(r, hi)]);
  bf16* Ow = O + (long)(q0 + wid * QBLK) * OPITCH + OCOL0 + h * D;
  { bf16* stg = (bf16*)(shm + LDS_OST) + wid * 2048;
    #pragma unroll
    for (int r = 0; r < 16; ++r) { const int orow = crow(r, hi);
      #pragma unroll
      for (int d0 = 0; d0 < 2; ++d0) stg[orow * 64 + d0 * 32 + r32] = __float2bfloat16(o[d0][r] * rli[r]); }
    asm volatile("s_waitcnt lgkmcnt(0)" ::: "memory");
    #pragma unroll
    for (int i = 0; i < 4; ++i) { const int row = i * 8 + (lane >> 3), ch = lane & 7; const u32x4 v = *(const u32x4*)(stg + row * 64 + ch * 8); ATTN_STORE16(Ow + (long)row * OPITCH + ch * 8, v); } }
  asm volatile("s_waitcnt lgkmcnt(0)\n\ts_barrier" ::: "memory");
  #undef DMA_K
  #undef DMA_V
  #undef ROT
}
#undef SBAR
#undef WAIT_BAR

typedef int v8i_t __attribute__((ext_vector_type(8)));
typedef unsigned u32x2_t __attribute__((ext_vector_type(2)));
typedef short v2s_t __attribute__((ext_vector_type(2)));
typedef _Float16 v2h_t __attribute__((ext_vector_type(2)));
constexpr int F8_SLOT = 4096, F8_RING = 12, F8_LDS_K = 0, F8_LDS_V = F8_RING * F8_SLOT, F8_LDS_WS = 2 * F8_RING * F8_SLOT, F8_LDS_OST = F8_LDS_WS + NW * 64 * 4, F8_LDS_BYTES = F8_LDS_OST + NW * 4096;
#define SBAR() __builtin_amdgcn_sched_barrier(0)
#define WAIT_BAR_(N) asm volatile("s_waitcnt vmcnt(" #N ") lgkmcnt(0)\n\ts_barrier" ::: "memory")
#define WAIT_BAR(N) WAIT_BAR_(N)
#define F8_LAG 4
#define F8_VMW 4
constexpr int F8_G = 3, F8_DK = F8_G + 1 + F8_LAG, F8_DV = F8_G - 1 + F8_LAG;
static_assert(2 * F8_G + F8_LAG <= F8_RING, "ring too small for the barrier period");
#define SLOTOF(u) ((unsigned)(((u) % F8_RING) * F8_SLOT))
#define SLOTC(SBJ, t, c) ((SBJ) >= 0 ? (unsigned)((((SBJ) + (c) + F8_RING) % F8_RING) * F8_SLOT) : SLOTOF((t) + (c)))
#define MFMA8_C(D, A, B, C, SA, SB) do { if (VAR & 64) { D = __builtin_amdgcn_mfma_f32_32x32x16_bf16(__builtin_bit_cast(bf16x8, (u32x4){(unsigned)A[0], (unsigned)A[1], (unsigned)A[2], (unsigned)A[3]}), __builtin_bit_cast(bf16x8, (u32x4){(unsigned)B[0], (unsigned)B[1], (unsigned)B[2], (unsigned)B[3]}), C, 0, 0, 0); \
      D = __builtin_amdgcn_mfma_f32_32x32x16_bf16(__builtin_bit_cast(bf16x8, (u32x4){(unsigned)A[4], (unsigned)A[5], (unsigned)A[6], (unsigned)A[7]}), __builtin_bit_cast(bf16x8, (u32x4){(unsigned)B[4], (unsigned)B[5], (unsigned)B[6], (unsigned)B[7]}), D, 0, 0, 0); } \
    else { asm volatile("v_mfma_scale_f32_32x32x64_f8f6f4 %0, %1, %2, %3, %4, %5 op_sel_hi:[0,0,0]" : "=&v"(D) : "v"(A), "v"(B), "v"(C), "v"(SA), "v"(SB)); \
      if (VAR & 256) asm volatile("v_mfma_scale_f32_32x32x64_f8f6f4 %0, %1, %2, %0, %3, %4 op_sel_hi:[0,0,0]" : "+v"(dacc) : "v"(A), "v"(B), "v"(SA), "v"(SB)); } } while (0)
#define MFMA8_ACC(D, A, B, SA, SB) do { if (VAR & 64) { D = __builtin_amdgcn_mfma_f32_32x32x16_bf16(__builtin_bit_cast(bf16x8, (u32x4){(unsigned)A[0], (unsigned)A[1], (unsigned)A[2], (unsigned)A[3]}), __builtin_bit_cast(bf16x8, (u32x4){(unsigned)B[0], (unsigned)B[1], (unsigned)B[2], (unsigned)B[3]}), D, 0, 0, 0); \
      D = __builtin_amdgcn_mfma_f32_32x32x16_bf16(__builtin_bit_cast(bf16x8, (u32x4){(unsigned)A[4], (unsigned)A[5], (unsigned)A[6], (unsigned)A[7]}), __builtin_bit_cast(bf16x8, (u32x4){(unsigned)B[4], (unsigned)B[5], (unsigned)B[6], (unsigned)B[7]}), D, 0, 0, 0); } \
    else { asm volatile("v_mfma_scale_f32_32x32x64_f8f6f4 %0, %1, %2, %0, %3, %4 op_sel_hi:[0,0,0]" : "+v"(D) : "v"(A), "v"(B), "v"(SA), "v"(SB)); \
      if (VAR & 256) asm volatile("v_mfma_scale_f32_32x32x64_f8f6f4 %0, %1, %2, %0, %3, %4 op_sel_hi:[0,0,0]" : "+v"(dacc) : "v"(A), "v"(B), "v"(SA), "v"(SB)); } } while (0)
template <int DBL> __device__ __forceinline__ v8i_t lds_frag32x(lds_cptr p) { const u32x4 lo = *(const __attribute__((address_space(3))) u32x4*)p, hi = *(const __attribute__((address_space(3))) u32x4*)(p + 2048);
  if (DBL) { const u32x4 lo2 = *(const volatile __attribute__((address_space(3))) u32x4*)(p + 4096), hi2 = *(const volatile __attribute__((address_space(3))) u32x4*)(p + 4112); asm volatile("" :: "v"(lo2), "v"(hi2)); }
  return (v8i_t){(int)lo.x, (int)lo.y, (int)lo.z, (int)lo.w, (int)hi.x, (int)hi.y, (int)hi.z, (int)hi.w}; }
__device__ __forceinline__ v8i_t lds_frag32(lds_cptr p) { const u32x4 lo = *(const __attribute__((address_space(3))) u32x4*)p, hi = *(const __attribute__((address_space(3))) u32x4*)(p + 16);
  return (v8i_t){(int)lo.x, (int)lo.y, (int)lo.z, (int)lo.w, (int)hi.x, (int)hi.y, (int)hi.z, (int)hi.w}; }
__device__ __forceinline__ unsigned pk4f8(float a, float b, float c, float d) { int p = __builtin_amdgcn_cvt_pk_fp8_f32(a, b, 0, false); p = __builtin_amdgcn_cvt_pk_fp8_f32(c, d, p, true); return (unsigned)p; }
struct ConvSub { const float* src; unsigned char* dst; int ldw, ldt, on; };
#define CV_ISSUE(S, p, B) do { if (S.on) { const unsigned vo_ = (unsigned)(((lane >> 3) * S.ldw + 4 * (lane & 7)) * 4); const char* gp_ = (const char*)(S.src + (size_t)(8 * (p)) * S.ldw); \
      asm volatile("s_mov_b32 m0, %1\n\ts_nop 0\n\tglobal_load_lds_dwordx4 %0, %2 nt" :: "v"(vo_), "s"((unsigned)__builtin_amdgcn_readfirstlane(cstage + (B) * 2048 + (p) * 1024)), "s"(gp_) : "memory", "m0"); } } while (0)
#define CV_CONSUME(S, B) do { if (S.on) { const __attribute__((address_space(3))) float* sp_ = (const __attribute__((address_space(3))) float*)(shm3 + F8_LDS_OST + wid * 4096 + (B) * 2048 + (lane >> 5) * 1024 + 4 * (lane & 31)); \
      const float c0_ = sp_[0], c1_ = sp_[32], c2_ = sp_[64], c3_ = sp_[96], c4_ = sp_[128], c5_ = sp_[160], c6_ = sp_[192], c7_ = sp_[224]; \
      const unsigned lo_ = pk4f8(c0_ * 32.f, c1_ * 32.f, c2_ * 32.f, c3_ * 32.f), hi_ = pk4f8(c4_ * 32.f, c5_ * 32.f, c6_ * 32.f, c7_ * 32.f); \
      __builtin_nontemporal_store((u32x2_t){lo_, hi_}, (u32x2_t*)(S.dst + (size_t)(lane & 31) * S.ldt + 8 * (lane >> 5))); S.on = 0; } } while (0)
template <class CV> __device__ __forceinline__ void conv_drain(CV& cv, char* shm, int wid) {
  const int lane = fresh_lane(); const unsigned lds0 = (unsigned)(uintptr_t)shm; const lds_cptr shm3 = (lds_cptr)shm; const unsigned cstage = lds0 + F8_LDS_OST + wid * 4096;
  for (;;) { ConvSub c; cv.get(c); if (!c.on) break;
    CV_ISSUE(c, 0, 0); CV_ISSUE(c, 1, 0); asm volatile("s_waitcnt vmcnt(0)" ::: "memory"); CV_CONSUME(c, 0); asm volatile("s_waitcnt lgkmcnt(0)" ::: "memory"); }
}
struct NoConv { __device__ __forceinline__ void get(ConvSub& c) { c.on = 0; } };
template <int VAR, class CV> __device__ __forceinline__ void attn_unit_f8(int h, int kvh, int qb, const unsigned char* Q8, const unsigned char* __restrict__ K8, const unsigned char* __restrict__ VT8, bf16* O, char* shm, int wid, float kmax2, CV& cv) {
  const int lane = fresh_lane(), r32 = lane & 31, hi = lane >> 5; const bool kwave = wid < 4;
  const int q0 = qb * QB;
  const unsigned lds0 = (unsigned)(uintptr_t)shm;
  float* wsf = (float*)(shm + F8_LDS_WS) + wid * 64;
  const int kpl = (wid & 3) >> 1, krow = 32 * (wid & 1) + (lane >> 1), khalf = (lane & 1) ^ ((krow >> 3) & 1), kch = 2 * khalf + kpl;
  const unsigned char* dsrc = kwave ? K8 + (size_t)krow * KPITCH + kvh * D + 16 * kch : VT8 + (size_t)kvh * (NT * 4096) + 1024 * (wid & 3) + 16 * lane;
  const long dstep = kwave ? (long)KVBLK * KPITCH : 4096;
  const unsigned ddst = lds0 + (kwave ? F8_LDS_K : F8_LDS_V) + (wid & 3) * 1024;
  const int doff = kwave ? F8_DK : F8_DV;
  #define DMA_T(t, slot) asm volatile("s_mov_b32 m0, %1\n\ts_nop 0\n\tglobal_load_lds_dwordx4 %0, off" :: "v"(dsrc + (long)(t) * dstep), "s"((unsigned)__builtin_amdgcn_readfirstlane(ddst + (slot))) : "memory", "m0")
  const lds_cptr shm3 = (lds_cptr)shm;
  const lds_cptr kp0 = shm3 + F8_LDS_K + r32 * 32 + 16 * (hi ^ ((r32 >> 3) & 1));
  const lds_cptr vp0 = shm3 + F8_LDS_V + r32 * 32 + 16 * (hi ^ ((r32 >> 3) & 1));
  v8i_t qf;
  { const unsigned char* qp = Q8 + (size_t)(q0 + wid * QBLK + r32) * QPITCH + h * D + 32 * hi; const u32x4 lo = *(const u32x4*)qp, hi4 = *(const u32x4*)(qp + 16);
    qf = (v8i_t){(int)lo.x, (int)lo.y, (int)lo.z, (int)lo.w, (int)hi4.x, (int)hi4.y, (int)hi4.z, (int)hi4.w}; }
  #pragma unroll
  for (int i = 0; i <= F8_DK; ++i) { if (i <= F8_DV) { DMA_T(i, SLOTOF(i)); } else if (kwave) { DMA_T(i, SLOTOF(i)); } }
  f32x16 lacc = f32x16{}; f32x16 o[2]; o[0] = f32x16{}; o[1] = f32x16{}; f32x16 negm;
  v8i_t ones8 = {0x38383838, 0x38383838, 0x38383838, 0x38383838, 0x38383838, 0x38383838, 0x38383838, 0x38383838}; asm volatile("" : "+v"(ones8));
  { float qn2 = 0.f;
    #pragma unroll
    for (int i = 0; i < 8; ++i) { const float f0 = __builtin_amdgcn_cvt_f32_fp8(qf[i], 0), f1 = __builtin_amdgcn_cvt_f32_fp8(qf[i], 1), f2 = __builtin_amdgcn_cvt_f32_fp8(qf[i], 2), f3 = __builtin_amdgcn_cvt_f32_fp8(qf[i], 3);
      qn2 += ((f0 * f0 + f1 * f1) + (f2 * f2 + f3 * f3)) * (1.f / 256.f); }
    auto rr = __builtin_amdgcn_permlane32_swap(__float_as_uint(qn2), __float_as_uint(qn2), false, false); qn2 = __uint_as_float(rr[0]) + __uint_as_float(rr[1]);
    const float bnd = sqrtf(qn2 * kmax2) * 1.004f + 0.01f;
    #pragma unroll
    for (int r = 0; r < 16; ++r) negm[r] = 8.f - bnd;
    asm volatile("" : "+v"(negm)); }
  int sQ = 0x7B7B7B7B, sONE = 0x7F7F7F7F; asm volatile("" : "+v"(sQ), "+v"(sONE));
  f32x16 dacc = f32x16{}; f32x16 pA0, pA1, pB0, pB1; v8i_t kf0, kf1, vfA0, vfA1, pwA = {0, 0, 0, 0, 0, 0, 0, 0}, pwB = {0, 0, 0, 0, 0, 0, 0, 0};
  #define PIN(x) asm volatile("" : "+v"(x))
  WAIT_BAR(F8_LAG);
  kf0 = lds_frag32x<(VAR & 512) != 0>(kp0); kf1 = lds_frag32x<(VAR & 512) != 0>(kp0 + 1024);
  asm volatile("s_waitcnt lgkmcnt(0)" ::: "memory");
  MFMA8_C(pA0, kf0, qf, negm, sONE, sQ); MFMA8_C(pA1, kf1, qf, negm, sONE, sQ);
  asm volatile("s_nop 15\n\ts_nop 15\n\ts_nop 7" : "+v"(pA0), "+v"(pA1));
  #pragma unroll
  for (int r = 0; r < 16; ++r) pA0[r] = __builtin_amdgcn_exp2f(pA0[r]);
  #define CVT2P(dst, a, b, c, d) do { dst = __builtin_amdgcn_cvt_pk_fp8_f32(a, b, dst, false); dst = __builtin_amdgcn_cvt_pk_fp8_f32(c, d, dst, true); } while (0)
  CVT2P(pwA[0], pA0[0], pA0[1], pA0[2], pA0[3]); CVT2P(pwA[1], pA0[4], pA0[5], pA0[6], pA0[7]); CVT2P(pwA[2], pA0[8], pA0[9], pA0[10], pA0[11]); CVT2P(pwA[3], pA0[12], pA0[13], pA0[14], pA0[15]);
  #undef CVT2P
  kf0 = lds_frag32x<(VAR & 512) != 0>(kp0 + SLOTOF(1)); kf1 = lds_frag32x<(VAR & 512) != 0>(kp0 + SLOTOF(1) + 1024);
  #define CVT2(dst, a, b, c, d) do { if (VAR & 1024) { v2s_t r_ = __builtin_bit_cast(v2s_t, dst); r_ = __builtin_amdgcn_cvt_scalef32_pk_fp8_f32(r_, a, b, 1.0f, false); r_ = __builtin_amdgcn_cvt_scalef32_pk_fp8_f32(r_, c, d, 1.0f, true); dst = __builtin_bit_cast(int, r_); } \
    else if (VAR & 2048) { v2s_t r_ = __builtin_bit_cast(v2s_t, dst); const v2h_t h0_ = __builtin_bit_cast(v2h_t, __builtin_amdgcn_cvt_pkrtz(a, b)), h1_ = __builtin_bit_cast(v2h_t, __builtin_amdgcn_cvt_pkrtz(c, d)); r_ = __builtin_amdgcn_cvt_scalef32_pk_fp8_f16(r_, h0_, 1.0f, false); r_ = __builtin_amdgcn_cvt_scalef32_pk_fp8_f16(r_, h1_, 1.0f, true); dst = __builtin_bit_cast(int, r_); } \
    else if (VAR & 16) { asm volatile("" : "+v"(dst) : "v"(a), "v"(b), "v"(c), "v"(d)); } else { dst = __builtin_amdgcn_cvt_pk_fp8_f32(a, b, dst, false); dst = __builtin_amdgcn_cvt_pk_fp8_f32(c, d, dst, true); if (VAR & 32) { asm volatile("" : "+v"(dst)); dst = __builtin_amdgcn_cvt_pk_fp8_f32(a, b, dst, false); dst = __builtin_amdgcn_cvt_pk_fp8_f32(c, d, dst, true); } } } while (0)
  #define EXF(v) ((VAR & 1) ? (v) * 0.999f : ((VAR & 128) ? __builtin_amdgcn_exp2f(__builtin_amdgcn_exp2f(v) * 1e-30f) + __builtin_amdgcn_exp2f(v) - 1.0f : __builtin_amdgcn_exp2f(v)))
  #define EX4(X, B) do { X[B] = EXF(X[B]); X[B + 1] = EXF(X[B + 1]); X[B + 2] = EXF(X[B + 2]); X[B + 3] = EXF(X[B + 3]); } while (0)
  #define STEP8(C0, C1, P1, PW, PWN, VF0, VF1, t, GK, GV, GL, SB) do { SBAR(); \
    VF0 = lds_frag32x<(VAR & 512) != 0>(vp0 + SLOTC(SB, t, -1)); VF1 = lds_frag32x<(VAR & 512) != 0>(vp0 + SLOTC(SB, t, -1) + 1024); SBAR(); \
    if (VAR & 2) { C0 = negm; asm volatile("" : "+v"(C0) : "v"(kf0)); } else { MFMA8_C(C0, kf0, qf, negm, sONE, sQ); } SBAR(); \
    EX4(P1, 0); EX4(P1, 4); EX4(P1, 8); PIN(P1); SBAR(); \
    if (VAR & 2) { C1 = negm; asm volatile("" : "+v"(C1) : "v"(kf1)); } else { MFMA8_C(C1, kf1, qf, negm, sONE, sQ); } SBAR(); \
    EX4(P1, 12); \
    CVT2(PW[4], P1[0], P1[1], P1[2], P1[3]); CVT2(PW[5], P1[4], P1[5], P1[6], P1[7]); CVT2(PW[6], P1[8], P1[9], P1[10], P1[11]); CVT2(PW[7], P1[12], P1[13], P1[14], P1[15]); \
    PIN(PW); SBAR(); \
    if ((GK) && (GV)) { DMA_T((t) + doff, kwave ? SLOTC(SB, t, F8_DK) : SLOTC(SB, t, F8_DV)); }     \
    else if (kwave) { if (GK) { DMA_T((t) + F8_DK, SLOTOF((t) + F8_DK)); } } else { if (GV) { DMA_T((t) + F8_DV, SLOTOF((t) + F8_DV)); } } \
    if (GL) { kf0 = lds_frag32x<(VAR & 512) != 0>(kp0 + SLOTC(SB, t, 1)); kf1 = lds_frag32x<(VAR & 512) != 0>(kp0 + SLOTC(SB, t, 1) + 1024); } SBAR(); \
    if (VAR & 2) { asm volatile("" : "+v"(lacc) : "v"(PW)); } else { MFMA8_ACC(lacc, PW, ones8, sONE, sONE); } asm volatile("" : "+v"(C0)); SBAR(); \
    EX4(C0, 0); EX4(C0, 4); PIN(C0); SBAR(); \
    if (VAR & 2) { asm volatile("" : "+v"(o[0]) : "v"(PW), "v"(VF0)); } else { MFMA8_ACC(o[0], PW, VF0, sONE, sONE); } SBAR(); \
    EX4(C0, 8); EX4(C0, 12); PIN(C0); SBAR(); \
    if (VAR & 2) { asm volatile("" : "+v"(o[1]) : "v"(PW), "v"(VF1)); } else { MFMA8_ACC(o[1], PW, VF1, sONE, sONE); } SBAR(); \
    CVT2(PWN[0], C0[0], C0[1], C0[2], C0[3]); CVT2(PWN[1], C0[4], C0[5], C0[6], C0[7]); CVT2(PWN[2], C0[8], C0[9], C0[10], C0[11]); CVT2(PWN[3], C0[12], C0[13], C0[14], C0[15]); PIN(PWN); SBAR(); } while (0)
  int t = 1;
  #define GBAR() do { if (VAR & 4) { asm volatile("s_waitcnt vmcnt(2) lgkmcnt(0)" ::: "memory"); } else { WAIT_BAR(F8_VMW); } } while (0)
  ConvSub cX, cY; cX.on = 0; cY.on = 0; cX.src = cY.src = nullptr; cX.dst = cY.dst = nullptr; cX.ldw = cY.ldw = 0; cX.ldt = cY.ldt = 0;
  const unsigned cstage = lds0 + F8_LDS_OST + wid * 4096;
  static_assert(F8_DK <= 12 && F8_DV <= 12, "over-run pieces must stay inside the workspace neighbours of K8 / VT8");
  #pragma unroll 1
  for (; t + 11 < NT; t += 12) {
    if (!VAR) { CV_CONSUME(cX, 0); CV_ISSUE(cY, 1, 1); }
    STEP8(pB0, pB1, pA1, pwA, pwB, vfA0, vfA1, t, true, true, true, 1);
    STEP8(pA0, pA1, pB1, pwB, pwA, vfA0, vfA1, t + 1, true, true, true, 2);
    STEP8(pB0, pB1, pA1, pwA, pwB, vfA0, vfA1, t + 2, true, true, true, 3); GBAR();
    if (!VAR) { cv.get(cX); CV_ISSUE(cX, 0, 0); }
    STEP8(pA0, pA1, pB1, pwB, pwA, vfA0, vfA1, t + 3, true, true, true, 4);
    STEP8(pB0, pB1, pA1, pwA, pwB, vfA0, vfA1, t + 4, true, true, true, 5);
    STEP8(pA0, pA1, pB1, pwB, pwA, vfA0, vfA1, t + 5, true, true, true, 6); GBAR();
    if (!VAR) { CV_CONSUME(cY, 1); CV_ISSUE(cX, 1, 0); }
    STEP8(pB0, pB1, pA1, pwA, pwB, vfA0, vfA1, t + 6, true, true, true, 7);
    STEP8(pA0, pA1, pB1, pwB, pwA, vfA0, vfA1, t + 7, true, true, true, 8);
    STEP8(pB0, pB1, pA1, pwA, pwB, vfA0, vfA1, t + 8, true, true, true, 9); GBAR();
    STEP8(pA0, pA1, pB1, pwB, pwA, vfA0, vfA1, t + 9, true, true, true, 10);
    STEP8(pB0, pB1, pA1, pwA, pwB, vfA0, vfA1, t + 10, true, true, true, 11);
    STEP8(pA0, pA1, pB1, pwB, pwA, vfA0, vfA1, t + 11, true, true, true, 0); GBAR();
  }
  if (!VAR) { CV_CONSUME(cX, 0); CV_ISSUE(cY, 1, 1); }
  #undef GBAR
  for (; t + 1 < NT; t += 2) {
    STEP8(pB0, pB1, pA1, pwA, pwB, vfA0, vfA1, t, (t + F8_DK < NT), (t + F8_DV < NT), (t + 1 < NT), -1);         WAIT_BAR(0);
    STEP8(pA0, pA1, pB1, pwB, pwA, vfA0, vfA1, t + 1, (t + 1 + F8_DK < NT), (t + 1 + F8_DV < NT), (t + 2 < NT), -1);     WAIT_BAR(0);
  }
  if (!VAR) { CV_CONSUME(cY, 1); }
  STEP8(pB0, pB1, pA1, pwA, pwB, vfA0, vfA1, NT - 1, false, false, false, -1);
  { asm volatile("s_nop 15\n\ts_nop 15\n\ts_nop 7" : "+v"(pB1));
    EX4(pB1, 0); EX4(pB1, 4); EX4(pB1, 8); EX4(pB1, 12);
    CVT2(pwB[4], pB1[0], pB1[1], pB1[2], pB1[3]); CVT2(pwB[5], pB1[4], pB1[5], pB1[6], pB1[7]); CVT2(pwB[6], pB1[8], pB1[9], pB1[10], pB1[11]); CVT2(pwB[7], pB1[12], pB1[13], pB1[14], pB1[15]);
    vfA0 = lds_frag32x<(VAR & 512) != 0>(vp0 + SLOTOF(NT - 1)); vfA1 = lds_frag32x<(VAR & 512) != 0>(vp0 + SLOTOF(NT - 1) + 1024);
    asm volatile("s_waitcnt lgkmcnt(0)" ::: "memory"); PIN(pwB); SBAR();
    MFMA8_ACC(o[0], pwB, vfA0, sONE, sONE); MFMA8_ACC(o[1], pwB, vfA1, sONE, sONE); MFMA8_ACC(lacc, pwB, ones8, sONE, sONE);
    asm volatile("s_nop 15\n\ts_nop 15\n\ts_nop 7" : "+v"(o[0]), "+v"(o[1]), "+v"(lacc)); }
  #undef STEP8
  #undef CVT2
  #undef EX4
  #undef EXF
  #undef PIN
  if (VAR & 256) asm volatile("" :: "v"(dacc));
  float rli[16];
  #pragma unroll
  for (int r = 0; r < 16; ++r) rli[r] = __builtin_amdgcn_rcpf(lacc[r]);
  bf16* Ow = O + (long)(q0 + wid * QBLK) * OPITCH + OCOL0 + h * D;
  { bf16* stg = (bf16*)(shm + F8_LDS_OST) + wid * 2048;
    #pragma unroll
    for (int r = 0; r < 16; ++r) { const int orow = crow(r, hi);
      #pragma unroll
      for (int d0 = 0; d0 < 2; ++d0) stg[orow * 64 + d0 * 32 + r32] = __float2bfloat16(o[d0][r] * rli[r]); }
    asm volatile("s_waitcnt lgkmcnt(0)" ::: "memory");
    #pragma unroll
    for (int i = 0; i < 4; ++i) { const int row = i * 8 + (lane >> 3), ch = lane & 7; const u32x4 v = *(const u32x4*)(stg + row * 64 + ch * 8); if (!(VAR & 8)) ATTN_STORE16(Ow + (long)row * OPITCH + ch * 8, v); } }
  asm volatile("s_waitcnt vmcnt(0) lgkmcnt(0)\n\ts_barrier" ::: "memory");
  #undef DMA_T
}
#undef MFMA8_C
#undef MFMA8_ACC
#undef SBAR
#undef WAIT_BAR
#undef WAIT_BAR_
#undef SLOTOF
#undef SLOTC
#undef CV_ISSUE
#undef CV_CONSUME
}

constexpr int NWAVES = 8, NTHR = NWAVES * 64;
constexpr size_t MiB = 1u << 20;
constexpr size_t WS_CTL = 0, CTL_ZERO_BYTES = 64 * 1024;
constexpr size_t WS_MOD = 1 * MiB;
constexpr size_t WS_MISC = WS_MOD + 64 * 1024;
constexpr size_t WS_IDX = WS_MISC, WS_GATE = WS_IDX + 128 * 1024, WS_TOKSLOT = WS_GATE + 128 * 1024;
constexpr size_t WS_AFF = 3 * MiB;
constexpr size_t WS_WIN = 4 * MiB;
constexpr size_t WS_WOUT = 7 * MiB;
constexpr size_t WS_WGU = 9 * MiB;
constexpr size_t WS_WD = 137 * MiB;
constexpr size_t WS_X1 = 201 * MiB;
constexpr size_t WS_R1 = 265 * MiB;
constexpr size_t WS_XN = WS_R1;
constexpr size_t WS_Q = WS_XN + (size_t)NROWS * DM * 2;
constexpr size_t WS_K = WS_Q + (size_t)NTOK * 768 * 2;
constexpr size_t WS_V = WS_K + (size_t)NROWS * 256 * 2;
constexpr size_t WS_FT = WS_V + (size_t)NROWS * 256 * 2;
constexpr size_t WS_MIX = WS_FT + (size_t)256 * NTOK * 4;
constexpr size_t WS_HID = WS_R1;
constexpr size_t WS_R2 = 393 * MiB;
constexpr size_t WS_H2 = WS_R2;
constexpr size_t WS_YE = WS_R2;
constexpr size_t WS_END = 457 * MiB;
static_assert(WS_MIX + (size_t)NTOK * DM * 2 <= WS_R1 + 128 * MiB, "R1 map");
static_assert(WS_TOKSLOT + (size_t)NTOK * 16 * 4 <= WS_AFF, "misc map");
constexpr int CW_TMO = 0, CW_FLAG = 2, CW_KMAX = 64, CW_BAR = 1024;

constexpr int LDS_BYTES = 163840;
constexpr int RING_BYTES = 131072, XTRA_OFF = RING_BYTES;
constexpr int MISC_OFF = LDS_BYTES - 512;

#define GAS __attribute__((address_space(1)))
#define LAS __attribute__((address_space(3)))
typedef unsigned short bf16;
typedef unsigned v4u __attribute__((ext_vector_type(4)));
typedef unsigned v2u __attribute__((ext_vector_type(2)));
typedef float f32x4 __attribute__((ext_vector_type(4)));
typedef float f32x2 __attribute__((ext_vector_type(2)));
typedef GAS unsigned gu32;
#define RLX_AGENT __ATOMIC_RELAXED, __HIP_MEMORY_SCOPE_AGENT
#define LDS_WAIT() asm volatile("s_waitcnt lgkmcnt(0)" ::: "memory")
#define VM_WAIT() asm volatile("s_waitcnt vmcnt(0)" ::: "memory")
__device__ __forceinline__ unsigned f2bf(float f) { unsigned u = __builtin_bit_cast(unsigned, f); return (u + 0x7fffu + ((u >> 16) & 1u)) >> 16; }
__device__ __forceinline__ unsigned pk2(float lo, float hi) { return f2bf(lo) | (f2bf(hi) << 16); }
__device__ __forceinline__ unsigned pk4_fp8(float a, float b, float c, float d) { int p = __builtin_amdgcn_cvt_pk_fp8_f32(a, b, 0, false); p = __builtin_amdgcn_cvt_pk_fp8_f32(c, d, p, true); return (unsigned)p; }
__device__ __forceinline__ float bf2f(unsigned short b) { return __builtin_bit_cast(float, (unsigned)b << 16); }

#define XB_TMO      128
#define XB_XCNT(j)  (256  + 64 * (j))
#define XB_XSUB(j)  (1280 + 64 * (j))
#define XB_XGEN(j)  (2304 + 64 * (j))
#define XB_TOP      3328
#define XB_TOPGEN   3392
#define XCD_BAR_WORDS 3456
#define XB_SPIN_CAP (1u << 20)
static_assert((CW_BAR + XCD_BAR_WORDS) * 4 <= (int)CTL_ZERO_BYTES, "ctl");
__device__ __forceinline__ unsigned xb_ld(unsigned* p)              { return __hip_atomic_load(p, __ATOMIC_RELAXED, __HIP_MEMORY_SCOPE_AGENT); }
__device__ __forceinline__ unsigned xb_add(unsigned* p, unsigned v) { return __hip_atomic_fetch_add(p, v, __ATOMIC_RELAXED, __HIP_MEMORY_SCOPE_AGENT); }
__device__ __forceinline__ unsigned xb_xcc_id() { return (unsigned)__builtin_amdgcn_s_getreg((3 << 11) | 20) & 0xFu; }
#define XB_SPIN(cond, bar) do { unsigned _sp = 0; while (cond) { __builtin_amdgcn_s_sleep(1); \
    if ((++_sp & 255u) == 0u) { if (xb_ld(&(bar)[XB_TMO])) break; if (_sp > XB_SPIN_CAP) { atomicAdd(&(bar)[XB_TMO], 1u); break; } } } } while (0)
struct XcdBarrier { unsigned* bar; unsigned x; volatile LAS unsigned* st; };
__device__ __forceinline__ XcdBarrier xcd_barrier_post(unsigned* bar, volatile LAS unsigned* st, bool leader) {
    XcdBarrier b; b.bar = bar; b.x = xb_xcc_id(); b.st = st;
    if (leader) (void)xb_add(&bar[XB_XCNT(b.x)], 1u);
    return b;
}
__device__ __forceinline__ void xcd_barrier_complete(unsigned* bar, unsigned x, unsigned& nloc, unsigned& nx) {
    const unsigned G = gridDim.x * gridDim.y * gridDim.z;
    unsigned sum, cnt, mine, sp = 0u;
    for (;;) {
        sum = 0u; cnt = 0u; mine = 0u;
#pragma unroll
        for (unsigned j = 0; j < 16; ++j) { const unsigned c = xb_ld(&bar[XB_XCNT(j)]); sum += c; cnt += (c > 0u) ? 1u : 0u; mine = (j == x) ? c : mine; }
        if (sum == G) break;
        __builtin_amdgcn_s_sleep(1);
        if ((++sp & 255u) == 0u) { if (xb_ld(&bar[XB_TMO])) break; if (sp > XB_SPIN_CAP) { atomicAdd(&bar[XB_TMO], 1u); break; } }
    }
    nloc = mine > 0u ? mine : 1u; nx = cnt > 0u ? cnt : 1u;
}
__device__ __forceinline__ void xcd_barrier(const XcdBarrier& b, int wave) {
    asm volatile("s_waitcnt vmcnt(0)" ::: "memory");
    __syncthreads();
    if (wave == 0 && fresh_lane() == 0) {
        unsigned* bar = b.bar;
        __builtin_amdgcn_s_waitcnt(0);
        unsigned nloc = b.st[0], nx = b.st[1];
        if (nloc == 0u) { xcd_barrier_complete(bar, b.x, nloc, nx); b.st[0] = nloc; b.st[1] = nx; }
        const unsigned old = xb_add(&bar[XB_XSUB(b.x)], 1u);
        const unsigned gen = old / nloc;
        if (old + 1u == (gen + 1u) * nloc) {
            __builtin_amdgcn_fence(__ATOMIC_RELEASE, "agent");
            asm volatile("s_waitcnt vmcnt(0)" ::: "memory");
            const unsigned og = xb_add(&bar[XB_TOP], 1u);
            const unsigned tg = og / nx;
            if (og + 1u == (tg + 1u) * nx) xb_add(&bar[XB_TOPGEN], 1u);
            else XB_SPIN(xb_ld(&bar[XB_TOPGEN]) == tg, bar);
            __builtin_amdgcn_fence(__ATOMIC_ACQUIRE, "agent");
            xb_add(&bar[XB_XGEN(b.x)], 1u);
            asm volatile("s_waitcnt vmcnt(0)" ::: "memory");
        } else {
            XB_SPIN(xb_ld(&bar[XB_XGEN(b.x)]) == gen, bar);
            __builtin_amdgcn_fence(__ATOMIC_ACQUIRE, "agent");
            asm volatile("s_waitcnt vmcnt(0)" ::: "memory");
        }
    }
    __syncthreads();
}

struct Args {
    const float *x, *c, *ctx, *c_ctx, *w_mod, *b_mod, *norm_mix_g, *norm_ffn_g, *w_in, *w_four, *q_norm_g, *k_norm_g, *w_out, *w_router, *w_gate, *w_up, *w_down, *final_norm_g;
    float* out; unsigned char* ws;
};

template <int CTRL> __device__ __forceinline__ float dppf(float v) { return __builtin_bit_cast(float, __builtin_amdgcn_update_dpp(0, __builtin_bit_cast(int, v), CTRL, 0xF, 0xF, true)); }
constexpr int DPP_X1 = 0xB1, DPP_X2 = 0x4E, DPP_HMIR = 0x141, DPP_MIR = 0x140;
__device__ __forceinline__ float xsum16(float a, float b) { auto rr = __builtin_amdgcn_permlane16_swap(__float_as_uint(a), __float_as_uint(b), false, false); return __uint_as_float(rr[0]) + __uint_as_float(rr[1]); }
__device__ __forceinline__ float xsum32(float a, float b) { auto rr = __builtin_amdgcn_permlane32_swap(__float_as_uint(a), __float_as_uint(b), false, false); return __uint_as_float(rr[0]) + __uint_as_float(rr[1]); }
__device__ __forceinline__ float xmax16(float a) { auto rr = __builtin_amdgcn_permlane16_swap(__float_as_uint(a), __float_as_uint(a), false, false); return fmaxf(__uint_as_float(rr[0]), __uint_as_float(rr[1])); }
__device__ __forceinline__ float xmax32(float a) { auto rr = __builtin_amdgcn_permlane32_swap(__float_as_uint(a), __float_as_uint(a), false, false); return fmaxf(__uint_as_float(rr[0]), __uint_as_float(rr[1])); }
__device__ __forceinline__ float wave_sum(float v) {
    v += dppf<DPP_X1>(v); v += dppf<DPP_X2>(v); v += dppf<DPP_HMIR>(v); v += dppf<DPP_MIR>(v); v = xsum16(v, v); v = xsum32(v, v);
    return v;
}

template <int CTRL> __device__ __forceinline__ unsigned dppu(unsigned v) { return (unsigned)__builtin_amdgcn_update_dpp(0, (int)v, CTRL, 0xF, 0xF, true); }
__device__ __forceinline__ unsigned wave_sum_u(unsigned v) {
    v += dppu<DPP_X1>(v); v += dppu<DPP_X2>(v); v += dppu<DPP_HMIR>(v); v += dppu<DPP_MIR>(v);
    { auto rr = __builtin_amdgcn_permlane16_swap(v, v, false, false); v = rr[0] + rr[1]; }
    { auto rr = __builtin_amdgcn_permlane32_swap(v, v, false, false); v = rr[0] + rr[1]; }
    return v;
}
template <class RowMap>
__device__ __forceinline__ void tr_item(const float* __restrict__ W, int ldw, int k0, int n0, bf16* WT, int ldt, int kdst0, const RowMap& drow, LAS float* scr, int lane) {
    const int kq = lane >> 4, nq = lane & 15;
    f32x4 v[16];
#pragma unroll
    for (int it = 0; it < 16; ++it) v[it] = *(const f32x4*)(W + (size_t)(k0 + 4 * it + kq) * ldw + n0 + 4 * nq);
#pragma unroll
    for (int it = 0; it < 16; ++it) { LAS float* s = scr + (4 * it + kq) * 65 + 4 * nq; s[0] = v[it][0]; s[1] = v[it][1]; s[2] = v[it][2]; s[3] = v[it][3]; }
    LDS_WAIT(); asm volatile("" ::: "memory");
    const int c = lane >> 3, nn = lane & 7;
#pragma unroll
    for (int j = 0; j < 8; ++j) { const int n = nn + 8 * j; const LAS float* s = scr + (8 * c) * 65 + n;
        v4u o; o.x = pk2(s[0 * 65], s[1 * 65]); o.y = pk2(s[2 * 65], s[3 * 65]); o.z = pk2(s[4 * 65], s[5 * 65]); o.w = pk2(s[6 * 65], s[7 * 65]);
        *(GAS v4u*)(WT + (size_t)drow(n0 + n) * ldt + kdst0 + k0 + 8 * c) = o; }
    LDS_WAIT(); asm volatile("" ::: "memory");
}
struct RowId { int base; __device__ __forceinline__ int operator()(int n) const { return base + n; } };
struct RowQKV { __device__ __forceinline__ int operator()(int n) const { const int t = n >> 8, w = n & 255, hd = w >> 6, d = w & 63; return 256 + 256 * t + 128 * (d >> 5) + 32 * hd + (d & 31); } };
struct RowGU { int base, up; __device__ __forceinline__ int operator()(int f) const { return base + 256 * (f >> 7) + 128 * up + (f & 127); } };


constexpr int MOE_ITEMS = 3 * 8192;
struct TrDesc { const float* src; bf16* dst; int ldw, ldt, f8; };
__device__ __forceinline__ TrDesc moe_desc(const Args& a, int r) {
    TrDesc d;
    if (r < 16384) { const int up = r >> 13, rr = r & 8191, e = rr >> 9, q = rr & 511, kb = q >> 5, nb = q & 31;
        d.src = (up ? a.w_up : a.w_gate) + (size_t)e * DM * DE + (size_t)(kb * 64) * DE + nb * 64; d.ldw = DE;
        d.dst = (bf16*)((unsigned char*)(a.ws + WS_WGU) + ((size_t)e * 4096 + 256 * (nb >> 1) + 128 * up + 64 * (nb & 1)) * DM + kb * 64); d.ldt = DM; d.f8 = 1; }
    else { const int rr = r - 16384, e = rr >> 9, q = rr & 511, kb = q >> 4, nb = q & 15;
        d.src = a.w_down + (size_t)e * DE * DM + (size_t)(kb * 64) * DM + nb * 64; d.ldw = DM;
        d.dst = (bf16*)((unsigned char*)(a.ws + WS_WD) + ((size_t)e * DM + nb * 64) * DE + kb * 64); d.ldt = DE; d.f8 = 1; }
    return d;
}
#define TR_LOAD(v, d) do { _Pragma("unroll") for (int _it = 0; _it < 16; ++_it) v[_it] = __builtin_nontemporal_load((const f32x4*)((d).src + (size_t)(4 * _it + kq) * (d).ldw + 4 * nq)); } while (0)
#define TR_PROC(v, d) do { \
    _Pragma("unroll") for (int _it = 0; _it < 16; ++_it) { LAS float* s_ = scr + (4 * _it + kq) * 65 + 4 * nq; s_[0] = v[_it][0]; s_[1] = v[_it][1]; s_[2] = v[_it][2]; s_[3] = v[_it][3]; } \
    LDS_WAIT(); asm volatile("" ::: "memory"); \
    if ((d).f8) { _Pragma("unroll") for (int _j = 0; _j < 8; ++_j) { const int n_ = nn + 8 * _j; const LAS float* s_ = scr + (8 * c8) * 65 + n_; \
        v2u o_; o_.x = pk4_fp8(s_[0 * 65] * 32.f, s_[1 * 65] * 32.f, s_[2 * 65] * 32.f, s_[3 * 65] * 32.f); o_.y = pk4_fp8(s_[4 * 65] * 32.f, s_[5 * 65] * 32.f, s_[6 * 65] * 32.f, s_[7 * 65] * 32.f); \
        __builtin_nontemporal_store(o_, (GAS v2u*)((unsigned char*)(d).dst + (size_t)n_ * (d).ldt + 8 * c8)); } } \
    else { _Pragma("unroll") for (int _j = 0; _j < 8; ++_j) { const int n_ = nn + 8 * _j; const LAS float* s_ = scr + (8 * c8) * 65 + n_; \
        v4u o_; o_.x = pk2(s_[0 * 65], s_[1 * 65]); o_.y = pk2(s_[2 * 65], s_[3 * 65]); o_.z = pk2(s_[4 * 65], s_[5 * 65]); o_.w = pk2(s_[6 * 65], s_[7 * 65]); \
        *(GAS v4u*)((d).dst + (size_t)n_ * (d).ldt + 8 * c8) = o_; } } \
    LDS_WAIT(); asm volatile("" ::: "memory"); } while (0)
__device__ __forceinline__ void moe_convert(const Args& a, LAS float* scr, int lo, int hi, int w, int nw) {
    const int lane = fresh_lane(), kq = lane >> 4, nq = lane & 15, c8 = lane >> 3, nn = lane & 7;
    int it = lo + w; if (it >= hi) return;
    f32x4 va[16], vb[16];
    TrDesc da = moe_desc(a, it), db = da; TR_LOAD(va, da);
    for (;;) {
        int nx = it + nw; bool hn = nx < hi;
        if (hn) { db = moe_desc(a, nx); TR_LOAD(vb, db); }
        TR_PROC(va, da);
        if (!hn) break;
        it = nx; nx = it + nw; hn = nx < hi;
        if (hn) { da = moe_desc(a, nx); TR_LOAD(va, da); }
        TR_PROC(vb, db);
        if (!hn) break;
        it = nx;
    }
}
struct ConvW { const Args* a; int next, end, stride; int cr; TrDesc cd;
    __device__ __forceinline__ bool dry() const { return next >= end; }
    __device__ __forceinline__ void get(attn_body::ConvSub& c) {
        if (next >= end) { c.on = 0; return; }
        const int sg = next; next += stride;
        const int r = sg >> 3, kb4 = (sg >> 1) & 3, nb2 = sg & 1;
        if (r != cr) { cd = moe_desc(*a, r); cr = r; }
        c.ldw = cd.ldw; c.ldt = cd.ldt; c.src = cd.src + (size_t)(16 * kb4) * cd.ldw + 32 * nb2; c.dst = (unsigned char*)cd.dst + (size_t)(32 * nb2) * cd.ldt + 16 * kb4; c.on = 1; } };
#ifndef MOE_S0
#define MOE_S0 0
#endif
#ifndef MOE_S1
#define MOE_S1 4096
#endif
#ifndef MOE_S2
#define MOE_S2 0
#endif
#ifndef MOE_S3
#define MOE_S3 6400
#endif
constexpr int MOE_B0 = MOE_S0, MOE_B1 = MOE_B0 + MOE_S1, MOE_B2 = MOE_B1 + MOE_S2, MOE_B3 = MOE_B2 + MOE_S3;

__host__ __device__ __forceinline__ int four_pos(int mp) { return mp == 0 ? 0 : (mp == 32 ? 1 : (mp < 32 ? 2 * mp : 2 * (64 - mp) + 1)); }

__device__ __forceinline__ void p0_prologue(const Args& a, LAS unsigned char* lds, int vcu, int G, int wave) {
    const int lane = fresh_lane(), tid = wave * 64 + lane;
    unsigned char* ws = a.ws;
    bf16* WinT = (bf16*)(ws + WS_WIN); bf16* WoT = (bf16*)(ws + WS_WOUT);
    float* MOD = (float*)(ws + WS_MOD);
    for (int item = vcu; item < 256; item += G) {
        LAS float* red = (LAS float*)lds;
        f32x4 a0 = {0.f, 0.f, 0.f, 0.f}, a1 = {0.f, 0.f, 0.f, 0.f};
        if (lane < 60) {
            const int rr = lane / 6, cq = lane % 6, col = item * 24 + 4 * cq;
#pragma unroll
            for (int it = 0; it < 13; ++it) { const int k = wave * 128 + it * 10 + rr;
                if (it * 10 + rr < 128) { const f32x4 w = *(const f32x4*)(a.w_mod + (size_t)k * (NMOD * DM) + col); const float c0 = a.c[k], c1 = a.c_ctx[k];
                    const float s0 = c0 / (1.f + __expf(-c0)), s1 = c1 / (1.f + __expf(-c1)); a0 += w * s0; a1 += w * s1; } }
        }
        *(LAS f32x4*)(red + ((wave * 2 + 0) * 64 + lane) * 4) = a0; *(LAS f32x4*)(red + ((wave * 2 + 1) * 64 + lane) * 4) = a1;
        __syncthreads();
        if (tid < 48) { const int v = tid / 24, cc = tid % 24, cq = cc >> 2, e = cc & 3; float sum = 0.f;
            for (int w = 0; w < 8; ++w)
#pragma unroll
                for (int r = 0; r < 10; ++r) sum += red[((w * 2 + v) * 64 + r * 6 + cq) * 4 + e];
            MOD[v * (NMOD * DM) + item * 24 + cc] = sum + a.b_mod[item * 24 + cc]; }
        __syncthreads();
    }
    const int cg = -1;
    LAS float* scr = (LAS float*)(lds + wave * 16640);
    constexpr int I_F1 = 256, I_F2 = 256, I_IN = 16 * 20, I_OUT = 12 * 16;
    constexpr int NITEMS = I_F1 + I_F2 + I_IN + I_OUT;
    for (int it = wave * G + vcu; it < NITEMS; it += NWAVES * G) {
        int r = it;
        if (r < I_F1) {
            const int g = r & 3, kb = (r >> 2) & 15, jq = r >> 6, k = kb * 64 + lane;
            LAS float* ct = scr;
            ct[lane] = cospif((float)lane * (1.f / 32.f)); LDS_WAIT(); asm volatile("" ::: "memory");
            float w[64];
#pragma unroll
            for (int c4 = 0; c4 < 16; ++c4) { const f32x4 t = *(const f32x4*)(a.w_in + (size_t)k * INW + 64 * g + 4 * c4); w[4 * c4] = t[0]; w[4 * c4 + 1] = t[1]; w[4 * c4 + 2] = t[2]; w[4 * c4 + 3] = t[3]; }
            for (int j = 16 * jq; j < 16 * jq + 16; ++j) { const int m = j <= 32 ? j : j - 32; const int ph = j <= 32 ? 0 : 48;
                float s = 0.f;
#pragma unroll
                for (int c = 0; c < 64; ++c) s += w[c] * ct[(c * m + ph) & 63];
                WinT[(size_t)(64 * g + j) * DM + k] = (bf16)f2bf(s * (1.f / 1024.f)); }
            LDS_WAIT(); asm volatile("" ::: "memory");
            continue; }
        r -= I_F1;
        if (r < I_F2) {
            const int g = r & 3, jb = (r >> 2) & 15, mq = r >> 6, j = jb * 64 + lane;
            float w[64];
#pragma unroll
            for (int d = 0; d < 64; ++d) w[d] = a.w_out[(size_t)(64 * g + d) * DM + j];
            for (int mp = 16 * mq; mp < 16 * mq + 16; ++mp) { float s = 0.f; const float* wf = a.w_four + (size_t)(g * 64 + mp) * 64;
#pragma unroll
                for (int d = 0; d < 64; ++d) s += wf[d] * w[d];
                WoT[(size_t)j * DM + 64 * g + four_pos(mp)] = (bf16)f2bf(s); }
            continue; }
        r -= I_F2;
        if (r < I_IN) { const int kb = r / 20, nb = r % 20; tr_item(a.w_in + 256, INW, kb * 64, nb * 64, WinT, DM, 0, RowQKV{}, scr, lane); continue; }
        r -= I_IN;
        { const int kb = r / 16, nb = r % 16; tr_item(a.w_out + (size_t)256 * DM, DM, kb * 64, nb * 64, WoT, DM, 256, RowId{0}, scr, lane); }
    }
    if (cg < 0 && MOE_S0 > 0) moe_convert(a, scr, 0, MOE_B0, ((wave + 4) & 7) * (G - 24) + vcu, NWAVES * (G - 24));
}

__device__ __forceinline__ void p0b_modulate(const Args& a, int vcu, int G, int wave) {
    const int lane = fresh_lane();
    unsigned char* ws = a.ws; const float* MOD = (const float*)(ws + WS_MOD); bf16* XN = (bf16*)(ws + WS_XN);
    const int gw = vcu * NWAVES + wave, NGW = G * NWAVES;
    for (int pass = 0; pass < 2; ++pass) {
        const float* md = MOD + pass * (NMOD * DM);
        const int nrows = pass == 0 ? NTOK : NCTX; const float* src = pass == 0 ? a.x : a.ctx; bf16* dst = XN + (size_t)(pass == 0 ? 0 : NTOK) * DM;
        if (gw >= nrows) continue;
        f32x4 av[4], sh[4];
#pragma unroll
        for (int j = 0; j < 4; ++j) { const int col = 4 * lane + 256 * j; const f32x4 g = *(const f32x4*)(a.norm_mix_g + col); const f32x4 sc = *(const f32x4*)(md + DM + col); av[j] = g * (sc + 1.f); sh[j] = *(const f32x4*)(md + col); }
        f32x4 v[4], vn[4];
        { const GAS f32x4* xr = (const GAS f32x4*)(src + (size_t)gw * DM) + lane;
#pragma unroll
          for (int j = 0; j < 4; ++j) v[j] = xr[64 * j]; }
        for (int m = gw; m < nrows; m += NGW) {
            const int mn = m + NGW;
            if (mn < nrows) { const GAS f32x4* xr = (const GAS f32x4*)(src + (size_t)mn * DM) + lane;
#pragma unroll
                for (int j = 0; j < 4; ++j) vn[j] = xr[64 * j]; }
            float s = 0.f;
#pragma unroll
            for (int j = 0; j < 4; ++j) s += (v[j].x * v[j].x + v[j].y * v[j].y) + (v[j].z * v[j].z + v[j].w * v[j].w);
            const float rinv = 1.f / sqrtf(wave_sum(s) * (1.f / DM) + EPS);
            GAS unsigned long long* o8 = (GAS unsigned long long*)(dst + (size_t)m * DM) + lane;
#pragma unroll
            for (int j = 0; j < 4; ++j) { const f32x4 y = v[j] * rinv * av[j] + sh[j]; o8[64 * j] = (unsigned long long)pk2(y.x, y.y) | ((unsigned long long)pk2(y.z, y.w) << 32); }
#pragma unroll
            for (int j = 0; j < 4; ++j) v[j] = vn[j];
        }
    }
}

struct P1Prob {
    static constexpr int K = DM; static constexpr bool PERM = false, FP8 = false; static constexpr int SCW = 0, SCA = 0;
    const bf16* XN; const bf16* WinT; bf16 *Q, *Kb, *Vb; float* FT; const float *qg, *kg; unsigned* kmax; pg8::StaticOrder so;
    __device__ __forceinline__ bool next(int i, pg8::Unit& u) const { return so.next(i, u); }
    __device__ __forceinline__ bool swapped(const pg8::Unit& u) const { return u.pn == 0 || (ATTN_F8 && u.pn == 5); }
    __device__ __forceinline__ const char* aptr(const pg8::Unit& u) const { return swapped(u) ? (const char*)(WinT + (size_t)u.pn * 256 * DM) : (const char*)(XN + (size_t)u.pm * 256 * DM); }
    __device__ __forceinline__ const char* bptr(const pg8::Unit& u) const { return swapped(u) ? (const char*)(XN + (size_t)u.pm * 256 * DM) : (const char*)(WinT + (size_t)u.pn * 256 * DM); }
    __device__ __forceinline__ void epi(const pg8::f32x4 (&acc)[2][2][4][2], const pg8::Unit& u, int wr, int wc, int fr, int fq) const {
        if (u.pn == 0) {
            if (u.pm >= NTOK / 256) return;
#pragma unroll
            for (int ai = 0; ai < 2; ++ai)
#pragma unroll
                for (int m = 0; m < 4; ++m) { float* rowp = FT + (size_t)(ai * 128 + wr * 64 + m * 16 + fr) * NTOK + u.pm * 256 + wc * 32 + 4 * fq;
#pragma unroll
                    for (int bj = 0; bj < 2; ++bj)
#pragma unroll
                        for (int n = 0; n < 2; ++n) *(pg8::f32x4*)(rowp + bj * 128 + n * 16) = acc[ai][bj][m][n]; }
            return;
        }
        const bool isq = u.pn <= 3, isv = u.pn == 5, lat = u.pm < NTOK / 256;
        if (isq && !lat) return;
        if (isv) {
#if ATTN_F8
            unsigned char* V8 = (unsigned char*)Vb;
#pragma unroll
            for (int ai = 0; ai < 2; ++ai)
#pragma unroll
                for (int m = 0; m < 4; ++m) { const int kvh_ = 2 * wr + (m >> 1), d = 32 * ai + 16 * (m & 1) + fr;
#pragma unroll
                    for (int bj = 0; bj < 2; ++bj)
#pragma unroll
                        for (int n = 0; n < 2; ++n) { const int t0 = u.pm * 256 + 128 * bj + 32 * wc + 16 * n + 4 * fq, key0 = t0 & 63, tile = t0 >> 6, k5 = key0 & 31, hk = (k5 >> 2) & 1, j0 = 4 * (k5 >> 3) + 16 * (key0 >> 5);
                            const pg8::f32x4 v = acc[ai][bj][m][n];
                            *(unsigned*)(V8 + (size_t)(kvh_ * (NKEYS / 64) + tile) * 4096 + (j0 >> 4) * 2048 + d * 32 + 16 * (hk ^ ((d >> 3) & 1)) + (j0 & 15)) = pk4_fp8(v[0], v[1], v[2], v[3]); } }
#else
#pragma unroll
            for (int ai = 0; ai < 2; ++ai)
#pragma unroll
                for (int m = 0; m < 4; ++m) { const int t = u.pm * 256 + ai * 128 + wr * 64 + m * 16 + fr; bf16* rowp = Vb + (size_t)t * 256 + wc * 64 + 4 * fq;
#pragma unroll
                    for (int bj = 0; bj < 2; ++bj)
#pragma unroll
                        for (int n = 0; n < 2; ++n) { const pg8::f32x4 v = acc[ai][bj][m][n]; *(v2u*)(rowp + 32 * bj + 16 * n) = (v2u){pk2(v[0], v[1]), pk2(v[2], v[3])}; } }
#endif
            return;
        }
        const float* gw = isq ? qg : kg;
        pg8::f32x4 gv[2][2];
#pragma unroll
        for (int bj = 0; bj < 2; ++bj)
#pragma unroll
            for (int n = 0; n < 2; ++n) gv[bj][n] = *(const pg8::f32x4*)(gw + 32 * bj + 16 * n + 4 * fq);
        float frq[4];
#pragma unroll
        for (int e = 0; e < 4; ++e) frq[e] = exp2f(-(float)(4 * fq + e) * (13.287712379549449f / 16.f)) * 0.15915494309189535f;
        const float qs = isq ? attn_body::C2 * (ATTN_F8 ? 16.f : 1.f) : 1.f;
#if ATTN_F8
        bf16* base = (bf16*)((unsigned char*)(isq ? Q : Kb) + (size_t)(isq ? (u.pn - 1) * 4 + wc : wc) * 64); const int pitch = isq ? 768 : 256;
#else
        bf16* base = isq ? Q + (size_t)((u.pn - 1) * 4 + wc) * 64 : Kb + (size_t)wc * 64; const int pitch = isq ? 768 : 256;
#endif
        float k2max = 0.f;
#pragma unroll
        for (int ai = 0; ai < 2; ++ai) {
            float rowpos = (float)(u.pm * 4 + ai * 2 + wr); asm volatile("" : "+v"(rowpos));
            float cr[4], sr[4];
#pragma unroll
            for (int e = 0; e < 4; ++e) { const float rev = rowpos * frq[e], f_ = rev - floorf(rev); cr[e] = __builtin_amdgcn_cosf(f_); sr[e] = __builtin_amdgcn_sinf(f_); }
#pragma unroll
            for (int m = 0; m < 4; ++m) {
                float colpos = (float)(m * 16 + fr); asm volatile("" : "+v"(colpos));
                const int t = u.pm * 256 + ai * 128 + wr * 64 + m * 16 + fr;
                float ss = 0.f;
#pragma unroll
                for (int bj = 0; bj < 2; ++bj)
#pragma unroll
                    for (int n = 0; n < 2; ++n) { const pg8::f32x4 v = acc[ai][bj][m][n]; ss += (v[0] * v[0] + v[1] * v[1]) + (v[2] * v[2] + v[3] * v[3]); }
                ss += __shfl_xor(ss, 16); ss += __shfl_xor(ss, 32);
                const float rinv = qs / sqrtf(ss * (1.f / 64.f) + EPS);
                pg8::f32x4 y[2][2];
#pragma unroll
                for (int bj = 0; bj < 2; ++bj)
#pragma unroll
                    for (int n = 0; n < 2; ++n) y[bj][n] = acc[ai][bj][m][n] * rinv * gv[bj][n];
                if (lat) {
#pragma unroll
                    for (int e = 0; e < 4; ++e) {
                        { const float x1 = y[0][0][e], x2 = y[0][1][e]; y[0][0][e] = x1 * cr[e] - x2 * sr[e]; y[0][1][e] = x1 * sr[e] + x2 * cr[e]; }
                        { const float rev = colpos * frq[e], f_ = rev - floorf(rev); const float cc = __builtin_amdgcn_cosf(f_), sc = __builtin_amdgcn_sinf(f_);
                          const float x1 = y[1][0][e], x2 = y[1][1][e]; y[1][0][e] = x1 * cc - x2 * sc; y[1][1][e] = x1 * sc + x2 * cc; }
                    }
                }
                ss = 0.f;
#if ATTN_F8
                unsigned char* rowp8 = (unsigned char*)base + ((size_t)t * pitch + 4 * fq);
#pragma unroll
                for (int bj = 0; bj < 2; ++bj)
#pragma unroll
                    for (int n = 0; n < 2; ++n) { const pg8::f32x4 v = y[bj][n]; const unsigned w = pk4_fp8(v[0], v[1], v[2], v[3]); *(unsigned*)(rowp8 + 32 * bj + 16 * n) = w;
                        if (!isq) { const float b0 = __builtin_amdgcn_cvt_f32_fp8((int)w, 0), b1 = __builtin_amdgcn_cvt_f32_fp8((int)w, 1), b2 = __builtin_amdgcn_cvt_f32_fp8((int)w, 2), b3 = __builtin_amdgcn_cvt_f32_fp8((int)w, 3); ss += (b0 * b0 + b1 * b1) + (b2 * b2 + b3 * b3); } }
#else
                bf16* rowp = base + (size_t)t * pitch + 4 * fq;
#pragma unroll
                for (int bj = 0; bj < 2; ++bj)
#pragma unroll
                    for (int n = 0; n < 2; ++n) { const pg8::f32x4 v = y[bj][n]; const v2u w = (v2u){pk2(v[0], v[1]), pk2(v[2], v[3])}; *(v2u*)(rowp + 32 * bj + 16 * n) = w;
                        if (!isq) { const float b0 = __uint_as_float(w.x << 16), b1 = __uint_as_float(w.x & 0xffff0000u), b2 = __uint_as_float(w.y << 16), b3 = __uint_as_float(w.y & 0xffff0000u); ss += (b0 * b0 + b1 * b1) + (b2 * b2 + b3 * b3); } }
#endif
                if (!isq) { float r2 = ss; r2 += __shfl_xor(r2, 16); r2 += __shfl_xor(r2, 32); k2max = fmaxf(k2max, r2); }
                asm volatile("" ::: "memory");
            }
        }
        if (!isq) {
#pragma unroll
            for (int o = 1; o < 16; o <<= 1) k2max = fmaxf(k2max, __shfl_xor(k2max, o));
            if (fr == 0 && fq == 0) __hip_atomic_fetch_max(kmax, __float_as_uint(k2max), __ATOMIC_RELAXED, __HIP_MEMORY_SCOPE_AGENT);
        }
    }
};

__device__ __forceinline__ unsigned rev4_12(unsigned k) { unsigned r = __brev(k) >> 20; return ((r & 0xAAAu) >> 1) | ((r & 0x555u) << 1); }
__device__ __forceinline__ void fft_block(const Args& a, LAS unsigned char* lds, int item, int wave) {
    const int tid = wave * 64 + fresh_lane();
    const int mm = item & 31, par = (item >> 5) & 1, g = item >> 6;
    const float* FT = (const float*)(a.ws + WS_FT); bf16* MIX = (bf16*)(a.ws + WS_MIX);
    LAS f32x2* X = (LAS f32x2*)lds;
    const float* re = FT + (size_t)(64 * g + mm) * NTOK; const float* im = FT + (size_t)(64 * g + 32 + mm) * NTOK;
#pragma unroll 1
    for (int i = 0; i < 2; ++i) {
        const int j0 = 4 * (tid + NTHR * i);
        f32x4 r4[4], i4[4];
#pragma unroll
        for (int q = 0; q < 4; ++q) { r4[q] = *(const f32x4*)(re + j0 + 4096 * q); i4[q] = *(const f32x4*)(im + j0 + 4096 * q); }
#pragma unroll
        for (int e = 0; e < 4; ++e) {
            const int j = j0 + e;
            const f32x2 a0 = {r4[0][e], i4[0][e]}, a1 = {r4[1][e], i4[1][e]}, a2 = {r4[2][e], i4[2][e]}, a3 = {r4[3][e], i4[3][e]};
            f32x2 ya, yb; float fa, fb;
            if (par == 0) { const f32x2 s02 = a0 + a2, s13 = a1 + a3; ya = s02 + s13; yb = s02 - s13; fa = 0.f; fb = (float)(2 * j) * (1.f / 16384.f); }
            else { const f32x2 d02 = a0 - a2, d13 = a1 - a3; ya = (f32x2){d02.x + d13.y, d02.y - d13.x}; yb = (f32x2){d02.x - d13.y, d02.y + d13.x}; fa = (float)j * (1.f / 16384.f); fb = (float)(3 * j) * (1.f / 16384.f); }
            const float ca = __builtin_amdgcn_cosf(fa), sa = __builtin_amdgcn_sinf(fa), cb = __builtin_amdgcn_cosf(fb), sb = __builtin_amdgcn_sinf(fb);
            X[j] = (f32x2){ya.x * ca + ya.y * sa, ya.y * ca - ya.x * sa};
            X[4096 + j] = (f32x2){yb.x * cb + yb.y * sb, yb.y * cb - yb.x * sb};
        }
    }
    __syncthreads();
#pragma unroll 1
    for (int s = 0; s < 6; ++s) {
        const int lq = 10 - 2 * s;
        const int Lq = 1 << lq;
        const float invL = 1.f / (float)(4 << lq);
#pragma unroll 2
        for (int i = 0; i < 4; ++i) {
            const int b = tid + NTHR * i, j = b & (Lq - 1), base = ((b >> lq) << (lq + 2)) + j;
            const f32x2 a0 = X[base], a1 = X[base + Lq], a2 = X[base + 2 * Lq], a3 = X[base + 3 * Lq];
            const f32x2 s02 = a0 + a2, d02 = a0 - a2, s13 = a1 + a3, d13 = a1 - a3;
            const f32x2 y0 = s02 + s13, y2 = s02 - s13;
            const f32x2 y1 = (f32x2){d02.x + d13.y, d02.y - d13.x};
            const f32x2 y3 = (f32x2){d02.x - d13.y, d02.y + d13.x};
            const float f1 = (float)j * invL;
            const float c1 = __builtin_amdgcn_cosf(f1), s1 = __builtin_amdgcn_sinf(f1);
            const float c2 = __builtin_amdgcn_cosf(2.f * f1), s2 = __builtin_amdgcn_sinf(2.f * f1);
            const float c3 = __builtin_amdgcn_cosf(3.f * f1), s3 = __builtin_amdgcn_sinf(3.f * f1);
            X[base] = y0;
            X[base + Lq] = (f32x2){y1.x * c1 + y1.y * s1, y1.y * c1 - y1.x * s1};
            X[base + 2 * Lq] = (f32x2){y2.x * c2 + y2.y * s2, y2.y * c2 - y2.x * s2};
            X[base + 3 * Lq] = (f32x2){y3.x * c3 + y3.y * s3, y3.y * c3 - y3.x * s3};
        }
        __syncthreads();
    }
    const int col = 64 * g + 2 * mm;
#pragma unroll 1
    for (int i = 0; i < 16; ++i) {
        const int k = 2 * (tid + NTHR * i) + par, kn = (NTOK - k) & (NTOK - 1);
        const f32x2 wk = X[(((k & 3) - par) >> 1) * 4096 + rev4_12((unsigned)(k >> 2))], wn = X[(((kn & 3) - par) >> 1) * 4096 + rev4_12((unsigned)(kn >> 2))];
        float o0, o1;
        if (mm == 0) { o0 = 0.5f * (wk.x + wn.x); o1 = 0.5f * (wk.y + wn.y); }
        else { o0 = wn.x; o1 = wk.x; }
        *(unsigned*)(MIX + (size_t)k * DM + col) = pk2(o0, o1);
    }
    __syncthreads();
}

struct P3Prob {
    static constexpr int K = DM; static constexpr bool PERM = false, FP8 = false; static constexpr int SCW = 0, SCA = 0;
    const bf16* MIX; const bf16* WoT; const float* x; const float* g1; float* X1; pg8::StaticOrder so;
    __device__ __forceinline__ bool next(int i, pg8::Unit& u) const { return so.next(i, u); }
    __device__ __forceinline__ const char* aptr(const pg8::Unit& u) const { return (const char*)(MIX + (size_t)u.pm * 256 * DM); }
    __device__ __forceinline__ const char* bptr(const pg8::Unit& u) const { return (const char*)(WoT + (size_t)u.pn * 256 * DM); }
    __device__ __forceinline__ void epi(const pg8::f32x4 (&acc)[2][2][4][2], const pg8::Unit& u, int wr, int wc, int fr, int fq) const {
        const int col0 = u.pn * 256 + wc * 32 + 4 * fq;
        pg8::f32x4 gv[2][2];
#pragma unroll
        for (int bj = 0; bj < 2; ++bj)
#pragma unroll
            for (int n = 0; n < 2; ++n) gv[bj][n] = *(const pg8::f32x4*)(g1 + col0 + bj * 128 + n * 16);
#pragma unroll
        for (int ai = 0; ai < 2; ++ai)
#pragma unroll
            for (int m = 0; m < 4; ++m) { const size_t off = (size_t)(u.pm * 256 + ai * 128 + wr * 64 + m * 16 + fr) * DM + col0;
#pragma unroll
                for (int bj = 0; bj < 2; ++bj)
#pragma unroll
                    for (int n = 0; n < 2; ++n) { const pg8::f32x4 bs = *(const pg8::f32x4*)(x + off + bj * 128 + n * 16); *(pg8::f32x4*)(X1 + off + bj * 128 + n * 16) = bs + gv[bj][n] * acc[ai][bj][m][n]; }
                if (m & 1) asm volatile("" ::: "memory"); }
    }
};

__device__ __forceinline__ void p3b_router(const Args& a, LAS unsigned char* lds, int vcu, int G, int wave) {
    const int lane = fresh_lane(), tid = wave * 64 + lane;
    unsigned char* ws = a.ws; const float* MOD = (const float*)(ws + WS_MOD); const float* X1 = (const float*)(ws + WS_X1); bf16* H2 = (bf16*)(ws + WS_H2); float* AFF = (float*)(ws + WS_AFF);
    LAS float* wrt = (LAS float*)lds;
    { f32x4 t[8];
#pragma unroll
      for (int q = 0; q < 8; ++q) t[q] = *(const f32x4*)(a.w_router + 4 * (tid + NTHR * q));
#pragma unroll
      for (int q = 0; q < 8; ++q) { const int i = 4 * (tid + NTHR * q), col = i >> 4, e = i & 15;
#pragma unroll
          for (int k = 0; k < 4; ++k) wrt[(e + k) * 1024 + col] = t[q][k]; } }
    __syncthreads();
    f32x4 av[4], sh[4];
#pragma unroll
    for (int j = 0; j < 4; ++j) { const int col = 4 * lane + 256 * j; const f32x4 g = *(const f32x4*)(a.norm_ffn_g + col); const f32x4 sc = *(const f32x4*)(MOD + 4 * DM + col); av[j] = g * (sc + 1.f); sh[j] = *(const f32x4*)(MOD + 3 * DM + col); }
    constexpr int R3B = 2;
    const int gw = vcu * NWAVES + wave, NGW = G * NWAVES;
    f32x4 vn[R3B][4];
    if (R3B * gw < NTOK) {
#pragma unroll
        for (int r = 0; r < R3B; ++r) { const GAS f32x4* xr = (const GAS f32x4*)(X1 + (size_t)(R3B * gw + r) * DM) + lane;
#pragma unroll
            for (int j = 0; j < 4; ++j) vn[r][j] = xr[64 * j]; } }
#pragma unroll 1
    for (int m0 = R3B * gw; m0 < NTOK; m0 += R3B * NGW) {
        f32x4 v[R3B][4];
#pragma unroll
        for (int r = 0; r < R3B; ++r)
#pragma unroll
            for (int j = 0; j < 4; ++j) v[r][j] = vn[r][j];
        { const int mn = m0 + R3B * NGW;
          if (mn < NTOK) {
#pragma unroll
              for (int r = 0; r < R3B; ++r) { const GAS f32x4* xr = (const GAS f32x4*)(X1 + (size_t)(mn + r) * DM) + lane;
#pragma unroll
                  for (int j = 0; j < 4; ++j) vn[r][j] = xr[64 * j]; } } }
        float ss[R3B];
#pragma unroll
        for (int r = 0; r < R3B; ++r) { float t = 0.f;
#pragma unroll
            for (int j = 0; j < 4; ++j) t += (v[r][j].x * v[r][j].x + v[r][j].y * v[r][j].y) + (v[r][j].z * v[r][j].z + v[r][j].w * v[r][j].w);
            ss[r] = t; }
#pragma unroll
        for (int r = 0; r < R3B; ++r) ss[r] = wave_sum(ss[r]);
#pragma unroll
        for (int r = 0; r < R3B; ++r) { const float rinv = 1.f / sqrtf(ss[r] * (1.f / DM) + EPS);
            GAS unsigned* o4 = (GAS unsigned*)((unsigned char*)H2 + (size_t)(m0 + r) * DM) + lane;
#pragma unroll
            for (int j = 0; j < 4; ++j) { v[r][j] = v[r][j] * rinv * av[j] + sh[j]; o4[64 * j] = pk4_fp8(v[r][j].x, v[r][j].y, v[r][j].z, v[r][j].w); } }
        float lg[R3B][16];
#pragma unroll
        for (int e = 0; e < 16; ++e) { f32x4 w[4];
#pragma unroll
            for (int j = 0; j < 4; ++j) w[j] = *(const LAS f32x4*)(wrt + e * 1024 + 4 * lane + 256 * j);
#pragma unroll
            for (int r = 0; r < R3B; ++r) { float p0 = v[r][0].x * w[0].x, p1 = v[r][0].y * w[0].y;
                p0 = __builtin_fmaf(v[r][0].z, w[0].z, p0); p1 = __builtin_fmaf(v[r][0].w, w[0].w, p1);
#pragma unroll
                for (int j = 1; j < 4; ++j) { p0 = __builtin_fmaf(v[r][j].x, w[j].x, p0); p1 = __builtin_fmaf(v[r][j].y, w[j].y, p1); p0 = __builtin_fmaf(v[r][j].z, w[j].z, p0); p1 = __builtin_fmaf(v[r][j].w, w[j].w, p1); }
                lg[r][e] = p0 + p1; }
            if ((e & 3) == 3) asm volatile("" ::: "memory"); }
        float r1[R3B];
#pragma unroll
        for (int r = 0; r < R3B; ++r) {
            float r8[8], r4[4], r2[2];
#pragma unroll
            for (int e = 0; e < 8; ++e) r8[e] = xsum32(lg[r][e], lg[r][e + 8]);
#pragma unroll
            for (int e = 0; e < 4; ++e) r4[e] = xsum16(r8[e], r8[e + 4]);
            { const bool up = (lane & 8) != 0;
#pragma unroll
              for (int e = 0; e < 2; ++e) { const float snd = up ? r4[e] : r4[e + 2], kp = up ? r4[e + 2] : r4[e]; r2[e] = kp + dppf<DPP_MIR>(snd); } }
            { const bool up = (lane & 4) != 0; const float snd = up ? r2[0] : r2[1], kp = up ? r2[1] : r2[0]; r1[r] = kp + dppf<DPP_HMIR>(snd); }
        }
#pragma unroll
        for (int r = 0; r < R3B; ++r) r1[r] += dppf<DPP_X2>(r1[r]);
#pragma unroll
        for (int r = 0; r < R3B; ++r) r1[r] += dppf<DPP_X1>(r1[r]);
        float mx[R3B], ex[R3B], den[R3B];
#pragma unroll
        for (int r = 0; r < R3B; ++r) { float m = r1[r]; m = fmaxf(m, dppf<DPP_HMIR>(m)); m = fmaxf(m, dppf<DPP_MIR>(m)); m = xmax16(m); mx[r] = xmax32(m); }
#pragma unroll
        for (int r = 0; r < R3B; ++r) { ex[r] = __expf(r1[r] - mx[r]); float d = ex[r]; d += dppf<DPP_HMIR>(d); d += dppf<DPP_MIR>(d); d = xsum16(d, d); den[r] = xsum32(d, d); }
        float mine = ex[0] / den[0];
#pragma unroll
        for (int r = 1; r < R3B; ++r) mine = ((lane & 3) == r) ? ex[r] / den[r] : mine;
        if ((lane & 3) < R3B) AFF[(size_t)(lane >> 2) * NTOK + m0 + (lane & 3)] = mine;
    }
}

__device__ __forceinline__ void p4_topk(const Args& a, LAS unsigned char* lds, int e, int wave) {
    const int lane = fresh_lane(), tid = wave * 64 + lane;
    unsigned char* ws = a.ws; const unsigned* AFF = (const unsigned*)(ws + WS_AFF) + (size_t)e * NTOK;
    int* IDX = (int*)(ws + WS_IDX) + e * CAP; float* GATE = (float*)(ws + WS_GATE) + e * CAP; int* TOKSLOT = (int*)(ws + WS_TOKSLOT);
    LAS unsigned* wcnt = (LAS unsigned*)lds;
    LAS unsigned* cg = wcnt + 16;
    LAS unsigned* ce = cg + 256;
    unsigned key[32];
#pragma unroll
    for (int i = 0; i < 32; ++i) key[i] = AFF[i * NTHR + tid];
    unsigned T = 0u;
    constexpr int TOPK_SLOW = 12, TOPK_LOW = 30 - TOPK_SLOW, TOPK_UMAX = 2048;
    int bit = 30;
#pragma unroll 1
    for (; bit > TOPK_LOW; --bit) {
        const unsigned cand = T | (1u << bit);
        unsigned c = 0u;
#pragma unroll
        for (int i = 0; i < 32; ++i) c += (unsigned)__popcll(__ballot(key[i] >= cand));
        LAS unsigned* wb = wcnt + 1024 + (bit & 1) * 8;
        if (lane == 0) wb[wave] = c;
        __syncthreads();
        unsigned tot = 0u;
#pragma unroll
        for (int w = 0; w < 8; ++w) tot += wb[w];
        if (tot >= (unsigned)CAP) T = cand;
    }
    LAS unsigned* uc = wcnt + 1100;
    LAS unsigned* ulist = (LAS unsigned*)(lds + 8192);
    const unsigned tp = T >> (TOPK_LOW + 1);
    { unsigned nu = 0u, na = 0u;
#pragma unroll
      for (int i = 0; i < 32; ++i) { const unsigned kp = key[i] >> (TOPK_LOW + 1); nu += (unsigned)__popcll(__ballot(kp == tp)); na += (unsigned)__popcll(__ballot(kp > tp)); }
      if (lane == 0) { uc[wave] = nu; uc[8 + wave] = na; } }
    __syncthreads();
    unsigned nund = 0u, nabove = 0u, ubase = 0u;
#pragma unroll
    for (int w = 0; w < 8; ++w) { const unsigned cu = uc[w]; ubase += (w < wave) ? cu : 0u; nund += cu; nabove += uc[8 + w]; }
    if (nund <= (unsigned)TOPK_UMAX) {
        const unsigned long long below_ = (1ull << lane) - 1ull;
        unsigned run = ubase;
#pragma unroll
        for (int i = 0; i < 32; ++i) { const unsigned kp = key[i] >> (TOPK_LOW + 1); const unsigned long long m = __ballot(kp == tp);
            if (kp == tp) ulist[run + (unsigned)__popcll(m & below_)] = key[i];
            run += (unsigned)__popcll(m); }
    }
    __syncthreads();
    if (nund <= (unsigned)TOPK_UMAX) {
        unsigned u4[4];
#pragma unroll
        for (int k = 0; k < 4; ++k) { const unsigned idx = (unsigned)tid + (unsigned)NTHR * k; u4[k] = idx < nund ? ulist[idx] : 0u; }
        { const unsigned cand = T | (1u << bit);
          unsigned c = 0u;
#pragma unroll
          for (int k = 0; k < 4; ++k) c += (unsigned)__popcll(__ballot(u4[k] >= cand));
          LAS unsigned* wb = wcnt + 1024 + (bit & 1) * 8;
          if (lane == 0) wb[wave] = c;
          __syncthreads();
          unsigned tot = nabove;
#pragma unroll
          for (int w = 0; w < 8; ++w) tot += wb[w];
          if (tot >= (unsigned)CAP) T = cand;
          --bit; }
        static_assert(TOPK_LOW % 3 == 0, "the fast stage takes bit TOPK_LOW alone, then three bits per pass");
        LAS unsigned* w7 = wcnt + 1200;
#pragma unroll 1
        for (int lb = bit - 2, ps = 0; lb >= 0; lb -= 3, ++ps) {
            unsigned c7[7];
#pragma unroll
            for (int j = 0; j < 7; ++j) { const unsigned cand = T | ((unsigned)(j + 1) << lb); unsigned c = 0u;
#pragma unroll
                for (int k = 0; k < 4; ++k) c += (unsigned)__popcll(__ballot(u4[k] >= cand));
                c7[j] = c; }
            LAS unsigned* wb = w7 + (ps & 1) * 56;
            if (lane == 0) {
#pragma unroll
                for (int j = 0; j < 7; ++j) wb[j * 8 + wave] = c7[j]; }
            __syncthreads();
            unsigned best = 0u;
#pragma unroll
            for (int j = 0; j < 7; ++j) { unsigned tot = nabove;
#pragma unroll
                for (int w = 0; w < 8; ++w) tot += wb[j * 8 + w];
                if (tot >= (unsigned)CAP) best = (unsigned)(j + 1); }
            T |= best << lb;
        }
        bit = -1;
    } else {
#pragma unroll 1
        for (; bit >= 0; --bit) {
            const unsigned cand = T | (1u << bit);
            unsigned c = 0u;
#pragma unroll
            for (int i = 0; i < 32; ++i) c += (unsigned)__popcll(__ballot(key[i] >= cand));
            LAS unsigned* wb = wcnt + 1024 + (bit & 1) * 8;
            if (lane == 0) wb[wave] = c;
            __syncthreads();
            unsigned tot = 0u;
#pragma unroll
            for (int w = 0; w < 8; ++w) tot += wb[w];
            if (tot >= (unsigned)CAP) T = cand;
        }
    }
    __syncthreads();
    unsigned long long below = (1ull << lane) - 1ull;
    unsigned rg[32], rq[32];
#pragma unroll
    for (int i = 0; i < 32; ++i) {
        const unsigned long long bg = __ballot(key[i] > T), bq = __ballot(key[i] == T);
        rg[i] = (unsigned)__popcll(bg & below); rq[i] = (unsigned)__popcll(bq & below);
        if (lane == 0) { cg[i * 8 + wave] = (unsigned)__popcll(bg); ce[i * 8 + wave] = (unsigned)__popcll(bq); }
    }
    __syncthreads();
    if (wave == 0) {
        unsigned g4[4], q4[4], sg = 0u, sq = 0u;
#pragma unroll
        for (int k = 0; k < 4; ++k) { g4[k] = cg[4 * lane + k]; q4[k] = ce[4 * lane + k]; sg += g4[k]; sq += q4[k]; }
        unsigned pg = sg, pq = sq;
#pragma unroll
        for (int o = 1; o < 64; o <<= 1) { const unsigned tg = __shfl_up(pg, o), tq = __shfl_up(pq, o); if (lane >= o) { pg += tg; pq += tq; } }
        pg -= sg; pq -= sq;
#pragma unroll
        for (int k = 0; k < 4; ++k) { cg[4 * lane + k] = pg; ce[4 * lane + k] = pq; pg += g4[k]; pq += q4[k]; }
        if (lane == 63) { wcnt[8] = pg; }
    }
    __syncthreads();
    const unsigned ngt = wcnt[8], need = (unsigned)CAP - ngt;
#pragma unroll
    for (int i = 0; i < 32; ++i) {
        const int tok = i * NTHR + tid;
        const unsigned gb = cg[i * 8 + wave] + rg[i], qb = ce[i * 8 + wave] + rq[i];
        const bool sel = key[i] > T || (key[i] == T && qb < need);
        const unsigned slot = gb + (qb < need ? qb : need);
        if (sel) { IDX[slot] = tok; GATE[slot] = __uint_as_float(key[i]); }
        TOKSLOT[(size_t)e * NTOK + tok] = sel ? (int)slot : -1;
    }
}

struct P5Prob {
    static constexpr int K = DM; static constexpr bool PERM = true, FP8 = true; static constexpr int SCW = 0x7A7A7A7A, SCA = 0x7F7F7F7F;
    const unsigned char* H2; const unsigned char* WguT; unsigned char* HID; pg8::StaticOrder so;
    __device__ __forceinline__ bool next(int i, pg8::Unit& u) const { return so.next(i, u); }
    __device__ __forceinline__ const char* aptr(const pg8::Unit&) const { return (const char*)H2; }
    __device__ __forceinline__ const char* bptr(const pg8::Unit& u) const { return (const char*)(WguT + ((size_t)(u.pm >> 3) * 4096 + (size_t)u.pn * 256) * DM); }
    __device__ __forceinline__ void epi(const pg8::f32x4 (&acc)[2][2][4][2], const pg8::Unit& u, int wr, int wc, int fr, int fq) const {
#pragma unroll
        for (int ai = 0; ai < 2; ++ai)
#pragma unroll
            for (int m = 0; m < 4; ++m) { unsigned char* rowp = HID + (size_t)(u.pm * 256 + ai * 128 + wr * 64 + m * 16 + fr) * DE + u.pn * 128 + wc * 32 + 8 * fq;
                float h[8];
#pragma unroll
                for (int n = 0; n < 2; ++n)
#pragma unroll
                    for (int e = 0; e < 4; ++e) { const float gt = acc[ai][0][m][n][e], up = acc[ai][1][m][n][e]; h[4 * n + e] = gt * __builtin_amdgcn_rcpf(1.f + __builtin_amdgcn_exp2f(-1.4426950408889634f * gt)) * up; }
                *(v2u*)rowp = (v2u){pk4_fp8(h[0], h[1], h[2], h[3]), pk4_fp8(h[4], h[5], h[6], h[7])}; }
    }
};
struct P6Prob {
    static constexpr int K = DE; static constexpr bool PERM = true, FP8 = true; static constexpr int SCW = 0x7A7A7A7A, SCA = 0x7F7F7F7F;
    const unsigned char* HID; const unsigned char* WdT; const float* GATE; bf16* YE; pg8::StaticOrder so;
    __device__ __forceinline__ bool next(int i, pg8::Unit& u) const { return so.next(i, u); }
    __device__ __forceinline__ const char* aptr(const pg8::Unit& u) const { return (const char*)(HID + (size_t)u.pm * 256 * DE); }
    __device__ __forceinline__ const char* bptr(const pg8::Unit& u) const { return (const char*)(WdT + ((size_t)(u.pm >> 3) * DM + (size_t)u.pn * 256) * DE); }
    __device__ __forceinline__ void epi(const pg8::f32x4 (&acc)[2][2][4][2], const pg8::Unit& u, int wr, int wc, int fr, int fq) const {
        float gt8[2][4];
#pragma unroll
        for (int ai = 0; ai < 2; ++ai)
#pragma unroll
            for (int m = 0; m < 4; ++m) gt8[ai][m] = GATE[u.pm * 256 + ai * 128 + wr * 64 + m * 16 + fr];
#pragma unroll
        for (int ai = 0; ai < 2; ++ai)
#pragma unroll
            for (int m = 0; m < 4; ++m) { const int row = u.pm * 256 + ai * 128 + wr * 64 + m * 16 + fr; const float gt = gt8[ai][m]; bf16* rowp = YE + (size_t)row * DM + u.pn * 256 + wc * 32 + 8 * fq;
#pragma unroll
                for (int bj = 0; bj < 2; ++bj) { const pg8::f32x4 v0 = acc[ai][bj][m][0] * gt, v1 = acc[ai][bj][m][1] * gt;
                    *(v4u*)(rowp + bj * 128) = (v4u){pk2(v0[0], v0[1]), pk2(v0[2], v0[3]), pk2(v1[0], v1[1]), pk2(v1[2], v1[3])}; } }
    }
};

__device__ __forceinline__ void p7_final(const Args& a, int vcu, int G, int wave, unsigned poison) {
    const int lane = fresh_lane();
    unsigned char* ws = a.ws; const float* MOD = (const float*)(ws + WS_MOD); const bf16* YE = (const bf16*)(ws + WS_YE); const int* TOKSLOT = (const int*)(ws + WS_TOKSLOT);
    const float* src = (STEP >= 2) ? (const float*)(ws + WS_X1) : a.x;
    f32x4 g2[4], fg[4];
#pragma unroll
    for (int j = 0; j < 4; ++j) { const int col = 4 * lane + 256 * j; g2[j] = *(const f32x4*)(MOD + 5 * DM + col); fg[j] = *(const f32x4*)(a.final_norm_g + col); }
    const int gw = vcu * NWAVES + wave, NGW = G * NWAVES;
    int slot_n = (STEP >= 4 && gw < NTOK && lane < 16) ? TOKSLOT[(size_t)lane * NTOK + gw] : -1;
    for (int m = gw; m < NTOK; m += NGW) {
        const GAS f32x4* xr = (const GAS f32x4*)(src + (size_t)m * DM) + lane;
        f32x4 v[4];
#pragma unroll
        for (int j = 0; j < 4; ++j) v[j] = xr[64 * j];
        if (STEP >= 4) {
            const int myslot = slot_n;
            { const int mn = m + NGW; slot_n = (mn < NTOK && lane < 16) ? TOKSLOT[(size_t)lane * NTOK + mn] : -1; }
            f32x4 s[4];
#pragma unroll
            for (int j = 0; j < 4; ++j) s[j] = (f32x4){0.f, 0.f, 0.f, 0.f};
            unsigned msk = (unsigned)__ballot(myslot >= 0) & 0xffffu;
#pragma unroll 1
            while (msk) {
                const int e0 = __builtin_ctz(msk); msk &= msk - 1u;
                const int e1 = msk ? __builtin_ctz(msk) : e0; const bool two = msk != 0u; msk &= msk - 1u;
                const int sl0 = __builtin_amdgcn_readlane(myslot, e0), sl1 = __builtin_amdgcn_readlane(myslot, e1);
                const GAS v2u* y0 = (const GAS v2u*)(YE + ((size_t)e0 * CAP + sl0) * DM) + lane; const GAS v2u* y1 = (const GAS v2u*)(YE + ((size_t)e1 * CAP + sl1) * DM) + lane;
                v2u w0[4], w1[4];
#pragma unroll
                for (int j = 0; j < 4; ++j) w0[j] = y0[64 * j];
#pragma unroll
                for (int j = 0; j < 4; ++j) w1[j] = y1[64 * j];
#pragma unroll
                for (int j = 0; j < 4; ++j) { s[j].x += __uint_as_float(w0[j].x << 16); s[j].y += __uint_as_float(w0[j].x & 0xffff0000u); s[j].z += __uint_as_float(w0[j].y << 16); s[j].w += __uint_as_float(w0[j].y & 0xffff0000u); }
                if (two) {
#pragma unroll
                    for (int j = 0; j < 4; ++j) { s[j].x += __uint_as_float(w1[j].x << 16); s[j].y += __uint_as_float(w1[j].x & 0xffff0000u); s[j].z += __uint_as_float(w1[j].y << 16); s[j].w += __uint_as_float(w1[j].y & 0xffff0000u); } }
            }
#pragma unroll
            for (int j = 0; j < 4; ++j) v[j] += g2[j] * s[j];
        }
        float ss = 0.f;
#pragma unroll
        for (int j = 0; j < 4; ++j) ss += (v[j].x * v[j].x + v[j].y * v[j].y) + (v[j].z * v[j].z + v[j].w * v[j].w);
        const float rinv = 1.f / sqrtf(wave_sum(ss) * (1.f / DM) + EPS);
        GAS f32x4* o = (GAS f32x4*)(a.out + (size_t)m * DM) + lane;
        const float q = __builtin_nanf("");
#pragma unroll
        for (int j = 0; j < 4; ++j) { f32x4 y = v[j] * rinv * fg[j]; if (poison) y = (f32x4){q, q, q, q}; o[64 * j] = y; }
    }
}


#if PROBE
__device__ __forceinline__ void dsincos(double x, double& sn, double& cs) {
    const double TWO_PI = 6.283185307179586476925286766559; x -= TWO_PI * rint(x / TWO_PI);
    const double x2 = x * x; double ts = x, tc = 1.0; sn = x; cs = 1.0;
#pragma unroll 1
    for (int k = 1; k <= 14; ++k) { tc *= -x2 / (double)((2 * k - 1) * (2 * k)); ts *= -x2 / (double)((2 * k) * (2 * k + 1)); cs += tc; sn += ts; }
}
__device__ __forceinline__ float block_sum(float v, LAS float* red, int wave, int lane) {
    v = wave_sum(v); __syncthreads(); if (lane == 0) red[wave] = v; __syncthreads(); float s = 0.f;
#pragma unroll
    for (int w = 0; w < 8; ++w) s += red[w];
    return s;
}
__device__ __forceinline__ float block_max(float v, LAS float* red, int wave, int lane) {
#pragma unroll
    for (int o = 1; o < 64; o <<= 1) v = fmaxf(v, __shfl_xor(v, o));
    __syncthreads(); if (lane == 0) red[wave] = v; __syncthreads(); float s = red[0];
#pragma unroll
    for (int w = 1; w < 8; ++w) s = fmaxf(s, red[w]);
    return s;
}
__device__ __forceinline__ void probe_qkv(const Args& a, LAS unsigned char* lds, int vcu, int wave) {
    const int lane = fresh_lane(), tid = wave * 64 + lane; unsigned char* ws = a.ws;
    const bf16* XN = (const bf16*)(ws + WS_XN); const bf16* Qb = (const bf16*)(ws + WS_Q); const bf16* Kb = (const bf16*)(ws + WS_K); const bf16* Vb = (const bf16*)(ws + WS_V);
    gu32* ctl = (gu32*)(ws + WS_CTL);
    LAS float* red = (LAS float*)lds; LAS float* raw = red + 16;
    for (int kind = 0; kind < 3; ++kind) {
        const int nrows = kind == 0 ? NTOK : NROWS, nh = kind == 0 ? NHQ : NHKV;
        const int t = (kind == 1 && (vcu & 7) == 3) ? NTOK + (vcu * 37) % NCTX : (vcu * 977 + 131 * kind + 5) % (kind == 0 ? NTOK : NTOK);
        const int h = (vcu * 5 + kind) % nh;
        const int wcol0 = 256 + (kind == 0 ? 0 : (kind == 1 ? 768 : 1024)) + 64 * h;
        { const int d = tid & 63, part = tid >> 6; float sacc = 0.f;
          for (int k = part * 128; k < part * 128 + 128; ++k) sacc += bf2f(XN[(size_t)t * DM + k]) * a.w_in[(size_t)k * INW + wcol0 + d];
          LAS float* part_s = raw + 64; part_s[part * 64 + d] = sacc; __syncthreads();
          if (tid < 64) { float s2 = 0.f; for (int pp = 0; pp < 8; ++pp) s2 += part_s[pp * 64 + tid]; raw[tid] = s2; }
          __syncthreads(); }
        float ref = 0.f, got = 0.f;
        if (tid < 64) {
            const int d = tid; float v = raw[d];
            if (kind < 2) {
                float ss = 0.f; for (int j = 0; j < 64; ++j) ss += raw[j] * raw[j];
                const float* gw = kind == 0 ? a.q_norm_g : a.k_norm_g;
                const float rinv = 1.f / sqrtf(ss / 64.f + EPS);
                if (t < NTOK) {
                    const int half = d >> 5, dd = d & 31, i = dd & 15; const int pos = half == 0 ? (t >> 6) : (t & 63);
                    const double freq = exp2(-(double)i * (13.287712379549449 / 16.0)); double sn, cs; dsincos((double)pos * freq, sn, cs);
                    const float x1 = raw[32 * half + i] * rinv * gw[32 * half + i], x2 = raw[32 * half + 16 + i] * rinv * gw[32 * half + 16 + i];
                    v = dd < 16 ? (float)(x1 * cs - x2 * sn) : (float)(x1 * sn + x2 * cs);
                } else v = v * rinv * gw[d];
                if (kind == 0) v *= attn_body::C2;
            }
            ref = v;
#if ATTN_F8
            { const unsigned char* Q8 = (const unsigned char*)Qb; const unsigned char* K8 = (const unsigned char*)Kb; const unsigned char* V8 = (const unsigned char*)Vb;
              if (kind == 0) got = __builtin_amdgcn_cvt_f32_fp8((int)Q8[(size_t)t * 768 + 64 * h + d], 0) * (1.f / 16.f);
              else if (kind == 1) got = __builtin_amdgcn_cvt_f32_fp8((int)K8[(size_t)t * 256 + 64 * h + d], 0);
              else { const int kk = t & 63, tile = t >> 6, k5 = kk & 31, hk = (k5 >> 2) & 1, j = (k5 & 3) + 4 * (k5 >> 3) + 16 * (kk >> 5);
                     got = __builtin_amdgcn_cvt_f32_fp8((int)V8[(size_t)(h * (NKEYS / 64) + tile) * 4096 + (j >> 4) * 2048 + d * 32 + 16 * (hk ^ ((d >> 3) & 1)) + (j & 15)], 0); } }
#else
            got = kind == 0 ? bf2f(Qb[(size_t)t * 768 + 64 * h + d]) : (kind == 1 ? bf2f(Kb[(size_t)t * 256 + 64 * h + d]) : bf2f(Vb[(size_t)t * 256 + 64 * h + d]));
#endif
        }
        const float mx = block_max(fabsf(ref), red, wave, lane);
        const float err = block_max(fabsf(ref - got), red, wave, lane);
        if (tid == 0 && !(err <= (ATTN_F8 ? 0.07f : 0.03f) * mx + 1e-6f)) __hip_atomic_fetch_or(ctl + CW_FLAG, 1u << kind, RLX_AGENT);
        __syncthreads();
    }
}
__device__ __forceinline__ void probe_attn(const Args& a, LAS unsigned char* lds, int vcu, int wave) {
    const int lane = fresh_lane(), tid = wave * 64 + lane; unsigned char* ws = a.ws;
    const bf16* Qb = (const bf16*)(ws + WS_Q); const bf16* Kb = (const bf16*)(ws + WS_K); const bf16* Vb = (const bf16*)(ws + WS_V); const bf16* MIX = (const bf16*)(ws + WS_MIX);
    gu32* ctl = (gu32*)(ws + WS_CTL);
    LAS float* red = (LAS float*)lds; LAS float* ored = red + 16;
    const int t = (vcu * 613 + 29) % NTOK, h = (vcu * 7 + 3) % NHQ, kvh = h / 3;
    float q[64];
#if ATTN_F8
    const unsigned char* Q8 = (const unsigned char*)Qb; const unsigned char* K8 = (const unsigned char*)Kb; const unsigned char* V8 = (const unsigned char*)Vb;
#pragma unroll
    for (int d = 0; d < 64; ++d) q[d] = __builtin_amdgcn_cvt_f32_fp8((int)Q8[(size_t)t * 768 + 64 * h + d], 0) * (1.f / 16.f);
#else
#pragma unroll
    for (int d = 0; d < 64; ++d) q[d] = bf2f(Qb[(size_t)t * 768 + 64 * h + d]);
#endif
    float sc[33]; float mx = -1e30f;
#pragma unroll
    for (int i = 0; i < 33; ++i) { const int key = i * NTHR + tid; float s = -1e30f;
#if ATTN_F8
        if (key < NKEYS) { s = 0.f; const unsigned char* kr = K8 + (size_t)key * 256 + 64 * kvh;
#pragma unroll
            for (int d = 0; d < 64; ++d) s += q[d] * __builtin_amdgcn_cvt_f32_fp8((int)kr[d], 0); }
#else
        if (key < NKEYS) { s = 0.f; const bf16* kr = Kb + (size_t)key * 256 + 64 * kvh;
#pragma unroll
            for (int d = 0; d < 64; ++d) s += q[d] * bf2f(kr[d]); }
#endif
        sc[i] = s; mx = fmaxf(mx, s); }
    mx = block_max(mx, red, wave, lane);
    float den = 0.f; float o[64];
#pragma unroll
    for (int d = 0; d < 64; ++d) o[d] = 0.f;
#pragma unroll
    for (int i = 0; i < 33; ++i) { const int key = i * NTHR + tid;
#if ATTN_F8
        if (key < NKEYS) { const float pp = exp2f(sc[i] - mx); den += pp; const int kk = key & 63, tile = key >> 6, k5 = kk & 31, hk = (k5 >> 2) & 1, j = (k5 & 3) + 4 * (k5 >> 3) + 16 * (kk >> 5);
            const unsigned char* vb = V8 + (size_t)(kvh * (NKEYS / 64) + tile) * 4096 + (j >> 4) * 2048 + (j & 15);
#pragma unroll
            for (int d = 0; d < 64; ++d) o[d] += pp * __builtin_amdgcn_cvt_f32_fp8((int)vb[d * 32 + 16 * (hk ^ ((d >> 3) & 1))], 0); } }
#else
        if (key < NKEYS) { const float pp = exp2f(sc[i] - mx); den += pp; const bf16* vr = Vb + (size_t)key * 256 + 64 * kvh;
#pragma unroll
            for (int d = 0; d < 64; ++d) o[d] += pp * bf2f(vr[d]); } }
#endif
    den = block_sum(den, red, wave, lane);
#pragma unroll
    for (int d = 0; d < 64; ++d) { const float w = wave_sum(o[d]); if (lane == 0) ored[wave * 64 + d] = w; }
    __syncthreads();
    float ref = 0.f, got = 0.f;
    if (tid < 64) { float s = 0.f; for (int w = 0; w < 8; ++w) s += ored[w * 64 + tid]; ref = s / den; got = bf2f(MIX[(size_t)t * DM + 256 + 64 * h + tid]); }
    const float m2 = block_max(fabsf(ref), red, wave, lane);
    const float err = block_max(fabsf(ref - got), red, wave, lane);
    if (tid == 0 && !(err <= 0.03f * m2 + 1e-7f)) __hip_atomic_fetch_or(ctl + CW_FLAG, 8u, RLX_AGENT);
    __syncthreads();
}
#endif

__global__ void __launch_bounds__(NTHR, 2) fwd_megakernel(Args args) {
    extern __shared__ __attribute__((aligned(16))) unsigned char lds_raw[];
    LAS unsigned char* lds = (LAS unsigned char*)lds_raw;
    volatile LAS unsigned* MISC = (volatile LAS unsigned*)(lds + MISC_OFF);
    const int wave = __builtin_amdgcn_readfirstlane(threadIdx.x >> 6);
    const int G = gridDim.x; const int bx = blockIdx.x; const int vcu = (G % 8 == 0) ? (bx % 8) * (G / 8) + bx / 8 : bx;
    unsigned char* ws = args.ws;
    gu32* ctl = (gu32*)(ws + WS_CTL);
    { const int l0 = fresh_lane(); if (wave < 2) ((LAS unsigned*)(lds + MISC_OFF))[wave * 64 + l0] = 0u;
      __syncthreads();
    }
    XcdBarrier bar = xcd_barrier_post((unsigned*)(ctl + CW_BAR), MISC + 8, wave == 0 && fresh_lane() == 0);
#define GRID_BAR() xcd_barrier(bar, wave)

    for (int rep = 0; rep < REP(0); ++rep) {
    if (STEP >= 2 && PH(0)) p0_prologue(args, lds, vcu, G, wave);
    GRID_BAR(); }
    for (int rep = 0; rep < REP(1); ++rep) {
    if (STEP >= 2 && PH(1)) p0b_modulate(args, vcu, G, wave);
    GRID_BAR(); }
    for (int rep = 0; rep < REP(2); ++rep) {
    if (STEP >= 2 && PH(2)) {
        P1Prob p; p.XN = (bf16*)(ws + WS_XN); p.WinT = (bf16*)(ws + WS_WIN); p.Q = (bf16*)(ws + WS_Q); p.Kb = (bf16*)(ws + WS_K); p.Vb = (bf16*)(ws + WS_V); p.FT = (float*)(ws + WS_FT);
        p.qg = args.q_norm_g; p.kg = args.k_norm_g; p.kmax = (unsigned*)(ctl + CW_KMAX); p.so.init(NROWS / 256, INW / 256, G, bx);
        pg8::gemm_phase<P1Prob, false, true, true>(lds, p, nullptr, wave);
        if (rep == 0 && MOE_S1 > 0) {
            const int nwg = (NROWS / 256) * (INW / 256), maxc = (nwg + G - 1) / G, c0 = nwg - (maxc - 1) * G;
            if (c0 >= G) moe_convert(args, (LAS float*)(lds + wave * 16640), MOE_B0, MOE_B1, bx * NWAVES + wave, G * NWAVES);
            else if (bx >= c0) moe_convert(args, (LAS float*)(lds + wave * 16640), MOE_B0, MOE_B1, (bx - c0) * NWAVES + wave, (G - c0) * NWAVES);
        }
    }
    GRID_BAR(); }
#if PROBE == 1
    probe_qkv(args, lds, vcu, wave);
#endif
    if (REP(12) > 1) {
        P1Prob p; p.XN = (bf16*)(ws + WS_XN); p.WinT = (bf16*)(ws + WS_WIN); p.Q = (bf16*)(ws + WS_Q); p.Kb = (bf16*)(ws + WS_K); p.Vb = (bf16*)(ws + WS_V); p.FT = (float*)(ws + WS_FT);
        p.qg = args.q_norm_g; p.kg = args.k_norm_g; p.kmax = (unsigned*)(ctl + CW_KMAX); p.so.init(NROWS / 256, INW / 256, G, bx);
        pg8::gemm_phase<P1Prob, false, true, true>(lds, p, nullptr, wave);
        GRID_BAR(); }
    for (int rep = 0; rep < REP(3); ++rep) {
    if (STEP >= 2 && PH(3)) {
        for (int item = vcu; item < 256; item += G) fft_block(args, lds, item, wave);
        if (rep == 0 && MOE_S2 > 0) {
            if (G > 256) { if (vcu >= 256) moe_convert(args, (LAS float*)(lds + wave * 16640), MOE_B1, MOE_B2, (vcu - 256) * NWAVES + wave, (G - 256) * NWAVES); }
            else moe_convert(args, (LAS float*)(lds + wave * 16640), MOE_B1, MOE_B2, vcu * NWAVES + wave, G * NWAVES);
        }
    }
    if (rep + 1 < REP(3)) GRID_BAR(); }
    for (int rep = 0; rep < REP(4); ++rep) {
    if (STEP >= 3 && PH(4)) {
        const attn_body::bf16* Qb = (const attn_body::bf16*)(ws + WS_Q); const attn_body::bf16* Kb = (const attn_body::bf16*)(ws + WS_K); const attn_body::bf16* Vb = (const attn_body::bf16*)(ws + WS_V);
        attn_body::bf16* MIX = (attn_body::bf16*)(ws + WS_MIX);
        const float kmax2 = __uint_as_float(__hip_atomic_load(ctl + CW_KMAX, RLX_AGENT));
        const int u0 = (G == 256) ? vcu * 3 : vcu, ustep = (G == 256) ? 1 : G, uend = (G == 256) ? vcu * 3 + 3 : 768;
        ConvW cw; cw.a = &args; cw.cr = -1; cw.cd = moe_desc(args, 0); { const int nsub = 8 * (MOE_ITEMS - MOE_B3), per = (nsub + NWAVES * G - 1) / (NWAVES * G), w0 = 8 * MOE_B3 + (vcu * NWAVES + wave) * per; cw.next = (rep == 0) ? w0 : 8 * MOE_ITEMS; cw.end = (rep == 0) ? (w0 + per < 8 * MOE_ITEMS ? w0 + per : 8 * MOE_ITEMS) : 8 * MOE_ITEMS; if (cw.next > cw.end) cw.next = cw.end; cw.stride = 1; }
        int ucnt = 0;
#pragma unroll 1
        for (int u = u0; u < uend; u += ustep, ++ucnt) {
            const int kvh = u / 192, w = u % 192, h = kvh * 3 + w / 64, qb = w % 64;
#if ATTN_F8
            attn_body::attn_unit_f8<0>(h, kvh, qb, (const unsigned char*)Qb, (const unsigned char*)Kb, (const unsigned char*)Vb, MIX, (char*)lds_raw, wave, kmax2, cw);
#ifdef DUMMYVAR
            { attn_body::NoConv nc; attn_body::attn_unit_f8<(DUMMYVAR) | 8>(h, kvh, qb, (const unsigned char*)Qb, (const unsigned char*)Kb, (const unsigned char*)Vb, MIX, (char*)lds_raw, wave, kmax2, nc); }
#endif
#else
            attn_body::attn_unit<8>(h, kvh, qb, Qb, Kb, Vb, MIX, (char*)lds_raw, wave, kmax2);
#endif
        }
#if ATTN_F8
        attn_body::conv_drain(cw, (char*)lds_raw, wave);
#else
        if (rep == 0 && MOE_B3 < MOE_ITEMS) moe_convert(args, (LAS float*)(lds + wave * 16640), MOE_B3, MOE_ITEMS, wave * G + vcu, NWAVES * G);
#endif
    } else if (STEP == 2) {
        bf16* MIX = (bf16*)(ws + WS_MIX);
        const int gw = vcu * NWAVES + wave, NGW = G * NWAVES, lane = fresh_lane();
        for (int m = gw; m < NTOK; m += NGW) { GAS v4u* o = (GAS v4u*)(MIX + (size_t)m * DM + 256); o[lane] = (v4u){0u, 0u, 0u, 0u}; if (lane < 32) o[64 + lane] = (v4u){0u, 0u, 0u, 0u}; }
    }
    GRID_BAR(); }
#if PROBE == 2
    probe_attn(args, lds, vcu, wave);
#endif
    for (int rep = 0; rep < REP(5); ++rep) {
    if (STEP >= 2 && PH(5)) {
        P3Prob p; p.MIX = (bf16*)(ws + WS_MIX); p.WoT = (bf16*)(ws + WS_WOUT); p.x = args.x; p.g1 = (const float*)(ws + WS_MOD) + 2 * DM; p.X1 = (float*)(ws + WS_X1); p.so.init(NTOK / 256, DM / 256, G, bx);
        pg8::gemm_phase<P3Prob, false, true, true>(lds, p, nullptr, wave);
    }
    GRID_BAR(); }
    for (int rep = 0; rep < REP(6); ++rep) {
    if (STEP >= 4 && PH(6)) p3b_router(args, lds, vcu, G, wave);
    GRID_BAR(); }
    for (int rep = 0; rep < REP(7); ++rep) {
    if (STEP >= 4 && PH(7)) {
#pragma unroll 1
        for (int e = vcu; e < NE; e += G) p4_topk(args, lds, e, wave);
        if (rep == 0) {
            if (G > NE) { if (vcu >= NE) moe_convert(args, (LAS float*)(lds + wave * 16640), MOE_B2, MOE_B3, (vcu - NE) * NWAVES + wave, (G - NE) * NWAVES); }
            else moe_convert(args, (LAS float*)(lds + wave * 16640), MOE_B2, MOE_B3, vcu * NWAVES + wave, G * NWAVES);
        } }
    GRID_BAR(); }
    if (REP(11) > 1) {
        moe_convert(args, (LAS float*)(lds + wave * 16640), MOE_B2, MOE_B3, vcu * NWAVES + wave, G * NWAVES);
        GRID_BAR(); }
    for (int rep = 0; rep < REP(8); ++rep) {
    if (STEP >= 4 && PH(8)) {
        P5Prob p; p.H2 = (const unsigned char*)(ws + WS_H2); p.WguT = (const unsigned char*)(ws + WS_WGU); p.HID = (unsigned char*)(ws + WS_HID); p.so.init(NE * CAP / 256, 2 * DE / 256, G, bx);
        LAS unsigned* rowtab = (LAS unsigned*)(lds + XTRA_OFF);
        const int* IDX = (const int*)(ws + WS_IDX);
        { const int tid = wave * 64 + fresh_lane(); pg8::Unit u; for (int i = 0; p.so.next(i, u) && i < 28; ++i) { if (tid < 256) rowtab[i * 256 + tid] = (unsigned)IDX[u.pm * 256 + tid]; } }
        __syncthreads();
        pg8::gemm_phase<P5Prob, true, true, true>(lds, p, rowtab, wave);
    }
    GRID_BAR(); }
    for (int rep = 0; rep < REP(9); ++rep) {
    if (STEP >= 4 && PH(9)) {
        P6Prob p; p.HID = (const unsigned char*)(ws + WS_HID); p.WdT = (const unsigned char*)(ws + WS_WD); p.GATE = (const float*)(ws + WS_GATE); p.YE = (bf16*)(ws + WS_YE); p.so.init(NE * CAP / 256, DM / 256, G, bx);
        pg8::gemm_phase<P6Prob, false, true, true>(lds, p, nullptr, wave);
    }
    GRID_BAR(); }
    {
        unsigned poison = (__hip_atomic_load(ctl + CW_BAR + XB_TMO, RLX_AGENT) != 0u) || (__hip_atomic_load(ctl + CW_FLAG, RLX_AGENT) != 0u);
        for (int rep = 0; rep < REP(10); ++rep) p7_final(args, vcu, G, wave, poison);
    }
}

extern "C" void kernel_launch(void* const* d_in, const int* in_sizes, int n_in, void* d_out, int out_size, void* d_ws, size_t ws_size, hipStream_t stream) {
    static int grid = 0;
    if (grid == 0) {
        if (n_in != 18 || in_sizes[0] != NTOK * DM || out_size != NTOK * DM || ws_size < WS_END) { fprintf(stderr, "kernel_launch: unexpected shapes (n_in %d, in0 %d, out %d, ws %zu)\n", n_in, n_in > 0 ? in_sizes[0] : -1, out_size, ws_size); grid = -1; return; }
        int dev = 0, cus = 0, per_cu = 0;
        if (hipGetDevice(&dev) != hipSuccess || hipDeviceGetAttribute(&cus, hipDeviceAttributeMultiprocessorCount, dev) != hipSuccess) { grid = -1; return; }
        if (hipFuncSetAttribute((const void*)fwd_megakernel, hipFuncAttributeMaxDynamicSharedMemorySize, LDS_BYTES) != hipSuccess) { fprintf(stderr, "kernel_launch: hipFuncSetAttribute failed\n"); grid = -1; return; }
        if (hipOccupancyMaxActiveBlocksPerMultiprocessor(&per_cu, (const void*)fwd_megakernel, NTHR, LDS_BYTES) != hipSuccess || per_cu < 1) { fprintf(stderr, "kernel_launch: occupancy query says %d blocks per CU\n", per_cu); (void)hipGetLastError(); grid = -1; return; }
        grid = cus;
    }
    if (grid < 0) return;
    (void)hipMemsetAsync((char*)d_ws + WS_CTL, 0, CTL_ZERO_BYTES, stream);
    Args a{};
    const float** f = (const float**)&a;
    for (int i = 0; i < 18; ++i) f[i] = (const float*)d_in[i];
    a.out = (float*)d_out; a.ws = (unsigned char*)d_ws;
    hipLaunchKernelGGL(fwd_megakernel, dim3(grid), dim3(NTHR), LDS_BYTES, stream, a);
}
```
